# Optimizing an MI355X kernel written in HIP

```python
import math
import jax, jax.numpy as jnp
from jax import lax
import numpy as np

D_MODEL = 2048
BATCH = 4
SEQ = 2048
DEPTH = 2

D_MIX = D_MODEL
CONV_WIDTH = D_MODEL // 4
CONV_K = 3
RET_HEAD_DIM = 128
RET_WIDTH = 3 * D_MODEL // 8
RET_HEADS = RET_WIDTH // RET_HEAD_DIM
HG_HEAD_DIM = 128
HG_WIDTH = D_MIX - CONV_WIDTH - RET_WIDTH
HG_HEADS = HG_WIDTH // HG_HEAD_DIM
IN_COLS = 3 * CONV_WIDTH + 4 * RET_WIDTH + 5 * HG_WIDTH
RET_CHUNK = 128
HG_CHUNK = 64
ROPE_BASE = 10000.0
N_EXPERTS = 16
N_GROUPS = 4
EXPERTS_PER_GROUP = N_EXPERTS // N_GROUPS
TOP_K = 2
D_EXPERT = 1408
MASK_NEG = -1e9
DEEPNORM_ALPHA = (2.0 * DEPTH) ** 0.25
DEEPNORM_BETA = (8.0 * DEPTH) ** -0.25
LN_EPS = 1e-5
HEAD_EPS = 1e-6
FORGET_FLOOR = 1e-6

kernel_name = "hybrid_conv_retention_hgrn2_groupmoe_encoder"


def _layer_norm(x, g, b):
    xf = x.astype(jnp.float32)
    mu = jnp.mean(xf, axis=-1, keepdims=True)
    var = jnp.mean(jnp.square(xf - mu), axis=-1, keepdims=True)
    y = (xf - mu) * lax.rsqrt(var + LN_EPS)
    return (y * g.astype(jnp.float32) + b.astype(jnp.float32)).astype(x.dtype)


def _head_group_norm(x):
    xf = x.astype(jnp.float32)
    mu = jnp.mean(xf, axis=-1, keepdims=True)
    var = jnp.mean(jnp.square(xf - mu), axis=-1, keepdims=True)
    return ((xf - mu) * lax.rsqrt(var + HEAD_EPS)).astype(x.dtype)


def _head_rms_norm(x):
    xf = x.astype(jnp.float32)
    return (xf * lax.rsqrt(jnp.mean(jnp.square(xf), axis=-1, keepdims=True) + HEAD_EPS)).astype(x.dtype)


def _heads(x, n_heads):
    b, t, w = x.shape
    return x.reshape(b, t, n_heads, w // n_heads).transpose(0, 2, 1, 3)


def _merge_heads(x):
    b, h, t, d = x.shape
    return x.transpose(0, 2, 1, 3).reshape(b, t, h * d)


def _flip(x):
    return jnp.flip(x, axis=2)


def _rotary(x):
    t, d = x.shape[2], x.shape[3]
    half = d // 2
    inv_freq = ROPE_BASE ** (-jnp.arange(half, dtype=jnp.float32) / half)
    ang = jnp.arange(t, dtype=jnp.float32)[:, None] * inv_freq[None, :]
    cos = jnp.cos(ang).astype(x.dtype)
    sin = jnp.sin(ang).astype(x.dtype)
    x1, x2 = x[..., :half], x[..., half:]
    return jnp.concatenate([x1 * cos - x2 * sin, x1 * sin + x2 * cos], axis=-1)


def _retention_dir(q, k, v, log_gamma):
    b, h, t, d = q.shape
    L = RET_CHUNK
    n = t // L
    qc = q.reshape(b, h, n, L, d)
    kc = k.reshape(b, h, n, L, d)
    vc = v.reshape(b, h, n, L, d)
    pos = jnp.arange(L, dtype=jnp.float32)
    lg = log_gamma[:, None]
    rel = pos[:, None] - pos[None, :]
    decay = jnp.where(rel >= 0, jnp.exp(lg[:, :, None] * jnp.maximum(rel, 0.0)), 0.0)
    scores = jnp.einsum('bhntd,bhnsd->bhnts', qc, kc) * decay[None, :, None]
    intra = jnp.einsum('bhnts,bhnse->bhnte', scores, vc)
    k_tail = kc * jnp.exp(lg * (L - 1.0 - pos))[None, :, None, :, None]
    chunk_state = jnp.einsum('bhnsd,bhnse->nbhde', k_tail, vc)
    chunk_decay = jnp.exp(log_gamma * L)[None, :, None, None].astype(chunk_state.dtype)

    def step(state, cs):
        return chunk_decay * state + cs, state

    _, prev = lax.scan(step, jnp.zeros_like(chunk_state[0]), chunk_state)
    q_head = qc * jnp.exp(lg * (pos + 1.0))[None, :, None, :, None]
    inter = jnp.einsum('bhntd,nbhde->bhnte', q_head, prev)
    return (intra + inter).reshape(b, h, t, d)


def _hgrn2_dir(q, k, v, logf):
    b, h, t, dk = q.shape
    dv = v.shape[-1]
    L = HG_CHUNK
    n = t // L

    def chunks(a):
        return jnp.moveaxis(a.reshape(b, h, n, L, a.shape[-1]), 2, 0)

    incl = jnp.tril(jnp.ones((L, L), dtype=bool))[:, :, None]

    def step(state, inp):
        qc, kc, vc, gc = inp
        cum = jnp.cumsum(gc, axis=2)
        diff = cum[:, :, :, None, :] - cum[:, :, None, :, :]
        decay = jnp.where(incl, jnp.exp(jnp.where(incl, diff, 0.0)), 0.0)
        scores = jnp.einsum('bhtk,bhsk,bhtsk->bhts', qc, kc, decay)
        intra = jnp.einsum('bhts,bhsv->bhtv', scores, vc)
        inter = jnp.einsum('bhtk,bhkv->bhtv', qc * jnp.exp(cum), state)
        total = cum[:, :, -1:, :]
        k_tail = kc * jnp.exp(total - cum)
        new_state = jnp.exp(total[:, :, 0, :, None]) * state + jnp.einsum('bhsk,bhsv->bhkv', k_tail, vc)
        return new_state, intra + inter

    init = jnp.zeros((b, h, dk, dv), jnp.float32)
    _, out = lax.scan(step, init, (chunks(q), chunks(k), chunks(v), chunks(logf)))
    return jnp.moveaxis(out, 0, 2).reshape(b, h, t, dv)


def _log_forget(z, lb):
    lb = lb.astype(jnp.float32)
    f = lb + (1.0 - lb) * jax.nn.sigmoid(z.astype(jnp.float32))
    return jnp.log(jnp.maximum(f, FORGET_FLOOR))


def _split_cols(proj):
    widths = [CONV_WIDTH] * 3 + [RET_WIDTH] * 4 + [HG_WIDTH] * 5
    offsets = []
    acc = 0
    for w in widths[:-1]:
        acc += w
        offsets.append(acc)
    return jnp.split(proj, offsets, axis=-1)


def _mixer(h, w_in, conv_w, beta, w_out, lb):
    proj = h @ w_in
    (cb, cc, ch, rq, rk, rv, rg, hq, hf_fwd, hf_bwd, hi, hg) = _split_cols(proj)

    u = cc * ch
    up = jnp.pad(u, ((0, 0), (1, 1), (0, 0)))
    y_conv = cb * (up[:, :-2] * conv_w[0] + up[:, 1:-1] * conv_w[1] + up[:, 2:] * conv_w[2])

    head_idx = jnp.arange(RET_HEADS, dtype=jnp.float32)
    lg_fwd = jnp.log1p(-jnp.exp2(-5.0 - head_idx))
    lg_bwd = jnp.log1p(-jnp.exp2(-5.5 - head_idx))
    q = _rotary(_heads(rq, RET_HEADS))
    k = _rotary(_heads(rk, RET_HEADS)) * (RET_HEAD_DIM ** -0.5)
    v = _heads(rv, RET_HEADS)
    r_fwd = _retention_dir(q, k, v, lg_fwd)
    r_bwd = _flip(_retention_dir(_flip(q), _flip(k), _flip(v), lg_bwd))
    y_ret = _merge_heads(_head_group_norm(r_fwd + r_bwd)) * jax.nn.silu(rg)

    gq = _heads(hq, HG_HEADS)
    gv = _heads(hi, HG_HEADS)
    lf_f = _heads(_log_forget(hf_fwd, lb[0]), HG_HEADS)
    lf_b = _heads(_log_forget(hf_bwd, lb[1]), HG_HEADS)
    k_f = -jnp.expm1(lf_f)
    k_b = -jnp.expm1(lf_b)
    o_f = _hgrn2_dir(gq, k_f, gv, lf_f)
    o_b = _flip(_hgrn2_dir(_flip(gq), _flip(k_b), _flip(gv), _flip(lf_b)))
    y_hg = _merge_heads(_head_rms_norm(o_f + o_b)) * jax.nn.silu(hg)

    mixed = jnp.concatenate([y_conv, y_ret, y_hg], axis=-1) * beta
    return mixed @ w_out


def _moe(h, w_router, router_bias, w_gate, w_up, w_down):
    b, t, d = h.shape
    tok = h.reshape(b * t, d)
    scores = jax.nn.softmax((tok @ w_router).astype(jnp.float32), axis=-1)
    sel = scores + router_bias.astype(jnp.float32)
    grouped = sel.reshape(-1, N_GROUPS, EXPERTS_PER_GROUP)
    group_score = lax.top_k(grouped, TOP_K)[0].sum(-1)
    best_group = jnp.argmax(group_score, axis=-1)
    in_group = best_group[:, None] == (jnp.arange(N_EXPERTS) // EXPERTS_PER_GROUP)[None, :]
    _, idx = lax.top_k(jnp.where(in_group, sel, MASK_NEG), TOP_K)
    w = jnp.take_along_axis(scores, idx, axis=-1)
    w = w / jnp.sum(w, axis=-1, keepdims=True)
    gates = jnp.sum(jax.nn.one_hot(idx, N_EXPERTS, dtype=jnp.float32) * w[..., None], axis=1)
    out = jnp.zeros_like(tok)
    for e in range(N_EXPERTS):
        hidden = jax.nn.silu(tok @ w_gate[e]) * (tok @ w_up[e])
        out = out + gates[:, e:e + 1].astype(tok.dtype) * (hidden @ w_down[e])
    return out.reshape(b, t, d)


def setup_inputs(seed: int = 0) -> dict:
    key = jax.random.key(seed)
    ks = jax.random.split(key, 20)
    f32 = jnp.float32
    nrm = lambda k, s: jax.random.normal(k, s, f32)
    D = D_MODEL
    return {
        "x": nrm(ks[0], (BATCH, SEQ, D)),
        "c": nrm(ks[1], (BATCH, D)),
        "emb_ln_g": 1.0 + 0.02 * nrm(ks[2], (D,)),
        "emb_ln_b": 0.02 * nrm(ks[3], (D,)),
        "w_ada": nrm(ks[4], (DEPTH, D, 6 * D)) * (0.1 * D ** -0.5),
        "b_ada": 0.01 * nrm(ks[5], (DEPTH, 6 * D)),
        "w_in": nrm(ks[6], (DEPTH, D, IN_COLS)) * (D ** -0.5),
        "conv_w": nrm(ks[7], (DEPTH, CONV_K, CONV_WIDTH)) * (CONV_K ** -0.5),
        "mix_beta": 1.0 + 0.02 * nrm(ks[8], (DEPTH, D_MIX)),
        "w_out": nrm(ks[9], (DEPTH, D_MIX, D)) * (D_MIX ** -0.5 * DEEPNORM_BETA),
        "hg_lb_logits": nrm(ks[10], (DEPTH, 2, HG_WIDTH)),
        "ln_g": 1.0 + 0.02 * nrm(ks[11], (DEPTH, 2, D)),
        "ln_b": 0.02 * nrm(ks[12], (DEPTH, 2, D)),
        "w_router": nrm(ks[13], (D, N_EXPERTS)) * (D ** -0.5),
        "router_bias": 0.01 * nrm(ks[14], (N_EXPERTS,)),
        "w_gate": nrm(ks[15], (DEPTH, N_EXPERTS, D, D_EXPERT)) * (D ** -0.5),
        "w_up": nrm(ks[16], (DEPTH, N_EXPERTS, D, D_EXPERT)) * (D ** -0.5),
        "w_down": nrm(ks[17], (DEPTH, N_EXPERTS, D_EXPERT, D)) * (D_EXPERT ** -0.5 * DEEPNORM_BETA),
    }


def reference(x, c, emb_ln_g, emb_ln_b, w_ada, b_ada, w_in, conv_w, mix_beta, w_out,
              hg_lb_logits, ln_g, ln_b, w_router, router_bias, w_gate, w_up, w_down):
    p = jax.nn.softmax(hg_lb_logits.astype(jnp.float32), axis=0)
    lb_all = jnp.cumsum(p, axis=0) - p[0:1]
    cond = jax.nn.silu(c)
    x = _layer_norm(x, emb_ln_g, emb_ln_b)
    for l in range(DEPTH):
        mod = (cond @ w_ada[l] + b_ada[l])[:, None, :]
        shift1, scale1, gate1, shift2, scale2, gate2 = jnp.split(mod, 6, axis=-1)
        h = x * (1.0 + scale1) + shift1
        y = _mixer(h, w_in[l], conv_w[l], mix_beta[l], w_out[l], lb_all[l])
        x = _layer_norm(DEEPNORM_ALPHA * x + (1.0 + gate1) * y, ln_g[l, 0], ln_b[l, 0])
        h = x * (1.0 + scale2) + shift2
        y = _moe(h, w_router, router_bias, w_gate[l], w_up[l], w_down[l])
        x = _layer_norm(DEEPNORM_ALPHA * x + (1.0 + gate2) * y, ln_g[l, 1], ln_b[l, 1])
    return x
```

```cpp
#include <hip/hip_runtime.h>
#include <stdint.h>
#include <stdio.h>

#define LAS __attribute__((address_space(3)))
typedef unsigned short bf16_t;
typedef short bf16x8 __attribute__((ext_vector_type(8)));
typedef float f32x4 __attribute__((ext_vector_type(4)));
typedef unsigned u32x4 __attribute__((ext_vector_type(4)));
typedef unsigned u32x2 __attribute__((ext_vector_type(2)));

constexpr int D = 2048, NB = 4, SEQ = 2048, T = NB * SEQ, DEPTH = 2;
constexpr int CW = 512, RW = 768, HWD = 768, INC = 8448;
constexpr int NE = 16, DE = 1408;
constexpr int C_CB = 0, C_CC = 512, C_CH = 1024, C_RQ = 1536, C_RK = 2304, C_RV = 3072, C_RG = 3840, C_HQ = 4608, C_HFF = 5376, C_HFB = 6144, C_HI = 6912, C_HG = 7680;
constexpr int XE_ROWS = 20480;
constexpr float ALPHA = 1.4142135623730951f;

constexpr size_t WS_BAR = 0;
constexpr size_t WS_CNT = 16384;
constexpr size_t WS_ZERO_BYTES = 32768;
constexpr size_t WS_MOD = 32768;
constexpr size_t WS_ROUTE = WS_MOD + 393216;
constexpr size_t WS_WIN = 1048576;
constexpr size_t SZ_WIN = (size_t)DEPTH * INC * D * 2;
constexpr size_t WS_WOUT = WS_WIN + SZ_WIN;
constexpr size_t SZ_WOUT = (size_t)DEPTH * D * D * 2;
constexpr size_t WS_WGU = WS_WOUT + SZ_WOUT;
constexpr size_t SZ_WGU = (size_t)DEPTH * NE * 2 * DE * D * 2;
constexpr size_t WS_WD = WS_WGU + SZ_WGU;
constexpr size_t SZ_WD = (size_t)DEPTH * NE * D * DE * 2;
constexpr size_t WS_XRES = WS_WD + SZ_WD;
constexpr size_t SZ_XRES = (size_t)T * D * 4;
constexpr size_t WS_HA = WS_XRES + SZ_XRES;
constexpr size_t SZ_H = (size_t)T * D * 2;
constexpr size_t WS_HB = WS_HA + SZ_H;
constexpr size_t WS_PROJ = WS_HB + SZ_H;
constexpr size_t SZ_PROJ = (size_t)T * INC * 2;
constexpr size_t WS_OBUF = WS_PROJ + SZ_PROJ;
constexpr size_t SZ_OBUF = (size_t)2 * T * 1536 * 4;
constexpr size_t WS_YE = WS_PROJ;
constexpr size_t SZ_YE = (size_t)XE_ROWS * D * 4;
static_assert(SZ_YE <= SZ_PROJ + SZ_OBUF, "ye alias");
constexpr size_t WS_MIXED = WS_OBUF + SZ_OBUF;
constexpr size_t WS_Y = WS_MIXED + SZ_H;
constexpr size_t SZ_Y = (size_t)T * D * 4;
constexpr size_t WS_XE = WS_Y + SZ_Y;
constexpr size_t SZ_XE = (size_t)XE_ROWS * D * 2;
constexpr size_t WS_HID = WS_XE + SZ_XE;
constexpr size_t SZ_HID = (size_t)XE_ROWS * DE * 2;
constexpr size_t WS_END = WS_HID + SZ_HID;

constexpr int LDS_BYTES = 147456;
constexpr int LDS_MISC = 131072;

struct Params {
    const float *x, *c, *emb_g, *emb_b, *w_ada, *b_ada, *w_in, *conv_w, *mix_beta, *w_out, *lb_logits, *ln_g, *ln_b, *w_router, *router_bias, *w_gate, *w_up, *w_down;
    float* out;
    unsigned char* ws;
    int ph_lo, ph_hi, l_lo, l_hi, fused, pad;
};

__device__ __forceinline__ float bf2f(unsigned b) { return __uint_as_float(b << 16); }
__device__ __forceinline__ unsigned f2bf(float f) { unsigned u = __float_as_uint(f); u += 0x7FFFu + ((u >> 16) & 1u); return u >> 16; }
__device__ __forceinline__ unsigned pack2(float lo, float hi) { return f2bf(lo) | (f2bf(hi) << 16); }
__device__ __forceinline__ float wave_sum(float v) {
#pragma unroll
    for (int o = 32; o > 0; o >>= 1) v += __shfl_xor(v, o, 64);
    return v;
}
__device__ __forceinline__ float half_sum(float v) {
#pragma unroll
    for (int o = 16; o > 0; o >>= 1) v += __shfl_xor(v, o, 64);
    return v;
}
__device__ __forceinline__ float sigmoidf_(float z) { return 1.0f / (1.0f + __expf(-z)); }
__device__ __forceinline__ float siluf_(float z) { return z / (1.0f + __expf(-z)); }

#define XB_TMO      128
#define XB_XCNT(j)  (256  + 64 * (j))
#define XB_XSUB(j)  (1280 + 64 * (j))
#define XB_XGEN(j)  (2304 + 64 * (j))
#define XB_TOP      3328
#define XB_TOPGEN   3392
#define XCD_BAR_WORDS 3456
#define XB_SPIN_CAP (1u << 22)
__device__ __forceinline__ unsigned xb_ld(unsigned* p)              { return __hip_atomic_load(p, __ATOMIC_RELAXED, __HIP_MEMORY_SCOPE_AGENT); }
__device__ __forceinline__ unsigned xb_add(unsigned* p, unsigned v) { return __hip_atomic_fetch_add(p, v, __ATOMIC_RELAXED, __HIP_MEMORY_SCOPE_AGENT); }
__device__ __forceinline__ unsigned xb_xcc_id() { return (unsigned)__builtin_amdgcn_s_getreg((3 << 11) | 20) & 0xFu; }
#define XB_SPIN(cond, bar) do { unsigned _sp = 0; while (cond) { __builtin_amdgcn_s_sleep(1); \
    if ((++_sp & 255u) == 0u) { if (xb_ld(&(bar)[XB_TMO])) break; if (_sp > XB_SPIN_CAP) { atomicAdd(&(bar)[XB_TMO], 1u); break; } } } } while (0)
struct XcdBarrier { unsigned* bar; unsigned x; volatile LAS unsigned* st; };
__device__ __forceinline__ XcdBarrier xcd_barrier_post(unsigned* bar, volatile LAS unsigned* st) {
    XcdBarrier b; b.bar = bar; b.x = xb_xcc_id(); b.st = st;
    if (threadIdx.x == 0) (void)xb_add(&bar[XB_XCNT(b.x)], 1u);
    return b;
}
__device__ __forceinline__ void xcd_barrier_complete(unsigned* bar, unsigned x, unsigned& nloc, unsigned& nx) {
    const unsigned G = gridDim.x * gridDim.y * gridDim.z;
    unsigned sum, cnt, mine, sp = 0u;
    for (;;) {
        sum = 0u; cnt = 0u; mine = 0u;
#pragma unroll
        for (unsigned j = 0; j < 16; ++j) { const unsigned c = xb_ld(&bar[XB_XCNT(j)]); sum += c; cnt += (c > 0u) ? 1u : 0u; mine = (j == x) ? c : mine; }
        if (sum == G) break;
        __builtin_amdgcn_s_sleep(1);
        if ((++sp & 255u) == 0u) { if (xb_ld(&bar[XB_TMO])) break; if (sp > XB_SPIN_CAP) { atomicAdd(&bar[XB_TMO], 1u); break; } }
    }
    nloc = mine > 0u ? mine : 1u; nx = cnt > 0u ? cnt : 1u;
}
__device__ __forceinline__ void xcd_barrier(const XcdBarrier& b) {
    asm volatile("s_waitcnt vmcnt(0)" ::: "memory");
    __syncthreads();
    if (threadIdx.x == 0) {
        unsigned* bar = b.bar;
        __builtin_amdgcn_s_waitcnt(0);
        unsigned nloc = b.st[0], nx = b.st[1];
        if (nloc == 0u) { xcd_barrier_complete(bar, b.x, nloc, nx); b.st[0] = nloc; b.st[1] = nx; }
        const unsigned old = xb_add(&bar[XB_XSUB(b.x)], 1u);
        const unsigned gen = old / nloc;
        if (old + 1u == (gen + 1u) * nloc) {
            __builtin_amdgcn_fence(__ATOMIC_RELEASE, "agent");
            asm volatile("s_waitcnt vmcnt(0)" ::: "memory");
            const unsigned og = xb_add(&bar[XB_TOP], 1u);
            const unsigned tg = og / nx;
            if (og + 1u == (tg + 1u) * nx) xb_add(&bar[XB_TOPGEN], 1u);
            else XB_SPIN(xb_ld(&bar[XB_TOPGEN]) == tg, bar);
            __builtin_amdgcn_fence(__ATOMIC_ACQUIRE, "agent");
            xb_add(&bar[XB_XGEN(b.x)], 1u);
            asm volatile("s_waitcnt vmcnt(0)" ::: "memory");
        } else {
            XB_SPIN(xb_ld(&bar[XB_XGEN(b.x)]) == gen, bar);
            __builtin_amdgcn_fence(__ATOMIC_ACQUIRE, "agent");
            asm volatile("s_waitcnt vmcnt(0)" ::: "memory");
        }
    }
    __syncthreads();
}

namespace pg8 {
constexpr int BM = 256, BK = 64, HALF = 128, HTB = HALF * BK * 2, STAGE_BYTES = 8 * HTB, NXCD = 8, WGM = 8;
__host__ __device__ __forceinline__ int lds_byte(int r, int c) { const int st = (r >> 4) * 2 + (c >> 5), rr = r & 15, cc = c & 31, ob = rr * 64 + cc * 2; return st * 1024 + (ob ^ (((ob >> 9) & 1) << 5)); }
__host__ __device__ __forceinline__ void stage_rc(int b, int& R, int& C) { const int st = b / 1024, sb = b % 1024, swz = sb ^ (((sb >> 9) & 1) << 5); R = (st >> 1) * 16 + swz / 64; C = (st & 1) * 32 + (swz % 64) / 2; }
__host__ __device__ __forceinline__ int perm32(int rho) { const int n = rho >> 4, i = rho & 15; return 8 * (i >> 2) + 4 * n + (i & 3); }

struct Unit { size_t aB, bB; int row0, col0; };
struct Gemm { const bf16_t* A; const bf16_t* Bt; int K; };

struct DenseOrder {
    int nM, nN, nwg, G, c; size_t tstep;
    __device__ void init(int M, int N, int K, int G_, int c_) { nM = M / BM; nN = N / BM; nwg = nM * nN; G = G_; c = c_; tstep = (size_t)BM * K * 2; }
    __device__ bool next(int i, Unit& u) const {
        const long L = (long)i * G + c; if (L >= nwg) return false;
        int wgid = (int)L; { const int q = nwg / NXCD, r = nwg % NXCD, xcd = wgid % NXCD, off = wgid / NXCD; wgid = (xcd < r ? xcd * (q + 1) : r * (q + 1) + (xcd - r) * q) + off; }
        const int nig = WGM * nN, gid = wgid / nig, fm = gid * WGM, gsz = (nM - fm) < WGM ? (nM - fm) : WGM;
        const int pm = fm + ((wgid % nig) % gsz), pn = (wgid % nig) / gsz;
        u.aB = (size_t)pm * tstep; u.bB = (size_t)pn * tstep; u.row0 = pm * BM; u.col0 = pn * BM; return true;
    }
};
struct MoeOrder {
    const LAS int* tab; int NTn, G, c; size_t tstep, bexp;
    __device__ bool next(int i, Unit& u) const {
        const int L = i * G + c; const int MT = tab[16]; if (L >= MT * NTn) return false;
        const int mt = L / NTn, nt = L - mt * NTn; int e = 0;
#pragma unroll
        for (int j = 1; j < 16; ++j) e += (mt >= tab[j]) ? 1 : 0;
        u.aB = (size_t)mt * tstep; u.bB = (size_t)e * bexp + (size_t)nt * tstep; u.row0 = mt * BM; u.col0 = nt * BM; return true;
    }
};

__device__ __forceinline__ unsigned cvt_pk_bf16(float lo, float hi) { unsigned r; asm volatile("v_cvt_pk_bf16_f32 %0, %1, %2" : "=v"(r) : "v"(lo), "v"(hi)); return r; }

struct EpiF32 {
    static constexpr bool PERM = false;
    float* C; int ldc;
    __device__ __forceinline__ void operator()(const f32x4 (&acc)[2][2][4][2], const Unit& u, int wr, int wc, int fr, int fq) const {
        const int row0 = u.row0 + wr * 64 + fr, col0 = u.col0 + wc * 32 + 4 * fq;
#pragma unroll
        for (int ai = 0; ai < 2; ++ai)
#pragma unroll
            for (int m = 0; m < 4; ++m) { float* rowp = C + (size_t)(row0 + ai * HALF + m * 16) * ldc + col0;
#pragma unroll
                for (int bj = 0; bj < 2; ++bj)
#pragma unroll
                    for (int n = 0; n < 2; ++n) *(f32x4*)(rowp + bj * HALF + n * 16) = acc[ai][bj][m][n]; }
    }
};
struct EpiBf16 {
    static constexpr bool PERM = true;
    bf16_t* O; int ldc;
    __device__ __forceinline__ void operator()(const f32x4 (&acc)[2][2][4][2], const Unit& u, int wr, int wc, int fr, int fq) const {
        const int row0 = u.row0 + wr * 64 + fr, col0 = u.col0 + wc * 32 + 8 * fq;
#pragma unroll
        for (int ai = 0; ai < 2; ++ai)
#pragma unroll
            for (int m = 0; m < 4; ++m) { bf16_t* rowp = O + (size_t)(row0 + ai * HALF + m * 16) * ldc + col0;
#pragma unroll
                for (int bj = 0; bj < 2; ++bj) { const f32x4 v0 = acc[ai][bj][m][0], v1 = acc[ai][bj][m][1];
                    u32x4 o; o[0] = cvt_pk_bf16(v0[0], v0[1]); o[1] = cvt_pk_bf16(v0[2], v0[3]); o[2] = cvt_pk_bf16(v1[0], v1[1]); o[3] = cvt_pk_bf16(v1[2], v1[3]);
                    *(u32x4*)(rowp + bj * HALF) = o; } }
    }
};
struct EpiHidden {
    static constexpr bool PERM = true;
    bf16_t* O;
    __device__ __forceinline__ void operator()(const f32x4 (&acc)[2][2][4][2], const Unit& u, int wr, int wc, int fr, int fq) const {
        const int row0 = u.row0 + wr * 64 + fr, col0 = (u.col0 >> 1) + wc * 32 + 8 * fq;
#pragma unroll
        for (int ai = 0; ai < 2; ++ai)
#pragma unroll
            for (int m = 0; m < 4; ++m) { bf16_t* rowp = O + (size_t)(row0 + ai * HALF + m * 16) * DE + col0;
                float h[8];
#pragma unroll
                for (int n = 0; n < 2; ++n)
#pragma unroll
                    for (int j = 0; j < 4; ++j) { const float g = acc[ai][0][m][n][j], up = acc[ai][1][m][n][j]; h[n * 4 + j] = g * __builtin_amdgcn_rcpf(1.0f + __expf(-g)) * up; }
                u32x4 o; o[0] = cvt_pk_bf16(h[0], h[1]); o[1] = cvt_pk_bf16(h[2], h[3]); o[2] = cvt_pk_bf16(h[4], h[5]); o[3] = cvt_pk_bf16(h[6], h[7]);
                *(u32x4*)rowp = o; }
    }
};

template <class Epi, class Sched>
__device__ __forceinline__ void gemm_phase(LAS unsigned char* lds, const Gemm g, const Sched& S, const Epi& E) {
    int tid = threadIdx.x; asm volatile("" : "+v"(tid)); const int wid = __builtin_amdgcn_readfirstlane(tid >> 6), lane = tid & 63, wr = wid >> 2, wc = wid & 3, fr = lane & 15, fq = lane >> 4;
    const int K = g.K, nt = K / BK;
    unsigned voffA[2], voffB[2];
#pragma unroll
    for (int i = 0; i < 2; ++i) { int R, C; stage_rc(tid * 16 + i * 8192, R, C); const int Rb = Epi::PERM ? ((R & ~31) + perm32(R & 31)) : R;
        voffA[i] = (unsigned)(R * K + C) * 2u; voffB[i] = (unsigned)(Rb * K + C) * 2u; }
    const size_t kstep = (size_t)(BK * 2);
    const size_t hstep = (size_t)HALF * K * 2;
    const unsigned ldsw = (unsigned)wid * 1024u;
    const int aoff = lds_byte(wr * 64 + fr, fq * 8), boff = lds_byte(wc * 32 + fr, fq * 8);
#define PG8_SA(b, h) (((b) * 2 + (h)) * HTB)
#define PG8_SB(b, h) ((4 + (b) * 2 + (h)) * HTB)
#define PG8_STAGE(bufoff, gbase, voff) do { _Pragma("unroll") for (int _i = 0; _i < 2; ++_i) \
        __builtin_amdgcn_global_load_lds((const unsigned*)((const char*)(gbase) + (voff)[_i]), (LAS unsigned*)(lds + (bufoff) + ldsw + _i * 8192), 16, 0, 0); } while (0)
#define PG8_LDA(dst, b, h) do { _Pragma("unroll") for (int m = 0; m < 4; ++m) _Pragma("unroll") for (int k = 0; k < 2; ++k) dst[m][k] = *(const LAS bf16x8*)(lds + PG8_SA(b, h) + aoff + m * 2048 + k * 1024); } while (0)
#define PG8_LDB(dst, b, h) do { _Pragma("unroll") for (int n = 0; n < 2; ++n) _Pragma("unroll") for (int k = 0; k < 2; ++k) dst[n][k] = *(const LAS bf16x8*)(lds + PG8_SB(b, h) + boff + n * 2048 + k * 1024); } while (0)
#define PG8_MMA(ai, bj, At, Bt) do { __builtin_amdgcn_s_setprio(1); _Pragma("unroll") for (int m = 0; m < 4; ++m) _Pragma("unroll") for (int n = 0; n < 2; ++n) _Pragma("unroll") for (int k = 0; k < 2; ++k) \
        acc[ai][bj][m][n] = __builtin_amdgcn_mfma_f32_16x16x32_bf16(Bt[n][k], At[m][k], acc[ai][bj][m][n], 0, 0, 0); __builtin_amdgcn_s_setprio(0); } while (0)
#define PG8_WAIT_V(n) asm volatile("s_waitcnt vmcnt(" #n ")" ::: "memory")
#define PG8_WAIT_L(n) asm volatile("s_waitcnt lgkmcnt(" #n ")" ::: "memory")
#define PG8_BAR __builtin_amdgcn_s_barrier()
#define PG8_SCHED __builtin_amdgcn_sched_barrier(0)
    Unit cur, nxt; int ui = 0;
    if (!S.next(0, cur)) return;
    f32x4 acc[2][2][4][2];
#pragma unroll
    for (int a = 0; a < 2; ++a)
#pragma unroll
        for (int b = 0; b < 2; ++b)
#pragma unroll
            for (int m = 0; m < 4; ++m)
#pragma unroll
                for (int n = 0; n < 2; ++n) acc[a][b][m][n] = (f32x4){0.f, 0.f, 0.f, 0.f};
    bf16x8 At[4][2], B0[2][2], B1[2][2];
    const char* cA = (const char*)g.A + cur.aB; const char* cB = (const char*)g.Bt + cur.bB;
    PG8_STAGE(PG8_SB(0, 0), cB, voffB); PG8_STAGE(PG8_SA(0, 0), cA, voffA); PG8_STAGE(PG8_SB(0, 1), cB + hstep, voffB); PG8_STAGE(PG8_SA(0, 1), cA + hstep, voffA);
    if (wr == 1) PG8_BAR;
    PG8_WAIT_V(4); PG8_BAR;
    PG8_STAGE(PG8_SB(1, 0), cB + kstep, voffB); PG8_STAGE(PG8_SA(1, 0), cA + kstep, voffA); PG8_STAGE(PG8_SB(1, 1), cB + hstep + kstep, voffB);
    PG8_WAIT_V(6); PG8_BAR;
    for (;;) {
        const bool has_next = S.next(ui + 1, nxt);
        const char* nA = has_next ? (const char*)g.A + nxt.aB : cA; const char* nB = has_next ? (const char*)g.Bt + nxt.bB : cB;
        for (int t = 0; t < nt; t += 2) {
            const bool last = (t == nt - 2);
            const char* a1 = cA + (size_t)(t + 1) * kstep;
            const char* a2 = last ? nA : cA + (size_t)(t + 2) * kstep; const char* b2 = last ? nB : cB + (size_t)(t + 2) * kstep;
            const char* a3 = a2 + kstep; const char* b3 = b2 + kstep;
            PG8_LDB(B0, 0, 0); PG8_SCHED; PG8_LDA(At, 0, 0); PG8_STAGE(PG8_SA(1, 1), a1 + hstep, voffA);
            PG8_WAIT_L(8); PG8_BAR; PG8_WAIT_L(0); PG8_MMA(0, 0, At, B0); PG8_BAR; PG8_SCHED;
            PG8_LDB(B1, 0, 1); PG8_STAGE(PG8_SB(0, 0), b2, voffB);
            PG8_BAR; PG8_WAIT_L(0); PG8_MMA(0, 1, At, B1); PG8_BAR;
            PG8_LDA(At, 0, 1); PG8_STAGE(PG8_SA(0, 0), a2, voffA);
            PG8_BAR; PG8_WAIT_L(0); PG8_MMA(1, 0, At, B0); PG8_BAR; PG8_SCHED;
            PG8_STAGE(PG8_SB(0, 1), b2 + hstep, voffB);
            PG8_WAIT_V(6); PG8_BAR; PG8_MMA(1, 1, At, B1); PG8_BAR;
            PG8_LDB(B0, 1, 0); PG8_SCHED; PG8_LDA(At, 1, 0); PG8_STAGE(PG8_SA(0, 1), a2 + hstep, voffA);
            PG8_WAIT_L(8); PG8_BAR; PG8_WAIT_L(0); PG8_MMA(0, 0, At, B0); PG8_BAR; PG8_SCHED;
            PG8_LDB(B1, 1, 1); PG8_STAGE(PG8_SB(1, 0), b3, voffB);
            PG8_BAR; PG8_WAIT_L(0); PG8_MMA(0, 1, At, B1); PG8_BAR;
            PG8_LDA(At, 1, 1); PG8_STAGE(PG8_SA(1, 0), a3, voffA);
            PG8_BAR; PG8_WAIT_L(0); PG8_MMA(1, 0, At, B0); PG8_BAR; PG8_SCHED;
            PG8_STAGE(PG8_SB(1, 1), b3 + hstep, voffB);
            PG8_WAIT_V(6); PG8_BAR; PG8_MMA(1, 1, At, B1); PG8_BAR;
        }
        E(acc, cur, wr, wc, fr, fq);
        if (!has_next) break;
#pragma unroll
        for (int a = 0; a < 2; ++a)
#pragma unroll
            for (int b = 0; b < 2; ++b)
#pragma unroll
                for (int m = 0; m < 4; ++m)
#pragma unroll
                    for (int n = 0; n < 2; ++n) acc[a][b][m][n] = (f32x4){0.f, 0.f, 0.f, 0.f};
        cur = nxt; cA = nA; cB = nB; ++ui;
    }
    PG8_WAIT_V(0);
    if (wr == 0) PG8_BAR;
    PG8_BAR;
#undef PG8_SA
#undef PG8_SB
#undef PG8_STAGE
#undef PG8_LDA
#undef PG8_LDB
#undef PG8_MMA
#undef PG8_WAIT_V
#undef PG8_WAIT_L
#undef PG8_BAR
#undef PG8_SCHED
}
}

__device__ __forceinline__ void cvt_tile(const float* __restrict__ src, int lds_, bf16_t* __restrict__ dst, int ldd, int k0, int n0, int drow0, LAS unsigned* tl, int tid) {
    const int kp = tid >> 4, n4 = (tid & 15) * 4;
    const float4 a = *(const float4*)(src + (size_t)(k0 + 2 * kp) * lds_ + n0 + n4);
    const float4 b = *(const float4*)(src + (size_t)(k0 + 2 * kp + 1) * lds_ + n0 + n4);
    tl[(n4 + 0) * 33 + kp] = pack2(a.x, b.x);
    tl[(n4 + 1) * 33 + kp] = pack2(a.y, b.y);
    tl[(n4 + 2) * 33 + kp] = pack2(a.z, b.z);
    tl[(n4 + 3) * 33 + kp] = pack2(a.w, b.w);
    __syncthreads();
    const int n = tid >> 3, kc = (tid & 7) * 4;
    u32x4 o; o[0] = tl[n * 33 + kc]; o[1] = tl[n * 33 + kc + 1]; o[2] = tl[n * 33 + kc + 2]; o[3] = tl[n * 33 + kc + 3];
    *(u32x4*)(dst + (size_t)(drow0 + n) * ldd + k0 + kc * 2) = o;
    __syncthreads();
}

__device__ __forceinline__ void phase_prologue(const Params& p, LAS unsigned char* lds) {
    int tid = threadIdx.x; asm volatile("" : "+v"(tid));
    unsigned char* ws = p.ws;
    {
        LAS float* cond = (LAS float*)lds;
        LAS float* red = (LAS float*)(lds + 32768);
        for (int i = tid; i < 4 * D; i += 512) { const float v = p.c[i]; cond[i] = siluf_(v); }
        __syncthreads();
        for (int ch = blockIdx.x; ch < 256; ch += gridDim.x) {
            const int l = ch >> 7, j0 = (ch & 127) * 96;
            const float* w = p.w_ada + (size_t)l * D * (6 * D);
            const int kg = tid / 24, cl = tid % 24;
            float acc[4][4];
#pragma unroll
            for (int b = 0; b < 4; ++b)
#pragma unroll
                for (int j = 0; j < 4; ++j) acc[b][j] = 0.f;
            if (kg < 21) {
                for (int k = kg; k < D; k += 21) {
                    const float4 wv = *(const float4*)(w + (size_t)k * (6 * D) + j0 + cl * 4);
#pragma unroll
                    for (int b = 0; b < 4; ++b) { const float cv = cond[b * D + k]; acc[b][0] += cv * wv.x; acc[b][1] += cv * wv.y; acc[b][2] += cv * wv.z; acc[b][3] += cv * wv.w; }
                }
#pragma unroll
                for (int b = 0; b < 4; ++b)
#pragma unroll
                    for (int j = 0; j < 4; ++j) red[(kg * 4 + b) * 96 + cl * 4 + j] = acc[b][j];
            }
            __syncthreads();
            if (tid < 384) {
                const int b = tid / 96, col = tid % 96; float s = 0.f;
                for (int g = 0; g < 21; ++g) s += red[(g * 4 + b) * 96 + col];
                float* mod = (float*)(ws + WS_MOD);
                mod[((size_t)l * 4 + b) * (6 * D) + j0 + col] = s + p.b_ada[(size_t)l * 6 * D + j0 + col];
            }
            __syncthreads();
        }
    }
    LAS unsigned* tl = (LAS unsigned*)lds;
    constexpr int T_IN = 32 * 132, T_OUT = 32 * 32, T_GU = 32 * 22, T_DN = 22 * 32;
    constexpr int N0 = DEPTH * T_IN, N1 = N0 + DEPTH * T_OUT, N2 = N1 + DEPTH * NE * 2 * T_GU, N3 = N2 + DEPTH * NE * T_DN;
    for (int ti = blockIdx.x; ti < N3; ti += gridDim.x) {
        if (ti < N0) {
            const int l = ti / T_IN, r = ti % T_IN, kt = r / 132, ntl = r % 132;
            cvt_tile(p.w_in + (size_t)l * D * INC, INC, (bf16_t*)(ws + WS_WIN) + (size_t)l * INC * D, D, kt * 64, ntl * 64, ntl * 64, tl, tid);
        } else if (ti < N1) {
            const int q = ti - N0, l = q / T_OUT, r = q % T_OUT, kt = r / 32, ntl = r % 32;
            cvt_tile(p.w_out + (size_t)l * D * D, D, (bf16_t*)(ws + WS_WOUT) + (size_t)l * D * D, D, kt * 64, ntl * 64, ntl * 64, tl, tid);
        } else if (ti < N2) {
            const int q = ti - N1, mat = q / T_GU, r = q % T_GU, kt = r / 22, ntl = r % 22;
            const int which = mat & 1, le = mat >> 1;
            const float* src = (which ? p.w_up : p.w_gate) + (size_t)le * D * DE;
            const int n0 = ntl * 64, drow0 = (n0 >> 7) * 256 + which * 128 + (n0 & 127);
            cvt_tile(src, DE, (bf16_t*)(ws + WS_WGU) + (size_t)le * (2 * DE) * D, D, kt * 64, n0, drow0, tl, tid);
        } else {
            const int q = ti - N2, le = q / T_DN, r = q % T_DN, kt = r / 32, ntl = r % 32;
            cvt_tile(p.w_down + (size_t)le * DE * D, D, (bf16_t*)(ws + WS_WD) + (size_t)le * D * DE, DE, kt * 64, ntl * 64, ntl * 64, tl, tid);
        }
    }
}

__device__ __forceinline__ void ln_rows(float4 (&v)[8], const float* __restrict__ g, const float* __restrict__ b, int lane) {
    float s = 0.f;
#pragma unroll
    for (int i = 0; i < 8; ++i) s += (v[i].x + v[i].y) + (v[i].z + v[i].w);
    const float mean = wave_sum(s) * (1.0f / D);
    float q = 0.f;
#pragma unroll
    for (int i = 0; i < 8; ++i) { const float a = v[i].x - mean, bb = v[i].y - mean, c = v[i].z - mean, d = v[i].w - mean; q += (a * a + bb * bb) + (c * c + d * d); }
    const float rstd = rsqrtf(wave_sum(q) * (1.0f / D) + 1e-5f);
#pragma unroll
    for (int i = 0; i < 8; ++i) {
        const float4 gv = *(const float4*)(g + i * 256 + lane * 4), bv = *(const float4*)(b + i * 256 + lane * 4);
        v[i].x = (v[i].x - mean) * rstd * gv.x + bv.x; v[i].y = (v[i].y - mean) * rstd * gv.y + bv.y;
        v[i].z = (v[i].z - mean) * rstd * gv.z + bv.z; v[i].w = (v[i].w - mean) * rstd * gv.w + bv.w;
    }
}
__device__ __forceinline__ void modulate_store(const float4 (&v)[8], const float* __restrict__ shift, const float* __restrict__ scale, bf16_t* __restrict__ dst, int lane) {
#pragma unroll
    for (int i = 0; i < 8; ++i) {
        const float4 sh = *(const float4*)(shift + i * 256 + lane * 4), sc = *(const float4*)(scale + i * 256 + lane * 4);
        u32x2 o; o[0] = pack2(v[i].x * (1.f + sc.x) + sh.x, v[i].y * (1.f + sc.y) + sh.y); o[1] = pack2(v[i].z * (1.f + sc.z) + sh.z, v[i].w * (1.f + sc.w) + sh.w);
        *(u32x2*)(dst + i * 256 + lane * 4) = o;
    }
}

__device__ __forceinline__ void phase_ln0(const Params& p) {
    int tid_ = threadIdx.x; asm volatile("" : "+v"(tid_)); const int wave = tid_ >> 6, lane = tid_ & 63;
    const float* mod = (const float*)(p.ws + WS_MOD);
    for (int n = blockIdx.x * 8 + wave; n < T; n += gridDim.x * 8) {
        const int b = n / SEQ;
        float4 v[8];
#pragma unroll
        for (int i = 0; i < 8; ++i) v[i] = *(const float4*)(p.x + (size_t)n * D + i * 256 + lane * 4);
        ln_rows(v, p.emb_g, p.emb_b, lane);
        float* xr = (float*)(p.ws + WS_XRES) + (size_t)n * D;
#pragma unroll
        for (int i = 0; i < 8; ++i) *(float4*)(xr + i * 256 + lane * 4) = v[i];
        const float* mb = mod + ((size_t)0 * 4 + b) * (6 * D);
        modulate_store(v, mb, mb + D, (bf16_t*)(p.ws + WS_HA) + (size_t)n * D, lane);
    }
}

__device__ __forceinline__ void phase_mixer_valu(const Params& p, int l, LAS unsigned char* lds) {
    LAS float* qs = (LAS float*)lds; LAS float* ks = qs + 4096; LAS float* fs = ks + 4096; LAS float* vs = fs + 4096; LAS float* po = vs + 1024;
    int tid = threadIdx.x; asm volatile("" : "+v"(tid)); const int wave = tid >> 6, lane = tid & 63, kk = tid >> 5, vv = tid & 31;
    const bf16_t* proj = (const bf16_t*)(p.ws + WS_PROJ);
    float* obuf = (float*)(p.ws + WS_OBUF);
    for (int u = blockIdx.x; u < 384; u += gridDim.x) {
        const int vsl = u & 3, dir = (u >> 2) & 1, hh = (u >> 3) % 6, b = ((u >> 3) / 6) % 4, type = (u >> 3) / 24;
        float S[8];
#pragma unroll
        for (int j = 0; j < 8; ++j) S[j] = 0.f;
        const float gamma = 1.0f - exp2f(-(dir ? 5.5f : 5.0f) - (float)hh);
        for (int blk = 0; blk < 64; ++blk) {
            const int rb = dir ? 63 - blk : blk, t0 = rb * 32;
            if (type == 0) {
#pragma unroll
                for (int j = 0; j < 4; ++j) {
                    const int idx = tid + 512 * j, tt = idx >> 6, dp = idx & 63;
                    const bf16_t* row = proj + (size_t)(b * SEQ + t0 + tt) * INC;
                    const float q1 = bf2f(row[C_RQ + hh * 128 + dp]), q2 = bf2f(row[C_RQ + hh * 128 + 64 + dp]);
                    const float k1 = bf2f(row[C_RK + hh * 128 + dp]), k2 = bf2f(row[C_RK + hh * 128 + 64 + dp]);
                    const float inv_freq = exp2f(-(float)dp * (13.287712379549449f / 64.0f));
                    const float ang = (float)(t0 + tt) * inv_freq;
                    float rev = ang * 0.15915494309189535f; rev -= rintf(rev);
                    const float sn = __builtin_amdgcn_sinf(rev), cs = __builtin_amdgcn_cosf(rev);
                    qs[tt * 128 + dp] = q1 * cs - q2 * sn; qs[tt * 128 + 64 + dp] = q1 * sn + q2 * cs;
                    ks[tt * 128 + dp] = (k1 * cs - k2 * sn) * 0.08838834764831845f; ks[tt * 128 + 64 + dp] = (k1 * sn + k2 * cs) * 0.08838834764831845f;
                    fs[tt * 128 + dp] = gamma; fs[tt * 128 + 64 + dp] = gamma;
                }
            } else {
#pragma unroll
                for (int j = 0; j < 8; ++j) {
                    const int idx = tid + 512 * j, tt = idx >> 7, d = idx & 127;
                    const bf16_t* row = proj + (size_t)(b * SEQ + t0 + tt) * INC;
                    const float q = bf2f(row[C_HQ + hh * 128 + d]);
                    const float z = bf2f(row[(dir ? C_HFB : C_HFF) + hh * 128 + d]);
                    float lb = 0.f;
                    if (l > 0) { const float a0 = p.lb_logits[(0 * 2 + dir) * HWD + hh * 128 + d], a1 = p.lb_logits[(1 * 2 + dir) * HWD + hh * 128 + d]; lb = 1.0f / (1.0f + expf(a0 - a1)); }
                    float f = lb + (1.0f - lb) * (1.0f / (1.0f + expf(-z)));
                    f = fmaxf(f, 1e-6f);
                    qs[tt * 128 + d] = q; ks[tt * 128 + d] = 1.0f - f; fs[tt * 128 + d] = f;
                }
            }
#pragma unroll
            for (int j = 0; j < 2; ++j) {
                const int idx = tid + 512 * j, tt = idx >> 5, c = idx & 31;
                const bf16_t* row = proj + (size_t)(b * SEQ + t0 + tt) * INC;
                vs[tt * 32 + c] = bf2f(row[(type ? C_HI : C_RV) + hh * 128 + vsl * 32 + c]);
            }
            __syncthreads();
            for (int s = 0; s < 32; ++s) {
                const int ss = dir ? 31 - s : s;
                const f32x4 qa = *(const LAS f32x4*)(qs + ss * 128 + kk * 8), qb = *(const LAS f32x4*)(qs + ss * 128 + kk * 8 + 4);
                const f32x4 ka = *(const LAS f32x4*)(ks + ss * 128 + kk * 8), kb = *(const LAS f32x4*)(ks + ss * 128 + kk * 8 + 4);
                const f32x4 fa = *(const LAS f32x4*)(fs + ss * 128 + kk * 8), fb = *(const LAS f32x4*)(fs + ss * 128 + kk * 8 + 4);
                const float vval = vs[ss * 32 + vv];
                float acc = 0.f;
#pragma unroll
                for (int j = 0; j < 4; ++j) { S[j] = fa[j] * S[j] + ka[j] * vval; acc += S[j] * qa[j]; }
#pragma unroll
                for (int j = 0; j < 4; ++j) { S[4 + j] = fb[j] * S[4 + j] + kb[j] * vval; acc += S[4 + j] * qb[j]; }
                acc += __shfl_xor(acc, 32, 64);
                if (lane < 32) po[(ss * 8 + wave) * 32 + vv] = acc;
            }
            __syncthreads();
#pragma unroll
            for (int j = 0; j < 2; ++j) {
                const int idx = tid + 512 * j, tt = idx >> 5, c = idx & 31;
                float s = 0.f;
#pragma unroll
                for (int w = 0; w < 8; ++w) s += po[(tt * 8 + w) * 32 + c];
                obuf[((size_t)dir * T + (size_t)(b * SEQ + t0 + tt)) * 1536 + type * 768 + hh * 128 + vsl * 32 + c] = s;
            }
        }
        __syncthreads();
    }
}

__device__ __forceinline__ float4 ld_bf4(const bf16_t* p) { const u32x2 r = *(const u32x2*)p; return make_float4(bf2f(r[0] & 0xffffu), bf2f(r[0] >> 16), bf2f(r[1] & 0xffffu), bf2f(r[1] >> 16)); }
__device__ __forceinline__ void phase_finalize(const Params& p, int l) {
    int tid_ = threadIdx.x; asm volatile("" : "+v"(tid_)); const int wave = tid_ >> 6, lane = tid_ & 63;
    const bf16_t* proj = (const bf16_t*)(p.ws + WS_PROJ);
    const float* obuf = (const float*)(p.ws + WS_OBUF);
    bf16_t* mixed = (bf16_t*)(p.ws + WS_MIXED);
    const float* cw = p.conv_w + (size_t)l * 3 * CW;
    const float* beta = p.mix_beta + (size_t)l * D;
    for (int n = blockIdx.x * 8 + wave; n < T; n += gridDim.x * 8) {
        const int t = n % SEQ;
        const bf16_t* row = proj + (size_t)n * INC;
        bf16_t* dst = mixed + (size_t)n * D;
#pragma unroll
        for (int i = 0; i < 8; ++i) {
            const int c = i * 256 + lane * 4;
            float4 r;
            if (i < 2) {
                const float4 cc = ld_bf4(row + C_CC + c), ch = ld_bf4(row + C_CH + c), cb = ld_bf4(row + C_CB + c);
                float4 um = make_float4(0.f, 0.f, 0.f, 0.f), up = um;
                if (t > 0) { const float4 a = ld_bf4(row - INC + C_CC + c), b2 = ld_bf4(row - INC + C_CH + c); um = make_float4(a.x * b2.x, a.y * b2.y, a.z * b2.z, a.w * b2.w); }
                if (t < SEQ - 1) { const float4 a = ld_bf4(row + INC + C_CC + c), b2 = ld_bf4(row + INC + C_CH + c); up = make_float4(a.x * b2.x, a.y * b2.y, a.z * b2.z, a.w * b2.w); }
                const float4 w0 = *(const float4*)(cw + c), w1 = *(const float4*)(cw + CW + c), w2 = *(const float4*)(cw + 2 * CW + c);
                r.x = cb.x * (um.x * w0.x + cc.x * ch.x * w1.x + up.x * w2.x);
                r.y = cb.y * (um.y * w0.y + cc.y * ch.y * w1.y + up.y * w2.y);
                r.z = cb.z * (um.z * w0.z + cc.z * ch.z * w1.z + up.z * w2.z);
                r.w = cb.w * (um.w * w0.w + cc.w * ch.w * w1.w + up.w * w2.w);
            } else {
                const int oc = c - 512;
                const float4 of = *(const float4*)(obuf + (size_t)n * 1536 + oc), ob = *(const float4*)(obuf + ((size_t)T + n) * 1536 + oc);
                float4 o = make_float4(of.x + ob.x, of.y + ob.y, of.z + ob.z, of.w + ob.w);
                float4 gt;
                if (i < 5) {
                    gt = ld_bf4(row + C_RG + oc);
                    const float mu = half_sum((o.x + o.y) + (o.z + o.w)) * (1.0f / 128.0f);
                    o.x -= mu; o.y -= mu; o.z -= mu; o.w -= mu;
                    const float var = half_sum((o.x * o.x + o.y * o.y) + (o.z * o.z + o.w * o.w)) * (1.0f / 128.0f);
                    const float rs = rsqrtf(var + 1e-6f);
                    o.x *= rs; o.y *= rs; o.z *= rs; o.w *= rs;
                } else {
                    gt = ld_bf4(row + C_HG + (oc - 768));
                    const float ms = half_sum((o.x * o.x + o.y * o.y) + (o.z * o.z + o.w * o.w)) * (1.0f / 128.0f);
                    const float rs = rsqrtf(ms + 1e-6f);
                    o.x *= rs; o.y *= rs; o.z *= rs; o.w *= rs;
                }
                r.x = o.x * siluf_(gt.x); r.y = o.y * siluf_(gt.y); r.z = o.z * siluf_(gt.z); r.w = o.w * siluf_(gt.w);
            }
            const float4 bt = *(const float4*)(beta + c);
            u32x2 ov; ov[0] = pack2(r.x * bt.x, r.y * bt.y); ov[1] = pack2(r.z * bt.z, r.w * bt.w);
            *(u32x2*)(dst + c) = ov;
        }
    }
}

__device__ __forceinline__ void phase_ln1_router(const Params& p, int l, LAS unsigned char* lds) {
    int tid = threadIdx.x; asm volatile("" : "+v"(tid)); const int wave = tid >> 6, lane = tid & 63;
    LAS float* wrt = (LAS float*)lds;
    for (int i = tid; i < D * NE / 4; i += 512) {
        const float4 w = *(const float4*)(p.w_router + (size_t)i * 4);
        const int d = i >> 2, e4 = (i & 3) * 4;
        wrt[(e4 + 0) * D + d] = w.x; wrt[(e4 + 1) * D + d] = w.y; wrt[(e4 + 2) * D + d] = w.z; wrt[(e4 + 3) * D + d] = w.w;
    }
    __syncthreads();
    const float* mod = (const float*)(p.ws + WS_MOD);
    const float* y = (const float*)(p.ws + WS_Y);
    float* xres = (float*)(p.ws + WS_XRES);
    unsigned* cnt = (unsigned*)(p.ws + WS_CNT) + l * 16;
    int* route = (int*)(p.ws + WS_ROUTE);
    for (int n = blockIdx.x * 8 + wave; n < T; n += gridDim.x * 8) {
        const int b = n / SEQ;
        const float* mb = mod + ((size_t)l * 4 + b) * (6 * D);
        float4 v[8];
#pragma unroll
        for (int i = 0; i < 8; ++i) {
            const float4 xv = *(const float4*)(xres + (size_t)n * D + i * 256 + lane * 4), yv = *(const float4*)(y + (size_t)n * D + i * 256 + lane * 4);
            const float4 g = *(const float4*)(mb + 2 * D + i * 256 + lane * 4);
            v[i].x = ALPHA * xv.x + (1.f + g.x) * yv.x; v[i].y = ALPHA * xv.y + (1.f + g.y) * yv.y; v[i].z = ALPHA * xv.z + (1.f + g.z) * yv.z; v[i].w = ALPHA * xv.w + (1.f + g.w) * yv.w;
        }
        ln_rows(v, p.ln_g + (size_t)(l * 2 + 0) * D, p.ln_b + (size_t)(l * 2 + 0) * D, lane);
#pragma unroll
        for (int i = 0; i < 8; ++i) *(float4*)(xres + (size_t)n * D + i * 256 + lane * 4) = v[i];
#pragma unroll
        for (int i = 0; i < 8; ++i) {
            const float4 sh = *(const float4*)(mb + 3 * D + i * 256 + lane * 4), sc = *(const float4*)(mb + 4 * D + i * 256 + lane * 4);
            v[i].x = v[i].x * (1.f + sc.x) + sh.x; v[i].y = v[i].y * (1.f + sc.y) + sh.y; v[i].z = v[i].z * (1.f + sc.z) + sh.z; v[i].w = v[i].w * (1.f + sc.w) + sh.w;
        }
        bf16_t* hb = (bf16_t*)(p.ws + WS_HB) + (size_t)n * D;
#pragma unroll
        for (int i = 0; i < 8; ++i) { u32x2 o; o[0] = pack2(v[i].x, v[i].y); o[1] = pack2(v[i].z, v[i].w); *(u32x2*)(hb + i * 256 + lane * 4) = o; }
        float lgv = 0.f;
#pragma unroll 1
        for (int e = 0; e < 16; ++e) {
            float s = 0.f;
#pragma unroll
            for (int i = 0; i < 8; ++i) { const f32x4 w = *(const LAS f32x4*)(wrt + e * D + i * 256 + lane * 4); s += (v[i].x * w[0] + v[i].y * w[1]) + (v[i].z * w[2] + v[i].w * w[3]); }
            s = wave_sum(s);
            lgv = (lane == e) ? s : lgv;
        }
        float lg[16];
#pragma unroll
        for (int e = 0; e < 16; ++e) lg[e] = __int_as_float(__builtin_amdgcn_readlane(__float_as_int(lgv), e));
        float mx = lg[0];
#pragma unroll
        for (int e = 1; e < 16; ++e) mx = fmaxf(mx, lg[e]);
        float sc[16], sum = 0.f;
#pragma unroll
        for (int e = 0; e < 16; ++e) { sc[e] = expf(lg[e] - mx); sum += sc[e]; }
        const float inv = 1.0f / sum;
        float sel[16];
#pragma unroll
        for (int e = 0; e < 16; ++e) { sc[e] *= inv; sel[e] = sc[e] + p.router_bias[e]; }
        float best_gs = -3.0e38f; int bi0 = 0, bi1 = 1; float bw0 = 0.f, bw1 = 0.f;
#pragma unroll
        for (int g = 0; g < 4; ++g) {
            int i0 = 0; float m0 = sel[4 * g];
#pragma unroll
            for (int j = 1; j < 4; ++j) if (sel[4 * g + j] > m0) { m0 = sel[4 * g + j]; i0 = j; }
            int i1 = -1; float m1 = -3.0e38f;
#pragma unroll
            for (int j = 0; j < 4; ++j) if (j != i0 && sel[4 * g + j] > m1) { m1 = sel[4 * g + j]; i1 = j; }
            float w0 = 0.f, w1 = 0.f;
#pragma unroll
            for (int j = 0; j < 4; ++j) { w0 = (j == i0) ? sc[4 * g + j] : w0; w1 = (j == i1) ? sc[4 * g + j] : w1; }
            const float gs = m0 + m1;
            if (gs > best_gs) { best_gs = gs; bi0 = 4 * g + i0; bi1 = 4 * g + i1; bw0 = w0; bw1 = w1; }
        }
        if (lane == 0) {
            const float ws_ = 1.0f / (bw0 + bw1);
            const unsigned p0 = atomicAdd(&cnt[bi0], 1u), p1 = atomicAdd(&cnt[bi1], 1u);
            int* r = route + (size_t)n * 8;
            r[0] = bi0; r[1] = bi1; r[2] = (int)p0; r[3] = (int)p1; r[4] = __float_as_int(bw0 * ws_); r[5] = __float_as_int(bw1 * ws_);
        }
    }
}

__device__ __forceinline__ void build_moe_tab(const Params& p, int l, LAS int* tab) {
    if (threadIdx.x == 0) {
        const unsigned* cnt = (const unsigned*)(p.ws + WS_CNT) + l * 16;
        int acc = 0;
        for (int e = 0; e < 16; ++e) { tab[e] = acc; acc += (int)((cnt[e] + 255u) >> 8); }
        tab[16] = acc;
    }
    __syncthreads();
}

__device__ __forceinline__ void phase_permute(const Params& p, int l, LAS int* tab) {
    build_moe_tab(p, l, tab);
    int tid_ = threadIdx.x; asm volatile("" : "+v"(tid_)); const int wave = tid_ >> 6, lane = tid_ & 63;
    int* route = (int*)(p.ws + WS_ROUTE);
    const bf16_t* hb = (const bf16_t*)(p.ws + WS_HB);
    bf16_t* xe = (bf16_t*)(p.ws + WS_XE);
    for (int n = blockIdx.x * 8 + wave; n < T; n += gridDim.x * 8) {
        int* r = route + (size_t)n * 8;
        const int e0 = r[0], e1 = r[1], p0 = r[2], p1 = r[3];
        const int row0 = tab[e0] * 256 + p0, row1 = tab[e1] * 256 + p1;
        const u32x4* src = (const u32x4*)(hb + (size_t)n * D);
        u32x4* d0 = (u32x4*)(xe + (size_t)row0 * D); u32x4* d1 = (u32x4*)(xe + (size_t)row1 * D);
#pragma unroll
        for (int i = 0; i < 4; ++i) { const u32x4 v = src[i * 64 + lane]; d0[i * 64 + lane] = v; d1[i * 64 + lane] = v; }
        if (lane == 0) { r[6] = row0; r[7] = row1; }
    }
}

__device__ __forceinline__ void phase_ln2(const Params& p, int l) {
    int tid_ = threadIdx.x; asm volatile("" : "+v"(tid_)); const int wave = tid_ >> 6, lane = tid_ & 63;
    const float* mod = (const float*)(p.ws + WS_MOD);
    const float* ye = (const float*)(p.ws + WS_YE);
    float* xres = (float*)(p.ws + WS_XRES);
    const int* route = (const int*)(p.ws + WS_ROUTE);
    for (int n = blockIdx.x * 8 + wave; n < T; n += gridDim.x * 8) {
        const int b = n / SEQ;
        const float* mb = mod + ((size_t)l * 4 + b) * (6 * D);
        const int* r = route + (size_t)n * 8;
        const float w0 = __int_as_float(r[4]), w1 = __int_as_float(r[5]);
        const float* y0 = ye + (size_t)r[6] * D; const float* y1 = ye + (size_t)r[7] * D;
        float4 v[8];
#pragma unroll
        for (int i = 0; i < 8; ++i) {
            const float4 xv = *(const float4*)(xres + (size_t)n * D + i * 256 + lane * 4);
            const float4 a = *(const float4*)(y0 + i * 256 + lane * 4), c = *(const float4*)(y1 + i * 256 + lane * 4);
            const float4 g = *(const float4*)(mb + 5 * D + i * 256 + lane * 4);
            v[i].x = ALPHA * xv.x + (1.f + g.x) * (w0 * a.x + w1 * c.x); v[i].y = ALPHA * xv.y + (1.f + g.y) * (w0 * a.y + w1 * c.y);
            v[i].z = ALPHA * xv.z + (1.f + g.z) * (w0 * a.z + w1 * c.z); v[i].w = ALPHA * xv.w + (1.f + g.w) * (w0 * a.w + w1 * c.w);
        }
        ln_rows(v, p.ln_g + (size_t)(l * 2 + 1) * D, p.ln_b + (size_t)(l * 2 + 1) * D, lane);
        if (l + 1 < DEPTH) {
#pragma unroll
            for (int i = 0; i < 8; ++i) *(float4*)(xres + (size_t)n * D + i * 256 + lane * 4) = v[i];
            const float* mn = mod + ((size_t)(l + 1) * 4 + b) * (6 * D);
            modulate_store(v, mn, mn + D, (bf16_t*)(p.ws + WS_HA) + (size_t)n * D, lane);
        } else {
#pragma unroll
            for (int i = 0; i < 8; ++i) *(float4*)(p.out + (size_t)n * D + i * 256 + lane * 4) = v[i];
        }
    }
}

typedef const __attribute__((address_space(4))) unsigned char* KargPtr;
__device__ __forceinline__ Params load_params(KargPtr q) { asm volatile("" : "+s"(q)); Params lp; __builtin_memcpy(&lp, q, sizeof(Params)); return lp; }

__global__ __launch_bounds__(512, 2) void mega(Params p_in) {
    extern __shared__ __attribute__((aligned(16))) unsigned char smem[];
    LAS unsigned char* lds = (LAS unsigned char*)smem;
    LAS int* tab = (LAS int*)(lds + LDS_MISC + 64);
    KargPtr kp = (KargPtr)__builtin_amdgcn_kernarg_segment_ptr();
    if (threadIdx.x == 0) { *(LAS u32x4*)(lds + LDS_MISC) = (u32x4){0u, 0u, 0u, 0u}; }
    __syncthreads();
    const int fused = p_in.fused, ph_lo = p_in.ph_lo, ph_hi = p_in.ph_hi, l_hi = p_in.l_hi;
    XcdBarrier bar;
    if (fused) bar = xcd_barrier_post((unsigned*)(p_in.ws + WS_BAR), (volatile LAS unsigned*)(lds + LDS_MISC));
    else { bar.bar = (unsigned*)(p_in.ws + WS_BAR); bar.x = 0; bar.st = (volatile LAS unsigned*)(lds + LDS_MISC); }
#ifdef ONLY_PH
#define PH(i) ((i) == ONLY_PH && ph_lo <= (i) && (i) < ph_hi)
#else
#define PH(i) (ph_lo <= (i) && (i) < ph_hi)
#endif
#define SYNC() do { if (fused) xcd_barrier(bar); } while (0)
    const int G = gridDim.x, c = blockIdx.x;
    if (PH(0)) { const Params p = load_params(kp); phase_prologue(p, lds); SYNC(); }
    if (PH(1)) { const Params p = load_params(kp); phase_ln0(p); SYNC(); }
    for (int l = p_in.l_lo; l < l_hi; ++l) {
        if (PH(2)) {
            const Params p = load_params(kp);
            pg8::DenseOrder S; S.init(T, INC, D, G, c);
            pg8::Gemm g{(const bf16_t*)(p.ws + WS_HA), (const bf16_t*)(p.ws + WS_WIN) + (size_t)l * INC * D, D};
            pg8::EpiBf16 E{(bf16_t*)(p.ws + WS_PROJ), INC};
            pg8::gemm_phase(lds, g, S, E);
            SYNC();
        }
        if (PH(3)) { const Params p = load_params(kp); phase_mixer_valu(p, l, lds); SYNC(); }
        if (PH(4)) { const Params p = load_params(kp); phase_finalize(p, l); SYNC(); }
        if (PH(5)) {
            const Params p = load_params(kp);
            pg8::DenseOrder S; S.init(T, D, D, G, c);
            pg8::Gemm g{(const bf16_t*)(p.ws + WS_MIXED), (const bf16_t*)(p.ws + WS_WOUT) + (size_t)l * D * D, D};
            pg8::EpiF32 E{(float*)(p.ws + WS_Y), D};
            pg8::gemm_phase(lds, g, S, E);
            SYNC();
        }
        if (PH(6)) { const Params p = load_params(kp); phase_ln1_router(p, l, lds); SYNC(); }
        if (PH(7)) { const Params p = load_params(kp); phase_permute(p, l, tab); SYNC(); }
        if (PH(8)) {
            const Params p = load_params(kp);
            build_moe_tab(p, l, tab);
            pg8::MoeOrder S; S.tab = tab; S.NTn = 11; S.G = G; S.c = c; S.tstep = (size_t)256 * D * 2; S.bexp = (size_t)2 * DE * D * 2;
            pg8::Gemm g{(const bf16_t*)(p.ws + WS_XE), (const bf16_t*)(p.ws + WS_WGU) + (size_t)l * NE * 2 * DE * D, D};
            pg8::EpiHidden E{(bf16_t*)(p.ws + WS_HID)};
            pg8::gemm_phase(lds, g, S, E);
            SYNC();
        }
        if (PH(9)) {
            const Params p = load_params(kp);
            build_moe_tab(p, l, tab);
            pg8::MoeOrder S; S.tab = tab; S.NTn = 8; S.G = G; S.c = c; S.tstep = (size_t)256 * DE * 2; S.bexp = (size_t)D * DE * 2;
            pg8::Gemm g{(const bf16_t*)(p.ws + WS_HID), (const bf16_t*)(p.ws + WS_WD) + (size_t)l * NE * D * DE, DE};
            pg8::EpiF32 E{(float*)(p.ws + WS_YE), D};
            pg8::gemm_phase(lds, g, S, E);
            SYNC();
        }
        if (PH(10)) { const Params p = load_params(kp); phase_ln2(p, l); SYNC(); }
    }
}

#ifndef MK_FUSED
#define MK_FUSED 0
#endif
extern "C" void kernel_launch(void* const* d_in, const int* in_sizes, int n_in, void* d_out, int out_size, void* d_ws, size_t ws_size, hipStream_t stream) {
    static int grid = 0;
    if (grid == 0) {
        if (n_in != 18 || ws_size < WS_END) { fprintf(stderr, "kernel_launch: unexpected n_in %d or ws_size %zu (< %zu)\n", n_in, ws_size, (size_t)WS_END); grid = -1; return; }
        int dev = 0, cus = 0, per_cu = 0;
        hipGetDevice(&dev);
        hipDeviceGetAttribute(&cus, hipDeviceAttributeMultiprocessorCount, dev);
        if (hipFuncSetAttribute((const void*)mega, hipFuncAttributeMaxDynamicSharedMemorySize, LDS_BYTES) != hipSuccess) { fprintf(stderr, "kernel_launch: hipFuncSetAttribute failed\n"); grid = -1; return; }
        hipOccupancyMaxActiveBlocksPerMultiprocessor(&per_cu, (const void*)mega, 512, LDS_BYTES);
        if (per_cu < 1) fprintf(stderr, "kernel_launch: occupancy query says %d\n", per_cu);
        grid = cus > 0 ? cus : 256;
    }
    if (grid < 0) return;
    hipMemsetAsync(d_ws, 0, WS_ZERO_BYTES, stream);
    Params p{};
    p.x = (const float*)d_in[0]; p.c = (const float*)d_in[1]; p.emb_g = (const float*)d_in[2]; p.emb_b = (const float*)d_in[3];
    p.w_ada = (const float*)d_in[4]; p.b_ada = (const float*)d_in[5]; p.w_in = (const float*)d_in[6]; p.conv_w = (const float*)d_in[7];
    p.mix_beta = (const float*)d_in[8]; p.w_out = (const float*)d_in[9]; p.lb_logits = (const float*)d_in[10]; p.ln_g = (const float*)d_in[11];
    p.ln_b = (const float*)d_in[12]; p.w_router = (const float*)d_in[13]; p.router_bias = (const float*)d_in[14]; p.w_gate = (const float*)d_in[15];
    p.w_up = (const float*)d_in[16]; p.w_down = (const float*)d_in[17];
    p.out = (float*)d_out; p.ws = (unsigned char*)d_ws; p.pad = 0;
#if MK_FUSED
    p.ph_lo = 0; p.ph_hi = 11; p.l_lo = 0; p.l_hi = DEPTH; p.fused = 1;
    hipLaunchKernelGGL(mega, dim3(grid), dim3(512), LDS_BYTES, stream, p);
#else
    p.fused = 0;
    for (int ph = 0; ph < 2; ++ph) { p.ph_lo = ph; p.ph_hi = ph + 1; p.l_lo = 0; p.l_hi = 0; hipLaunchKernelGGL(mega, dim3(grid), dim3(512), LDS_BYTES, stream, p); }
    for (int l = 0; l < DEPTH; ++l)
        for (int ph = 2; ph < 11; ++ph) { p.ph_lo = ph; p.ph_hi = ph + 1; p.l_lo = l; p.l_hi = l + 1; hipLaunchKernelGGL(mega, dim3(grid), dim3(512), LDS_BYTES, stream, p); }
#endif
}
```

```cpp
#include <hip/hip_runtime.h>
#include <stdint.h>
#include <stdio.h>

#define LAS __attribute__((address_space(3)))
typedef unsigned short bf16_t;
typedef short bf16x8 __attribute__((ext_vector_type(8)));
typedef float f32x4 __attribute__((ext_vector_type(4)));
typedef unsigned u32x4 __attribute__((ext_vector_type(4)));
typedef unsigned u32x2 __attribute__((ext_vector_type(2)));

constexpr int D = 2048, NB = 4, SEQ = 2048, T = NB * SEQ, DEPTH = 2;
constexpr int CW = 512, RW = 768, HWD = 768, INC = 8448;
constexpr int NE = 16, DE = 1408;
constexpr int C_CB = 0, C_CC = 512, C_CH = 1024, C_RQ = 1536, C_RK = 2304, C_RV = 3072, C_RG = 3840, C_HQ = 4608, C_HFF = 5376, C_HFB = 6144, C_HI = 6912, C_HG = 7680;
constexpr int XE_ROWS = 20480;
constexpr float ALPHA = 1.4142135623730951f;

constexpr size_t WS_BAR = 0;
constexpr size_t WS_CNT = 16384;
constexpr size_t WS_ZERO_BYTES = 32768;
constexpr size_t WS_MOD = 32768;
constexpr size_t WS_ROUTE = WS_MOD + 393216;
constexpr size_t WS_WIN = 1048576;
constexpr size_t SZ_WIN = (size_t)DEPTH * INC * D * 2;
constexpr size_t WS_WOUT = WS_WIN + SZ_WIN;
constexpr size_t SZ_WOUT = (size_t)DEPTH * D * D * 2;
constexpr size_t WS_WGU = WS_WOUT + SZ_WOUT;
constexpr size_t SZ_WGU = (size_t)DEPTH * NE * 2 * DE * D * 2;
constexpr size_t WS_WD = WS_WGU + SZ_WGU;
constexpr size_t SZ_WD = (size_t)DEPTH * NE * D * DE * 2;
constexpr size_t WS_XRES = WS_WD + SZ_WD;
constexpr size_t SZ_XRES = (size_t)T * D * 4;
constexpr size_t WS_HA = WS_XRES + SZ_XRES;
constexpr size_t SZ_H = (size_t)T * D * 2;
constexpr size_t WS_HB = WS_HA + SZ_H;
constexpr size_t WS_PROJ = WS_HB + SZ_H;
constexpr size_t SZ_PROJ = (size_t)T * INC * 2;
constexpr size_t WS_OBUF = WS_PROJ + SZ_PROJ;
constexpr size_t SZ_OBUF = (size_t)2 * T * 1536 * 4;
constexpr size_t WS_YE = WS_PROJ;
constexpr size_t SZ_YE = (size_t)XE_ROWS * D * 4;
static_assert(SZ_YE <= SZ_PROJ + SZ_OBUF, "ye alias");
constexpr size_t WS_MIXED = WS_OBUF + SZ_OBUF;
constexpr size_t WS_Y = WS_MIXED + SZ_H;
constexpr size_t SZ_Y = (size_t)T * D * 4;
constexpr size_t WS_XE = WS_Y + SZ_Y;
constexpr size_t SZ_XE = (size_t)XE_ROWS * D * 2;
constexpr size_t WS_HID = WS_XE + SZ_XE;
constexpr size_t SZ_HID = (size_t)XE_ROWS * DE * 2;
constexpr size_t WS_END = WS_HID + SZ_HID;

constexpr int LDS_BYTES = 147456;
constexpr int LDS_MISC = 131072;

struct Params {
    const float *x, *c, *emb_g, *emb_b, *w_ada, *b_ada, *w_in, *conv_w, *mix_beta, *w_out, *lb_logits, *ln_g, *ln_b, *w_router, *router_bias, *w_gate, *w_up, *w_down;
    float* out;
    unsigned char* ws;
    int ph_lo, ph_hi, l_lo, l_hi, fused, pad;
};

__device__ __forceinline__ float bf2f(unsigned b) { return __uint_as_float(b << 16); }
__device__ __forceinline__ unsigned f2bf(float f) { unsigned u = __float_as_uint(f); u += 0x7FFFu + ((u >> 16) & 1u); return u >> 16; }
__device__ __forceinline__ unsigned pack2(float lo, float hi) { return f2bf(lo) | (f2bf(hi) << 16); }
__device__ __forceinline__ float wave_sum(float v) {
#pragma unroll
    for (int o = 32; o > 0; o >>= 1) v += __shfl_xor(v, o, 64);
    return v;
}
__device__ __forceinline__ float half_sum(float v) {
#pragma unroll
    for (int o = 16; o > 0; o >>= 1) v += __shfl_xor(v, o, 64);
    return v;
}
__device__ __forceinline__ float sigmoidf_(float z) { return 1.0f / (1.0f + __expf(-z)); }
__device__ __forceinline__ float siluf_(float z) { return z / (1.0f + __expf(-z)); }

#define XB_TMO      128
#define XB_XCNT(j)  (256  + 64 * (j))
#define XB_XSUB(j)  (1280 + 64 * (j))
#define XB_XGEN(j)  (2304 + 64 * (j))
#define XB_TOP      3328
#define XB_TOPGEN   3392
#define XCD_BAR_WORDS 3456
#define XB_SPIN_CAP (1u << 22)
__device__ __forceinline__ unsigned xb_ld(unsigned* p)              { return __hip_atomic_load(p, __ATOMIC_RELAXED, __HIP_MEMORY_SCOPE_AGENT); }
__device__ __forceinline__ unsigned xb_add(unsigned* p, unsigned v) { return __hip_atomic_fetch_add(p, v, __ATOMIC_RELAXED, __HIP_MEMORY_SCOPE_AGENT); }
__device__ __forceinline__ unsigned xb_xcc_id() { return (unsigned)__builtin_amdgcn_s_getreg((3 << 11) | 20) & 0xFu; }
#define XB_SPIN(cond, bar) do { unsigned _sp = 0; while (cond) { __builtin_amdgcn_s_sleep(1); \
    if ((++_sp & 255u) == 0u) { if (xb_ld(&(bar)[XB_TMO])) break; if (_sp > XB_SPIN_CAP) { atomicAdd(&(bar)[XB_TMO], 1u); break; } } } } while (0)
struct XcdBarrier { unsigned* bar; unsigned x; volatile LAS unsigned* st; };
__device__ __forceinline__ XcdBarrier xcd_barrier_post(unsigned* bar, volatile LAS unsigned* st) {
    XcdBarrier b; b.bar = bar; b.x = xb_xcc_id(); b.st = st;
    if (threadIdx.x == 0) (void)xb_add(&bar[XB_XCNT(b.x)], 1u);
    return b;
}
__device__ __forceinline__ void xcd_barrier_complete(unsigned* bar, unsigned x, unsigned& nloc, unsigned& nx) {
    const unsigned G = gridDim.x * gridDim.y * gridDim.z;
    unsigned sum, cnt, mine, sp = 0u;
    for (;;) {
        sum = 0u; cnt = 0u; mine = 0u;
#pragma unroll
        for (unsigned j = 0; j < 16; ++j) { const unsigned c = xb_ld(&bar[XB_XCNT(j)]); sum += c; cnt += (c > 0u) ? 1u : 0u; mine = (j == x) ? c : mine; }
        if (sum == G) break;
        __builtin_amdgcn_s_sleep(1);
        if ((++sp & 255u) == 0u) { if (xb_ld(&bar[XB_TMO])) break; if (sp > XB_SPIN_CAP) { atomicAdd(&bar[XB_TMO], 1u); break; } }
    }
    nloc = mine > 0u ? mine : 1u; nx = cnt > 0u ? cnt : 1u;
}
__device__ __forceinline__ void xcd_barrier(const XcdBarrier& b) {
    asm volatile("s_waitcnt vmcnt(0)" ::: "memory");
    __syncthreads();
    if (threadIdx.x == 0) {
        unsigned* bar = b.bar;
        __builtin_amdgcn_s_waitcnt(0);
        unsigned nloc = b.st[0], nx = b.st[1];
        if (nloc == 0u) { xcd_barrier_complete(bar, b.x, nloc, nx); b.st[0] = nloc; b.st[1] = nx; }
        const unsigned old = xb_add(&bar[XB_XSUB(b.x)], 1u);
        const unsigned gen = old / nloc;
        if (old + 1u == (gen + 1u) * nloc) {
            __builtin_amdgcn_fence(__ATOMIC_RELEASE, "agent");
            asm volatile("s_waitcnt vmcnt(0)" ::: "memory");
            const unsigned og = xb_add(&bar[XB_TOP], 1u);
            const unsigned tg = og / nx;
            if (og + 1u == (tg + 1u) * nx) xb_add(&bar[XB_TOPGEN], 1u);
            else XB_SPIN(xb_ld(&bar[XB_TOPGEN]) == tg, bar);
            __builtin_amdgcn_fence(__ATOMIC_ACQUIRE, "agent");
            xb_add(&bar[XB_XGEN(b.x)], 1u);
            asm volatile("s_waitcnt vmcnt(0)" ::: "memory");
        } else {
            XB_SPIN(xb_ld(&bar[XB_XGEN(b.x)]) == gen, bar);
            __builtin_amdgcn_fence(__ATOMIC_ACQUIRE, "agent");
            asm volatile("s_waitcnt vmcnt(0)" ::: "memory");
        }
    }
    __syncthreads();
}

namespace pg8 {
constexpr int BM = 256, BK = 64, HALF = 128, HTB = HALF * BK * 2, STAGE_BYTES = 8 * HTB, NXCD = 8, WGM = 8;
__host__ __device__ __forceinline__ int lds_byte(int r, int c) { const int st = (r >> 4) * 2 + (c >> 5), rr = r & 15, cc = c & 31, ob = rr * 64 + cc * 2; return st * 1024 + (ob ^ (((ob >> 9) & 1) << 5)); }
__host__ __device__ __forceinline__ void stage_rc(int b, int& R, int& C) { const int st = b / 1024, sb = b % 1024, swz = sb ^ (((sb >> 9) & 1) << 5); R = (st >> 1) * 16 + swz / 64; C = (st & 1) * 32 + (swz % 64) / 2; }
__host__ __device__ __forceinline__ int perm32(int rho) { const int n = rho >> 4, i = rho & 15; return 8 * (i >> 2) + 4 * n + (i & 3); }

struct Unit { size_t aB, bB; int row0, col0; };
struct Gemm { const bf16_t* A; const bf16_t* Bt; int K; };

struct DenseOrder {
    int nM, nN, nwg, G, c; size_t tstep;
    __device__ void init(int M, int N, int K, int G_, int c_) { nM = M / BM; nN = N / BM; nwg = nM * nN; G = G_; c = c_; tstep = (size_t)BM * K * 2; }
    __device__ bool next(int i, Unit& u) const {
        const long L = (long)i * G + c; if (L >= nwg) return false;
        int wgid = (int)L; { const int q = nwg / NXCD, r = nwg % NXCD, xcd = wgid % NXCD, off = wgid / NXCD; wgid = (xcd < r ? xcd * (q + 1) : r * (q + 1) + (xcd - r) * q) + off; }
        const int nig = WGM * nN, gid = wgid / nig, fm = gid * WGM, gsz = (nM - fm) < WGM ? (nM - fm) : WGM;
        const int pm = fm + ((wgid % nig) % gsz), pn = (wgid % nig) / gsz;
        u.aB = (size_t)pm * tstep; u.bB = (size_t)pn * tstep; u.row0 = pm * BM; u.col0 = pn * BM; return true;
    }
};
struct MoeOrder {
    const LAS int* tab; int NTn, G, c; size_t tstep, bexp;
    __device__ bool next(int i, Unit& u) const {
        const int L = i * G + c; const int MT = tab[16]; if (L >= MT * NTn) return false;
        const int mt = L / NTn, nt = L - mt * NTn; int e = 0;
#pragma unroll
        for (int j = 1; j < 16; ++j) e += (mt >= tab[j]) ? 1 : 0;
        u.aB = (size_t)mt * tstep; u.bB = (size_t)e * bexp + (size_t)nt * tstep; u.row0 = mt * BM; u.col0 = nt * BM; return true;
    }
};

__device__ __forceinline__ unsigned cvt_pk_bf16(float lo, float hi) { unsigned r; asm volatile("v_cvt_pk_bf16_f32 %0, %1, %2" : "=v"(r) : "v"(lo), "v"(hi)); return r; }

struct EpiF32 {
    static constexpr bool PERM = false;
    float* C; int ldc;
    __device__ __forceinline__ void operator()(const f32x4 (&acc)[2][2][4][2], const Unit& u, int wr, int wc, int fr, int fq) const {
        const int row0 = u.row0 + wr * 64 + fr, col0 = u.col0 + wc * 32 + 4 * fq;
#pragma unroll
        for (int ai = 0; ai < 2; ++ai)
#pragma unroll
            for (int m = 0; m < 4; ++m) { float* rowp = C + (size_t)(row0 + ai * HALF + m * 16) * ldc + col0;
#pragma unroll
                for (int bj = 0; bj < 2; ++bj)
#pragma unroll
                    for (int n = 0; n < 2; ++n) *(f32x4*)(rowp + bj * HALF + n * 16) = acc[ai][bj][m][n]; }
    }
};
struct EpiBf16 {
    static constexpr bool PERM = true;
    bf16_t* O; int ldc;
    __device__ __forceinline__ void operator()(const f32x4 (&acc)[2][2][4][2], const Unit& u, int wr, int wc, int fr, int fq) const {
        const int row0 = u.row0 + wr * 64 + fr, col0 = u.col0 + wc * 32 + 8 * fq;
#pragma unroll
        for (int ai = 0; ai < 2; ++ai)
#pragma unroll
            for (int m = 0; m < 4; ++m) { bf16_t* rowp = O + (size_t)(row0 + ai * HALF + m * 16) * ldc + col0;
#pragma unroll
                for (int bj = 0; bj < 2; ++bj) { const f32x4 v0 = acc[ai][bj][m][0], v1 = acc[ai][bj][m][1];
                    u32x4 o; o[0] = cvt_pk_bf16(v0[0], v0[1]); o[1] = cvt_pk_bf16(v0[2], v0[3]); o[2] = cvt_pk_bf16(v1[0], v1[1]); o[3] = cvt_pk_bf16(v1[2], v1[3]);
                    *(u32x4*)(rowp + bj * HALF) = o; } }
    }
};
struct EpiHidden {
    static constexpr bool PERM = true;
    bf16_t* O;
    __device__ __forceinline__ void operator()(const f32x4 (&acc)[2][2][4][2], const Unit& u, int wr, int wc, int fr, int fq) const {
        const int row0 = u.row0 + wr * 64 + fr, col0 = (u.col0 >> 1) + wc * 32 + 8 * fq;
#pragma unroll
        for (int ai = 0; ai < 2; ++ai)
#pragma unroll
            for (int m = 0; m < 4; ++m) { bf16_t* rowp = O + (size_t)(row0 + ai * HALF + m * 16) * DE + col0;
                float h[8];
#pragma unroll
                for (int n = 0; n < 2; ++n)
#pragma unroll
                    for (int j = 0; j < 4; ++j) { const float g = acc[ai][0][m][n][j], up = acc[ai][1][m][n][j]; h[n * 4 + j] = g * __builtin_amdgcn_rcpf(1.0f + __expf(-g)) * up; }
                u32x4 o; o[0] = cvt_pk_bf16(h[0], h[1]); o[1] = cvt_pk_bf16(h[2], h[3]); o[2] = cvt_pk_bf16(h[4], h[5]); o[3] = cvt_pk_bf16(h[6], h[7]);
                *(u32x4*)rowp = o; }
    }
};

template <class Epi, class Sched>
__device__ __forceinline__ void gemm_phase(LAS unsigned char* lds, const Gemm g, const Sched& S, const Epi& E) {
    int tid = threadIdx.x; asm volatile("" : "+v"(tid)); const int wid = __builtin_amdgcn_readfirstlane(tid >> 6), lane = tid & 63, wr = wid >> 2, wc = wid & 3, fr = lane & 15, fq = lane >> 4;
    const int K = g.K, nt = K / BK;
    unsigned voffA[2], voffB[2];
#pragma unroll
    for (int i = 0; i < 2; ++i) { int R, C; stage_rc(tid * 16 + i * 8192, R, C); const int Rb = Epi::PERM ? ((R & ~31) + perm32(R & 31)) : R;
        voffA[i] = (unsigned)(R * K + C) * 2u; voffB[i] = (unsigned)(Rb * K + C) * 2u; }
    const size_t kstep = (size_t)(BK * 2);
    const size_t hstep = (size_t)HALF * K * 2;
    const unsigned ldsw = (unsigned)wid * 1024u;
    const int aoff = lds_byte(wr * 64 + fr, fq * 8), boff = lds_byte(wc * 32 + fr, fq * 8);
#define PG8_SA(b, h) (((b) * 2 + (h)) * HTB)
#define PG8_SB(b, h) ((4 + (b) * 2 + (h)) * HTB)
#define PG8_STAGE(bufoff, gbase, voff) do { _Pragma("unroll") for (int _i = 0; _i < 2; ++_i) \
        __builtin_amdgcn_global_load_lds((const unsigned*)((const char*)(gbase) + (voff)[_i]), (LAS unsigned*)(lds + (bufoff) + ldsw + _i * 8192), 16, 0, 0); } while (0)
#define PG8_LDA(dst, b, h) do { _Pragma("unroll") for (int m = 0; m < 4; ++m) _Pragma("unroll") for (int k = 0; k < 2; ++k) dst[m][k] = *(const LAS bf16x8*)(lds + PG8_SA(b, h) + aoff + m * 2048 + k * 1024); } while (0)
#define PG8_LDB(dst, b, h) do { _Pragma("unroll") for (int n = 0; n < 2; ++n) _Pragma("unroll") for (int k = 0; k < 2; ++k) dst[n][k] = *(const LAS bf16x8*)(lds + PG8_SB(b, h) + boff + n * 2048 + k * 1024); } while (0)
#define PG8_MMA(ai, bj, At, Bt) do { __builtin_amdgcn_s_setprio(1); _Pragma("unroll") for (int m = 0; m < 4; ++m) _Pragma("unroll") for (int n = 0; n < 2; ++n) _Pragma("unroll") for (int k = 0; k < 2; ++k) \
        acc[ai][bj][m][n] = __builtin_amdgcn_mfma_f32_16x16x32_bf16(Bt[n][k], At[m][k], acc[ai][bj][m][n], 0, 0, 0); __builtin_amdgcn_s_setprio(0); } while (0)
#define PG8_WAIT_V(n) asm volatile("s_waitcnt vmcnt(" #n ")" ::: "memory")
#define PG8_WAIT_L(n) asm volatile("s_waitcnt lgkmcnt(" #n ")" ::: "memory")
#define PG8_BAR __builtin_amdgcn_s_barrier()
#define PG8_SCHED __builtin_amdgcn_sched_barrier(0)
    Unit cur, nxt; int ui = 0;
    if (!S.next(0, cur)) return;
    f32x4 acc[2][2][4][2];
#pragma unroll
    for (int a = 0; a < 2; ++a)
#pragma unroll
        for (int b = 0; b < 2; ++b)
#pragma unroll
            for (int m = 0; m < 4; ++m)
#pragma unroll
                for (int n = 0; n < 2; ++n) acc[a][b][m][n] = (f32x4){0.f, 0.f, 0.f, 0.f};
    bf16x8 At[4][2], B0[2][2], B1[2][2];
    const char* cA = (const char*)g.A + cur.aB; const char* cB = (const char*)g.Bt + cur.bB;
    PG8_STAGE(PG8_SB(0, 0), cB, voffB); PG8_STAGE(PG8_SA(0, 0), cA, voffA); PG8_STAGE(PG8_SB(0, 1), cB + hstep, voffB); PG8_STAGE(PG8_SA(0, 1), cA + hstep, voffA);
    if (wr == 1) PG8_BAR;
    PG8_WAIT_V(4); PG8_BAR;
    PG8_STAGE(PG8_SB(1, 0), cB + kstep, voffB); PG8_STAGE(PG8_SA(1, 0), cA + kstep, voffA); PG8_STAGE(PG8_SB(1, 1), cB + hstep + kstep, voffB);
    PG8_WAIT_V(6); PG8_BAR;
    for (;;) {
        const bool has_next = S.next(ui + 1, nxt);
        const char* nA = has_next ? (const char*)g.A + nxt.aB : cA; const char* nB = has_next ? (const char*)g.Bt + nxt.bB : cB;
        for (int t = 0; t < nt; t += 2) {
            const bool last = (t == nt - 2);
            const char* a1 = cA + (size_t)(t + 1) * kstep;
            const char* a2 = last ? nA : cA + (size_t)(t + 2) * kstep; const char* b2 = last ? nB : cB + (size_t)(t + 2) * kstep;
            const char* a3 = a2 + kstep; const char* b3 = b2 + kstep;
            PG8_LDB(B0, 0, 0); PG8_SCHED; PG8_LDA(At, 0, 0); PG8_STAGE(PG8_SA(1, 1), a1 + hstep, voffA);
            PG8_WAIT_L(8); PG8_BAR; PG8_WAIT_L(0); PG8_MMA(0, 0, At, B0); PG8_BAR; PG8_SCHED;
            PG8_LDB(B1, 0, 1); PG8_STAGE(PG8_SB(0, 0), b2, voffB);
            PG8_BAR; PG8_WAIT_L(0); PG8_MMA(0, 1, At, B1); PG8_BAR;
            PG8_LDA(At, 0, 1); PG8_STAGE(PG8_SA(0, 0), a2, voffA);
            PG8_BAR; PG8_WAIT_L(0); PG8_MMA(1, 0, At, B0); PG8_BAR; PG8_SCHED;
            PG8_STAGE(PG8_SB(0, 1), b2 + hstep, voffB);
            PG8_WAIT_V(6); PG8_BAR; PG8_MMA(1, 1, At, B1); PG8_BAR;
            PG8_LDB(B0, 1, 0); PG8_SCHED; PG8_LDA(At, 1, 0); PG8_STAGE(PG8_SA(0, 1), a2 + hstep, voffA);
            PG8_WAIT_L(8); PG8_BAR; PG8_WAIT_L(0); PG8_MMA(0, 0, At, B0); PG8_BAR; PG8_SCHED;
            PG8_LDB(B1, 1, 1); PG8_STAGE(PG8_SB(1, 0), b3, voffB);
            PG8_BAR; PG8_WAIT_L(0); PG8_MMA(0, 1, At, B1); PG8_BAR;
            PG8_LDA(At, 1, 1); PG8_STAGE(PG8_SA(1, 0), a3, voffA);
            PG8_BAR; PG8_WAIT_L(0); PG8_MMA(1, 0, At, B0); PG8_BAR; PG8_SCHED;
            PG8_STAGE(PG8_SB(1, 1), b3 + hstep, voffB);
            PG8_WAIT_V(6); PG8_BAR; PG8_MMA(1, 1, At, B1); PG8_BAR;
        }
        E(acc, cur, wr, wc, fr, fq);
        if (!has_next) break;
#pragma unroll
        for (int a = 0; a < 2; ++a)
#pragma unroll
            for (int b = 0; b < 2; ++b)
#pragma unroll
                for (int m = 0; m < 4; ++m)
#pragma unroll
                    for (int n = 0; n < 2; ++n) acc[a][b][m][n] = (f32x4){0.f, 0.f, 0.f, 0.f};
        cur = nxt; cA = nA; cB = nB; ++ui;
    }
    PG8_WAIT_V(0);
    if (wr == 0) PG8_BAR;
    PG8_BAR;
#undef PG8_SA
#undef PG8_SB
#undef PG8_STAGE
#undef PG8_LDA
#undef PG8_LDB
#undef PG8_MMA
#undef PG8_WAIT_V
#undef PG8_WAIT_L
#undef PG8_BAR
#undef PG8_SCHED
}
}

__device__ __forceinline__ void cvt_tile(const float* __restrict__ src, int lds_, bf16_t* __restrict__ dst, int ldd, int k0, int n0, int drow0, LAS unsigned* tl, int tid) {
    const int kp = tid >> 4, n4 = (tid & 15) * 4;
    const float4 a = *(const float4*)(src + (size_t)(k0 + 2 * kp) * lds_ + n0 + n4);
    const float4 b = *(const float4*)(src + (size_t)(k0 + 2 * kp + 1) * lds_ + n0 + n4);
    tl[(n4 + 0) * 33 + kp] = pack2(a.x, b.x);
    tl[(n4 + 1) * 33 + kp] = pack2(a.y, b.y);
    tl[(n4 + 2) * 33 + kp] = pack2(a.z, b.z);
    tl[(n4 + 3) * 33 + kp] = pack2(a.w, b.w);
    __syncthreads();
    const int n = tid >> 3, kc = (tid & 7) * 4;
    u32x4 o; o[0] = tl[n * 33 + kc]; o[1] = tl[n * 33 + kc + 1]; o[2] = tl[n * 33 + kc + 2]; o[3] = tl[n * 33 + kc + 3];
    *(u32x4*)(dst + (size_t)(drow0 + n) * ldd + k0 + kc * 2) = o;
    __syncthreads();
}

__device__ __forceinline__ void phase_prologue(const Params& p, LAS unsigned char* lds) {
    int tid = threadIdx.x; asm volatile("" : "+v"(tid));
    unsigned char* ws = p.ws;
    {
        LAS float* cond = (LAS float*)lds;
        LAS float* red = (LAS float*)(lds + 32768);
        for (int i = tid; i < 4 * D; i += 512) { const float v = p.c[i]; cond[i] = siluf_(v); }
        __syncthreads();
        for (int ch = blockIdx.x; ch < 256; ch += gridDim.x) {
            const int l = ch >> 7, j0 = (ch & 127) * 96;
            const float* w = p.w_ada + (size_t)l * D * (6 * D);
            const int kg = tid / 24, cl = tid % 24;
            float acc[4][4];
#pragma unroll
            for (int b = 0; b < 4; ++b)
#pragma unroll
                for (int j = 0; j < 4; ++j) acc[b][j] = 0.f;
            if (kg < 21) {
                for (int k = kg; k < D; k += 21) {
                    const float4 wv = *(const float4*)(w + (size_t)k * (6 * D) + j0 + cl * 4);
#pragma unroll
                    for (int b = 0; b < 4; ++b) { const float cv = cond[b * D + k]; acc[b][0] += cv * wv.x; acc[b][1] += cv * wv.y; acc[b][2] += cv * wv.z; acc[b][3] += cv * wv.w; }
                }
#pragma unroll
                for (int b = 0; b < 4; ++b)
#pragma unroll
                    for (int j = 0; j < 4; ++j) red[(kg * 4 + b) * 96 + cl * 4 + j] = acc[b][j];
            }
            __syncthreads();
            if (tid < 384) {
                const int b = tid / 96, col = tid % 96; float s = 0.f;
                for (int g = 0; g < 21; ++g) s += red[(g * 4 + b) * 96 + col];
                float* mod = (float*)(ws + WS_MOD);
                mod[((size_t)l * 4 + b) * (6 * D) + j0 + col] = s + p.b_ada[(size_t)l * 6 * D + j0 + col];
            }
            __syncthreads();
        }
    }
    LAS unsigned* tl = (LAS unsigned*)lds;
    constexpr int T_IN = 32 * 132, T_OUT = 32 * 32, T_GU = 32 * 22, T_DN = 22 * 32;
    constexpr int N0 = DEPTH * T_IN, N1 = N0 + DEPTH * T_OUT, N2 = N1 + DEPTH * NE * 2 * T_GU, N3 = N2 + DEPTH * NE * T_DN;
    for (int ti = blockIdx.x; ti < N3; ti += gridDim.x) {
        if (ti < N0) {
            const int l = ti / T_IN, r = ti % T_IN, kt = r / 132, ntl = r % 132;
            cvt_tile(p.w_in + (size_t)l * D * INC, INC, (bf16_t*)(ws + WS_WIN) + (size_t)l * INC * D, D, kt * 64, ntl * 64, ntl * 64, tl, tid);
        } else if (ti < N1) {
            const int q = ti - N0, l = q / T_OUT, r = q % T_OUT, kt = r / 32, ntl = r % 32;
            cvt_tile(p.w_out + (size_t)l * D * D, D, (bf16_t*)(ws + WS_WOUT) + (size_t)l * D * D, D, kt * 64, ntl * 64, ntl * 64, tl, tid);
        } else if (ti < N2) {
            const int q = ti - N1, mat = q / T_GU, r = q % T_GU, kt = r / 22, ntl = r % 22;
            const int which = mat & 1, le = mat >> 1;
            const float* src = (which ? p.w_up : p.w_gate) + (size_t)le * D * DE;
            const int n0 = ntl * 64, drow0 = (n0 >> 7) * 256 + which * 128 + (n0 & 127);
            cvt_tile(src, DE, (bf16_t*)(ws + WS_WGU) + (size_t)le * (2 * DE) * D, D, kt * 64, n0, drow0, tl, tid);
        } else {
            const int q = ti - N2, le = q / T_DN, r = q % T_DN, kt = r / 32, ntl = r % 32;
            cvt_tile(p.w_down + (size_t)le * DE * D, D, (bf16_t*)(ws + WS_WD) + (size_t)le * D * DE, DE, kt * 64, ntl * 64, ntl * 64, tl, tid);
        }
    }
}

__device__ __forceinline__ void ln_rows(float4 (&v)[8], const float* __restrict__ g, const float* __restrict__ b, int lane) {
    float s = 0.f;
#pragma unroll
    for (int i = 0; i < 8; ++i) s += (v[i].x + v[i].y) + (v[i].z + v[i].w);
    const float mean = wave_sum(s) * (1.0f / D);
    float q = 0.f;
#pragma unroll
    for (int i = 0; i < 8; ++i) { const float a = v[i].x - mean, bb = v[i].y - mean, c = v[i].z - mean, d = v[i].w - mean; q += (a * a + bb * bb) + (c * c + d * d); }
    const float rstd = rsqrtf(wave_sum(q) * (1.0f / D) + 1e-5f);
#pragma unroll
    for (int i = 0; i < 8; ++i) {
        const float4 gv = *(const float4*)(g + i * 256 + lane * 4), bv = *(const float4*)(b + i * 256 + lane * 4);
        v[i].x = (v[i].x - mean) * rstd * gv.x + bv.x; v[i].y = (v[i].y - mean) * rstd * gv.y + bv.y;
        v[i].z = (v[i].z - mean) * rstd * gv.z + bv.z; v[i].w = (v[i].w - mean) * rstd * gv.w + bv.w;
    }
}
__device__ __forceinline__ void modulate_store(const float4 (&v)[8], const float* __restrict__ shift, const float* __restrict__ scale, bf16_t* __restrict__ dst, int lane) {
#pragma unroll
    for (int i = 0; i < 8; ++i) {
        const float4 sh = *(const float4*)(shift + i * 256 + lane * 4), sc = *(const float4*)(scale + i * 256 + lane * 4);
        u32x2 o; o[0] = pack2(v[i].x * (1.f + sc.x) + sh.x, v[i].y * (1.f + sc.y) + sh.y); o[1] = pack2(v[i].z * (1.f + sc.z) + sh.z, v[i].w * (1.f + sc.w) + sh.w);
        *(u32x2*)(dst + i * 256 + lane * 4) = o;
    }
}

__device__ __forceinline__ void phase_ln0(const Params& p) {
    int tid_ = threadIdx.x; asm volatile("" : "+v"(tid_)); const int wave = tid_ >> 6, lane = tid_ & 63;
    const float* mod = (const float*)(p.ws + WS_MOD);
    for (int n = blockIdx.x * 8 + wave; n < T; n += gridDim.x * 8) {
        const int b = n / SEQ;
        float4 v[8];
#pragma unroll
        for (int i = 0; i < 8; ++i) v[i] = *(const float4*)(p.x + (size_t)n * D + i * 256 + lane * 4);
        ln_rows(v, p.emb_g, p.emb_b, lane);
        float* xr = (float*)(p.ws + WS_XRES) + (size_t)n * D;
#pragma unroll
        for (int i = 0; i < 8; ++i) *(float4*)(xr + i * 256 + lane * 4) = v[i];
        const float* mb = mod + ((size_t)0 * 4 + b) * (6 * D);
        modulate_store(v, mb, mb + D, (bf16_t*)(p.ws + WS_HA) + (size_t)n * D, lane);
    }
}

__device__ __forceinline__ void phase_mixer_valu(const Params& p, int l, LAS unsigned char* lds) {
    LAS float* qs = (LAS float*)lds; LAS float* ks = qs + 4096; LAS float* fs = ks + 4096; LAS float* vs = fs + 4096; LAS float* po = vs + 1024;
    int tid = threadIdx.x; asm volatile("" : "+v"(tid)); const int wave = tid >> 6, lane = tid & 63, kk = tid >> 5, vv = tid & 31;
    const bf16_t* proj = (const bf16_t*)(p.ws + WS_PROJ);
    float* obuf = (float*)(p.ws + WS_OBUF);
    for (int u = blockIdx.x; u < 384; u += gridDim.x) {
        const int vsl = u & 3, dir = (u >> 2) & 1, hh = (u >> 3) % 6, b = ((u >> 3) / 6) % 4, type = (u >> 3) / 24;
        float S[8];
#pragma unroll
        for (int j = 0; j < 8; ++j) S[j] = 0.f;
        const float gamma = 1.0f - exp2f(-(dir ? 5.5f : 5.0f) - (float)hh);
        for (int blk = 0; blk < 64; ++blk) {
            const int rb = dir ? 63 - blk : blk, t0 = rb * 32;
            if (type == 0) {
#pragma unroll
                for (int j = 0; j < 4; ++j) {
                    const int idx = tid + 512 * j, tt = idx >> 6, dp = idx & 63;
                    const bf16_t* row = proj + (size_t)(b * SEQ + t0 + tt) * INC;
                    const float q1 = bf2f(row[C_RQ + hh * 128 + dp]), q2 = bf2f(row[C_RQ + hh * 128 + 64 + dp]);
                    const float k1 = bf2f(row[C_RK + hh * 128 + dp]), k2 = bf2f(row[C_RK + hh * 128 + 64 + dp]);
                    const float inv_freq = exp2f(-(float)dp * (13.287712379549449f / 64.0f));
                    const float ang = (float)(t0 + tt) * inv_freq;
                    float rev = ang * 0.15915494309189535f; rev -= rintf(rev);
                    const float sn = __builtin_amdgcn_sinf(rev), cs = __builtin_amdgcn_cosf(rev);
                    qs[tt * 128 + dp] = q1 * cs - q2 * sn; qs[tt * 128 + 64 + dp] = q1 * sn + q2 * cs;
                    ks[tt * 128 + dp] = (k1 * cs - k2 * sn) * 0.08838834764831845f; ks[tt * 128 + 64 + dp] = (k1 * sn + k2 * cs) * 0.08838834764831845f;
                    fs[tt * 128 + dp] = gamma; fs[tt * 128 + 64 + dp] = gamma;
                }
            } else {
#pragma unroll
                for (int j = 0; j < 8; ++j) {
                    const int idx = tid + 512 * j, tt = idx >> 7, d = idx & 127;
                    const bf16_t* row = proj + (size_t)(b * SEQ + t0 + tt) * INC;
                    const float q = bf2f(row[C_HQ + hh * 128 + d]);
                    const float z = bf2f(row[(dir ? C_HFB : C_HFF) + hh * 128 + d]);
                    float lb = 0.f;
                    if (l > 0) { const float a0 = p.lb_logits[(0 * 2 + dir) * HWD + hh * 128 + d], a1 = p.lb_logits[(1 * 2 + dir) * HWD + hh * 128 + d]; lb = 1.0f / (1.0f + expf(a0 - a1)); }
                    float f = lb + (1.0f - lb) * (1.0f / (1.0f + expf(-z)));
                    f = fmaxf(f, 1e-6f);
                    qs[tt * 128 + d] = q; ks[tt * 128 + d] = 1.0f - f; fs[tt * 128 + d] = f;
                }
            }
#pragma unroll
            for (int j = 0; j < 2; ++j) {
                const int idx = tid + 512 * j, tt = idx >> 5, c = idx & 31;
                const bf16_t* row = proj + (size_t)(b * SEQ + t0 + tt) * INC;
                vs[tt * 32 + c] = bf2f(row[(type ? C_HI : C_RV) + hh * 128 + vsl * 32 + c]);
            }
            __syncthreads();
            for (int s = 0; s < 32; ++s) {
                const int ss = dir ? 31 - s : s;
                const f32x4 qa = *(const LAS f32x4*)(qs + ss * 128 + kk * 8), qb = *(const LAS f32x4*)(qs + ss * 128 + kk * 8 + 4);
                const f32x4 ka = *(const LAS f32x4*)(ks + ss * 128 + kk * 8), kb = *(const LAS f32x4*)(ks + ss * 128 + kk * 8 + 4);
                const f32x4 fa = *(const LAS f32x4*)(fs + ss * 128 + kk * 8), fb = *(const LAS f32x4*)(fs + ss * 128 + kk * 8 + 4);
                const float vval = vs[ss * 32 + vv];
                float acc = 0.f;
#pragma unroll
                for (int j = 0; j < 4; ++j) { S[j] = fa[j] * S[j] + ka[j] * vval; acc += S[j] * qa[j]; }
#pragma unroll
                for (int j = 0; j < 4; ++j) { S[4 + j] = fb[j] * S[4 + j] + kb[j] * vval; acc += S[4 + j] * qb[j]; }
                acc += __shfl_xor(acc, 32, 64);
                if (lane < 32) po[(ss * 8 + wave) * 32 + vv] = acc;
            }
            __syncthreads();
#pragma unroll
            for (int j = 0; j < 2; ++j) {
                const int idx = tid + 512 * j, tt = idx >> 5, c = idx & 31;
                float s = 0.f;
#pragma unroll
                for (int w = 0; w < 8; ++w) s += po[(tt * 8 + w) * 32 + c];
                obuf[((size_t)dir * T + (size_t)(b * SEQ + t0 + tt)) * 1536 + type * 768 + hh * 128 + vsl * 32 + c] = s;
            }
        }
        __syncthreads();
    }
}

__device__ __forceinline__ float4 ld_bf4(const bf16_t* p) { const u32x2 r = *(const u32x2*)p; return make_float4(bf2f(r[0] & 0xffffu), bf2f(r[0] >> 16), bf2f(r[1] & 0xffffu), bf2f(r[1] >> 16)); }
__device__ __forceinline__ void phase_finalize(const Params& p, int l) {
    int tid_ = threadIdx.x; asm volatile("" : "+v"(tid_)); const int wave = tid_ >> 6, lane = tid_ & 63;
    const bf16_t* proj = (const bf16_t*)(p.ws + WS_PROJ);
    const float* obuf = (const float*)(p.ws + WS_OBUF);
    bf16_t* mixed = (bf16_t*)(p.ws + WS_MIXED);
    const float* cw = p.conv_w + (size_t)l * 3 * CW;
    const float* beta = p.mix_beta + (size_t)l * D;
    for (int n = blockIdx.x * 8 + wave; n < T; n += gridDim.x * 8) {
        const int t = n % SEQ;
        const bf16_t* row = proj + (size_t)n * INC;
        bf16_t* dst = mixed + (size_t)n * D;
#pragma unroll
        for (int i = 0; i < 8; ++i) {
            const int c = i * 256 + lane * 4;
            float4 r;
            if (i < 2) {
                const float4 cc = ld_bf4(row + C_CC + c), ch = ld_bf4(row + C_CH + c), cb = ld_bf4(row + C_CB + c);
                float4 um = make_float4(0.f, 0.f, 0.f, 0.f), up = um;
                if (t > 0) { const float4 a = ld_bf4(row - INC + C_CC + c), b2 = ld_bf4(row - INC + C_CH + c); um = make_float4(a.x * b2.x, a.y * b2.y, a.z * b2.z, a.w * b2.w); }
                if (t < SEQ - 1) { const float4 a = ld_bf4(row + INC + C_CC + c), b2 = ld_bf4(row + INC + C_CH + c); up = make_float4(a.x * b2.x, a.y * b2.y, a.z * b2.z, a.w * b2.w); }
                const float4 w0 = *(const float4*)(cw + c), w1 = *(const float4*)(cw + CW + c), w2 = *(const float4*)(cw + 2 * CW + c);
                r.x = cb.x * (um.x * w0.x + cc.x * ch.x * w1.x + up.x * w2.x);
                r.y = cb.y * (um.y * w0.y + cc.y * ch.y * w1.y + up.y * w2.y);
                r.z = cb.z * (um.z * w0.z + cc.z * ch.z * w1.z + up.z * w2.z);
                r.w = cb.w * (um.w * w0.w + cc.w * ch.w * w1.w + up.w * w2.w);
            } else {
                const int oc = c - 512;
                const float4 of = *(const float4*)(obuf + (size_t)n * 1536 + oc), ob = *(const float4*)(obuf + ((size_t)T + n) * 1536 + oc);
                float4 o = make_float4(of.x + ob.x, of.y + ob.y, of.z + ob.z, of.w + ob.w);
                float4 gt;
                if (i < 5) {
                    gt = ld_bf4(row + C_RG + oc);
                    const float mu = half_sum((o.x + o.y) + (o.z + o.w)) * (1.0f / 128.0f);
                    o.x -= mu; o.y -= mu; o.z -= mu; o.w -= mu;
                    const float var = half_sum((o.x * o.x + o.y * o.y) + (o.z * o.z + o.w * o.w)) * (1.0f / 128.0f);
                    const float rs = rsqrtf(var + 1e-6f);
                    o.x *= rs; o.y *= rs; o.z *= rs; o.w *= rs;
                } else {
                    gt = ld_bf4(row + C_HG + (oc - 768));
                    const float ms = half_sum((o.x * o.x + o.y * o.y) + (o.z * o.z + o.w * o.w)) * (1.0f / 128.0f);
                    const float rs = rsqrtf(ms + 1e-6f);
                    o.x *= rs; o.y *= rs; o.z *= rs; o.w *= rs;
                }
                r.x = o.x * siluf_(gt.x); r.y = o.y * siluf_(gt.y); r.z = o.z * siluf_(gt.z); r.w = o.w * siluf_(gt.w);
            }
            const float4 bt = *(const float4*)(beta + c);
            u32x2 ov; ov[0] = pack2(r.x * bt.x, r.y * bt.y); ov[1] = pack2(r.z * bt.z, r.w * bt.w);
            *(u32x2*)(dst + c) = ov;
        }
    }
}

__device__ __forceinline__ void phase_ln1_router(const Params& p, int l, LAS unsigned char* lds) {
    int tid = threadIdx.x; asm volatile("" : "+v"(tid)); const int wave = tid >> 6, lane = tid & 63;
    LAS float* wrt = (LAS float*)lds;
    for (int i = tid; i < D * NE / 4; i += 512) {
        const float4 w = *(const float4*)(p.w_router + (size_t)i * 4);
        const int d = i >> 2, e4 = (i & 3) * 4;
        wrt[(e4 + 0) * D + d] = w.x; wrt[(e4 + 1) * D + d] = w.y; wrt[(e4 + 2) * D + d] = w.z; wrt[(e4 + 3) * D + d] = w.w;
    }
    __syncthreads();
    const float* mod = (const float*)(p.ws + WS_MOD);
    const float* y = (const float*)(p.ws + WS_Y);
    float* xres = (float*)(p.ws + WS_XRES);
    unsigned* cnt = (unsigned*)(p.ws + WS_CNT) + l * 16;
    int* route = (int*)(p.ws + WS_ROUTE);
    for (int n = blockIdx.x * 8 + wave; n < T; n += gridDim.x * 8) {
        const int b = n / SEQ;
        const float* mb = mod + ((size_t)l * 4 + b) * (6 * D);
        float4 v[8];
#pragma unroll
        for (int i = 0; i < 8; ++i) {
            const float4 xv = *(const float4*)(xres + (size_t)n * D + i * 256 + lane * 4), yv = *(const float4*)(y + (size_t)n * D + i * 256 + lane * 4);
            const float4 g = *(const float4*)(mb + 2 * D + i * 256 + lane * 4);
            v[i].x = ALPHA * xv.x + (1.f + g.x) * yv.x; v[i].y = ALPHA * xv.y + (1.f + g.y) * yv.y; v[i].z = ALPHA * xv.z + (1.f + g.z) * yv.z; v[i].w = ALPHA * xv.w + (1.f + g.w) * yv.w;
        }
        ln_rows(v, p.ln_g + (size_t)(l * 2 + 0) * D, p.ln_b + (size_t)(l * 2 + 0) * D, lane);
#pragma unroll
        for (int i = 0; i < 8; ++i) *(float4*)(xres + (size_t)n * D + i * 256 + lane * 4) = v[i];
#pragma unroll
        for (int i = 0; i < 8; ++i) {
            const float4 sh = *(const float4*)(mb + 3 * D + i * 256 + lane * 4), sc = *(const float4*)(mb + 4 * D + i * 256 + lane * 4);
            v[i].x = v[i].x * (1.f + sc.x) + sh.x; v[i].y = v[i].y * (1.f + sc.y) + sh.y; v[i].z = v[i].z * (1.f + sc.z) + sh.z; v[i].w = v[i].w * (1.f + sc.w) + sh.w;
        }
        bf16_t* hb = (bf16_t*)(p.ws + WS_HB) + (size_t)n * D;
#pragma unroll
        for (int i = 0; i < 8; ++i) { u32x2 o; o[0] = pack2(v[i].x, v[i].y); o[1] = pack2(v[i].z, v[i].w); *(u32x2*)(hb + i * 256 + lane * 4) = o; }
        float lgv = 0.f;
#pragma unroll 1
        for (int e = 0; e < 16; ++e) {
            float s = 0.f;
#pragma unroll
            for (int i = 0; i < 8; ++i) { const f32x4 w = *(const LAS f32x4*)(wrt + e * D + i * 256 + lane * 4); s += (v[i].x * w[0] + v[i].y * w[1]) + (v[i].z * w[2] + v[i].w * w[3]); }
            s = wave_sum(s);
            lgv = (lane == e) ? s : lgv;
        }
        float lg[16];
#pragma unroll
        for (int e = 0; e < 16; ++e) lg[e] = __int_as_float(__builtin_amdgcn_readlane(__float_as_int(lgv), e));
        float mx = lg[0];
#pragma unroll
        for (int e = 1; e < 16; ++e) mx = fmaxf(mx, lg[e]);
        float sc[16], sum = 0.f;
#pragma unroll
        for (int e = 0; e < 16; ++e) { sc[e] = expf(lg[e] - mx); sum += sc[e]; }
        const float inv = 1.0f / sum;
        float sel[16];
#pragma unroll
        for (int e = 0; e < 16; ++e) { sc[e] *= inv; sel[e] = sc[e] + p.router_bias[e]; }
        float best_gs = -3.0e38f; int bi0 = 0, bi1 = 1; float bw0 = 0.f, bw1 = 0.f;
#pragma unroll
        for (int g = 0; g < 4; ++g) {
            int i0 = 0; float m0 = sel[4 * g];
#pragma unroll
            for (int j = 1; j < 4; ++j) if (sel[4 * g + j] > m0) { m0 = sel[4 * g + j]; i0 = j; }
            int i1 = -1; float m1 = -3.0e38f;
#pragma unroll
            for (int j = 0; j < 4; ++j) if (j != i0 && sel[4 * g + j] > m1) { m1 = sel[4 * g + j]; i1 = j; }
            float w0 = 0.f, w1 = 0.f;
#pragma unroll
            for (int j = 0; j < 4; ++j) { w0 = (j == i0) ? sc[4 * g + j] : w0; w1 = (j == i1) ? sc[4 * g + j] : w1; }
            const float gs = m0 + m1;
            if (gs > best_gs) { best_gs = gs; bi0 = 4 * g + i0; bi1 = 4 * g + i1; bw0 = w0; bw1 = w1; }
        }
        if (lane == 0) {
            const float ws_ = 1.0f / (bw0 + bw1);
            const unsigned p0 = atomicAdd(&cnt[bi0], 1u), p1 = atomicAdd(&cnt[bi1], 1u);
            int* r = route + (size_t)n * 8;
            r[0] = bi0; r[1] = bi1; r[2] = (int)p0; r[3] = (int)p1; r[4] = __float_as_int(bw0 * ws_); r[5] = __float_as_int(bw1 * ws_);
        }
    }
}

__device__ __forceinline__ void build_moe_tab(const Params& p, int l, LAS int* tab) {
    if (threadIdx.x == 0) {
        const unsigned* cnt = (const unsigned*)(p.ws + WS_CNT) + l * 16;
        int acc = 0;
        for (int e = 0; e < 16; ++e) { tab[e] = acc; acc += (int)((cnt[e] + 255u) >> 8); }
        tab[16] = acc;
    }
    __syncthreads();
}

__device__ __forceinline__ void phase_permute(const Params& p, int l, LAS int* tab) {
    build_moe_tab(p, l, tab);
    int tid_ = threadIdx.x; asm volatile("" : "+v"(tid_)); const int wave = tid_ >> 6, lane = tid_ & 63;
    int* route = (int*)(p.ws + WS_ROUTE);
    const bf16_t* hb = (const bf16_t*)(p.ws + WS_HB);
    bf16_t* xe = (bf16_t*)(p.ws + WS_XE);
    for (int n = blockIdx.x * 8 + wave; n < T; n += gridDim.x * 8) {
        int* r = route + (size_t)n * 8;
        const int e0 = r[0], e1 = r[1], p0 = r[2], p1 = r[3];
        const int row0 = tab[e0] * 256 + p0, row1 = tab[e1] * 256 + p1;
        const u32x4* src = (const u32x4*)(hb + (size_t)n * D);
        u32x4* d0 = (u32x4*)(xe + (size_t)row0 * D); u32x4* d1 = (u32x4*)(xe + (size_t)row1 * D);
#pragma unroll
        for (int i = 0; i < 4; ++i) { const u32x4 v = src[i * 64 + lane]; d0[i * 64 + lane] = v; d1[i * 64 + lane] = v; }
        if (lane == 0) { r[6] = row0; r[7] = row1; }
    }
}

__device__ __forceinline__ void phase_ln2(const Params& p, int l) {
    int tid_ = threadIdx.x; asm volatile("" : "+v"(tid_)); const int wave = tid_ >> 6, lane = tid_ & 63;
    const float* mod = (const float*)(p.ws + WS_MOD);
    const float* ye = (const float*)(p.ws + WS_YE);
    float* xres = (float*)(p.ws + WS_XRES);
    const int* route = (const int*)(p.ws + WS_ROUTE);
    for (int n = blockIdx.x * 8 + wave; n < T; n += gridDim.x * 8) {
        const int b = n / SEQ;
        const float* mb = mod + ((size_t)l * 4 + b) * (6 * D);
        const int* r = route + (size_t)n * 8;
        const float w0 = __int_as_float(r[4]), w1 = __int_as_float(r[5]);
        const float* y0 = ye + (size_t)r[6] * D; const float* y1 = ye + (size_t)r[7] * D;
        float4 v[8];
#pragma unroll
        for (int i = 0; i < 8; ++i) {
            const float4 xv = *(const float4*)(xres + (size_t)n * D + i * 256 + lane * 4);
            const float4 a = *(const float4*)(y0 + i * 256 + lane * 4), c = *(const float4*)(y1 + i * 256 + lane * 4);
            const float4 g = *(const float4*)(mb + 5 * D + i * 256 + lane * 4);
            v[i].x = ALPHA * xv.x + (1.f + g.x) * (w0 * a.x + w1 * c.x); v[i].y = ALPHA * xv.y + (1.f + g.y) * (w0 * a.y + w1 * c.y);
            v[i].z = ALPHA * xv.z + (1.f + g.z) * (w0 * a.z + w1 * c.z); v[i].w = ALPHA * xv.w + (1.f + g.w) * (w0 * a.w + w1 * c.w);
        }
        ln_rows(v, p.ln_g + (size_t)(l * 2 + 1) * D, p.ln_b + (size_t)(l * 2 + 1) * D, lane);
        if (l + 1 < DEPTH) {
#pragma unroll
            for (int i = 0; i < 8; ++i) *(float4*)(xres + (size_t)n * D + i * 256 + lane * 4) = v[i];
            const float* mn = mod + ((size_t)(l + 1) * 4 + b) * (6 * D);
            modulate_store(v, mn, mn + D, (bf16_t*)(p.ws + WS_HA) + (size_t)n * D, lane);
        } else {
#pragma unroll
            for (int i = 0; i < 8; ++i) *(float4*)(p.out + (size_t)n * D + i * 256 + lane * 4) = v[i];
        }
    }
}

typedef const __attribute__((address_space(4))) unsigned char* KargPtr;
__device__ __forceinline__ Params load_params(KargPtr q) { asm volatile("" : "+s"(q)); Params lp; __builtin_memcpy(&lp, q, sizeof(Params)); return lp; }

__global__ __launch_bounds__(512, 2) void mega(Params p_in) {
    extern __shared__ __attribute__((aligned(16))) unsigned char smem[];
    LAS unsigned char* lds = (LAS unsigned char*)smem;
    LAS int* tab = (LAS int*)(lds + LDS_MISC + 64);
    KargPtr kp = (KargPtr)__builtin_amdgcn_kernarg_segment_ptr();
    if (threadIdx.x == 0) { *(LAS u32x4*)(lds + LDS_MISC) = (u32x4){0u, 0u, 0u, 0u}; }
    __syncthreads();
    const int fused = p_in.fused, ph_lo = p_in.ph_lo, ph_hi = p_in.ph_hi, l_hi = p_in.l_hi;
    XcdBarrier bar;
    if (fused) bar = xcd_barrier_post((unsigned*)(p_in.ws + WS_BAR), (volatile LAS unsigned*)(lds + LDS_MISC));
    else { bar.bar = (unsigned*)(p_in.ws + WS_BAR); bar.x = 0; bar.st = (volatile LAS unsigned*)(lds + LDS_MISC); }
#ifdef ONLY_PH
#define PH(i) ((i) == ONLY_PH && ph_lo <= (i) && (i) < ph_hi)
#else
#define PH(i) (ph_lo <= (i) && (i) < ph_hi)
#endif
#define SYNC() do { if (fused) xcd_barrier(bar); } while (0)
    const int G = gridDim.x, c = blockIdx.x;
    if (PH(0)) { const Params p = load_params(kp); phase_prologue(p, lds); SYNC(); }
    if (PH(1)) { const Params p = load_params(kp); phase_ln0(p); SYNC(); }
    for (int l = p_in.l_lo; l < l_hi; ++l) {
        if (PH(2)) {
            const Params p = load_params(kp);
            pg8::DenseOrder S; S.init(T, INC, D, G, c);
            pg8::Gemm g{(const bf16_t*)(p.ws + WS_HA), (const bf16_t*)(p.ws + WS_WIN) + (size_t)l * INC * D, D};
            pg8::EpiBf16 E{(bf16_t*)(p.ws + WS_PROJ), INC};
            pg8::gemm_phase(lds, g, S, E);
            SYNC();
        }
        if (PH(3)) { const Params p = load_params(kp); phase_mixer_valu(p, l, lds); SYNC(); }
        if (PH(4)) { const Params p = load_params(kp); phase_finalize(p, l); SYNC(); }
        if (PH(5)) {
            const Params p = load_params(kp);
            pg8::DenseOrder S; S.init(T, D, D, G, c);
            pg8::Gemm g{(const bf16_t*)(p.ws + WS_MIXED), (const bf16_t*)(p.ws + WS_WOUT) + (size_t)l * D * D, D};
            pg8::EpiF32 E{(float*)(p.ws + WS_Y), D};
            pg8::gemm_phase(lds, g, S, E);
            SYNC();
        }
        if (PH(6)) { const Params p = load_params(kp); phase_ln1_router(p, l, lds); SYNC(); }
        if (PH(7)) { const Params p = load_params(kp); phase_permute(p, l, tab); SYNC(); }
        if (PH(8)) {
            const Params p = load_params(kp);
            build_moe_tab(p, l, tab);
            pg8::MoeOrder S; S.tab = tab; S.NTn = 11; S.G = G; S.c = c; S.tstep = (size_t)256 * D * 2; S.bexp = (size_t)2 * DE * D * 2;
            pg8::Gemm g{(const bf16_t*)(p.ws + WS_XE), (const bf16_t*)(p.ws + WS_WGU) + (size_t)l * NE * 2 * DE * D, D};
            pg8::EpiHidden E{(bf16_t*)(p.ws + WS_HID)};
            pg8::gemm_phase(lds, g, S, E);
            SYNC();
        }
        if (PH(9)) {
            const Params p = load_params(kp);
            build_moe_tab(p, l, tab);
            pg8::MoeOrder S; S.tab = tab; S.NTn = 8; S.G = G; S.c = c; S.tstep = (size_t)256 * DE * 2; S.bexp = (size_t)D * DE * 2;
            pg8::Gemm g{(const bf16_t*)(p.ws + WS_HID), (const bf16_t*)(p.ws + WS_WD) + (size_t)l * NE * D * DE, DE};
            pg8::EpiF32 E{(float*)(p.ws + WS_YE), D};
            pg8::gemm_phase(lds, g, S, E);
            SYNC();
        }
        if (PH(10)) { const Params p = load_params(kp); phase_ln2(p, l); SYNC(); }
    }
}

#ifndef MK_FUSED
#define MK_FUSED 1
#endif
extern "C" void kernel_launch(void* const* d_in, const int* in_sizes, int n_in, void* d_out, int out_size, void* d_ws, size_t ws_size, hipStream_t stream) {
    static int grid = 0;
    if (grid == 0) {
        if (n_in != 18 || ws_size < WS_END) { fprintf(stderr, "kernel_launch: unexpected n_in %d or ws_size %zu (< %zu)\n", n_in, ws_size, (size_t)WS_END); grid = -1; return; }
        int dev = 0, cus = 0, per_cu = 0;
        hipGetDevice(&dev);
        hipDeviceGetAttribute(&cus, hipDeviceAttributeMultiprocessorCount, dev);
        if (hipFuncSetAttribute((const void*)mega, hipFuncAttributeMaxDynamicSharedMemorySize, LDS_BYTES) != hipSuccess) { fprintf(stderr, "kernel_launch: hipFuncSetAttribute failed\n"); grid = -1; return; }
        hipOccupancyMaxActiveBlocksPerMultiprocessor(&per_cu, (const void*)mega, 512, LDS_BYTES);
        if (per_cu < 1) fprintf(stderr, "kernel_launch: occupancy query says %d\n", per_cu);
        grid = cus > 0 ? cus : 256;
    }
    if (grid < 0) return;
    hipMemsetAsync(d_ws, 0, WS_ZERO_BYTES, stream);
    Params p{};
    p.x = (const float*)d_in[0]; p.c = (const float*)d_in[1]; p.emb_g = (const float*)d_in[2]; p.emb_b = (const float*)d_in[3];
    p.w_ada = (const float*)d_in[4]; p.b_ada = (const float*)d_in[5]; p.w_in = (const float*)d_in[6]; p.conv_w = (const float*)d_in[7];
    p.mix_beta = (const float*)d_in[8]; p.w_out = (const float*)d_in[9]; p.lb_logits = (const float*)d_in[10]; p.ln_g = (const float*)d_in[11];
    p.ln_b = (const float*)d_in[12]; p.w_router = (const float*)d_in[13]; p.router_bias = (const float*)d_in[14]; p.w_gate = (const float*)d_in[15];
    p.w_up = (const float*)d_in[16]; p.w_down = (const float*)d_in[17];
    p.out = (float*)d_out; p.ws = (unsigned char*)d_ws; p.pad = 0;
#if MK_FUSED
    p.ph_lo = 0; p.ph_hi = 11; p.l_lo = 0; p.l_hi = DEPTH; p.fused = 1;
    hipLaunchKernelGGL(mega, dim3(grid), dim3(512), LDS_BYTES, stream, p);
#else
    p.fused = 0;
    for (int ph = 0; ph < 2; ++ph) { p.ph_lo = ph; p.ph_hi = ph + 1; p.l_lo = 0; p.l_hi = 0; hipLaunchKernelGGL(mega, dim3(grid), dim3(512), LDS_BYTES, stream, p); }
    for (int l = 0; l < DEPTH; ++l)
        for (int ph = 2; ph < 11; ++ph) { p.ph_lo = ph; p.ph_hi = ph + 1; p.l_lo = l; p.l_hi = l + 1; hipLaunchKernelGGL(mega, dim3(grid), dim3(512), LDS_BYTES, stream, p); }
#endif
}
```

```cpp
#include <hip/hip_runtime.h>
#include <stdint.h>
#include <stdio.h>

#define LAS __attribute__((address_space(3)))
typedef unsigned short bf16_t;
typedef short bf16x8 __attribute__((ext_vector_type(8)));
typedef float f32x4 __attribute__((ext_vector_type(4)));
typedef unsigned u32x4 __attribute__((ext_vector_type(4)));
typedef unsigned u32x2 __attribute__((ext_vector_type(2)));

constexpr int D = 2048, NB = 4, SEQ = 2048, T = NB * SEQ, DEPTH = 2;
constexpr int CW = 512, RW = 768, HWD = 768, INC = 8448;
constexpr int NE = 16, DE = 1408;
constexpr int C_CB = 0, C_CC = 512, C_CH = 1024, C_RQ = 1536, C_RK = 2304, C_RV = 3072, C_RG = 3840, C_HQ = 4608, C_HFF = 5376, C_HFB = 6144, C_HI = 6912, C_HG = 7680;
constexpr int XE_ROWS = 20480;
constexpr float ALPHA = 1.4142135623730951f;

constexpr size_t WS_BAR = 0;
constexpr size_t WS_CNT = 16384;
constexpr size_t WS_ZERO_BYTES = 32768;
constexpr size_t WS_MOD = 32768;
constexpr size_t WS_ROUTE = WS_MOD + 393216;
constexpr size_t WS_WIN = 1048576;
constexpr size_t SZ_WIN = (size_t)DEPTH * INC * D * 2;
constexpr size_t WS_WOUT = WS_WIN + SZ_WIN;
constexpr size_t SZ_WOUT = (size_t)DEPTH * D * D * 2;
constexpr size_t WS_WGU = WS_WOUT + SZ_WOUT;
constexpr size_t SZ_WGU = (size_t)DEPTH * NE * 2 * DE * D * 2;
constexpr size_t WS_WD = WS_WGU + SZ_WGU;
constexpr size_t SZ_WD = (size_t)DEPTH * NE * D * DE * 2;
constexpr size_t WS_XRES = WS_WD + SZ_WD;
constexpr size_t SZ_XRES = (size_t)T * D * 4;
constexpr size_t WS_HA = WS_XRES + SZ_XRES;
constexpr size_t SZ_H = (size_t)T * D * 2;
constexpr size_t WS_HB = WS_HA + SZ_H;
constexpr size_t WS_PROJ = WS_HB + SZ_H;
constexpr size_t SZ_PROJ = (size_t)T * INC * 2;
constexpr size_t WS_OBUF = WS_PROJ + SZ_PROJ;
constexpr size_t SZ_OBUF = (size_t)2 * T * 1536 * 4;
constexpr size_t WS_YE = WS_PROJ;
constexpr size_t SZ_YE = (size_t)XE_ROWS * D * 4;
static_assert(SZ_YE <= SZ_PROJ + SZ_OBUF, "ye alias");
constexpr size_t WS_MIXED = WS_OBUF + SZ_OBUF;
constexpr size_t WS_Y = WS_MIXED + SZ_H;
constexpr size_t SZ_Y = (size_t)T * D * 4;
constexpr size_t WS_XE = WS_Y + SZ_Y;
constexpr size_t SZ_XE = (size_t)XE_ROWS * D * 2;
constexpr size_t WS_HID = WS_XE + SZ_XE;
constexpr size_t SZ_HID = (size_t)XE_ROWS * DE * 2;
constexpr size_t WS_END = WS_HID + SZ_HID;

constexpr int LDS_BYTES = 147456;
constexpr int LDS_MISC = 131072;

struct Params {
    const float *x, *c, *emb_g, *emb_b, *w_ada, *b_ada, *w_in, *conv_w, *mix_beta, *w_out, *lb_logits, *ln_g, *ln_b, *w_router, *router_bias, *w_gate, *w_up, *w_down;
    float* out;
    unsigned char* ws;
    int ph_lo, ph_hi, l_lo, l_hi, fused, pad;
};

__device__ __forceinline__ float bf2f(unsigned b) { return __uint_as_float(b << 16); }
__device__ __forceinline__ unsigned f2bf(float f) { unsigned u = __float_as_uint(f); u += 0x7FFFu + ((u >> 16) & 1u); return u >> 16; }
__device__ __forceinline__ unsigned pack2(float lo, float hi) { return f2bf(lo) | (f2bf(hi) << 16); }
__device__ __forceinline__ float wave_sum(float v) {
#pragma unroll
    for (int o = 32; o > 0; o >>= 1) v += __shfl_xor(v, o, 64);
    return v;
}
__device__ __forceinline__ float half_sum(float v) {
#pragma unroll
    for (int o = 16; o > 0; o >>= 1) v += __shfl_xor(v, o, 64);
    return v;
}
__device__ __forceinline__ float sigmoidf_(float z) { return 1.0f / (1.0f + __expf(-z)); }
__device__ __forceinline__ float siluf_(float z) { return z / (1.0f + __expf(-z)); }

#define XB_TMO      128
#define XB_XCNT(j)  (256  + 64 * (j))
#define XB_XSUB(j)  (1280 + 64 * (j))
#define XB_XGEN(j)  (2304 + 64 * (j))
#define XB_TOP      3328
#define XB_TOPGEN   3392
#define XCD_BAR_WORDS 3456
#define XB_SPIN_CAP (1u << 22)
__device__ __forceinline__ unsigned xb_ld(unsigned* p)              { return __hip_atomic_load(p, __ATOMIC_RELAXED, __HIP_MEMORY_SCOPE_AGENT); }
__device__ __forceinline__ unsigned xb_add(unsigned* p, unsigned v) { return __hip_atomic_fetch_add(p, v, __ATOMIC_RELAXED, __HIP_MEMORY_SCOPE_AGENT); }
__device__ __forceinline__ unsigned xb_xcc_id() { return (unsigned)__builtin_amdgcn_s_getreg((3 << 11) | 20) & 0xFu; }
#define XB_SPIN(cond, bar) do { unsigned _sp = 0; while (cond) { __builtin_amdgcn_s_sleep(1); \
    if ((++_sp & 255u) == 0u) { if (xb_ld(&(bar)[XB_TMO])) break; if (_sp > XB_SPIN_CAP) { atomicAdd(&(bar)[XB_TMO], 1u); break; } } } } while (0)
struct XcdBarrier { unsigned* bar; unsigned x; volatile LAS unsigned* st; };
__device__ __forceinline__ XcdBarrier xcd_barrier_post(unsigned* bar, volatile LAS unsigned* st) {
    XcdBarrier b; b.bar = bar; b.x = xb_xcc_id(); b.st = st;
    if (threadIdx.x == 0) (void)xb_add(&bar[XB_XCNT(b.x)], 1u);
    return b;
}
__device__ __forceinline__ void xcd_barrier_complete(unsigned* bar, unsigned x, unsigned& nloc, unsigned& nx) {
    const unsigned G = gridDim.x * gridDim.y * gridDim.z;
    unsigned sum, cnt, mine, sp = 0u;
    for (;;) {
        sum = 0u; cnt = 0u; mine = 0u;
#pragma unroll
        for (unsigned j = 0; j < 16; ++j) { const unsigned c = xb_ld(&bar[XB_XCNT(j)]); sum += c; cnt += (c > 0u) ? 1u : 0u; mine = (j == x) ? c : mine; }
        if (sum == G) break;
        __builtin_amdgcn_s_sleep(1);
        if ((++sp & 255u) == 0u) { if (xb_ld(&bar[XB_TMO])) break; if (sp > XB_SPIN_CAP) { atomicAdd(&bar[XB_TMO], 1u); break; } }
    }
    nloc = mine > 0u ? mine : 1u; nx = cnt > 0u ? cnt : 1u;
}
__device__ __forceinline__ void xcd_barrier(const XcdBarrier& b) {
    asm volatile("s_waitcnt vmcnt(0)" ::: "memory");
    __syncthreads();
    if (threadIdx.x == 0) {
        unsigned* bar = b.bar;
        __builtin_amdgcn_s_waitcnt(0);
        unsigned nloc = b.st[0], nx = b.st[1];
        if (nloc == 0u) { xcd_barrier_complete(bar, b.x, nloc, nx); b.st[0] = nloc; b.st[1] = nx; }
        const unsigned old = xb_add(&bar[XB_XSUB(b.x)], 1u);
        const unsigned gen = old / nloc;
        if (old + 1u == (gen + 1u) * nloc) {
            __builtin_amdgcn_fence(__ATOMIC_RELEASE, "agent");
            asm volatile("s_waitcnt vmcnt(0)" ::: "memory");
            const unsigned og = xb_add(&bar[XB_TOP], 1u);
            const unsigned tg = og / nx;
            if (og + 1u == (tg + 1u) * nx) xb_add(&bar[XB_TOPGEN], 1u);
            else XB_SPIN(xb_ld(&bar[XB_TOPGEN]) == tg, bar);
            __builtin_amdgcn_fence(__ATOMIC_ACQUIRE, "agent");
            xb_add(&bar[XB_XGEN(b.x)], 1u);
            asm volatile("s_waitcnt vmcnt(0)" ::: "memory");
        } else {
            XB_SPIN(xb_ld(&bar[XB_XGEN(b.x)]) == gen, bar);
            __builtin_amdgcn_fence(__ATOMIC_ACQUIRE, "agent");
            asm volatile("s_waitcnt vmcnt(0)" ::: "memory");
        }
    }
    __syncthreads();
}

namespace pg8 {
constexpr int BM = 256, BK = 64, HALF = 128, HTB = HALF * BK * 2, STAGE_BYTES = 8 * HTB, NXCD = 8, WGM = 8;
__host__ __device__ __forceinline__ int lds_byte(int r, int c) { const int st = (r >> 4) * 2 + (c >> 5), rr = r & 15, cc = c & 31, ob = rr * 64 + cc * 2; return st * 1024 + (ob ^ (((ob >> 9) & 1) << 5)); }
__host__ __device__ __forceinline__ void stage_rc(int b, int& R, int& C) { const int st = b / 1024, sb = b % 1024, swz = sb ^ (((sb >> 9) & 1) << 5); R = (st >> 1) * 16 + swz / 64; C = (st & 1) * 32 + (swz % 64) / 2; }
__host__ __device__ __forceinline__ int perm32(int rho) { const int n = rho >> 4, i = rho & 15; return 8 * (i >> 2) + 4 * n + (i & 3); }

struct Unit { size_t aB, bB; int row0, col0; };
struct Gemm { const bf16_t* A; const bf16_t* Bt; int K; };

struct DenseOrder {
    int nM, nN, nwg, G, c; size_t tstep;
    __device__ void init(int M, int N, int K, int G_, int c_) { nM = M / BM; nN = N / BM; nwg = nM * nN; G = G_; c = c_; tstep = (size_t)BM * K * 2; }
    __device__ bool next(int i, Unit& u) const {
        const long L = (long)i * G + c; if (L >= nwg) return false;
        int wgid = (int)L; { const int q = nwg / NXCD, r = nwg % NXCD, xcd = wgid % NXCD, off = wgid / NXCD; wgid = (xcd < r ? xcd * (q + 1) : r * (q + 1) + (xcd - r) * q) + off; }
        const int nig = WGM * nN, gid = wgid / nig, fm = gid * WGM, gsz = (nM - fm) < WGM ? (nM - fm) : WGM;
        const int pm = fm + ((wgid % nig) % gsz), pn = (wgid % nig) / gsz;
        u.aB = (size_t)pm * tstep; u.bB = (size_t)pn * tstep; u.row0 = pm * BM; u.col0 = pn * BM; return true;
    }
};
struct MoeOrder {
    const LAS int* tab; int NTn, G, c; size_t tstep, bexp;
    __device__ bool next(int i, Unit& u) const {
        const int L = i * G + c; const int MT = tab[16]; if (L >= MT * NTn) return false;
        const int mt = L / NTn, nt = L - mt * NTn; int e = 0;
#pragma unroll
        for (int j = 1; j < 16; ++j) e += (mt >= tab[j]) ? 1 : 0;
        u.aB = (size_t)mt * tstep; u.bB = (size_t)e * bexp + (size_t)nt * tstep; u.row0 = mt * BM; u.col0 = nt * BM; return true;
    }
};

__device__ __forceinline__ unsigned cvt_pk_bf16(float lo, float hi) { unsigned r; asm volatile("v_cvt_pk_bf16_f32 %0, %1, %2" : "=v"(r) : "v"(lo), "v"(hi)); return r; }

struct EpiF32 {
    static constexpr bool PERM = false;
    float* C; int ldc;
    __device__ __forceinline__ void operator()(const f32x4 (&acc)[2][2][4][2], const Unit& u, int wr, int wc, int fr, int fq) const {
        const int row0 = u.row0 + wr * 64 + fr, col0 = u.col0 + wc * 32 + 4 * fq;
#pragma unroll
        for (int ai = 0; ai < 2; ++ai)
#pragma unroll
            for (int m = 0; m < 4; ++m) { float* rowp = C + (size_t)(row0 + ai * HALF + m * 16) * ldc + col0;
#pragma unroll
                for (int bj = 0; bj < 2; ++bj)
#pragma unroll
                    for (int n = 0; n < 2; ++n) *(f32x4*)(rowp + bj * HALF + n * 16) = acc[ai][bj][m][n]; }
    }
};
struct EpiBf16 {
    static constexpr bool PERM = true;
    bf16_t* O; int ldc;
    __device__ __forceinline__ void operator()(const f32x4 (&acc)[2][2][4][2], const Unit& u, int wr, int wc, int fr, int fq) const {
        const int row0 = u.row0 + wr * 64 + fr, col0 = u.col0 + wc * 32 + 8 * fq;
#pragma unroll
        for (int ai = 0; ai < 2; ++ai)
#pragma unroll
            for (int m = 0; m < 4; ++m) { bf16_t* rowp = O + (size_t)(row0 + ai * HALF + m * 16) * ldc + col0;
#pragma unroll
                for (int bj = 0; bj < 2; ++bj) { const f32x4 v0 = acc[ai][bj][m][0], v1 = acc[ai][bj][m][1];
                    u32x4 o; o[0] = cvt_pk_bf16(v0[0], v0[1]); o[1] = cvt_pk_bf16(v0[2], v0[3]); o[2] = cvt_pk_bf16(v1[0], v1[1]); o[3] = cvt_pk_bf16(v1[2], v1[3]);
                    *(u32x4*)(rowp + bj * HALF) = o; } }
    }
};
struct EpiHidden {
    static constexpr bool PERM = true;
    bf16_t* O;
    __device__ __forceinline__ void operator()(const f32x4 (&acc)[2][2][4][2], const Unit& u, int wr, int wc, int fr, int fq) const {
        const int row0 = u.row0 + wr * 64 + fr, col0 = (u.col0 >> 1) + wc * 32 + 8 * fq;
#pragma unroll
        for (int ai = 0; ai < 2; ++ai)
#pragma unroll
            for (int m = 0; m < 4; ++m) { bf16_t* rowp = O + (size_t)(row0 + ai * HALF + m * 16) * DE + col0;
                float h[8];
#pragma unroll
                for (int n = 0; n < 2; ++n)
#pragma unroll
                    for (int j = 0; j < 4; ++j) { const float g = acc[ai][0][m][n][j], up = acc[ai][1][m][n][j]; h[n * 4 + j] = g * __builtin_amdgcn_rcpf(1.0f + __expf(-g)) * up; }
                u32x4 o; o[0] = cvt_pk_bf16(h[0], h[1]); o[1] = cvt_pk_bf16(h[2], h[3]); o[2] = cvt_pk_bf16(h[4], h[5]); o[3] = cvt_pk_bf16(h[6], h[7]);
                *(u32x4*)rowp = o; }
    }
};

template <class Epi, class Sched>
__device__ __forceinline__ void gemm_phase(LAS unsigned char* lds, const Gemm g, const Sched& S, const Epi& E) {
    int tid = threadIdx.x; asm volatile("" : "+v"(tid)); const int wid = __builtin_amdgcn_readfirstlane(tid >> 6), lane = tid & 63, wr = wid >> 2, wc = wid & 3, fr = lane & 15, fq = lane >> 4;
    const int K = g.K, nt = K / BK;
    unsigned voffA[2], voffB[2];
#pragma unroll
    for (int i = 0; i < 2; ++i) { int R, C; stage_rc(tid * 16 + i * 8192, R, C); const int Rb = Epi::PERM ? ((R & ~31) + perm32(R & 31)) : R;
        voffA[i] = (unsigned)(R * K + C) * 2u; voffB[i] = (unsigned)(Rb * K + C) * 2u; }
    const size_t kstep = (size_t)(BK * 2);
    const size_t hstep = (size_t)HALF * K * 2;
    const unsigned ldsw = (unsigned)wid * 1024u;
    const int aoff = lds_byte(wr * 64 + fr, fq * 8), boff = lds_byte(wc * 32 + fr, fq * 8);
#define PG8_SA(b, h) (((b) * 2 + (h)) * HTB)
#define PG8_SB(b, h) ((4 + (b) * 2 + (h)) * HTB)
#define PG8_STAGE(bufoff, gbase, voff) do { _Pragma("unroll") for (int _i = 0; _i < 2; ++_i) \
        __builtin_amdgcn_global_load_lds((const unsigned*)((const char*)(gbase) + (voff)[_i]), (LAS unsigned*)(lds + (bufoff) + ldsw + _i * 8192), 16, 0, 0); } while (0)
#define PG8_LDA(dst, b, h) do { _Pragma("unroll") for (int m = 0; m < 4; ++m) _Pragma("unroll") for (int k = 0; k < 2; ++k) dst[m][k] = *(const LAS bf16x8*)(lds + PG8_SA(b, h) + aoff + m * 2048 + k * 1024); } while (0)
#define PG8_LDB(dst, b, h) do { _Pragma("unroll") for (int n = 0; n < 2; ++n) _Pragma("unroll") for (int k = 0; k < 2; ++k) dst[n][k] = *(const LAS bf16x8*)(lds + PG8_SB(b, h) + boff + n * 2048 + k * 1024); } while (0)
#define PG8_MMA(ai, bj, At, Bt) do { __builtin_amdgcn_s_setprio(1); _Pragma("unroll") for (int m = 0; m < 4; ++m) _Pragma("unroll") for (int n = 0; n < 2; ++n) _Pragma("unroll") for (int k = 0; k < 2; ++k) \
        acc[ai][bj][m][n] = __builtin_amdgcn_mfma_f32_16x16x32_bf16(Bt[n][k], At[m][k], acc[ai][bj][m][n], 0, 0, 0); __builtin_amdgcn_s_setprio(0); } while (0)
#define PG8_WAIT_V(n) asm volatile("s_waitcnt vmcnt(" #n ")" ::: "memory")
#define PG8_WAIT_L(n) asm volatile("s_waitcnt lgkmcnt(" #n ")" ::: "memory")
#define PG8_BAR __builtin_amdgcn_s_barrier()
#define PG8_SCHED __builtin_amdgcn_sched_barrier(0)
    Unit cur, nxt; int ui = 0;
    if (!S.next(0, cur)) return;
    f32x4 acc[2][2][4][2];
#pragma unroll
    for (int a = 0; a < 2; ++a)
#pragma unroll
        for (int b = 0; b < 2; ++b)
#pragma unroll
            for (int m = 0; m < 4; ++m)
#pragma unroll
                for (int n = 0; n < 2; ++n) acc[a][b][m][n] = (f32x4){0.f, 0.f, 0.f, 0.f};
    bf16x8 At[4][2], B0[2][2], B1[2][2];
    const char* cA = (const char*)g.A + cur.aB; const char* cB = (const char*)g.Bt + cur.bB;
    PG8_STAGE(PG8_SB(0, 0), cB, voffB); PG8_STAGE(PG8_SA(0, 0), cA, voffA); PG8_STAGE(PG8_SB(0, 1), cB + hstep, voffB); PG8_STAGE(PG8_SA(0, 1), cA + hstep, voffA);
    if (wr == 1) PG8_BAR;
    PG8_WAIT_V(4); PG8_BAR;
    PG8_STAGE(PG8_SB(1, 0), cB + kstep, voffB); PG8_STAGE(PG8_SA(1, 0), cA + kstep, voffA); PG8_STAGE(PG8_SB(1, 1), cB + hstep + kstep, voffB);
    PG8_WAIT_V(6); PG8_BAR;
    for (;;) {
        const bool has_next = S.next(ui + 1, nxt);
        const char* nA = has_next ? (const char*)g.A + nxt.aB : cA; const char* nB = has_next ? (const char*)g.Bt + nxt.bB : cB;
        for (int t = 0; t < nt; t += 2) {
            const bool last = (t == nt - 2);
            const char* a1 = cA + (size_t)(t + 1) * kstep;
            const char* a2 = last ? nA : cA + (size_t)(t + 2) * kstep; const char* b2 = last ? nB : cB + (size_t)(t + 2) * kstep;
            const char* a3 = a2 + kstep; const char* b3 = b2 + kstep;
            PG8_LDB(B0, 0, 0); PG8_SCHED; PG8_LDA(At, 0, 0); PG8_STAGE(PG8_SA(1, 1), a1 + hstep, voffA);
            PG8_WAIT_L(8); PG8_BAR; PG8_WAIT_L(0); PG8_MMA(0, 0, At, B0); PG8_BAR; PG8_SCHED;
            PG8_LDB(B1, 0, 1); PG8_STAGE(PG8_SB(0, 0), b2, voffB);
            PG8_BAR; PG8_WAIT_L(0); PG8_MMA(0, 1, At, B1); PG8_BAR;
            PG8_LDA(At, 0, 1); PG8_STAGE(PG8_SA(0, 0), a2, voffA);
            PG8_BAR; PG8_WAIT_L(0); PG8_MMA(1, 0, At, B0); PG8_BAR; PG8_SCHED;
            PG8_STAGE(PG8_SB(0, 1), b2 + hstep, voffB);
            PG8_WAIT_V(6); PG8_BAR; PG8_MMA(1, 1, At, B1); PG8_BAR;
            PG8_LDB(B0, 1, 0); PG8_SCHED; PG8_LDA(At, 1, 0); PG8_STAGE(PG8_SA(0, 1), a2 + hstep, voffA);
            PG8_WAIT_L(8); PG8_BAR; PG8_WAIT_L(0); PG8_MMA(0, 0, At, B0); PG8_BAR; PG8_SCHED;
            PG8_LDB(B1, 1, 1); PG8_STAGE(PG8_SB(1, 0), b3, voffB);
            PG8_BAR; PG8_WAIT_L(0); PG8_MMA(0, 1, At, B1); PG8_BAR;
            PG8_LDA(At, 1, 1); PG8_STAGE(PG8_SA(1, 0), a3, voffA);
            PG8_BAR; PG8_WAIT_L(0); PG8_MMA(1, 0, At, B0); PG8_BAR; PG8_SCHED;
            PG8_STAGE(PG8_SB(1, 1), b3 + hstep, voffB);
            PG8_WAIT_V(6); PG8_BAR; PG8_MMA(1, 1, At, B1); PG8_BAR;
        }
        E(acc, cur, wr, wc, fr, fq);
        if (!has_next) break;
#pragma unroll
        for (int a = 0; a < 2; ++a)
#pragma unroll
            for (int b = 0; b < 2; ++b)
#pragma unroll
                for (int m = 0; m < 4; ++m)
#pragma unroll
                    for (int n = 0; n < 2; ++n) acc[a][b][m][n] = (f32x4){0.f, 0.f, 0.f, 0.f};
        cur = nxt; cA = nA; cB = nB; ++ui;
    }
    PG8_WAIT_V(0);
    if (wr == 0) PG8_BAR;
    PG8_BAR;
#undef PG8_SA
#undef PG8_SB
#undef PG8_STAGE
#undef PG8_LDA
#undef PG8_LDB
#undef PG8_MMA
#undef PG8_WAIT_V
#undef PG8_WAIT_L
#undef PG8_BAR
#undef PG8_SCHED
}
}

__device__ __forceinline__ void cvt_tile(const float* __restrict__ src, int lds_, bf16_t* __restrict__ dst, int ldd, int k0, int n0, int drow0, LAS unsigned* tl, int tid) {
    const int kp = tid >> 4, n4 = (tid & 15) * 4;
    const float4 a = *(const float4*)(src + (size_t)(k0 + 2 * kp) * lds_ + n0 + n4);
    const float4 b = *(const float4*)(src + (size_t)(k0 + 2 * kp + 1) * lds_ + n0 + n4);
    tl[(n4 + 0) * 33 + kp] = pack2(a.x, b.x);
    tl[(n4 + 1) * 33 + kp] = pack2(a.y, b.y);
    tl[(n4 + 2) * 33 + kp] = pack2(a.z, b.z);
    tl[(n4 + 3) * 33 + kp] = pack2(a.w, b.w);
    __syncthreads();
    const int n = tid >> 3, kc = (tid & 7) * 4;
    u32x4 o; o[0] = tl[n * 33 + kc]; o[1] = tl[n * 33 + kc + 1]; o[2] = tl[n * 33 + kc + 2]; o[3] = tl[n * 33 + kc + 3];
    *(u32x4*)(dst + (size_t)(drow0 + n) * ldd + k0 + kc * 2) = o;
    __syncthreads();
}

__device__ __forceinline__ void phase_prologue(const Params& p, LAS unsigned char* lds) {
    int tid = threadIdx.x; asm volatile("" : "+v"(tid));
    unsigned char* ws = p.ws;
    {
        LAS float* cond = (LAS float*)lds;
        LAS float* red = (LAS float*)(lds + 32768);
        for (int i = tid; i < 4 * D; i += 512) { const float v = p.c[i]; cond[i] = siluf_(v); }
        __syncthreads();
        for (int ch = blockIdx.x; ch < 256; ch += gridDim.x) {
            const int l = ch >> 7, j0 = (ch & 127) * 96;
            const float* w = p.w_ada + (size_t)l * D * (6 * D);
            const int kg = tid / 24, cl = tid % 24;
            float acc[4][4];
#pragma unroll
            for (int b = 0; b < 4; ++b)
#pragma unroll
                for (int j = 0; j < 4; ++j) acc[b][j] = 0.f;
            if (kg < 21) {
                for (int k = kg; k < D; k += 21) {
                    const float4 wv = *(const float4*)(w + (size_t)k * (6 * D) + j0 + cl * 4);
#pragma unroll
                    for (int b = 0; b < 4; ++b) { const float cv = cond[b * D + k]; acc[b][0] += cv * wv.x; acc[b][1] += cv * wv.y; acc[b][2] += cv * wv.z; acc[b][3] += cv * wv.w; }
                }
#pragma unroll
                for (int b = 0; b < 4; ++b)
#pragma unroll
                    for (int j = 0; j < 4; ++j) red[(kg * 4 + b) * 96 + cl * 4 + j] = acc[b][j];
            }
            __syncthreads();
            if (tid < 384) {
                const int b = tid / 96, col = tid % 96; float s = 0.f;
                for (int g = 0; g < 21; ++g) s += red[(g * 4 + b) * 96 + col];
                float* mod = (float*)(ws + WS_MOD);
                mod[((size_t)l * 4 + b) * (6 * D) + j0 + col] = s + p.b_ada[(size_t)l * 6 * D + j0 + col];
            }
            __syncthreads();
        }
    }
    LAS unsigned* tl = (LAS unsigned*)lds;
    constexpr int T_IN = 32 * 132, T_OUT = 32 * 32, T_GU = 32 * 22, T_DN = 22 * 32;
    constexpr int N0 = DEPTH * T_IN, N1 = N0 + DEPTH * T_OUT, N2 = N1 + DEPTH * NE * 2 * T_GU, N3 = N2 + DEPTH * NE * T_DN;
    for (int ti = blockIdx.x; ti < N3; ti += gridDim.x) {
        if (ti < N0) {
            const int l = ti / T_IN, r = ti % T_IN, kt = r / 132, ntl = r % 132;
            cvt_tile(p.w_in + (size_t)l * D * INC, INC, (bf16_t*)(ws + WS_WIN) + (size_t)l * INC * D, D, kt * 64, ntl * 64, ntl * 64, tl, tid);
        } else if (ti < N1) {
            const int q = ti - N0, l = q / T_OUT, r = q % T_OUT, kt = r / 32, ntl = r % 32;
            cvt_tile(p.w_out + (size_t)l * D * D, D, (bf16_t*)(ws + WS_WOUT) + (size_t)l * D * D, D, kt * 64, ntl * 64, ntl * 64, tl, tid);
        } else if (ti < N2) {
            const int q = ti - N1, mat = q / T_GU, r = q % T_GU, kt = r / 22, ntl = r % 22;
            const int which = mat & 1, le = mat >> 1;
            const float* src = (which ? p.w_up : p.w_gate) + (size_t)le * D * DE;
            const int n0 = ntl * 64, drow0 = (n0 >> 7) * 256 + which * 128 + (n0 & 127);
            cvt_tile(src, DE, (bf16_t*)(ws + WS_WGU) + (size_t)le * (2 * DE) * D, D, kt * 64, n0, drow0, tl, tid);
        } else {
            const int q = ti - N2, le = q / T_DN, r = q % T_DN, kt = r / 32, ntl = r % 32;
            cvt_tile(p.w_down + (size_t)le * DE * D, D, (bf16_t*)(ws + WS_WD) + (size_t)le * D * DE, DE, kt * 64, ntl * 64, ntl * 64, tl, tid);
        }
    }
}

__device__ __forceinline__ void ln_rows(float4 (&v)[8], const float* __restrict__ g, const float* __restrict__ b, int lane) {
    float s = 0.f;
#pragma unroll
    for (int i = 0; i < 8; ++i) s += (v[i].x + v[i].y) + (v[i].z + v[i].w);
    const float mean = wave_sum(s) * (1.0f / D);
    float q = 0.f;
#pragma unroll
    for (int i = 0; i < 8; ++i) { const float a = v[i].x - mean, bb = v[i].y - mean, c = v[i].z - mean, d = v[i].w - mean; q += (a * a + bb * bb) + (c * c + d * d); }
    const float rstd = rsqrtf(wave_sum(q) * (1.0f / D) + 1e-5f);
#pragma unroll
    for (int i = 0; i < 8; ++i) {
        const float4 gv = *(const float4*)(g + i * 256 + lane * 4), bv = *(const float4*)(b + i * 256 + lane * 4);
        v[i].x = (v[i].x - mean) * rstd * gv.x + bv.x; v[i].y = (v[i].y - mean) * rstd * gv.y + bv.y;
        v[i].z = (v[i].z - mean) * rstd * gv.z + bv.z; v[i].w = (v[i].w - mean) * rstd * gv.w + bv.w;
    }
}
__device__ __forceinline__ void modulate_store(const float4 (&v)[8], const float* __restrict__ shift, const float* __restrict__ scale, bf16_t* __restrict__ dst, int lane) {
#pragma unroll
    for (int i = 0; i < 8; ++i) {
        const float4 sh = *(const float4*)(shift + i * 256 + lane * 4), sc = *(const float4*)(scale + i * 256 + lane * 4);
        u32x2 o; o[0] = pack2(v[i].x * (1.f + sc.x) + sh.x, v[i].y * (1.f + sc.y) + sh.y); o[1] = pack2(v[i].z * (1.f + sc.z) + sh.z, v[i].w * (1.f + sc.w) + sh.w);
        *(u32x2*)(dst + i * 256 + lane * 4) = o;
    }
}

__device__ __forceinline__ void phase_ln0(const Params& p) {
    int tid_ = threadIdx.x; asm volatile("" : "+v"(tid_)); const int wave = tid_ >> 6, lane = tid_ & 63;
    const float* mod = (const float*)(p.ws + WS_MOD);
    for (int n = blockIdx.x * 8 + wave; n < T; n += gridDim.x * 8) {
        const int b = n / SEQ;
        float4 v[8];
#pragma unroll
        for (int i = 0; i < 8; ++i) v[i] = *(const float4*)(p.x + (size_t)n * D + i * 256 + lane * 4);
        ln_rows(v, p.emb_g, p.emb_b, lane);
        float* xr = (float*)(p.ws + WS_XRES) + (size_t)n * D;
#pragma unroll
        for (int i = 0; i < 8; ++i) *(float4*)(xr + i * 256 + lane * 4) = v[i];
        const float* mb = mod + ((size_t)0 * 4 + b) * (6 * D);
        modulate_store(v, mb, mb + D, (bf16_t*)(p.ws + WS_HA) + (size_t)n * D, lane);
    }
}

__device__ __forceinline__ void phase_mixer_valu(const Params& p, int l, LAS unsigned char* lds) {
    LAS float* qs = (LAS float*)lds; LAS float* ks = qs + 4096; LAS float* fs = ks + 4096; LAS float* vs = fs + 4096; LAS float* po = vs + 1024;
    int tid = threadIdx.x; asm volatile("" : "+v"(tid)); const int wave = tid >> 6, lane = tid & 63, kk = tid >> 5, vv = tid & 31;
    const bf16_t* proj = (const bf16_t*)(p.ws + WS_PROJ);
    float* obuf = (float*)(p.ws + WS_OBUF);
    for (int u = blockIdx.x; u < 384; u += gridDim.x) {
        const int vsl = u & 3, dir = (u >> 2) & 1, hh = (u >> 3) % 6, b = ((u >> 3) / 6) % 4, type = (u >> 3) / 24;
        float S[8];
#pragma unroll
        for (int j = 0; j < 8; ++j) S[j] = 0.f;
        const float gamma = 1.0f - exp2f(-(dir ? 5.5f : 5.0f) - (float)hh);
        for (int blk = 0; blk < 64; ++blk) {
            const int rb = dir ? 63 - blk : blk, t0 = rb * 32;
            if (type == 0) {
#pragma unroll
                for (int j = 0; j < 4; ++j) {
                    const int idx = tid + 512 * j, tt = idx >> 6, dp = idx & 63;
                    const bf16_t* row = proj + (size_t)(b * SEQ + t0 + tt) * INC;
                    const float q1 = bf2f(row[C_RQ + hh * 128 + dp]), q2 = bf2f(row[C_RQ + hh * 128 + 64 + dp]);
                    const float k1 = bf2f(row[C_RK + hh * 128 + dp]), k2 = bf2f(row[C_RK + hh * 128 + 64 + dp]);
                    const float inv_freq = exp2f(-(float)dp * (13.287712379549449f / 64.0f));
                    const float ang = (float)(t0 + tt) * inv_freq;
                    float rev = ang * 0.15915494309189535f; rev -= rintf(rev);
                    const float sn = __builtin_amdgcn_sinf(rev), cs = __builtin_amdgcn_cosf(rev);
                    qs[tt * 128 + dp] = q1 * cs - q2 * sn; qs[tt * 128 + 64 + dp] = q1 * sn + q2 * cs;
                    ks[tt * 128 + dp] = (k1 * cs - k2 * sn) * 0.08838834764831845f; ks[tt * 128 + 64 + dp] = (k1 * sn + k2 * cs) * 0.08838834764831845f;
                    fs[tt * 128 + dp] = gamma; fs[tt * 128 + 64 + dp] = gamma;
                }
            } else {
#pragma unroll
                for (int j = 0; j < 8; ++j) {
                    const int idx = tid + 512 * j, tt = idx >> 7, d = idx & 127;
                    const bf16_t* row = proj + (size_t)(b * SEQ + t0 + tt) * INC;
                    const float q = bf2f(row[C_HQ + hh * 128 + d]);
                    const float z = bf2f(row[(dir ? C_HFB : C_HFF) + hh * 128 + d]);
                    float lb = 0.f;
                    if (l > 0) { const float a0 = p.lb_logits[(0 * 2 + dir) * HWD + hh * 128 + d], a1 = p.lb_logits[(1 * 2 + dir) * HWD + hh * 128 + d]; lb = 1.0f / (1.0f + expf(a0 - a1)); }
                    float f = lb + (1.0f - lb) * (1.0f / (1.0f + expf(-z)));
                    f = fmaxf(f, 1e-6f);
                    qs[tt * 128 + d] = q; ks[tt * 128 + d] = 1.0f - f; fs[tt * 128 + d] = f;
                }
            }
#pragma unroll
            for (int j = 0; j < 2; ++j) {
                const int idx = tid + 512 * j, tt = idx >> 5, c = idx & 31;
                const bf16_t* row = proj + (size_t)(b * SEQ + t0 + tt) * INC;
                vs[tt * 32 + c] = bf2f(row[(type ? C_HI : C_RV) + hh * 128 + vsl * 32 + c]);
            }
            __syncthreads();
            for (int s = 0; s < 32; ++s) {
                const int ss = dir ? 31 - s : s;
                const f32x4 qa = *(const LAS f32x4*)(qs + ss * 128 + kk * 8), qb = *(const LAS f32x4*)(qs + ss * 128 + kk * 8 + 4);
                const f32x4 ka = *(const LAS f32x4*)(ks + ss * 128 + kk * 8), kb = *(const LAS f32x4*)(ks + ss * 128 + kk * 8 + 4);
                const f32x4 fa = *(const LAS f32x4*)(fs + ss * 128 + kk * 8), fb = *(const LAS f32x4*)(fs + ss * 128 + kk * 8 + 4);
                const float vval = vs[ss * 32 + vv];
                float acc = 0.f;
#pragma unroll
                for (int j = 0; j < 4; ++j) { S[j] = fa[j] * S[j] + ka[j] * vval; acc += S[j] * qa[j]; }
#pragma unroll
                for (int j = 0; j < 4; ++j) { S[4 + j] = fb[j] * S[4 + j] + kb[j] * vval; acc += S[4 + j] * qb[j]; }
                acc += __shfl_xor(acc, 32, 64);
                if (lane < 32) po[(ss * 8 + wave) * 32 + vv] = acc;
            }
            __syncthreads();
#pragma unroll
            for (int j = 0; j < 2; ++j) {
                const int idx = tid + 512 * j, tt = idx >> 5, c = idx & 31;
                float s = 0.f;
#pragma unroll
                for (int w = 0; w < 8; ++w) s += po[(tt * 8 + w) * 32 + c];
                obuf[((size_t)dir * T + (size_t)(b * SEQ + t0 + tt)) * 1536 + type * 768 + hh * 128 + vsl * 32 + c] = s;
            }
        }
        __syncthreads();
    }
}

constexpr int MX_QI = 0, MX_KI = 17408, MX_QS = 34816, MX_KTT = 52224, MX_VT = 70656, MX_P = 79872, MX_ST = 89088, MX_TOT = 106496, MX_DEC = 110592;
__device__ __forceinline__ float ex2(float x) { return __builtin_amdgcn_exp2f(x); }
__device__ __forceinline__ float clampe(float x) { return fminf(fmaxf(x, -120.f), 120.f); }
__device__ __forceinline__ void phase_mixer_mfma(const Params& p, int l, LAS unsigned char* lds, float* __restrict__ obuf) {
    int tid = threadIdx.x; asm volatile("" : "+v"(tid));
    const int wave = __builtin_amdgcn_readfirstlane(tid >> 6), lane = tid & 63, fr = lane & 15, fq = lane >> 4;
    const bf16_t* proj = (const bf16_t*)(p.ws + WS_PROJ);
    for (int u = blockIdx.x; u < 192; u += gridDim.x) {
        const int vsl = u & 1, dir = (u >> 1) & 1, hh = (u >> 2) % 6, b = ((u >> 2) / 6) % 4, type = (u >> 2) / 24;
        float lg2 = 0.f, invf0 = 0.f, invf1 = 0.f, sgn = 1.f, lb0 = 0.f, lb1 = 0.f;
        if (type == 0) {
            const float gamma = 1.0f - exp2f(-(dir ? 5.5f : 5.0f) - (float)hh);
            lg2 = log2f(gamma);
            const int dm0 = (2 * lane) & 63;
            invf0 = exp2f(-(float)dm0 * (13.287712379549449f / 64.0f)); invf1 = exp2f(-(float)(dm0 + 1) * (13.287712379549449f / 64.0f));
            sgn = lane < 32 ? -1.f : 1.f;
        } else if (l > 0) {
            const float* lbl = p.lb_logits + dir * HWD + hh * 128 + 2 * lane;
            lb0 = 1.0f / (1.0f + expf(lbl[0] - lbl[2 * HWD])); lb1 = 1.0f / (1.0f + expf(lbl[1] - lbl[2 * HWD + 1]));
        }
        const int colA = (type ? C_HQ : C_RQ) + hh * 128, colB = (type ? (dir ? C_HFB : C_HFF) : C_RK) + hh * 128;
        const int colV = (type ? C_HI : C_RV) + hh * 128 + vsl * 64 + lane;
        const int own = 2 * lane, par = (2 * lane + 64) & 127;
        const size_t ocol = (size_t)type * 768 + hh * 128 + vsl * 64;
        unsigned ra[8], rb[8], rc[8], rd[8]; unsigned short rv[8];
#define MX_LOAD(ch) do { _Pragma("unroll") for (int j = 0; j < 8; ++j) { const int tau = (ch) * 64 + wave * 8 + j; const int t = dir ? (SEQ - 1 - tau) : tau; \
            const bf16_t* row = proj + (size_t)(b * SEQ + t) * INC; \
            ra[j] = *(const unsigned*)(row + colA + own); rb[j] = *(const unsigned*)(row + colB + own); \
            if (type == 0) { rc[j] = *(const unsigned*)(row + colA + par); rd[j] = *(const unsigned*)(row + colB + par); } else { rc[j] = 0u; rd[j] = 0u; } \
            rv[j] = row[colV]; } } while (0)
        f32x4 Sacc[4];
#pragma unroll
        for (int vt = 0; vt < 4; ++vt) Sacc[vt] = (f32x4){0.f, 0.f, 0.f, 0.f};
        for (int i = tid; i < 64 * 272 / 4; i += 512) ((LAS unsigned*)(lds + MX_ST))[i] = 0u;
        MX_LOAD(0);
        __syncthreads();
        for (int ch = 0; ch < 32; ++ch) {
            float q0[8], q1[8], k0[8], k1[8], c0[8], c1[8];
            float run0 = 0.f, run1 = 0.f;
#pragma unroll
            for (int j = 0; j < 8; ++j) {
                const float a_lo = bf2f(ra[j] & 0xffffu), a_hi = bf2f(ra[j] >> 16), b_lo = bf2f(rb[j] & 0xffffu), b_hi = bf2f(rb[j] >> 16);
                float g0, g1;
                if (type == 0) {
                    const int tau = ch * 64 + wave * 8 + j; const int t = dir ? (SEQ - 1 - tau) : tau;
                    float rev0 = (float)t * invf0 * 0.15915494309189535f, rev1 = (float)t * invf1 * 0.15915494309189535f;
                    rev0 -= rintf(rev0); rev1 -= rintf(rev1);
                    const float sn0 = __builtin_amdgcn_sinf(rev0), cs0 = __builtin_amdgcn_cosf(rev0), sn1 = __builtin_amdgcn_sinf(rev1), cs1 = __builtin_amdgcn_cosf(rev1);
                    const float pa_lo = bf2f(rc[j] & 0xffffu), pa_hi = bf2f(rc[j] >> 16), pb_lo = bf2f(rd[j] & 0xffffu), pb_hi = bf2f(rd[j] >> 16);
                    q0[j] = a_lo * cs0 + sgn * pa_lo * sn0; q1[j] = a_hi * cs1 + sgn * pa_hi * sn1;
                    k0[j] = (b_lo * cs0 + sgn * pb_lo * sn0) * 0.08838834764831845f; k1[j] = (b_hi * cs1 + sgn * pb_hi * sn1) * 0.08838834764831845f;
                    g0 = lg2; g1 = lg2;
                } else {
                    q0[j] = a_lo; q1[j] = a_hi;
                    float f0 = lb0 + (1.0f - lb0) * __builtin_amdgcn_rcpf(1.0f + ex2(-b_lo * 1.4426950408889634f));
                    float f1 = lb1 + (1.0f - lb1) * __builtin_amdgcn_rcpf(1.0f + ex2(-b_hi * 1.4426950408889634f));
                    f0 = fmaxf(f0, 1e-6f); f1 = fmaxf(f1, 1e-6f);
                    k0[j] = 1.0f - f0; k1[j] = 1.0f - f1;
                    g0 = __builtin_amdgcn_logf(f0); g1 = __builtin_amdgcn_logf(f1);
                }
                run0 += g0; run1 += g1; c0[j] = run0; c1[j] = run1;
            }
            u32x4 vpk;
            vpk[0] = (unsigned)rv[0] | ((unsigned)rv[1] << 16); vpk[1] = (unsigned)rv[2] | ((unsigned)rv[3] << 16);
            vpk[2] = (unsigned)rv[4] | ((unsigned)rv[5] << 16); vpk[3] = (unsigned)rv[6] | ((unsigned)rv[7] << 16);
            { typedef float f32x2_ __attribute__((ext_vector_type(2))); *(LAS f32x2_*)(lds + MX_TOT + (wave * 128 + 2 * lane) * 4) = (f32x2_){run0, run1}; }
            __syncthreads();
            float off0 = 0.f, off1 = 0.f, m0 = 0.f, m1 = 0.f, tt0 = 0.f, tt1 = 0.f;
#pragma unroll
            for (int g = 0; g < 8; ++g) {
                typedef float f32x2_ __attribute__((ext_vector_type(2)));
                const f32x2_ tv = *(const LAS f32x2_*)(lds + MX_TOT + (g * 128 + 2 * lane) * 4);
                if (g < wave) { off0 += tv[0]; off1 += tv[1]; }
                if (g < 4) { m0 += tv[0]; m1 += tv[1]; }
                tt0 += tv[0]; tt1 += tv[1];
            }
            float kt0[8], kt1[8];
#pragma unroll
            for (int j = 0; j < 8; ++j) {
                const float cu0 = c0[j] + off0, cu1 = c1[j] + off1;
                const float e10 = ex2(clampe(cu0 - m0)), e11 = ex2(clampe(cu1 - m1));
                const float e20 = ex2(clampe(m0 - cu0)), e21 = ex2(clampe(m1 - cu1));
                const float e30 = ex2(cu0), e31 = ex2(cu1);
                const float e40 = ex2(tt0 - cu0), e41 = ex2(tt1 - cu1);
                const int pos = wave * 8 + j;
                *(LAS unsigned*)(lds + MX_QI + pos * 272 + lane * 4) = pack2(q0[j] * e10, q1[j] * e11);
                *(LAS unsigned*)(lds + MX_KI + pos * 272 + lane * 4) = pack2(k0[j] * e20, k1[j] * e21);
                *(LAS unsigned*)(lds + MX_QS + pos * 272 + lane * 4) = pack2(q0[j] * e30, q1[j] * e31);
                kt0[j] = k0[j] * e40; kt1[j] = k1[j] * e41;
            }
            { u32x4 w0, w1;
              w0[0] = pack2(kt0[0], kt0[1]); w0[1] = pack2(kt0[2], kt0[3]); w0[2] = pack2(kt0[4], kt0[5]); w0[3] = pack2(kt0[6], kt0[7]);
              w1[0] = pack2(kt1[0], kt1[1]); w1[1] = pack2(kt1[2], kt1[3]); w1[2] = pack2(kt1[4], kt1[5]); w1[3] = pack2(kt1[6], kt1[7]);
              *(LAS u32x4*)(lds + MX_KTT + (2 * lane) * 144 + wave * 16) = w0;
              *(LAS u32x4*)(lds + MX_KTT + (2 * lane + 1) * 144 + wave * 16) = w1;
              *(LAS u32x4*)(lds + MX_VT + lane * 144 + wave * 16) = vpk; }
            if (wave == 0) { typedef float f32x2_ __attribute__((ext_vector_type(2))); *(LAS f32x2_*)(lds + MX_DEC + lane * 8) = (f32x2_){ex2(tt0), ex2(tt1)}; }
            __syncthreads();
            if (ch + 1 < 32) MX_LOAD(ch + 1);
            {
                const int it = wave >> 1;
#pragma unroll
                for (int h2 = 0; h2 < 2; ++h2) {
                    const int st = 2 * (wave & 1) + h2;
                    f32x4 acc = (f32x4){0.f, 0.f, 0.f, 0.f};
                    if (st <= it) {
#pragma unroll
                        for (int kq = 0; kq < 4; ++kq) {
                            const bf16x8 af = *(const LAS bf16x8*)(lds + MX_KI + (16 * st + fr) * 272 + (32 * kq + 8 * fq) * 2);
                            const bf16x8 bfg = *(const LAS bf16x8*)(lds + MX_QI + (16 * it + fr) * 272 + (32 * kq + 8 * fq) * 2);
                            acc = __builtin_amdgcn_mfma_f32_16x16x32_bf16(af, bfg, acc, 0, 0, 0);
                        }
                    }
                    const int i = 16 * it + fr, s0 = 16 * st + 4 * fq;
                    const float v0 = (s0 + 0 <= i) ? acc[0] : 0.f, v1 = (s0 + 1 <= i) ? acc[1] : 0.f, v2 = (s0 + 2 <= i) ? acc[2] : 0.f, v3 = (s0 + 3 <= i) ? acc[3] : 0.f;
                    u32x2 o; o[0] = pack2(v0, v1); o[1] = pack2(v2, v3);
                    *(LAS u32x2*)(lds + MX_P + i * 144 + s0 * 2) = o;
                }
            }
            __syncthreads();
            {
                const int vt = wave >> 1;
#pragma unroll
                for (int h2 = 0; h2 < 2; ++h2) {
                    const int it = 2 * (wave & 1) + h2;
                    f32x4 acc = (f32x4){0.f, 0.f, 0.f, 0.f};
#pragma unroll
                    for (int kq = 0; kq < 2; ++kq) {
                        const bf16x8 af = *(const LAS bf16x8*)(lds + MX_VT + (16 * vt + fr) * 144 + (32 * kq + 8 * fq) * 2);
                        const bf16x8 bfg = *(const LAS bf16x8*)(lds + MX_P + (16 * it + fr) * 144 + (32 * kq + 8 * fq) * 2);
                        acc = __builtin_amdgcn_mfma_f32_16x16x32_bf16(af, bfg, acc, 0, 0, 0);
                    }
#pragma unroll
                    for (int kq = 0; kq < 4; ++kq) {
                        const bf16x8 af = *(const LAS bf16x8*)(lds + MX_ST + (16 * vt + fr) * 272 + (32 * kq + 8 * fq) * 2);
                        const bf16x8 bfg = *(const LAS bf16x8*)(lds + MX_QS + (16 * it + fr) * 272 + (32 * kq + 8 * fq) * 2);
                        acc = __builtin_amdgcn_mfma_f32_16x16x32_bf16(af, bfg, acc, 0, 0, 0);
                    }
                    const int tau = ch * 64 + 16 * it + fr; const int t = dir ? (SEQ - 1 - tau) : tau;
                    *(f32x4*)(obuf + ((size_t)dir * T + (size_t)(b * SEQ + t)) * 1536 + ocol + 16 * vt + 4 * fq) = acc;
                }
            }
            {
                const f32x4 dc = *(const LAS f32x4*)(lds + MX_DEC + (16 * wave + 4 * fq) * 4);
                bf16x8 af[2];
#pragma unroll
                for (int kq = 0; kq < 2; ++kq) af[kq] = *(const LAS bf16x8*)(lds + MX_KTT + (16 * wave + fr) * 144 + (32 * kq + 8 * fq) * 2);
#pragma unroll
                for (int vt = 0; vt < 4; ++vt) {
                    f32x4 a = Sacc[vt]; a[0] *= dc[0]; a[1] *= dc[1]; a[2] *= dc[2]; a[3] *= dc[3];
#pragma unroll
                    for (int kq = 0; kq < 2; ++kq) {
                        const bf16x8 bfg = *(const LAS bf16x8*)(lds + MX_VT + (16 * vt + fr) * 144 + (32 * kq + 8 * fq) * 2);
                        a = __builtin_amdgcn_mfma_f32_16x16x32_bf16(af[kq], bfg, a, 0, 0, 0);
                    }
                    Sacc[vt] = a;
                }
            }
            __syncthreads();
#pragma unroll
            for (int vt = 0; vt < 4; ++vt) { u32x2 o; o[0] = pack2(Sacc[vt][0], Sacc[vt][1]); o[1] = pack2(Sacc[vt][2], Sacc[vt][3]);
                *(LAS u32x2*)(lds + MX_ST + (16 * vt + fr) * 272 + (16 * wave + 4 * fq) * 2) = o; }
        }
        __syncthreads();
#undef MX_LOAD
    }
}

#ifdef MIXER_CHECK
__device__ __forceinline__ void phase_mixer_check(const Params& p, const float* __restrict__ oa, const float* __restrict__ ob, float* chk) {
    int tid_ = threadIdx.x; asm volatile("" : "+v"(tid_)); const int wave = tid_ >> 6, lane = tid_ & 63;
    for (int r = blockIdx.x * 8 + wave; r < 2 * T; r += gridDim.x * 8) {
        const int dir = r / T;
#pragma unroll
        for (int ty = 0; ty < 2; ++ty) {
            float sd = 0.f, sq = 0.f;
#pragma unroll
            for (int i = 0; i < 3; ++i) { const float4 a = *(const float4*)(oa + (size_t)r * 1536 + ty * 768 + i * 256 + lane * 4), bq = *(const float4*)(ob + (size_t)r * 1536 + ty * 768 + i * 256 + lane * 4);
                sd += (a.x - bq.x) * (a.x - bq.x) + (a.y - bq.y) * (a.y - bq.y) + (a.z - bq.z) * (a.z - bq.z) + (a.w - bq.w) * (a.w - bq.w);
                sq += a.x * a.x + a.y * a.y + a.z * a.z + a.w * a.w; }
            sd = wave_sum(sd); sq = wave_sum(sq);
            if (lane == 0) { atomicAdd(&chk[(ty * 2 + dir) * 2 + 0], sd); atomicAdd(&chk[(ty * 2 + dir) * 2 + 1], sq); }
        }
    }
}
#endif

__device__ __forceinline__ float4 ld_bf4(const bf16_t* p) { const u32x2 r = *(const u32x2*)p; return make_float4(bf2f(r[0] & 0xffffu), bf2f(r[0] >> 16), bf2f(r[1] & 0xffffu), bf2f(r[1] >> 16)); }
__device__ __forceinline__ void phase_finalize(const Params& p, int l) {
    int tid_ = threadIdx.x; asm volatile("" : "+v"(tid_)); const int wave = tid_ >> 6, lane = tid_ & 63;
    const bf16_t* proj = (const bf16_t*)(p.ws + WS_PROJ);
    const float* obuf = (const float*)(p.ws + WS_OBUF);
    bf16_t* mixed = (bf16_t*)(p.ws + WS_MIXED);
    const float* cw = p.conv_w + (size_t)l * 3 * CW;
    const float* beta = p.mix_beta + (size_t)l * D;
    for (int n = blockIdx.x * 8 + wave; n < T; n += gridDim.x * 8) {
        const int t = n % SEQ;
        const bf16_t* row = proj + (size_t)n * INC;
        bf16_t* dst = mixed + (size_t)n * D;
#pragma unroll
        for (int i = 0; i < 8; ++i) {
            const int c = i * 256 + lane * 4;
            float4 r;
            if (i < 2) {
                const float4 cc = ld_bf4(row + C_CC + c), ch = ld_bf4(row + C_CH + c), cb = ld_bf4(row + C_CB + c);
                float4 um = make_float4(0.f, 0.f, 0.f, 0.f), up = um;
                if (t > 0) { const float4 a = ld_bf4(row - INC + C_CC + c), b2 = ld_bf4(row - INC + C_CH + c); um = make_float4(a.x * b2.x, a.y * b2.y, a.z * b2.z, a.w * b2.w); }
                if (t < SEQ - 1) { const float4 a = ld_bf4(row + INC + C_CC + c), b2 = ld_bf4(row + INC + C_CH + c); up = make_float4(a.x * b2.x, a.y * b2.y, a.z * b2.z, a.w * b2.w); }
                const float4 w0 = *(const float4*)(cw + c), w1 = *(const float4*)(cw + CW + c), w2 = *(const float4*)(cw + 2 * CW + c);
                r.x = cb.x * (um.x * w0.x + cc.x * ch.x * w1.x + up.x * w2.x);
                r.y = cb.y * (um.y * w0.y + cc.y * ch.y * w1.y + up.y * w2.y);
                r.z = cb.z * (um.z * w0.z + cc.z * ch.z * w1.z + up.z * w2.z);
                r.w = cb.w * (um.w * w0.w + cc.w * ch.w * w1.w + up.w * w2.w);
            } else {
                const int oc = c - 512;
                const float4 of = *(const float4*)(obuf + (size_t)n * 1536 + oc), ob = *(const float4*)(obuf + ((size_t)T + n) * 1536 + oc);
                float4 o = make_float4(of.x + ob.x, of.y + ob.y, of.z + ob.z, of.w + ob.w);
                float4 gt;
                if (i < 5) {
                    gt = ld_bf4(row + C_RG + oc);
                    const float mu = half_sum((o.x + o.y) + (o.z + o.w)) * (1.0f / 128.0f);
                    o.x -= mu; o.y -= mu; o.z -= mu; o.w -= mu;
                    const float var = half_sum((o.x * o.x + o.y * o.y) + (o.z * o.z + o.w * o.w)) * (1.0f / 128.0f);
                    const float rs = rsqrtf(var + 1e-6f);
                    o.x *= rs; o.y *= rs; o.z *= rs; o.w *= rs;
                } else {
                    gt = ld_bf4(row + C_HG + (oc - 768));
                    const float ms = half_sum((o.x * o.x + o.y * o.y) + (o.z * o.z + o.w * o.w)) * (1.0f / 128.0f);
                    const float rs = rsqrtf(ms + 1e-6f);
                    o.x *= rs; o.y *= rs; o.z *= rs; o.w *= rs;
                }
                r.x = o.x * siluf_(gt.x); r.y = o.y * siluf_(gt.y); r.z = o.z * siluf_(gt.z); r.w = o.w * siluf_(gt.w);
            }
            const float4 bt = *(const float4*)(beta + c);
            u32x2 ov; ov[0] = pack2(r.x * bt.x, r.y * bt.y); ov[1] = pack2(r.z * bt.z, r.w * bt.w);
            *(u32x2*)(dst + c) = ov;
        }
    }
}

__device__ __forceinline__ void phase_ln1_router(const Params& p, int l, LAS unsigned char* lds) {
    int tid = threadIdx.x; asm volatile("" : "+v"(tid)); const int wave = tid >> 6, lane = tid & 63;
    LAS float* wrt = (LAS float*)lds;
    for (int i = tid; i < D * NE / 4; i += 512) {
        const float4 w = *(const float4*)(p.w_router + (size_t)i * 4);
        const int d = i >> 2, e4 = (i & 3) * 4;
        wrt[(e4 + 0) * D + d] = w.x; wrt[(e4 + 1) * D + d] = w.y; wrt[(e4 + 2) * D + d] = w.z; wrt[(e4 + 3) * D + d] = w.w;
    }
    __syncthreads();
    const float* mod = (const float*)(p.ws + WS_MOD);
    const float* y = (const float*)(p.ws + WS_Y);
    float* xres = (float*)(p.ws + WS_XRES);
    unsigned* cnt = (unsigned*)(p.ws + WS_CNT) + l * 16;
    int* route = (int*)(p.ws + WS_ROUTE);
    for (int n = blockIdx.x * 8 + wave; n < T; n += gridDim.x * 8) {
        const int b = n / SEQ;
        const float* mb = mod + ((size_t)l * 4 + b) * (6 * D);
        float4 v[8];
#pragma unroll
        for (int i = 0; i < 8; ++i) {
            const float4 xv = *(const float4*)(xres + (size_t)n * D + i * 256 + lane * 4), yv = *(const float4*)(y + (size_t)n * D + i * 256 + lane * 4);
            const float4 g = *(const float4*)(mb + 2 * D + i * 256 + lane * 4);
            v[i].x = ALPHA * xv.x + (1.f + g.x) * yv.x; v[i].y = ALPHA * xv.y + (1.f + g.y) * yv.y; v[i].z = ALPHA * xv.z + (1.f + g.z) * yv.z; v[i].w = ALPHA * xv.w + (1.f + g.w) * yv.w;
        }
        ln_rows(v, p.ln_g + (size_t)(l * 2 + 0) * D, p.ln_b + (size_t)(l * 2 + 0) * D, lane);
#pragma unroll
        for (int i = 0; i < 8; ++i) *(float4*)(xres + (size_t)n * D + i * 256 + lane * 4) = v[i];
#pragma unroll
        for (int i = 0; i < 8; ++i) {
            const float4 sh = *(const float4*)(mb + 3 * D + i * 256 + lane * 4), sc = *(const float4*)(mb + 4 * D + i * 256 + lane * 4);
            v[i].x = v[i].x * (1.f + sc.x) + sh.x; v[i].y = v[i].y * (1.f + sc.y) + sh.y; v[i].z = v[i].z * (1.f + sc.z) + sh.z; v[i].w = v[i].w * (1.f + sc.w) + sh.w;
        }
        bf16_t* hb = (bf16_t*)(p.ws + WS_HB) + (size_t)n * D;
#pragma unroll
        for (int i = 0; i < 8; ++i) { u32x2 o; o[0] = pack2(v[i].x, v[i].y); o[1] = pack2(v[i].z, v[i].w); *(u32x2*)(hb + i * 256 + lane * 4) = o; }
        float lgv = 0.f;
#pragma unroll 1
        for (int e = 0; e < 16; ++e) {
            float s = 0.f;
#pragma unroll
            for (int i = 0; i < 8; ++i) { const f32x4 w = *(const LAS f32x4*)(wrt + e * D + i * 256 + lane * 4); s += (v[i].x * w[0] + v[i].y * w[1]) + (v[i].z * w[2] + v[i].w * w[3]); }
            s = wave_sum(s);
            lgv = (lane == e) ? s : lgv;
        }
        float lg[16];
#pragma unroll
        for (int e = 0; e < 16; ++e) lg[e] = __int_as_float(__builtin_amdgcn_readlane(__float_as_int(lgv), e));
        float mx = lg[0];
#pragma unroll
        for (int e = 1; e < 16; ++e) mx = fmaxf(mx, lg[e]);
        float sc[16], sum = 0.f;
#pragma unroll
        for (int e = 0; e < 16; ++e) { sc[e] = expf(lg[e] - mx); sum += sc[e]; }
        const float inv = 1.0f / sum;
        float sel[16];
#pragma unroll
        for (int e = 0; e < 16; ++e) { sc[e] *= inv; sel[e] = sc[e] + p.router_bias[e]; }
        float best_gs = -3.0e38f; int bi0 = 0, bi1 = 1; float bw0 = 0.f, bw1 = 0.f;
#pragma unroll
        for (int g = 0; g < 4; ++g) {
            int i0 = 0; float m0 = sel[4 * g];
#pragma unroll
            for (int j = 1; j < 4; ++j) if (sel[4 * g + j] > m0) { m0 = sel[4 * g + j]; i0 = j; }
            int i1 = -1; float m1 = -3.0e38f;
#pragma unroll
            for (int j = 0; j < 4; ++j) if (j != i0 && sel[4 * g + j] > m1) { m1 = sel[4 * g + j]; i1 = j; }
            float w0 = 0.f, w1 = 0.f;
#pragma unroll
            for (int j = 0; j < 4; ++j) { w0 = (j == i0) ? sc[4 * g + j] : w0; w1 = (j == i1) ? sc[4 * g + j] : w1; }
            const float gs = m0 + m1;
            if (gs > best_gs) { best_gs = gs; bi0 = 4 * g + i0; bi1 = 4 * g + i1; bw0 = w0; bw1 = w1; }
        }
        if (lane == 0) {
            const float ws_ = 1.0f / (bw0 + bw1);
            const unsigned p0 = atomicAdd(&cnt[bi0], 1u), p1 = atomicAdd(&cnt[bi1], 1u);
            int* r = route + (size_t)n * 8;
            r[0] = bi0; r[1] = bi1; r[2] = (int)p0; r[3] = (int)p1; r[4] = __float_as_int(bw0 * ws_); r[5] = __float_as_int(bw1 * ws_);
        }
    }
}

__device__ __forceinline__ void build_moe_tab(const Params& p, int l, LAS int* tab) {
    if (threadIdx.x == 0) {
        const unsigned* cnt = (const unsigned*)(p.ws + WS_CNT) + l * 16;
        int acc = 0;
        for (int e = 0; e < 16; ++e) { tab[e] = acc; acc += (int)((cnt[e] + 255u) >> 8); }
        tab[16] = acc;
    }
    __syncthreads();
}

__device__ __forceinline__ void phase_permute(const Params& p, int l, LAS int* tab) {
    build_moe_tab(p, l, tab);
    int tid_ = threadIdx.x; asm volatile("" : "+v"(tid_)); const int wave = tid_ >> 6, lane = tid_ & 63;
    int* route = (int*)(p.ws + WS_ROUTE);
    const bf16_t* hb = (const bf16_t*)(p.ws + WS_HB);
    bf16_t* xe = (bf16_t*)(p.ws + WS_XE);
    for (int n = blockIdx.x * 8 + wave; n < T; n += gridDim.x * 8) {
        int* r = route + (size_t)n * 8;
        const int e0 = r[0], e1 = r[1], p0 = r[2], p1 = r[3];
        const int row0 = tab[e0] * 256 + p0, row1 = tab[e1] * 256 + p1;
        const u32x4* src = (const u32x4*)(hb + (size_t)n * D);
        u32x4* d0 = (u32x4*)(xe + (size_t)row0 * D); u32x4* d1 = (u32x4*)(xe + (size_t)row1 * D);
#pragma unroll
        for (int i = 0; i < 4; ++i) { const u32x4 v = src[i * 64 + lane]; d0[i * 64 + lane] = v; d1[i * 64 + lane] = v; }
        if (lane == 0) { r[6] = row0; r[7] = row1; }
    }
}

__device__ __forceinline__ void phase_ln2(const Params& p, int l) {
    int tid_ = threadIdx.x; asm volatile("" : "+v"(tid_)); const int wave = tid_ >> 6, lane = tid_ & 63;
    const float* mod = (const float*)(p.ws + WS_MOD);
    const float* ye = (const float*)(p.ws + WS_YE);
    float* xres = (float*)(p.ws + WS_XRES);
    const int* route = (const int*)(p.ws + WS_ROUTE);
    for (int n = blockIdx.x * 8 + wave; n < T; n += gridDim.x * 8) {
        const int b = n / SEQ;
        const float* mb = mod + ((size_t)l * 4 + b) * (6 * D);
        const int* r = route + (size_t)n * 8;
        const float w0 = __int_as_float(r[4]), w1 = __int_as_float(r[5]);
        const float* y0 = ye + (size_t)r[6] * D; const float* y1 = ye + (size_t)r[7] * D;
        float4 v[8];
#pragma unroll
        for (int i = 0; i < 8; ++i) {
            const float4 xv = *(const float4*)(xres + (size_t)n * D + i * 256 + lane * 4);
            const float4 a = *(const float4*)(y0 + i * 256 + lane * 4), c = *(const float4*)(y1 + i * 256 + lane * 4);
            const float4 g = *(const float4*)(mb + 5 * D + i * 256 + lane * 4);
            v[i].x = ALPHA * xv.x + (1.f + g.x) * (w0 * a.x + w1 * c.x); v[i].y = ALPHA * xv.y + (1.f + g.y) * (w0 * a.y + w1 * c.y);
            v[i].z = ALPHA * xv.z + (1.f + g.z) * (w0 * a.z + w1 * c.z); v[i].w = ALPHA * xv.w + (1.f + g.w) * (w0 * a.w + w1 * c.w);
        }
        ln_rows(v, p.ln_g + (size_t)(l * 2 + 1) * D, p.ln_b + (size_t)(l * 2 + 1) * D, lane);
        if (l + 1 < DEPTH) {
#pragma unroll
            for (int i = 0; i < 8; ++i) *(float4*)(xres + (size_t)n * D + i * 256 + lane * 4) = v[i];
            const float* mn = mod + ((size_t)(l + 1) * 4 + b) * (6 * D);
            modulate_store(v, mn, mn + D, (bf16_t*)(p.ws + WS_HA) + (size_t)n * D, lane);
        } else {
#ifdef MIXER_CHECK
            { const float* chk = (const float*)(p.ws + WS_CNT + 1024); float scale = 1.f;
              for (int j = 7; j >= 0; --j) { const float sd = chk[j * 2], sq = chk[j * 2 + 1]; if (!(sd <= 1e-3f * sq)) scale = 1.0f + 0.25f * (float)(1 << (j & 3)) + 8.f * (float)(j >> 2); }
#pragma unroll
              for (int i = 0; i < 8; ++i) { v[i].x *= scale; v[i].y *= scale; v[i].z *= scale; v[i].w *= scale; } }
#endif
#pragma unroll
            for (int i = 0; i < 8; ++i) *(float4*)(p.out + (size_t)n * D + i * 256 + lane * 4) = v[i];
        }
    }
}

typedef const __attribute__((address_space(4))) unsigned char* KargPtr;
__device__ __forceinline__ Params load_params(KargPtr q) { asm volatile("" : "+s"(q)); Params lp; __builtin_memcpy(&lp, q, sizeof(Params)); return lp; }

__global__ __launch_bounds__(512, 2) void mega(Params p_in) {
    extern __shared__ __attribute__((aligned(16))) unsigned char smem[];
    LAS unsigned char* lds = (LAS unsigned char*)smem;
    LAS int* tab = (LAS int*)(lds + LDS_MISC + 64);
    KargPtr kp = (KargPtr)__builtin_amdgcn_kernarg_segment_ptr();
    if (threadIdx.x == 0) { *(LAS u32x4*)(lds + LDS_MISC) = (u32x4){0u, 0u, 0u, 0u}; }
    __syncthreads();
    const int fused = p_in.fused, ph_lo = p_in.ph_lo, ph_hi = p_in.ph_hi, l_hi = p_in.l_hi;
    XcdBarrier bar;
    if (fused) bar = xcd_barrier_post((unsigned*)(p_in.ws + WS_BAR), (volatile LAS unsigned*)(lds + LDS_MISC));
    else { bar.bar = (unsigned*)(p_in.ws + WS_BAR); bar.x = 0; bar.st = (volatile LAS unsigned*)(lds + LDS_MISC); }
#ifdef ONLY_PH
#define PH(i) ((i) == ONLY_PH && ph_lo <= (i) && (i) < ph_hi)
#else
#define PH(i) (ph_lo <= (i) && (i) < ph_hi)
#endif
#define SYNC() do { if (fused) xcd_barrier(bar); } while (0)
    const int G = gridDim.x, c = blockIdx.x;
    if (PH(0)) { const Params p = load_params(kp); phase_prologue(p, lds); SYNC(); }
    if (PH(1)) { const Params p = load_params(kp); phase_ln0(p); SYNC(); }
    for (int l = p_in.l_lo; l < l_hi; ++l) {
        if (PH(2)) {
            const Params p = load_params(kp);
            pg8::DenseOrder S; S.init(T, INC, D, G, c);
            pg8::Gemm g{(const bf16_t*)(p.ws + WS_HA), (const bf16_t*)(p.ws + WS_WIN) + (size_t)l * INC * D, D};
            pg8::EpiBf16 E{(bf16_t*)(p.ws + WS_PROJ), INC};
            pg8::gemm_phase(lds, g, S, E);
            SYNC();
        }
#ifdef MIXER_CHECK
        if (PH(3)) { const Params p = load_params(kp); phase_mixer_valu(p, l, lds); SYNC(); }
        if (PH(3)) { const Params p = load_params(kp); phase_mixer_mfma(p, l, lds, (float*)(p.ws + WS_XE)); SYNC(); }
        if (PH(3)) { const Params p = load_params(kp); phase_mixer_check(p, (const float*)(p.ws + WS_OBUF), (const float*)(p.ws + WS_XE), (float*)(p.ws + WS_CNT + 1024) + l * 8); SYNC(); }
#else
        if (PH(3)) { const Params p = load_params(kp); phase_mixer_mfma(p, l, lds, (float*)(p.ws + WS_OBUF)); SYNC(); }
#endif
        if (PH(4)) { const Params p = load_params(kp); phase_finalize(p, l); SYNC(); }
        if (PH(5)) {
            const Params p = load_params(kp);
            pg8::DenseOrder S; S.init(T, D, D, G, c);
            pg8::Gemm g{(const bf16_t*)(p.ws + WS_MIXED), (const bf16_t*)(p.ws + WS_WOUT) + (size_t)l * D * D, D};
            pg8::EpiF32 E{(float*)(p.ws + WS_Y), D};
            pg8::gemm_phase(lds, g, S, E);
            SYNC();
        }
        if (PH(6)) { const Params p = load_params(kp); phase_ln1_router(p, l, lds); SYNC(); }
        if (PH(7)) { const Params p = load_params(kp); phase_permute(p, l, tab); SYNC(); }
        if (PH(8)) {
            const Params p = load_params(kp);
            build_moe_tab(p, l, tab);
            pg8::MoeOrder S; S.tab = tab; S.NTn = 11; S.G = G; S.c = c; S.tstep = (size_t)256 * D * 2; S.bexp = (size_t)2 * DE * D * 2;
            pg8::Gemm g{(const bf16_t*)(p.ws + WS_XE), (const bf16_t*)(p.ws + WS_WGU) + (size_t)l * NE * 2 * DE * D, D};
            pg8::EpiHidden E{(bf16_t*)(p.ws + WS_HID)};
            pg8::gemm_phase(lds, g, S, E);
            SYNC();
        }
        if (PH(9)) {
            const Params p = load_params(kp);
            build_moe_tab(p, l, tab);
            pg8::MoeOrder S; S.tab = tab; S.NTn = 8; S.G = G; S.c = c; S.tstep = (size_t)256 * DE * 2; S.bexp = (size_t)D * DE * 2;
            pg8::Gemm g{(const bf16_t*)(p.ws + WS_HID), (const bf16_t*)(p.ws + WS_WD) + (size_t)l * NE * D * DE, DE};
            pg8::EpiF32 E{(float*)(p.ws + WS_YE), D};
            pg8::gemm_phase(lds, g, S, E);
            SYNC();
        }
        if (PH(10)) { const Params p = load_params(kp); phase_ln2(p, l); SYNC(); }
    }
}

#ifndef MK_FUSED
#define MK_FUSED 1
#endif
extern "C" void kernel_launch(void* const* d_in, const int* in_sizes, int n_in, void* d_out, int out_size, void* d_ws, size_t ws_size, hipStream_t stream) {
    static int grid = 0;
    if (grid == 0) {
        if (n_in != 18 || ws_size < WS_END) { fprintf(stderr, "kernel_launch: unexpected n_in %d or ws_size %zu (< %zu)\n", n_in, ws_size, (size_t)WS_END); grid = -1; return; }
        int dev = 0, cus = 0, per_cu = 0;
        hipGetDevice(&dev);
        hipDeviceGetAttribute(&cus, hipDeviceAttributeMultiprocessorCount, dev);
        if (hipFuncSetAttribute((const void*)mega, hipFuncAttributeMaxDynamicSharedMemorySize, LDS_BYTES) != hipSuccess) { fprintf(stderr, "kernel_launch: hipFuncSetAttribute failed\n"); grid = -1; return; }
        hipOccupancyMaxActiveBlocksPerMultiprocessor(&per_cu, (const void*)mega, 512, LDS_BYTES);
        if (per_cu < 1) fprintf(stderr, "kernel_launch: occupancy query says %d\n", per_cu);
        grid = cus > 0 ? cus : 256;
    }
    if (grid < 0) return;
    hipMemsetAsync(d_ws, 0, WS_ZERO_BYTES, stream);
    Params p{};
    p.x = (const float*)d_in[0]; p.c = (const float*)d_in[1]; p.emb_g = (const float*)d_in[2]; p.emb_b = (const float*)d_in[3];
    p.w_ada = (const float*)d_in[4]; p.b_ada = (const float*)d_in[5]; p.w_in = (const float*)d_in[6]; p.conv_w = (const float*)d_in[7];
    p.mix_beta = (const float*)d_in[8]; p.w_out = (const float*)d_in[9]; p.lb_logits = (const float*)d_in[10]; p.ln_g = (const float*)d_in[11];
    p.ln_b = (const float*)d_in[12]; p.w_router = (const float*)d_in[13]; p.router_bias = (const float*)d_in[14]; p.w_gate = (const float*)d_in[15];
    p.w_up = (const float*)d_in[16]; p.w_down = (const float*)d_in[17];
    p.out = (float*)d_out; p.ws = (unsigned char*)d_ws; p.pad = 0;
#if MK_FUSED
    p.ph_lo = 0; p.ph_hi = 11; p.l_lo = 0; p.l_hi = DEPTH; p.fused = 1;
    hipLaunchKernelGGL(mega, dim3(grid), dim3(512), LDS_BYTES, stream, p);
#else
    p.fused = 0;
    for (int ph = 0; ph < 2; ++ph) { p.ph_lo = ph; p.ph_hi = ph + 1; p.l_lo = 0; p.l_hi = 0; hipLaunchKernelGGL(mega, dim3(grid), dim3(512), LDS_BYTES, stream, p); }
    for (int l = 0; l < DEPTH; ++l)
        for (int ph = 2; ph < 11; ++ph) { p.ph_lo = ph; p.ph_hi = ph + 1; p.l_lo = l; p.l_hi = l + 1; hipLaunchKernelGGL(mega, dim3(grid), dim3(512), LDS_BYTES, stream, p); }
#endif
}
```

```cpp
#include <hip/hip_runtime.h>
#include <stdint.h>
#include <stdio.h>

#define LAS __attribute__((address_space(3)))
typedef unsigned short bf16_t;
typedef short bf16x8 __attribute__((ext_vector_type(8)));
typedef float f32x4 __attribute__((ext_vector_type(4)));
typedef unsigned u32x4 __attribute__((ext_vector_type(4)));
typedef unsigned u32x2 __attribute__((ext_vector_type(2)));

constexpr int D = 2048, NB = 4, SEQ = 2048, T = NB * SEQ, DEPTH = 2;
constexpr int CW = 512, RW = 768, HWD = 768, INC = 8448;
constexpr int NE = 16, DE = 1408;
constexpr int C_CB = 0, C_CC = 512, C_CH = 1024, C_RQ = 1536, C_RK = 2304, C_RV = 3072, C_RG = 3840, C_HQ = 4608, C_HFF = 5376, C_HFB = 6144, C_HI = 6912, C_HG = 7680;
constexpr int XE_ROWS = 20480;
constexpr float ALPHA = 1.4142135623730951f;

constexpr size_t WS_BAR = 0;
constexpr size_t WS_CNT = 16384;
constexpr size_t WS_ZERO_BYTES = 32768;
constexpr size_t WS_MOD = 32768;
constexpr size_t WS_ROUTE = WS_MOD + 393216;
constexpr size_t WS_WGCNT = WS_ROUTE + 262144;
constexpr size_t WS_WIN = 1048576;
constexpr size_t SZ_WIN = (size_t)DEPTH * INC * D * 2;
constexpr size_t WS_WOUT = WS_WIN + SZ_WIN;
constexpr size_t SZ_WOUT = (size_t)DEPTH * D * D * 2;
constexpr size_t WS_WGU = WS_WOUT + SZ_WOUT;
constexpr size_t SZ_WGU = (size_t)DEPTH * NE * 2 * DE * D * 2;
constexpr size_t WS_WD = WS_WGU + SZ_WGU;
constexpr size_t SZ_WD = (size_t)DEPTH * NE * D * DE * 2;
constexpr size_t WS_XRES = WS_WD + SZ_WD;
constexpr size_t SZ_XRES = (size_t)T * D * 4;
constexpr size_t WS_HA = WS_XRES + SZ_XRES;
constexpr size_t SZ_H = (size_t)T * D * 2;
constexpr size_t WS_HB = WS_HA + SZ_H;
constexpr size_t WS_PROJ = WS_HB + SZ_H;
constexpr size_t SZ_PROJ = (size_t)T * INC * 2;
constexpr size_t WS_OBUF = WS_PROJ + SZ_PROJ;
constexpr size_t SZ_OBUF = (size_t)2 * T * 1536 * 4;
constexpr size_t WS_YE = WS_PROJ;
constexpr size_t SZ_YE = (size_t)XE_ROWS * D * 4;
static_assert(SZ_YE <= SZ_PROJ + SZ_OBUF, "ye alias");
constexpr size_t WS_MIXED = WS_OBUF + SZ_OBUF;
constexpr size_t WS_Y = WS_MIXED + SZ_H;
constexpr size_t SZ_Y = (size_t)T * D * 4;
constexpr size_t WS_XE = WS_Y + SZ_Y;
constexpr size_t SZ_XE = (size_t)XE_ROWS * D * 2;
constexpr size_t WS_HID = WS_XE + SZ_XE;
constexpr size_t SZ_HID = (size_t)XE_ROWS * DE * 2;
constexpr size_t WS_END = WS_HID + SZ_HID;

constexpr int LDS_BYTES = 147456;
constexpr int LDS_MISC = 131072;

struct Params {
    const float *x, *c, *emb_g, *emb_b, *w_ada, *b_ada, *w_in, *conv_w, *mix_beta, *w_out, *lb_logits, *ln_g, *ln_b, *w_router, *router_bias, *w_gate, *w_up, *w_down;
    float* out;
    unsigned char* ws;
    int ph_lo, ph_hi, l_lo, l_hi, fused, pad;
};

__device__ __forceinline__ float bf2f(unsigned b) { return __uint_as_float(b << 16); }
__device__ __forceinline__ unsigned f2bf(float f) { unsigned u = __float_as_uint(f); u += 0x7FFFu + ((u >> 16) & 1u); return u >> 16; }
__device__ __forceinline__ unsigned pack2(float lo, float hi) { return f2bf(lo) | (f2bf(hi) << 16); }
__device__ __forceinline__ float wave_sum(float v) {
#pragma unroll
    for (int o = 32; o > 0; o >>= 1) v += __shfl_xor(v, o, 64);
    return v;
}
__device__ __forceinline__ float half_sum(float v) {
#pragma unroll
    for (int o = 16; o > 0; o >>= 1) v += __shfl_xor(v, o, 64);
    return v;
}
__device__ __forceinline__ float sigmoidf_(float z) { return 1.0f / (1.0f + __expf(-z)); }
__device__ __forceinline__ float siluf_(float z) { return z / (1.0f + __expf(-z)); }

#define XB_TMO      128
#define XB_XCNT(j)  (256  + 64 * (j))
#define XB_XSUB(j)  (1280 + 64 * (j))
#define XB_XGEN(j)  (2304 + 64 * (j))
#define XB_TOP      3328
#define XB_TOPGEN   3392
#define XCD_BAR_WORDS 3456
#define XB_SPIN_CAP (1u << 22)
__device__ __forceinline__ unsigned xb_ld(unsigned* p)              { return __hip_atomic_load(p, __ATOMIC_RELAXED, __HIP_MEMORY_SCOPE_AGENT); }
__device__ __forceinline__ unsigned xb_add(unsigned* p, unsigned v) { return __hip_atomic_fetch_add(p, v, __ATOMIC_RELAXED, __HIP_MEMORY_SCOPE_AGENT); }
__device__ __forceinline__ unsigned xb_xcc_id() { return (unsigned)__builtin_amdgcn_s_getreg((3 << 11) | 20) & 0xFu; }
#define XB_SPIN(cond, bar) do { unsigned _sp = 0; while (cond) { __builtin_amdgcn_s_sleep(1); \
    if ((++_sp & 255u) == 0u) { if (xb_ld(&(bar)[XB_TMO])) break; if (_sp > XB_SPIN_CAP) { atomicAdd(&(bar)[XB_TMO], 1u); break; } } } } while (0)
struct XcdBarrier { unsigned* bar; unsigned x; volatile LAS unsigned* st; };
__device__ __forceinline__ XcdBarrier xcd_barrier_post(unsigned* bar, volatile LAS unsigned* st) {
    XcdBarrier b; b.bar = bar; b.x = xb_xcc_id(); b.st = st;
    if (threadIdx.x == 0) (void)xb_add(&bar[XB_XCNT(b.x)], 1u);
    return b;
}
__device__ __forceinline__ void xcd_barrier_complete(unsigned* bar, unsigned x, unsigned& nloc, unsigned& nx) {
    const unsigned G = gridDim.x * gridDim.y * gridDim.z;
    unsigned sum, cnt, mine, sp = 0u;
    for (;;) {
        sum = 0u; cnt = 0u; mine = 0u;
#pragma unroll
        for (unsigned j = 0; j < 16; ++j) { const unsigned c = xb_ld(&bar[XB_XCNT(j)]); sum += c; cnt += (c > 0u) ? 1u : 0u; mine = (j == x) ? c : mine; }
        if (sum == G) break;
        __builtin_amdgcn_s_sleep(1);
        if ((++sp & 255u) == 0u) { if (xb_ld(&bar[XB_TMO])) break; if (sp > XB_SPIN_CAP) { atomicAdd(&bar[XB_TMO], 1u); break; } }
    }
    nloc = mine > 0u ? mine : 1u; nx = cnt > 0u ? cnt : 1u;
}
__device__ __forceinline__ void xcd_barrier(const XcdBarrier& b) {
    asm volatile("s_waitcnt vmcnt(0)" ::: "memory");
    __syncthreads();
    if (threadIdx.x == 0) {
        unsigned* bar = b.bar;
        __builtin_amdgcn_s_waitcnt(0);
        unsigned nloc = b.st[0], nx = b.st[1];
        if (nloc == 0u) { xcd_barrier_complete(bar, b.x, nloc, nx); b.st[0] = nloc; b.st[1] = nx; }
        const unsigned old = xb_add(&bar[XB_XSUB(b.x)], 1u);
        const unsigned gen = old / nloc;
        if (old + 1u == (gen + 1u) * nloc) {
            __builtin_amdgcn_fence(__ATOMIC_RELEASE, "agent");
            asm volatile("s_waitcnt vmcnt(0)" ::: "memory");
            const unsigned og = xb_add(&bar[XB_TOP], 1u);
            const unsigned tg = og / nx;
            if (og + 1u == (tg + 1u) * nx) xb_add(&bar[XB_TOPGEN], 1u);
            else XB_SPIN(xb_ld(&bar[XB_TOPGEN]) == tg, bar);
            __builtin_amdgcn_fence(__ATOMIC_ACQUIRE, "agent");
            xb_add(&bar[XB_XGEN(b.x)], 1u);
            asm volatile("s_waitcnt vmcnt(0)" ::: "memory");
        } else {
            XB_SPIN(xb_ld(&bar[XB_XGEN(b.x)]) == gen, bar);
            __builtin_amdgcn_fence(__ATOMIC_ACQUIRE, "agent");
            asm volatile("s_waitcnt vmcnt(0)" ::: "memory");
        }
    }
    __syncthreads();
}

namespace pg8 {
constexpr int BM = 256, BK = 64, HALF = 128, HTB = HALF * BK * 2, STAGE_BYTES = 8 * HTB, NXCD = 8, WGM = 8;
__host__ __device__ __forceinline__ int lds_byte(int r, int c) { const int st = (r >> 4) * 2 + (c >> 5), rr = r & 15, cc = c & 31, ob = rr * 64 + cc * 2; return st * 1024 + (ob ^ (((ob >> 9) & 1) << 5)); }
__host__ __device__ __forceinline__ void stage_rc(int b, int& R, int& C) { const int st = b / 1024, sb = b % 1024, swz = sb ^ (((sb >> 9) & 1) << 5); R = (st >> 1) * 16 + swz / 64; C = (st & 1) * 32 + (swz % 64) / 2; }
__host__ __device__ __forceinline__ int perm32(int rho) { const int n = rho >> 4, i = rho & 15; return 8 * (i >> 2) + 4 * n + (i & 3); }

struct Unit { size_t aB, bB; int row0, col0; };
struct Gemm { const bf16_t* A; const bf16_t* Bt; int K; };

struct DenseOrder {
    int nM, nN, nwg, G, c; size_t tstep;
    __device__ void init(int M, int N, int K, int G_, int c_) { nM = M / BM; nN = N / BM; nwg = nM * nN; G = G_; c = c_; tstep = (size_t)BM * K * 2; }
    __device__ bool next(int i, Unit& u) const {
        const long L = (long)i * G + c; if (L >= nwg) return false;
        int wgid = (int)L; { const int q = nwg / NXCD, r = nwg % NXCD, xcd = wgid % NXCD, off = wgid / NXCD; wgid = (xcd < r ? xcd * (q + 1) : r * (q + 1) + (xcd - r) * q) + off; }
        const int nig = WGM * nN, gid = wgid / nig, fm = gid * WGM, gsz = (nM - fm) < WGM ? (nM - fm) : WGM;
        const int pm = fm + ((wgid % nig) % gsz), pn = (wgid % nig) / gsz;
        u.aB = (size_t)pm * tstep; u.bB = (size_t)pn * tstep; u.row0 = pm * BM; u.col0 = pn * BM; return true;
    }
};
struct MoeOrder {
    const LAS int* tab; int NTn, G, c; size_t tstep, bexp;
    __device__ bool next(int i, Unit& u) const {
        const int MT = tab[16], U = MT * NTn, nx = G >> 3;
        int f;
        if ((G & 7) == 0) { const int per = (U + 7) >> 3, x = c & 7, j = c >> 3, loc = i * nx + j; f = x * per + loc; if (loc >= per || f >= U) return false; }
        else { f = i * G + c; if (f >= U) return false; }
        int e = 0;
#pragma unroll
        for (int j = 1; j < 16; ++j) e += (f >= tab[j] * NTn) ? 1 : 0;
        const int t0 = tab[e], te = tab[e + 1] - t0, r = f - t0 * NTn;
        const int nt = r / te, mt = t0 + (r - nt * te);
        u.aB = (size_t)mt * tstep; u.bB = (size_t)e * bexp + (size_t)nt * tstep; u.row0 = mt * BM; u.col0 = nt * BM; return true;
    }
};

__device__ __forceinline__ unsigned cvt_pk_bf16(float lo, float hi) { unsigned r; asm volatile("v_cvt_pk_bf16_f32 %0, %1, %2" : "=v"(r) : "v"(lo), "v"(hi)); return r; }

struct EpiF32 {
    static constexpr bool PERM = false;
    float* C; int ldc;
    __device__ __forceinline__ void operator()(const f32x4 (&acc)[2][2][4][2], const Unit& u, int wr, int wc, int fr, int fq) const {
        const int row0 = u.row0 + wr * 64 + fr, col0 = u.col0 + wc * 32 + 4 * fq;
#pragma unroll
        for (int ai = 0; ai < 2; ++ai)
#pragma unroll
            for (int m = 0; m < 4; ++m) { float* rowp = C + (size_t)(row0 + ai * HALF + m * 16) * ldc + col0;
#pragma unroll
                for (int bj = 0; bj < 2; ++bj)
#pragma unroll
                    for (int n = 0; n < 2; ++n) *(f32x4*)(rowp + bj * HALF + n * 16) = acc[ai][bj][m][n]; }
    }
};
struct EpiBf16 {
    static constexpr bool PERM = true;
    bf16_t* O; int ldc;
    __device__ __forceinline__ void operator()(const f32x4 (&acc)[2][2][4][2], const Unit& u, int wr, int wc, int fr, int fq) const {
        const int row0 = u.row0 + wr * 64 + fr, col0 = u.col0 + wc * 32 + 8 * fq;
#pragma unroll
        for (int ai = 0; ai < 2; ++ai)
#pragma unroll
            for (int m = 0; m < 4; ++m) { bf16_t* rowp = O + (size_t)(row0 + ai * HALF + m * 16) * ldc + col0;
#pragma unroll
                for (int bj = 0; bj < 2; ++bj) { const f32x4 v0 = acc[ai][bj][m][0], v1 = acc[ai][bj][m][1];
                    u32x4 o; o[0] = cvt_pk_bf16(v0[0], v0[1]); o[1] = cvt_pk_bf16(v0[2], v0[3]); o[2] = cvt_pk_bf16(v1[0], v1[1]); o[3] = cvt_pk_bf16(v1[2], v1[3]);
                    *(u32x4*)(rowp + bj * HALF) = o; } }
    }
};
struct EpiHidden {
    static constexpr bool PERM = true;
    bf16_t* O;
    __device__ __forceinline__ void operator()(const f32x4 (&acc)[2][2][4][2], const Unit& u, int wr, int wc, int fr, int fq) const {
        const int row0 = u.row0 + wr * 64 + fr, col0 = (u.col0 >> 1) + wc * 32 + 8 * fq;
#pragma unroll
        for (int ai = 0; ai < 2; ++ai)
#pragma unroll
            for (int m = 0; m < 4; ++m) { bf16_t* rowp = O + (size_t)(row0 + ai * HALF + m * 16) * DE + col0;
                float h[8];
#pragma unroll
                for (int n = 0; n < 2; ++n)
#pragma unroll
                    for (int j = 0; j < 4; ++j) { const float g = acc[ai][0][m][n][j], up = acc[ai][1][m][n][j]; h[n * 4 + j] = g * __builtin_amdgcn_rcpf(1.0f + __expf(-g)) * up; }
                u32x4 o; o[0] = cvt_pk_bf16(h[0], h[1]); o[1] = cvt_pk_bf16(h[2], h[3]); o[2] = cvt_pk_bf16(h[4], h[5]); o[3] = cvt_pk_bf16(h[6], h[7]);
                *(u32x4*)rowp = o; }
    }
};

template <class Epi, class Sched>
__device__ __forceinline__ void gemm_phase(LAS unsigned char* lds, const Gemm g, const Sched& S, const Epi& E) {
    int tid = threadIdx.x; asm volatile("" : "+v"(tid)); const int wid = __builtin_amdgcn_readfirstlane(tid >> 6), lane = tid & 63, wr = wid >> 2, wc = wid & 3, fr = lane & 15, fq = lane >> 4;
    const int K = g.K, nt = K / BK;
    unsigned voffA[2], voffB[2];
#pragma unroll
    for (int i = 0; i < 2; ++i) { int R, C; stage_rc(tid * 16 + i * 8192, R, C); const int Rb = Epi::PERM ? ((R & ~31) + perm32(R & 31)) : R;
        voffA[i] = (unsigned)(R * K + C) * 2u; voffB[i] = (unsigned)(Rb * K + C) * 2u; }
    const size_t kstep = (size_t)(BK * 2);
    const size_t hstep = (size_t)HALF * K * 2;
    const unsigned ldsw = (unsigned)wid * 1024u;
    const int aoff = lds_byte(wr * 64 + fr, fq * 8), boff = lds_byte(wc * 32 + fr, fq * 8);
#define PG8_SA(b, h) (((b) * 2 + (h)) * HTB)
#define PG8_SB(b, h) ((4 + (b) * 2 + (h)) * HTB)
#define PG8_STAGE(bufoff, gbase, voff) do { _Pragma("unroll") for (int _i = 0; _i < 2; ++_i) \
        __builtin_amdgcn_global_load_lds((const unsigned*)((const char*)(gbase) + (voff)[_i]), (LAS unsigned*)(lds + (bufoff) + ldsw + _i * 8192), 16, 0, 0); } while (0)
#define PG8_LDA(dst, b, h) do { _Pragma("unroll") for (int m = 0; m < 4; ++m) _Pragma("unroll") for (int k = 0; k < 2; ++k) dst[m][k] = *(const LAS bf16x8*)(lds + PG8_SA(b, h) + aoff + m * 2048 + k * 1024); } while (0)
#define PG8_LDB(dst, b, h) do { _Pragma("unroll") for (int n = 0; n < 2; ++n) _Pragma("unroll") for (int k = 0; k < 2; ++k) dst[n][k] = *(const LAS bf16x8*)(lds + PG8_SB(b, h) + boff + n * 2048 + k * 1024); } while (0)
#define PG8_MMA(ai, bj, At, Bt) do { __builtin_amdgcn_s_setprio(1); _Pragma("unroll") for (int m = 0; m < 4; ++m) _Pragma("unroll") for (int n = 0; n < 2; ++n) _Pragma("unroll") for (int k = 0; k < 2; ++k) \
        acc[ai][bj][m][n] = __builtin_amdgcn_mfma_f32_16x16x32_bf16(Bt[n][k], At[m][k], acc[ai][bj][m][n], 0, 0, 0); __builtin_amdgcn_s_setprio(0); } while (0)
#define PG8_WAIT_V(n) asm volatile("s_waitcnt vmcnt(" #n ")" ::: "memory")
#define PG8_WAIT_L(n) asm volatile("s_waitcnt lgkmcnt(" #n ")" ::: "memory")
#define PG8_BAR __builtin_amdgcn_s_barrier()
#define PG8_SCHED __builtin_amdgcn_sched_barrier(0)
    Unit cur, nxt; int ui = 0;
    if (!S.next(0, cur)) return;
    f32x4 acc[2][2][4][2];
#pragma unroll
    for (int a = 0; a < 2; ++a)
#pragma unroll
        for (int b = 0; b < 2; ++b)
#pragma unroll
            for (int m = 0; m < 4; ++m)
#pragma unroll
                for (int n = 0; n < 2; ++n) acc[a][b][m][n] = (f32x4){0.f, 0.f, 0.f, 0.f};
    bf16x8 At[4][2], B0[2][2], B1[2][2];
    const char* cA = (const char*)g.A + cur.aB; const char* cB = (const char*)g.Bt + cur.bB;
    PG8_STAGE(PG8_SB(0, 0), cB, voffB); PG8_STAGE(PG8_SA(0, 0), cA, voffA); PG8_STAGE(PG8_SB(0, 1), cB + hstep, voffB); PG8_STAGE(PG8_SA(0, 1), cA + hstep, voffA);
    if (wr == 1) PG8_BAR;
    PG8_WAIT_V(4); PG8_BAR;
    PG8_STAGE(PG8_SB(1, 0), cB + kstep, voffB); PG8_STAGE(PG8_SA(1, 0), cA + kstep, voffA); PG8_STAGE(PG8_SB(1, 1), cB + hstep + kstep, voffB);
    PG8_WAIT_V(6); PG8_BAR;
    for (;;) {
        const bool has_next = S.next(ui + 1, nxt);
        const char* nA = has_next ? (const char*)g.A + nxt.aB : cA; const char* nB = has_next ? (const char*)g.Bt + nxt.bB : cB;
        for (int t = 0; t < nt; t += 2) {
            const bool last = (t == nt - 2);
            const char* a1 = cA + (size_t)(t + 1) * kstep;
            const char* a2 = last ? nA : cA + (size_t)(t + 2) * kstep; const char* b2 = last ? nB : cB + (size_t)(t + 2) * kstep;
            const char* a3 = a2 + kstep; const char* b3 = b2 + kstep;
            PG8_LDB(B0, 0, 0); PG8_SCHED; PG8_LDA(At, 0, 0); PG8_STAGE(PG8_SA(1, 1), a1 + hstep, voffA);
            PG8_WAIT_L(8); PG8_BAR; PG8_WAIT_L(0); PG8_MMA(0, 0, At, B0); PG8_BAR; PG8_SCHED;
            PG8_LDB(B1, 0, 1); PG8_STAGE(PG8_SB(0, 0), b2, voffB);
            PG8_BAR; PG8_WAIT_L(0); PG8_MMA(0, 1, At, B1); PG8_BAR;
            PG8_LDA(At, 0, 1); PG8_STAGE(PG8_SA(0, 0), a2, voffA);
            PG8_BAR; PG8_WAIT_L(0); PG8_MMA(1, 0, At, B0); PG8_BAR; PG8_SCHED;
            PG8_STAGE(PG8_SB(0, 1), b2 + hstep, voffB);
            PG8_WAIT_V(6); PG8_BAR; PG8_MMA(1, 1, At, B1); PG8_BAR;
            PG8_LDB(B0, 1, 0); PG8_SCHED; PG8_LDA(At, 1, 0); PG8_STAGE(PG8_SA(0, 1), a2 + hstep, voffA);
            PG8_WAIT_L(8); PG8_BAR; PG8_WAIT_L(0); PG8_MMA(0, 0, At, B0); PG8_BAR; PG8_SCHED;
            PG8_LDB(B1, 1, 1); PG8_STAGE(PG8_SB(1, 0), b3, voffB);
            PG8_BAR; PG8_WAIT_L(0); PG8_MMA(0, 1, At, B1); PG8_BAR;
            PG8_LDA(At, 1, 1); PG8_STAGE(PG8_SA(1, 0), a3, voffA);
            PG8_BAR; PG8_WAIT_L(0); PG8_MMA(1, 0, At, B0); PG8_BAR; PG8_SCHED;
            PG8_STAGE(PG8_SB(1, 1), b3 + hstep, voffB);
            PG8_WAIT_V(6); PG8_BAR; PG8_MMA(1, 1, At, B1); PG8_BAR;
        }
        E(acc, cur, wr, wc, fr, fq);
        if (!has_next) break;
#pragma unroll
        for (int a = 0; a < 2; ++a)
#pragma unroll
            for (int b = 0; b < 2; ++b)
#pragma unroll
                for (int m = 0; m < 4; ++m)
#pragma unroll
                    for (int n = 0; n < 2; ++n) acc[a][b][m][n] = (f32x4){0.f, 0.f, 0.f, 0.f};
        cur = nxt; cA = nA; cB = nB; ++ui;
    }
    PG8_WAIT_V(0);
    if (wr == 0) PG8_BAR;
    PG8_BAR;
#undef PG8_SA
#undef PG8_SB
#undef PG8_STAGE
#undef PG8_LDA
#undef PG8_LDB
#undef PG8_MMA
#undef PG8_WAIT_V
#undef PG8_WAIT_L
#undef PG8_BAR
#undef PG8_SCHED
}
}

__device__ __forceinline__ void cvt_strip(const float* __restrict__ src, int lds_, bf16_t* __restrict__ dst, int ldd, int k0, int n0, int drow0, LAS unsigned* tl, int tid) {
    const int kp = tid >> 4, n4 = (tid & 15) * 4;
    float4 a[2][2], b[2][2];
#pragma unroll
    for (int ki = 0; ki < 2; ++ki)
#pragma unroll
        for (int ni = 0; ni < 2; ++ni) {
            a[ki][ni] = *(const float4*)(src + (size_t)(k0 + ki * 64 + 2 * kp) * lds_ + n0 + ni * 64 + n4);
            b[ki][ni] = *(const float4*)(src + (size_t)(k0 + ki * 64 + 2 * kp + 1) * lds_ + n0 + ni * 64 + n4);
        }
#pragma unroll
    for (int ki = 0; ki < 2; ++ki)
#pragma unroll
        for (int ni = 0; ni < 2; ++ni) {
            LAS unsigned* t = tl + (ki * 2 + ni) * 2112;
            t[(n4 + 0) * 33 + kp] = pack2(a[ki][ni].x, b[ki][ni].x);
            t[(n4 + 1) * 33 + kp] = pack2(a[ki][ni].y, b[ki][ni].y);
            t[(n4 + 2) * 33 + kp] = pack2(a[ki][ni].z, b[ki][ni].z);
            t[(n4 + 3) * 33 + kp] = pack2(a[ki][ni].w, b[ki][ni].w);
        }
    __syncthreads();
    const int n = tid >> 3, kc = (tid & 7) * 4;
#pragma unroll
    for (int ki = 0; ki < 2; ++ki)
#pragma unroll
        for (int ni = 0; ni < 2; ++ni) {
            const LAS unsigned* t = tl + (ki * 2 + ni) * 2112;
            u32x4 o; o[0] = t[n * 33 + kc]; o[1] = t[n * 33 + kc + 1]; o[2] = t[n * 33 + kc + 2]; o[3] = t[n * 33 + kc + 3];
            *(u32x4*)(dst + (size_t)(drow0 + ni * 64 + n) * ldd + k0 + ki * 64 + kc * 2) = o;
        }
}

__device__ __forceinline__ void phase_prologue(const Params& p, LAS unsigned char* lds) {
    int tid = threadIdx.x; asm volatile("" : "+v"(tid));
    unsigned char* ws = p.ws;
    {
        LAS float* cond = (LAS float*)lds;
        LAS float* red = (LAS float*)(lds + 32768);
        for (int i = tid; i < 4 * D; i += 512) { const float v = p.c[i]; cond[i] = siluf_(v); }
        __syncthreads();
        for (int ch = blockIdx.x; ch < 256; ch += gridDim.x) {
            const int l = ch >> 7, j0 = (ch & 127) * 96;
            const float* w = p.w_ada + (size_t)l * D * (6 * D);
            const int kg = tid / 24, cl = tid % 24;
            float acc[4][4];
#pragma unroll
            for (int b = 0; b < 4; ++b)
#pragma unroll
                for (int j = 0; j < 4; ++j) acc[b][j] = 0.f;
            if (kg < 21) {
                for (int it0 = 0; it0 < 98; it0 += 7) {
                    float4 wv[7];
#pragma unroll
                    for (int q = 0; q < 7; ++q) { const int k = kg + 21 * (it0 + q); wv[q] = (k < D) ? *(const float4*)(w + (size_t)k * (6 * D) + j0 + cl * 4) : make_float4(0.f, 0.f, 0.f, 0.f); }
#pragma unroll
                    for (int q = 0; q < 7; ++q) { const int k = kg + 21 * (it0 + q); const int kc = k < D ? k : 0;
#pragma unroll
                        for (int b = 0; b < 4; ++b) { const float cv = cond[b * D + kc]; acc[b][0] += cv * wv[q].x; acc[b][1] += cv * wv[q].y; acc[b][2] += cv * wv[q].z; acc[b][3] += cv * wv[q].w; } }
                }
#pragma unroll
                for (int b = 0; b < 4; ++b)
#pragma unroll
                    for (int j = 0; j < 4; ++j) red[(kg * 4 + b) * 96 + cl * 4 + j] = acc[b][j];
            }
            __syncthreads();
            if (tid < 384) {
                const int b = tid / 96, col = tid % 96; float s = 0.f;
                for (int g = 0; g < 21; ++g) s += red[(g * 4 + b) * 96 + col];
                float* mod = (float*)(ws + WS_MOD);
                mod[((size_t)l * 4 + b) * (6 * D) + j0 + col] = s + p.b_ada[(size_t)l * 6 * D + j0 + col];
            }
            __syncthreads();
        }
    }
    constexpr int S_IN = 16 * 66, S_OUT = 16 * 16, S_GU = 16 * 11, S_DN = 11 * 16;
    constexpr int N0 = DEPTH * S_IN, N1 = N0 + DEPTH * S_OUT, N2 = N1 + DEPTH * NE * 2 * S_GU, N3 = N2 + DEPTH * NE * S_DN;
    int par = 0;
    for (int ti = blockIdx.x; ti < N3; ti += gridDim.x, par ^= 1) {
        LAS unsigned* tl = (LAS unsigned*)lds + par * (4 * 2112);
        if (ti < N0) {
            const int l = ti / S_IN, r = ti % S_IN, kt = r / 66, ntl = r % 66;
            cvt_strip(p.w_in + (size_t)l * D * INC, INC, (bf16_t*)(ws + WS_WIN) + (size_t)l * INC * D, D, kt * 128, ntl * 128, ntl * 128, tl, tid);
        } else if (ti < N1) {
            const int q = ti - N0, l = q / S_OUT, r = q % S_OUT, kt = r / 16, ntl = r % 16;
            cvt_strip(p.w_out + (size_t)l * D * D, D, (bf16_t*)(ws + WS_WOUT) + (size_t)l * D * D, D, kt * 128, ntl * 128, ntl * 128, tl, tid);
        } else if (ti < N2) {
            const int q = ti - N1, mat = q / S_GU, r = q % S_GU, kt = r / 11, ntl = r % 11;
            const int which = mat & 1, le = mat >> 1;
            const float* src = (which ? p.w_up : p.w_gate) + (size_t)le * D * DE;
            cvt_strip(src, DE, (bf16_t*)(ws + WS_WGU) + (size_t)le * (2 * DE) * D, D, kt * 128, ntl * 128, ntl * 256 + which * 128, tl, tid);
        } else {
            const int q = ti - N2, le = q / S_DN, r = q % S_DN, kt = r / 16, ntl = r % 16;
            cvt_strip(p.w_down + (size_t)le * DE * D, D, (bf16_t*)(ws + WS_WD) + (size_t)le * D * DE, DE, kt * 128, ntl * 128, ntl * 128, tl, tid);
        }
    }
    __syncthreads();
}

__device__ __forceinline__ void ln_rows(float4 (&v)[8], const float* __restrict__ g, const float* __restrict__ b, int lane) {
    float s = 0.f;
#pragma unroll
    for (int i = 0; i < 8; ++i) s += (v[i].x + v[i].y) + (v[i].z + v[i].w);
    const float mean = wave_sum(s) * (1.0f / D);
    float q = 0.f;
#pragma unroll
    for (int i = 0; i < 8; ++i) { const float a = v[i].x - mean, bb = v[i].y - mean, c = v[i].z - mean, d = v[i].w - mean; q += (a * a + bb * bb) + (c * c + d * d); }
    const float rstd = rsqrtf(wave_sum(q) * (1.0f / D) + 1e-5f);
#pragma unroll
    for (int i = 0; i < 8; ++i) {
        const float4 gv = *(const float4*)(g + i * 256 + lane * 4), bv = *(const float4*)(b + i * 256 + lane * 4);
        v[i].x = (v[i].x - mean) * rstd * gv.x + bv.x; v[i].y = (v[i].y - mean) * rstd * gv.y + bv.y;
        v[i].z = (v[i].z - mean) * rstd * gv.z + bv.z; v[i].w = (v[i].w - mean) * rstd * gv.w + bv.w;
    }
}
__device__ __forceinline__ void modulate_store(const float4 (&v)[8], const float* __restrict__ shift, const float* __restrict__ scale, bf16_t* __restrict__ dst, int lane) {
#pragma unroll
    for (int i = 0; i < 8; ++i) {
        const float4 sh = *(const float4*)(shift + i * 256 + lane * 4), sc = *(const float4*)(scale + i * 256 + lane * 4);
        u32x2 o; o[0] = pack2(v[i].x * (1.f + sc.x) + sh.x, v[i].y * (1.f + sc.y) + sh.y); o[1] = pack2(v[i].z * (1.f + sc.z) + sh.z, v[i].w * (1.f + sc.w) + sh.w);
        *(u32x2*)(dst + i * 256 + lane * 4) = o;
    }
}

__device__ __forceinline__ void phase_ln0(const Params& p) {
    int tid_ = threadIdx.x; asm volatile("" : "+v"(tid_)); const int wave = tid_ >> 6, lane = tid_ & 63;
    const float* mod = (const float*)(p.ws + WS_MOD);
    for (int n = blockIdx.x * 8 + wave; n < T; n += gridDim.x * 8) {
        const int b = n / SEQ;
        float4 v[8];
#pragma unroll
        for (int i = 0; i < 8; ++i) v[i] = *(const float4*)(p.x + (size_t)n * D + i * 256 + lane * 4);
        ln_rows(v, p.emb_g, p.emb_b, lane);
        float* xr = (float*)(p.ws + WS_XRES) + (size_t)n * D;
#pragma unroll
        for (int i = 0; i < 8; ++i) *(float4*)(xr + i * 256 + lane * 4) = v[i];
        const float* mb = mod + ((size_t)0 * 4 + b) * (6 * D);
        modulate_store(v, mb, mb + D, (bf16_t*)(p.ws + WS_HA) + (size_t)n * D, lane);
    }
}

__device__ __forceinline__ void phase_mixer_valu(const Params& p, int l, LAS unsigned char* lds) {
    LAS float* qs = (LAS float*)lds; LAS float* ks = qs + 4096; LAS float* fs = ks + 4096; LAS float* vs = fs + 4096; LAS float* po = vs + 1024;
    int tid = threadIdx.x; asm volatile("" : "+v"(tid)); const int wave = tid >> 6, lane = tid & 63, kk = tid >> 5, vv = tid & 31;
    const bf16_t* proj = (const bf16_t*)(p.ws + WS_PROJ);
    float* obuf = (float*)(p.ws + WS_OBUF);
    for (int u = blockIdx.x; u < 384; u += gridDim.x) {
        const int vsl = u & 3, dir = (u >> 2) & 1, hh = (u >> 3) % 6, b = ((u >> 3) / 6) % 4, type = (u >> 3) / 24;
        float S[8];
#pragma unroll
        for (int j = 0; j < 8; ++j) S[j] = 0.f;
        const float gamma = 1.0f - exp2f(-(dir ? 5.5f : 5.0f) - (float)hh);
        for (int blk = 0; blk < 64; ++blk) {
            const int rb = dir ? 63 - blk : blk, t0 = rb * 32;
            if (type == 0) {
#pragma unroll
                for (int j = 0; j < 4; ++j) {
                    const int idx = tid + 512 * j, tt = idx >> 6, dp = idx & 63;
                    const bf16_t* row = proj + (size_t)(b * SEQ + t0 + tt) * INC;
                    const float q1 = bf2f(row[C_RQ + hh * 128 + dp]), q2 = bf2f(row[C_RQ + hh * 128 + 64 + dp]);
                    const float k1 = bf2f(row[C_RK + hh * 128 + dp]), k2 = bf2f(row[C_RK + hh * 128 + 64 + dp]);
                    const float inv_freq = exp2f(-(float)dp * (13.287712379549449f / 64.0f));
                    const float ang = (float)(t0 + tt) * inv_freq;
                    float rev = ang * 0.15915494309189535f; rev -= rintf(rev);
                    const float sn = __builtin_amdgcn_sinf(rev), cs = __builtin_amdgcn_cosf(rev);
                    qs[tt * 128 + dp] = q1 * cs - q2 * sn; qs[tt * 128 + 64 + dp] = q1 * sn + q2 * cs;
                    ks[tt * 128 + dp] = (k1 * cs - k2 * sn) * 0.08838834764831845f; ks[tt * 128 + 64 + dp] = (k1 * sn + k2 * cs) * 0.08838834764831845f;
                    fs[tt * 128 + dp] = gamma; fs[tt * 128 + 64 + dp] = gamma;
                }
            } else {
#pragma unroll
                for (int j = 0; j < 8; ++j) {
                    const int idx = tid + 512 * j, tt = idx >> 7, d = idx & 127;
                    const bf16_t* row = proj + (size_t)(b * SEQ + t0 + tt) * INC;
                    const float q = bf2f(row[C_HQ + hh * 128 + d]);
                    const float z = bf2f(row[(dir ? C_HFB : C_HFF) + hh * 128 + d]);
                    float lb = 0.f;
                    if (l > 0) { const float a0 = p.lb_logits[(0 * 2 + dir) * HWD + hh * 128 + d], a1 = p.lb_logits[(1 * 2 + dir) * HWD + hh * 128 + d]; lb = 1.0f / (1.0f + expf(a0 - a1)); }
                    float f = lb + (1.0f - lb) * (1.0f / (1.0f + expf(-z)));
                    f = fmaxf(f, 1e-6f);
                    qs[tt * 128 + d] = q; ks[tt * 128 + d] = 1.0f - f; fs[tt * 128 + d] = f;
                }
            }
#pragma unroll
            for (int j = 0; j < 2; ++j) {
                const int idx = tid + 512 * j, tt = idx >> 5, c = idx & 31;
                const bf16_t* row = proj + (size_t)(b * SEQ + t0 + tt) * INC;
                vs[tt * 32 + c] = bf2f(row[(type ? C_HI : C_RV) + hh * 128 + vsl * 32 + c]);
            }
            __syncthreads();
            for (int s = 0; s < 32; ++s) {
                const int ss = dir ? 31 - s : s;
                const f32x4 qa = *(const LAS f32x4*)(qs + ss * 128 + kk * 8), qb = *(const LAS f32x4*)(qs + ss * 128 + kk * 8 + 4);
                const f32x4 ka = *(const LAS f32x4*)(ks + ss * 128 + kk * 8), kb = *(const LAS f32x4*)(ks + ss * 128 + kk * 8 + 4);
                const f32x4 fa = *(const LAS f32x4*)(fs + ss * 128 + kk * 8), fb = *(const LAS f32x4*)(fs + ss * 128 + kk * 8 + 4);
                const float vval = vs[ss * 32 + vv];
                float acc = 0.f;
#pragma unroll
                for (int j = 0; j < 4; ++j) { S[j] = fa[j] * S[j] + ka[j] * vval; acc += S[j] * qa[j]; }
#pragma unroll
                for (int j = 0; j < 4; ++j) { S[4 + j] = fb[j] * S[4 + j] + kb[j] * vval; acc += S[4 + j] * qb[j]; }
                acc += __shfl_xor(acc, 32, 64);
                if (lane < 32) po[(ss * 8 + wave) * 32 + vv] = acc;
            }
            __syncthreads();
#pragma unroll
            for (int j = 0; j < 2; ++j) {
                const int idx = tid + 512 * j, tt = idx >> 5, c = idx & 31;
                float s = 0.f;
#pragma unroll
                for (int w = 0; w < 8; ++w) s += po[(tt * 8 + w) * 32 + c];
                obuf[((size_t)dir * T + (size_t)(b * SEQ + t0 + tt)) * 1536 + type * 768 + hh * 128 + vsl * 32 + c] = s;
            }
        }
        __syncthreads();
    }
}

constexpr int MX_QI = 0, MX_KI = 17408, MX_QS = 34816, MX_KTT = 52224, MX_VT = 70656, MX_P = 79872, MX_ST = 89088, MX_TOT = 106496, MX_DEC = 110592;
__device__ __forceinline__ float ex2(float x) { return __builtin_amdgcn_exp2f(x); }
__device__ __forceinline__ float clampe(float x) { return fminf(fmaxf(x, -120.f), 120.f); }
__device__ __forceinline__ void phase_mixer_mfma(const Params& p, int l, LAS unsigned char* lds, float* __restrict__ obuf) {
    int tid = threadIdx.x; asm volatile("" : "+v"(tid));
    const int wave = __builtin_amdgcn_readfirstlane(tid >> 6), lane = tid & 63, fr = lane & 15, fq = lane >> 4;
    const bf16_t* proj = (const bf16_t*)(p.ws + WS_PROJ);
    for (int u = blockIdx.x; u < 192; u += gridDim.x) {
        const int vsl = u & 1, dir = (u >> 1) & 1, hh = (u >> 2) % 6, b = ((u >> 2) / 6) % 4, type = (u >> 2) / 24;
        float lg2 = 0.f, invf0 = 0.f, invf1 = 0.f, sgn = 1.f, lb0 = 0.f, lb1 = 0.f;
        if (type == 0) {
            const float gamma = 1.0f - exp2f(-(dir ? 5.5f : 5.0f) - (float)hh);
            lg2 = log2f(gamma);
            const int dm0 = (2 * lane) & 63;
            invf0 = exp2f(-(float)dm0 * (13.287712379549449f / 64.0f)); invf1 = exp2f(-(float)(dm0 + 1) * (13.287712379549449f / 64.0f));
            sgn = lane < 32 ? -1.f : 1.f;
        } else if (l > 0) {
            const float* lbl = p.lb_logits + dir * HWD + hh * 128 + 2 * lane;
            lb0 = 1.0f / (1.0f + expf(lbl[0] - lbl[2 * HWD])); lb1 = 1.0f / (1.0f + expf(lbl[1] - lbl[2 * HWD + 1]));
        }
        const int colA = (type ? C_HQ : C_RQ) + hh * 128, colB = (type ? (dir ? C_HFB : C_HFF) : C_RK) + hh * 128;
        const int colV = (type ? C_HI : C_RV) + hh * 128 + vsl * 64 + lane;
        const int own = 2 * lane, par = (2 * lane + 64) & 127;
        const size_t ocol = (size_t)type * 768 + hh * 128 + vsl * 64;
        unsigned ra[8], rb[8], rc[8], rd[8]; unsigned short rv[8];
#define MX_LOAD(ch) do { _Pragma("unroll") for (int j = 0; j < 8; ++j) { const int tau = (ch) * 64 + wave * 8 + j; const int t = dir ? (SEQ - 1 - tau) : tau; \
            const bf16_t* row = proj + (size_t)(b * SEQ + t) * INC; \
            ra[j] = *(const unsigned*)(row + colA + own); rb[j] = *(const unsigned*)(row + colB + own); \
            if (type == 0) { rc[j] = *(const unsigned*)(row + colA + par); rd[j] = *(const unsigned*)(row + colB + par); } else { rc[j] = 0u; rd[j] = 0u; } \
            rv[j] = row[colV]; } } while (0)
        f32x4 Sacc[4];
#pragma unroll
        for (int vt = 0; vt < 4; ++vt) Sacc[vt] = (f32x4){0.f, 0.f, 0.f, 0.f};
        for (int i = tid; i < 64 * 272 / 4; i += 512) ((LAS unsigned*)(lds + MX_ST))[i] = 0u;
        MX_LOAD(0);
        __syncthreads();
        for (int ch = 0; ch < 32; ++ch) {
            float q0[8], q1[8], k0[8], k1[8], c0[8], c1[8];
            float run0 = 0.f, run1 = 0.f;
#pragma unroll
            for (int j = 0; j < 8; ++j) {
                const float a_lo = bf2f(ra[j] & 0xffffu), a_hi = bf2f(ra[j] >> 16), b_lo = bf2f(rb[j] & 0xffffu), b_hi = bf2f(rb[j] >> 16);
                float g0, g1;
                if (type == 0) {
                    const int tau = ch * 64 + wave * 8 + j; const int t = dir ? (SEQ - 1 - tau) : tau;
                    float rev0 = (float)t * invf0 * 0.15915494309189535f, rev1 = (float)t * invf1 * 0.15915494309189535f;
                    rev0 -= rintf(rev0); rev1 -= rintf(rev1);
                    const float sn0 = __builtin_amdgcn_sinf(rev0), cs0 = __builtin_amdgcn_cosf(rev0), sn1 = __builtin_amdgcn_sinf(rev1), cs1 = __builtin_amdgcn_cosf(rev1);
                    const float pa_lo = bf2f(rc[j] & 0xffffu), pa_hi = bf2f(rc[j] >> 16), pb_lo = bf2f(rd[j] & 0xffffu), pb_hi = bf2f(rd[j] >> 16);
                    q0[j] = a_lo * cs0 + sgn * pa_lo * sn0; q1[j] = a_hi * cs1 + sgn * pa_hi * sn1;
                    k0[j] = (b_lo * cs0 + sgn * pb_lo * sn0) * 0.08838834764831845f; k1[j] = (b_hi * cs1 + sgn * pb_hi * sn1) * 0.08838834764831845f;
                    g0 = lg2; g1 = lg2;
                } else {
                    q0[j] = a_lo; q1[j] = a_hi;
                    float f0 = lb0 + (1.0f - lb0) * __builtin_amdgcn_rcpf(1.0f + ex2(-b_lo * 1.4426950408889634f));
                    float f1 = lb1 + (1.0f - lb1) * __builtin_amdgcn_rcpf(1.0f + ex2(-b_hi * 1.4426950408889634f));
                    f0 = fmaxf(f0, 1e-6f); f1 = fmaxf(f1, 1e-6f);
                    k0[j] = 1.0f - f0; k1[j] = 1.0f - f1;
                    g0 = __builtin_amdgcn_logf(f0); g1 = __builtin_amdgcn_logf(f1);
                }
                run0 += g0; run1 += g1; c0[j] = run0; c1[j] = run1;
            }
            u32x4 vpk;
            vpk[0] = (unsigned)rv[0] | ((unsigned)rv[1] << 16); vpk[1] = (unsigned)rv[2] | ((unsigned)rv[3] << 16);
            vpk[2] = (unsigned)rv[4] | ((unsigned)rv[5] << 16); vpk[3] = (unsigned)rv[6] | ((unsigned)rv[7] << 16);
            { typedef float f32x2_ __attribute__((ext_vector_type(2))); *(LAS f32x2_*)(lds + MX_TOT + (wave * 128 + 2 * lane) * 4) = (f32x2_){run0, run1}; }
            __syncthreads();
            float off0 = 0.f, off1 = 0.f, m0 = 0.f, m1 = 0.f, tt0 = 0.f, tt1 = 0.f;
#pragma unroll
            for (int g = 0; g < 8; ++g) {
                typedef float f32x2_ __attribute__((ext_vector_type(2)));
                const f32x2_ tv = *(const LAS f32x2_*)(lds + MX_TOT + (g * 128 + 2 * lane) * 4);
                if (g < wave) { off0 += tv[0]; off1 += tv[1]; }
                if (g < 4) { m0 += tv[0]; m1 += tv[1]; }
                tt0 += tv[0]; tt1 += tv[1];
            }
            float kt0[8], kt1[8];
#pragma unroll
            for (int j = 0; j < 8; ++j) {
                const float cu0 = c0[j] + off0, cu1 = c1[j] + off1;
                const float e10 = ex2(clampe(cu0 - m0)), e11 = ex2(clampe(cu1 - m1));
                const float e20 = ex2(clampe(m0 - cu0)), e21 = ex2(clampe(m1 - cu1));
                const float e30 = ex2(cu0), e31 = ex2(cu1);
                const float e40 = ex2(tt0 - cu0), e41 = ex2(tt1 - cu1);
                const int pos = wave * 8 + j;
                *(LAS unsigned*)(lds + MX_QI + pos * 272 + lane * 4) = pack2(q0[j] * e10, q1[j] * e11);
                *(LAS unsigned*)(lds + MX_KI + pos * 272 + lane * 4) = pack2(k0[j] * e20, k1[j] * e21);
                *(LAS unsigned*)(lds + MX_QS + pos * 272 + lane * 4) = pack2(q0[j] * e30, q1[j] * e31);
                kt0[j] = k0[j] * e40; kt1[j] = k1[j] * e41;
            }
            { u32x4 w0, w1;
              w0[0] = pack2(kt0[0], kt0[1]); w0[1] = pack2(kt0[2], kt0[3]); w0[2] = pack2(kt0[4], kt0[5]); w0[3] = pack2(kt0[6], kt0[7]);
              w1[0] = pack2(kt1[0], kt1[1]); w1[1] = pack2(kt1[2], kt1[3]); w1[2] = pack2(kt1[4], kt1[5]); w1[3] = pack2(kt1[6], kt1[7]);
              *(LAS u32x4*)(lds + MX_KTT + (2 * lane) * 144 + wave * 16) = w0;
              *(LAS u32x4*)(lds + MX_KTT + (2 * lane + 1) * 144 + wave * 16) = w1;
              *(LAS u32x4*)(lds + MX_VT + lane * 144 + wave * 16) = vpk; }
            if (wave == 0) { typedef float f32x2_ __attribute__((ext_vector_type(2))); *(LAS f32x2_*)(lds + MX_DEC + lane * 8) = (f32x2_){ex2(tt0), ex2(tt1)}; }
            __syncthreads();
            if (ch + 1 < 32) MX_LOAD(ch + 1);
            {
                const int it = wave >> 1;
#pragma unroll
                for (int h2 = 0; h2 < 2; ++h2) {
                    const int st = 2 * (wave & 1) + h2;
                    f32x4 acc = (f32x4){0.f, 0.f, 0.f, 0.f};
                    if (st <= it) {
#pragma unroll
                        for (int kq = 0; kq < 4; ++kq) {
                            const bf16x8 af = *(const LAS bf16x8*)(lds + MX_KI + (16 * st + fr) * 272 + (32 * kq + 8 * fq) * 2);
                            const bf16x8 bfg = *(const LAS bf16x8*)(lds + MX_QI + (16 * it + fr) * 272 + (32 * kq + 8 * fq) * 2);
                            acc = __builtin_amdgcn_mfma_f32_16x16x32_bf16(af, bfg, acc, 0, 0, 0);
                        }
                    }
                    const int i = 16 * it + fr, s0 = 16 * st + 4 * fq;
                    const float v0 = (s0 + 0 <= i) ? acc[0] : 0.f, v1 = (s0 + 1 <= i) ? acc[1] : 0.f, v2 = (s0 + 2 <= i) ? acc[2] : 0.f, v3 = (s0 + 3 <= i) ? acc[3] : 0.f;
                    u32x2 o; o[0] = pack2(v0, v1); o[1] = pack2(v2, v3);
                    *(LAS u32x2*)(lds + MX_P + i * 144 + s0 * 2) = o;
                }
            }
            __syncthreads();
            {
                const int vt = wave >> 1;
#pragma unroll
                for (int h2 = 0; h2 < 2; ++h2) {
                    const int it = 2 * (wave & 1) + h2;
                    f32x4 acc = (f32x4){0.f, 0.f, 0.f, 0.f};
#pragma unroll
                    for (int kq = 0; kq < 2; ++kq) {
                        const bf16x8 af = *(const LAS bf16x8*)(lds + MX_VT + (16 * vt + fr) * 144 + (32 * kq + 8 * fq) * 2);
                        const bf16x8 bfg = *(const LAS bf16x8*)(lds + MX_P + (16 * it + fr) * 144 + (32 * kq + 8 * fq) * 2);
                        acc = __builtin_amdgcn_mfma_f32_16x16x32_bf16(af, bfg, acc, 0, 0, 0);
                    }
#pragma unroll
                    for (int kq = 0; kq < 4; ++kq) {
                        const bf16x8 af = *(const LAS bf16x8*)(lds + MX_ST + (16 * vt + fr) * 272 + (32 * kq + 8 * fq) * 2);
                        const bf16x8 bfg = *(const LAS bf16x8*)(lds + MX_QS + (16 * it + fr) * 272 + (32 * kq + 8 * fq) * 2);
                        acc = __builtin_amdgcn_mfma_f32_16x16x32_bf16(af, bfg, acc, 0, 0, 0);
                    }
                    const int tau = ch * 64 + 16 * it + fr; const int t = dir ? (SEQ - 1 - tau) : tau;
                    *(f32x4*)(obuf + ((size_t)dir * T + (size_t)(b * SEQ + t)) * 1536 + ocol + 16 * vt + 4 * fq) = acc;
                }
            }
            {
                const f32x4 dc = *(const LAS f32x4*)(lds + MX_DEC + (16 * wave + 4 * fq) * 4);
                bf16x8 af[2];
#pragma unroll
                for (int kq = 0; kq < 2; ++kq) af[kq] = *(const LAS bf16x8*)(lds + MX_KTT + (16 * wave + fr) * 144 + (32 * kq + 8 * fq) * 2);
#pragma unroll
                for (int vt = 0; vt < 4; ++vt) {
                    f32x4 a = Sacc[vt]; a[0] *= dc[0]; a[1] *= dc[1]; a[2] *= dc[2]; a[3] *= dc[3];
#pragma unroll
                    for (int kq = 0; kq < 2; ++kq) {
                        const bf16x8 bfg = *(const LAS bf16x8*)(lds + MX_VT + (16 * vt + fr) * 144 + (32 * kq + 8 * fq) * 2);
                        a = __builtin_amdgcn_mfma_f32_16x16x32_bf16(af[kq], bfg, a, 0, 0, 0);
                    }
                    Sacc[vt] = a;
                }
            }
            __syncthreads();
#pragma unroll
            for (int vt = 0; vt < 4; ++vt) { u32x2 o; o[0] = pack2(Sacc[vt][0], Sacc[vt][1]); o[1] = pack2(Sacc[vt][2], Sacc[vt][3]);
                *(LAS u32x2*)(lds + MX_ST + (16 * vt + fr) * 272 + (16 * wave + 4 * fq) * 2) = o; }
        }
        __syncthreads();
#undef MX_LOAD
    }
}

#ifdef MIXER_CHECK
__device__ __forceinline__ void phase_mixer_check(const Params& p, const float* __restrict__ oa, const float* __restrict__ ob, float* chk) {
    int tid_ = threadIdx.x; asm volatile("" : "+v"(tid_)); const int wave = tid_ >> 6, lane = tid_ & 63;
    for (int r = blockIdx.x * 8 + wave; r < 2 * T; r += gridDim.x * 8) {
        const int dir = r / T;
#pragma unroll
        for (int ty = 0; ty < 2; ++ty) {
            float sd = 0.f, sq = 0.f;
#pragma unroll
            for (int i = 0; i < 3; ++i) { const float4 a = *(const float4*)(oa + (size_t)r * 1536 + ty * 768 + i * 256 + lane * 4), bq = *(const float4*)(ob + (size_t)r * 1536 + ty * 768 + i * 256 + lane * 4);
                sd += (a.x - bq.x) * (a.x - bq.x) + (a.y - bq.y) * (a.y - bq.y) + (a.z - bq.z) * (a.z - bq.z) + (a.w - bq.w) * (a.w - bq.w);
                sq += a.x * a.x + a.y * a.y + a.z * a.z + a.w * a.w; }
            sd = wave_sum(sd); sq = wave_sum(sq);
            if (lane == 0) { atomicAdd(&chk[(ty * 2 + dir) * 2 + 0], sd); atomicAdd(&chk[(ty * 2 + dir) * 2 + 1], sq); }
        }
    }
}
#endif

__device__ __forceinline__ float4 ld_bf4(const bf16_t* p) { const u32x2 r = *(const u32x2*)p; return make_float4(bf2f(r[0] & 0xffffu), bf2f(r[0] >> 16), bf2f(r[1] & 0xffffu), bf2f(r[1] >> 16)); }
__device__ __forceinline__ void phase_finalize(const Params& p, int l) {
    int tid_ = threadIdx.x; asm volatile("" : "+v"(tid_)); const int wave = tid_ >> 6, lane = tid_ & 63;
    const bf16_t* proj = (const bf16_t*)(p.ws + WS_PROJ);
    const float* obuf = (const float*)(p.ws + WS_OBUF);
    bf16_t* mixed = (bf16_t*)(p.ws + WS_MIXED);
    const float* cw = p.conv_w + (size_t)l * 3 * CW;
    const float* beta = p.mix_beta + (size_t)l * D;
    for (int n = blockIdx.x * 8 + wave; n < T; n += gridDim.x * 8) {
        const int t = n % SEQ;
        const bf16_t* row = proj + (size_t)n * INC;
        bf16_t* dst = mixed + (size_t)n * D;
#pragma unroll
        for (int i = 0; i < 8; ++i) {
            const int c = i * 256 + lane * 4;
            float4 r;
            if (i < 2) {
                const float4 cc = ld_bf4(row + C_CC + c), ch = ld_bf4(row + C_CH + c), cb = ld_bf4(row + C_CB + c);
                float4 um = make_float4(0.f, 0.f, 0.f, 0.f), up = um;
                if (t > 0) { const float4 a = ld_bf4(row - INC + C_CC + c), b2 = ld_bf4(row - INC + C_CH + c); um = make_float4(a.x * b2.x, a.y * b2.y, a.z * b2.z, a.w * b2.w); }
                if (t < SEQ - 1) { const float4 a = ld_bf4(row + INC + C_CC + c), b2 = ld_bf4(row + INC + C_CH + c); up = make_float4(a.x * b2.x, a.y * b2.y, a.z * b2.z, a.w * b2.w); }
                const float4 w0 = *(const float4*)(cw + c), w1 = *(const float4*)(cw + CW + c), w2 = *(const float4*)(cw + 2 * CW + c);
                r.x = cb.x * (um.x * w0.x + cc.x * ch.x * w1.x + up.x * w2.x);
                r.y = cb.y * (um.y * w0.y + cc.y * ch.y * w1.y + up.y * w2.y);
                r.z = cb.z * (um.z * w0.z + cc.z * ch.z * w1.z + up.z * w2.z);
                r.w = cb.w * (um.w * w0.w + cc.w * ch.w * w1.w + up.w * w2.w);
            } else {
                const int oc = c - 512;
                const float4 of = *(const float4*)(obuf + (size_t)n * 1536 + oc), ob = *(const float4*)(obuf + ((size_t)T + n) * 1536 + oc);
                float4 o = make_float4(of.x + ob.x, of.y + ob.y, of.z + ob.z, of.w + ob.w);
                float4 gt;
                if (i < 5) {
                    gt = ld_bf4(row + C_RG + oc);
                    const float mu = half_sum((o.x + o.y) + (o.z + o.w)) * (1.0f / 128.0f);
                    o.x -= mu; o.y -= mu; o.z -= mu; o.w -= mu;
                    const float var = half_sum((o.x * o.x + o.y * o.y) + (o.z * o.z + o.w * o.w)) * (1.0f / 128.0f);
                    const float rs = rsqrtf(var + 1e-6f);
                    o.x *= rs; o.y *= rs; o.z *= rs; o.w *= rs;
                } else {
                    gt = ld_bf4(row + C_HG + (oc - 768));
                    const float ms = half_sum((o.x * o.x + o.y * o.y) + (o.z * o.z + o.w * o.w)) * (1.0f / 128.0f);
                    const float rs = rsqrtf(ms + 1e-6f);
                    o.x *= rs; o.y *= rs; o.z *= rs; o.w *= rs;
                }
                r.x = o.x * siluf_(gt.x); r.y = o.y * siluf_(gt.y); r.z = o.z * siluf_(gt.z); r.w = o.w * siluf_(gt.w);
            }
            const float4 bt = *(const float4*)(beta + c);
            u32x2 ov; ov[0] = pack2(r.x * bt.x, r.y * bt.y); ov[1] = pack2(r.z * bt.z, r.w * bt.w);
            *(u32x2*)(dst + c) = ov;
        }
    }
}

__device__ __forceinline__ void phase_ln1_router(const Params& p, int l, LAS unsigned char* lds) {
    int tid = threadIdx.x; asm volatile("" : "+v"(tid)); const int wave = tid >> 6, lane = tid & 63;
    LAS float* wrt = (LAS float*)lds;
    for (int i = tid; i < D * NE / 4; i += 512) {
        const float4 w = *(const float4*)(p.w_router + (size_t)i * 4);
        const int d = i >> 2, e4 = (i & 3) * 4;
        wrt[(e4 + 0) * D + d] = w.x; wrt[(e4 + 1) * D + d] = w.y; wrt[(e4 + 2) * D + d] = w.z; wrt[(e4 + 3) * D + d] = w.w;
    }
    LAS int* lcnt = (LAS int*)(lds + LDS_MISC + 256);
    if (tid < 16) lcnt[tid] = 0;
    __syncthreads();
    const float* mod = (const float*)(p.ws + WS_MOD);
    const float* y = (const float*)(p.ws + WS_Y);
    float* xres = (float*)(p.ws + WS_XRES);
    int* route = (int*)(p.ws + WS_ROUTE);
    for (int n = blockIdx.x * 8 + wave; n < T; n += gridDim.x * 8) {
        const int b = n / SEQ;
        const float* mb = mod + ((size_t)l * 4 + b) * (6 * D);
        float4 v[8];
#pragma unroll
        for (int i = 0; i < 8; ++i) {
            const float4 xv = *(const float4*)(xres + (size_t)n * D + i * 256 + lane * 4), yv = *(const float4*)(y + (size_t)n * D + i * 256 + lane * 4);
            const float4 g = *(const float4*)(mb + 2 * D + i * 256 + lane * 4);
            v[i].x = ALPHA * xv.x + (1.f + g.x) * yv.x; v[i].y = ALPHA * xv.y + (1.f + g.y) * yv.y; v[i].z = ALPHA * xv.z + (1.f + g.z) * yv.z; v[i].w = ALPHA * xv.w + (1.f + g.w) * yv.w;
        }
        ln_rows(v, p.ln_g + (size_t)(l * 2 + 0) * D, p.ln_b + (size_t)(l * 2 + 0) * D, lane);
#pragma unroll
        for (int i = 0; i < 8; ++i) *(float4*)(xres + (size_t)n * D + i * 256 + lane * 4) = v[i];
#pragma unroll
        for (int i = 0; i < 8; ++i) {
            const float4 sh = *(const float4*)(mb + 3 * D + i * 256 + lane * 4), sc = *(const float4*)(mb + 4 * D + i * 256 + lane * 4);
            v[i].x = v[i].x * (1.f + sc.x) + sh.x; v[i].y = v[i].y * (1.f + sc.y) + sh.y; v[i].z = v[i].z * (1.f + sc.z) + sh.z; v[i].w = v[i].w * (1.f + sc.w) + sh.w;
        }
        bf16_t* hb = (bf16_t*)(p.ws + WS_HB) + (size_t)n * D;
#pragma unroll
        for (int i = 0; i < 8; ++i) { u32x2 o; o[0] = pack2(v[i].x, v[i].y); o[1] = pack2(v[i].z, v[i].w); *(u32x2*)(hb + i * 256 + lane * 4) = o; }
        float lgv = 0.f;
#pragma unroll 1
        for (int e = 0; e < 16; ++e) {
            float s = 0.f;
#pragma unroll
            for (int i = 0; i < 8; ++i) { const f32x4 w = *(const LAS f32x4*)(wrt + e * D + i * 256 + lane * 4); s += (v[i].x * w[0] + v[i].y * w[1]) + (v[i].z * w[2] + v[i].w * w[3]); }
            s = wave_sum(s);
            lgv = (lane == e) ? s : lgv;
        }
        float lg[16];
#pragma unroll
        for (int e = 0; e < 16; ++e) lg[e] = __int_as_float(__builtin_amdgcn_readlane(__float_as_int(lgv), e));
        float mx = lg[0];
#pragma unroll
        for (int e = 1; e < 16; ++e) mx = fmaxf(mx, lg[e]);
        float sc[16], sum = 0.f;
#pragma unroll
        for (int e = 0; e < 16; ++e) { sc[e] = expf(lg[e] - mx); sum += sc[e]; }
        const float inv = 1.0f / sum;
        float sel[16];
#pragma unroll
        for (int e = 0; e < 16; ++e) { sc[e] *= inv; sel[e] = sc[e] + p.router_bias[e]; }
        float best_gs = -3.0e38f; int bi0 = 0, bi1 = 1; float bw0 = 0.f, bw1 = 0.f;
#pragma unroll
        for (int g = 0; g < 4; ++g) {
            int i0 = 0; float m0 = sel[4 * g];
#pragma unroll
            for (int j = 1; j < 4; ++j) if (sel[4 * g + j] > m0) { m0 = sel[4 * g + j]; i0 = j; }
            int i1 = -1; float m1 = -3.0e38f;
#pragma unroll
            for (int j = 0; j < 4; ++j) if (j != i0 && sel[4 * g + j] > m1) { m1 = sel[4 * g + j]; i1 = j; }
            float w0 = 0.f, w1 = 0.f;
#pragma unroll
            for (int j = 0; j < 4; ++j) { w0 = (j == i0) ? sc[4 * g + j] : w0; w1 = (j == i1) ? sc[4 * g + j] : w1; }
            const float gs = m0 + m1;
            if (gs > best_gs) { best_gs = gs; bi0 = 4 * g + i0; bi1 = 4 * g + i1; bw0 = w0; bw1 = w1; }
        }
        if (lane == 0) {
            const float ws_ = 1.0f / (bw0 + bw1);
            const int p0 = __hip_atomic_fetch_add(&lcnt[bi0], 1, __ATOMIC_RELAXED, __HIP_MEMORY_SCOPE_WORKGROUP), p1 = __hip_atomic_fetch_add(&lcnt[bi1], 1, __ATOMIC_RELAXED, __HIP_MEMORY_SCOPE_WORKGROUP);
            int* r = route + (size_t)n * 8;
            r[0] = bi0; r[1] = bi1; r[2] = (int)p0; r[3] = (int)p1; r[4] = __float_as_int(bw0 * ws_); r[5] = __float_as_int(bw1 * ws_);
        }
    }
    __syncthreads();
    if (tid < 16) ((int*)(p.ws + WS_WGCNT))[((size_t)l * 1024 + blockIdx.x) * 16 + tid] = lcnt[tid];
}

__device__ __forceinline__ void build_moe_tab(const Params& p, int l, LAS int* tab) {
    if (threadIdx.x == 0) {
        const unsigned* cnt = (const unsigned*)(p.ws + WS_CNT) + l * 16;
        int acc = 0;
        for (int e = 0; e < 16; ++e) { tab[e] = acc; acc += (int)((cnt[e] + 255u) >> 8); }
        tab[16] = acc;
    }
    __syncthreads();
}

__device__ __forceinline__ void phase_permute(const Params& p, int l, LAS int* tab) {
    int tid_ = threadIdx.x; asm volatile("" : "+v"(tid_)); const int wave = tid_ >> 6, lane = tid_ & 63;
    LAS int* base = tab + 32; LAS int* total = tab + 48;
    if (tid_ < 16) { base[tid_] = 0; total[tid_] = 0; }
    __syncthreads();
    {
        const int* wgc = (const int*)(p.ws + WS_WGCNT) + (size_t)l * 1024 * 16;
        const int e = tid_ & 15; int bs = 0, tt = 0;
        for (int w = tid_ >> 4; w < (int)gridDim.x; w += 32) { const int v = wgc[w * 16 + e]; tt += v; bs += (w < (int)blockIdx.x) ? v : 0; }
        __hip_atomic_fetch_add(&base[e], bs, __ATOMIC_RELAXED, __HIP_MEMORY_SCOPE_WORKGROUP);
        __hip_atomic_fetch_add(&total[e], tt, __ATOMIC_RELAXED, __HIP_MEMORY_SCOPE_WORKGROUP);
    }
    __syncthreads();
    if (tid_ == 0) { int acc = 0; for (int e = 0; e < 16; ++e) { tab[e] = acc; acc += (total[e] + 255) >> 8; } tab[16] = acc; }
    if (blockIdx.x == 0 && tid_ < 16) ((unsigned*)(p.ws + WS_CNT))[l * 16 + tid_] = (unsigned)total[tid_];
    __syncthreads();
    int* route = (int*)(p.ws + WS_ROUTE);
    const bf16_t* hb = (const bf16_t*)(p.ws + WS_HB);
    bf16_t* xe = (bf16_t*)(p.ws + WS_XE);
    for (int n = blockIdx.x * 8 + wave; n < T; n += gridDim.x * 8) {
        int* r = route + (size_t)n * 8;
        const int e0 = r[0], e1 = r[1], p0 = r[2], p1 = r[3];
        const int row0 = tab[e0] * 256 + base[e0] + p0, row1 = tab[e1] * 256 + base[e1] + p1;
        const u32x4* src = (const u32x4*)(hb + (size_t)n * D);
        u32x4* d0 = (u32x4*)(xe + (size_t)row0 * D); u32x4* d1 = (u32x4*)(xe + (size_t)row1 * D);
#pragma unroll
        for (int i = 0; i < 4; ++i) { const u32x4 v = src[i * 64 + lane]; d0[i * 64 + lane] = v; d1[i * 64 + lane] = v; }
        if (lane == 0) { r[6] = row0; r[7] = row1; }
    }
}

__device__ __forceinline__ void phase_ln2(const Params& p, int l) {
    int tid_ = threadIdx.x; asm volatile("" : "+v"(tid_)); const int wave = tid_ >> 6, lane = tid_ & 63;
    const float* mod = (const float*)(p.ws + WS_MOD);
    const float* ye = (const float*)(p.ws + WS_YE);
    float* xres = (float*)(p.ws + WS_XRES);
    const int* route = (const int*)(p.ws + WS_ROUTE);
    for (int n = blockIdx.x * 8 + wave; n < T; n += gridDim.x * 8) {
        const int b = n / SEQ;
        const float* mb = mod + ((size_t)l * 4 + b) * (6 * D);
        const int* r = route + (size_t)n * 8;
        const float w0 = __int_as_float(r[4]), w1 = __int_as_float(r[5]);
        const float* y0 = ye + (size_t)r[6] * D; const float* y1 = ye + (size_t)r[7] * D;
        float4 v[8];
#pragma unroll
        for (int i = 0; i < 8; ++i) {
            const float4 xv = *(const float4*)(xres + (size_t)n * D + i * 256 + lane * 4);
            const float4 a = *(const float4*)(y0 + i * 256 + lane * 4), c = *(const float4*)(y1 + i * 256 + lane * 4);
            const float4 g = *(const float4*)(mb + 5 * D + i * 256 + lane * 4);
            v[i].x = ALPHA * xv.x + (1.f + g.x) * (w0 * a.x + w1 * c.x); v[i].y = ALPHA * xv.y + (1.f + g.y) * (w0 * a.y + w1 * c.y);
            v[i].z = ALPHA * xv.z + (1.f + g.z) * (w0 * a.z + w1 * c.z); v[i].w = ALPHA * xv.w + (1.f + g.w) * (w0 * a.w + w1 * c.w);
        }
        ln_rows(v, p.ln_g + (size_t)(l * 2 + 1) * D, p.ln_b + (size_t)(l * 2 + 1) * D, lane);
        if (l + 1 < DEPTH) {
#pragma unroll
            for (int i = 0; i < 8; ++i) *(float4*)(xres + (size_t)n * D + i * 256 + lane * 4) = v[i];
            const float* mn = mod + ((size_t)(l + 1) * 4 + b) * (6 * D);
            modulate_store(v, mn, mn + D, (bf16_t*)(p.ws + WS_HA) + (size_t)n * D, lane);
        } else {
#ifdef MIXER_CHECK
            { const float* chk = (const float*)(p.ws + WS_CNT + 1024); float scale = 1.f;
              for (int j = 7; j >= 0; --j) { const float sd = chk[j * 2], sq = chk[j * 2 + 1]; if (!(sd <= 1e-3f * sq)) scale = 1.0f + 0.25f * (float)(1 << (j & 3)) + 8.f * (float)(j >> 2); }
#pragma unroll
              for (int i = 0; i < 8; ++i) { v[i].x *= scale; v[i].y *= scale; v[i].z *= scale; v[i].w *= scale; } }
#endif
#pragma unroll
            for (int i = 0; i < 8; ++i) *(float4*)(p.out + (size_t)n * D + i * 256 + lane * 4) = v[i];
        }
    }
}

typedef const __attribute__((address_space(4))) unsigned char* KargPtr;
__device__ __forceinline__ Params load_params(KargPtr q) { asm volatile("" : "+s"(q)); Params lp; __builtin_memcpy(&lp, q, sizeof(Params)); return lp; }

__global__ __launch_bounds__(512, 2) void mega(Params p_in) {
    extern __shared__ __attribute__((aligned(16))) unsigned char smem[];
    LAS unsigned char* lds = (LAS unsigned char*)smem;
    LAS int* tab = (LAS int*)(lds + LDS_MISC + 64);
    KargPtr kp = (KargPtr)__builtin_amdgcn_kernarg_segment_ptr();
    if (threadIdx.x == 0) { *(LAS u32x4*)(lds + LDS_MISC) = (u32x4){0u, 0u, 0u, 0u}; }
    __syncthreads();
    const int fused = p_in.fused, ph_lo = p_in.ph_lo, ph_hi = p_in.ph_hi, l_hi = p_in.l_hi;
    XcdBarrier bar;
    if (fused) bar = xcd_barrier_post((unsigned*)(p_in.ws + WS_BAR), (volatile LAS unsigned*)(lds + LDS_MISC));
    else { bar.bar = (unsigned*)(p_in.ws + WS_BAR); bar.x = 0; bar.st = (volatile LAS unsigned*)(lds + LDS_MISC); }
#ifdef ONLY_PH
#define PH(i) ((i) == ONLY_PH && ph_lo <= (i) && (i) < ph_hi)
#else
#define PH(i) (ph_lo <= (i) && (i) < ph_hi)
#endif
#define SYNC() do { if (fused) xcd_barrier(bar); } while (0)
#ifndef DUP_MASK
#define DUP_MASK 0
#endif
#define REP(i) _Pragma("unroll 1") for (int rep_ = 0; rep_ < 1 + ((DUP_MASK >> (i)) & 1); ++rep_)
    const int G = gridDim.x, c = blockIdx.x;
    if (PH(0)) REP(0) { const Params p = load_params(kp); phase_prologue(p, lds); SYNC(); }
    if (PH(1)) REP(1) { const Params p = load_params(kp); phase_ln0(p); SYNC(); }
    for (int l = p_in.l_lo; l < l_hi; ++l) {
        if (PH(2)) REP(2) {
            const Params p = load_params(kp);
            pg8::DenseOrder S; S.init(T, INC, D, G, c);
            pg8::Gemm g{(const bf16_t*)(p.ws + WS_HA), (const bf16_t*)(p.ws + WS_WIN) + (size_t)l * INC * D, D};
            pg8::EpiBf16 E{(bf16_t*)(p.ws + WS_PROJ), INC};
            pg8::gemm_phase(lds, g, S, E);
            SYNC();
        }
#ifdef MIXER_CHECK
        if (PH(3)) REP(3) { const Params p = load_params(kp); phase_mixer_valu(p, l, lds); SYNC(); }
        if (PH(3)) REP(3) { const Params p = load_params(kp); phase_mixer_mfma(p, l, lds, (float*)(p.ws + WS_XE)); SYNC(); }
        if (PH(3)) REP(3) { const Params p = load_params(kp); phase_mixer_check(p, (const float*)(p.ws + WS_OBUF), (const float*)(p.ws + WS_XE), (float*)(p.ws + WS_CNT + 1024) + l * 8); SYNC(); }
#else
        if (PH(3)) REP(3) { const Params p = load_params(kp); phase_mixer_mfma(p, l, lds, (float*)(p.ws + WS_OBUF)); SYNC(); }
#endif
        if (PH(4)) REP(4) { const Params p = load_params(kp); phase_finalize(p, l); SYNC(); }
        if (PH(5)) REP(5) {
            const Params p = load_params(kp);
            pg8::DenseOrder S; S.init(T, D, D, G, c);
            pg8::Gemm g{(const bf16_t*)(p.ws + WS_MIXED), (const bf16_t*)(p.ws + WS_WOUT) + (size_t)l * D * D, D};
            pg8::EpiF32 E{(float*)(p.ws + WS_Y), D};
            pg8::gemm_phase(lds, g, S, E);
            SYNC();
        }
        if (PH(6)) REP(6) { const Params p = load_params(kp); phase_ln1_router(p, l, lds); SYNC(); }
        if (PH(7)) REP(7) { const Params p = load_params(kp); phase_permute(p, l, tab); SYNC(); }
        if (PH(8)) REP(8) {
            const Params p = load_params(kp);
            build_moe_tab(p, l, tab);
            pg8::MoeOrder S; S.tab = tab; S.NTn = 11; S.G = G; S.c = c; S.tstep = (size_t)256 * D * 2; S.bexp = (size_t)2 * DE * D * 2;
            pg8::Gemm g{(const bf16_t*)(p.ws + WS_XE), (const bf16_t*)(p.ws + WS_WGU) + (size_t)l * NE * 2 * DE * D, D};
            pg8::EpiHidden E{(bf16_t*)(p.ws + WS_HID)};
            pg8::gemm_phase(lds, g, S, E);
            SYNC();
        }
        if (PH(9)) REP(9) {
            const Params p = load_params(kp);
            build_moe_tab(p, l, tab);
            pg8::MoeOrder S; S.tab = tab; S.NTn = 8; S.G = G; S.c = c; S.tstep = (size_t)256 * DE * 2; S.bexp = (size_t)D * DE * 2;
            pg8::Gemm g{(const bf16_t*)(p.ws + WS_HID), (const bf16_t*)(p.ws + WS_WD) + (size_t)l * NE * D * DE, DE};
            pg8::EpiF32 E{(float*)(p.ws + WS_YE), D};
            pg8::gemm_phase(lds, g, S, E);
            SYNC();
        }
        if (PH(10)) REP(10) { const Params p = load_params(kp); phase_ln2(p, l); SYNC(); }
    }
}

#ifndef MK_FUSED
#define MK_FUSED 1
#endif
extern "C" void kernel_launch(void* const* d_in, const int* in_sizes, int n_in, void* d_out, int out_size, void* d_ws, size_t ws_size, hipStream_t stream) {
    static int grid = 0;
    if (grid == 0) {
        if (n_in != 18 || ws_size < WS_END) { fprintf(stderr, "kernel_launch: unexpected n_in %d or ws_size %zu (< %zu)\n", n_in, ws_size, (size_t)WS_END); grid = -1; return; }
        int dev = 0, cus = 0, per_cu = 0;
        hipGetDevice(&dev);
        hipDeviceGetAttribute(&cus, hipDeviceAttributeMultiprocessorCount, dev);
        if (hipFuncSetAttribute((const void*)mega, hipFuncAttributeMaxDynamicSharedMemorySize, LDS_BYTES) != hipSuccess) { fprintf(stderr, "kernel_launch: hipFuncSetAttribute failed\n"); grid = -1; return; }
        hipOccupancyMaxActiveBlocksPerMultiprocessor(&per_cu, (const void*)mega, 512, LDS_BYTES);
        if (per_cu < 1) fprintf(stderr, "kernel_launch: occupancy query says %d\n", per_cu);
        grid = cus > 0 ? cus : 256;
    }
    if (grid < 0) return;
    hipMemsetAsync(d_ws, 0, WS_ZERO_BYTES, stream);
    Params p{};
    p.x = (const float*)d_in[0]; p.c = (const float*)d_in[1]; p.emb_g = (const float*)d_in[2]; p.emb_b = (const float*)d_in[3];
    p.w_ada = (const float*)d_in[4]; p.b_ada = (const float*)d_in[5]; p.w_in = (const float*)d_in[6]; p.conv_w = (const float*)d_in[7];
    p.mix_beta = (const float*)d_in[8]; p.w_out = (const float*)d_in[9]; p.lb_logits = (const float*)d_in[10]; p.ln_g = (const float*)d_in[11];
    p.ln_b = (const float*)d_in[12]; p.w_router = (const float*)d_in[13]; p.router_bias = (const float*)d_in[14]; p.w_gate = (const float*)d_in[15];
    p.w_up = (const float*)d_in[16]; p.w_down = (const float*)d_in[17];
    p.out = (float*)d_out; p.ws = (unsigned char*)d_ws; p.pad = 0;
#if MK_FUSED
    p.ph_lo = 0; p.ph_hi = 11; p.l_lo = 0; p.l_hi = DEPTH; p.fused = 1;
    hipLaunchKernelGGL(mega, dim3(grid), dim3(512), LDS_BYTES, stream, p);
#else
    p.fused = 0;
    for (int ph = 0; ph < 2; ++ph) { p.ph_lo = ph; p.ph_hi = ph + 1; p.l_lo = 0; p.l_hi = 0; hipLaunchKernelGGL(mega, dim3(grid), dim3(512), LDS_BYTES, stream, p); }
    for (int l = 0; l < DEPTH; ++l)
        for (int ph = 2; ph < 11; ++ph) { p.ph_lo = ph; p.ph_hi = ph + 1; p.l_lo = l; p.l_hi = l + 1; hipLaunchKernelGGL(mega, dim3(grid), dim3(512), LDS_BYTES, stream, p); }
#endif
}
```

```cpp
#include <hip/hip_runtime.h>
#include <stdint.h>
#include <stdio.h>

#define LAS __attribute__((address_space(3)))
typedef unsigned short bf16_t;
typedef short bf16x8 __attribute__((ext_vector_type(8)));
typedef float f32x4 __attribute__((ext_vector_type(4)));
typedef unsigned u32x4 __attribute__((ext_vector_type(4)));
typedef unsigned u32x2 __attribute__((ext_vector_type(2)));

constexpr int D = 2048, NB = 4, SEQ = 2048, T = NB * SEQ, DEPTH = 2;
constexpr int CW = 512, RW = 768, HWD = 768, INC = 8448;
constexpr int NE = 16, DE = 1408;
constexpr int C_CB = 0, C_CC = 512, C_CH = 1024, C_RQ = 1536, C_RK = 2304, C_RV = 3072, C_RG = 3840, C_HQ = 4608, C_HFF = 5376, C_HFB = 6144, C_HI = 6912, C_HG = 7680;
constexpr int XE_ROWS = 20480;
constexpr float ALPHA = 1.4142135623730951f;

constexpr size_t WS_BAR = 0;
constexpr size_t WS_CNT = 16384;
constexpr size_t WS_CVTQ = 20480;
constexpr size_t WS_ZERO_BYTES = 32768;
constexpr size_t WS_MOD = 32768;
constexpr size_t WS_ROUTE = WS_MOD + 393216;
constexpr size_t WS_WGCNT = WS_ROUTE + 262144;
constexpr size_t WS_WIN = 1048576;
constexpr size_t SZ_WIN = (size_t)DEPTH * INC * D * 2;
constexpr size_t WS_WOUT = WS_WIN + SZ_WIN;
constexpr size_t SZ_WOUT = (size_t)DEPTH * D * D * 2;
constexpr size_t WS_WGU = WS_WOUT + SZ_WOUT;
constexpr size_t SZ_WGU = (size_t)DEPTH * NE * 2 * DE * D * 2;
constexpr size_t WS_WD = WS_WGU + SZ_WGU;
constexpr size_t SZ_WD = (size_t)DEPTH * NE * D * DE * 2;
constexpr size_t WS_XRES = WS_WD + SZ_WD;
constexpr size_t SZ_XRES = (size_t)T * D * 4;
constexpr size_t WS_HA = WS_XRES + SZ_XRES;
constexpr size_t SZ_H = (size_t)T * D * 2;
constexpr size_t WS_HB = WS_HA + SZ_H;
constexpr size_t WS_PROJ = WS_HB + SZ_H;
constexpr size_t SZ_PROJ = (size_t)T * INC * 2;
constexpr size_t WS_OBUF = WS_PROJ + SZ_PROJ;
constexpr size_t SZ_OBUF = (size_t)2 * T * 1536 * 4;
constexpr size_t WS_YE = WS_PROJ;
constexpr size_t SZ_YE = (size_t)XE_ROWS * D * 4;
static_assert(SZ_YE <= SZ_PROJ + SZ_OBUF, "ye alias");
constexpr size_t WS_MIXED = WS_OBUF + SZ_OBUF;
constexpr size_t WS_Y = WS_MIXED + SZ_H;
constexpr size_t SZ_Y = (size_t)T * D * 4;
constexpr size_t WS_XE = WS_Y + SZ_Y;
constexpr size_t SZ_XE = (size_t)XE_ROWS * D * 2;
constexpr size_t WS_HID = WS_XE + SZ_XE;
constexpr size_t SZ_HID = (size_t)XE_ROWS * DE * 2;
constexpr size_t WS_END = WS_HID + SZ_HID;

constexpr int LDS_BYTES = 147456;
constexpr int LDS_MISC = 131072;

struct Params {
    const float *x, *c, *emb_g, *emb_b, *w_ada, *b_ada, *w_in, *conv_w, *mix_beta, *w_out, *lb_logits, *ln_g, *ln_b, *w_router, *router_bias, *w_gate, *w_up, *w_down;
    float* out;
    unsigned char* ws;
    int ph_lo, ph_hi, l_lo, l_hi, fused, pad;
};

__device__ __forceinline__ float bf2f(unsigned b) { return __uint_as_float(b << 16); }
__device__ __forceinline__ unsigned f2bf(float f) { unsigned u = __float_as_uint(f); u += 0x7FFFu + ((u >> 16) & 1u); return u >> 16; }
__device__ __forceinline__ unsigned pack2(float lo, float hi) { unsigned r; asm("v_cvt_pk_bf16_f32 %0, %1, %2" : "=v"(r) : "v"(lo), "v"(hi)); return r; }
__device__ __forceinline__ float wave_sum(float v) {
#pragma unroll
    for (int o = 32; o > 0; o >>= 1) v += __shfl_xor(v, o, 64);
    return v;
}
__device__ __forceinline__ float half_sum(float v) {
#pragma unroll
    for (int o = 16; o > 0; o >>= 1) v += __shfl_xor(v, o, 64);
    return v;
}
__device__ __forceinline__ float sigmoidf_(float z) { return 1.0f / (1.0f + __expf(-z)); }
__device__ __forceinline__ float siluf_(float z) { return z / (1.0f + __expf(-z)); }

#define XB_TMO      128
#define XB_XCNT(j)  (256  + 64 * (j))
#define XB_XSUB(j)  (1280 + 64 * (j))
#define XB_XGEN(j)  (2304 + 64 * (j))
#define XB_TOP      3328
#define XB_TOPGEN   3392
#define XCD_BAR_WORDS 3456
#define XB_SPIN_CAP (1u << 22)
__device__ __forceinline__ unsigned xb_ld(unsigned* p)              { return __hip_atomic_load(p, __ATOMIC_RELAXED, __HIP_MEMORY_SCOPE_AGENT); }
__device__ __forceinline__ unsigned xb_add(unsigned* p, unsigned v) { return __hip_atomic_fetch_add(p, v, __ATOMIC_RELAXED, __HIP_MEMORY_SCOPE_AGENT); }
__device__ __forceinline__ unsigned xb_xcc_id() { return (unsigned)__builtin_amdgcn_s_getreg((3 << 11) | 20) & 0xFu; }
#define XB_SPIN(cond, bar) do { unsigned _sp = 0; while (cond) { __builtin_amdgcn_s_sleep(1); \
    if ((++_sp & 255u) == 0u) { if (xb_ld(&(bar)[XB_TMO])) break; if (_sp > XB_SPIN_CAP) { atomicAdd(&(bar)[XB_TMO], 1u); break; } } } } while (0)
struct XcdBarrier { unsigned* bar; unsigned x; volatile LAS unsigned* st; };
__device__ __forceinline__ XcdBarrier xcd_barrier_post(unsigned* bar, volatile LAS unsigned* st) {
    XcdBarrier b; b.bar = bar; b.x = xb_xcc_id(); b.st = st;
    if (threadIdx.x == 0) (void)xb_add(&bar[XB_XCNT(b.x)], 1u);
    return b;
}
__device__ __forceinline__ void xcd_barrier_complete(unsigned* bar, unsigned x, unsigned& nloc, unsigned& nx) {
    const unsigned G = gridDim.x * gridDim.y * gridDim.z;
    unsigned sum, cnt, mine, sp = 0u;
    for (;;) {
        sum = 0u; cnt = 0u; mine = 0u;
#pragma unroll
        for (unsigned j = 0; j < 16; ++j) { const unsigned c = xb_ld(&bar[XB_XCNT(j)]); sum += c; cnt += (c > 0u) ? 1u : 0u; mine = (j == x) ? c : mine; }
        if (sum == G) break;
        __builtin_amdgcn_s_sleep(1);
        if ((++sp & 255u) == 0u) { if (xb_ld(&bar[XB_TMO])) break; if (sp > XB_SPIN_CAP) { atomicAdd(&bar[XB_TMO], 1u); break; } }
    }
    nloc = mine > 0u ? mine : 1u; nx = cnt > 0u ? cnt : 1u;
}
__device__ __forceinline__ void xcd_barrier(const XcdBarrier& b) {
    asm volatile("s_waitcnt vmcnt(0)" ::: "memory");
    __syncthreads();
    if (threadIdx.x == 0) {
        unsigned* bar = b.bar;
        __builtin_amdgcn_s_waitcnt(0);
        unsigned nloc = b.st[0], nx = b.st[1];
        if (nloc == 0u) { xcd_barrier_complete(bar, b.x, nloc, nx); b.st[0] = nloc; b.st[1] = nx; }
        const unsigned old = xb_add(&bar[XB_XSUB(b.x)], 1u);
        const unsigned gen = old / nloc;
        if (old + 1u == (gen + 1u) * nloc) {
            __builtin_amdgcn_fence(__ATOMIC_RELEASE, "agent");
            asm volatile("s_waitcnt vmcnt(0)" ::: "memory");
            const unsigned og = xb_add(&bar[XB_TOP], 1u);
            const unsigned tg = og / nx;
            if (og + 1u == (tg + 1u) * nx) xb_add(&bar[XB_TOPGEN], 1u);
            else XB_SPIN(xb_ld(&bar[XB_TOPGEN]) == tg, bar);
            __builtin_amdgcn_fence(__ATOMIC_ACQUIRE, "agent");
            xb_add(&bar[XB_XGEN(b.x)], 1u);
            asm volatile("s_waitcnt vmcnt(0)" ::: "memory");
        } else {
            XB_SPIN(xb_ld(&bar[XB_XGEN(b.x)]) == gen, bar);
            __builtin_amdgcn_fence(__ATOMIC_ACQUIRE, "agent");
            asm volatile("s_waitcnt vmcnt(0)" ::: "memory");
        }
    }
    __syncthreads();
}

namespace pg8 {
constexpr int BM = 256, BK = 64, HALF = 128, HTB = HALF * BK * 2, STAGE_BYTES = 8 * HTB, NXCD = 8, WGM = 8;
__host__ __device__ __forceinline__ int lds_byte(int r, int c) { const int st = (r >> 4) * 2 + (c >> 5), rr = r & 15, cc = c & 31, ob = rr * 64 + cc * 2; return st * 1024 + (ob ^ (((ob >> 9) & 1) << 5)); }
__host__ __device__ __forceinline__ void stage_rc(int b, int& R, int& C) { const int st = b / 1024, sb = b % 1024, swz = sb ^ (((sb >> 9) & 1) << 5); R = (st >> 1) * 16 + swz / 64; C = (st & 1) * 32 + (swz % 64) / 2; }
__host__ __device__ __forceinline__ int perm32(int rho) { const int n = rho >> 4, i = rho & 15; return 8 * (i >> 2) + 4 * n + (i & 3); }

struct Unit { size_t aB, bB; int row0, col0; };
struct Gemm { const bf16_t* A; const bf16_t* Bt; int K; };

struct DenseOrder {
    int nM, nN, nwg, G, c; size_t tstep;
    __device__ void init(int M, int N, int K, int G_, int c_) { nM = M / BM; nN = N / BM; nwg = nM * nN; G = G_; c = c_; tstep = (size_t)BM * K * 2; }
    __device__ bool next(int i, Unit& u) const {
        const long L = (long)i * G + c; if (L >= nwg) return false;
        int wgid = (int)L; { const int q = nwg / NXCD, r = nwg % NXCD, xcd = wgid % NXCD, off = wgid / NXCD; wgid = (xcd < r ? xcd * (q + 1) : r * (q + 1) + (xcd - r) * q) + off; }
        const int nig = WGM * nN, gid = wgid / nig, fm = gid * WGM, gsz = (nM - fm) < WGM ? (nM - fm) : WGM;
        const int pm = fm + ((wgid % nig) % gsz), pn = (wgid % nig) / gsz;
        u.aB = (size_t)pm * tstep; u.bB = (size_t)pn * tstep; u.row0 = pm * BM; u.col0 = pn * BM; return true;
    }
};
struct OneUnit {
    Unit u0;
    __device__ bool next(int i, Unit& u) const { if (i > 0) return false; u = u0; return true; }
};
struct MoeOrder {
    const LAS int* tab; int NTn, G, c; size_t tstep, bexp;
    __device__ bool next(int i, Unit& u) const {
        const int MT = tab[16], U = MT * NTn, nx = G >> 3;
        int f;
        if ((G & 7) == 0) { const int per = (U + 7) >> 3, x = c & 7, j = c >> 3, loc = i * nx + j; f = x * per + loc; if (loc >= per || f >= U) return false; }
        else { f = i * G + c; if (f >= U) return false; }
        int e = 0;
#pragma unroll
        for (int j = 1; j < 16; ++j) e += (f >= tab[j] * NTn) ? 1 : 0;
        const int t0 = tab[e], te = tab[e + 1] - t0, r = f - t0 * NTn;
        const int nt = r / te, mt = t0 + (r - nt * te);
        u.aB = (size_t)mt * tstep; u.bB = (size_t)e * bexp + (size_t)nt * tstep; u.row0 = mt * BM; u.col0 = nt * BM; return true;
    }
};

__device__ __forceinline__ size_t rfl64(size_t v) { const unsigned lo = (unsigned)__builtin_amdgcn_readfirstlane((int)(unsigned)v), hi = (unsigned)__builtin_amdgcn_readfirstlane((int)(unsigned)(v >> 32)); return ((size_t)hi << 32) | lo; }
__device__ __forceinline__ void uniformize(Unit& u) { u.aB = rfl64(u.aB); u.bB = rfl64(u.bB); u.row0 = __builtin_amdgcn_readfirstlane(u.row0); u.col0 = __builtin_amdgcn_readfirstlane(u.col0); }
__device__ __forceinline__ unsigned cvt_pk_bf16(float lo, float hi) { unsigned r; asm volatile("v_cvt_pk_bf16_f32 %0, %1, %2" : "=v"(r) : "v"(lo), "v"(hi)); return r; }

struct EpiF32 {
    static constexpr bool PERM = false;
    float* C; int ldc;
    __device__ __forceinline__ void operator()(const f32x4 (&acc)[2][2][4][2], const Unit& u, int wr, int wc, int fr, int fq) const {
        const int row0 = u.row0 + wr * 64 + fr, col0 = u.col0 + wc * 32 + 4 * fq;
#pragma unroll
        for (int ai = 0; ai < 2; ++ai)
#pragma unroll
            for (int m = 0; m < 4; ++m) { float* rowp = C + (size_t)(row0 + ai * HALF + m * 16) * ldc + col0;
#pragma unroll
                for (int bj = 0; bj < 2; ++bj)
#pragma unroll
                    for (int n = 0; n < 2; ++n) *(f32x4*)(rowp + bj * HALF + n * 16) = acc[ai][bj][m][n]; }
    }
};
struct EpiBf16 {
    static constexpr bool PERM = true;
    bf16_t* O; int ldc;
    __device__ __forceinline__ void operator()(const f32x4 (&acc)[2][2][4][2], const Unit& u, int wr, int wc, int fr, int fq) const {
        const int row0 = u.row0 + wr * 64 + fr, col0 = u.col0 + wc * 32 + 8 * fq;
#pragma unroll
        for (int ai = 0; ai < 2; ++ai)
#pragma unroll
            for (int m = 0; m < 4; ++m) { bf16_t* rowp = O + (size_t)(row0 + ai * HALF + m * 16) * ldc + col0;
#pragma unroll
                for (int bj = 0; bj < 2; ++bj) { const f32x4 v0 = acc[ai][bj][m][0], v1 = acc[ai][bj][m][1];
                    u32x4 o; o[0] = cvt_pk_bf16(v0[0], v0[1]); o[1] = cvt_pk_bf16(v0[2], v0[3]); o[2] = cvt_pk_bf16(v1[0], v1[1]); o[3] = cvt_pk_bf16(v1[2], v1[3]);
                    *(u32x4*)(rowp + bj * HALF) = o; } }
    }
};
struct EpiHidden {
    static constexpr bool PERM = true;
    bf16_t* O;
    __device__ __forceinline__ void operator()(const f32x4 (&acc)[2][2][4][2], const Unit& u, int wr, int wc, int fr, int fq) const {
        const int row0 = u.row0 + wr * 64 + fr, col0 = (u.col0 >> 1) + wc * 32 + 8 * fq;
#pragma unroll
        for (int ai = 0; ai < 2; ++ai)
#pragma unroll
            for (int m = 0; m < 4; ++m) { bf16_t* rowp = O + (size_t)(row0 + ai * HALF + m * 16) * DE + col0;
                float h[8];
#pragma unroll
                for (int n = 0; n < 2; ++n)
#pragma unroll
                    for (int j = 0; j < 4; ++j) { const float g = acc[ai][0][m][n][j], up = acc[ai][1][m][n][j]; h[n * 4 + j] = g * __builtin_amdgcn_rcpf(1.0f + __expf(-g)) * up; }
                u32x4 o; o[0] = cvt_pk_bf16(h[0], h[1]); o[1] = cvt_pk_bf16(h[2], h[3]); o[2] = cvt_pk_bf16(h[4], h[5]); o[3] = cvt_pk_bf16(h[6], h[7]);
                *(u32x4*)rowp = o; }
    }
};

template <class Epi, class Sched>
__device__ __forceinline__ void gemm_phase(LAS unsigned char* lds, const Gemm g, const Sched& S, const Epi& E) {
    int tid = threadIdx.x; asm volatile("" : "+v"(tid)); const int wid = __builtin_amdgcn_readfirstlane(tid >> 6), lane = tid & 63, wr = wid >> 2, wc = wid & 3, fr = lane & 15, fq = lane >> 4;
    const int K = g.K, nt = K / BK;
    unsigned voffA[2], voffB[2];
#pragma unroll
    for (int i = 0; i < 2; ++i) { int R, C; stage_rc(tid * 16 + i * 8192, R, C); const int Rb = Epi::PERM ? ((R & ~31) + perm32(R & 31)) : R;
        voffA[i] = (unsigned)(R * K + C) * 2u; voffB[i] = (unsigned)(Rb * K + C) * 2u; }
    const size_t kstep = (size_t)(BK * 2);
    const size_t hstep = (size_t)HALF * K * 2;
    const unsigned ldsw = (unsigned)wid * 1024u;
    const int aoff = lds_byte(wr * 64 + fr, fq * 8), boff = lds_byte(wc * 32 + fr, fq * 8);
#define PG8_SA(b, h) (((b) * 2 + (h)) * HTB)
#define PG8_SB(b, h) ((4 + (b) * 2 + (h)) * HTB)
#define PG8_STAGE(bufoff, gbase, voff) do { _Pragma("unroll") for (int _i = 0; _i < 2; ++_i) \
        __builtin_amdgcn_global_load_lds((const unsigned*)((const char*)(gbase) + (voff)[_i]), (LAS unsigned*)(lds + (bufoff) + ldsw + _i * 8192), 16, 0, 0); } while (0)
#define PG8_LDA(dst, b, h) do { _Pragma("unroll") for (int m = 0; m < 4; ++m) _Pragma("unroll") for (int k = 0; k < 2; ++k) dst[m][k] = *(const LAS bf16x8*)(lds + PG8_SA(b, h) + aoff + m * 2048 + k * 1024); } while (0)
#define PG8_LDB(dst, b, h) do { _Pragma("unroll") for (int n = 0; n < 2; ++n) _Pragma("unroll") for (int k = 0; k < 2; ++k) dst[n][k] = *(const LAS bf16x8*)(lds + PG8_SB(b, h) + boff + n * 2048 + k * 1024); } while (0)
#define PG8_MMA(ai, bj, At, Bt) do { __builtin_amdgcn_s_setprio(1); _Pragma("unroll") for (int m = 0; m < 4; ++m) _Pragma("unroll") for (int n = 0; n < 2; ++n) _Pragma("unroll") for (int k = 0; k < 2; ++k) \
        acc[ai][bj][m][n] = __builtin_amdgcn_mfma_f32_16x16x32_bf16(Bt[n][k], At[m][k], acc[ai][bj][m][n], 0, 0, 0); __builtin_amdgcn_s_setprio(0); } while (0)
#define PG8_WAIT_V(n) asm volatile("s_waitcnt vmcnt(" #n ")" ::: "memory")
#define PG8_WAIT_L(n) asm volatile("s_waitcnt lgkmcnt(" #n ")" ::: "memory")
#define PG8_BAR __builtin_amdgcn_s_barrier()
#define PG8_SCHED __builtin_amdgcn_sched_barrier(0)
    Unit cur, nxt; int ui = 0;
    if (!S.next(0, cur)) return;
    uniformize(cur);
    f32x4 acc[2][2][4][2];
#pragma unroll
    for (int a = 0; a < 2; ++a)
#pragma unroll
        for (int b = 0; b < 2; ++b)
#pragma unroll
            for (int m = 0; m < 4; ++m)
#pragma unroll
                for (int n = 0; n < 2; ++n) acc[a][b][m][n] = (f32x4){0.f, 0.f, 0.f, 0.f};
    bf16x8 At[4][2], B0[2][2], B1[2][2];
    const char* cA = (const char*)g.A + cur.aB; const char* cB = (const char*)g.Bt + cur.bB;
    PG8_STAGE(PG8_SB(0, 0), cB, voffB); PG8_STAGE(PG8_SA(0, 0), cA, voffA); PG8_STAGE(PG8_SB(0, 1), cB + hstep, voffB); PG8_STAGE(PG8_SA(0, 1), cA + hstep, voffA);
    if (wr == 1) PG8_BAR;
    PG8_WAIT_V(4); PG8_BAR;
    PG8_STAGE(PG8_SB(1, 0), cB + kstep, voffB); PG8_STAGE(PG8_SA(1, 0), cA + kstep, voffA); PG8_STAGE(PG8_SB(1, 1), cB + hstep + kstep, voffB);
    PG8_WAIT_V(6); PG8_BAR;
    for (;;) {
        const bool has_next = S.next(ui + 1, nxt);
        uniformize(nxt);
        const char* nA = has_next ? (const char*)g.A + nxt.aB : cA; const char* nB = has_next ? (const char*)g.Bt + nxt.bB : cB;
        for (int t = 0; t < nt; t += 2) {
            const bool last = (t == nt - 2);
            const char* a1 = cA + (size_t)(t + 1) * kstep;
            const char* a2 = last ? nA : cA + (size_t)(t + 2) * kstep; const char* b2 = last ? nB : cB + (size_t)(t + 2) * kstep;
            const char* a3 = a2 + kstep; const char* b3 = b2 + kstep;
            PG8_LDB(B0, 0, 0); PG8_SCHED; PG8_LDA(At, 0, 0); PG8_STAGE(PG8_SA(1, 1), a1 + hstep, voffA);
            PG8_WAIT_L(8); PG8_BAR; PG8_WAIT_L(0); PG8_MMA(0, 0, At, B0); PG8_BAR; PG8_SCHED;
            PG8_LDB(B1, 0, 1); PG8_STAGE(PG8_SB(0, 0), b2, voffB);
            PG8_BAR; PG8_WAIT_L(0); PG8_MMA(0, 1, At, B1); PG8_BAR;
            PG8_LDA(At, 0, 1); PG8_STAGE(PG8_SA(0, 0), a2, voffA);
            PG8_BAR; PG8_WAIT_L(0); PG8_MMA(1, 0, At, B0); PG8_BAR; PG8_SCHED;
            PG8_STAGE(PG8_SB(0, 1), b2 + hstep, voffB);
            PG8_WAIT_V(6); PG8_BAR; PG8_MMA(1, 1, At, B1); PG8_BAR;
            PG8_LDB(B0, 1, 0); PG8_SCHED; PG8_LDA(At, 1, 0); PG8_STAGE(PG8_SA(0, 1), a2 + hstep, voffA);
            PG8_WAIT_L(8); PG8_BAR; PG8_WAIT_L(0); PG8_MMA(0, 0, At, B0); PG8_BAR; PG8_SCHED;
            PG8_LDB(B1, 1, 1); PG8_STAGE(PG8_SB(1, 0), b3, voffB);
            PG8_BAR; PG8_WAIT_L(0); PG8_MMA(0, 1, At, B1); PG8_BAR;
            PG8_LDA(At, 1, 1); PG8_STAGE(PG8_SA(1, 0), a3, voffA);
            PG8_BAR; PG8_WAIT_L(0); PG8_MMA(1, 0, At, B0); PG8_BAR; PG8_SCHED;
            PG8_STAGE(PG8_SB(1, 1), b3 + hstep, voffB);
            PG8_WAIT_V(6); PG8_BAR; PG8_MMA(1, 1, At, B1); PG8_BAR;
        }
        E(acc, cur, wr, wc, fr, fq);
        if (!has_next) break;
#pragma unroll
        for (int a = 0; a < 2; ++a)
#pragma unroll
            for (int b = 0; b < 2; ++b)
#pragma unroll
                for (int m = 0; m < 4; ++m)
#pragma unroll
                    for (int n = 0; n < 2; ++n) acc[a][b][m][n] = (f32x4){0.f, 0.f, 0.f, 0.f};
        cur = nxt; cA = nA; cB = nB; ++ui;
    }
    PG8_WAIT_V(0);
    if (wr == 0) PG8_BAR;
    PG8_BAR;
#undef PG8_SA
#undef PG8_SB
#undef PG8_STAGE
#undef PG8_LDA
#undef PG8_LDB
#undef PG8_MMA
#undef PG8_WAIT_V
#undef PG8_WAIT_L
#undef PG8_BAR
#undef PG8_SCHED
}
}

constexpr int S_IN = 16 * 66, S_OUT = 16 * 16, S_GU = 16 * 11, S_DN = 11 * 16;
constexpr int CV_PER_L = S_IN + S_OUT + NE * 2 * S_GU + NE * S_DN;
constexpr int CV_A0 = S_IN + S_OUT;
constexpr int CV_A1 = CV_A0 + NE * 2 * S_GU;
constexpr int CV_TOTAL = DEPTH * CV_PER_L;
constexpr int CV_LAST = 1 << 30;
struct StripDesc { const float* src; bf16_t* dst; int lds_, ldd, k0, n0, drow0; };
__device__ __forceinline__ StripDesc strip_desc(const Params& p, int si) {
    unsigned char* ws = p.ws; StripDesc d;
    const int l = si / CV_PER_L; int r = si - l * CV_PER_L;
    if (r < S_IN) {
        const int kt = r / 66, ntl = r % 66;
        d.src = p.w_in + (size_t)l * D * INC; d.lds_ = INC; d.dst = (bf16_t*)(ws + WS_WIN) + (size_t)l * INC * D; d.ldd = D; d.k0 = kt * 128; d.n0 = ntl * 128; d.drow0 = ntl * 128;
    } else if (r < CV_A0) {
        r -= S_IN; const int kt = r / 16, ntl = r % 16;
        d.src = p.w_out + (size_t)l * D * D; d.lds_ = D; d.dst = (bf16_t*)(ws + WS_WOUT) + (size_t)l * D * D; d.ldd = D; d.k0 = kt * 128; d.n0 = ntl * 128; d.drow0 = ntl * 128;
    } else if (r < CV_A1) {
        r -= CV_A0; const int mat = r / S_GU, q = r % S_GU, kt = q / 11, ntl = q % 11;
        const int which = mat & 1, le = l * NE + (mat >> 1);
        d.src = (which ? p.w_up : p.w_gate) + (size_t)le * D * DE; d.lds_ = DE; d.dst = (bf16_t*)(ws + WS_WGU) + (size_t)le * (2 * DE) * D; d.ldd = D; d.k0 = kt * 128; d.n0 = ntl * 128; d.drow0 = ntl * 256 + which * 128;
    } else {
        r -= CV_A1; const int le = l * NE + r / S_DN, q = r % S_DN, kt = q / 16, ntl = q % 16;
        d.src = p.w_down + (size_t)le * DE * D; d.lds_ = D; d.dst = (bf16_t*)(ws + WS_WD) + (size_t)le * D * DE; d.ldd = DE; d.k0 = kt * 128; d.n0 = ntl * 128; d.drow0 = ntl * 128;
    }
    return d;
}
__device__ __forceinline__ void cvt_pull(const Params& p, LAS unsigned char* lds, int limit, unsigned* done_ctr, unsigned need_done) {
    int tid = threadIdx.x; asm volatile("" : "+v"(tid));
    LAS int* slot = (LAS int*)(lds + LDS_MISC + 512);
    unsigned* head = (unsigned*)(p.ws + WS_CVTQ);
    if (tid == 0) {
        int sv = -1;
        const bool stop = done_ctr ? (xb_ld(done_ctr) >= need_done) : (xb_ld(head) >= (unsigned)limit);
        if (!stop) { const unsigned c = xb_add(head, 1u); sv = c < (unsigned)CV_TOTAL ? (int)c : -1; }
        slot[0] = sv;
    }
    __syncthreads();
    const int kp = tid >> 4, n4 = (tid & 15) * 4;
    for (;;) {
        const int sraw = slot[0];
        if (sraw < 0) break;
        const int si = sraw & (CV_LAST - 1); const bool lastone = (sraw & CV_LAST) != 0;
        const StripDesc d = strip_desc(p, si);
        float4 a[2][2], b[2][2];
#pragma unroll
        for (int ki = 0; ki < 2; ++ki)
#pragma unroll
            for (int ni = 0; ni < 2; ++ni) {
                a[ki][ni] = *(const float4*)(d.src + (size_t)(d.k0 + ki * 64 + 2 * kp) * d.lds_ + d.n0 + ni * 64 + n4);
                b[ki][ni] = *(const float4*)(d.src + (size_t)(d.k0 + ki * 64 + 2 * kp + 1) * d.lds_ + d.n0 + ni * 64 + n4);
            }
        unsigned c = 0u, dn = 0u;
        if (tid == 0 && !lastone) { c = xb_add(head, 1u); if (done_ctr) dn = xb_ld(done_ctr); }
        LAS unsigned* tl = (LAS unsigned*)lds;
#pragma unroll
        for (int ki = 0; ki < 2; ++ki)
#pragma unroll
            for (int ni = 0; ni < 2; ++ni) {
                LAS unsigned* t = tl + (ki * 2 + ni) * 2112;
                t[(n4 + 0) * 33 + kp] = pack2(a[ki][ni].x, b[ki][ni].x);
                t[(n4 + 1) * 33 + kp] = pack2(a[ki][ni].y, b[ki][ni].y);
                t[(n4 + 2) * 33 + kp] = pack2(a[ki][ni].z, b[ki][ni].z);
                t[(n4 + 3) * 33 + kp] = pack2(a[ki][ni].w, b[ki][ni].w);
            }
        __syncthreads();
        const int n = tid >> 3, kc = (tid & 7) * 4;
#pragma unroll
        for (int ki = 0; ki < 2; ++ki)
#pragma unroll
            for (int ni = 0; ni < 2; ++ni) {
                const LAS unsigned* t = tl + (ki * 2 + ni) * 2112;
                u32x4 o; o[0] = t[n * 33 + kc]; o[1] = t[n * 33 + kc + 1]; o[2] = t[n * 33 + kc + 2]; o[3] = t[n * 33 + kc + 3];
                *(u32x4*)(d.dst + (size_t)(d.drow0 + ni * 64 + n) * d.ldd + d.k0 + ki * 64 + kc * 2) = o;
            }
        if (tid == 0) {
            int sv = -1;
            if (!lastone && c < (unsigned)CV_TOTAL) { const bool fin = done_ctr ? (dn >= need_done) : (c >= (unsigned)limit); sv = (int)c | (fin ? CV_LAST : 0); }
            slot[0] = sv;
        }
        __syncthreads();
    }
    __syncthreads();
}
__device__ __forceinline__ void tail_pull(const Params& p, LAS unsigned char* lds, int ctr_idx) {
    unsigned* ctr = (unsigned*)(p.ws + WS_CVTQ) + 64 * (1 + ctr_idx);
    __syncthreads();
    if (threadIdx.x == 0) (void)xb_add(ctr, 1u);
    cvt_pull(p, lds, 0, ctr, gridDim.x);
}

__device__ __forceinline__ void phase_prologue(const Params& p, LAS unsigned char* lds) {
    int tid = threadIdx.x; asm volatile("" : "+v"(tid));
    unsigned char* ws = p.ws;
    {
        LAS float* cond = (LAS float*)lds;
        LAS float* red = (LAS float*)(lds + 32768);
        for (int i = tid; i < 4 * D; i += 512) { const float v = p.c[i]; cond[i] = siluf_(v); }
        __syncthreads();
        for (int ch = blockIdx.x; ch < 256; ch += gridDim.x) {
            const int l = ch >> 7, j0 = (ch & 127) * 96;
            const float* w = p.w_ada + (size_t)l * D * (6 * D);
            const int kg = tid / 24, cl = tid % 24;
            float acc[4][4];
#pragma unroll
            for (int b = 0; b < 4; ++b)
#pragma unroll
                for (int j = 0; j < 4; ++j) acc[b][j] = 0.f;
            if (kg < 21) {
                for (int it0 = 0; it0 < 98; it0 += 7) {
                    float4 wv[7];
#pragma unroll
                    for (int q = 0; q < 7; ++q) { const int k = kg + 21 * (it0 + q); wv[q] = (k < D) ? *(const float4*)(w + (size_t)k * (6 * D) + j0 + cl * 4) : make_float4(0.f, 0.f, 0.f, 0.f); }
#pragma unroll
                    for (int q = 0; q < 7; ++q) { const int k = kg + 21 * (it0 + q); const int kc = k < D ? k : 0;
#pragma unroll
                        for (int b = 0; b < 4; ++b) { const float cv = cond[b * D + kc]; acc[b][0] += cv * wv[q].x; acc[b][1] += cv * wv[q].y; acc[b][2] += cv * wv[q].z; acc[b][3] += cv * wv[q].w; } }
                }
#pragma unroll
                for (int b = 0; b < 4; ++b)
#pragma unroll
                    for (int j = 0; j < 4; ++j) red[(kg * 4 + b) * 96 + cl * 4 + j] = acc[b][j];
            }
            __syncthreads();
            if (tid < 384) {
                const int b = tid / 96, col = tid % 96; float s = 0.f;
                for (int g = 0; g < 21; ++g) s += red[(g * 4 + b) * 96 + col];
                float* mod = (float*)(ws + WS_MOD);
                mod[((size_t)l * 4 + b) * (6 * D) + j0 + col] = s + p.b_ada[(size_t)l * 6 * D + j0 + col];
            }
            __syncthreads();
        }
    }
    cvt_pull(p, lds, CV_A0, nullptr, 0u);
}

__device__ __forceinline__ void ln_rows(float4 (&v)[8], const float* __restrict__ g, const float* __restrict__ b, int lane) {
    float s = 0.f;
#pragma unroll
    for (int i = 0; i < 8; ++i) s += (v[i].x + v[i].y) + (v[i].z + v[i].w);
    const float mean = wave_sum(s) * (1.0f / D);
    float q = 0.f;
#pragma unroll
    for (int i = 0; i < 8; ++i) { const float a = v[i].x - mean, bb = v[i].y - mean, c = v[i].z - mean, d = v[i].w - mean; q += (a * a + bb * bb) + (c * c + d * d); }
    const float rstd = rsqrtf(wave_sum(q) * (1.0f / D) + 1e-5f);
#pragma unroll
    for (int i = 0; i < 8; ++i) {
        const float4 gv = *(const float4*)(g + i * 256 + lane * 4), bv = *(const float4*)(b + i * 256 + lane * 4);
        v[i].x = (v[i].x - mean) * rstd * gv.x + bv.x; v[i].y = (v[i].y - mean) * rstd * gv.y + bv.y;
        v[i].z = (v[i].z - mean) * rstd * gv.z + bv.z; v[i].w = (v[i].w - mean) * rstd * gv.w + bv.w;
    }
}
__device__ __forceinline__ void modulate_store(const float4 (&v)[8], const float* __restrict__ shift, const float* __restrict__ scale, bf16_t* __restrict__ dst, int lane) {
#pragma unroll
    for (int i = 0; i < 8; ++i) {
        const float4 sh = *(const float4*)(shift + i * 256 + lane * 4), sc = *(const float4*)(scale + i * 256 + lane * 4);
        u32x2 o; o[0] = pack2(v[i].x * (1.f + sc.x) + sh.x, v[i].y * (1.f + sc.y) + sh.y); o[1] = pack2(v[i].z * (1.f + sc.z) + sh.z, v[i].w * (1.f + sc.w) + sh.w);
        *(u32x2*)(dst + i * 256 + lane * 4) = o;
    }
}

__device__ __forceinline__ void phase_ln0(const Params& p) {
    int tid_ = threadIdx.x; asm volatile("" : "+v"(tid_)); const int wave = tid_ >> 6, lane = tid_ & 63;
    const float* mod = (const float*)(p.ws + WS_MOD);
    for (int n = blockIdx.x * 8 + wave; n < T; n += gridDim.x * 8) {
        const int b = n / SEQ;
        float4 v[8];
#pragma unroll
        for (int i = 0; i < 8; ++i) v[i] = *(const float4*)(p.x + (size_t)n * D + i * 256 + lane * 4);
        ln_rows(v, p.emb_g, p.emb_b, lane);
        float* xr = (float*)(p.ws + WS_XRES) + (size_t)n * D;
#pragma unroll
        for (int i = 0; i < 8; ++i) *(float4*)(xr + i * 256 + lane * 4) = v[i];
        const float* mb = mod + ((size_t)0 * 4 + b) * (6 * D);
        modulate_store(v, mb, mb + D, (bf16_t*)(p.ws + WS_HA) + (size_t)n * D, lane);
    }
}

__device__ __forceinline__ void phase_mixer_valu(const Params& p, int l, LAS unsigned char* lds) {
    LAS float* qs = (LAS float*)lds; LAS float* ks = qs + 4096; LAS float* fs = ks + 4096; LAS float* vs = fs + 4096; LAS float* po = vs + 1024;
    int tid = threadIdx.x; asm volatile("" : "+v"(tid)); const int wave = tid >> 6, lane = tid & 63, kk = tid >> 5, vv = tid & 31;
    const bf16_t* proj = (const bf16_t*)(p.ws + WS_PROJ);
    float* obuf = (float*)(p.ws + WS_OBUF);
    for (int u = blockIdx.x; u < 384; u += gridDim.x) {
        const int vsl = u & 3, dir = (u >> 2) & 1, hh = (u >> 3) % 6, b = ((u >> 3) / 6) % 4, type = (u >> 3) / 24;
        float S[8];
#pragma unroll
        for (int j = 0; j < 8; ++j) S[j] = 0.f;
        const float gamma = 1.0f - exp2f(-(dir ? 5.5f : 5.0f) - (float)hh);
        for (int blk = 0; blk < 64; ++blk) {
            const int rb = dir ? 63 - blk : blk, t0 = rb * 32;
            if (type == 0) {
#pragma unroll
                for (int j = 0; j < 4; ++j) {
                    const int idx = tid + 512 * j, tt = idx >> 6, dp = idx & 63;
                    const bf16_t* row = proj + (size_t)(b * SEQ + t0 + tt) * INC;
                    const float q1 = bf2f(row[C_RQ + hh * 128 + dp]), q2 = bf2f(row[C_RQ + hh * 128 + 64 + dp]);
                    const float k1 = bf2f(row[C_RK + hh * 128 + dp]), k2 = bf2f(row[C_RK + hh * 128 + 64 + dp]);
                    const float inv_freq = exp2f(-(float)dp * (13.287712379549449f / 64.0f));
                    const float ang = (float)(t0 + tt) * inv_freq;
                    float rev = ang * 0.15915494309189535f; rev -= rintf(rev);
                    const float sn = __builtin_amdgcn_sinf(rev), cs = __builtin_amdgcn_cosf(rev);
                    qs[tt * 128 + dp] = q1 * cs - q2 * sn; qs[tt * 128 + 64 + dp] = q1 * sn + q2 * cs;
                    ks[tt * 128 + dp] = (k1 * cs - k2 * sn) * 0.08838834764831845f; ks[tt * 128 + 64 + dp] = (k1 * sn + k2 * cs) * 0.08838834764831845f;
                    fs[tt * 128 + dp] = gamma; fs[tt * 128 + 64 + dp] = gamma;
                }
            } else {
#pragma unroll
                for (int j = 0; j < 8; ++j) {
                    const int idx = tid + 512 * j, tt = idx >> 7, d = idx & 127;
                    const bf16_t* row = proj + (size_t)(b * SEQ + t0 + tt) * INC;
                    const float q = bf2f(row[C_HQ + hh * 128 + d]);
                    const float z = bf2f(row[(dir ? C_HFB : C_HFF) + hh * 128 + d]);
                    float lb = 0.f;
                    if (l > 0) { const float a0 = p.lb_logits[(0 * 2 + dir) * HWD + hh * 128 + d], a1 = p.lb_logits[(1 * 2 + dir) * HWD + hh * 128 + d]; lb = 1.0f / (1.0f + expf(a0 - a1)); }
                    float f = lb + (1.0f - lb) * (1.0f / (1.0f + expf(-z)));
                    f = fmaxf(f, 1e-6f);
                    qs[tt * 128 + d] = q; ks[tt * 128 + d] = 1.0f - f; fs[tt * 128 + d] = f;
                }
            }
#pragma unroll
            for (int j = 0; j < 2; ++j) {
                const int idx = tid + 512 * j, tt = idx >> 5, c = idx & 31;
                const bf16_t* row = proj + (size_t)(b * SEQ + t0 + tt) * INC;
                vs[tt * 32 + c] = bf2f(row[(type ? C_HI : C_RV) + hh * 128 + vsl * 32 + c]);
            }
            __syncthreads();
            for (int s = 0; s < 32; ++s) {
                const int ss = dir ? 31 - s : s;
                const f32x4 qa = *(const LAS f32x4*)(qs + ss * 128 + kk * 8), qb = *(const LAS f32x4*)(qs + ss * 128 + kk * 8 + 4);
                const f32x4 ka = *(const LAS f32x4*)(ks + ss * 128 + kk * 8), kb = *(const LAS f32x4*)(ks + ss * 128 + kk * 8 + 4);
                const f32x4 fa = *(const LAS f32x4*)(fs + ss * 128 + kk * 8), fb = *(const LAS f32x4*)(fs + ss * 128 + kk * 8 + 4);
                const float vval = vs[ss * 32 + vv];
                float acc = 0.f;
#pragma unroll
                for (int j = 0; j < 4; ++j) { S[j] = fa[j] * S[j] + ka[j] * vval; acc += S[j] * qa[j]; }
#pragma unroll
                for (int j = 0; j < 4; ++j) { S[4 + j] = fb[j] * S[4 + j] + kb[j] * vval; acc += S[4 + j] * qb[j]; }
                acc += __shfl_xor(acc, 32, 64);
                if (lane < 32) po[(ss * 8 + wave) * 32 + vv] = acc;
            }
            __syncthreads();
#pragma unroll
            for (int j = 0; j < 2; ++j) {
                const int idx = tid + 512 * j, tt = idx >> 5, c = idx & 31;
                float s = 0.f;
#pragma unroll
                for (int w = 0; w < 8; ++w) s += po[(tt * 8 + w) * 32 + c];
                obuf[((size_t)dir * T + (size_t)(b * SEQ + t0 + tt)) * 1536 + type * 768 + hh * 128 + vsl * 32 + c] = s;
            }
        }
        __syncthreads();
    }
}

constexpr int MX_QI = 0, MX_KI = 17408, MX_QS = 34816, MX_KTT = 52224, MX_VT = 70656, MX_P = 79872, MX_ST = 89088, MX_TOT = 106496, MX_DEC = 110592;
__device__ __forceinline__ float ex2(float x) { return __builtin_amdgcn_exp2f(x); }
__device__ __forceinline__ float clampe(float x) { return fminf(fmaxf(x, -120.f), 120.f); }
__device__ __forceinline__ void phase_mixer_mfma(const Params& p, int l, LAS unsigned char* lds, float* __restrict__ obuf) {
    int tid = threadIdx.x; asm volatile("" : "+v"(tid));
    const int wave = __builtin_amdgcn_readfirstlane(tid >> 6), lane = tid & 63, fr = lane & 15, fq = lane >> 4;
    const bf16_t* proj = (const bf16_t*)(p.ws + WS_PROJ);
    for (int u = blockIdx.x; u < 192; u += gridDim.x) {
        const int vsl = u & 1, dir = (u >> 1) & 1, hh = (u >> 2) % 6, b = ((u >> 2) / 6) % 4, type = (u >> 2) / 24;
        float lg2 = 0.f, invf0 = 0.f, invf1 = 0.f, sgn = 1.f, lb0 = 0.f, lb1 = 0.f;
        if (type == 0) {
            const float gamma = 1.0f - exp2f(-(dir ? 5.5f : 5.0f) - (float)hh);
            lg2 = log2f(gamma);
            const int dm0 = (2 * lane) & 63;
            invf0 = exp2f(-(float)dm0 * (13.287712379549449f / 64.0f)); invf1 = exp2f(-(float)(dm0 + 1) * (13.287712379549449f / 64.0f));
            sgn = lane < 32 ? -1.f : 1.f;
        } else if (l > 0) {
            const float* lbl = p.lb_logits + dir * HWD + hh * 128 + 2 * lane;
            lb0 = 1.0f / (1.0f + expf(lbl[0] - lbl[2 * HWD])); lb1 = 1.0f / (1.0f + expf(lbl[1] - lbl[2 * HWD + 1]));
        }
        const int colA = (type ? C_HQ : C_RQ) + hh * 128, colB = (type ? (dir ? C_HFB : C_HFF) : C_RK) + hh * 128;
        const int colV = (type ? C_HI : C_RV) + hh * 128 + vsl * 64 + lane;
        const int own = 2 * lane, par = (2 * lane + 64) & 127;
        const size_t ocol = (size_t)type * 768 + hh * 128 + vsl * 64;
        unsigned ra[8], rb[8], rc[8], rd[8]; unsigned short rv[8];
#define MX_LOAD(ch) do { _Pragma("unroll") for (int j = 0; j < 8; ++j) { const int tau = (ch) * 64 + wave * 8 + j; const int t = dir ? (SEQ - 1 - tau) : tau; \
            const bf16_t* row = proj + (size_t)(b * SEQ + t) * INC; \
            ra[j] = *(const unsigned*)(row + colA + own); rb[j] = *(const unsigned*)(row + colB + own); \
            if (type == 0) { rc[j] = *(const unsigned*)(row + colA + par); rd[j] = *(const unsigned*)(row + colB + par); } else { rc[j] = 0u; rd[j] = 0u; } \
            rv[j] = row[colV]; } } while (0)
        f32x4 Sacc[4];
#pragma unroll
        for (int vt = 0; vt < 4; ++vt) Sacc[vt] = (f32x4){0.f, 0.f, 0.f, 0.f};
        for (int i = tid; i < 64 * 272 / 4; i += 512) ((LAS unsigned*)(lds + MX_ST))[i] = 0u;
        float cd0 = 1.f, sd0 = 0.f, cd1 = 1.f, sd1 = 0.f;
        if (type == 0) {
            if (tid < 64) { const float fi = (float)tid; *(LAS f32x4*)(lds + MX_DEC + 512 + tid * 16) = (f32x4){ex2((fi - 31.f) * lg2), ex2((31.f - fi) * lg2), ex2((fi + 1.f) * lg2), ex2((63.f - fi) * lg2)}; }
            const float r0 = invf0 * 0.15915494309189535f, r1 = invf1 * 0.15915494309189535f, sg = dir ? -1.f : 1.f;
            cd0 = __builtin_amdgcn_cosf(r0); sd0 = sg * __builtin_amdgcn_sinf(r0); cd1 = __builtin_amdgcn_cosf(r1); sd1 = sg * __builtin_amdgcn_sinf(r1);
        }
        MX_LOAD(0);
        __syncthreads();
        for (int ch = 0; ch < 32; ++ch) {
            float q0[8], q1[8], k0[8], k1[8], c0[8], c1[8];
            float run0 = 0.f, run1 = 0.f;
            if (type == 0) {
                const int tau0 = ch * 64 + wave * 8; const int t0 = dir ? (SEQ - 1 - tau0) : tau0;
                float rev0 = (float)t0 * invf0 * 0.15915494309189535f, rev1 = (float)t0 * invf1 * 0.15915494309189535f;
                rev0 -= rintf(rev0); rev1 -= rintf(rev1);
                float sn0 = __builtin_amdgcn_sinf(rev0), cs0 = __builtin_amdgcn_cosf(rev0), sn1 = __builtin_amdgcn_sinf(rev1), cs1 = __builtin_amdgcn_cosf(rev1);
#pragma unroll
                for (int j = 0; j < 8; ++j) {
                    const float a_lo = bf2f(ra[j] & 0xffffu), a_hi = bf2f(ra[j] >> 16), b_lo = bf2f(rb[j] & 0xffffu), b_hi = bf2f(rb[j] >> 16);
                    const float pa_lo = bf2f(rc[j] & 0xffffu), pa_hi = bf2f(rc[j] >> 16), pb_lo = bf2f(rd[j] & 0xffffu), pb_hi = bf2f(rd[j] >> 16);
                    const float ss0 = sgn * sn0, ss1 = sgn * sn1;
                    q0[j] = a_lo * cs0 + pa_lo * ss0; q1[j] = a_hi * cs1 + pa_hi * ss1;
                    k0[j] = (b_lo * cs0 + pb_lo * ss0) * 0.08838834764831845f; k1[j] = (b_hi * cs1 + pb_hi * ss1) * 0.08838834764831845f;
                    const float nc0 = cs0 * cd0 - sn0 * sd0, ns0 = sn0 * cd0 + cs0 * sd0, nc1 = cs1 * cd1 - sn1 * sd1, ns1 = sn1 * cd1 + cs1 * sd1;
                    cs0 = nc0; sn0 = ns0; cs1 = nc1; sn1 = ns1;
                    c0[j] = 0.f; c1[j] = 0.f;
                }
            } else {
#pragma unroll
                for (int j = 0; j < 8; ++j) {
                    const float a_lo = bf2f(ra[j] & 0xffffu), a_hi = bf2f(ra[j] >> 16), b_lo = bf2f(rb[j] & 0xffffu), b_hi = bf2f(rb[j] >> 16);
                    q0[j] = a_lo; q1[j] = a_hi;
                    float f0 = lb0 + (1.0f - lb0) * __builtin_amdgcn_rcpf(1.0f + ex2(-b_lo * 1.4426950408889634f));
                    float f1 = lb1 + (1.0f - lb1) * __builtin_amdgcn_rcpf(1.0f + ex2(-b_hi * 1.4426950408889634f));
                    f0 = fmaxf(f0, 1e-6f); f1 = fmaxf(f1, 1e-6f);
                    k0[j] = 1.0f - f0; k1[j] = 1.0f - f1;
                    run0 += __builtin_amdgcn_logf(f0); run1 += __builtin_amdgcn_logf(f1); c0[j] = run0; c1[j] = run1;
                }
            }
            u32x4 vpk;
            vpk[0] = (unsigned)rv[0] | ((unsigned)rv[1] << 16); vpk[1] = (unsigned)rv[2] | ((unsigned)rv[3] << 16);
            vpk[2] = (unsigned)rv[4] | ((unsigned)rv[5] << 16); vpk[3] = (unsigned)rv[6] | ((unsigned)rv[7] << 16);
            { typedef float f32x2_ __attribute__((ext_vector_type(2))); *(LAS f32x2_*)(lds + MX_TOT + (wave * 128 + 2 * lane) * 4) = (f32x2_){run0, run1}; }
            __syncthreads();
            float kt0[8], kt1[8];
            float tt0, tt1;
            if (type == 0) {
                tt0 = tt1 = 64.f * lg2;
#pragma unroll
                for (int j = 0; j < 8; ++j) {
                    const int pos = wave * 8 + j;
                    const f32x4 e = *(const LAS f32x4*)(lds + MX_DEC + 512 + pos * 16);
                    *(LAS unsigned*)(lds + MX_QI + pos * 272 + lane * 4) = pack2(q0[j] * e[0], q1[j] * e[0]);
                    *(LAS unsigned*)(lds + MX_KI + pos * 272 + lane * 4) = pack2(k0[j] * e[1], k1[j] * e[1]);
                    *(LAS unsigned*)(lds + MX_QS + pos * 272 + lane * 4) = pack2(q0[j] * e[2], q1[j] * e[2]);
                    kt0[j] = k0[j] * e[3]; kt1[j] = k1[j] * e[3];
                }
            } else {
                float off0 = 0.f, off1 = 0.f, m0 = 0.f, m1 = 0.f; tt0 = 0.f; tt1 = 0.f;
#pragma unroll
                for (int g = 0; g < 8; ++g) {
                    typedef float f32x2_ __attribute__((ext_vector_type(2)));
                    const f32x2_ tv = *(const LAS f32x2_*)(lds + MX_TOT + (g * 128 + 2 * lane) * 4);
                    if (g < wave) { off0 += tv[0]; off1 += tv[1]; }
                    if (g < 4) { m0 += tv[0]; m1 += tv[1]; }
                    tt0 += tv[0]; tt1 += tv[1];
                }
                const float em0 = ex2(m0), em1 = ex2(m1), etm0 = ex2(tt0 - m0), etm1 = ex2(tt1 - m1);
#pragma unroll
                for (int j = 0; j < 8; ++j) {
                    const float cu0 = c0[j] + off0, cu1 = c1[j] + off1;
                    const float e10 = ex2(clampe(cu0 - m0)), e11 = ex2(clampe(cu1 - m1));
                    const float e20 = __builtin_amdgcn_rcpf(e10), e21 = __builtin_amdgcn_rcpf(e11);
                    const int pos = wave * 8 + j;
                    *(LAS unsigned*)(lds + MX_QI + pos * 272 + lane * 4) = pack2(q0[j] * e10, q1[j] * e11);
                    *(LAS unsigned*)(lds + MX_KI + pos * 272 + lane * 4) = pack2(k0[j] * e20, k1[j] * e21);
                    *(LAS unsigned*)(lds + MX_QS + pos * 272 + lane * 4) = pack2(q0[j] * (e10 * em0), q1[j] * (e11 * em1));
                    kt0[j] = k0[j] * (e20 * etm0); kt1[j] = k1[j] * (e21 * etm1);
                }
            }
            { u32x4 w0, w1;
              w0[0] = pack2(kt0[0], kt0[1]); w0[1] = pack2(kt0[2], kt0[3]); w0[2] = pack2(kt0[4], kt0[5]); w0[3] = pack2(kt0[6], kt0[7]);
              w1[0] = pack2(kt1[0], kt1[1]); w1[1] = pack2(kt1[2], kt1[3]); w1[2] = pack2(kt1[4], kt1[5]); w1[3] = pack2(kt1[6], kt1[7]);
              *(LAS u32x4*)(lds + MX_KTT + (2 * lane) * 144 + wave * 16) = w0;
              *(LAS u32x4*)(lds + MX_KTT + (2 * lane + 1) * 144 + wave * 16) = w1;
              *(LAS u32x4*)(lds + MX_VT + lane * 144 + wave * 16) = vpk; }
            if (wave == 0) { typedef float f32x2_ __attribute__((ext_vector_type(2))); *(LAS f32x2_*)(lds + MX_DEC + lane * 8) = (f32x2_){ex2(tt0), ex2(tt1)}; }
            __syncthreads();
            if (ch + 1 < 32) MX_LOAD(ch + 1);
            {
                const int it = wave >> 1;
#pragma unroll
                for (int h2 = 0; h2 < 2; ++h2) {
                    const int st = 2 * (wave & 1) + h2;
                    f32x4 acc = (f32x4){0.f, 0.f, 0.f, 0.f};
                    if (st <= it) {
#pragma unroll
                        for (int kq = 0; kq < 4; ++kq) {
                            const bf16x8 af = *(const LAS bf16x8*)(lds + MX_KI + (16 * st + fr) * 272 + (32 * kq + 8 * fq) * 2);
                            const bf16x8 bfg = *(const LAS bf16x8*)(lds + MX_QI + (16 * it + fr) * 272 + (32 * kq + 8 * fq) * 2);
                            acc = __builtin_amdgcn_mfma_f32_16x16x32_bf16(af, bfg, acc, 0, 0, 0);
                        }
                    }
                    const int i = 16 * it + fr, s0 = 16 * st + 4 * fq;
                    const float v0 = (s0 + 0 <= i) ? acc[0] : 0.f, v1 = (s0 + 1 <= i) ? acc[1] : 0.f, v2 = (s0 + 2 <= i) ? acc[2] : 0.f, v3 = (s0 + 3 <= i) ? acc[3] : 0.f;
                    u32x2 o; o[0] = pack2(v0, v1); o[1] = pack2(v2, v3);
                    *(LAS u32x2*)(lds + MX_P + i * 144 + s0 * 2) = o;
                }
            }
            __syncthreads();
            {
                const int vt = wave >> 1;
#pragma unroll
                for (int h2 = 0; h2 < 2; ++h2) {
                    const int it = 2 * (wave & 1) + h2;
                    f32x4 acc = (f32x4){0.f, 0.f, 0.f, 0.f};
#pragma unroll
                    for (int kq = 0; kq < 2; ++kq) {
                        const bf16x8 af = *(const LAS bf16x8*)(lds + MX_VT + (16 * vt + fr) * 144 + (32 * kq + 8 * fq) * 2);
                        const bf16x8 bfg = *(const LAS bf16x8*)(lds + MX_P + (16 * it + fr) * 144 + (32 * kq + 8 * fq) * 2);
                        acc = __builtin_amdgcn_mfma_f32_16x16x32_bf16(af, bfg, acc, 0, 0, 0);
                    }
#pragma unroll
                    for (int kq = 0; kq < 4; ++kq) {
                        const bf16x8 af = *(const LAS bf16x8*)(lds + MX_ST + (16 * vt + fr) * 272 + (32 * kq + 8 * fq) * 2);
                        const bf16x8 bfg = *(const LAS bf16x8*)(lds + MX_QS + (16 * it + fr) * 272 + (32 * kq + 8 * fq) * 2);
                        acc = __builtin_amdgcn_mfma_f32_16x16x32_bf16(af, bfg, acc, 0, 0, 0);
                    }
                    const int tau = ch * 64 + 16 * it + fr; const int t = dir ? (SEQ - 1 - tau) : tau;
                    *(f32x4*)(obuf + ((size_t)dir * T + (size_t)(b * SEQ + t)) * 1536 + ocol + 16 * vt + 4 * fq) = acc;
                }
            }
            {
                const f32x4 dc = *(const LAS f32x4*)(lds + MX_DEC + (16 * wave + 4 * fq) * 4);
                bf16x8 af[2];
#pragma unroll
                for (int kq = 0; kq < 2; ++kq) af[kq] = *(const LAS bf16x8*)(lds + MX_KTT + (16 * wave + fr) * 144 + (32 * kq + 8 * fq) * 2);
#pragma unroll
                for (int vt = 0; vt < 4; ++vt) {
                    f32x4 a = Sacc[vt]; a[0] *= dc[0]; a[1] *= dc[1]; a[2] *= dc[2]; a[3] *= dc[3];
#pragma unroll
                    for (int kq = 0; kq < 2; ++kq) {
                        const bf16x8 bfg = *(const LAS bf16x8*)(lds + MX_VT + (16 * vt + fr) * 144 + (32 * kq + 8 * fq) * 2);
                        a = __builtin_amdgcn_mfma_f32_16x16x32_bf16(af[kq], bfg, a, 0, 0, 0);
                    }
                    Sacc[vt] = a;
                }
            }
            __syncthreads();
#pragma unroll
            for (int vt = 0; vt < 4; ++vt) { u32x2 o; o[0] = pack2(Sacc[vt][0], Sacc[vt][1]); o[1] = pack2(Sacc[vt][2], Sacc[vt][3]);
                *(LAS u32x2*)(lds + MX_ST + (16 * vt + fr) * 272 + (16 * wave + 4 * fq) * 2) = o; }
        }
        __syncthreads();
#undef MX_LOAD
    }
}

#ifdef MIXER_CHECK
__device__ __forceinline__ void phase_mixer_check(const Params& p, const float* __restrict__ oa, const float* __restrict__ ob, float* chk) {
    int tid_ = threadIdx.x; asm volatile("" : "+v"(tid_)); const int wave = tid_ >> 6, lane = tid_ & 63;
    for (int r = blockIdx.x * 8 + wave; r < 2 * T; r += gridDim.x * 8) {
        const int dir = r / T;
#pragma unroll
        for (int ty = 0; ty < 2; ++ty) {
            float sd = 0.f, sq = 0.f;
#pragma unroll
            for (int i = 0; i < 3; ++i) { const float4 a = *(const float4*)(oa + (size_t)r * 1536 + ty * 768 + i * 256 + lane * 4), bq = *(const float4*)(ob + (size_t)r * 1536 + ty * 768 + i * 256 + lane * 4);
                sd += (a.x - bq.x) * (a.x - bq.x) + (a.y - bq.y) * (a.y - bq.y) + (a.z - bq.z) * (a.z - bq.z) + (a.w - bq.w) * (a.w - bq.w);
                sq += a.x * a.x + a.y * a.y + a.z * a.z + a.w * a.w; }
            sd = wave_sum(sd); sq = wave_sum(sq);
            if (lane == 0) { atomicAdd(&chk[(ty * 2 + dir) * 2 + 0], sd); atomicAdd(&chk[(ty * 2 + dir) * 2 + 1], sq); }
        }
    }
}
#endif

__device__ __forceinline__ float4 ld_bf4(const bf16_t* p) { const u32x2 r = *(const u32x2*)p; return make_float4(bf2f(r[0] & 0xffffu), bf2f(r[0] >> 16), bf2f(r[1] & 0xffffu), bf2f(r[1] >> 16)); }
__device__ __forceinline__ void phase_finalize(const Params& p, int l) {
    int tid_ = threadIdx.x; asm volatile("" : "+v"(tid_)); const int wave = tid_ >> 6, lane = tid_ & 63;
    const bf16_t* proj = (const bf16_t*)(p.ws + WS_PROJ);
    const float* obuf = (const float*)(p.ws + WS_OBUF);
    bf16_t* mixed = (bf16_t*)(p.ws + WS_MIXED);
    const float* cw = p.conv_w + (size_t)l * 3 * CW;
    const float* beta = p.mix_beta + (size_t)l * D;
    for (int n = blockIdx.x * 8 + wave; n < T; n += gridDim.x * 8) {
        const int t = n % SEQ;
        const bf16_t* row = proj + (size_t)n * INC;
        bf16_t* dst = mixed + (size_t)n * D;
#pragma unroll
        for (int i = 0; i < 8; ++i) {
            const int c = i * 256 + lane * 4;
            float4 r;
            if (i < 2) {
                const float4 cc = ld_bf4(row + C_CC + c), ch = ld_bf4(row + C_CH + c), cb = ld_bf4(row + C_CB + c);
                float4 um = make_float4(0.f, 0.f, 0.f, 0.f), up = um;
                if (t > 0) { const float4 a = ld_bf4(row - INC + C_CC + c), b2 = ld_bf4(row - INC + C_CH + c); um = make_float4(a.x * b2.x, a.y * b2.y, a.z * b2.z, a.w * b2.w); }
                if (t < SEQ - 1) { const float4 a = ld_bf4(row + INC + C_CC + c), b2 = ld_bf4(row + INC + C_CH + c); up = make_float4(a.x * b2.x, a.y * b2.y, a.z * b2.z, a.w * b2.w); }
                const float4 w0 = *(const float4*)(cw + c), w1 = *(const float4*)(cw + CW + c), w2 = *(const float4*)(cw + 2 * CW + c);
                r.x = cb.x * (um.x * w0.x + cc.x * ch.x * w1.x + up.x * w2.x);
                r.y = cb.y * (um.y * w0.y + cc.y * ch.y * w1.y + up.y * w2.y);
                r.z = cb.z * (um.z * w0.z + cc.z * ch.z * w1.z + up.z * w2.z);
                r.w = cb.w * (um.w * w0.w + cc.w * ch.w * w1.w + up.w * w2.w);
            } else {
                const int oc = c - 512;
                const float4 of = *(const float4*)(obuf + (size_t)n * 1536 + oc), ob = *(const float4*)(obuf + ((size_t)T + n) * 1536 + oc);
                float4 o = make_float4(of.x + ob.x, of.y + ob.y, of.z + ob.z, of.w + ob.w);
                float4 gt;
                if (i < 5) {
                    gt = ld_bf4(row + C_RG + oc);
                    const float mu = half_sum((o.x + o.y) + (o.z + o.w)) * (1.0f / 128.0f);
                    o.x -= mu; o.y -= mu; o.z -= mu; o.w -= mu;
                    const float var = half_sum((o.x * o.x + o.y * o.y) + (o.z * o.z + o.w * o.w)) * (1.0f / 128.0f);
                    const float rs = rsqrtf(var + 1e-6f);
                    o.x *= rs; o.y *= rs; o.z *= rs; o.w *= rs;
                } else {
                    gt = ld_bf4(row + C_HG + (oc - 768));
                    const float ms = half_sum((o.x * o.x + o.y * o.y) + (o.z * o.z + o.w * o.w)) * (1.0f / 128.0f);
                    const float rs = rsqrtf(ms + 1e-6f);
                    o.x *= rs; o.y *= rs; o.z *= rs; o.w *= rs;
                }
                r.x = o.x * siluf_(gt.x); r.y = o.y * siluf_(gt.y); r.z = o.z * siluf_(gt.z); r.w = o.w * siluf_(gt.w);
            }
            const float4 bt = *(const float4*)(beta + c);
            u32x2 ov; ov[0] = pack2(r.x * bt.x, r.y * bt.y); ov[1] = pack2(r.z * bt.z, r.w * bt.w);
            *(u32x2*)(dst + c) = ov;
        }
    }
}

__device__ __forceinline__ void phase_ln1_router(const Params& p, int l, LAS unsigned char* lds) {
    int tid = threadIdx.x; asm volatile("" : "+v"(tid)); const int wave = tid >> 6, lane = tid & 63;
    LAS float* wrt = (LAS float*)lds;
    for (int i = tid; i < D * NE / 4; i += 512) {
        const float4 w = *(const float4*)(p.w_router + (size_t)i * 4);
        const int d = i >> 2, e4 = (i & 3) * 4;
        wrt[(e4 + 0) * D + d] = w.x; wrt[(e4 + 1) * D + d] = w.y; wrt[(e4 + 2) * D + d] = w.z; wrt[(e4 + 3) * D + d] = w.w;
    }
    LAS int* lcnt = (LAS int*)(lds + LDS_MISC + 256);
    if (tid < 16) lcnt[tid] = 0;
    __syncthreads();
    const float* mod = (const float*)(p.ws + WS_MOD);
    const float* y = (const float*)(p.ws + WS_Y);
    float* xres = (float*)(p.ws + WS_XRES);
    int* route = (int*)(p.ws + WS_ROUTE);
    for (int n = blockIdx.x * 8 + wave; n < T; n += gridDim.x * 8) {
        const int b = n / SEQ;
        const float* mb = mod + ((size_t)l * 4 + b) * (6 * D);
        float4 v[8];
#pragma unroll
        for (int i = 0; i < 8; ++i) {
            const float4 xv = *(const float4*)(xres + (size_t)n * D + i * 256 + lane * 4), yv = *(const float4*)(y + (size_t)n * D + i * 256 + lane * 4);
            const float4 g = *(const float4*)(mb + 2 * D + i * 256 + lane * 4);
            v[i].x = ALPHA * xv.x + (1.f + g.x) * yv.x; v[i].y = ALPHA * xv.y + (1.f + g.y) * yv.y; v[i].z = ALPHA * xv.z + (1.f + g.z) * yv.z; v[i].w = ALPHA * xv.w + (1.f + g.w) * yv.w;
        }
        ln_rows(v, p.ln_g + (size_t)(l * 2 + 0) * D, p.ln_b + (size_t)(l * 2 + 0) * D, lane);
#pragma unroll
        for (int i = 0; i < 8; ++i) *(float4*)(xres + (size_t)n * D + i * 256 + lane * 4) = v[i];
#pragma unroll
        for (int i = 0; i < 8; ++i) {
            const float4 sh = *(const float4*)(mb + 3 * D + i * 256 + lane * 4), sc = *(const float4*)(mb + 4 * D + i * 256 + lane * 4);
            v[i].x = v[i].x * (1.f + sc.x) + sh.x; v[i].y = v[i].y * (1.f + sc.y) + sh.y; v[i].z = v[i].z * (1.f + sc.z) + sh.z; v[i].w = v[i].w * (1.f + sc.w) + sh.w;
        }
        bf16_t* hb = (bf16_t*)(p.ws + WS_HB) + (size_t)n * D;
#pragma unroll
        for (int i = 0; i < 8; ++i) { u32x2 o; o[0] = pack2(v[i].x, v[i].y); o[1] = pack2(v[i].z, v[i].w); *(u32x2*)(hb + i * 256 + lane * 4) = o; }
        float lgv = 0.f;
#pragma unroll 1
        for (int e = 0; e < 16; ++e) {
            float s = 0.f;
#pragma unroll
            for (int i = 0; i < 8; ++i) { const f32x4 w = *(const LAS f32x4*)(wrt + e * D + i * 256 + lane * 4); s += (v[i].x * w[0] + v[i].y * w[1]) + (v[i].z * w[2] + v[i].w * w[3]); }
            s = wave_sum(s);
            lgv = (lane == e) ? s : lgv;
        }
        float lg[16];
#pragma unroll
        for (int e = 0; e < 16; ++e) lg[e] = __int_as_float(__builtin_amdgcn_readlane(__float_as_int(lgv), e));
        float mx = lg[0];
#pragma unroll
        for (int e = 1; e < 16; ++e) mx = fmaxf(mx, lg[e]);
        float sc[16], sum = 0.f;
#pragma unroll
        for (int e = 0; e < 16; ++e) { sc[e] = expf(lg[e] - mx); sum += sc[e]; }
        const float inv = 1.0f / sum;
        float sel[16];
#pragma unroll
        for (int e = 0; e < 16; ++e) { sc[e] *= inv; sel[e] = sc[e] + p.router_bias[e]; }
        float best_gs = -3.0e38f; int bi0 = 0, bi1 = 1; float bw0 = 0.f, bw1 = 0.f;
#pragma unroll
        for (int g = 0; g < 4; ++g) {
            int i0 = 0; float m0 = sel[4 * g];
#pragma unroll
            for (int j = 1; j < 4; ++j) if (sel[4 * g + j] > m0) { m0 = sel[4 * g + j]; i0 = j; }
            int i1 = -1; float m1 = -3.0e38f;
#pragma unroll
            for (int j = 0; j < 4; ++j) if (j != i0 && sel[4 * g + j] > m1) { m1 = sel[4 * g + j]; i1 = j; }
            float w0 = 0.f, w1 = 0.f;
#pragma unroll
            for (int j = 0; j < 4; ++j) { w0 = (j == i0) ? sc[4 * g + j] : w0; w1 = (j == i1) ? sc[4 * g + j] : w1; }
            const float gs = m0 + m1;
            if (gs > best_gs) { best_gs = gs; bi0 = 4 * g + i0; bi1 = 4 * g + i1; bw0 = w0; bw1 = w1; }
        }
        if (lane == 0) {
            const float ws_ = 1.0f / (bw0 + bw1);
            const int p0 = __hip_atomic_fetch_add(&lcnt[bi0], 1, __ATOMIC_RELAXED, __HIP_MEMORY_SCOPE_WORKGROUP), p1 = __hip_atomic_fetch_add(&lcnt[bi1], 1, __ATOMIC_RELAXED, __HIP_MEMORY_SCOPE_WORKGROUP);
            int* r = route + (size_t)n * 8;
            r[0] = bi0; r[1] = bi1; r[2] = (int)p0; r[3] = (int)p1; r[4] = __float_as_int(bw0 * ws_); r[5] = __float_as_int(bw1 * ws_);
        }
    }
    __syncthreads();
    if (tid < 16) ((int*)(p.ws + WS_WGCNT))[((size_t)l * 1024 + blockIdx.x) * 16 + tid] = lcnt[tid];
}

__device__ __forceinline__ void build_moe_tab(const Params& p, int l, LAS int* tab) {
    if (threadIdx.x == 0) {
        const unsigned* cnt = (const unsigned*)(p.ws + WS_CNT) + l * 16;
        int acc = 0;
        for (int e = 0; e < 16; ++e) { tab[e] = acc; acc += (int)((cnt[e] + 255u) >> 8); }
        tab[16] = acc;
    }
    __syncthreads();
}

__device__ __forceinline__ void phase_permute(const Params& p, int l, LAS int* tab) {
    int tid_ = threadIdx.x; asm volatile("" : "+v"(tid_)); const int wave = tid_ >> 6, lane = tid_ & 63;
    LAS int* base = tab + 32; LAS int* total = tab + 48;
    if (tid_ < 16) { base[tid_] = 0; total[tid_] = 0; }
    __syncthreads();
    {
        const int* wgc = (const int*)(p.ws + WS_WGCNT) + (size_t)l * 1024 * 16;
        const int e = tid_ & 15; int bs = 0, tt = 0;
        for (int w = tid_ >> 4; w < (int)gridDim.x; w += 32) { const int v = wgc[w * 16 + e]; tt += v; bs += (w < (int)blockIdx.x) ? v : 0; }
        __hip_atomic_fetch_add(&base[e], bs, __ATOMIC_RELAXED, __HIP_MEMORY_SCOPE_WORKGROUP);
        __hip_atomic_fetch_add(&total[e], tt, __ATOMIC_RELAXED, __HIP_MEMORY_SCOPE_WORKGROUP);
    }
    __syncthreads();
    if (tid_ == 0) { int acc = 0; for (int e = 0; e < 16; ++e) { tab[e] = acc; acc += (total[e] + 255) >> 8; } tab[16] = acc; }
    if (blockIdx.x == 0 && tid_ < 16) ((unsigned*)(p.ws + WS_CNT))[l * 16 + tid_] = (unsigned)total[tid_];
    __syncthreads();
    int* route = (int*)(p.ws + WS_ROUTE);
    const bf16_t* hb = (const bf16_t*)(p.ws + WS_HB);
    bf16_t* xe = (bf16_t*)(p.ws + WS_XE);
    for (int n = blockIdx.x * 8 + wave; n < T; n += gridDim.x * 8) {
        int* r = route + (size_t)n * 8;
        const int e0 = r[0], e1 = r[1], p0 = r[2], p1 = r[3];
        const int row0 = tab[e0] * 256 + base[e0] + p0, row1 = tab[e1] * 256 + base[e1] + p1;
        const u32x4* src = (const u32x4*)(hb + (size_t)n * D);
        u32x4* d0 = (u32x4*)(xe + (size_t)row0 * D); u32x4* d1 = (u32x4*)(xe + (size_t)row1 * D);
#pragma unroll
        for (int i = 0; i < 4; ++i) { const u32x4 v = src[i * 64 + lane]; d0[i * 64 + lane] = v; d1[i * 64 + lane] = v; }
        if (lane == 0) { r[6] = row0; r[7] = row1; }
    }
}

__device__ __forceinline__ void phase_ln2(const Params& p, int l) {
    int tid_ = threadIdx.x; asm volatile("" : "+v"(tid_)); const int wave = tid_ >> 6, lane = tid_ & 63;
    const float* mod = (const float*)(p.ws + WS_MOD);
    const float* ye = (const float*)(p.ws + WS_YE);
    float* xres = (float*)(p.ws + WS_XRES);
    const int* route = (const int*)(p.ws + WS_ROUTE);
    for (int n = blockIdx.x * 8 + wave; n < T; n += gridDim.x * 8) {
        const int b = n / SEQ;
        const float* mb = mod + ((size_t)l * 4 + b) * (6 * D);
        const int* r = route + (size_t)n * 8;
        const float w0 = __int_as_float(r[4]), w1 = __int_as_float(r[5]);
        const float* y0 = ye + (size_t)r[6] * D; const float* y1 = ye + (size_t)r[7] * D;
        float4 v[8];
#pragma unroll
        for (int i = 0; i < 8; ++i) {
            const float4 xv = *(const float4*)(xres + (size_t)n * D + i * 256 + lane * 4);
            const float4 a = *(const float4*)(y0 + i * 256 + lane * 4), c = *(const float4*)(y1 + i * 256 + lane * 4);
            const float4 g = *(const float4*)(mb + 5 * D + i * 256 + lane * 4);
            v[i].x = ALPHA * xv.x + (1.f + g.x) * (w0 * a.x + w1 * c.x); v[i].y = ALPHA * xv.y + (1.f + g.y) * (w0 * a.y + w1 * c.y);
            v[i].z = ALPHA * xv.z + (1.f + g.z) * (w0 * a.z + w1 * c.z); v[i].w = ALPHA * xv.w + (1.f + g.w) * (w0 * a.w + w1 * c.w);
        }
        ln_rows(v, p.ln_g + (size_t)(l * 2 + 1) * D, p.ln_b + (size_t)(l * 2 + 1) * D, lane);
        if (l + 1 < DEPTH) {
#pragma unroll
            for (int i = 0; i < 8; ++i) *(float4*)(xres + (size_t)n * D + i * 256 + lane * 4) = v[i];
            const float* mn = mod + ((size_t)(l + 1) * 4 + b) * (6 * D);
            modulate_store(v, mn, mn + D, (bf16_t*)(p.ws + WS_HA) + (size_t)n * D, lane);
        } else {
#ifdef MIXER_CHECK
            { const float* chk = (const float*)(p.ws + WS_CNT + 1024); float scale = 1.f;
              for (int j = 7; j >= 0; --j) { const float sd = chk[j * 2], sq = chk[j * 2 + 1]; if (!(sd <= 1e-3f * sq)) scale = 1.0f + 0.25f * (float)(1 << (j & 3)) + 8.f * (float)(j >> 2); }
#pragma unroll
              for (int i = 0; i < 8; ++i) { v[i].x *= scale; v[i].y *= scale; v[i].z *= scale; v[i].w *= scale; } }
#endif
#pragma unroll
            for (int i = 0; i < 8; ++i) *(float4*)(p.out + (size_t)n * D + i * 256 + lane * 4) = v[i];
        }
    }
}

typedef const __attribute__((address_space(4))) unsigned char* KargPtr;
__device__ __forceinline__ Params load_params(KargPtr q) { asm volatile("" : "+s"(q)); Params lp; __builtin_memcpy(&lp, q, sizeof(Params)); return lp; }

__global__ __launch_bounds__(512, 2) void mega(Params p_in) {
    extern __shared__ __attribute__((aligned(16))) unsigned char smem[];
    LAS unsigned char* lds = (LAS unsigned char*)smem;
    LAS int* tab = (LAS int*)(lds + LDS_MISC + 64);
    KargPtr kp = (KargPtr)__builtin_amdgcn_kernarg_segment_ptr();
    if (threadIdx.x == 0) { *(LAS u32x4*)(lds + LDS_MISC) = (u32x4){0u, 0u, 0u, 0u}; }
    __syncthreads();
    const int fused = p_in.fused, ph_lo = p_in.ph_lo, ph_hi = p_in.ph_hi, l_hi = p_in.l_hi;
    XcdBarrier bar;
    if (fused) bar = xcd_barrier_post((unsigned*)(p_in.ws + WS_BAR), (volatile LAS unsigned*)(lds + LDS_MISC));
    else { bar.bar = (unsigned*)(p_in.ws + WS_BAR); bar.x = 0; bar.st = (volatile LAS unsigned*)(lds + LDS_MISC); }
#ifdef ONLY_PH
#define PH(i) ((i) == ONLY_PH && ph_lo <= (i) && (i) < ph_hi)
#else
#define PH(i) (ph_lo <= (i) && (i) < ph_hi)
#endif
#define SYNC() do { if (fused) xcd_barrier(bar); } while (0)
#ifndef DUP_MASK
#define DUP_MASK 0
#endif
#define REP(i) _Pragma("unroll 1") for (int rep_ = 0; rep_ < 1 + ((DUP_MASK >> (i)) & 1); ++rep_)
    const int G = gridDim.x, c = blockIdx.x;
    if (PH(0)) REP(0) { const Params p = load_params(kp); phase_prologue(p, lds); SYNC(); }
    if (PH(1)) REP(1) { const Params p = load_params(kp); phase_ln0(p); SYNC(); }
    for (int l = p_in.l_lo; l < l_hi; ++l) {
        const bool split_in = (G >= 224);
        if (PH(2)) REP(2) {
            const Params p = load_params(kp);
            pg8::DenseOrder S; S.init(T, split_in ? INC - 256 : INC, D, G, c);
            pg8::Gemm g{(const bf16_t*)(p.ws + WS_HA), (const bf16_t*)(p.ws + WS_WIN) + (size_t)l * INC * D, D};
            pg8::EpiBf16 E{(bf16_t*)(p.ws + WS_PROJ), INC};
            pg8::gemm_phase(lds, g, S, E);
            if (!split_in) tail_pull(p, lds, l * 4 + 0);
            SYNC();
        }
#ifdef MIXER_CHECK
        if (PH(3)) REP(3) { const Params p = load_params(kp); phase_mixer_valu(p, l, lds); SYNC(); }
        if (PH(3)) REP(3) { const Params p = load_params(kp); phase_mixer_mfma(p, l, lds, (float*)(p.ws + WS_XE)); SYNC(); }
        if (PH(3)) REP(3) { const Params p = load_params(kp); phase_mixer_check(p, (const float*)(p.ws + WS_OBUF), (const float*)(p.ws + WS_XE), (float*)(p.ws + WS_CNT + 1024) + l * 8); SYNC(); }
#else
        if (PH(3)) REP(3) {
            const Params p = load_params(kp);
            if (split_in && c >= 192 && c < 224) {
                pg8::OneUnit S; S.u0.aB = (size_t)(c - 192) * 256 * D * 2; S.u0.bB = (size_t)32 * 256 * D * 2; S.u0.row0 = (c - 192) * 256; S.u0.col0 = 32 * 256;
                pg8::Gemm g{(const bf16_t*)(p.ws + WS_HA), (const bf16_t*)(p.ws + WS_WIN) + (size_t)l * INC * D, D};
                pg8::EpiBf16 E{(bf16_t*)(p.ws + WS_PROJ), INC};
                pg8::gemm_phase(lds, g, S, E);
            }
            phase_mixer_mfma(p, l, lds, (float*)(p.ws + WS_OBUF));
            tail_pull(p, lds, l * 4 + 1);
            SYNC();
        }
#endif
        if (PH(4)) REP(4) { const Params p = load_params(kp); phase_finalize(p, l); SYNC(); }
        if (PH(5)) REP(5) {
            const Params p = load_params(kp);
            pg8::DenseOrder S; S.init(T, D, D, G, c);
            pg8::Gemm g{(const bf16_t*)(p.ws + WS_MIXED), (const bf16_t*)(p.ws + WS_WOUT) + (size_t)l * D * D, D};
            pg8::EpiF32 E{(float*)(p.ws + WS_Y), D};
            pg8::gemm_phase(lds, g, S, E);
            SYNC();
        }
        if (PH(6)) REP(6) { const Params p = load_params(kp); phase_ln1_router(p, l, lds); SYNC(); }
        if (PH(7)) REP(7) { const Params p = load_params(kp); phase_permute(p, l, tab); cvt_pull(p, lds, l * CV_PER_L + CV_A1, nullptr, 0u); SYNC(); }
        if (PH(8)) REP(8) {
            const Params p = load_params(kp);
            build_moe_tab(p, l, tab);
            pg8::MoeOrder S; S.tab = tab; S.NTn = 11; S.G = G; S.c = c; S.tstep = (size_t)256 * D * 2; S.bexp = (size_t)2 * DE * D * 2;
            pg8::Gemm g{(const bf16_t*)(p.ws + WS_XE), (const bf16_t*)(p.ws + WS_WGU) + (size_t)l * NE * 2 * DE * D, D};
            pg8::EpiHidden E{(bf16_t*)(p.ws + WS_HID)};
            pg8::gemm_phase(lds, g, S, E);
            tail_pull(p, lds, l * 4 + 2);
            cvt_pull(p, lds, (l + 1) * CV_PER_L, nullptr, 0u);
            SYNC();
        }
        if (PH(9)) REP(9) {
            const Params p = load_params(kp);
            build_moe_tab(p, l, tab);
            pg8::MoeOrder S; S.tab = tab; S.NTn = 8; S.G = G; S.c = c; S.tstep = (size_t)256 * DE * 2; S.bexp = (size_t)D * DE * 2;
            pg8::Gemm g{(const bf16_t*)(p.ws + WS_HID), (const bf16_t*)(p.ws + WS_WD) + (size_t)l * NE * D * DE, DE};
            pg8::EpiF32 E{(float*)(p.ws + WS_YE), D};
            pg8::gemm_phase(lds, g, S, E);
            tail_pull(p, lds, l * 4 + 3);
            if (l + 1 < DEPTH) cvt_pull(p, lds, (l + 1) * CV_PER_L + CV_A0, nullptr, 0u);
            SYNC();
        }
        if (PH(10)) REP(10) { const Params p = load_params(kp); phase_ln2(p, l); SYNC(); }
    }
}

#ifndef MK_FUSED
#define MK_FUSED 1
#endif
extern "C" void kernel_launch(void* const* d_in, const int* in_sizes, int n_in, void* d_out, int out_size, void* d_ws, size_t ws_size, hipStream_t stream) {
    static int grid = 0;
    if (grid == 0) {
        if (n_in != 18 || ws_size < WS_END) { fprintf(stderr, "kernel_launch: unexpected n_in %d or ws_size %zu (< %zu)\n", n_in, ws_size, (size_t)WS_END); grid = -1; return; }
        int dev = 0, cus = 0, per_cu = 0;
        hipGetDevice(&dev);
        hipDeviceGetAttribute(&cus, hipDeviceAttributeMultiprocessorCount, dev);
        if (hipFuncSetAttribute((const void*)mega, hipFuncAttributeMaxDynamicSharedMemorySize, LDS_BYTES) != hipSuccess) { fprintf(stderr, "kernel_launch: hipFuncSetAttribute failed\n"); grid = -1; return; }
        hipOccupancyMaxActiveBlocksPerMultiprocessor(&per_cu, (const void*)mega, 512, LDS_BYTES);
        if (per_cu < 1) fprintf(stderr, "kernel_launch: occupancy query says %d\n", per_cu);
        grid = cus > 0 ? cus : 256;
    }
    if (grid < 0) return;
    hipMemsetAsync(d_ws, 0, WS_ZERO_BYTES, stream);
    Params p{};
    p.x = (const float*)d_in[0]; p.c = (const float*)d_in[1]; p.emb_g = (const float*)d_in[2]; p.emb_b = (const float*)d_in[3];
    p.w_ada = (const float*)d_in[4]; p.b_ada = (const float*)d_in[5]; p.w_in = (const float*)d_in[6]; p.conv_w = (const float*)d_in[7];
    p.mix_beta = (const float*)d_in[8]; p.w_out = (const float*)d_in[9]; p.lb_logits = (const float*)d_in[10]; p.ln_g = (const float*)d_in[11];
    p.ln_b = (const float*)d_in[12]; p.w_router = (const float*)d_in[13]; p.router_bias = (const float*)d_in[14]; p.w_gate = (const float*)d_in[15];
    p.w_up = (const float*)d_in[16]; p.w_down = (const float*)d_in[17];
    p.out = (float*)d_out; p.ws = (unsigned char*)d_ws; p.pad = 0;
#if MK_FUSED
    p.ph_lo = 0; p.ph_hi = 11; p.l_lo = 0; p.l_hi = DEPTH; p.fused = 1;
    hipLaunchKernelGGL(mega, dim3(grid), dim3(512), LDS_BYTES, stream, p);
#else
    p.fused = 0;
    for (int ph = 0; ph < 2; ++ph) { p.ph_lo = ph; p.ph_hi = ph + 1; p.l_lo = 0; p.l_hi = 0; hipLaunchKernelGGL(mega, dim3(grid), dim3(512), LDS_BYTES, stream, p); }
    for (int l = 0; l < DEPTH; ++l)
        for (int ph = 2; ph < 11; ++ph) { p.ph_lo = ph; p.ph_hi = ph + 1; p.l_lo = l; p.l_hi = l + 1; hipLaunchKernelGGL(mega, dim3(grid), dim3(512), LDS_BYTES, stream, p); }
#endif
}
```

```cpp
#include <hip/hip_runtime.h>
#include <stdint.h>
#include <stdio.h>

#define LAS __attribute__((address_space(3)))
typedef unsigned short bf16_t;
typedef short bf16x8 __attribute__((ext_vector_type(8)));
typedef float f32x4 __attribute__((ext_vector_type(4)));
typedef unsigned u32x4 __attribute__((ext_vector_type(4)));
typedef unsigned u32x2 __attribute__((ext_vector_type(2)));

constexpr int D = 2048, NB = 4, SEQ = 2048, T = NB * SEQ, DEPTH = 2;
constexpr int CW = 512, RW = 768, HWD = 768, INC = 8448;
constexpr int NE = 16, DE = 1408;
constexpr int C_CB = 0, C_CC = 512, C_CH = 1024, C_RQ = 1536, C_RK = 2304, C_RV = 3072, C_RG = 3840, C_HQ = 4608, C_HFF = 5376, C_HFB = 6144, C_HI = 6912, C_HG = 7680;
constexpr int XE_ROWS = 20480;
#ifndef MOE_FP8
#define MOE_FP8 1
#endif
constexpr int DEP = 1536;
constexpr float W8_SCALE = 64.f, H8_SCALE = 8.f;
constexpr float ALPHA = 1.4142135623730951f;

constexpr size_t WS_BAR = 0;
constexpr size_t WS_CNT = 16384;
constexpr size_t WS_CVTQ = 20480;
constexpr size_t WS_ZERO_BYTES = 32768;
constexpr size_t WS_MOD = 32768;
constexpr size_t WS_ROUTE = WS_MOD + 393216;
constexpr size_t WS_WGCNT = WS_ROUTE + 262144;
constexpr size_t WS_WIN = 1048576;
constexpr size_t SZ_WIN = (size_t)DEPTH * INC * D * 2;
constexpr size_t WS_WOUT = WS_WIN + SZ_WIN;
constexpr size_t SZ_WOUT = (size_t)DEPTH * D * D * 2;
constexpr size_t WS_WGU = WS_WOUT + SZ_WOUT;
constexpr size_t SZ_WGU = (size_t)DEPTH * NE * 2 * DE * D * 2;
constexpr size_t WS_WD = WS_WGU + SZ_WGU;
constexpr size_t SZ_WD = (size_t)DEPTH * NE * D * DE * 2;
constexpr size_t WS_XRES = WS_WD + SZ_WD;
constexpr size_t SZ_XRES = (size_t)T * D * 4;
constexpr size_t WS_HA = WS_XRES + SZ_XRES;
constexpr size_t SZ_H = (size_t)T * D * 2;
constexpr size_t WS_HB = WS_HA + SZ_H;
constexpr size_t WS_PROJ = WS_HB + SZ_H;
constexpr size_t SZ_PROJ = (size_t)T * INC * 2;
constexpr size_t WS_OBUF = WS_PROJ + SZ_PROJ;
constexpr size_t SZ_OBUF = (size_t)2 * T * 1536 * 4;
constexpr size_t WS_YE = WS_PROJ;
constexpr size_t SZ_YE = (size_t)XE_ROWS * D * 4;
static_assert(SZ_YE <= SZ_PROJ + SZ_OBUF, "ye alias");
constexpr size_t WS_MIXED = WS_OBUF + SZ_OBUF;
constexpr size_t WS_Y = WS_MIXED + SZ_H;
constexpr size_t SZ_Y = (size_t)T * D * 4;
constexpr size_t WS_XE = WS_Y + SZ_Y;
constexpr size_t SZ_XE = (size_t)XE_ROWS * D * 2;
constexpr size_t WS_HID = WS_XE + SZ_XE;
constexpr size_t SZ_HID = (size_t)XE_ROWS * DE * 2;
constexpr size_t WS_END = WS_HID + SZ_HID;

constexpr int LDS_BYTES = 156672;
constexpr int LDS_MISC = 153600;

struct Params {
    const float *x, *c, *emb_g, *emb_b, *w_ada, *b_ada, *w_in, *conv_w, *mix_beta, *w_out, *lb_logits, *ln_g, *ln_b, *w_router, *router_bias, *w_gate, *w_up, *w_down;
    float* out;
    unsigned char* ws;
    int ph_lo, ph_hi, l_lo, l_hi, fused, pad;
};

__device__ __forceinline__ float bf2f(unsigned b) { return __uint_as_float(b << 16); }
__device__ __forceinline__ unsigned f2bf(float f) { unsigned u = __float_as_uint(f); u += 0x7FFFu + ((u >> 16) & 1u); return u >> 16; }
__device__ __forceinline__ unsigned pack2(float lo, float hi) { unsigned r; asm("v_cvt_pk_bf16_f32 %0, %1, %2" : "=v"(r) : "v"(lo), "v"(hi)); return r; }
__device__ __forceinline__ float wave_sum(float v) {
#pragma unroll
    for (int o = 32; o > 0; o >>= 1) v += __shfl_xor(v, o, 64);
    return v;
}
__device__ __forceinline__ float half_sum(float v) {
#pragma unroll
    for (int o = 16; o > 0; o >>= 1) v += __shfl_xor(v, o, 64);
    return v;
}
#define LDS_BARRIER() do { asm volatile("s_waitcnt lgkmcnt(0)" ::: "memory"); __builtin_amdgcn_s_barrier(); asm volatile("" ::: "memory"); } while (0)
__device__ __forceinline__ float sigmoidf_(float z) { return 1.0f / (1.0f + __expf(-z)); }
__device__ __forceinline__ float siluf_(float z) { return z / (1.0f + __expf(-z)); }

#define XB_TMO      128
#define XB_XCNT(j)  (256  + 64 * (j))
#define XB_XSUB(j)  (1280 + 64 * (j))
#define XB_XGEN(j)  (2304 + 64 * (j))
#define XB_TOP      3328
#define XB_TOPGEN   3392
#define XCD_BAR_WORDS 3456
#define XB_SPIN_CAP (1u << 22)
__device__ __forceinline__ unsigned xb_ld(unsigned* p)              { return __hip_atomic_load(p, __ATOMIC_RELAXED, __HIP_MEMORY_SCOPE_AGENT); }
__device__ __forceinline__ unsigned xb_add(unsigned* p, unsigned v) { return __hip_atomic_fetch_add(p, v, __ATOMIC_RELAXED, __HIP_MEMORY_SCOPE_AGENT); }
__device__ __forceinline__ unsigned xb_xcc_id() { return (unsigned)__builtin_amdgcn_s_getreg((3 << 11) | 20) & 0xFu; }
#define XB_SPIN(cond, bar) do { unsigned _sp = 0; while (cond) { __builtin_amdgcn_s_sleep(1); \
    if ((++_sp & 255u) == 0u) { if (xb_ld(&(bar)[XB_TMO])) break; if (_sp > XB_SPIN_CAP) { atomicAdd(&(bar)[XB_TMO], 1u); break; } } } } while (0)
struct XcdBarrier { unsigned* bar; unsigned x; volatile LAS unsigned* st; };
__device__ __forceinline__ XcdBarrier xcd_barrier_post(unsigned* bar, volatile LAS unsigned* st) {
    XcdBarrier b; b.bar = bar; b.x = xb_xcc_id(); b.st = st;
    if (threadIdx.x == 0) (void)xb_add(&bar[XB_XCNT(b.x)], 1u);
    return b;
}
__device__ __forceinline__ void xcd_barrier_complete(unsigned* bar, unsigned x, unsigned& nloc, unsigned& nx) {
    const unsigned G = gridDim.x * gridDim.y * gridDim.z;
    unsigned sum, cnt, mine, sp = 0u;
    for (;;) {
        sum = 0u; cnt = 0u; mine = 0u;
#pragma unroll
        for (unsigned j = 0; j < 16; ++j) { const unsigned c = xb_ld(&bar[XB_XCNT(j)]); sum += c; cnt += (c > 0u) ? 1u : 0u; mine = (j == x) ? c : mine; }
        if (sum == G) break;
        __builtin_amdgcn_s_sleep(1);
        if ((++sp & 255u) == 0u) { if (xb_ld(&bar[XB_TMO])) break; if (sp > XB_SPIN_CAP) { atomicAdd(&bar[XB_TMO], 1u); break; } }
    }
    nloc = mine > 0u ? mine : 1u; nx = cnt > 0u ? cnt : 1u;
}
__device__ __forceinline__ void xcd_barrier(const XcdBarrier& b) {
    asm volatile("s_waitcnt vmcnt(0)" ::: "memory");
    __syncthreads();
    if (threadIdx.x == 0) {
        unsigned* bar = b.bar;
        __builtin_amdgcn_s_waitcnt(0);
        unsigned nloc = b.st[0], nx = b.st[1];
        if (nloc == 0u) { xcd_barrier_complete(bar, b.x, nloc, nx); b.st[0] = nloc; b.st[1] = nx; }
        const unsigned old = xb_add(&bar[XB_XSUB(b.x)], 1u);
        const unsigned gen = old / nloc;
        if (old + 1u == (gen + 1u) * nloc) {
            __builtin_amdgcn_fence(__ATOMIC_RELEASE, "agent");
            asm volatile("s_waitcnt vmcnt(0)" ::: "memory");
            const unsigned og = xb_add(&bar[XB_TOP], 1u);
            const unsigned tg = og / nx;
            if (og + 1u == (tg + 1u) * nx) xb_add(&bar[XB_TOPGEN], 1u);
            else XB_SPIN(xb_ld(&bar[XB_TOPGEN]) == tg, bar);
            __builtin_amdgcn_fence(__ATOMIC_ACQUIRE, "agent");
            xb_add(&bar[XB_XGEN(b.x)], 1u);
            asm volatile("s_waitcnt vmcnt(0)" ::: "memory");
        } else {
            XB_SPIN(xb_ld(&bar[XB_XGEN(b.x)]) == gen, bar);
            __builtin_amdgcn_fence(__ATOMIC_ACQUIRE, "agent");
            asm volatile("s_waitcnt vmcnt(0)" ::: "memory");
        }
    }
    __syncthreads();
}

namespace pg8 {
constexpr int BM = 256, BK = 64, HALF = 128, HTB = HALF * BK * 2, STAGE_BYTES = 8 * HTB, NXCD = 8, WGM = 8;
__host__ __device__ __forceinline__ int lds_byte(int r, int c) { const int st = (r >> 4) * 2 + (c >> 5), rr = r & 15, cc = c & 31, ob = rr * 64 + cc * 2; return st * 1024 + (ob ^ (((ob >> 9) & 1) << 5)); }
__host__ __device__ __forceinline__ void stage_rc(int b, int& R, int& C) { const int st = b / 1024, sb = b % 1024, swz = sb ^ (((sb >> 9) & 1) << 5); R = (st >> 1) * 16 + swz / 64; C = (st & 1) * 32 + (swz % 64) / 2; }
__host__ __device__ __forceinline__ int perm32(int rho) { const int n = rho >> 4, i = rho & 15; return 8 * (i >> 2) + 4 * n + (i & 3); }

struct Unit { size_t aB, bB; int row0, col0; };
struct Gemm { const bf16_t* A; const bf16_t* Bt; int K; };

struct DenseOrder {
    int nM, nN, nwg, G, c; size_t tstep;
    __device__ void init(int M, int N, int K, int G_, int c_) { nM = M / BM; nN = N / BM; nwg = nM * nN; G = G_; c = c_; tstep = (size_t)BM * K * 2; }
    __device__ bool next(int i, Unit& u) const {
        const long L = (long)i * G + c; if (L >= nwg) return false;
        int wgid = (int)L; { const int q = nwg / NXCD, r = nwg % NXCD, xcd = wgid % NXCD, off = wgid / NXCD; wgid = (xcd < r ? xcd * (q + 1) : r * (q + 1) + (xcd - r) * q) + off; }
        const int nig = WGM * nN, gid = wgid / nig, fm = gid * WGM, gsz = (nM - fm) < WGM ? (nM - fm) : WGM;
        const int pm = fm + ((wgid % nig) % gsz), pn = (wgid % nig) / gsz;
        u.aB = (size_t)pm * tstep; u.bB = (size_t)pn * tstep; u.row0 = pm * BM; u.col0 = pn * BM; return true;
    }
};
struct OneUnit {
    Unit u0;
    __device__ bool next(int i, Unit& u) const { if (i > 0) return false; u = u0; return true; }
};
struct MoeOrder {
    const LAS int* tab; int NTn, G, c; size_t tstep, bexp;
    __device__ bool next(int i, Unit& u) const {
        const int MT = tab[16], U = MT * NTn, nx = G >> 3;
        int f;
        if ((G & 7) == 0) { const int per = (U + 7) >> 3, x = c & 7, j = c >> 3, loc = i * nx + j; f = x * per + loc; if (loc >= per || f >= U) return false; }
        else { f = i * G + c; if (f >= U) return false; }
        int e = 0;
#pragma unroll
        for (int j = 1; j < 16; ++j) e += (f >= tab[j] * NTn) ? 1 : 0;
        const int t0 = tab[e], te = tab[e + 1] - t0, r = f - t0 * NTn;
        const int nt = r / te, mt = t0 + (r - nt * te);
        u.aB = (size_t)mt * tstep; u.bB = (size_t)e * bexp + (size_t)nt * tstep; u.row0 = mt * BM; u.col0 = nt * BM; return true;
    }
};

__device__ __forceinline__ size_t rfl64(size_t v) { const unsigned lo = (unsigned)__builtin_amdgcn_readfirstlane((int)(unsigned)v), hi = (unsigned)__builtin_amdgcn_readfirstlane((int)(unsigned)(v >> 32)); return ((size_t)hi << 32) | lo; }
__device__ __forceinline__ void uniformize(Unit& u) { u.aB = rfl64(u.aB); u.bB = rfl64(u.bB); u.row0 = __builtin_amdgcn_readfirstlane(u.row0); u.col0 = __builtin_amdgcn_readfirstlane(u.col0); }
__device__ __forceinline__ unsigned cvt_pk_bf16(float lo, float hi) { unsigned r; asm volatile("v_cvt_pk_bf16_f32 %0, %1, %2" : "=v"(r) : "v"(lo), "v"(hi)); return r; }

struct EpiF32 {
    static constexpr bool PERM = false;
    float* C; int ldc;
    __device__ __forceinline__ void operator()(const f32x4 (&acc)[2][2][4][2], const Unit& u, int wr, int wc, int fr, int fq) const {
        const int row0 = u.row0 + wr * 64 + fr, col0 = u.col0 + wc * 32 + 4 * fq;
#pragma unroll
        for (int ai = 0; ai < 2; ++ai)
#pragma unroll
            for (int m = 0; m < 4; ++m) { float* rowp = C + (size_t)(row0 + ai * HALF + m * 16) * ldc + col0;
#pragma unroll
                for (int bj = 0; bj < 2; ++bj)
#pragma unroll
                    for (int n = 0; n < 2; ++n) *(f32x4*)(rowp + bj * HALF + n * 16) = acc[ai][bj][m][n]; }
    }
};
struct EpiBf16 {
    static constexpr bool PERM = true;
    bf16_t* O; int ldc;
    __device__ __forceinline__ void operator()(const f32x4 (&acc)[2][2][4][2], const Unit& u, int wr, int wc, int fr, int fq) const {
        const int row0 = u.row0 + wr * 64 + fr, col0 = u.col0 + wc * 32 + 8 * fq;
#pragma unroll
        for (int ai = 0; ai < 2; ++ai)
#pragma unroll
            for (int m = 0; m < 4; ++m) { bf16_t* rowp = O + (size_t)(row0 + ai * HALF + m * 16) * ldc + col0;
#pragma unroll
                for (int bj = 0; bj < 2; ++bj) { const f32x4 v0 = acc[ai][bj][m][0], v1 = acc[ai][bj][m][1];
                    u32x4 o; o[0] = cvt_pk_bf16(v0[0], v0[1]); o[1] = cvt_pk_bf16(v0[2], v0[3]); o[2] = cvt_pk_bf16(v1[0], v1[1]); o[3] = cvt_pk_bf16(v1[2], v1[3]);
                    *(u32x4*)(rowp + bj * HALF) = o; } }
    }
};
struct EpiHidden {
    static constexpr bool PERM = true;
    bf16_t* O;
    __device__ __forceinline__ void operator()(const f32x4 (&acc)[2][2][4][2], const Unit& u, int wr, int wc, int fr, int fq) const {
        const int row0 = u.row0 + wr * 64 + fr, col0 = (u.col0 >> 1) + wc * 32 + 8 * fq;
#pragma unroll
        for (int ai = 0; ai < 2; ++ai)
#pragma unroll
            for (int m = 0; m < 4; ++m) { bf16_t* rowp = O + (size_t)(row0 + ai * HALF + m * 16) * DE + col0;
                float h[8];
#pragma unroll
                for (int n = 0; n < 2; ++n)
#pragma unroll
                    for (int j = 0; j < 4; ++j) { const float g = acc[ai][0][m][n][j], up = acc[ai][1][m][n][j]; h[n * 4 + j] = g * __builtin_amdgcn_rcpf(1.0f + __expf(-g)) * up; }
                u32x4 o; o[0] = cvt_pk_bf16(h[0], h[1]); o[1] = cvt_pk_bf16(h[2], h[3]); o[2] = cvt_pk_bf16(h[4], h[5]); o[3] = cvt_pk_bf16(h[6], h[7]);
                *(u32x4*)rowp = o; }
    }
};

typedef int v8i32 __attribute__((ext_vector_type(8)));
typedef int v4i32 __attribute__((ext_vector_type(4)));
struct EpiHidden8 {
    static constexpr bool PERM = true;
    unsigned char* O;
    __device__ __forceinline__ void operator()(const f32x4 (&acc)[2][2][4][2], const Unit& u, int wr, int wc, int fr, int fq) const {
        const int row0 = u.row0 + wr * 64 + fr, col0 = (u.col0 >> 1) + wc * 32 + 8 * fq;
#pragma unroll
        for (int ai = 0; ai < 2; ++ai)
#pragma unroll
            for (int m = 0; m < 4; ++m) { unsigned char* rowp = O + (size_t)(row0 + ai * HALF + m * 16) * DEP + col0;
                float h[8];
#pragma unroll
                for (int n = 0; n < 2; ++n)
#pragma unroll
                    for (int j = 0; j < 4; ++j) { const float g = acc[ai][0][m][n][j], up = acc[ai][1][m][n][j]; h[n * 4 + j] = g * __builtin_amdgcn_rcpf(1.0f + __expf(-g)) * up * H8_SCALE; }
                int o0 = __builtin_amdgcn_cvt_pk_fp8_f32(h[0], h[1], 0, false); o0 = __builtin_amdgcn_cvt_pk_fp8_f32(h[2], h[3], o0, true);
                int o1 = __builtin_amdgcn_cvt_pk_fp8_f32(h[4], h[5], 0, false); o1 = __builtin_amdgcn_cvt_pk_fp8_f32(h[6], h[7], o1, true);
                u32x2 o; o[0] = (unsigned)o0; o[1] = (unsigned)o1;
                *(u32x2*)rowp = o; }
    }
};
template <class Epi, class Sched, bool FP8 = false>
__device__ __forceinline__ void gemm_phase(LAS unsigned char* lds, const Gemm g, const Sched& S, const Epi& E, int sclW = 127, int sclA = 127) {
    int tid = threadIdx.x; asm volatile("" : "+v"(tid)); const int wid = __builtin_amdgcn_readfirstlane(tid >> 6), lane = tid & 63, wr = wid >> 2, wc = wid & 3, fr = lane & 15, fq = lane >> 4;
    const int K = g.K, rowb = FP8 ? K : 2 * K, nt = rowb / 128;
    int sclWv = sclW, sclAv = sclA; asm volatile("" : "+v"(sclWv), "+v"(sclAv));
    unsigned voffA[2], voffB[2];
#pragma unroll
    for (int i = 0; i < 2; ++i) { int R, C; stage_rc(tid * 16 + i * 8192, R, C); const int Rb = Epi::PERM ? ((R & ~31) + perm32(R & 31)) : R;
        voffA[i] = (unsigned)(R * rowb + 2 * C); voffB[i] = (unsigned)(Rb * rowb + 2 * C); }
    const size_t kstep = 128;
    const size_t hstep = (size_t)HALF * rowb;
    const unsigned ldsw = (unsigned)wid * 1024u;
    const int aoff = FP8 ? lds_byte(wr * 64 + fr, fq * 16) : lds_byte(wr * 64 + fr, fq * 8), boff = FP8 ? lds_byte(wc * 32 + fr, fq * 16) : lds_byte(wc * 32 + fr, fq * 8);
    constexpr int P2 = FP8 ? 16 : 1024;
#define PG8_SA(b, h) (((b) * 2 + (h)) * HTB)
#define PG8_SB(b, h) ((4 + (b) * 2 + (h)) * HTB)
#define PG8_STAGE(bufoff, gbase, voff) do { _Pragma("unroll") for (int _i = 0; _i < 2; ++_i) \
        __builtin_amdgcn_global_load_lds((const unsigned*)((const char*)(gbase) + (voff)[_i]), (LAS unsigned*)(lds + (bufoff) + ldsw + _i * 8192), 16, 0, 0); } while (0)
#define PG8_LDA(dst, b, h) do { _Pragma("unroll") for (int m = 0; m < 4; ++m) { \
        if constexpr (FP8) dst[m] = *(const LAS v8i32*)(lds + PG8_SA(b, h) + aoff + m * 2048); \
        else { const v4i32 _l = *(const LAS v4i32*)(lds + PG8_SA(b, h) + aoff + m * 2048), _h = *(const LAS v4i32*)(lds + PG8_SA(b, h) + aoff + P2 + m * 2048); \
               dst[m] = __builtin_shufflevector(_l, _h, 0, 1, 2, 3, 4, 5, 6, 7); } } } while (0)
#define PG8_LDB(dst, b, h) do { _Pragma("unroll") for (int n = 0; n < 2; ++n) { \
        if constexpr (FP8) dst[n] = *(const LAS v8i32*)(lds + PG8_SB(b, h) + boff + n * 2048); \
        else { const v4i32 _l = *(const LAS v4i32*)(lds + PG8_SB(b, h) + boff + n * 2048), _h = *(const LAS v4i32*)(lds + PG8_SB(b, h) + boff + P2 + n * 2048); \
               dst[n] = __builtin_shufflevector(_l, _h, 0, 1, 2, 3, 4, 5, 6, 7); } } } while (0)
#define PG8_MMA(ai, bj, At, Bt) do { __builtin_amdgcn_s_setprio(1); _Pragma("unroll") for (int m = 0; m < 4; ++m) _Pragma("unroll") for (int n = 0; n < 2; ++n) { \
        if constexpr (FP8) { \
            asm volatile("v_mfma_scale_f32_16x16x128_f8f6f4 %0, %1, %2, %0, %3, %4 op_sel_hi:[0,0,0]" : "+v"(acc[ai][bj][m][n]) : "v"(Bt[n]), "v"(At[m]), "v"(sclWv), "v"(sclAv)); \
        } else { \
            acc[ai][bj][m][n] = __builtin_amdgcn_mfma_f32_16x16x32_bf16(__builtin_bit_cast(bf16x8, __builtin_shufflevector(Bt[n], Bt[n], 0, 1, 2, 3)), __builtin_bit_cast(bf16x8, __builtin_shufflevector(At[m], At[m], 0, 1, 2, 3)), acc[ai][bj][m][n], 0, 0, 0); \
            acc[ai][bj][m][n] = __builtin_amdgcn_mfma_f32_16x16x32_bf16(__builtin_bit_cast(bf16x8, __builtin_shufflevector(Bt[n], Bt[n], 4, 5, 6, 7)), __builtin_bit_cast(bf16x8, __builtin_shufflevector(At[m], At[m], 4, 5, 6, 7)), acc[ai][bj][m][n], 0, 0, 0); } } \
        __builtin_amdgcn_s_setprio(0); } while (0)
#define PG8_WAIT_V(n) asm volatile("s_waitcnt vmcnt(" #n ")" ::: "memory")
#define PG8_WAIT_L(n) asm volatile("s_waitcnt lgkmcnt(" #n ")" ::: "memory")
#define PG8_BAR __builtin_amdgcn_s_barrier()
#define PG8_SCHED __builtin_amdgcn_sched_barrier(0)
    Unit cur, nxt; int ui = 0;
    if (!S.next(0, cur)) return;
    uniformize(cur);
    f32x4 acc[2][2][4][2];
#pragma unroll
    for (int a = 0; a < 2; ++a)
#pragma unroll
        for (int b = 0; b < 2; ++b)
#pragma unroll
            for (int m = 0; m < 4; ++m)
#pragma unroll
                for (int n = 0; n < 2; ++n) acc[a][b][m][n] = (f32x4){0.f, 0.f, 0.f, 0.f};
    v8i32 At[4], B0[2], B1[2];
    const char* cA = (const char*)g.A + cur.aB; const char* cB = (const char*)g.Bt + cur.bB;
    PG8_STAGE(PG8_SB(0, 0), cB, voffB); PG8_STAGE(PG8_SA(0, 0), cA, voffA); PG8_STAGE(PG8_SB(0, 1), cB + hstep, voffB); PG8_STAGE(PG8_SA(0, 1), cA + hstep, voffA);
    if (wr == 1) PG8_BAR;
    PG8_WAIT_V(4); PG8_BAR;
    PG8_STAGE(PG8_SB(1, 0), cB + kstep, voffB); PG8_STAGE(PG8_SA(1, 0), cA + kstep, voffA); PG8_STAGE(PG8_SB(1, 1), cB + hstep + kstep, voffB);
    PG8_WAIT_V(6); PG8_BAR;
    for (;;) {
        const bool has_next = S.next(ui + 1, nxt);
        uniformize(nxt);
        const char* nA = has_next ? (const char*)g.A + nxt.aB : cA; const char* nB = has_next ? (const char*)g.Bt + nxt.bB : cB;
        for (int t = 0; t < nt; t += 2) {
            const bool last = (t == nt - 2);
            const char* a1 = cA + (size_t)(t + 1) * kstep;
            const char* a2 = last ? nA : cA + (size_t)(t + 2) * kstep; const char* b2 = last ? nB : cB + (size_t)(t + 2) * kstep;
            const char* a3 = a2 + kstep; const char* b3 = b2 + kstep;
            PG8_LDB(B0, 0, 0); PG8_SCHED; PG8_LDA(At, 0, 0); PG8_STAGE(PG8_SA(1, 1), a1 + hstep, voffA);
            PG8_WAIT_L(8); PG8_BAR; PG8_WAIT_L(0); PG8_MMA(0, 0, At, B0); PG8_BAR; PG8_SCHED;
            PG8_LDB(B1, 0, 1); PG8_STAGE(PG8_SB(0, 0), b2, voffB);
            PG8_BAR; PG8_WAIT_L(0); PG8_MMA(0, 1, At, B1); PG8_BAR;
            PG8_LDA(At, 0, 1); PG8_STAGE(PG8_SA(0, 0), a2, voffA);
            PG8_BAR; PG8_WAIT_L(0); PG8_MMA(1, 0, At, B0); PG8_BAR; PG8_SCHED;
            PG8_STAGE(PG8_SB(0, 1), b2 + hstep, voffB);
            PG8_WAIT_V(6); PG8_BAR; PG8_MMA(1, 1, At, B1); PG8_BAR;
            PG8_LDB(B0, 1, 0); PG8_SCHED; PG8_LDA(At, 1, 0); PG8_STAGE(PG8_SA(0, 1), a2 + hstep, voffA);
            PG8_WAIT_L(8); PG8_BAR; PG8_WAIT_L(0); PG8_MMA(0, 0, At, B0); PG8_BAR; PG8_SCHED;
            PG8_LDB(B1, 1, 1); PG8_STAGE(PG8_SB(1, 0), b3, voffB);
            PG8_BAR; PG8_WAIT_L(0); PG8_MMA(0, 1, At, B1); PG8_BAR;
            PG8_LDA(At, 1, 1); PG8_STAGE(PG8_SA(1, 0), a3, voffA);
            PG8_BAR; PG8_WAIT_L(0); PG8_MMA(1, 0, At, B0); PG8_BAR; PG8_SCHED;
            PG8_STAGE(PG8_SB(1, 1), b3 + hstep, voffB);
            PG8_WAIT_V(6); PG8_BAR; PG8_MMA(1, 1, At, B1); PG8_BAR;
        }
        if constexpr (FP8) asm volatile("s_nop 15\n\ts_nop 15" ::: "memory");
        E(acc, cur, wr, wc, fr, fq);
        if (!has_next) break;
#pragma unroll
        for (int a = 0; a < 2; ++a)
#pragma unroll
            for (int b = 0; b < 2; ++b)
#pragma unroll
                for (int m = 0; m < 4; ++m)
#pragma unroll
                    for (int n = 0; n < 2; ++n) acc[a][b][m][n] = (f32x4){0.f, 0.f, 0.f, 0.f};
        cur = nxt; cA = nA; cB = nB; ++ui;
    }
    PG8_WAIT_V(0);
    if (wr == 0) PG8_BAR;
    PG8_BAR;
#undef PG8_SA
#undef PG8_SB
#undef PG8_STAGE
#undef PG8_LDA
#undef PG8_LDB
#undef PG8_MMA
#undef PG8_WAIT_V
#undef PG8_WAIT_L
#undef PG8_BAR
#undef PG8_SCHED
}
}

constexpr int S_IN = 16 * 66, S_OUT = 16 * 16, S_GU = 16 * 11, S_DN = 11 * 16;
constexpr int CV_PER_L = S_IN + S_OUT + NE * 2 * S_GU + NE * S_DN;
constexpr int CV_A0 = S_IN + S_OUT;
constexpr int CV_A1 = CV_A0 + NE * 2 * S_GU;
constexpr int CV_TOTAL = DEPTH * CV_PER_L;
constexpr int CV_LAST = 1 << 30;
struct StripDesc { const float* src; bf16_t* dst; int lds_, ldd, k0, n0, drow0, fp8; };
__device__ __forceinline__ StripDesc strip_desc(const Params& p, int si) {
    unsigned char* ws = p.ws; StripDesc d;
    const int l = si / CV_PER_L; int r = si - l * CV_PER_L;
    if (r < S_IN) {
        const int kt = r / 66, ntl = r % 66;
        d.src = p.w_in + (size_t)l * D * INC; d.lds_ = INC; d.dst = (bf16_t*)(ws + WS_WIN) + (size_t)l * INC * D; d.ldd = D; d.k0 = kt * 128; d.n0 = ntl * 128; d.drow0 = ntl * 128; d.fp8 = 0;
    } else if (r < CV_A0) {
        r -= S_IN; const int kt = r / 16, ntl = r % 16;
        d.src = p.w_out + (size_t)l * D * D; d.lds_ = D; d.dst = (bf16_t*)(ws + WS_WOUT) + (size_t)l * D * D; d.ldd = D; d.k0 = kt * 128; d.n0 = ntl * 128; d.drow0 = ntl * 128; d.fp8 = 0;
    } else if (r < CV_A1) {
        r -= CV_A0; const int mat = r / S_GU, q = r % S_GU, kt = q / 11, ntl = q % 11;
        const int which = mat & 1, le = l * NE + (mat >> 1);
        d.src = (which ? p.w_up : p.w_gate) + (size_t)le * D * DE; d.lds_ = DE; d.fp8 = MOE_FP8; d.dst = MOE_FP8 ? (bf16_t*)(ws + WS_WGU + (size_t)le * (2 * DE) * D) : (bf16_t*)(ws + WS_WGU) + (size_t)le * (2 * DE) * D; d.ldd = D; d.k0 = kt * 128; d.n0 = ntl * 128; d.drow0 = ntl * 256 + which * 128;
    } else {
        r -= CV_A1; const int le = l * NE + r / S_DN, q = r % S_DN, kt = q / 16, ntl = q % 16;
        d.src = p.w_down + (size_t)le * DE * D; d.lds_ = D; d.fp8 = MOE_FP8; d.dst = MOE_FP8 ? (bf16_t*)(ws + WS_WD + (size_t)le * D * DEP) : (bf16_t*)(ws + WS_WD) + (size_t)le * D * DE; d.ldd = MOE_FP8 ? DEP : DE; d.k0 = kt * 128; d.n0 = ntl * 128; d.drow0 = ntl * 128;
    }
    return d;
}
__device__ __forceinline__ void cvt_pull(const Params& p, LAS unsigned char* lds, int limit, unsigned* done_ctr, unsigned need_done) {
    int tid = threadIdx.x; asm volatile("" : "+v"(tid));
    LAS int* slot = (LAS int*)(lds + LDS_MISC + 512);
    unsigned* head = (unsigned*)(p.ws + WS_CVTQ);
    if (tid == 0) {
        int sv = -1;
        const bool stop = done_ctr ? (xb_ld(done_ctr) >= need_done) : (xb_ld(head) >= (unsigned)limit);
        if (!stop) { const unsigned c = xb_add(head, 1u); sv = c < (unsigned)CV_TOTAL ? (int)c : -1; }
        slot[0] = sv;
    }
    __syncthreads();
    const int kp = tid >> 4, n4 = (tid & 15) * 4;
    for (;;) {
        const int sraw = slot[0];
        if (sraw < 0) break;
        const int si = sraw & (CV_LAST - 1); const bool lastone = (sraw & CV_LAST) != 0;
        const StripDesc d = strip_desc(p, si);
        float4 a[2][2], b[2][2];
#pragma unroll
        for (int ki = 0; ki < 2; ++ki)
#pragma unroll
            for (int ni = 0; ni < 2; ++ni) {
                a[ki][ni] = *(const float4*)(d.src + (size_t)(d.k0 + ki * 64 + 2 * kp) * d.lds_ + d.n0 + ni * 64 + n4);
                b[ki][ni] = *(const float4*)(d.src + (size_t)(d.k0 + ki * 64 + 2 * kp + 1) * d.lds_ + d.n0 + ni * 64 + n4);
            }
        unsigned c = 0u, dn = 0u;
        if (tid == 0 && !lastone) { c = xb_add(head, 1u); if (done_ctr) dn = xb_ld(done_ctr); }
        LAS unsigned* tl = (LAS unsigned*)lds;
        if (!d.fp8) {
#pragma unroll
            for (int ki = 0; ki < 2; ++ki)
#pragma unroll
                for (int ni = 0; ni < 2; ++ni) {
                    LAS unsigned* t = tl + (ki * 2 + ni) * 2112;
                    t[(n4 + 0) * 33 + kp] = pack2(a[ki][ni].x, b[ki][ni].x);
                    t[(n4 + 1) * 33 + kp] = pack2(a[ki][ni].y, b[ki][ni].y);
                    t[(n4 + 2) * 33 + kp] = pack2(a[ki][ni].z, b[ki][ni].z);
                    t[(n4 + 3) * 33 + kp] = pack2(a[ki][ni].w, b[ki][ni].w);
                }
            LDS_BARRIER();
            const int n = tid >> 3, kc = (tid & 7) * 4;
#pragma unroll
            for (int ki = 0; ki < 2; ++ki)
#pragma unroll
                for (int ni = 0; ni < 2; ++ni) {
                    const LAS unsigned* t = tl + (ki * 2 + ni) * 2112;
                    u32x4 o; o[0] = t[n * 33 + kc]; o[1] = t[n * 33 + kc + 1]; o[2] = t[n * 33 + kc + 2]; o[3] = t[n * 33 + kc + 3];
                    *(u32x4*)(d.dst + (size_t)(d.drow0 + ni * 64 + n) * d.ldd + d.k0 + ki * 64 + kc * 2) = o;
                }
        } else {
            LAS unsigned char* tb = (LAS unsigned char*)lds;
#pragma unroll
            for (int ki = 0; ki < 2; ++ki)
#pragma unroll
                for (int ni = 0; ni < 2; ++ni) {
                    LAS unsigned char* t = tb + (ki * 2 + ni) * 4352;
                    *(LAS unsigned short*)(t + (n4 + 0) * 68 + 2 * kp) = (unsigned short)__builtin_amdgcn_cvt_pk_fp8_f32(a[ki][ni].x * W8_SCALE, b[ki][ni].x * W8_SCALE, 0, false);
                    *(LAS unsigned short*)(t + (n4 + 1) * 68 + 2 * kp) = (unsigned short)__builtin_amdgcn_cvt_pk_fp8_f32(a[ki][ni].y * W8_SCALE, b[ki][ni].y * W8_SCALE, 0, false);
                    *(LAS unsigned short*)(t + (n4 + 2) * 68 + 2 * kp) = (unsigned short)__builtin_amdgcn_cvt_pk_fp8_f32(a[ki][ni].z * W8_SCALE, b[ki][ni].z * W8_SCALE, 0, false);
                    *(LAS unsigned short*)(t + (n4 + 3) * 68 + 2 * kp) = (unsigned short)__builtin_amdgcn_cvt_pk_fp8_f32(a[ki][ni].w * W8_SCALE, b[ki][ni].w * W8_SCALE, 0, false);
                }
            LDS_BARRIER();
            const int n = tid >> 3, kc8 = (tid & 7) * 8;
            unsigned char* dst8 = (unsigned char*)d.dst;
#pragma unroll
            for (int ki = 0; ki < 2; ++ki)
#pragma unroll
                for (int ni = 0; ni < 2; ++ni) {
                    const LAS unsigned char* t = tb + (ki * 2 + ni) * 4352;
                    u32x2 o; o[0] = *(const LAS unsigned*)(t + n * 68 + kc8); o[1] = *(const LAS unsigned*)(t + n * 68 + kc8 + 4);
                    *(u32x2*)(dst8 + (size_t)(d.drow0 + ni * 64 + n) * d.ldd + d.k0 + ki * 64 + kc8) = o;
                }
        }
        if (tid == 0) {
            int sv = -1;
            if (!lastone && c < (unsigned)CV_TOTAL) { const bool fin = done_ctr ? (dn >= need_done) : (c >= (unsigned)limit); sv = (int)c | (fin ? CV_LAST : 0); }
            slot[0] = sv;
        }
        LDS_BARRIER();
    }
    __syncthreads();
}
__device__ __forceinline__ void tail_pull(const Params& p, LAS unsigned char* lds, int ctr_idx) {
    unsigned* ctr = (unsigned*)(p.ws + WS_CVTQ) + 64 * (1 + ctr_idx);
    __syncthreads();
    if (threadIdx.x == 0) (void)xb_add(ctr, 1u);
    cvt_pull(p, lds, 0, ctr, gridDim.x);
}

__device__ __forceinline__ void phase_prologue(const Params& p, LAS unsigned char* lds) {
    int tid = threadIdx.x; asm volatile("" : "+v"(tid));
    unsigned char* ws = p.ws;
    {
        LAS float* cond = (LAS float*)lds;
        LAS float* red = (LAS float*)(lds + 32768);
        for (int i = tid; i < 4 * D; i += 512) { const float v = p.c[i]; cond[i] = siluf_(v); }
        __syncthreads();
        for (int ch = blockIdx.x; ch < 256; ch += gridDim.x) {
            const int l = ch >> 7, j0 = (ch & 127) * 96;
            const float* w = p.w_ada + (size_t)l * D * (6 * D);
            const int kg = tid / 24, cl = tid % 24;
            float acc[4][4];
#pragma unroll
            for (int b = 0; b < 4; ++b)
#pragma unroll
                for (int j = 0; j < 4; ++j) acc[b][j] = 0.f;
            if (kg < 21) {
                for (int it0 = 0; it0 < 98; it0 += 7) {
                    float4 wv[7];
#pragma unroll
                    for (int q = 0; q < 7; ++q) { const int k = kg + 21 * (it0 + q); wv[q] = (k < D) ? *(const float4*)(w + (size_t)k * (6 * D) + j0 + cl * 4) : make_float4(0.f, 0.f, 0.f, 0.f); }
#pragma unroll
                    for (int q = 0; q < 7; ++q) { const int k = kg + 21 * (it0 + q); const int kc = k < D ? k : 0;
#pragma unroll
                        for (int b = 0; b < 4; ++b) { const float cv = cond[b * D + kc]; acc[b][0] += cv * wv[q].x; acc[b][1] += cv * wv[q].y; acc[b][2] += cv * wv[q].z; acc[b][3] += cv * wv[q].w; } }
                }
#pragma unroll
                for (int b = 0; b < 4; ++b)
#pragma unroll
                    for (int j = 0; j < 4; ++j) red[(kg * 4 + b) * 96 + cl * 4 + j] = acc[b][j];
            }
            __syncthreads();
            if (tid < 384) {
                const int b = tid / 96, col = tid % 96; float s = 0.f;
                for (int g = 0; g < 21; ++g) s += red[(g * 4 + b) * 96 + col];
                float* mod = (float*)(ws + WS_MOD);
                mod[((size_t)l * 4 + b) * (6 * D) + j0 + col] = s + p.b_ada[(size_t)l * 6 * D + j0 + col];
            }
            __syncthreads();
        }
    }
    cvt_pull(p, lds, CV_A0, nullptr, 0u);
}

__device__ __forceinline__ void ln_rows(float4 (&v)[8], const float* __restrict__ g, const float* __restrict__ b, int lane) {
    float s = 0.f;
#pragma unroll
    for (int i = 0; i < 8; ++i) s += (v[i].x + v[i].y) + (v[i].z + v[i].w);
    const float mean = wave_sum(s) * (1.0f / D);
    float q = 0.f;
#pragma unroll
    for (int i = 0; i < 8; ++i) { const float a = v[i].x - mean, bb = v[i].y - mean, c = v[i].z - mean, d = v[i].w - mean; q += (a * a + bb * bb) + (c * c + d * d); }
    const float rstd = rsqrtf(wave_sum(q) * (1.0f / D) + 1e-5f);
#pragma unroll
    for (int i = 0; i < 8; ++i) {
        const float4 gv = *(const float4*)(g + i * 256 + lane * 4), bv = *(const float4*)(b + i * 256 + lane * 4);
        v[i].x = (v[i].x - mean) * rstd * gv.x + bv.x; v[i].y = (v[i].y - mean) * rstd * gv.y + bv.y;
        v[i].z = (v[i].z - mean) * rstd * gv.z + bv.z; v[i].w = (v[i].w - mean) * rstd * gv.w + bv.w;
    }
}
__device__ __forceinline__ void modulate_store(const float4 (&v)[8], const float* __restrict__ shift, const float* __restrict__ scale, bf16_t* __restrict__ dst, int lane) {
#pragma unroll
    for (int i = 0; i < 8; ++i) {
        const float4 sh = *(const float4*)(shift + i * 256 + lane * 4), sc = *(const float4*)(scale + i * 256 + lane * 4);
        u32x2 o; o[0] = pack2(v[i].x * (1.f + sc.x) + sh.x, v[i].y * (1.f + sc.y) + sh.y); o[1] = pack2(v[i].z * (1.f + sc.z) + sh.z, v[i].w * (1.f + sc.w) + sh.w);
        *(u32x2*)(dst + i * 256 + lane * 4) = o;
    }
}

__device__ __forceinline__ void phase_ln0(const Params& p) {
    int tid_ = threadIdx.x; asm volatile("" : "+v"(tid_)); const int wave = tid_ >> 6, lane = tid_ & 63;
    const float* mod = (const float*)(p.ws + WS_MOD);
    for (int n = blockIdx.x * 8 + wave; n < T; n += gridDim.x * 8) {
        const int b = n / SEQ;
        float4 v[8];
#pragma unroll
        for (int i = 0; i < 8; ++i) v[i] = *(const float4*)(p.x + (size_t)n * D + i * 256 + lane * 4);
        ln_rows(v, p.emb_g, p.emb_b, lane);
        float* xr = (float*)(p.ws + WS_XRES) + (size_t)n * D;
#pragma unroll
        for (int i = 0; i < 8; ++i) *(float4*)(xr + i * 256 + lane * 4) = v[i];
        const float* mb = mod + ((size_t)0 * 4 + b) * (6 * D);
        modulate_store(v, mb, mb + D, (bf16_t*)(p.ws + WS_HA) + (size_t)n * D, lane);
    }
}

__device__ __forceinline__ void phase_mixer_valu(const Params& p, int l, LAS unsigned char* lds) {
    LAS float* qs = (LAS float*)lds; LAS float* ks = qs + 4096; LAS float* fs = ks + 4096; LAS float* vs = fs + 4096; LAS float* po = vs + 1024;
    int tid = threadIdx.x; asm volatile("" : "+v"(tid)); const int wave = tid >> 6, lane = tid & 63, kk = tid >> 5, vv = tid & 31;
    const bf16_t* proj = (const bf16_t*)(p.ws + WS_PROJ);
    float* obuf = (float*)(p.ws + WS_OBUF);
    for (int u = blockIdx.x; u < 384; u += gridDim.x) {
        const int vsl = u & 3, dir = (u >> 2) & 1, hh = (u >> 3) % 6, b = ((u >> 3) / 6) % 4, type = (u >> 3) / 24;
        float S[8];
#pragma unroll
        for (int j = 0; j < 8; ++j) S[j] = 0.f;
        const float gamma = 1.0f - exp2f(-(dir ? 5.5f : 5.0f) - (float)hh);
        for (int blk = 0; blk < 64; ++blk) {
            const int rb = dir ? 63 - blk : blk, t0 = rb * 32;
            if (type == 0) {
#pragma unroll
                for (int j = 0; j < 4; ++j) {
                    const int idx = tid + 512 * j, tt = idx >> 6, dp = idx & 63;
                    const bf16_t* row = proj + (size_t)(b * SEQ + t0 + tt) * INC;
                    const float q1 = bf2f(row[C_RQ + hh * 128 + dp]), q2 = bf2f(row[C_RQ + hh * 128 + 64 + dp]);
                    const float k1 = bf2f(row[C_RK + hh * 128 + dp]), k2 = bf2f(row[C_RK + hh * 128 + 64 + dp]);
                    const float inv_freq = exp2f(-(float)dp * (13.287712379549449f / 64.0f));
                    const float ang = (float)(t0 + tt) * inv_freq;
                    float rev = ang * 0.15915494309189535f; rev -= rintf(rev);
                    const float sn = __builtin_amdgcn_sinf(rev), cs = __builtin_amdgcn_cosf(rev);
                    qs[tt * 128 + dp] = q1 * cs - q2 * sn; qs[tt * 128 + 64 + dp] = q1 * sn + q2 * cs;
                    ks[tt * 128 + dp] = (k1 * cs - k2 * sn) * 0.08838834764831845f; ks[tt * 128 + 64 + dp] = (k1 * sn + k2 * cs) * 0.08838834764831845f;
                    fs[tt * 128 + dp] = gamma; fs[tt * 128 + 64 + dp] = gamma;
                }
            } else {
#pragma unroll
                for (int j = 0; j < 8; ++j) {
                    const int idx = tid + 512 * j, tt = idx >> 7, d = idx & 127;
                    const bf16_t* row = proj + (size_t)(b * SEQ + t0 + tt) * INC;
                    const float q = bf2f(row[C_HQ + hh * 128 + d]);
                    const float z = bf2f(row[(dir ? C_HFB : C_HFF) + hh * 128 + d]);
                    float lb = 0.f;
                    if (l > 0) { const float a0 = p.lb_logits[(0 * 2 + dir) * HWD + hh * 128 + d], a1 = p.lb_logits[(1 * 2 + dir) * HWD + hh * 128 + d]; lb = 1.0f / (1.0f + expf(a0 - a1)); }
                    float f = lb + (1.0f - lb) * (1.0f / (1.0f + expf(-z)));
                    f = fmaxf(f, 1e-6f);
                    qs[tt * 128 + d] = q; ks[tt * 128 + d] = 1.0f - f; fs[tt * 128 + d] = f;
                }
            }
#pragma unroll
            for (int j = 0; j < 2; ++j) {
                const int idx = tid + 512 * j, tt = idx >> 5, c = idx & 31;
                const bf16_t* row = proj + (size_t)(b * SEQ + t0 + tt) * INC;
                vs[tt * 32 + c] = bf2f(row[(type ? C_HI : C_RV) + hh * 128 + vsl * 32 + c]);
            }
            __syncthreads();
            for (int s = 0; s < 32; ++s) {
                const int ss = dir ? 31 - s : s;
                const f32x4 qa = *(const LAS f32x4*)(qs + ss * 128 + kk * 8), qb = *(const LAS f32x4*)(qs + ss * 128 + kk * 8 + 4);
                const f32x4 ka = *(const LAS f32x4*)(ks + ss * 128 + kk * 8), kb = *(const LAS f32x4*)(ks + ss * 128 + kk * 8 + 4);
                const f32x4 fa = *(const LAS f32x4*)(fs + ss * 128 + kk * 8), fb = *(const LAS f32x4*)(fs + ss * 128 + kk * 8 + 4);
                const float vval = vs[ss * 32 + vv];
                float acc = 0.f;
#pragma unroll
                for (int j = 0; j < 4; ++j) { S[j] = fa[j] * S[j] + ka[j] * vval; acc += S[j] * qa[j]; }
#pragma unroll
                for (int j = 0; j < 4; ++j) { S[4 + j] = fb[j] * S[4 + j] + kb[j] * vval; acc += S[4 + j] * qb[j]; }
                acc += __shfl_xor(acc, 32, 64);
                if (lane < 32) po[(ss * 8 + wave) * 32 + vv] = acc;
            }
            __syncthreads();
#pragma unroll
            for (int j = 0; j < 2; ++j) {
                const int idx = tid + 512 * j, tt = idx >> 5, c = idx & 31;
                float s = 0.f;
#pragma unroll
                for (int w = 0; w < 8; ++w) s += po[(tt * 8 + w) * 32 + c];
                obuf[((size_t)dir * T + (size_t)(b * SEQ + t0 + tt)) * 1536 + type * 768 + hh * 128 + vsl * 32 + c] = s;
            }
        }
        __syncthreads();
    }
}

constexpr int MX_QI = 0, MX_KI = 17408, MX_QS = 34816, MX_KTT = 52224, MX_VT = 70656, MX_P = 79872, MX_ST = 89088, MX_TOT = 106496, MX_DEC = 110592, MX_RQ = 112128, MX_RK = 128512, MX_RV = 144896;
__device__ __forceinline__ float ex2(float x) { return __builtin_amdgcn_exp2f(x); }
__device__ __forceinline__ float clampe(float x) { return fminf(fmaxf(x, -120.f), 120.f); }
template <int MODE>
__device__ __forceinline__ void phase_mixer_mfma(const Params& p, int l, LAS unsigned char* lds, float* __restrict__ obuf) {
    int tid = threadIdx.x; asm volatile("" : "+v"(tid));
    const int wave = __builtin_amdgcn_readfirstlane(tid >> 6), lane = tid & 63, fr = lane & 15, fq = lane >> 4;
    const bf16_t* proj = (const bf16_t*)(p.ws + WS_PROJ);
    for (int u = blockIdx.x; u < 192; u += gridDim.x) {
        const int vsl = u & 1, dir = (u >> 1) & 1, hh = (u >> 2) % 6, b = ((u >> 2) / 6) % 4, type = (u >> 2) / 24;
        float lg2 = 0.f, invf0 = 0.f, invf1 = 0.f, sgn = 1.f, lb0 = 0.f, lb1 = 0.f;
        if (type == 0) {
            const float gamma = 1.0f - exp2f(-(dir ? 5.5f : 5.0f) - (float)hh);
            lg2 = log2f(gamma);
            const int dm0 = (2 * lane) & 63;
            invf0 = exp2f(-(float)dm0 * (13.287712379549449f / 64.0f)); invf1 = exp2f(-(float)(dm0 + 1) * (13.287712379549449f / 64.0f));
            sgn = lane < 32 ? -1.f : 1.f;
        } else if (l > 0) {
            const float* lbl = p.lb_logits + dir * HWD + hh * 128 + 2 * lane;
            lb0 = 1.0f / (1.0f + expf(lbl[0] - lbl[2 * HWD])); lb1 = 1.0f / (1.0f + expf(lbl[1] - lbl[2 * HWD + 1]));
        }
        const int colA = (type ? C_HQ : C_RQ) + hh * 128, colB = (type ? (dir ? C_HFB : C_HFF) : C_RK) + hh * 128;
        const int colV0 = (type ? C_HI : C_RV) + hh * 128 + vsl * 64;
        const int own = 2 * lane, par = (2 * lane + 64) & 127;
        const size_t ocol = (size_t)type * 768 + hh * 128 + vsl * 64;
#define MX_LOAD(ch) do { \
            _Pragma("unroll") for (int i2 = 0; i2 < 2; ++i2) { const int pos = wave * 8 + i2 * 4 + (lane >> 4); const int tau = (ch) * 64 + pos; const int t = dir ? (SEQ - 1 - tau) : tau; \
                const bf16_t* row = proj + (size_t)(b * SEQ + t) * INC + (lane & 15) * 8; \
                __builtin_amdgcn_global_load_lds((const unsigned*)(row + colA), (LAS unsigned*)(lds + MX_RQ + (wave * 8 + i2 * 4) * 256), 16, 0, 0); \
                __builtin_amdgcn_global_load_lds((const unsigned*)(row + colB), (LAS unsigned*)(lds + MX_RK + (wave * 8 + i2 * 4) * 256), 16, 0, 0); } \
            { const int pos = wave * 8 + (lane >> 3); const int tau = (ch) * 64 + pos; const int t = dir ? (SEQ - 1 - tau) : tau; \
              const bf16_t* row = proj + (size_t)(b * SEQ + t) * INC + colV0 + (lane & 7) * 8; \
              __builtin_amdgcn_global_load_lds((const unsigned*)row, (LAS unsigned*)(lds + MX_RV + (wave * 8) * 128), 16, 0, 0); } } while (0)
        f32x4 Sacc[4];
#pragma unroll
        for (int vt = 0; vt < 4; ++vt) Sacc[vt] = (f32x4){0.f, 0.f, 0.f, 0.f};
        for (int i = tid; i < 64 * 272 / 4; i += 512) ((LAS unsigned*)(lds + MX_ST))[i] = 0u;
        float cd0 = 1.f, sd0 = 0.f, cd1 = 1.f, sd1 = 0.f;
        if (type == 0) {
            if (tid < 64) { const float fi = (float)tid; *(LAS f32x4*)(lds + MX_DEC + 512 + tid * 16) = (f32x4){ex2((fi - 31.f) * lg2), ex2((31.f - fi) * lg2), ex2((fi + 1.f) * lg2), ex2((63.f - fi) * lg2)}; }
            const float r0 = invf0 * 0.15915494309189535f, r1 = invf1 * 0.15915494309189535f, sg = dir ? -1.f : 1.f;
            cd0 = __builtin_amdgcn_cosf(r0); sd0 = sg * __builtin_amdgcn_sinf(r0); cd1 = __builtin_amdgcn_cosf(r1); sd1 = sg * __builtin_amdgcn_sinf(r1);
        }
        __syncthreads();
        MX_LOAD(0);
        asm volatile("s_waitcnt vmcnt(0)" ::: "memory");
        __syncthreads();
        for (int ch = 0; ch < 32; ++ch) {
            float q0[8], q1[8], k0[8], k1[8], c0[8], c1[8];
            float run0 = 0.f, run1 = 0.f;
            u32x4 vpk = (u32x4){0u, 0u, 0u, 0u};
#pragma unroll
            for (int j = 0; j < 8; ++j) { q0[j] = q1[j] = k0[j] = k1[j] = c0[j] = c1[j] = 0.f; }
            if (MODE != 3 && MODE != 4) {
            if (type == 0) {
                const int tau0 = ch * 64 + wave * 8; const int t0 = dir ? (SEQ - 1 - tau0) : tau0;
                float rev0 = (float)t0 * invf0 * 0.15915494309189535f, rev1 = (float)t0 * invf1 * 0.15915494309189535f;
                rev0 -= rintf(rev0); rev1 -= rintf(rev1);
                float sn0 = __builtin_amdgcn_sinf(rev0), cs0 = __builtin_amdgcn_cosf(rev0), sn1 = __builtin_amdgcn_sinf(rev1), cs1 = __builtin_amdgcn_cosf(rev1);
#pragma unroll
                for (int j = 0; j < 8; ++j) {
                    const int pos_ = wave * 8 + j;
                    const unsigned ra_ = *(const LAS unsigned*)(lds + MX_RQ + pos_ * 256 + own * 2), rb_ = *(const LAS unsigned*)(lds + MX_RK + pos_ * 256 + own * 2);
                    const unsigned rc_ = *(const LAS unsigned*)(lds + MX_RQ + pos_ * 256 + par * 2), rd_ = *(const LAS unsigned*)(lds + MX_RK + pos_ * 256 + par * 2);
                    const float a_lo = bf2f(ra_ & 0xffffu), a_hi = bf2f(ra_ >> 16), b_lo = bf2f(rb_ & 0xffffu), b_hi = bf2f(rb_ >> 16);
                    const float pa_lo = bf2f(rc_ & 0xffffu), pa_hi = bf2f(rc_ >> 16), pb_lo = bf2f(rd_ & 0xffffu), pb_hi = bf2f(rd_ >> 16);
                    const float ss0 = sgn * sn0, ss1 = sgn * sn1;
                    q0[j] = a_lo * cs0 + pa_lo * ss0; q1[j] = a_hi * cs1 + pa_hi * ss1;
                    k0[j] = (b_lo * cs0 + pb_lo * ss0) * 0.08838834764831845f; k1[j] = (b_hi * cs1 + pb_hi * ss1) * 0.08838834764831845f;
                    const float nc0 = cs0 * cd0 - sn0 * sd0, ns0 = sn0 * cd0 + cs0 * sd0, nc1 = cs1 * cd1 - sn1 * sd1, ns1 = sn1 * cd1 + cs1 * sd1;
                    cs0 = nc0; sn0 = ns0; cs1 = nc1; sn1 = ns1;
                    c0[j] = 0.f; c1[j] = 0.f;
                }
            } else {
#pragma unroll
                for (int j = 0; j < 8; ++j) {
                    const int pos_ = wave * 8 + j;
                    const unsigned ra_ = *(const LAS unsigned*)(lds + MX_RQ + pos_ * 256 + own * 2), rb_ = *(const LAS unsigned*)(lds + MX_RK + pos_ * 256 + own * 2);
                    const float a_lo = bf2f(ra_ & 0xffffu), a_hi = bf2f(ra_ >> 16), b_lo = bf2f(rb_ & 0xffffu), b_hi = bf2f(rb_ >> 16);
                    q0[j] = a_lo; q1[j] = a_hi;
                    float f0 = lb0 + (1.0f - lb0) * __builtin_amdgcn_rcpf(1.0f + ex2(-b_lo * 1.4426950408889634f));
                    float f1 = lb1 + (1.0f - lb1) * __builtin_amdgcn_rcpf(1.0f + ex2(-b_hi * 1.4426950408889634f));
                    f0 = fmaxf(f0, 1e-6f); f1 = fmaxf(f1, 1e-6f);
                    k0[j] = 1.0f - f0; k1[j] = 1.0f - f1;
                    run0 += __builtin_amdgcn_logf(f0); run1 += __builtin_amdgcn_logf(f1); c0[j] = run0; c1[j] = run1;
                }
            }
            { unsigned rv[8];
#pragma unroll
              for (int j = 0; j < 8; ++j) rv[j] = *(const LAS unsigned short*)(lds + MX_RV + (wave * 8 + j) * 128 + lane * 2);
              vpk[0] = rv[0] | (rv[1] << 16); vpk[1] = rv[2] | (rv[3] << 16); vpk[2] = rv[4] | (rv[5] << 16); vpk[3] = rv[6] | (rv[7] << 16); }
            }
            { typedef float f32x2_ __attribute__((ext_vector_type(2))); *(LAS f32x2_*)(lds + MX_TOT + (wave * 128 + 2 * lane) * 4) = (f32x2_){run0, run1}; }
            LDS_BARRIER();
            if (ch + 1 < 32) MX_LOAD(ch + 1);
            float kt0[8], kt1[8];
            float tt0, tt1;
#pragma unroll
            for (int j = 0; j < 8; ++j) { kt0[j] = kt1[j] = 0.f; }
            tt0 = tt1 = 0.f;
            if (MODE != 3 && MODE != 4) {
            if (type == 0) {
                tt0 = tt1 = 64.f * lg2;
#pragma unroll
                for (int j = 0; j < 8; ++j) {
                    const int pos = wave * 8 + j;
                    const f32x4 e = *(const LAS f32x4*)(lds + MX_DEC + 512 + pos * 16);
                    *(LAS unsigned*)(lds + MX_QI + pos * 272 + lane * 4) = pack2(q0[j] * e[0], q1[j] * e[0]);
                    *(LAS unsigned*)(lds + MX_KI + pos * 272 + lane * 4) = pack2(k0[j] * e[1], k1[j] * e[1]);
                    *(LAS unsigned*)(lds + MX_QS + pos * 272 + lane * 4) = pack2(q0[j] * e[2], q1[j] * e[2]);
                    kt0[j] = k0[j] * e[3]; kt1[j] = k1[j] * e[3];
                }
            } else {
                float off0 = 0.f, off1 = 0.f, m0 = 0.f, m1 = 0.f; tt0 = 0.f; tt1 = 0.f;
#pragma unroll
                for (int g = 0; g < 8; ++g) {
                    typedef float f32x2_ __attribute__((ext_vector_type(2)));
                    const f32x2_ tv = *(const LAS f32x2_*)(lds + MX_TOT + (g * 128 + 2 * lane) * 4);
                    if (g < wave) { off0 += tv[0]; off1 += tv[1]; }
                    if (g < 4) { m0 += tv[0]; m1 += tv[1]; }
                    tt0 += tv[0]; tt1 += tv[1];
                }
                const float em0 = ex2(m0), em1 = ex2(m1), etm0 = ex2(tt0 - m0), etm1 = ex2(tt1 - m1);
#pragma unroll
                for (int j = 0; j < 8; ++j) {
                    const float cu0 = c0[j] + off0, cu1 = c1[j] + off1;
                    const float e10 = ex2(clampe(cu0 - m0)), e11 = ex2(clampe(cu1 - m1));
                    const float e20 = __builtin_amdgcn_rcpf(e10), e21 = __builtin_amdgcn_rcpf(e11);
                    const int pos = wave * 8 + j;
                    *(LAS unsigned*)(lds + MX_QI + pos * 272 + lane * 4) = pack2(q0[j] * e10, q1[j] * e11);
                    *(LAS unsigned*)(lds + MX_KI + pos * 272 + lane * 4) = pack2(k0[j] * e20, k1[j] * e21);
                    *(LAS unsigned*)(lds + MX_QS + pos * 272 + lane * 4) = pack2(q0[j] * (e10 * em0), q1[j] * (e11 * em1));
                    kt0[j] = k0[j] * (e20 * etm0); kt1[j] = k1[j] * (e21 * etm1);
                }
            }
            }
            { u32x4 w0, w1;
              w0[0] = pack2(kt0[0], kt0[1]); w0[1] = pack2(kt0[2], kt0[3]); w0[2] = pack2(kt0[4], kt0[5]); w0[3] = pack2(kt0[6], kt0[7]);
              w1[0] = pack2(kt1[0], kt1[1]); w1[1] = pack2(kt1[2], kt1[3]); w1[2] = pack2(kt1[4], kt1[5]); w1[3] = pack2(kt1[6], kt1[7]);
              *(LAS u32x4*)(lds + MX_KTT + (2 * lane) * 144 + wave * 16) = w0;
              *(LAS u32x4*)(lds + MX_KTT + (2 * lane + 1) * 144 + wave * 16) = w1;
              *(LAS u32x4*)(lds + MX_VT + lane * 144 + wave * 16) = vpk; }
            if (wave == 0) { typedef float f32x2_ __attribute__((ext_vector_type(2))); *(LAS f32x2_*)(lds + MX_DEC + lane * 8) = (f32x2_){ex2(tt0), ex2(tt1)}; }
            LDS_BARRIER();
            if (MODE != 2 && MODE != 4) {
                const int it = wave >> 1, st0 = 2 * (wave & 1);
                bf16x8 ka[2][4], qb[4];
#pragma unroll
                for (int kq = 0; kq < 4; ++kq) {
                    qb[kq] = *(const LAS bf16x8*)(lds + MX_QI + (16 * it + fr) * 272 + (32 * kq + 8 * fq) * 2);
                    ka[0][kq] = *(const LAS bf16x8*)(lds + MX_KI + (16 * st0 + fr) * 272 + (32 * kq + 8 * fq) * 2);
                    ka[1][kq] = *(const LAS bf16x8*)(lds + MX_KI + (16 * st0 + 16 + fr) * 272 + (32 * kq + 8 * fq) * 2);
                }
                asm volatile("s_waitcnt lgkmcnt(0)" ::: "memory");
                f32x4 acc0 = (f32x4){0.f, 0.f, 0.f, 0.f}, acc1 = acc0;
#pragma unroll
                for (int kq = 0; kq < 4; ++kq) {
                    acc0 = __builtin_amdgcn_mfma_f32_16x16x32_bf16(ka[0][kq], qb[kq], acc0, 0, 0, 0);
                    acc1 = __builtin_amdgcn_mfma_f32_16x16x32_bf16(ka[1][kq], qb[kq], acc1, 0, 0, 0);
                }
                const int i = 16 * it + fr;
                { const int s0 = 16 * st0 + 4 * fq;
                  const float v0 = (s0 + 0 <= i) ? acc0[0] : 0.f, v1 = (s0 + 1 <= i) ? acc0[1] : 0.f, v2 = (s0 + 2 <= i) ? acc0[2] : 0.f, v3 = (s0 + 3 <= i) ? acc0[3] : 0.f;
                  u32x2 o; o[0] = pack2(v0, v1); o[1] = pack2(v2, v3);
                  *(LAS u32x2*)(lds + MX_P + i * 144 + s0 * 2) = o; }
                { const int s0 = 16 * st0 + 16 + 4 * fq;
                  const float v0 = (s0 + 0 <= i) ? acc1[0] : 0.f, v1 = (s0 + 1 <= i) ? acc1[1] : 0.f, v2 = (s0 + 2 <= i) ? acc1[2] : 0.f, v3 = (s0 + 3 <= i) ? acc1[3] : 0.f;
                  u32x2 o; o[0] = pack2(v0, v1); o[1] = pack2(v2, v3);
                  *(LAS u32x2*)(lds + MX_P + i * 144 + s0 * 2) = o; }
            }
            LDS_BARRIER();
            if (MODE != 2 && MODE != 4) {
                const int vt = wave >> 1, it0 = 2 * (wave & 1);
                bf16x8 va[2], sa[4], pb[2][2], qsb[2][4], kta[2], vb[4][2];
#pragma unroll
                for (int kq = 0; kq < 2; ++kq) {
                    va[kq] = *(const LAS bf16x8*)(lds + MX_VT + (16 * vt + fr) * 144 + (32 * kq + 8 * fq) * 2);
                    pb[0][kq] = *(const LAS bf16x8*)(lds + MX_P + (16 * it0 + fr) * 144 + (32 * kq + 8 * fq) * 2);
                    pb[1][kq] = *(const LAS bf16x8*)(lds + MX_P + (16 * it0 + 16 + fr) * 144 + (32 * kq + 8 * fq) * 2);
                    kta[kq] = *(const LAS bf16x8*)(lds + MX_KTT + (16 * wave + fr) * 144 + (32 * kq + 8 * fq) * 2);
                }
#pragma unroll
                for (int kq = 0; kq < 4; ++kq) {
                    sa[kq] = *(const LAS bf16x8*)(lds + MX_ST + (16 * vt + fr) * 272 + (32 * kq + 8 * fq) * 2);
                    qsb[0][kq] = *(const LAS bf16x8*)(lds + MX_QS + (16 * it0 + fr) * 272 + (32 * kq + 8 * fq) * 2);
                    qsb[1][kq] = *(const LAS bf16x8*)(lds + MX_QS + (16 * it0 + 16 + fr) * 272 + (32 * kq + 8 * fq) * 2);
                }
#pragma unroll
                for (int v4 = 0; v4 < 4; ++v4)
#pragma unroll
                    for (int kq = 0; kq < 2; ++kq) vb[v4][kq] = *(const LAS bf16x8*)(lds + MX_VT + (16 * v4 + fr) * 144 + (32 * kq + 8 * fq) * 2);
                const f32x4 dc = *(const LAS f32x4*)(lds + MX_DEC + (16 * wave + 4 * fq) * 4);
                asm volatile("s_waitcnt lgkmcnt(0)" ::: "memory");
                f32x4 acc0 = (f32x4){0.f, 0.f, 0.f, 0.f}, acc1 = acc0;
#pragma unroll
                for (int kq = 0; kq < 2; ++kq) {
                    acc0 = __builtin_amdgcn_mfma_f32_16x16x32_bf16(va[kq], pb[0][kq], acc0, 0, 0, 0);
                    acc1 = __builtin_amdgcn_mfma_f32_16x16x32_bf16(va[kq], pb[1][kq], acc1, 0, 0, 0);
                }
#pragma unroll
                for (int kq = 0; kq < 4; ++kq) {
                    acc0 = __builtin_amdgcn_mfma_f32_16x16x32_bf16(sa[kq], qsb[0][kq], acc0, 0, 0, 0);
                    acc1 = __builtin_amdgcn_mfma_f32_16x16x32_bf16(sa[kq], qsb[1][kq], acc1, 0, 0, 0);
                }
#pragma unroll
                for (int v4 = 0; v4 < 4; ++v4) {
                    f32x4 a = Sacc[v4]; a[0] *= dc[0]; a[1] *= dc[1]; a[2] *= dc[2]; a[3] *= dc[3];
                    a = __builtin_amdgcn_mfma_f32_16x16x32_bf16(kta[0], vb[v4][0], a, 0, 0, 0);
                    a = __builtin_amdgcn_mfma_f32_16x16x32_bf16(kta[1], vb[v4][1], a, 0, 0, 0);
                    Sacc[v4] = a;
                }
                { const int tau = ch * 64 + 16 * it0 + fr; const int t = dir ? (SEQ - 1 - tau) : tau;
                  *(f32x4*)(obuf + ((size_t)dir * T + (size_t)(b * SEQ + t)) * 1536 + ocol + 16 * vt + 4 * fq) = acc0; }
                { const int tau = ch * 64 + 16 * it0 + 16 + fr; const int t = dir ? (SEQ - 1 - tau) : tau;
                  *(f32x4*)(obuf + ((size_t)dir * T + (size_t)(b * SEQ + t)) * 1536 + ocol + 16 * vt + 4 * fq) = acc1; }
            }
            asm volatile("s_waitcnt vmcnt(2)" ::: "memory");
            LDS_BARRIER();
#pragma unroll
            for (int vt = 0; vt < 4; ++vt) { u32x2 o; o[0] = pack2(Sacc[vt][0], Sacc[vt][1]); o[1] = pack2(Sacc[vt][2], Sacc[vt][3]);
                *(LAS u32x2*)(lds + MX_ST + (16 * vt + fr) * 272 + (16 * wave + 4 * fq) * 2) = o; }
        }
        __syncthreads();
#undef MX_LOAD
    }
}

#ifdef MIXER_CHECK
__device__ __forceinline__ void phase_mixer_check(const Params& p, const float* __restrict__ oa, const float* __restrict__ ob, float* chk) {
    int tid_ = threadIdx.x; asm volatile("" : "+v"(tid_)); const int wave = tid_ >> 6, lane = tid_ & 63;
    for (int r = blockIdx.x * 8 + wave; r < 2 * T; r += gridDim.x * 8) {
        const int dir = r / T;
#pragma unroll
        for (int ty = 0; ty < 2; ++ty) {
            float sd = 0.f, sq = 0.f;
#pragma unroll
            for (int i = 0; i < 3; ++i) { const float4 a = *(const float4*)(oa + (size_t)r * 1536 + ty * 768 + i * 256 + lane * 4), bq = *(const float4*)(ob + (size_t)r * 1536 + ty * 768 + i * 256 + lane * 4);
                sd += (a.x - bq.x) * (a.x - bq.x) + (a.y - bq.y) * (a.y - bq.y) + (a.z - bq.z) * (a.z - bq.z) + (a.w - bq.w) * (a.w - bq.w);
                sq += a.x * a.x + a.y * a.y + a.z * a.z + a.w * a.w; }
            sd = wave_sum(sd); sq = wave_sum(sq);
            if (lane == 0) { atomicAdd(&chk[(ty * 2 + dir) * 2 + 0], sd); atomicAdd(&chk[(ty * 2 + dir) * 2 + 1], sq); }
        }
    }
}
#endif

__device__ __forceinline__ float4 ld_bf4(const bf16_t* p) { const u32x2 r = *(const u32x2*)p; return make_float4(bf2f(r[0] & 0xffffu), bf2f(r[0] >> 16), bf2f(r[1] & 0xffffu), bf2f(r[1] >> 16)); }
__device__ __forceinline__ void phase_finalize(const Params& p, int l) {
    int tid_ = threadIdx.x; asm volatile("" : "+v"(tid_)); const int wave = tid_ >> 6, lane = tid_ & 63;
    const bf16_t* proj = (const bf16_t*)(p.ws + WS_PROJ);
    const float* obuf = (const float*)(p.ws + WS_OBUF);
    bf16_t* mixed = (bf16_t*)(p.ws + WS_MIXED);
    const float* cw = p.conv_w + (size_t)l * 3 * CW;
    const float* beta = p.mix_beta + (size_t)l * D;
    for (int n = blockIdx.x * 8 + wave; n < T; n += gridDim.x * 8) {
        const int t = n % SEQ;
        const bf16_t* row = proj + (size_t)n * INC;
        bf16_t* dst = mixed + (size_t)n * D;
#pragma unroll
        for (int i = 0; i < 8; ++i) {
            const int c = i * 256 + lane * 4;
            float4 r;
            if (i < 2) {
                const float4 cc = ld_bf4(row + C_CC + c), ch = ld_bf4(row + C_CH + c), cb = ld_bf4(row + C_CB + c);
                float4 um = make_float4(0.f, 0.f, 0.f, 0.f), up = um;
                if (t > 0) { const float4 a = ld_bf4(row - INC + C_CC + c), b2 = ld_bf4(row - INC + C_CH + c); um = make_float4(a.x * b2.x, a.y * b2.y, a.z * b2.z, a.w * b2.w); }
                if (t < SEQ - 1) { const float4 a = ld_bf4(row + INC + C_CC + c), b2 = ld_bf4(row + INC + C_CH + c); up = make_float4(a.x * b2.x, a.y * b2.y, a.z * b2.z, a.w * b2.w); }
                const float4 w0 = *(const float4*)(cw + c), w1 = *(const float4*)(cw + CW + c), w2 = *(const float4*)(cw + 2 * CW + c);
                r.x = cb.x * (um.x * w0.x + cc.x * ch.x * w1.x + up.x * w2.x);
                r.y = cb.y * (um.y * w0.y + cc.y * ch.y * w1.y + up.y * w2.y);
                r.z = cb.z * (um.z * w0.z + cc.z * ch.z * w1.z + up.z * w2.z);
                r.w = cb.w * (um.w * w0.w + cc.w * ch.w * w1.w + up.w * w2.w);
            } else {
                const int oc = c - 512;
                const float4 of = *(const float4*)(obuf + (size_t)n * 1536 + oc), ob = *(const float4*)(obuf + ((size_t)T + n) * 1536 + oc);
                float4 o = make_float4(of.x + ob.x, of.y + ob.y, of.z + ob.z, of.w + ob.w);
                float4 gt;
                if (i < 5) {
                    gt = ld_bf4(row + C_RG + oc);
                    const float mu = half_sum((o.x + o.y) + (o.z + o.w)) * (1.0f / 128.0f);
                    o.x -= mu; o.y -= mu; o.z -= mu; o.w -= mu;
                    const float var = half_sum((o.x * o.x + o.y * o.y) + (o.z * o.z + o.w * o.w)) * (1.0f / 128.0f);
                    const float rs = rsqrtf(var + 1e-6f);
                    o.x *= rs; o.y *= rs; o.z *= rs; o.w *= rs;
                } else {
                    gt = ld_bf4(row + C_HG + (oc - 768));
                    const float ms = half_sum((o.x * o.x + o.y * o.y) + (o.z * o.z + o.w * o.w)) * (1.0f / 128.0f);
                    const float rs = rsqrtf(ms + 1e-6f);
                    o.x *= rs; o.y *= rs; o.z *= rs; o.w *= rs;
                }
                r.x = o.x * siluf_(gt.x); r.y = o.y * siluf_(gt.y); r.z = o.z * siluf_(gt.z); r.w = o.w * siluf_(gt.w);
            }
            const float4 bt = *(const float4*)(beta + c);
            u32x2 ov; ov[0] = pack2(r.x * bt.x, r.y * bt.y); ov[1] = pack2(r.z * bt.z, r.w * bt.w);
            *(u32x2*)(dst + c) = ov;
        }
    }
}

__device__ __forceinline__ void phase_ln1_router(const Params& p, int l, LAS unsigned char* lds) {
    int tid = threadIdx.x; asm volatile("" : "+v"(tid)); const int wave = tid >> 6, lane = tid & 63;
    LAS float* wrt = (LAS float*)lds;
    for (int i = tid; i < D * NE / 4; i += 512) {
        const float4 w = *(const float4*)(p.w_router + (size_t)i * 4);
        const int d = i >> 2, e4 = (i & 3) * 4;
        wrt[(e4 + 0) * D + d] = w.x; wrt[(e4 + 1) * D + d] = w.y; wrt[(e4 + 2) * D + d] = w.z; wrt[(e4 + 3) * D + d] = w.w;
    }
    LAS int* lcnt = (LAS int*)(lds + LDS_MISC + 256);
    if (tid < 16) lcnt[tid] = 0;
    __syncthreads();
    const float* mod = (const float*)(p.ws + WS_MOD);
    const float* y = (const float*)(p.ws + WS_Y);
    float* xres = (float*)(p.ws + WS_XRES);
    int* route = (int*)(p.ws + WS_ROUTE);
    for (int n = blockIdx.x * 8 + wave; n < T; n += gridDim.x * 8) {
        const int b = n / SEQ;
        const float* mb = mod + ((size_t)l * 4 + b) * (6 * D);
        float4 v[8];
#pragma unroll
        for (int i = 0; i < 8; ++i) {
            const float4 xv = *(const float4*)(xres + (size_t)n * D + i * 256 + lane * 4), yv = *(const float4*)(y + (size_t)n * D + i * 256 + lane * 4);
            const float4 g = *(const float4*)(mb + 2 * D + i * 256 + lane * 4);
            v[i].x = ALPHA * xv.x + (1.f + g.x) * yv.x; v[i].y = ALPHA * xv.y + (1.f + g.y) * yv.y; v[i].z = ALPHA * xv.z + (1.f + g.z) * yv.z; v[i].w = ALPHA * xv.w + (1.f + g.w) * yv.w;
        }
        ln_rows(v, p.ln_g + (size_t)(l * 2 + 0) * D, p.ln_b + (size_t)(l * 2 + 0) * D, lane);
#pragma unroll
        for (int i = 0; i < 8; ++i) *(float4*)(xres + (size_t)n * D + i * 256 + lane * 4) = v[i];
#pragma unroll
        for (int i = 0; i < 8; ++i) {
            const float4 sh = *(const float4*)(mb + 3 * D + i * 256 + lane * 4), sc = *(const float4*)(mb + 4 * D + i * 256 + lane * 4);
            v[i].x = v[i].x * (1.f + sc.x) + sh.x; v[i].y = v[i].y * (1.f + sc.y) + sh.y; v[i].z = v[i].z * (1.f + sc.z) + sh.z; v[i].w = v[i].w * (1.f + sc.w) + sh.w;
        }
#if MOE_FP8
        unsigned char* hb = p.ws + WS_HB + (size_t)n * D;
#pragma unroll
        for (int i = 0; i < 8; ++i) { int o = __builtin_amdgcn_cvt_pk_fp8_f32(v[i].x, v[i].y, 0, false); o = __builtin_amdgcn_cvt_pk_fp8_f32(v[i].z, v[i].w, o, true); *(int*)(hb + i * 256 + lane * 4) = o; }
#else
        bf16_t* hb = (bf16_t*)(p.ws + WS_HB) + (size_t)n * D;
#pragma unroll
        for (int i = 0; i < 8; ++i) { u32x2 o; o[0] = pack2(v[i].x, v[i].y); o[1] = pack2(v[i].z, v[i].w); *(u32x2*)(hb + i * 256 + lane * 4) = o; }
#endif
        float lgv = 0.f;
#pragma unroll 1
        for (int e = 0; e < 16; ++e) {
            float s = 0.f;
#pragma unroll
            for (int i = 0; i < 8; ++i) { const f32x4 w = *(const LAS f32x4*)(wrt + e * D + i * 256 + lane * 4); s += (v[i].x * w[0] + v[i].y * w[1]) + (v[i].z * w[2] + v[i].w * w[3]); }
            s = wave_sum(s);
            lgv = (lane == e) ? s : lgv;
        }
        float lg[16];
#pragma unroll
        for (int e = 0; e < 16; ++e) lg[e] = __int_as_float(__builtin_amdgcn_readlane(__float_as_int(lgv), e));
        float mx = lg[0];
#pragma unroll
        for (int e = 1; e < 16; ++e) mx = fmaxf(mx, lg[e]);
        float sc[16], sum = 0.f;
#pragma unroll
        for (int e = 0; e < 16; ++e) { sc[e] = expf(lg[e] - mx); sum += sc[e]; }
        const float inv = 1.0f / sum;
        float sel[16];
#pragma unroll
        for (int e = 0; e < 16; ++e) { sc[e] *= inv; sel[e] = sc[e] + p.router_bias[e]; }
        float best_gs = -3.0e38f; int bi0 = 0, bi1 = 1; float bw0 = 0.f, bw1 = 0.f;
#pragma unroll
        for (int g = 0; g < 4; ++g) {
            int i0 = 0; float m0 = sel[4 * g];
#pragma unroll
            for (int j = 1; j < 4; ++j) if (sel[4 * g + j] > m0) { m0 = sel[4 * g + j]; i0 = j; }
            int i1 = -1; float m1 = -3.0e38f;
#pragma unroll
            for (int j = 0; j < 4; ++j) if (j != i0 && sel[4 * g + j] > m1) { m1 = sel[4 * g + j]; i1 = j; }
            float w0 = 0.f, w1 = 0.f;
#pragma unroll
            for (int j = 0; j < 4; ++j) { w0 = (j == i0) ? sc[4 * g + j] : w0; w1 = (j == i1) ? sc[4 * g + j] : w1; }
            const float gs = m0 + m1;
            if (gs > best_gs) { best_gs = gs; bi0 = 4 * g + i0; bi1 = 4 * g + i1; bw0 = w0; bw1 = w1; }
        }
        if (lane == 0) {
            const float ws_ = 1.0f / (bw0 + bw1);
            const int p0 = __hip_atomic_fetch_add(&lcnt[bi0], 1, __ATOMIC_RELAXED, __HIP_MEMORY_SCOPE_WORKGROUP), p1 = __hip_atomic_fetch_add(&lcnt[bi1], 1, __ATOMIC_RELAXED, __HIP_MEMORY_SCOPE_WORKGROUP);
            int* r = route + (size_t)n * 8;
            r[0] = bi0; r[1] = bi1; r[2] = (int)p0; r[3] = (int)p1; r[4] = __float_as_int(bw0 * ws_); r[5] = __float_as_int(bw1 * ws_);
        }
    }
    __syncthreads();
    if (tid < 16) ((int*)(p.ws + WS_WGCNT))[((size_t)l * 1024 + blockIdx.x) * 16 + tid] = lcnt[tid];
}

__device__ __forceinline__ void build_moe_tab(const Params& p, int l, LAS int* tab) {
    if (threadIdx.x == 0) {
        const unsigned* cnt = (const unsigned*)(p.ws + WS_CNT) + l * 16;
        int acc = 0;
        for (int e = 0; e < 16; ++e) { tab[e] = acc; acc += (int)((cnt[e] + 255u) >> 8); }
        tab[16] = acc;
    }
    __syncthreads();
}

__device__ __forceinline__ void phase_permute(const Params& p, int l, LAS int* tab) {
    int tid_ = threadIdx.x; asm volatile("" : "+v"(tid_)); const int wave = tid_ >> 6, lane = tid_ & 63;
    LAS int* base = tab + 32; LAS int* total = tab + 48;
    if (tid_ < 16) { base[tid_] = 0; total[tid_] = 0; }
    __syncthreads();
    {
        const int* wgc = (const int*)(p.ws + WS_WGCNT) + (size_t)l * 1024 * 16;
        const int e = tid_ & 15; int bs = 0, tt = 0;
        for (int w = tid_ >> 4; w < (int)gridDim.x; w += 32) { const int v = wgc[w * 16 + e]; tt += v; bs += (w < (int)blockIdx.x) ? v : 0; }
        __hip_atomic_fetch_add(&base[e], bs, __ATOMIC_RELAXED, __HIP_MEMORY_SCOPE_WORKGROUP);
        __hip_atomic_fetch_add(&total[e], tt, __ATOMIC_RELAXED, __HIP_MEMORY_SCOPE_WORKGROUP);
    }
    __syncthreads();
    if (tid_ == 0) { int acc = 0; for (int e = 0; e < 16; ++e) { tab[e] = acc; acc += (total[e] + 255) >> 8; } tab[16] = acc; }
    if (blockIdx.x == 0 && tid_ < 16) ((unsigned*)(p.ws + WS_CNT))[l * 16 + tid_] = (unsigned)total[tid_];
    __syncthreads();
#if MOE_FP8
    for (int i = blockIdx.x * 512 + tid_; i < XE_ROWS * 8; i += gridDim.x * 512) *(u32x4*)(p.ws + WS_HID + (size_t)(i >> 3) * DEP + DE + (i & 7) * 16) = (u32x4){0u, 0u, 0u, 0u};
#endif
    int* route = (int*)(p.ws + WS_ROUTE);
    const bf16_t* hb = (const bf16_t*)(p.ws + WS_HB);
    bf16_t* xe = (bf16_t*)(p.ws + WS_XE);
    for (int n = blockIdx.x * 8 + wave; n < T; n += gridDim.x * 8) {
        int* r = route + (size_t)n * 8;
        const int e0 = r[0], e1 = r[1], p0 = r[2], p1 = r[3];
        const int row0 = tab[e0] * 256 + base[e0] + p0, row1 = tab[e1] * 256 + base[e1] + p1;
        constexpr int RB = MOE_FP8 ? D : 2 * D;
        const u32x4* src = (const u32x4*)((const unsigned char*)hb + (size_t)n * RB);
        u32x4* d0 = (u32x4*)((unsigned char*)xe + (size_t)row0 * RB); u32x4* d1 = (u32x4*)((unsigned char*)xe + (size_t)row1 * RB);
#pragma unroll
        for (int i = 0; i < RB / 1024; ++i) { const u32x4 v = src[i * 64 + lane]; d0[i * 64 + lane] = v; d1[i * 64 + lane] = v; }
        if (lane == 0) { r[6] = row0; r[7] = row1; }
    }
}

__device__ __forceinline__ void phase_ln2(const Params& p, int l) {
    int tid_ = threadIdx.x; asm volatile("" : "+v"(tid_)); const int wave = tid_ >> 6, lane = tid_ & 63;
    const float* mod = (const float*)(p.ws + WS_MOD);
    const float* ye = (const float*)(p.ws + WS_YE);
    float* xres = (float*)(p.ws + WS_XRES);
    const int* route = (const int*)(p.ws + WS_ROUTE);
    for (int n = blockIdx.x * 8 + wave; n < T; n += gridDim.x * 8) {
        const int b = n / SEQ;
        const float* mb = mod + ((size_t)l * 4 + b) * (6 * D);
        const int* r = route + (size_t)n * 8;
        const float w0 = __int_as_float(r[4]), w1 = __int_as_float(r[5]);
        const float* y0 = ye + (size_t)r[6] * D; const float* y1 = ye + (size_t)r[7] * D;
        float4 v[8];
#pragma unroll
        for (int i = 0; i < 8; ++i) {
            const float4 xv = *(const float4*)(xres + (size_t)n * D + i * 256 + lane * 4);
            const float4 a = *(const float4*)(y0 + i * 256 + lane * 4), c = *(const float4*)(y1 + i * 256 + lane * 4);
            const float4 g = *(const float4*)(mb + 5 * D + i * 256 + lane * 4);
            v[i].x = ALPHA * xv.x + (1.f + g.x) * (w0 * a.x + w1 * c.x); v[i].y = ALPHA * xv.y + (1.f + g.y) * (w0 * a.y + w1 * c.y);
            v[i].z = ALPHA * xv.z + (1.f + g.z) * (w0 * a.z + w1 * c.z); v[i].w = ALPHA * xv.w + (1.f + g.w) * (w0 * a.w + w1 * c.w);
        }
        ln_rows(v, p.ln_g + (size_t)(l * 2 + 1) * D, p.ln_b + (size_t)(l * 2 + 1) * D, lane);
        if (l + 1 < DEPTH) {
#pragma unroll
            for (int i = 0; i < 8; ++i) *(float4*)(xres + (size_t)n * D + i * 256 + lane * 4) = v[i];
            const float* mn = mod + ((size_t)(l + 1) * 4 + b) * (6 * D);
            modulate_store(v, mn, mn + D, (bf16_t*)(p.ws + WS_HA) + (size_t)n * D, lane);
        } else {
#ifdef MIXER_CHECK
            { const float* chk = (const float*)(p.ws + WS_CNT + 1024); float scale = 1.f;
              for (int j = 7; j >= 0; --j) { const float sd = chk[j * 2], sq = chk[j * 2 + 1]; if (!(sd <= 1e-3f * sq)) scale = 1.0f + 0.25f * (float)(1 << (j & 3)) + 8.f * (float)(j >> 2); }
#pragma unroll
              for (int i = 0; i < 8; ++i) { v[i].x *= scale; v[i].y *= scale; v[i].z *= scale; v[i].w *= scale; } }
#endif
#pragma unroll
            for (int i = 0; i < 8; ++i) *(float4*)(p.out + (size_t)n * D + i * 256 + lane * 4) = v[i];
        }
    }
}

typedef const __attribute__((address_space(4))) unsigned char* KargPtr;
__device__ __forceinline__ Params load_params(KargPtr q) { asm volatile("" : "+s"(q)); Params lp; __builtin_memcpy(&lp, q, sizeof(Params)); return lp; }

__global__ __launch_bounds__(512, 2) void mega(Params p_in) {
    extern __shared__ __attribute__((aligned(16))) unsigned char smem[];
    LAS unsigned char* lds = (LAS unsigned char*)smem;
    LAS int* tab = (LAS int*)(lds + LDS_MISC + 64);
    KargPtr kp = (KargPtr)__builtin_amdgcn_kernarg_segment_ptr();
    if (threadIdx.x == 0) { *(LAS u32x4*)(lds + LDS_MISC) = (u32x4){0u, 0u, 0u, 0u}; }
    __syncthreads();
    const int fused = p_in.fused, ph_lo = p_in.ph_lo, ph_hi = p_in.ph_hi, l_hi = p_in.l_hi;
    XcdBarrier bar;
    if (fused) bar = xcd_barrier_post((unsigned*)(p_in.ws + WS_BAR), (volatile LAS unsigned*)(lds + LDS_MISC));
    else { bar.bar = (unsigned*)(p_in.ws + WS_BAR); bar.x = 0; bar.st = (volatile LAS unsigned*)(lds + LDS_MISC); }
#ifdef ONLY_PH
#define PH(i) ((i) == ONLY_PH && ph_lo <= (i) && (i) < ph_hi)
#else
#define PH(i) (ph_lo <= (i) && (i) < ph_hi)
#endif
#define SYNC() do { if (fused) xcd_barrier(bar); } while (0)
#ifndef DUP_MASK
#define DUP_MASK 0
#endif
#define REP(i) _Pragma("unroll 1") for (int rep_ = 0; rep_ < 1 + ((DUP_MASK >> (i)) & 1); ++rep_)
    const int G = gridDim.x, c = blockIdx.x;
    if (PH(0)) REP(0) { const Params p = load_params(kp); phase_prologue(p, lds); SYNC(); }
    if (PH(1)) REP(1) { const Params p = load_params(kp); phase_ln0(p); SYNC(); }
    for (int l = p_in.l_lo; l < l_hi; ++l) {
        const bool split_in = (G >= 224);
        if (PH(2)) REP(2) {
            const Params p = load_params(kp);
            pg8::DenseOrder S; S.init(T, split_in ? INC - 256 : INC, D, G, c);
            pg8::Gemm g{(const bf16_t*)(p.ws + WS_HA), (const bf16_t*)(p.ws + WS_WIN) + (size_t)l * INC * D, D};
            pg8::EpiBf16 E{(bf16_t*)(p.ws + WS_PROJ), INC};
            pg8::gemm_phase(lds, g, S, E);
            if (!split_in) tail_pull(p, lds, l * 4 + 0);
            SYNC();
        }
#ifdef MIXER_CHECK
        if (PH(3)) REP(3) { const Params p = load_params(kp); phase_mixer_valu(p, l, lds); SYNC(); }
        if (PH(3)) REP(3) { const Params p = load_params(kp); phase_mixer_mfma<0>(p, l, lds, (float*)(p.ws + WS_XE)); SYNC(); }
        if (PH(3)) REP(3) { const Params p = load_params(kp); phase_mixer_check(p, (const float*)(p.ws + WS_OBUF), (const float*)(p.ws + WS_XE), (float*)(p.ws + WS_CNT + 1024) + l * 8); SYNC(); }
#else
        if (PH(3)) REP(3) {
            const Params p = load_params(kp);
            if (split_in && c >= 192 && c < 224) {
                pg8::OneUnit S; S.u0.aB = (size_t)(c - 192) * 256 * D * 2; S.u0.bB = (size_t)32 * 256 * D * 2; S.u0.row0 = (c - 192) * 256; S.u0.col0 = 32 * 256;
                pg8::Gemm g{(const bf16_t*)(p.ws + WS_HA), (const bf16_t*)(p.ws + WS_WIN) + (size_t)l * INC * D, D};
                pg8::EpiBf16 E{(bf16_t*)(p.ws + WS_PROJ), INC};
                pg8::gemm_phase(lds, g, S, E);
            }
            phase_mixer_mfma<0>(p, l, lds, (float*)(p.ws + WS_OBUF));
            tail_pull(p, lds, l * 4 + 1);
            SYNC();
#ifdef MIXER_PROBE
            phase_mixer_mfma<MIXER_PROBE>(p, l, lds, (float*)(p.ws + WS_XE));
            SYNC();
#endif
        }
#endif
        if (PH(4)) REP(4) { const Params p = load_params(kp); phase_finalize(p, l); SYNC(); }
        if (PH(5)) REP(5) {
            const Params p = load_params(kp);
            pg8::DenseOrder S; S.init(T, D, D, G, c);
            pg8::Gemm g{(const bf16_t*)(p.ws + WS_MIXED), (const bf16_t*)(p.ws + WS_WOUT) + (size_t)l * D * D, D};
            pg8::EpiF32 E{(float*)(p.ws + WS_Y), D};
            pg8::gemm_phase(lds, g, S, E);
            SYNC();
        }
        if (PH(6)) REP(6) { const Params p = load_params(kp); phase_ln1_router(p, l, lds); SYNC(); }
        if (PH(7)) REP(7) { const Params p = load_params(kp); phase_permute(p, l, tab); cvt_pull(p, lds, l * CV_PER_L + CV_A1, nullptr, 0u); SYNC(); }
        if (PH(8)) REP(8) {
            const Params p = load_params(kp);
            build_moe_tab(p, l, tab);
#if MOE_FP8
            pg8::MoeOrder S; S.tab = tab; S.NTn = 11; S.G = G; S.c = c; S.tstep = (size_t)256 * D; S.bexp = (size_t)2 * DE * D;
            pg8::Gemm g{(const bf16_t*)(p.ws + WS_XE), (const bf16_t*)(p.ws + WS_WGU + (size_t)l * NE * 2 * DE * D), D};
            pg8::EpiHidden8 E{p.ws + WS_HID};
            pg8::gemm_phase<pg8::EpiHidden8, pg8::MoeOrder, true>(lds, g, S, E, 121, 127);
#else
            pg8::MoeOrder S; S.tab = tab; S.NTn = 11; S.G = G; S.c = c; S.tstep = (size_t)256 * D * 2; S.bexp = (size_t)2 * DE * D * 2;
            pg8::Gemm g{(const bf16_t*)(p.ws + WS_XE), (const bf16_t*)(p.ws + WS_WGU) + (size_t)l * NE * 2 * DE * D, D};
            pg8::EpiHidden E{(bf16_t*)(p.ws + WS_HID)};
            pg8::gemm_phase(lds, g, S, E);
#endif
            tail_pull(p, lds, l * 4 + 2);
            cvt_pull(p, lds, (l + 1) * CV_PER_L, nullptr, 0u);
            SYNC();
        }
        if (PH(9)) REP(9) {
            const Params p = load_params(kp);
            build_moe_tab(p, l, tab);
#if MOE_FP8
            pg8::MoeOrder S; S.tab = tab; S.NTn = 8; S.G = G; S.c = c; S.tstep = (size_t)256 * DEP; S.bexp = (size_t)D * DEP;
            pg8::Gemm g{(const bf16_t*)(p.ws + WS_HID), (const bf16_t*)(p.ws + WS_WD + (size_t)l * NE * D * DEP), DEP};
            pg8::EpiF32 E{(float*)(p.ws + WS_YE), D};
            pg8::gemm_phase<pg8::EpiF32, pg8::MoeOrder, true>(lds, g, S, E, 121, 124);
#else
            pg8::MoeOrder S; S.tab = tab; S.NTn = 8; S.G = G; S.c = c; S.tstep = (size_t)256 * DE * 2; S.bexp = (size_t)D * DE * 2;
            pg8::Gemm g{(const bf16_t*)(p.ws + WS_HID), (const bf16_t*)(p.ws + WS_WD) + (size_t)l * NE * D * DE, DE};
            pg8::EpiF32 E{(float*)(p.ws + WS_YE), D};
            pg8::gemm_phase(lds, g, S, E);
#endif
            tail_pull(p, lds, l * 4 + 3);
            if (l + 1 < DEPTH) cvt_pull(p, lds, (l + 1) * CV_PER_L + CV_A0, nullptr, 0u);
            SYNC();
        }
        if (PH(10)) REP(10) { const Params p = load_params(kp); phase_ln2(p, l); SYNC(); }
    }
}

#ifndef MK_FUSED
#define MK_FUSED 1
#endif
extern "C" void kernel_launch(void* const* d_in, const int* in_sizes, int n_in, void* d_out, int out_size, void* d_ws, size_t ws_size, hipStream_t stream) {
    static int grid = 0;
    if (grid == 0) {
        if (n_in != 18 || ws_size < WS_END) { fprintf(stderr, "kernel_launch: unexpected n_in %d or ws_size %zu (< %zu)\n", n_in, ws_size, (size_t)WS_END); grid = -1; return; }
        int dev = 0, cus = 0, per_cu = 0;
        hipGetDevice(&dev);
        hipDeviceGetAttribute(&cus, hipDeviceAttributeMultiprocessorCount, dev);
        if (hipFuncSetAttribute((const void*)mega, hipFuncAttributeMaxDynamicSharedMemorySize, LDS_BYTES) != hipSuccess) { fprintf(stderr, "kernel_launch: hipFuncSetAttribute failed\n"); grid = -1; return; }
        hipOccupancyMaxActiveBlocksPerMultiprocessor(&per_cu, (const void*)mega, 512, LDS_BYTES);
        if (per_cu < 1) fprintf(stderr, "kernel_launch: occupancy query says %d\n", per_cu);
        grid = cus > 0 ? cus : 256;
    }
    if (grid < 0) return;
    hipMemsetAsync(d_ws, 0, WS_ZERO_BYTES, stream);
    Params p{};
    p.x = (const float*)d_in[0]; p.c = (const float*)d_in[1]; p.emb_g = (const float*)d_in[2]; p.emb_b = (const float*)d_in[3];
    p.w_ada = (const float*)d_in[4]; p.b_ada = (const float*)d_in[5]; p.w_in = (const float*)d_in[6]; p.conv_w = (const float*)d_in[7];
    p.mix_beta = (const float*)d_in[8]; p.w_out = (const float*)d_in[9]; p.lb_logits = (const float*)d_in[10]; p.ln_g = (const float*)d_in[11];
    p.ln_b = (const float*)d_in[12]; p.w_router = (const float*)d_in[13]; p.router_bias = (const float*)d_in[14]; p.w_gate = (const float*)d_in[15];
    p.w_up = (const float*)d_in[16]; p.w_down = (const float*)d_in[17];
    p.out = (float*)d_out; p.ws = (unsigned char*)d_ws; p.pad = 0;
#if MK_FUSED
    p.ph_lo = 0; p.ph_hi = 11; p.l_lo = 0; p.l_hi = DEPTH; p.fused = 1;
    hipLaunchKernelGGL(mega, dim3(grid), dim3(512), LDS_BYTES, stream, p);
#else
    p.fused = 0;
    for (int ph = 0; ph < 2; ++ph) { p.ph_lo = ph; p.ph_hi = ph + 1; p.l_lo = 0; p.l_hi = 0; hipLaunchKernelGGL(mega, dim3(grid), dim3(512), LDS_BYTES, stream, p); }
    for (int l = 0; l < DEPTH; ++l)
        for (int ph = 2; ph < 11; ++ph) { p.ph_lo = ph; p.ph_hi = ph + 1; p.l_lo = l; p.l_hi = l + 1; hipLaunchKernelGGL(mega, dim3(grid), dim3(512), LDS_BYTES, stream, p); }
#endif
}
```

```cpp
#include <hip/hip_runtime.h>
#include <stdint.h>
#include <stdio.h>

#define LAS __attribute__((address_space(3)))
typedef unsigned short bf16_t;
typedef short bf16x8 __attribute__((ext_vector_type(8)));
typedef float f32x4 __attribute__((ext_vector_type(4)));
typedef unsigned u32x4 __attribute__((ext_vector_type(4)));
typedef unsigned u32x2 __attribute__((ext_vector_type(2)));

constexpr int D = 2048, NB = 4, SEQ = 2048, T = NB * SEQ, DEPTH = 2;
constexpr int CW = 512, RW = 768, HWD = 768, INC = 8448;
constexpr int NE = 16, DE = 1408;
constexpr int C_CB = 0, C_CC = 512, C_CH = 1024, C_RQ = 1536, C_RK = 2304, C_RV = 3072, C_RG = 3840, C_HQ = 4608, C_HFF = 5376, C_HFB = 6144, C_HI = 6912, C_HG = 7680;
constexpr int XE_ROWS = 20480;
#ifndef MOE_FP8
#define MOE_FP8 1
#endif
#ifndef INP_FP8_FROM
#define INP_FP8_FROM 1
#endif
#define INP8(l) ((l) >= INP_FP8_FROM)
#ifndef OUT_FP8_FROM
#define OUT_FP8_FROM 1
#endif
#define OUT8(l) ((l) >= OUT_FP8_FROM)
constexpr int DEP = 1536;
constexpr float W8_SCALE = 64.f, H8_SCALE = 8.f;
constexpr float ALPHA = 1.4142135623730951f;

constexpr size_t WS_BAR = 0;
constexpr size_t WS_CNT = 16384;
constexpr size_t WS_CVTQ = 20480;
constexpr size_t WS_ZERO_BYTES = 32768;
constexpr size_t WS_MOD = 32768;
constexpr size_t WS_ROUTE = WS_MOD + 393216;
constexpr size_t WS_WGCNT = WS_ROUTE + 262144;
constexpr size_t WS_WIN = 1048576;
constexpr size_t SZ_WIN = (size_t)DEPTH * INC * D * 2;
constexpr size_t WS_WOUT = WS_WIN + SZ_WIN;
constexpr size_t SZ_WOUT = (size_t)DEPTH * D * D * 2;
constexpr size_t WS_WGU = WS_WOUT + SZ_WOUT;
constexpr size_t SZ_WGU = (size_t)DEPTH * NE * 2 * DE * D * 2;
constexpr size_t WS_WD = WS_WGU + SZ_WGU;
constexpr size_t SZ_WD = (size_t)DEPTH * NE * D * DE * 2;
constexpr size_t WS_XRES = WS_WD + SZ_WD;
constexpr size_t SZ_XRES = (size_t)T * D * 4;
constexpr size_t WS_HA = WS_XRES + SZ_XRES;
constexpr size_t SZ_H = (size_t)T * D * 2;
constexpr size_t WS_HB = WS_HA + SZ_H;
constexpr size_t WS_PROJ = WS_HB + SZ_H;
constexpr size_t SZ_PROJ = (size_t)T * INC * 2;
constexpr size_t WS_OBUF = WS_PROJ + SZ_PROJ;
constexpr size_t SZ_OBUF = (size_t)2 * T * 1536 * 4;
constexpr size_t WS_YE = WS_PROJ;
constexpr size_t SZ_YE = (size_t)XE_ROWS * D * 4;
static_assert(SZ_YE <= SZ_PROJ + SZ_OBUF, "ye alias");
constexpr size_t WS_MIXED = WS_OBUF + SZ_OBUF;
constexpr size_t WS_Y = WS_MIXED + SZ_H;
constexpr size_t SZ_Y = (size_t)T * D * 4;
constexpr size_t WS_XE = WS_Y + SZ_Y;
constexpr size_t SZ_XE = (size_t)XE_ROWS * D * 2;
constexpr size_t WS_HID = WS_XE + SZ_XE;
constexpr size_t SZ_HID = (size_t)XE_ROWS * DE * 2;
constexpr size_t WS_END = WS_HID + SZ_HID;

constexpr int LDS_BYTES = 156672;
constexpr int LDS_MISC = 153600;

struct Params {
    const float *x, *c, *emb_g, *emb_b, *w_ada, *b_ada, *w_in, *conv_w, *mix_beta, *w_out, *lb_logits, *ln_g, *ln_b, *w_router, *router_bias, *w_gate, *w_up, *w_down;
    float* out;
    unsigned char* ws;
    int ph_lo, ph_hi, l_lo, l_hi, fused, pad;
};

__device__ __forceinline__ float bf2f(unsigned b) { return __uint_as_float(b << 16); }
__device__ __forceinline__ unsigned f2bf(float f) { unsigned u = __float_as_uint(f); u += 0x7FFFu + ((u >> 16) & 1u); return u >> 16; }
typedef __bf16 bf16x2_t __attribute__((ext_vector_type(2)));
typedef float f32x2_t __attribute__((ext_vector_type(2)));
__device__ __forceinline__ unsigned pack2a(float lo, float hi) { unsigned r; asm("v_cvt_pk_bf16_f32 %0, %1, %2" : "=v"(r) : "v"(lo), "v"(hi)); return r; }
__device__ __forceinline__ unsigned pack2(float lo, float hi) { const bf16x2_t r = __builtin_convertvector((f32x2_t){lo, hi}, bf16x2_t); return __builtin_bit_cast(unsigned, r); }
__device__ __forceinline__ float wave_sum(float v) {
#pragma unroll
    for (int o = 32; o > 0; o >>= 1) v += __shfl_xor(v, o, 64);
    return v;
}
__device__ __forceinline__ float half_sum(float v) {
#pragma unroll
    for (int o = 16; o > 0; o >>= 1) v += __shfl_xor(v, o, 64);
    return v;
}
#define LDS_BARRIER() do { asm volatile("s_waitcnt lgkmcnt(0)" ::: "memory"); __builtin_amdgcn_s_barrier(); asm volatile("" ::: "memory"); } while (0)
__device__ __forceinline__ float sigmoidf_(float z) { return 1.0f / (1.0f + __expf(-z)); }
__device__ __forceinline__ float siluf_(float z) { return z / (1.0f + __expf(-z)); }

#define XB_TMO      128
#define XB_XCNT(j)  (256  + 64 * (j))
#define XB_XSUB(j)  (1280 + 64 * (j))
#define XB_XGEN(j)  (2304 + 64 * (j))
#define XB_TOP      3328
#define XB_TOPGEN   3392
#define XCD_BAR_WORDS 3456
#define XB_SPIN_CAP (1u << 22)
__device__ __forceinline__ unsigned xb_ld(unsigned* p)              { return __hip_atomic_load(p, __ATOMIC_RELAXED, __HIP_MEMORY_SCOPE_AGENT); }
__device__ __forceinline__ unsigned xb_add(unsigned* p, unsigned v) { return __hip_atomic_fetch_add(p, v, __ATOMIC_RELAXED, __HIP_MEMORY_SCOPE_AGENT); }
__device__ __forceinline__ unsigned xb_xcc_id() { return (unsigned)__builtin_amdgcn_s_getreg((3 << 11) | 20) & 0xFu; }
#define XB_SPIN(cond, bar) do { unsigned _sp = 0; while (cond) { __builtin_amdgcn_s_sleep(1); \
    if ((++_sp & 255u) == 0u) { if (xb_ld(&(bar)[XB_TMO])) break; if (_sp > XB_SPIN_CAP) { atomicAdd(&(bar)[XB_TMO], 1u); break; } } } } while (0)
struct XcdBarrier { unsigned* bar; unsigned x; volatile LAS unsigned* st; };
__device__ __forceinline__ XcdBarrier xcd_barrier_post(unsigned* bar, volatile LAS unsigned* st) {
    XcdBarrier b; b.bar = bar; b.x = xb_xcc_id(); b.st = st;
    if (threadIdx.x == 0) (void)xb_add(&bar[XB_XCNT(b.x)], 1u);
    return b;
}
__device__ __forceinline__ void xcd_barrier_complete(unsigned* bar, unsigned x, unsigned& nloc, unsigned& nx) {
    const unsigned G = gridDim.x * gridDim.y * gridDim.z;
    unsigned sum, cnt, mine, sp = 0u;
    for (;;) {
        sum = 0u; cnt = 0u; mine = 0u;
#pragma unroll
        for (unsigned j = 0; j < 16; ++j) { const unsigned c = xb_ld(&bar[XB_XCNT(j)]); sum += c; cnt += (c > 0u) ? 1u : 0u; mine = (j == x) ? c : mine; }
        if (sum == G) break;
        __builtin_amdgcn_s_sleep(1);
        if ((++sp & 255u) == 0u) { if (xb_ld(&bar[XB_TMO])) break; if (sp > XB_SPIN_CAP) { atomicAdd(&bar[XB_TMO], 1u); break; } }
    }
    nloc = mine > 0u ? mine : 1u; nx = cnt > 0u ? cnt : 1u;
}
__device__ __forceinline__ void xcd_barrier(const XcdBarrier& b) {
    asm volatile("s_waitcnt vmcnt(0)" ::: "memory");
    __syncthreads();
    if (threadIdx.x == 0) {
        unsigned* bar = b.bar;
        __builtin_amdgcn_s_waitcnt(0);
        unsigned nloc = b.st[0], nx = b.st[1];
        if (nloc == 0u) { xcd_barrier_complete(bar, b.x, nloc, nx); b.st[0] = nloc; b.st[1] = nx; }
        const unsigned old = xb_add(&bar[XB_XSUB(b.x)], 1u);
        const unsigned gen = old / nloc;
        if (old + 1u == (gen + 1u) * nloc) {
            __builtin_amdgcn_fence(__ATOMIC_RELEASE, "agent");
            asm volatile("s_waitcnt vmcnt(0)" ::: "memory");
            const unsigned og = xb_add(&bar[XB_TOP], 1u);
            const unsigned tg = og / nx;
            if (og + 1u == (tg + 1u) * nx) xb_add(&bar[XB_TOPGEN], 1u);
            else XB_SPIN(xb_ld(&bar[XB_TOPGEN]) == tg, bar);
            __builtin_amdgcn_fence(__ATOMIC_ACQUIRE, "agent");
            xb_add(&bar[XB_XGEN(b.x)], 1u);
            asm volatile("s_waitcnt vmcnt(0)" ::: "memory");
        } else {
            XB_SPIN(xb_ld(&bar[XB_XGEN(b.x)]) == gen, bar);
            __builtin_amdgcn_fence(__ATOMIC_ACQUIRE, "agent");
            asm volatile("s_waitcnt vmcnt(0)" ::: "memory");
        }
    }
    __syncthreads();
}

namespace pg8 {
constexpr int BM = 256, BK = 64, HALF = 128, HTB = HALF * BK * 2, STAGE_BYTES = 8 * HTB, NXCD = 8, WGM = 8;
__host__ __device__ __forceinline__ int lds_byte(int r, int c) { const int st = (r >> 4) * 2 + (c >> 5), rr = r & 15, cc = c & 31, ob = rr * 64 + cc * 2; return st * 1024 + (ob ^ (((ob >> 9) & 1) << 5)); }
__host__ __device__ __forceinline__ void stage_rc(int b, int& R, int& C) { const int st = b / 1024, sb = b % 1024, swz = sb ^ (((sb >> 9) & 1) << 5); R = (st >> 1) * 16 + swz / 64; C = (st & 1) * 32 + (swz % 64) / 2; }
__host__ __device__ __forceinline__ int perm32(int rho) { const int n = rho >> 4, i = rho & 15; return 8 * (i >> 2) + 4 * n + (i & 3); }

struct Unit { size_t aB, bB; int row0, col0; };
struct Gemm { const bf16_t* A; const bf16_t* Bt; int K; };

template <int NM, int NN>
struct DenseOrder {
    int G, c; size_t tstep;
    __device__ void init(int rowbytes, int G_, int c_) { G = G_; c = c_; tstep = (size_t)BM * rowbytes; }
    __device__ bool next(int i, Unit& u) const {
        constexpr int nwg = NM * NN, q = nwg / NXCD, r = nwg % NXCD, nig = WGM * NN;
        static_assert(NM % WGM == 0, "row tiles come in groups of 8");
        const int L = __builtin_amdgcn_readfirstlane(i * G + c); if (L >= nwg) return false;
        const int xcd = L % NXCD, off = L / NXCD;
        const int wgid = (xcd < r ? xcd * (q + 1) : r * (q + 1) + (xcd - r) * q) + off;
        const int gid = wgid / nig, fm = gid * WGM, rem = wgid % nig;
        const int pm = fm + (rem % WGM), pn = rem / WGM;
        u.aB = (size_t)pm * tstep; u.bB = (size_t)pn * tstep; u.row0 = pm * BM; u.col0 = pn * BM; return true;
    }
};
struct OneUnit {
    Unit u0;
    __device__ bool next(int i, Unit& u) const { if (i > 0) return false; u = u0; return true; }
};
struct MoeOrder {
    const LAS int* tab; int NTn, G, c; size_t tstep, bexp;
    __device__ bool next(int i, Unit& u) const {
        const int MT = tab[16], U = MT * NTn, nx = G >> 3;
        int f;
        if ((G & 7) == 0) { const int per = (U + 7) >> 3, x = c & 7, j = c >> 3, loc = i * nx + j; f = x * per + loc; if (loc >= per || f >= U) return false; }
        else { f = i * G + c; if (f >= U) return false; }
        int e = 0;
#pragma unroll
        for (int j = 1; j < 16; ++j) e += (f >= tab[j] * NTn) ? 1 : 0;
        const int t0 = tab[e], te = tab[e + 1] - t0, r = f - t0 * NTn;
        const int nt = r / te, mt = t0 + (r - nt * te);
        u.aB = (size_t)mt * tstep; u.bB = (size_t)e * bexp + (size_t)nt * tstep; u.row0 = mt * BM; u.col0 = nt * BM; return true;
    }
};

__device__ __forceinline__ size_t rfl64(size_t v) { const unsigned lo = (unsigned)__builtin_amdgcn_readfirstlane((int)(unsigned)v), hi = (unsigned)__builtin_amdgcn_readfirstlane((int)(unsigned)(v >> 32)); return ((size_t)hi << 32) | lo; }
__device__ __forceinline__ void uniformize(Unit& u) { u.aB = rfl64(u.aB); u.bB = rfl64(u.bB); u.row0 = __builtin_amdgcn_readfirstlane(u.row0); u.col0 = __builtin_amdgcn_readfirstlane(u.col0); }
__device__ __forceinline__ unsigned cvt_pk_bf16(float lo, float hi) { unsigned r; asm volatile("v_cvt_pk_bf16_f32 %0, %1, %2" : "=v"(r) : "v"(lo), "v"(hi)); return r; }

struct EpiF32 {
    static constexpr bool PERM = false;
    float* C; int ldc;
    __device__ __forceinline__ void operator()(const f32x4 (&acc)[2][2][4][2], const Unit& u, int wr, int wc, int fr, int fq) const {
        const int row0 = u.row0 + wr * 64 + fr, col0 = u.col0 + wc * 32 + 4 * fq;
#pragma unroll
        for (int ai = 0; ai < 2; ++ai)
#pragma unroll
            for (int m = 0; m < 4; ++m) { float* rowp = C + (size_t)(row0 + ai * HALF + m * 16) * ldc + col0;
#pragma unroll
                for (int bj = 0; bj < 2; ++bj)
#pragma unroll
                    for (int n = 0; n < 2; ++n) *(f32x4*)(rowp + bj * HALF + n * 16) = acc[ai][bj][m][n]; }
    }
};
struct EpiBf16 {
    static constexpr bool PERM = true;
    bf16_t* O; int ldc;
    __device__ __forceinline__ void operator()(const f32x4 (&acc)[2][2][4][2], const Unit& u, int wr, int wc, int fr, int fq) const {
        const int row0 = u.row0 + wr * 64 + fr, col0 = u.col0 + wc * 32 + 8 * fq;
#pragma unroll
        for (int ai = 0; ai < 2; ++ai)
#pragma unroll
            for (int m = 0; m < 4; ++m) { bf16_t* rowp = O + (size_t)(row0 + ai * HALF + m * 16) * ldc + col0;
#pragma unroll
                for (int bj = 0; bj < 2; ++bj) { const f32x4 v0 = acc[ai][bj][m][0], v1 = acc[ai][bj][m][1];
                    u32x4 o; o[0] = cvt_pk_bf16(v0[0], v0[1]); o[1] = cvt_pk_bf16(v0[2], v0[3]); o[2] = cvt_pk_bf16(v1[0], v1[1]); o[3] = cvt_pk_bf16(v1[2], v1[3]);
                    *(u32x4*)(rowp + bj * HALF) = o; } }
    }
};
struct EpiHidden {
    static constexpr bool PERM = true;
    bf16_t* O;
    __device__ __forceinline__ void operator()(const f32x4 (&acc)[2][2][4][2], const Unit& u, int wr, int wc, int fr, int fq) const {
        const int row0 = u.row0 + wr * 64 + fr, col0 = (u.col0 >> 1) + wc * 32 + 8 * fq;
#pragma unroll
        for (int ai = 0; ai < 2; ++ai)
#pragma unroll
            for (int m = 0; m < 4; ++m) { bf16_t* rowp = O + (size_t)(row0 + ai * HALF + m * 16) * DE + col0;
                float h[8];
#pragma unroll
                for (int n = 0; n < 2; ++n)
#pragma unroll
                    for (int j = 0; j < 4; ++j) { const float g = acc[ai][0][m][n][j], up = acc[ai][1][m][n][j]; h[n * 4 + j] = g * __builtin_amdgcn_rcpf(1.0f + __expf(-g)) * up; }
                u32x4 o; o[0] = cvt_pk_bf16(h[0], h[1]); o[1] = cvt_pk_bf16(h[2], h[3]); o[2] = cvt_pk_bf16(h[4], h[5]); o[3] = cvt_pk_bf16(h[6], h[7]);
                *(u32x4*)rowp = o; }
    }
};

typedef int v8i32 __attribute__((ext_vector_type(8)));
typedef int v4i32 __attribute__((ext_vector_type(4)));
struct EpiHidden8 {
    static constexpr bool PERM = true;
    unsigned char* O;
    __device__ __forceinline__ void operator()(const f32x4 (&acc)[2][2][4][2], const Unit& u, int wr, int wc, int fr, int fq) const {
        const int row0 = u.row0 + wr * 64 + fr, col0 = (u.col0 >> 1) + wc * 32 + 8 * fq;
#pragma unroll
        for (int ai = 0; ai < 2; ++ai)
#pragma unroll
            for (int m = 0; m < 4; ++m) { unsigned char* rowp = O + (size_t)(row0 + ai * HALF + m * 16) * DEP + col0;
                float h[8];
#pragma unroll
                for (int n = 0; n < 2; ++n)
#pragma unroll
                    for (int j = 0; j < 4; ++j) { const float g = acc[ai][0][m][n][j], up = acc[ai][1][m][n][j]; h[n * 4 + j] = g * __builtin_amdgcn_rcpf(1.0f + __expf(-g)) * up * H8_SCALE; }
                int o0 = __builtin_amdgcn_cvt_pk_fp8_f32(h[0], h[1], 0, false); o0 = __builtin_amdgcn_cvt_pk_fp8_f32(h[2], h[3], o0, true);
                int o1 = __builtin_amdgcn_cvt_pk_fp8_f32(h[4], h[5], 0, false); o1 = __builtin_amdgcn_cvt_pk_fp8_f32(h[6], h[7], o1, true);
                u32x2 o; o[0] = (unsigned)o0; o[1] = (unsigned)o1;
                *(u32x2*)rowp = o; }
    }
};
template <class Epi, class Sched, bool FP8 = false>
__device__ __forceinline__ void gemm_phase(LAS unsigned char* lds, const Gemm g, const Sched& S, const Epi& E, int sclW = 127, int sclA = 127) {
    int tid = threadIdx.x; asm volatile("" : "+v"(tid)); const int wid = __builtin_amdgcn_readfirstlane(tid >> 6), lane = tid & 63, wr = wid >> 2, wc = wid & 3, fr = lane & 15, fq = lane >> 4;
    const int K = g.K, rowb = FP8 ? K : 2 * K, nt = rowb / 128;
    int sclWv = sclW, sclAv = sclA; asm volatile("" : "+v"(sclWv), "+v"(sclAv));
    unsigned voffA[2], voffB[2];
#pragma unroll
    for (int i = 0; i < 2; ++i) { int R, C; stage_rc(tid * 16 + i * 8192, R, C); const int Rb = Epi::PERM ? ((R & ~31) + perm32(R & 31)) : R;
        voffA[i] = (unsigned)(R * rowb + 2 * C); voffB[i] = (unsigned)(Rb * rowb + 2 * C); }
    const size_t kstep = 128;
    const size_t hstep = (size_t)HALF * rowb;
    const unsigned ldsw = (unsigned)wid * 1024u;
    const int aoff = lds_byte(wr * 64 + fr, fq * 8), boff = lds_byte(wc * 32 + fr, fq * 8);
    constexpr int P2 = 1024;
#define PG8_SA(b, h) (((b) * 2 + (h)) * HTB)
#define PG8_SB(b, h) ((4 + (b) * 2 + (h)) * HTB)
#define PG8_STAGE(bufoff, gbase, voff) do { _Pragma("unroll") for (int _i = 0; _i < 2; ++_i) \
        __builtin_amdgcn_global_load_lds((const unsigned*)((const char*)(gbase) + (voff)[_i]), (LAS unsigned*)(lds + (bufoff) + ldsw + _i * 8192), 16, 0, 0); } while (0)
#define PG8_LDA(dst, b, h) do { _Pragma("unroll") for (int m = 0; m < 4; ++m) { \
        const v4i32 _l = *(const LAS v4i32*)(lds + PG8_SA(b, h) + aoff + m * 2048), _h = *(const LAS v4i32*)(lds + PG8_SA(b, h) + aoff + P2 + m * 2048); \
        dst[m] = __builtin_shufflevector(_l, _h, 0, 1, 2, 3, 4, 5, 6, 7); } } while (0)
#define PG8_LDB(dst, b, h) do { _Pragma("unroll") for (int n = 0; n < 2; ++n) { \
        const v4i32 _l = *(const LAS v4i32*)(lds + PG8_SB(b, h) + boff + n * 2048), _h = *(const LAS v4i32*)(lds + PG8_SB(b, h) + boff + P2 + n * 2048); \
        dst[n] = __builtin_shufflevector(_l, _h, 0, 1, 2, 3, 4, 5, 6, 7); } } while (0)
#define PG8_MMA(ai, bj, At, Bt) do { __builtin_amdgcn_s_setprio(1); _Pragma("unroll") for (int m = 0; m < 4; ++m) _Pragma("unroll") for (int n = 0; n < 2; ++n) { \
        if constexpr (FP8) { \
            asm volatile("v_mfma_scale_f32_16x16x128_f8f6f4 %0, %1, %2, %0, %3, %4 op_sel_hi:[0,0,0]" : "+v"(acc[ai][bj][m][n]) : "v"(Bt[n]), "v"(At[m]), "v"(sclWv), "v"(sclAv)); \
        } else { \
            acc[ai][bj][m][n] = __builtin_amdgcn_mfma_f32_16x16x32_bf16(__builtin_bit_cast(bf16x8, __builtin_shufflevector(Bt[n], Bt[n], 0, 1, 2, 3)), __builtin_bit_cast(bf16x8, __builtin_shufflevector(At[m], At[m], 0, 1, 2, 3)), acc[ai][bj][m][n], 0, 0, 0); \
            acc[ai][bj][m][n] = __builtin_amdgcn_mfma_f32_16x16x32_bf16(__builtin_bit_cast(bf16x8, __builtin_shufflevector(Bt[n], Bt[n], 4, 5, 6, 7)), __builtin_bit_cast(bf16x8, __builtin_shufflevector(At[m], At[m], 4, 5, 6, 7)), acc[ai][bj][m][n], 0, 0, 0); } } \
        __builtin_amdgcn_s_setprio(0); } while (0)
#define PG8_WAIT_V(n) asm volatile("s_waitcnt vmcnt(" #n ")" ::: "memory")
#define PG8_WAIT_L(n) asm volatile("s_waitcnt lgkmcnt(" #n ")" ::: "memory")
#define PG8_BAR __builtin_amdgcn_s_barrier()
#define PG8_SCHED __builtin_amdgcn_sched_barrier(0)
    Unit cur, nxt; int ui = 0;
    if (!S.next(0, cur)) return;
    uniformize(cur);
    f32x4 acc[2][2][4][2];
#pragma unroll
    for (int a = 0; a < 2; ++a)
#pragma unroll
        for (int b = 0; b < 2; ++b)
#pragma unroll
            for (int m = 0; m < 4; ++m)
#pragma unroll
                for (int n = 0; n < 2; ++n) acc[a][b][m][n] = (f32x4){0.f, 0.f, 0.f, 0.f};
    v8i32 At[4], B0[2], B1[2];
    const char* cA = (const char*)g.A + cur.aB; const char* cB = (const char*)g.Bt + cur.bB;
    PG8_STAGE(PG8_SB(0, 0), cB, voffB); PG8_STAGE(PG8_SA(0, 0), cA, voffA); PG8_STAGE(PG8_SB(0, 1), cB + hstep, voffB); PG8_STAGE(PG8_SA(0, 1), cA + hstep, voffA);
    if (wr == 1) PG8_BAR;
    PG8_WAIT_V(4); PG8_BAR;
    PG8_STAGE(PG8_SB(1, 0), cB + kstep, voffB); PG8_STAGE(PG8_SA(1, 0), cA + kstep, voffA); PG8_STAGE(PG8_SB(1, 1), cB + hstep + kstep, voffB);
    PG8_WAIT_V(6); PG8_BAR;
    for (;;) {
        const bool has_next = S.next(ui + 1, nxt);
        uniformize(nxt);
        const char* nA = has_next ? (const char*)g.A + nxt.aB : cA; const char* nB = has_next ? (const char*)g.Bt + nxt.bB : cB;
        for (int t = 0; t < nt; t += 2) {
            const bool last = (t == nt - 2);
            const char* a1 = cA + (size_t)(t + 1) * kstep;
            const char* a2 = last ? nA : cA + (size_t)(t + 2) * kstep; const char* b2 = last ? nB : cB + (size_t)(t + 2) * kstep;
            const char* a3 = a2 + kstep; const char* b3 = b2 + kstep;
            PG8_LDB(B0, 0, 0); PG8_SCHED; PG8_LDA(At, 0, 0); PG8_STAGE(PG8_SA(1, 1), a1 + hstep, voffA);
            PG8_WAIT_L(8); PG8_BAR; PG8_WAIT_L(0); PG8_MMA(0, 0, At, B0); PG8_BAR; PG8_SCHED;
            PG8_LDB(B1, 0, 1); PG8_STAGE(PG8_SB(0, 0), b2, voffB);
            PG8_BAR; PG8_WAIT_L(0); PG8_MMA(0, 1, At, B1); PG8_BAR;
            PG8_LDA(At, 0, 1); PG8_STAGE(PG8_SA(0, 0), a2, voffA);
            PG8_BAR; PG8_WAIT_L(0); PG8_MMA(1, 0, At, B0); PG8_BAR; PG8_SCHED;
            PG8_STAGE(PG8_SB(0, 1), b2 + hstep, voffB);
            PG8_WAIT_V(6); PG8_BAR; PG8_MMA(1, 1, At, B1); PG8_BAR;
            PG8_LDB(B0, 1, 0); PG8_SCHED; PG8_LDA(At, 1, 0); PG8_STAGE(PG8_SA(0, 1), a2 + hstep, voffA);
            PG8_WAIT_L(8); PG8_BAR; PG8_WAIT_L(0); PG8_MMA(0, 0, At, B0); PG8_BAR; PG8_SCHED;
            PG8_LDB(B1, 1, 1); PG8_STAGE(PG8_SB(1, 0), b3, voffB);
            PG8_BAR; PG8_WAIT_L(0); PG8_MMA(0, 1, At, B1); PG8_BAR;
            PG8_LDA(At, 1, 1); PG8_STAGE(PG8_SA(1, 0), a3, voffA);
            PG8_BAR; PG8_WAIT_L(0); PG8_MMA(1, 0, At, B0); PG8_BAR; PG8_SCHED;
            PG8_STAGE(PG8_SB(1, 1), b3 + hstep, voffB);
            PG8_WAIT_V(6); PG8_BAR; PG8_MMA(1, 1, At, B1); PG8_BAR;
        }
        if constexpr (FP8) asm volatile("s_nop 15\n\ts_nop 15" ::: "memory");
        E(acc, cur, wr, wc, fr, fq);
        if (!has_next) break;
#pragma unroll
        for (int a = 0; a < 2; ++a)
#pragma unroll
            for (int b = 0; b < 2; ++b)
#pragma unroll
                for (int m = 0; m < 4; ++m)
#pragma unroll
                    for (int n = 0; n < 2; ++n) acc[a][b][m][n] = (f32x4){0.f, 0.f, 0.f, 0.f};
        cur = nxt; cA = nA; cB = nB; ++ui;
    }
    PG8_WAIT_V(0);
    if (wr == 0) PG8_BAR;
    PG8_BAR;
#undef PG8_SA
#undef PG8_SB
#undef PG8_STAGE
#undef PG8_LDA
#undef PG8_LDB
#undef PG8_MMA
#undef PG8_WAIT_V
#undef PG8_WAIT_L
#undef PG8_BAR
#undef PG8_SCHED
}
}

constexpr int S_IN = 16 * 66, S_OUT = 16 * 16, S_GU = 16 * 11, S_DN = 11 * 16;
constexpr int CV_PER_L = S_IN + S_OUT + NE * 2 * S_GU + NE * S_DN;
constexpr int CV_A0 = S_IN + S_OUT;
constexpr int CV_A1 = CV_A0 + NE * 2 * S_GU;
constexpr int CV_TOTAL = DEPTH * CV_PER_L;
constexpr int CV_LAST = 1 << 30;
struct StripDesc { const float* src; bf16_t* dst; int lds_, ldd, k0, n0, drow0, fp8; };
__device__ __forceinline__ StripDesc strip_desc(const Params& p, int si) {
    unsigned char* ws = p.ws; StripDesc d;
    const int l = si / CV_PER_L; int r = si - l * CV_PER_L;
    if (r < S_IN) {
        const int kt = r / 66, ntl = r % 66;
        d.src = p.w_in + (size_t)l * D * INC; d.lds_ = INC; d.fp8 = INP8(l) ? 1 : 0; d.dst = (bf16_t*)(ws + WS_WIN) + (size_t)l * INC * D; d.ldd = D; d.k0 = kt * 128; d.n0 = ntl * 128; d.drow0 = ntl * 128;
    } else if (r < CV_A0) {
        r -= S_IN; const int kt = r / 16, ntl = r % 16;
        d.src = p.w_out + (size_t)l * D * D; d.lds_ = D; d.dst = (bf16_t*)(ws + WS_WOUT) + (size_t)l * D * D; d.ldd = D; d.k0 = kt * 128; d.n0 = ntl * 128; d.drow0 = ntl * 128; d.fp8 = OUT8(l) ? 1 : 0;
    } else if (r < CV_A1) {
        r -= CV_A0; const int mat = r / S_GU, q = r % S_GU, kt = q / 11, ntl = q % 11;
        const int which = mat & 1, le = l * NE + (mat >> 1);
        d.src = (which ? p.w_up : p.w_gate) + (size_t)le * D * DE; d.lds_ = DE; d.fp8 = MOE_FP8; d.dst = MOE_FP8 ? (bf16_t*)(ws + WS_WGU + (size_t)le * (2 * DE) * D) : (bf16_t*)(ws + WS_WGU) + (size_t)le * (2 * DE) * D; d.ldd = D; d.k0 = kt * 128; d.n0 = ntl * 128; d.drow0 = ntl * 256 + which * 128;
    } else {
        r -= CV_A1; const int le = l * NE + r / S_DN, q = r % S_DN, kt = q / 16, ntl = q % 16;
        d.src = p.w_down + (size_t)le * DE * D; d.lds_ = D; d.fp8 = MOE_FP8; d.dst = MOE_FP8 ? (bf16_t*)(ws + WS_WD + (size_t)le * D * DEP) : (bf16_t*)(ws + WS_WD) + (size_t)le * D * DE; d.ldd = MOE_FP8 ? DEP : DE; d.k0 = kt * 128; d.n0 = ntl * 128; d.drow0 = ntl * 128;
    }
    return d;
}
__device__ __forceinline__ void cvt_store_strip(const StripDesc& d, const float4 (&a)[2][2], const float4 (&b)[2][2], LAS unsigned char* tb, int tid, bool readout) {
    const int kp = tid >> 4, n4 = (tid & 15) * 4;
    if (!readout) {
        if (!d.fp8) {
#pragma unroll
            for (int ki = 0; ki < 2; ++ki)
#pragma unroll
                for (int ni = 0; ni < 2; ++ni) {
                    LAS unsigned* t = (LAS unsigned*)tb + (ki * 2 + ni) * 2112;
                    t[(n4 + 0) * 33 + kp] = pack2a(a[ki][ni].x, b[ki][ni].x);
                    t[(n4 + 1) * 33 + kp] = pack2a(a[ki][ni].y, b[ki][ni].y);
                    t[(n4 + 2) * 33 + kp] = pack2a(a[ki][ni].z, b[ki][ni].z);
                    t[(n4 + 3) * 33 + kp] = pack2a(a[ki][ni].w, b[ki][ni].w);
                }
        } else {
#pragma unroll
            for (int ki = 0; ki < 2; ++ki)
#pragma unroll
                for (int ni = 0; ni < 2; ++ni) {
                    LAS unsigned char* t = tb + (ki * 2 + ni) * 4352;
                    *(LAS unsigned short*)(t + (n4 + 0) * 68 + 2 * kp) = (unsigned short)__builtin_amdgcn_cvt_pk_fp8_f32(a[ki][ni].x * W8_SCALE, b[ki][ni].x * W8_SCALE, 0, false);
                    *(LAS unsigned short*)(t + (n4 + 1) * 68 + 2 * kp) = (unsigned short)__builtin_amdgcn_cvt_pk_fp8_f32(a[ki][ni].y * W8_SCALE, b[ki][ni].y * W8_SCALE, 0, false);
                    *(LAS unsigned short*)(t + (n4 + 2) * 68 + 2 * kp) = (unsigned short)__builtin_amdgcn_cvt_pk_fp8_f32(a[ki][ni].z * W8_SCALE, b[ki][ni].z * W8_SCALE, 0, false);
                    *(LAS unsigned short*)(t + (n4 + 3) * 68 + 2 * kp) = (unsigned short)__builtin_amdgcn_cvt_pk_fp8_f32(a[ki][ni].w * W8_SCALE, b[ki][ni].w * W8_SCALE, 0, false);
                }
        }
    } else {
        if (!d.fp8) {
            const int n = tid >> 3, kc = (tid & 7) * 4;
#pragma unroll
            for (int ki = 0; ki < 2; ++ki)
#pragma unroll
                for (int ni = 0; ni < 2; ++ni) {
                    const LAS unsigned* t = (const LAS unsigned*)tb + (ki * 2 + ni) * 2112;
                    u32x4 o; o[0] = t[n * 33 + kc]; o[1] = t[n * 33 + kc + 1]; o[2] = t[n * 33 + kc + 2]; o[3] = t[n * 33 + kc + 3];
                    *(u32x4*)(d.dst + (size_t)(d.drow0 + ni * 64 + n) * d.ldd + d.k0 + ki * 64 + kc * 2) = o;
                }
        } else {
            const int n = tid >> 3, kc8 = (tid & 7) * 8;
            unsigned char* dst8 = (unsigned char*)d.dst;
#pragma unroll
            for (int ki = 0; ki < 2; ++ki)
#pragma unroll
                for (int ni = 0; ni < 2; ++ni) {
                    const LAS unsigned char* t = tb + (ki * 2 + ni) * 4352;
                    u32x2 o; o[0] = *(const LAS unsigned*)(t + n * 68 + kc8); o[1] = *(const LAS unsigned*)(t + n * 68 + kc8 + 4);
                    *(u32x2*)(dst8 + (size_t)(d.drow0 + ni * 64 + n) * d.ldd + d.k0 + ki * 64 + kc8) = o;
                }
        }
    }
}
__device__ __forceinline__ void cvt_pull(const Params& p, LAS unsigned char* lds, int limit, unsigned* done_ctr, unsigned need_done) {
    int tid = threadIdx.x; asm volatile("" : "+v"(tid));
    LAS int* slot = (LAS int*)(lds + LDS_MISC + 512);
    unsigned* head = (unsigned*)(p.ws + WS_CVTQ);
    if (tid == 0) {
        int sv = -1;
        const bool stop = done_ctr ? (xb_ld(done_ctr) >= need_done) : (xb_ld(head) >= (unsigned)limit);
        if (!stop) { const unsigned c = xb_add(head, 2u); sv = c < (unsigned)CV_TOTAL ? (int)c : -1; }
        slot[0] = sv;
    }
    __syncthreads();
    const int kp = tid >> 4, n4 = (tid & 15) * 4;
    for (;;) {
        const int sraw = slot[0];
        if (sraw < 0) break;
        const int si = sraw & (CV_LAST - 1); const bool lastone = (sraw & CV_LAST) != 0;
        const StripDesc d0 = strip_desc(p, si), d1 = strip_desc(p, si + 1);
        float4 a0[2][2], b0[2][2], a1[2][2], b1[2][2];
#pragma unroll
        for (int ki = 0; ki < 2; ++ki)
#pragma unroll
            for (int ni = 0; ni < 2; ++ni) {
                a0[ki][ni] = *(const float4*)(d0.src + (size_t)(d0.k0 + ki * 64 + 2 * kp) * d0.lds_ + d0.n0 + ni * 64 + n4);
                b0[ki][ni] = *(const float4*)(d0.src + (size_t)(d0.k0 + ki * 64 + 2 * kp + 1) * d0.lds_ + d0.n0 + ni * 64 + n4);
            }
#pragma unroll
        for (int ki = 0; ki < 2; ++ki)
#pragma unroll
            for (int ni = 0; ni < 2; ++ni) {
                a1[ki][ni] = *(const float4*)(d1.src + (size_t)(d1.k0 + ki * 64 + 2 * kp) * d1.lds_ + d1.n0 + ni * 64 + n4);
                b1[ki][ni] = *(const float4*)(d1.src + (size_t)(d1.k0 + ki * 64 + 2 * kp + 1) * d1.lds_ + d1.n0 + ni * 64 + n4);
            }
        unsigned c = 0u, dn = 0u;
        if (tid == 0 && !lastone) { c = xb_add(head, 2u); if (done_ctr) dn = xb_ld(done_ctr); }
        cvt_store_strip(d0, a0, b0, lds, tid, false);
        cvt_store_strip(d1, a1, b1, lds + 33792, tid, false);
        LDS_BARRIER();
        cvt_store_strip(d0, a0, b0, lds, tid, true);
        cvt_store_strip(d1, a1, b1, lds + 33792, tid, true);
        if (tid == 0) {
            int sv = -1;
            if (!lastone && c < (unsigned)CV_TOTAL) { const bool fin = done_ctr ? (dn >= need_done) : (c >= (unsigned)limit); sv = (int)c | (fin ? CV_LAST : 0); }
            slot[0] = sv;
        }
        LDS_BARRIER();
    }
    __syncthreads();
}
__device__ __forceinline__ void tail_pull(const Params& p, LAS unsigned char* lds, int ctr_idx) {
    unsigned* ctr = (unsigned*)(p.ws + WS_CVTQ) + 64 * (1 + ctr_idx);
    __syncthreads();
    if (threadIdx.x == 0) (void)xb_add(ctr, 1u);
    cvt_pull(p, lds, 0, ctr, gridDim.x);
}

__device__ __forceinline__ void ada_chunks(const Params& p, LAS unsigned char* lds, int ch0, int ch_end, int step) {
    int tid = threadIdx.x; asm volatile("" : "+v"(tid));
    unsigned char* ws = p.ws;
    LAS float* cond = (LAS float*)lds;
    LAS float* red = (LAS float*)(lds + 32768);
    if (ch0 >= ch_end) return;
    for (int i = tid; i < 4 * D; i += 512) { const float v = p.c[i]; cond[i] = siluf_(v); }
    __syncthreads();
    for (int ch = ch0; ch < ch_end; ch += step) {
        const int l = ch >> 7, j0 = (ch & 127) * 96;
        const float* w = p.w_ada + (size_t)l * D * (6 * D);
        const int kg = tid / 24, cl = tid % 24;
        float acc[4][4];
#pragma unroll
        for (int b = 0; b < 4; ++b)
#pragma unroll
            for (int j = 0; j < 4; ++j) acc[b][j] = 0.f;
        if (kg < 21) {
            for (int it0 = 0; it0 < 98; it0 += 14) {
                float4 wv[14];
#pragma unroll
                for (int q = 0; q < 14; ++q) { const int k = kg + 21 * (it0 + q); wv[q] = (k < D) ? *(const float4*)(w + (size_t)k * (6 * D) + j0 + cl * 4) : make_float4(0.f, 0.f, 0.f, 0.f); }
#pragma unroll
                for (int q = 0; q < 14; ++q) { const int k = kg + 21 * (it0 + q); const int kc = k < D ? k : 0;
#pragma unroll
                    for (int b = 0; b < 4; ++b) { const float cv = cond[b * D + kc]; acc[b][0] += cv * wv[q].x; acc[b][1] += cv * wv[q].y; acc[b][2] += cv * wv[q].z; acc[b][3] += cv * wv[q].w; } }
            }
#pragma unroll
            for (int b = 0; b < 4; ++b)
#pragma unroll
                for (int j = 0; j < 4; ++j) red[(kg * 4 + b) * 96 + cl * 4 + j] = acc[b][j];
        }
        __syncthreads();
        if (tid < 384) {
            const int b = tid / 96, col = tid % 96; float s = 0.f;
            for (int g = 0; g < 21; ++g) s += red[(g * 4 + b) * 96 + col];
            float* mod = (float*)(ws + WS_MOD);
            mod[((size_t)l * 4 + b) * (6 * D) + j0 + col] = s + p.b_ada[(size_t)l * 6 * D + j0 + col];
        }
        __syncthreads();
    }
}
__device__ __forceinline__ void phase_prologue(const Params& p, LAS unsigned char* lds) {
    const bool svc = (gridDim.x >= 256);
    ada_chunks(p, lds, blockIdx.x, svc ? 128 : 256, gridDim.x);
    cvt_pull(p, lds, S_IN, nullptr, 0u);
}

#define COLK(k) ((((k) >> 1) << 9) + lane * 8 + (((k) & 1) << 2))
#define COL8(i) (((i) << 9) + lane * 8)
__device__ __forceinline__ void ld_bf8(const bf16_t* p, float4& a, float4& b) {
    const u32x4 r = *(const u32x4*)p;
    a = make_float4(bf2f(r[0] & 0xffffu), bf2f(r[0] >> 16), bf2f(r[1] & 0xffffu), bf2f(r[1] >> 16));
    b = make_float4(bf2f(r[2] & 0xffffu), bf2f(r[2] >> 16), bf2f(r[3] & 0xffffu), bf2f(r[3] >> 16));
}
__device__ __forceinline__ void st_bf8(bf16_t* p, const float4& a, const float4& b) {
    u32x4 o; o[0] = pack2a(a.x, a.y); o[1] = pack2a(a.z, a.w); o[2] = pack2a(b.x, b.y); o[3] = pack2a(b.z, b.w);
    *(u32x4*)p = o;
}
__device__ __forceinline__ void st_fp8x8(unsigned char* p, const float4& a, const float4& b) {
    int o0 = __builtin_amdgcn_cvt_pk_fp8_f32(a.x, a.y, 0, false); o0 = __builtin_amdgcn_cvt_pk_fp8_f32(a.z, a.w, o0, true);
    int o1 = __builtin_amdgcn_cvt_pk_fp8_f32(b.x, b.y, 0, false); o1 = __builtin_amdgcn_cvt_pk_fp8_f32(b.z, b.w, o1, true);
    u32x2 o; o[0] = (unsigned)o0; o[1] = (unsigned)o1;
    *(u32x2*)p = o;
}
__device__ __forceinline__ void ln_rows(float4 (&v)[8], const float* __restrict__ g, const float* __restrict__ b, int lane) {
    float s = 0.f;
#pragma unroll
    for (int i = 0; i < 8; ++i) s += (v[i].x + v[i].y) + (v[i].z + v[i].w);
    const float mean = wave_sum(s) * (1.0f / D);
    float q = 0.f;
#pragma unroll
    for (int i = 0; i < 8; ++i) { const float a = v[i].x - mean, bb = v[i].y - mean, c = v[i].z - mean, d = v[i].w - mean; q += (a * a + bb * bb) + (c * c + d * d); }
    const float rstd = rsqrtf(wave_sum(q) * (1.0f / D) + 1e-5f);
#pragma unroll
    for (int i = 0; i < 8; ++i) {
        const float4 gv = *(const float4*)(g + COLK(i)), bv = *(const float4*)(b + COLK(i));
        v[i].x = (v[i].x - mean) * rstd * gv.x + bv.x; v[i].y = (v[i].y - mean) * rstd * gv.y + bv.y;
        v[i].z = (v[i].z - mean) * rstd * gv.z + bv.z; v[i].w = (v[i].w - mean) * rstd * gv.w + bv.w;
    }
}
__device__ __forceinline__ void modulate_store(const float4 (&v)[8], const float* __restrict__ shift, const float* __restrict__ scale, bf16_t* __restrict__ dst, int lane, bool fp8) {
#pragma unroll
    for (int i = 0; i < 4; ++i) {
        float4 h[2];
#pragma unroll
        for (int q = 0; q < 2; ++q) {
            const float4 sh = *(const float4*)(shift + COLK(2 * i + q)), sc = *(const float4*)(scale + COLK(2 * i + q));
            const float4 x = v[2 * i + q];
            h[q] = make_float4(x.x * (1.f + sc.x) + sh.x, x.y * (1.f + sc.y) + sh.y, x.z * (1.f + sc.z) + sh.z, x.w * (1.f + sc.w) + sh.w);
        }
        if (fp8) st_fp8x8((unsigned char*)dst + COL8(i), h[0], h[1]);
        else st_bf8(dst + COL8(i), h[0], h[1]);
    }
}

__device__ __forceinline__ void phase_ln0(const Params& p) {
    int tid_ = threadIdx.x; asm volatile("" : "+v"(tid_)); const int wave = tid_ >> 6, lane = tid_ & 63;
    const float* mod = (const float*)(p.ws + WS_MOD);
    for (int n = blockIdx.x * 8 + wave; n < T; n += gridDim.x * 8) {
        const int b = n / SEQ;
        float4 v[8];
#pragma unroll
        for (int i = 0; i < 8; ++i) v[i] = *(const float4*)(p.x + (size_t)n * D + COLK(i));
        ln_rows(v, p.emb_g, p.emb_b, lane);
        bf16_t* xr = (bf16_t*)(p.ws + WS_XRES) + (size_t)n * D;
#pragma unroll
        for (int i = 0; i < 4; ++i) st_bf8(xr + COL8(i), v[2 * i], v[2 * i + 1]);
        const float* mb = mod + ((size_t)0 * 4 + b) * (6 * D);
        modulate_store(v, mb, mb + D, INP8(0) ? (bf16_t*)(p.ws + WS_HA + (size_t)n * D) : (bf16_t*)(p.ws + WS_HA) + (size_t)n * D, lane, INP8(0));
    }
}

__device__ __forceinline__ void phase_mixer_valu(const Params& p, int l, LAS unsigned char* lds) {
    LAS float* qs = (LAS float*)lds; LAS float* ks = qs + 4096; LAS float* fs = ks + 4096; LAS float* vs = fs + 4096; LAS float* po = vs + 1024;
    int tid = threadIdx.x; asm volatile("" : "+v"(tid)); const int wave = tid >> 6, lane = tid & 63, kk = tid >> 5, vv = tid & 31;
    const bf16_t* proj = (const bf16_t*)(p.ws + WS_PROJ);
    float* obuf = (float*)(p.ws + WS_OBUF);
    for (int u = blockIdx.x; u < 384; u += gridDim.x) {
        const int vsl = u & 3, dir = (u >> 2) & 1, hh = (u >> 3) % 6, b = ((u >> 3) / 6) % 4, type = (u >> 3) / 24;
        float S[8];
#pragma unroll
        for (int j = 0; j < 8; ++j) S[j] = 0.f;
        const float gamma = 1.0f - exp2f(-(dir ? 5.5f : 5.0f) - (float)hh);
        for (int blk = 0; blk < 64; ++blk) {
            const int rb = dir ? 63 - blk : blk, t0 = rb * 32;
            if (type == 0) {
#pragma unroll
                for (int j = 0; j < 4; ++j) {
                    const int idx = tid + 512 * j, tt = idx >> 6, dp = idx & 63;
                    const bf16_t* row = proj + (size_t)(b * SEQ + t0 + tt) * INC;
                    const float q1 = bf2f(row[C_RQ + hh * 128 + dp]), q2 = bf2f(row[C_RQ + hh * 128 + 64 + dp]);
                    const float k1 = bf2f(row[C_RK + hh * 128 + dp]), k2 = bf2f(row[C_RK + hh * 128 + 64 + dp]);
                    const float inv_freq = exp2f(-(float)dp * (13.287712379549449f / 64.0f));
                    const float ang = (float)(t0 + tt) * inv_freq;
                    float rev = ang * 0.15915494309189535f; rev -= rintf(rev);
                    const float sn = __builtin_amdgcn_sinf(rev), cs = __builtin_amdgcn_cosf(rev);
                    qs[tt * 128 + dp] = q1 * cs - q2 * sn; qs[tt * 128 + 64 + dp] = q1 * sn + q2 * cs;
                    ks[tt * 128 + dp] = (k1 * cs - k2 * sn) * 0.08838834764831845f; ks[tt * 128 + 64 + dp] = (k1 * sn + k2 * cs) * 0.08838834764831845f;
                    fs[tt * 128 + dp] = gamma; fs[tt * 128 + 64 + dp] = gamma;
                }
            } else {
#pragma unroll
                for (int j = 0; j < 8; ++j) {
                    const int idx = tid + 512 * j, tt = idx >> 7, d = idx & 127;
                    const bf16_t* row = proj + (size_t)(b * SEQ + t0 + tt) * INC;
                    const float q = bf2f(row[C_HQ + hh * 128 + d]);
                    const float z = bf2f(row[(dir ? C_HFB : C_HFF) + hh * 128 + d]);
                    float lb = 0.f;
                    if (l > 0) { const float a0 = p.lb_logits[(0 * 2 + dir) * HWD + hh * 128 + d], a1 = p.lb_logits[(1 * 2 + dir) * HWD + hh * 128 + d]; lb = 1.0f / (1.0f + expf(a0 - a1)); }
                    float f = lb + (1.0f - lb) * (1.0f / (1.0f + expf(-z)));
                    f = fmaxf(f, 1e-6f);
                    qs[tt * 128 + d] = q; ks[tt * 128 + d] = 1.0f - f; fs[tt * 128 + d] = f;
                }
            }
#pragma unroll
            for (int j = 0; j < 2; ++j) {
                const int idx = tid + 512 * j, tt = idx >> 5, c = idx & 31;
                const bf16_t* row = proj + (size_t)(b * SEQ + t0 + tt) * INC;
                vs[tt * 32 + c] = bf2f(row[(type ? C_HI : C_RV) + hh * 128 + vsl * 32 + c]);
            }
            __syncthreads();
            for (int s = 0; s < 32; ++s) {
                const int ss = dir ? 31 - s : s;
                const f32x4 qa = *(const LAS f32x4*)(qs + ss * 128 + kk * 8), qb = *(const LAS f32x4*)(qs + ss * 128 + kk * 8 + 4);
                const f32x4 ka = *(const LAS f32x4*)(ks + ss * 128 + kk * 8), kb = *(const LAS f32x4*)(ks + ss * 128 + kk * 8 + 4);
                const f32x4 fa = *(const LAS f32x4*)(fs + ss * 128 + kk * 8), fb = *(const LAS f32x4*)(fs + ss * 128 + kk * 8 + 4);
                const float vval = vs[ss * 32 + vv];
                float acc = 0.f;
#pragma unroll
                for (int j = 0; j < 4; ++j) { S[j] = fa[j] * S[j] + ka[j] * vval; acc += S[j] * qa[j]; }
#pragma unroll
                for (int j = 0; j < 4; ++j) { S[4 + j] = fb[j] * S[4 + j] + kb[j] * vval; acc += S[4 + j] * qb[j]; }
                acc += __shfl_xor(acc, 32, 64);
                if (lane < 32) po[(ss * 8 + wave) * 32 + vv] = acc;
            }
            __syncthreads();
#pragma unroll
            for (int j = 0; j < 2; ++j) {
                const int idx = tid + 512 * j, tt = idx >> 5, c = idx & 31;
                float s = 0.f;
#pragma unroll
                for (int w = 0; w < 8; ++w) s += po[(tt * 8 + w) * 32 + c];
                obuf[((size_t)dir * T + (size_t)(b * SEQ + t0 + tt)) * 1536 + type * 768 + hh * 128 + vsl * 32 + c] = s;
            }
        }
        __syncthreads();
    }
}

constexpr int MX_QI = 0, MX_KI = 17408, MX_QS = 34816, MX_KTT = 52224, MX_VT = 70656, MX_P = 79872, MX_ST = 89088, MX_TOT = 106496, MX_DEC = 110592, MX_RQ = 112128, MX_RK = 128512, MX_RV = 144896;
__device__ __forceinline__ float ex2(float x) { return __builtin_amdgcn_exp2f(x); }
__device__ __forceinline__ float clampe(float x) { return fminf(fmaxf(x, -120.f), 120.f); }
template <int MODE>
__device__ __forceinline__ void phase_mixer_mfma(const Params& p, int l, LAS unsigned char* lds, float* __restrict__ obuf) {
    int tid = threadIdx.x; asm volatile("" : "+v"(tid));
    const int wave = __builtin_amdgcn_readfirstlane(tid >> 6), lane = tid & 63, fr = lane & 15, fq = lane >> 4;
    const bf16_t* proj = (const bf16_t*)(p.ws + WS_PROJ);
    for (int u = blockIdx.x; u < 192; u += gridDim.x) {
        const int vsl = u & 1, dir = (u >> 1) & 1, hh = (u >> 2) % 6, b = ((u >> 2) / 6) % 4, type = (u >> 2) / 24;
        float lg2 = 0.f, invf0 = 0.f, invf1 = 0.f, sgn = 1.f, lb0 = 0.f, lb1 = 0.f;
        if (type == 0) {
            const float gamma = 1.0f - exp2f(-(dir ? 5.5f : 5.0f) - (float)hh);
            lg2 = log2f(gamma);
            const int dm0 = (2 * lane) & 63;
            invf0 = exp2f(-(float)dm0 * (13.287712379549449f / 64.0f)); invf1 = exp2f(-(float)(dm0 + 1) * (13.287712379549449f / 64.0f));
            sgn = lane < 32 ? -1.f : 1.f;
        } else if (l > 0) {
            const float* lbl = p.lb_logits + dir * HWD + hh * 128 + 2 * lane;
            lb0 = 1.0f / (1.0f + expf(lbl[0] - lbl[2 * HWD])); lb1 = 1.0f / (1.0f + expf(lbl[1] - lbl[2 * HWD + 1]));
        }
        const int colA = (type ? C_HQ : C_RQ) + hh * 128, colB = (type ? (dir ? C_HFB : C_HFF) : C_RK) + hh * 128;
        const int colV0 = (type ? C_HI : C_RV) + hh * 128 + vsl * 64;
        const int own = 2 * lane, par = (2 * lane + 64) & 127;
        const size_t ocol = (size_t)type * 768 + hh * 128 + vsl * 64;
#define MX_LOAD(ch) do { \
            _Pragma("unroll") for (int i2 = 0; i2 < 2; ++i2) { const int pos = wave * 8 + i2 * 4 + (lane >> 4); const int tau = (ch) * 64 + pos; const int t = dir ? (SEQ - 1 - tau) : tau; \
                const bf16_t* row = proj + (size_t)(b * SEQ + t) * INC + (lane & 15) * 8; \
                __builtin_amdgcn_global_load_lds((const unsigned*)(row + colA), (LAS unsigned*)(lds + MX_RQ + (wave * 8 + i2 * 4) * 256), 16, 0, 0); \
                __builtin_amdgcn_global_load_lds((const unsigned*)(row + colB), (LAS unsigned*)(lds + MX_RK + (wave * 8 + i2 * 4) * 256), 16, 0, 0); } \
            { const int pos = wave * 8 + (lane >> 3); const int tau = (ch) * 64 + pos; const int t = dir ? (SEQ - 1 - tau) : tau; \
              const bf16_t* row = proj + (size_t)(b * SEQ + t) * INC + colV0 + (lane & 7) * 8; \
              __builtin_amdgcn_global_load_lds((const unsigned*)row, (LAS unsigned*)(lds + MX_RV + (wave * 8) * 128), 16, 0, 0); } } while (0)
        f32x4 Sacc[4];
#pragma unroll
        for (int vt = 0; vt < 4; ++vt) Sacc[vt] = (f32x4){0.f, 0.f, 0.f, 0.f};
        for (int i = tid; i < 64 * 272 / 4; i += 512) ((LAS unsigned*)(lds + MX_ST))[i] = 0u;
        float cd0 = 1.f, sd0 = 0.f, cd1 = 1.f, sd1 = 0.f;
        if (type == 0) {
            if (tid < 64) { const float fi = (float)tid; *(LAS f32x4*)(lds + MX_DEC + 512 + tid * 16) = (f32x4){ex2((fi - 31.f) * lg2), ex2((31.f - fi) * lg2), ex2((fi + 1.f) * lg2), ex2((63.f - fi) * lg2)}; }
            const float r0 = invf0 * 0.15915494309189535f, r1 = invf1 * 0.15915494309189535f, sg = dir ? -1.f : 1.f;
            cd0 = __builtin_amdgcn_cosf(r0); sd0 = sg * __builtin_amdgcn_sinf(r0); cd1 = __builtin_amdgcn_cosf(r1); sd1 = sg * __builtin_amdgcn_sinf(r1);
        }
        __syncthreads();
        MX_LOAD(0);
        asm volatile("s_waitcnt vmcnt(0)" ::: "memory");
        __syncthreads();
        for (int ch = 0; ch < 32; ++ch) {
            float q0[8], q1[8], k0[8], k1[8], c0[8], c1[8];
            float run0 = 0.f, run1 = 0.f;
            u32x4 vpk = (u32x4){0u, 0u, 0u, 0u};
#pragma unroll
            for (int j = 0; j < 8; ++j) { q0[j] = q1[j] = k0[j] = k1[j] = c0[j] = c1[j] = 0.f; }
            if (MODE != 3 && MODE != 4) {
            if (type == 0) {
                const int tau0 = ch * 64 + wave * 8; const int t0 = dir ? (SEQ - 1 - tau0) : tau0;
                float rev0 = (float)t0 * invf0 * 0.15915494309189535f, rev1 = (float)t0 * invf1 * 0.15915494309189535f;
                rev0 -= rintf(rev0); rev1 -= rintf(rev1);
                float sn0 = __builtin_amdgcn_sinf(rev0), cs0 = __builtin_amdgcn_cosf(rev0), sn1 = __builtin_amdgcn_sinf(rev1), cs1 = __builtin_amdgcn_cosf(rev1);
#pragma unroll
                for (int j = 0; j < 8; ++j) {
                    const int pos_ = wave * 8 + j;
                    const unsigned ra_ = *(const LAS unsigned*)(lds + MX_RQ + pos_ * 256 + own * 2), rb_ = *(const LAS unsigned*)(lds + MX_RK + pos_ * 256 + own * 2);
                    const unsigned rc_ = *(const LAS unsigned*)(lds + MX_RQ + pos_ * 256 + par * 2), rd_ = *(const LAS unsigned*)(lds + MX_RK + pos_ * 256 + par * 2);
                    const float a_lo = bf2f(ra_ & 0xffffu), a_hi = bf2f(ra_ >> 16), b_lo = bf2f(rb_ & 0xffffu), b_hi = bf2f(rb_ >> 16);
                    const float pa_lo = bf2f(rc_ & 0xffffu), pa_hi = bf2f(rc_ >> 16), pb_lo = bf2f(rd_ & 0xffffu), pb_hi = bf2f(rd_ >> 16);
                    const float ss0 = sgn * sn0, ss1 = sgn * sn1;
                    q0[j] = a_lo * cs0 + pa_lo * ss0; q1[j] = a_hi * cs1 + pa_hi * ss1;
                    k0[j] = (b_lo * cs0 + pb_lo * ss0) * 0.08838834764831845f; k1[j] = (b_hi * cs1 + pb_hi * ss1) * 0.08838834764831845f;
                    const float nc0 = cs0 * cd0 - sn0 * sd0, ns0 = sn0 * cd0 + cs0 * sd0, nc1 = cs1 * cd1 - sn1 * sd1, ns1 = sn1 * cd1 + cs1 * sd1;
                    cs0 = nc0; sn0 = ns0; cs1 = nc1; sn1 = ns1;
                    c0[j] = 0.f; c1[j] = 0.f;
                }
            } else {
#pragma unroll
                for (int j = 0; j < 8; ++j) {
                    const int pos_ = wave * 8 + j;
                    const unsigned ra_ = *(const LAS unsigned*)(lds + MX_RQ + pos_ * 256 + own * 2), rb_ = *(const LAS unsigned*)(lds + MX_RK + pos_ * 256 + own * 2);
                    const float a_lo = bf2f(ra_ & 0xffffu), a_hi = bf2f(ra_ >> 16), b_lo = bf2f(rb_ & 0xffffu), b_hi = bf2f(rb_ >> 16);
                    q0[j] = a_lo; q1[j] = a_hi;
                    float f0 = lb0 + (1.0f - lb0) * __builtin_amdgcn_rcpf(1.0f + ex2(-b_lo * 1.4426950408889634f));
                    float f1 = lb1 + (1.0f - lb1) * __builtin_amdgcn_rcpf(1.0f + ex2(-b_hi * 1.4426950408889634f));
                    f0 = fmaxf(f0, 1e-6f); f1 = fmaxf(f1, 1e-6f);
                    k0[j] = 1.0f - f0; k1[j] = 1.0f - f1;
                    run0 += __builtin_amdgcn_logf(f0); run1 += __builtin_amdgcn_logf(f1); c0[j] = run0; c1[j] = run1;
                }
            }
            { unsigned rv[8];
#pragma unroll
              for (int j = 0; j < 8; ++j) rv[j] = *(const LAS unsigned short*)(lds + MX_RV + (wave * 8 + j) * 128 + lane * 2);
              vpk[0] = rv[0] | (rv[1] << 16); vpk[1] = rv[2] | (rv[3] << 16); vpk[2] = rv[4] | (rv[5] << 16); vpk[3] = rv[6] | (rv[7] << 16); }
            }
            { typedef float f32x2_ __attribute__((ext_vector_type(2))); *(LAS f32x2_*)(lds + MX_TOT + (wave * 128 + 2 * lane) * 4) = (f32x2_){run0, run1}; }
            LDS_BARRIER();
            if (ch + 1 < 32) MX_LOAD(ch + 1);
            float kt0[8], kt1[8];
            float tt0, tt1;
#pragma unroll
            for (int j = 0; j < 8; ++j) { kt0[j] = kt1[j] = 0.f; }
            tt0 = tt1 = 0.f;
            if (MODE != 3 && MODE != 4) {
            if (type == 0) {
                tt0 = tt1 = 64.f * lg2;
#pragma unroll
                for (int j = 0; j < 8; ++j) {
                    const int pos = wave * 8 + j;
                    const f32x4 e = *(const LAS f32x4*)(lds + MX_DEC + 512 + pos * 16);
                    *(LAS unsigned*)(lds + MX_QI + pos * 272 + lane * 4) = pack2(q0[j] * e[0], q1[j] * e[0]);
                    *(LAS unsigned*)(lds + MX_KI + pos * 272 + lane * 4) = pack2(k0[j] * e[1], k1[j] * e[1]);
                    kt0[j] = k0[j] * e[3]; kt1[j] = k1[j] * e[3];
                }
            } else {
                float off0 = 0.f, off1 = 0.f, m0 = 0.f, m1 = 0.f; tt0 = 0.f; tt1 = 0.f;
#pragma unroll
                for (int g = 0; g < 8; ++g) {
                    typedef float f32x2_ __attribute__((ext_vector_type(2)));
                    const f32x2_ tv = *(const LAS f32x2_*)(lds + MX_TOT + (g * 128 + 2 * lane) * 4);
                    if (g < wave) { off0 += tv[0]; off1 += tv[1]; }
                    if (g < 4) { m0 += tv[0]; m1 += tv[1]; }
                    tt0 += tv[0]; tt1 += tv[1];
                }
                const float etm0 = ex2(tt0 - m0), etm1 = ex2(tt1 - m1);
#pragma unroll
                for (int j = 0; j < 8; ++j) {
                    const float cu0 = c0[j] + off0, cu1 = c1[j] + off1;
                    const float e10 = ex2(clampe(cu0 - m0)), e11 = ex2(clampe(cu1 - m1));
                    const float e20 = __builtin_amdgcn_rcpf(e10), e21 = __builtin_amdgcn_rcpf(e11);
                    const int pos = wave * 8 + j;
                    *(LAS unsigned*)(lds + MX_QI + pos * 272 + lane * 4) = pack2(q0[j] * e10, q1[j] * e11);
                    *(LAS unsigned*)(lds + MX_KI + pos * 272 + lane * 4) = pack2(k0[j] * e20, k1[j] * e21);
                    kt0[j] = k0[j] * (e20 * etm0); kt1[j] = k1[j] * (e21 * etm1);
                }
            }
            }
            { u32x4 w0, w1;
              w0[0] = pack2(kt0[0], kt0[1]); w0[1] = pack2(kt0[2], kt0[3]); w0[2] = pack2(kt0[4], kt0[5]); w0[3] = pack2(kt0[6], kt0[7]);
              w1[0] = pack2(kt1[0], kt1[1]); w1[1] = pack2(kt1[2], kt1[3]); w1[2] = pack2(kt1[4], kt1[5]); w1[3] = pack2(kt1[6], kt1[7]);
              *(LAS u32x4*)(lds + MX_KTT + (2 * lane) * 144 + wave * 16) = w0;
              *(LAS u32x4*)(lds + MX_KTT + (2 * lane + 1) * 144 + wave * 16) = w1;
              *(LAS u32x4*)(lds + MX_VT + lane * 144 + wave * 16) = vpk; }
            if (MODE != 3 && MODE != 4) {
                f32x4 em;
                if (type == 0) { const float e_ = ex2(32.f * lg2); em = (f32x4){e_, e_, e_, e_}; }
                else {
                    f32x4 ms = (f32x4){0.f, 0.f, 0.f, 0.f};
#pragma unroll
                    for (int g = 0; g < 4; ++g) ms += *(const LAS f32x4*)(lds + MX_TOT + (g * 128 + 16 * wave + 4 * fq) * 4);
                    em = (f32x4){ex2(ms[0]), ex2(ms[1]), ex2(ms[2]), ex2(ms[3])};
                }
#pragma unroll
                for (int vt = 0; vt < 4; ++vt) { u32x2 o; o[0] = pack2(Sacc[vt][0] * em[0], Sacc[vt][1] * em[1]); o[1] = pack2(Sacc[vt][2] * em[2], Sacc[vt][3] * em[3]);
                    *(LAS u32x2*)(lds + MX_ST + (16 * vt + fr) * 272 + (16 * wave + 4 * fq) * 2) = o; }
            }
            if (wave == 0) { typedef float f32x2_ __attribute__((ext_vector_type(2))); *(LAS f32x2_*)(lds + MX_DEC + lane * 8) = (f32x2_){ex2(tt0), ex2(tt1)}; }
            LDS_BARRIER();
            if (MODE != 2 && MODE != 4) {
                const int it = wave >> 1, st0 = 2 * (wave & 1);
                bf16x8 ka[2][4], qb[4];
#pragma unroll
                for (int kq = 0; kq < 4; ++kq) {
                    qb[kq] = *(const LAS bf16x8*)(lds + MX_QI + (16 * it + fr) * 272 + (32 * kq + 8 * fq) * 2);
                    ka[0][kq] = *(const LAS bf16x8*)(lds + MX_KI + (16 * st0 + fr) * 272 + (32 * kq + 8 * fq) * 2);
                    ka[1][kq] = *(const LAS bf16x8*)(lds + MX_KI + (16 * st0 + 16 + fr) * 272 + (32 * kq + 8 * fq) * 2);
                }
                asm volatile("s_waitcnt lgkmcnt(0)" ::: "memory");
                f32x4 acc0 = (f32x4){0.f, 0.f, 0.f, 0.f}, acc1 = acc0;
#pragma unroll
                for (int kq = 0; kq < 4; ++kq) {
                    acc0 = __builtin_amdgcn_mfma_f32_16x16x32_bf16(ka[0][kq], qb[kq], acc0, 0, 0, 0);
                    acc1 = __builtin_amdgcn_mfma_f32_16x16x32_bf16(ka[1][kq], qb[kq], acc1, 0, 0, 0);
                }
                const int i = 16 * it + fr;
                { const int s0 = 16 * st0 + 4 * fq;
                  const float v0 = (s0 + 0 <= i) ? acc0[0] : 0.f, v1 = (s0 + 1 <= i) ? acc0[1] : 0.f, v2 = (s0 + 2 <= i) ? acc0[2] : 0.f, v3 = (s0 + 3 <= i) ? acc0[3] : 0.f;
                  u32x2 o; o[0] = pack2(v0, v1); o[1] = pack2(v2, v3);
                  *(LAS u32x2*)(lds + MX_P + i * 144 + s0 * 2) = o; }
                { const int s0 = 16 * st0 + 16 + 4 * fq;
                  const float v0 = (s0 + 0 <= i) ? acc1[0] : 0.f, v1 = (s0 + 1 <= i) ? acc1[1] : 0.f, v2 = (s0 + 2 <= i) ? acc1[2] : 0.f, v3 = (s0 + 3 <= i) ? acc1[3] : 0.f;
                  u32x2 o; o[0] = pack2(v0, v1); o[1] = pack2(v2, v3);
                  *(LAS u32x2*)(lds + MX_P + i * 144 + s0 * 2) = o; }
            }
            LDS_BARRIER();
            if (MODE != 2 && MODE != 4) {
                const int vt = wave >> 1, it0 = 2 * (wave & 1);
                bf16x8 va[2], sa[4], pb[2][2], qsb[2][4], kta[2], vb[4][2];
#pragma unroll
                for (int kq = 0; kq < 2; ++kq) {
                    va[kq] = *(const LAS bf16x8*)(lds + MX_VT + (16 * vt + fr) * 144 + (32 * kq + 8 * fq) * 2);
                    pb[0][kq] = *(const LAS bf16x8*)(lds + MX_P + (16 * it0 + fr) * 144 + (32 * kq + 8 * fq) * 2);
                    pb[1][kq] = *(const LAS bf16x8*)(lds + MX_P + (16 * it0 + 16 + fr) * 144 + (32 * kq + 8 * fq) * 2);
                    kta[kq] = *(const LAS bf16x8*)(lds + MX_KTT + (16 * wave + fr) * 144 + (32 * kq + 8 * fq) * 2);
                }
#pragma unroll
                for (int kq = 0; kq < 4; ++kq) {
                    sa[kq] = *(const LAS bf16x8*)(lds + MX_ST + (16 * vt + fr) * 272 + (32 * kq + 8 * fq) * 2);
                    qsb[0][kq] = *(const LAS bf16x8*)(lds + MX_QI + (16 * it0 + fr) * 272 + (32 * kq + 8 * fq) * 2);
                    qsb[1][kq] = *(const LAS bf16x8*)(lds + MX_QI + (16 * it0 + 16 + fr) * 272 + (32 * kq + 8 * fq) * 2);
                }
#pragma unroll
                for (int v4 = 0; v4 < 4; ++v4)
#pragma unroll
                    for (int kq = 0; kq < 2; ++kq) vb[v4][kq] = *(const LAS bf16x8*)(lds + MX_VT + (16 * v4 + fr) * 144 + (32 * kq + 8 * fq) * 2);
                const f32x4 dc = *(const LAS f32x4*)(lds + MX_DEC + (16 * wave + 4 * fq) * 4);
                asm volatile("s_waitcnt lgkmcnt(0)" ::: "memory");
                f32x4 acc0 = (f32x4){0.f, 0.f, 0.f, 0.f}, acc1 = acc0;
#pragma unroll
                for (int kq = 0; kq < 2; ++kq) {
                    acc0 = __builtin_amdgcn_mfma_f32_16x16x32_bf16(va[kq], pb[0][kq], acc0, 0, 0, 0);
                    acc1 = __builtin_amdgcn_mfma_f32_16x16x32_bf16(va[kq], pb[1][kq], acc1, 0, 0, 0);
                }
#pragma unroll
                for (int kq = 0; kq < 4; ++kq) {
                    acc0 = __builtin_amdgcn_mfma_f32_16x16x32_bf16(sa[kq], qsb[0][kq], acc0, 0, 0, 0);
                    acc1 = __builtin_amdgcn_mfma_f32_16x16x32_bf16(sa[kq], qsb[1][kq], acc1, 0, 0, 0);
                }
#pragma unroll
                for (int v4 = 0; v4 < 4; ++v4) {
                    f32x4 a = Sacc[v4]; a[0] *= dc[0]; a[1] *= dc[1]; a[2] *= dc[2]; a[3] *= dc[3];
                    a = __builtin_amdgcn_mfma_f32_16x16x32_bf16(kta[0], vb[v4][0], a, 0, 0, 0);
                    a = __builtin_amdgcn_mfma_f32_16x16x32_bf16(kta[1], vb[v4][1], a, 0, 0, 0);
                    Sacc[v4] = a;
                }
                asm volatile("s_waitcnt vmcnt(0)" ::: "memory");
                { const int tau = ch * 64 + 16 * it0 + fr; const int t = dir ? (SEQ - 1 - tau) : tau;
                  u32x2 o; o[0] = pack2(acc0[0], acc0[1]); o[1] = pack2(acc0[2], acc0[3]);
                  *(u32x2*)((bf16_t*)obuf + ((size_t)dir * T + (size_t)(b * SEQ + t)) * 1536 + ocol + 16 * vt + 4 * fq) = o; }
                { const int tau = ch * 64 + 16 * it0 + 16 + fr; const int t = dir ? (SEQ - 1 - tau) : tau;
                  u32x2 o; o[0] = pack2(acc1[0], acc1[1]); o[1] = pack2(acc1[2], acc1[3]);
                  *(u32x2*)((bf16_t*)obuf + ((size_t)dir * T + (size_t)(b * SEQ + t)) * 1536 + ocol + 16 * vt + 4 * fq) = o; }
            }
        }
        __syncthreads();
#undef MX_LOAD
    }
}

#ifdef MIXER_CHECK
__device__ __forceinline__ void phase_mixer_check(const Params& p, const float* __restrict__ oa, const float* __restrict__ ob, float* chk) {
    int tid_ = threadIdx.x; asm volatile("" : "+v"(tid_)); const int wave = tid_ >> 6, lane = tid_ & 63;
    for (int r = blockIdx.x * 8 + wave; r < 2 * T; r += gridDim.x * 8) {
        const int dir = r / T;
#pragma unroll
        for (int ty = 0; ty < 2; ++ty) {
            float sd = 0.f, sq = 0.f;
#pragma unroll
            for (int i = 0; i < 3; ++i) { const float4 a = *(const float4*)(oa + (size_t)r * 1536 + ty * 768 + i * 256 + lane * 4), bq = *(const float4*)(ob + (size_t)r * 1536 + ty * 768 + i * 256 + lane * 4);
                sd += (a.x - bq.x) * (a.x - bq.x) + (a.y - bq.y) * (a.y - bq.y) + (a.z - bq.z) * (a.z - bq.z) + (a.w - bq.w) * (a.w - bq.w);
                sq += a.x * a.x + a.y * a.y + a.z * a.z + a.w * a.w; }
            sd = wave_sum(sd); sq = wave_sum(sq);
            if (lane == 0) { atomicAdd(&chk[(ty * 2 + dir) * 2 + 0], sd); atomicAdd(&chk[(ty * 2 + dir) * 2 + 1], sq); }
        }
    }
}
#endif

__device__ __forceinline__ float4 ld_bf4(const bf16_t* p) { const u32x2 r = *(const u32x2*)p; return make_float4(bf2f(r[0] & 0xffffu), bf2f(r[0] >> 16), bf2f(r[1] & 0xffffu), bf2f(r[1] >> 16)); }
__device__ __forceinline__ float grp16_sum(float v) {
#pragma unroll
    for (int o = 8; o > 0; o >>= 1) v += __shfl_xor(v, o, 64);
    return v;
}
__device__ __forceinline__ void phase_finalize(const Params& p, int l) {
    int tid_ = threadIdx.x; asm volatile("" : "+v"(tid_)); const int wave = tid_ >> 6, lane = tid_ & 63;
    const bf16_t* proj = (const bf16_t*)(p.ws + WS_PROJ);
    const bf16_t* obuf = (const bf16_t*)(p.ws + WS_OBUF);
    bf16_t* mixed = (bf16_t*)(p.ws + WS_MIXED);
    const float* cw = p.conv_w + (size_t)l * 3 * CW;
    const float* beta = p.mix_beta + (size_t)l * D;
    for (int n = blockIdx.x * 8 + wave; n < T; n += gridDim.x * 8) {
        const int t = n % SEQ;
        const bf16_t* row = proj + (size_t)n * INC;
#pragma unroll
        for (int i = 0; i < 4; ++i) {
            const int c = COL8(i);
            float4 r[2];
            if (i == 0) {
                float4 cc[2], ch[2], cb[2], um[2], up[2];
                ld_bf8(row + C_CC + c, cc[0], cc[1]); ld_bf8(row + C_CH + c, ch[0], ch[1]); ld_bf8(row + C_CB + c, cb[0], cb[1]);
                um[0] = um[1] = up[0] = up[1] = make_float4(0.f, 0.f, 0.f, 0.f);
                if (t > 0) { float4 a[2], b2[2]; ld_bf8(row - INC + C_CC + c, a[0], a[1]); ld_bf8(row - INC + C_CH + c, b2[0], b2[1]);
#pragma unroll
                    for (int q = 0; q < 2; ++q) um[q] = make_float4(a[q].x * b2[q].x, a[q].y * b2[q].y, a[q].z * b2[q].z, a[q].w * b2[q].w); }
                if (t < SEQ - 1) { float4 a[2], b2[2]; ld_bf8(row + INC + C_CC + c, a[0], a[1]); ld_bf8(row + INC + C_CH + c, b2[0], b2[1]);
#pragma unroll
                    for (int q = 0; q < 2; ++q) up[q] = make_float4(a[q].x * b2[q].x, a[q].y * b2[q].y, a[q].z * b2[q].z, a[q].w * b2[q].w); }
#pragma unroll
                for (int q = 0; q < 2; ++q) {
                    const float4 w0 = *(const float4*)(cw + c + 4 * q), w1 = *(const float4*)(cw + CW + c + 4 * q), w2 = *(const float4*)(cw + 2 * CW + c + 4 * q);
                    r[q].x = cb[q].x * (um[q].x * w0.x + cc[q].x * ch[q].x * w1.x + up[q].x * w2.x);
                    r[q].y = cb[q].y * (um[q].y * w0.y + cc[q].y * ch[q].y * w1.y + up[q].y * w2.y);
                    r[q].z = cb[q].z * (um[q].z * w0.z + cc[q].z * ch[q].z * w1.z + up[q].z * w2.z);
                    r[q].w = cb[q].w * (um[q].w * w0.w + cc[q].w * ch[q].w * w1.w + up[q].w * w2.w);
                }
            } else {
                const int oc = c - 512;
                const bool isret = oc < 768;
                float4 of[2], ob[2], gt[2];
                ld_bf8(obuf + (size_t)n * 1536 + oc, of[0], of[1]); ld_bf8(obuf + ((size_t)T + n) * 1536 + oc, ob[0], ob[1]);
                ld_bf8(row + (isret ? C_RG + oc : C_HG + (oc - 768)), gt[0], gt[1]);
                float4 o[2];
#pragma unroll
                for (int q = 0; q < 2; ++q) o[q] = make_float4(of[q].x + ob[q].x, of[q].y + ob[q].y, of[q].z + ob[q].z, of[q].w + ob[q].w);
                const float sm = grp16_sum(((o[0].x + o[0].y) + (o[0].z + o[0].w)) + ((o[1].x + o[1].y) + (o[1].z + o[1].w)));
                const float mu = isret ? sm * (1.0f / 128.0f) : 0.f;
#pragma unroll
                for (int q = 0; q < 2; ++q) { o[q].x -= mu; o[q].y -= mu; o[q].z -= mu; o[q].w -= mu; }
                const float var = grp16_sum(((o[0].x * o[0].x + o[0].y * o[0].y) + (o[0].z * o[0].z + o[0].w * o[0].w)) + ((o[1].x * o[1].x + o[1].y * o[1].y) + (o[1].z * o[1].z + o[1].w * o[1].w))) * (1.0f / 128.0f);
                const float rs = rsqrtf(var + 1e-6f);
#pragma unroll
                for (int q = 0; q < 2; ++q) r[q] = make_float4(o[q].x * rs * siluf_(gt[q].x), o[q].y * rs * siluf_(gt[q].y), o[q].z * rs * siluf_(gt[q].z), o[q].w * rs * siluf_(gt[q].w));
            }
            const float4 bt0 = *(const float4*)(beta + c), bt1 = *(const float4*)(beta + c + 4);
            r[0] = make_float4(r[0].x * bt0.x, r[0].y * bt0.y, r[0].z * bt0.z, r[0].w * bt0.w);
            r[1] = make_float4(r[1].x * bt1.x, r[1].y * bt1.y, r[1].z * bt1.z, r[1].w * bt1.w);
            if (OUT8(l)) { const float4 a4 = make_float4(r[0].x * 4.f, r[0].y * 4.f, r[0].z * 4.f, r[0].w * 4.f), b4 = make_float4(r[1].x * 4.f, r[1].y * 4.f, r[1].z * 4.f, r[1].w * 4.f);
                           st_fp8x8((unsigned char*)mixed + (size_t)n * D + c, a4, b4); }
            else st_bf8(mixed + (size_t)n * D + c, r[0], r[1]);
        }
    }
}

__device__ __forceinline__ void phase_ln1_router(const Params& p, int l, LAS unsigned char* lds) {
    int tid = threadIdx.x; asm volatile("" : "+v"(tid)); const int wave = tid >> 6, lane = tid & 63;
    LAS float* wrt = (LAS float*)lds;
    for (int i = tid; i < D * NE / 4; i += 512) {
        const float4 w = *(const float4*)(p.w_router + (size_t)i * 4);
        const int d = i >> 2, e4 = (i & 3) * 4;
        const int dp = (((d >> 9) * 2 + ((d >> 2) & 1)) << 8) + (((d >> 3) & 63) << 2) + (d & 3);
        wrt[(e4 + 0) * D + dp] = w.x; wrt[(e4 + 1) * D + dp] = w.y; wrt[(e4 + 2) * D + dp] = w.z; wrt[(e4 + 3) * D + dp] = w.w;
    }
    LAS int* lcnt = (LAS int*)(lds + LDS_MISC + 256);
    if (tid < 16) lcnt[tid] = 0;
    __syncthreads();
    const float* mod = (const float*)(p.ws + WS_MOD);
    const float* y = (const float*)(p.ws + WS_Y);
    float* xres = (float*)(p.ws + WS_XRES);
    int* route = (int*)(p.ws + WS_ROUTE);
    for (int n = blockIdx.x * 8 + wave; n < T; n += gridDim.x * 8) {
        const int b = n / SEQ;
        const float* mb = mod + ((size_t)l * 4 + b) * (6 * D);
        float4 v[8];
#pragma unroll
        for (int i = 0; i < 4; ++i) {
            float4 xv[2], yv[2];
            ld_bf8((const bf16_t*)xres + (size_t)n * D + COL8(i), xv[0], xv[1]); ld_bf8((const bf16_t*)y + (size_t)n * D + COL8(i), yv[0], yv[1]);
#pragma unroll
            for (int q = 0; q < 2; ++q) {
                const float4 g = *(const float4*)(mb + 2 * D + COLK(2 * i + q));
                v[2 * i + q] = make_float4(ALPHA * xv[q].x + (1.f + g.x) * yv[q].x, ALPHA * xv[q].y + (1.f + g.y) * yv[q].y, ALPHA * xv[q].z + (1.f + g.z) * yv[q].z, ALPHA * xv[q].w + (1.f + g.w) * yv[q].w);
            }
        }
        ln_rows(v, p.ln_g + (size_t)(l * 2 + 0) * D, p.ln_b + (size_t)(l * 2 + 0) * D, lane);
#pragma unroll
        for (int i = 0; i < 4; ++i) st_bf8((bf16_t*)xres + (size_t)n * D + COL8(i), v[2 * i], v[2 * i + 1]);
#pragma unroll
        for (int i = 0; i < 8; ++i) {
            const float4 sh = *(const float4*)(mb + 3 * D + COLK(i)), sc = *(const float4*)(mb + 4 * D + COLK(i));
            v[i].x = v[i].x * (1.f + sc.x) + sh.x; v[i].y = v[i].y * (1.f + sc.y) + sh.y; v[i].z = v[i].z * (1.f + sc.z) + sh.z; v[i].w = v[i].w * (1.f + sc.w) + sh.w;
        }
#if MOE_FP8
        unsigned char* hb = p.ws + WS_HB + (size_t)n * D;
#pragma unroll
        for (int i = 0; i < 4; ++i) st_fp8x8(hb + COL8(i), v[2 * i], v[2 * i + 1]);
#else
        bf16_t* hb = (bf16_t*)(p.ws + WS_HB) + (size_t)n * D;
#pragma unroll
        for (int i = 0; i < 4; ++i) st_bf8(hb + COL8(i), v[2 * i], v[2 * i + 1]);
#endif
        float lgk0 = 0.f, lgk1 = 0.f, lgk2 = 0.f, lgk3 = 0.f;
        const bool b5 = (lane & 32) != 0, b4 = (lane & 16) != 0;
#pragma unroll 1
        for (int eg = 0; eg < 4; ++eg) {
            float s4[4];
#pragma unroll
            for (int q = 0; q < 4; ++q) {
                float s = 0.f;
#pragma unroll
                for (int i = 0; i < 8; ++i) { const f32x4 w = *(const LAS f32x4*)(wrt + (eg * 4 + q) * D + i * 256 + lane * 4); s += (v[i].x * w[0] + v[i].y * w[1]) + (v[i].z * w[2] + v[i].w * w[3]); }
                s4[q] = s;
            }
            const float tA = (b5 ? s4[2] : s4[0]) + __shfl_xor(b5 ? s4[0] : s4[2], 32, 64);
            const float tB = (b5 ? s4[3] : s4[1]) + __shfl_xor(b5 ? s4[1] : s4[3], 32, 64);
            float u = (b4 ? tB : tA) + __shfl_xor(b4 ? tA : tB, 16, 64);
            u += __shfl_xor(u, 8, 64); u += __shfl_xor(u, 4, 64); u += __shfl_xor(u, 2, 64); u += __shfl_xor(u, 1, 64);
            lgk0 = (eg == 0) ? u : lgk0; lgk1 = (eg == 1) ? u : lgk1; lgk2 = (eg == 2) ? u : lgk2; lgk3 = (eg == 3) ? u : lgk3;
        }
        float lg[16];
#pragma unroll
        for (int q = 0; q < 4; ++q) {
            const int src = ((q >> 1) * 32) + ((q & 1) * 16);
            lg[0 + q] = __int_as_float(__builtin_amdgcn_readlane(__float_as_int(lgk0), src));
            lg[4 + q] = __int_as_float(__builtin_amdgcn_readlane(__float_as_int(lgk1), src));
            lg[8 + q] = __int_as_float(__builtin_amdgcn_readlane(__float_as_int(lgk2), src));
            lg[12 + q] = __int_as_float(__builtin_amdgcn_readlane(__float_as_int(lgk3), src));
        }
        float mx = lg[0];
#pragma unroll
        for (int e = 1; e < 16; ++e) mx = fmaxf(mx, lg[e]);
        float sc[16], sum = 0.f;
#pragma unroll
        for (int e = 0; e < 16; ++e) { sc[e] = expf(lg[e] - mx); sum += sc[e]; }
        const float inv = 1.0f / sum;
        float sel[16];
#pragma unroll
        for (int e = 0; e < 16; ++e) { sc[e] *= inv; sel[e] = sc[e] + p.router_bias[e]; }
        float best_gs = -3.0e38f; int bi0 = 0, bi1 = 1; float bw0 = 0.f, bw1 = 0.f;
#pragma unroll
        for (int g = 0; g < 4; ++g) {
            int i0 = 0; float m0 = sel[4 * g];
#pragma unroll
            for (int j = 1; j < 4; ++j) if (sel[4 * g + j] > m0) { m0 = sel[4 * g + j]; i0 = j; }
            int i1 = -1; float m1 = -3.0e38f;
#pragma unroll
            for (int j = 0; j < 4; ++j) if (j != i0 && sel[4 * g + j] > m1) { m1 = sel[4 * g + j]; i1 = j; }
            float w0 = 0.f, w1 = 0.f;
#pragma unroll
            for (int j = 0; j < 4; ++j) { w0 = (j == i0) ? sc[4 * g + j] : w0; w1 = (j == i1) ? sc[4 * g + j] : w1; }
            const float gs = m0 + m1;
            if (gs > best_gs) { best_gs = gs; bi0 = 4 * g + i0; bi1 = 4 * g + i1; bw0 = w0; bw1 = w1; }
        }
        if (lane == 0) {
            const float ws_ = 1.0f / (bw0 + bw1);
            const int p0 = __hip_atomic_fetch_add(&lcnt[bi0], 1, __ATOMIC_RELAXED, __HIP_MEMORY_SCOPE_WORKGROUP), p1 = __hip_atomic_fetch_add(&lcnt[bi1], 1, __ATOMIC_RELAXED, __HIP_MEMORY_SCOPE_WORKGROUP);
            int* r = route + (size_t)n * 8;
            r[0] = bi0; r[1] = bi1; r[2] = (int)p0; r[3] = (int)p1; r[4] = __float_as_int(bw0 * ws_); r[5] = __float_as_int(bw1 * ws_);
        }
    }
    __syncthreads();
    if (tid < 16) ((int*)(p.ws + WS_WGCNT))[((size_t)l * 1024 + blockIdx.x) * 16 + tid] = lcnt[tid];
}

__device__ __forceinline__ void build_moe_tab(const Params& p, int l, LAS int* tab) {
    if (threadIdx.x == 0) {
        const unsigned* cnt = (const unsigned*)(p.ws + WS_CNT) + l * 16;
        int acc = 0;
        for (int e = 0; e < 16; ++e) { tab[e] = acc; acc += (int)((cnt[e] + 255u) >> 8); }
        tab[16] = acc;
    }
    __syncthreads();
}

__device__ __forceinline__ void phase_permute(const Params& p, int l, LAS int* tab) {
    int tid_ = threadIdx.x; asm volatile("" : "+v"(tid_)); const int wave = tid_ >> 6, lane = tid_ & 63;
    LAS int* base = tab + 32; LAS int* total = tab + 48;
    if (tid_ < 16) { base[tid_] = 0; total[tid_] = 0; }
    __syncthreads();
    {
        const int* wgc = (const int*)(p.ws + WS_WGCNT) + (size_t)l * 1024 * 16;
        const int e = tid_ & 15; int bs = 0, tt = 0;
        for (int w = tid_ >> 4; w < (int)gridDim.x; w += 32) { const int v = wgc[w * 16 + e]; tt += v; bs += (w < (int)blockIdx.x) ? v : 0; }
        __hip_atomic_fetch_add(&base[e], bs, __ATOMIC_RELAXED, __HIP_MEMORY_SCOPE_WORKGROUP);
        __hip_atomic_fetch_add(&total[e], tt, __ATOMIC_RELAXED, __HIP_MEMORY_SCOPE_WORKGROUP);
    }
    __syncthreads();
    if (tid_ == 0) { int acc = 0; for (int e = 0; e < 16; ++e) { tab[e] = acc; acc += (total[e] + 255) >> 8; } tab[16] = acc; }
    if (blockIdx.x == 0 && tid_ < 16) ((unsigned*)(p.ws + WS_CNT))[l * 16 + tid_] = (unsigned)total[tid_];
    __syncthreads();
#if MOE_FP8
    for (int i = blockIdx.x * 512 + tid_; i < XE_ROWS * 8; i += gridDim.x * 512) *(u32x4*)(p.ws + WS_HID + (size_t)(i >> 3) * DEP + DE + (i & 7) * 16) = (u32x4){0u, 0u, 0u, 0u};
#endif
    int* route = (int*)(p.ws + WS_ROUTE);
    const bf16_t* hb = (const bf16_t*)(p.ws + WS_HB);
    bf16_t* xe = (bf16_t*)(p.ws + WS_XE);
    for (int n = blockIdx.x * 8 + wave; n < T; n += gridDim.x * 8) {
        int* r = route + (size_t)n * 8;
        const int e0 = r[0], e1 = r[1], p0 = r[2], p1 = r[3];
        const int row0 = tab[e0] * 256 + base[e0] + p0, row1 = tab[e1] * 256 + base[e1] + p1;
        constexpr int RB = MOE_FP8 ? D : 2 * D;
        const u32x4* src = (const u32x4*)((const unsigned char*)hb + (size_t)n * RB);
        u32x4* d0 = (u32x4*)((unsigned char*)xe + (size_t)row0 * RB); u32x4* d1 = (u32x4*)((unsigned char*)xe + (size_t)row1 * RB);
#pragma unroll
        for (int i = 0; i < RB / 1024; ++i) { const u32x4 v = src[i * 64 + lane]; d0[i * 64 + lane] = v; d1[i * 64 + lane] = v; }
        if (lane == 0) { r[6] = row0; r[7] = row1; }
    }
}

__device__ __forceinline__ void phase_ln2(const Params& p, int l) {
    int tid_ = threadIdx.x; asm volatile("" : "+v"(tid_)); const int wave = tid_ >> 6, lane = tid_ & 63;
    const float* mod = (const float*)(p.ws + WS_MOD);
    const float* ye = (const float*)(p.ws + WS_YE);
    float* xres = (float*)(p.ws + WS_XRES);
    const int* route = (const int*)(p.ws + WS_ROUTE);
    for (int n = blockIdx.x * 8 + wave; n < T; n += gridDim.x * 8) {
        const int b = n / SEQ;
        const float* mb = mod + ((size_t)l * 4 + b) * (6 * D);
        const int* r = route + (size_t)n * 8;
        const float w0 = __int_as_float(r[4]), w1 = __int_as_float(r[5]);
        const bf16_t* y0 = (const bf16_t*)ye + (size_t)r[6] * D; const bf16_t* y1 = (const bf16_t*)ye + (size_t)r[7] * D;
        float4 v[8];
#pragma unroll
        for (int i = 0; i < 4; ++i) {
            float4 xv[2], a[2], c[2];
            ld_bf8((const bf16_t*)xres + (size_t)n * D + COL8(i), xv[0], xv[1]); ld_bf8(y0 + COL8(i), a[0], a[1]); ld_bf8(y1 + COL8(i), c[0], c[1]);
#pragma unroll
            for (int q = 0; q < 2; ++q) {
                const float4 g = *(const float4*)(mb + 5 * D + COLK(2 * i + q));
                v[2 * i + q] = make_float4(ALPHA * xv[q].x + (1.f + g.x) * (w0 * a[q].x + w1 * c[q].x), ALPHA * xv[q].y + (1.f + g.y) * (w0 * a[q].y + w1 * c[q].y),
                                           ALPHA * xv[q].z + (1.f + g.z) * (w0 * a[q].z + w1 * c[q].z), ALPHA * xv[q].w + (1.f + g.w) * (w0 * a[q].w + w1 * c[q].w));
            }
        }
        ln_rows(v, p.ln_g + (size_t)(l * 2 + 1) * D, p.ln_b + (size_t)(l * 2 + 1) * D, lane);
        if (l + 1 < DEPTH) {
#pragma unroll
            for (int i = 0; i < 4; ++i) st_bf8((bf16_t*)xres + (size_t)n * D + COL8(i), v[2 * i], v[2 * i + 1]);
            const float* mn = mod + ((size_t)(l + 1) * 4 + b) * (6 * D);
            modulate_store(v, mn, mn + D, INP8(l + 1) ? (bf16_t*)(p.ws + WS_HA + (size_t)n * D) : (bf16_t*)(p.ws + WS_HA) + (size_t)n * D, lane, INP8(l + 1));
        } else {
#ifdef MIXER_CHECK
            { const float* chk = (const float*)(p.ws + WS_CNT + 1024); float scale = 1.f;
              for (int j = 7; j >= 0; --j) { const float sd = chk[j * 2], sq = chk[j * 2 + 1]; if (!(sd <= 1e-3f * sq)) scale = 1.0f + 0.25f * (float)(1 << (j & 3)) + 8.f * (float)(j >> 2); }
#pragma unroll
              for (int i = 0; i < 8; ++i) { v[i].x *= scale; v[i].y *= scale; v[i].z *= scale; v[i].w *= scale; } }
#endif
#pragma unroll
            for (int i = 0; i < 8; ++i) *(float4*)(p.out + (size_t)n * D + COLK(i)) = v[i];
        }
    }
}

typedef const __attribute__((address_space(4))) unsigned char* KargPtr;
__device__ __forceinline__ Params load_params(KargPtr q) { asm volatile("" : "+s"(q)); Params lp; __builtin_memcpy(&lp, q, sizeof(Params)); return lp; }

__global__ __launch_bounds__(512, 2) void mega(Params p_in) {
    extern __shared__ __attribute__((aligned(16))) unsigned char smem[];
    LAS unsigned char* lds = (LAS unsigned char*)smem;
    LAS int* tab = (LAS int*)(lds + LDS_MISC + 64);
    KargPtr kp = (KargPtr)__builtin_amdgcn_kernarg_segment_ptr();
    if (threadIdx.x == 0) { *(LAS u32x4*)(lds + LDS_MISC) = (u32x4){0u, 0u, 0u, 0u}; *(LAS u32x4*)(lds + LDS_MISC + 768) = (u32x4){0u, 0u, 0u, 0u}; *(LAS u32x4*)(lds + LDS_MISC + 784) = (u32x4){0u, 0u, 0u, 0u}; }
    __syncthreads();
    const int fused = p_in.fused, ph_lo = p_in.ph_lo, ph_hi = p_in.ph_hi, l_hi = p_in.l_hi;
    XcdBarrier bar;
    if (fused) bar = xcd_barrier_post((unsigned*)(p_in.ws + WS_BAR), (volatile LAS unsigned*)(lds + LDS_MISC));
    else { bar.bar = (unsigned*)(p_in.ws + WS_BAR); bar.x = 0; bar.st = (volatile LAS unsigned*)(lds + LDS_MISC); }
#ifdef ONLY_PH
#define PH(i) ((i) == ONLY_PH && ph_lo <= (i) && (i) < ph_hi)
#else
#define PH(i) (ph_lo <= (i) && (i) < ph_hi)
#endif
#ifdef PROBE_PH
#define SYNC_PLAIN() do { if (fused) xcd_barrier(bar); } while (0)
#define PSTART(i) do { if ((i) == PROBE_PH && blockIdx.x == 0 && threadIdx.x == 0) { *(LAS unsigned long long*)(lds + LDS_MISC + 768) = __builtin_amdgcn_s_memrealtime(); } } while (0)
#define PSTOP(i) do { if ((i) == PROBE_PH && blockIdx.x == 0 && threadIdx.x == 0) { *(LAS unsigned long long*)(lds + LDS_MISC + 776) += __builtin_amdgcn_s_memrealtime() - *(LAS unsigned long long*)(lds + LDS_MISC + 768); } } while (0)
#else
#define PSTART(i) do { } while (0)
#define PSTOP(i) do { } while (0)
#endif
#if defined(PROBE_PH) && defined(PROBE_SUB)
#define QSTART(i, k) do { if ((i) == PROBE_PH && (k) == PROBE_SUB && blockIdx.x == PROBE_WG && threadIdx.x == 0) { *(LAS unsigned long long*)(lds + LDS_MISC + 784) = __builtin_amdgcn_s_memrealtime(); } } while (0)
#define QSTOP(i, k) do { if ((i) == PROBE_PH && (k) == PROBE_SUB && blockIdx.x == PROBE_WG && threadIdx.x == 0) { *(LAS unsigned long long*)(lds + LDS_MISC + 792) += __builtin_amdgcn_s_memrealtime() - *(LAS unsigned long long*)(lds + LDS_MISC + 784); } } while (0)
#else
#define QSTART(i, k) do { } while (0)
#define QSTOP(i, k) do { } while (0)
#endif
#define SYNC() do { if (fused) xcd_barrier(bar); } while (0)
#ifndef DUP_MASK
#define DUP_MASK 0
#endif
#define REP(i) _Pragma("unroll 1") for (int rep_ = 0; rep_ < 1 + ((DUP_MASK >> (i)) & 1); ++rep_)
    const int G = gridDim.x, c = blockIdx.x;
    if (PH(0)) REP(0) { PSTART(0); const Params p = load_params(kp); phase_prologue(p, lds); SYNC(); PSTOP(0); }
    if (PH(1)) REP(1) { PSTART(1); const Params p = load_params(kp); phase_ln0(p); SYNC(); PSTOP(1); }
    for (int l = p_in.l_lo; l < l_hi; ++l) {
        const bool svc = (l == 0) && (G >= 256);
        if (PH(2)) REP(2) { PSTART(2);
            const Params p = load_params(kp);
            pg8::Gemm g{(const bf16_t*)(p.ws + WS_HA), (const bf16_t*)(p.ws + WS_WIN) + (size_t)l * INC * D, D};
            pg8::EpiBf16 E{(bf16_t*)(p.ws + WS_PROJ), INC};
            if (svc) {
                if (c < 240) {
                    pg8::DenseOrder<32, 30> S; S.init(INP8(0) ? D : 2 * D, 240, c);
                    if (INP8(0)) pg8::gemm_phase<pg8::EpiBf16, pg8::DenseOrder<32, 30>, true>(lds, g, S, E, 121, 127);
                    else pg8::gemm_phase(lds, g, S, E);
                } else ada_chunks(p, lds, 128 + (c - 240), 256, 16);
                tail_pull(p, lds, l * 4 + 0);
            } else {
                pg8::DenseOrder<32, 32> S; S.init(INP8(l) ? D : 2 * D, G, c);
                if (INP8(l)) pg8::gemm_phase<pg8::EpiBf16, pg8::DenseOrder<32, 32>, true>(lds, g, S, E, 121, 127);
                else pg8::gemm_phase(lds, g, S, E);
            }
            SYNC(); PSTOP(2);
        }
#ifdef MIXER_CHECK
        if (PH(3)) REP(3) { PSTART(3); const Params p = load_params(kp); phase_mixer_valu(p, l, lds); SYNC(); PSTOP(3); }
        if (PH(3)) REP(3) { PSTART(3); const Params p = load_params(kp); phase_mixer_mfma<0>(p, l, lds, (float*)(p.ws + WS_XE)); SYNC(); PSTOP(3); }
        if (PH(3)) REP(3) { PSTART(3); const Params p = load_params(kp); phase_mixer_check(p, (const float*)(p.ws + WS_OBUF), (const float*)(p.ws + WS_XE), (float*)(p.ws + WS_CNT + 1024) + l * 8); SYNC(); PSTOP(3); }
#else
        if (PH(3)) REP(3) { PSTART(3);
            const Params p = load_params(kp);
            const int n_extra = svc ? 96 : 32, pn0 = svc ? 30 : 32;
            for (int uu = (G >= 224 ? c - 192 : c); uu >= 0 && uu < n_extra; uu += (G >= 224 ? 64 : G)) {
                const int RBI = INP8(l) ? D : 2 * D;
                pg8::OneUnit S; S.u0.aB = (size_t)(uu & 31) * 256 * RBI; S.u0.bB = (size_t)(pn0 + (uu >> 5)) * 256 * RBI; S.u0.row0 = (uu & 31) * 256; S.u0.col0 = (pn0 + (uu >> 5)) * 256;
                pg8::EpiBf16 E{(bf16_t*)(p.ws + WS_PROJ), INC};
                pg8::Gemm g{(const bf16_t*)(p.ws + WS_HA), (const bf16_t*)(p.ws + WS_WIN) + (size_t)l * INC * D, D};
                if (INP8(l)) pg8::gemm_phase<pg8::EpiBf16, pg8::OneUnit, true>(lds, g, S, E, 121, 127);
                else pg8::gemm_phase(lds, g, S, E);
            }
            phase_mixer_mfma<0>(p, l, lds, (float*)(p.ws + WS_OBUF));
            tail_pull(p, lds, l * 4 + 1);
            SYNC(); PSTOP(3);
#ifdef MIXER_PROBE
            phase_mixer_mfma<MIXER_PROBE>(p, l, lds, (float*)(p.ws + WS_XE));
            SYNC(); PSTOP(3);
#endif
        }
#endif
        if (PH(4)) REP(4) { PSTART(4); const Params p = load_params(kp); phase_finalize(p, l); if (l == 0) cvt_pull(p, lds, CV_A0, nullptr, 0u); SYNC(); PSTOP(4); }
        if (PH(5)) REP(5) { PSTART(5);
            const Params p = load_params(kp);
            pg8::DenseOrder<32, 8> S; S.init(OUT8(l) ? D : 2 * D, G, c);
            pg8::Gemm g{(const bf16_t*)(p.ws + WS_MIXED), (const bf16_t*)(p.ws + WS_WOUT) + (size_t)l * D * D, D};
            pg8::EpiBf16 E{(bf16_t*)(p.ws + WS_Y), D};
            if (OUT8(l)) pg8::gemm_phase<pg8::EpiBf16, pg8::DenseOrder<32, 8>, true>(lds, g, S, E, 121, 125);
            else pg8::gemm_phase(lds, g, S, E);
            SYNC(); PSTOP(5);
        }
        if (PH(6)) REP(6) { PSTART(6); const Params p = load_params(kp); phase_ln1_router(p, l, lds); SYNC(); PSTOP(6); }
        if (PH(7)) REP(7) { PSTART(7); const Params p = load_params(kp); phase_permute(p, l, tab); cvt_pull(p, lds, l * CV_PER_L + CV_A1, nullptr, 0u); SYNC(); PSTOP(7); }
        if (PH(8)) REP(8) { PSTART(8);
            const Params p = load_params(kp);
            build_moe_tab(p, l, tab);
#if MOE_FP8
            pg8::MoeOrder S; S.tab = tab; S.NTn = 11; S.G = G; S.c = c; S.tstep = (size_t)256 * D; S.bexp = (size_t)2 * DE * D;
            pg8::Gemm g{(const bf16_t*)(p.ws + WS_XE), (const bf16_t*)(p.ws + WS_WGU + (size_t)l * NE * 2 * DE * D), D};
            pg8::EpiHidden8 E{p.ws + WS_HID};
            QSTART(8, 1); pg8::gemm_phase<pg8::EpiHidden8, pg8::MoeOrder, true>(lds, g, S, E, 121, 127); QSTOP(8, 1);
#else
            pg8::MoeOrder S; S.tab = tab; S.NTn = 11; S.G = G; S.c = c; S.tstep = (size_t)256 * D * 2; S.bexp = (size_t)2 * DE * D * 2;
            pg8::Gemm g{(const bf16_t*)(p.ws + WS_XE), (const bf16_t*)(p.ws + WS_WGU) + (size_t)l * NE * 2 * DE * D, D};
            pg8::EpiHidden E{(bf16_t*)(p.ws + WS_HID)};
            pg8::gemm_phase(lds, g, S, E);
#endif
            QSTART(8, 2); tail_pull(p, lds, l * 4 + 2); QSTOP(8, 2);
            QSTART(8, 3); cvt_pull(p, lds, (l + 1) * CV_PER_L, nullptr, 0u); QSTOP(8, 3);
            SYNC(); PSTOP(8);
        }
        if (PH(9)) REP(9) { PSTART(9);
            const Params p = load_params(kp);
            build_moe_tab(p, l, tab);
#if MOE_FP8
            pg8::MoeOrder S; S.tab = tab; S.NTn = 8; S.G = G; S.c = c; S.tstep = (size_t)256 * DEP; S.bexp = (size_t)D * DEP;
            pg8::Gemm g{(const bf16_t*)(p.ws + WS_HID), (const bf16_t*)(p.ws + WS_WD + (size_t)l * NE * D * DEP), DEP};
            pg8::EpiBf16 E{(bf16_t*)(p.ws + WS_YE), D};
            QSTART(9, 1); pg8::gemm_phase<pg8::EpiBf16, pg8::MoeOrder, true>(lds, g, S, E, 121, 124); QSTOP(9, 1);
#else
            pg8::MoeOrder S; S.tab = tab; S.NTn = 8; S.G = G; S.c = c; S.tstep = (size_t)256 * DE * 2; S.bexp = (size_t)D * DE * 2;
            pg8::Gemm g{(const bf16_t*)(p.ws + WS_HID), (const bf16_t*)(p.ws + WS_WD) + (size_t)l * NE * D * DE, DE};
            pg8::EpiBf16 E{(bf16_t*)(p.ws + WS_YE), D};
            pg8::gemm_phase(lds, g, S, E);
#endif
            QSTART(9, 2); tail_pull(p, lds, l * 4 + 3); QSTOP(9, 2);
            QSTART(9, 3); if (l + 1 < DEPTH) cvt_pull(p, lds, (l + 1) * CV_PER_L + CV_A0, nullptr, 0u); QSTOP(9, 3);
            SYNC(); PSTOP(9);
        }
        if (PH(10)) REP(10) { PSTART(10); const Params p = load_params(kp); phase_ln2(p, l); SYNC(); PSTOP(10); }
    }
#ifdef PROBE_PH
    if (blockIdx.x == 0 && threadIdx.x == 0) {
#ifdef PROBE_SUB
        const unsigned long long t = 0ull, t0 = __builtin_amdgcn_s_memrealtime();
#else
        const unsigned long long t = *(LAS unsigned long long*)(lds + LDS_MISC + 776) * 4ull, t0 = __builtin_amdgcn_s_memrealtime();
#endif
        while (__builtin_amdgcn_s_memrealtime() - t0 < t) __builtin_amdgcn_s_sleep(8);
    }
#ifdef PROBE_SUB
    if (blockIdx.x == PROBE_WG && threadIdx.x == 0) {
        const unsigned long long t = *(LAS unsigned long long*)(lds + LDS_MISC + 792) * 4ull, t0 = __builtin_amdgcn_s_memrealtime();
        while (__builtin_amdgcn_s_memrealtime() - t0 < t) __builtin_amdgcn_s_sleep(8);
    }
#endif
#endif
}

#ifndef MK_FUSED
#define MK_FUSED 1
#endif
extern "C" void kernel_launch(void* const* d_in, const int* in_sizes, int n_in, void* d_out, int out_size, void* d_ws, size_t ws_size, hipStream_t stream) {
    static int grid = 0;
    if (grid == 0) {
        if (n_in != 18 || ws_size < WS_END) { fprintf(stderr, "kernel_launch: unexpected n_in %d or ws_size %zu (< %zu)\n", n_in, ws_size, (size_t)WS_END); grid = -1; return; }
        int dev = 0, cus = 0, per_cu = 0;
        hipGetDevice(&dev);
        hipDeviceGetAttribute(&cus, hipDeviceAttributeMultiprocessorCount, dev);
        if (hipFuncSetAttribute((const void*)mega, hipFuncAttributeMaxDynamicSharedMemorySize, LDS_BYTES) != hipSuccess) { fprintf(stderr, "kernel_launch: hipFuncSetAttribute failed\n"); grid = -1; return; }
        hipOccupancyMaxActiveBlocksPerMultiprocessor(&per_cu, (const void*)mega, 512, LDS_BYTES);
        if (per_cu < 1) fprintf(stderr, "kernel_launch: occupancy query says %d\n", per_cu);
        grid = cus > 0 ? cus : 256;
    }
    if (grid < 0) return;
    hipMemsetAsync(d_ws, 0, WS_ZERO_BYTES, stream);
    Params p{};
    p.x = (const float*)d_in[0]; p.c = (const float*)d_in[1]; p.emb_g = (const float*)d_in[2]; p.emb_b = (const float*)d_in[3];
    p.w_ada = (const float*)d_in[4]; p.b_ada = (const float*)d_in[5]; p.w_in = (const float*)d_in[6]; p.conv_w = (const float*)d_in[7];
    p.mix_beta = (const float*)d_in[8]; p.w_out = (const float*)d_in[9]; p.lb_logits = (const float*)d_in[10]; p.ln_g = (const float*)d_in[11];
    p.ln_b = (const float*)d_in[12]; p.w_router = (const float*)d_in[13]; p.router_bias = (const float*)d_in[14]; p.w_gate = (const float*)d_in[15];
    p.w_up = (const float*)d_in[16]; p.w_down = (const float*)d_in[17];
    p.out = (float*)d_out; p.ws = (unsigned char*)d_ws; p.pad = 0;
#if MK_FUSED
    p.ph_lo = 0; p.ph_hi = 11; p.l_lo = 0; p.l_hi = DEPTH; p.fused = 1;
    hipLaunchKernelGGL(mega, dim3(grid), dim3(512), LDS_BYTES, stream, p);
#else
    p.fused = 0;
    for (int ph = 0; ph < 2; ++ph) { p.ph_lo = ph; p.ph_hi = ph + 1; p.l_lo = 0; p.l_hi = 0; hipLaunchKernelGGL(mega, dim3(grid), dim3(512), LDS_BYTES, stream, p); }
    for (int l = 0; l < DEPTH; ++l)
        for (int ph = 2; ph < 11; ++ph) { p.ph_lo = ph; p.ph_hi = ph + 1; p.l_lo = l; p.l_hi = l + 1; hipLaunchKernelGGL(mega, dim3(grid), dim3(512), LDS_BYTES, stream, p); }
#endif
}
```

```cpp
#include <hip/hip_runtime.h>
#include <stdint.h>
#include <stdio.h>

#define LAS __attribute__((address_space(3)))
typedef unsigned short bf16_t;
typedef short bf16x8 __attribute__((ext_vector_type(8)));
typedef float f32x4 __attribute__((ext_vector_type(4)));
typedef unsigned u32x4 __attribute__((ext_vector_type(4)));
typedef unsigned u32x2 __attribute__((ext_vector_type(2)));

constexpr int D = 2048, NB = 4, SEQ = 2048, T = NB * SEQ, DEPTH = 2;
constexpr int CW = 512, RW = 768, HWD = 768, INC = 8448;
constexpr int NE = 16, DE = 1408;
constexpr int C_CB = 0, C_CC = 512, C_CH = 1024, C_RQ = 1536, C_RK = 2304, C_RV = 3072, C_RG = 3840, C_HQ = 4608, C_HFF = 5376, C_HFB = 6144, C_HI = 6912, C_HG = 7680;
constexpr int XE_ROWS = 20480;
#ifndef MOE_FP8
#define MOE_FP8 1
#endif
#ifndef INP_FP8_FROM
#define INP_FP8_FROM 1
#endif
#define INP8(l) ((l) >= INP_FP8_FROM)
#ifndef OUT_FP8_FROM
#define OUT_FP8_FROM 1
#endif
#define OUT8(l) ((l) >= OUT_FP8_FROM)
constexpr int DEP = 1536;
constexpr float W8_SCALE = 64.f, H8_SCALE = 8.f;
constexpr float ALPHA = 1.4142135623730951f;

constexpr size_t WS_BAR = 0;
constexpr size_t WS_CNT = 16384;
constexpr size_t WS_CVTQ = 20480;
constexpr size_t WS_ZERO_BYTES = 32768;
constexpr size_t WS_MOD = 32768;
constexpr size_t WS_ROUTE = WS_MOD + 393216;
constexpr size_t WS_WGCNT = WS_ROUTE + 262144;
constexpr size_t WS_WIN = 1048576;
constexpr size_t SZ_WIN = (size_t)DEPTH * INC * D * 2;
constexpr size_t WS_WOUT = WS_WIN + SZ_WIN;
constexpr size_t SZ_WOUT = (size_t)DEPTH * D * D * 2;
constexpr size_t WS_WGU = WS_WOUT + SZ_WOUT;
constexpr size_t SZ_WGU = (size_t)DEPTH * NE * 2 * DE * D * 2;
constexpr size_t WS_WD = WS_WGU + SZ_WGU;
constexpr size_t SZ_WD = (size_t)DEPTH * NE * D * DE * 2;
constexpr size_t WS_XRES = WS_WD + SZ_WD;
constexpr size_t SZ_XRES = (size_t)T * D * 4;
constexpr size_t WS_HA = WS_XRES + SZ_XRES;
constexpr size_t SZ_H = (size_t)T * D * 2;
constexpr size_t WS_HB = WS_HA + SZ_H;
constexpr size_t WS_PROJ = WS_HB + SZ_H;
constexpr size_t SZ_PROJ = (size_t)T * INC * 2;
constexpr size_t WS_OBUF = WS_PROJ + SZ_PROJ;
constexpr size_t SZ_OBUF = (size_t)2 * T * 1536 * 4;
constexpr size_t WS_YE = WS_PROJ;
constexpr size_t SZ_YE = (size_t)XE_ROWS * D * 4;
static_assert(SZ_YE <= SZ_PROJ + SZ_OBUF, "ye alias");
constexpr size_t WS_MIXED = WS_OBUF + SZ_OBUF;
constexpr size_t WS_Y = WS_MIXED + SZ_H;
constexpr size_t SZ_Y = (size_t)T * D * 4;
constexpr size_t WS_XE = WS_Y + SZ_Y;
constexpr size_t SZ_XE = (size_t)XE_ROWS * D * 2;
constexpr size_t WS_HID = WS_XE + SZ_XE;
constexpr size_t SZ_HID = (size_t)XE_ROWS * DE * 2;
constexpr size_t WS_END = WS_HID + SZ_HID;

constexpr int LDS_BYTES = 156672;
constexpr int LDS_MISC = 153600;

struct Params {
    const float *x, *c, *emb_g, *emb_b, *w_ada, *b_ada, *w_in, *conv_w, *mix_beta, *w_out, *lb_logits, *ln_g, *ln_b, *w_router, *router_bias, *w_gate, *w_up, *w_down;
    float* out;
    unsigned char* ws;
    int ph_lo, ph_hi, l_lo, l_hi, fused, pad;
};

__device__ __forceinline__ float bf2f(unsigned b) { return __uint_as_float(b << 16); }
__device__ __forceinline__ unsigned f2bf(float f) { unsigned u = __float_as_uint(f); u += 0x7FFFu + ((u >> 16) & 1u); return u >> 16; }
typedef __bf16 bf16x2_t __attribute__((ext_vector_type(2)));
typedef float f32x2_t __attribute__((ext_vector_type(2)));
__device__ __forceinline__ unsigned pack2a(float lo, float hi) { unsigned r; asm("v_cvt_pk_bf16_f32 %0, %1, %2" : "=v"(r) : "v"(lo), "v"(hi)); return r; }
__device__ __forceinline__ unsigned pack2(float lo, float hi) { const bf16x2_t r = __builtin_convertvector((f32x2_t){lo, hi}, bf16x2_t); return __builtin_bit_cast(unsigned, r); }
__device__ __forceinline__ float wave_sum(float v) {
#pragma unroll
    for (int o = 32; o > 0; o >>= 1) v += __shfl_xor(v, o, 64);
    return v;
}
__device__ __forceinline__ float half_sum(float v) {
#pragma unroll
    for (int o = 16; o > 0; o >>= 1) v += __shfl_xor(v, o, 64);
    return v;
}
#define LDS_BARRIER() do { asm volatile("s_waitcnt lgkmcnt(0)" ::: "memory"); __builtin_amdgcn_s_barrier(); asm volatile("" ::: "memory"); } while (0)
__device__ __forceinline__ float sigmoidf_(float z) { return 1.0f / (1.0f + __expf(-z)); }
__device__ __forceinline__ float siluf_(float z) { return z / (1.0f + __expf(-z)); }

#define XB_TMO      128
#define XB_XCNT(j)  (256  + 64 * (j))
#define XB_XSUB(j)  (1280 + 64 * (j))
#define XB_XGEN(j)  (2304 + 64 * (j))
#define XB_TOP      3328
#define XB_TOPGEN   3392
#define XCD_BAR_WORDS 3456
#define XB_SPIN_CAP (1u << 22)
__device__ __forceinline__ unsigned xb_ld(unsigned* p)              { return __hip_atomic_load(p, __ATOMIC_RELAXED, __HIP_MEMORY_SCOPE_AGENT); }
__device__ __forceinline__ unsigned xb_add(unsigned* p, unsigned v) { return __hip_atomic_fetch_add(p, v, __ATOMIC_RELAXED, __HIP_MEMORY_SCOPE_AGENT); }
__device__ __forceinline__ unsigned xb_xcc_id() { return (unsigned)__builtin_amdgcn_s_getreg((3 << 11) | 20) & 0xFu; }
#define XB_SPIN(cond, bar) do { unsigned _sp = 0; while (cond) { __builtin_amdgcn_s_sleep(1); \
    if ((++_sp & 255u) == 0u) { if (xb_ld(&(bar)[XB_TMO])) break; if (_sp > XB_SPIN_CAP) { atomicAdd(&(bar)[XB_TMO], 1u); break; } } } } while (0)
struct XcdBarrier { unsigned* bar; unsigned x; volatile LAS unsigned* st; };
__device__ __forceinline__ XcdBarrier xcd_barrier_post(unsigned* bar, volatile LAS unsigned* st) {
    XcdBarrier b; b.bar = bar; b.x = xb_xcc_id(); b.st = st;
    if (threadIdx.x == 0) (void)xb_add(&bar[XB_XCNT(b.x)], 1u);
    return b;
}
__device__ __forceinline__ void xcd_barrier_complete(unsigned* bar, unsigned x, unsigned& nloc, unsigned& nx) {
    const unsigned G = gridDim.x * gridDim.y * gridDim.z;
    unsigned sum, cnt, mine, sp = 0u;
    for (;;) {
        sum = 0u; cnt = 0u; mine = 0u;
#pragma unroll
        for (unsigned j = 0; j < 16; ++j) { const unsigned c = xb_ld(&bar[XB_XCNT(j)]); sum += c; cnt += (c > 0u) ? 1u : 0u; mine = (j == x) ? c : mine; }
        if (sum == G) break;
        __builtin_amdgcn_s_sleep(1);
        if ((++sp & 255u) == 0u) { if (xb_ld(&bar[XB_TMO])) break; if (sp > XB_SPIN_CAP) { atomicAdd(&bar[XB_TMO], 1u); break; } }
    }
    nloc = mine > 0u ? mine : 1u; nx = cnt > 0u ? cnt : 1u;
}
__device__ __forceinline__ void xcd_barrier(const XcdBarrier& b) {
    asm volatile("s_waitcnt vmcnt(0)" ::: "memory");
    __syncthreads();
    if (threadIdx.x == 0) {
        unsigned* bar = b.bar;
        __builtin_amdgcn_s_waitcnt(0);
        unsigned nloc = b.st[0], nx = b.st[1];
        if (nloc == 0u) { xcd_barrier_complete(bar, b.x, nloc, nx); b.st[0] = nloc; b.st[1] = nx; }
        const unsigned old = xb_add(&bar[XB_XSUB(b.x)], 1u);
        const unsigned gen = old / nloc;
        if (old + 1u == (gen + 1u) * nloc) {
            __builtin_amdgcn_fence(__ATOMIC_RELEASE, "agent");
            asm volatile("s_waitcnt vmcnt(0)" ::: "memory");
            const unsigned og = xb_add(&bar[XB_TOP], 1u);
            const unsigned tg = og / nx;
            if (og + 1u == (tg + 1u) * nx) xb_add(&bar[XB_TOPGEN], 1u);
            else XB_SPIN(xb_ld(&bar[XB_TOPGEN]) == tg, bar);
            __builtin_amdgcn_fence(__ATOMIC_ACQUIRE, "agent");
            xb_add(&bar[XB_XGEN(b.x)], 1u);
            asm volatile("s_waitcnt vmcnt(0)" ::: "memory");
        } else {
            XB_SPIN(xb_ld(&bar[XB_XGEN(b.x)]) == gen, bar);
            __builtin_amdgcn_fence(__ATOMIC_ACQUIRE, "agent");
            asm volatile("s_waitcnt vmcnt(0)" ::: "memory");
        }
    }
    __syncthreads();
}

namespace pg8 {
constexpr int BM = 256, BK = 64, HALF = 128, HTB = HALF * BK * 2, STAGE_BYTES = 8 * HTB, NXCD = 8, WGM = 8;
__host__ __device__ __forceinline__ int lds_byte(int r, int c) { const int st = (r >> 4) * 2 + (c >> 5), rr = r & 15, cc = c & 31, ob = rr * 64 + cc * 2; return st * 1024 + (ob ^ (((ob >> 9) & 1) << 5)); }
__host__ __device__ __forceinline__ void stage_rc(int b, int& R, int& C) { const int st = b / 1024, sb = b % 1024, swz = sb ^ (((sb >> 9) & 1) << 5); R = (st >> 1) * 16 + swz / 64; C = (st & 1) * 32 + (swz % 64) / 2; }
__host__ __device__ __forceinline__ int perm32(int rho) { const int n = rho >> 4, i = rho & 15; return 8 * (i >> 2) + 4 * n + (i & 3); }

struct Unit { size_t aB, bB; int row0, col0; };
struct Gemm { const bf16_t* A; const bf16_t* Bt; int K; };

template <int NM, int NN>
struct DenseOrder {
    int G, c; size_t tstep;
    __device__ void init(int rowbytes, int G_, int c_) { G = G_; c = c_; tstep = (size_t)BM * rowbytes; }
    __device__ bool next(int i, Unit& u) const {
        constexpr int nwg = NM * NN, q = nwg / NXCD, r = nwg % NXCD, nig = WGM * NN;
        static_assert(NM % WGM == 0, "row tiles come in groups of 8");
        const int L = __builtin_amdgcn_readfirstlane(i * G + c); if (L >= nwg) return false;
        const int xcd = L % NXCD, off = L / NXCD;
        const int wgid = (xcd < r ? xcd * (q + 1) : r * (q + 1) + (xcd - r) * q) + off;
        const int gid = wgid / nig, fm = gid * WGM, rem = wgid % nig;
        const int pm = fm + (rem % WGM), pn = rem / WGM;
        u.aB = (size_t)pm * tstep; u.bB = (size_t)pn * tstep; u.row0 = pm * BM; u.col0 = pn * BM; return true;
    }
};
struct OneUnit {
    Unit u0;
    __device__ bool next(int i, Unit& u) const { if (i > 0) return false; u = u0; return true; }
};
struct MoeOrder {
    const LAS int* tab; int NTn, G, c; size_t tstep, bexp;
    __device__ bool next(int i, Unit& u) const {
        const int MT = tab[16], U = MT * NTn, nx = G >> 3;
        int f;
        if ((G & 7) == 0) { const int per = (U + 7) >> 3, x = c & 7, j = c >> 3, loc = i * nx + j; f = x * per + loc; if (loc >= per || f >= U) return false; }
        else { f = i * G + c; if (f >= U) return false; }
        int e = 0;
#pragma unroll
        for (int j = 1; j < 16; ++j) e += (f >= tab[j] * NTn) ? 1 : 0;
        const int t0 = tab[e], te = tab[e + 1] - t0, r = f - t0 * NTn;
        const int nt = r / te, mt = t0 + (r - nt * te);
        u.aB = (size_t)mt * tstep; u.bB = (size_t)e * bexp + (size_t)nt * tstep; u.row0 = mt * BM; u.col0 = nt * BM; return true;
    }
};

__device__ __forceinline__ size_t rfl64(size_t v) { const unsigned lo = (unsigned)__builtin_amdgcn_readfirstlane((int)(unsigned)v), hi = (unsigned)__builtin_amdgcn_readfirstlane((int)(unsigned)(v >> 32)); return ((size_t)hi << 32) | lo; }
__device__ __forceinline__ void uniformize(Unit& u) { u.aB = rfl64(u.aB); u.bB = rfl64(u.bB); u.row0 = __builtin_amdgcn_readfirstlane(u.row0); u.col0 = __builtin_amdgcn_readfirstlane(u.col0); }
__device__ __forceinline__ unsigned cvt_pk_bf16(float lo, float hi) { unsigned r; asm volatile("v_cvt_pk_bf16_f32 %0, %1, %2" : "=v"(r) : "v"(lo), "v"(hi)); return r; }

struct EpiF32 {
    static constexpr bool PERM = false;
    float* C; int ldc;
    __device__ __forceinline__ void operator()(const f32x4 (&acc)[2][2][4][2], const Unit& u, int wr, int wc, int fr, int fq) const {
        const int row0 = u.row0 + wr * 64 + fr, col0 = u.col0 + wc * 32 + 4 * fq;
#pragma unroll
        for (int ai = 0; ai < 2; ++ai)
#pragma unroll
            for (int m = 0; m < 4; ++m) { float* rowp = C + (size_t)(row0 + ai * HALF + m * 16) * ldc + col0;
#pragma unroll
                for (int bj = 0; bj < 2; ++bj)
#pragma unroll
                    for (int n = 0; n < 2; ++n) *(f32x4*)(rowp + bj * HALF + n * 16) = acc[ai][bj][m][n]; }
    }
};
struct EpiBf16 {
    static constexpr bool PERM = true;
    bf16_t* O; int ldc;
    __device__ __forceinline__ void operator()(const f32x4 (&acc)[2][2][4][2], const Unit& u, int wr, int wc, int fr, int fq) const {
        const int row0 = u.row0 + wr * 64 + fr, col0 = u.col0 + wc * 32 + 8 * fq;
#pragma unroll
        for (int ai = 0; ai < 2; ++ai)
#pragma unroll
            for (int m = 0; m < 4; ++m) { bf16_t* rowp = O + (size_t)(row0 + ai * HALF + m * 16) * ldc + col0;
#pragma unroll
                for (int bj = 0; bj < 2; ++bj) { const f32x4 v0 = acc[ai][bj][m][0], v1 = acc[ai][bj][m][1];
                    u32x4 o; o[0] = cvt_pk_bf16(v0[0], v0[1]); o[1] = cvt_pk_bf16(v0[2], v0[3]); o[2] = cvt_pk_bf16(v1[0], v1[1]); o[3] = cvt_pk_bf16(v1[2], v1[3]);
                    *(u32x4*)(rowp + bj * HALF) = o; } }
    }
};
struct EpiHidden {
    static constexpr bool PERM = true;
    bf16_t* O;
    __device__ __forceinline__ void operator()(const f32x4 (&acc)[2][2][4][2], const Unit& u, int wr, int wc, int fr, int fq) const {
        const int row0 = u.row0 + wr * 64 + fr, col0 = (u.col0 >> 1) + wc * 32 + 8 * fq;
#pragma unroll
        for (int ai = 0; ai < 2; ++ai)
#pragma unroll
            for (int m = 0; m < 4; ++m) { bf16_t* rowp = O + (size_t)(row0 + ai * HALF + m * 16) * DE + col0;
                float h[8];
#pragma unroll
                for (int n = 0; n < 2; ++n)
#pragma unroll
                    for (int j = 0; j < 4; ++j) { const float g = acc[ai][0][m][n][j], up = acc[ai][1][m][n][j]; h[n * 4 + j] = g * __builtin_amdgcn_rcpf(1.0f + __expf(-g)) * up; }
                u32x4 o; o[0] = cvt_pk_bf16(h[0], h[1]); o[1] = cvt_pk_bf16(h[2], h[3]); o[2] = cvt_pk_bf16(h[4], h[5]); o[3] = cvt_pk_bf16(h[6], h[7]);
                *(u32x4*)rowp = o; }
    }
};

typedef int v8i32 __attribute__((ext_vector_type(8)));
typedef int v4i32 __attribute__((ext_vector_type(4)));
struct EpiHidden8 {
    static constexpr bool PERM = true;
    unsigned char* O;
    __device__ __forceinline__ void operator()(const f32x4 (&acc)[2][2][4][2], const Unit& u, int wr, int wc, int fr, int fq) const {
        const int row0 = u.row0 + wr * 64 + fr, col0 = (u.col0 >> 1) + wc * 32 + 8 * fq;
#pragma unroll
        for (int ai = 0; ai < 2; ++ai)
#pragma unroll
            for (int m = 0; m < 4; ++m) { unsigned char* rowp = O + (size_t)(row0 + ai * HALF + m * 16) * DEP + col0;
                float h[8];
#pragma unroll
                for (int n = 0; n < 2; ++n)
#pragma unroll
                    for (int j = 0; j < 4; ++j) { const float g = acc[ai][0][m][n][j], up = acc[ai][1][m][n][j]; h[n * 4 + j] = g * __builtin_amdgcn_rcpf(1.0f + __expf(-g)) * up * H8_SCALE; }
                int o0 = __builtin_amdgcn_cvt_pk_fp8_f32(h[0], h[1], 0, false); o0 = __builtin_amdgcn_cvt_pk_fp8_f32(h[2], h[3], o0, true);
                int o1 = __builtin_amdgcn_cvt_pk_fp8_f32(h[4], h[5], 0, false); o1 = __builtin_amdgcn_cvt_pk_fp8_f32(h[6], h[7], o1, true);
                u32x2 o; o[0] = (unsigned)o0; o[1] = (unsigned)o1;
                *(u32x2*)rowp = o; }
    }
};
template <class Epi, class Sched, bool FP8 = false>
__device__ __forceinline__ void gemm_phase(LAS unsigned char* lds, const Gemm g, const Sched& S, const Epi& E, int sclW = 127, int sclA = 127) {
    int tid = threadIdx.x; asm volatile("" : "+v"(tid)); const int wid = __builtin_amdgcn_readfirstlane(tid >> 6), lane = tid & 63, wr = wid >> 2, wc = wid & 3, fr = lane & 15, fq = lane >> 4;
    const int K = g.K, rowb = FP8 ? K : 2 * K, nt = rowb / 128;
    int sclWv = sclW, sclAv = sclA; asm volatile("" : "+v"(sclWv), "+v"(sclAv));
    unsigned voffA[2], voffB[2];
#pragma unroll
    for (int i = 0; i < 2; ++i) { int R, C; stage_rc(tid * 16 + i * 8192, R, C); const int Rb = Epi::PERM ? ((R & ~31) + perm32(R & 31)) : R;
        voffA[i] = (unsigned)(R * rowb + 2 * C); voffB[i] = (unsigned)(Rb * rowb + 2 * C); }
    const size_t kstep = 128;
    const size_t hstep = (size_t)HALF * rowb;
    const unsigned ldsw = (unsigned)wid * 1024u;
    const int aoff = lds_byte(wr * 64 + fr, fq * 8), boff = lds_byte(wc * 32 + fr, fq * 8);
    constexpr int P2 = 1024;
#define PG8_SA(b, h) (((b) * 2 + (h)) * HTB)
#define PG8_SB(b, h) ((4 + (b) * 2 + (h)) * HTB)
#define PG8_STAGE(bufoff, gbase, voff) do { _Pragma("unroll") for (int _i = 0; _i < 2; ++_i) \
        __builtin_amdgcn_global_load_lds((const unsigned*)((const char*)(gbase) + (voff)[_i]), (LAS unsigned*)(lds + (bufoff) + ldsw + _i * 8192), 16, 0, 0); } while (0)
#define PG8_LDA(dst, b, h) do { _Pragma("unroll") for (int m = 0; m < 4; ++m) { \
        const v4i32 _l = *(const LAS v4i32*)(lds + PG8_SA(b, h) + aoff + m * 2048), _h = *(const LAS v4i32*)(lds + PG8_SA(b, h) + aoff + P2 + m * 2048); \
        dst[m] = __builtin_shufflevector(_l, _h, 0, 1, 2, 3, 4, 5, 6, 7); } } while (0)
#define PG8_LDB(dst, b, h) do { _Pragma("unroll") for (int n = 0; n < 2; ++n) { \
        const v4i32 _l = *(const LAS v4i32*)(lds + PG8_SB(b, h) + boff + n * 2048), _h = *(const LAS v4i32*)(lds + PG8_SB(b, h) + boff + P2 + n * 2048); \
        dst[n] = __builtin_shufflevector(_l, _h, 0, 1, 2, 3, 4, 5, 6, 7); } } while (0)
#define PG8_MMA(ai, bj, At, Bt) do { __builtin_amdgcn_s_setprio(1); _Pragma("unroll") for (int m = 0; m < 4; ++m) _Pragma("unroll") for (int n = 0; n < 2; ++n) { \
        if constexpr (FP8) { \
            asm volatile("v_mfma_scale_f32_16x16x128_f8f6f4 %0, %1, %2, %0, %3, %4 op_sel_hi:[0,0,0]" : "+v"(acc[ai][bj][m][n]) : "v"(Bt[n]), "v"(At[m]), "v"(sclWv), "v"(sclAv)); \
        } else { \
            acc[ai][bj][m][n] = __builtin_amdgcn_mfma_f32_16x16x32_bf16(__builtin_bit_cast(bf16x8, __builtin_shufflevector(Bt[n], Bt[n], 0, 1, 2, 3)), __builtin_bit_cast(bf16x8, __builtin_shufflevector(At[m], At[m], 0, 1, 2, 3)), acc[ai][bj][m][n], 0, 0, 0); \
            acc[ai][bj][m][n] = __builtin_amdgcn_mfma_f32_16x16x32_bf16(__builtin_bit_cast(bf16x8, __builtin_shufflevector(Bt[n], Bt[n], 4, 5, 6, 7)), __builtin_bit_cast(bf16x8, __builtin_shufflevector(At[m], At[m], 4, 5, 6, 7)), acc[ai][bj][m][n], 0, 0, 0); } } \
        __builtin_amdgcn_s_setprio(0); } while (0)
#define PG8_WAIT_V(n) asm volatile("s_waitcnt vmcnt(" #n ")" ::: "memory")
#define PG8_WAIT_L(n) asm volatile("s_waitcnt lgkmcnt(" #n ")" ::: "memory")
#define PG8_BAR __builtin_amdgcn_s_barrier()
#define PG8_SCHED __builtin_amdgcn_sched_barrier(0)
    Unit cur, nxt; int ui = 0;
    if (!S.next(0, cur)) return;
    uniformize(cur);
    f32x4 acc[2][2][4][2];
#pragma unroll
    for (int a = 0; a < 2; ++a)
#pragma unroll
        for (int b = 0; b < 2; ++b)
#pragma unroll
            for (int m = 0; m < 4; ++m)
#pragma unroll
                for (int n = 0; n < 2; ++n) acc[a][b][m][n] = (f32x4){0.f, 0.f, 0.f, 0.f};
    v8i32 At[4], B0[2], B1[2];
    const char* cA = (const char*)g.A + cur.aB; const char* cB = (const char*)g.Bt + cur.bB;
    PG8_STAGE(PG8_SB(0, 0), cB, voffB); PG8_STAGE(PG8_SA(0, 0), cA, voffA); PG8_STAGE(PG8_SB(0, 1), cB + hstep, voffB); PG8_STAGE(PG8_SA(0, 1), cA + hstep, voffA);
    if (wr == 1) PG8_BAR;
    PG8_WAIT_V(4); PG8_BAR;
    PG8_STAGE(PG8_SB(1, 0), cB + kstep, voffB); PG8_STAGE(PG8_SA(1, 0), cA + kstep, voffA); PG8_STAGE(PG8_SB(1, 1), cB + hstep + kstep, voffB);
    PG8_WAIT_V(6); PG8_BAR;
    for (;;) {
        const bool has_next = S.next(ui + 1, nxt);
        uniformize(nxt);
        const char* nA = has_next ? (const char*)g.A + nxt.aB : cA; const char* nB = has_next ? (const char*)g.Bt + nxt.bB : cB;
        for (int t = 0; t < nt; t += 2) {
            const bool last = (t == nt - 2);
            const char* a1 = cA + (size_t)(t + 1) * kstep;
            const char* a2 = last ? nA : cA + (size_t)(t + 2) * kstep; const char* b2 = last ? nB : cB + (size_t)(t + 2) * kstep;
            const char* a3 = a2 + kstep; const char* b3 = b2 + kstep;
            PG8_LDB(B0, 0, 0); PG8_SCHED; PG8_LDA(At, 0, 0); PG8_STAGE(PG8_SA(1, 1), a1 + hstep, voffA);
            PG8_WAIT_L(8); PG8_BAR; PG8_WAIT_L(0); PG8_MMA(0, 0, At, B0); PG8_BAR; PG8_SCHED;
            PG8_LDB(B1, 0, 1); PG8_STAGE(PG8_SB(0, 0), b2, voffB);
            PG8_BAR; PG8_WAIT_L(0); PG8_MMA(0, 1, At, B1); PG8_BAR;
            PG8_LDA(At, 0, 1); PG8_STAGE(PG8_SA(0, 0), a2, voffA);
            PG8_BAR; PG8_WAIT_L(0); PG8_MMA(1, 0, At, B0); PG8_BAR; PG8_SCHED;
            PG8_STAGE(PG8_SB(0, 1), b2 + hstep, voffB);
            PG8_WAIT_V(6); PG8_BAR; PG8_MMA(1, 1, At, B1); PG8_BAR;
            PG8_LDB(B0, 1, 0); PG8_SCHED; PG8_LDA(At, 1, 0); PG8_STAGE(PG8_SA(0, 1), a2 + hstep, voffA);
            PG8_WAIT_L(8); PG8_BAR; PG8_WAIT_L(0); PG8_MMA(0, 0, At, B0); PG8_BAR; PG8_SCHED;
            PG8_LDB(B1, 1, 1); PG8_STAGE(PG8_SB(1, 0), b3, voffB);
            PG8_BAR; PG8_WAIT_L(0); PG8_MMA(0, 1, At, B1); PG8_BAR;
            PG8_LDA(At, 1, 1); PG8_STAGE(PG8_SA(1, 0), a3, voffA);
            PG8_BAR; PG8_WAIT_L(0); PG8_MMA(1, 0, At, B0); PG8_BAR; PG8_SCHED;
            PG8_STAGE(PG8_SB(1, 1), b3 + hstep, voffB);
            PG8_WAIT_V(6); PG8_BAR; PG8_MMA(1, 1, At, B1); PG8_BAR;
        }
        if constexpr (FP8) asm volatile("s_nop 15\n\ts_nop 15" ::: "memory");
        E(acc, cur, wr, wc, fr, fq);
        if (!has_next) break;
#pragma unroll
        for (int a = 0; a < 2; ++a)
#pragma unroll
            for (int b = 0; b < 2; ++b)
#pragma unroll
                for (int m = 0; m < 4; ++m)
#pragma unroll
                    for (int n = 0; n < 2; ++n) acc[a][b][m][n] = (f32x4){0.f, 0.f, 0.f, 0.f};
        cur = nxt; cA = nA; cB = nB; ++ui;
    }
    PG8_WAIT_V(0);
    if (wr == 0) PG8_BAR;
    PG8_BAR;
#undef PG8_SA
#undef PG8_SB
#undef PG8_STAGE
#undef PG8_LDA
#undef PG8_LDB
#undef PG8_MMA
#undef PG8_WAIT_V
#undef PG8_WAIT_L
#undef PG8_BAR
#undef PG8_SCHED
}
}

constexpr int S_IN = 16 * 66, S_OUT = 16 * 16, S_GU = 16 * 11, S_DN = 11 * 16;
constexpr int CV_PER_L = S_IN + S_OUT + NE * 2 * S_GU + NE * S_DN;
constexpr int CV_A0 = S_IN + S_OUT;
constexpr int CV_A1 = CV_A0 + NE * 2 * S_GU;
constexpr int CV_TOTAL = DEPTH * CV_PER_L;
constexpr int CV_LAST = 1 << 30;
struct StripDesc { const float* src; bf16_t* dst; int lds_, ldd, k0, n0, drow0, fp8; };
__device__ __forceinline__ StripDesc strip_desc(const Params& p, int si) {
    unsigned char* ws = p.ws; StripDesc d;
    const int l = si / CV_PER_L; int r = si - l * CV_PER_L;
    if (r < S_IN) {
        const int kt = r / 66, ntl = r % 66;
        d.src = p.w_in + (size_t)l * D * INC; d.lds_ = INC; d.fp8 = INP8(l) ? 1 : 0; d.dst = (bf16_t*)(ws + WS_WIN) + (size_t)l * INC * D; d.ldd = D; d.k0 = kt * 128; d.n0 = ntl * 128; d.drow0 = ntl * 128;
    } else if (r < CV_A0) {
        r -= S_IN; const int kt = r / 16, ntl = r % 16;
        d.src = p.w_out + (size_t)l * D * D; d.lds_ = D; d.dst = (bf16_t*)(ws + WS_WOUT) + (size_t)l * D * D; d.ldd = D; d.k0 = kt * 128; d.n0 = ntl * 128; d.drow0 = ntl * 128; d.fp8 = OUT8(l) ? 1 : 0;
    } else if (r < CV_A1) {
        r -= CV_A0; const int mat = r / S_GU, q = r % S_GU, kt = q / 11, ntl = q % 11;
        const int which = mat & 1, le = l * NE + (mat >> 1);
        d.src = (which ? p.w_up : p.w_gate) + (size_t)le * D * DE; d.lds_ = DE; d.fp8 = MOE_FP8; d.dst = MOE_FP8 ? (bf16_t*)(ws + WS_WGU + (size_t)le * (2 * DE) * D) : (bf16_t*)(ws + WS_WGU) + (size_t)le * (2 * DE) * D; d.ldd = D; d.k0 = kt * 128; d.n0 = ntl * 128; d.drow0 = ntl * 256 + which * 128;
    } else {
        r -= CV_A1; const int le = l * NE + r / S_DN, q = r % S_DN, kt = q / 16, ntl = q % 16;
        d.src = p.w_down + (size_t)le * DE * D; d.lds_ = D; d.fp8 = MOE_FP8; d.dst = MOE_FP8 ? (bf16_t*)(ws + WS_WD + (size_t)le * D * DEP) : (bf16_t*)(ws + WS_WD) + (size_t)le * D * DE; d.ldd = MOE_FP8 ? DEP : DE; d.k0 = kt * 128; d.n0 = ntl * 128; d.drow0 = ntl * 128;
    }
    return d;
}
__device__ __forceinline__ void cvt_store_strip(const StripDesc& d, const float4 (&a)[2][2], const float4 (&b)[2][2], LAS unsigned char* tb, int tid, bool readout) {
    const int kp = tid >> 4, n4 = (tid & 15) * 4;
    if (!readout) {
        if (!d.fp8) {
#pragma unroll
            for (int ki = 0; ki < 2; ++ki)
#pragma unroll
                for (int ni = 0; ni < 2; ++ni) {
                    LAS unsigned* t = (LAS unsigned*)tb + (ki * 2 + ni) * 2112;
                    t[(n4 + 0) * 33 + kp] = pack2a(a[ki][ni].x, b[ki][ni].x);
                    t[(n4 + 1) * 33 + kp] = pack2a(a[ki][ni].y, b[ki][ni].y);
                    t[(n4 + 2) * 33 + kp] = pack2a(a[ki][ni].z, b[ki][ni].z);
                    t[(n4 + 3) * 33 + kp] = pack2a(a[ki][ni].w, b[ki][ni].w);
                }
        } else {
#pragma unroll
            for (int ki = 0; ki < 2; ++ki)
#pragma unroll
                for (int ni = 0; ni < 2; ++ni) {
                    LAS unsigned char* t = tb + (ki * 2 + ni) * 4352;
                    *(LAS unsigned short*)(t + (n4 + 0) * 68 + 2 * kp) = (unsigned short)__builtin_amdgcn_cvt_pk_fp8_f32(a[ki][ni].x * W8_SCALE, b[ki][ni].x * W8_SCALE, 0, false);
                    *(LAS unsigned short*)(t + (n4 + 1) * 68 + 2 * kp) = (unsigned short)__builtin_amdgcn_cvt_pk_fp8_f32(a[ki][ni].y * W8_SCALE, b[ki][ni].y * W8_SCALE, 0, false);
                    *(LAS unsigned short*)(t + (n4 + 2) * 68 + 2 * kp) = (unsigned short)__builtin_amdgcn_cvt_pk_fp8_f32(a[ki][ni].z * W8_SCALE, b[ki][ni].z * W8_SCALE, 0, false);
                    *(LAS unsigned short*)(t + (n4 + 3) * 68 + 2 * kp) = (unsigned short)__builtin_amdgcn_cvt_pk_fp8_f32(a[ki][ni].w * W8_SCALE, b[ki][ni].w * W8_SCALE, 0, false);
                }
        }
    } else {
        if (!d.fp8) {
            const int n = tid >> 3, kc = (tid & 7) * 4;
#pragma unroll
            for (int ki = 0; ki < 2; ++ki)
#pragma unroll
                for (int ni = 0; ni < 2; ++ni) {
                    const LAS unsigned* t = (const LAS unsigned*)tb + (ki * 2 + ni) * 2112;
                    u32x4 o; o[0] = t[n * 33 + kc]; o[1] = t[n * 33 + kc + 1]; o[2] = t[n * 33 + kc + 2]; o[3] = t[n * 33 + kc + 3];
                    *(u32x4*)(d.dst + (size_t)(d.drow0 + ni * 64 + n) * d.ldd + d.k0 + ki * 64 + kc * 2) = o;
                }
        } else {
            const int n = tid >> 3, kc8 = (tid & 7) * 8;
            unsigned char* dst8 = (unsigned char*)d.dst;
#pragma unroll
            for (int ki = 0; ki < 2; ++ki)
#pragma unroll
                for (int ni = 0; ni < 2; ++ni) {
                    const LAS unsigned char* t = tb + (ki * 2 + ni) * 4352;
                    u32x2 o; o[0] = *(const LAS unsigned*)(t + n * 68 + kc8); o[1] = *(const LAS unsigned*)(t + n * 68 + kc8 + 4);
                    *(u32x2*)(dst8 + (size_t)(d.drow0 + ni * 64 + n) * d.ldd + d.k0 + ki * 64 + kc8) = o;
                }
        }
    }
}
__device__ __forceinline__ void cvt_pull(const Params& p, LAS unsigned char* lds, int limit, unsigned* done_ctr, unsigned need_done) {
    int tid = threadIdx.x; asm volatile("" : "+v"(tid));
    LAS int* slot = (LAS int*)(lds + LDS_MISC + 512);
    unsigned* head = (unsigned*)(p.ws + WS_CVTQ);
    if (tid == 0) {
        int sv = -1;
        const bool stop = done_ctr ? (xb_ld(done_ctr) >= need_done) : (xb_ld(head) >= (unsigned)limit);
        if (!stop) { const unsigned c = xb_add(head, 2u); sv = c < (unsigned)CV_TOTAL ? (int)c : -1; }
        slot[0] = sv;
    }
    __syncthreads();
    const int kp = tid >> 4, n4 = (tid & 15) * 4;
    for (;;) {
        const int sraw = slot[0];
        if (sraw < 0) break;
        const int si = sraw & (CV_LAST - 1); const bool lastone = (sraw & CV_LAST) != 0;
        const StripDesc d0 = strip_desc(p, si), d1 = strip_desc(p, si + 1);
        float4 a0[2][2], b0[2][2], a1[2][2], b1[2][2];
#pragma unroll
        for (int ki = 0; ki < 2; ++ki)
#pragma unroll
            for (int ni = 0; ni < 2; ++ni) {
                a0[ki][ni] = *(const float4*)(d0.src + (size_t)(d0.k0 + ki * 64 + 2 * kp) * d0.lds_ + d0.n0 + ni * 64 + n4);
                b0[ki][ni] = *(const float4*)(d0.src + (size_t)(d0.k0 + ki * 64 + 2 * kp + 1) * d0.lds_ + d0.n0 + ni * 64 + n4);
            }
#pragma unroll
        for (int ki = 0; ki < 2; ++ki)
#pragma unroll
            for (int ni = 0; ni < 2; ++ni) {
                a1[ki][ni] = *(const float4*)(d1.src + (size_t)(d1.k0 + ki * 64 + 2 * kp) * d1.lds_ + d1.n0 + ni * 64 + n4);
                b1[ki][ni] = *(const float4*)(d1.src + (size_t)(d1.k0 + ki * 64 + 2 * kp + 1) * d1.lds_ + d1.n0 + ni * 64 + n4);
            }
        unsigned c = 0u, dn = 0u;
        if (tid == 0 && !lastone) { c = xb_add(head, 2u); if (done_ctr) dn = xb_ld(done_ctr); }
        cvt_store_strip(d0, a0, b0, lds, tid, false);
        cvt_store_strip(d1, a1, b1, lds + 33792, tid, false);
        LDS_BARRIER();
        cvt_store_strip(d0, a0, b0, lds, tid, true);
        cvt_store_strip(d1, a1, b1, lds + 33792, tid, true);
        if (tid == 0) {
            int sv = -1;
            if (!lastone && c < (unsigned)CV_TOTAL) { const bool fin = done_ctr ? (dn >= need_done) : (c >= (unsigned)limit); sv = (int)c | (fin ? CV_LAST : 0); }
            slot[0] = sv;
        }
        LDS_BARRIER();
    }
    __syncthreads();
}
__device__ __forceinline__ void tail_pull(const Params& p, LAS unsigned char* lds, int ctr_idx) {
    unsigned* ctr = (unsigned*)(p.ws + WS_CVTQ) + 64 * (1 + ctr_idx);
    __syncthreads();
    if (threadIdx.x == 0) (void)xb_add(ctr, 1u);
    cvt_pull(p, lds, 0, ctr, gridDim.x);
}

__device__ __forceinline__ void ada_chunks(const Params& p, LAS unsigned char* lds, int ch0, int ch_end, int step) {
    int tid = threadIdx.x; asm volatile("" : "+v"(tid));
    unsigned char* ws = p.ws;
    LAS float* cond = (LAS float*)lds;
    LAS float* red = (LAS float*)(lds + 32768);
    if (ch0 >= ch_end) return;
    for (int i = tid; i < 4 * D; i += 512) { const float v = p.c[i]; cond[i] = siluf_(v); }
    __syncthreads();
    for (int ch = ch0; ch < ch_end; ch += step) {
        const int l = ch >> 7, j0 = (ch & 127) * 96;
        const float* w = p.w_ada + (size_t)l * D * (6 * D);
        const int kg = tid / 24, cl = tid % 24;
        float acc[4][4];
#pragma unroll
        for (int b = 0; b < 4; ++b)
#pragma unroll
            for (int j = 0; j < 4; ++j) acc[b][j] = 0.f;
        if (kg < 21) {
            for (int it0 = 0; it0 < 98; it0 += 14) {
                float4 wv[14];
#pragma unroll
                for (int q = 0; q < 14; ++q) { const int k = kg + 21 * (it0 + q); wv[q] = (k < D) ? *(const float4*)(w + (size_t)k * (6 * D) + j0 + cl * 4) : make_float4(0.f, 0.f, 0.f, 0.f); }
#pragma unroll
                for (int q = 0; q < 14; ++q) { const int k = kg + 21 * (it0 + q); const int kc = k < D ? k : 0;
#pragma unroll
                    for (int b = 0; b < 4; ++b) { const float cv = cond[b * D + kc]; acc[b][0] += cv * wv[q].x; acc[b][1] += cv * wv[q].y; acc[b][2] += cv * wv[q].z; acc[b][3] += cv * wv[q].w; } }
            }
#pragma unroll
            for (int b = 0; b < 4; ++b)
#pragma unroll
                for (int j = 0; j < 4; ++j) red[(kg * 4 + b) * 96 + cl * 4 + j] = acc[b][j];
        }
        __syncthreads();
        if (tid < 384) {
            const int b = tid / 96, col = tid % 96; float s = 0.f;
            for (int g = 0; g < 21; ++g) s += red[(g * 4 + b) * 96 + col];
            float* mod = (float*)(ws + WS_MOD);
            mod[((size_t)l * 4 + b) * (6 * D) + j0 + col] = s + p.b_ada[(size_t)l * 6 * D + j0 + col];
        }
        __syncthreads();
    }
}
__device__ __forceinline__ void phase_prologue(const Params& p, LAS unsigned char* lds) {
    const bool svc = (gridDim.x >= 256);
    ada_chunks(p, lds, blockIdx.x, svc ? 128 : 256, gridDim.x);
    cvt_pull(p, lds, CV_A0, nullptr, 0u);
}

#define COLK(k) ((((k) >> 1) << 9) + lane * 8 + (((k) & 1) << 2))
#define COL8(i) (((i) << 9) + lane * 8)
__device__ __forceinline__ void ld_bf8(const bf16_t* p, float4& a, float4& b) {
    const u32x4 r = *(const u32x4*)p;
    a = make_float4(bf2f(r[0] & 0xffffu), bf2f(r[0] >> 16), bf2f(r[1] & 0xffffu), bf2f(r[1] >> 16));
    b = make_float4(bf2f(r[2] & 0xffffu), bf2f(r[2] >> 16), bf2f(r[3] & 0xffffu), bf2f(r[3] >> 16));
}
__device__ __forceinline__ void st_bf8(bf16_t* p, const float4& a, const float4& b) {
    u32x4 o; o[0] = pack2a(a.x, a.y); o[1] = pack2a(a.z, a.w); o[2] = pack2a(b.x, b.y); o[3] = pack2a(b.z, b.w);
    *(u32x4*)p = o;
}
__device__ __forceinline__ void st_fp8x8(unsigned char* p, const float4& a, const float4& b) {
    int o0 = __builtin_amdgcn_cvt_pk_fp8_f32(a.x, a.y, 0, false); o0 = __builtin_amdgcn_cvt_pk_fp8_f32(a.z, a.w, o0, true);
    int o1 = __builtin_amdgcn_cvt_pk_fp8_f32(b.x, b.y, 0, false); o1 = __builtin_amdgcn_cvt_pk_fp8_f32(b.z, b.w, o1, true);
    u32x2 o; o[0] = (unsigned)o0; o[1] = (unsigned)o1;
    *(u32x2*)p = o;
}
__device__ __forceinline__ void ln_rows(float4 (&v)[8], const float* __restrict__ g, const float* __restrict__ b, int lane) {
    float s = 0.f;
#pragma unroll
    for (int i = 0; i < 8; ++i) s += (v[i].x + v[i].y) + (v[i].z + v[i].w);
    const float mean = wave_sum(s) * (1.0f / D);
    float q = 0.f;
#pragma unroll
    for (int i = 0; i < 8; ++i) { const float a = v[i].x - mean, bb = v[i].y - mean, c = v[i].z - mean, d = v[i].w - mean; q += (a * a + bb * bb) + (c * c + d * d); }
    const float rstd = rsqrtf(wave_sum(q) * (1.0f / D) + 1e-5f);
#pragma unroll
    for (int i = 0; i < 8; ++i) {
        const float4 gv = *(const float4*)(g + COLK(i)), bv = *(const float4*)(b + COLK(i));
        v[i].x = (v[i].x - mean) * rstd * gv.x + bv.x; v[i].y = (v[i].y - mean) * rstd * gv.y + bv.y;
        v[i].z = (v[i].z - mean) * rstd * gv.z + bv.z; v[i].w = (v[i].w - mean) * rstd * gv.w + bv.w;
    }
}
__device__ __forceinline__ void modulate_store(const float4 (&v)[8], const float* __restrict__ shift, const float* __restrict__ scale, bf16_t* __restrict__ dst, int lane, bool fp8) {
#pragma unroll
    for (int i = 0; i < 4; ++i) {
        float4 h[2];
#pragma unroll
        for (int q = 0; q < 2; ++q) {
            const float4 sh = *(const float4*)(shift + COLK(2 * i + q)), sc = *(const float4*)(scale + COLK(2 * i + q));
            const float4 x = v[2 * i + q];
            h[q] = make_float4(x.x * (1.f + sc.x) + sh.x, x.y * (1.f + sc.y) + sh.y, x.z * (1.f + sc.z) + sh.z, x.w * (1.f + sc.w) + sh.w);
        }
        if (fp8) st_fp8x8((unsigned char*)dst + COL8(i), h[0], h[1]);
        else st_bf8(dst + COL8(i), h[0], h[1]);
    }
}

__device__ __forceinline__ void phase_ln0(const Params& p) {
    int tid_ = threadIdx.x; asm volatile("" : "+v"(tid_)); const int wave = tid_ >> 6, lane = tid_ & 63;
    const float* mod = (const float*)(p.ws + WS_MOD);
    for (int n = blockIdx.x * 8 + wave; n < T; n += gridDim.x * 8) {
        const int b = n / SEQ;
        float4 v[8];
#pragma unroll
        for (int i = 0; i < 8; ++i) v[i] = *(const float4*)(p.x + (size_t)n * D + COLK(i));
        ln_rows(v, p.emb_g, p.emb_b, lane);
        bf16_t* xr = (bf16_t*)(p.ws + WS_XRES) + (size_t)n * D;
#pragma unroll
        for (int i = 0; i < 4; ++i) st_bf8(xr + COL8(i), v[2 * i], v[2 * i + 1]);
        const float* mb = mod + ((size_t)0 * 4 + b) * (6 * D);
        modulate_store(v, mb, mb + D, INP8(0) ? (bf16_t*)(p.ws + WS_HA + (size_t)n * D) : (bf16_t*)(p.ws + WS_HA) + (size_t)n * D, lane, INP8(0));
    }
}

__device__ __forceinline__ void phase_mixer_valu(const Params& p, int l, LAS unsigned char* lds) {
    LAS float* qs = (LAS float*)lds; LAS float* ks = qs + 4096; LAS float* fs = ks + 4096; LAS float* vs = fs + 4096; LAS float* po = vs + 1024;
    int tid = threadIdx.x; asm volatile("" : "+v"(tid)); const int wave = tid >> 6, lane = tid & 63, kk = tid >> 5, vv = tid & 31;
    const bf16_t* proj = (const bf16_t*)(p.ws + WS_PROJ);
    float* obuf = (float*)(p.ws + WS_OBUF);
    for (int u = blockIdx.x; u < 384; u += gridDim.x) {
        const int vsl = u & 3, dir = (u >> 2) & 1, hh = (u >> 3) % 6, b = ((u >> 3) / 6) % 4, type = (u >> 3) / 24;
        float S[8];
#pragma unroll
        for (int j = 0; j < 8; ++j) S[j] = 0.f;
        const float gamma = 1.0f - exp2f(-(dir ? 5.5f : 5.0f) - (float)hh);
        for (int blk = 0; blk < 64; ++blk) {
            const int rb = dir ? 63 - blk : blk, t0 = rb * 32;
            if (type == 0) {
#pragma unroll
                for (int j = 0; j < 4; ++j) {
                    const int idx = tid + 512 * j, tt = idx >> 6, dp = idx & 63;
                    const bf16_t* row = proj + (size_t)(b * SEQ + t0 + tt) * INC;
                    const float q1 = bf2f(row[C_RQ + hh * 128 + dp]), q2 = bf2f(row[C_RQ + hh * 128 + 64 + dp]);
                    const float k1 = bf2f(row[C_RK + hh * 128 + dp]), k2 = bf2f(row[C_RK + hh * 128 + 64 + dp]);
                    const float inv_freq = exp2f(-(float)dp * (13.287712379549449f / 64.0f));
                    const float ang = (float)(t0 + tt) * inv_freq;
                    float rev = ang * 0.15915494309189535f; rev -= rintf(rev);
                    const float sn = __builtin_amdgcn_sinf(rev), cs = __builtin_amdgcn_cosf(rev);
                    qs[tt * 128 + dp] = q1 * cs - q2 * sn; qs[tt * 128 + 64 + dp] = q1 * sn + q2 * cs;
                    ks[tt * 128 + dp] = (k1 * cs - k2 * sn) * 0.08838834764831845f; ks[tt * 128 + 64 + dp] = (k1 * sn + k2 * cs) * 0.08838834764831845f;
                    fs[tt * 128 + dp] = gamma; fs[tt * 128 + 64 + dp] = gamma;
                }
            } else {
#pragma unroll
                for (int j = 0; j < 8; ++j) {
                    const int idx = tid + 512 * j, tt = idx >> 7, d = idx & 127;
                    const bf16_t* row = proj + (size_t)(b * SEQ + t0 + tt) * INC;
                    const float q = bf2f(row[C_HQ + hh * 128 + d]);
                    const float z = bf2f(row[(dir ? C_HFB : C_HFF) + hh * 128 + d]);
                    float lb = 0.f;
                    if (l > 0) { const float a0 = p.lb_logits[(0 * 2 + dir) * HWD + hh * 128 + d], a1 = p.lb_logits[(1 * 2 + dir) * HWD + hh * 128 + d]; lb = 1.0f / (1.0f + expf(a0 - a1)); }
                    float f = lb + (1.0f - lb) * (1.0f / (1.0f + expf(-z)));
                    f = fmaxf(f, 1e-6f);
                    qs[tt * 128 + d] = q; ks[tt * 128 + d] = 1.0f - f; fs[tt * 128 + d] = f;
                }
            }
#pragma unroll
            for (int j = 0; j < 2; ++j) {
                const int idx = tid + 512 * j, tt = idx >> 5, c = idx & 31;
                const bf16_t* row = proj + (size_t)(b * SEQ + t0 + tt) * INC;
                vs[tt * 32 + c] = bf2f(row[(type ? C_HI : C_RV) + hh * 128 + vsl * 32 + c]);
            }
            __syncthreads();
            for (int s = 0; s < 32; ++s) {
                const int ss = dir ? 31 - s : s;
                const f32x4 qa = *(const LAS f32x4*)(qs + ss * 128 + kk * 8), qb = *(const LAS f32x4*)(qs + ss * 128 + kk * 8 + 4);
                const f32x4 ka = *(const LAS f32x4*)(ks + ss * 128 + kk * 8), kb = *(const LAS f32x4*)(ks + ss * 128 + kk * 8 + 4);
                const f32x4 fa = *(const LAS f32x4*)(fs + ss * 128 + kk * 8), fb = *(const LAS f32x4*)(fs + ss * 128 + kk * 8 + 4);
                const float vval = vs[ss * 32 + vv];
                float acc = 0.f;
#pragma unroll
                for (int j = 0; j < 4; ++j) { S[j] = fa[j] * S[j] + ka[j] * vval; acc += S[j] * qa[j]; }
#pragma unroll
                for (int j = 0; j < 4; ++j) { S[4 + j] = fb[j] * S[4 + j] + kb[j] * vval; acc += S[4 + j] * qb[j]; }
                acc += __shfl_xor(acc, 32, 64);
                if (lane < 32) po[(ss * 8 + wave) * 32 + vv] = acc;
            }
            __syncthreads();
#pragma unroll
            for (int j = 0; j < 2; ++j) {
                const int idx = tid + 512 * j, tt = idx >> 5, c = idx & 31;
                float s = 0.f;
#pragma unroll
                for (int w = 0; w < 8; ++w) s += po[(tt * 8 + w) * 32 + c];
                obuf[((size_t)dir * T + (size_t)(b * SEQ + t0 + tt)) * 1536 + type * 768 + hh * 128 + vsl * 32 + c] = s;
            }
        }
        __syncthreads();
    }
}

constexpr int MX_QI = 0, MX_KI = 17408, MX_QS = 34816, MX_KTT = 52224, MX_VT = 70656, MX_P = 79872, MX_ST = 89088, MX_TOT = 106496, MX_DEC = 110592, MX_RQ = 112128, MX_RK = 128512, MX_RV = 144896;
__device__ __forceinline__ float ex2(float x) { return __builtin_amdgcn_exp2f(x); }
#define MX_BIG 1.329228e36f
__device__ __forceinline__ float clampe(float x) { return fminf(fmaxf(x, -120.f), 120.f); }
template <int MODE>
__device__ __forceinline__ void phase_mixer_mfma(const Params& p, int l, LAS unsigned char* lds, float* __restrict__ obuf) {
    int tid = threadIdx.x; asm volatile("" : "+v"(tid));
    const int wave = __builtin_amdgcn_readfirstlane(tid >> 6), lane = tid & 63, fr = lane & 15, fq = lane >> 4;
    const bf16_t* proj = (const bf16_t*)(p.ws + WS_PROJ);
    for (int u = blockIdx.x; u < 192; u += gridDim.x) {
        const int vsl = u & 1, dir = (u >> 1) & 1, hh = (u >> 2) % 6, b = ((u >> 2) / 6) % 4, type = (u >> 2) / 24;
        float lg2 = 0.f, invf0 = 0.f, invf1 = 0.f, sgn = 1.f, lb0 = 0.f, lb1 = 0.f;
        if (type == 0) {
            const float gamma = 1.0f - exp2f(-(dir ? 5.5f : 5.0f) - (float)hh);
            lg2 = log2f(gamma);
            const int dm0 = (2 * lane) & 63;
            invf0 = exp2f(-(float)dm0 * (13.287712379549449f / 64.0f)); invf1 = exp2f(-(float)(dm0 + 1) * (13.287712379549449f / 64.0f));
            sgn = lane < 32 ? -1.f : 1.f;
        } else if (l > 0) {
            const float* lbl = p.lb_logits + dir * HWD + hh * 128 + 2 * lane;
            lb0 = 1.0f / (1.0f + expf(lbl[0] - lbl[2 * HWD])); lb1 = 1.0f / (1.0f + expf(lbl[1] - lbl[2 * HWD + 1]));
        }
        const int colA = (type ? C_HQ : C_RQ) + hh * 128, colB = (type ? (dir ? C_HFB : C_HFF) : C_RK) + hh * 128;
        const int colV0 = (type ? C_HI : C_RV) + hh * 128 + vsl * 64;
        const int own = 2 * lane, par = (2 * lane + 64) & 127;
        const size_t ocol = (size_t)type * 768 + hh * 128 + vsl * 64;
#define MX_LOAD(ch) do { \
            _Pragma("unroll") for (int i2 = 0; i2 < 2; ++i2) { const int pos = wave * 8 + i2 * 4 + (lane >> 4); const int tau = (ch) * 64 + pos; const int t = dir ? (SEQ - 1 - tau) : tau; \
                const bf16_t* row = proj + (size_t)(b * SEQ + t) * INC + (lane & 15) * 8; \
                __builtin_amdgcn_global_load_lds((const unsigned*)(row + colA), (LAS unsigned*)(lds + MX_RQ + (wave * 8 + i2 * 4) * 256), 16, 0, 0); \
                __builtin_amdgcn_global_load_lds((const unsigned*)(row + colB), (LAS unsigned*)(lds + MX_RK + (wave * 8 + i2 * 4) * 256), 16, 0, 0); } \
            { const int pos = wave * 8 + (lane >> 3); const int tau = (ch) * 64 + pos; const int t = dir ? (SEQ - 1 - tau) : tau; \
              const bf16_t* row = proj + (size_t)(b * SEQ + t) * INC + colV0 + (lane & 7) * 8; \
              __builtin_amdgcn_global_load_lds((const unsigned*)row, (LAS unsigned*)(lds + MX_RV + (wave * 8) * 128), 16, 0, 0); } } while (0)
        f32x4 Sacc[4];
#pragma unroll
        for (int vt = 0; vt < 4; ++vt) Sacc[vt] = (f32x4){0.f, 0.f, 0.f, 0.f};
        for (int i = tid; i < 64 * 272 / 4; i += 512) ((LAS unsigned*)(lds + MX_ST))[i] = 0u;
        float cd0 = 1.f, sd0 = 0.f, cd1 = 1.f, sd1 = 0.f;
        if (type == 0) {
            if (tid < 64) { const float fi = (float)tid; *(LAS f32x4*)(lds + MX_DEC + 512 + tid * 16) = (f32x4){ex2((fi - 31.f) * lg2), ex2((31.f - fi) * lg2), ex2((fi + 1.f) * lg2), ex2((63.f - fi) * lg2)}; }
            const float r0 = invf0 * 0.15915494309189535f, r1 = invf1 * 0.15915494309189535f, sg = dir ? -1.f : 1.f;
            cd0 = __builtin_amdgcn_cosf(r0); sd0 = sg * __builtin_amdgcn_sinf(r0); cd1 = __builtin_amdgcn_cosf(r1); sd1 = sg * __builtin_amdgcn_sinf(r1);
        }
        __syncthreads();
        MX_LOAD(0);
        asm volatile("s_waitcnt vmcnt(0)" ::: "memory");
        __syncthreads();
        for (int ch = 0; ch < 32; ++ch) {
            f32x4 dcv = (f32x4){1.f, 1.f, 1.f, 1.f};
            float q0[8], q1[8], k0[8], k1[8], c0[8], c1[8], uu0[8], uu1[8];
            float run0 = 1.f, run1 = 1.f, runu0 = 1.f, runu1 = 1.f;
            u32x4 vpk = (u32x4){0u, 0u, 0u, 0u};
#pragma unroll
            for (int j = 0; j < 8; ++j) { q0[j] = q1[j] = k0[j] = k1[j] = c0[j] = c1[j] = 0.f; uu0[j] = uu1[j] = 1.f; }
            if (MODE != 3 && MODE != 4) {
            if (type == 0) {
                const int tau0 = ch * 64 + wave * 8; const int t0 = dir ? (SEQ - 1 - tau0) : tau0;
                float rev0 = (float)t0 * invf0 * 0.15915494309189535f, rev1 = (float)t0 * invf1 * 0.15915494309189535f;
                rev0 -= rintf(rev0); rev1 -= rintf(rev1);
                float sn0 = __builtin_amdgcn_sinf(rev0), cs0 = __builtin_amdgcn_cosf(rev0), sn1 = __builtin_amdgcn_sinf(rev1), cs1 = __builtin_amdgcn_cosf(rev1);
#pragma unroll
                for (int j = 0; j < 8; ++j) {
                    const int pos_ = wave * 8 + j;
                    const unsigned ra_ = *(const LAS unsigned*)(lds + MX_RQ + pos_ * 256 + own * 2), rb_ = *(const LAS unsigned*)(lds + MX_RK + pos_ * 256 + own * 2);
                    const unsigned rc_ = *(const LAS unsigned*)(lds + MX_RQ + pos_ * 256 + par * 2), rd_ = *(const LAS unsigned*)(lds + MX_RK + pos_ * 256 + par * 2);
                    const float a_lo = bf2f(ra_ & 0xffffu), a_hi = bf2f(ra_ >> 16), b_lo = bf2f(rb_ & 0xffffu), b_hi = bf2f(rb_ >> 16);
                    const float pa_lo = bf2f(rc_ & 0xffffu), pa_hi = bf2f(rc_ >> 16), pb_lo = bf2f(rd_ & 0xffffu), pb_hi = bf2f(rd_ >> 16);
                    const float ss0 = sgn * sn0, ss1 = sgn * sn1;
                    q0[j] = a_lo * cs0 + pa_lo * ss0; q1[j] = a_hi * cs1 + pa_hi * ss1;
                    k0[j] = (b_lo * cs0 + pb_lo * ss0) * 0.08838834764831845f; k1[j] = (b_hi * cs1 + pb_hi * ss1) * 0.08838834764831845f;
                    const float nc0 = cs0 * cd0 - sn0 * sd0, ns0 = sn0 * cd0 + cs0 * sd0, nc1 = cs1 * cd1 - sn1 * sd1, ns1 = sn1 * cd1 + cs1 * sd1;
                    cs0 = nc0; sn0 = ns0; cs1 = nc1; sn1 = ns1;
                    c0[j] = 0.f; c1[j] = 0.f;
                }
            } else {
#pragma unroll
                for (int j = 0; j < 8; ++j) {
                    const int pos_ = wave * 8 + j;
                    const unsigned ra_ = *(const LAS unsigned*)(lds + MX_RQ + pos_ * 256 + own * 2), rb_ = *(const LAS unsigned*)(lds + MX_RK + pos_ * 256 + own * 2);
                    const float a_lo = bf2f(ra_ & 0xffffu), a_hi = bf2f(ra_ >> 16), b_lo = bf2f(rb_ & 0xffffu), b_hi = bf2f(rb_ >> 16);
                    q0[j] = a_lo; q1[j] = a_hi;
                    const float u0 = 1.0f + ex2(-b_lo * 1.4426950408889634f), u1 = 1.0f + ex2(-b_hi * 1.4426950408889634f);
                    float f0 = lb0 + (1.0f - lb0) * __builtin_amdgcn_rcpf(u0), f1 = lb1 + (1.0f - lb1) * __builtin_amdgcn_rcpf(u1);
                    f0 = fmaxf(f0, 1e-6f); f1 = fmaxf(f1, 1e-6f);
                    k0[j] = 1.0f - f0; k1[j] = 1.0f - f1;
                    c0[j] = f0; c1[j] = f1;
                    if (l > 0) { uu0[j] = __builtin_amdgcn_rcpf(f0); uu1[j] = __builtin_amdgcn_rcpf(f1); } else { uu0[j] = fminf(u0, 1e6f); uu1[j] = fminf(u1, 1e6f); }
                    run0 *= f0; run1 *= f1; runu0 = fminf(runu0 * uu0[j], MX_BIG); runu1 = fminf(runu1 * uu1[j], MX_BIG);
                }
            }
            { unsigned rv[8];
#pragma unroll
              for (int j = 0; j < 8; ++j) rv[j] = *(const LAS unsigned short*)(lds + MX_RV + (wave * 8 + j) * 128 + lane * 2);
              vpk[0] = rv[0] | (rv[1] << 16); vpk[1] = rv[2] | (rv[3] << 16); vpk[2] = rv[4] | (rv[5] << 16); vpk[3] = rv[6] | (rv[7] << 16); }
            }
            { typedef float f32x2_ __attribute__((ext_vector_type(2))); *(LAS f32x2_*)(lds + MX_TOT + (wave * 128 + 2 * lane) * 4) = (f32x2_){run0, run1};
              *(LAS f32x2_*)(lds + MX_QS + (wave * 128 + 2 * lane) * 4) = (f32x2_){runu0, runu1}; }
            LDS_BARRIER();
            if (ch + 1 < 32) MX_LOAD(ch + 1);
            float kt0[8], kt1[8];
            float tt0, tt1;
#pragma unroll
            for (int j = 0; j < 8; ++j) { kt0[j] = kt1[j] = 0.f; }
            tt0 = tt1 = 0.f;
            if (MODE != 3 && MODE != 4) {
            if (type == 0) {
                tt0 = tt1 = 64.f * lg2;
#pragma unroll
                for (int j = 0; j < 8; ++j) {
                    const int pos = wave * 8 + j;
                    const f32x4 e = *(const LAS f32x4*)(lds + MX_DEC + 512 + pos * 16);
                    *(LAS unsigned*)(lds + MX_QI + pos * 272 + lane * 4) = pack2(q0[j] * e[0], q1[j] * e[0]);
                    *(LAS unsigned*)(lds + MX_KI + pos * 272 + lane * 4) = pack2(k0[j] * e[1], k1[j] * e[1]);
                    kt0[j] = k0[j] * e[3]; kt1[j] = k1[j] * e[3];
                }
            } else {
                float sf0 = 1.f, sf1 = 1.f, su0 = 1.f, su1 = 1.f;
#pragma unroll
                for (int g = 0; g < 8; ++g) {
                    typedef float f32x2_ __attribute__((ext_vector_type(2)));
                    const f32x2_ fv = *(const LAS f32x2_*)(lds + MX_TOT + (g * 128 + 2 * lane) * 4), uv = *(const LAS f32x2_*)(lds + MX_QS + (g * 128 + 2 * lane) * 4);
                    if (g > wave) { sf0 *= fv[0]; sf1 *= fv[1]; su0 = fminf(su0 * uv[0], MX_BIG); su1 = fminf(su1 * uv[1], MX_BIG); }
                }
                tt0 = tt1 = 0.f;
#pragma unroll
                for (int j = 7; j >= 0; --j) {
                    const int pos = wave * 8 + j;
                    *(LAS unsigned*)(lds + MX_QI + pos * 272 + lane * 4) = pack2(q0[j] * su0, q1[j] * su1);
                    kt0[j] = k0[j] * sf0; kt1[j] = k1[j] * sf1;
                    *(LAS unsigned*)(lds + MX_KI + pos * 272 + lane * 4) = pack2(kt0[j], kt1[j]);
                    sf0 *= c0[j]; sf1 *= c1[j]; su0 = fminf(su0 * uu0[j], MX_BIG); su1 = fminf(su1 * uu1[j], MX_BIG);
                }
            }
            }
            { u32x4 w0, w1;
              w0[0] = pack2(kt0[0], kt0[1]); w0[1] = pack2(kt0[2], kt0[3]); w0[2] = pack2(kt0[4], kt0[5]); w0[3] = pack2(kt0[6], kt0[7]);
              w1[0] = pack2(kt1[0], kt1[1]); w1[1] = pack2(kt1[2], kt1[3]); w1[2] = pack2(kt1[4], kt1[5]); w1[3] = pack2(kt1[6], kt1[7]);
              *(LAS u32x4*)(lds + MX_KTT + (2 * lane) * 144 + wave * 16) = w0;
              *(LAS u32x4*)(lds + MX_KTT + (2 * lane + 1) * 144 + wave * 16) = w1;
              *(LAS u32x4*)(lds + MX_VT + lane * 144 + wave * 16) = vpk; }
            if (MODE != 3 && MODE != 4) {
                f32x4 em;
                if (type == 0) { const float e_ = ex2(32.f * lg2), d_ = ex2(64.f * lg2); em = (f32x4){e_, e_, e_, e_}; dcv = (f32x4){d_, d_, d_, d_}; }
                else {
                    f32x4 ms = (f32x4){1.f, 1.f, 1.f, 1.f};
#pragma unroll
                    for (int g = 0; g < 8; ++g) ms *= *(const LAS f32x4*)(lds + MX_TOT + (g * 128 + 16 * wave + 4 * fq) * 4);
                    em = ms; dcv = ms;
                }
#pragma unroll
                for (int vt = 0; vt < 4; ++vt) { u32x2 o; o[0] = pack2(Sacc[vt][0] * em[0], Sacc[vt][1] * em[1]); o[1] = pack2(Sacc[vt][2] * em[2], Sacc[vt][3] * em[3]);
                    *(LAS u32x2*)(lds + MX_ST + (16 * vt + fr) * 272 + (16 * wave + 4 * fq) * 2) = o; }
            }
            LDS_BARRIER();
            if (MODE != 2 && MODE != 4) {
                const int it = wave >> 1, st0 = 2 * (wave & 1);
                bf16x8 ka[2][4], qb[4];
#pragma unroll
                for (int kq = 0; kq < 4; ++kq) {
                    qb[kq] = *(const LAS bf16x8*)(lds + MX_QI + (16 * it + fr) * 272 + (32 * kq + 8 * fq) * 2);
                    ka[0][kq] = *(const LAS bf16x8*)(lds + MX_KI + (16 * st0 + fr) * 272 + (32 * kq + 8 * fq) * 2);
                    ka[1][kq] = *(const LAS bf16x8*)(lds + MX_KI + (16 * st0 + 16 + fr) * 272 + (32 * kq + 8 * fq) * 2);
                }
                asm volatile("s_waitcnt lgkmcnt(0)" ::: "memory");
                f32x4 acc0 = (f32x4){0.f, 0.f, 0.f, 0.f}, acc1 = acc0;
#pragma unroll
                for (int kq = 0; kq < 4; ++kq) {
                    acc0 = __builtin_amdgcn_mfma_f32_16x16x32_bf16(ka[0][kq], qb[kq], acc0, 0, 0, 0);
                    acc1 = __builtin_amdgcn_mfma_f32_16x16x32_bf16(ka[1][kq], qb[kq], acc1, 0, 0, 0);
                }
                const int i = 16 * it + fr;
                { const int s0 = 16 * st0 + 4 * fq;
                  const float v0 = (s0 + 0 <= i) ? acc0[0] : 0.f, v1 = (s0 + 1 <= i) ? acc0[1] : 0.f, v2 = (s0 + 2 <= i) ? acc0[2] : 0.f, v3 = (s0 + 3 <= i) ? acc0[3] : 0.f;
                  u32x2 o; o[0] = pack2(v0, v1); o[1] = pack2(v2, v3);
                  *(LAS u32x2*)(lds + MX_P + i * 144 + s0 * 2) = o; }
                { const int s0 = 16 * st0 + 16 + 4 * fq;
                  const float v0 = (s0 + 0 <= i) ? acc1[0] : 0.f, v1 = (s0 + 1 <= i) ? acc1[1] : 0.f, v2 = (s0 + 2 <= i) ? acc1[2] : 0.f, v3 = (s0 + 3 <= i) ? acc1[3] : 0.f;
                  u32x2 o; o[0] = pack2(v0, v1); o[1] = pack2(v2, v3);
                  *(LAS u32x2*)(lds + MX_P + i * 144 + s0 * 2) = o; }
            }
            LDS_BARRIER();
            if (MODE != 2 && MODE != 4) {
                const int vt = wave >> 1, it0 = 2 * (wave & 1);
                bf16x8 va[2], sa[4], pb[2][2], qsb[2][4], kta[2], vb[4][2];
#pragma unroll
                for (int kq = 0; kq < 2; ++kq) {
                    va[kq] = *(const LAS bf16x8*)(lds + MX_VT + (16 * vt + fr) * 144 + (32 * kq + 8 * fq) * 2);
                    pb[0][kq] = *(const LAS bf16x8*)(lds + MX_P + (16 * it0 + fr) * 144 + (32 * kq + 8 * fq) * 2);
                    pb[1][kq] = *(const LAS bf16x8*)(lds + MX_P + (16 * it0 + 16 + fr) * 144 + (32 * kq + 8 * fq) * 2);
                    kta[kq] = *(const LAS bf16x8*)(lds + MX_KTT + (16 * wave + fr) * 144 + (32 * kq + 8 * fq) * 2);
                }
#pragma unroll
                for (int kq = 0; kq < 4; ++kq) {
                    sa[kq] = *(const LAS bf16x8*)(lds + MX_ST + (16 * vt + fr) * 272 + (32 * kq + 8 * fq) * 2);
                    qsb[0][kq] = *(const LAS bf16x8*)(lds + MX_QI + (16 * it0 + fr) * 272 + (32 * kq + 8 * fq) * 2);
                    qsb[1][kq] = *(const LAS bf16x8*)(lds + MX_QI + (16 * it0 + 16 + fr) * 272 + (32 * kq + 8 * fq) * 2);
                }
#pragma unroll
                for (int v4 = 0; v4 < 4; ++v4)
#pragma unroll
                    for (int kq = 0; kq < 2; ++kq) vb[v4][kq] = *(const LAS bf16x8*)(lds + MX_VT + (16 * v4 + fr) * 144 + (32 * kq + 8 * fq) * 2);
                const f32x4 dc = dcv;
                asm volatile("s_waitcnt lgkmcnt(0)" ::: "memory");
                f32x4 acc0 = (f32x4){0.f, 0.f, 0.f, 0.f}, acc1 = acc0;
#pragma unroll
                for (int kq = 0; kq < 2; ++kq) {
                    acc0 = __builtin_amdgcn_mfma_f32_16x16x32_bf16(va[kq], pb[0][kq], acc0, 0, 0, 0);
                    acc1 = __builtin_amdgcn_mfma_f32_16x16x32_bf16(va[kq], pb[1][kq], acc1, 0, 0, 0);
                }
#pragma unroll
                for (int kq = 0; kq < 4; ++kq) {
                    acc0 = __builtin_amdgcn_mfma_f32_16x16x32_bf16(sa[kq], qsb[0][kq], acc0, 0, 0, 0);
                    acc1 = __builtin_amdgcn_mfma_f32_16x16x32_bf16(sa[kq], qsb[1][kq], acc1, 0, 0, 0);
                }
#pragma unroll
                for (int v4 = 0; v4 < 4; ++v4) {
                    f32x4 a = Sacc[v4]; a[0] *= dc[0]; a[1] *= dc[1]; a[2] *= dc[2]; a[3] *= dc[3];
                    a = __builtin_amdgcn_mfma_f32_16x16x32_bf16(kta[0], vb[v4][0], a, 0, 0, 0);
                    a = __builtin_amdgcn_mfma_f32_16x16x32_bf16(kta[1], vb[v4][1], a, 0, 0, 0);
                    Sacc[v4] = a;
                }
                asm volatile("s_waitcnt vmcnt(0)" ::: "memory");
                { const int tau = ch * 64 + 16 * it0 + fr; const int t = dir ? (SEQ - 1 - tau) : tau;
                  u32x2 o; o[0] = pack2(acc0[0], acc0[1]); o[1] = pack2(acc0[2], acc0[3]);
                  *(u32x2*)((bf16_t*)obuf + ((size_t)dir * T + (size_t)(b * SEQ + t)) * 1536 + ocol + 16 * vt + 4 * fq) = o; }
                { const int tau = ch * 64 + 16 * it0 + 16 + fr; const int t = dir ? (SEQ - 1 - tau) : tau;
                  u32x2 o; o[0] = pack2(acc1[0], acc1[1]); o[1] = pack2(acc1[2], acc1[3]);
                  *(u32x2*)((bf16_t*)obuf + ((size_t)dir * T + (size_t)(b * SEQ + t)) * 1536 + ocol + 16 * vt + 4 * fq) = o; }
            }
        }
        __syncthreads();
#undef MX_LOAD
    }
}

#ifdef MIXER_CHECK
__device__ __forceinline__ void phase_mixer_check(const Params& p, const float* __restrict__ oa, const float* __restrict__ ob, float* chk) {
    int tid_ = threadIdx.x; asm volatile("" : "+v"(tid_)); const int wave = tid_ >> 6, lane = tid_ & 63;
    for (int r = blockIdx.x * 8 + wave; r < 2 * T; r += gridDim.x * 8) {
        const int dir = r / T;
#pragma unroll
        for (int ty = 0; ty < 2; ++ty) {
            float sd = 0.f, sq = 0.f;
#pragma unroll
            for (int i = 0; i < 3; ++i) { const float4 a = *(const float4*)(oa + (size_t)r * 1536 + ty * 768 + i * 256 + lane * 4), bq = *(const float4*)(ob + (size_t)r * 1536 + ty * 768 + i * 256 + lane * 4);
                sd += (a.x - bq.x) * (a.x - bq.x) + (a.y - bq.y) * (a.y - bq.y) + (a.z - bq.z) * (a.z - bq.z) + (a.w - bq.w) * (a.w - bq.w);
                sq += a.x * a.x + a.y * a.y + a.z * a.z + a.w * a.w; }
            sd = wave_sum(sd); sq = wave_sum(sq);
            if (lane == 0) { atomicAdd(&chk[(ty * 2 + dir) * 2 + 0], sd); atomicAdd(&chk[(ty * 2 + dir) * 2 + 1], sq); }
        }
    }
}
#endif

__device__ __forceinline__ float4 ld_bf4(const bf16_t* p) { const u32x2 r = *(const u32x2*)p; return make_float4(bf2f(r[0] & 0xffffu), bf2f(r[0] >> 16), bf2f(r[1] & 0xffffu), bf2f(r[1] >> 16)); }
__device__ __forceinline__ float grp16_sum(float v) {
#pragma unroll
    for (int o = 8; o > 0; o >>= 1) v += __shfl_xor(v, o, 64);
    return v;
}
__device__ __forceinline__ void phase_finalize(const Params& p, int l) {
    int tid_ = threadIdx.x; asm volatile("" : "+v"(tid_)); const int wave = tid_ >> 6, lane = tid_ & 63;
    const bf16_t* proj = (const bf16_t*)(p.ws + WS_PROJ);
    const bf16_t* obuf = (const bf16_t*)(p.ws + WS_OBUF);
    bf16_t* mixed = (bf16_t*)(p.ws + WS_MIXED);
    const float* cw = p.conv_w + (size_t)l * 3 * CW;
    const float* beta = p.mix_beta + (size_t)l * D;
    for (int n = blockIdx.x * 8 + wave; n < T; n += gridDim.x * 8) {
        const int t = n % SEQ;
        const bf16_t* row = proj + (size_t)n * INC;
#pragma unroll
        for (int i = 0; i < 4; ++i) {
            const int c = COL8(i);
            float4 r[2];
            if (i == 0) {
                float4 cc[2], ch[2], cb[2], um[2], up[2];
                ld_bf8(row + C_CC + c, cc[0], cc[1]); ld_bf8(row + C_CH + c, ch[0], ch[1]); ld_bf8(row + C_CB + c, cb[0], cb[1]);
                um[0] = um[1] = up[0] = up[1] = make_float4(0.f, 0.f, 0.f, 0.f);
                if (t > 0) { float4 a[2], b2[2]; ld_bf8(row - INC + C_CC + c, a[0], a[1]); ld_bf8(row - INC + C_CH + c, b2[0], b2[1]);
#pragma unroll
                    for (int q = 0; q < 2; ++q) um[q] = make_float4(a[q].x * b2[q].x, a[q].y * b2[q].y, a[q].z * b2[q].z, a[q].w * b2[q].w); }
                if (t < SEQ - 1) { float4 a[2], b2[2]; ld_bf8(row + INC + C_CC + c, a[0], a[1]); ld_bf8(row + INC + C_CH + c, b2[0], b2[1]);
#pragma unroll
                    for (int q = 0; q < 2; ++q) up[q] = make_float4(a[q].x * b2[q].x, a[q].y * b2[q].y, a[q].z * b2[q].z, a[q].w * b2[q].w); }
#pragma unroll
                for (int q = 0; q < 2; ++q) {
                    const float4 w0 = *(const float4*)(cw + c + 4 * q), w1 = *(const float4*)(cw + CW + c + 4 * q), w2 = *(const float4*)(cw + 2 * CW + c + 4 * q);
                    r[q].x = cb[q].x * (um[q].x * w0.x + cc[q].x * ch[q].x * w1.x + up[q].x * w2.x);
                    r[q].y = cb[q].y * (um[q].y * w0.y + cc[q].y * ch[q].y * w1.y + up[q].y * w2.y);
                    r[q].z = cb[q].z * (um[q].z * w0.z + cc[q].z * ch[q].z * w1.z + up[q].z * w2.z);
                    r[q].w = cb[q].w * (um[q].w * w0.w + cc[q].w * ch[q].w * w1.w + up[q].w * w2.w);
                }
            } else {
                const int oc = c - 512;
                const bool isret = oc < 768;
                float4 of[2], ob[2], gt[2];
                ld_bf8(obuf + (size_t)n * 1536 + oc, of[0], of[1]); ld_bf8(obuf + ((size_t)T + n) * 1536 + oc, ob[0], ob[1]);
                ld_bf8(row + (isret ? C_RG + oc : C_HG + (oc - 768)), gt[0], gt[1]);
                float4 o[2];
#pragma unroll
                for (int q = 0; q < 2; ++q) o[q] = make_float4(of[q].x + ob[q].x, of[q].y + ob[q].y, of[q].z + ob[q].z, of[q].w + ob[q].w);
                const float sm = grp16_sum(((o[0].x + o[0].y) + (o[0].z + o[0].w)) + ((o[1].x + o[1].y) + (o[1].z + o[1].w)));
                const float mu = isret ? sm * (1.0f / 128.0f) : 0.f;
#pragma unroll
                for (int q = 0; q < 2; ++q) { o[q].x -= mu; o[q].y -= mu; o[q].z -= mu; o[q].w -= mu; }
                const float var = grp16_sum(((o[0].x * o[0].x + o[0].y * o[0].y) + (o[0].z * o[0].z + o[0].w * o[0].w)) + ((o[1].x * o[1].x + o[1].y * o[1].y) + (o[1].z * o[1].z + o[1].w * o[1].w))) * (1.0f / 128.0f);
                const float rs = rsqrtf(var + 1e-6f);
#pragma unroll
                for (int q = 0; q < 2; ++q) r[q] = make_float4(o[q].x * rs * siluf_(gt[q].x), o[q].y * rs * siluf_(gt[q].y), o[q].z * rs * siluf_(gt[q].z), o[q].w * rs * siluf_(gt[q].w));
            }
            const float4 bt0 = *(const float4*)(beta + c), bt1 = *(const float4*)(beta + c + 4);
            r[0] = make_float4(r[0].x * bt0.x, r[0].y * bt0.y, r[0].z * bt0.z, r[0].w * bt0.w);
            r[1] = make_float4(r[1].x * bt1.x, r[1].y * bt1.y, r[1].z * bt1.z, r[1].w * bt1.w);
            if (OUT8(l)) { const float4 a4 = make_float4(r[0].x * 4.f, r[0].y * 4.f, r[0].z * 4.f, r[0].w * 4.f), b4 = make_float4(r[1].x * 4.f, r[1].y * 4.f, r[1].z * 4.f, r[1].w * 4.f);
                           st_fp8x8((unsigned char*)mixed + (size_t)n * D + c, a4, b4); }
            else st_bf8(mixed + (size_t)n * D + c, r[0], r[1]);
        }
    }
}

__device__ __forceinline__ void phase_ln1_router(const Params& p, int l, LAS unsigned char* lds) {
    int tid = threadIdx.x; asm volatile("" : "+v"(tid)); const int wave = tid >> 6, lane = tid & 63;
    LAS float* wrt = (LAS float*)lds;
    for (int i = tid; i < D * NE / 4; i += 512) {
        const float4 w = *(const float4*)(p.w_router + (size_t)i * 4);
        const int d = i >> 2, e4 = (i & 3) * 4;
        const int dp = (((d >> 9) * 2 + ((d >> 2) & 1)) << 8) + (((d >> 3) & 63) << 2) + (d & 3);
        wrt[(e4 + 0) * D + dp] = w.x; wrt[(e4 + 1) * D + dp] = w.y; wrt[(e4 + 2) * D + dp] = w.z; wrt[(e4 + 3) * D + dp] = w.w;
    }
    LAS int* lcnt = (LAS int*)(lds + LDS_MISC + 256);
    if (tid < 16) lcnt[tid] = 0;
    __syncthreads();
    const float* mod = (const float*)(p.ws + WS_MOD);
    const float* y = (const float*)(p.ws + WS_Y);
    float* xres = (float*)(p.ws + WS_XRES);
    int* route = (int*)(p.ws + WS_ROUTE);
    for (int n = blockIdx.x * 8 + wave; n < T; n += gridDim.x * 8) {
        const int b = n / SEQ;
        const float* mb = mod + ((size_t)l * 4 + b) * (6 * D);
        float4 v[8];
#pragma unroll
        for (int i = 0; i < 4; ++i) {
            float4 xv[2], yv[2];
            ld_bf8((const bf16_t*)xres + (size_t)n * D + COL8(i), xv[0], xv[1]); ld_bf8((const bf16_t*)y + (size_t)n * D + COL8(i), yv[0], yv[1]);
#pragma unroll
            for (int q = 0; q < 2; ++q) {
                const float4 g = *(const float4*)(mb + 2 * D + COLK(2 * i + q));
                v[2 * i + q] = make_float4(ALPHA * xv[q].x + (1.f + g.x) * yv[q].x, ALPHA * xv[q].y + (1.f + g.y) * yv[q].y, ALPHA * xv[q].z + (1.f + g.z) * yv[q].z, ALPHA * xv[q].w + (1.f + g.w) * yv[q].w);
            }
        }
        ln_rows(v, p.ln_g + (size_t)(l * 2 + 0) * D, p.ln_b + (size_t)(l * 2 + 0) * D, lane);
#pragma unroll
        for (int i = 0; i < 4; ++i) st_bf8((bf16_t*)xres + (size_t)n * D + COL8(i), v[2 * i], v[2 * i + 1]);
#pragma unroll
        for (int i = 0; i < 8; ++i) {
            const float4 sh = *(const float4*)(mb + 3 * D + COLK(i)), sc = *(const float4*)(mb + 4 * D + COLK(i));
            v[i].x = v[i].x * (1.f + sc.x) + sh.x; v[i].y = v[i].y * (1.f + sc.y) + sh.y; v[i].z = v[i].z * (1.f + sc.z) + sh.z; v[i].w = v[i].w * (1.f + sc.w) + sh.w;
        }
#if MOE_FP8
        unsigned char* hb = p.ws + WS_HB + (size_t)n * D;
#pragma unroll
        for (int i = 0; i < 4; ++i) st_fp8x8(hb + COL8(i), v[2 * i], v[2 * i + 1]);
#else
        bf16_t* hb = (bf16_t*)(p.ws + WS_HB) + (size_t)n * D;
#pragma unroll
        for (int i = 0; i < 4; ++i) st_bf8(hb + COL8(i), v[2 * i], v[2 * i + 1]);
#endif
        float lgk0 = 0.f, lgk1 = 0.f, lgk2 = 0.f, lgk3 = 0.f;
        const bool b5 = (lane & 32) != 0, b4 = (lane & 16) != 0;
#pragma unroll 1
        for (int eg = 0; eg < 4; ++eg) {
            float s4[4];
#pragma unroll
            for (int q = 0; q < 4; ++q) {
                float s = 0.f;
#pragma unroll
                for (int i = 0; i < 8; ++i) { const f32x4 w = *(const LAS f32x4*)(wrt + (eg * 4 + q) * D + i * 256 + lane * 4); s += (v[i].x * w[0] + v[i].y * w[1]) + (v[i].z * w[2] + v[i].w * w[3]); }
                s4[q] = s;
            }
            const float tA = (b5 ? s4[2] : s4[0]) + __shfl_xor(b5 ? s4[0] : s4[2], 32, 64);
            const float tB = (b5 ? s4[3] : s4[1]) + __shfl_xor(b5 ? s4[1] : s4[3], 32, 64);
            float u = (b4 ? tB : tA) + __shfl_xor(b4 ? tA : tB, 16, 64);
            u += __shfl_xor(u, 8, 64); u += __shfl_xor(u, 4, 64); u += __shfl_xor(u, 2, 64); u += __shfl_xor(u, 1, 64);
            lgk0 = (eg == 0) ? u : lgk0; lgk1 = (eg == 1) ? u : lgk1; lgk2 = (eg == 2) ? u : lgk2; lgk3 = (eg == 3) ? u : lgk3;
        }
        float lg[16];
#pragma unroll
        for (int q = 0; q < 4; ++q) {
            const int src = ((q >> 1) * 32) + ((q & 1) * 16);
            lg[0 + q] = __int_as_float(__builtin_amdgcn_readlane(__float_as_int(lgk0), src));
            lg[4 + q] = __int_as_float(__builtin_amdgcn_readlane(__float_as_int(lgk1), src));
            lg[8 + q] = __int_as_float(__builtin_amdgcn_readlane(__float_as_int(lgk2), src));
            lg[12 + q] = __int_as_float(__builtin_amdgcn_readlane(__float_as_int(lgk3), src));
        }
        float mx = lg[0];
#pragma unroll
        for (int e = 1; e < 16; ++e) mx = fmaxf(mx, lg[e]);
        float sc[16], sum = 0.f;
#pragma unroll
        for (int e = 0; e < 16; ++e) { sc[e] = expf(lg[e] - mx); sum += sc[e]; }
        const float inv = 1.0f / sum;
        float sel[16];
#pragma unroll
        for (int e = 0; e < 16; ++e) { sc[e] *= inv; sel[e] = sc[e] + p.router_bias[e]; }
        float best_gs = -3.0e38f; int bi0 = 0, bi1 = 1; float bw0 = 0.f, bw1 = 0.f;
#pragma unroll
        for (int g = 0; g < 4; ++g) {
            int i0 = 0; float m0 = sel[4 * g];
#pragma unroll
            for (int j = 1; j < 4; ++j) if (sel[4 * g + j] > m0) { m0 = sel[4 * g + j]; i0 = j; }
            int i1 = -1; float m1 = -3.0e38f;
#pragma unroll
            for (int j = 0; j < 4; ++j) if (j != i0 && sel[4 * g + j] > m1) { m1 = sel[4 * g + j]; i1 = j; }
            float w0 = 0.f, w1 = 0.f;
#pragma unroll
            for (int j = 0; j < 4; ++j) { w0 = (j == i0) ? sc[4 * g + j] : w0; w1 = (j == i1) ? sc[4 * g + j] : w1; }
            const float gs = m0 + m1;
            if (gs > best_gs) { best_gs = gs; bi0 = 4 * g + i0; bi1 = 4 * g + i1; bw0 = w0; bw1 = w1; }
        }
        if (lane == 0) {
            const float ws_ = 1.0f / (bw0 + bw1);
            const int p0 = __hip_atomic_fetch_add(&lcnt[bi0], 1, __ATOMIC_RELAXED, __HIP_MEMORY_SCOPE_WORKGROUP), p1 = __hip_atomic_fetch_add(&lcnt[bi1], 1, __ATOMIC_RELAXED, __HIP_MEMORY_SCOPE_WORKGROUP);
            int* r = route + (size_t)n * 8;
            r[0] = bi0; r[1] = bi1; r[2] = (int)p0; r[3] = (int)p1; r[4] = __float_as_int(bw0 * ws_); r[5] = __float_as_int(bw1 * ws_);
        }
    }
    __syncthreads();
    if (tid < 16) ((int*)(p.ws + WS_WGCNT))[((size_t)l * 1024 + blockIdx.x) * 16 + tid] = lcnt[tid];
}

__device__ __forceinline__ void build_moe_tab(const Params& p, int l, LAS int* tab) {
    if (threadIdx.x == 0) {
        const unsigned* cnt = (const unsigned*)(p.ws + WS_CNT) + l * 16;
        int acc = 0;
        for (int e = 0; e < 16; ++e) { tab[e] = acc; acc += (int)((cnt[e] + 255u) >> 8); }
        tab[16] = acc;
    }
    __syncthreads();
}

__device__ __forceinline__ void phase_permute(const Params& p, int l, LAS int* tab) {
    int tid_ = threadIdx.x; asm volatile("" : "+v"(tid_)); const int wave = tid_ >> 6, lane = tid_ & 63;
    LAS int* base = tab + 32; LAS int* total = tab + 48;
    if (tid_ < 16) { base[tid_] = 0; total[tid_] = 0; }
    __syncthreads();
    {
        const int* wgc = (const int*)(p.ws + WS_WGCNT) + (size_t)l * 1024 * 16;
        const int e = tid_ & 15; int bs = 0, tt = 0;
        for (int w = tid_ >> 4; w < (int)gridDim.x; w += 32) { const int v = wgc[w * 16 + e]; tt += v; bs += (w < (int)blockIdx.x) ? v : 0; }
        __hip_atomic_fetch_add(&base[e], bs, __ATOMIC_RELAXED, __HIP_MEMORY_SCOPE_WORKGROUP);
        __hip_atomic_fetch_add(&total[e], tt, __ATOMIC_RELAXED, __HIP_MEMORY_SCOPE_WORKGROUP);
    }
    __syncthreads();
    if (tid_ == 0) { int acc = 0; for (int e = 0; e < 16; ++e) { tab[e] = acc; acc += (total[e] + 255) >> 8; } tab[16] = acc; }
    if (blockIdx.x == 0 && tid_ < 16) ((unsigned*)(p.ws + WS_CNT))[l * 16 + tid_] = (unsigned)total[tid_];
    __syncthreads();
#if MOE_FP8
    for (int i = blockIdx.x * 512 + tid_; i < XE_ROWS * 8; i += gridDim.x * 512) *(u32x4*)(p.ws + WS_HID + (size_t)(i >> 3) * DEP + DE + (i & 7) * 16) = (u32x4){0u, 0u, 0u, 0u};
#endif
    int* route = (int*)(p.ws + WS_ROUTE);
    const bf16_t* hb = (const bf16_t*)(p.ws + WS_HB);
    bf16_t* xe = (bf16_t*)(p.ws + WS_XE);
    for (int n = blockIdx.x * 8 + wave; n < T; n += gridDim.x * 8) {
        int* r = route + (size_t)n * 8;
        const int e0 = r[0], e1 = r[1], p0 = r[2], p1 = r[3];
        const int row0 = tab[e0] * 256 + base[e0] + p0, row1 = tab[e1] * 256 + base[e1] + p1;
        constexpr int RB = MOE_FP8 ? D : 2 * D;
        const u32x4* src = (const u32x4*)((const unsigned char*)hb + (size_t)n * RB);
        u32x4* d0 = (u32x4*)((unsigned char*)xe + (size_t)row0 * RB); u32x4* d1 = (u32x4*)((unsigned char*)xe + (size_t)row1 * RB);
#pragma unroll
        for (int i = 0; i < RB / 1024; ++i) { const u32x4 v = src[i * 64 + lane]; d0[i * 64 + lane] = v; d1[i * 64 + lane] = v; }
        if (lane == 0) { r[6] = row0; r[7] = row1; }
    }
}

__device__ __forceinline__ void phase_ln2(const Params& p, int l) {
    int tid_ = threadIdx.x; asm volatile("" : "+v"(tid_)); const int wave = tid_ >> 6, lane = tid_ & 63;
    const float* mod = (const float*)(p.ws + WS_MOD);
    const float* ye = (const float*)(p.ws + WS_YE);
    float* xres = (float*)(p.ws + WS_XRES);
    const int* route = (const int*)(p.ws + WS_ROUTE);
    for (int n = blockIdx.x * 8 + wave; n < T; n += gridDim.x * 8) {
        const int b = n / SEQ;
        const float* mb = mod + ((size_t)l * 4 + b) * (6 * D);
        const int* r = route + (size_t)n * 8;
        const float w0 = __int_as_float(r[4]), w1 = __int_as_float(r[5]);
        const bf16_t* y0 = (const bf16_t*)ye + (size_t)r[6] * D; const bf16_t* y1 = (const bf16_t*)ye + (size_t)r[7] * D;
        float4 v[8];
#pragma unroll
        for (int i = 0; i < 4; ++i) {
            float4 xv[2], a[2], c[2];
            ld_bf8((const bf16_t*)xres + (size_t)n * D + COL8(i), xv[0], xv[1]); ld_bf8(y0 + COL8(i), a[0], a[1]); ld_bf8(y1 + COL8(i), c[0], c[1]);
#pragma unroll
            for (int q = 0; q < 2; ++q) {
                const float4 g = *(const float4*)(mb + 5 * D + COLK(2 * i + q));
                v[2 * i + q] = make_float4(ALPHA * xv[q].x + (1.f + g.x) * (w0 * a[q].x + w1 * c[q].x), ALPHA * xv[q].y + (1.f + g.y) * (w0 * a[q].y + w1 * c[q].y),
                                           ALPHA * xv[q].z + (1.f + g.z) * (w0 * a[q].z + w1 * c[q].z), ALPHA * xv[q].w + (1.f + g.w) * (w0 * a[q].w + w1 * c[q].w));
            }
        }
        ln_rows(v, p.ln_g + (size_t)(l * 2 + 1) * D, p.ln_b + (size_t)(l * 2 + 1) * D, lane);
        if (l + 1 < DEPTH) {
#pragma unroll
            for (int i = 0; i < 4; ++i) st_bf8((bf16_t*)xres + (size_t)n * D + COL8(i), v[2 * i], v[2 * i + 1]);
            const float* mn = mod + ((size_t)(l + 1) * 4 + b) * (6 * D);
            modulate_store(v, mn, mn + D, INP8(l + 1) ? (bf16_t*)(p.ws + WS_HA + (size_t)n * D) : (bf16_t*)(p.ws + WS_HA) + (size_t)n * D, lane, INP8(l + 1));
        } else {
#ifdef MIXER_CHECK
            { const float* chk = (const float*)(p.ws + WS_CNT + 1024); float scale = 1.f;
              for (int j = 7; j >= 0; --j) { const float sd = chk[j * 2], sq = chk[j * 2 + 1]; if (!(sd <= 1e-3f * sq)) scale = 1.0f + 0.25f * (float)(1 << (j & 3)) + 8.f * (float)(j >> 2); }
#pragma unroll
              for (int i = 0; i < 8; ++i) { v[i].x *= scale; v[i].y *= scale; v[i].z *= scale; v[i].w *= scale; } }
#endif
#pragma unroll
            for (int i = 0; i < 8; ++i) *(float4*)(p.out + (size_t)n * D + COLK(i)) = v[i];
        }
    }
}

typedef const __attribute__((address_space(4))) unsigned char* KargPtr;
__device__ __forceinline__ Params load_params(KargPtr q) { asm volatile("" : "+s"(q)); Params lp; __builtin_memcpy(&lp, q, sizeof(Params)); return lp; }

__global__ __launch_bounds__(512, 2) void mega(Params p_in) {
    extern __shared__ __attribute__((aligned(16))) unsigned char smem[];
    LAS unsigned char* lds = (LAS unsigned char*)smem;
    LAS int* tab = (LAS int*)(lds + LDS_MISC + 64);
    KargPtr kp = (KargPtr)__builtin_amdgcn_kernarg_segment_ptr();
    if (threadIdx.x == 0) { *(LAS u32x4*)(lds + LDS_MISC) = (u32x4){0u, 0u, 0u, 0u}; *(LAS u32x4*)(lds + LDS_MISC + 768) = (u32x4){0u, 0u, 0u, 0u}; *(LAS u32x4*)(lds + LDS_MISC + 784) = (u32x4){0u, 0u, 0u, 0u}; }
    __syncthreads();
    const int fused = p_in.fused, ph_lo = p_in.ph_lo, ph_hi = p_in.ph_hi, l_hi = p_in.l_hi;
    XcdBarrier bar;
    if (fused) bar = xcd_barrier_post((unsigned*)(p_in.ws + WS_BAR), (volatile LAS unsigned*)(lds + LDS_MISC));
    else { bar.bar = (unsigned*)(p_in.ws + WS_BAR); bar.x = 0; bar.st = (volatile LAS unsigned*)(lds + LDS_MISC); }
#ifdef ONLY_PH
#define PH(i) ((i) == ONLY_PH && ph_lo <= (i) && (i) < ph_hi)
#else
#define PH(i) (ph_lo <= (i) && (i) < ph_hi)
#endif
#ifdef PROBE_PH
#define SYNC_PLAIN() do { if (fused) xcd_barrier(bar); } while (0)
#define PSTART(i) do { if ((i) == PROBE_PH && blockIdx.x == 0 && threadIdx.x == 0) { *(LAS unsigned long long*)(lds + LDS_MISC + 768) = __builtin_amdgcn_s_memrealtime(); } } while (0)
#define PSTOP(i) do { if ((i) == PROBE_PH && blockIdx.x == 0 && threadIdx.x == 0) { *(LAS unsigned long long*)(lds + LDS_MISC + 776) += __builtin_amdgcn_s_memrealtime() - *(LAS unsigned long long*)(lds + LDS_MISC + 768); } } while (0)
#else
#define PSTART(i) do { } while (0)
#define PSTOP(i) do { } while (0)
#endif
#if defined(PROBE_PH) && defined(PROBE_SUB)
#define QSTART(i, k) do { if ((i) == PROBE_PH && (k) == PROBE_SUB && blockIdx.x == PROBE_WG && threadIdx.x == 0) { *(LAS unsigned long long*)(lds + LDS_MISC + 784) = __builtin_amdgcn_s_memrealtime(); } } while (0)
#define QSTOP(i, k) do { if ((i) == PROBE_PH && (k) == PROBE_SUB && blockIdx.x == PROBE_WG && threadIdx.x == 0) { *(LAS unsigned long long*)(lds + LDS_MISC + 792) += __builtin_amdgcn_s_memrealtime() - *(LAS unsigned long long*)(lds + LDS_MISC + 784); } } while (0)
#else
#define QSTART(i, k) do { } while (0)
#define QSTOP(i, k) do { } while (0)
#endif
#define SYNC() do { if (fused) xcd_barrier(bar); } while (0)
#ifndef DUP_MASK
#define DUP_MASK 0
#endif
#define REP(i) _Pragma("unroll 1") for (int rep_ = 0; rep_ < 1 + ((DUP_MASK >> (i)) & 1); ++rep_)
    const int G = gridDim.x, c = blockIdx.x;
    if (PH(0)) REP(0) { PSTART(0); const Params p = load_params(kp); phase_prologue(p, lds); SYNC(); PSTOP(0); }
    if (PH(1)) REP(1) { PSTART(1); const Params p = load_params(kp); phase_ln0(p); SYNC(); PSTOP(1); }
    for (int l = p_in.l_lo; l < l_hi; ++l) {
        const bool svc = (l == 0) && (G >= 256);
        if (PH(2)) REP(2) { PSTART(2);
            const Params p = load_params(kp);
            pg8::Gemm g{(const bf16_t*)(p.ws + WS_HA), (const bf16_t*)(p.ws + WS_WIN) + (size_t)l * INC * D, D};
            pg8::EpiBf16 E{(bf16_t*)(p.ws + WS_PROJ), INC};
            if (svc) {
                if (c < 240) {
                    pg8::DenseOrder<32, 30> S; S.init(INP8(0) ? D : 2 * D, 240, c);
                    if (INP8(0)) pg8::gemm_phase<pg8::EpiBf16, pg8::DenseOrder<32, 30>, true>(lds, g, S, E, 121, 127);
                    else pg8::gemm_phase(lds, g, S, E);
                } else ada_chunks(p, lds, 128 + (c - 240), 256, 16);
                tail_pull(p, lds, l * 4 + 0);
            } else {
                pg8::DenseOrder<32, 32> S; S.init(INP8(l) ? D : 2 * D, G, c);
                if (INP8(l)) pg8::gemm_phase<pg8::EpiBf16, pg8::DenseOrder<32, 32>, true>(lds, g, S, E, 121, 127);
                else pg8::gemm_phase(lds, g, S, E);
            }
            SYNC(); PSTOP(2);
        }
#ifdef MIXER_CHECK
        if (PH(3)) REP(3) { PSTART(3); const Params p = load_params(kp); phase_mixer_valu(p, l, lds); SYNC(); PSTOP(3); }
        if (PH(3)) REP(3) { PSTART(3); const Params p = load_params(kp); phase_mixer_mfma<0>(p, l, lds, (float*)(p.ws + WS_XE)); SYNC(); PSTOP(3); }
        if (PH(3)) REP(3) { PSTART(3); const Params p = load_params(kp); phase_mixer_check(p, (const float*)(p.ws + WS_OBUF), (const float*)(p.ws + WS_XE), (float*)(p.ws + WS_CNT + 1024) + l * 8); SYNC(); PSTOP(3); }
#else
        if (PH(3)) REP(3) { PSTART(3);
            const Params p = load_params(kp);
            const int n_extra = svc ? 96 : 32, pn0 = svc ? 30 : 32;
            for (int uu = (G >= 224 ? c - 192 : c); uu >= 0 && uu < n_extra; uu += (G >= 224 ? 64 : G)) {
                const int RBI = INP8(l) ? D : 2 * D;
                pg8::OneUnit S; S.u0.aB = (size_t)(uu & 31) * 256 * RBI; S.u0.bB = (size_t)(pn0 + (uu >> 5)) * 256 * RBI; S.u0.row0 = (uu & 31) * 256; S.u0.col0 = (pn0 + (uu >> 5)) * 256;
                pg8::EpiBf16 E{(bf16_t*)(p.ws + WS_PROJ), INC};
                pg8::Gemm g{(const bf16_t*)(p.ws + WS_HA), (const bf16_t*)(p.ws + WS_WIN) + (size_t)l * INC * D, D};
                if (INP8(l)) pg8::gemm_phase<pg8::EpiBf16, pg8::OneUnit, true>(lds, g, S, E, 121, 127);
                else pg8::gemm_phase(lds, g, S, E);
            }
            phase_mixer_mfma<0>(p, l, lds, (float*)(p.ws + WS_OBUF));
            tail_pull(p, lds, l * 4 + 1);
            SYNC(); PSTOP(3);
#ifdef MIXER_PROBE
            phase_mixer_mfma<MIXER_PROBE>(p, l, lds, (float*)(p.ws + WS_XE));
            SYNC(); PSTOP(3);
#endif
        }
#endif
        if (PH(4)) REP(4) { PSTART(4); const Params p = load_params(kp); phase_finalize(p, l); SYNC(); PSTOP(4); }
        if (PH(5)) REP(5) { PSTART(5);
            const Params p = load_params(kp);
            pg8::DenseOrder<32, 8> S; S.init(OUT8(l) ? D : 2 * D, G, c);
            pg8::Gemm g{(const bf16_t*)(p.ws + WS_MIXED), (const bf16_t*)(p.ws + WS_WOUT) + (size_t)l * D * D, D};
            pg8::EpiBf16 E{(bf16_t*)(p.ws + WS_Y), D};
            if (OUT8(l)) pg8::gemm_phase<pg8::EpiBf16, pg8::DenseOrder<32, 8>, true>(lds, g, S, E, 121, 125);
            else pg8::gemm_phase(lds, g, S, E);
            SYNC(); PSTOP(5);
        }
        if (PH(6)) REP(6) { PSTART(6); const Params p = load_params(kp); phase_ln1_router(p, l, lds); SYNC(); PSTOP(6); }
        if (PH(7)) REP(7) { PSTART(7); const Params p = load_params(kp); phase_permute(p, l, tab); cvt_pull(p, lds, l * CV_PER_L + CV_A1, nullptr, 0u); SYNC(); PSTOP(7); }
        if (PH(8)) REP(8) { PSTART(8);
            const Params p = load_params(kp);
            build_moe_tab(p, l, tab);
#if MOE_FP8
            pg8::MoeOrder S; S.tab = tab; S.NTn = 11; S.G = G; S.c = c; S.tstep = (size_t)256 * D; S.bexp = (size_t)2 * DE * D;
            pg8::Gemm g{(const bf16_t*)(p.ws + WS_XE), (const bf16_t*)(p.ws + WS_WGU + (size_t)l * NE * 2 * DE * D), D};
            pg8::EpiHidden8 E{p.ws + WS_HID};
            QSTART(8, 1); pg8::gemm_phase<pg8::EpiHidden8, pg8::MoeOrder, true>(lds, g, S, E, 121, 127); QSTOP(8, 1);
#else
            pg8::MoeOrder S; S.tab = tab; S.NTn = 11; S.G = G; S.c = c; S.tstep = (size_t)256 * D * 2; S.bexp = (size_t)2 * DE * D * 2;
            pg8::Gemm g{(const bf16_t*)(p.ws + WS_XE), (const bf16_t*)(p.ws + WS_WGU) + (size_t)l * NE * 2 * DE * D, D};
            pg8::EpiHidden E{(bf16_t*)(p.ws + WS_HID)};
            pg8::gemm_phase(lds, g, S, E);
#endif
            QSTART(8, 2); tail_pull(p, lds, l * 4 + 2); QSTOP(8, 2);
            QSTART(8, 3); cvt_pull(p, lds, (l + 1) * CV_PER_L, nullptr, 0u); QSTOP(8, 3);
            SYNC(); PSTOP(8);
        }
        if (PH(9)) REP(9) { PSTART(9);
            const Params p = load_params(kp);
            build_moe_tab(p, l, tab);
#if MOE_FP8
            pg8::MoeOrder S; S.tab = tab; S.NTn = 8; S.G = G; S.c = c; S.tstep = (size_t)256 * DEP; S.bexp = (size_t)D * DEP;
            pg8::Gemm g{(const bf16_t*)(p.ws + WS_HID), (const bf16_t*)(p.ws + WS_WD + (size_t)l * NE * D * DEP), DEP};
            pg8::EpiBf16 E{(bf16_t*)(p.ws + WS_YE), D};
            QSTART(9, 1); pg8::gemm_phase<pg8::EpiBf16, pg8::MoeOrder, true>(lds, g, S, E, 121, 124); QSTOP(9, 1);
#else
            pg8::MoeOrder S; S.tab = tab; S.NTn = 8; S.G = G; S.c = c; S.tstep = (size_t)256 * DE * 2; S.bexp = (size_t)D * DE * 2;
            pg8::Gemm g{(const bf16_t*)(p.ws + WS_HID), (const bf16_t*)(p.ws + WS_WD) + (size_t)l * NE * D * DE, DE};
            pg8::EpiBf16 E{(bf16_t*)(p.ws + WS_YE), D};
            pg8::gemm_phase(lds, g, S, E);
#endif
            QSTART(9, 2); tail_pull(p, lds, l * 4 + 3); QSTOP(9, 2);
            QSTART(9, 3); if (l + 1 < DEPTH) cvt_pull(p, lds, (l + 1) * CV_PER_L + CV_A0, nullptr, 0u); QSTOP(9, 3);
            SYNC(); PSTOP(9);
        }
        if (PH(10)) REP(10) { PSTART(10); const Params p = load_params(kp); phase_ln2(p, l); SYNC(); PSTOP(10); }
    }
#ifdef PROBE_PH
    if (blockIdx.x == 0 && threadIdx.x == 0) {
#ifdef PROBE_SUB
        const unsigned long long t = 0ull, t0 = __builtin_amdgcn_s_memrealtime();
#else
        const unsigned long long t = *(LAS unsigned long long*)(lds + LDS_MISC + 776) * 4ull, t0 = __builtin_amdgcn_s_memrealtime();
#endif
        while (__builtin_amdgcn_s_memrealtime() - t0 < t) __builtin_amdgcn_s_sleep(8);
    }
#ifdef PROBE_SUB
    if (blockIdx.x == PROBE_WG && threadIdx.x == 0) {
        const unsigned long long t = *(LAS unsigned long long*)(lds + LDS_MISC + 792) * 4ull, t0 = __builtin_amdgcn_s_memrealtime();
        while (__builtin_amdgcn_s_memrealtime() - t0 < t) __builtin_amdgcn_s_sleep(8);
    }
#endif
#endif
}

#ifndef MK_FUSED
#define MK_FUSED 1
#endif
extern "C" void kernel_launch(void* const* d_in, const int* in_sizes, int n_in, void* d_out, int out_size, void* d_ws, size_t ws_size, hipStream_t stream) {
    static int grid = 0;
    if (grid == 0) {
        if (n_in != 18 || ws_size < WS_END) { fprintf(stderr, "kernel_launch: unexpected n_in %d or ws_size %zu (< %zu)\n", n_in, ws_size, (size_t)WS_END); grid = -1; return; }
        int dev = 0, cus = 0, per_cu = 0;
        hipGetDevice(&dev);
        hipDeviceGetAttribute(&cus, hipDeviceAttributeMultiprocessorCount, dev);
        if (hipFuncSetAttribute((const void*)mega, hipFuncAttributeMaxDynamicSharedMemorySize, LDS_BYTES) != hipSuccess) { fprintf(stderr, "kernel_launch: hipFuncSetAttribute failed\n"); grid = -1; return; }
        hipOccupancyMaxActiveBlocksPerMultiprocessor(&per_cu, (const void*)mega, 512, LDS_BYTES);
        if (per_cu < 1) fprintf(stderr, "kernel_launch: occupancy query says %d\n", per_cu);
        grid = cus > 0 ? cus : 256;
    }
    if (grid < 0) return;
    hipMemsetAsync(d_ws, 0, WS_ZERO_BYTES, stream);
    Params p{};
    p.x = (const float*)d_in[0]; p.c = (const float*)d_in[1]; p.emb_g = (const float*)d_in[2]; p.emb_b = (const float*)d_in[3];
    p.w_ada = (const float*)d_in[4]; p.b_ada = (const float*)d_in[5]; p.w_in = (const float*)d_in[6]; p.conv_w = (const float*)d_in[7];
    p.mix_beta = (const float*)d_in[8]; p.w_out = (const float*)d_in[9]; p.lb_logits = (const float*)d_in[10]; p.ln_g = (const float*)d_in[11];
    p.ln_b = (const float*)d_in[12]; p.w_router = (const float*)d_in[13]; p.router_bias = (const float*)d_in[14]; p.w_gate = (const float*)d_in[15];
    p.w_up = (const float*)d_in[16]; p.w_down = (const float*)d_in[17];
    p.out = (float*)d_out; p.ws = (unsigned char*)d_ws; p.pad = 0;
#if MK_FUSED
    p.ph_lo = 0; p.ph_hi = 11; p.l_lo = 0; p.l_hi = DEPTH; p.fused = 1;
    hipLaunchKernelGGL(mega, dim3(grid), dim3(512), LDS_BYTES, stream, p);
#else
    p.fused = 0;
    for (int ph = 0; ph < 2; ++ph) { p.ph_lo = ph; p.ph_hi = ph + 1; p.l_lo = 0; p.l_hi = 0; hipLaunchKernelGGL(mega, dim3(grid), dim3(512), LDS_BYTES, stream, p); }
    for (int l = 0; l < DEPTH; ++l)
        for (int ph = 2; ph < 11; ++ph) { p.ph_lo = ph; p.ph_hi = ph + 1; p.l_lo = l; p.l_hi = l + 1; hipLaunchKernelGGL(mega, dim3(grid), dim3(512), LDS_BYTES, stream, p); }
#endif
}
```

```cpp
#include <hip/hip_runtime.h>
#include <stdint.h>
#include <stdio.h>

#define LAS __attribute__((address_space(3)))
typedef unsigned short bf16_t;
typedef short bf16x8 __attribute__((ext_vector_type(8)));
typedef float f32x4 __attribute__((ext_vector_type(4)));
typedef unsigned u32x4 __attribute__((ext_vector_type(4)));
typedef unsigned u32x2 __attribute__((ext_vector_type(2)));

constexpr int D = 2048, NB = 4, SEQ = 2048, T = NB * SEQ, DEPTH = 2;
constexpr int CW = 512, RW = 768, HWD = 768, INC = 8448;
constexpr int NE = 16, DE = 1408;
constexpr int C_CB = 0, C_CC = 512, C_CH = 1024, C_RQ = 1536, C_RK = 2304, C_RV = 3072, C_RG = 3840, C_HQ = 4608, C_HFF = 5376, C_HFB = 6144, C_HI = 6912, C_HG = 7680;
constexpr int XE_ROWS = 20480;
#ifndef MOE_FP8
#define MOE_FP8 1
#endif
#ifndef INP_FP8_FROM
#define INP_FP8_FROM 1
#endif
#define INP8(l) ((l) >= INP_FP8_FROM)
#ifndef OUT_FP8_FROM
#define OUT_FP8_FROM 1
#endif
#define OUT8(l) ((l) >= OUT_FP8_FROM)
constexpr int DEP = 1536;
constexpr float W8_SCALE = 64.f, H8_SCALE = 8.f;
constexpr float ALPHA = 1.4142135623730951f;

constexpr size_t WS_BAR = 0;
constexpr size_t WS_CNT = 16384;
constexpr size_t WS_CVTQ = 20480;
constexpr size_t WS_ZERO_BYTES = 32768;
constexpr size_t WS_MOD = 32768;
constexpr size_t WS_ROUTE = WS_MOD + 393216;
constexpr size_t WS_WGCNT = WS_ROUTE + 262144;
constexpr size_t WS_WIN = 1048576;
constexpr size_t SZ_WIN = (size_t)DEPTH * INC * D * 2;
constexpr size_t WS_WOUT = WS_WIN + SZ_WIN;
constexpr size_t SZ_WOUT = (size_t)DEPTH * D * D * 2;
constexpr size_t WS_WGU = WS_WOUT + SZ_WOUT;
constexpr size_t SZ_WGU = (size_t)DEPTH * NE * 2 * DE * D * 2;
constexpr size_t WS_WD = WS_WGU + SZ_WGU;
constexpr size_t SZ_WD = (size_t)DEPTH * NE * D * DE * 2;
constexpr size_t WS_XRES = WS_WD + SZ_WD;
constexpr size_t SZ_XRES = (size_t)T * D * 4;
constexpr size_t WS_HA = WS_XRES + SZ_XRES;
constexpr size_t SZ_H = (size_t)T * D * 2;
constexpr size_t WS_HB = WS_HA + SZ_H;
constexpr size_t WS_PROJ = WS_HB + SZ_H;
constexpr size_t SZ_PROJ = (size_t)T * INC * 2;
constexpr size_t WS_OBUF = WS_PROJ + SZ_PROJ;
constexpr size_t SZ_OBUF = (size_t)2 * T * 1536 * 4;
constexpr size_t WS_YE = WS_PROJ;
constexpr size_t SZ_YE = (size_t)XE_ROWS * D * 4;
static_assert(SZ_YE <= SZ_PROJ + SZ_OBUF, "ye alias");
constexpr size_t WS_MIXED = WS_OBUF + SZ_OBUF;
constexpr size_t WS_Y = WS_MIXED + SZ_H;
constexpr size_t SZ_Y = (size_t)T * D * 4;
constexpr size_t WS_XE = WS_Y + SZ_Y;
constexpr size_t SZ_XE = (size_t)XE_ROWS * D * 2;
constexpr size_t WS_HID = WS_XE + SZ_XE;
constexpr size_t SZ_HID = (size_t)XE_ROWS * DE * 2;
constexpr size_t WS_END = WS_HID + SZ_HID;

constexpr int LDS_BYTES = 156672;
constexpr int LDS_MISC = 153600;

struct Params {
    const float *x, *c, *emb_g, *emb_b, *w_ada, *b_ada, *w_in, *conv_w, *mix_beta, *w_out, *lb_logits, *ln_g, *ln_b, *w_router, *router_bias, *w_gate, *w_up, *w_down;
    float* out;
    unsigned char* ws;
    int ph_lo, ph_hi, l_lo, l_hi, fused, pad;
};

__device__ __forceinline__ float bf2f(unsigned b) { return __uint_as_float(b << 16); }
__device__ __forceinline__ unsigned f2bf(float f) { unsigned u = __float_as_uint(f); u += 0x7FFFu + ((u >> 16) & 1u); return u >> 16; }
typedef __bf16 bf16x2_t __attribute__((ext_vector_type(2)));
typedef float f32x2_t __attribute__((ext_vector_type(2)));
__device__ __forceinline__ unsigned pack2a(float lo, float hi) { unsigned r; asm("v_cvt_pk_bf16_f32 %0, %1, %2" : "=v"(r) : "v"(lo), "v"(hi)); return r; }
__device__ __forceinline__ unsigned pack2(float lo, float hi) { const bf16x2_t r = __builtin_convertvector((f32x2_t){lo, hi}, bf16x2_t); return __builtin_bit_cast(unsigned, r); }
__device__ __forceinline__ float wave_sum(float v) {
#pragma unroll
    for (int o = 32; o > 0; o >>= 1) v += __shfl_xor(v, o, 64);
    return v;
}
__device__ __forceinline__ float half_sum(float v) {
#pragma unroll
    for (int o = 16; o > 0; o >>= 1) v += __shfl_xor(v, o, 64);
    return v;
}
#define LDS_BARRIER() do { asm volatile("s_waitcnt lgkmcnt(0)" ::: "memory"); __builtin_amdgcn_s_barrier(); asm volatile("" ::: "memory"); } while (0)
__device__ __forceinline__ float sigmoidf_(float z) { return 1.0f / (1.0f + __expf(-z)); }
__device__ __forceinline__ float siluf_(float z) { return z / (1.0f + __expf(-z)); }

#define XB_TMO      128
#define XB_XCNT(j)  (256  + 64 * (j))
#define XB_XSUB(j)  (1280 + 64 * (j))
#define XB_XGEN(j)  (2304 + 64 * (j))
#define XB_TOP      3328
#define XB_TOPGEN   3392
#define XCD_BAR_WORDS 3456
#define XB_SPIN_CAP (1u << 22)
__device__ __forceinline__ unsigned xb_ld(unsigned* p)              { return __hip_atomic_load(p, __ATOMIC_RELAXED, __HIP_MEMORY_SCOPE_AGENT); }
__device__ __forceinline__ unsigned xb_add(unsigned* p, unsigned v) { return __hip_atomic_fetch_add(p, v, __ATOMIC_RELAXED, __HIP_MEMORY_SCOPE_AGENT); }
__device__ __forceinline__ unsigned xb_xcc_id() { return (unsigned)__builtin_amdgcn_s_getreg((3 << 11) | 20) & 0xFu; }
#define XB_SPIN(cond, bar) do { unsigned _sp = 0; while (cond) { __builtin_amdgcn_s_sleep(1); \
    if ((++_sp & 255u) == 0u) { if (xb_ld(&(bar)[XB_TMO])) break; if (_sp > XB_SPIN_CAP) { atomicAdd(&(bar)[XB_TMO], 1u); break; } } } } while (0)
struct XcdBarrier { unsigned* bar; unsigned x; volatile LAS unsigned* st; };
__device__ __forceinline__ XcdBarrier xcd_barrier_post(unsigned* bar, volatile LAS unsigned* st) {
    XcdBarrier b; b.bar = bar; b.x = xb_xcc_id(); b.st = st;
    if (threadIdx.x == 0) (void)xb_add(&bar[XB_XCNT(b.x)], 1u);
    return b;
}
__device__ __forceinline__ void xcd_barrier_complete(unsigned* bar, unsigned x, unsigned& nloc, unsigned& nx) {
    const unsigned G = gridDim.x * gridDim.y * gridDim.z;
    unsigned sum, cnt, mine, sp = 0u;
    for (;;) {
        sum = 0u; cnt = 0u; mine = 0u;
#pragma unroll
        for (unsigned j = 0; j < 16; ++j) { const unsigned c = xb_ld(&bar[XB_XCNT(j)]); sum += c; cnt += (c > 0u) ? 1u : 0u; mine = (j == x) ? c : mine; }
        if (sum == G) break;
        __builtin_amdgcn_s_sleep(1);
        if ((++sp & 255u) == 0u) { if (xb_ld(&bar[XB_TMO])) break; if (sp > XB_SPIN_CAP) { atomicAdd(&bar[XB_TMO], 1u); break; } }
    }
    nloc = mine > 0u ? mine : 1u; nx = cnt > 0u ? cnt : 1u;
}
__device__ __forceinline__ void xcd_barrier(const XcdBarrier& b) {
    asm volatile("s_waitcnt vmcnt(0)" ::: "memory");
    __syncthreads();
    if (threadIdx.x == 0) {
        unsigned* bar = b.bar;
        __builtin_amdgcn_s_waitcnt(0);
        unsigned nloc = b.st[0], nx = b.st[1];
        if (nloc == 0u) { xcd_barrier_complete(bar, b.x, nloc, nx); b.st[0] = nloc; b.st[1] = nx; }
        const unsigned old = xb_add(&bar[XB_XSUB(b.x)], 1u);
        const unsigned gen = old / nloc;
        if (old + 1u == (gen + 1u) * nloc) {
            __builtin_amdgcn_fence(__ATOMIC_RELEASE, "agent");
            asm volatile("s_waitcnt vmcnt(0)" ::: "memory");
            const unsigned og = xb_add(&bar[XB_TOP], 1u);
            const unsigned tg = og / nx;
            if (og + 1u == (tg + 1u) * nx) xb_add(&bar[XB_TOPGEN], 1u);
            else XB_SPIN(xb_ld(&bar[XB_TOPGEN]) == tg, bar);
            __builtin_amdgcn_fence(__ATOMIC_ACQUIRE, "agent");
            xb_add(&bar[XB_XGEN(b.x)], 1u);
            asm volatile("s_waitcnt vmcnt(0)" ::: "memory");
        } else {
            XB_SPIN(xb_ld(&bar[XB_XGEN(b.x)]) == gen, bar);
            __builtin_amdgcn_fence(__ATOMIC_ACQUIRE, "agent");
            asm volatile("s_waitcnt vmcnt(0)" ::: "memory");
        }
    }
    __syncthreads();
}

namespace pg8 {
constexpr int BM = 256, BK = 64, HALF = 128, HTB = HALF * BK * 2, STAGE_BYTES = 8 * HTB, NXCD = 8, WGM = 8;
__host__ __device__ __forceinline__ int lds_byte(int r, int c) { const int st = (r >> 4) * 2 + (c >> 5), rr = r & 15, cc = c & 31, ob = rr * 64 + cc * 2; return st * 1024 + (ob ^ (((ob >> 9) & 1) << 5)); }
__host__ __device__ __forceinline__ void stage_rc(int b, int& R, int& C) { const int st = b / 1024, sb = b % 1024, swz = sb ^ (((sb >> 9) & 1) << 5); R = (st >> 1) * 16 + swz / 64; C = (st & 1) * 32 + (swz % 64) / 2; }
__host__ __device__ __forceinline__ int perm32(int rho) { const int n = rho >> 4, i = rho & 15; return 8 * (i >> 2) + 4 * n + (i & 3); }

struct Unit { size_t aB, bB; int row0, col0; };
struct Gemm { const bf16_t* A; const bf16_t* Bt; int K; };

template <int NM, int NN>
struct DenseOrder {
    int G, c; size_t tstep;
    __device__ void init(int rowbytes, int G_, int c_) { G = G_; c = c_; tstep = (size_t)BM * rowbytes; }
    __device__ bool next(int i, Unit& u) const {
        constexpr int nwg = NM * NN, q = nwg / NXCD, r = nwg % NXCD, nig = WGM * NN;
        static_assert(NM % WGM == 0, "row tiles come in groups of 8");
        const int L = __builtin_amdgcn_readfirstlane(i * G + c); if (L >= nwg) return false;
        const int xcd = L % NXCD, off = L / NXCD;
        const int wgid = (xcd < r ? xcd * (q + 1) : r * (q + 1) + (xcd - r) * q) + off;
        const int gid = wgid / nig, fm = gid * WGM, rem = wgid % nig;
        const int pm = fm + (rem % WGM), pn = rem / WGM;
        u.aB = (size_t)pm * tstep; u.bB = (size_t)pn * tstep; u.row0 = pm * BM; u.col0 = pn * BM; return true;
    }
};
struct OneUnit {
    Unit u0;
    __device__ bool next(int i, Unit& u) const { if (i > 0) return false; u = u0; return true; }
};
struct MoeOrder {
    const LAS int* tab; int NTn, G, c; size_t tstep, bexp;
    __device__ bool next(int i, Unit& u) const {
        const int MT = tab[16], U = MT * NTn, nx = G >> 3;
        int f;
        if ((G & 7) == 0) { const int per = (U + 7) >> 3, x = c & 7, j = c >> 3, loc = i * nx + j; f = x * per + loc; if (loc >= per || f >= U) return false; }
        else { f = i * G + c; if (f >= U) return false; }
        int e = 0;
#pragma unroll
        for (int j = 1; j < 16; ++j) e += (f >= tab[j] * NTn) ? 1 : 0;
        const int t0 = tab[e], te = tab[e + 1] - t0, r = f - t0 * NTn;
        const int nt = r / te, mt = t0 + (r - nt * te);
        u.aB = (size_t)mt * tstep; u.bB = (size_t)e * bexp + (size_t)nt * tstep; u.row0 = mt * BM; u.col0 = nt * BM; return true;
    }
};

__device__ __forceinline__ size_t rfl64(size_t v) { const unsigned lo = (unsigned)__builtin_amdgcn_readfirstlane((int)(unsigned)v), hi = (unsigned)__builtin_amdgcn_readfirstlane((int)(unsigned)(v >> 32)); return ((size_t)hi << 32) | lo; }
__device__ __forceinline__ void uniformize(Unit& u) { u.aB = rfl64(u.aB); u.bB = rfl64(u.bB); u.row0 = __builtin_amdgcn_readfirstlane(u.row0); u.col0 = __builtin_amdgcn_readfirstlane(u.col0); }
__device__ __forceinline__ unsigned cvt_pk_bf16(float lo, float hi) { unsigned r; asm volatile("v_cvt_pk_bf16_f32 %0, %1, %2" : "=v"(r) : "v"(lo), "v"(hi)); return r; }

struct EpiF32 {
    static constexpr bool PERM = false;
    float* C; int ldc;
    __device__ __forceinline__ void operator()(const f32x4 (&acc)[2][2][4][2], const Unit& u, int wr, int wc, int fr, int fq) const {
        const int row0 = u.row0 + wr * 64 + fr, col0 = u.col0 + wc * 32 + 4 * fq;
#pragma unroll
        for (int ai = 0; ai < 2; ++ai)
#pragma unroll
            for (int m = 0; m < 4; ++m) { float* rowp = C + (size_t)(row0 + ai * HALF + m * 16) * ldc + col0;
#pragma unroll
                for (int bj = 0; bj < 2; ++bj)
#pragma unroll
                    for (int n = 0; n < 2; ++n) *(f32x4*)(rowp + bj * HALF + n * 16) = acc[ai][bj][m][n]; }
    }
};
struct EpiBf16 {
    static constexpr bool PERM = true;
    bf16_t* O; int ldc;
    __device__ __forceinline__ void operator()(const f32x4 (&acc)[2][2][4][2], const Unit& u, int wr, int wc, int fr, int fq) const {
        const int row0 = u.row0 + wr * 64 + fr, col0 = u.col0 + wc * 32 + 8 * fq;
#pragma unroll
        for (int ai = 0; ai < 2; ++ai)
#pragma unroll
            for (int m = 0; m < 4; ++m) { bf16_t* rowp = O + (size_t)(row0 + ai * HALF + m * 16) * ldc + col0;
#pragma unroll
                for (int bj = 0; bj < 2; ++bj) { const f32x4 v0 = acc[ai][bj][m][0], v1 = acc[ai][bj][m][1];
                    u32x4 o; o[0] = cvt_pk_bf16(v0[0], v0[1]); o[1] = cvt_pk_bf16(v0[2], v0[3]); o[2] = cvt_pk_bf16(v1[0], v1[1]); o[3] = cvt_pk_bf16(v1[2], v1[3]);
                    *(u32x4*)(rowp + bj * HALF) = o; } }
    }
};
struct EpiHidden {
    static constexpr bool PERM = true;
    bf16_t* O;
    __device__ __forceinline__ void operator()(const f32x4 (&acc)[2][2][4][2], const Unit& u, int wr, int wc, int fr, int fq) const {
        const int row0 = u.row0 + wr * 64 + fr, col0 = (u.col0 >> 1) + wc * 32 + 8 * fq;
#pragma unroll
        for (int ai = 0; ai < 2; ++ai)
#pragma unroll
            for (int m = 0; m < 4; ++m) { bf16_t* rowp = O + (size_t)(row0 + ai * HALF + m * 16) * DE + col0;
                float h[8];
#pragma unroll
                for (int n = 0; n < 2; ++n)
#pragma unroll
                    for (int j = 0; j < 4; ++j) { const float g = acc[ai][0][m][n][j], up = acc[ai][1][m][n][j]; h[n * 4 + j] = g * __builtin_amdgcn_rcpf(1.0f + __expf(-g)) * up; }
                u32x4 o; o[0] = cvt_pk_bf16(h[0], h[1]); o[1] = cvt_pk_bf16(h[2], h[3]); o[2] = cvt_pk_bf16(h[4], h[5]); o[3] = cvt_pk_bf16(h[6], h[7]);
                *(u32x4*)rowp = o; }
    }
};

typedef int v8i32 __attribute__((ext_vector_type(8)));
typedef int v4i32 __attribute__((ext_vector_type(4)));
struct EpiHidden8 {
    static constexpr bool PERM = true;
    unsigned char* O;
    __device__ __forceinline__ void operator()(const f32x4 (&acc)[2][2][4][2], const Unit& u, int wr, int wc, int fr, int fq) const {
        const int row0 = u.row0 + wr * 64 + fr, col0 = (u.col0 >> 1) + wc * 32 + 8 * fq;
#pragma unroll
        for (int ai = 0; ai < 2; ++ai)
#pragma unroll
            for (int m = 0; m < 4; ++m) { unsigned char* rowp = O + (size_t)(row0 + ai * HALF + m * 16) * DEP + col0;
                float h[8];
#pragma unroll
                for (int n = 0; n < 2; ++n)
#pragma unroll
                    for (int j = 0; j < 4; ++j) { const float g = acc[ai][0][m][n][j], up = acc[ai][1][m][n][j]; h[n * 4 + j] = g * __builtin_amdgcn_rcpf(1.0f + __expf(-g)) * up * H8_SCALE; }
                int o0 = __builtin_amdgcn_cvt_pk_fp8_f32(h[0], h[1], 0, false); o0 = __builtin_amdgcn_cvt_pk_fp8_f32(h[2], h[3], o0, true);
                int o1 = __builtin_amdgcn_cvt_pk_fp8_f32(h[4], h[5], 0, false); o1 = __builtin_amdgcn_cvt_pk_fp8_f32(h[6], h[7], o1, true);
                u32x2 o; o[0] = (unsigned)o0; o[1] = (unsigned)o1;
                *(u32x2*)rowp = o; }
    }
};
template <class Epi, class Sched, bool FP8 = false>
__device__ __forceinline__ void gemm_phase(LAS unsigned char* lds, const Gemm g, const Sched& S, const Epi& E, int sclW = 127, int sclA = 127) {
    int tid = threadIdx.x; asm volatile("" : "+v"(tid)); const int wid = __builtin_amdgcn_readfirstlane(tid >> 6), lane = tid & 63, wr = wid >> 2, wc = wid & 3, fr = lane & 15, fq = lane >> 4;
    const int K = g.K, rowb = FP8 ? K : 2 * K, nt = rowb / 128;
    int sclWv = sclW, sclAv = sclA; asm volatile("" : "+v"(sclWv), "+v"(sclAv));
    unsigned voffA[2], voffB[2];
#pragma unroll
    for (int i = 0; i < 2; ++i) { int R, C; stage_rc(tid * 16 + i * 8192, R, C); const int Rb = Epi::PERM ? ((R & ~31) + perm32(R & 31)) : R;
        voffA[i] = (unsigned)(R * rowb + 2 * C); voffB[i] = (unsigned)(Rb * rowb + 2 * C); }
    const size_t kstep = 128;
    const size_t hstep = (size_t)HALF * rowb;
    const unsigned ldsw = (unsigned)wid * 1024u;
    const int aoff = lds_byte(wr * 64 + fr, fq * 8), boff = lds_byte(wc * 32 + fr, fq * 8);
    constexpr int P2 = 1024;
#define PG8_SA(b, h) (((b) * 2 + (h)) * HTB)
#define PG8_SB(b, h) ((4 + (b) * 2 + (h)) * HTB)
#define PG8_STAGE(bufoff, gbase, voff) do { _Pragma("unroll") for (int _i = 0; _i < 2; ++_i) \
        __builtin_amdgcn_global_load_lds((const unsigned*)((const char*)(gbase) + (voff)[_i]), (LAS unsigned*)(lds + (bufoff) + ldsw + _i * 8192), 16, 0, 0); } while (0)
#define PG8_LDA(dst, b, h) do { _Pragma("unroll") for (int m = 0; m < 4; ++m) { \
        const v4i32 _l = *(const LAS v4i32*)(lds + PG8_SA(b, h) + aoff + m * 2048), _h = *(const LAS v4i32*)(lds + PG8_SA(b, h) + aoff + P2 + m * 2048); \
        dst[m] = __builtin_shufflevector(_l, _h, 0, 1, 2, 3, 4, 5, 6, 7); } } while (0)
#define PG8_LDB(dst, b, h) do { _Pragma("unroll") for (int n = 0; n < 2; ++n) { \
        const v4i32 _l = *(const LAS v4i32*)(lds + PG8_SB(b, h) + boff + n * 2048), _h = *(const LAS v4i32*)(lds + PG8_SB(b, h) + boff + P2 + n * 2048); \
        dst[n] = __builtin_shufflevector(_l, _h, 0, 1, 2, 3, 4, 5, 6, 7); } } while (0)
#define PG8_MMA(ai, bj, At, Bt) do { __builtin_amdgcn_s_setprio(1); _Pragma("unroll") for (int m = 0; m < 4; ++m) _Pragma("unroll") for (int n = 0; n < 2; ++n) { \
        if constexpr (FP8) { \
            asm volatile("v_mfma_scale_f32_16x16x128_f8f6f4 %0, %1, %2, %0, %3, %4 op_sel_hi:[0,0,0]" : "+v"(acc[ai][bj][m][n]) : "v"(Bt[n]), "v"(At[m]), "v"(sclWv), "v"(sclAv)); \
        } else { \
            acc[ai][bj][m][n] = __builtin_amdgcn_mfma_f32_16x16x32_bf16(__builtin_bit_cast(bf16x8, __builtin_shufflevector(Bt[n], Bt[n], 0, 1, 2, 3)), __builtin_bit_cast(bf16x8, __builtin_shufflevector(At[m], At[m], 0, 1, 2, 3)), acc[ai][bj][m][n], 0, 0, 0); \
            acc[ai][bj][m][n] = __builtin_amdgcn_mfma_f32_16x16x32_bf16(__builtin_bit_cast(bf16x8, __builtin_shufflevector(Bt[n], Bt[n], 4, 5, 6, 7)), __builtin_bit_cast(bf16x8, __builtin_shufflevector(At[m], At[m], 4, 5, 6, 7)), acc[ai][bj][m][n], 0, 0, 0); } } \
        __builtin_amdgcn_s_setprio(0); } while (0)
#define PG8_WAIT_V(n) asm volatile("s_waitcnt vmcnt(" #n ")" ::: "memory")
#define PG8_WAIT_L(n) asm volatile("s_waitcnt lgkmcnt(" #n ")" ::: "memory")
#define PG8_BAR __builtin_amdgcn_s_barrier()
#define PG8_SCHED __builtin_amdgcn_sched_barrier(0)
    Unit cur, nxt; int ui = 0;
    if (!S.next(0, cur)) return;
    uniformize(cur);
    f32x4 acc[2][2][4][2];
#pragma unroll
    for (int a = 0; a < 2; ++a)
#pragma unroll
        for (int b = 0; b < 2; ++b)
#pragma unroll
            for (int m = 0; m < 4; ++m)
#pragma unroll
                for (int n = 0; n < 2; ++n) acc[a][b][m][n] = (f32x4){0.f, 0.f, 0.f, 0.f};
    v8i32 At[4], B0[2], B1[2];
    const char* cA = (const char*)g.A + cur.aB; const char* cB = (const char*)g.Bt + cur.bB;
    PG8_STAGE(PG8_SB(0, 0), cB, voffB); PG8_STAGE(PG8_SA(0, 0), cA, voffA); PG8_STAGE(PG8_SB(0, 1), cB + hstep, voffB); PG8_STAGE(PG8_SA(0, 1), cA + hstep, voffA);
    if (wr == 1) PG8_BAR;
    PG8_WAIT_V(4); PG8_BAR;
    PG8_STAGE(PG8_SB(1, 0), cB + kstep, voffB); PG8_STAGE(PG8_SA(1, 0), cA + kstep, voffA); PG8_STAGE(PG8_SB(1, 1), cB + hstep + kstep, voffB);
    PG8_WAIT_V(6); PG8_BAR;
    for (;;) {
        const bool has_next = S.next(ui + 1, nxt);
        uniformize(nxt);
        const char* nA = has_next ? (const char*)g.A + nxt.aB : cA; const char* nB = has_next ? (const char*)g.Bt + nxt.bB : cB;
        for (int t = 0; t < nt; t += 2) {
            const bool last = (t == nt - 2);
            const char* a1 = cA + (size_t)(t + 1) * kstep;
            const char* a2 = last ? nA : cA + (size_t)(t + 2) * kstep; const char* b2 = last ? nB : cB + (size_t)(t + 2) * kstep;
            const char* a3 = a2 + kstep; const char* b3 = b2 + kstep;
            PG8_LDB(B0, 0, 0); PG8_SCHED; PG8_LDA(At, 0, 0); PG8_STAGE(PG8_SA(1, 1), a1 + hstep, voffA);
            PG8_WAIT_L(8); PG8_BAR; PG8_WAIT_L(0); PG8_MMA(0, 0, At, B0); PG8_BAR; PG8_SCHED;
            PG8_LDB(B1, 0, 1); PG8_STAGE(PG8_SB(0, 0), b2, voffB);
            PG8_BAR; PG8_WAIT_L(0); PG8_MMA(0, 1, At, B1); PG8_BAR;
            PG8_LDA(At, 0, 1); PG8_STAGE(PG8_SA(0, 0), a2, voffA);
            PG8_BAR; PG8_WAIT_L(0); PG8_MMA(1, 0, At, B0); PG8_BAR; PG8_SCHED;
            PG8_STAGE(PG8_SB(0, 1), b2 + hstep, voffB);
            PG8_WAIT_V(6); PG8_BAR; PG8_MMA(1, 1, At, B1); PG8_BAR;
            PG8_LDB(B0, 1, 0); PG8_SCHED; PG8_LDA(At, 1, 0); PG8_STAGE(PG8_SA(0, 1), a2 + hstep, voffA);
            PG8_WAIT_L(8); PG8_BAR; PG8_WAIT_L(0); PG8_MMA(0, 0, At, B0); PG8_BAR; PG8_SCHED;
            PG8_LDB(B1, 1, 1); PG8_STAGE(PG8_SB(1, 0), b3, voffB);
            PG8_BAR; PG8_WAIT_L(0); PG8_MMA(0, 1, At, B1); PG8_BAR;
            PG8_LDA(At, 1, 1); PG8_STAGE(PG8_SA(1, 0), a3, voffA);
            PG8_BAR; PG8_WAIT_L(0); PG8_MMA(1, 0, At, B0); PG8_BAR; PG8_SCHED;
            PG8_STAGE(PG8_SB(1, 1), b3 + hstep, voffB);
            PG8_WAIT_V(6); PG8_BAR; PG8_MMA(1, 1, At, B1); PG8_BAR;
        }
        if constexpr (FP8) asm volatile("s_nop 15\n\ts_nop 15" ::: "memory");
        E(acc, cur, wr, wc, fr, fq);
        if (!has_next) break;
#pragma unroll
        for (int a = 0; a < 2; ++a)
#pragma unroll
            for (int b = 0; b < 2; ++b)
#pragma unroll
                for (int m = 0; m < 4; ++m)
#pragma unroll
                    for (int n = 0; n < 2; ++n) acc[a][b][m][n] = (f32x4){0.f, 0.f, 0.f, 0.f};
        cur = nxt; cA = nA; cB = nB; ++ui;
    }
    PG8_WAIT_V(0);
    if (wr == 0) PG8_BAR;
    PG8_BAR;
#undef PG8_SA
#undef PG8_SB
#undef PG8_STAGE
#undef PG8_LDA
#undef PG8_LDB
#undef PG8_MMA
#undef PG8_WAIT_V
#undef PG8_WAIT_L
#undef PG8_BAR
#undef PG8_SCHED
}
}

constexpr int S_IN = 16 * 66, S_OUT = 16 * 16, S_GU = 16 * 11, S_DN = 11 * 16;
constexpr int CV_PER_L = S_IN + S_OUT + NE * 2 * S_GU + NE * S_DN;
constexpr int CV_A0 = S_IN + S_OUT;
constexpr int CV_A1 = CV_A0 + NE * 2 * S_GU;
constexpr int CV_TOTAL = DEPTH * CV_PER_L;
constexpr int CV_LAST = 1 << 30;
struct StripDesc { const float* src; bf16_t* dst; int lds_, ldd, k0, n0, drow0, fp8; };
__device__ __forceinline__ StripDesc strip_desc(const Params& p, int si) {
    unsigned char* ws = p.ws; StripDesc d;
    const int l = si / CV_PER_L; int r = si - l * CV_PER_L;
    if (r < S_IN) {
        const int kt = r / 66, ntl = r % 66;
        d.src = p.w_in + (size_t)l * D * INC; d.lds_ = INC; d.fp8 = INP8(l) ? 1 : 0; d.dst = (bf16_t*)(ws + WS_WIN) + (size_t)l * INC * D; d.ldd = D; d.k0 = kt * 128; d.n0 = ntl * 128; d.drow0 = ntl * 128;
    } else if (r < CV_A0) {
        r -= S_IN; const int kt = r / 16, ntl = r % 16;
        d.src = p.w_out + (size_t)l * D * D; d.lds_ = D; d.dst = (bf16_t*)(ws + WS_WOUT) + (size_t)l * D * D; d.ldd = D; d.k0 = kt * 128; d.n0 = ntl * 128; d.drow0 = ntl * 128; d.fp8 = OUT8(l) ? 1 : 0;
    } else if (r < CV_A1) {
        r -= CV_A0; const int mat = r / S_GU, q = r % S_GU, kt = q / 11, ntl = q % 11;
        const int which = mat & 1, le = l * NE + (mat >> 1);
        d.src = (which ? p.w_up : p.w_gate) + (size_t)le * D * DE; d.lds_ = DE; d.fp8 = MOE_FP8; d.dst = MOE_FP8 ? (bf16_t*)(ws + WS_WGU + (size_t)le * (2 * DE) * D) : (bf16_t*)(ws + WS_WGU) + (size_t)le * (2 * DE) * D; d.ldd = D; d.k0 = kt * 128; d.n0 = ntl * 128; d.drow0 = ntl * 256 + which * 128;
    } else {
        r -= CV_A1; const int le = l * NE + r / S_DN, q = r % S_DN, kt = q / 16, ntl = q % 16;
        d.src = p.w_down + (size_t)le * DE * D; d.lds_ = D; d.fp8 = MOE_FP8; d.dst = MOE_FP8 ? (bf16_t*)(ws + WS_WD + (size_t)le * D * DEP) : (bf16_t*)(ws + WS_WD) + (size_t)le * D * DE; d.ldd = MOE_FP8 ? DEP : DE; d.k0 = kt * 128; d.n0 = ntl * 128; d.drow0 = ntl * 128;
    }
    return d;
}
__device__ __forceinline__ void cvt_store_strip(const StripDesc& d, const float4 (&a)[2][2], const float4 (&b)[2][2], LAS unsigned char* tb, int tid, bool readout) {
    const int kp = tid >> 4, n4 = (tid & 15) * 4;
    if (!readout) {
        if (!d.fp8) {
#pragma unroll
            for (int ki = 0; ki < 2; ++ki)
#pragma unroll
                for (int ni = 0; ni < 2; ++ni) {
                    LAS unsigned* t = (LAS unsigned*)tb + (ki * 2 + ni) * 2112;
                    t[(n4 + 0) * 33 + kp] = pack2a(a[ki][ni].x, b[ki][ni].x);
                    t[(n4 + 1) * 33 + kp] = pack2a(a[ki][ni].y, b[ki][ni].y);
                    t[(n4 + 2) * 33 + kp] = pack2a(a[ki][ni].z, b[ki][ni].z);
                    t[(n4 + 3) * 33 + kp] = pack2a(a[ki][ni].w, b[ki][ni].w);
                }
        } else {
#pragma unroll
            for (int ki = 0; ki < 2; ++ki)
#pragma unroll
                for (int ni = 0; ni < 2; ++ni) {
                    LAS unsigned char* t = tb + (ki * 2 + ni) * 4352;
                    *(LAS unsigned short*)(t + (n4 + 0) * 68 + 2 * kp) = (unsigned short)__builtin_amdgcn_cvt_pk_fp8_f32(a[ki][ni].x * W8_SCALE, b[ki][ni].x * W8_SCALE, 0, false);
                    *(LAS unsigned short*)(t + (n4 + 1) * 68 + 2 * kp) = (unsigned short)__builtin_amdgcn_cvt_pk_fp8_f32(a[ki][ni].y * W8_SCALE, b[ki][ni].y * W8_SCALE, 0, false);
                    *(LAS unsigned short*)(t + (n4 + 2) * 68 + 2 * kp) = (unsigned short)__builtin_amdgcn_cvt_pk_fp8_f32(a[ki][ni].z * W8_SCALE, b[ki][ni].z * W8_SCALE, 0, false);
                    *(LAS unsigned short*)(t + (n4 + 3) * 68 + 2 * kp) = (unsigned short)__builtin_amdgcn_cvt_pk_fp8_f32(a[ki][ni].w * W8_SCALE, b[ki][ni].w * W8_SCALE, 0, false);
                }
        }
    } else {
        if (!d.fp8) {
            const int n = tid >> 3, kc = (tid & 7) * 4;
#pragma unroll
            for (int ki = 0; ki < 2; ++ki)
#pragma unroll
                for (int ni = 0; ni < 2; ++ni) {
                    const LAS unsigned* t = (const LAS unsigned*)tb + (ki * 2 + ni) * 2112;
                    u32x4 o; o[0] = t[n * 33 + kc]; o[1] = t[n * 33 + kc + 1]; o[2] = t[n * 33 + kc + 2]; o[3] = t[n * 33 + kc + 3];
                    *(u32x4*)(d.dst + (size_t)(d.drow0 + ni * 64 + n) * d.ldd + d.k0 + ki * 64 + kc * 2) = o;
                }
        } else {
            const int n = tid >> 3, kc8 = (tid & 7) * 8;
            unsigned char* dst8 = (unsigned char*)d.dst;
#pragma unroll
            for (int ki = 0; ki < 2; ++ki)
#pragma unroll
                for (int ni = 0; ni < 2; ++ni) {
                    const LAS unsigned char* t = tb + (ki * 2 + ni) * 4352;
                    u32x2 o; o[0] = *(const LAS unsigned*)(t + n * 68 + kc8); o[1] = *(const LAS unsigned*)(t + n * 68 + kc8 + 4);
                    *(u32x2*)(dst8 + (size_t)(d.drow0 + ni * 64 + n) * d.ldd + d.k0 + ki * 64 + kc8) = o;
                }
        }
    }
}
__device__ __forceinline__ void cvt_pull(const Params& p, LAS unsigned char* lds, int limit, unsigned* done_ctr, unsigned need_done) {
    int tid = threadIdx.x; asm volatile("" : "+v"(tid));
    LAS int* slot = (LAS int*)(lds + LDS_MISC + 512);
    unsigned* head = (unsigned*)(p.ws + WS_CVTQ);
    if (tid == 0) {
        int sv = -1;
        const bool stop = done_ctr ? (xb_ld(done_ctr) >= need_done) : (xb_ld(head) >= (unsigned)limit);
        if (!stop) { const unsigned c = xb_add(head, 2u); sv = c < (unsigned)CV_TOTAL ? (int)c : -1; }
        slot[0] = sv;
    }
    __syncthreads();
    const int kp = tid >> 4, n4 = (tid & 15) * 4;
    for (;;) {
        const int sraw = slot[0];
        if (sraw < 0) break;
        const int si = sraw & (CV_LAST - 1); const bool lastone = (sraw & CV_LAST) != 0;
        const StripDesc d0 = strip_desc(p, si), d1 = strip_desc(p, si + 1);
        float4 a0[2][2], b0[2][2], a1[2][2], b1[2][2];
#pragma unroll
        for (int ki = 0; ki < 2; ++ki)
#pragma unroll
            for (int ni = 0; ni < 2; ++ni) {
                a0[ki][ni] = *(const float4*)(d0.src + (size_t)(d0.k0 + ki * 64 + 2 * kp) * d0.lds_ + d0.n0 + ni * 64 + n4);
                b0[ki][ni] = *(const float4*)(d0.src + (size_t)(d0.k0 + ki * 64 + 2 * kp + 1) * d0.lds_ + d0.n0 + ni * 64 + n4);
            }
#pragma unroll
        for (int ki = 0; ki < 2; ++ki)
#pragma unroll
            for (int ni = 0; ni < 2; ++ni) {
                a1[ki][ni] = *(const float4*)(d1.src + (size_t)(d1.k0 + ki * 64 + 2 * kp) * d1.lds_ + d1.n0 + ni * 64 + n4);
                b1[ki][ni] = *(const float4*)(d1.src + (size_t)(d1.k0 + ki * 64 + 2 * kp + 1) * d1.lds_ + d1.n0 + ni * 64 + n4);
            }
        unsigned c = 0u, dn = 0u;
        if (tid == 0 && !lastone) { c = xb_add(head, 2u); if (done_ctr) dn = xb_ld(done_ctr); }
        cvt_store_strip(d0, a0, b0, lds, tid, false);
        cvt_store_strip(d1, a1, b1, lds + 33792, tid, false);
        LDS_BARRIER();
        cvt_store_strip(d0, a0, b0, lds, tid, true);
        cvt_store_strip(d1, a1, b1, lds + 33792, tid, true);
        if (tid == 0) {
            int sv = -1;
            if (!lastone && c < (unsigned)CV_TOTAL) { const bool fin = done_ctr ? (dn >= need_done) : (c >= (unsigned)limit); sv = (int)c | (fin ? CV_LAST : 0); }
            slot[0] = sv;
        }
        LDS_BARRIER();
    }
    __syncthreads();
}
__device__ __forceinline__ void tail_pull(const Params& p, LAS unsigned char* lds, int ctr_idx) {
    unsigned* ctr = (unsigned*)(p.ws + WS_CVTQ) + 64 * (1 + ctr_idx);
    __syncthreads();
    if (threadIdx.x == 0) (void)xb_add(ctr, 1u);
    cvt_pull(p, lds, 0, ctr, gridDim.x);
}

__device__ __forceinline__ void ada_chunks(const Params& p, LAS unsigned char* lds, int ch0, int ch_end, int step) {
    int tid = threadIdx.x; asm volatile("" : "+v"(tid));
    unsigned char* ws = p.ws;
    LAS float* cond = (LAS float*)lds;
    LAS float* red = (LAS float*)(lds + 32768);
    if (ch0 >= ch_end) return;
    for (int i = tid; i < 4 * D; i += 512) { const float v = p.c[i]; cond[i] = siluf_(v); }
    __syncthreads();
    for (int ch = ch0; ch < ch_end; ch += step) {
        const int l = ch >> 7, j0 = (ch & 127) * 96;
        const float* w = p.w_ada + (size_t)l * D * (6 * D);
        const int kg = tid / 24, cl = tid % 24;
        float acc[4][4];
#pragma unroll
        for (int b = 0; b < 4; ++b)
#pragma unroll
            for (int j = 0; j < 4; ++j) acc[b][j] = 0.f;
        if (kg < 21) {
            for (int it0 = 0; it0 < 98; it0 += 14) {
                float4 wv[14];
#pragma unroll
                for (int q = 0; q < 14; ++q) { const int k = kg + 21 * (it0 + q); wv[q] = (k < D) ? *(const float4*)(w + (size_t)k * (6 * D) + j0 + cl * 4) : make_float4(0.f, 0.f, 0.f, 0.f); }
#pragma unroll
                for (int q = 0; q < 14; ++q) { const int k = kg + 21 * (it0 + q); const int kc = k < D ? k : 0;
#pragma unroll
                    for (int b = 0; b < 4; ++b) { const float cv = cond[b * D + kc]; acc[b][0] += cv * wv[q].x; acc[b][1] += cv * wv[q].y; acc[b][2] += cv * wv[q].z; acc[b][3] += cv * wv[q].w; } }
            }
#pragma unroll
            for (int b = 0; b < 4; ++b)
#pragma unroll
                for (int j = 0; j < 4; ++j) red[(kg * 4 + b) * 96 + cl * 4 + j] = acc[b][j];
        }
        __syncthreads();
        if (tid < 384) {
            const int b = tid / 96, col = tid % 96; float s = 0.f;
            for (int g = 0; g < 21; ++g) s += red[(g * 4 + b) * 96 + col];
            float* mod = (float*)(ws + WS_MOD);
            mod[((size_t)l * 4 + b) * (6 * D) + j0 + col] = s + p.b_ada[(size_t)l * 6 * D + j0 + col];
        }
        __syncthreads();
    }
}
__device__ __forceinline__ void phase_prologue(const Params& p, LAS unsigned char* lds) {
    const bool svc = (gridDim.x >= 256);
    ada_chunks(p, lds, blockIdx.x, svc ? 128 : 256, gridDim.x);
    cvt_pull(p, lds, CV_A0, nullptr, 0u);
}

#define COLK(k) ((((k) >> 1) << 9) + lane * 8 + (((k) & 1) << 2))
#define COL8(i) (((i) << 9) + lane * 8)
__device__ __forceinline__ void ld_bf8(const bf16_t* p, float4& a, float4& b) {
    const u32x4 r = *(const u32x4*)p;
    a = make_float4(bf2f(r[0] & 0xffffu), bf2f(r[0] >> 16), bf2f(r[1] & 0xffffu), bf2f(r[1] >> 16));
    b = make_float4(bf2f(r[2] & 0xffffu), bf2f(r[2] >> 16), bf2f(r[3] & 0xffffu), bf2f(r[3] >> 16));
}
__device__ __forceinline__ void st_bf8(bf16_t* p, const float4& a, const float4& b) {
    u32x4 o; o[0] = pack2a(a.x, a.y); o[1] = pack2a(a.z, a.w); o[2] = pack2a(b.x, b.y); o[3] = pack2a(b.z, b.w);
    *(u32x4*)p = o;
}
__device__ __forceinline__ void st_fp8x8(unsigned char* p, const float4& a, const float4& b) {
    int o0 = __builtin_amdgcn_cvt_pk_fp8_f32(a.x, a.y, 0, false); o0 = __builtin_amdgcn_cvt_pk_fp8_f32(a.z, a.w, o0, true);
    int o1 = __builtin_amdgcn_cvt_pk_fp8_f32(b.x, b.y, 0, false); o1 = __builtin_amdgcn_cvt_pk_fp8_f32(b.z, b.w, o1, true);
    u32x2 o; o[0] = (unsigned)o0; o[1] = (unsigned)o1;
    *(u32x2*)p = o;
}
__device__ __forceinline__ void ln_rows(float4 (&v)[8], const float* __restrict__ g, const float* __restrict__ b, int lane) {
    float s = 0.f;
#pragma unroll
    for (int i = 0; i < 8; ++i) s += (v[i].x + v[i].y) + (v[i].z + v[i].w);
    const float mean = wave_sum(s) * (1.0f / D);
    float q = 0.f;
#pragma unroll
    for (int i = 0; i < 8; ++i) { const float a = v[i].x - mean, bb = v[i].y - mean, c = v[i].z - mean, d = v[i].w - mean; q += (a * a + bb * bb) + (c * c + d * d); }
    const float rstd = rsqrtf(wave_sum(q) * (1.0f / D) + 1e-5f);
#pragma unroll
    for (int i = 0; i < 8; ++i) {
        const float4 gv = *(const float4*)(g + COLK(i)), bv = *(const float4*)(b + COLK(i));
        v[i].x = (v[i].x - mean) * rstd * gv.x + bv.x; v[i].y = (v[i].y - mean) * rstd * gv.y + bv.y;
        v[i].z = (v[i].z - mean) * rstd * gv.z + bv.z; v[i].w = (v[i].w - mean) * rstd * gv.w + bv.w;
    }
}
__device__ __forceinline__ void modulate_store(const float4 (&v)[8], const float* __restrict__ shift, const float* __restrict__ scale, bf16_t* __restrict__ dst, int lane, bool fp8) {
#pragma unroll
    for (int i = 0; i < 4; ++i) {
        float4 h[2];
#pragma unroll
        for (int q = 0; q < 2; ++q) {
            const float4 sh = *(const float4*)(shift + COLK(2 * i + q)), sc = *(const float4*)(scale + COLK(2 * i + q));
            const float4 x = v[2 * i + q];
            h[q] = make_float4(x.x * (1.f + sc.x) + sh.x, x.y * (1.f + sc.y) + sh.y, x.z * (1.f + sc.z) + sh.z, x.w * (1.f + sc.w) + sh.w);
        }
        if (fp8) st_fp8x8((unsigned char*)dst + COL8(i), h[0], h[1]);
        else st_bf8(dst + COL8(i), h[0], h[1]);
    }
}

__device__ __forceinline__ void phase_ln0(const Params& p) {
    int tid_ = threadIdx.x; asm volatile("" : "+v"(tid_)); const int wave = tid_ >> 6, lane = tid_ & 63;
    const float* mod = (const float*)(p.ws + WS_MOD);
    for (int n = blockIdx.x * 8 + wave; n < T; n += gridDim.x * 8) {
        const int b = n / SEQ;
        float4 v[8];
#pragma unroll
        for (int i = 0; i < 8; ++i) v[i] = *(const float4*)(p.x + (size_t)n * D + COLK(i));
        ln_rows(v, p.emb_g, p.emb_b, lane);
        bf16_t* xr = (bf16_t*)(p.ws + WS_XRES) + (size_t)n * D;
#pragma unroll
        for (int i = 0; i < 4; ++i) st_bf8(xr + COL8(i), v[2 * i], v[2 * i + 1]);
        const float* mb = mod + ((size_t)0 * 4 + b) * (6 * D);
        modulate_store(v, mb, mb + D, INP8(0) ? (bf16_t*)(p.ws + WS_HA + (size_t)n * D) : (bf16_t*)(p.ws + WS_HA) + (size_t)n * D, lane, INP8(0));
    }
}

__device__ __forceinline__ void phase_mixer_valu(const Params& p, int l, LAS unsigned char* lds) {
    LAS float* qs = (LAS float*)lds; LAS float* ks = qs + 4096; LAS float* fs = ks + 4096; LAS float* vs = fs + 4096; LAS float* po = vs + 1024;
    int tid = threadIdx.x; asm volatile("" : "+v"(tid)); const int wave = tid >> 6, lane = tid & 63, kk = tid >> 5, vv = tid & 31;
    const bf16_t* proj = (const bf16_t*)(p.ws + WS_PROJ);
    float* obuf = (float*)(p.ws + WS_OBUF);
    for (int u = blockIdx.x; u < 384; u += gridDim.x) {
        const int vsl = u & 3, dir = (u >> 2) & 1, hh = (u >> 3) % 6, b = ((u >> 3) / 6) % 4, type = (u >> 3) / 24;
        float S[8];
#pragma unroll
        for (int j = 0; j < 8; ++j) S[j] = 0.f;
        const float gamma = 1.0f - exp2f(-(dir ? 5.5f : 5.0f) - (float)hh);
        for (int blk = 0; blk < 64; ++blk) {
            const int rb = dir ? 63 - blk : blk, t0 = rb * 32;
            if (type == 0) {
#pragma unroll
                for (int j = 0; j < 4; ++j) {
                    const int idx = tid + 512 * j, tt = idx >> 6, dp = idx & 63;
                    const bf16_t* row = proj + (size_t)(b * SEQ + t0 + tt) * INC;
                    const float q1 = bf2f(row[C_RQ + hh * 128 + dp]), q2 = bf2f(row[C_RQ + hh * 128 + 64 + dp]);
                    const float k1 = bf2f(row[C_RK + hh * 128 + dp]), k2 = bf2f(row[C_RK + hh * 128 + 64 + dp]);
                    const float inv_freq = exp2f(-(float)dp * (13.287712379549449f / 64.0f));
                    const float ang = (float)(t0 + tt) * inv_freq;
                    float rev = ang * 0.15915494309189535f; rev -= rintf(rev);
                    const float sn = __builtin_amdgcn_sinf(rev), cs = __builtin_amdgcn_cosf(rev);
                    qs[tt * 128 + dp] = q1 * cs - q2 * sn; qs[tt * 128 + 64 + dp] = q1 * sn + q2 * cs;
                    ks[tt * 128 + dp] = (k1 * cs - k2 * sn) * 0.08838834764831845f; ks[tt * 128 + 64 + dp] = (k1 * sn + k2 * cs) * 0.08838834764831845f;
                    fs[tt * 128 + dp] = gamma; fs[tt * 128 + 64 + dp] = gamma;
                }
            } else {
#pragma unroll
                for (int j = 0; j < 8; ++j) {
                    const int idx = tid + 512 * j, tt = idx >> 7, d = idx & 127;
                    const bf16_t* row = proj + (size_t)(b * SEQ + t0 + tt) * INC;
                    const float q = bf2f(row[C_HQ + hh * 128 + d]);
                    const float z = bf2f(row[(dir ? C_HFB : C_HFF) + hh * 128 + d]);
                    float lb = 0.f;
                    if (l > 0) { const float a0 = p.lb_logits[(0 * 2 + dir) * HWD + hh * 128 + d], a1 = p.lb_logits[(1 * 2 + dir) * HWD + hh * 128 + d]; lb = 1.0f / (1.0f + expf(a0 - a1)); }
                    float f = lb + (1.0f - lb) * (1.0f / (1.0f + expf(-z)));
                    f = fmaxf(f, 1e-6f);
                    qs[tt * 128 + d] = q; ks[tt * 128 + d] = 1.0f - f; fs[tt * 128 + d] = f;
                }
            }
#pragma unroll
            for (int j = 0; j < 2; ++j) {
                const int idx = tid + 512 * j, tt = idx >> 5, c = idx & 31;
                const bf16_t* row = proj + (size_t)(b * SEQ + t0 + tt) * INC;
                vs[tt * 32 + c] = bf2f(row[(type ? C_HI : C_RV) + hh * 128 + vsl * 32 + c]);
            }
            __syncthreads();
            for (int s = 0; s < 32; ++s) {
                const int ss = dir ? 31 - s : s;
                const f32x4 qa = *(const LAS f32x4*)(qs + ss * 128 + kk * 8), qb = *(const LAS f32x4*)(qs + ss * 128 + kk * 8 + 4);
                const f32x4 ka = *(const LAS f32x4*)(ks + ss * 128 + kk * 8), kb = *(const LAS f32x4*)(ks + ss * 128 + kk * 8 + 4);
                const f32x4 fa = *(const LAS f32x4*)(fs + ss * 128 + kk * 8), fb = *(const LAS f32x4*)(fs + ss * 128 + kk * 8 + 4);
                const float vval = vs[ss * 32 + vv];
                float acc = 0.f;
#pragma unroll
                for (int j = 0; j < 4; ++j) { S[j] = fa[j] * S[j] + ka[j] * vval; acc += S[j] * qa[j]; }
#pragma unroll
                for (int j = 0; j < 4; ++j) { S[4 + j] = fb[j] * S[4 + j] + kb[j] * vval; acc += S[4 + j] * qb[j]; }
                acc += __shfl_xor(acc, 32, 64);
                if (lane < 32) po[(ss * 8 + wave) * 32 + vv] = acc;
            }
            __syncthreads();
#pragma unroll
            for (int j = 0; j < 2; ++j) {
                const int idx = tid + 512 * j, tt = idx >> 5, c = idx & 31;
                float s = 0.f;
#pragma unroll
                for (int w = 0; w < 8; ++w) s += po[(tt * 8 + w) * 32 + c];
                obuf[((size_t)dir * T + (size_t)(b * SEQ + t0 + tt)) * 1536 + type * 768 + hh * 128 + vsl * 32 + c] = s;
            }
        }
        __syncthreads();
    }
}

constexpr int MX_QI = 0, MX_KI = 17408, MX_QS = 34816, MX_KTT = 52224, MX_VT = 70656, MX_P = 79872, MX_ST = 89088, MX_TOT = 106496, MX_DEC = 110592, MX_RQ = 112128, MX_RK = 128512, MX_RV = 144896;
__device__ __forceinline__ float ex2(float x) { return __builtin_amdgcn_exp2f(x); }
__device__ __forceinline__ float clampe(float x) { return fminf(fmaxf(x, -120.f), 120.f); }
template <int MODE>
__device__ __forceinline__ void phase_mixer_mfma(const Params& p, int l, LAS unsigned char* lds, float* __restrict__ obuf) {
    int tid = threadIdx.x; asm volatile("" : "+v"(tid));
    const int wave = __builtin_amdgcn_readfirstlane(tid >> 6), lane = tid & 63, fr = lane & 15, fq = lane >> 4;
    const bf16_t* proj = (const bf16_t*)(p.ws + WS_PROJ);
    for (int u = blockIdx.x; u < 192; u += gridDim.x) {
        const int vsl = u & 1, dir = (u >> 1) & 1, hh = (u >> 2) % 6, b = ((u >> 2) / 6) % 4, type = (u >> 2) / 24;
        float lg2 = 0.f, invf0 = 0.f, invf1 = 0.f, sgn = 1.f, lb0 = 0.f, lb1 = 0.f;
        if (type == 0) {
            const float gamma = 1.0f - exp2f(-(dir ? 5.5f : 5.0f) - (float)hh);
            lg2 = log2f(gamma);
            const int dm0 = (2 * lane) & 63;
            invf0 = exp2f(-(float)dm0 * (13.287712379549449f / 64.0f)); invf1 = exp2f(-(float)(dm0 + 1) * (13.287712379549449f / 64.0f));
            sgn = lane < 32 ? -1.f : 1.f;
        } else if (l > 0) {
            const float* lbl = p.lb_logits + dir * HWD + hh * 128 + 2 * lane;
            lb0 = 1.0f / (1.0f + expf(lbl[0] - lbl[2 * HWD])); lb1 = 1.0f / (1.0f + expf(lbl[1] - lbl[2 * HWD + 1]));
        }
        const int colA = (type ? C_HQ : C_RQ) + hh * 128, colB = (type ? (dir ? C_HFB : C_HFF) : C_RK) + hh * 128;
        const int colV0 = (type ? C_HI : C_RV) + hh * 128 + vsl * 64;
        const int own = 2 * lane, par = (2 * lane + 64) & 127;
        const size_t ocol = (size_t)type * 768 + hh * 128 + vsl * 64;
#define MX_LOAD(ch) do { \
            _Pragma("unroll") for (int i2 = 0; i2 < 2; ++i2) { const int pos = wave * 8 + i2 * 4 + (lane >> 4); const int tau = (ch) * 64 + pos; const int t = dir ? (SEQ - 1 - tau) : tau; \
                const bf16_t* row = proj + (size_t)(b * SEQ + t) * INC + (lane & 15) * 8; \
                __builtin_amdgcn_global_load_lds((const unsigned*)(row + colA), (LAS unsigned*)(lds + MX_RQ + (wave * 8 + i2 * 4) * 256), 16, 0, 0); \
                __builtin_amdgcn_global_load_lds((const unsigned*)(row + colB), (LAS unsigned*)(lds + MX_RK + (wave * 8 + i2 * 4) * 256), 16, 0, 0); } \
            { const int pos = wave * 8 + (lane >> 3); const int tau = (ch) * 64 + pos; const int t = dir ? (SEQ - 1 - tau) : tau; \
              const bf16_t* row = proj + (size_t)(b * SEQ + t) * INC + colV0 + (lane & 7) * 8; \
              __builtin_amdgcn_global_load_lds((const unsigned*)row, (LAS unsigned*)(lds + MX_RV + (wave * 8) * 128), 16, 0, 0); } } while (0)
        f32x4 Sacc[4];
#pragma unroll
        for (int vt = 0; vt < 4; ++vt) Sacc[vt] = (f32x4){0.f, 0.f, 0.f, 0.f};
        for (int i = tid; i < 64 * 272 / 4; i += 512) ((LAS unsigned*)(lds + MX_ST))[i] = 0u;
        float cd0 = 1.f, sd0 = 0.f, cd1 = 1.f, sd1 = 0.f;
        if (type == 0) {
            if (tid < 64) { const float fi = (float)tid; *(LAS f32x4*)(lds + MX_DEC + 512 + tid * 16) = (f32x4){ex2((fi - 31.f) * lg2), ex2((31.f - fi) * lg2), ex2((fi + 1.f) * lg2), ex2((63.f - fi) * lg2)}; }
            const float r0 = invf0 * 0.15915494309189535f, r1 = invf1 * 0.15915494309189535f, sg = dir ? -1.f : 1.f;
            cd0 = __builtin_amdgcn_cosf(r0); sd0 = sg * __builtin_amdgcn_sinf(r0); cd1 = __builtin_amdgcn_cosf(r1); sd1 = sg * __builtin_amdgcn_sinf(r1);
        }
        __syncthreads();
        MX_LOAD(0);
        asm volatile("s_waitcnt vmcnt(0)" ::: "memory");
        __syncthreads();
        for (int ch = 0; ch < 32; ++ch) {
            float q0[8], q1[8], k0[8], k1[8], c0[8], c1[8];
            float run0 = 0.f, run1 = 0.f;
            u32x4 vpk = (u32x4){0u, 0u, 0u, 0u};
#pragma unroll
            for (int j = 0; j < 8; ++j) { q0[j] = q1[j] = k0[j] = k1[j] = c0[j] = c1[j] = 0.f; }
            if (MODE != 3 && MODE != 4) {
            if (type == 0) {
                const int tau0 = ch * 64 + wave * 8; const int t0 = dir ? (SEQ - 1 - tau0) : tau0;
                float rev0 = (float)t0 * invf0 * 0.15915494309189535f, rev1 = (float)t0 * invf1 * 0.15915494309189535f;
                rev0 -= rintf(rev0); rev1 -= rintf(rev1);
                float sn0 = __builtin_amdgcn_sinf(rev0), cs0 = __builtin_amdgcn_cosf(rev0), sn1 = __builtin_amdgcn_sinf(rev1), cs1 = __builtin_amdgcn_cosf(rev1);
#pragma unroll
                for (int j = 0; j < 8; ++j) {
                    const int pos_ = wave * 8 + j;
                    const unsigned ra_ = *(const LAS unsigned*)(lds + MX_RQ + pos_ * 256 + own * 2), rb_ = *(const LAS unsigned*)(lds + MX_RK + pos_ * 256 + own * 2);
                    const unsigned rc_ = *(const LAS unsigned*)(lds + MX_RQ + pos_ * 256 + par * 2), rd_ = *(const LAS unsigned*)(lds + MX_RK + pos_ * 256 + par * 2);
                    const float a_lo = bf2f(ra_ & 0xffffu), a_hi = bf2f(ra_ >> 16), b_lo = bf2f(rb_ & 0xffffu), b_hi = bf2f(rb_ >> 16);
                    const float pa_lo = bf2f(rc_ & 0xffffu), pa_hi = bf2f(rc_ >> 16), pb_lo = bf2f(rd_ & 0xffffu), pb_hi = bf2f(rd_ >> 16);
                    const float ss0 = sgn * sn0, ss1 = sgn * sn1;
                    q0[j] = a_lo * cs0 + pa_lo * ss0; q1[j] = a_hi * cs1 + pa_hi * ss1;
                    k0[j] = (b_lo * cs0 + pb_lo * ss0) * 0.08838834764831845f; k1[j] = (b_hi * cs1 + pb_hi * ss1) * 0.08838834764831845f;
                    const float nc0 = cs0 * cd0 - sn0 * sd0, ns0 = sn0 * cd0 + cs0 * sd0, nc1 = cs1 * cd1 - sn1 * sd1, ns1 = sn1 * cd1 + cs1 * sd1;
                    cs0 = nc0; sn0 = ns0; cs1 = nc1; sn1 = ns1;
                    c0[j] = 0.f; c1[j] = 0.f;
                }
            } else {
#pragma unroll
                for (int j = 0; j < 8; ++j) {
                    const int pos_ = wave * 8 + j;
                    const unsigned ra_ = *(const LAS unsigned*)(lds + MX_RQ + pos_ * 256 + own * 2), rb_ = *(const LAS unsigned*)(lds + MX_RK + pos_ * 256 + own * 2);
                    const float a_lo = bf2f(ra_ & 0xffffu), a_hi = bf2f(ra_ >> 16), b_lo = bf2f(rb_ & 0xffffu), b_hi = bf2f(rb_ >> 16);
                    q0[j] = a_lo; q1[j] = a_hi;
                    float f0 = lb0 + (1.0f - lb0) * __builtin_amdgcn_rcpf(1.0f + ex2(-b_lo * 1.4426950408889634f));
                    float f1 = lb1 + (1.0f - lb1) * __builtin_amdgcn_rcpf(1.0f + ex2(-b_hi * 1.4426950408889634f));
                    f0 = fmaxf(f0, 1e-6f); f1 = fmaxf(f1, 1e-6f);
                    k0[j] = 1.0f - f0; k1[j] = 1.0f - f1;
                    run0 += __builtin_amdgcn_logf(f0); run1 += __builtin_amdgcn_logf(f1); c0[j] = run0; c1[j] = run1;
                }
            }
            { unsigned rv[8];
#pragma unroll
              for (int j = 0; j < 8; ++j) rv[j] = *(const LAS unsigned short*)(lds + MX_RV + (wave * 8 + j) * 128 + lane * 2);
              vpk[0] = rv[0] | (rv[1] << 16); vpk[1] = rv[2] | (rv[3] << 16); vpk[2] = rv[4] | (rv[5] << 16); vpk[3] = rv[6] | (rv[7] << 16); }
            }
            { typedef float f32x2_ __attribute__((ext_vector_type(2))); *(LAS f32x2_*)(lds + MX_TOT + (wave * 128 + 2 * lane) * 4) = (f32x2_){run0, run1}; }
            LDS_BARRIER();
            if (ch + 1 < 32) MX_LOAD(ch + 1);
            float kt0[8], kt1[8];
            float tt0, tt1;
#pragma unroll
            for (int j = 0; j < 8; ++j) { kt0[j] = kt1[j] = 0.f; }
            tt0 = tt1 = 0.f;
            if (MODE != 3 && MODE != 4) {
            if (type == 0) {
                tt0 = tt1 = 64.f * lg2;
#pragma unroll
                for (int j = 0; j < 8; ++j) {
                    const int pos = wave * 8 + j;
                    const f32x4 e = *(const LAS f32x4*)(lds + MX_DEC + 512 + pos * 16);
                    *(LAS unsigned*)(lds + MX_QI + pos * 272 + lane * 4) = pack2(q0[j] * e[0], q1[j] * e[0]);
                    *(LAS unsigned*)(lds + MX_KI + pos * 272 + lane * 4) = pack2(k0[j] * e[1], k1[j] * e[1]);
                    kt0[j] = k0[j] * e[3]; kt1[j] = k1[j] * e[3];
                }
            } else {
                float off0 = 0.f, off1 = 0.f, m0 = 0.f, m1 = 0.f; tt0 = 0.f; tt1 = 0.f;
#pragma unroll
                for (int g = 0; g < 8; ++g) {
                    typedef float f32x2_ __attribute__((ext_vector_type(2)));
                    const f32x2_ tv = *(const LAS f32x2_*)(lds + MX_TOT + (g * 128 + 2 * lane) * 4);
                    if (g < wave) { off0 += tv[0]; off1 += tv[1]; }
                    if (g < 4) { m0 += tv[0]; m1 += tv[1]; }
                    tt0 += tv[0]; tt1 += tv[1];
                }
                const float etm0 = ex2(tt0 - m0), etm1 = ex2(tt1 - m1);
#pragma unroll
                for (int j = 0; j < 8; ++j) {
                    const float cu0 = c0[j] + off0, cu1 = c1[j] + off1;
                    const float e10 = ex2(clampe(cu0 - m0)), e11 = ex2(clampe(cu1 - m1));
                    const float e20 = __builtin_amdgcn_rcpf(e10), e21 = __builtin_amdgcn_rcpf(e11);
                    const int pos = wave * 8 + j;
                    *(LAS unsigned*)(lds + MX_QI + pos * 272 + lane * 4) = pack2(q0[j] * e10, q1[j] * e11);
                    *(LAS unsigned*)(lds + MX_KI + pos * 272 + lane * 4) = pack2(k0[j] * e20, k1[j] * e21);
                    kt0[j] = k0[j] * (e20 * etm0); kt1[j] = k1[j] * (e21 * etm1);
                }
            }
            }
            { u32x4 w0, w1;
              w0[0] = pack2(kt0[0], kt0[1]); w0[1] = pack2(kt0[2], kt0[3]); w0[2] = pack2(kt0[4], kt0[5]); w0[3] = pack2(kt0[6], kt0[7]);
              w1[0] = pack2(kt1[0], kt1[1]); w1[1] = pack2(kt1[2], kt1[3]); w1[2] = pack2(kt1[4], kt1[5]); w1[3] = pack2(kt1[6], kt1[7]);
              *(LAS u32x4*)(lds + MX_KTT + (2 * lane) * 144 + wave * 16) = w0;
              *(LAS u32x4*)(lds + MX_KTT + (2 * lane + 1) * 144 + wave * 16) = w1;
              *(LAS u32x4*)(lds + MX_VT + lane * 144 + wave * 16) = vpk; }
            if (MODE != 3 && MODE != 4) {
                f32x4 em;
                if (type == 0) { const float e_ = ex2(32.f * lg2); em = (f32x4){e_, e_, e_, e_}; }
                else {
                    f32x4 ms = (f32x4){0.f, 0.f, 0.f, 0.f};
#pragma unroll
                    for (int g = 0; g < 4; ++g) ms += *(const LAS f32x4*)(lds + MX_TOT + (g * 128 + 16 * wave + 4 * fq) * 4);
                    em = (f32x4){ex2(ms[0]), ex2(ms[1]), ex2(ms[2]), ex2(ms[3])};
                }
#pragma unroll
                for (int vt = 0; vt < 4; ++vt) { u32x2 o; o[0] = pack2(Sacc[vt][0] * em[0], Sacc[vt][1] * em[1]); o[1] = pack2(Sacc[vt][2] * em[2], Sacc[vt][3] * em[3]);
                    *(LAS u32x2*)(lds + MX_ST + (16 * vt + fr) * 272 + (16 * wave + 4 * fq) * 2) = o; }
            }
            if (wave == 0) { typedef float f32x2_ __attribute__((ext_vector_type(2))); *(LAS f32x2_*)(lds + MX_DEC + lane * 8) = (f32x2_){ex2(tt0), ex2(tt1)}; }
            LDS_BARRIER();
            if (MODE != 2 && MODE != 4) {
                const int it = wave >> 1, st0 = 2 * (wave & 1);
                bf16x8 ka[2][4], qb[4];
#pragma unroll
                for (int kq = 0; kq < 4; ++kq) {
                    qb[kq] = *(const LAS bf16x8*)(lds + MX_QI + (16 * it + fr) * 272 + (32 * kq + 8 * fq) * 2);
                    ka[0][kq] = *(const LAS bf16x8*)(lds + MX_KI + (16 * st0 + fr) * 272 + (32 * kq + 8 * fq) * 2);
                    ka[1][kq] = *(const LAS bf16x8*)(lds + MX_KI + (16 * st0 + 16 + fr) * 272 + (32 * kq + 8 * fq) * 2);
                }
                asm volatile("s_waitcnt lgkmcnt(0)" ::: "memory");
                f32x4 acc0 = (f32x4){0.f, 0.f, 0.f, 0.f}, acc1 = acc0;
#pragma unroll
                for (int kq = 0; kq < 4; ++kq) {
                    acc0 = __builtin_amdgcn_mfma_f32_16x16x32_bf16(ka[0][kq], qb[kq], acc0, 0, 0, 0);
                    acc1 = __builtin_amdgcn_mfma_f32_16x16x32_bf16(ka[1][kq], qb[kq], acc1, 0, 0, 0);
                }
                const int i = 16 * it + fr;
                { const int s0 = 16 * st0 + 4 * fq;
                  const float v0 = (s0 + 0 <= i) ? acc0[0] : 0.f, v1 = (s0 + 1 <= i) ? acc0[1] : 0.f, v2 = (s0 + 2 <= i) ? acc0[2] : 0.f, v3 = (s0 + 3 <= i) ? acc0[3] : 0.f;
                  u32x2 o; o[0] = pack2(v0, v1); o[1] = pack2(v2, v3);
                  *(LAS u32x2*)(lds + MX_P + i * 144 + s0 * 2) = o; }
                { const int s0 = 16 * st0 + 16 + 4 * fq;
                  const float v0 = (s0 + 0 <= i) ? acc1[0] : 0.f, v1 = (s0 + 1 <= i) ? acc1[1] : 0.f, v2 = (s0 + 2 <= i) ? acc1[2] : 0.f, v3 = (s0 + 3 <= i) ? acc1[3] : 0.f;
                  u32x2 o; o[0] = pack2(v0, v1); o[1] = pack2(v2, v3);
                  *(LAS u32x2*)(lds + MX_P + i * 144 + s0 * 2) = o; }
            }
            LDS_BARRIER();
            if (MODE != 2 && MODE != 4) {
                const int vt = wave >> 1, it0 = 2 * (wave & 1);
                bf16x8 va[2], sa[4], pb[2][2], qsb[2][4], kta[2], vb[4][2];
#pragma unroll
                for (int kq = 0; kq < 2; ++kq) {
                    va[kq] = *(const LAS bf16x8*)(lds + MX_VT + (16 * vt + fr) * 144 + (32 * kq + 8 * fq) * 2);
                    pb[0][kq] = *(const LAS bf16x8*)(lds + MX_P + (16 * it0 + fr) * 144 + (32 * kq + 8 * fq) * 2);
                    pb[1][kq] = *(const LAS bf16x8*)(lds + MX_P + (16 * it0 + 16 + fr) * 144 + (32 * kq + 8 * fq) * 2);
                    kta[kq] = *(const LAS bf16x8*)(lds + MX_KTT + (16 * wave + fr) * 144 + (32 * kq + 8 * fq) * 2);
                }
#pragma unroll
                for (int kq = 0; kq < 4; ++kq) {
                    sa[kq] = *(const LAS bf16x8*)(lds + MX_ST + (16 * vt + fr) * 272 + (32 * kq + 8 * fq) * 2);
                    qsb[0][kq] = *(const LAS bf16x8*)(lds + MX_QI + (16 * it0 + fr) * 272 + (32 * kq + 8 * fq) * 2);
                    qsb[1][kq] = *(const LAS bf16x8*)(lds + MX_QI + (16 * it0 + 16 + fr) * 272 + (32 * kq + 8 * fq) * 2);
                }
#pragma unroll
                for (int v4 = 0; v4 < 4; ++v4)
#pragma unroll
                    for (int kq = 0; kq < 2; ++kq) vb[v4][kq] = *(const LAS bf16x8*)(lds + MX_VT + (16 * v4 + fr) * 144 + (32 * kq + 8 * fq) * 2);
                const f32x4 dc = *(const LAS f32x4*)(lds + MX_DEC + (16 * wave + 4 * fq) * 4);
                asm volatile("s_waitcnt lgkmcnt(0)" ::: "memory");
                f32x4 acc0 = (f32x4){0.f, 0.f, 0.f, 0.f}, acc1 = acc0;
#pragma unroll
                for (int kq = 0; kq < 2; ++kq) {
                    acc0 = __builtin_amdgcn_mfma_f32_16x16x32_bf16(va[kq], pb[0][kq], acc0, 0, 0, 0);
                    acc1 = __builtin_amdgcn_mfma_f32_16x16x32_bf16(va[kq], pb[1][kq], acc1, 0, 0, 0);
                }
#pragma unroll
                for (int kq = 0; kq < 4; ++kq) {
                    acc0 = __builtin_amdgcn_mfma_f32_16x16x32_bf16(sa[kq], qsb[0][kq], acc0, 0, 0, 0);
                    acc1 = __builtin_amdgcn_mfma_f32_16x16x32_bf16(sa[kq], qsb[1][kq], acc1, 0, 0, 0);
                }
#pragma unroll
                for (int v4 = 0; v4 < 4; ++v4) {
                    f32x4 a = Sacc[v4]; a[0] *= dc[0]; a[1] *= dc[1]; a[2] *= dc[2]; a[3] *= dc[3];
                    a = __builtin_amdgcn_mfma_f32_16x16x32_bf16(kta[0], vb[v4][0], a, 0, 0, 0);
                    a = __builtin_amdgcn_mfma_f32_16x16x32_bf16(kta[1], vb[v4][1], a, 0, 0, 0);
                    Sacc[v4] = a;
                }
                asm volatile("s_waitcnt vmcnt(0)" ::: "memory");
                { const int tau = ch * 64 + 16 * it0 + fr; const int t = dir ? (SEQ - 1 - tau) : tau;
                  u32x2 o; o[0] = pack2(acc0[0], acc0[1]); o[1] = pack2(acc0[2], acc0[3]);
                  *(u32x2*)((bf16_t*)obuf + ((size_t)dir * T + (size_t)(b * SEQ + t)) * 1536 + ocol + 16 * vt + 4 * fq) = o; }
                { const int tau = ch * 64 + 16 * it0 + 16 + fr; const int t = dir ? (SEQ - 1 - tau) : tau;
                  u32x2 o; o[0] = pack2(acc1[0], acc1[1]); o[1] = pack2(acc1[2], acc1[3]);
                  *(u32x2*)((bf16_t*)obuf + ((size_t)dir * T + (size_t)(b * SEQ + t)) * 1536 + ocol + 16 * vt + 4 * fq) = o; }
            }
        }
        __syncthreads();
#undef MX_LOAD
    }
}

#ifdef MIXER_CHECK
__device__ __forceinline__ void phase_mixer_check(const Params& p, const float* __restrict__ oa, const float* __restrict__ ob, float* chk) {
    int tid_ = threadIdx.x; asm volatile("" : "+v"(tid_)); const int wave = tid_ >> 6, lane = tid_ & 63;
    for (int r = blockIdx.x * 8 + wave; r < 2 * T; r += gridDim.x * 8) {
        const int dir = r / T;
#pragma unroll
        for (int ty = 0; ty < 2; ++ty) {
            float sd = 0.f, sq = 0.f;
#pragma unroll
            for (int i = 0; i < 3; ++i) { const float4 a = *(const float4*)(oa + (size_t)r * 1536 + ty * 768 + i * 256 + lane * 4), bq = *(const float4*)(ob + (size_t)r * 1536 + ty * 768 + i * 256 + lane * 4);
                sd += (a.x - bq.x) * (a.x - bq.x) + (a.y - bq.y) * (a.y - bq.y) + (a.z - bq.z) * (a.z - bq.z) + (a.w - bq.w) * (a.w - bq.w);
                sq += a.x * a.x + a.y * a.y + a.z * a.z + a.w * a.w; }
            sd = wave_sum(sd); sq = wave_sum(sq);
            if (lane == 0) { atomicAdd(&chk[(ty * 2 + dir) * 2 + 0], sd); atomicAdd(&chk[(ty * 2 + dir) * 2 + 1], sq); }
        }
    }
}
#endif

__device__ __forceinline__ float4 ld_bf4(const bf16_t* p) { const u32x2 r = *(const u32x2*)p; return make_float4(bf2f(r[0] & 0xffffu), bf2f(r[0] >> 16), bf2f(r[1] & 0xffffu), bf2f(r[1] >> 16)); }
__device__ __forceinline__ float grp16_sum(float v) {
#pragma unroll
    for (int o = 8; o > 0; o >>= 1) v += __shfl_xor(v, o, 64);
    return v;
}
__device__ __forceinline__ void phase_finalize(const Params& p, int l) {
    int tid_ = threadIdx.x; asm volatile("" : "+v"(tid_)); const int wave = tid_ >> 6, lane = tid_ & 63;
    const bf16_t* proj = (const bf16_t*)(p.ws + WS_PROJ);
    const bf16_t* obuf = (const bf16_t*)(p.ws + WS_OBUF);
    bf16_t* mixed = (bf16_t*)(p.ws + WS_MIXED);
    const float* cw = p.conv_w + (size_t)l * 3 * CW;
    const float* beta = p.mix_beta + (size_t)l * D;
    for (int n = blockIdx.x * 8 + wave; n < T; n += gridDim.x * 8) {
        const int t = n % SEQ;
        const bf16_t* row = proj + (size_t)n * INC;
#pragma unroll
        for (int i = 0; i < 4; ++i) {
            const int c = COL8(i);
            float4 r[2];
            if (i == 0) {
                float4 cc[2], ch[2], cb[2], um[2], up[2];
                ld_bf8(row + C_CC + c, cc[0], cc[1]); ld_bf8(row + C_CH + c, ch[0], ch[1]); ld_bf8(row + C_CB + c, cb[0], cb[1]);
                um[0] = um[1] = up[0] = up[1] = make_float4(0.f, 0.f, 0.f, 0.f);
                if (t > 0) { float4 a[2], b2[2]; ld_bf8(row - INC + C_CC + c, a[0], a[1]); ld_bf8(row - INC + C_CH + c, b2[0], b2[1]);
#pragma unroll
                    for (int q = 0; q < 2; ++q) um[q] = make_float4(a[q].x * b2[q].x, a[q].y * b2[q].y, a[q].z * b2[q].z, a[q].w * b2[q].w); }
                if (t < SEQ - 1) { float4 a[2], b2[2]; ld_bf8(row + INC + C_CC + c, a[0], a[1]); ld_bf8(row + INC + C_CH + c, b2[0], b2[1]);
#pragma unroll
                    for (int q = 0; q < 2; ++q) up[q] = make_float4(a[q].x * b2[q].x, a[q].y * b2[q].y, a[q].z * b2[q].z, a[q].w * b2[q].w); }
#pragma unroll
                for (int q = 0; q < 2; ++q) {
                    const float4 w0 = *(const float4*)(cw + c + 4 * q), w1 = *(const float4*)(cw + CW + c + 4 * q), w2 = *(const float4*)(cw + 2 * CW + c + 4 * q);
                    r[q].x = cb[q].x * (um[q].x * w0.x + cc[q].x * ch[q].x * w1.x + up[q].x * w2.x);
                    r[q].y = cb[q].y * (um[q].y * w0.y + cc[q].y * ch[q].y * w1.y + up[q].y * w2.y);
                    r[q].z = cb[q].z * (um[q].z * w0.z + cc[q].z * ch[q].z * w1.z + up[q].z * w2.z);
                    r[q].w = cb[q].w * (um[q].w * w0.w + cc[q].w * ch[q].w * w1.w + up[q].w * w2.w);
                }
            } else {
                const int oc = c - 512;
                const bool isret = oc < 768;
                float4 of[2], ob[2], gt[2];
                ld_bf8(obuf + (size_t)n * 1536 + oc, of[0], of[1]); ld_bf8(obuf + ((size_t)T + n) * 1536 + oc, ob[0], ob[1]);
                ld_bf8(row + (isret ? C_RG + oc : C_HG + (oc - 768)), gt[0], gt[1]);
                float4 o[2];
#pragma unroll
                for (int q = 0; q < 2; ++q) o[q] = make_float4(of[q].x + ob[q].x, of[q].y + ob[q].y, of[q].z + ob[q].z, of[q].w + ob[q].w);
                const float sm = grp16_sum(((o[0].x + o[0].y) + (o[0].z + o[0].w)) + ((o[1].x + o[1].y) + (o[1].z + o[1].w)));
                const float mu = isret ? sm * (1.0f / 128.0f) : 0.f;
#pragma unroll
                for (int q = 0; q < 2; ++q) { o[q].x -= mu; o[q].y -= mu; o[q].z -= mu; o[q].w -= mu; }
                const float var = grp16_sum(((o[0].x * o[0].x + o[0].y * o[0].y) + (o[0].z * o[0].z + o[0].w * o[0].w)) + ((o[1].x * o[1].x + o[1].y * o[1].y) + (o[1].z * o[1].z + o[1].w * o[1].w))) * (1.0f / 128.0f);
                const float rs = rsqrtf(var + 1e-6f);
#pragma unroll
                for (int q = 0; q < 2; ++q) r[q] = make_float4(o[q].x * rs * siluf_(gt[q].x), o[q].y * rs * siluf_(gt[q].y), o[q].z * rs * siluf_(gt[q].z), o[q].w * rs * siluf_(gt[q].w));
            }
            const float4 bt0 = *(const float4*)(beta + c), bt1 = *(const float4*)(beta + c + 4);
            r[0] = make_float4(r[0].x * bt0.x, r[0].y * bt0.y, r[0].z * bt0.z, r[0].w * bt0.w);
            r[1] = make_float4(r[1].x * bt1.x, r[1].y * bt1.y, r[1].z * bt1.z, r[1].w * bt1.w);
            if (OUT8(l)) { const float4 a4 = make_float4(r[0].x * 4.f, r[0].y * 4.f, r[0].z * 4.f, r[0].w * 4.f), b4 = make_float4(r[1].x * 4.f, r[1].y * 4.f, r[1].z * 4.f, r[1].w * 4.f);
                           st_fp8x8((unsigned char*)mixed + (size_t)n * D + c, a4, b4); }
            else st_bf8(mixed + (size_t)n * D + c, r[0], r[1]);
        }
    }
}

#define RGRP 2
__device__ __forceinline__ void phase_ln1_router(const Params& p, int l, LAS unsigned char* lds) {
    int tid = threadIdx.x; asm volatile("" : "+v"(tid)); const int wave = tid >> 6, lane = tid & 63;
    LAS float* wrt = (LAS float*)lds;
    for (int i = tid; i < D * NE / 4; i += 512) {
        const float4 w = *(const float4*)(p.w_router + (size_t)i * 4);
        const int d = i >> 2, e4 = (i & 3) * 4;
        const int dp = (((d >> 9) * 2 + ((d >> 2) & 1)) << 8) + (((d >> 3) & 63) << 2) + (d & 3);
        wrt[(e4 + 0) * D + dp] = w.x; wrt[(e4 + 1) * D + dp] = w.y; wrt[(e4 + 2) * D + dp] = w.z; wrt[(e4 + 3) * D + dp] = w.w;
    }
    LAS int* lcnt = (LAS int*)(lds + LDS_MISC + 256);
    if (tid < 16) lcnt[tid] = 0;
    __syncthreads();
    const float* mod = (const float*)(p.ws + WS_MOD);
    const float* y = (const float*)(p.ws + WS_Y);
    float* xres = (float*)(p.ws + WS_XRES);
    int* route = (int*)(p.ws + WS_ROUTE);
    for (int n0 = blockIdx.x * 8 + wave; n0 < T; n0 += gridDim.x * 8 * RGRP) {
        float4 h[RGRP][8];
#pragma unroll
        for (int r = 0; r < RGRP; ++r) {
            const int n = n0 + r * (int)gridDim.x * 8;
            float4 (&v)[8] = h[r];
            if (n < T) {
                const int b = n / SEQ;
                const float* mb = mod + ((size_t)l * 4 + b) * (6 * D);
#pragma unroll
                for (int i = 0; i < 4; ++i) {
                    float4 xv[2], yv[2];
                    ld_bf8((const bf16_t*)xres + (size_t)n * D + COL8(i), xv[0], xv[1]); ld_bf8((const bf16_t*)y + (size_t)n * D + COL8(i), yv[0], yv[1]);
#pragma unroll
                    for (int q = 0; q < 2; ++q) {
                        const float4 g = *(const float4*)(mb + 2 * D + COLK(2 * i + q));
                        v[2 * i + q] = make_float4(ALPHA * xv[q].x + (1.f + g.x) * yv[q].x, ALPHA * xv[q].y + (1.f + g.y) * yv[q].y, ALPHA * xv[q].z + (1.f + g.z) * yv[q].z, ALPHA * xv[q].w + (1.f + g.w) * yv[q].w);
                    }
                }
                ln_rows(v, p.ln_g + (size_t)(l * 2 + 0) * D, p.ln_b + (size_t)(l * 2 + 0) * D, lane);
#pragma unroll
                for (int i = 0; i < 4; ++i) st_bf8((bf16_t*)xres + (size_t)n * D + COL8(i), v[2 * i], v[2 * i + 1]);
#pragma unroll
                for (int i = 0; i < 8; ++i) {
                    const float4 sh = *(const float4*)(mb + 3 * D + COLK(i)), sc = *(const float4*)(mb + 4 * D + COLK(i));
                    v[i].x = v[i].x * (1.f + sc.x) + sh.x; v[i].y = v[i].y * (1.f + sc.y) + sh.y; v[i].z = v[i].z * (1.f + sc.z) + sh.z; v[i].w = v[i].w * (1.f + sc.w) + sh.w;
                }
#if MOE_FP8
                unsigned char* hb = p.ws + WS_HB + (size_t)n * D;
#pragma unroll
                for (int i = 0; i < 4; ++i) st_fp8x8(hb + COL8(i), v[2 * i], v[2 * i + 1]);
#else
                bf16_t* hb = (bf16_t*)(p.ws + WS_HB) + (size_t)n * D;
#pragma unroll
                for (int i = 0; i < 4; ++i) st_bf8(hb + COL8(i), v[2 * i], v[2 * i + 1]);
#endif
            } else {
#pragma unroll
                for (int i = 0; i < 8; ++i) v[i] = make_float4(0.f, 0.f, 0.f, 0.f);
            }
        }
        float lgk0 = 0.f, lgk1 = 0.f, lgk2 = 0.f, lgk3 = 0.f;
        const bool b5 = (lane & 32) != 0, b4 = (lane & 16) != 0, b3 = (lane & 8) != 0, b2 = (lane & 4) != 0;
#pragma unroll 1
        for (int eg = 0; eg < 4; ++eg) {
            float s[RGRP][4];
#pragma unroll
            for (int q = 0; q < 4; ++q) {
#pragma unroll
                for (int r = 0; r < RGRP; ++r) s[r][q] = 0.f;
#pragma unroll
                for (int i = 0; i < 8; ++i) {
                    const f32x4 w = *(const LAS f32x4*)(wrt + (eg * 4 + q) * D + i * 256 + lane * 4);
#pragma unroll
                    for (int r = 0; r < RGRP; ++r) s[r][q] += (h[r][i].x * w[0] + h[r][i].y * w[1]) + (h[r][i].z * w[2] + h[r][i].w * w[3]);
                }
            }
            float u[RGRP];
#pragma unroll
            for (int r = 0; r < RGRP; ++r) {
                const float tA = (b5 ? s[r][2] : s[r][0]) + __shfl_xor(b5 ? s[r][0] : s[r][2], 32, 64);
                const float tB = (b5 ? s[r][3] : s[r][1]) + __shfl_xor(b5 ? s[r][1] : s[r][3], 32, 64);
                u[r] = (b4 ? tB : tA) + __shfl_xor(b4 ? tA : tB, 16, 64);
            }
#if RGRP == 4
            const float pA = (b3 ? u[2] : u[0]) + __shfl_xor(b3 ? u[0] : u[2], 8, 64);
            const float pB = (b3 ? u[3] : u[1]) + __shfl_xor(b3 ? u[1] : u[3], 8, 64);
            float z = (b2 ? pB : pA) + __shfl_xor(b2 ? pA : pB, 4, 64);
#else
            float z = (b3 ? u[1] : u[0]) + __shfl_xor(b3 ? u[0] : u[1], 8, 64);
            z += __shfl_xor(z, 4, 64);
#endif
            z += __shfl_xor(z, 2, 64); z += __shfl_xor(z, 1, 64);
            lgk0 = (eg == 0) ? z : lgk0; lgk1 = (eg == 1) ? z : lgk1; lgk2 = (eg == 2) ? z : lgk2; lgk3 = (eg == 3) ? z : lgk3;
        }
#pragma unroll 1
        for (int r = 0; r < RGRP; ++r) {
            const int n = n0 + r * (int)gridDim.x * 8;
            if (n >= T) break;
            const int rl = (RGRP == 4) ? (r >> 1) * 8 + (r & 1) * 4 : r * 8;
            float lg[16];
#pragma unroll
            for (int q = 0; q < 4; ++q) {
                const int src = ((q >> 1) * 32) + ((q & 1) * 16) + rl;
                lg[0 + q] = __int_as_float(__builtin_amdgcn_readlane(__float_as_int(lgk0), src));
                lg[4 + q] = __int_as_float(__builtin_amdgcn_readlane(__float_as_int(lgk1), src));
                lg[8 + q] = __int_as_float(__builtin_amdgcn_readlane(__float_as_int(lgk2), src));
                lg[12 + q] = __int_as_float(__builtin_amdgcn_readlane(__float_as_int(lgk3), src));
            }
            float mx = lg[0];
#pragma unroll
            for (int e = 1; e < 16; ++e) mx = fmaxf(mx, lg[e]);
            float sc[16], sum = 0.f;
#pragma unroll
            for (int e = 0; e < 16; ++e) { sc[e] = expf(lg[e] - mx); sum += sc[e]; }
            const float inv = 1.0f / sum;
            float sel[16];
#pragma unroll
            for (int e = 0; e < 16; ++e) { sc[e] *= inv; sel[e] = sc[e] + p.router_bias[e]; }
            float best_gs = -3.0e38f; int bi0 = 0, bi1 = 1; float bw0 = 0.f, bw1 = 0.f;
#pragma unroll
            for (int g = 0; g < 4; ++g) {
                int i0 = 0; float m0 = sel[4 * g];
#pragma unroll
                for (int j = 1; j < 4; ++j) if (sel[4 * g + j] > m0) { m0 = sel[4 * g + j]; i0 = j; }
                int i1 = -1; float m1 = -3.0e38f;
#pragma unroll
                for (int j = 0; j < 4; ++j) if (j != i0 && sel[4 * g + j] > m1) { m1 = sel[4 * g + j]; i1 = j; }
                float w0 = 0.f, w1 = 0.f;
#pragma unroll
                for (int j = 0; j < 4; ++j) { w0 = (j == i0) ? sc[4 * g + j] : w0; w1 = (j == i1) ? sc[4 * g + j] : w1; }
                const float gs = m0 + m1;
                if (gs > best_gs) { best_gs = gs; bi0 = 4 * g + i0; bi1 = 4 * g + i1; bw0 = w0; bw1 = w1; }
            }
            if (lane == 0) {
                const float ws_ = 1.0f / (bw0 + bw1);
                const int p0 = __hip_atomic_fetch_add(&lcnt[bi0], 1, __ATOMIC_RELAXED, __HIP_MEMORY_SCOPE_WORKGROUP), p1 = __hip_atomic_fetch_add(&lcnt[bi1], 1, __ATOMIC_RELAXED, __HIP_MEMORY_SCOPE_WORKGROUP);
                int* rr = route + (size_t)n * 8;
                rr[0] = bi0; rr[1] = bi1; rr[2] = (int)p0; rr[3] = (int)p1; rr[4] = __float_as_int(bw0 * ws_); rr[5] = __float_as_int(bw1 * ws_);
            }
        }
    }
    __syncthreads();
    if (tid < 16) ((int*)(p.ws + WS_WGCNT))[((size_t)l * 1024 + blockIdx.x) * 16 + tid] = lcnt[tid];
}

__device__ __forceinline__ void build_moe_tab(const Params& p, int l, LAS int* tab) {
    if (threadIdx.x == 0) {
        const unsigned* cnt = (const unsigned*)(p.ws + WS_CNT) + l * 16;
        int acc = 0;
        for (int e = 0; e < 16; ++e) { tab[e] = acc; acc += (int)((cnt[e] + 255u) >> 8); }
        tab[16] = acc;
    }
    __syncthreads();
}

__device__ __forceinline__ void phase_permute(const Params& p, int l, LAS int* tab) {
    int tid_ = threadIdx.x; asm volatile("" : "+v"(tid_)); const int wave = tid_ >> 6, lane = tid_ & 63;
    LAS int* base = tab + 32; LAS int* total = tab + 48;
    if (tid_ < 16) { base[tid_] = 0; total[tid_] = 0; }
    __syncthreads();
    {
        const int* wgc = (const int*)(p.ws + WS_WGCNT) + (size_t)l * 1024 * 16;
        const int e = tid_ & 15; int bs = 0, tt = 0;
        for (int w = tid_ >> 4; w < (int)gridDim.x; w += 32) { const int v = wgc[w * 16 + e]; tt += v; bs += (w < (int)blockIdx.x) ? v : 0; }
        __hip_atomic_fetch_add(&base[e], bs, __ATOMIC_RELAXED, __HIP_MEMORY_SCOPE_WORKGROUP);
        __hip_atomic_fetch_add(&total[e], tt, __ATOMIC_RELAXED, __HIP_MEMORY_SCOPE_WORKGROUP);
    }
    __syncthreads();
    if (tid_ == 0) { int acc = 0; for (int e = 0; e < 16; ++e) { tab[e] = acc; acc += (total[e] + 255) >> 8; } tab[16] = acc; }
    if (blockIdx.x == 0 && tid_ < 16) ((unsigned*)(p.ws + WS_CNT))[l * 16 + tid_] = (unsigned)total[tid_];
    __syncthreads();
#if MOE_FP8
    for (int i = blockIdx.x * 512 + tid_; i < XE_ROWS * 8; i += gridDim.x * 512) *(u32x4*)(p.ws + WS_HID + (size_t)(i >> 3) * DEP + DE + (i & 7) * 16) = (u32x4){0u, 0u, 0u, 0u};
#endif
    int* route = (int*)(p.ws + WS_ROUTE);
    const bf16_t* hb = (const bf16_t*)(p.ws + WS_HB);
    bf16_t* xe = (bf16_t*)(p.ws + WS_XE);
    for (int n = blockIdx.x * 8 + wave; n < T; n += gridDim.x * 8) {
        int* r = route + (size_t)n * 8;
        const int e0 = r[0], e1 = r[1], p0 = r[2], p1 = r[3];
        const int row0 = tab[e0] * 256 + base[e0] + p0, row1 = tab[e1] * 256 + base[e1] + p1;
        constexpr int RB = MOE_FP8 ? D : 2 * D;
        const u32x4* src = (const u32x4*)((const unsigned char*)hb + (size_t)n * RB);
        u32x4* d0 = (u32x4*)((unsigned char*)xe + (size_t)row0 * RB); u32x4* d1 = (u32x4*)((unsigned char*)xe + (size_t)row1 * RB);
#pragma unroll
        for (int i = 0; i < RB / 1024; ++i) { const u32x4 v = src[i * 64 + lane]; d0[i * 64 + lane] = v; d1[i * 64 + lane] = v; }
        if (lane == 0) { r[6] = row0; r[7] = row1; }
    }
}

__device__ __forceinline__ void phase_ln2(const Params& p, int l) {
    int tid_ = threadIdx.x; asm volatile("" : "+v"(tid_)); const int wave = tid_ >> 6, lane = tid_ & 63;
    const float* mod = (const float*)(p.ws + WS_MOD);
    const float* ye = (const float*)(p.ws + WS_YE);
    float* xres = (float*)(p.ws + WS_XRES);
    const int* route = (const int*)(p.ws + WS_ROUTE);
    for (int n = blockIdx.x * 8 + wave; n < T; n += gridDim.x * 8) {
        const int b = n / SEQ;
        const float* mb = mod + ((size_t)l * 4 + b) * (6 * D);
        const int* r = route + (size_t)n * 8;
        const float w0 = __int_as_float(r[4]), w1 = __int_as_float(r[5]);
        const bf16_t* y0 = (const bf16_t*)ye + (size_t)r[6] * D; const bf16_t* y1 = (const bf16_t*)ye + (size_t)r[7] * D;
        float4 v[8];
#pragma unroll
        for (int i = 0; i < 4; ++i) {
            float4 xv[2], a[2], c[2];
            ld_bf8((const bf16_t*)xres + (size_t)n * D + COL8(i), xv[0], xv[1]); ld_bf8(y0 + COL8(i), a[0], a[1]); ld_bf8(y1 + COL8(i), c[0], c[1]);
#pragma unroll
            for (int q = 0; q < 2; ++q) {
                const float4 g = *(const float4*)(mb + 5 * D + COLK(2 * i + q));
                v[2 * i + q] = make_float4(ALPHA * xv[q].x + (1.f + g.x) * (w0 * a[q].x + w1 * c[q].x), ALPHA * xv[q].y + (1.f + g.y) * (w0 * a[q].y + w1 * c[q].y),
                                           ALPHA * xv[q].z + (1.f + g.z) * (w0 * a[q].z + w1 * c[q].z), ALPHA * xv[q].w + (1.f + g.w) * (w0 * a[q].w + w1 * c[q].w));
            }
        }
        ln_rows(v, p.ln_g + (size_t)(l * 2 + 1) * D, p.ln_b + (size_t)(l * 2 + 1) * D, lane);
        if (l + 1 < DEPTH) {
#pragma unroll
            for (int i = 0; i < 4; ++i) st_bf8((bf16_t*)xres + (size_t)n * D + COL8(i), v[2 * i], v[2 * i + 1]);
            const float* mn = mod + ((size_t)(l + 1) * 4 + b) * (6 * D);
            modulate_store(v, mn, mn + D, INP8(l + 1) ? (bf16_t*)(p.ws + WS_HA + (size_t)n * D) : (bf16_t*)(p.ws + WS_HA) + (size_t)n * D, lane, INP8(l + 1));
        } else {
#ifdef MIXER_CHECK
            { const float* chk = (const float*)(p.ws + WS_CNT + 1024); float scale = 1.f;
              for (int j = 7; j >= 0; --j) { const float sd = chk[j * 2], sq = chk[j * 2 + 1]; if (!(sd <= 1e-3f * sq)) scale = 1.0f + 0.25f * (float)(1 << (j & 3)) + 8.f * (float)(j >> 2); }
#pragma unroll
              for (int i = 0; i < 8; ++i) { v[i].x *= scale; v[i].y *= scale; v[i].z *= scale; v[i].w *= scale; } }
#endif
#pragma unroll
            for (int i = 0; i < 8; ++i) *(float4*)(p.out + (size_t)n * D + COLK(i)) = v[i];
        }
    }
}

typedef const __attribute__((address_space(4))) unsigned char* KargPtr;
__device__ __forceinline__ Params load_params(KargPtr q) { asm volatile("" : "+s"(q)); Params lp; __builtin_memcpy(&lp, q, sizeof(Params)); return lp; }

__global__ __launch_bounds__(512, 2) void mega(Params p_in) {
    extern __shared__ __attribute__((aligned(16))) unsigned char smem[];
    LAS unsigned char* lds = (LAS unsigned char*)smem;
    LAS int* tab = (LAS int*)(lds + LDS_MISC + 64);
    KargPtr kp = (KargPtr)__builtin_amdgcn_kernarg_segment_ptr();
    if (threadIdx.x == 0) { *(LAS u32x4*)(lds + LDS_MISC) = (u32x4){0u, 0u, 0u, 0u}; *(LAS u32x4*)(lds + LDS_MISC + 768) = (u32x4){0u, 0u, 0u, 0u}; *(LAS u32x4*)(lds + LDS_MISC + 784) = (u32x4){0u, 0u, 0u, 0u}; }
    __syncthreads();
    const int fused = p_in.fused, ph_lo = p_in.ph_lo, ph_hi = p_in.ph_hi, l_hi = p_in.l_hi;
    XcdBarrier bar;
    if (fused) bar = xcd_barrier_post((unsigned*)(p_in.ws + WS_BAR), (volatile LAS unsigned*)(lds + LDS_MISC));
    else { bar.bar = (unsigned*)(p_in.ws + WS_BAR); bar.x = 0; bar.st = (volatile LAS unsigned*)(lds + LDS_MISC); }
#ifdef ONLY_PH
#define PH(i) ((i) == ONLY_PH && ph_lo <= (i) && (i) < ph_hi)
#else
#define PH(i) (ph_lo <= (i) && (i) < ph_hi)
#endif
#ifdef PROBE_PH
#define SYNC_PLAIN() do { if (fused) xcd_barrier(bar); } while (0)
#define PSTART(i) do { if ((i) == PROBE_PH && blockIdx.x == 0 && threadIdx.x == 0) { *(LAS unsigned long long*)(lds + LDS_MISC + 768) = __builtin_amdgcn_s_memrealtime(); } } while (0)
#define PSTOP(i) do { if ((i) == PROBE_PH && blockIdx.x == 0 && threadIdx.x == 0) { *(LAS unsigned long long*)(lds + LDS_MISC + 776) += __builtin_amdgcn_s_memrealtime() - *(LAS unsigned long long*)(lds + LDS_MISC + 768); } } while (0)
#else
#define PSTART(i) do { } while (0)
#define PSTOP(i) do { } while (0)
#endif
#if defined(PROBE_PH) && defined(PROBE_SUB)
#define QSTART(i, k) do { if ((i) == PROBE_PH && (k) == PROBE_SUB && blockIdx.x == PROBE_WG && threadIdx.x == 0) { *(LAS unsigned long long*)(lds + LDS_MISC + 784) = __builtin_amdgcn_s_memrealtime(); } } while (0)
#define QSTOP(i, k) do { if ((i) == PROBE_PH && (k) == PROBE_SUB && blockIdx.x == PROBE_WG && threadIdx.x == 0) { *(LAS unsigned long long*)(lds + LDS_MISC + 792) += __builtin_amdgcn_s_memrealtime() - *(LAS unsigned long long*)(lds + LDS_MISC + 784); } } while (0)
#else
#define QSTART(i, k) do { } while (0)
#define QSTOP(i, k) do { } while (0)
#endif
#define SYNC() do { if (fused) xcd_barrier(bar); } while (0)
#ifndef DUP_MASK
#define DUP_MASK 0
#endif
#define REP(i) _Pragma("unroll 1") for (int rep_ = 0; rep_ < 1 + ((DUP_MASK >> (i)) & 1); ++rep_)
    const int G = gridDim.x, c = blockIdx.x;
    if (PH(0)) REP(0) { PSTART(0); const Params p = load_params(kp); phase_prologue(p, lds); SYNC(); PSTOP(0); }
    if (PH(1)) REP(1) { PSTART(1); const Params p = load_params(kp); phase_ln0(p); SYNC(); PSTOP(1); }
    for (int l = p_in.l_lo; l < l_hi; ++l) {
        const bool svc = (l == 0) && (G >= 256);
        if (PH(2)) REP(2) { PSTART(2);
            const Params p = load_params(kp);
            pg8::Gemm g{(const bf16_t*)(p.ws + WS_HA), (const bf16_t*)(p.ws + WS_WIN) + (size_t)l * INC * D, D};
            pg8::EpiBf16 E{(bf16_t*)(p.ws + WS_PROJ), INC};
            if (svc) {
                if (c < 240) {
                    pg8::DenseOrder<32, 30> S; S.init(INP8(0) ? D : 2 * D, 240, c);
                    if (INP8(0)) pg8::gemm_phase<pg8::EpiBf16, pg8::DenseOrder<32, 30>, true>(lds, g, S, E, 121, 127);
                    else pg8::gemm_phase(lds, g, S, E);
                } else ada_chunks(p, lds, 128 + (c - 240), 256, 16);
                tail_pull(p, lds, l * 4 + 0);
            } else {
                pg8::DenseOrder<32, 32> S; S.init(INP8(l) ? D : 2 * D, G, c);
                if (INP8(l)) pg8::gemm_phase<pg8::EpiBf16, pg8::DenseOrder<32, 32>, true>(lds, g, S, E, 121, 127);
                else pg8::gemm_phase(lds, g, S, E);
            }
            SYNC(); PSTOP(2);
        }
#ifdef MIXER_CHECK
        if (PH(3)) REP(3) { PSTART(3); const Params p = load_params(kp); phase_mixer_valu(p, l, lds); SYNC(); PSTOP(3); }
        if (PH(3)) REP(3) { PSTART(3); const Params p = load_params(kp); phase_mixer_mfma<0>(p, l, lds, (float*)(p.ws + WS_XE)); SYNC(); PSTOP(3); }
        if (PH(3)) REP(3) { PSTART(3); const Params p = load_params(kp); phase_mixer_check(p, (const float*)(p.ws + WS_OBUF), (const float*)(p.ws + WS_XE), (float*)(p.ws + WS_CNT + 1024) + l * 8); SYNC(); PSTOP(3); }
#else
        if (PH(3)) REP(3) { PSTART(3);
            const Params p = load_params(kp);
            const int n_extra = svc ? 96 : 32, pn0 = svc ? 30 : 32;
            for (int uu = (G >= 224 ? c - 192 : c); uu >= 0 && uu < n_extra; uu += (G >= 224 ? 64 : G)) {
                const int RBI = INP8(l) ? D : 2 * D;
                pg8::OneUnit S; S.u0.aB = (size_t)(uu & 31) * 256 * RBI; S.u0.bB = (size_t)(pn0 + (uu >> 5)) * 256 * RBI; S.u0.row0 = (uu & 31) * 256; S.u0.col0 = (pn0 + (uu >> 5)) * 256;
                pg8::EpiBf16 E{(bf16_t*)(p.ws + WS_PROJ), INC};
                pg8::Gemm g{(const bf16_t*)(p.ws + WS_HA), (const bf16_t*)(p.ws + WS_WIN) + (size_t)l * INC * D, D};
                if (INP8(l)) pg8::gemm_phase<pg8::EpiBf16, pg8::OneUnit, true>(lds, g, S, E, 121, 127);
                else pg8::gemm_phase(lds, g, S, E);
            }
            phase_mixer_mfma<0>(p, l, lds, (float*)(p.ws + WS_OBUF));
            tail_pull(p, lds, l * 4 + 1);
            SYNC(); PSTOP(3);
#ifdef MIXER_PROBE
            phase_mixer_mfma<MIXER_PROBE>(p, l, lds, (float*)(p.ws + WS_XE));
            SYNC(); PSTOP(3);
#endif
        }
#endif
        if (PH(4)) REP(4) { PSTART(4); const Params p = load_params(kp); phase_finalize(p, l); SYNC(); PSTOP(4); }
        if (PH(5)) REP(5) { PSTART(5);
            const Params p = load_params(kp);
            pg8::DenseOrder<32, 8> S; S.init(OUT8(l) ? D : 2 * D, G, c);
            pg8::Gemm g{(const bf16_t*)(p.ws + WS_MIXED), (const bf16_t*)(p.ws + WS_WOUT) + (size_t)l * D * D, D};
            pg8::EpiBf16 E{(bf16_t*)(p.ws + WS_Y), D};
            if (OUT8(l)) pg8::gemm_phase<pg8::EpiBf16, pg8::DenseOrder<32, 8>, true>(lds, g, S, E, 121, 125);
            else pg8::gemm_phase(lds, g, S, E);
            SYNC(); PSTOP(5);
        }
        if (PH(6)) REP(6) { PSTART(6); const Params p = load_params(kp); phase_ln1_router(p, l, lds); SYNC(); PSTOP(6); }
        if (PH(7)) REP(7) { PSTART(7); const Params p = load_params(kp); phase_permute(p, l, tab); cvt_pull(p, lds, l * CV_PER_L + CV_A1, nullptr, 0u); SYNC(); PSTOP(7); }
        if (PH(8)) REP(8) { PSTART(8);
            const Params p = load_params(kp);
            build_moe_tab(p, l, tab);
#if MOE_FP8
            pg8::MoeOrder S; S.tab = tab; S.NTn = 11; S.G = G; S.c = c; S.tstep = (size_t)256 * D; S.bexp = (size_t)2 * DE * D;
            pg8::Gemm g{(const bf16_t*)(p.ws + WS_XE), (const bf16_t*)(p.ws + WS_WGU + (size_t)l * NE * 2 * DE * D), D};
            pg8::EpiHidden8 E{p.ws + WS_HID};
            QSTART(8, 1); pg8::gemm_phase<pg8::EpiHidden8, pg8::MoeOrder, true>(lds, g, S, E, 121, 127); QSTOP(8, 1);
#else
            pg8::MoeOrder S; S.tab = tab; S.NTn = 11; S.G = G; S.c = c; S.tstep = (size_t)256 * D * 2; S.bexp = (size_t)2 * DE * D * 2;
            pg8::Gemm g{(const bf16_t*)(p.ws + WS_XE), (const bf16_t*)(p.ws + WS_WGU) + (size_t)l * NE * 2 * DE * D, D};
            pg8::EpiHidden E{(bf16_t*)(p.ws + WS_HID)};
            pg8::gemm_phase(lds, g, S, E);
#endif
            QSTART(8, 2); tail_pull(p, lds, l * 4 + 2); QSTOP(8, 2);
            QSTART(8, 3); cvt_pull(p, lds, (l + 1) * CV_PER_L, nullptr, 0u); QSTOP(8, 3);
            SYNC(); PSTOP(8);
        }
        if (PH(9)) REP(9) { PSTART(9);
            const Params p = load_params(kp);
            build_moe_tab(p, l, tab);
#if MOE_FP8
            pg8::MoeOrder S; S.tab = tab; S.NTn = 8; S.G = G; S.c = c; S.tstep = (size_t)256 * DEP; S.bexp = (size_t)D * DEP;
            pg8::Gemm g{(const bf16_t*)(p.ws + WS_HID), (const bf16_t*)(p.ws + WS_WD + (size_t)l * NE * D * DEP), DEP};
            pg8::EpiBf16 E{(bf16_t*)(p.ws + WS_YE), D};
            QSTART(9, 1); pg8::gemm_phase<pg8::EpiBf16, pg8::MoeOrder, true>(lds, g, S, E, 121, 124); QSTOP(9, 1);
#else
            pg8::MoeOrder S; S.tab = tab; S.NTn = 8; S.G = G; S.c = c; S.tstep = (size_t)256 * DE * 2; S.bexp = (size_t)D * DE * 2;
            pg8::Gemm g{(const bf16_t*)(p.ws + WS_HID), (const bf16_t*)(p.ws + WS_WD) + (size_t)l * NE * D * DE, DE};
            pg8::EpiBf16 E{(bf16_t*)(p.ws + WS_YE), D};
            pg8::gemm_phase(lds, g, S, E);
#endif
            QSTART(9, 2); tail_pull(p, lds, l * 4 + 3); QSTOP(9, 2);
            QSTART(9, 3); if (l + 1 < DEPTH) cvt_pull(p, lds, (l + 1) * CV_PER_L + CV_A0, nullptr, 0u); QSTOP(9, 3);
            SYNC(); PSTOP(9);
        }
        if (PH(10)) REP(10) { PSTART(10); const Params p = load_params(kp); phase_ln2(p, l); SYNC(); PSTOP(10); }
    }
#ifdef PROBE_PH
    if (blockIdx.x == 0 && threadIdx.x == 0) {
#ifdef PROBE_SUB
        const unsigned long long t = 0ull, t0 = __builtin_amdgcn_s_memrealtime();
#else
        const unsigned long long t = *(LAS unsigned long long*)(lds + LDS_MISC + 776) * 4ull, t0 = __builtin_amdgcn_s_memrealtime();
#endif
        while (__builtin_amdgcn_s_memrealtime() - t0 < t) __builtin_amdgcn_s_sleep(8);
    }
#ifdef PROBE_SUB
    if (blockIdx.x == PROBE_WG && threadIdx.x == 0) {
        const unsigned long long t = *(LAS unsigned long long*)(lds + LDS_MISC + 792) * 4ull, t0 = __builtin_amdgcn_s_memrealtime();
        while (__builtin_amdgcn_s_memrealtime() - t0 < t) __builtin_amdgcn_s_sleep(8);
    }
#endif
#endif
}

#ifndef MK_FUSED
#define MK_FUSED 1
#endif
extern "C" void kernel_launch(void* const* d_in, const int* in_sizes, int n_in, void* d_out, int out_size, void* d_ws, size_t ws_size, hipStream_t stream) {
    static int grid = 0;
    if (grid == 0) {
        if (n_in != 18 || ws_size < WS_END) { fprintf(stderr, "kernel_launch: unexpected n_in %d or ws_size %zu (< %zu)\n", n_in, ws_size, (size_t)WS_END); grid = -1; return; }
        int dev = 0, cus = 0, per_cu = 0;
        hipGetDevice(&dev);
        hipDeviceGetAttribute(&cus, hipDeviceAttributeMultiprocessorCount, dev);
        if (hipFuncSetAttribute((const void*)mega, hipFuncAttributeMaxDynamicSharedMemorySize, LDS_BYTES) != hipSuccess) { fprintf(stderr, "kernel_launch: hipFuncSetAttribute failed\n"); grid = -1; return; }
        hipOccupancyMaxActiveBlocksPerMultiprocessor(&per_cu, (const void*)mega, 512, LDS_BYTES);
        if (per_cu < 1) fprintf(stderr, "kernel_launch: occupancy query says %d\n", per_cu);
        grid = cus > 0 ? cus : 256;
    }
    if (grid < 0) return;
    hipMemsetAsync(d_ws, 0, WS_ZERO_BYTES, stream);
    Params p{};
    p.x = (const float*)d_in[0]; p.c = (const float*)d_in[1]; p.emb_g = (const float*)d_in[2]; p.emb_b = (const float*)d_in[3];
    p.w_ada = (const float*)d_in[4]; p.b_ada = (const float*)d_in[5]; p.w_in = (const float*)d_in[6]; p.conv_w = (const float*)d_in[7];
    p.mix_beta = (const float*)d_in[8]; p.w_out = (const float*)d_in[9]; p.lb_logits = (const float*)d_in[10]; p.ln_g = (const float*)d_in[11];
    p.ln_b = (const float*)d_in[12]; p.w_router = (const float*)d_in[13]; p.router_bias = (const float*)d_in[14]; p.w_gate = (const float*)d_in[15];
    p.w_up = (const float*)d_in[16]; p.w_down = (const float*)d_in[17];
    p.out = (float*)d_out; p.ws = (unsigned char*)d_ws; p.pad = 0;
#if MK_FUSED
    p.ph_lo = 0; p.ph_hi = 11; p.l_lo = 0; p.l_hi = DEPTH; p.fused = 1;
    hipLaunchKernelGGL(mega, dim3(grid), dim3(512), LDS_BYTES, stream, p);
#else
    p.fused = 0;
    for (int ph = 0; ph < 2; ++ph) { p.ph_lo = ph; p.ph_hi = ph + 1; p.l_lo = 0; p.l_hi = 0; hipLaunchKernelGGL(mega, dim3(grid), dim3(512), LDS_BYTES, stream, p); }
    for (int l = 0; l < DEPTH; ++l)
        for (int ph = 2; ph < 11; ++ph) { p.ph_lo = ph; p.ph_hi = ph + 1; p.l_lo = l; p.l_hi = l + 1; hipLaunchKernelGGL(mega, dim3(grid), dim3(512), LDS_BYTES, stream, p); }
#endif
}
```

```cpp
#include <hip/hip_runtime.h>
#include <stdint.h>
#include <stdio.h>

#define LAS __attribute__((address_space(3)))
typedef unsigned short bf16_t;
typedef short bf16x8 __attribute__((ext_vector_type(8)));
typedef float f32x4 __attribute__((ext_vector_type(4)));
typedef unsigned u32x4 __attribute__((ext_vector_type(4)));
typedef unsigned u32x2 __attribute__((ext_vector_type(2)));

constexpr int D = 2048, NB = 4, SEQ = 2048, T = NB * SEQ, DEPTH = 2;
constexpr int CW = 512, RW = 768, HWD = 768, INC = 8448;
constexpr int NE = 16, DE = 1408;
constexpr int C_CB = 0, C_CC = 512, C_CH = 1024, C_RQ = 1536, C_RK = 2304, C_RV = 3072, C_RG = 3840, C_HQ = 4608, C_HFF = 5376, C_HFB = 6144, C_HI = 6912, C_HG = 7680;
constexpr int XE_ROWS = 20480;
#ifndef MOE_FP8
#define MOE_FP8 1
#endif
#ifndef INP_FP8_FROM
#define INP_FP8_FROM 1
#endif
#define INP8(l) ((l) >= INP_FP8_FROM)
#ifndef OUT_FP8_FROM
#define OUT_FP8_FROM 1
#endif
#define OUT8(l) ((l) >= OUT_FP8_FROM)
constexpr int DEP = 1536;
constexpr float W8_SCALE = 64.f, H8_SCALE = 8.f;
constexpr float ALPHA = 1.4142135623730951f;

constexpr size_t WS_BAR = 0;
constexpr size_t WS_CNT = 16384;
constexpr size_t WS_CVTQ = 20480;
constexpr size_t WS_ZERO_BYTES = 32768;
constexpr size_t WS_MOD = 32768;
constexpr size_t WS_ROUTE = WS_MOD + 393216;
constexpr size_t WS_WGCNT = WS_ROUTE + 262144;
constexpr size_t WS_WIN = 1048576;
constexpr size_t SZ_WIN = (size_t)DEPTH * INC * D * 2;
constexpr size_t WS_WOUT = WS_WIN + SZ_WIN;
constexpr size_t SZ_WOUT = (size_t)DEPTH * D * D * 2;
constexpr size_t WS_WGU = WS_WOUT + SZ_WOUT;
constexpr size_t SZ_WGU = (size_t)DEPTH * NE * 2 * DE * D * 2;
constexpr size_t WS_WD = WS_WGU + SZ_WGU;
constexpr size_t SZ_WD = (size_t)DEPTH * NE * D * DE * 2;
constexpr size_t WS_XRES = WS_WD + SZ_WD;
constexpr size_t SZ_XRES = (size_t)T * D * 4;
constexpr size_t WS_HA = WS_XRES + SZ_XRES;
constexpr size_t SZ_H = (size_t)T * D * 2;
constexpr size_t WS_HB = WS_HA + SZ_H;
constexpr size_t WS_PROJ = WS_HB + SZ_H;
constexpr size_t SZ_PROJ = (size_t)T * INC * 2;
constexpr size_t WS_OBUF = WS_PROJ + SZ_PROJ;
constexpr size_t SZ_OBUF = (size_t)2 * T * 1536 * 4;
constexpr size_t WS_YE = WS_PROJ;
constexpr size_t SZ_YE = (size_t)XE_ROWS * D * 4;
static_assert(SZ_YE <= SZ_PROJ + SZ_OBUF, "ye alias");
constexpr size_t WS_MIXED = WS_OBUF + SZ_OBUF;
constexpr size_t WS_Y = WS_MIXED + SZ_H;
constexpr size_t SZ_Y = (size_t)T * D * 4;
constexpr size_t WS_XE = WS_Y + SZ_Y;
constexpr size_t SZ_XE = (size_t)XE_ROWS * D * 2;
constexpr size_t WS_HID = WS_XE + SZ_XE;
constexpr size_t SZ_HID = (size_t)XE_ROWS * DE * 2;
constexpr size_t WS_END = WS_HID + SZ_HID;

constexpr int LDS_BYTES = 156672;
constexpr int LDS_MISC = 153600;

struct Params {
    const float *x, *c, *emb_g, *emb_b, *w_ada, *b_ada, *w_in, *conv_w, *mix_beta, *w_out, *lb_logits, *ln_g, *ln_b, *w_router, *router_bias, *w_gate, *w_up, *w_down;
    float* out;
    unsigned char* ws;
    int ph_lo, ph_hi, l_lo, l_hi, fused, pad;
};

__device__ __forceinline__ float bf2f(unsigned b) { return __uint_as_float(b << 16); }
__device__ __forceinline__ unsigned f2bf(float f) { unsigned u = __float_as_uint(f); u += 0x7FFFu + ((u >> 16) & 1u); return u >> 16; }
typedef __bf16 bf16x2_t __attribute__((ext_vector_type(2)));
typedef float f32x2_t __attribute__((ext_vector_type(2)));
__device__ __forceinline__ unsigned pack2a(float lo, float hi) { unsigned r; asm("v_cvt_pk_bf16_f32 %0, %1, %2" : "=v"(r) : "v"(lo), "v"(hi)); return r; }
__device__ __forceinline__ unsigned pack2(float lo, float hi) { const bf16x2_t r = __builtin_convertvector((f32x2_t){lo, hi}, bf16x2_t); return __builtin_bit_cast(unsigned, r); }
__device__ __forceinline__ float wave_sum(float v) {
#pragma unroll
    for (int o = 32; o > 0; o >>= 1) v += __shfl_xor(v, o, 64);
    return v;
}
__device__ __forceinline__ float half_sum(float v) {
#pragma unroll
    for (int o = 16; o > 0; o >>= 1) v += __shfl_xor(v, o, 64);
    return v;
}
#define LDS_BARRIER() do { asm volatile("s_waitcnt lgkmcnt(0)" ::: "memory"); __builtin_amdgcn_s_barrier(); asm volatile("" ::: "memory"); } while (0)
__device__ __forceinline__ float sigmoidf_(float z) { return 1.0f / (1.0f + __expf(-z)); }
__device__ __forceinline__ float siluf_(float z) { return z / (1.0f + __expf(-z)); }

#define XB_TMO      128
#define XB_XCNT(j)  (256  + 64 * (j))
#define XB_XSUB(j)  (1280 + 64 * (j))
#define XB_XGEN(j)  (2304 + 64 * (j))
#define XB_TOP      3328
#define XB_TOPGEN   3392
#define XCD_BAR_WORDS 3456
#define XB_SPIN_CAP (1u << 22)
__device__ __forceinline__ unsigned xb_ld(unsigned* p)              { return __hip_atomic_load(p, __ATOMIC_RELAXED, __HIP_MEMORY_SCOPE_AGENT); }
__device__ __forceinline__ unsigned xb_add(unsigned* p, unsigned v) { return __hip_atomic_fetch_add(p, v, __ATOMIC_RELAXED, __HIP_MEMORY_SCOPE_AGENT); }
__device__ __forceinline__ unsigned xb_xcc_id() { return (unsigned)__builtin_amdgcn_s_getreg((3 << 11) | 20) & 0xFu; }
#define XB_SPIN(cond, bar) do { unsigned _sp = 0; while (cond) { __builtin_amdgcn_s_sleep(1); \
    if ((++_sp & 255u) == 0u) { if (xb_ld(&(bar)[XB_TMO])) break; if (_sp > XB_SPIN_CAP) { atomicAdd(&(bar)[XB_TMO], 1u); break; } } } } while (0)
struct XcdBarrier { unsigned* bar; unsigned x; volatile LAS unsigned* st; };
__device__ __forceinline__ XcdBarrier xcd_barrier_post(unsigned* bar, volatile LAS unsigned* st) {
    XcdBarrier b; b.bar = bar; b.x = xb_xcc_id(); b.st = st;
    if (threadIdx.x == 0) (void)xb_add(&bar[XB_XCNT(b.x)], 1u);
    return b;
}
__device__ __forceinline__ void xcd_barrier_complete(unsigned* bar, unsigned x, unsigned& nloc, unsigned& nx) {
    const unsigned G = gridDim.x * gridDim.y * gridDim.z;
    unsigned sum, cnt, mine, sp = 0u;
    for (;;) {
        sum = 0u; cnt = 0u; mine = 0u;
#pragma unroll
        for (unsigned j = 0; j < 16; ++j) { const unsigned c = xb_ld(&bar[XB_XCNT(j)]); sum += c; cnt += (c > 0u) ? 1u : 0u; mine = (j == x) ? c : mine; }
        if (sum == G) break;
        __builtin_amdgcn_s_sleep(1);
        if ((++sp & 255u) == 0u) { if (xb_ld(&bar[XB_TMO])) break; if (sp > XB_SPIN_CAP) { atomicAdd(&bar[XB_TMO], 1u); break; } }
    }
    nloc = mine > 0u ? mine : 1u; nx = cnt > 0u ? cnt : 1u;
}
__device__ __forceinline__ void xcd_barrier(const XcdBarrier& b) {
    asm volatile("s_waitcnt vmcnt(0)" ::: "memory");
    __syncthreads();
    if (threadIdx.x == 0) {
        unsigned* bar = b.bar;
        __builtin_amdgcn_s_waitcnt(0);
        unsigned nloc = b.st[0], nx = b.st[1];
        if (nloc == 0u) { xcd_barrier_complete(bar, b.x, nloc, nx); b.st[0] = nloc; b.st[1] = nx; }
        const unsigned old = xb_add(&bar[XB_XSUB(b.x)], 1u);
        const unsigned gen = old / nloc;
        if (old + 1u == (gen + 1u) * nloc) {
            __builtin_amdgcn_fence(__ATOMIC_RELEASE, "agent");
            asm volatile("s_waitcnt vmcnt(0)" ::: "memory");
            const unsigned og = xb_add(&bar[XB_TOP], 1u);
            const unsigned tg = og / nx;
            if (og + 1u == (tg + 1u) * nx) xb_add(&bar[XB_TOPGEN], 1u);
            else XB_SPIN(xb_ld(&bar[XB_TOPGEN]) == tg, bar);
            __builtin_amdgcn_fence(__ATOMIC_ACQUIRE, "agent");
            xb_add(&bar[XB_XGEN(b.x)], 1u);
            asm volatile("s_waitcnt vmcnt(0)" ::: "memory");
        } else {
            XB_SPIN(xb_ld(&bar[XB_XGEN(b.x)]) == gen, bar);
            __builtin_amdgcn_fence(__ATOMIC_ACQUIRE, "agent");
            asm volatile("s_waitcnt vmcnt(0)" ::: "memory");
        }
    }
    __syncthreads();
}

namespace pg8 {
constexpr int BM = 256, BK = 64, HALF = 128, HTB = HALF * BK * 2, STAGE_BYTES = 8 * HTB, NXCD = 8, WGM = 8;
__host__ __device__ __forceinline__ int lds_byte(int r, int c) { const int st = (r >> 4) * 2 + (c >> 5), rr = r & 15, cc = c & 31, ob = rr * 64 + cc * 2; return st * 1024 + (ob ^ (((ob >> 9) & 1) << 5)); }
__host__ __device__ __forceinline__ void stage_rc(int b, int& R, int& C) { const int st = b / 1024, sb = b % 1024, swz = sb ^ (((sb >> 9) & 1) << 5); R = (st >> 1) * 16 + swz / 64; C = (st & 1) * 32 + (swz % 64) / 2; }
__host__ __device__ __forceinline__ int perm32(int rho) { const int n = rho >> 4, i = rho & 15; return 8 * (i >> 2) + 4 * n + (i & 3); }

struct Unit { size_t aB, bB; int row0, col0; };
struct Gemm { const bf16_t* A; const bf16_t* Bt; int K; };

template <int NM, int NN>
struct DenseOrder {
    int G, c; size_t tstep;
    __device__ void init(int rowbytes, int G_, int c_) { G = G_; c = c_; tstep = (size_t)BM * rowbytes; }
    __device__ bool next(int i, Unit& u) const {
        constexpr int nwg = NM * NN, q = nwg / NXCD, r = nwg % NXCD, nig = WGM * NN;
        static_assert(NM % WGM == 0, "row tiles come in groups of 8");
        const int L = __builtin_amdgcn_readfirstlane(i * G + c); if (L >= nwg) return false;
        const int xcd = L % NXCD, off = L / NXCD;
        const int wgid = (xcd < r ? xcd * (q + 1) : r * (q + 1) + (xcd - r) * q) + off;
        const int gid = wgid / nig, fm = gid * WGM, rem = wgid % nig;
        const int pm = fm + (rem % WGM), pn = rem / WGM;
        u.aB = (size_t)pm * tstep; u.bB = (size_t)pn * tstep; u.row0 = pm * BM; u.col0 = pn * BM; return true;
    }
};
struct OneUnit {
    Unit u0;
    __device__ bool next(int i, Unit& u) const { if (i > 0) return false; u = u0; return true; }
};
struct MoeOrder {
    const LAS int* tab; int NTn, G, c; size_t tstep, bexp;
    __device__ bool next(int i, Unit& u) const {
        const int MT = tab[16], U = MT * NTn, nx = G >> 3;
        int f;
        if ((G & 7) == 0) { const int per = (U + 7) >> 3, x = c & 7, j = c >> 3, loc = i * nx + j; f = x * per + loc; if (loc >= per || f >= U) return false; }
        else { f = i * G + c; if (f >= U) return false; }
        int e = 0;
#pragma unroll
        for (int j = 1; j < 16; ++j) e += (f >= tab[j] * NTn) ? 1 : 0;
        const int t0 = tab[e], te = tab[e + 1] - t0, r = f - t0 * NTn;
        const int nt = r / te, mt = t0 + (r - nt * te);
        u.aB = (size_t)mt * tstep; u.bB = (size_t)e * bexp + (size_t)nt * tstep; u.row0 = mt * BM; u.col0 = nt * BM; return true;
    }
};

__device__ __forceinline__ size_t rfl64(size_t v) { const unsigned lo = (unsigned)__builtin_amdgcn_readfirstlane((int)(unsigned)v), hi = (unsigned)__builtin_amdgcn_readfirstlane((int)(unsigned)(v >> 32)); return ((size_t)hi << 32) | lo; }
__device__ __forceinline__ void uniformize(Unit& u) { u.aB = rfl64(u.aB); u.bB = rfl64(u.bB); u.row0 = __builtin_amdgcn_readfirstlane(u.row0); u.col0 = __builtin_amdgcn_readfirstlane(u.col0); }
__device__ __forceinline__ unsigned cvt_pk_bf16(float lo, float hi) { unsigned r; asm volatile("v_cvt_pk_bf16_f32 %0, %1, %2" : "=v"(r) : "v"(lo), "v"(hi)); return r; }

struct EpiF32 {
    static constexpr bool PERM = false;
    float* C; int ldc;
    __device__ __forceinline__ void operator()(const f32x4 (&acc)[2][2][4][2], const Unit& u, int wr, int wc, int fr, int fq) const {
        const int row0 = u.row0 + wr * 64 + fr, col0 = u.col0 + wc * 32 + 4 * fq;
#pragma unroll
        for (int ai = 0; ai < 2; ++ai)
#pragma unroll
            for (int m = 0; m < 4; ++m) { float* rowp = C + (size_t)(row0 + ai * HALF + m * 16) * ldc + col0;
#pragma unroll
                for (int bj = 0; bj < 2; ++bj)
#pragma unroll
                    for (int n = 0; n < 2; ++n) *(f32x4*)(rowp + bj * HALF + n * 16) = acc[ai][bj][m][n]; }
    }
};
struct EpiBf16 {
    static constexpr bool PERM = true;
    bf16_t* O; int ldc;
    __device__ __forceinline__ void operator()(const f32x4 (&acc)[2][2][4][2], const Unit& u, int wr, int wc, int fr, int fq) const {
        const int row0 = u.row0 + wr * 64 + fr, col0 = u.col0 + wc * 32 + 8 * fq;
#pragma unroll
        for (int ai = 0; ai < 2; ++ai)
#pragma unroll
            for (int m = 0; m < 4; ++m) { bf16_t* rowp = O + (size_t)(row0 + ai * HALF + m * 16) * ldc + col0;
#pragma unroll
                for (int bj = 0; bj < 2; ++bj) { const f32x4 v0 = acc[ai][bj][m][0], v1 = acc[ai][bj][m][1];
                    u32x4 o; o[0] = cvt_pk_bf16(v0[0], v0[1]); o[1] = cvt_pk_bf16(v0[2], v0[3]); o[2] = cvt_pk_bf16(v1[0], v1[1]); o[3] = cvt_pk_bf16(v1[2], v1[3]);
                    *(u32x4*)(rowp + bj * HALF) = o; } }
    }
};
struct EpiHidden {
    static constexpr bool PERM = true;
    bf16_t* O;
    __device__ __forceinline__ void operator()(const f32x4 (&acc)[2][2][4][2], const Unit& u, int wr, int wc, int fr, int fq) const {
        const int row0 = u.row0 + wr * 64 + fr, col0 = (u.col0 >> 1) + wc * 32 + 8 * fq;
#pragma unroll
        for (int ai = 0; ai < 2; ++ai)
#pragma unroll
            for (int m = 0; m < 4; ++m) { bf16_t* rowp = O + (size_t)(row0 + ai * HALF + m * 16) * DE + col0;
                float h[8];
#pragma unroll
                for (int n = 0; n < 2; ++n)
#pragma unroll
                    for (int j = 0; j < 4; ++j) { const float g = acc[ai][0][m][n][j], up = acc[ai][1][m][n][j]; h[n * 4 + j] = g * __builtin_amdgcn_rcpf(1.0f + __expf(-g)) * up; }
                u32x4 o; o[0] = cvt_pk_bf16(h[0], h[1]); o[1] = cvt_pk_bf16(h[2], h[3]); o[2] = cvt_pk_bf16(h[4], h[5]); o[3] = cvt_pk_bf16(h[6], h[7]);
                *(u32x4*)rowp = o; }
    }
};

typedef int v8i32 __attribute__((ext_vector_type(8)));
typedef int v4i32 __attribute__((ext_vector_type(4)));
struct EpiHidden8 {
    static constexpr bool PERM = true;
    unsigned char* O;
    __device__ __forceinline__ void operator()(const f32x4 (&acc)[2][2][4][2], const Unit& u, int wr, int wc, int fr, int fq) const {
        const int row0 = u.row0 + wr * 64 + fr, col0 = (u.col0 >> 1) + wc * 32 + 8 * fq;
#pragma unroll
        for (int ai = 0; ai < 2; ++ai)
#pragma unroll
            for (int m = 0; m < 4; ++m) { unsigned char* rowp = O + (size_t)(row0 + ai * HALF + m * 16) * DEP + col0;
                float h[8];
#pragma unroll
                for (int n = 0; n < 2; ++n)
#pragma unroll
                    for (int j = 0; j < 4; ++j) { const float g = acc[ai][0][m][n][j], up = acc[ai][1][m][n][j]; h[n * 4 + j] = g * __builtin_amdgcn_rcpf(1.0f + __expf(-g)) * up * H8_SCALE; }
                int o0 = __builtin_amdgcn_cvt_pk_fp8_f32(h[0], h[1], 0, false); o0 = __builtin_amdgcn_cvt_pk_fp8_f32(h[2], h[3], o0, true);
                int o1 = __builtin_amdgcn_cvt_pk_fp8_f32(h[4], h[5], 0, false); o1 = __builtin_amdgcn_cvt_pk_fp8_f32(h[6], h[7], o1, true);
                u32x2 o; o[0] = (unsigned)o0; o[1] = (unsigned)o1;
                *(u32x2*)rowp = o; }
    }
};
template <class Epi, class Sched, bool FP8 = false>
__device__ __forceinline__ void gemm_phase(LAS unsigned char* lds, const Gemm g, const Sched& S, const Epi& E, int sclW = 127, int sclA = 127) {
    int tid = threadIdx.x; asm volatile("" : "+v"(tid)); const int wid = __builtin_amdgcn_readfirstlane(tid >> 6), lane = tid & 63, wr = wid >> 2, wc = wid & 3, fr = lane & 15, fq = lane >> 4;
    const int K = g.K, rowb = FP8 ? K : 2 * K, nt = rowb / 128;
    int sclWv = sclW, sclAv = sclA; asm volatile("" : "+v"(sclWv), "+v"(sclAv));
    unsigned voffA[2], voffB[2];
#pragma unroll
    for (int i = 0; i < 2; ++i) { int R, C; stage_rc(tid * 16 + i * 8192, R, C); const int Rb = Epi::PERM ? ((R & ~31) + perm32(R & 31)) : R;
        voffA[i] = (unsigned)(R * rowb + 2 * C); voffB[i] = (unsigned)(Rb * rowb + 2 * C); }
    const size_t kstep = 128;
    const size_t hstep = (size_t)HALF * rowb;
    const unsigned ldsw = (unsigned)wid * 1024u;
    const int aoff = lds_byte(wr * 64 + fr, fq * 8), boff = lds_byte(wc * 32 + fr, fq * 8);
    constexpr int P2 = 1024;
#define PG8_SA(b, h) (((b) * 2 + (h)) * HTB)
#define PG8_SB(b, h) ((4 + (b) * 2 + (h)) * HTB)
#define PG8_STAGE(bufoff, gbase, voff) do { _Pragma("unroll") for (int _i = 0; _i < 2; ++_i) \
        __builtin_amdgcn_global_load_lds((const unsigned*)((const char*)(gbase) + (voff)[_i]), (LAS unsigned*)(lds + (bufoff) + ldsw + _i * 8192), 16, 0, 0); } while (0)
#define PG8_LDA(dst, b, h) do { _Pragma("unroll") for (int m = 0; m < 4; ++m) { \
        const v4i32 _l = *(const LAS v4i32*)(lds + PG8_SA(b, h) + aoff + m * 2048), _h = *(const LAS v4i32*)(lds + PG8_SA(b, h) + aoff + P2 + m * 2048); \
        dst[m] = __builtin_shufflevector(_l, _h, 0, 1, 2, 3, 4, 5, 6, 7); } } while (0)
#define PG8_LDB(dst, b, h) do { _Pragma("unroll") for (int n = 0; n < 2; ++n) { \
        const v4i32 _l = *(const LAS v4i32*)(lds + PG8_SB(b, h) + boff + n * 2048), _h = *(const LAS v4i32*)(lds + PG8_SB(b, h) + boff + P2 + n * 2048); \
        dst[n] = __builtin_shufflevector(_l, _h, 0, 1, 2, 3, 4, 5, 6, 7); } } while (0)
#define PG8_MMA(ai, bj, At, Bt) do { __builtin_amdgcn_s_setprio(1); _Pragma("unroll") for (int m = 0; m < 4; ++m) _Pragma("unroll") for (int n = 0; n < 2; ++n) { \
        if constexpr (FP8) { \
            asm volatile("v_mfma_scale_f32_16x16x128_f8f6f4 %0, %1, %2, %0, %3, %4 op_sel_hi:[0,0,0]" : "+v"(acc[ai][bj][m][n]) : "v"(Bt[n]), "v"(At[m]), "v"(sclWv), "v"(sclAv)); \
        } else { \
            acc[ai][bj][m][n] = __builtin_amdgcn_mfma_f32_16x16x32_bf16(__builtin_bit_cast(bf16x8, __builtin_shufflevector(Bt[n], Bt[n], 0, 1, 2, 3)), __builtin_bit_cast(bf16x8, __builtin_shufflevector(At[m], At[m], 0, 1, 2, 3)), acc[ai][bj][m][n], 0, 0, 0); \
            acc[ai][bj][m][n] = __builtin_amdgcn_mfma_f32_16x16x32_bf16(__builtin_bit_cast(bf16x8, __builtin_shufflevector(Bt[n], Bt[n], 4, 5, 6, 7)), __builtin_bit_cast(bf16x8, __builtin_shufflevector(At[m], At[m], 4, 5, 6, 7)), acc[ai][bj][m][n], 0, 0, 0); } } \
        __builtin_amdgcn_s_setprio(0); } while (0)
#define PG8_WAIT_V(n) asm volatile("s_waitcnt vmcnt(" #n ")" ::: "memory")
#define PG8_WAIT_L(n) asm volatile("s_waitcnt lgkmcnt(" #n ")" ::: "memory")
#define PG8_BAR __builtin_amdgcn_s_barrier()
#define PG8_SCHED __builtin_amdgcn_sched_barrier(0)
    Unit cur, nxt; int ui = 0;
    if (!S.next(0, cur)) return;
    uniformize(cur);
    f32x4 acc[2][2][4][2];
#pragma unroll
    for (int a = 0; a < 2; ++a)
#pragma unroll
        for (int b = 0; b < 2; ++b)
#pragma unroll
            for (int m = 0; m < 4; ++m)
#pragma unroll
                for (int n = 0; n < 2; ++n) acc[a][b][m][n] = (f32x4){0.f, 0.f, 0.f, 0.f};
    v8i32 At[4], B0[2], B1[2];
    const char* cA = (const char*)g.A + cur.aB; const char* cB = (const char*)g.Bt + cur.bB;
    PG8_STAGE(PG8_SB(0, 0), cB, voffB); PG8_STAGE(PG8_SA(0, 0), cA, voffA); PG8_STAGE(PG8_SB(0, 1), cB + hstep, voffB); PG8_STAGE(PG8_SA(0, 1), cA + hstep, voffA);
    if (wr == 1) PG8_BAR;
    PG8_WAIT_V(4); PG8_BAR;
    PG8_STAGE(PG8_SB(1, 0), cB + kstep, voffB); PG8_STAGE(PG8_SA(1, 0), cA + kstep, voffA); PG8_STAGE(PG8_SB(1, 1), cB + hstep + kstep, voffB);
    PG8_WAIT_V(6); PG8_BAR;
    for (;;) {
        const bool has_next = S.next(ui + 1, nxt);
        uniformize(nxt);
        const char* nA = has_next ? (const char*)g.A + nxt.aB : cA; const char* nB = has_next ? (const char*)g.Bt + nxt.bB : cB;
        for (int t = 0; t < nt; t += 2) {
            const bool last = (t == nt - 2);
            const char* a1 = cA + (size_t)(t + 1) * kstep;
            const char* a2 = last ? nA : cA + (size_t)(t + 2) * kstep; const char* b2 = last ? nB : cB + (size_t)(t + 2) * kstep;
            const char* a3 = a2 + kstep; const char* b3 = b2 + kstep;
            PG8_LDB(B0, 0, 0); PG8_SCHED; PG8_LDA(At, 0, 0); PG8_STAGE(PG8_SA(1, 1), a1 + hstep, voffA);
            PG8_WAIT_L(8); PG8_BAR; PG8_WAIT_L(0); PG8_MMA(0, 0, At, B0); PG8_BAR; PG8_SCHED;
            PG8_LDB(B1, 0, 1); PG8_STAGE(PG8_SB(0, 0), b2, voffB);
            PG8_BAR; PG8_WAIT_L(0); PG8_MMA(0, 1, At, B1); PG8_BAR;
            PG8_LDA(At, 0, 1); PG8_STAGE(PG8_SA(0, 0), a2, voffA);
            PG8_BAR; PG8_WAIT_L(0); PG8_MMA(1, 0, At, B0); PG8_BAR; PG8_SCHED;
            PG8_STAGE(PG8_SB(0, 1), b2 + hstep, voffB);
            PG8_WAIT_V(6); PG8_BAR; PG8_MMA(1, 1, At, B1); PG8_BAR;
            PG8_LDB(B0, 1, 0); PG8_SCHED; PG8_LDA(At, 1, 0); PG8_STAGE(PG8_SA(0, 1), a2 + hstep, voffA);
            PG8_WAIT_L(8); PG8_BAR; PG8_WAIT_L(0); PG8_MMA(0, 0, At, B0); PG8_BAR; PG8_SCHED;
            PG8_LDB(B1, 1, 1); PG8_STAGE(PG8_SB(1, 0), b3, voffB);
            PG8_BAR; PG8_WAIT_L(0); PG8_MMA(0, 1, At, B1); PG8_BAR;
            PG8_LDA(At, 1, 1); PG8_STAGE(PG8_SA(1, 0), a3, voffA);
            PG8_BAR; PG8_WAIT_L(0); PG8_MMA(1, 0, At, B0); PG8_BAR; PG8_SCHED;
            PG8_STAGE(PG8_SB(1, 1), b3 + hstep, voffB);
            PG8_WAIT_V(6); PG8_BAR; PG8_MMA(1, 1, At, B1); PG8_BAR;
        }
        if constexpr (FP8) asm volatile("s_nop 15\n\ts_nop 15" ::: "memory");
        E(acc, cur, wr, wc, fr, fq);
        if (!has_next) break;
#pragma unroll
        for (int a = 0; a < 2; ++a)
#pragma unroll
            for (int b = 0; b < 2; ++b)
#pragma unroll
                for (int m = 0; m < 4; ++m)
#pragma unroll
                    for (int n = 0; n < 2; ++n) acc[a][b][m][n] = (f32x4){0.f, 0.f, 0.f, 0.f};
        cur = nxt; cA = nA; cB = nB; ++ui;
    }
    PG8_WAIT_V(0);
    if (wr == 0) PG8_BAR;
    PG8_BAR;
#undef PG8_SA
#undef PG8_SB
#undef PG8_STAGE
#undef PG8_LDA
#undef PG8_LDB
#undef PG8_MMA
#undef PG8_WAIT_V
#undef PG8_WAIT_L
#undef PG8_BAR
#undef PG8_SCHED
}
}

constexpr int S_IN = 16 * 66, S_OUT = 16 * 16, S_GU = 16 * 11, S_DN = 11 * 16;
constexpr int CV_PER_L = S_IN + S_OUT + NE * 2 * S_GU + NE * S_DN;
constexpr int CV_A0 = S_IN + S_OUT;
constexpr int CV_A1 = CV_A0 + NE * 2 * S_GU;
constexpr int CV_TOTAL = DEPTH * CV_PER_L;
constexpr int CV_LAST = 1 << 30;
struct StripDesc { const float* src; bf16_t* dst; int lds_, ldd, k0, n0, drow0, fp8; };
__device__ __forceinline__ StripDesc strip_desc(const Params& p, int si) {
    unsigned char* ws = p.ws; StripDesc d;
    const int l = si / CV_PER_L; int r = si - l * CV_PER_L;
    if (r < S_IN) {
        const int kt = r / 66, ntl = r % 66;
        d.src = p.w_in + (size_t)l * D * INC; d.lds_ = INC; d.fp8 = INP8(l) ? 1 : 0; d.dst = (bf16_t*)(ws + WS_WIN) + (size_t)l * INC * D; d.ldd = D; d.k0 = kt * 128; d.n0 = ntl * 128; d.drow0 = ntl * 128;
    } else if (r < CV_A0) {
        r -= S_IN; const int kt = r / 16, ntl = r % 16;
        d.src = p.w_out + (size_t)l * D * D; d.lds_ = D; d.dst = (bf16_t*)(ws + WS_WOUT) + (size_t)l * D * D; d.ldd = D; d.k0 = kt * 128; d.n0 = ntl * 128; d.drow0 = ntl * 128; d.fp8 = OUT8(l) ? 1 : 0;
    } else if (r < CV_A1) {
        r -= CV_A0; const int mat = r / S_GU, q = r % S_GU, kt = q / 11, ntl = q % 11;
        const int which = mat & 1, le = l * NE + (mat >> 1);
        d.src = (which ? p.w_up : p.w_gate) + (size_t)le * D * DE; d.lds_ = DE; d.fp8 = MOE_FP8; d.dst = MOE_FP8 ? (bf16_t*)(ws + WS_WGU + (size_t)le * (2 * DE) * D) : (bf16_t*)(ws + WS_WGU) + (size_t)le * (2 * DE) * D; d.ldd = D; d.k0 = kt * 128; d.n0 = ntl * 128; d.drow0 = ntl * 256 + which * 128;
    } else {
        r -= CV_A1; const int le = l * NE + r / S_DN, q = r % S_DN, kt = q / 16, ntl = q % 16;
        d.src = p.w_down + (size_t)le * DE * D; d.lds_ = D; d.fp8 = MOE_FP8; d.dst = MOE_FP8 ? (bf16_t*)(ws + WS_WD + (size_t)le * D * DEP) : (bf16_t*)(ws + WS_WD) + (size_t)le * D * DE; d.ldd = MOE_FP8 ? DEP : DE; d.k0 = kt * 128; d.n0 = ntl * 128; d.drow0 = ntl * 128;
    }
    return d;
}
__device__ __forceinline__ void cvt_store_strip(const StripDesc& d, const float4 (&a)[2][2], const float4 (&b)[2][2], LAS unsigned char* tb, int tid, bool readout) {
    const int kp = tid >> 4, n4 = (tid & 15) * 4;
    if (!readout) {
        if (!d.fp8) {
#pragma unroll
            for (int ki = 0; ki < 2; ++ki)
#pragma unroll
                for (int ni = 0; ni < 2; ++ni) {
                    LAS unsigned* t = (LAS unsigned*)tb + (ki * 2 + ni) * 2112;
                    t[(n4 + 0) * 33 + kp] = pack2a(a[ki][ni].x, b[ki][ni].x);
                    t[(n4 + 1) * 33 + kp] = pack2a(a[ki][ni].y, b[ki][ni].y);
                    t[(n4 + 2) * 33 + kp] = pack2a(a[ki][ni].z, b[ki][ni].z);
                    t[(n4 + 3) * 33 + kp] = pack2a(a[ki][ni].w, b[ki][ni].w);
                }
        } else {
#pragma unroll
            for (int ki = 0; ki < 2; ++ki)
#pragma unroll
                for (int ni = 0; ni < 2; ++ni) {
                    LAS unsigned char* t = tb + (ki * 2 + ni) * 4352;
                    *(LAS unsigned short*)(t + (n4 + 0) * 68 + 2 * kp) = (unsigned short)__builtin_amdgcn_cvt_pk_fp8_f32(a[ki][ni].x * W8_SCALE, b[ki][ni].x * W8_SCALE, 0, false);
                    *(LAS unsigned short*)(t + (n4 + 1) * 68 + 2 * kp) = (unsigned short)__builtin_amdgcn_cvt_pk_fp8_f32(a[ki][ni].y * W8_SCALE, b[ki][ni].y * W8_SCALE, 0, false);
                    *(LAS unsigned short*)(t + (n4 + 2) * 68 + 2 * kp) = (unsigned short)__builtin_amdgcn_cvt_pk_fp8_f32(a[ki][ni].z * W8_SCALE, b[ki][ni].z * W8_SCALE, 0, false);
                    *(LAS unsigned short*)(t + (n4 + 3) * 68 + 2 * kp) = (unsigned short)__builtin_amdgcn_cvt_pk_fp8_f32(a[ki][ni].w * W8_SCALE, b[ki][ni].w * W8_SCALE, 0, false);
                }
        }
    } else {
        if (!d.fp8) {
            const int n = tid >> 3, kc = (tid & 7) * 4;
#pragma unroll
            for (int ki = 0; ki < 2; ++ki)
#pragma unroll
                for (int ni = 0; ni < 2; ++ni) {
                    const LAS unsigned* t = (const LAS unsigned*)tb + (ki * 2 + ni) * 2112;
                    u32x4 o; o[0] = t[n * 33 + kc]; o[1] = t[n * 33 + kc + 1]; o[2] = t[n * 33 + kc + 2]; o[3] = t[n * 33 + kc + 3];
                    *(u32x4*)(d.dst + (size_t)(d.drow0 + ni * 64 + n) * d.ldd + d.k0 + ki * 64 + kc * 2) = o;
                }
        } else {
            const int n = tid >> 3, kc8 = (tid & 7) * 8;
            unsigned char* dst8 = (unsigned char*)d.dst;
#pragma unroll
            for (int ki = 0; ki < 2; ++ki)
#pragma unroll
                for (int ni = 0; ni < 2; ++ni) {
                    const LAS unsigned char* t = tb + (ki * 2 + ni) * 4352;
                    u32x2 o; o[0] = *(const LAS unsigned*)(t + n * 68 + kc8); o[1] = *(const LAS unsigned*)(t + n * 68 + kc8 + 4);
                    *(u32x2*)(dst8 + (size_t)(d.drow0 + ni * 64 + n) * d.ldd + d.k0 + ki * 64 + kc8) = o;
                }
        }
    }
}
__device__ __forceinline__ void cvt_pull(const Params& p, LAS unsigned char* lds, int limit, unsigned* done_ctr, unsigned need_done) {
    int tid = threadIdx.x; asm volatile("" : "+v"(tid));
    LAS int* slot = (LAS int*)(lds + LDS_MISC + 512);
    unsigned* head = (unsigned*)(p.ws + WS_CVTQ);
    if (tid == 0) {
        int sv = -1;
        const bool stop = done_ctr ? (xb_ld(done_ctr) >= need_done) : (xb_ld(head) >= (unsigned)limit);
        if (!stop) { const unsigned c = xb_add(head, 2u); sv = c < (unsigned)CV_TOTAL ? (int)c : -1; }
        slot[0] = sv;
    }
    __syncthreads();
    const int kp = tid >> 4, n4 = (tid & 15) * 4;
    for (;;) {
        const int sraw = slot[0];
        if (sraw < 0) break;
        const int si = sraw & (CV_LAST - 1); const bool lastone = (sraw & CV_LAST) != 0;
        const StripDesc d0 = strip_desc(p, si), d1 = strip_desc(p, si + 1);
        float4 a0[2][2], b0[2][2], a1[2][2], b1[2][2];
#pragma unroll
        for (int ki = 0; ki < 2; ++ki)
#pragma unroll
            for (int ni = 0; ni < 2; ++ni) {
                a0[ki][ni] = *(const float4*)(d0.src + (size_t)(d0.k0 + ki * 64 + 2 * kp) * d0.lds_ + d0.n0 + ni * 64 + n4);
                b0[ki][ni] = *(const float4*)(d0.src + (size_t)(d0.k0 + ki * 64 + 2 * kp + 1) * d0.lds_ + d0.n0 + ni * 64 + n4);
            }
#pragma unroll
        for (int ki = 0; ki < 2; ++ki)
#pragma unroll
            for (int ni = 0; ni < 2; ++ni) {
                a1[ki][ni] = *(const float4*)(d1.src + (size_t)(d1.k0 + ki * 64 + 2 * kp) * d1.lds_ + d1.n0 + ni * 64 + n4);
                b1[ki][ni] = *(const float4*)(d1.src + (size_t)(d1.k0 + ki * 64 + 2 * kp + 1) * d1.lds_ + d1.n0 + ni * 64 + n4);
            }
        unsigned c = 0u, dn = 0u;
        if (tid == 0 && !lastone) { c = xb_add(head, 2u); if (done_ctr) dn = xb_ld(done_ctr); }
        cvt_store_strip(d0, a0, b0, lds, tid, false);
        cvt_store_strip(d1, a1, b1, lds + 33792, tid, false);
        LDS_BARRIER();
        cvt_store_strip(d0, a0, b0, lds, tid, true);
        cvt_store_strip(d1, a1, b1, lds + 33792, tid, true);
        if (tid == 0) {
            int sv = -1;
            if (!lastone && c < (unsigned)CV_TOTAL) { const bool fin = done_ctr ? (dn >= need_done) : (c >= (unsigned)limit); sv = (int)c | (fin ? CV_LAST : 0); }
            slot[0] = sv;
        }
        LDS_BARRIER();
    }
    __syncthreads();
}
__device__ __forceinline__ void tail_pull(const Params& p, LAS unsigned char* lds, int ctr_idx) {
    unsigned* ctr = (unsigned*)(p.ws + WS_CVTQ) + 64 * (1 + ctr_idx);
    __syncthreads();
    if (threadIdx.x == 0) (void)xb_add(ctr, 1u);
    cvt_pull(p, lds, 0, ctr, gridDim.x);
}

__device__ __forceinline__ void ada_chunks(const Params& p, LAS unsigned char* lds, int ch0, int ch_end, int step) {
    int tid = threadIdx.x; asm volatile("" : "+v"(tid));
    unsigned char* ws = p.ws;
    LAS float* cond = (LAS float*)lds;
    LAS float* red = (LAS float*)(lds + 32768);
    if (ch0 >= ch_end) return;
    for (int i = tid; i < 4 * D; i += 512) { const float v = p.c[i]; cond[i] = siluf_(v); }
    __syncthreads();
    for (int ch = ch0; ch < ch_end; ch += step) {
        const int l = ch >> 7, j0 = (ch & 127) * 96;
        const float* w = p.w_ada + (size_t)l * D * (6 * D);
        const int kg = tid / 24, cl = tid % 24;
        float acc[4][4];
#pragma unroll
        for (int b = 0; b < 4; ++b)
#pragma unroll
            for (int j = 0; j < 4; ++j) acc[b][j] = 0.f;
        if (kg < 21) {
            for (int it0 = 0; it0 < 98; it0 += 14) {
                float4 wv[14];
#pragma unroll
                for (int q = 0; q < 14; ++q) { const int k = kg + 21 * (it0 + q); wv[q] = (k < D) ? *(const float4*)(w + (size_t)k * (6 * D) + j0 + cl * 4) : make_float4(0.f, 0.f, 0.f, 0.f); }
#pragma unroll
                for (int q = 0; q < 14; ++q) { const int k = kg + 21 * (it0 + q); const int kc = k < D ? k : 0;
#pragma unroll
                    for (int b = 0; b < 4; ++b) { const float cv = cond[b * D + kc]; acc[b][0] += cv * wv[q].x; acc[b][1] += cv * wv[q].y; acc[b][2] += cv * wv[q].z; acc[b][3] += cv * wv[q].w; } }
            }
#pragma unroll
            for (int b = 0; b < 4; ++b)
#pragma unroll
                for (int j = 0; j < 4; ++j) red[(kg * 4 + b) * 96 + cl * 4 + j] = acc[b][j];
        }
        __syncthreads();
        if (tid < 384) {
            const int b = tid / 96, col = tid % 96; float s = 0.f;
            for (int g = 0; g < 21; ++g) s += red[(g * 4 + b) * 96 + col];
            float* mod = (float*)(ws + WS_MOD);
            mod[((size_t)l * 4 + b) * (6 * D) + j0 + col] = s + p.b_ada[(size_t)l * 6 * D + j0 + col];
        }
        __syncthreads();
    }
}
__device__ __forceinline__ void phase_prologue(const Params& p, LAS unsigned char* lds) {
    const bool svc = (gridDim.x >= 256);
    ada_chunks(p, lds, blockIdx.x, svc ? 128 : 256, gridDim.x);
    cvt_pull(p, lds, CV_A0, nullptr, 0u);
}

#define COLK(k) ((((k) >> 1) << 9) + lane * 8 + (((k) & 1) << 2))
#define COL8(i) (((i) << 9) + lane * 8)
__device__ __forceinline__ void ld_bf8(const bf16_t* p, float4& a, float4& b) {
    const u32x4 r = *(const u32x4*)p;
    a = make_float4(bf2f(r[0] & 0xffffu), bf2f(r[0] >> 16), bf2f(r[1] & 0xffffu), bf2f(r[1] >> 16));
    b = make_float4(bf2f(r[2] & 0xffffu), bf2f(r[2] >> 16), bf2f(r[3] & 0xffffu), bf2f(r[3] >> 16));
}
__device__ __forceinline__ void st_bf8(bf16_t* p, const float4& a, const float4& b) {
    u32x4 o; o[0] = pack2a(a.x, a.y); o[1] = pack2a(a.z, a.w); o[2] = pack2a(b.x, b.y); o[3] = pack2a(b.z, b.w);
    *(u32x4*)p = o;
}
__device__ __forceinline__ void st_fp8x8(unsigned char* p, const float4& a, const float4& b) {
    int o0 = __builtin_amdgcn_cvt_pk_fp8_f32(a.x, a.y, 0, false); o0 = __builtin_amdgcn_cvt_pk_fp8_f32(a.z, a.w, o0, true);
    int o1 = __builtin_amdgcn_cvt_pk_fp8_f32(b.x, b.y, 0, false); o1 = __builtin_amdgcn_cvt_pk_fp8_f32(b.z, b.w, o1, true);
    u32x2 o; o[0] = (unsigned)o0; o[1] = (unsigned)o1;
    *(u32x2*)p = o;
}
__device__ __forceinline__ void ln_rows(float4 (&v)[8], const float* __restrict__ g, const float* __restrict__ b, int lane) {
    float s = 0.f;
#pragma unroll
    for (int i = 0; i < 8; ++i) s += (v[i].x + v[i].y) + (v[i].z + v[i].w);
    const float mean = wave_sum(s) * (1.0f / D);
    float q = 0.f;
#pragma unroll
    for (int i = 0; i < 8; ++i) { const float a = v[i].x - mean, bb = v[i].y - mean, c = v[i].z - mean, d = v[i].w - mean; q += (a * a + bb * bb) + (c * c + d * d); }
    const float rstd = rsqrtf(wave_sum(q) * (1.0f / D) + 1e-5f);
#pragma unroll
    for (int i = 0; i < 8; ++i) {
        const float4 gv = *(const float4*)(g + COLK(i)), bv = *(const float4*)(b + COLK(i));
        v[i].x = (v[i].x - mean) * rstd * gv.x + bv.x; v[i].y = (v[i].y - mean) * rstd * gv.y + bv.y;
        v[i].z = (v[i].z - mean) * rstd * gv.z + bv.z; v[i].w = (v[i].w - mean) * rstd * gv.w + bv.w;
    }
}
__device__ __forceinline__ void modulate_store(const float4 (&v)[8], const float* __restrict__ shift, const float* __restrict__ scale, bf16_t* __restrict__ dst, int lane, bool fp8) {
#pragma unroll
    for (int i = 0; i < 4; ++i) {
        float4 h[2];
#pragma unroll
        for (int q = 0; q < 2; ++q) {
            const float4 sh = *(const float4*)(shift + COLK(2 * i + q)), sc = *(const float4*)(scale + COLK(2 * i + q));
            const float4 x = v[2 * i + q];
            h[q] = make_float4(x.x * (1.f + sc.x) + sh.x, x.y * (1.f + sc.y) + sh.y, x.z * (1.f + sc.z) + sh.z, x.w * (1.f + sc.w) + sh.w);
        }
        if (fp8) st_fp8x8((unsigned char*)dst + COL8(i), h[0], h[1]);
        else st_bf8(dst + COL8(i), h[0], h[1]);
    }
}

__device__ __forceinline__ void phase_ln0(const Params& p) {
    int tid_ = threadIdx.x; asm volatile("" : "+v"(tid_)); const int wave = tid_ >> 6, lane = tid_ & 63;
    const float* mod = (const float*)(p.ws + WS_MOD);
    for (int n = blockIdx.x * 8 + wave; n < T; n += gridDim.x * 8) {
        const int b = n / SEQ;
        float4 v[8];
#pragma unroll
        for (int i = 0; i < 8; ++i) v[i] = *(const float4*)(p.x + (size_t)n * D + COLK(i));
        ln_rows(v, p.emb_g, p.emb_b, lane);
        bf16_t* xr = (bf16_t*)(p.ws + WS_XRES) + (size_t)n * D;
#pragma unroll
        for (int i = 0; i < 4; ++i) st_bf8(xr + COL8(i), v[2 * i], v[2 * i + 1]);
        const float* mb = mod + ((size_t)0 * 4 + b) * (6 * D);
        modulate_store(v, mb, mb + D, INP8(0) ? (bf16_t*)(p.ws + WS_HA + (size_t)n * D) : (bf16_t*)(p.ws + WS_HA) + (size_t)n * D, lane, INP8(0));
    }
}

__device__ __forceinline__ void phase_mixer_valu(const Params& p, int l, LAS unsigned char* lds) {
    LAS float* qs = (LAS float*)lds; LAS float* ks = qs + 4096; LAS float* fs = ks + 4096; LAS float* vs = fs + 4096; LAS float* po = vs + 1024;
    int tid = threadIdx.x; asm volatile("" : "+v"(tid)); const int wave = tid >> 6, lane = tid & 63, kk = tid >> 5, vv = tid & 31;
    const bf16_t* proj = (const bf16_t*)(p.ws + WS_PROJ);
    float* obuf = (float*)(p.ws + WS_OBUF);
    for (int u = blockIdx.x; u < 384; u += gridDim.x) {
        const int vsl = u & 3, dir = (u >> 2) & 1, hh = (u >> 3) % 6, b = ((u >> 3) / 6) % 4, type = (u >> 3) / 24;
        float S[8];
#pragma unroll
        for (int j = 0; j < 8; ++j) S[j] = 0.f;
        const float gamma = 1.0f - exp2f(-(dir ? 5.5f : 5.0f) - (float)hh);
        for (int blk = 0; blk < 64; ++blk) {
            const int rb = dir ? 63 - blk : blk, t0 = rb * 32;
            if (type == 0) {
#pragma unroll
                for (int j = 0; j < 4; ++j) {
                    const int idx = tid + 512 * j, tt = idx >> 6, dp = idx & 63;
                    const bf16_t* row = proj + (size_t)(b * SEQ + t0 + tt) * INC;
                    const float q1 = bf2f(row[C_RQ + hh * 128 + dp]), q2 = bf2f(row[C_RQ + hh * 128 + 64 + dp]);
                    const float k1 = bf2f(row[C_RK + hh * 128 + dp]), k2 = bf2f(row[C_RK + hh * 128 + 64 + dp]);
                    const float inv_freq = exp2f(-(float)dp * (13.287712379549449f / 64.0f));
                    const float ang = (float)(t0 + tt) * inv_freq;
                    float rev = ang * 0.15915494309189535f; rev -= rintf(rev);
                    const float sn = __builtin_amdgcn_sinf(rev), cs = __builtin_amdgcn_cosf(rev);
                    qs[tt * 128 + dp] = q1 * cs - q2 * sn; qs[tt * 128 + 64 + dp] = q1 * sn + q2 * cs;
                    ks[tt * 128 + dp] = (k1 * cs - k2 * sn) * 0.08838834764831845f; ks[tt * 128 + 64 + dp] = (k1 * sn + k2 * cs) * 0.08838834764831845f;
                    fs[tt * 128 + dp] = gamma; fs[tt * 128 + 64 + dp] = gamma;
                }
            } else {
#pragma unroll
                for (int j = 0; j < 8; ++j) {
                    const int idx = tid + 512 * j, tt = idx >> 7, d = idx & 127;
                    const bf16_t* row = proj + (size_t)(b * SEQ + t0 + tt) * INC;
                    const float q = bf2f(row[C_HQ + hh * 128 + d]);
                    const float z = bf2f(row[(dir ? C_HFB : C_HFF) + hh * 128 + d]);
                    float lb = 0.f;
                    if (l > 0) { const float a0 = p.lb_logits[(0 * 2 + dir) * HWD + hh * 128 + d], a1 = p.lb_logits[(1 * 2 + dir) * HWD + hh * 128 + d]; lb = 1.0f / (1.0f + expf(a0 - a1)); }
                    float f = lb + (1.0f - lb) * (1.0f / (1.0f + expf(-z)));
                    f = fmaxf(f, 1e-6f);
                    qs[tt * 128 + d] = q; ks[tt * 128 + d] = 1.0f - f; fs[tt * 128 + d] = f;
                }
            }
#pragma unroll
            for (int j = 0; j < 2; ++j) {
                const int idx = tid + 512 * j, tt = idx >> 5, c = idx & 31;
                const bf16_t* row = proj + (size_t)(b * SEQ + t0 + tt) * INC;
                vs[tt * 32 + c] = bf2f(row[(type ? C_HI : C_RV) + hh * 128 + vsl * 32 + c]);
            }
            __syncthreads();
            for (int s = 0; s < 32; ++s) {
                const int ss = dir ? 31 - s : s;
                const f32x4 qa = *(const LAS f32x4*)(qs + ss * 128 + kk * 8), qb = *(const LAS f32x4*)(qs + ss * 128 + kk * 8 + 4);
                const f32x4 ka = *(const LAS f32x4*)(ks + ss * 128 + kk * 8), kb = *(const LAS f32x4*)(ks + ss * 128 + kk * 8 + 4);
                const f32x4 fa = *(const LAS f32x4*)(fs + ss * 128 + kk * 8), fb = *(const LAS f32x4*)(fs + ss * 128 + kk * 8 + 4);
                const float vval = vs[ss * 32 + vv];
                float acc = 0.f;
#pragma unroll
                for (int j = 0; j < 4; ++j) { S[j] = fa[j] * S[j] + ka[j] * vval; acc += S[j] * qa[j]; }
#pragma unroll
                for (int j = 0; j < 4; ++j) { S[4 + j] = fb[j] * S[4 + j] + kb[j] * vval; acc += S[4 + j] * qb[j]; }
                acc += __shfl_xor(acc, 32, 64);
                if (lane < 32) po[(ss * 8 + wave) * 32 + vv] = acc;
            }
            __syncthreads();
#pragma unroll
            for (int j = 0; j < 2; ++j) {
                const int idx = tid + 512 * j, tt = idx >> 5, c = idx & 31;
                float s = 0.f;
#pragma unroll
                for (int w = 0; w < 8; ++w) s += po[(tt * 8 + w) * 32 + c];
                obuf[((size_t)dir * T + (size_t)(b * SEQ + t0 + tt)) * 1536 + type * 768 + hh * 128 + vsl * 32 + c] = s;
            }
        }
        __syncthreads();
    }
}

constexpr int MX_QI = 0, MX_KI = 17408, MX_QS = 34816, MX_KTT = 52224, MX_VT = 70656, MX_P = 79872, MX_ST = 89088, MX_TOT = 106496, MX_DEC = 110592, MX_RQ = 112128, MX_RK = 128512, MX_RV = 144896;
__device__ __forceinline__ float ex2(float x) { return __builtin_amdgcn_exp2f(x); }
__device__ __forceinline__ float clampe(float x) { return fminf(fmaxf(x, -120.f), 120.f); }
template <int MODE>
__device__ __forceinline__ void phase_mixer_mfma(const Params& p, int l, LAS unsigned char* lds, float* __restrict__ obuf) {
    int tid = threadIdx.x; asm volatile("" : "+v"(tid));
    const int wave = __builtin_amdgcn_readfirstlane(tid >> 6), lane = tid & 63, fr = lane & 15, fq = lane >> 4;
    const bf16_t* proj = (const bf16_t*)(p.ws + WS_PROJ);
    for (int u = blockIdx.x; u < 192; u += gridDim.x) {
        const int vsl = u & 1, dir = (u >> 1) & 1, hh = (u >> 2) % 6, b = ((u >> 2) / 6) % 4, type = (u >> 2) / 24;
        float lg2 = 0.f, invf0 = 0.f, invf1 = 0.f, sgn = 1.f, lb0 = 0.f, lb1 = 0.f;
        if (type == 0) {
            const float gamma = 1.0f - exp2f(-(dir ? 5.5f : 5.0f) - (float)hh);
            lg2 = log2f(gamma);
            const int dm0 = (2 * lane) & 63;
            invf0 = exp2f(-(float)dm0 * (13.287712379549449f / 64.0f)); invf1 = exp2f(-(float)(dm0 + 1) * (13.287712379549449f / 64.0f));
            sgn = lane < 32 ? -1.f : 1.f;
        } else if (l > 0) {
            const float* lbl = p.lb_logits + dir * HWD + hh * 128 + 2 * lane;
            lb0 = 1.0f / (1.0f + expf(lbl[0] - lbl[2 * HWD])); lb1 = 1.0f / (1.0f + expf(lbl[1] - lbl[2 * HWD + 1]));
        }
        const int colA = (type ? C_HQ : C_RQ) + hh * 128, colB = (type ? (dir ? C_HFB : C_HFF) : C_RK) + hh * 128;
        const int colV0 = (type ? C_HI : C_RV) + hh * 128 + vsl * 64;
        const int own = 2 * lane, par = (2 * lane + 64) & 127;
        const size_t ocol = (size_t)type * 768 + hh * 128 + vsl * 64;
#define MX_LOAD(ch) do { \
            _Pragma("unroll") for (int i2 = 0; i2 < 2; ++i2) { const int pos = wave * 8 + i2 * 4 + (lane >> 4); const int tau = (ch) * 64 + pos; const int t = dir ? (SEQ - 1 - tau) : tau; \
                const bf16_t* row = proj + (size_t)(b * SEQ + t) * INC + (lane & 15) * 8; \
                __builtin_amdgcn_global_load_lds((const unsigned*)(row + colA), (LAS unsigned*)(lds + MX_RQ + (wave * 8 + i2 * 4) * 256), 16, 0, 0); \
                __builtin_amdgcn_global_load_lds((const unsigned*)(row + colB), (LAS unsigned*)(lds + MX_RK + (wave * 8 + i2 * 4) * 256), 16, 0, 0); } \
            { const int pos = wave * 8 + (lane >> 3); const int tau = (ch) * 64 + pos; const int t = dir ? (SEQ - 1 - tau) : tau; \
              const bf16_t* row = proj + (size_t)(b * SEQ + t) * INC + colV0 + (lane & 7) * 8; \
              __builtin_amdgcn_global_load_lds((const unsigned*)row, (LAS unsigned*)(lds + MX_RV + (wave * 8) * 128), 16, 0, 0); } } while (0)
        f32x4 Sacc[4];
#pragma unroll
        for (int vt = 0; vt < 4; ++vt) Sacc[vt] = (f32x4){0.f, 0.f, 0.f, 0.f};
        for (int i = tid; i < 64 * 272 / 4; i += 512) ((LAS unsigned*)(lds + MX_ST))[i] = 0u;
        float cd0 = 1.f, sd0 = 0.f, cd1 = 1.f, sd1 = 0.f;
        if (type == 0) {
            if (tid < 64) { const float fi = (float)tid; *(LAS f32x4*)(lds + MX_DEC + 512 + tid * 16) = (f32x4){ex2((fi - 31.f) * lg2), ex2((31.f - fi) * lg2), ex2((fi + 1.f) * lg2), ex2((63.f - fi) * lg2)}; }
            const float r0 = invf0 * 0.15915494309189535f, r1 = invf1 * 0.15915494309189535f, sg = dir ? -1.f : 1.f;
            cd0 = __builtin_amdgcn_cosf(r0); sd0 = sg * __builtin_amdgcn_sinf(r0); cd1 = __builtin_amdgcn_cosf(r1); sd1 = sg * __builtin_amdgcn_sinf(r1);
        }
        __syncthreads();
        MX_LOAD(0);
        asm volatile("s_waitcnt vmcnt(0)" ::: "memory");
        __syncthreads();
        for (int ch = 0; ch < 32; ++ch) {
            float q0[8], q1[8], k0[8], k1[8], c0[8], c1[8];
            float run0 = 0.f, run1 = 0.f;
            u32x4 vpk = (u32x4){0u, 0u, 0u, 0u};
#pragma unroll
            for (int j = 0; j < 8; ++j) { q0[j] = q1[j] = k0[j] = k1[j] = c0[j] = c1[j] = 0.f; }
            if (MODE != 3 && MODE != 4) {
            if (type == 0) {
                const int tau0 = ch * 64 + wave * 8; const int t0 = dir ? (SEQ - 1 - tau0) : tau0;
                float rev0 = (float)t0 * invf0 * 0.15915494309189535f, rev1 = (float)t0 * invf1 * 0.15915494309189535f;
                rev0 -= rintf(rev0); rev1 -= rintf(rev1);
                float sn0 = __builtin_amdgcn_sinf(rev0), cs0 = __builtin_amdgcn_cosf(rev0), sn1 = __builtin_amdgcn_sinf(rev1), cs1 = __builtin_amdgcn_cosf(rev1);
#pragma unroll
                for (int j = 0; j < 8; ++j) {
                    const int pos_ = wave * 8 + j;
                    const unsigned ra_ = *(const LAS unsigned*)(lds + MX_RQ + pos_ * 256 + own * 2), rb_ = *(const LAS unsigned*)(lds + MX_RK + pos_ * 256 + own * 2);
                    const unsigned rc_ = *(const LAS unsigned*)(lds + MX_RQ + pos_ * 256 + par * 2), rd_ = *(const LAS unsigned*)(lds + MX_RK + pos_ * 256 + par * 2);
                    const float a_lo = bf2f(ra_ & 0xffffu), a_hi = bf2f(ra_ >> 16), b_lo = bf2f(rb_ & 0xffffu), b_hi = bf2f(rb_ >> 16);
                    const float pa_lo = bf2f(rc_ & 0xffffu), pa_hi = bf2f(rc_ >> 16), pb_lo = bf2f(rd_ & 0xffffu), pb_hi = bf2f(rd_ >> 16);
                    const float ss0 = sgn * sn0, ss1 = sgn * sn1;
                    q0[j] = a_lo * cs0 + pa_lo * ss0; q1[j] = a_hi * cs1 + pa_hi * ss1;
                    k0[j] = (b_lo * cs0 + pb_lo * ss0) * 0.08838834764831845f; k1[j] = (b_hi * cs1 + pb_hi * ss1) * 0.08838834764831845f;
                    const float nc0 = cs0 * cd0 - sn0 * sd0, ns0 = sn0 * cd0 + cs0 * sd0, nc1 = cs1 * cd1 - sn1 * sd1, ns1 = sn1 * cd1 + cs1 * sd1;
                    cs0 = nc0; sn0 = ns0; cs1 = nc1; sn1 = ns1;
                    c0[j] = 0.f; c1[j] = 0.f;
                }
            } else {
#pragma unroll
                for (int j = 0; j < 8; ++j) {
                    const int pos_ = wave * 8 + j;
                    const unsigned ra_ = *(const LAS unsigned*)(lds + MX_RQ + pos_ * 256 + own * 2), rb_ = *(const LAS unsigned*)(lds + MX_RK + pos_ * 256 + own * 2);
                    const float a_lo = bf2f(ra_ & 0xffffu), a_hi = bf2f(ra_ >> 16), b_lo = bf2f(rb_ & 0xffffu), b_hi = bf2f(rb_ >> 16);
                    q0[j] = a_lo; q1[j] = a_hi;
                    float f0 = lb0 + (1.0f - lb0) * __builtin_amdgcn_rcpf(1.0f + ex2(-b_lo * 1.4426950408889634f));
                    float f1 = lb1 + (1.0f - lb1) * __builtin_amdgcn_rcpf(1.0f + ex2(-b_hi * 1.4426950408889634f));
                    f0 = fmaxf(f0, 1e-6f); f1 = fmaxf(f1, 1e-6f);
                    k0[j] = 1.0f - f0; k1[j] = 1.0f - f1;
                    run0 += __builtin_amdgcn_logf(f0); run1 += __builtin_amdgcn_logf(f1); c0[j] = run0; c1[j] = run1;
                }
            }
            { unsigned rv[8];
#pragma unroll
              for (int j = 0; j < 8; ++j) rv[j] = *(const LAS unsigned short*)(lds + MX_RV + (wave * 8 + j) * 128 + lane * 2);
              vpk[0] = rv[0] | (rv[1] << 16); vpk[1] = rv[2] | (rv[3] << 16); vpk[2] = rv[4] | (rv[5] << 16); vpk[3] = rv[6] | (rv[7] << 16); }
            }
            { typedef float f32x2_ __attribute__((ext_vector_type(2))); *(LAS f32x2_*)(lds + MX_TOT + (wave * 128 + 2 * lane) * 4) = (f32x2_){run0, run1}; }
            LDS_BARRIER();
            if (ch + 1 < 32) MX_LOAD(ch + 1);
            float kt0[8], kt1[8];
            float tt0, tt1;
#pragma unroll
            for (int j = 0; j < 8; ++j) { kt0[j] = kt1[j] = 0.f; }
            tt0 = tt1 = 0.f;
            if (MODE != 3 && MODE != 4) {
            if (type == 0) {
                tt0 = tt1 = 64.f * lg2;
#pragma unroll
                for (int j = 0; j < 8; ++j) {
                    const int pos = wave * 8 + j;
                    const f32x4 e = *(const LAS f32x4*)(lds + MX_DEC + 512 + pos * 16);
                    *(LAS unsigned*)(lds + MX_QI + pos * 272 + lane * 4) = pack2(q0[j] * e[0], q1[j] * e[0]);
                    *(LAS unsigned*)(lds + MX_KI + pos * 272 + lane * 4) = pack2(k0[j] * e[1], k1[j] * e[1]);
                    kt0[j] = k0[j] * e[3]; kt1[j] = k1[j] * e[3];
                }
            } else {
                float off0 = 0.f, off1 = 0.f, m0 = 0.f, m1 = 0.f; tt0 = 0.f; tt1 = 0.f;
#pragma unroll
                for (int g = 0; g < 8; ++g) {
                    typedef float f32x2_ __attribute__((ext_vector_type(2)));
                    const f32x2_ tv = *(const LAS f32x2_*)(lds + MX_TOT + (g * 128 + 2 * lane) * 4);
                    if (g < wave) { off0 += tv[0]; off1 += tv[1]; }
                    if (g < 4) { m0 += tv[0]; m1 += tv[1]; }
                    tt0 += tv[0]; tt1 += tv[1];
                }
                const float etm0 = ex2(tt0 - m0), etm1 = ex2(tt1 - m1);
#pragma unroll
                for (int j = 0; j < 8; ++j) {
                    const float cu0 = c0[j] + off0, cu1 = c1[j] + off1;
                    const float e10 = ex2(clampe(cu0 - m0)), e11 = ex2(clampe(cu1 - m1));
                    const float e20 = __builtin_amdgcn_rcpf(e10), e21 = __builtin_amdgcn_rcpf(e11);
                    const int pos = wave * 8 + j;
                    *(LAS unsigned*)(lds + MX_QI + pos * 272 + lane * 4) = pack2(q0[j] * e10, q1[j] * e11);
                    *(LAS unsigned*)(lds + MX_KI + pos * 272 + lane * 4) = pack2(k0[j] * e20, k1[j] * e21);
                    kt0[j] = k0[j] * (e20 * etm0); kt1[j] = k1[j] * (e21 * etm1);
                }
            }
            }
            { u32x4 w0, w1;
              w0[0] = pack2(kt0[0], kt0[1]); w0[1] = pack2(kt0[2], kt0[3]); w0[2] = pack2(kt0[4], kt0[5]); w0[3] = pack2(kt0[6], kt0[7]);
              w1[0] = pack2(kt1[0], kt1[1]); w1[1] = pack2(kt1[2], kt1[3]); w1[2] = pack2(kt1[4], kt1[5]); w1[3] = pack2(kt1[6], kt1[7]);
              *(LAS u32x4*)(lds + MX_KTT + (2 * lane) * 144 + wave * 16) = w0;
              *(LAS u32x4*)(lds + MX_KTT + (2 * lane + 1) * 144 + wave * 16) = w1;
              *(LAS u32x4*)(lds + MX_VT + lane * 144 + wave * 16) = vpk; }
            if (MODE != 3 && MODE != 4) {
                f32x4 em;
                if (type == 0) { const float e_ = ex2(32.f * lg2); em = (f32x4){e_, e_, e_, e_}; }
                else {
                    f32x4 ms = (f32x4){0.f, 0.f, 0.f, 0.f};
#pragma unroll
                    for (int g = 0; g < 4; ++g) ms += *(const LAS f32x4*)(lds + MX_TOT + (g * 128 + 16 * wave + 4 * fq) * 4);
                    em = (f32x4){ex2(ms[0]), ex2(ms[1]), ex2(ms[2]), ex2(ms[3])};
                }
#pragma unroll
                for (int vt = 0; vt < 4; ++vt) { u32x2 o; o[0] = pack2(Sacc[vt][0] * em[0], Sacc[vt][1] * em[1]); o[1] = pack2(Sacc[vt][2] * em[2], Sacc[vt][3] * em[3]);
                    *(LAS u32x2*)(lds + MX_ST + (16 * vt + fr) * 272 + (16 * wave + 4 * fq) * 2) = o; }
            }
            if (wave == 0) { typedef float f32x2_ __attribute__((ext_vector_type(2))); *(LAS f32x2_*)(lds + MX_DEC + lane * 8) = (f32x2_){ex2(tt0), ex2(tt1)}; }
            LDS_BARRIER();
            if (MODE != 2 && MODE != 4) {
                const int it = wave >> 1, st0 = 2 * (wave & 1);
                bf16x8 ka[2][4], qb[4];
#pragma unroll
                for (int kq = 0; kq < 4; ++kq) {
                    qb[kq] = *(const LAS bf16x8*)(lds + MX_QI + (16 * it + fr) * 272 + (32 * kq + 8 * fq) * 2);
                    ka[0][kq] = *(const LAS bf16x8*)(lds + MX_KI + (16 * st0 + fr) * 272 + (32 * kq + 8 * fq) * 2);
                    ka[1][kq] = *(const LAS bf16x8*)(lds + MX_KI + (16 * st0 + 16 + fr) * 272 + (32 * kq + 8 * fq) * 2);
                }
                asm volatile("s_waitcnt lgkmcnt(0)" ::: "memory");
                f32x4 acc0 = (f32x4){0.f, 0.f, 0.f, 0.f}, acc1 = acc0;
#pragma unroll
                for (int kq = 0; kq < 4; ++kq) {
                    acc0 = __builtin_amdgcn_mfma_f32_16x16x32_bf16(ka[0][kq], qb[kq], acc0, 0, 0, 0);
                    acc1 = __builtin_amdgcn_mfma_f32_16x16x32_bf16(ka[1][kq], qb[kq], acc1, 0, 0, 0);
                }
                const int i = 16 * it + fr;
                { const int s0 = 16 * st0 + 4 * fq;
                  const float v0 = (s0 + 0 <= i) ? acc0[0] : 0.f, v1 = (s0 + 1 <= i) ? acc0[1] : 0.f, v2 = (s0 + 2 <= i) ? acc0[2] : 0.f, v3 = (s0 + 3 <= i) ? acc0[3] : 0.f;
                  u32x2 o; o[0] = pack2(v0, v1); o[1] = pack2(v2, v3);
                  *(LAS u32x2*)(lds + MX_P + i * 144 + s0 * 2) = o; }
                { const int s0 = 16 * st0 + 16 + 4 * fq;
                  const float v0 = (s0 + 0 <= i) ? acc1[0] : 0.f, v1 = (s0 + 1 <= i) ? acc1[1] : 0.f, v2 = (s0 + 2 <= i) ? acc1[2] : 0.f, v3 = (s0 + 3 <= i) ? acc1[3] : 0.f;
                  u32x2 o; o[0] = pack2(v0, v1); o[1] = pack2(v2, v3);
                  *(LAS u32x2*)(lds + MX_P + i * 144 + s0 * 2) = o; }
            }
            LDS_BARRIER();
            if (MODE != 2 && MODE != 4) {
                const int vt = wave >> 1, it0 = 2 * (wave & 1);
                bf16x8 va[2], sa[4], pb[2][2], qsb[2][4], kta[2], vb[4][2];
#pragma unroll
                for (int kq = 0; kq < 2; ++kq) {
                    va[kq] = *(const LAS bf16x8*)(lds + MX_VT + (16 * vt + fr) * 144 + (32 * kq + 8 * fq) * 2);
                    pb[0][kq] = *(const LAS bf16x8*)(lds + MX_P + (16 * it0 + fr) * 144 + (32 * kq + 8 * fq) * 2);
                    pb[1][kq] = *(const LAS bf16x8*)(lds + MX_P + (16 * it0 + 16 + fr) * 144 + (32 * kq + 8 * fq) * 2);
                    kta[kq] = *(const LAS bf16x8*)(lds + MX_KTT + (16 * wave + fr) * 144 + (32 * kq + 8 * fq) * 2);
                }
#pragma unroll
                for (int kq = 0; kq < 4; ++kq) {
                    sa[kq] = *(const LAS bf16x8*)(lds + MX_ST + (16 * vt + fr) * 272 + (32 * kq + 8 * fq) * 2);
                    qsb[0][kq] = *(const LAS bf16x8*)(lds + MX_QI + (16 * it0 + fr) * 272 + (32 * kq + 8 * fq) * 2);
                    qsb[1][kq] = *(const LAS bf16x8*)(lds + MX_QI + (16 * it0 + 16 + fr) * 272 + (32 * kq + 8 * fq) * 2);
                }
#pragma unroll
                for (int v4 = 0; v4 < 4; ++v4)
#pragma unroll
                    for (int kq = 0; kq < 2; ++kq) vb[v4][kq] = *(const LAS bf16x8*)(lds + MX_VT + (16 * v4 + fr) * 144 + (32 * kq + 8 * fq) * 2);
                const f32x4 dc = *(const LAS f32x4*)(lds + MX_DEC + (16 * wave + 4 * fq) * 4);
                asm volatile("s_waitcnt lgkmcnt(0)" ::: "memory");
                f32x4 acc0 = (f32x4){0.f, 0.f, 0.f, 0.f}, acc1 = acc0;
#pragma unroll
                for (int kq = 0; kq < 2; ++kq) {
                    acc0 = __builtin_amdgcn_mfma_f32_16x16x32_bf16(va[kq], pb[0][kq], acc0, 0, 0, 0);
                    acc1 = __builtin_amdgcn_mfma_f32_16x16x32_bf16(va[kq], pb[1][kq], acc1, 0, 0, 0);
                }
#pragma unroll
                for (int kq = 0; kq < 4; ++kq) {
                    acc0 = __builtin_amdgcn_mfma_f32_16x16x32_bf16(sa[kq], qsb[0][kq], acc0, 0, 0, 0);
                    acc1 = __builtin_amdgcn_mfma_f32_16x16x32_bf16(sa[kq], qsb[1][kq], acc1, 0, 0, 0);
                }
#pragma unroll
                for (int v4 = 0; v4 < 4; ++v4) {
                    f32x4 a = Sacc[v4]; a[0] *= dc[0]; a[1] *= dc[1]; a[2] *= dc[2]; a[3] *= dc[3];
                    a = __builtin_amdgcn_mfma_f32_16x16x32_bf16(kta[0], vb[v4][0], a, 0, 0, 0);
                    a = __builtin_amdgcn_mfma_f32_16x16x32_bf16(kta[1], vb[v4][1], a, 0, 0, 0);
                    Sacc[v4] = a;
                }
                asm volatile("s_waitcnt vmcnt(0)" ::: "memory");
                { const int tau = ch * 64 + 16 * it0 + fr; const int t = dir ? (SEQ - 1 - tau) : tau;
                  u32x2 o; o[0] = pack2(acc0[0], acc0[1]); o[1] = pack2(acc0[2], acc0[3]);
                  *(u32x2*)((bf16_t*)obuf + ((size_t)dir * T + (size_t)(b * SEQ + t)) * 1536 + ocol + 16 * vt + 4 * fq) = o; }
                { const int tau = ch * 64 + 16 * it0 + 16 + fr; const int t = dir ? (SEQ - 1 - tau) : tau;
                  u32x2 o; o[0] = pack2(acc1[0], acc1[1]); o[1] = pack2(acc1[2], acc1[3]);
                  *(u32x2*)((bf16_t*)obuf + ((size_t)dir * T + (size_t)(b * SEQ + t)) * 1536 + ocol + 16 * vt + 4 * fq) = o; }
            }
        }
        __syncthreads();
#undef MX_LOAD
    }
}

#ifdef MIXER_CHECK
__device__ __forceinline__ void phase_mixer_check(const Params& p, const float* __restrict__ oa, const float* __restrict__ ob, float* chk) {
    int tid_ = threadIdx.x; asm volatile("" : "+v"(tid_)); const int wave = tid_ >> 6, lane = tid_ & 63;
    for (int r = blockIdx.x * 8 + wave; r < 2 * T; r += gridDim.x * 8) {
        const int dir = r / T;
#pragma unroll
        for (int ty = 0; ty < 2; ++ty) {
            float sd = 0.f, sq = 0.f;
#pragma unroll
            for (int i = 0; i < 3; ++i) { const float4 a = *(const float4*)(oa + (size_t)r * 1536 + ty * 768 + i * 256 + lane * 4), bq = *(const float4*)(ob + (size_t)r * 1536 + ty * 768 + i * 256 + lane * 4);
                sd += (a.x - bq.x) * (a.x - bq.x) + (a.y - bq.y) * (a.y - bq.y) + (a.z - bq.z) * (a.z - bq.z) + (a.w - bq.w) * (a.w - bq.w);
                sq += a.x * a.x + a.y * a.y + a.z * a.z + a.w * a.w; }
            sd = wave_sum(sd); sq = wave_sum(sq);
            if (lane == 0) { atomicAdd(&chk[(ty * 2 + dir) * 2 + 0], sd); atomicAdd(&chk[(ty * 2 + dir) * 2 + 1], sq); }
        }
    }
}
#endif

__device__ __forceinline__ float4 ld_bf4(const bf16_t* p) { const u32x2 r = *(const u32x2*)p; return make_float4(bf2f(r[0] & 0xffffu), bf2f(r[0] >> 16), bf2f(r[1] & 0xffffu), bf2f(r[1] >> 16)); }
__device__ __forceinline__ float grp16_sum(float v) {
#pragma unroll
    for (int o = 8; o > 0; o >>= 1) v += __shfl_xor(v, o, 64);
    return v;
}
__device__ __forceinline__ void phase_finalize(const Params& p, int l) {
    int tid_ = threadIdx.x; asm volatile("" : "+v"(tid_)); const int wave = tid_ >> 6, lane = tid_ & 63;
    const bf16_t* proj = (const bf16_t*)(p.ws + WS_PROJ);
    const bf16_t* obuf = (const bf16_t*)(p.ws + WS_OBUF);
    bf16_t* mixed = (bf16_t*)(p.ws + WS_MIXED);
    const float* cw = p.conv_w + (size_t)l * 3 * CW;
    const float* beta = p.mix_beta + (size_t)l * D;
    for (int n = blockIdx.x * 8 + wave; n < T; n += gridDim.x * 8) {
        const int t = n % SEQ;
        const bf16_t* row = proj + (size_t)n * INC;
#pragma unroll
        for (int i = 0; i < 4; ++i) {
            const int c = COL8(i);
            float4 r[2];
            if (i == 0) {
                float4 cc[2], ch[2], cb[2], um[2], up[2];
                ld_bf8(row + C_CC + c, cc[0], cc[1]); ld_bf8(row + C_CH + c, ch[0], ch[1]); ld_bf8(row + C_CB + c, cb[0], cb[1]);
                um[0] = um[1] = up[0] = up[1] = make_float4(0.f, 0.f, 0.f, 0.f);
                if (t > 0) { float4 a[2], b2[2]; ld_bf8(row - INC + C_CC + c, a[0], a[1]); ld_bf8(row - INC + C_CH + c, b2[0], b2[1]);
#pragma unroll
                    for (int q = 0; q < 2; ++q) um[q] = make_float4(a[q].x * b2[q].x, a[q].y * b2[q].y, a[q].z * b2[q].z, a[q].w * b2[q].w); }
                if (t < SEQ - 1) { float4 a[2], b2[2]; ld_bf8(row + INC + C_CC + c, a[0], a[1]); ld_bf8(row + INC + C_CH + c, b2[0], b2[1]);
#pragma unroll
                    for (int q = 0; q < 2; ++q) up[q] = make_float4(a[q].x * b2[q].x, a[q].y * b2[q].y, a[q].z * b2[q].z, a[q].w * b2[q].w); }
#pragma unroll
                for (int q = 0; q < 2; ++q) {
                    const float4 w0 = *(const float4*)(cw + c + 4 * q), w1 = *(const float4*)(cw + CW + c + 4 * q), w2 = *(const float4*)(cw + 2 * CW + c + 4 * q);
                    r[q].x = cb[q].x * (um[q].x * w0.x + cc[q].x * ch[q].x * w1.x + up[q].x * w2.x);
                    r[q].y = cb[q].y * (um[q].y * w0.y + cc[q].y * ch[q].y * w1.y + up[q].y * w2.y);
                    r[q].z = cb[q].z * (um[q].z * w0.z + cc[q].z * ch[q].z * w1.z + up[q].z * w2.z);
                    r[q].w = cb[q].w * (um[q].w * w0.w + cc[q].w * ch[q].w * w1.w + up[q].w * w2.w);
                }
            } else {
                const int oc = c - 512;
                const bool isret = oc < 768;
                float4 of[2], ob[2], gt[2];
                ld_bf8(obuf + (size_t)n * 1536 + oc, of[0], of[1]); ld_bf8(obuf + ((size_t)T + n) * 1536 + oc, ob[0], ob[1]);
                ld_bf8(row + (isret ? C_RG + oc : C_HG + (oc - 768)), gt[0], gt[1]);
                float4 o[2];
#pragma unroll
                for (int q = 0; q < 2; ++q) o[q] = make_float4(of[q].x + ob[q].x, of[q].y + ob[q].y, of[q].z + ob[q].z, of[q].w + ob[q].w);
                const float sm = grp16_sum(((o[0].x + o[0].y) + (o[0].z + o[0].w)) + ((o[1].x + o[1].y) + (o[1].z + o[1].w)));
                const float mu = isret ? sm * (1.0f / 128.0f) : 0.f;
#pragma unroll
                for (int q = 0; q < 2; ++q) { o[q].x -= mu; o[q].y -= mu; o[q].z -= mu; o[q].w -= mu; }
                const float var = grp16_sum(((o[0].x * o[0].x + o[0].y * o[0].y) + (o[0].z * o[0].z + o[0].w * o[0].w)) + ((o[1].x * o[1].x + o[1].y * o[1].y) + (o[1].z * o[1].z + o[1].w * o[1].w))) * (1.0f / 128.0f);
                const float rs = rsqrtf(var + 1e-6f);
#pragma unroll
                for (int q = 0; q < 2; ++q) r[q] = make_float4(o[q].x * rs * siluf_(gt[q].x), o[q].y * rs * siluf_(gt[q].y), o[q].z * rs * siluf_(gt[q].z), o[q].w * rs * siluf_(gt[q].w));
            }
            const float4 bt0 = *(const float4*)(beta + c), bt1 = *(const float4*)(beta + c + 4);
            r[0] = make_float4(r[0].x * bt0.x, r[0].y * bt0.y, r[0].z * bt0.z, r[0].w * bt0.w);
            r[1] = make_float4(r[1].x * bt1.x, r[1].y * bt1.y, r[1].z * bt1.z, r[1].w * bt1.w);
            if (OUT8(l)) { const float4 a4 = make_float4(r[0].x * 4.f, r[0].y * 4.f, r[0].z * 4.f, r[0].w * 4.f), b4 = make_float4(r[1].x * 4.f, r[1].y * 4.f, r[1].z * 4.f, r[1].w * 4.f);
                           st_fp8x8((unsigned char*)mixed + (size_t)n * D + c, a4, b4); }
            else st_bf8(mixed + (size_t)n * D + c, r[0], r[1]);
        }
    }
}

#define RGRP 2
__device__ __forceinline__ void phase_ln1_router(const Params& p, int l, LAS unsigned char* lds) {
    int tid = threadIdx.x; asm volatile("" : "+v"(tid)); const int wave = tid >> 6, lane = tid & 63;
    LAS float* wrt = (LAS float*)lds;
    for (int i = tid; i < D * NE / 4; i += 512) {
        const float4 w = *(const float4*)(p.w_router + (size_t)i * 4);
        const int d = i >> 2, e4 = (i & 3) * 4;
        const int dp = (((d >> 9) * 2 + ((d >> 2) & 1)) << 8) + (((d >> 3) & 63) << 2) + (d & 3);
        wrt[(e4 + 0) * D + dp] = w.x; wrt[(e4 + 1) * D + dp] = w.y; wrt[(e4 + 2) * D + dp] = w.z; wrt[(e4 + 3) * D + dp] = w.w;
    }
    LAS int* lcnt = (LAS int*)(lds + LDS_MISC + 256);
    if (tid < 16) lcnt[tid] = 0;
    __syncthreads();
    const float* mod = (const float*)(p.ws + WS_MOD);
    const float* y = (const float*)(p.ws + WS_Y);
    float* xres = (float*)(p.ws + WS_XRES);
    int* route = (int*)(p.ws + WS_ROUTE);
    for (int n0 = (blockIdx.x * 8 + wave) * 2; n0 < T; n0 += gridDim.x * 16) {
        float4 h[2][8];
        {
            const int b = n0 / SEQ;
            const float* mb = mod + ((size_t)l * 4 + b) * (6 * D);
#pragma unroll
            for (int i = 0; i < 4; ++i) {
                float4 xv[2][2], yv[2][2];
#pragma unroll
                for (int r = 0; r < 2; ++r) { ld_bf8((const bf16_t*)xres + (size_t)(n0 + r) * D + COL8(i), xv[r][0], xv[r][1]); ld_bf8((const bf16_t*)y + (size_t)(n0 + r) * D + COL8(i), yv[r][0], yv[r][1]); }
#pragma unroll
                for (int q = 0; q < 2; ++q) {
                    const float4 g = *(const float4*)(mb + 2 * D + COLK(2 * i + q));
#pragma unroll
                    for (int r = 0; r < 2; ++r)
                        h[r][2 * i + q] = make_float4(ALPHA * xv[r][q].x + (1.f + g.x) * yv[r][q].x, ALPHA * xv[r][q].y + (1.f + g.y) * yv[r][q].y, ALPHA * xv[r][q].z + (1.f + g.z) * yv[r][q].z, ALPHA * xv[r][q].w + (1.f + g.w) * yv[r][q].w);
                }
            }
            float s0 = 0.f, s1 = 0.f;
#pragma unroll
            for (int i = 0; i < 8; ++i) { s0 += (h[0][i].x + h[0][i].y) + (h[0][i].z + h[0][i].w); s1 += (h[1][i].x + h[1][i].y) + (h[1][i].z + h[1][i].w); }
#pragma unroll
            for (int o = 32; o > 0; o >>= 1) { s0 += __shfl_xor(s0, o, 64); s1 += __shfl_xor(s1, o, 64); }
            const float mean0 = s0 * (1.0f / D), mean1 = s1 * (1.0f / D);
            float q0 = 0.f, q1 = 0.f;
#pragma unroll
            for (int i = 0; i < 8; ++i) {
                { const float a = h[0][i].x - mean0, bb = h[0][i].y - mean0, c = h[0][i].z - mean0, d = h[0][i].w - mean0; q0 += (a * a + bb * bb) + (c * c + d * d); }
                { const float a = h[1][i].x - mean1, bb = h[1][i].y - mean1, c = h[1][i].z - mean1, d = h[1][i].w - mean1; q1 += (a * a + bb * bb) + (c * c + d * d); }
            }
#pragma unroll
            for (int o = 32; o > 0; o >>= 1) { q0 += __shfl_xor(q0, o, 64); q1 += __shfl_xor(q1, o, 64); }
            const float rstd0 = rsqrtf(q0 * (1.0f / D) + 1e-5f), rstd1 = rsqrtf(q1 * (1.0f / D) + 1e-5f);
            const float* lg_ = p.ln_g + (size_t)(l * 2 + 0) * D; const float* lb_ = p.ln_b + (size_t)(l * 2 + 0) * D;
#pragma unroll
            for (int i = 0; i < 8; ++i) {
                const float4 gv = *(const float4*)(lg_ + COLK(i)), bv = *(const float4*)(lb_ + COLK(i));
                h[0][i].x = (h[0][i].x - mean0) * rstd0 * gv.x + bv.x; h[0][i].y = (h[0][i].y - mean0) * rstd0 * gv.y + bv.y;
                h[0][i].z = (h[0][i].z - mean0) * rstd0 * gv.z + bv.z; h[0][i].w = (h[0][i].w - mean0) * rstd0 * gv.w + bv.w;
                h[1][i].x = (h[1][i].x - mean1) * rstd1 * gv.x + bv.x; h[1][i].y = (h[1][i].y - mean1) * rstd1 * gv.y + bv.y;
                h[1][i].z = (h[1][i].z - mean1) * rstd1 * gv.z + bv.z; h[1][i].w = (h[1][i].w - mean1) * rstd1 * gv.w + bv.w;
            }
#pragma unroll
            for (int r = 0; r < 2; ++r)
#pragma unroll
                for (int i = 0; i < 4; ++i) st_bf8((bf16_t*)xres + (size_t)(n0 + r) * D + COL8(i), h[r][2 * i], h[r][2 * i + 1]);
#pragma unroll
            for (int i = 0; i < 8; ++i) {
                const float4 sh = *(const float4*)(mb + 3 * D + COLK(i)), sc = *(const float4*)(mb + 4 * D + COLK(i));
#pragma unroll
                for (int r = 0; r < 2; ++r) {
                    float4& v = h[r][i];
                    v.x = v.x * (1.f + sc.x) + sh.x; v.y = v.y * (1.f + sc.y) + sh.y; v.z = v.z * (1.f + sc.z) + sh.z; v.w = v.w * (1.f + sc.w) + sh.w;
                }
            }
#pragma unroll
            for (int r = 0; r < 2; ++r) {
#if MOE_FP8
                unsigned char* hb = p.ws + WS_HB + (size_t)(n0 + r) * D;
#pragma unroll
                for (int i = 0; i < 4; ++i) st_fp8x8(hb + COL8(i), h[r][2 * i], h[r][2 * i + 1]);
#else
                bf16_t* hb = (bf16_t*)(p.ws + WS_HB) + (size_t)(n0 + r) * D;
#pragma unroll
                for (int i = 0; i < 4; ++i) st_bf8(hb + COL8(i), h[r][2 * i], h[r][2 * i + 1]);
#endif
            }
        }
        float lgk0 = 0.f, lgk1 = 0.f, lgk2 = 0.f, lgk3 = 0.f;
        const bool b5 = (lane & 32) != 0, b4 = (lane & 16) != 0, b3 = (lane & 8) != 0, b2 = (lane & 4) != 0;
#pragma unroll 1
        for (int eg = 0; eg < 4; ++eg) {
            float s[RGRP][4];
#pragma unroll
            for (int q = 0; q < 4; ++q) {
                f32x2_t ac[RGRP];
#pragma unroll
                for (int r = 0; r < RGRP; ++r) ac[r] = (f32x2_t){0.f, 0.f};
#pragma unroll
                for (int i = 0; i < 8; ++i) {
                    const f32x4 w = *(const LAS f32x4*)(wrt + (eg * 4 + q) * D + i * 256 + lane * 4);
                    const f32x2_t w01 = __builtin_shufflevector(w, w, 0, 1), w23 = __builtin_shufflevector(w, w, 2, 3);
#pragma unroll
                    for (int r = 0; r < RGRP; ++r) {
                        ac[r] = __builtin_elementwise_fma((f32x2_t){h[r][i].x, h[r][i].y}, w01, ac[r]);
                        ac[r] = __builtin_elementwise_fma((f32x2_t){h[r][i].z, h[r][i].w}, w23, ac[r]);
                    }
                }
#pragma unroll
                for (int r = 0; r < RGRP; ++r) s[r][q] = ac[r][0] + ac[r][1];
            }
            float u[RGRP];
#pragma unroll
            for (int r = 0; r < RGRP; ++r) {
                const float tA = (b5 ? s[r][2] : s[r][0]) + __shfl_xor(b5 ? s[r][0] : s[r][2], 32, 64);
                const float tB = (b5 ? s[r][3] : s[r][1]) + __shfl_xor(b5 ? s[r][1] : s[r][3], 32, 64);
                u[r] = (b4 ? tB : tA) + __shfl_xor(b4 ? tA : tB, 16, 64);
            }
#if RGRP == 4
            const float pA = (b3 ? u[2] : u[0]) + __shfl_xor(b3 ? u[0] : u[2], 8, 64);
            const float pB = (b3 ? u[3] : u[1]) + __shfl_xor(b3 ? u[1] : u[3], 8, 64);
            float z = (b2 ? pB : pA) + __shfl_xor(b2 ? pA : pB, 4, 64);
#else
            float z = (b3 ? u[1] : u[0]) + __shfl_xor(b3 ? u[0] : u[1], 8, 64);
            z += __shfl_xor(z, 4, 64);
#endif
            z += __shfl_xor(z, 2, 64); z += __shfl_xor(z, 1, 64);
            lgk0 = (eg == 0) ? z : lgk0; lgk1 = (eg == 1) ? z : lgk1; lgk2 = (eg == 2) ? z : lgk2; lgk3 = (eg == 3) ? z : lgk3;
        }
#pragma unroll 1
        for (int r = 0; r < RGRP; ++r) {
            const int n = n0 + r;
            const int rl = r * 8;
            float lg[16];
#pragma unroll
            for (int q = 0; q < 4; ++q) {
                const int src = ((q >> 1) * 32) + ((q & 1) * 16) + rl;
                lg[0 + q] = __int_as_float(__builtin_amdgcn_readlane(__float_as_int(lgk0), src));
                lg[4 + q] = __int_as_float(__builtin_amdgcn_readlane(__float_as_int(lgk1), src));
                lg[8 + q] = __int_as_float(__builtin_amdgcn_readlane(__float_as_int(lgk2), src));
                lg[12 + q] = __int_as_float(__builtin_amdgcn_readlane(__float_as_int(lgk3), src));
            }
            float mx = lg[0];
#pragma unroll
            for (int e = 1; e < 16; ++e) mx = fmaxf(mx, lg[e]);
            float sc[16], sum = 0.f;
#pragma unroll
            for (int e = 0; e < 16; ++e) { sc[e] = expf(lg[e] - mx); sum += sc[e]; }
            const float inv = 1.0f / sum;
            float sel[16];
#pragma unroll
            for (int e = 0; e < 16; ++e) { sc[e] *= inv; sel[e] = sc[e] + p.router_bias[e]; }
            float best_gs = -3.0e38f; int bi0 = 0, bi1 = 1; float bw0 = 0.f, bw1 = 0.f;
#pragma unroll
            for (int g = 0; g < 4; ++g) {
                int i0 = 0; float m0 = sel[4 * g];
#pragma unroll
                for (int j = 1; j < 4; ++j) if (sel[4 * g + j] > m0) { m0 = sel[4 * g + j]; i0 = j; }
                int i1 = -1; float m1 = -3.0e38f;
#pragma unroll
                for (int j = 0; j < 4; ++j) if (j != i0 && sel[4 * g + j] > m1) { m1 = sel[4 * g + j]; i1 = j; }
                float w0 = 0.f, w1 = 0.f;
#pragma unroll
                for (int j = 0; j < 4; ++j) { w0 = (j == i0) ? sc[4 * g + j] : w0; w1 = (j == i1) ? sc[4 * g + j] : w1; }
                const float gs = m0 + m1;
                if (gs > best_gs) { best_gs = gs; bi0 = 4 * g + i0; bi1 = 4 * g + i1; bw0 = w0; bw1 = w1; }
            }
            if (lane == 0) {
                const float ws_ = 1.0f / (bw0 + bw1);
                const int p0 = __hip_atomic_fetch_add(&lcnt[bi0], 1, __ATOMIC_RELAXED, __HIP_MEMORY_SCOPE_WORKGROUP), p1 = __hip_atomic_fetch_add(&lcnt[bi1], 1, __ATOMIC_RELAXED, __HIP_MEMORY_SCOPE_WORKGROUP);
                int* rr = route + (size_t)n * 8;
                rr[0] = bi0; rr[1] = bi1; rr[2] = (int)p0; rr[3] = (int)p1; rr[4] = __float_as_int(bw0 * ws_); rr[5] = __float_as_int(bw1 * ws_);
            }
        }
    }
    __syncthreads();
    if (tid < 16) ((int*)(p.ws + WS_WGCNT))[((size_t)l * 1024 + blockIdx.x) * 16 + tid] = lcnt[tid];
}

__device__ __forceinline__ void build_moe_tab(const Params& p, int l, LAS int* tab) {
    if (threadIdx.x == 0) {
        const unsigned* cnt = (const unsigned*)(p.ws + WS_CNT) + l * 16;
        int acc = 0;
        for (int e = 0; e < 16; ++e) { tab[e] = acc; acc += (int)((cnt[e] + 255u) >> 8); }
        tab[16] = acc;
    }
    __syncthreads();
}

__device__ __forceinline__ void phase_permute(const Params& p, int l, LAS int* tab) {
    int tid_ = threadIdx.x; asm volatile("" : "+v"(tid_)); const int wave = tid_ >> 6, lane = tid_ & 63;
    LAS int* base = tab + 32; LAS int* total = tab + 48;
    if (tid_ < 16) { base[tid_] = 0; total[tid_] = 0; }
    __syncthreads();
    {
        const int* wgc = (const int*)(p.ws + WS_WGCNT) + (size_t)l * 1024 * 16;
        const int e = tid_ & 15; int bs = 0, tt = 0;
        for (int w = tid_ >> 4; w < (int)gridDim.x; w += 32) { const int v = wgc[w * 16 + e]; tt += v; bs += (w < (int)blockIdx.x) ? v : 0; }
        __hip_atomic_fetch_add(&base[e], bs, __ATOMIC_RELAXED, __HIP_MEMORY_SCOPE_WORKGROUP);
        __hip_atomic_fetch_add(&total[e], tt, __ATOMIC_RELAXED, __HIP_MEMORY_SCOPE_WORKGROUP);
    }
    __syncthreads();
    if (tid_ == 0) { int acc = 0; for (int e = 0; e < 16; ++e) { tab[e] = acc; acc += (total[e] + 255) >> 8; } tab[16] = acc; }
    if (blockIdx.x == 0 && tid_ < 16) ((unsigned*)(p.ws + WS_CNT))[l * 16 + tid_] = (unsigned)total[tid_];
    __syncthreads();
#if MOE_FP8
    for (int i = blockIdx.x * 512 + tid_; i < XE_ROWS * 8; i += gridDim.x * 512) *(u32x4*)(p.ws + WS_HID + (size_t)(i >> 3) * DEP + DE + (i & 7) * 16) = (u32x4){0u, 0u, 0u, 0u};
#endif
    int* route = (int*)(p.ws + WS_ROUTE);
    const bf16_t* hb = (const bf16_t*)(p.ws + WS_HB);
    bf16_t* xe = (bf16_t*)(p.ws + WS_XE);
    for (int m = blockIdx.x * 16 + wave * 2; m < T; m += gridDim.x * 16)
#pragma unroll 1
    for (int n = m; n < m + 2; ++n) {
        int* r = route + (size_t)n * 8;
        const int e0 = r[0], e1 = r[1], p0 = r[2], p1 = r[3];
        const int row0 = tab[e0] * 256 + base[e0] + p0, row1 = tab[e1] * 256 + base[e1] + p1;
        constexpr int RB = MOE_FP8 ? D : 2 * D;
        const u32x4* src = (const u32x4*)((const unsigned char*)hb + (size_t)n * RB);
        u32x4* d0 = (u32x4*)((unsigned char*)xe + (size_t)row0 * RB); u32x4* d1 = (u32x4*)((unsigned char*)xe + (size_t)row1 * RB);
#pragma unroll
        for (int i = 0; i < RB / 1024; ++i) { const u32x4 v = src[i * 64 + lane]; d0[i * 64 + lane] = v; d1[i * 64 + lane] = v; }
        if (lane == 0) { r[6] = row0; r[7] = row1; }
    }
}

__device__ __forceinline__ void phase_ln2(const Params& p, int l) {
    int tid_ = threadIdx.x; asm volatile("" : "+v"(tid_)); const int wave = tid_ >> 6, lane = tid_ & 63;
    const float* mod = (const float*)(p.ws + WS_MOD);
    const float* ye = (const float*)(p.ws + WS_YE);
    float* xres = (float*)(p.ws + WS_XRES);
    const int* route = (const int*)(p.ws + WS_ROUTE);
    for (int n = blockIdx.x * 8 + wave; n < T; n += gridDim.x * 8) {
        const int b = n / SEQ;
        const float* mb = mod + ((size_t)l * 4 + b) * (6 * D);
        const int* r = route + (size_t)n * 8;
        const float w0 = __int_as_float(r[4]), w1 = __int_as_float(r[5]);
        const bf16_t* y0 = (const bf16_t*)ye + (size_t)r[6] * D; const bf16_t* y1 = (const bf16_t*)ye + (size_t)r[7] * D;
        float4 v[8];
#pragma unroll
        for (int i = 0; i < 4; ++i) {
            float4 xv[2], a[2], c[2];
            ld_bf8((const bf16_t*)xres + (size_t)n * D + COL8(i), xv[0], xv[1]); ld_bf8(y0 + COL8(i), a[0], a[1]); ld_bf8(y1 + COL8(i), c[0], c[1]);
#pragma unroll
            for (int q = 0; q < 2; ++q) {
                const float4 g = *(const float4*)(mb + 5 * D + COLK(2 * i + q));
                v[2 * i + q] = make_float4(ALPHA * xv[q].x + (1.f + g.x) * (w0 * a[q].x + w1 * c[q].x), ALPHA * xv[q].y + (1.f + g.y) * (w0 * a[q].y + w1 * c[q].y),
                                           ALPHA * xv[q].z + (1.f + g.z) * (w0 * a[q].z + w1 * c[q].z), ALPHA * xv[q].w + (1.f + g.w) * (w0 * a[q].w + w1 * c[q].w));
            }
        }
        ln_rows(v, p.ln_g + (size_t)(l * 2 + 1) * D, p.ln_b + (size_t)(l * 2 + 1) * D, lane);
        if (l + 1 < DEPTH) {
#pragma unroll
            for (int i = 0; i < 4; ++i) st_bf8((bf16_t*)xres + (size_t)n * D + COL8(i), v[2 * i], v[2 * i + 1]);
            const float* mn = mod + ((size_t)(l + 1) * 4 + b) * (6 * D);
            modulate_store(v, mn, mn + D, INP8(l + 1) ? (bf16_t*)(p.ws + WS_HA + (size_t)n * D) : (bf16_t*)(p.ws + WS_HA) + (size_t)n * D, lane, INP8(l + 1));
        } else {
#ifdef MIXER_CHECK
            { const float* chk = (const float*)(p.ws + WS_CNT + 1024); float scale = 1.f;
              for (int j = 7; j >= 0; --j) { const float sd = chk[j * 2], sq = chk[j * 2 + 1]; if (!(sd <= 1e-3f * sq)) scale = 1.0f + 0.25f * (float)(1 << (j & 3)) + 8.f * (float)(j >> 2); }
#pragma unroll
              for (int i = 0; i < 8; ++i) { v[i].x *= scale; v[i].y *= scale; v[i].z *= scale; v[i].w *= scale; } }
#endif
#pragma unroll
            for (int i = 0; i < 8; ++i) *(float4*)(p.out + (size_t)n * D + COLK(i)) = v[i];
        }
    }
}

typedef const __attribute__((address_space(4))) unsigned char* KargPtr;
__device__ __forceinline__ Params load_params(KargPtr q) { asm volatile("" : "+s"(q)); Params lp; __builtin_memcpy(&lp, q, sizeof(Params)); return lp; }

__global__ __launch_bounds__(512, 2) void mega(Params p_in) {
    extern __shared__ __attribute__((aligned(16))) unsigned char smem[];
    LAS unsigned char* lds = (LAS unsigned char*)smem;
    LAS int* tab = (LAS int*)(lds + LDS_MISC + 64);
    KargPtr kp = (KargPtr)__builtin_amdgcn_kernarg_segment_ptr();
    if (threadIdx.x == 0) { *(LAS u32x4*)(lds + LDS_MISC) = (u32x4){0u, 0u, 0u, 0u}; *(LAS u32x4*)(lds + LDS_MISC + 768) = (u32x4){0u, 0u, 0u, 0u}; *(LAS u32x4*)(lds + LDS_MISC + 784) = (u32x4){0u, 0u, 0u, 0u}; }
    __syncthreads();
    const int fused = p_in.fused, ph_lo = p_in.ph_lo, ph_hi = p_in.ph_hi, l_hi = p_in.l_hi;
    XcdBarrier bar;
    if (fused) bar = xcd_barrier_post((unsigned*)(p_in.ws + WS_BAR), (volatile LAS unsigned*)(lds + LDS_MISC));
    else { bar.bar = (unsigned*)(p_in.ws + WS_BAR); bar.x = 0; bar.st = (volatile LAS unsigned*)(lds + LDS_MISC); }
#ifdef ONLY_PH
#define PH(i) ((i) == ONLY_PH && ph_lo <= (i) && (i) < ph_hi)
#else
#define PH(i) (ph_lo <= (i) && (i) < ph_hi)
#endif
#ifdef PROBE_PH
#define SYNC_PLAIN() do { if (fused) xcd_barrier(bar); } while (0)
#define PSTART(i) do { if ((i) == PROBE_PH && blockIdx.x == 0 && threadIdx.x == 0) { *(LAS unsigned long long*)(lds + LDS_MISC + 768) = __builtin_amdgcn_s_memrealtime(); } } while (0)
#define PSTOP(i) do { if ((i) == PROBE_PH && blockIdx.x == 0 && threadIdx.x == 0) { *(LAS unsigned long long*)(lds + LDS_MISC + 776) += __builtin_amdgcn_s_memrealtime() - *(LAS unsigned long long*)(lds + LDS_MISC + 768); } } while (0)
#else
#define PSTART(i) do { } while (0)
#define PSTOP(i) do { } while (0)
#endif
#if defined(PROBE_PH) && defined(PROBE_SUB)
#define QSTART(i, k) do { if ((i) == PROBE_PH && (k) == PROBE_SUB && blockIdx.x == PROBE_WG && threadIdx.x == 0) { *(LAS unsigned long long*)(lds + LDS_MISC + 784) = __builtin_amdgcn_s_memrealtime(); } } while (0)
#define QSTOP(i, k) do { if ((i) == PROBE_PH && (k) == PROBE_SUB && blockIdx.x == PROBE_WG && threadIdx.x == 0) { *(LAS unsigned long long*)(lds + LDS_MISC + 792) += __builtin_amdgcn_s_memrealtime() - *(LAS unsigned long long*)(lds + LDS_MISC + 784); } } while (0)
#else
#define QSTART(i, k) do { } while (0)
#define QSTOP(i, k) do { } while (0)
#endif
#define SYNC() do { if (fused) xcd_barrier(bar); } while (0)
#ifndef DUP_MASK
#define DUP_MASK 0
#endif
#define REP(i) _Pragma("unroll 1") for (int rep_ = 0; rep_ < 1 + ((DUP_MASK >> (i)) & 1); ++rep_)
    const int G = gridDim.x, c = blockIdx.x;
    if (PH(0)) REP(0) { PSTART(0); const Params p = load_params(kp); phase_prologue(p, lds); SYNC(); PSTOP(0); }
    if (PH(1)) REP(1) { PSTART(1); const Params p = load_params(kp); phase_ln0(p); SYNC(); PSTOP(1); }
    for (int l = p_in.l_lo; l < l_hi; ++l) {
        const bool svc = (l == 0) && (G >= 256);
        if (PH(2)) REP(2) { PSTART(2);
            const Params p = load_params(kp);
            pg8::Gemm g{(const bf16_t*)(p.ws + WS_HA), (const bf16_t*)(p.ws + WS_WIN) + (size_t)l * INC * D, D};
            pg8::EpiBf16 E{(bf16_t*)(p.ws + WS_PROJ), INC};
            if (svc) {
                if (c < 240) {
                    pg8::DenseOrder<32, 30> S; S.init(INP8(0) ? D : 2 * D, 240, c);
                    if (INP8(0)) pg8::gemm_phase<pg8::EpiBf16, pg8::DenseOrder<32, 30>, true>(lds, g, S, E, 121, 127);
                    else pg8::gemm_phase(lds, g, S, E);
                } else ada_chunks(p, lds, 128 + (c - 240), 256, 16);
                tail_pull(p, lds, l * 4 + 0);
            } else {
                pg8::DenseOrder<32, 32> S; S.init(INP8(l) ? D : 2 * D, G, c);
                if (INP8(l)) pg8::gemm_phase<pg8::EpiBf16, pg8::DenseOrder<32, 32>, true>(lds, g, S, E, 121, 127);
                else pg8::gemm_phase(lds, g, S, E);
            }
            SYNC(); PSTOP(2);
        }
#ifdef MIXER_CHECK
        if (PH(3)) REP(3) { PSTART(3); const Params p = load_params(kp); phase_mixer_valu(p, l, lds); SYNC(); PSTOP(3); }
        if (PH(3)) REP(3) { PSTART(3); const Params p = load_params(kp); phase_mixer_mfma<0>(p, l, lds, (float*)(p.ws + WS_XE)); SYNC(); PSTOP(3); }
        if (PH(3)) REP(3) { PSTART(3); const Params p = load_params(kp); phase_mixer_check(p, (const float*)(p.ws + WS_OBUF), (const float*)(p.ws + WS_XE), (float*)(p.ws + WS_CNT + 1024) + l * 8); SYNC(); PSTOP(3); }
#else
        if (PH(3)) REP(3) { PSTART(3);
            const Params p = load_params(kp);
            const int n_extra = svc ? 96 : 32, pn0 = svc ? 30 : 32;
            for (int uu = (G >= 224 ? c - 192 : c); uu >= 0 && uu < n_extra; uu += (G >= 224 ? 64 : G)) {
                const int RBI = INP8(l) ? D : 2 * D;
                pg8::OneUnit S; S.u0.aB = (size_t)(uu & 31) * 256 * RBI; S.u0.bB = (size_t)(pn0 + (uu >> 5)) * 256 * RBI; S.u0.row0 = (uu & 31) * 256; S.u0.col0 = (pn0 + (uu >> 5)) * 256;
                pg8::EpiBf16 E{(bf16_t*)(p.ws + WS_PROJ), INC};
                pg8::Gemm g{(const bf16_t*)(p.ws + WS_HA), (const bf16_t*)(p.ws + WS_WIN) + (size_t)l * INC * D, D};
                if (INP8(l)) pg8::gemm_phase<pg8::EpiBf16, pg8::OneUnit, true>(lds, g, S, E, 121, 127);
                else pg8::gemm_phase(lds, g, S, E);
            }
            phase_mixer_mfma<0>(p, l, lds, (float*)(p.ws + WS_OBUF));
            tail_pull(p, lds, l * 4 + 1);
            SYNC(); PSTOP(3);
#ifdef MIXER_PROBE
            phase_mixer_mfma<MIXER_PROBE>(p, l, lds, (float*)(p.ws + WS_XE));
            SYNC(); PSTOP(3);
#endif
        }
#endif
        if (PH(4)) REP(4) { PSTART(4); const Params p = load_params(kp); phase_finalize(p, l); SYNC(); PSTOP(4); }
        if (PH(5)) REP(5) { PSTART(5);
            const Params p = load_params(kp);
            pg8::DenseOrder<32, 8> S; S.init(OUT8(l) ? D : 2 * D, G, c);
            pg8::Gemm g{(const bf16_t*)(p.ws + WS_MIXED), (const bf16_t*)(p.ws + WS_WOUT) + (size_t)l * D * D, D};
            pg8::EpiBf16 E{(bf16_t*)(p.ws + WS_Y), D};
            if (OUT8(l)) pg8::gemm_phase<pg8::EpiBf16, pg8::DenseOrder<32, 8>, true>(lds, g, S, E, 121, 125);
            else pg8::gemm_phase(lds, g, S, E);
            SYNC(); PSTOP(5);
        }
        if (PH(6)) REP(6) { PSTART(6); const Params p = load_params(kp); phase_ln1_router(p, l, lds); SYNC(); PSTOP(6); }
        if (PH(7)) REP(7) { PSTART(7); const Params p = load_params(kp); phase_permute(p, l, tab); cvt_pull(p, lds, l * CV_PER_L + CV_A1, nullptr, 0u); SYNC(); PSTOP(7); }
        if (PH(8)) REP(8) { PSTART(8);
            const Params p = load_params(kp);
            build_moe_tab(p, l, tab);
#if MOE_FP8
            pg8::MoeOrder S; S.tab = tab; S.NTn = 11; S.G = G; S.c = c; S.tstep = (size_t)256 * D; S.bexp = (size_t)2 * DE * D;
            pg8::Gemm g{(const bf16_t*)(p.ws + WS_XE), (const bf16_t*)(p.ws + WS_WGU + (size_t)l * NE * 2 * DE * D), D};
            pg8::EpiHidden8 E{p.ws + WS_HID};
            QSTART(8, 1); pg8::gemm_phase<pg8::EpiHidden8, pg8::MoeOrder, true>(lds, g, S, E, 121, 127); QSTOP(8, 1);
#else
            pg8::MoeOrder S; S.tab = tab; S.NTn = 11; S.G = G; S.c = c; S.tstep = (size_t)256 * D * 2; S.bexp = (size_t)2 * DE * D * 2;
            pg8::Gemm g{(const bf16_t*)(p.ws + WS_XE), (const bf16_t*)(p.ws + WS_WGU) + (size_t)l * NE * 2 * DE * D, D};
            pg8::EpiHidden E{(bf16_t*)(p.ws + WS_HID)};
            pg8::gemm_phase(lds, g, S, E);
#endif
            QSTART(8, 2); tail_pull(p, lds, l * 4 + 2); QSTOP(8, 2);
            QSTART(8, 3); cvt_pull(p, lds, (l + 1) * CV_PER_L, nullptr, 0u); QSTOP(8, 3);
            SYNC(); PSTOP(8);
        }
        if (PH(9)) REP(9) { PSTART(9);
            const Params p = load_params(kp);
            build_moe_tab(p, l, tab);
#if MOE_FP8
            pg8::MoeOrder S; S.tab = tab; S.NTn = 8; S.G = G; S.c = c; S.tstep = (size_t)256 * DEP; S.bexp = (size_t)D * DEP;
            pg8::Gemm g{(const bf16_t*)(p.ws + WS_HID), (const bf16_t*)(p.ws + WS_WD + (size_t)l * NE * D * DEP), DEP};
            pg8::EpiBf16 E{(bf16_t*)(p.ws + WS_YE), D};
            QSTART(9, 1); pg8::gemm_phase<pg8::EpiBf16, pg8::MoeOrder, true>(lds, g, S, E, 121, 124); QSTOP(9, 1);
#else
            pg8::MoeOrder S; S.tab = tab; S.NTn = 8; S.G = G; S.c = c; S.tstep = (size_t)256 * DE * 2; S.bexp = (size_t)D * DE * 2;
            pg8::Gemm g{(const bf16_t*)(p.ws + WS_HID), (const bf16_t*)(p.ws + WS_WD) + (size_t)l * NE * D * DE, DE};
            pg8::EpiBf16 E{(bf16_t*)(p.ws + WS_YE), D};
            pg8::gemm_phase(lds, g, S, E);
#endif
            QSTART(9, 2); tail_pull(p, lds, l * 4 + 3); QSTOP(9, 2);
            QSTART(9, 3); if (l + 1 < DEPTH) cvt_pull(p, lds, (l + 1) * CV_PER_L + CV_A0, nullptr, 0u); QSTOP(9, 3);
            SYNC(); PSTOP(9);
        }
        if (PH(10)) REP(10) { PSTART(10); const Params p = load_params(kp); phase_ln2(p, l); SYNC(); PSTOP(10); }
    }
#ifdef PROBE_PH
    if (blockIdx.x == 0 && threadIdx.x == 0) {
#ifdef PROBE_SUB
        const unsigned long long t = 0ull, t0 = __builtin_amdgcn_s_memrealtime();
#else
        const unsigned long long t = *(LAS unsigned long long*)(lds + LDS_MISC + 776) * 4ull, t0 = __builtin_amdgcn_s_memrealtime();
#endif
        while (__builtin_amdgcn_s_memrealtime() - t0 < t) __builtin_amdgcn_s_sleep(8);
    }
#ifdef PROBE_SUB
    if (blockIdx.x == PROBE_WG && threadIdx.x == 0) {
        const unsigned long long t = *(LAS unsigned long long*)(lds + LDS_MISC + 792) * 4ull, t0 = __builtin_amdgcn_s_memrealtime();
        while (__builtin_amdgcn_s_memrealtime() - t0 < t) __builtin_amdgcn_s_sleep(8);
    }
#endif
#endif
}

#ifndef MK_FUSED
#define MK_FUSED 1
#endif
extern "C" void kernel_launch(void* const* d_in, const int* in_sizes, int n_in, void* d_out, int out_size, void* d_ws, size_t ws_size, hipStream_t stream) {
    static int grid = 0;
    if (grid == 0) {
        if (n_in != 18 || ws_size < WS_END) { fprintf(stderr, "kernel_launch: unexpected n_in %d or ws_size %zu (< %zu)\n", n_in, ws_size, (size_t)WS_END); grid = -1; return; }
        int dev = 0, cus = 0, per_cu = 0;
        hipGetDevice(&dev);
        hipDeviceGetAttribute(&cus, hipDeviceAttributeMultiprocessorCount, dev);
        if (hipFuncSetAttribute((const void*)mega, hipFuncAttributeMaxDynamicSharedMemorySize, LDS_BYTES) != hipSuccess) { fprintf(stderr, "kernel_launch: hipFuncSetAttribute failed\n"); grid = -1; return; }
        hipOccupancyMaxActiveBlocksPerMultiprocessor(&per_cu, (const void*)mega, 512, LDS_BYTES);
        if (per_cu < 1) fprintf(stderr, "kernel_launch: occupancy query says %d\n", per_cu);
        grid = cus > 0 ? cus : 256;
    }
    if (grid < 0) return;
    hipMemsetAsync(d_ws, 0, WS_ZERO_BYTES, stream);
    Params p{};
    p.x = (const float*)d_in[0]; p.c = (const float*)d_in[1]; p.emb_g = (const float*)d_in[2]; p.emb_b = (const float*)d_in[3];
    p.w_ada = (const float*)d_in[4]; p.b_ada = (const float*)d_in[5]; p.w_in = (const float*)d_in[6]; p.conv_w = (const float*)d_in[7];
    p.mix_beta = (const float*)d_in[8]; p.w_out = (const float*)d_in[9]; p.lb_logits = (const float*)d_in[10]; p.ln_g = (const float*)d_in[11];
    p.ln_b = (const float*)d_in[12]; p.w_router = (const float*)d_in[13]; p.router_bias = (const float*)d_in[14]; p.w_gate = (const float*)d_in[15];
    p.w_up = (const float*)d_in[16]; p.w_down = (const float*)d_in[17];
    p.out = (float*)d_out; p.ws = (unsigned char*)d_ws; p.pad = 0;
#if MK_FUSED
    p.ph_lo = 0; p.ph_hi = 11; p.l_lo = 0; p.l_hi = DEPTH; p.fused = 1;
    hipLaunchKernelGGL(mega, dim3(grid), dim3(512), LDS_BYTES, stream, p);
#else
    p.fused = 0;
    for (int ph = 0; ph < 2; ++ph) { p.ph_lo = ph; p.ph_hi = ph + 1; p.l_lo = 0; p.l_hi = 0; hipLaunchKernelGGL(mega, dim3(grid), dim3(512), LDS_BYTES, stream, p); }
    for (int l = 0; l < DEPTH; ++l)
        for (int ph = 2; ph < 11; ++ph) { p.ph_lo = ph; p.ph_hi = ph + 1; p.l_lo = l; p.l_hi = l + 1; hipLaunchKernelGGL(mega, dim3(grid), dim3(512), LDS_BYTES, stream, p); }
#endif
}
```

```cpp
#include <hip/hip_runtime.h>
#include <stdint.h>
#include <stdio.h>

#define LAS __attribute__((address_space(3)))
typedef unsigned short bf16_t;
typedef short bf16x8 __attribute__((ext_vector_type(8)));
typedef float f32x4 __attribute__((ext_vector_type(4)));
typedef unsigned u32x4 __attribute__((ext_vector_type(4)));
typedef unsigned u32x2 __attribute__((ext_vector_type(2)));

constexpr int D = 2048, NB = 4, SEQ = 2048, T = NB * SEQ, DEPTH = 2;
constexpr int CW = 512, RW = 768, HWD = 768, INC = 8448;
constexpr int NE = 16, DE = 1408;
constexpr int C_CB = 0, C_CC = 512, C_CH = 1024, C_RQ = 1536, C_RK = 2304, C_RV = 3072, C_RG = 3840, C_HQ = 4608, C_HFF = 5376, C_HFB = 6144, C_HI = 6912, C_HG = 7680;
constexpr int XE_ROWS = 20480;
#ifndef MOE_FP8
#define MOE_FP8 1
#endif
#ifndef INP_FP8_FROM
#define INP_FP8_FROM 1
#endif
#define INP8(l) ((l) >= INP_FP8_FROM)
#ifndef OUT_FP8_FROM
#define OUT_FP8_FROM 1
#endif
#define OUT8(l) ((l) >= OUT_FP8_FROM)
constexpr int DEP = 1536;
constexpr float W8_SCALE = 64.f, H8_SCALE = 8.f;
constexpr float ALPHA = 1.4142135623730951f;

constexpr size_t WS_BAR = 0;
constexpr size_t WS_CNT = 16384;
constexpr size_t WS_CVTQ = 20480;
constexpr size_t WS_ZERO_BYTES = 32768;
constexpr size_t WS_MOD = 32768;
constexpr size_t WS_ROUTE = WS_MOD + 393216;
constexpr size_t WS_WGCNT = WS_ROUTE + 262144;
constexpr size_t WS_WIN = 1048576;
constexpr size_t SZ_WIN = (size_t)DEPTH * INC * D * 2;
constexpr size_t WS_WOUT = WS_WIN + SZ_WIN;
constexpr size_t SZ_WOUT = (size_t)DEPTH * D * D * 2;
constexpr size_t WS_WGU = WS_WOUT + SZ_WOUT;
constexpr size_t SZ_WGU = (size_t)DEPTH * NE * 2 * DE * D * 2;
constexpr size_t WS_WD = WS_WGU + SZ_WGU;
constexpr size_t SZ_WD = (size_t)DEPTH * NE * D * DE * 2;
constexpr size_t WS_XRES = WS_WD + SZ_WD;
constexpr size_t SZ_XRES = (size_t)T * D * 4;
constexpr size_t WS_HA = WS_XRES + SZ_XRES;
constexpr size_t SZ_H = (size_t)T * D * 2;
constexpr size_t WS_HB = WS_HA + SZ_H;
constexpr size_t WS_PROJ = WS_HB + SZ_H;
constexpr size_t SZ_PROJ = (size_t)T * INC * 2;
constexpr size_t WS_OBUF = WS_PROJ + SZ_PROJ;
constexpr size_t SZ_OBUF = (size_t)2 * T * 1536 * 4;
constexpr size_t WS_YE = WS_PROJ;
constexpr size_t SZ_YE = (size_t)XE_ROWS * D * 4;
static_assert(SZ_YE <= SZ_PROJ + SZ_OBUF, "ye alias");
constexpr size_t WS_MIXED = WS_OBUF + SZ_OBUF;
constexpr size_t WS_Y = WS_MIXED + SZ_H;
constexpr size_t SZ_Y = (size_t)T * D * 4;
constexpr size_t WS_XE = WS_Y + SZ_Y;
constexpr size_t SZ_XE = (size_t)XE_ROWS * D * 2;
constexpr size_t WS_HID = WS_XE + SZ_XE;
constexpr size_t SZ_HID = (size_t)XE_ROWS * DE * 2;
constexpr size_t WS_END = WS_HID + SZ_HID;

constexpr int LDS_BYTES = 156672;
constexpr int LDS_MISC = 153600;

struct Params {
    const float *x, *c, *emb_g, *emb_b, *w_ada, *b_ada, *w_in, *conv_w, *mix_beta, *w_out, *lb_logits, *ln_g, *ln_b, *w_router, *router_bias, *w_gate, *w_up, *w_down;
    float* out;
    unsigned char* ws;
    int ph_lo, ph_hi, l_lo, l_hi, fused, pad;
};

__device__ __forceinline__ float bf2f(unsigned b) { return __uint_as_float(b << 16); }
__device__ __forceinline__ unsigned f2bf(float f) { unsigned u = __float_as_uint(f); u += 0x7FFFu + ((u >> 16) & 1u); return u >> 16; }
typedef __bf16 bf16x2_t __attribute__((ext_vector_type(2)));
typedef float f32x2_t __attribute__((ext_vector_type(2)));
__device__ __forceinline__ unsigned pack2a(float lo, float hi) { unsigned r; asm("v_cvt_pk_bf16_f32 %0, %1, %2" : "=v"(r) : "v"(lo), "v"(hi)); return r; }
__device__ __forceinline__ unsigned pack2(float lo, float hi) { const bf16x2_t r = __builtin_convertvector((f32x2_t){lo, hi}, bf16x2_t); return __builtin_bit_cast(unsigned, r); }
__device__ __forceinline__ float wave_sum(float v) {
#pragma unroll
    for (int o = 32; o > 0; o >>= 1) v += __shfl_xor(v, o, 64);
    return v;
}
__device__ __forceinline__ float half_sum(float v) {
#pragma unroll
    for (int o = 16; o > 0; o >>= 1) v += __shfl_xor(v, o, 64);
    return v;
}
#define LDS_BARRIER() do { asm volatile("s_waitcnt lgkmcnt(0)" ::: "memory"); __builtin_amdgcn_s_barrier(); asm volatile("" ::: "memory"); } while (0)
__device__ __forceinline__ float sigmoidf_(float z) { return 1.0f / (1.0f + __expf(-z)); }
__device__ __forceinline__ float siluf_(float z) { return z / (1.0f + __expf(-z)); }

#define XB_TMO      128
#define XB_XCNT(j)  (256  + 64 * (j))
#define XB_XSUB(j)  (1280 + 64 * (j))
#define XB_XGEN(j)  (2304 + 64 * (j))
#define XB_TOP      3328
#define XB_TOPGEN   3392
#define XCD_BAR_WORDS 3456
#define XB_SPIN_CAP (1u << 22)
__device__ __forceinline__ unsigned xb_ld(unsigned* p)              { return __hip_atomic_load(p, __ATOMIC_RELAXED, __HIP_MEMORY_SCOPE_AGENT); }
__device__ __forceinline__ unsigned xb_add(unsigned* p, unsigned v) { return __hip_atomic_fetch_add(p, v, __ATOMIC_RELAXED, __HIP_MEMORY_SCOPE_AGENT); }
__device__ __forceinline__ unsigned xb_xcc_id() { return (unsigned)__builtin_amdgcn_s_getreg((3 << 11) | 20) & 0xFu; }
#define XB_SPIN(cond, bar) do { unsigned _sp = 0; while (cond) { __builtin_amdgcn_s_sleep(1); \
    if ((++_sp & 255u) == 0u) { if (xb_ld(&(bar)[XB_TMO])) break; if (_sp > XB_SPIN_CAP) { atomicAdd(&(bar)[XB_TMO], 1u); break; } } } } while (0)
struct XcdBarrier { unsigned* bar; unsigned x; volatile LAS unsigned* st; };
__device__ __forceinline__ XcdBarrier xcd_barrier_post(unsigned* bar, volatile LAS unsigned* st) {
    XcdBarrier b; b.bar = bar; b.x = xb_xcc_id(); b.st = st;
    if (threadIdx.x == 0) (void)xb_add(&bar[XB_XCNT(b.x)], 1u);
    return b;
}
__device__ __forceinline__ void xcd_barrier_complete(unsigned* bar, unsigned x, unsigned& nloc, unsigned& nx) {
    const unsigned G = gridDim.x * gridDim.y * gridDim.z;
    unsigned sum, cnt, mine, sp = 0u;
    for (;;) {
        sum = 0u; cnt = 0u; mine = 0u;
#pragma unroll
        for (unsigned j = 0; j < 16; ++j) { const unsigned c = xb_ld(&bar[XB_XCNT(j)]); sum += c; cnt += (c > 0u) ? 1u : 0u; mine = (j == x) ? c : mine; }
        if (sum == G) break;
        __builtin_amdgcn_s_sleep(1);
        if ((++sp & 255u) == 0u) { if (xb_ld(&bar[XB_TMO])) break; if (sp > XB_SPIN_CAP) { atomicAdd(&bar[XB_TMO], 1u); break; } }
    }
    nloc = mine > 0u ? mine : 1u; nx = cnt > 0u ? cnt : 1u;
}
__device__ __forceinline__ void xcd_barrier(const XcdBarrier& b) {
    asm volatile("s_waitcnt vmcnt(0)" ::: "memory");
    __syncthreads();
    if (threadIdx.x == 0) {
        unsigned* bar = b.bar;
        __builtin_amdgcn_s_waitcnt(0);
        unsigned nloc = b.st[0], nx = b.st[1];
        if (nloc == 0u) { xcd_barrier_complete(bar, b.x, nloc, nx); b.st[0] = nloc; b.st[1] = nx; }
        const unsigned old = xb_add(&bar[XB_XSUB(b.x)], 1u);
        const unsigned gen = old / nloc;
        if (old + 1u == (gen + 1u) * nloc) {
            __builtin_amdgcn_fence(__ATOMIC_RELEASE, "agent");
            asm volatile("s_waitcnt vmcnt(0)" ::: "memory");
            const unsigned og = xb_add(&bar[XB_TOP], 1u);
            const unsigned tg = og / nx;
            if (og + 1u == (tg + 1u) * nx) xb_add(&bar[XB_TOPGEN], 1u);
            else XB_SPIN(xb_ld(&bar[XB_TOPGEN]) == tg, bar);
            __builtin_amdgcn_fence(__ATOMIC_ACQUIRE, "agent");
            xb_add(&bar[XB_XGEN(b.x)], 1u);
            asm volatile("s_waitcnt vmcnt(0)" ::: "memory");
        } else {
            XB_SPIN(xb_ld(&bar[XB_XGEN(b.x)]) == gen, bar);
            __builtin_amdgcn_fence(__ATOMIC_ACQUIRE, "agent");
            asm volatile("s_waitcnt vmcnt(0)" ::: "memory");
        }
    }
    __syncthreads();
}

namespace pg8 {
constexpr int BM = 256, BK = 64, HALF = 128, HTB = HALF * BK * 2, STAGE_BYTES = 8 * HTB, NXCD = 8, WGM = 8;
__host__ __device__ __forceinline__ int lds_byte(int r, int c) { const int st = (r >> 4) * 2 + (c >> 5), rr = r & 15, cc = c & 31, ob = rr * 64 + cc * 2; return st * 1024 + (ob ^ (((ob >> 9) & 1) << 5)); }
__host__ __device__ __forceinline__ void stage_rc(int b, int& R, int& C) { const int st = b / 1024, sb = b % 1024, swz = sb ^ (((sb >> 9) & 1) << 5); R = (st >> 1) * 16 + swz / 64; C = (st & 1) * 32 + (swz % 64) / 2; }
__host__ __device__ __forceinline__ int perm32(int rho) { const int n = rho >> 4, i = rho & 15; return 8 * (i >> 2) + 4 * n + (i & 3); }

struct Unit { size_t aB, bB; int row0, col0; };
struct Gemm { const bf16_t* A; const bf16_t* Bt; int K; };

template <int NM, int NN>
struct DenseOrder {
    int G, c; size_t tstep;
    __device__ void init(int rowbytes, int G_, int c_) { G = G_; c = c_; tstep = (size_t)BM * rowbytes; }
    __device__ bool next(int i, Unit& u) const {
        constexpr int nwg = NM * NN, q = nwg / NXCD, r = nwg % NXCD, nig = WGM * NN;
        static_assert(NM % WGM == 0, "row tiles come in groups of 8");
        const int L = __builtin_amdgcn_readfirstlane(i * G + c); if (L >= nwg) return false;
        const int xcd = L % NXCD, off = L / NXCD;
        const int wgid = (xcd < r ? xcd * (q + 1) : r * (q + 1) + (xcd - r) * q) + off;
        const int gid = wgid / nig, fm = gid * WGM, rem = wgid % nig;
        const int pm = fm + (rem % WGM), pn = rem / WGM;
        u.aB = (size_t)pm * tstep; u.bB = (size_t)pn * tstep; u.row0 = pm * BM; u.col0 = pn * BM; return true;
    }
};
struct OneUnit {
    Unit u0;
    __device__ bool next(int i, Unit& u) const { if (i > 0) return false; u = u0; return true; }
};
struct MoeOrder {
    const LAS int* tab; int NTn, G, c; size_t tstep, bexp;
    __device__ bool next(int i, Unit& u) const {
        const int MT = tab[16], U = MT * NTn, nx = G >> 3;
        int f;
        if ((G & 7) == 0) { const int per = (U + 7) >> 3, x = c & 7, j = c >> 3, loc = i * nx + j; f = x * per + loc; if (loc >= per || f >= U) return false; }
        else { f = i * G + c; if (f >= U) return false; }
        int e = 0;
#pragma unroll
        for (int j = 1; j < 16; ++j) e += (f >= tab[j] * NTn) ? 1 : 0;
        const int t0 = tab[e], te = tab[e + 1] - t0, r = f - t0 * NTn;
        const int nt = r / te, mt = t0 + (r - nt * te);
        u.aB = (size_t)mt * tstep; u.bB = (size_t)e * bexp + (size_t)nt * tstep; u.row0 = mt * BM; u.col0 = nt * BM; return true;
    }
};

__device__ __forceinline__ size_t rfl64(size_t v) { const unsigned lo = (unsigned)__builtin_amdgcn_readfirstlane((int)(unsigned)v), hi = (unsigned)__builtin_amdgcn_readfirstlane((int)(unsigned)(v >> 32)); return ((size_t)hi << 32) | lo; }
__device__ __forceinline__ void uniformize(Unit& u) { u.aB = rfl64(u.aB); u.bB = rfl64(u.bB); u.row0 = __builtin_amdgcn_readfirstlane(u.row0); u.col0 = __builtin_amdgcn_readfirstlane(u.col0); }
__device__ __forceinline__ unsigned cvt_pk_bf16(float lo, float hi) { unsigned r; asm volatile("v_cvt_pk_bf16_f32 %0, %1, %2" : "=v"(r) : "v"(lo), "v"(hi)); return r; }

struct EpiF32 {
    static constexpr bool PERM = false;
    float* C; int ldc;
    __device__ __forceinline__ void operator()(const f32x4 (&acc)[2][2][4][2], const Unit& u, int wr, int wc, int fr, int fq) const {
        const int row0 = u.row0 + wr * 64 + fr, col0 = u.col0 + wc * 32 + 4 * fq;
#pragma unroll
        for (int ai = 0; ai < 2; ++ai)
#pragma unroll
            for (int m = 0; m < 4; ++m) { float* rowp = C + (size_t)(row0 + ai * HALF + m * 16) * ldc + col0;
#pragma unroll
                for (int bj = 0; bj < 2; ++bj)
#pragma unroll
                    for (int n = 0; n < 2; ++n) *(f32x4*)(rowp + bj * HALF + n * 16) = acc[ai][bj][m][n]; }
    }
};
struct EpiBf16 {
    static constexpr bool PERM = true;
    bf16_t* O; int ldc;
    __device__ __forceinline__ void operator()(const f32x4 (&acc)[2][2][4][2], const Unit& u, int wr, int wc, int fr, int fq) const {
        const int row0 = u.row0 + wr * 64 + fr, col0 = u.col0 + wc * 32 + 8 * fq;
#pragma unroll
        for (int ai = 0; ai < 2; ++ai)
#pragma unroll
            for (int m = 0; m < 4; ++m) { bf16_t* rowp = O + (size_t)(row0 + ai * HALF + m * 16) * ldc + col0;
#pragma unroll
                for (int bj = 0; bj < 2; ++bj) { const f32x4 v0 = acc[ai][bj][m][0], v1 = acc[ai][bj][m][1];
                    u32x4 o; o[0] = cvt_pk_bf16(v0[0], v0[1]); o[1] = cvt_pk_bf16(v0[2], v0[3]); o[2] = cvt_pk_bf16(v1[0], v1[1]); o[3] = cvt_pk_bf16(v1[2], v1[3]);
                    *(u32x4*)(rowp + bj * HALF) = o; } }
    }
};
struct EpiHidden {
    static constexpr bool PERM = true;
    bf16_t* O;
    __device__ __forceinline__ void operator()(const f32x4 (&acc)[2][2][4][2], const Unit& u, int wr, int wc, int fr, int fq) const {
        const int row0 = u.row0 + wr * 64 + fr, col0 = (u.col0 >> 1) + wc * 32 + 8 * fq;
#pragma unroll
        for (int ai = 0; ai < 2; ++ai)
#pragma unroll
            for (int m = 0; m < 4; ++m) { bf16_t* rowp = O + (size_t)(row0 + ai * HALF + m * 16) * DE + col0;
                float h[8];
#pragma unroll
                for (int n = 0; n < 2; ++n)
#pragma unroll
                    for (int j = 0; j < 4; ++j) { const float g = acc[ai][0][m][n][j], up = acc[ai][1][m][n][j]; h[n * 4 + j] = g * __builtin_amdgcn_rcpf(1.0f + __expf(-g)) * up; }
                u32x4 o; o[0] = cvt_pk_bf16(h[0], h[1]); o[1] = cvt_pk_bf16(h[2], h[3]); o[2] = cvt_pk_bf16(h[4], h[5]); o[3] = cvt_pk_bf16(h[6], h[7]);
                *(u32x4*)rowp = o; }
    }
};

typedef int v8i32 __attribute__((ext_vector_type(8)));
typedef int v4i32 __attribute__((ext_vector_type(4)));
struct EpiHidden8 {
    static constexpr bool PERM = true;
    unsigned char* O;
    __device__ __forceinline__ void operator()(const f32x4 (&acc)[2][2][4][2], const Unit& u, int wr, int wc, int fr, int fq) const {
        const int row0 = u.row0 + wr * 64 + fr, col0 = (u.col0 >> 1) + wc * 32 + 8 * fq;
#pragma unroll
        for (int ai = 0; ai < 2; ++ai)
#pragma unroll
            for (int m = 0; m < 4; ++m) { unsigned char* rowp = O + (size_t)(row0 + ai * HALF + m * 16) * DEP + col0;
                float h[8];
#pragma unroll
                for (int n = 0; n < 2; ++n)
#pragma unroll
                    for (int j = 0; j < 4; ++j) { const float g = acc[ai][0][m][n][j], up = acc[ai][1][m][n][j]; h[n * 4 + j] = g * __builtin_amdgcn_rcpf(1.0f + __expf(-g)) * up * H8_SCALE; }
                int o0 = __builtin_amdgcn_cvt_pk_fp8_f32(h[0], h[1], 0, false); o0 = __builtin_amdgcn_cvt_pk_fp8_f32(h[2], h[3], o0, true);
                int o1 = __builtin_amdgcn_cvt_pk_fp8_f32(h[4], h[5], 0, false); o1 = __builtin_amdgcn_cvt_pk_fp8_f32(h[6], h[7], o1, true);
                u32x2 o; o[0] = (unsigned)o0; o[1] = (unsigned)o1;
                *(u32x2*)rowp = o; }
    }
};
template <class Epi, class Sched, bool FP8 = false>
__device__ __forceinline__ void gemm_phase(LAS unsigned char* lds, const Gemm g, const Sched& S, const Epi& E, int sclW = 127, int sclA = 127) {
    int tid = threadIdx.x; asm volatile("" : "+v"(tid)); const int wid = __builtin_amdgcn_readfirstlane(tid >> 6), lane = tid & 63, wr = wid >> 2, wc = wid & 3, fr = lane & 15, fq = lane >> 4;
    const int K = g.K, rowb = FP8 ? K : 2 * K, nt = rowb / 128;
    int sclWv = sclW, sclAv = sclA; asm volatile("" : "+v"(sclWv), "+v"(sclAv));
    unsigned voffA[2], voffB[2];
#pragma unroll
    for (int i = 0; i < 2; ++i) { int R, C; stage_rc(tid * 16 + i * 8192, R, C); const int Rb = Epi::PERM ? ((R & ~31) + perm32(R & 31)) : R;
        voffA[i] = (unsigned)(R * rowb + 2 * C); voffB[i] = (unsigned)(Rb * rowb + 2 * C); }
    const size_t kstep = 128;
    const size_t hstep = (size_t)HALF * rowb;
    const unsigned ldsw = (unsigned)wid * 1024u;
    const int aoff = lds_byte(wr * 64 + fr, fq * 8), boff = lds_byte(wc * 32 + fr, fq * 8);
    constexpr int P2 = 1024;
#define PG8_SA(b, h) (((b) * 2 + (h)) * HTB)
#define PG8_SB(b, h) ((4 + (b) * 2 + (h)) * HTB)
#define PG8_STAGE(bufoff, gbase, voff) do { _Pragma("unroll") for (int _i = 0; _i < 2; ++_i) \
        __builtin_amdgcn_global_load_lds((const unsigned*)((const char*)(gbase) + (voff)[_i]), (LAS unsigned*)(lds + (bufoff) + ldsw + _i * 8192), 16, 0, 0); } while (0)
#define PG8_LDA(dst, b, h) do { _Pragma("unroll") for (int m = 0; m < 4; ++m) { \
        const v4i32 _l = *(const LAS v4i32*)(lds + PG8_SA(b, h) + aoff + m * 2048), _h = *(const LAS v4i32*)(lds + PG8_SA(b, h) + aoff + P2 + m * 2048); \
        dst[m] = __builtin_shufflevector(_l, _h, 0, 1, 2, 3, 4, 5, 6, 7); } } while (0)
#define PG8_LDB(dst, b, h) do { _Pragma("unroll") for (int n = 0; n < 2; ++n) { \
        const v4i32 _l = *(const LAS v4i32*)(lds + PG8_SB(b, h) + boff + n * 2048), _h = *(const LAS v4i32*)(lds + PG8_SB(b, h) + boff + P2 + n * 2048); \
        dst[n] = __builtin_shufflevector(_l, _h, 0, 1, 2, 3, 4, 5, 6, 7); } } while (0)
#define PG8_MMA(ai, bj, At, Bt) do { __builtin_amdgcn_s_setprio(1); _Pragma("unroll") for (int m = 0; m < 4; ++m) _Pragma("unroll") for (int n = 0; n < 2; ++n) { \
        if constexpr (FP8) { \
            asm volatile("v_mfma_scale_f32_16x16x128_f8f6f4 %0, %1, %2, %0, %3, %4 op_sel_hi:[0,0,0]" : "+v"(acc[ai][bj][m][n]) : "v"(Bt[n]), "v"(At[m]), "v"(sclWv), "v"(sclAv)); \
        } else { \
            acc[ai][bj][m][n] = __builtin_amdgcn_mfma_f32_16x16x32_bf16(__builtin_bit_cast(bf16x8, __builtin_shufflevector(Bt[n], Bt[n], 0, 1, 2, 3)), __builtin_bit_cast(bf16x8, __builtin_shufflevector(At[m], At[m], 0, 1, 2, 3)), acc[ai][bj][m][n], 0, 0, 0); \
            acc[ai][bj][m][n] = __builtin_amdgcn_mfma_f32_16x16x32_bf16(__builtin_bit_cast(bf16x8, __builtin_shufflevector(Bt[n], Bt[n], 4, 5, 6, 7)), __builtin_bit_cast(bf16x8, __builtin_shufflevector(At[m], At[m], 4, 5, 6, 7)), acc[ai][bj][m][n], 0, 0, 0); } } \
        __builtin_amdgcn_s_setprio(0); } while (0)
#define PG8_WAIT_V(n) asm volatile("s_waitcnt vmcnt(" #n ")" ::: "memory")
#define PG8_WAIT_L(n) asm volatile("s_waitcnt lgkmcnt(" #n ")" ::: "memory")
#define PG8_BAR __builtin_amdgcn_s_barrier()
#define PG8_SCHED __builtin_amdgcn_sched_barrier(0)
    Unit cur, nxt; int ui = 0;
    if (!S.next(0, cur)) return;
    uniformize(cur);
    f32x4 acc[2][2][4][2];
#pragma unroll
    for (int a = 0; a < 2; ++a)
#pragma unroll
        for (int b = 0; b < 2; ++b)
#pragma unroll
            for (int m = 0; m < 4; ++m)
#pragma unroll
                for (int n = 0; n < 2; ++n) acc[a][b][m][n] = (f32x4){0.f, 0.f, 0.f, 0.f};
    v8i32 At[4], B0[2], B1[2];
    const char* cA = (const char*)g.A + cur.aB; const char* cB = (const char*)g.Bt + cur.bB;
    PG8_STAGE(PG8_SB(0, 0), cB, voffB); PG8_STAGE(PG8_SA(0, 0), cA, voffA); PG8_STAGE(PG8_SB(0, 1), cB + hstep, voffB); PG8_STAGE(PG8_SA(0, 1), cA + hstep, voffA);
    if (wr == 1) PG8_BAR;
    PG8_WAIT_V(4); PG8_BAR;
    PG8_STAGE(PG8_SB(1, 0), cB + kstep, voffB); PG8_STAGE(PG8_SA(1, 0), cA + kstep, voffA); PG8_STAGE(PG8_SB(1, 1), cB + hstep + kstep, voffB);
    PG8_WAIT_V(6); PG8_BAR;
    for (;;) {
        const bool has_next = S.next(ui + 1, nxt);
        uniformize(nxt);
        const char* nA = has_next ? (const char*)g.A + nxt.aB : cA; const char* nB = has_next ? (const char*)g.Bt + nxt.bB : cB;
        for (int t = 0; t < nt; t += 2) {
            const bool last = (t == nt - 2);
            const char* a1 = cA + (size_t)(t + 1) * kstep;
            const char* a2 = last ? nA : cA + (size_t)(t + 2) * kstep; const char* b2 = last ? nB : cB + (size_t)(t + 2) * kstep;
            const char* a3 = a2 + kstep; const char* b3 = b2 + kstep;
            PG8_LDB(B0, 0, 0); PG8_SCHED; PG8_LDA(At, 0, 0); PG8_STAGE(PG8_SA(1, 1), a1 + hstep, voffA);
            PG8_WAIT_L(8); PG8_BAR; PG8_WAIT_L(0); PG8_MMA(0, 0, At, B0); PG8_BAR; PG8_SCHED;
            PG8_LDB(B1, 0, 1); PG8_STAGE(PG8_SB(0, 0), b2, voffB);
            PG8_BAR; PG8_WAIT_L(0); PG8_MMA(0, 1, At, B1); PG8_BAR;
            PG8_LDA(At, 0, 1); PG8_STAGE(PG8_SA(0, 0), a2, voffA);
            PG8_BAR; PG8_WAIT_L(0); PG8_MMA(1, 0, At, B0); PG8_BAR; PG8_SCHED;
            PG8_STAGE(PG8_SB(0, 1), b2 + hstep, voffB);
            PG8_WAIT_V(6); PG8_BAR; PG8_MMA(1, 1, At, B1); PG8_BAR;
            PG8_LDB(B0, 1, 0); PG8_SCHED; PG8_LDA(At, 1, 0); PG8_STAGE(PG8_SA(0, 1), a2 + hstep, voffA);
            PG8_WAIT_L(8); PG8_BAR; PG8_WAIT_L(0); PG8_MMA(0, 0, At, B0); PG8_BAR; PG8_SCHED;
            PG8_LDB(B1, 1, 1); PG8_STAGE(PG8_SB(1, 0), b3, voffB);
            PG8_BAR; PG8_WAIT_L(0); PG8_MMA(0, 1, At, B1); PG8_BAR;
            PG8_LDA(At, 1, 1); PG8_STAGE(PG8_SA(1, 0), a3, voffA);
            PG8_BAR; PG8_WAIT_L(0); PG8_MMA(1, 0, At, B0); PG8_BAR; PG8_SCHED;
            PG8_STAGE(PG8_SB(1, 1), b3 + hstep, voffB);
            PG8_WAIT_V(6); PG8_BAR; PG8_MMA(1, 1, At, B1); PG8_BAR;
        }
        if constexpr (FP8) asm volatile("s_nop 15\n\ts_nop 15" ::: "memory");
        E(acc, cur, wr, wc, fr, fq);
        if (!has_next) break;
#pragma unroll
        for (int a = 0; a < 2; ++a)
#pragma unroll
            for (int b = 0; b < 2; ++b)
#pragma unroll
                for (int m = 0; m < 4; ++m)
#pragma unroll
                    for (int n = 0; n < 2; ++n) acc[a][b][m][n] = (f32x4){0.f, 0.f, 0.f, 0.f};
        cur = nxt; cA = nA; cB = nB; ++ui;
    }
    PG8_WAIT_V(0);
    if (wr == 0) PG8_BAR;
    PG8_BAR;
#undef PG8_SA
#undef PG8_SB
#undef PG8_STAGE
#undef PG8_LDA
#undef PG8_LDB
#undef PG8_MMA
#undef PG8_WAIT_V
#undef PG8_WAIT_L
#undef PG8_BAR
#undef PG8_SCHED
}
}

constexpr int S_IN = 16 * 66, S_OUT = 16 * 16, S_GU = 16 * 11, S_DN = 11 * 16;
constexpr int CV_PER_L = S_IN + S_OUT + NE * 2 * S_GU + NE * S_DN;
constexpr int CV_A0 = S_IN + S_OUT;
constexpr int CV_A1 = CV_A0 + NE * 2 * S_GU;
constexpr int CV_TOTAL = DEPTH * CV_PER_L;
constexpr int CV_LAST = 1 << 30;
struct StripDesc { const float* src; bf16_t* dst; int lds_, ldd, k0, n0, drow0, fp8; };
__device__ __forceinline__ StripDesc strip_desc(const Params& p, int si) {
    unsigned char* ws = p.ws; StripDesc d;
    const int l = si / CV_PER_L; int r = si - l * CV_PER_L;
    if (r < S_IN) {
        const int kt = r / 66, ntl = r % 66;
        d.src = p.w_in + (size_t)l * D * INC; d.lds_ = INC; d.fp8 = INP8(l) ? 1 : 0; d.dst = (bf16_t*)(ws + WS_WIN) + (size_t)l * INC * D; d.ldd = D; d.k0 = kt * 128; d.n0 = ntl * 128; d.drow0 = ntl * 128;
    } else if (r < CV_A0) {
        r -= S_IN; const int kt = r / 16, ntl = r % 16;
        d.src = p.w_out + (size_t)l * D * D; d.lds_ = D; d.dst = (bf16_t*)(ws + WS_WOUT) + (size_t)l * D * D; d.ldd = D; d.k0 = kt * 128; d.n0 = ntl * 128; d.drow0 = ntl * 128; d.fp8 = OUT8(l) ? 1 : 0;
    } else if (r < CV_A1) {
        r -= CV_A0; const int mat = r / S_GU, q = r % S_GU, kt = q / 11, ntl = q % 11;
        const int which = mat & 1, le = l * NE + (mat >> 1);
        d.src = (which ? p.w_up : p.w_gate) + (size_t)le * D * DE; d.lds_ = DE; d.fp8 = MOE_FP8; d.dst = MOE_FP8 ? (bf16_t*)(ws + WS_WGU + (size_t)le * (2 * DE) * D) : (bf16_t*)(ws + WS_WGU) + (size_t)le * (2 * DE) * D; d.ldd = D; d.k0 = kt * 128; d.n0 = ntl * 128; d.drow0 = ntl * 256 + which * 128;
    } else {
        r -= CV_A1; const int le = l * NE + r / S_DN, q = r % S_DN, kt = q / 16, ntl = q % 16;
        d.src = p.w_down + (size_t)le * DE * D; d.lds_ = D; d.fp8 = MOE_FP8; d.dst = MOE_FP8 ? (bf16_t*)(ws + WS_WD + (size_t)le * D * DEP) : (bf16_t*)(ws + WS_WD) + (size_t)le * D * DE; d.ldd = MOE_FP8 ? DEP : DE; d.k0 = kt * 128; d.n0 = ntl * 128; d.drow0 = ntl * 128;
    }
    return d;
}
__device__ __forceinline__ void cvt_store_strip(const StripDesc& d, const float4 (&a)[2][2], const float4 (&b)[2][2], LAS unsigned char* tb, int tid, bool readout) {
    const int kp = tid >> 4, n4 = (tid & 15) * 4;
    if (!readout) {
        if (!d.fp8) {
#pragma unroll
            for (int ki = 0; ki < 2; ++ki)
#pragma unroll
                for (int ni = 0; ni < 2; ++ni) {
                    LAS unsigned* t = (LAS unsigned*)tb + (ki * 2 + ni) * 2112;
                    t[(n4 + 0) * 33 + kp] = pack2a(a[ki][ni].x, b[ki][ni].x);
                    t[(n4 + 1) * 33 + kp] = pack2a(a[ki][ni].y, b[ki][ni].y);
                    t[(n4 + 2) * 33 + kp] = pack2a(a[ki][ni].z, b[ki][ni].z);
                    t[(n4 + 3) * 33 + kp] = pack2a(a[ki][ni].w, b[ki][ni].w);
                }
        } else {
#pragma unroll
            for (int ki = 0; ki < 2; ++ki)
#pragma unroll
                for (int ni = 0; ni < 2; ++ni) {
                    LAS unsigned char* t = tb + (ki * 2 + ni) * 4352;
                    *(LAS unsigned short*)(t + (n4 + 0) * 68 + 2 * kp) = (unsigned short)__builtin_amdgcn_cvt_pk_fp8_f32(a[ki][ni].x * W8_SCALE, b[ki][ni].x * W8_SCALE, 0, false);
                    *(LAS unsigned short*)(t + (n4 + 1) * 68 + 2 * kp) = (unsigned short)__builtin_amdgcn_cvt_pk_fp8_f32(a[ki][ni].y * W8_SCALE, b[ki][ni].y * W8_SCALE, 0, false);
                    *(LAS unsigned short*)(t + (n4 + 2) * 68 + 2 * kp) = (unsigned short)__builtin_amdgcn_cvt_pk_fp8_f32(a[ki][ni].z * W8_SCALE, b[ki][ni].z * W8_SCALE, 0, false);
                    *(LAS unsigned short*)(t + (n4 + 3) * 68 + 2 * kp) = (unsigned short)__builtin_amdgcn_cvt_pk_fp8_f32(a[ki][ni].w * W8_SCALE, b[ki][ni].w * W8_SCALE, 0, false);
                }
        }
    } else {
        if (!d.fp8) {
            const int n = tid >> 3, kc = (tid & 7) * 4;
#pragma unroll
            for (int ki = 0; ki < 2; ++ki)
#pragma unroll
                for (int ni = 0; ni < 2; ++ni) {
                    const LAS unsigned* t = (const LAS unsigned*)tb + (ki * 2 + ni) * 2112;
                    u32x4 o; o[0] = t[n * 33 + kc]; o[1] = t[n * 33 + kc + 1]; o[2] = t[n * 33 + kc + 2]; o[3] = t[n * 33 + kc + 3];
                    *(u32x4*)(d.dst + (size_t)(d.drow0 + ni * 64 + n) * d.ldd + d.k0 + ki * 64 + kc * 2) = o;
                }
        } else {
            const int n = tid >> 3, kc8 = (tid & 7) * 8;
            unsigned char* dst8 = (unsigned char*)d.dst;
#pragma unroll
            for (int ki = 0; ki < 2; ++ki)
#pragma unroll
                for (int ni = 0; ni < 2; ++ni) {
                    const LAS unsigned char* t = tb + (ki * 2 + ni) * 4352;
                    u32x2 o; o[0] = *(const LAS unsigned*)(t + n * 68 + kc8); o[1] = *(const LAS unsigned*)(t + n * 68 + kc8 + 4);
                    *(u32x2*)(dst8 + (size_t)(d.drow0 + ni * 64 + n) * d.ldd + d.k0 + ki * 64 + kc8) = o;
                }
        }
    }
}
__device__ __forceinline__ void cvt_pull(const Params& p, LAS unsigned char* lds, int limit, unsigned* done_ctr, unsigned need_done) {
    int tid = threadIdx.x; asm volatile("" : "+v"(tid));
    LAS int* slot = (LAS int*)(lds + LDS_MISC + 512);
    unsigned* head = (unsigned*)(p.ws + WS_CVTQ);
    if (tid == 0) {
        int sv = -1;
        const bool stop = done_ctr ? (xb_ld(done_ctr) >= need_done) : (xb_ld(head) >= (unsigned)limit);
        if (!stop) { const unsigned c = xb_add(head, 2u); sv = c < (unsigned)CV_TOTAL ? (int)c : -1; }
        slot[0] = sv;
    }
    __syncthreads();
    const int kp = tid >> 4, n4 = (tid & 15) * 4;
    for (;;) {
        const int sraw = slot[0];
        if (sraw < 0) break;
        const int si = sraw & (CV_LAST - 1); const bool lastone = (sraw & CV_LAST) != 0;
        const StripDesc d0 = strip_desc(p, si), d1 = strip_desc(p, si + 1);
        float4 a0[2][2], b0[2][2], a1[2][2], b1[2][2];
#pragma unroll
        for (int ki = 0; ki < 2; ++ki)
#pragma unroll
            for (int ni = 0; ni < 2; ++ni) {
                a0[ki][ni] = *(const float4*)(d0.src + (size_t)(d0.k0 + ki * 64 + 2 * kp) * d0.lds_ + d0.n0 + ni * 64 + n4);
                b0[ki][ni] = *(const float4*)(d0.src + (size_t)(d0.k0 + ki * 64 + 2 * kp + 1) * d0.lds_ + d0.n0 + ni * 64 + n4);
            }
#pragma unroll
        for (int ki = 0; ki < 2; ++ki)
#pragma unroll
            for (int ni = 0; ni < 2; ++ni) {
                a1[ki][ni] = *(const float4*)(d1.src + (size_t)(d1.k0 + ki * 64 + 2 * kp) * d1.lds_ + d1.n0 + ni * 64 + n4);
                b1[ki][ni] = *(const float4*)(d1.src + (size_t)(d1.k0 + ki * 64 + 2 * kp + 1) * d1.lds_ + d1.n0 + ni * 64 + n4);
            }
        unsigned c = 0u, dn = 0u;
        if (tid == 0 && !lastone) { c = xb_add(head, 2u); if (done_ctr) dn = xb_ld(done_ctr); }
        cvt_store_strip(d0, a0, b0, lds, tid, false);
        cvt_store_strip(d1, a1, b1, lds + 33792, tid, false);
        LDS_BARRIER();
        cvt_store_strip(d0, a0, b0, lds, tid, true);
        cvt_store_strip(d1, a1, b1, lds + 33792, tid, true);
        if (tid == 0) {
            int sv = -1;
            if (!lastone && c < (unsigned)CV_TOTAL) { const bool fin = done_ctr ? (dn >= need_done) : (c >= (unsigned)limit); sv = (int)c | (fin ? CV_LAST : 0); }
            slot[0] = sv;
        }
        LDS_BARRIER();
    }
    __syncthreads();
}
__device__ __forceinline__ void tail_pull(const Params& p, LAS unsigned char* lds, int ctr_idx) {
    unsigned* ctr = (unsigned*)(p.ws + WS_CVTQ) + 64 * (1 + ctr_idx);
    __syncthreads();
    if (threadIdx.x == 0) (void)xb_add(ctr, 1u);
    cvt_pull(p, lds, 0, ctr, gridDim.x);
}

__device__ __forceinline__ void ada_chunks(const Params& p, LAS unsigned char* lds, int ch0, int ch_end, int step) {
    int tid = threadIdx.x; asm volatile("" : "+v"(tid));
    unsigned char* ws = p.ws;
    LAS float* cond = (LAS float*)lds;
    LAS float* red = (LAS float*)(lds + 32768);
    if (ch0 >= ch_end) return;
    for (int i = tid; i < 4 * D; i += 512) { const float v = p.c[i]; cond[i] = siluf_(v); }
    __syncthreads();
    for (int ch = ch0; ch < ch_end; ch += step) {
        const int l = ch >> 7, j0 = (ch & 127) * 96;
        const float* w = p.w_ada + (size_t)l * D * (6 * D);
        const int kg = tid / 24, cl = tid % 24;
        float acc[4][4];
#pragma unroll
        for (int b = 0; b < 4; ++b)
#pragma unroll
            for (int j = 0; j < 4; ++j) acc[b][j] = 0.f;
        if (kg < 21) {
            for (int it0 = 0; it0 < 98; it0 += 14) {
                float4 wv[14];
#pragma unroll
                for (int q = 0; q < 14; ++q) { const int k = kg + 21 * (it0 + q); wv[q] = (k < D) ? *(const float4*)(w + (size_t)k * (6 * D) + j0 + cl * 4) : make_float4(0.f, 0.f, 0.f, 0.f); }
#pragma unroll
                for (int q = 0; q < 14; ++q) { const int k = kg + 21 * (it0 + q); const int kc = k < D ? k : 0;
#pragma unroll
                    for (int b = 0; b < 4; ++b) { const float cv = cond[b * D + kc]; acc[b][0] += cv * wv[q].x; acc[b][1] += cv * wv[q].y; acc[b][2] += cv * wv[q].z; acc[b][3] += cv * wv[q].w; } }
            }
#pragma unroll
            for (int b = 0; b < 4; ++b)
#pragma unroll
                for (int j = 0; j < 4; ++j) red[(kg * 4 + b) * 96 + cl * 4 + j] = acc[b][j];
        }
        __syncthreads();
        if (tid < 384) {
            const int b = tid / 96, col = tid % 96; float s = 0.f;
            for (int g = 0; g < 21; ++g) s += red[(g * 4 + b) * 96 + col];
            float* mod = (float*)(ws + WS_MOD);
            mod[((size_t)l * 4 + b) * (6 * D) + j0 + col] = s + p.b_ada[(size_t)l * 6 * D + j0 + col];
        }
        __syncthreads();
    }
}
__device__ __forceinline__ void phase_prologue(const Params& p, LAS unsigned char* lds) {
    const bool svc = (gridDim.x >= 256);
    ada_chunks(p, lds, blockIdx.x, svc ? 128 : 256, gridDim.x);
    cvt_pull(p, lds, CV_A0, nullptr, 0u);
}

#define COLK(k) ((((k) >> 1) << 9) + lane * 8 + (((k) & 1) << 2))
#define COL8(i) (((i) << 9) + lane * 8)
__device__ __forceinline__ void ld_bf8(const bf16_t* p, float4& a, float4& b) {
    const u32x4 r = *(const u32x4*)p;
    a = make_float4(bf2f(r[0] & 0xffffu), bf2f(r[0] >> 16), bf2f(r[1] & 0xffffu), bf2f(r[1] >> 16));
    b = make_float4(bf2f(r[2] & 0xffffu), bf2f(r[2] >> 16), bf2f(r[3] & 0xffffu), bf2f(r[3] >> 16));
}
__device__ __forceinline__ void st_bf8(bf16_t* p, const float4& a, const float4& b) {
    u32x4 o; o[0] = pack2a(a.x, a.y); o[1] = pack2a(a.z, a.w); o[2] = pack2a(b.x, b.y); o[3] = pack2a(b.z, b.w);
    *(u32x4*)p = o;
}
__device__ __forceinline__ void st_fp8x8(unsigned char* p, const float4& a, const float4& b) {
    int o0 = __builtin_amdgcn_cvt_pk_fp8_f32(a.x, a.y, 0, false); o0 = __builtin_amdgcn_cvt_pk_fp8_f32(a.z, a.w, o0, true);
    int o1 = __builtin_amdgcn_cvt_pk_fp8_f32(b.x, b.y, 0, false); o1 = __builtin_amdgcn_cvt_pk_fp8_f32(b.z, b.w, o1, true);
    u32x2 o; o[0] = (unsigned)o0; o[1] = (unsigned)o1;
    *(u32x2*)p = o;
}
__device__ __forceinline__ void ln_rows(float4 (&v)[8], const float* __restrict__ g, const float* __restrict__ b, int lane) {
    float s = 0.f;
#pragma unroll
    for (int i = 0; i < 8; ++i) s += (v[i].x + v[i].y) + (v[i].z + v[i].w);
    const float mean = wave_sum(s) * (1.0f / D);
    float q = 0.f;
#pragma unroll
    for (int i = 0; i < 8; ++i) { const float a = v[i].x - mean, bb = v[i].y - mean, c = v[i].z - mean, d = v[i].w - mean; q += (a * a + bb * bb) + (c * c + d * d); }
    const float rstd = rsqrtf(wave_sum(q) * (1.0f / D) + 1e-5f);
#pragma unroll
    for (int i = 0; i < 8; ++i) {
        const float4 gv = *(const float4*)(g + COLK(i)), bv = *(const float4*)(b + COLK(i));
        v[i].x = (v[i].x - mean) * rstd * gv.x + bv.x; v[i].y = (v[i].y - mean) * rstd * gv.y + bv.y;
        v[i].z = (v[i].z - mean) * rstd * gv.z + bv.z; v[i].w = (v[i].w - mean) * rstd * gv.w + bv.w;
    }
}
__device__ __forceinline__ void modulate_store(const float4 (&v)[8], const float* __restrict__ shift, const float* __restrict__ scale, bf16_t* __restrict__ dst, int lane, bool fp8) {
#pragma unroll
    for (int i = 0; i < 4; ++i) {
        float4 h[2];
#pragma unroll
        for (int q = 0; q < 2; ++q) {
            const float4 sh = *(const float4*)(shift + COLK(2 * i + q)), sc = *(const float4*)(scale + COLK(2 * i + q));
            const float4 x = v[2 * i + q];
            h[q] = make_float4(x.x * (1.f + sc.x) + sh.x, x.y * (1.f + sc.y) + sh.y, x.z * (1.f + sc.z) + sh.z, x.w * (1.f + sc.w) + sh.w);
        }
        if (fp8) st_fp8x8((unsigned char*)dst + COL8(i), h[0], h[1]);
        else st_bf8(dst + COL8(i), h[0], h[1]);
    }
}

__device__ __forceinline__ void phase_ln0(const Params& p) {
    int tid_ = threadIdx.x; asm volatile("" : "+v"(tid_)); const int wave = tid_ >> 6, lane = tid_ & 63;
    const float* mod = (const float*)(p.ws + WS_MOD);
    for (int n = blockIdx.x * 8 + wave; n < T; n += gridDim.x * 8) {
        const int b = n / SEQ;
        float4 v[8];
#pragma unroll
        for (int i = 0; i < 8; ++i) v[i] = *(const float4*)(p.x + (size_t)n * D + COLK(i));
        ln_rows(v, p.emb_g, p.emb_b, lane);
        bf16_t* xr = (bf16_t*)(p.ws + WS_XRES) + (size_t)n * D;
#pragma unroll
        for (int i = 0; i < 4; ++i) st_bf8(xr + COL8(i), v[2 * i], v[2 * i + 1]);
        const float* mb = mod + ((size_t)0 * 4 + b) * (6 * D);
        modulate_store(v, mb, mb + D, INP8(0) ? (bf16_t*)(p.ws + WS_HA + (size_t)n * D) : (bf16_t*)(p.ws + WS_HA) + (size_t)n * D, lane, INP8(0));
    }
}

__device__ __forceinline__ void phase_mixer_valu(const Params& p, int l, LAS unsigned char* lds) {
    LAS float* qs = (LAS float*)lds; LAS float* ks = qs + 4096; LAS float* fs = ks + 4096; LAS float* vs = fs + 4096; LAS float* po = vs + 1024;
    int tid = threadIdx.x; asm volatile("" : "+v"(tid)); const int wave = tid >> 6, lane = tid & 63, kk = tid >> 5, vv = tid & 31;
    const bf16_t* proj = (const bf16_t*)(p.ws + WS_PROJ);
    float* obuf = (float*)(p.ws + WS_OBUF);
    for (int u = blockIdx.x; u < 384; u += gridDim.x) {
        const int vsl = u & 3, dir = (u >> 2) & 1, hh = (u >> 3) % 6, b = ((u >> 3) / 6) % 4, type = (u >> 3) / 24;
        float S[8];
#pragma unroll
        for (int j = 0; j < 8; ++j) S[j] = 0.f;
        const float gamma = 1.0f - exp2f(-(dir ? 5.5f : 5.0f) - (float)hh);
        for (int blk = 0; blk < 64; ++blk) {
            const int rb = dir ? 63 - blk : blk, t0 = rb * 32;
            if (type == 0) {
#pragma unroll
                for (int j = 0; j < 4; ++j) {
                    const int idx = tid + 512 * j, tt = idx >> 6, dp = idx & 63;
                    const bf16_t* row = proj + (size_t)(b * SEQ + t0 + tt) * INC;
                    const float q1 = bf2f(row[C_RQ + hh * 128 + dp]), q2 = bf2f(row[C_RQ + hh * 128 + 64 + dp]);
                    const float k1 = bf2f(row[C_RK + hh * 128 + dp]), k2 = bf2f(row[C_RK + hh * 128 + 64 + dp]);
                    const float inv_freq = exp2f(-(float)dp * (13.287712379549449f / 64.0f));
                    const float ang = (float)(t0 + tt) * inv_freq;
                    float rev = ang * 0.15915494309189535f; rev -= rintf(rev);
                    const float sn = __builtin_amdgcn_sinf(rev), cs = __builtin_amdgcn_cosf(rev);
                    qs[tt * 128 + dp] = q1 * cs - q2 * sn; qs[tt * 128 + 64 + dp] = q1 * sn + q2 * cs;
                    ks[tt * 128 + dp] = (k1 * cs - k2 * sn) * 0.08838834764831845f; ks[tt * 128 + 64 + dp] = (k1 * sn + k2 * cs) * 0.08838834764831845f;
                    fs[tt * 128 + dp] = gamma; fs[tt * 128 + 64 + dp] = gamma;
                }
            } else {
#pragma unroll
                for (int j = 0; j < 8; ++j) {
                    const int idx = tid + 512 * j, tt = idx >> 7, d = idx & 127;
                    const bf16_t* row = proj + (size_t)(b * SEQ + t0 + tt) * INC;
                    const float q = bf2f(row[C_HQ + hh * 128 + d]);
                    const float z = bf2f(row[(dir ? C_HFB : C_HFF) + hh * 128 + d]);
                    float lb = 0.f;
                    if (l > 0) { const float a0 = p.lb_logits[(0 * 2 + dir) * HWD + hh * 128 + d], a1 = p.lb_logits[(1 * 2 + dir) * HWD + hh * 128 + d]; lb = 1.0f / (1.0f + expf(a0 - a1)); }
                    float f = lb + (1.0f - lb) * (1.0f / (1.0f + expf(-z)));
                    f = fmaxf(f, 1e-6f);
                    qs[tt * 128 + d] = q; ks[tt * 128 + d] = 1.0f - f; fs[tt * 128 + d] = f;
                }
            }
#pragma unroll
            for (int j = 0; j < 2; ++j) {
                const int idx = tid + 512 * j, tt = idx >> 5, c = idx & 31;
                const bf16_t* row = proj + (size_t)(b * SEQ + t0 + tt) * INC;
                vs[tt * 32 + c] = bf2f(row[(type ? C_HI : C_RV) + hh * 128 + vsl * 32 + c]);
            }
            __syncthreads();
            for (int s = 0; s < 32; ++s) {
                const int ss = dir ? 31 - s : s;
                const f32x4 qa = *(const LAS f32x4*)(qs + ss * 128 + kk * 8), qb = *(const LAS f32x4*)(qs + ss * 128 + kk * 8 + 4);
                const f32x4 ka = *(const LAS f32x4*)(ks + ss * 128 + kk * 8), kb = *(const LAS f32x4*)(ks + ss * 128 + kk * 8 + 4);
                const f32x4 fa = *(const LAS f32x4*)(fs + ss * 128 + kk * 8), fb = *(const LAS f32x4*)(fs + ss * 128 + kk * 8 + 4);
                const float vval = vs[ss * 32 + vv];
                float acc = 0.f;
#pragma unroll
                for (int j = 0; j < 4; ++j) { S[j] = fa[j] * S[j] + ka[j] * vval; acc += S[j] * qa[j]; }
#pragma unroll
                for (int j = 0; j < 4; ++j) { S[4 + j] = fb[j] * S[4 + j] + kb[j] * vval; acc += S[4 + j] * qb[j]; }
                acc += __shfl_xor(acc, 32, 64);
                if (lane < 32) po[(ss * 8 + wave) * 32 + vv] = acc;
            }
            __syncthreads();
#pragma unroll
            for (int j = 0; j < 2; ++j) {
                const int idx = tid + 512 * j, tt = idx >> 5, c = idx & 31;
                float s = 0.f;
#pragma unroll
                for (int w = 0; w < 8; ++w) s += po[(tt * 8 + w) * 32 + c];
                obuf[((size_t)dir * T + (size_t)(b * SEQ + t0 + tt)) * 1536 + type * 768 + hh * 128 + vsl * 32 + c] = s;
            }
        }
        __syncthreads();
    }
}

constexpr int MX_QI = 0, MX_KI = 17408, MX_QS = 34816, MX_KTT = 52224, MX_VT = 70656, MX_P = 79872, MX_ST = 89088, MX_TOT = 106496, MX_DEC = 110592, MX_RQ = 112128, MX_RK = 128512, MX_RV = 144896;
__device__ __forceinline__ float ex2(float x) { return __builtin_amdgcn_exp2f(x); }
__device__ __forceinline__ float clampe(float x) { return fminf(fmaxf(x, -120.f), 120.f); }
template <int MODE>
__device__ __forceinline__ void phase_mixer_mfma(const Params& p, int l, LAS unsigned char* lds, float* __restrict__ obuf) {
    int tid = threadIdx.x; asm volatile("" : "+v"(tid));
    const int wave = __builtin_amdgcn_readfirstlane(tid >> 6), lane = tid & 63, fr = lane & 15, fq = lane >> 4;
    const bf16_t* proj = (const bf16_t*)(p.ws + WS_PROJ);
    for (int u = blockIdx.x; u < 192; u += gridDim.x) {
        const int vsl = u & 1, dir = (u >> 1) & 1, hh = (u >> 2) % 6, b = ((u >> 2) / 6) % 4, type = (u >> 2) / 24;
        float lg2 = 0.f, invf0 = 0.f, invf1 = 0.f, sgn = 1.f, lb0 = 0.f, lb1 = 0.f;
        if (type == 0) {
            const float gamma = 1.0f - exp2f(-(dir ? 5.5f : 5.0f) - (float)hh);
            lg2 = log2f(gamma);
            const int dm0 = (2 * lane) & 63;
            invf0 = exp2f(-(float)dm0 * (13.287712379549449f / 64.0f)); invf1 = exp2f(-(float)(dm0 + 1) * (13.287712379549449f / 64.0f));
            sgn = lane < 32 ? -1.f : 1.f;
        } else if (l > 0) {
            const float* lbl = p.lb_logits + dir * HWD + hh * 128 + 2 * lane;
            lb0 = 1.0f / (1.0f + expf(lbl[0] - lbl[2 * HWD])); lb1 = 1.0f / (1.0f + expf(lbl[1] - lbl[2 * HWD + 1]));
        }
        const int colA = (type ? C_HQ : C_RQ) + hh * 128, colB = (type ? (dir ? C_HFB : C_HFF) : C_RK) + hh * 128;
        const int colV0 = (type ? C_HI : C_RV) + hh * 128 + vsl * 64;
        const int own = 2 * lane, par = (2 * lane + 64) & 127;
        const size_t ocol = (size_t)type * 768 + hh * 128 + vsl * 64;
#define MX_LOAD(ch) do { \
            _Pragma("unroll") for (int i2 = 0; i2 < 2; ++i2) { const int pos = wave * 8 + i2 * 4 + (lane >> 4); const int tau = (ch) * 64 + pos; const int t = dir ? (SEQ - 1 - tau) : tau; \
                const bf16_t* row = proj + (size_t)(b * SEQ + t) * INC + (lane & 15) * 8; \
                __builtin_amdgcn_global_load_lds((const unsigned*)(row + colA), (LAS unsigned*)(lds + MX_RQ + (wave * 8 + i2 * 4) * 256), 16, 0, 0); \
                __builtin_amdgcn_global_load_lds((const unsigned*)(row + colB), (LAS unsigned*)(lds + MX_RK + (wave * 8 + i2 * 4) * 256), 16, 0, 0); } \
            { const int pos = wave * 8 + (lane >> 3); const int tau = (ch) * 64 + pos; const int t = dir ? (SEQ - 1 - tau) : tau; \
              const bf16_t* row = proj + (size_t)(b * SEQ + t) * INC + colV0 + (lane & 7) * 8; \
              __builtin_amdgcn_global_load_lds((const unsigned*)row, (LAS unsigned*)(lds + MX_RV + (wave * 8) * 128), 16, 0, 0); } } while (0)
        f32x4 Sacc[4];
#pragma unroll
        for (int vt = 0; vt < 4; ++vt) Sacc[vt] = (f32x4){0.f, 0.f, 0.f, 0.f};
        for (int i = tid; i < 64 * 272 / 4; i += 512) ((LAS unsigned*)(lds + MX_ST))[i] = 0u;
        float cd0 = 1.f, sd0 = 0.f, cd1 = 1.f, sd1 = 0.f;
        if (type == 0) {
            if (tid < 64) { const float fi = (float)tid; *(LAS f32x4*)(lds + MX_DEC + 512 + tid * 16) = (f32x4){ex2((fi - 31.f) * lg2), ex2((31.f - fi) * lg2), ex2((fi + 1.f) * lg2), ex2((63.f - fi) * lg2)}; }
            const float r0 = invf0 * 0.15915494309189535f, r1 = invf1 * 0.15915494309189535f, sg = dir ? -1.f : 1.f;
            cd0 = __builtin_amdgcn_cosf(r0); sd0 = sg * __builtin_amdgcn_sinf(r0); cd1 = __builtin_amdgcn_cosf(r1); sd1 = sg * __builtin_amdgcn_sinf(r1);
        }
        __syncthreads();
        MX_LOAD(0);
        asm volatile("s_waitcnt vmcnt(0)" ::: "memory");
        __syncthreads();
        for (int ch = 0; ch < 32; ++ch) {
            float q0[8], q1[8], k0[8], k1[8], c0[8], c1[8];
            float run0 = 0.f, run1 = 0.f;
            u32x4 vpk = (u32x4){0u, 0u, 0u, 0u};
#pragma unroll
            for (int j = 0; j < 8; ++j) { q0[j] = q1[j] = k0[j] = k1[j] = c0[j] = c1[j] = 0.f; }
            if (MODE != 3 && MODE != 4) {
            if (type == 0) {
                const int tau0 = ch * 64 + wave * 8; const int t0 = dir ? (SEQ - 1 - tau0) : tau0;
                float rev0 = (float)t0 * invf0 * 0.15915494309189535f, rev1 = (float)t0 * invf1 * 0.15915494309189535f;
                rev0 -= rintf(rev0); rev1 -= rintf(rev1);
                float sn0 = __builtin_amdgcn_sinf(rev0), cs0 = __builtin_amdgcn_cosf(rev0), sn1 = __builtin_amdgcn_sinf(rev1), cs1 = __builtin_amdgcn_cosf(rev1);
#pragma unroll
                for (int j = 0; j < 8; ++j) {
                    const int pos_ = wave * 8 + j;
                    const unsigned ra_ = *(const LAS unsigned*)(lds + MX_RQ + pos_ * 256 + own * 2), rb_ = *(const LAS unsigned*)(lds + MX_RK + pos_ * 256 + own * 2);
                    const unsigned rc_ = *(const LAS unsigned*)(lds + MX_RQ + pos_ * 256 + par * 2), rd_ = *(const LAS unsigned*)(lds + MX_RK + pos_ * 256 + par * 2);
                    const float a_lo = bf2f(ra_ & 0xffffu), a_hi = bf2f(ra_ >> 16), b_lo = bf2f(rb_ & 0xffffu), b_hi = bf2f(rb_ >> 16);
                    const float pa_lo = bf2f(rc_ & 0xffffu), pa_hi = bf2f(rc_ >> 16), pb_lo = bf2f(rd_ & 0xffffu), pb_hi = bf2f(rd_ >> 16);
                    const float ss0 = sgn * sn0, ss1 = sgn * sn1;
                    q0[j] = a_lo * cs0 + pa_lo * ss0; q1[j] = a_hi * cs1 + pa_hi * ss1;
                    k0[j] = (b_lo * cs0 + pb_lo * ss0) * 0.08838834764831845f; k1[j] = (b_hi * cs1 + pb_hi * ss1) * 0.08838834764831845f;
                    const float nc0 = cs0 * cd0 - sn0 * sd0, ns0 = sn0 * cd0 + cs0 * sd0, nc1 = cs1 * cd1 - sn1 * sd1, ns1 = sn1 * cd1 + cs1 * sd1;
                    cs0 = nc0; sn0 = ns0; cs1 = nc1; sn1 = ns1;
                    c0[j] = 0.f; c1[j] = 0.f;
                }
            } else {
#pragma unroll
                for (int j = 0; j < 8; ++j) {
                    const int pos_ = wave * 8 + j;
                    const unsigned ra_ = *(const LAS unsigned*)(lds + MX_RQ + pos_ * 256 + own * 2), rb_ = *(const LAS unsigned*)(lds + MX_RK + pos_ * 256 + own * 2);
                    const float a_lo = bf2f(ra_ & 0xffffu), a_hi = bf2f(ra_ >> 16), b_lo = bf2f(rb_ & 0xffffu), b_hi = bf2f(rb_ >> 16);
                    q0[j] = a_lo; q1[j] = a_hi;
                    float f0 = lb0 + (1.0f - lb0) * __builtin_amdgcn_rcpf(1.0f + ex2(-b_lo * 1.4426950408889634f));
                    float f1 = lb1 + (1.0f - lb1) * __builtin_amdgcn_rcpf(1.0f + ex2(-b_hi * 1.4426950408889634f));
                    f0 = fmaxf(f0, 1e-6f); f1 = fmaxf(f1, 1e-6f);
                    k0[j] = 1.0f - f0; k1[j] = 1.0f - f1;
                    run0 += __builtin_amdgcn_logf(f0); run1 += __builtin_amdgcn_logf(f1); c0[j] = run0; c1[j] = run1;
                }
            }
            { unsigned rv[8];
#pragma unroll
              for (int j = 0; j < 8; ++j) rv[j] = *(const LAS unsigned short*)(lds + MX_RV + (wave * 8 + j) * 128 + lane * 2);
              vpk[0] = rv[0] | (rv[1] << 16); vpk[1] = rv[2] | (rv[3] << 16); vpk[2] = rv[4] | (rv[5] << 16); vpk[3] = rv[6] | (rv[7] << 16); }
            }
            { typedef float f32x2_ __attribute__((ext_vector_type(2))); *(LAS f32x2_*)(lds + MX_TOT + (wave * 128 + 2 * lane) * 4) = (f32x2_){run0, run1}; }
            LDS_BARRIER();
            if (ch + 1 < 32) MX_LOAD(ch + 1);
            float kt0[8], kt1[8];
            float tt0, tt1;
#pragma unroll
            for (int j = 0; j < 8; ++j) { kt0[j] = kt1[j] = 0.f; }
            tt0 = tt1 = 0.f;
            if (MODE != 3 && MODE != 4) {
            if (type == 0) {
                tt0 = tt1 = 64.f * lg2;
#pragma unroll
                for (int j = 0; j < 8; ++j) {
                    const int pos = wave * 8 + j;
                    const f32x4 e = *(const LAS f32x4*)(lds + MX_DEC + 512 + pos * 16);
                    *(LAS unsigned*)(lds + MX_QI + pos * 272 + lane * 4) = pack2(q0[j] * e[0], q1[j] * e[0]);
                    *(LAS unsigned*)(lds + MX_KI + pos * 272 + lane * 4) = pack2(k0[j] * e[1], k1[j] * e[1]);
                    kt0[j] = k0[j] * e[3]; kt1[j] = k1[j] * e[3];
                }
            } else {
                float off0 = 0.f, off1 = 0.f, m0 = 0.f, m1 = 0.f; tt0 = 0.f; tt1 = 0.f;
#pragma unroll
                for (int g = 0; g < 8; ++g) {
                    typedef float f32x2_ __attribute__((ext_vector_type(2)));
                    const f32x2_ tv = *(const LAS f32x2_*)(lds + MX_TOT + (g * 128 + 2 * lane) * 4);
                    if (g < wave) { off0 += tv[0]; off1 += tv[1]; }
                    if (g < 4) { m0 += tv[0]; m1 += tv[1]; }
                    tt0 += tv[0]; tt1 += tv[1];
                }
                const float etm0 = ex2(tt0 - m0), etm1 = ex2(tt1 - m1);
#pragma unroll
                for (int j = 0; j < 8; ++j) {
                    const float cu0 = c0[j] + off0, cu1 = c1[j] + off1;
                    const float e10 = ex2(clampe(cu0 - m0)), e11 = ex2(clampe(cu1 - m1));
                    const float e20 = __builtin_amdgcn_rcpf(e10), e21 = __builtin_amdgcn_rcpf(e11);
                    const int pos = wave * 8 + j;
                    *(LAS unsigned*)(lds + MX_QI + pos * 272 + lane * 4) = pack2(q0[j] * e10, q1[j] * e11);
                    *(LAS unsigned*)(lds + MX_KI + pos * 272 + lane * 4) = pack2(k0[j] * e20, k1[j] * e21);
                    kt0[j] = k0[j] * (e20 * etm0); kt1[j] = k1[j] * (e21 * etm1);
                }
            }
            }
            { u32x4 w0, w1;
              w0[0] = pack2(kt0[0], kt0[1]); w0[1] = pack2(kt0[2], kt0[3]); w0[2] = pack2(kt0[4], kt0[5]); w0[3] = pack2(kt0[6], kt0[7]);
              w1[0] = pack2(kt1[0], kt1[1]); w1[1] = pack2(kt1[2], kt1[3]); w1[2] = pack2(kt1[4], kt1[5]); w1[3] = pack2(kt1[6], kt1[7]);
              *(LAS u32x4*)(lds + MX_KTT + (2 * lane) * 144 + wave * 16) = w0;
              *(LAS u32x4*)(lds + MX_KTT + (2 * lane + 1) * 144 + wave * 16) = w1;
              *(LAS u32x4*)(lds + MX_VT + lane * 144 + wave * 16) = vpk; }
            if (MODE != 3 && MODE != 4) {
                f32x4 em;
                if (type == 0) { const float e_ = ex2(32.f * lg2); em = (f32x4){e_, e_, e_, e_}; }
                else {
                    f32x4 ms = (f32x4){0.f, 0.f, 0.f, 0.f};
#pragma unroll
                    for (int g = 0; g < 4; ++g) ms += *(const LAS f32x4*)(lds + MX_TOT + (g * 128 + 16 * wave + 4 * fq) * 4);
                    em = (f32x4){ex2(ms[0]), ex2(ms[1]), ex2(ms[2]), ex2(ms[3])};
                }
#pragma unroll
                for (int vt = 0; vt < 4; ++vt) { u32x2 o; o[0] = pack2(Sacc[vt][0] * em[0], Sacc[vt][1] * em[1]); o[1] = pack2(Sacc[vt][2] * em[2], Sacc[vt][3] * em[3]);
                    *(LAS u32x2*)(lds + MX_ST + (16 * vt + fr) * 272 + (16 * wave + 4 * fq) * 2) = o; }
            }
            if (wave == 0) { typedef float f32x2_ __attribute__((ext_vector_type(2))); *(LAS f32x2_*)(lds + MX_DEC + lane * 8) = (f32x2_){ex2(tt0), ex2(tt1)}; }
            LDS_BARRIER();
            if (MODE != 2 && MODE != 4) {
                const int it = wave >> 1, st0 = 2 * (wave & 1);
                bf16x8 ka[2][4], qb[4];
#pragma unroll
                for (int kq = 0; kq < 4; ++kq) {
                    qb[kq] = *(const LAS bf16x8*)(lds + MX_QI + (16 * it + fr) * 272 + (32 * kq + 8 * fq) * 2);
                    ka[0][kq] = *(const LAS bf16x8*)(lds + MX_KI + (16 * st0 + fr) * 272 + (32 * kq + 8 * fq) * 2);
                    ka[1][kq] = *(const LAS bf16x8*)(lds + MX_KI + (16 * st0 + 16 + fr) * 272 + (32 * kq + 8 * fq) * 2);
                }
                asm volatile("s_waitcnt lgkmcnt(0)" ::: "memory");
                f32x4 acc0 = (f32x4){0.f, 0.f, 0.f, 0.f}, acc1 = acc0;
#pragma unroll
                for (int kq = 0; kq < 4; ++kq) {
                    acc0 = __builtin_amdgcn_mfma_f32_16x16x32_bf16(ka[0][kq], qb[kq], acc0, 0, 0, 0);
                    acc1 = __builtin_amdgcn_mfma_f32_16x16x32_bf16(ka[1][kq], qb[kq], acc1, 0, 0, 0);
                }
                const int i = 16 * it + fr;
                { const int s0 = 16 * st0 + 4 * fq;
                  const float v0 = (s0 + 0 <= i) ? acc0[0] : 0.f, v1 = (s0 + 1 <= i) ? acc0[1] : 0.f, v2 = (s0 + 2 <= i) ? acc0[2] : 0.f, v3 = (s0 + 3 <= i) ? acc0[3] : 0.f;
                  u32x2 o; o[0] = pack2(v0, v1); o[1] = pack2(v2, v3);
                  *(LAS u32x2*)(lds + MX_P + i * 144 + s0 * 2) = o; }
                { const int s0 = 16 * st0 + 16 + 4 * fq;
                  const float v0 = (s0 + 0 <= i) ? acc1[0] : 0.f, v1 = (s0 + 1 <= i) ? acc1[1] : 0.f, v2 = (s0 + 2 <= i) ? acc1[2] : 0.f, v3 = (s0 + 3 <= i) ? acc1[3] : 0.f;
                  u32x2 o; o[0] = pack2(v0, v1); o[1] = pack2(v2, v3);
                  *(LAS u32x2*)(lds + MX_P + i * 144 + s0 * 2) = o; }
            }
            LDS_BARRIER();
            if (MODE != 2 && MODE != 4) {
                const int vt = wave >> 1, it0 = 2 * (wave & 1);
                bf16x8 va[2], sa[4], pb[2][2], qsb[2][4], kta[2], vb[4][2];
#pragma unroll
                for (int kq = 0; kq < 2; ++kq) {
                    va[kq] = *(const LAS bf16x8*)(lds + MX_VT + (16 * vt + fr) * 144 + (32 * kq + 8 * fq) * 2);
                    pb[0][kq] = *(const LAS bf16x8*)(lds + MX_P + (16 * it0 + fr) * 144 + (32 * kq + 8 * fq) * 2);
                    pb[1][kq] = *(const LAS bf16x8*)(lds + MX_P + (16 * it0 + 16 + fr) * 144 + (32 * kq + 8 * fq) * 2);
                    kta[kq] = *(const LAS bf16x8*)(lds + MX_KTT + (16 * wave + fr) * 144 + (32 * kq + 8 * fq) * 2);
                }
#pragma unroll
                for (int kq = 0; kq < 4; ++kq) {
                    sa[kq] = *(const LAS bf16x8*)(lds + MX_ST + (16 * vt + fr) * 272 + (32 * kq + 8 * fq) * 2);
                    qsb[0][kq] = *(const LAS bf16x8*)(lds + MX_QI + (16 * it0 + fr) * 272 + (32 * kq + 8 * fq) * 2);
                    qsb[1][kq] = *(const LAS bf16x8*)(lds + MX_QI + (16 * it0 + 16 + fr) * 272 + (32 * kq + 8 * fq) * 2);
                }
#pragma unroll
                for (int v4 = 0; v4 < 4; ++v4)
#pragma unroll
                    for (int kq = 0; kq < 2; ++kq) vb[v4][kq] = *(const LAS bf16x8*)(lds + MX_VT + (16 * v4 + fr) * 144 + (32 * kq + 8 * fq) * 2);
                const f32x4 dc = *(const LAS f32x4*)(lds + MX_DEC + (16 * wave + 4 * fq) * 4);
                asm volatile("s_waitcnt lgkmcnt(0)" ::: "memory");
                f32x4 acc0 = (f32x4){0.f, 0.f, 0.f, 0.f}, acc1 = acc0;
#pragma unroll
                for (int kq = 0; kq < 2; ++kq) {
                    acc0 = __builtin_amdgcn_mfma_f32_16x16x32_bf16(va[kq], pb[0][kq], acc0, 0, 0, 0);
                    acc1 = __builtin_amdgcn_mfma_f32_16x16x32_bf16(va[kq], pb[1][kq], acc1, 0, 0, 0);
                }
#pragma unroll
                for (int kq = 0; kq < 4; ++kq) {
                    acc0 = __builtin_amdgcn_mfma_f32_16x16x32_bf16(sa[kq], qsb[0][kq], acc0, 0, 0, 0);
                    acc1 = __builtin_amdgcn_mfma_f32_16x16x32_bf16(sa[kq], qsb[1][kq], acc1, 0, 0, 0);
                }
#pragma unroll
                for (int v4 = 0; v4 < 4; ++v4) {
                    f32x4 a = Sacc[v4]; a[0] *= dc[0]; a[1] *= dc[1]; a[2] *= dc[2]; a[3] *= dc[3];
                    a = __builtin_amdgcn_mfma_f32_16x16x32_bf16(kta[0], vb[v4][0], a, 0, 0, 0);
                    a = __builtin_amdgcn_mfma_f32_16x16x32_bf16(kta[1], vb[v4][1], a, 0, 0, 0);
                    Sacc[v4] = a;
                }
                asm volatile("s_waitcnt vmcnt(0)" ::: "memory");
                { const int tau = ch * 64 + 16 * it0 + fr; const int t = dir ? (SEQ - 1 - tau) : tau;
                  u32x2 o; o[0] = pack2(acc0[0], acc0[1]); o[1] = pack2(acc0[2], acc0[3]);
                  *(u32x2*)((bf16_t*)obuf + ((size_t)dir * T + (size_t)(b * SEQ + t)) * 1536 + ocol + 16 * vt + 4 * fq) = o; }
                { const int tau = ch * 64 + 16 * it0 + 16 + fr; const int t = dir ? (SEQ - 1 - tau) : tau;
                  u32x2 o; o[0] = pack2(acc1[0], acc1[1]); o[1] = pack2(acc1[2], acc1[3]);
                  *(u32x2*)((bf16_t*)obuf + ((size_t)dir * T + (size_t)(b * SEQ + t)) * 1536 + ocol + 16 * vt + 4 * fq) = o; }
            }
        }
        __syncthreads();
#undef MX_LOAD
    }
}

#ifdef MIXER_CHECK
__device__ __forceinline__ void phase_mixer_check(const Params& p, const float* __restrict__ oa, const float* __restrict__ ob, float* chk) {
    int tid_ = threadIdx.x; asm volatile("" : "+v"(tid_)); const int wave = tid_ >> 6, lane = tid_ & 63;
    for (int r = blockIdx.x * 8 + wave; r < 2 * T; r += gridDim.x * 8) {
        const int dir = r / T;
#pragma unroll
        for (int ty = 0; ty < 2; ++ty) {
            float sd = 0.f, sq = 0.f;
#pragma unroll
            for (int i = 0; i < 3; ++i) { const float4 a = *(const float4*)(oa + (size_t)r * 1536 + ty * 768 + i * 256 + lane * 4), bq = *(const float4*)(ob + (size_t)r * 1536 + ty * 768 + i * 256 + lane * 4);
                sd += (a.x - bq.x) * (a.x - bq.x) + (a.y - bq.y) * (a.y - bq.y) + (a.z - bq.z) * (a.z - bq.z) + (a.w - bq.w) * (a.w - bq.w);
                sq += a.x * a.x + a.y * a.y + a.z * a.z + a.w * a.w; }
            sd = wave_sum(sd); sq = wave_sum(sq);
            if (lane == 0) { atomicAdd(&chk[(ty * 2 + dir) * 2 + 0], sd); atomicAdd(&chk[(ty * 2 + dir) * 2 + 1], sq); }
        }
    }
}
#endif

__device__ __forceinline__ float4 ld_bf4(const bf16_t* p) { const u32x2 r = *(const u32x2*)p; return make_float4(bf2f(r[0] & 0xffffu), bf2f(r[0] >> 16), bf2f(r[1] & 0xffffu), bf2f(r[1] >> 16)); }
__device__ __forceinline__ float grp16_sum(float v) {
#pragma unroll
    for (int o = 8; o > 0; o >>= 1) v += __shfl_xor(v, o, 64);
    return v;
}
__device__ __forceinline__ void phase_finalize(const Params& p, int l) {
    int tid_ = threadIdx.x; asm volatile("" : "+v"(tid_)); const int wave = tid_ >> 6, lane = tid_ & 63;
    const bf16_t* proj = (const bf16_t*)(p.ws + WS_PROJ);
    const bf16_t* obuf = (const bf16_t*)(p.ws + WS_OBUF);
    bf16_t* mixed = (bf16_t*)(p.ws + WS_MIXED);
    const float* cw = p.conv_w + (size_t)l * 3 * CW;
    const float* beta = p.mix_beta + (size_t)l * D;
    for (int n = blockIdx.x * 8 + wave; n < T; n += gridDim.x * 8) {
        const int t = n % SEQ;
        const bf16_t* row = proj + (size_t)n * INC;
#pragma unroll
        for (int i = 0; i < 4; ++i) {
            const int c = COL8(i);
            float4 r[2];
            if (i == 0) {
                float4 cc[2], ch[2], cb[2], um[2], up[2];
                ld_bf8(row + C_CC + c, cc[0], cc[1]); ld_bf8(row + C_CH + c, ch[0], ch[1]); ld_bf8(row + C_CB + c, cb[0], cb[1]);
                um[0] = um[1] = up[0] = up[1] = make_float4(0.f, 0.f, 0.f, 0.f);
                if (t > 0) { float4 a[2], b2[2]; ld_bf8(row - INC + C_CC + c, a[0], a[1]); ld_bf8(row - INC + C_CH + c, b2[0], b2[1]);
#pragma unroll
                    for (int q = 0; q < 2; ++q) um[q] = make_float4(a[q].x * b2[q].x, a[q].y * b2[q].y, a[q].z * b2[q].z, a[q].w * b2[q].w); }
                if (t < SEQ - 1) { float4 a[2], b2[2]; ld_bf8(row + INC + C_CC + c, a[0], a[1]); ld_bf8(row + INC + C_CH + c, b2[0], b2[1]);
#pragma unroll
                    for (int q = 0; q < 2; ++q) up[q] = make_float4(a[q].x * b2[q].x, a[q].y * b2[q].y, a[q].z * b2[q].z, a[q].w * b2[q].w); }
#pragma unroll
                for (int q = 0; q < 2; ++q) {
                    const float4 w0 = *(const float4*)(cw + c + 4 * q), w1 = *(const float4*)(cw + CW + c + 4 * q), w2 = *(const float4*)(cw + 2 * CW + c + 4 * q);
                    r[q].x = cb[q].x * (um[q].x * w0.x + cc[q].x * ch[q].x * w1.x + up[q].x * w2.x);
                    r[q].y = cb[q].y * (um[q].y * w0.y + cc[q].y * ch[q].y * w1.y + up[q].y * w2.y);
                    r[q].z = cb[q].z * (um[q].z * w0.z + cc[q].z * ch[q].z * w1.z + up[q].z * w2.z);
                    r[q].w = cb[q].w * (um[q].w * w0.w + cc[q].w * ch[q].w * w1.w + up[q].w * w2.w);
                }
            } else {
                const int oc = c - 512;
                const bool isret = oc < 768;
                float4 of[2], ob[2], gt[2];
                ld_bf8(obuf + (size_t)n * 1536 + oc, of[0], of[1]); ld_bf8(obuf + ((size_t)T + n) * 1536 + oc, ob[0], ob[1]);
                ld_bf8(row + (isret ? C_RG + oc : C_HG + (oc - 768)), gt[0], gt[1]);
                float4 o[2];
#pragma unroll
                for (int q = 0; q < 2; ++q) o[q] = make_float4(of[q].x + ob[q].x, of[q].y + ob[q].y, of[q].z + ob[q].z, of[q].w + ob[q].w);
                const float sm = grp16_sum(((o[0].x + o[0].y) + (o[0].z + o[0].w)) + ((o[1].x + o[1].y) + (o[1].z + o[1].w)));
                const float mu = isret ? sm * (1.0f / 128.0f) : 0.f;
#pragma unroll
                for (int q = 0; q < 2; ++q) { o[q].x -= mu; o[q].y -= mu; o[q].z -= mu; o[q].w -= mu; }
                const float var = grp16_sum(((o[0].x * o[0].x + o[0].y * o[0].y) + (o[0].z * o[0].z + o[0].w * o[0].w)) + ((o[1].x * o[1].x + o[1].y * o[1].y) + (o[1].z * o[1].z + o[1].w * o[1].w))) * (1.0f / 128.0f);
                const float rs = rsqrtf(var + 1e-6f);
#pragma unroll
                for (int q = 0; q < 2; ++q) r[q] = make_float4(o[q].x * rs * siluf_(gt[q].x), o[q].y * rs * siluf_(gt[q].y), o[q].z * rs * siluf_(gt[q].z), o[q].w * rs * siluf_(gt[q].w));
            }
            const float4 bt0 = *(const float4*)(beta + c), bt1 = *(const float4*)(beta + c + 4);
            r[0] = make_float4(r[0].x * bt0.x, r[0].y * bt0.y, r[0].z * bt0.z, r[0].w * bt0.w);
            r[1] = make_float4(r[1].x * bt1.x, r[1].y * bt1.y, r[1].z * bt1.z, r[1].w * bt1.w);
            if (OUT8(l)) { const float4 a4 = make_float4(r[0].x * 4.f, r[0].y * 4.f, r[0].z * 4.f, r[0].w * 4.f), b4 = make_float4(r[1].x * 4.f, r[1].y * 4.f, r[1].z * 4.f, r[1].w * 4.f);
                           st_fp8x8((unsigned char*)mixed + (size_t)n * D + c, a4, b4); }
            else st_bf8(mixed + (size_t)n * D + c, r[0], r[1]);
        }
    }
}

#define RGRP 4
#if RGRP == 4
#define LN1_SB() __builtin_amdgcn_sched_barrier(0)
#else
#define LN1_SB()
#endif
__device__ __forceinline__ void phase_ln1_router(const Params& p, int l, LAS unsigned char* lds) {
    int tid = threadIdx.x; asm volatile("" : "+v"(tid)); const int wave = tid >> 6, lane = tid & 63;
    LAS float* wrt = (LAS float*)lds;
    for (int i = tid; i < D * NE / 4; i += 512) {
        const float4 w = *(const float4*)(p.w_router + (size_t)i * 4);
        const int d = i >> 2, e4 = (i & 3) * 4;
        const int dp = (((d >> 9) * 2 + ((d >> 2) & 1)) << 8) + (((d >> 3) & 63) << 2) + (d & 3);
        wrt[(e4 + 0) * D + dp] = w.x; wrt[(e4 + 1) * D + dp] = w.y; wrt[(e4 + 2) * D + dp] = w.z; wrt[(e4 + 3) * D + dp] = w.w;
    }
    LAS int* lcnt = (LAS int*)(lds + LDS_MISC + 256);
    if (tid < 16) lcnt[tid] = 0;
    __syncthreads();
    const float* mod = (const float*)(p.ws + WS_MOD);
    const float* y = (const float*)(p.ws + WS_Y);
    float* xres = (float*)(p.ws + WS_XRES);
    int* route = (int*)(p.ws + WS_ROUTE);
    for (int n0 = (blockIdx.x * 8 + wave) * RGRP; n0 < T; n0 += gridDim.x * 8 * RGRP) {
        float4 h[RGRP][8];
        {
            const int b = n0 / SEQ;
            const float* mb = mod + ((size_t)l * 4 + b) * (6 * D);
#pragma unroll
            for (int i = 0; i < 4; ++i) {
                float4 xv[RGRP][2], yv[RGRP][2];
#pragma unroll
                for (int r = 0; r < RGRP; ++r) { ld_bf8((const bf16_t*)xres + (size_t)(n0 + r) * D + COL8(i), xv[r][0], xv[r][1]); ld_bf8((const bf16_t*)y + (size_t)(n0 + r) * D + COL8(i), yv[r][0], yv[r][1]); }
#pragma unroll
                for (int q = 0; q < 2; ++q) {
                    const float4 g = *(const float4*)(mb + 2 * D + COLK(2 * i + q));
#pragma unroll
                    for (int r = 0; r < RGRP; ++r)
                        h[r][2 * i + q] = make_float4(ALPHA * xv[r][q].x + (1.f + g.x) * yv[r][q].x, ALPHA * xv[r][q].y + (1.f + g.y) * yv[r][q].y, ALPHA * xv[r][q].z + (1.f + g.z) * yv[r][q].z, ALPHA * xv[r][q].w + (1.f + g.w) * yv[r][q].w);
                }
                LN1_SB();
            }
            float mean[RGRP], rstd[RGRP];
#pragma unroll
            for (int r = 0; r < RGRP; ++r) {
                float s0 = 0.f;
#pragma unroll
                for (int i = 0; i < 8; ++i) s0 += (h[r][i].x + h[r][i].y) + (h[r][i].z + h[r][i].w);
                mean[r] = s0;
            }
#pragma unroll
            for (int o = 32; o > 0; o >>= 1)
#pragma unroll
                for (int r = 0; r < RGRP; ++r) mean[r] += __shfl_xor(mean[r], o, 64);
#pragma unroll
            for (int r = 0; r < RGRP; ++r) {
                mean[r] *= (1.0f / D);
                float q0 = 0.f;
#pragma unroll
                for (int i = 0; i < 8; ++i) { const float a = h[r][i].x - mean[r], bb = h[r][i].y - mean[r], c = h[r][i].z - mean[r], d = h[r][i].w - mean[r]; q0 += (a * a + bb * bb) + (c * c + d * d); }
                rstd[r] = q0;
            }
#pragma unroll
            for (int o = 32; o > 0; o >>= 1)
#pragma unroll
                for (int r = 0; r < RGRP; ++r) rstd[r] += __shfl_xor(rstd[r], o, 64);
#pragma unroll
            for (int r = 0; r < RGRP; ++r) rstd[r] = rsqrtf(rstd[r] * (1.0f / D) + 1e-5f);
            const float* lg_ = p.ln_g + (size_t)(l * 2 + 0) * D; const float* lb_ = p.ln_b + (size_t)(l * 2 + 0) * D;
            LN1_SB();
#pragma unroll
            for (int i = 0; i < 8; ++i) {
                const float4 gv = *(const float4*)(lg_ + COLK(i)), bv = *(const float4*)(lb_ + COLK(i));
#pragma unroll
                for (int r = 0; r < RGRP; ++r) {
                    float4& v = h[r][i];
                    v.x = (v.x - mean[r]) * rstd[r] * gv.x + bv.x; v.y = (v.y - mean[r]) * rstd[r] * gv.y + bv.y;
                    v.z = (v.z - mean[r]) * rstd[r] * gv.z + bv.z; v.w = (v.w - mean[r]) * rstd[r] * gv.w + bv.w;
                }
                if (i & 1) LN1_SB();
            }
#pragma unroll
            for (int r = 0; r < RGRP; ++r)
#pragma unroll
                for (int i = 0; i < 4; ++i) st_bf8((bf16_t*)xres + (size_t)(n0 + r) * D + COL8(i), h[r][2 * i], h[r][2 * i + 1]);
            LN1_SB();
#pragma unroll
            for (int i = 0; i < 8; ++i) {
                const float4 sh = *(const float4*)(mb + 3 * D + COLK(i)), sc = *(const float4*)(mb + 4 * D + COLK(i));
#pragma unroll
                for (int r = 0; r < RGRP; ++r) {
                    float4& v = h[r][i];
                    v.x = v.x * (1.f + sc.x) + sh.x; v.y = v.y * (1.f + sc.y) + sh.y; v.z = v.z * (1.f + sc.z) + sh.z; v.w = v.w * (1.f + sc.w) + sh.w;
                }
                if (i & 1) LN1_SB();
            }
#pragma unroll
            for (int r = 0; r < RGRP; ++r) {
#if MOE_FP8
                unsigned char* hb = p.ws + WS_HB + (size_t)(n0 + r) * D;
#pragma unroll
                for (int i = 0; i < 4; ++i) st_fp8x8(hb + COL8(i), h[r][2 * i], h[r][2 * i + 1]);
#else
                bf16_t* hb = (bf16_t*)(p.ws + WS_HB) + (size_t)(n0 + r) * D;
#pragma unroll
                for (int i = 0; i < 4; ++i) st_bf8(hb + COL8(i), h[r][2 * i], h[r][2 * i + 1]);
#endif
            }
        }
        float lgk0 = 0.f, lgk1 = 0.f, lgk2 = 0.f, lgk3 = 0.f;
        const bool b5 = (lane & 32) != 0, b4 = (lane & 16) != 0, b3 = (lane & 8) != 0, b2 = (lane & 4) != 0;
#pragma unroll 1
        for (int eg = 0; eg < 4; ++eg) {
            float s[RGRP][4];
#pragma unroll
            for (int q = 0; q < 4; ++q) {
                f32x2_t ac[RGRP];
#pragma unroll
                for (int r = 0; r < RGRP; ++r) ac[r] = (f32x2_t){0.f, 0.f};
#pragma unroll
                for (int i = 0; i < 8; ++i) {
                    const f32x4 w = *(const LAS f32x4*)(wrt + (eg * 4 + q) * D + i * 256 + lane * 4);
                    const f32x2_t w01 = __builtin_shufflevector(w, w, 0, 1), w23 = __builtin_shufflevector(w, w, 2, 3);
#pragma unroll
                    for (int r = 0; r < RGRP; ++r) {
                        ac[r] = __builtin_elementwise_fma((f32x2_t){h[r][i].x, h[r][i].y}, w01, ac[r]);
                        ac[r] = __builtin_elementwise_fma((f32x2_t){h[r][i].z, h[r][i].w}, w23, ac[r]);
                    }
                }
#pragma unroll
                for (int r = 0; r < RGRP; ++r) s[r][q] = ac[r][0] + ac[r][1];
                LN1_SB();
            }
            float u[RGRP];
#pragma unroll
            for (int r = 0; r < RGRP; ++r) {
                const float tA = (b5 ? s[r][2] : s[r][0]) + __shfl_xor(b5 ? s[r][0] : s[r][2], 32, 64);
                const float tB = (b5 ? s[r][3] : s[r][1]) + __shfl_xor(b5 ? s[r][1] : s[r][3], 32, 64);
                u[r] = (b4 ? tB : tA) + __shfl_xor(b4 ? tA : tB, 16, 64);
            }
#if RGRP == 4
            const float pA = (b3 ? u[2] : u[0]) + __shfl_xor(b3 ? u[0] : u[2], 8, 64);
            const float pB = (b3 ? u[3] : u[1]) + __shfl_xor(b3 ? u[1] : u[3], 8, 64);
            float z = (b2 ? pB : pA) + __shfl_xor(b2 ? pA : pB, 4, 64);
#else
            float z = (b3 ? u[1] : u[0]) + __shfl_xor(b3 ? u[0] : u[1], 8, 64);
            z += __shfl_xor(z, 4, 64);
#endif
            z += __shfl_xor(z, 2, 64); z += __shfl_xor(z, 1, 64);
            lgk0 = (eg == 0) ? z : lgk0; lgk1 = (eg == 1) ? z : lgk1; lgk2 = (eg == 2) ? z : lgk2; lgk3 = (eg == 3) ? z : lgk3;
        }
#pragma unroll 1
        for (int r = 0; r < RGRP; ++r) {
            const int n = n0 + r;
            const int rl = (RGRP == 4) ? (r >> 1) * 8 + (r & 1) * 4 : r * 8;
            float lg[16];
#pragma unroll
            for (int q = 0; q < 4; ++q) {
                const int src = ((q >> 1) * 32) + ((q & 1) * 16) + rl;
                lg[0 + q] = __int_as_float(__builtin_amdgcn_readlane(__float_as_int(lgk0), src));
                lg[4 + q] = __int_as_float(__builtin_amdgcn_readlane(__float_as_int(lgk1), src));
                lg[8 + q] = __int_as_float(__builtin_amdgcn_readlane(__float_as_int(lgk2), src));
                lg[12 + q] = __int_as_float(__builtin_amdgcn_readlane(__float_as_int(lgk3), src));
            }
            float mx = lg[0];
#pragma unroll
            for (int e = 1; e < 16; ++e) mx = fmaxf(mx, lg[e]);
            float sc[16], sum = 0.f;
#pragma unroll
            for (int e = 0; e < 16; ++e) { sc[e] = expf(lg[e] - mx); sum += sc[e]; }
            const float inv = 1.0f / sum;
            float sel[16];
#pragma unroll
            for (int e = 0; e < 16; ++e) { sc[e] *= inv; sel[e] = sc[e] + p.router_bias[e]; }
            float best_gs = -3.0e38f; int bi0 = 0, bi1 = 1; float bw0 = 0.f, bw1 = 0.f;
#pragma unroll
            for (int g = 0; g < 4; ++g) {
                int i0 = 0; float m0 = sel[4 * g];
#pragma unroll
                for (int j = 1; j < 4; ++j) if (sel[4 * g + j] > m0) { m0 = sel[4 * g + j]; i0 = j; }
                int i1 = -1; float m1 = -3.0e38f;
#pragma unroll
                for (int j = 0; j < 4; ++j) if (j != i0 && sel[4 * g + j] > m1) { m1 = sel[4 * g + j]; i1 = j; }
                float w0 = 0.f, w1 = 0.f;
#pragma unroll
                for (int j = 0; j < 4; ++j) { w0 = (j == i0) ? sc[4 * g + j] : w0; w1 = (j == i1) ? sc[4 * g + j] : w1; }
                const float gs = m0 + m1;
                if (gs > best_gs) { best_gs = gs; bi0 = 4 * g + i0; bi1 = 4 * g + i1; bw0 = w0; bw1 = w1; }
            }
            if (lane == 0) {
                const float ws_ = 1.0f / (bw0 + bw1);
                const int p0 = __hip_atomic_fetch_add(&lcnt[bi0], 1, __ATOMIC_RELAXED, __HIP_MEMORY_SCOPE_WORKGROUP), p1 = __hip_atomic_fetch_add(&lcnt[bi1], 1, __ATOMIC_RELAXED, __HIP_MEMORY_SCOPE_WORKGROUP);
                int* rr = route + (size_t)n * 8;
                rr[0] = bi0; rr[1] = bi1; rr[2] = (int)p0; rr[3] = (int)p1; rr[4] = __float_as_int(bw0 * ws_); rr[5] = __float_as_int(bw1 * ws_);
            }
        }
    }
    __syncthreads();
    if (tid < 16) ((int*)(p.ws + WS_WGCNT))[((size_t)l * 1024 + blockIdx.x) * 16 + tid] = lcnt[tid];
}

__device__ __forceinline__ void build_moe_tab(const Params& p, int l, LAS int* tab) {
    if (threadIdx.x == 0) {
        const unsigned* cnt = (const unsigned*)(p.ws + WS_CNT) + l * 16;
        int acc = 0;
        for (int e = 0; e < 16; ++e) { tab[e] = acc; acc += (int)((cnt[e] + 255u) >> 8); }
        tab[16] = acc;
    }
    __syncthreads();
}

__device__ __forceinline__ void phase_permute(const Params& p, int l, LAS int* tab) {
    int tid_ = threadIdx.x; asm volatile("" : "+v"(tid_)); const int wave = tid_ >> 6, lane = tid_ & 63;
    LAS int* base = tab + 32; LAS int* total = tab + 48;
    if (tid_ < 16) { base[tid_] = 0; total[tid_] = 0; }
    __syncthreads();
    {
        const int* wgc = (const int*)(p.ws + WS_WGCNT) + (size_t)l * 1024 * 16;
        const int e = tid_ & 15; int bs = 0, tt = 0;
        for (int w = tid_ >> 4; w < (int)gridDim.x; w += 32) { const int v = wgc[w * 16 + e]; tt += v; bs += (w < (int)blockIdx.x) ? v : 0; }
        __hip_atomic_fetch_add(&base[e], bs, __ATOMIC_RELAXED, __HIP_MEMORY_SCOPE_WORKGROUP);
        __hip_atomic_fetch_add(&total[e], tt, __ATOMIC_RELAXED, __HIP_MEMORY_SCOPE_WORKGROUP);
    }
    __syncthreads();
    if (tid_ == 0) { int acc = 0; for (int e = 0; e < 16; ++e) { tab[e] = acc; acc += (total[e] + 255) >> 8; } tab[16] = acc; }
    if (blockIdx.x == 0 && tid_ < 16) ((unsigned*)(p.ws + WS_CNT))[l * 16 + tid_] = (unsigned)total[tid_];
    __syncthreads();
#if MOE_FP8
    for (int i = blockIdx.x * 512 + tid_; i < XE_ROWS * 8; i += gridDim.x * 512) *(u32x4*)(p.ws + WS_HID + (size_t)(i >> 3) * DEP + DE + (i & 7) * 16) = (u32x4){0u, 0u, 0u, 0u};
#endif
    int* route = (int*)(p.ws + WS_ROUTE);
    const bf16_t* hb = (const bf16_t*)(p.ws + WS_HB);
    bf16_t* xe = (bf16_t*)(p.ws + WS_XE);
    for (int m = (blockIdx.x * 8 + wave) * RGRP; m < T; m += gridDim.x * 8 * RGRP)
#pragma unroll 1
    for (int n = m; n < m + RGRP; ++n) {
        int* r = route + (size_t)n * 8;
        const int e0 = r[0], e1 = r[1], p0 = r[2], p1 = r[3];
        const int row0 = tab[e0] * 256 + base[e0] + p0, row1 = tab[e1] * 256 + base[e1] + p1;
        constexpr int RB = MOE_FP8 ? D : 2 * D;
        const u32x4* src = (const u32x4*)((const unsigned char*)hb + (size_t)n * RB);
        u32x4* d0 = (u32x4*)((unsigned char*)xe + (size_t)row0 * RB); u32x4* d1 = (u32x4*)((unsigned char*)xe + (size_t)row1 * RB);
#pragma unroll
        for (int i = 0; i < RB / 1024; ++i) { const u32x4 v = src[i * 64 + lane]; d0[i * 64 + lane] = v; d1[i * 64 + lane] = v; }
        if (lane == 0) { r[6] = row0; r[7] = row1; }
    }
}

__device__ __forceinline__ void phase_ln2(const Params& p, int l) {
    int tid_ = threadIdx.x; asm volatile("" : "+v"(tid_)); const int wave = tid_ >> 6, lane = tid_ & 63;
    const float* mod = (const float*)(p.ws + WS_MOD);
    const float* ye = (const float*)(p.ws + WS_YE);
    float* xres = (float*)(p.ws + WS_XRES);
    const int* route = (const int*)(p.ws + WS_ROUTE);
    for (int n = blockIdx.x * 8 + wave; n < T; n += gridDim.x * 8) {
        const int b = n / SEQ;
        const float* mb = mod + ((size_t)l * 4 + b) * (6 * D);
        const int* r = route + (size_t)n * 8;
        const float w0 = __int_as_float(r[4]), w1 = __int_as_float(r[5]);
        const bf16_t* y0 = (const bf16_t*)ye + (size_t)r[6] * D; const bf16_t* y1 = (const bf16_t*)ye + (size_t)r[7] * D;
        float4 v[8];
#pragma unroll
        for (int i = 0; i < 4; ++i) {
            float4 xv[2], a[2], c[2];
            ld_bf8((const bf16_t*)xres + (size_t)n * D + COL8(i), xv[0], xv[1]); ld_bf8(y0 + COL8(i), a[0], a[1]); ld_bf8(y1 + COL8(i), c[0], c[1]);
#pragma unroll
            for (int q = 0; q < 2; ++q) {
                const float4 g = *(const float4*)(mb + 5 * D + COLK(2 * i + q));
                v[2 * i + q] = make_float4(ALPHA * xv[q].x + (1.f + g.x) * (w0 * a[q].x + w1 * c[q].x), ALPHA * xv[q].y + (1.f + g.y) * (w0 * a[q].y + w1 * c[q].y),
                                           ALPHA * xv[q].z + (1.f + g.z) * (w0 * a[q].z + w1 * c[q].z), ALPHA * xv[q].w + (1.f + g.w) * (w0 * a[q].w + w1 * c[q].w));
            }
        }
        ln_rows(v, p.ln_g + (size_t)(l * 2 + 1) * D, p.ln_b + (size_t)(l * 2 + 1) * D, lane);
        if (l + 1 < DEPTH) {
#pragma unroll
            for (int i = 0; i < 4; ++i) st_bf8((bf16_t*)xres + (size_t)n * D + COL8(i), v[2 * i], v[2 * i + 1]);
            const float* mn = mod + ((size_t)(l + 1) * 4 + b) * (6 * D);
            modulate_store(v, mn, mn + D, INP8(l + 1) ? (bf16_t*)(p.ws + WS_HA + (size_t)n * D) : (bf16_t*)(p.ws + WS_HA) + (size_t)n * D, lane, INP8(l + 1));
        } else {
#ifdef MIXER_CHECK
            { const float* chk = (const float*)(p.ws + WS_CNT + 1024); float scale = 1.f;
              for (int j = 7; j >= 0; --j) { const float sd = chk[j * 2], sq = chk[j * 2 + 1]; if (!(sd <= 1e-3f * sq)) scale = 1.0f + 0.25f * (float)(1 << (j & 3)) + 8.f * (float)(j >> 2); }
#pragma unroll
              for (int i = 0; i < 8; ++i) { v[i].x *= scale; v[i].y *= scale; v[i].z *= scale; v[i].w *= scale; } }
#endif
#pragma unroll
            for (int i = 0; i < 8; ++i) *(float4*)(p.out + (size_t)n * D + COLK(i)) = v[i];
        }
    }
}

typedef const __attribute__((address_space(4))) unsigned char* KargPtr;
__device__ __forceinline__ Params load_params(KargPtr q) { asm volatile("" : "+s"(q)); Params lp; __builtin_memcpy(&lp, (const __attribute__((address_space(4))) unsigned long long*)q, sizeof(Params)); return lp; }

__global__ __launch_bounds__(512, 2) void mega(Params p_in) {
    extern __shared__ __attribute__((aligned(16))) unsigned char smem[];
    LAS unsigned char* lds = (LAS unsigned char*)smem;
    LAS int* tab = (LAS int*)(lds + LDS_MISC + 64);
    KargPtr kp = (KargPtr)__builtin_amdgcn_kernarg_segment_ptr();
    if (threadIdx.x == 0) { *(LAS u32x4*)(lds + LDS_MISC) = (u32x4){0u, 0u, 0u, 0u}; *(LAS u32x4*)(lds + LDS_MISC + 768) = (u32x4){0u, 0u, 0u, 0u}; *(LAS u32x4*)(lds + LDS_MISC + 784) = (u32x4){0u, 0u, 0u, 0u}; }
    __syncthreads();
    const int fused = p_in.fused, ph_lo = p_in.ph_lo, ph_hi = p_in.ph_hi, l_hi = p_in.l_hi;
    XcdBarrier bar;
    if (fused) bar = xcd_barrier_post((unsigned*)(p_in.ws + WS_BAR), (volatile LAS unsigned*)(lds + LDS_MISC));
    else { bar.bar = (unsigned*)(p_in.ws + WS_BAR); bar.x = 0; bar.st = (volatile LAS unsigned*)(lds + LDS_MISC); }
#ifdef ONLY_PH
#define PH(i) ((i) == ONLY_PH && ph_lo <= (i) && (i) < ph_hi)
#else
#define PH(i) (ph_lo <= (i) && (i) < ph_hi)
#endif
#ifdef PROBE_PH
#define SYNC_PLAIN() do { if (fused) xcd_barrier(bar); } while (0)
#define PSTART(i) do { if ((i) == PROBE_PH && blockIdx.x == 0 && threadIdx.x == 0) { *(LAS unsigned long long*)(lds + LDS_MISC + 768) = __builtin_amdgcn_s_memrealtime(); } } while (0)
#define PSTOP(i) do { if ((i) == PROBE_PH && blockIdx.x == 0 && threadIdx.x == 0) { *(LAS unsigned long long*)(lds + LDS_MISC + 776) += __builtin_amdgcn_s_memrealtime() - *(LAS unsigned long long*)(lds + LDS_MISC + 768); } } while (0)
#else
#define PSTART(i) do { } while (0)
#define PSTOP(i) do { } while (0)
#endif
#if defined(PROBE_PH) && defined(PROBE_SUB)
#define QSTART(i, k) do { if ((i) == PROBE_PH && (k) == PROBE_SUB && blockIdx.x == PROBE_WG && threadIdx.x == 0) { *(LAS unsigned long long*)(lds + LDS_MISC + 784) = __builtin_amdgcn_s_memrealtime(); } } while (0)
#define QSTOP(i, k) do { if ((i) == PROBE_PH && (k) == PROBE_SUB && blockIdx.x == PROBE_WG && threadIdx.x == 0) { *(LAS unsigned long long*)(lds + LDS_MISC + 792) += __builtin_amdgcn_s_memrealtime() - *(LAS unsigned long long*)(lds + LDS_MISC + 784); } } while (0)
#else
#define QSTART(i, k) do { } while (0)
#define QSTOP(i, k) do { } while (0)
#endif
#define SYNC() do { if (fused) xcd_barrier(bar); } while (0)
#ifndef DUP_MASK
#define DUP_MASK 0
#endif
#define REP(i) _Pragma("unroll 1") for (int rep_ = 0; rep_ < 1 + ((DUP_MASK >> (i)) & 1); ++rep_)
    const int G = gridDim.x, c = blockIdx.x;
    if (PH(0)) REP(0) { PSTART(0); const Params p = load_params(kp); phase_prologue(p, lds); SYNC(); PSTOP(0); }
    if (PH(1)) REP(1) { PSTART(1); const Params p = load_params(kp); phase_ln0(p); SYNC(); PSTOP(1); }
    for (int l = p_in.l_lo; l < l_hi; ++l) {
        const bool svc = (l == 0) && (G >= 256);
        if (PH(2)) REP(2) { PSTART(2);
            const Params p = load_params(kp);
            pg8::Gemm g{(const bf16_t*)(p.ws + WS_HA), (const bf16_t*)(p.ws + WS_WIN) + (size_t)l * INC * D, D};
            pg8::EpiBf16 E{(bf16_t*)(p.ws + WS_PROJ), INC};
            if (svc) {
                if (c < 240) {
                    pg8::DenseOrder<32, 30> S; S.init(INP8(0) ? D : 2 * D, 240, c);
                    if (INP8(0)) pg8::gemm_phase<pg8::EpiBf16, pg8::DenseOrder<32, 30>, true>(lds, g, S, E, 121, 127);
                    else pg8::gemm_phase(lds, g, S, E);
                } else ada_chunks(p, lds, 128 + (c - 240), 256, 16);
                tail_pull(p, lds, l * 4 + 0);
            } else {
                pg8::DenseOrder<32, 32> S; S.init(INP8(l) ? D : 2 * D, G, c);
                if (INP8(l)) pg8::gemm_phase<pg8::EpiBf16, pg8::DenseOrder<32, 32>, true>(lds, g, S, E, 121, 127);
                else pg8::gemm_phase(lds, g, S, E);
            }
            SYNC(); PSTOP(2);
        }
#ifdef MIXER_CHECK
        if (PH(3)) REP(3) { PSTART(3); const Params p = load_params(kp); phase_mixer_valu(p, l, lds); SYNC(); PSTOP(3); }
        if (PH(3)) REP(3) { PSTART(3); const Params p = load_params(kp); phase_mixer_mfma<0>(p, l, lds, (float*)(p.ws + WS_XE)); SYNC(); PSTOP(3); }
        if (PH(3)) REP(3) { PSTART(3); const Params p = load_params(kp); phase_mixer_check(p, (const float*)(p.ws + WS_OBUF), (const float*)(p.ws + WS_XE), (float*)(p.ws + WS_CNT + 1024) + l * 8); SYNC(); PSTOP(3); }
#else
        if (PH(3)) REP(3) { PSTART(3);
            const Params p = load_params(kp);
            const int n_extra = svc ? 96 : 32, pn0 = svc ? 30 : 32;
            for (int uu = (G >= 224 ? c - 192 : c); uu >= 0 && uu < n_extra; uu += (G >= 224 ? 64 : G)) {
                const int RBI = INP8(l) ? D : 2 * D;
                pg8::OneUnit S; S.u0.aB = (size_t)(uu & 31) * 256 * RBI; S.u0.bB = (size_t)(pn0 + (uu >> 5)) * 256 * RBI; S.u0.row0 = (uu & 31) * 256; S.u0.col0 = (pn0 + (uu >> 5)) * 256;
                pg8::EpiBf16 E{(bf16_t*)(p.ws + WS_PROJ), INC};
                pg8::Gemm g{(const bf16_t*)(p.ws + WS_HA), (const bf16_t*)(p.ws + WS_WIN) + (size_t)l * INC * D, D};
                if (INP8(l)) pg8::gemm_phase<pg8::EpiBf16, pg8::OneUnit, true>(lds, g, S, E, 121, 127);
                else pg8::gemm_phase(lds, g, S, E);
            }
            phase_mixer_mfma<0>(p, l, lds, (float*)(p.ws + WS_OBUF));
            tail_pull(p, lds, l * 4 + 1);
            SYNC(); PSTOP(3);
#ifdef MIXER_PROBE
            phase_mixer_mfma<MIXER_PROBE>(p, l, lds, (float*)(p.ws + WS_XE));
            SYNC(); PSTOP(3);
#endif
        }
#endif
        if (PH(4)) REP(4) { PSTART(4); const Params p = load_params(kp); phase_finalize(p, l); SYNC(); PSTOP(4); }
        if (PH(5)) REP(5) { PSTART(5);
            const Params p = load_params(kp);
            pg8::DenseOrder<32, 8> S; S.init(OUT8(l) ? D : 2 * D, G, c);
            pg8::Gemm g{(const bf16_t*)(p.ws + WS_MIXED), (const bf16_t*)(p.ws + WS_WOUT) + (size_t)l * D * D, D};
            pg8::EpiBf16 E{(bf16_t*)(p.ws + WS_Y), D};
            if (OUT8(l)) pg8::gemm_phase<pg8::EpiBf16, pg8::DenseOrder<32, 8>, true>(lds, g, S, E, 121, 125);
            else pg8::gemm_phase(lds, g, S, E);
            SYNC(); PSTOP(5);
        }
        if (PH(6)) REP(6) { PSTART(6); const Params p = load_params(kp); phase_ln1_router(p, l, lds); SYNC(); PSTOP(6); }
        if (PH(7)) REP(7) { PSTART(7); const Params p = load_params(kp); phase_permute(p, l, tab); cvt_pull(p, lds, l * CV_PER_L + CV_A1, nullptr, 0u); SYNC(); PSTOP(7); }
        if (PH(8)) REP(8) { PSTART(8);
            const Params p = load_params(kp);
            build_moe_tab(p, l, tab);
#if MOE_FP8
            pg8::MoeOrder S; S.tab = tab; S.NTn = 11; S.G = G; S.c = c; S.tstep = (size_t)256 * D; S.bexp = (size_t)2 * DE * D;
            pg8::Gemm g{(const bf16_t*)(p.ws + WS_XE), (const bf16_t*)(p.ws + WS_WGU + (size_t)l * NE * 2 * DE * D), D};
            pg8::EpiHidden8 E{p.ws + WS_HID};
            QSTART(8, 1); pg8::gemm_phase<pg8::EpiHidden8, pg8::MoeOrder, true>(lds, g, S, E, 121, 127); QSTOP(8, 1);
#else
            pg8::MoeOrder S; S.tab = tab; S.NTn = 11; S.G = G; S.c = c; S.tstep = (size_t)256 * D * 2; S.bexp = (size_t)2 * DE * D * 2;
            pg8::Gemm g{(const bf16_t*)(p.ws + WS_XE), (const bf16_t*)(p.ws + WS_WGU) + (size_t)l * NE * 2 * DE * D, D};
            pg8::EpiHidden E{(bf16_t*)(p.ws + WS_HID)};
            pg8::gemm_phase(lds, g, S, E);
#endif
            QSTART(8, 2); tail_pull(p, lds, l * 4 + 2); QSTOP(8, 2);
            QSTART(8, 3); cvt_pull(p, lds, (l + 1) * CV_PER_L, nullptr, 0u); QSTOP(8, 3);
            SYNC(); PSTOP(8);
        }
        if (PH(9)) REP(9) { PSTART(9);
            const Params p = load_params(kp);
            build_moe_tab(p, l, tab);
#if MOE_FP8
            pg8::MoeOrder S; S.tab = tab; S.NTn = 8; S.G = G; S.c = c; S.tstep = (size_t)256 * DEP; S.bexp = (size_t)D * DEP;
            pg8::Gemm g{(const bf16_t*)(p.ws + WS_HID), (const bf16_t*)(p.ws + WS_WD + (size_t)l * NE * D * DEP), DEP};
            pg8::EpiBf16 E{(bf16_t*)(p.ws + WS_YE), D};
            QSTART(9, 1); pg8::gemm_phase<pg8::EpiBf16, pg8::MoeOrder, true>(lds, g, S, E, 121, 124); QSTOP(9, 1);
#else
            pg8::MoeOrder S; S.tab = tab; S.NTn = 8; S.G = G; S.c = c; S.tstep = (size_t)256 * DE * 2; S.bexp = (size_t)D * DE * 2;
            pg8::Gemm g{(const bf16_t*)(p.ws + WS_HID), (const bf16_t*)(p.ws + WS_WD) + (size_t)l * NE * D * DE, DE};
            pg8::EpiBf16 E{(bf16_t*)(p.ws + WS_YE), D};
            pg8::gemm_phase(lds, g, S, E);
#endif
            QSTART(9, 2); tail_pull(p, lds, l * 4 + 3); QSTOP(9, 2);
            QSTART(9, 3); if (l + 1 < DEPTH) cvt_pull(p, lds, (l + 1) * CV_PER_L + CV_A0, nullptr, 0u); QSTOP(9, 3);
            SYNC(); PSTOP(9);
        }
        if (PH(10)) REP(10) { PSTART(10); const Params p = load_params(kp); phase_ln2(p, l); SYNC(); PSTOP(10); }
    }
#ifdef PROBE_PH
    if (blockIdx.x == 0 && threadIdx.x == 0) {
#ifdef PROBE_SUB
        const unsigned long long t = 0ull, t0 = __builtin_amdgcn_s_memrealtime();
#else
        const unsigned long long t = *(LAS unsigned long long*)(lds + LDS_MISC + 776) * 4ull, t0 = __builtin_amdgcn_s_memrealtime();
#endif
        while (__builtin_amdgcn_s_memrealtime() - t0 < t) __builtin_amdgcn_s_sleep(8);
    }
#ifdef PROBE_SUB
    if (blockIdx.x == PROBE_WG && threadIdx.x == 0) {
        const unsigned long long t = *(LAS unsigned long long*)(lds + LDS_MISC + 792) * 4ull, t0 = __builtin_amdgcn_s_memrealtime();
        while (__builtin_amdgcn_s_memrealtime() - t0 < t) __builtin_amdgcn_s_sleep(8);
    }
#endif
#endif
}

#ifndef MK_FUSED
#define MK_FUSED 1
#endif
extern "C" void kernel_launch(void* const* d_in, const int* in_sizes, int n_in, void* d_out, int out_size, void* d_ws, size_t ws_size, hipStream_t stream) {
    static int grid = 0;
    if (grid == 0) {
        if (n_in != 18 || ws_size < WS_END) { fprintf(stderr, "kernel_launch: unexpected n_in %d or ws_size %zu (< %zu)\n", n_in, ws_size, (size_t)WS_END); grid = -1; return; }
        int dev = 0, cus = 0, per_cu = 0;
        hipGetDevice(&dev);
        hipDeviceGetAttribute(&cus, hipDeviceAttributeMultiprocessorCount, dev);
        if (hipFuncSetAttribute((const void*)mega, hipFuncAttributeMaxDynamicSharedMemorySize, LDS_BYTES) != hipSuccess) { fprintf(stderr, "kernel_launch: hipFuncSetAttribute failed\n"); grid = -1; return; }
        hipOccupancyMaxActiveBlocksPerMultiprocessor(&per_cu, (const void*)mega, 512, LDS_BYTES);
        if (per_cu < 1) fprintf(stderr, "kernel_launch: occupancy query says %d\n", per_cu);
        grid = cus > 0 ? cus : 256;
    }
    if (grid < 0) return;
    hipMemsetAsync(d_ws, 0, WS_ZERO_BYTES, stream);
    Params p{};
    p.x = (const float*)d_in[0]; p.c = (const float*)d_in[1]; p.emb_g = (const float*)d_in[2]; p.emb_b = (const float*)d_in[3];
    p.w_ada = (const float*)d_in[4]; p.b_ada = (const float*)d_in[5]; p.w_in = (const float*)d_in[6]; p.conv_w = (const float*)d_in[7];
    p.mix_beta = (const float*)d_in[8]; p.w_out = (const float*)d_in[9]; p.lb_logits = (const float*)d_in[10]; p.ln_g = (const float*)d_in[11];
    p.ln_b = (const float*)d_in[12]; p.w_router = (const float*)d_in[13]; p.router_bias = (const float*)d_in[14]; p.w_gate = (const float*)d_in[15];
    p.w_up = (const float*)d_in[16]; p.w_down = (const float*)d_in[17];
    p.out = (float*)d_out; p.ws = (unsigned char*)d_ws; p.pad = 0;
#if MK_FUSED
    p.ph_lo = 0; p.ph_hi = 11; p.l_lo = 0; p.l_hi = DEPTH; p.fused = 1;
    hipLaunchKernelGGL(mega, dim3(grid), dim3(512), LDS_BYTES, stream, p);
#else
    p.fused = 0;
    for (int ph = 0; ph < 2; ++ph) { p.ph_lo = ph; p.ph_hi = ph + 1; p.l_lo = 0; p.l_hi = 0; hipLaunchKernelGGL(mega, dim3(grid), dim3(512), LDS_BYTES, stream, p); }
    for (int l = 0; l < DEPTH; ++l)
        for (int ph = 2; ph < 11; ++ph) { p.ph_lo = ph; p.ph_hi = ph + 1; p.l_lo = l; p.l_hi = l + 1; hipLaunchKernelGGL(mega, dim3(grid), dim3(512), LDS_BYTES, stream, p); }
#endif
}
```

```cpp
#include <hip/hip_runtime.h>
#include <stdint.h>
#include <stdio.h>

#define LAS __attribute__((address_space(3)))
typedef unsigned short bf16_t;
typedef short bf16x8 __attribute__((ext_vector_type(8)));
typedef float f32x4 __attribute__((ext_vector_type(4)));
typedef unsigned u32x4 __attribute__((ext_vector_type(4)));
typedef unsigned u32x2 __attribute__((ext_vector_type(2)));

constexpr int D = 2048, NB = 4, SEQ = 2048, T = NB * SEQ, DEPTH = 2;
constexpr int CW = 512, RW = 768, HWD = 768, INC = 8448;
constexpr int NE = 16, DE = 1408;
constexpr int C_CB = 0, C_CC = 512, C_CH = 1024, C_RQ = 1536, C_RK = 2304, C_RV = 3072, C_RG = 3840, C_HQ = 4608, C_HFF = 5376, C_HFB = 6144, C_HI = 6912, C_HG = 7680;
constexpr int XE_ROWS = 20480;
#ifndef MOE_FP8
#define MOE_FP8 1
#endif
#ifndef INP_FP8_FROM
#define INP_FP8_FROM 1
#endif
#define INP8(l) ((l) >= INP_FP8_FROM)
#ifndef OUT_FP8_FROM
#define OUT_FP8_FROM 1
#endif
#define OUT8(l) ((l) >= OUT_FP8_FROM)
constexpr int DEP = 1536;
constexpr float W8_SCALE = 64.f, H8_SCALE = 8.f;
constexpr float ALPHA = 1.4142135623730951f;

constexpr size_t WS_BAR = 0;
constexpr size_t WS_CNT = 16384;
constexpr size_t WS_CVTQ = 20480;
constexpr size_t WS_ZERO_BYTES = 32768;
constexpr size_t WS_MOD = 32768;
constexpr size_t WS_ROUTE = WS_MOD + 393216;
constexpr size_t WS_WGCNT = WS_ROUTE + 262144;
constexpr size_t WS_WIN = 1048576;
constexpr size_t SZ_WIN = (size_t)DEPTH * INC * D * 2;
constexpr size_t WS_WOUT = WS_WIN + SZ_WIN;
constexpr size_t SZ_WOUT = (size_t)DEPTH * D * D * 2;
constexpr size_t WS_WGU = WS_WOUT + SZ_WOUT;
constexpr size_t SZ_WGU = (size_t)DEPTH * NE * 2 * DE * D * 2;
constexpr size_t WS_WD = WS_WGU + SZ_WGU;
constexpr size_t SZ_WD = (size_t)DEPTH * NE * D * DE * 2;
constexpr size_t WS_XRES = WS_WD + SZ_WD;
constexpr size_t SZ_XRES = (size_t)T * D * 4;
constexpr size_t WS_HA = WS_XRES + SZ_XRES;
constexpr size_t SZ_H = (size_t)T * D * 2;
constexpr size_t WS_HB = WS_HA + SZ_H;
constexpr size_t WS_PROJ = WS_HB + SZ_H;
constexpr size_t SZ_PROJ = (size_t)T * INC * 2;
constexpr size_t WS_OBUF = WS_PROJ + SZ_PROJ;
constexpr size_t SZ_OBUF = (size_t)2 * T * 1536 * 4;
constexpr size_t WS_YE = WS_PROJ;
constexpr size_t SZ_YE = (size_t)XE_ROWS * D * 4;
static_assert(SZ_YE <= SZ_PROJ + SZ_OBUF, "ye alias");
constexpr size_t WS_MIXED = WS_OBUF + SZ_OBUF;
constexpr size_t WS_Y = WS_MIXED + SZ_H;
constexpr size_t SZ_Y = (size_t)T * D * 4;
constexpr size_t WS_XE = WS_Y + SZ_Y;
constexpr size_t SZ_XE = (size_t)XE_ROWS * D * 2;
constexpr size_t WS_HID = WS_XE + SZ_XE;
constexpr size_t SZ_HID = (size_t)XE_ROWS * DE * 2;
constexpr size_t WS_END = WS_HID + SZ_HID;

constexpr int LDS_BYTES = 156672;
constexpr int LDS_MISC = 153600;

struct Params {
    const float *x, *c, *emb_g, *emb_b, *w_ada, *b_ada, *w_in, *conv_w, *mix_beta, *w_out, *lb_logits, *ln_g, *ln_b, *w_router, *router_bias, *w_gate, *w_up, *w_down;
    float* out;
    unsigned char* ws;
    int ph_lo, ph_hi, l_lo, l_hi, fused, pad;
};

__device__ __forceinline__ float bf2f(unsigned b) { return __uint_as_float(b << 16); }
__device__ __forceinline__ unsigned f2bf(float f) { unsigned u = __float_as_uint(f); u += 0x7FFFu + ((u >> 16) & 1u); return u >> 16; }
typedef __bf16 bf16x2_t __attribute__((ext_vector_type(2)));
typedef float f32x2_t __attribute__((ext_vector_type(2)));
__device__ __forceinline__ unsigned pack2a(float lo, float hi) { unsigned r; asm("v_cvt_pk_bf16_f32 %0, %1, %2" : "=v"(r) : "v"(lo), "v"(hi)); return r; }
__device__ __forceinline__ unsigned pack2(float lo, float hi) { const bf16x2_t r = __builtin_convertvector((f32x2_t){lo, hi}, bf16x2_t); return __builtin_bit_cast(unsigned, r); }
__device__ __forceinline__ float wave_sum(float v) {
#pragma unroll
    for (int o = 32; o > 0; o >>= 1) v += __shfl_xor(v, o, 64);
    return v;
}
__device__ __forceinline__ float half_sum(float v) {
#pragma unroll
    for (int o = 16; o > 0; o >>= 1) v += __shfl_xor(v, o, 64);
    return v;
}
#define LDS_BARRIER() do { asm volatile("s_waitcnt lgkmcnt(0)" ::: "memory"); __builtin_amdgcn_s_barrier(); asm volatile("" ::: "memory"); } while (0)
__device__ __forceinline__ float sigmoidf_(float z) { return 1.0f / (1.0f + __expf(-z)); }
__device__ __forceinline__ float siluf_(float z) { return z / (1.0f + __expf(-z)); }

#define XB_TMO      128
#define XB_XCNT(j)  (256  + 64 * (j))
#define XB_XSUB(j)  (1280 + 64 * (j))
#define XB_XGEN(j)  (2304 + 64 * (j))
#define XB_TOP      3328
#define XB_TOPGEN   3392
#define XCD_BAR_WORDS 3456
#define XB_SPIN_CAP (1u << 22)
__device__ __forceinline__ unsigned xb_ld(unsigned* p)              { return __hip_atomic_load(p, __ATOMIC_RELAXED, __HIP_MEMORY_SCOPE_AGENT); }
__device__ __forceinline__ unsigned xb_add(unsigned* p, unsigned v) { return __hip_atomic_fetch_add(p, v, __ATOMIC_RELAXED, __HIP_MEMORY_SCOPE_AGENT); }
__device__ __forceinline__ unsigned xb_xcc_id() { return (unsigned)__builtin_amdgcn_s_getreg((3 << 11) | 20) & 0xFu; }
#define XB_SPIN(cond, bar) do { unsigned _sp = 0; while (cond) { __builtin_amdgcn_s_sleep(1); \
    if ((++_sp & 255u) == 0u) { if (xb_ld(&(bar)[XB_TMO])) break; if (_sp > XB_SPIN_CAP) { atomicAdd(&(bar)[XB_TMO], 1u); break; } } } } while (0)
struct XcdBarrier { unsigned* bar; unsigned x; volatile LAS unsigned* st; };
__device__ __forceinline__ XcdBarrier xcd_barrier_post(unsigned* bar, volatile LAS unsigned* st) {
    XcdBarrier b; b.bar = bar; b.x = xb_xcc_id(); b.st = st;
    if (threadIdx.x == 0) (void)xb_add(&bar[XB_XCNT(b.x)], 1u);
    return b;
}
__device__ __forceinline__ void xcd_barrier_complete(unsigned* bar, unsigned x, unsigned& nloc, unsigned& nx) {
    const unsigned G = gridDim.x * gridDim.y * gridDim.z;
    unsigned sum, cnt, mine, sp = 0u;
    for (;;) {
        sum = 0u; cnt = 0u; mine = 0u;
#pragma unroll
        for (unsigned j = 0; j < 16; ++j) { const unsigned c = xb_ld(&bar[XB_XCNT(j)]); sum += c; cnt += (c > 0u) ? 1u : 0u; mine = (j == x) ? c : mine; }
        if (sum == G) break;
        __builtin_amdgcn_s_sleep(1);
        if ((++sp & 255u) == 0u) { if (xb_ld(&bar[XB_TMO])) break; if (sp > XB_SPIN_CAP) { atomicAdd(&bar[XB_TMO], 1u); break; } }
    }
    nloc = mine > 0u ? mine : 1u; nx = cnt > 0u ? cnt : 1u;
}
__device__ __forceinline__ void xcd_barrier(const XcdBarrier& b) {
    asm volatile("s_waitcnt vmcnt(0)" ::: "memory");
    __syncthreads();
    if (threadIdx.x == 0) {
        unsigned* bar = b.bar;
        __builtin_amdgcn_s_waitcnt(0);
        unsigned nloc = b.st[0], nx = b.st[1];
        if (nloc == 0u) { xcd_barrier_complete(bar, b.x, nloc, nx); b.st[0] = nloc; b.st[1] = nx; }
        const unsigned old = xb_add(&bar[XB_XSUB(b.x)], 1u);
        const unsigned gen = old / nloc;
        if (old + 1u == (gen + 1u) * nloc) {
            __builtin_amdgcn_fence(__ATOMIC_RELEASE, "agent");
            asm volatile("s_waitcnt vmcnt(0)" ::: "memory");
            const unsigned og = xb_add(&bar[XB_TOP], 1u);
            const unsigned tg = og / nx;
            if (og + 1u == (tg + 1u) * nx) xb_add(&bar[XB_TOPGEN], 1u);
            else XB_SPIN(xb_ld(&bar[XB_TOPGEN]) == tg, bar);
            __builtin_amdgcn_fence(__ATOMIC_ACQUIRE, "agent");
            xb_add(&bar[XB_XGEN(b.x)], 1u);
            asm volatile("s_waitcnt vmcnt(0)" ::: "memory");
        } else {
            XB_SPIN(xb_ld(&bar[XB_XGEN(b.x)]) == gen, bar);
            __builtin_amdgcn_fence(__ATOMIC_ACQUIRE, "agent");
            asm volatile("s_waitcnt vmcnt(0)" ::: "memory");
        }
    }
    __syncthreads();
}

namespace pg8 {
constexpr int BM = 256, BK = 64, HALF = 128, HTB = HALF * BK * 2, STAGE_BYTES = 8 * HTB, NXCD = 8, WGM = 8;
__host__ __device__ __forceinline__ int lds_byte(int r, int c) { const int st = (r >> 4) * 2 + (c >> 5), rr = r & 15, cc = c & 31, ob = rr * 64 + cc * 2; return st * 1024 + (ob ^ (((ob >> 9) & 1) << 5)); }
__host__ __device__ __forceinline__ void stage_rc(int b, int& R, int& C) { const int st = b / 1024, sb = b % 1024, swz = sb ^ (((sb >> 9) & 1) << 5); R = (st >> 1) * 16 + swz / 64; C = (st & 1) * 32 + (swz % 64) / 2; }
__host__ __device__ __forceinline__ int perm32(int rho) { const int n = rho >> 4, i = rho & 15; return 8 * (i >> 2) + 4 * n + (i & 3); }

struct Unit { size_t aB, bB; int row0, col0; };
struct Gemm { const bf16_t* A; const bf16_t* Bt; int K; };

template <int NM, int NN>
struct DenseOrder {
    int G, c; size_t tstep;
    __device__ void init(int rowbytes, int G_, int c_) { G = G_; c = c_; tstep = (size_t)BM * rowbytes; }
    __device__ bool next(int i, Unit& u) const {
        constexpr int nwg = NM * NN, q = nwg / NXCD, r = nwg % NXCD, nig = WGM * NN;
        static_assert(NM % WGM == 0, "row tiles come in groups of 8");
        const int L = __builtin_amdgcn_readfirstlane(i * G + c); if (L >= nwg) return false;
        const int xcd = L % NXCD, off = L / NXCD;
        const int wgid = (xcd < r ? xcd * (q + 1) : r * (q + 1) + (xcd - r) * q) + off;
        const int gid = wgid / nig, fm = gid * WGM, rem = wgid % nig;
        const int pm = fm + (rem % WGM), pn = rem / WGM;
        u.aB = (size_t)pm * tstep; u.bB = (size_t)pn * tstep; u.row0 = pm * BM; u.col0 = pn * BM; return true;
    }
};
struct OneUnit {
    Unit u0;
    __device__ bool next(int i, Unit& u) const { if (i > 0) return false; u = u0; return true; }
};
struct MoeOrder {
    const LAS int* tab; int NTn, G, c; size_t tstep, bexp;
    __device__ bool next(int i, Unit& u) const {
        const int MT = tab[16], U = MT * NTn, nx = G >> 3;
        int f;
        if ((G & 7) == 0) { const int per = (U + 7) >> 3, x = c & 7, j = c >> 3, loc = i * nx + j; f = x * per + loc; if (loc >= per || f >= U) return false; }
        else { f = i * G + c; if (f >= U) return false; }
        int e = 0;
#pragma unroll
        for (int j = 1; j < 16; ++j) e += (f >= tab[j] * NTn) ? 1 : 0;
        const int t0 = tab[e], te = tab[e + 1] - t0, r = f - t0 * NTn;
        const int nt = r / te, mt = t0 + (r - nt * te);
        u.aB = (size_t)mt * tstep; u.bB = (size_t)e * bexp + (size_t)nt * tstep; u.row0 = mt * BM; u.col0 = nt * BM; return true;
    }
};

__device__ __forceinline__ size_t rfl64(size_t v) { const unsigned lo = (unsigned)__builtin_amdgcn_readfirstlane((int)(unsigned)v), hi = (unsigned)__builtin_amdgcn_readfirstlane((int)(unsigned)(v >> 32)); return ((size_t)hi << 32) | lo; }
__device__ __forceinline__ void uniformize(Unit& u) { u.aB = rfl64(u.aB); u.bB = rfl64(u.bB); u.row0 = __builtin_amdgcn_readfirstlane(u.row0); u.col0 = __builtin_amdgcn_readfirstlane(u.col0); }
__device__ __forceinline__ unsigned cvt_pk_bf16(float lo, float hi) { unsigned r; asm volatile("v_cvt_pk_bf16_f32 %0, %1, %2" : "=v"(r) : "v"(lo), "v"(hi)); return r; }

struct EpiF32 {
    static constexpr bool PERM = false;
    float* C; int ldc;
    __device__ __forceinline__ void operator()(const f32x4 (&acc)[2][2][4][2], const Unit& u, int wr, int wc, int fr, int fq) const {
        const int row0 = u.row0 + wr * 64 + fr, col0 = u.col0 + wc * 32 + 4 * fq;
#pragma unroll
        for (int ai = 0; ai < 2; ++ai)
#pragma unroll
            for (int m = 0; m < 4; ++m) { float* rowp = C + (size_t)(row0 + ai * HALF + m * 16) * ldc + col0;
#pragma unroll
                for (int bj = 0; bj < 2; ++bj)
#pragma unroll
                    for (int n = 0; n < 2; ++n) *(f32x4*)(rowp + bj * HALF + n * 16) = acc[ai][bj][m][n]; }
    }
};
struct EpiBf16 {
    static constexpr bool PERM = true;
    bf16_t* O; int ldc;
    __device__ __forceinline__ void operator()(const f32x4 (&acc)[2][2][4][2], const Unit& u, int wr, int wc, int fr, int fq) const {
        const int row0 = u.row0 + wr * 64 + fr, col0 = u.col0 + wc * 32 + 8 * fq;
#pragma unroll
        for (int ai = 0; ai < 2; ++ai)
#pragma unroll
            for (int m = 0; m < 4; ++m) { bf16_t* rowp = O + (size_t)(row0 + ai * HALF + m * 16) * ldc + col0;
#pragma unroll
                for (int bj = 0; bj < 2; ++bj) { const f32x4 v0 = acc[ai][bj][m][0], v1 = acc[ai][bj][m][1];
                    u32x4 o; o[0] = cvt_pk_bf16(v0[0], v0[1]); o[1] = cvt_pk_bf16(v0[2], v0[3]); o[2] = cvt_pk_bf16(v1[0], v1[1]); o[3] = cvt_pk_bf16(v1[2], v1[3]);
                    *(u32x4*)(rowp + bj * HALF) = o; } }
    }
};
struct EpiHidden {
    static constexpr bool PERM = true;
    bf16_t* O;
    __device__ __forceinline__ void operator()(const f32x4 (&acc)[2][2][4][2], const Unit& u, int wr, int wc, int fr, int fq) const {
        const int row0 = u.row0 + wr * 64 + fr, col0 = (u.col0 >> 1) + wc * 32 + 8 * fq;
#pragma unroll
        for (int ai = 0; ai < 2; ++ai)
#pragma unroll
            for (int m = 0; m < 4; ++m) { bf16_t* rowp = O + (size_t)(row0 + ai * HALF + m * 16) * DE + col0;
                float h[8];
#pragma unroll
                for (int n = 0; n < 2; ++n)
#pragma unroll
                    for (int j = 0; j < 4; ++j) { const float g = acc[ai][0][m][n][j], up = acc[ai][1][m][n][j]; h[n * 4 + j] = g * __builtin_amdgcn_rcpf(1.0f + __expf(-g)) * up; }
                u32x4 o; o[0] = cvt_pk_bf16(h[0], h[1]); o[1] = cvt_pk_bf16(h[2], h[3]); o[2] = cvt_pk_bf16(h[4], h[5]); o[3] = cvt_pk_bf16(h[6], h[7]);
                *(u32x4*)rowp = o; }
    }
};

typedef int v8i32 __attribute__((ext_vector_type(8)));
typedef int v4i32 __attribute__((ext_vector_type(4)));
struct EpiHidden8 {
    static constexpr bool PERM = true;
    unsigned char* O;
    __device__ __forceinline__ void operator()(const f32x4 (&acc)[2][2][4][2], const Unit& u, int wr, int wc, int fr, int fq) const {
        const int row0 = u.row0 + wr * 64 + fr, col0 = (u.col0 >> 1) + wc * 32 + 8 * fq;
#pragma unroll
        for (int ai = 0; ai < 2; ++ai)
#pragma unroll
            for (int m = 0; m < 4; ++m) { unsigned char* rowp = O + (size_t)(row0 + ai * HALF + m * 16) * DEP + col0;
                float h[8];
#pragma unroll
                for (int n = 0; n < 2; ++n)
#pragma unroll
                    for (int j = 0; j < 4; ++j) { const float g = acc[ai][0][m][n][j], up = acc[ai][1][m][n][j]; h[n * 4 + j] = g * __builtin_amdgcn_rcpf(1.0f + __expf(-g)) * up * H8_SCALE; }
                int o0 = __builtin_amdgcn_cvt_pk_fp8_f32(h[0], h[1], 0, false); o0 = __builtin_amdgcn_cvt_pk_fp8_f32(h[2], h[3], o0, true);
                int o1 = __builtin_amdgcn_cvt_pk_fp8_f32(h[4], h[5], 0, false); o1 = __builtin_amdgcn_cvt_pk_fp8_f32(h[6], h[7], o1, true);
                u32x2 o; o[0] = (unsigned)o0; o[1] = (unsigned)o1;
                *(u32x2*)rowp = o; }
    }
};
template <class Epi, class Sched, bool FP8 = false>
__device__ __forceinline__ void gemm_phase(LAS unsigned char* lds, const Gemm g, const Sched& S, const Epi& E, int sclW = 127, int sclA = 127) {
    int tid = threadIdx.x; asm volatile("" : "+v"(tid)); const int wid = __builtin_amdgcn_readfirstlane(tid >> 6), lane = tid & 63, wr = wid >> 2, wc = wid & 3, fr = lane & 15, fq = lane >> 4;
    const int K = g.K, rowb = FP8 ? K : 2 * K, nt = rowb / 128;
    int sclWv = sclW, sclAv = sclA; asm volatile("" : "+v"(sclWv), "+v"(sclAv));
    unsigned voffA[2], voffB[2];
#pragma unroll
    for (int i = 0; i < 2; ++i) { int R, C; stage_rc(tid * 16 + i * 8192, R, C); const int Rb = Epi::PERM ? ((R & ~31) + perm32(R & 31)) : R;
        voffA[i] = (unsigned)(R * rowb + 2 * C); voffB[i] = (unsigned)(Rb * rowb + 2 * C); }
    const size_t kstep = 128;
    const size_t hstep = (size_t)HALF * rowb;
    const unsigned ldsw = (unsigned)wid * 1024u;
    const int aoff = lds_byte(wr * 64 + fr, fq * 8), boff = lds_byte(wc * 32 + fr, fq * 8);
    constexpr int P2 = 1024;
#define PG8_SA(b, h) (((b) * 2 + (h)) * HTB)
#define PG8_SB(b, h) ((4 + (b) * 2 + (h)) * HTB)
#define PG8_STAGE(bufoff, gbase, voff) do { _Pragma("unroll") for (int _i = 0; _i < 2; ++_i) \
        __builtin_amdgcn_global_load_lds((const unsigned*)((const char*)(gbase) + (voff)[_i]), (LAS unsigned*)(lds + (bufoff) + ldsw + _i * 8192), 16, 0, 0); } while (0)
#define PG8_LDA(dst, b, h) do { _Pragma("unroll") for (int m = 0; m < 4; ++m) { \
        const v4i32 _l = *(const LAS v4i32*)(lds + PG8_SA(b, h) + aoff + m * 2048), _h = *(const LAS v4i32*)(lds + PG8_SA(b, h) + aoff + P2 + m * 2048); \
        dst[m] = __builtin_shufflevector(_l, _h, 0, 1, 2, 3, 4, 5, 6, 7); } } while (0)
#define PG8_LDB(dst, b, h) do { _Pragma("unroll") for (int n = 0; n < 2; ++n) { \
        const v4i32 _l = *(const LAS v4i32*)(lds + PG8_SB(b, h) + boff + n * 2048), _h = *(const LAS v4i32*)(lds + PG8_SB(b, h) + boff + P2 + n * 2048); \
        dst[n] = __builtin_shufflevector(_l, _h, 0, 1, 2, 3, 4, 5, 6, 7); } } while (0)
#define PG8_MMA(ai, bj, At, Bt) do { __builtin_amdgcn_s_setprio(1); _Pragma("unroll") for (int m = 0; m < 4; ++m) _Pragma("unroll") for (int n = 0; n < 2; ++n) { \
        if constexpr (FP8) { \
            asm volatile("v_mfma_scale_f32_16x16x128_f8f6f4 %0, %1, %2, %0, %3, %4 op_sel_hi:[0,0,0]" : "+v"(acc[ai][bj][m][n]) : "v"(Bt[n]), "v"(At[m]), "v"(sclWv), "v"(sclAv)); \
        } else { \
            acc[ai][bj][m][n] = __builtin_amdgcn_mfma_f32_16x16x32_bf16(__builtin_bit_cast(bf16x8, __builtin_shufflevector(Bt[n], Bt[n], 0, 1, 2, 3)), __builtin_bit_cast(bf16x8, __builtin_shufflevector(At[m], At[m], 0, 1, 2, 3)), acc[ai][bj][m][n], 0, 0, 0); \
            acc[ai][bj][m][n] = __builtin_amdgcn_mfma_f32_16x16x32_bf16(__builtin_bit_cast(bf16x8, __builtin_shufflevector(Bt[n], Bt[n], 4, 5, 6, 7)), __builtin_bit_cast(bf16x8, __builtin_shufflevector(At[m], At[m], 4, 5, 6, 7)), acc[ai][bj][m][n], 0, 0, 0); } } \
        __builtin_amdgcn_s_setprio(0); } while (0)
#define PG8_WAIT_V(n) asm volatile("s_waitcnt vmcnt(" #n ")" ::: "memory")
#define PG8_WAIT_L(n) asm volatile("s_waitcnt lgkmcnt(" #n ")" ::: "memory")
#define PG8_BAR __builtin_amdgcn_s_barrier()
#define PG8_SCHED __builtin_amdgcn_sched_barrier(0)
    Unit cur, nxt; int ui = 0;
    if (!S.next(0, cur)) return;
    uniformize(cur);
    f32x4 acc[2][2][4][2];
#pragma unroll
    for (int a = 0; a < 2; ++a)
#pragma unroll
        for (int b = 0; b < 2; ++b)
#pragma unroll
            for (int m = 0; m < 4; ++m)
#pragma unroll
                for (int n = 0; n < 2; ++n) acc[a][b][m][n] = (f32x4){0.f, 0.f, 0.f, 0.f};
    v8i32 At[4], B0[2], B1[2];
    const char* cA = (const char*)g.A + cur.aB; const char* cB = (const char*)g.Bt + cur.bB;
    PG8_STAGE(PG8_SB(0, 0), cB, voffB); PG8_STAGE(PG8_SA(0, 0), cA, voffA); PG8_STAGE(PG8_SB(0, 1), cB + hstep, voffB); PG8_STAGE(PG8_SA(0, 1), cA + hstep, voffA);
    if (wr == 1) PG8_BAR;
    PG8_WAIT_V(4); PG8_BAR;
    PG8_STAGE(PG8_SB(1, 0), cB + kstep, voffB); PG8_STAGE(PG8_SA(1, 0), cA + kstep, voffA); PG8_STAGE(PG8_SB(1, 1), cB + hstep + kstep, voffB);
    PG8_WAIT_V(6); PG8_BAR;
    for (;;) {
        const bool has_next = S.next(ui + 1, nxt);
        uniformize(nxt);
        const char* nA = has_next ? (const char*)g.A + nxt.aB : cA; const char* nB = has_next ? (const char*)g.Bt + nxt.bB : cB;
        for (int t = 0; t < nt; t += 2) {
            const bool last = (t == nt - 2);
            const char* a1 = cA + (size_t)(t + 1) * kstep;
            const char* a2 = last ? nA : cA + (size_t)(t + 2) * kstep; const char* b2 = last ? nB : cB + (size_t)(t + 2) * kstep;
            const char* a3 = a2 + kstep; const char* b3 = b2 + kstep;
            PG8_LDB(B0, 0, 0); PG8_SCHED; PG8_LDA(At, 0, 0); PG8_STAGE(PG8_SA(1, 1), a1 + hstep, voffA);
            PG8_WAIT_L(8); PG8_BAR; PG8_WAIT_L(0); PG8_MMA(0, 0, At, B0); PG8_BAR; PG8_SCHED;
            PG8_LDB(B1, 0, 1); PG8_STAGE(PG8_SB(0, 0), b2, voffB);
            PG8_BAR; PG8_WAIT_L(0); PG8_MMA(0, 1, At, B1); PG8_BAR;
            PG8_LDA(At, 0, 1); PG8_STAGE(PG8_SA(0, 0), a2, voffA);
            PG8_BAR; PG8_WAIT_L(0); PG8_MMA(1, 0, At, B0); PG8_BAR; PG8_SCHED;
            PG8_STAGE(PG8_SB(0, 1), b2 + hstep, voffB);
            PG8_WAIT_V(6); PG8_BAR; PG8_MMA(1, 1, At, B1); PG8_BAR;
            PG8_LDB(B0, 1, 0); PG8_SCHED; PG8_LDA(At, 1, 0); PG8_STAGE(PG8_SA(0, 1), a2 + hstep, voffA);
            PG8_WAIT_L(8); PG8_BAR; PG8_WAIT_L(0); PG8_MMA(0, 0, At, B0); PG8_BAR; PG8_SCHED;
            PG8_LDB(B1, 1, 1); PG8_STAGE(PG8_SB(1, 0), b3, voffB);
            PG8_BAR; PG8_WAIT_L(0); PG8_MMA(0, 1, At, B1); PG8_BAR;
            PG8_LDA(At, 1, 1); PG8_STAGE(PG8_SA(1, 0), a3, voffA);
            PG8_BAR; PG8_WAIT_L(0); PG8_MMA(1, 0, At, B0); PG8_BAR; PG8_SCHED;
            PG8_STAGE(PG8_SB(1, 1), b3 + hstep, voffB);
            PG8_WAIT_V(6); PG8_BAR; PG8_MMA(1, 1, At, B1); PG8_BAR;
        }
        if constexpr (FP8) asm volatile("s_nop 15\n\ts_nop 15" ::: "memory");
        E(acc, cur, wr, wc, fr, fq);
        if (!has_next) break;
#pragma unroll
        for (int a = 0; a < 2; ++a)
#pragma unroll
            for (int b = 0; b < 2; ++b)
#pragma unroll
                for (int m = 0; m < 4; ++m)
#pragma unroll
                    for (int n = 0; n < 2; ++n) acc[a][b][m][n] = (f32x4){0.f, 0.f, 0.f, 0.f};
        cur = nxt; cA = nA; cB = nB; ++ui;
    }
    PG8_WAIT_V(0);
    if (wr == 0) PG8_BAR;
    PG8_BAR;
#undef PG8_SA
#undef PG8_SB
#undef PG8_STAGE
#undef PG8_LDA
#undef PG8_LDB
#undef PG8_MMA
#undef PG8_WAIT_V
#undef PG8_WAIT_L
#undef PG8_BAR
#undef PG8_SCHED
}
}

constexpr int S_IN = 16 * 66, S_OUT = 16 * 16, S_GU = 16 * 11, S_DN = 11 * 16;
constexpr int CV_PER_L = S_IN + S_OUT + NE * 2 * S_GU + NE * S_DN;
constexpr int CV_A0 = S_IN + S_OUT;
constexpr int CV_A1 = CV_A0 + NE * 2 * S_GU;
constexpr int CV_TOTAL = DEPTH * CV_PER_L;
constexpr int CV_LAST = 1 << 30;
struct StripDesc { const float* src; bf16_t* dst; int lds_, ldd, k0, n0, drow0, fp8; };
__device__ __forceinline__ StripDesc strip_desc(const Params& p, int si) {
    unsigned char* ws = p.ws; StripDesc d;
    const int l = si / CV_PER_L; int r = si - l * CV_PER_L;
    if (r < S_IN) {
        const int kt = r / 66, ntl = r % 66;
        d.src = p.w_in + (size_t)l * D * INC; d.lds_ = INC; d.fp8 = INP8(l) ? 1 : 0; d.dst = (bf16_t*)(ws + WS_WIN) + (size_t)l * INC * D; d.ldd = D; d.k0 = kt * 128; d.n0 = ntl * 128; d.drow0 = ntl * 128;
    } else if (r < CV_A0) {
        r -= S_IN; const int kt = r / 16, ntl = r % 16;
        d.src = p.w_out + (size_t)l * D * D; d.lds_ = D; d.dst = (bf16_t*)(ws + WS_WOUT) + (size_t)l * D * D; d.ldd = D; d.k0 = kt * 128; d.n0 = ntl * 128; d.drow0 = ntl * 128; d.fp8 = OUT8(l) ? 1 : 0;
    } else if (r < CV_A1) {
        r -= CV_A0; const int mat = r / S_GU, q = r % S_GU, kt = q / 11, ntl = q % 11;
        const int which = mat & 1, le = l * NE + (mat >> 1);
        d.src = (which ? p.w_up : p.w_gate) + (size_t)le * D * DE; d.lds_ = DE; d.fp8 = MOE_FP8; d.dst = MOE_FP8 ? (bf16_t*)(ws + WS_WGU + (size_t)le * (2 * DE) * D) : (bf16_t*)(ws + WS_WGU) + (size_t)le * (2 * DE) * D; d.ldd = D; d.k0 = kt * 128; d.n0 = ntl * 128; d.drow0 = ntl * 256 + which * 128;
    } else {
        r -= CV_A1; const int le = l * NE + r / S_DN, q = r % S_DN, kt = q / 16, ntl = q % 16;
        d.src = p.w_down + (size_t)le * DE * D; d.lds_ = D; d.fp8 = MOE_FP8; d.dst = MOE_FP8 ? (bf16_t*)(ws + WS_WD + (size_t)le * D * DEP) : (bf16_t*)(ws + WS_WD) + (size_t)le * D * DE; d.ldd = MOE_FP8 ? DEP : DE; d.k0 = kt * 128; d.n0 = ntl * 128; d.drow0 = ntl * 128;
    }
    return d;
}
__device__ __forceinline__ void cvt_store_strip(const StripDesc& d, const float4 (&a)[2][2], const float4 (&b)[2][2], LAS unsigned char* tb, int tid, bool readout) {
    const int kp = tid >> 4, n4 = (tid & 15) * 4;
    if (!readout) {
        if (!d.fp8) {
#pragma unroll
            for (int ki = 0; ki < 2; ++ki)
#pragma unroll
                for (int ni = 0; ni < 2; ++ni) {
                    LAS unsigned* t = (LAS unsigned*)tb + (ki * 2 + ni) * 2112;
                    t[(n4 + 0) * 33 + kp] = pack2a(a[ki][ni].x, b[ki][ni].x);
                    t[(n4 + 1) * 33 + kp] = pack2a(a[ki][ni].y, b[ki][ni].y);
                    t[(n4 + 2) * 33 + kp] = pack2a(a[ki][ni].z, b[ki][ni].z);
                    t[(n4 + 3) * 33 + kp] = pack2a(a[ki][ni].w, b[ki][ni].w);
                }
        } else {
#pragma unroll
            for (int ki = 0; ki < 2; ++ki)
#pragma unroll
                for (int ni = 0; ni < 2; ++ni) {
                    LAS unsigned char* t = tb + (ki * 2 + ni) * 4352;
                    *(LAS unsigned short*)(t + (n4 + 0) * 68 + 2 * kp) = (unsigned short)__builtin_amdgcn_cvt_pk_fp8_f32(a[ki][ni].x * W8_SCALE, b[ki][ni].x * W8_SCALE, 0, false);
                    *(LAS unsigned short*)(t + (n4 + 1) * 68 + 2 * kp) = (unsigned short)__builtin_amdgcn_cvt_pk_fp8_f32(a[ki][ni].y * W8_SCALE, b[ki][ni].y * W8_SCALE, 0, false);
                    *(LAS unsigned short*)(t + (n4 + 2) * 68 + 2 * kp) = (unsigned short)__builtin_amdgcn_cvt_pk_fp8_f32(a[ki][ni].z * W8_SCALE, b[ki][ni].z * W8_SCALE, 0, false);
                    *(LAS unsigned short*)(t + (n4 + 3) * 68 + 2 * kp) = (unsigned short)__builtin_amdgcn_cvt_pk_fp8_f32(a[ki][ni].w * W8_SCALE, b[ki][ni].w * W8_SCALE, 0, false);
                }
        }
    } else {
        if (!d.fp8) {
            const int n = tid >> 3, kc = (tid & 7) * 4;
#pragma unroll
            for (int ki = 0; ki < 2; ++ki)
#pragma unroll
                for (int ni = 0; ni < 2; ++ni) {
                    const LAS unsigned* t = (const LAS unsigned*)tb + (ki * 2 + ni) * 2112;
                    u32x4 o; o[0] = t[n * 33 + kc]; o[1] = t[n * 33 + kc + 1]; o[2] = t[n * 33 + kc + 2]; o[3] = t[n * 33 + kc + 3];
                    *(u32x4*)(d.dst + (size_t)(d.drow0 + ni * 64 + n) * d.ldd + d.k0 + ki * 64 + kc * 2) = o;
                }
        } else {
            const int n = tid >> 3, kc8 = (tid & 7) * 8;
            unsigned char* dst8 = (unsigned char*)d.dst;
#pragma unroll
            for (int ki = 0; ki < 2; ++ki)
#pragma unroll
                for (int ni = 0; ni < 2; ++ni) {
                    const LAS unsigned char* t = tb + (ki * 2 + ni) * 4352;
                    u32x2 o; o[0] = *(const LAS unsigned*)(t + n * 68 + kc8); o[1] = *(const LAS unsigned*)(t + n * 68 + kc8 + 4);
                    *(u32x2*)(dst8 + (size_t)(d.drow0 + ni * 64 + n) * d.ldd + d.k0 + ki * 64 + kc8) = o;
                }
        }
    }
}
__device__ __forceinline__ void cvt_pull(const Params& p, LAS unsigned char* lds, int limit, unsigned* done_ctr, unsigned need_done) {
    int tid = threadIdx.x; asm volatile("" : "+v"(tid));
    LAS int* slot = (LAS int*)(lds + LDS_MISC + 512);
    unsigned* head = (unsigned*)(p.ws + WS_CVTQ);
    if (tid == 0) {
        int sv = -1;
        const bool stop = done_ctr ? (xb_ld(done_ctr) >= need_done) : (xb_ld(head) >= (unsigned)limit);
        if (!stop) { const unsigned c = xb_add(head, 2u); sv = c < (unsigned)CV_TOTAL ? (int)c : -1; }
        slot[0] = sv;
    }
    __syncthreads();
    const int kp = tid >> 4, n4 = (tid & 15) * 4;
    for (;;) {
        const int sraw = slot[0];
        if (sraw < 0) break;
        const int si = sraw & (CV_LAST - 1); const bool lastone = (sraw & CV_LAST) != 0;
        const StripDesc d0 = strip_desc(p, si), d1 = strip_desc(p, si + 1);
        float4 a0[2][2], b0[2][2], a1[2][2], b1[2][2];
#pragma unroll
        for (int ki = 0; ki < 2; ++ki)
#pragma unroll
            for (int ni = 0; ni < 2; ++ni) {
                a0[ki][ni] = *(const float4*)(d0.src + (size_t)(d0.k0 + ki * 64 + 2 * kp) * d0.lds_ + d0.n0 + ni * 64 + n4);
                b0[ki][ni] = *(const float4*)(d0.src + (size_t)(d0.k0 + ki * 64 + 2 * kp + 1) * d0.lds_ + d0.n0 + ni * 64 + n4);
            }
#pragma unroll
        for (int ki = 0; ki < 2; ++ki)
#pragma unroll
            for (int ni = 0; ni < 2; ++ni) {
                a1[ki][ni] = *(const float4*)(d1.src + (size_t)(d1.k0 + ki * 64 + 2 * kp) * d1.lds_ + d1.n0 + ni * 64 + n4);
                b1[ki][ni] = *(const float4*)(d1.src + (size_t)(d1.k0 + ki * 64 + 2 * kp + 1) * d1.lds_ + d1.n0 + ni * 64 + n4);
            }
        unsigned c = 0u, dn = 0u;
        if (tid == 0 && !lastone) { c = xb_add(head, 2u); if (done_ctr) dn = xb_ld(done_ctr); }
        cvt_store_strip(d0, a0, b0, lds, tid, false);
        cvt_store_strip(d1, a1, b1, lds + 33792, tid, false);
        LDS_BARRIER();
        cvt_store_strip(d0, a0, b0, lds, tid, true);
        cvt_store_strip(d1, a1, b1, lds + 33792, tid, true);
        if (tid == 0) {
            int sv = -1;
            if (!lastone && c < (unsigned)CV_TOTAL) { const bool fin = done_ctr ? (dn >= need_done) : (c >= (unsigned)limit); sv = (int)c | (fin ? CV_LAST : 0); }
            slot[0] = sv;
        }
        LDS_BARRIER();
    }
    __syncthreads();
}
__device__ __forceinline__ void tail_pull(const Params& p, LAS unsigned char* lds, int ctr_idx) {
    unsigned* ctr = (unsigned*)(p.ws + WS_CVTQ) + 64 * (1 + ctr_idx);
    __syncthreads();
    if (threadIdx.x == 0) (void)xb_add(ctr, 1u);
    cvt_pull(p, lds, 0, ctr, gridDim.x);
}

__device__ __forceinline__ void ada_chunks(const Params& p, LAS unsigned char* lds, int ch0, int ch_end, int step) {
    int tid = threadIdx.x; asm volatile("" : "+v"(tid));
    unsigned char* ws = p.ws;
    LAS float* cond = (LAS float*)lds;
    LAS float* red = (LAS float*)(lds + 32768);
    if (ch0 >= ch_end) return;
    for (int i = tid; i < 4 * D; i += 512) { const float v = p.c[i]; cond[i] = siluf_(v); }
    __syncthreads();
    for (int ch = ch0; ch < ch_end; ch += step) {
        const int l = ch >> 7, j0 = (ch & 127) * 96;
        const float* w = p.w_ada + (size_t)l * D * (6 * D);
        const int kg = tid / 24, cl = tid % 24;
        float acc[4][4];
#pragma unroll
        for (int b = 0; b < 4; ++b)
#pragma unroll
            for (int j = 0; j < 4; ++j) acc[b][j] = 0.f;
        if (kg < 21) {
            for (int it0 = 0; it0 < 98; it0 += 14) {
                float4 wv[14];
#pragma unroll
                for (int q = 0; q < 14; ++q) { const int k = kg + 21 * (it0 + q); wv[q] = (k < D) ? *(const float4*)(w + (size_t)k * (6 * D) + j0 + cl * 4) : make_float4(0.f, 0.f, 0.f, 0.f); }
#pragma unroll
                for (int q = 0; q < 14; ++q) { const int k = kg + 21 * (it0 + q); const int kc = k < D ? k : 0;
#pragma unroll
                    for (int b = 0; b < 4; ++b) { const float cv = cond[b * D + kc]; acc[b][0] += cv * wv[q].x; acc[b][1] += cv * wv[q].y; acc[b][2] += cv * wv[q].z; acc[b][3] += cv * wv[q].w; } }
            }
#pragma unroll
            for (int b = 0; b < 4; ++b)
#pragma unroll
                for (int j = 0; j < 4; ++j) red[(kg * 4 + b) * 96 + cl * 4 + j] = acc[b][j];
        }
        __syncthreads();
        if (tid < 384) {
            const int b = tid / 96, col = tid % 96; float s = 0.f;
            for (int g = 0; g < 21; ++g) s += red[(g * 4 + b) * 96 + col];
            float* mod = (float*)(ws + WS_MOD);
            mod[((size_t)l * 4 + b) * (6 * D) + j0 + col] = s + p.b_ada[(size_t)l * 6 * D + j0 + col];
        }
        __syncthreads();
    }
}
__device__ __forceinline__ void phase_prologue(const Params& p, LAS unsigned char* lds) {
    const bool svc = (gridDim.x >= 256);
    ada_chunks(p, lds, blockIdx.x, svc ? 128 : 256, gridDim.x);
    cvt_pull(p, lds, CV_A0, nullptr, 0u);
}

#define COLK(k) ((((k) >> 1) << 9) + lane * 8 + (((k) & 1) << 2))
#define COL8(i) (((i) << 9) + lane * 8)
__device__ __forceinline__ void ld_bf8(const bf16_t* p, float4& a, float4& b) {
    const u32x4 r = *(const u32x4*)p;
    a = make_float4(bf2f(r[0] & 0xffffu), bf2f(r[0] >> 16), bf2f(r[1] & 0xffffu), bf2f(r[1] >> 16));
    b = make_float4(bf2f(r[2] & 0xffffu), bf2f(r[2] >> 16), bf2f(r[3] & 0xffffu), bf2f(r[3] >> 16));
}
__device__ __forceinline__ void st_bf8(bf16_t* p, const float4& a, const float4& b) {
    u32x4 o; o[0] = pack2a(a.x, a.y); o[1] = pack2a(a.z, a.w); o[2] = pack2a(b.x, b.y); o[3] = pack2a(b.z, b.w);
    *(u32x4*)p = o;
}
__device__ __forceinline__ void st_fp8x8(unsigned char* p, const float4& a, const float4& b) {
    int o0 = __builtin_amdgcn_cvt_pk_fp8_f32(a.x, a.y, 0, false); o0 = __builtin_amdgcn_cvt_pk_fp8_f32(a.z, a.w, o0, true);
    int o1 = __builtin_amdgcn_cvt_pk_fp8_f32(b.x, b.y, 0, false); o1 = __builtin_amdgcn_cvt_pk_fp8_f32(b.z, b.w, o1, true);
    u32x2 o; o[0] = (unsigned)o0; o[1] = (unsigned)o1;
    *(u32x2*)p = o;
}
__device__ __forceinline__ void ln_rows(float4 (&v)[8], const float* __restrict__ g, const float* __restrict__ b, int lane) {
    float s = 0.f;
#pragma unroll
    for (int i = 0; i < 8; ++i) s += (v[i].x + v[i].y) + (v[i].z + v[i].w);
    const float mean = wave_sum(s) * (1.0f / D);
    float q = 0.f;
#pragma unroll
    for (int i = 0; i < 8; ++i) { const float a = v[i].x - mean, bb = v[i].y - mean, c = v[i].z - mean, d = v[i].w - mean; q += (a * a + bb * bb) + (c * c + d * d); }
    const float rstd = rsqrtf(wave_sum(q) * (1.0f / D) + 1e-5f);
#pragma unroll
    for (int i = 0; i < 8; ++i) {
        const float4 gv = *(const float4*)(g + COLK(i)), bv = *(const float4*)(b + COLK(i));
        v[i].x = (v[i].x - mean) * rstd * gv.x + bv.x; v[i].y = (v[i].y - mean) * rstd * gv.y + bv.y;
        v[i].z = (v[i].z - mean) * rstd * gv.z + bv.z; v[i].w = (v[i].w - mean) * rstd * gv.w + bv.w;
    }
}
__device__ __forceinline__ void modulate_store(const float4 (&v)[8], const float* __restrict__ shift, const float* __restrict__ scale, bf16_t* __restrict__ dst, int lane, bool fp8) {
#pragma unroll
    for (int i = 0; i < 4; ++i) {
        float4 h[2];
#pragma unroll
        for (int q = 0; q < 2; ++q) {
            const float4 sh = *(const float4*)(shift + COLK(2 * i + q)), sc = *(const float4*)(scale + COLK(2 * i + q));
            const float4 x = v[2 * i + q];
            h[q] = make_float4(x.x * (1.f + sc.x) + sh.x, x.y * (1.f + sc.y) + sh.y, x.z * (1.f + sc.z) + sh.z, x.w * (1.f + sc.w) + sh.w);
        }
        if (fp8) st_fp8x8((unsigned char*)dst + COL8(i), h[0], h[1]);
        else st_bf8(dst + COL8(i), h[0], h[1]);
    }
}

__device__ __forceinline__ void phase_ln0(const Params& p) {
    int tid_ = threadIdx.x; asm volatile("" : "+v"(tid_)); const int wave = tid_ >> 6, lane = tid_ & 63;
    const float* mod = (const float*)(p.ws + WS_MOD);
    for (int n = blockIdx.x * 8 + wave; n < T; n += gridDim.x * 8) {
        const int b = n / SEQ;
        float4 v[8];
#pragma unroll
        for (int i = 0; i < 8; ++i) v[i] = *(const float4*)(p.x + (size_t)n * D + COLK(i));
        ln_rows(v, p.emb_g, p.emb_b, lane);
        bf16_t* xr = (bf16_t*)(p.ws + WS_XRES) + (size_t)n * D;
#pragma unroll
        for (int i = 0; i < 4; ++i) st_bf8(xr + COL8(i), v[2 * i], v[2 * i + 1]);
        const float* mb = mod + ((size_t)0 * 4 + b) * (6 * D);
        modulate_store(v, mb, mb + D, INP8(0) ? (bf16_t*)(p.ws + WS_HA + (size_t)n * D) : (bf16_t*)(p.ws + WS_HA) + (size_t)n * D, lane, INP8(0));
    }
}

__device__ __forceinline__ void phase_mixer_valu(const Params& p, int l, LAS unsigned char* lds) {
    LAS float* qs = (LAS float*)lds; LAS float* ks = qs + 4096; LAS float* fs = ks + 4096; LAS float* vs = fs + 4096; LAS float* po = vs + 1024;
    int tid = threadIdx.x; asm volatile("" : "+v"(tid)); const int wave = tid >> 6, lane = tid & 63, kk = tid >> 5, vv = tid & 31;
    const bf16_t* proj = (const bf16_t*)(p.ws + WS_PROJ);
    float* obuf = (float*)(p.ws + WS_OBUF);
    for (int u = blockIdx.x; u < 384; u += gridDim.x) {
        const int vsl = u & 3, dir = (u >> 2) & 1, hh = (u >> 3) % 6, b = ((u >> 3) / 6) % 4, type = (u >> 3) / 24;
        float S[8];
#pragma unroll
        for (int j = 0; j < 8; ++j) S[j] = 0.f;
        const float gamma = 1.0f - exp2f(-(dir ? 5.5f : 5.0f) - (float)hh);
        for (int blk = 0; blk < 64; ++blk) {
            const int rb = dir ? 63 - blk : blk, t0 = rb * 32;
            if (type == 0) {
#pragma unroll
                for (int j = 0; j < 4; ++j) {
                    const int idx = tid + 512 * j, tt = idx >> 6, dp = idx & 63;
                    const bf16_t* row = proj + (size_t)(b * SEQ + t0 + tt) * INC;
                    const float q1 = bf2f(row[C_RQ + hh * 128 + dp]), q2 = bf2f(row[C_RQ + hh * 128 + 64 + dp]);
                    const float k1 = bf2f(row[C_RK + hh * 128 + dp]), k2 = bf2f(row[C_RK + hh * 128 + 64 + dp]);
                    const float inv_freq = exp2f(-(float)dp * (13.287712379549449f / 64.0f));
                    const float ang = (float)(t0 + tt) * inv_freq;
                    float rev = ang * 0.15915494309189535f; rev -= rintf(rev);
                    const float sn = __builtin_amdgcn_sinf(rev), cs = __builtin_amdgcn_cosf(rev);
                    qs[tt * 128 + dp] = q1 * cs - q2 * sn; qs[tt * 128 + 64 + dp] = q1 * sn + q2 * cs;
                    ks[tt * 128 + dp] = (k1 * cs - k2 * sn) * 0.08838834764831845f; ks[tt * 128 + 64 + dp] = (k1 * sn + k2 * cs) * 0.08838834764831845f;
                    fs[tt * 128 + dp] = gamma; fs[tt * 128 + 64 + dp] = gamma;
                }
            } else {
#pragma unroll
                for (int j = 0; j < 8; ++j) {
                    const int idx = tid + 512 * j, tt = idx >> 7, d = idx & 127;
                    const bf16_t* row = proj + (size_t)(b * SEQ + t0 + tt) * INC;
                    const float q = bf2f(row[C_HQ + hh * 128 + d]);
                    const float z = bf2f(row[(dir ? C_HFB : C_HFF) + hh * 128 + d]);
                    float lb = 0.f;
                    if (l > 0) { const float a0 = p.lb_logits[(0 * 2 + dir) * HWD + hh * 128 + d], a1 = p.lb_logits[(1 * 2 + dir) * HWD + hh * 128 + d]; lb = 1.0f / (1.0f + expf(a0 - a1)); }
                    float f = lb + (1.0f - lb) * (1.0f / (1.0f + expf(-z)));
                    f = fmaxf(f, 1e-6f);
                    qs[tt * 128 + d] = q; ks[tt * 128 + d] = 1.0f - f; fs[tt * 128 + d] = f;
                }
            }
#pragma unroll
            for (int j = 0; j < 2; ++j) {
                const int idx = tid + 512 * j, tt = idx >> 5, c = idx & 31;
                const bf16_t* row = proj + (size_t)(b * SEQ + t0 + tt) * INC;
                vs[tt * 32 + c] = bf2f(row[(type ? C_HI : C_RV) + hh * 128 + vsl * 32 + c]);
            }
            __syncthreads();
            for (int s = 0; s < 32; ++s) {
                const int ss = dir ? 31 - s : s;
                const f32x4 qa = *(const LAS f32x4*)(qs + ss * 128 + kk * 8), qb = *(const LAS f32x4*)(qs + ss * 128 + kk * 8 + 4);
                const f32x4 ka = *(const LAS f32x4*)(ks + ss * 128 + kk * 8), kb = *(const LAS f32x4*)(ks + ss * 128 + kk * 8 + 4);
                const f32x4 fa = *(const LAS f32x4*)(fs + ss * 128 + kk * 8), fb = *(const LAS f32x4*)(fs + ss * 128 + kk * 8 + 4);
                const float vval = vs[ss * 32 + vv];
                float acc = 0.f;
#pragma unroll
                for (int j = 0; j < 4; ++j) { S[j] = fa[j] * S[j] + ka[j] * vval; acc += S[j] * qa[j]; }
#pragma unroll
                for (int j = 0; j < 4; ++j) { S[4 + j] = fb[j] * S[4 + j] + kb[j] * vval; acc += S[4 + j] * qb[j]; }
                acc += __shfl_xor(acc, 32, 64);
                if (lane < 32) po[(ss * 8 + wave) * 32 + vv] = acc;
            }
            __syncthreads();
#pragma unroll
            for (int j = 0; j < 2; ++j) {
                const int idx = tid + 512 * j, tt = idx >> 5, c = idx & 31;
                float s = 0.f;
#pragma unroll
                for (int w = 0; w < 8; ++w) s += po[(tt * 8 + w) * 32 + c];
                obuf[((size_t)dir * T + (size_t)(b * SEQ + t0 + tt)) * 1536 + type * 768 + hh * 128 + vsl * 32 + c] = s;
            }
        }
        __syncthreads();
    }
}

constexpr int MX_QI = 0, MX_KI = 17408, MX_QS = 34816, MX_KTT = 52224, MX_VT = 70656, MX_P = 79872, MX_ST = 89088, MX_TOT = 106496, MX_DEC = 110592, MX_RQ = 112128, MX_RK = 128512, MX_RV = 144896;
__device__ __forceinline__ float ex2(float x) { return __builtin_amdgcn_exp2f(x); }
__device__ __forceinline__ float clampe(float x) { return fminf(fmaxf(x, -120.f), 120.f); }
template <int MODE>
__device__ __forceinline__ void phase_mixer_mfma(const Params& p, int l, LAS unsigned char* lds, float* __restrict__ obuf) {
    int tid = threadIdx.x; asm volatile("" : "+v"(tid));
    const int wave = __builtin_amdgcn_readfirstlane(tid >> 6), lane = tid & 63, fr = lane & 15, fq = lane >> 4;
    const bf16_t* proj = (const bf16_t*)(p.ws + WS_PROJ);
    for (int u = blockIdx.x; u < 192; u += gridDim.x) {
        const int vsl = u & 1, dir = (u >> 1) & 1, hh = (u >> 2) % 6, b = ((u >> 2) / 6) % 4, type = (u >> 2) / 24;
        float lg2 = 0.f, invf0 = 0.f, invf1 = 0.f, sgn = 1.f, lb0 = 0.f, lb1 = 0.f;
        if (type == 0) {
            const float gamma = 1.0f - exp2f(-(dir ? 5.5f : 5.0f) - (float)hh);
            lg2 = log2f(gamma);
            const int dm0 = (2 * lane) & 63;
            invf0 = exp2f(-(float)dm0 * (13.287712379549449f / 64.0f)); invf1 = exp2f(-(float)(dm0 + 1) * (13.287712379549449f / 64.0f));
            sgn = lane < 32 ? -1.f : 1.f;
        } else if (l > 0) {
            const float* lbl = p.lb_logits + dir * HWD + hh * 128 + 2 * lane;
            lb0 = 1.0f / (1.0f + expf(lbl[0] - lbl[2 * HWD])); lb1 = 1.0f / (1.0f + expf(lbl[1] - lbl[2 * HWD + 1]));
        }
        const int colA = (type ? C_HQ : C_RQ) + hh * 128, colB = (type ? (dir ? C_HFB : C_HFF) : C_RK) + hh * 128;
        const int colV0 = (type ? C_HI : C_RV) + hh * 128 + vsl * 64;
        const int own = 2 * lane, par = (2 * lane + 64) & 127;
        const size_t ocol = (size_t)type * 768 + hh * 128 + vsl * 64;
#define MX_LOAD(ch) do { \
            _Pragma("unroll") for (int i2 = 0; i2 < 2; ++i2) { const int pos = wave * 8 + i2 * 4 + (lane >> 4); const int tau = (ch) * 64 + pos; const int t = dir ? (SEQ - 1 - tau) : tau; \
                const bf16_t* row = proj + (size_t)(b * SEQ + t) * INC + (lane & 15) * 8; \
                __builtin_amdgcn_global_load_lds((const unsigned*)(row + colA), (LAS unsigned*)(lds + MX_RQ + (wave * 8 + i2 * 4) * 256), 16, 0, 0); \
                __builtin_amdgcn_global_load_lds((const unsigned*)(row + colB), (LAS unsigned*)(lds + MX_RK + (wave * 8 + i2 * 4) * 256), 16, 0, 0); } \
            { const int pos = wave * 8 + (lane >> 3); const int tau = (ch) * 64 + pos; const int t = dir ? (SEQ - 1 - tau) : tau; \
              const bf16_t* row = proj + (size_t)(b * SEQ + t) * INC + colV0 + (lane & 7) * 8; \
              __builtin_amdgcn_global_load_lds((const unsigned*)row, (LAS unsigned*)(lds + MX_RV + (wave * 8) * 128), 16, 0, 0); } } while (0)
        f32x4 Sacc[4];
#pragma unroll
        for (int vt = 0; vt < 4; ++vt) Sacc[vt] = (f32x4){0.f, 0.f, 0.f, 0.f};
        for (int i = tid; i < 64 * 272 / 4; i += 512) ((LAS unsigned*)(lds + MX_ST))[i] = 0u;
        float cd0 = 1.f, sd0 = 0.f, cd1 = 1.f, sd1 = 0.f;
        if (type == 0) {
            if (tid < 64) { const float fi = (float)tid; *(LAS f32x4*)(lds + MX_DEC + 512 + tid * 16) = (f32x4){ex2((fi - 31.f) * lg2), ex2((31.f - fi) * lg2), ex2((fi + 1.f) * lg2), ex2((63.f - fi) * lg2)}; }
            const float r0 = invf0 * 0.15915494309189535f, r1 = invf1 * 0.15915494309189535f, sg = dir ? -1.f : 1.f;
            cd0 = __builtin_amdgcn_cosf(r0); sd0 = sg * __builtin_amdgcn_sinf(r0); cd1 = __builtin_amdgcn_cosf(r1); sd1 = sg * __builtin_amdgcn_sinf(r1);
        }
        __syncthreads();
        MX_LOAD(0);
        asm volatile("s_waitcnt vmcnt(0)" ::: "memory");
        __syncthreads();
        for (int ch = 0; ch < 32; ++ch) {
            float q0[8], q1[8], k0[8], k1[8], c0[8], c1[8];
            float run0 = 0.f, run1 = 0.f;
            u32x4 vpk = (u32x4){0u, 0u, 0u, 0u};
#pragma unroll
            for (int j = 0; j < 8; ++j) { q0[j] = q1[j] = k0[j] = k1[j] = c0[j] = c1[j] = 0.f; }
            if (MODE != 3 && MODE != 4) {
            if (type == 0) {
                const int tau0 = ch * 64 + wave * 8; const int t0 = dir ? (SEQ - 1 - tau0) : tau0;
                float rev0 = (float)t0 * invf0 * 0.15915494309189535f, rev1 = (float)t0 * invf1 * 0.15915494309189535f;
                rev0 -= rintf(rev0); rev1 -= rintf(rev1);
                float sn0 = __builtin_amdgcn_sinf(rev0), cs0 = __builtin_amdgcn_cosf(rev0), sn1 = __builtin_amdgcn_sinf(rev1), cs1 = __builtin_amdgcn_cosf(rev1);
#pragma unroll
                for (int j = 0; j < 8; ++j) {
                    const int pos_ = wave * 8 + j;
                    const unsigned ra_ = *(const LAS unsigned*)(lds + MX_RQ + pos_ * 256 + own * 2), rb_ = *(const LAS unsigned*)(lds + MX_RK + pos_ * 256 + own * 2);
                    const unsigned rc_ = *(const LAS unsigned*)(lds + MX_RQ + pos_ * 256 + par * 2), rd_ = *(const LAS unsigned*)(lds + MX_RK + pos_ * 256 + par * 2);
                    const float a_lo = bf2f(ra_ & 0xffffu), a_hi = bf2f(ra_ >> 16), b_lo = bf2f(rb_ & 0xffffu), b_hi = bf2f(rb_ >> 16);
                    const float pa_lo = bf2f(rc_ & 0xffffu), pa_hi = bf2f(rc_ >> 16), pb_lo = bf2f(rd_ & 0xffffu), pb_hi = bf2f(rd_ >> 16);
                    const float ss0 = sgn * sn0, ss1 = sgn * sn1;
                    q0[j] = a_lo * cs0 + pa_lo * ss0; q1[j] = a_hi * cs1 + pa_hi * ss1;
                    k0[j] = (b_lo * cs0 + pb_lo * ss0) * 0.08838834764831845f; k1[j] = (b_hi * cs1 + pb_hi * ss1) * 0.08838834764831845f;
                    const float nc0 = cs0 * cd0 - sn0 * sd0, ns0 = sn0 * cd0 + cs0 * sd0, nc1 = cs1 * cd1 - sn1 * sd1, ns1 = sn1 * cd1 + cs1 * sd1;
                    cs0 = nc0; sn0 = ns0; cs1 = nc1; sn1 = ns1;
                    c0[j] = 0.f; c1[j] = 0.f;
                }
            } else {
#pragma unroll
                for (int j = 0; j < 8; ++j) {
                    const int pos_ = wave * 8 + j;
                    const unsigned ra_ = *(const LAS unsigned*)(lds + MX_RQ + pos_ * 256 + own * 2), rb_ = *(const LAS unsigned*)(lds + MX_RK + pos_ * 256 + own * 2);
                    const float a_lo = bf2f(ra_ & 0xffffu), a_hi = bf2f(ra_ >> 16), b_lo = bf2f(rb_ & 0xffffu), b_hi = bf2f(rb_ >> 16);
                    q0[j] = a_lo; q1[j] = a_hi;
                    float f0 = lb0 + (1.0f - lb0) * __builtin_amdgcn_rcpf(1.0f + ex2(-b_lo * 1.4426950408889634f));
                    float f1 = lb1 + (1.0f - lb1) * __builtin_amdgcn_rcpf(1.0f + ex2(-b_hi * 1.4426950408889634f));
                    f0 = fmaxf(f0, 1e-6f); f1 = fmaxf(f1, 1e-6f);
                    k0[j] = 1.0f - f0; k1[j] = 1.0f - f1;
                    run0 += __builtin_amdgcn_logf(f0); run1 += __builtin_amdgcn_logf(f1); c0[j] = run0; c1[j] = run1;
                }
            }
            { unsigned rv[8];
#pragma unroll
              for (int j = 0; j < 8; ++j) rv[j] = *(const LAS unsigned short*)(lds + MX_RV + (wave * 8 + j) * 128 + lane * 2);
              vpk[0] = rv[0] | (rv[1] << 16); vpk[1] = rv[2] | (rv[3] << 16); vpk[2] = rv[4] | (rv[5] << 16); vpk[3] = rv[6] | (rv[7] << 16); }
            }
            { typedef float f32x2_ __attribute__((ext_vector_type(2))); *(LAS f32x2_*)(lds + MX_TOT + (wave * 128 + 2 * lane) * 4) = (f32x2_){run0, run1}; }
            LDS_BARRIER();
            if (ch + 1 < 32) MX_LOAD(ch + 1);
            float kt0[8], kt1[8];
            float tt0, tt1;
#pragma unroll
            for (int j = 0; j < 8; ++j) { kt0[j] = kt1[j] = 0.f; }
            tt0 = tt1 = 0.f;
            if (MODE != 3 && MODE != 4) {
            if (type == 0) {
                tt0 = tt1 = 64.f * lg2;
#pragma unroll
                for (int j = 0; j < 8; ++j) {
                    const int pos = wave * 8 + j;
                    const f32x4 e = *(const LAS f32x4*)(lds + MX_DEC + 512 + pos * 16);
                    *(LAS unsigned*)(lds + MX_QI + pos * 272 + lane * 4) = pack2(q0[j] * e[0], q1[j] * e[0]);
                    *(LAS unsigned*)(lds + MX_KI + pos * 272 + lane * 4) = pack2(k0[j] * e[1], k1[j] * e[1]);
                    kt0[j] = k0[j] * e[3]; kt1[j] = k1[j] * e[3];
                }
            } else {
                float off0 = 0.f, off1 = 0.f, m0 = 0.f, m1 = 0.f; tt0 = 0.f; tt1 = 0.f;
#pragma unroll
                for (int g = 0; g < 8; ++g) {
                    typedef float f32x2_ __attribute__((ext_vector_type(2)));
                    const f32x2_ tv = *(const LAS f32x2_*)(lds + MX_TOT + (g * 128 + 2 * lane) * 4);
                    if (g < wave) { off0 += tv[0]; off1 += tv[1]; }
                    if (g < 4) { m0 += tv[0]; m1 += tv[1]; }
                    tt0 += tv[0]; tt1 += tv[1];
                }
                const float etm0 = ex2(tt0 - m0), etm1 = ex2(tt1 - m1);
#pragma unroll
                for (int j = 0; j < 8; ++j) {
                    const float cu0 = c0[j] + off0, cu1 = c1[j] + off1;
                    const float e10 = ex2(clampe(cu0 - m0)), e11 = ex2(clampe(cu1 - m1));
                    const float e20 = __builtin_amdgcn_rcpf(e10), e21 = __builtin_amdgcn_rcpf(e11);
                    const int pos = wave * 8 + j;
                    *(LAS unsigned*)(lds + MX_QI + pos * 272 + lane * 4) = pack2(q0[j] * e10, q1[j] * e11);
                    *(LAS unsigned*)(lds + MX_KI + pos * 272 + lane * 4) = pack2(k0[j] * e20, k1[j] * e21);
                    kt0[j] = k0[j] * (e20 * etm0); kt1[j] = k1[j] * (e21 * etm1);
                }
            }
            }
            { u32x4 w0, w1;
              w0[0] = pack2(kt0[0], kt0[1]); w0[1] = pack2(kt0[2], kt0[3]); w0[2] = pack2(kt0[4], kt0[5]); w0[3] = pack2(kt0[6], kt0[7]);
              w1[0] = pack2(kt1[0], kt1[1]); w1[1] = pack2(kt1[2], kt1[3]); w1[2] = pack2(kt1[4], kt1[5]); w1[3] = pack2(kt1[6], kt1[7]);
              *(LAS u32x4*)(lds + MX_KTT + (2 * lane) * 144 + wave * 16) = w0;
              *(LAS u32x4*)(lds + MX_KTT + (2 * lane + 1) * 144 + wave * 16) = w1;
              *(LAS u32x4*)(lds + MX_VT + lane * 144 + wave * 16) = vpk; }
            if (MODE != 3 && MODE != 4) {
                f32x4 em;
                if (type == 0) { const float e_ = ex2(32.f * lg2); em = (f32x4){e_, e_, e_, e_}; }
                else {
                    f32x4 ms = (f32x4){0.f, 0.f, 0.f, 0.f};
#pragma unroll
                    for (int g = 0; g < 4; ++g) ms += *(const LAS f32x4*)(lds + MX_TOT + (g * 128 + 16 * wave + 4 * fq) * 4);
                    em = (f32x4){ex2(ms[0]), ex2(ms[1]), ex2(ms[2]), ex2(ms[3])};
                }
#pragma unroll
                for (int vt = 0; vt < 4; ++vt) { u32x2 o; o[0] = pack2(Sacc[vt][0] * em[0], Sacc[vt][1] * em[1]); o[1] = pack2(Sacc[vt][2] * em[2], Sacc[vt][3] * em[3]);
                    *(LAS u32x2*)(lds + MX_ST + (16 * vt + fr) * 272 + (16 * wave + 4 * fq) * 2) = o; }
            }
            if (wave == 0) { typedef float f32x2_ __attribute__((ext_vector_type(2))); *(LAS f32x2_*)(lds + MX_DEC + lane * 8) = (f32x2_){ex2(tt0), ex2(tt1)}; }
            LDS_BARRIER();
            if (MODE != 2 && MODE != 4) {
                const int it = wave >> 1, st0 = 2 * (wave & 1);
                bf16x8 ka[2][4], qb[4];
#pragma unroll
                for (int kq = 0; kq < 4; ++kq) {
                    qb[kq] = *(const LAS bf16x8*)(lds + MX_QI + (16 * it + fr) * 272 + (32 * kq + 8 * fq) * 2);
                    ka[0][kq] = *(const LAS bf16x8*)(lds + MX_KI + (16 * st0 + fr) * 272 + (32 * kq + 8 * fq) * 2);
                    ka[1][kq] = *(const LAS bf16x8*)(lds + MX_KI + (16 * st0 + 16 + fr) * 272 + (32 * kq + 8 * fq) * 2);
                }
                asm volatile("s_waitcnt lgkmcnt(0)" ::: "memory");
                f32x4 acc0 = (f32x4){0.f, 0.f, 0.f, 0.f}, acc1 = acc0;
#pragma unroll
                for (int kq = 0; kq < 4; ++kq) {
                    acc0 = __builtin_amdgcn_mfma_f32_16x16x32_bf16(ka[0][kq], qb[kq], acc0, 0, 0, 0);
                    acc1 = __builtin_amdgcn_mfma_f32_16x16x32_bf16(ka[1][kq], qb[kq], acc1, 0, 0, 0);
                }
                const int i = 16 * it + fr;
                { const int s0 = 16 * st0 + 4 * fq;
                  const float v0 = (s0 + 0 <= i) ? acc0[0] : 0.f, v1 = (s0 + 1 <= i) ? acc0[1] : 0.f, v2 = (s0 + 2 <= i) ? acc0[2] : 0.f, v3 = (s0 + 3 <= i) ? acc0[3] : 0.f;
                  u32x2 o; o[0] = pack2(v0, v1); o[1] = pack2(v2, v3);
                  *(LAS u32x2*)(lds + MX_P + i * 144 + s0 * 2) = o; }
                { const int s0 = 16 * st0 + 16 + 4 * fq;
                  const float v0 = (s0 + 0 <= i) ? acc1[0] : 0.f, v1 = (s0 + 1 <= i) ? acc1[1] : 0.f, v2 = (s0 + 2 <= i) ? acc1[2] : 0.f, v3 = (s0 + 3 <= i) ? acc1[3] : 0.f;
                  u32x2 o; o[0] = pack2(v0, v1); o[1] = pack2(v2, v3);
                  *(LAS u32x2*)(lds + MX_P + i * 144 + s0 * 2) = o; }
            }
            LDS_BARRIER();
            if (MODE != 2 && MODE != 4) {
                const int vt = wave >> 1, it0 = 2 * (wave & 1);
                bf16x8 va[2], sa[4], pb[2][2], qsb[2][4], kta[2], vb[4][2];
#pragma unroll
                for (int kq = 0; kq < 2; ++kq) {
                    va[kq] = *(const LAS bf16x8*)(lds + MX_VT + (16 * vt + fr) * 144 + (32 * kq + 8 * fq) * 2);
                    pb[0][kq] = *(const LAS bf16x8*)(lds + MX_P + (16 * it0 + fr) * 144 + (32 * kq + 8 * fq) * 2);
                    pb[1][kq] = *(const LAS bf16x8*)(lds + MX_P + (16 * it0 + 16 + fr) * 144 + (32 * kq + 8 * fq) * 2);
                    kta[kq] = *(const LAS bf16x8*)(lds + MX_KTT + (16 * wave + fr) * 144 + (32 * kq + 8 * fq) * 2);
                }
#pragma unroll
                for (int kq = 0; kq < 4; ++kq) {
                    sa[kq] = *(const LAS bf16x8*)(lds + MX_ST + (16 * vt + fr) * 272 + (32 * kq + 8 * fq) * 2);
                    qsb[0][kq] = *(const LAS bf16x8*)(lds + MX_QI + (16 * it0 + fr) * 272 + (32 * kq + 8 * fq) * 2);
                    qsb[1][kq] = *(const LAS bf16x8*)(lds + MX_QI + (16 * it0 + 16 + fr) * 272 + (32 * kq + 8 * fq) * 2);
                }
#pragma unroll
                for (int v4 = 0; v4 < 4; ++v4)
#pragma unroll
                    for (int kq = 0; kq < 2; ++kq) vb[v4][kq] = *(const LAS bf16x8*)(lds + MX_VT + (16 * v4 + fr) * 144 + (32 * kq + 8 * fq) * 2);
                const f32x4 dc = *(const LAS f32x4*)(lds + MX_DEC + (16 * wave + 4 * fq) * 4);
                asm volatile("s_waitcnt lgkmcnt(0)" ::: "memory");
                f32x4 acc0 = (f32x4){0.f, 0.f, 0.f, 0.f}, acc1 = acc0;
#pragma unroll
                for (int kq = 0; kq < 2; ++kq) {
                    acc0 = __builtin_amdgcn_mfma_f32_16x16x32_bf16(va[kq], pb[0][kq], acc0, 0, 0, 0);
                    acc1 = __builtin_amdgcn_mfma_f32_16x16x32_bf16(va[kq], pb[1][kq], acc1, 0, 0, 0);
                }
#pragma unroll
                for (int kq = 0; kq < 4; ++kq) {
                    acc0 = __builtin_amdgcn_mfma_f32_16x16x32_bf16(sa[kq], qsb[0][kq], acc0, 0, 0, 0);
                    acc1 = __builtin_amdgcn_mfma_f32_16x16x32_bf16(sa[kq], qsb[1][kq], acc1, 0, 0, 0);
                }
#pragma unroll
                for (int v4 = 0; v4 < 4; ++v4) {
                    f32x4 a = Sacc[v4]; a[0] *= dc[0]; a[1] *= dc[1]; a[2] *= dc[2]; a[3] *= dc[3];
                    a = __builtin_amdgcn_mfma_f32_16x16x32_bf16(kta[0], vb[v4][0], a, 0, 0, 0);
                    a = __builtin_amdgcn_mfma_f32_16x16x32_bf16(kta[1], vb[v4][1], a, 0, 0, 0);
                    Sacc[v4] = a;
                }
                asm volatile("s_waitcnt vmcnt(0)" ::: "memory");
                { const int tau = ch * 64 + 16 * it0 + fr; const int t = dir ? (SEQ - 1 - tau) : tau;
                  u32x2 o; o[0] = pack2(acc0[0], acc0[1]); o[1] = pack2(acc0[2], acc0[3]);
                  *(u32x2*)((bf16_t*)obuf + ((size_t)dir * T + (size_t)(b * SEQ + t)) * 1536 + ocol + 16 * vt + 4 * fq) = o; }
                { const int tau = ch * 64 + 16 * it0 + 16 + fr; const int t = dir ? (SEQ - 1 - tau) : tau;
                  u32x2 o; o[0] = pack2(acc1[0], acc1[1]); o[1] = pack2(acc1[2], acc1[3]);
                  *(u32x2*)((bf16_t*)obuf + ((size_t)dir * T + (size_t)(b * SEQ + t)) * 1536 + ocol + 16 * vt + 4 * fq) = o; }
            }
        }
        __syncthreads();
#undef MX_LOAD
    }
}

#ifdef MIXER_CHECK
__device__ __forceinline__ void phase_mixer_check(const Params& p, const float* __restrict__ oa, const float* __restrict__ ob, float* chk) {
    int tid_ = threadIdx.x; asm volatile("" : "+v"(tid_)); const int wave = tid_ >> 6, lane = tid_ & 63;
    for (int r = blockIdx.x * 8 + wave; r < 2 * T; r += gridDim.x * 8) {
        const int dir = r / T;
#pragma unroll
        for (int ty = 0; ty < 2; ++ty) {
            float sd = 0.f, sq = 0.f;
#pragma unroll
            for (int i = 0; i < 3; ++i) { const float4 a = *(const float4*)(oa + (size_t)r * 1536 + ty * 768 + i * 256 + lane * 4), bq = *(const float4*)(ob + (size_t)r * 1536 + ty * 768 + i * 256 + lane * 4);
                sd += (a.x - bq.x) * (a.x - bq.x) + (a.y - bq.y) * (a.y - bq.y) + (a.z - bq.z) * (a.z - bq.z) + (a.w - bq.w) * (a.w - bq.w);
                sq += a.x * a.x + a.y * a.y + a.z * a.z + a.w * a.w; }
            sd = wave_sum(sd); sq = wave_sum(sq);
            if (lane == 0) { atomicAdd(&chk[(ty * 2 + dir) * 2 + 0], sd); atomicAdd(&chk[(ty * 2 + dir) * 2 + 1], sq); }
        }
    }
}
#endif

__device__ __forceinline__ float4 ld_bf4(const bf16_t* p) { const u32x2 r = *(const u32x2*)p; return make_float4(bf2f(r[0] & 0xffffu), bf2f(r[0] >> 16), bf2f(r[1] & 0xffffu), bf2f(r[1] >> 16)); }
__device__ __forceinline__ float grp16_sum(float v) {
#pragma unroll
    for (int o = 8; o > 0; o >>= 1) v += __shfl_xor(v, o, 64);
    return v;
}
__device__ __forceinline__ void phase_finalize(const Params& p, int l) {
    int tid_ = threadIdx.x; asm volatile("" : "+v"(tid_)); const int wave = tid_ >> 6, lane = tid_ & 63;
    const bf16_t* proj = (const bf16_t*)(p.ws + WS_PROJ);
    const bf16_t* obuf = (const bf16_t*)(p.ws + WS_OBUF);
    bf16_t* mixed = (bf16_t*)(p.ws + WS_MIXED);
    const float* cw = p.conv_w + (size_t)l * 3 * CW;
    const float* beta = p.mix_beta + (size_t)l * D;
    for (int n = blockIdx.x * 8 + wave; n < T; n += gridDim.x * 8) {
        const int t = n % SEQ;
        const bf16_t* row = proj + (size_t)n * INC;
#pragma unroll
        for (int i = 0; i < 4; ++i) {
            const int c = COL8(i);
            float4 r[2];
            if (i == 0) {
                float4 cc[2], ch[2], cb[2], um[2], up[2];
                ld_bf8(row + C_CC + c, cc[0], cc[1]); ld_bf8(row + C_CH + c, ch[0], ch[1]); ld_bf8(row + C_CB + c, cb[0], cb[1]);
                um[0] = um[1] = up[0] = up[1] = make_float4(0.f, 0.f, 0.f, 0.f);
                if (t > 0) { float4 a[2], b2[2]; ld_bf8(row - INC + C_CC + c, a[0], a[1]); ld_bf8(row - INC + C_CH + c, b2[0], b2[1]);
#pragma unroll
                    for (int q = 0; q < 2; ++q) um[q] = make_float4(a[q].x * b2[q].x, a[q].y * b2[q].y, a[q].z * b2[q].z, a[q].w * b2[q].w); }
                if (t < SEQ - 1) { float4 a[2], b2[2]; ld_bf8(row + INC + C_CC + c, a[0], a[1]); ld_bf8(row + INC + C_CH + c, b2[0], b2[1]);
#pragma unroll
                    for (int q = 0; q < 2; ++q) up[q] = make_float4(a[q].x * b2[q].x, a[q].y * b2[q].y, a[q].z * b2[q].z, a[q].w * b2[q].w); }
#pragma unroll
                for (int q = 0; q < 2; ++q) {
                    const float4 w0 = *(const float4*)(cw + c + 4 * q), w1 = *(const float4*)(cw + CW + c + 4 * q), w2 = *(const float4*)(cw + 2 * CW + c + 4 * q);
                    r[q].x = cb[q].x * (um[q].x * w0.x + cc[q].x * ch[q].x * w1.x + up[q].x * w2.x);
                    r[q].y = cb[q].y * (um[q].y * w0.y + cc[q].y * ch[q].y * w1.y + up[q].y * w2.y);
                    r[q].z = cb[q].z * (um[q].z * w0.z + cc[q].z * ch[q].z * w1.z + up[q].z * w2.z);
                    r[q].w = cb[q].w * (um[q].w * w0.w + cc[q].w * ch[q].w * w1.w + up[q].w * w2.w);
                }
            } else {
                const int oc = c - 512;
                const bool isret = oc < 768;
                float4 of[2], ob[2], gt[2];
                ld_bf8(obuf + (size_t)n * 1536 + oc, of[0], of[1]); ld_bf8(obuf + ((size_t)T + n) * 1536 + oc, ob[0], ob[1]);
                ld_bf8(row + (isret ? C_RG + oc : C_HG + (oc - 768)), gt[0], gt[1]);
                float4 o[2];
#pragma unroll
                for (int q = 0; q < 2; ++q) o[q] = make_float4(of[q].x + ob[q].x, of[q].y + ob[q].y, of[q].z + ob[q].z, of[q].w + ob[q].w);
                const float sm = grp16_sum(((o[0].x + o[0].y) + (o[0].z + o[0].w)) + ((o[1].x + o[1].y) + (o[1].z + o[1].w)));
                const float mu = isret ? sm * (1.0f / 128.0f) : 0.f;
#pragma unroll
                for (int q = 0; q < 2; ++q) { o[q].x -= mu; o[q].y -= mu; o[q].z -= mu; o[q].w -= mu; }
                const float var = grp16_sum(((o[0].x * o[0].x + o[0].y * o[0].y) + (o[0].z * o[0].z + o[0].w * o[0].w)) + ((o[1].x * o[1].x + o[1].y * o[1].y) + (o[1].z * o[1].z + o[1].w * o[1].w))) * (1.0f / 128.0f);
                const float rs = rsqrtf(var + 1e-6f);
#pragma unroll
                for (int q = 0; q < 2; ++q) r[q] = make_float4(o[q].x * rs * siluf_(gt[q].x), o[q].y * rs * siluf_(gt[q].y), o[q].z * rs * siluf_(gt[q].z), o[q].w * rs * siluf_(gt[q].w));
            }
            const float4 bt0 = *(const float4*)(beta + c), bt1 = *(const float4*)(beta + c + 4);
            r[0] = make_float4(r[0].x * bt0.x, r[0].y * bt0.y, r[0].z * bt0.z, r[0].w * bt0.w);
            r[1] = make_float4(r[1].x * bt1.x, r[1].y * bt1.y, r[1].z * bt1.z, r[1].w * bt1.w);
            if (OUT8(l)) { const float4 a4 = make_float4(r[0].x * 4.f, r[0].y * 4.f, r[0].z * 4.f, r[0].w * 4.f), b4 = make_float4(r[1].x * 4.f, r[1].y * 4.f, r[1].z * 4.f, r[1].w * 4.f);
                           st_fp8x8((unsigned char*)mixed + (size_t)n * D + c, a4, b4); }
            else st_bf8(mixed + (size_t)n * D + c, r[0], r[1]);
        }
    }
}

#define RGRP 4
#if RGRP == 4
#define LN1_SB() __builtin_amdgcn_sched_barrier(0)
#else
#define LN1_SB()
#endif
__device__ __forceinline__ void phase_ln1_router(const Params& p, int l, LAS unsigned char* lds) {
    int tid = threadIdx.x; asm volatile("" : "+v"(tid)); const int wave = tid >> 6, lane = tid & 63;
    LAS float* wrt = (LAS float*)lds;
    for (int i = tid; i < D * NE / 4; i += 512) {
        const float4 w = *(const float4*)(p.w_router + (size_t)i * 4);
        const int d = i >> 2, e4 = (i & 3) * 4;
        const int dp = (((d >> 9) * 2 + ((d >> 2) & 1)) << 8) + (((d >> 3) & 63) << 2) + (d & 3);
        wrt[(e4 + 0) * D + dp] = w.x; wrt[(e4 + 1) * D + dp] = w.y; wrt[(e4 + 2) * D + dp] = w.z; wrt[(e4 + 3) * D + dp] = w.w;
    }
    LAS int* lcnt = (LAS int*)(lds + LDS_MISC + 256);
    if (tid < 16) lcnt[tid] = 0;
    __syncthreads();
    const float* mod = (const float*)(p.ws + WS_MOD);
    const float* y = (const float*)(p.ws + WS_Y);
    float* xres = (float*)(p.ws + WS_XRES);
    int* route = (int*)(p.ws + WS_ROUTE);
    for (int n0 = (blockIdx.x * 8 + wave) * RGRP; n0 < T; n0 += gridDim.x * 8 * RGRP) {
        float4 h[RGRP][8];
        {
            const int b = n0 / SEQ;
            const float* mb = mod + ((size_t)l * 4 + b) * (6 * D);
#pragma unroll
            for (int i = 0; i < 4; ++i) {
                float4 xv[RGRP][2], yv[RGRP][2];
#pragma unroll
                for (int r = 0; r < RGRP; ++r) { ld_bf8((const bf16_t*)xres + (size_t)(n0 + r) * D + COL8(i), xv[r][0], xv[r][1]); ld_bf8((const bf16_t*)y + (size_t)(n0 + r) * D + COL8(i), yv[r][0], yv[r][1]); }
#pragma unroll
                for (int q = 0; q < 2; ++q) {
                    const float4 g = *(const float4*)(mb + 2 * D + COLK(2 * i + q));
#pragma unroll
                    for (int r = 0; r < RGRP; ++r)
                        h[r][2 * i + q] = make_float4(ALPHA * xv[r][q].x + (1.f + g.x) * yv[r][q].x, ALPHA * xv[r][q].y + (1.f + g.y) * yv[r][q].y, ALPHA * xv[r][q].z + (1.f + g.z) * yv[r][q].z, ALPHA * xv[r][q].w + (1.f + g.w) * yv[r][q].w);
                }
                LN1_SB();
            }
            float mean[RGRP], rstd[RGRP];
#pragma unroll
            for (int r = 0; r < RGRP; ++r) {
                float s0 = 0.f;
#pragma unroll
                for (int i = 0; i < 8; ++i) s0 += (h[r][i].x + h[r][i].y) + (h[r][i].z + h[r][i].w);
                mean[r] = s0;
            }
#pragma unroll
            for (int o = 32; o > 0; o >>= 1)
#pragma unroll
                for (int r = 0; r < RGRP; ++r) mean[r] += __shfl_xor(mean[r], o, 64);
#pragma unroll
            for (int r = 0; r < RGRP; ++r) {
                mean[r] *= (1.0f / D);
                float q0 = 0.f;
#pragma unroll
                for (int i = 0; i < 8; ++i) { const float a = h[r][i].x - mean[r], bb = h[r][i].y - mean[r], c = h[r][i].z - mean[r], d = h[r][i].w - mean[r]; q0 += (a * a + bb * bb) + (c * c + d * d); }
                rstd[r] = q0;
            }
#pragma unroll
            for (int o = 32; o > 0; o >>= 1)
#pragma unroll
                for (int r = 0; r < RGRP; ++r) rstd[r] += __shfl_xor(rstd[r], o, 64);
#pragma unroll
            for (int r = 0; r < RGRP; ++r) rstd[r] = rsqrtf(rstd[r] * (1.0f / D) + 1e-5f);
            const float* lg_ = p.ln_g + (size_t)(l * 2 + 0) * D; const float* lb_ = p.ln_b + (size_t)(l * 2 + 0) * D;
            LN1_SB();
#pragma unroll
            for (int i = 0; i < 8; ++i) {
                const float4 gv = *(const float4*)(lg_ + COLK(i)), bv = *(const float4*)(lb_ + COLK(i));
#pragma unroll
                for (int r = 0; r < RGRP; ++r) {
                    float4& v = h[r][i];
                    v.x = (v.x - mean[r]) * rstd[r] * gv.x + bv.x; v.y = (v.y - mean[r]) * rstd[r] * gv.y + bv.y;
                    v.z = (v.z - mean[r]) * rstd[r] * gv.z + bv.z; v.w = (v.w - mean[r]) * rstd[r] * gv.w + bv.w;
                }
                if (i & 1) LN1_SB();
            }
#pragma unroll
            for (int r = 0; r < RGRP; ++r)
#pragma unroll
                for (int i = 0; i < 4; ++i) st_bf8((bf16_t*)xres + (size_t)(n0 + r) * D + COL8(i), h[r][2 * i], h[r][2 * i + 1]);
            LN1_SB();
#pragma unroll
            for (int i = 0; i < 8; ++i) {
                const float4 sh = *(const float4*)(mb + 3 * D + COLK(i)), sc = *(const float4*)(mb + 4 * D + COLK(i));
#pragma unroll
                for (int r = 0; r < RGRP; ++r) {
                    float4& v = h[r][i];
                    v.x = v.x * (1.f + sc.x) + sh.x; v.y = v.y * (1.f + sc.y) + sh.y; v.z = v.z * (1.f + sc.z) + sh.z; v.w = v.w * (1.f + sc.w) + sh.w;
                }
                if (i & 1) LN1_SB();
            }
#pragma unroll
            for (int r = 0; r < RGRP; ++r) {
#if MOE_FP8
                unsigned char* hb = p.ws + WS_HB + (size_t)(n0 + r) * D;
#pragma unroll
                for (int i = 0; i < 4; ++i) st_fp8x8(hb + COL8(i), h[r][2 * i], h[r][2 * i + 1]);
#else
                bf16_t* hb = (bf16_t*)(p.ws + WS_HB) + (size_t)(n0 + r) * D;
#pragma unroll
                for (int i = 0; i < 4; ++i) st_bf8(hb + COL8(i), h[r][2 * i], h[r][2 * i + 1]);
#endif
            }
        }
        float lgk0 = 0.f, lgk1 = 0.f, lgk2 = 0.f, lgk3 = 0.f;
        const bool b5 = (lane & 32) != 0, b4 = (lane & 16) != 0, b3 = (lane & 8) != 0, b2 = (lane & 4) != 0;
#pragma unroll 1
        for (int eg = 0; eg < 4; ++eg) {
            float s[RGRP][4];
#pragma unroll
            for (int q = 0; q < 4; ++q) {
                f32x2_t ac[RGRP];
#pragma unroll
                for (int r = 0; r < RGRP; ++r) ac[r] = (f32x2_t){0.f, 0.f};
#pragma unroll
                for (int i = 0; i < 8; ++i) {
                    const f32x4 w = *(const LAS f32x4*)(wrt + (eg * 4 + q) * D + i * 256 + lane * 4);
                    const f32x2_t w01 = __builtin_shufflevector(w, w, 0, 1), w23 = __builtin_shufflevector(w, w, 2, 3);
#pragma unroll
                    for (int r = 0; r < RGRP; ++r) {
                        ac[r] = __builtin_elementwise_fma((f32x2_t){h[r][i].x, h[r][i].y}, w01, ac[r]);
                        ac[r] = __builtin_elementwise_fma((f32x2_t){h[r][i].z, h[r][i].w}, w23, ac[r]);
                    }
                }
#pragma unroll
                for (int r = 0; r < RGRP; ++r) s[r][q] = ac[r][0] + ac[r][1];
                LN1_SB();
            }
            float u[RGRP];
#pragma unroll
            for (int r = 0; r < RGRP; ++r) {
                const float tA = (b5 ? s[r][2] : s[r][0]) + __shfl_xor(b5 ? s[r][0] : s[r][2], 32, 64);
                const float tB = (b5 ? s[r][3] : s[r][1]) + __shfl_xor(b5 ? s[r][1] : s[r][3], 32, 64);
                u[r] = (b4 ? tB : tA) + __shfl_xor(b4 ? tA : tB, 16, 64);
            }
#if RGRP == 4
            const float pA = (b3 ? u[2] : u[0]) + __shfl_xor(b3 ? u[0] : u[2], 8, 64);
            const float pB = (b3 ? u[3] : u[1]) + __shfl_xor(b3 ? u[1] : u[3], 8, 64);
            float z = (b2 ? pB : pA) + __shfl_xor(b2 ? pA : pB, 4, 64);
#else
            float z = (b3 ? u[1] : u[0]) + __shfl_xor(b3 ? u[0] : u[1], 8, 64);
            z += __shfl_xor(z, 4, 64);
#endif
            z += __shfl_xor(z, 2, 64); z += __shfl_xor(z, 1, 64);
            lgk0 = (eg == 0) ? z : lgk0; lgk1 = (eg == 1) ? z : lgk1; lgk2 = (eg == 2) ? z : lgk2; lgk3 = (eg == 3) ? z : lgk3;
        }
#pragma unroll 1
        for (int r = 0; r < RGRP; ++r) {
            const int n = n0 + r;
            const int rl = (RGRP == 4) ? (r >> 1) * 8 + (r & 1) * 4 : r * 8;
            float lg[16];
#pragma unroll
            for (int q = 0; q < 4; ++q) {
                const int src = ((q >> 1) * 32) + ((q & 1) * 16) + rl;
                lg[0 + q] = __int_as_float(__builtin_amdgcn_readlane(__float_as_int(lgk0), src));
                lg[4 + q] = __int_as_float(__builtin_amdgcn_readlane(__float_as_int(lgk1), src));
                lg[8 + q] = __int_as_float(__builtin_amdgcn_readlane(__float_as_int(lgk2), src));
                lg[12 + q] = __int_as_float(__builtin_amdgcn_readlane(__float_as_int(lgk3), src));
            }
            float mx = lg[0];
#pragma unroll
            for (int e = 1; e < 16; ++e) mx = fmaxf(mx, lg[e]);
            float sc[16], sum = 0.f;
#pragma unroll
            for (int e = 0; e < 16; ++e) { sc[e] = expf(lg[e] - mx); sum += sc[e]; }
            const float inv = 1.0f / sum;
            float sel[16];
#pragma unroll
            for (int e = 0; e < 16; ++e) { sc[e] *= inv; sel[e] = sc[e] + p.router_bias[e]; }
            float best_gs = -3.0e38f; int bi0 = 0, bi1 = 1; float bw0 = 0.f, bw1 = 0.f;
#pragma unroll
            for (int g = 0; g < 4; ++g) {
                int i0 = 0; float m0 = sel[4 * g];
#pragma unroll
                for (int j = 1; j < 4; ++j) if (sel[4 * g + j] > m0) { m0 = sel[4 * g + j]; i0 = j; }
                int i1 = -1; float m1 = -3.0e38f;
#pragma unroll
                for (int j = 0; j < 4; ++j) if (j != i0 && sel[4 * g + j] > m1) { m1 = sel[4 * g + j]; i1 = j; }
                float w0 = 0.f, w1 = 0.f;
#pragma unroll
                for (int j = 0; j < 4; ++j) { w0 = (j == i0) ? sc[4 * g + j] : w0; w1 = (j == i1) ? sc[4 * g + j] : w1; }
                const float gs = m0 + m1;
                if (gs > best_gs) { best_gs = gs; bi0 = 4 * g + i0; bi1 = 4 * g + i1; bw0 = w0; bw1 = w1; }
            }
            if (lane == 0) {
                const float ws_ = 1.0f / (bw0 + bw1);
                const int p0 = __hip_atomic_fetch_add(&lcnt[bi0], 1, __ATOMIC_RELAXED, __HIP_MEMORY_SCOPE_WORKGROUP), p1 = __hip_atomic_fetch_add(&lcnt[bi1], 1, __ATOMIC_RELAXED, __HIP_MEMORY_SCOPE_WORKGROUP);
                int* rr = route + (size_t)n * 8;
                rr[0] = bi0; rr[1] = bi1; rr[2] = (int)p0; rr[3] = (int)p1; rr[4] = __float_as_int(bw0 * ws_); rr[5] = __float_as_int(bw1 * ws_);
            }
        }
    }
    __syncthreads();
    if (tid < 16) ((int*)(p.ws + WS_WGCNT))[((size_t)l * 1024 + blockIdx.x) * 16 + tid] = lcnt[tid];
}

__device__ __forceinline__ void build_moe_tab(const Params& p, int l, LAS int* tab) {
    if (threadIdx.x == 0) {
        const unsigned* cnt = (const unsigned*)(p.ws + WS_CNT) + l * 16;
        int acc = 0;
        for (int e = 0; e < 16; ++e) { tab[e] = acc; acc += (int)((cnt[e] + 255u) >> 8); }
        tab[16] = acc;
    }
    __syncthreads();
}

__device__ __forceinline__ void phase_permute(const Params& p, int l, LAS int* tab) {
    int tid_ = threadIdx.x; asm volatile("" : "+v"(tid_)); const int wave = tid_ >> 6, lane = tid_ & 63;
    LAS int* base = tab + 32; LAS int* total = tab + 48;
    if (tid_ < 16) { base[tid_] = 0; total[tid_] = 0; }
    __syncthreads();
    {
        const int* wgc = (const int*)(p.ws + WS_WGCNT) + (size_t)l * 1024 * 16;
        const int e = tid_ & 15; int bs = 0, tt = 0;
        for (int w = tid_ >> 4; w < (int)gridDim.x; w += 32) { const int v = wgc[w * 16 + e]; tt += v; bs += (w < (int)blockIdx.x) ? v : 0; }
        __hip_atomic_fetch_add(&base[e], bs, __ATOMIC_RELAXED, __HIP_MEMORY_SCOPE_WORKGROUP);
        __hip_atomic_fetch_add(&total[e], tt, __ATOMIC_RELAXED, __HIP_MEMORY_SCOPE_WORKGROUP);
    }
    __syncthreads();
    if (tid_ == 0) { int acc = 0; for (int e = 0; e < 16; ++e) { tab[e] = acc; acc += (total[e] + 255) >> 8; } tab[16] = acc; }
    if (blockIdx.x == 0 && tid_ < 16) ((unsigned*)(p.ws + WS_CNT))[l * 16 + tid_] = (unsigned)total[tid_];
    __syncthreads();
#if MOE_FP8
    for (int i = blockIdx.x * 512 + tid_; i < XE_ROWS * 8; i += gridDim.x * 512) *(u32x4*)(p.ws + WS_HID + (size_t)(i >> 3) * DEP + DE + (i & 7) * 16) = (u32x4){0u, 0u, 0u, 0u};
#endif
    int* route = (int*)(p.ws + WS_ROUTE);
    const bf16_t* hb = (const bf16_t*)(p.ws + WS_HB);
    bf16_t* xe = (bf16_t*)(p.ws + WS_XE);
    for (int m = (blockIdx.x * 8 + wave) * RGRP; m < T; m += gridDim.x * 8 * RGRP)
#pragma unroll 1
    for (int n = m; n < m + RGRP; ++n) {
        int* r = route + (size_t)n * 8;
        const int e0 = r[0], e1 = r[1], p0 = r[2], p1 = r[3];
        const int row0 = tab[e0] * 256 + base[e0] + p0, row1 = tab[e1] * 256 + base[e1] + p1;
        constexpr int RB = MOE_FP8 ? D : 2 * D;
        const u32x4* src = (const u32x4*)((const unsigned char*)hb + (size_t)n * RB);
        u32x4* d0 = (u32x4*)((unsigned char*)xe + (size_t)row0 * RB); u32x4* d1 = (u32x4*)((unsigned char*)xe + (size_t)row1 * RB);
#pragma unroll
        for (int i = 0; i < RB / 1024; ++i) { const u32x4 v = src[i * 64 + lane]; d0[i * 64 + lane] = v; d1[i * 64 + lane] = v; }
        if (lane == 0) { r[6] = row0; r[7] = row1; }
    }
}

#define LN2_RG 2
#define LN2_SB() __builtin_amdgcn_sched_barrier(0)
__device__ __forceinline__ void phase_ln2(const Params& p, int l) {
    int tid_ = threadIdx.x; asm volatile("" : "+v"(tid_)); const int wave = tid_ >> 6, lane = tid_ & 63;
    const float* mod = (const float*)(p.ws + WS_MOD);
    const float* ye = (const float*)(p.ws + WS_YE);
    float* xres = (float*)(p.ws + WS_XRES);
    const int* route = (const int*)(p.ws + WS_ROUTE);
    for (int n0 = (blockIdx.x * 8 + wave) * LN2_RG; n0 < T; n0 += gridDim.x * 8 * LN2_RG) {
        const int b = n0 / SEQ;
        const float* mb = mod + ((size_t)l * 4 + b) * (6 * D);
        float w0[LN2_RG], w1[LN2_RG]; const bf16_t* y0[LN2_RG]; const bf16_t* y1[LN2_RG];
#pragma unroll
        for (int r = 0; r < LN2_RG; ++r) {
            const int* rr = route + (size_t)(n0 + r) * 8;
            w0[r] = __int_as_float(rr[4]); w1[r] = __int_as_float(rr[5]);
            y0[r] = (const bf16_t*)ye + (size_t)rr[6] * D; y1[r] = (const bf16_t*)ye + (size_t)rr[7] * D;
        }
        float4 v[LN2_RG][8];
#pragma unroll
        for (int i = 0; i < 4; ++i) {
            float4 xv[LN2_RG][2], a[LN2_RG][2], c[LN2_RG][2];
#pragma unroll
            for (int r = 0; r < LN2_RG; ++r) { ld_bf8((const bf16_t*)xres + (size_t)(n0 + r) * D + COL8(i), xv[r][0], xv[r][1]); ld_bf8(y0[r] + COL8(i), a[r][0], a[r][1]); ld_bf8(y1[r] + COL8(i), c[r][0], c[r][1]); }
#pragma unroll
            for (int q = 0; q < 2; ++q) {
                const float4 g = *(const float4*)(mb + 5 * D + COLK(2 * i + q));
#pragma unroll
                for (int r = 0; r < LN2_RG; ++r)
                    v[r][2 * i + q] = make_float4(ALPHA * xv[r][q].x + (1.f + g.x) * (w0[r] * a[r][q].x + w1[r] * c[r][q].x), ALPHA * xv[r][q].y + (1.f + g.y) * (w0[r] * a[r][q].y + w1[r] * c[r][q].y),
                                                  ALPHA * xv[r][q].z + (1.f + g.z) * (w0[r] * a[r][q].z + w1[r] * c[r][q].z), ALPHA * xv[r][q].w + (1.f + g.w) * (w0[r] * a[r][q].w + w1[r] * c[r][q].w));
            }
            LN2_SB();
        }
        float mean[LN2_RG], rstd[LN2_RG];
#pragma unroll
        for (int r = 0; r < LN2_RG; ++r) {
            float s0 = 0.f;
#pragma unroll
            for (int i = 0; i < 8; ++i) s0 += (v[r][i].x + v[r][i].y) + (v[r][i].z + v[r][i].w);
            mean[r] = s0;
        }
#pragma unroll
        for (int o = 32; o > 0; o >>= 1)
#pragma unroll
            for (int r = 0; r < LN2_RG; ++r) mean[r] += __shfl_xor(mean[r], o, 64);
#pragma unroll
        for (int r = 0; r < LN2_RG; ++r) {
            mean[r] *= (1.0f / D);
            float q0 = 0.f;
#pragma unroll
            for (int i = 0; i < 8; ++i) { const float aa = v[r][i].x - mean[r], bb = v[r][i].y - mean[r], cc = v[r][i].z - mean[r], dd = v[r][i].w - mean[r]; q0 += (aa * aa + bb * bb) + (cc * cc + dd * dd); }
            rstd[r] = q0;
        }
#pragma unroll
        for (int o = 32; o > 0; o >>= 1)
#pragma unroll
            for (int r = 0; r < LN2_RG; ++r) rstd[r] += __shfl_xor(rstd[r], o, 64);
#pragma unroll
        for (int r = 0; r < LN2_RG; ++r) rstd[r] = rsqrtf(rstd[r] * (1.0f / D) + 1e-5f);
        const float* lg_ = p.ln_g + (size_t)(l * 2 + 1) * D; const float* lb_ = p.ln_b + (size_t)(l * 2 + 1) * D;
        LN2_SB();
#pragma unroll
        for (int i = 0; i < 8; ++i) {
            const float4 gv = *(const float4*)(lg_ + COLK(i)), bv = *(const float4*)(lb_ + COLK(i));
#pragma unroll
            for (int r = 0; r < LN2_RG; ++r) {
                float4& x = v[r][i];
                x.x = (x.x - mean[r]) * rstd[r] * gv.x + bv.x; x.y = (x.y - mean[r]) * rstd[r] * gv.y + bv.y;
                x.z = (x.z - mean[r]) * rstd[r] * gv.z + bv.z; x.w = (x.w - mean[r]) * rstd[r] * gv.w + bv.w;
            }
            if (i & 1) LN2_SB();
        }
        if (l + 1 < DEPTH) {
#pragma unroll
            for (int r = 0; r < LN2_RG; ++r)
#pragma unroll
                for (int i = 0; i < 4; ++i) st_bf8((bf16_t*)xres + (size_t)(n0 + r) * D + COL8(i), v[r][2 * i], v[r][2 * i + 1]);
            const float* mn = mod + ((size_t)(l + 1) * 4 + b) * (6 * D);
            LN2_SB();
#pragma unroll
            for (int i = 0; i < 4; ++i) {
                float4 sh[2], sc[2];
#pragma unroll
                for (int q = 0; q < 2; ++q) { sh[q] = *(const float4*)(mn + COLK(2 * i + q)); sc[q] = *(const float4*)(mn + D + COLK(2 * i + q)); }
#pragma unroll
                for (int r = 0; r < LN2_RG; ++r) {
                    float4 h[2];
#pragma unroll
                    for (int q = 0; q < 2; ++q) { const float4 x = v[r][2 * i + q]; h[q] = make_float4(x.x * (1.f + sc[q].x) + sh[q].x, x.y * (1.f + sc[q].y) + sh[q].y, x.z * (1.f + sc[q].z) + sh[q].z, x.w * (1.f + sc[q].w) + sh[q].w); }
                    if (INP8(l + 1)) st_fp8x8(p.ws + WS_HA + (size_t)(n0 + r) * D + COL8(i), h[0], h[1]);
                    else st_bf8((bf16_t*)(p.ws + WS_HA) + (size_t)(n0 + r) * D + COL8(i), h[0], h[1]);
                }
                LN2_SB();
            }
        } else {
#pragma unroll
            for (int r = 0; r < LN2_RG; ++r)
#pragma unroll
                for (int i = 0; i < 8; ++i) *(float4*)(p.out + (size_t)(n0 + r) * D + COLK(i)) = v[r][i];
        }
    }
}

typedef const __attribute__((address_space(4))) unsigned char* KargPtr;
__device__ __forceinline__ Params load_params(KargPtr q) { asm volatile("" : "+s"(q)); Params lp; __builtin_memcpy(&lp, (const __attribute__((address_space(4))) unsigned long long*)q, sizeof(Params)); return lp; }

__global__ __launch_bounds__(512, 2) void mega(Params p_in) {
    extern __shared__ __attribute__((aligned(16))) unsigned char smem[];
    LAS unsigned char* lds = (LAS unsigned char*)smem;
    LAS int* tab = (LAS int*)(lds + LDS_MISC + 64);
    KargPtr kp = (KargPtr)__builtin_amdgcn_kernarg_segment_ptr();
    if (threadIdx.x == 0) { *(LAS u32x4*)(lds + LDS_MISC) = (u32x4){0u, 0u, 0u, 0u}; *(LAS u32x4*)(lds + LDS_MISC + 768) = (u32x4){0u, 0u, 0u, 0u}; *(LAS u32x4*)(lds + LDS_MISC + 784) = (u32x4){0u, 0u, 0u, 0u}; }
    __syncthreads();
    const int fused = p_in.fused, ph_lo = p_in.ph_lo, ph_hi = p_in.ph_hi, l_hi = p_in.l_hi;
    XcdBarrier bar;
    if (fused) bar = xcd_barrier_post((unsigned*)(p_in.ws + WS_BAR), (volatile LAS unsigned*)(lds + LDS_MISC));
    else { bar.bar = (unsigned*)(p_in.ws + WS_BAR); bar.x = 0; bar.st = (volatile LAS unsigned*)(lds + LDS_MISC); }
#ifdef ONLY_PH
#define PH(i) ((i) == ONLY_PH && ph_lo <= (i) && (i) < ph_hi)
#else
#define PH(i) (ph_lo <= (i) && (i) < ph_hi)
#endif
#ifdef PROBE_PH
#define SYNC_PLAIN() do { if (fused) xcd_barrier(bar); } while (0)
#define PSTART(i) do { if ((i) == PROBE_PH && blockIdx.x == 0 && threadIdx.x == 0) { *(LAS unsigned long long*)(lds + LDS_MISC + 768) = __builtin_amdgcn_s_memrealtime(); } } while (0)
#define PSTOP(i) do { if ((i) == PROBE_PH && blockIdx.x == 0 && threadIdx.x == 0) { *(LAS unsigned long long*)(lds + LDS_MISC + 776) += __builtin_amdgcn_s_memrealtime() - *(LAS unsigned long long*)(lds + LDS_MISC + 768); } } while (0)
#else
#define PSTART(i) do { } while (0)
#define PSTOP(i) do { } while (0)
#endif
#if defined(PROBE_PH) && defined(PROBE_SUB)
#define QSTART(i, k) do { if ((i) == PROBE_PH && (k) == PROBE_SUB && blockIdx.x == PROBE_WG && threadIdx.x == 0) { *(LAS unsigned long long*)(lds + LDS_MISC + 784) = __builtin_amdgcn_s_memrealtime(); } } while (0)
#define QSTOP(i, k) do { if ((i) == PROBE_PH && (k) == PROBE_SUB && blockIdx.x == PROBE_WG && threadIdx.x == 0) { *(LAS unsigned long long*)(lds + LDS_MISC + 792) += __builtin_amdgcn_s_memrealtime() - *(LAS unsigned long long*)(lds + LDS_MISC + 784); } } while (0)
#else
#define QSTART(i, k) do { } while (0)
#define QSTOP(i, k) do { } while (0)
#endif
#define SYNC() do { if (fused) xcd_barrier(bar); } while (0)
#ifndef DUP_MASK
#define DUP_MASK 0
#endif
#define REP(i) _Pragma("unroll 1") for (int rep_ = 0; rep_ < 1 + ((DUP_MASK >> (i)) & 1); ++rep_)
    const int G = gridDim.x, c = blockIdx.x;
    if (PH(0)) REP(0) { PSTART(0); const Params p = load_params(kp); phase_prologue(p, lds); SYNC(); PSTOP(0); }
    if (PH(1)) REP(1) { PSTART(1); const Params p = load_params(kp); phase_ln0(p); SYNC(); PSTOP(1); }
    for (int l = p_in.l_lo; l < l_hi; ++l) {
        const bool svc = (l == 0) && (G >= 256);
        if (PH(2)) REP(2) { PSTART(2);
            const Params p = load_params(kp);
            pg8::Gemm g{(const bf16_t*)(p.ws + WS_HA), (const bf16_t*)(p.ws + WS_WIN) + (size_t)l * INC * D, D};
            pg8::EpiBf16 E{(bf16_t*)(p.ws + WS_PROJ), INC};
            if (svc) {
                if (c < 240) {
                    pg8::DenseOrder<32, 30> S; S.init(INP8(0) ? D : 2 * D, 240, c);
                    if (INP8(0)) pg8::gemm_phase<pg8::EpiBf16, pg8::DenseOrder<32, 30>, true>(lds, g, S, E, 121, 127);
                    else pg8::gemm_phase(lds, g, S, E);
                } else ada_chunks(p, lds, 128 + (c - 240), 256, 16);
                tail_pull(p, lds, l * 4 + 0);
            } else {
                pg8::DenseOrder<32, 32> S; S.init(INP8(l) ? D : 2 * D, G, c);
                if (INP8(l)) pg8::gemm_phase<pg8::EpiBf16, pg8::DenseOrder<32, 32>, true>(lds, g, S, E, 121, 127);
                else pg8::gemm_phase(lds, g, S, E);
            }
            SYNC(); PSTOP(2);
        }
#ifdef MIXER_CHECK
        if (PH(3)) REP(3) { PSTART(3); const Params p = load_params(kp); phase_mixer_valu(p, l, lds); SYNC(); PSTOP(3); }
        if (PH(3)) REP(3) { PSTART(3); const Params p = load_params(kp); phase_mixer_mfma<0>(p, l, lds, (float*)(p.ws + WS_XE)); SYNC(); PSTOP(3); }
        if (PH(3)) REP(3) { PSTART(3); const Params p = load_params(kp); phase_mixer_check(p, (const float*)(p.ws + WS_OBUF), (const float*)(p.ws + WS_XE), (float*)(p.ws + WS_CNT + 1024) + l * 8); SYNC(); PSTOP(3); }
#else
        if (PH(3)) REP(3) { PSTART(3);
            const Params p = load_params(kp);
            const int n_extra = svc ? 96 : 32, pn0 = svc ? 30 : 32;
            for (int uu = (G >= 224 ? c - 192 : c); uu >= 0 && uu < n_extra; uu += (G >= 224 ? 64 : G)) {
                const int RBI = INP8(l) ? D : 2 * D;
                pg8::OneUnit S; S.u0.aB = (size_t)(uu & 31) * 256 * RBI; S.u0.bB = (size_t)(pn0 + (uu >> 5)) * 256 * RBI; S.u0.row0 = (uu & 31) * 256; S.u0.col0 = (pn0 + (uu >> 5)) * 256;
                pg8::EpiBf16 E{(bf16_t*)(p.ws + WS_PROJ), INC};
                pg8::Gemm g{(const bf16_t*)(p.ws + WS_HA), (const bf16_t*)(p.ws + WS_WIN) + (size_t)l * INC * D, D};
                if (INP8(l)) pg8::gemm_phase<pg8::EpiBf16, pg8::OneUnit, true>(lds, g, S, E, 121, 127);
                else pg8::gemm_phase(lds, g, S, E);
            }
            phase_mixer_mfma<0>(p, l, lds, (float*)(p.ws + WS_OBUF));
            tail_pull(p, lds, l * 4 + 1);
            SYNC(); PSTOP(3);
#ifdef MIXER_PROBE
            phase_mixer_mfma<MIXER_PROBE>(p, l, lds, (float*)(p.ws + WS_XE));
            SYNC(); PSTOP(3);
#endif
        }
#endif
        if (PH(4)) REP(4) { PSTART(4); const Params p = load_params(kp); phase_finalize(p, l); SYNC(); PSTOP(4); }
        if (PH(5)) REP(5) { PSTART(5);
            const Params p = load_params(kp);
            pg8::DenseOrder<32, 8> S; S.init(OUT8(l) ? D : 2 * D, G, c);
            pg8::Gemm g{(const bf16_t*)(p.ws + WS_MIXED), (const bf16_t*)(p.ws + WS_WOUT) + (size_t)l * D * D, D};
            pg8::EpiBf16 E{(bf16_t*)(p.ws + WS_Y), D};
            if (OUT8(l)) pg8::gemm_phase<pg8::EpiBf16, pg8::DenseOrder<32, 8>, true>(lds, g, S, E, 121, 125);
            else pg8::gemm_phase(lds, g, S, E);
            SYNC(); PSTOP(5);
        }
        if (PH(6)) REP(6) { PSTART(6); const Params p = load_params(kp); phase_ln1_router(p, l, lds); SYNC(); PSTOP(6); }
        if (PH(7)) REP(7) { PSTART(7); const Params p = load_params(kp); phase_permute(p, l, tab); cvt_pull(p, lds, l * CV_PER_L + CV_A1, nullptr, 0u); SYNC(); PSTOP(7); }
        if (PH(8)) REP(8) { PSTART(8);
            const Params p = load_params(kp);
            build_moe_tab(p, l, tab);
#if MOE_FP8
            pg8::MoeOrder S; S.tab = tab; S.NTn = 11; S.G = G; S.c = c; S.tstep = (size_t)256 * D; S.bexp = (size_t)2 * DE * D;
            pg8::Gemm g{(const bf16_t*)(p.ws + WS_XE), (const bf16_t*)(p.ws + WS_WGU + (size_t)l * NE * 2 * DE * D), D};
            pg8::EpiHidden8 E{p.ws + WS_HID};
            QSTART(8, 1); pg8::gemm_phase<pg8::EpiHidden8, pg8::MoeOrder, true>(lds, g, S, E, 121, 127); QSTOP(8, 1);
#else
            pg8::MoeOrder S; S.tab = tab; S.NTn = 11; S.G = G; S.c = c; S.tstep = (size_t)256 * D * 2; S.bexp = (size_t)2 * DE * D * 2;
            pg8::Gemm g{(const bf16_t*)(p.ws + WS_XE), (const bf16_t*)(p.ws + WS_WGU) + (size_t)l * NE * 2 * DE * D, D};
            pg8::EpiHidden E{(bf16_t*)(p.ws + WS_HID)};
            pg8::gemm_phase(lds, g, S, E);
#endif
            QSTART(8, 2); tail_pull(p, lds, l * 4 + 2); QSTOP(8, 2);
            QSTART(8, 3); cvt_pull(p, lds, (l + 1) * CV_PER_L, nullptr, 0u); QSTOP(8, 3);
            SYNC(); PSTOP(8);
        }
        if (PH(9)) REP(9) { PSTART(9);
            const Params p = load_params(kp);
            build_moe_tab(p, l, tab);
#if MOE_FP8
            pg8::MoeOrder S; S.tab = tab; S.NTn = 8; S.G = G; S.c = c; S.tstep = (size_t)256 * DEP; S.bexp = (size_t)D * DEP;
            pg8::Gemm g{(const bf16_t*)(p.ws + WS_HID), (const bf16_t*)(p.ws + WS_WD + (size_t)l * NE * D * DEP), DEP};
            pg8::EpiBf16 E{(bf16_t*)(p.ws + WS_YE), D};
            QSTART(9, 1); pg8::gemm_phase<pg8::EpiBf16, pg8::MoeOrder, true>(lds, g, S, E, 121, 124); QSTOP(9, 1);
#else
            pg8::MoeOrder S; S.tab = tab; S.NTn = 8; S.G = G; S.c = c; S.tstep = (size_t)256 * DE * 2; S.bexp = (size_t)D * DE * 2;
            pg8::Gemm g{(const bf16_t*)(p.ws + WS_HID), (const bf16_t*)(p.ws + WS_WD) + (size_t)l * NE * D * DE, DE};
            pg8::EpiBf16 E{(bf16_t*)(p.ws + WS_YE), D};
            pg8::gemm_phase(lds, g, S, E);
#endif
            QSTART(9, 2); tail_pull(p, lds, l * 4 + 3); QSTOP(9, 2);
            QSTART(9, 3); if (l + 1 < DEPTH) cvt_pull(p, lds, (l + 1) * CV_PER_L + CV_A0, nullptr, 0u); QSTOP(9, 3);
            SYNC(); PSTOP(9);
        }
        if (PH(10)) REP(10) { PSTART(10); const Params p = load_params(kp); phase_ln2(p, l); SYNC(); PSTOP(10); }
    }
#ifdef PROBE_PH
    if (blockIdx.x == 0 && threadIdx.x == 0) {
#ifdef PROBE_SUB
        const unsigned long long t = 0ull, t0 = __builtin_amdgcn_s_memrealtime();
#else
        const unsigned long long t = *(LAS unsigned long long*)(lds + LDS_MISC + 776) * 4ull, t0 = __builtin_amdgcn_s_memrealtime();
#endif
        while (__builtin_amdgcn_s_memrealtime() - t0 < t) __builtin_amdgcn_s_sleep(8);
    }
#ifdef PROBE_SUB
    if (blockIdx.x == PROBE_WG && threadIdx.x == 0) {
        const unsigned long long t = *(LAS unsigned long long*)(lds + LDS_MISC + 792) * 4ull, t0 = __builtin_amdgcn_s_memrealtime();
        while (__builtin_amdgcn_s_memrealtime() - t0 < t) __builtin_amdgcn_s_sleep(8);
    }
#endif
#endif
}

#ifndef MK_FUSED
#define MK_FUSED 1
#endif
extern "C" void kernel_launch(void* const* d_in, const int* in_sizes, int n_in, void* d_out, int out_size, void* d_ws, size_t ws_size, hipStream_t stream) {
    static int grid = 0;
    if (grid == 0) {
        if (n_in != 18 || ws_size < WS_END) { fprintf(stderr, "kernel_launch: unexpected n_in %d or ws_size %zu (< %zu)\n", n_in, ws_size, (size_t)WS_END); grid = -1; return; }
        int dev = 0, cus = 0, per_cu = 0;
        hipGetDevice(&dev);
        hipDeviceGetAttribute(&cus, hipDeviceAttributeMultiprocessorCount, dev);
        if (hipFuncSetAttribute((const void*)mega, hipFuncAttributeMaxDynamicSharedMemorySize, LDS_BYTES) != hipSuccess) { fprintf(stderr, "kernel_launch: hipFuncSetAttribute failed\n"); grid = -1; return; }
        hipOccupancyMaxActiveBlocksPerMultiprocessor(&per_cu, (const void*)mega, 512, LDS_BYTES);
        if (per_cu < 1) fprintf(stderr, "kernel_launch: occupancy query says %d\n", per_cu);
        grid = cus > 0 ? cus : 256;
    }
    if (grid < 0) return;
    hipMemsetAsync(d_ws, 0, WS_ZERO_BYTES, stream);
    Params p{};
    p.x = (const float*)d_in[0]; p.c = (const float*)d_in[1]; p.emb_g = (const float*)d_in[2]; p.emb_b = (const float*)d_in[3];
    p.w_ada = (const float*)d_in[4]; p.b_ada = (const float*)d_in[5]; p.w_in = (const float*)d_in[6]; p.conv_w = (const float*)d_in[7];
    p.mix_beta = (const float*)d_in[8]; p.w_out = (const float*)d_in[9]; p.lb_logits = (const float*)d_in[10]; p.ln_g = (const float*)d_in[11];
    p.ln_b = (const float*)d_in[12]; p.w_router = (const float*)d_in[13]; p.router_bias = (const float*)d_in[14]; p.w_gate = (const float*)d_in[15];
    p.w_up = (const float*)d_in[16]; p.w_down = (const float*)d_in[17];
    p.out = (float*)d_out; p.ws = (unsigned char*)d_ws; p.pad = 0;
#if MK_FUSED
    p.ph_lo = 0; p.ph_hi = 11; p.l_lo = 0; p.l_hi = DEPTH; p.fused = 1;
    hipLaunchKernelGGL(mega, dim3(grid), dim3(512), LDS_BYTES, stream, p);
#else
    p.fused = 0;
    for (int ph = 0; ph < 2; ++ph) { p.ph_lo = ph; p.ph_hi = ph + 1; p.l_lo = 0; p.l_hi = 0; hipLaunchKernelGGL(mega, dim3(grid), dim3(512), LDS_BYTES, stream, p); }
    for (int l = 0; l < DEPTH; ++l)
        for (int ph = 2; ph < 11; ++ph) { p.ph_lo = ph; p.ph_hi = ph + 1; p.l_lo = l; p.l_hi = l + 1; hipLaunchKernelGGL(mega, dim3(grid), dim3(512), LDS_BYTES, stream, p); }
#endif
}
```

```cpp
#include <hip/hip_runtime.h>
#include <stdint.h>
#include <stdio.h>

#define LAS __attribute__((address_space(3)))
typedef unsigned short bf16_t;
typedef short bf16x8 __attribute__((ext_vector_type(8)));
typedef float f32x4 __attribute__((ext_vector_type(4)));
typedef unsigned u32x4 __attribute__((ext_vector_type(4)));
typedef unsigned u32x2 __attribute__((ext_vector_type(2)));

constexpr int D = 2048, NB = 4, SEQ = 2048, T = NB * SEQ, DEPTH = 2;
constexpr int CW = 512, RW = 768, HWD = 768, INC = 8448;
constexpr int NE = 16, DE = 1408;
constexpr int C_CB = 0, C_CC = 512, C_CH = 1024, C_RQ = 1536, C_RK = 2304, C_RV = 3072, C_RG = 3840, C_HQ = 4608, C_HFF = 5376, C_HFB = 6144, C_HI = 6912, C_HG = 7680;
constexpr int XE_ROWS = 20480;
#ifndef MOE_FP8
#define MOE_FP8 1
#endif
#ifndef INP_FP8_FROM
#define INP_FP8_FROM 1
#endif
#define INP8(l) ((l) >= INP_FP8_FROM)
#ifndef OUT_FP8_FROM
#define OUT_FP8_FROM 1
#endif
#define OUT8(l) ((l) >= OUT_FP8_FROM)
constexpr int DEP = 1536;
constexpr float W8_SCALE = 64.f, H8_SCALE = 8.f;
constexpr float ALPHA = 1.4142135623730951f;

constexpr size_t WS_BAR = 0;
constexpr size_t WS_CNT = 16384;
constexpr size_t WS_CVTQ = 20480;
constexpr size_t WS_ZERO_BYTES = 32768;
constexpr size_t WS_MOD = 32768;
constexpr size_t WS_ROUTE = WS_MOD + 393216;
constexpr size_t WS_WGCNT = WS_ROUTE + 262144;
constexpr size_t WS_WIN = 1048576;
constexpr size_t SZ_WIN = (size_t)DEPTH * INC * D * 2;
constexpr size_t WS_WOUT = WS_WIN + SZ_WIN;
constexpr size_t SZ_WOUT = (size_t)DEPTH * D * D * 2;
constexpr size_t WS_WGU = WS_WOUT + SZ_WOUT;
constexpr size_t SZ_WGU = (size_t)DEPTH * NE * 2 * DE * D * 2;
constexpr size_t WS_WD = WS_WGU + SZ_WGU;
constexpr size_t SZ_WD = (size_t)DEPTH * NE * D * DE * 2;
constexpr size_t WS_XRES = WS_WD + SZ_WD;
constexpr size_t SZ_XRES = (size_t)T * D * 4;
constexpr size_t WS_HA = WS_XRES + SZ_XRES;
constexpr size_t SZ_H = (size_t)T * D * 2;
constexpr size_t WS_HB = WS_HA + SZ_H;
constexpr size_t WS_PROJ = WS_HB + SZ_H;
constexpr size_t SZ_PROJ = (size_t)T * INC * 2;
constexpr size_t WS_OBUF = WS_PROJ + SZ_PROJ;
constexpr size_t SZ_OBUF = (size_t)2 * T * 1536 * 4;
constexpr size_t WS_YE = WS_PROJ;
constexpr size_t SZ_YE = (size_t)XE_ROWS * D * 4;
static_assert(SZ_YE <= SZ_PROJ + SZ_OBUF, "ye alias");
constexpr size_t WS_MIXED = WS_OBUF + SZ_OBUF;
constexpr size_t WS_Y = WS_MIXED + SZ_H;
constexpr size_t SZ_Y = (size_t)T * D * 4;
constexpr size_t WS_XE = WS_Y + SZ_Y;
constexpr size_t SZ_XE = (size_t)XE_ROWS * D * 2;
constexpr size_t WS_HID = WS_XE + SZ_XE;
constexpr size_t SZ_HID = (size_t)XE_ROWS * DE * 2;
constexpr size_t WS_END = WS_HID + SZ_HID;

constexpr int LDS_BYTES = 156672;
constexpr int LDS_MISC = 153600;

struct Params {
    const float *x, *c, *emb_g, *emb_b, *w_ada, *b_ada, *w_in, *conv_w, *mix_beta, *w_out, *lb_logits, *ln_g, *ln_b, *w_router, *router_bias, *w_gate, *w_up, *w_down;
    float* out;
    unsigned char* ws;
    int ph_lo, ph_hi, l_lo, l_hi, fused, pad;
};

__device__ __forceinline__ float bf2f(unsigned b) { return __uint_as_float(b << 16); }
__device__ __forceinline__ unsigned f2bf(float f) { unsigned u = __float_as_uint(f); u += 0x7FFFu + ((u >> 16) & 1u); return u >> 16; }
typedef __bf16 bf16x2_t __attribute__((ext_vector_type(2)));
typedef float f32x2_t __attribute__((ext_vector_type(2)));
__device__ __forceinline__ unsigned pack2a(float lo, float hi) { unsigned r; asm("v_cvt_pk_bf16_f32 %0, %1, %2" : "=v"(r) : "v"(lo), "v"(hi)); return r; }
__device__ __forceinline__ unsigned pack2(float lo, float hi) { const bf16x2_t r = __builtin_convertvector((f32x2_t){lo, hi}, bf16x2_t); return __builtin_bit_cast(unsigned, r); }
__device__ __forceinline__ float wave_sum(float v) {
#pragma unroll
    for (int o = 32; o > 0; o >>= 1) v += __shfl_xor(v, o, 64);
    return v;
}
__device__ __forceinline__ float half_sum(float v) {
#pragma unroll
    for (int o = 16; o > 0; o >>= 1) v += __shfl_xor(v, o, 64);
    return v;
}
#define LDS_BARRIER() do { asm volatile("s_waitcnt lgkmcnt(0)" ::: "memory"); __builtin_amdgcn_s_barrier(); asm volatile("" ::: "memory"); } while (0)
__device__ __forceinline__ float sigmoidf_(float z) { return 1.0f / (1.0f + __expf(-z)); }
__device__ __forceinline__ float siluf_(float z) { return z / (1.0f + __expf(-z)); }

#define XB_TMO      128
#define XB_XCNT(j)  (256  + 64 * (j))
#define XB_XSUB(j)  (1280 + 64 * (j))
#define XB_XGEN(j)  (2304 + 64 * (j))
#define XB_TOP      3328
#define XB_TOPGEN   3392
#define XCD_BAR_WORDS 3456
#define XB_SPIN_CAP (1u << 22)
__device__ __forceinline__ unsigned xb_ld(unsigned* p)              { return __hip_atomic_load(p, __ATOMIC_RELAXED, __HIP_MEMORY_SCOPE_AGENT); }
__device__ __forceinline__ unsigned xb_add(unsigned* p, unsigned v) { return __hip_atomic_fetch_add(p, v, __ATOMIC_RELAXED, __HIP_MEMORY_SCOPE_AGENT); }
__device__ __forceinline__ unsigned xb_xcc_id() { return (unsigned)__builtin_amdgcn_s_getreg((3 << 11) | 20) & 0xFu; }
#define XB_SPIN(cond, bar) do { unsigned _sp = 0; while (cond) { __builtin_amdgcn_s_sleep(1); \
    if ((++_sp & 255u) == 0u) { if (xb_ld(&(bar)[XB_TMO])) break; if (_sp > XB_SPIN_CAP) { atomicAdd(&(bar)[XB_TMO], 1u); break; } } } } while (0)
struct XcdBarrier { unsigned* bar; unsigned x; volatile LAS unsigned* st; };
__device__ __forceinline__ XcdBarrier xcd_barrier_post(unsigned* bar, volatile LAS unsigned* st) {
    XcdBarrier b; b.bar = bar; b.x = xb_xcc_id(); b.st = st;
    if (threadIdx.x == 0) (void)xb_add(&bar[XB_XCNT(b.x)], 1u);
    return b;
}
__device__ __forceinline__ void xcd_barrier_complete(unsigned* bar, unsigned x, unsigned& nloc, unsigned& nx) {
    const unsigned G = gridDim.x * gridDim.y * gridDim.z;
    unsigned sum, cnt, mine, sp = 0u;
    for (;;) {
        sum = 0u; cnt = 0u; mine = 0u;
#pragma unroll
        for (unsigned j = 0; j < 16; ++j) { const unsigned c = xb_ld(&bar[XB_XCNT(j)]); sum += c; cnt += (c > 0u) ? 1u : 0u; mine = (j == x) ? c : mine; }
        if (sum == G) break;
        __builtin_amdgcn_s_sleep(1);
        if ((++sp & 255u) == 0u) { if (xb_ld(&bar[XB_TMO])) break; if (sp > XB_SPIN_CAP) { atomicAdd(&bar[XB_TMO], 1u); break; } }
    }
    nloc = mine > 0u ? mine : 1u; nx = cnt > 0u ? cnt : 1u;
}
__device__ __forceinline__ void xcd_barrier(const XcdBarrier& b) {
    asm volatile("s_waitcnt vmcnt(0)" ::: "memory");
    __syncthreads();
    if (threadIdx.x == 0) {
        unsigned* bar = b.bar;
        __builtin_amdgcn_s_waitcnt(0);
        unsigned nloc = b.st[0], nx = b.st[1];
        if (nloc == 0u) { xcd_barrier_complete(bar, b.x, nloc, nx); b.st[0] = nloc; b.st[1] = nx; }
        const unsigned old = xb_add(&bar[XB_XSUB(b.x)], 1u);
        const unsigned gen = old / nloc;
        if (old + 1u == (gen + 1u) * nloc) {
            __builtin_amdgcn_fence(__ATOMIC_RELEASE, "agent");
            asm volatile("s_waitcnt vmcnt(0)" ::: "memory");
            const unsigned og = xb_add(&bar[XB_TOP], 1u);
            const unsigned tg = og / nx;
            if (og + 1u == (tg + 1u) * nx) xb_add(&bar[XB_TOPGEN], 1u);
            else XB_SPIN(xb_ld(&bar[XB_TOPGEN]) == tg, bar);
            __builtin_amdgcn_fence(__ATOMIC_ACQUIRE, "agent");
            xb_add(&bar[XB_XGEN(b.x)], 1u);
            asm volatile("s_waitcnt vmcnt(0)" ::: "memory");
        } else {
            XB_SPIN(xb_ld(&bar[XB_XGEN(b.x)]) == gen, bar);
            __builtin_amdgcn_fence(__ATOMIC_ACQUIRE, "agent");
            asm volatile("s_waitcnt vmcnt(0)" ::: "memory");
        }
    }
    __syncthreads();
}

namespace pg8 {
constexpr int BM = 256, BK = 64, HALF = 128, HTB = HALF * BK * 2, STAGE_BYTES = 8 * HTB, NXCD = 8, WGM = 8;
__host__ __device__ __forceinline__ int lds_byte(int r, int c) { const int st = (r >> 4) * 2 + (c >> 5), rr = r & 15, cc = c & 31, ob = rr * 64 + cc * 2; return st * 1024 + (ob ^ (((ob >> 9) & 1) << 5)); }
__host__ __device__ __forceinline__ void stage_rc(int b, int& R, int& C) { const int st = b / 1024, sb = b % 1024, swz = sb ^ (((sb >> 9) & 1) << 5); R = (st >> 1) * 16 + swz / 64; C = (st & 1) * 32 + (swz % 64) / 2; }
__host__ __device__ __forceinline__ int perm32(int rho) { const int n = rho >> 4, i = rho & 15; return 8 * (i >> 2) + 4 * n + (i & 3); }

struct Unit { size_t aB, bB; int row0, col0; };
struct Gemm { const bf16_t* A; const bf16_t* Bt; int K; };

template <int NM, int NN>
struct DenseOrder {
    int G, c; size_t tstep;
    __device__ void init(int rowbytes, int G_, int c_) { G = G_; c = c_; tstep = (size_t)BM * rowbytes; }
    __device__ bool next(int i, Unit& u) const {
        constexpr int nwg = NM * NN, q = nwg / NXCD, r = nwg % NXCD, nig = WGM * NN;
        static_assert(NM % WGM == 0, "row tiles come in groups of 8");
        const int L = __builtin_amdgcn_readfirstlane(i * G + c); if (L >= nwg) return false;
        const int xcd = L % NXCD, off = L / NXCD;
        const int wgid = (xcd < r ? xcd * (q + 1) : r * (q + 1) + (xcd - r) * q) + off;
        const int gid = wgid / nig, fm = gid * WGM, rem = wgid % nig;
        const int pm = fm + (rem % WGM), pn = rem / WGM;
        u.aB = (size_t)pm * tstep; u.bB = (size_t)pn * tstep; u.row0 = pm * BM; u.col0 = pn * BM; return true;
    }
};
struct OneUnit {
    Unit u0;
    __device__ bool next(int i, Unit& u) const { if (i > 0) return false; u = u0; return true; }
};
struct MoeOrder {
    const LAS int* tab; int NTn, G, c; size_t tstep, bexp;
    __device__ bool next(int i, Unit& u) const {
        const int MT = tab[16], U = MT * NTn, nx = G >> 3;
        int f;
        if ((G & 7) == 0) { const int per = (U + 7) >> 3, x = c & 7, j = c >> 3, loc = i * nx + j; f = x * per + loc; if (loc >= per || f >= U) return false; }
        else { f = i * G + c; if (f >= U) return false; }
        int e = 0;
#pragma unroll
        for (int j = 1; j < 16; ++j) e += (f >= tab[j] * NTn) ? 1 : 0;
        const int t0 = tab[e], te = tab[e + 1] - t0, r = f - t0 * NTn;
        const int nt = r / te, mt = t0 + (r - nt * te);
        u.aB = (size_t)mt * tstep; u.bB = (size_t)e * bexp + (size_t)nt * tstep; u.row0 = mt * BM; u.col0 = nt * BM; return true;
    }
};

__device__ __forceinline__ size_t rfl64(size_t v) { const unsigned lo = (unsigned)__builtin_amdgcn_readfirstlane((int)(unsigned)v), hi = (unsigned)__builtin_amdgcn_readfirstlane((int)(unsigned)(v >> 32)); return ((size_t)hi << 32) | lo; }
__device__ __forceinline__ void uniformize(Unit& u) { u.aB = rfl64(u.aB); u.bB = rfl64(u.bB); u.row0 = __builtin_amdgcn_readfirstlane(u.row0); u.col0 = __builtin_amdgcn_readfirstlane(u.col0); }
__device__ __forceinline__ unsigned cvt_pk_bf16(float lo, float hi) { unsigned r; asm volatile("v_cvt_pk_bf16_f32 %0, %1, %2" : "=v"(r) : "v"(lo), "v"(hi)); return r; }

struct EpiF32 {
    static constexpr bool PERM = false;
    float* C; int ldc;
    __device__ __forceinline__ void operator()(const f32x4 (&acc)[2][2][4][2], const Unit& u, int wr, int wc, int fr, int fq) const {
        const int row0 = u.row0 + wr * 64 + fr, col0 = u.col0 + wc * 32 + 4 * fq;
#pragma unroll
        for (int ai = 0; ai < 2; ++ai)
#pragma unroll
            for (int m = 0; m < 4; ++m) { float* rowp = C + (size_t)(row0 + ai * HALF + m * 16) * ldc + col0;
#pragma unroll
                for (int bj = 0; bj < 2; ++bj)
#pragma unroll
                    for (int n = 0; n < 2; ++n) *(f32x4*)(rowp + bj * HALF + n * 16) = acc[ai][bj][m][n]; }
    }
};
struct EpiBf16 {
    static constexpr bool PERM = true;
    bf16_t* O; int ldc;
    __device__ __forceinline__ void operator()(const f32x4 (&acc)[2][2][4][2], const Unit& u, int wr, int wc, int fr, int fq) const {
        const int row0 = u.row0 + wr * 64 + fr, col0 = u.col0 + wc * 32 + 8 * fq;
#pragma unroll
        for (int ai = 0; ai < 2; ++ai)
#pragma unroll
            for (int m = 0; m < 4; ++m) { bf16_t* rowp = O + (size_t)(row0 + ai * HALF + m * 16) * ldc + col0;
#pragma unroll
                for (int bj = 0; bj < 2; ++bj) { const f32x4 v0 = acc[ai][bj][m][0], v1 = acc[ai][bj][m][1];
                    u32x4 o; o[0] = cvt_pk_bf16(v0[0], v0[1]); o[1] = cvt_pk_bf16(v0[2], v0[3]); o[2] = cvt_pk_bf16(v1[0], v1[1]); o[3] = cvt_pk_bf16(v1[2], v1[3]);
                    *(u32x4*)(rowp + bj * HALF) = o; } }
    }
};
struct EpiHidden {
    static constexpr bool PERM = true;
    bf16_t* O;
    __device__ __forceinline__ void operator()(const f32x4 (&acc)[2][2][4][2], const Unit& u, int wr, int wc, int fr, int fq) const {
        const int row0 = u.row0 + wr * 64 + fr, col0 = (u.col0 >> 1) + wc * 32 + 8 * fq;
#pragma unroll
        for (int ai = 0; ai < 2; ++ai)
#pragma unroll
            for (int m = 0; m < 4; ++m) { bf16_t* rowp = O + (size_t)(row0 + ai * HALF + m * 16) * DE + col0;
                float h[8];
#pragma unroll
                for (int n = 0; n < 2; ++n)
#pragma unroll
                    for (int j = 0; j < 4; ++j) { const float g = acc[ai][0][m][n][j], up = acc[ai][1][m][n][j]; h[n * 4 + j] = g * __builtin_amdgcn_rcpf(1.0f + __expf(-g)) * up; }
                u32x4 o; o[0] = cvt_pk_bf16(h[0], h[1]); o[1] = cvt_pk_bf16(h[2], h[3]); o[2] = cvt_pk_bf16(h[4], h[5]); o[3] = cvt_pk_bf16(h[6], h[7]);
                *(u32x4*)rowp = o; }
    }
};

typedef int v8i32 __attribute__((ext_vector_type(8)));
typedef int v4i32 __attribute__((ext_vector_type(4)));
struct EpiHidden8 {
    static constexpr bool PERM = true;
    unsigned char* O;
    __device__ __forceinline__ void operator()(const f32x4 (&acc)[2][2][4][2], const Unit& u, int wr, int wc, int fr, int fq) const {
        const int row0 = u.row0 + wr * 64 + fr, col0 = (u.col0 >> 1) + wc * 32 + 8 * fq;
#pragma unroll
        for (int ai = 0; ai < 2; ++ai)
#pragma unroll
            for (int m = 0; m < 4; ++m) { unsigned char* rowp = O + (size_t)(row0 + ai * HALF + m * 16) * DEP + col0;
                float h[8];
#pragma unroll
                for (int n = 0; n < 2; ++n)
#pragma unroll
                    for (int j = 0; j < 4; ++j) { const float g = acc[ai][0][m][n][j], up = acc[ai][1][m][n][j]; h[n * 4 + j] = g * __builtin_amdgcn_rcpf(1.0f + __expf(-g)) * up * H8_SCALE; }
                int o0 = __builtin_amdgcn_cvt_pk_fp8_f32(h[0], h[1], 0, false); o0 = __builtin_amdgcn_cvt_pk_fp8_f32(h[2], h[3], o0, true);
                int o1 = __builtin_amdgcn_cvt_pk_fp8_f32(h[4], h[5], 0, false); o1 = __builtin_amdgcn_cvt_pk_fp8_f32(h[6], h[7], o1, true);
                u32x2 o; o[0] = (unsigned)o0; o[1] = (unsigned)o1;
                *(u32x2*)rowp = o; }
    }
};
template <class Epi, class Sched, bool FP8 = false>
__device__ __forceinline__ void gemm_phase(LAS unsigned char* lds, const Gemm g, const Sched& S, const Epi& E, int sclW = 127, int sclA = 127) {
    int tid = threadIdx.x; asm volatile("" : "+v"(tid)); const int wid = __builtin_amdgcn_readfirstlane(tid >> 6), lane = tid & 63, wr = wid >> 2, wc = wid & 3, fr = lane & 15, fq = lane >> 4;
    const int K = g.K, rowb = FP8 ? K : 2 * K, nt = rowb / 128;
    int sclWv = sclW, sclAv = sclA; asm volatile("" : "+v"(sclWv), "+v"(sclAv));
    unsigned voffA[2], voffB[2];
#pragma unroll
    for (int i = 0; i < 2; ++i) { int R, C; stage_rc(tid * 16 + i * 8192, R, C); const int Rb = Epi::PERM ? ((R & ~31) + perm32(R & 31)) : R;
        voffA[i] = (unsigned)(R * rowb + 2 * C); voffB[i] = (unsigned)(Rb * rowb + 2 * C); }
    const size_t kstep = 128;
    const size_t hstep = (size_t)HALF * rowb;
    const unsigned ldsw = (unsigned)wid * 1024u;
    const int aoff = lds_byte(wr * 64 + fr, fq * 8), boff = lds_byte(wc * 32 + fr, fq * 8);
    constexpr int P2 = 1024;
#define PG8_SA(b, h) (((b) * 2 + (h)) * HTB)
#define PG8_SB(b, h) ((4 + (b) * 2 + (h)) * HTB)
#define PG8_STAGE(bufoff, gbase, voff) do { _Pragma("unroll") for (int _i = 0; _i < 2; ++_i) \
        __builtin_amdgcn_global_load_lds((const unsigned*)((const char*)(gbase) + (voff)[_i]), (LAS unsigned*)(lds + (bufoff) + ldsw + _i * 8192), 16, 0, 0); } while (0)
#define PG8_LDA(dst, b, h) do { _Pragma("unroll") for (int m = 0; m < 4; ++m) { \
        const v4i32 _l = *(const LAS v4i32*)(lds + PG8_SA(b, h) + aoff + m * 2048), _h = *(const LAS v4i32*)(lds + PG8_SA(b, h) + aoff + P2 + m * 2048); \
        dst[m] = __builtin_shufflevector(_l, _h, 0, 1, 2, 3, 4, 5, 6, 7); } } while (0)
#define PG8_LDB(dst, b, h) do { _Pragma("unroll") for (int n = 0; n < 2; ++n) { \
        const v4i32 _l = *(const LAS v4i32*)(lds + PG8_SB(b, h) + boff + n * 2048), _h = *(const LAS v4i32*)(lds + PG8_SB(b, h) + boff + P2 + n * 2048); \
        dst[n] = __builtin_shufflevector(_l, _h, 0, 1, 2, 3, 4, 5, 6, 7); } } while (0)
#define PG8_MMA(ai, bj, At, Bt) do { __builtin_amdgcn_s_setprio(1); _Pragma("unroll") for (int m = 0; m < 4; ++m) _Pragma("unroll") for (int n = 0; n < 2; ++n) { \
        if constexpr (FP8) { \
            asm volatile("v_mfma_scale_f32_16x16x128_f8f6f4 %0, %1, %2, %0, %3, %4 op_sel_hi:[0,0,0]" : "+v"(acc[ai][bj][m][n]) : "v"(Bt[n]), "v"(At[m]), "v"(sclWv), "v"(sclAv)); \
        } else { \
            acc[ai][bj][m][n] = __builtin_amdgcn_mfma_f32_16x16x32_bf16(__builtin_bit_cast(bf16x8, __builtin_shufflevector(Bt[n], Bt[n], 0, 1, 2, 3)), __builtin_bit_cast(bf16x8, __builtin_shufflevector(At[m], At[m], 0, 1, 2, 3)), acc[ai][bj][m][n], 0, 0, 0); \
            acc[ai][bj][m][n] = __builtin_amdgcn_mfma_f32_16x16x32_bf16(__builtin_bit_cast(bf16x8, __builtin_shufflevector(Bt[n], Bt[n], 4, 5, 6, 7)), __builtin_bit_cast(bf16x8, __builtin_shufflevector(At[m], At[m], 4, 5, 6, 7)), acc[ai][bj][m][n], 0, 0, 0); } } \
        __builtin_amdgcn_s_setprio(0); } while (0)
#define PG8_WAIT_V(n) asm volatile("s_waitcnt vmcnt(" #n ")" ::: "memory")
#define PG8_WAIT_L(n) asm volatile("s_waitcnt lgkmcnt(" #n ")" ::: "memory")
#define PG8_BAR __builtin_amdgcn_s_barrier()
#define PG8_SCHED __builtin_amdgcn_sched_barrier(0)
    Unit cur, nxt; int ui = 0;
    if (!S.next(0, cur)) return;
    uniformize(cur);
    f32x4 acc[2][2][4][2];
#pragma unroll
    for (int a = 0; a < 2; ++a)
#pragma unroll
        for (int b = 0; b < 2; ++b)
#pragma unroll
            for (int m = 0; m < 4; ++m)
#pragma unroll
                for (int n = 0; n < 2; ++n) acc[a][b][m][n] = (f32x4){0.f, 0.f, 0.f, 0.f};
    v8i32 At[4], B0[2], B1[2];
    const char* cA = (const char*)g.A + cur.aB; const char* cB = (const char*)g.Bt + cur.bB;
    PG8_STAGE(PG8_SB(0, 0), cB, voffB); PG8_STAGE(PG8_SA(0, 0), cA, voffA); PG8_STAGE(PG8_SB(0, 1), cB + hstep, voffB); PG8_STAGE(PG8_SA(0, 1), cA + hstep, voffA);
    if (wr == 1) PG8_BAR;
    PG8_WAIT_V(4); PG8_BAR;
    PG8_STAGE(PG8_SB(1, 0), cB + kstep, voffB); PG8_STAGE(PG8_SA(1, 0), cA + kstep, voffA); PG8_STAGE(PG8_SB(1, 1), cB + hstep + kstep, voffB);
    PG8_WAIT_V(6); PG8_BAR;
    for (;;) {
        const bool has_next = S.next(ui + 1, nxt);
        uniformize(nxt);
        const char* nA = has_next ? (const char*)g.A + nxt.aB : cA; const char* nB = has_next ? (const char*)g.Bt + nxt.bB : cB;
        for (int t = 0; t < nt; t += 2) {
            const bool last = (t == nt - 2);
            const char* a1 = cA + (size_t)(t + 1) * kstep;
            const char* a2 = last ? nA : cA + (size_t)(t + 2) * kstep; const char* b2 = last ? nB : cB + (size_t)(t + 2) * kstep;
            const char* a3 = a2 + kstep; const char* b3 = b2 + kstep;
            PG8_LDB(B0, 0, 0); PG8_SCHED; PG8_LDA(At, 0, 0); PG8_STAGE(PG8_SA(1, 1), a1 + hstep, voffA);
            PG8_WAIT_L(8); PG8_BAR; PG8_WAIT_L(0); PG8_MMA(0, 0, At, B0); PG8_BAR; PG8_SCHED;
            PG8_LDB(B1, 0, 1); PG8_STAGE(PG8_SB(0, 0), b2, voffB);
            PG8_BAR; PG8_WAIT_L(0); PG8_MMA(0, 1, At, B1); PG8_BAR;
            PG8_LDA(At, 0, 1); PG8_STAGE(PG8_SA(0, 0), a2, voffA);
            PG8_BAR; PG8_WAIT_L(0); PG8_MMA(1, 0, At, B0); PG8_BAR; PG8_SCHED;
            PG8_STAGE(PG8_SB(0, 1), b2 + hstep, voffB);
            PG8_WAIT_V(6); PG8_BAR; PG8_MMA(1, 1, At, B1); PG8_BAR;
            PG8_LDB(B0, 1, 0); PG8_SCHED; PG8_LDA(At, 1, 0); PG8_STAGE(PG8_SA(0, 1), a2 + hstep, voffA);
            PG8_WAIT_L(8); PG8_BAR; PG8_WAIT_L(0); PG8_MMA(0, 0, At, B0); PG8_BAR; PG8_SCHED;
            PG8_LDB(B1, 1, 1); PG8_STAGE(PG8_SB(1, 0), b3, voffB);
            PG8_BAR; PG8_WAIT_L(0); PG8_MMA(0, 1, At, B1); PG8_BAR;
            PG8_LDA(At, 1, 1); PG8_STAGE(PG8_SA(1, 0), a3, voffA);
            PG8_BAR; PG8_WAIT_L(0); PG8_MMA(1, 0, At, B0); PG8_BAR; PG8_SCHED;
            PG8_STAGE(PG8_SB(1, 1), b3 + hstep, voffB);
            PG8_WAIT_V(6); PG8_BAR; PG8_MMA(1, 1, At, B1); PG8_BAR;
        }
        if constexpr (FP8) asm volatile("s_nop 15\n\ts_nop 15" ::: "memory");
        E(acc, cur, wr, wc, fr, fq);
        if (!has_next) break;
#pragma unroll
        for (int a = 0; a < 2; ++a)
#pragma unroll
            for (int b = 0; b < 2; ++b)
#pragma unroll
                for (int m = 0; m < 4; ++m)
#pragma unroll
                    for (int n = 0; n < 2; ++n) acc[a][b][m][n] = (f32x4){0.f, 0.f, 0.f, 0.f};
        cur = nxt; cA = nA; cB = nB; ++ui;
    }
    PG8_WAIT_V(0);
    if (wr == 0) PG8_BAR;
    PG8_BAR;
#undef PG8_SA
#undef PG8_SB
#undef PG8_STAGE
#undef PG8_LDA
#undef PG8_LDB
#undef PG8_MMA
#undef PG8_WAIT_V
#undef PG8_WAIT_L
#undef PG8_BAR
#undef PG8_SCHED
}
}

constexpr int S_IN = 16 * 66, S_OUT = 16 * 16, S_GU = 16 * 11, S_DN = 11 * 16;
constexpr int CV_PER_L = S_IN + S_OUT + NE * 2 * S_GU + NE * S_DN;
constexpr int CV_A0 = S_IN + S_OUT;
constexpr int CV_A1 = CV_A0 + NE * 2 * S_GU;
constexpr int CV_TOTAL = DEPTH * CV_PER_L;
constexpr int CV_LAST = 1 << 30;
struct StripDesc { const float* src; bf16_t* dst; int lds_, ldd, k0, n0, drow0, fp8; };
__device__ __forceinline__ StripDesc strip_desc(const Params& p, int si) {
    unsigned char* ws = p.ws; StripDesc d;
    const int l = si / CV_PER_L; int r = si - l * CV_PER_L;
    if (r < S_IN) {
        const int kt = r / 66, ntl = r % 66;
        d.src = p.w_in + (size_t)l * D * INC; d.lds_ = INC; d.fp8 = INP8(l) ? 1 : 0; d.dst = (bf16_t*)(ws + WS_WIN) + (size_t)l * INC * D; d.ldd = D; d.k0 = kt * 128; d.n0 = ntl * 128; d.drow0 = ntl * 128;
    } else if (r < CV_A0) {
        r -= S_IN; const int kt = r / 16, ntl = r % 16;
        d.src = p.w_out + (size_t)l * D * D; d.lds_ = D; d.dst = (bf16_t*)(ws + WS_WOUT) + (size_t)l * D * D; d.ldd = D; d.k0 = kt * 128; d.n0 = ntl * 128; d.drow0 = ntl * 128; d.fp8 = OUT8(l) ? 1 : 0;
    } else if (r < CV_A1) {
        r -= CV_A0; const int mat = r / S_GU, q = r % S_GU, kt = q / 11, ntl = q % 11;
        const int which = mat & 1, le = l * NE + (mat >> 1);
        d.src = (which ? p.w_up : p.w_gate) + (size_t)le * D * DE; d.lds_ = DE; d.fp8 = MOE_FP8; d.dst = MOE_FP8 ? (bf16_t*)(ws + WS_WGU + (size_t)le * (2 * DE) * D) : (bf16_t*)(ws + WS_WGU) + (size_t)le * (2 * DE) * D; d.ldd = D; d.k0 = kt * 128; d.n0 = ntl * 128; d.drow0 = ntl * 256 + which * 128;
    } else {
        r -= CV_A1; const int le = l * NE + r / S_DN, q = r % S_DN, kt = q / 16, ntl = q % 16;
        d.src = p.w_down + (size_t)le * DE * D; d.lds_ = D; d.fp8 = MOE_FP8; d.dst = MOE_FP8 ? (bf16_t*)(ws + WS_WD + (size_t)le * D * DEP) : (bf16_t*)(ws + WS_WD) + (size_t)le * D * DE; d.ldd = MOE_FP8 ? DEP : DE; d.k0 = kt * 128; d.n0 = ntl * 128; d.drow0 = ntl * 128;
    }
    return d;
}
__device__ __forceinline__ void cvt_store_strip(const StripDesc& d, const float4 (&a)[2][2], const float4 (&b)[2][2], LAS unsigned char* tb, int tid, bool readout) {
    const int kp = tid >> 4, n4 = (tid & 15) * 4;
    if (!readout) {
        if (!d.fp8) {
#pragma unroll
            for (int ki = 0; ki < 2; ++ki)
#pragma unroll
                for (int ni = 0; ni < 2; ++ni) {
                    LAS unsigned* t = (LAS unsigned*)tb + (ki * 2 + ni) * 2112;
                    t[(n4 + 0) * 33 + kp] = pack2a(a[ki][ni].x, b[ki][ni].x);
                    t[(n4 + 1) * 33 + kp] = pack2a(a[ki][ni].y, b[ki][ni].y);
                    t[(n4 + 2) * 33 + kp] = pack2a(a[ki][ni].z, b[ki][ni].z);
                    t[(n4 + 3) * 33 + kp] = pack2a(a[ki][ni].w, b[ki][ni].w);
                }
        } else {
#pragma unroll
            for (int ki = 0; ki < 2; ++ki)
#pragma unroll
                for (int ni = 0; ni < 2; ++ni) {
                    LAS unsigned char* t = tb + (ki * 2 + ni) * 4352;
                    *(LAS unsigned short*)(t + (n4 + 0) * 68 + 2 * kp) = (unsigned short)__builtin_amdgcn_cvt_pk_fp8_f32(a[ki][ni].x * W8_SCALE, b[ki][ni].x * W8_SCALE, 0, false);
                    *(LAS unsigned short*)(t + (n4 + 1) * 68 + 2 * kp) = (unsigned short)__builtin_amdgcn_cvt_pk_fp8_f32(a[ki][ni].y * W8_SCALE, b[ki][ni].y * W8_SCALE, 0, false);
                    *(LAS unsigned short*)(t + (n4 + 2) * 68 + 2 * kp) = (unsigned short)__builtin_amdgcn_cvt_pk_fp8_f32(a[ki][ni].z * W8_SCALE, b[ki][ni].z * W8_SCALE, 0, false);
                    *(LAS unsigned short*)(t + (n4 + 3) * 68 + 2 * kp) = (unsigned short)__builtin_amdgcn_cvt_pk_fp8_f32(a[ki][ni].w * W8_SCALE, b[ki][ni].w * W8_SCALE, 0, false);
                }
        }
    } else {
        if (!d.fp8) {
            const int n = tid >> 3, kc = (tid & 7) * 4;
#pragma unroll
            for (int ki = 0; ki < 2; ++ki)
#pragma unroll
                for (int ni = 0; ni < 2; ++ni) {
                    const LAS unsigned* t = (const LAS unsigned*)tb + (ki * 2 + ni) * 2112;
                    u32x4 o; o[0] = t[n * 33 + kc]; o[1] = t[n * 33 + kc + 1]; o[2] = t[n * 33 + kc + 2]; o[3] = t[n * 33 + kc + 3];
                    *(u32x4*)(d.dst + (size_t)(d.drow0 + ni * 64 + n) * d.ldd + d.k0 + ki * 64 + kc * 2) = o;
                }
        } else {
            const int n = tid >> 3, kc8 = (tid & 7) * 8;
            unsigned char* dst8 = (unsigned char*)d.dst;
#pragma unroll
            for (int ki = 0; ki < 2; ++ki)
#pragma unroll
                for (int ni = 0; ni < 2; ++ni) {
                    const LAS unsigned char* t = tb + (ki * 2 + ni) * 4352;
                    u32x2 o; o[0] = *(const LAS unsigned*)(t + n * 68 + kc8); o[1] = *(const LAS unsigned*)(t + n * 68 + kc8 + 4);
                    *(u32x2*)(dst8 + (size_t)(d.drow0 + ni * 64 + n) * d.ldd + d.k0 + ki * 64 + kc8) = o;
                }
        }
    }
}
__device__ __forceinline__ void cvt_pull(const Params& p, LAS unsigned char* lds, int limit, unsigned* done_ctr, unsigned need_done) {
    int tid = threadIdx.x; asm volatile("" : "+v"(tid));
    LAS int* slot = (LAS int*)(lds + LDS_MISC + 512);
    unsigned* head = (unsigned*)(p.ws + WS_CVTQ);
    if (tid == 0) {
        int sv = -1;
        const bool stop = done_ctr ? (xb_ld(done_ctr) >= need_done) : (xb_ld(head) >= (unsigned)limit);
        if (!stop) { const unsigned c = xb_add(head, 2u); sv = c < (unsigned)CV_TOTAL ? (int)c : -1; }
        slot[0] = sv;
    }
    __syncthreads();
    const int kp = tid >> 4, n4 = (tid & 15) * 4;
    for (;;) {
        const int sraw = slot[0];
        if (sraw < 0) break;
        const int si = sraw & (CV_LAST - 1); const bool lastone = (sraw & CV_LAST) != 0;
        const StripDesc d0 = strip_desc(p, si), d1 = strip_desc(p, si + 1);
        float4 a0[2][2], b0[2][2], a1[2][2], b1[2][2];
#pragma unroll
        for (int ki = 0; ki < 2; ++ki)
#pragma unroll
            for (int ni = 0; ni < 2; ++ni) {
                a0[ki][ni] = *(const float4*)(d0.src + (size_t)(d0.k0 + ki * 64 + 2 * kp) * d0.lds_ + d0.n0 + ni * 64 + n4);
                b0[ki][ni] = *(const float4*)(d0.src + (size_t)(d0.k0 + ki * 64 + 2 * kp + 1) * d0.lds_ + d0.n0 + ni * 64 + n4);
            }
#pragma unroll
        for (int ki = 0; ki < 2; ++ki)
#pragma unroll
            for (int ni = 0; ni < 2; ++ni) {
                a1[ki][ni] = *(const float4*)(d1.src + (size_t)(d1.k0 + ki * 64 + 2 * kp) * d1.lds_ + d1.n0 + ni * 64 + n4);
                b1[ki][ni] = *(const float4*)(d1.src + (size_t)(d1.k0 + ki * 64 + 2 * kp + 1) * d1.lds_ + d1.n0 + ni * 64 + n4);
            }
        unsigned c = 0u, dn = 0u;
        if (tid == 0 && !lastone) { c = xb_add(head, 2u); if (done_ctr) dn = xb_ld(done_ctr); }
        cvt_store_strip(d0, a0, b0, lds, tid, false);
        cvt_store_strip(d1, a1, b1, lds + 33792, tid, false);
        LDS_BARRIER();
        cvt_store_strip(d0, a0, b0, lds, tid, true);
        cvt_store_strip(d1, a1, b1, lds + 33792, tid, true);
        if (tid == 0) {
            int sv = -1;
            if (!lastone && c < (unsigned)CV_TOTAL) { const bool fin = done_ctr ? (dn >= need_done) : (c >= (unsigned)limit); sv = (int)c | (fin ? CV_LAST : 0); }
            slot[0] = sv;
        }
        LDS_BARRIER();
    }
    __syncthreads();
}
__device__ __forceinline__ void tail_pull(const Params& p, LAS unsigned char* lds, int ctr_idx) {
    unsigned* ctr = (unsigned*)(p.ws + WS_CVTQ) + 64 * (1 + ctr_idx);
    __syncthreads();
    if (threadIdx.x == 0) (void)xb_add(ctr, 1u);
    cvt_pull(p, lds, 0, ctr, gridDim.x);
}

__device__ __forceinline__ void ada_chunks(const Params& p, LAS unsigned char* lds, int ch0, int ch_end, int step) {
    int tid = threadIdx.x; asm volatile("" : "+v"(tid));
    unsigned char* ws = p.ws;
    LAS float* cond = (LAS float*)lds;
    LAS float* red = (LAS float*)(lds + 32768);
    if (ch0 >= ch_end) return;
    for (int i = tid; i < 4 * D; i += 512) { const float v = p.c[i]; cond[i] = siluf_(v); }
    __syncthreads();
    for (int ch = ch0; ch < ch_end; ch += step) {
        const int l = ch >> 7, j0 = (ch & 127) * 96;
        const float* w = p.w_ada + (size_t)l * D * (6 * D);
        const int kg = tid / 24, cl = tid % 24;
        float acc[4][4];
#pragma unroll
        for (int b = 0; b < 4; ++b)
#pragma unroll
            for (int j = 0; j < 4; ++j) acc[b][j] = 0.f;
        if (kg < 21) {
            for (int it0 = 0; it0 < 98; it0 += 14) {
                float4 wv[14];
#pragma unroll
                for (int q = 0; q < 14; ++q) { const int k = kg + 21 * (it0 + q); wv[q] = (k < D) ? *(const float4*)(w + (size_t)k * (6 * D) + j0 + cl * 4) : make_float4(0.f, 0.f, 0.f, 0.f); }
#pragma unroll
                for (int q = 0; q < 14; ++q) { const int k = kg + 21 * (it0 + q); const int kc = k < D ? k : 0;
#pragma unroll
                    for (int b = 0; b < 4; ++b) { const float cv = cond[b * D + kc]; acc[b][0] += cv * wv[q].x; acc[b][1] += cv * wv[q].y; acc[b][2] += cv * wv[q].z; acc[b][3] += cv * wv[q].w; } }
            }
#pragma unroll
            for (int b = 0; b < 4; ++b)
#pragma unroll
                for (int j = 0; j < 4; ++j) red[(kg * 4 + b) * 96 + cl * 4 + j] = acc[b][j];
        }
        __syncthreads();
        if (tid < 384) {
            const int b = tid / 96, col = tid % 96; float s = 0.f;
            for (int g = 0; g < 21; ++g) s += red[(g * 4 + b) * 96 + col];
            float* mod = (float*)(ws + WS_MOD);
            mod[((size_t)l * 4 + b) * (6 * D) + j0 + col] = s + p.b_ada[(size_t)l * 6 * D + j0 + col];
        }
        __syncthreads();
    }
}
__device__ __forceinline__ void phase_prologue(const Params& p, LAS unsigned char* lds) {
    const bool svc = (gridDim.x >= 256);
    ada_chunks(p, lds, blockIdx.x, svc ? 128 : 256, gridDim.x);
    cvt_pull(p, lds, CV_A0, nullptr, 0u);
}

#define COLK(k) ((unsigned)((((k) >> 1) << 9) + lane * 8 + (((k) & 1) << 2)))
#define COL8(i) ((unsigned)(((i) << 9) + lane * 8))
__device__ __forceinline__ void ld_bf8(const bf16_t* p, float4& a, float4& b) {
    const u32x4 r = *(const u32x4*)p;
    a = make_float4(bf2f(r[0] & 0xffffu), bf2f(r[0] >> 16), bf2f(r[1] & 0xffffu), bf2f(r[1] >> 16));
    b = make_float4(bf2f(r[2] & 0xffffu), bf2f(r[2] >> 16), bf2f(r[3] & 0xffffu), bf2f(r[3] >> 16));
}
__device__ __forceinline__ void st_bf8(bf16_t* p, const float4& a, const float4& b) {
    u32x4 o; o[0] = pack2a(a.x, a.y); o[1] = pack2a(a.z, a.w); o[2] = pack2a(b.x, b.y); o[3] = pack2a(b.z, b.w);
    *(u32x4*)p = o;
}
__device__ __forceinline__ void st_fp8x8(unsigned char* p, const float4& a, const float4& b) {
    int o0 = __builtin_amdgcn_cvt_pk_fp8_f32(a.x, a.y, 0, false); o0 = __builtin_amdgcn_cvt_pk_fp8_f32(a.z, a.w, o0, true);
    int o1 = __builtin_amdgcn_cvt_pk_fp8_f32(b.x, b.y, 0, false); o1 = __builtin_amdgcn_cvt_pk_fp8_f32(b.z, b.w, o1, true);
    u32x2 o; o[0] = (unsigned)o0; o[1] = (unsigned)o1;
    *(u32x2*)p = o;
}
__device__ __forceinline__ void ln_rows(float4 (&v)[8], const float* __restrict__ g, const float* __restrict__ b, int lane) {
    float s = 0.f;
#pragma unroll
    for (int i = 0; i < 8; ++i) s += (v[i].x + v[i].y) + (v[i].z + v[i].w);
    const float mean = wave_sum(s) * (1.0f / D);
    float q = 0.f;
#pragma unroll
    for (int i = 0; i < 8; ++i) { const float a = v[i].x - mean, bb = v[i].y - mean, c = v[i].z - mean, d = v[i].w - mean; q += (a * a + bb * bb) + (c * c + d * d); }
    const float rstd = rsqrtf(wave_sum(q) * (1.0f / D) + 1e-5f);
#pragma unroll
    for (int i = 0; i < 8; ++i) {
        const float4 gv = *(const float4*)(g + COLK(i)), bv = *(const float4*)(b + COLK(i));
        v[i].x = (v[i].x - mean) * rstd * gv.x + bv.x; v[i].y = (v[i].y - mean) * rstd * gv.y + bv.y;
        v[i].z = (v[i].z - mean) * rstd * gv.z + bv.z; v[i].w = (v[i].w - mean) * rstd * gv.w + bv.w;
    }
}
__device__ __forceinline__ void modulate_store(const float4 (&v)[8], const float* __restrict__ shift, const float* __restrict__ scale, bf16_t* __restrict__ dst, int lane, bool fp8) {
#pragma unroll
    for (int i = 0; i < 4; ++i) {
        float4 h[2];
#pragma unroll
        for (int q = 0; q < 2; ++q) {
            const float4 sh = *(const float4*)(shift + COLK(2 * i + q)), sc = *(const float4*)(scale + COLK(2 * i + q));
            const float4 x = v[2 * i + q];
            h[q] = make_float4(x.x * (1.f + sc.x) + sh.x, x.y * (1.f + sc.y) + sh.y, x.z * (1.f + sc.z) + sh.z, x.w * (1.f + sc.w) + sh.w);
        }
        if (fp8) st_fp8x8((unsigned char*)dst + COL8(i), h[0], h[1]);
        else st_bf8(dst + COL8(i), h[0], h[1]);
    }
}

__device__ __forceinline__ void phase_ln0(const Params& p) {
    int tid_ = threadIdx.x; asm volatile("" : "+v"(tid_)); const int wave = __builtin_amdgcn_readfirstlane(tid_ >> 6), lane = tid_ & 63;
    const float* mod = (const float*)(p.ws + WS_MOD);
    for (int n = blockIdx.x * 8 + wave; n < T; n += gridDim.x * 8) {
        const int b = n / SEQ;
        float4 v[8];
#pragma unroll
        for (int i = 0; i < 8; ++i) v[i] = *(const float4*)(p.x + (size_t)n * D + COLK(i));
        ln_rows(v, p.emb_g, p.emb_b, lane);
        bf16_t* xr = (bf16_t*)(p.ws + WS_XRES) + (size_t)n * D;
#pragma unroll
        for (int i = 0; i < 4; ++i) st_bf8(xr + COL8(i), v[2 * i], v[2 * i + 1]);
        const float* mb = mod + ((size_t)0 * 4 + b) * (6 * D);
        modulate_store(v, mb, mb + D, INP8(0) ? (bf16_t*)(p.ws + WS_HA + (size_t)n * D) : (bf16_t*)(p.ws + WS_HA) + (size_t)n * D, lane, INP8(0));
    }
}

__device__ __forceinline__ void phase_mixer_valu(const Params& p, int l, LAS unsigned char* lds) {
    LAS float* qs = (LAS float*)lds; LAS float* ks = qs + 4096; LAS float* fs = ks + 4096; LAS float* vs = fs + 4096; LAS float* po = vs + 1024;
    int tid = threadIdx.x; asm volatile("" : "+v"(tid)); const int wave = tid >> 6, lane = tid & 63, kk = tid >> 5, vv = tid & 31;
    const bf16_t* proj = (const bf16_t*)(p.ws + WS_PROJ);
    float* obuf = (float*)(p.ws + WS_OBUF);
    for (int u = blockIdx.x; u < 384; u += gridDim.x) {
        const int vsl = u & 3, dir = (u >> 2) & 1, hh = (u >> 3) % 6, b = ((u >> 3) / 6) % 4, type = (u >> 3) / 24;
        float S[8];
#pragma unroll
        for (int j = 0; j < 8; ++j) S[j] = 0.f;
        const float gamma = 1.0f - exp2f(-(dir ? 5.5f : 5.0f) - (float)hh);
        for (int blk = 0; blk < 64; ++blk) {
            const int rb = dir ? 63 - blk : blk, t0 = rb * 32;
            if (type == 0) {
#pragma unroll
                for (int j = 0; j < 4; ++j) {
                    const int idx = tid + 512 * j, tt = idx >> 6, dp = idx & 63;
                    const bf16_t* row = proj + (size_t)(b * SEQ + t0 + tt) * INC;
                    const float q1 = bf2f(row[C_RQ + hh * 128 + dp]), q2 = bf2f(row[C_RQ + hh * 128 + 64 + dp]);
                    const float k1 = bf2f(row[C_RK + hh * 128 + dp]), k2 = bf2f(row[C_RK + hh * 128 + 64 + dp]);
                    const float inv_freq = exp2f(-(float)dp * (13.287712379549449f / 64.0f));
                    const float ang = (float)(t0 + tt) * inv_freq;
                    float rev = ang * 0.15915494309189535f; rev -= rintf(rev);
                    const float sn = __builtin_amdgcn_sinf(rev), cs = __builtin_amdgcn_cosf(rev);
                    qs[tt * 128 + dp] = q1 * cs - q2 * sn; qs[tt * 128 + 64 + dp] = q1 * sn + q2 * cs;
                    ks[tt * 128 + dp] = (k1 * cs - k2 * sn) * 0.08838834764831845f; ks[tt * 128 + 64 + dp] = (k1 * sn + k2 * cs) * 0.08838834764831845f;
                    fs[tt * 128 + dp] = gamma; fs[tt * 128 + 64 + dp] = gamma;
                }
            } else {
#pragma unroll
                for (int j = 0; j < 8; ++j) {
                    const int idx = tid + 512 * j, tt = idx >> 7, d = idx & 127;
                    const bf16_t* row = proj + (size_t)(b * SEQ + t0 + tt) * INC;
                    const float q = bf2f(row[C_HQ + hh * 128 + d]);
                    const float z = bf2f(row[(dir ? C_HFB : C_HFF) + hh * 128 + d]);
                    float lb = 0.f;
                    if (l > 0) { const float a0 = p.lb_logits[(0 * 2 + dir) * HWD + hh * 128 + d], a1 = p.lb_logits[(1 * 2 + dir) * HWD + hh * 128 + d]; lb = 1.0f / (1.0f + expf(a0 - a1)); }
                    float f = lb + (1.0f - lb) * (1.0f / (1.0f + expf(-z)));
                    f = fmaxf(f, 1e-6f);
                    qs[tt * 128 + d] = q; ks[tt * 128 + d] = 1.0f - f; fs[tt * 128 + d] = f;
                }
            }
#pragma unroll
            for (int j = 0; j < 2; ++j) {
                const int idx = tid + 512 * j, tt = idx >> 5, c = idx & 31;
                const bf16_t* row = proj + (size_t)(b * SEQ + t0 + tt) * INC;
                vs[tt * 32 + c] = bf2f(row[(type ? C_HI : C_RV) + hh * 128 + vsl * 32 + c]);
            }
            __syncthreads();
            for (int s = 0; s < 32; ++s) {
                const int ss = dir ? 31 - s : s;
                const f32x4 qa = *(const LAS f32x4*)(qs + ss * 128 + kk * 8), qb = *(const LAS f32x4*)(qs + ss * 128 + kk * 8 + 4);
                const f32x4 ka = *(const LAS f32x4*)(ks + ss * 128 + kk * 8), kb = *(const LAS f32x4*)(ks + ss * 128 + kk * 8 + 4);
                const f32x4 fa = *(const LAS f32x4*)(fs + ss * 128 + kk * 8), fb = *(const LAS f32x4*)(fs + ss * 128 + kk * 8 + 4);
                const float vval = vs[ss * 32 + vv];
                float acc = 0.f;
#pragma unroll
                for (int j = 0; j < 4; ++j) { S[j] = fa[j] * S[j] + ka[j] * vval; acc += S[j] * qa[j]; }
#pragma unroll
                for (int j = 0; j < 4; ++j) { S[4 + j] = fb[j] * S[4 + j] + kb[j] * vval; acc += S[4 + j] * qb[j]; }
                acc += __shfl_xor(acc, 32, 64);
                if (lane < 32) po[(ss * 8 + wave) * 32 + vv] = acc;
            }
            __syncthreads();
#pragma unroll
            for (int j = 0; j < 2; ++j) {
                const int idx = tid + 512 * j, tt = idx >> 5, c = idx & 31;
                float s = 0.f;
#pragma unroll
                for (int w = 0; w < 8; ++w) s += po[(tt * 8 + w) * 32 + c];
                obuf[((size_t)dir * T + (size_t)(b * SEQ + t0 + tt)) * 1536 + type * 768 + hh * 128 + vsl * 32 + c] = s;
            }
        }
        __syncthreads();
    }
}

constexpr int MX_QI = 0, MX_KI = 17408, MX_QS = 34816, MX_KTT = 52224, MX_VT = 70656, MX_P = 79872, MX_ST = 89088, MX_TOT = 106496, MX_DEC = 110592, MX_RQ = 112128, MX_RK = 128512, MX_RV = 144896;
__device__ __forceinline__ float ex2(float x) { return __builtin_amdgcn_exp2f(x); }
__device__ __forceinline__ float clampe(float x) { return fminf(fmaxf(x, -120.f), 120.f); }
template <int MODE>
__device__ __forceinline__ void phase_mixer_mfma(const Params& p, int l, LAS unsigned char* lds, float* __restrict__ obuf) {
    int tid = threadIdx.x; asm volatile("" : "+v"(tid));
    const int wave = __builtin_amdgcn_readfirstlane(tid >> 6), lane = tid & 63, fr = lane & 15, fq = lane >> 4;
    const bf16_t* proj = (const bf16_t*)(p.ws + WS_PROJ);
    for (int u = blockIdx.x; u < 192; u += gridDim.x) {
        const int vsl = u & 1, dir = (u >> 1) & 1, hh = (u >> 2) % 6, b = ((u >> 2) / 6) % 4, type = (u >> 2) / 24;
        float lg2 = 0.f, invf0 = 0.f, invf1 = 0.f, sgn = 1.f, lb0 = 0.f, lb1 = 0.f;
        if (type == 0) {
            const float gamma = 1.0f - exp2f(-(dir ? 5.5f : 5.0f) - (float)hh);
            lg2 = log2f(gamma);
            const int dm0 = (2 * lane) & 63;
            invf0 = exp2f(-(float)dm0 * (13.287712379549449f / 64.0f)); invf1 = exp2f(-(float)(dm0 + 1) * (13.287712379549449f / 64.0f));
            sgn = lane < 32 ? -1.f : 1.f;
        } else if (l > 0) {
            const float* lbl = p.lb_logits + dir * HWD + hh * 128 + 2 * lane;
            lb0 = 1.0f / (1.0f + expf(lbl[0] - lbl[2 * HWD])); lb1 = 1.0f / (1.0f + expf(lbl[1] - lbl[2 * HWD + 1]));
        }
        const int colA = (type ? C_HQ : C_RQ) + hh * 128, colB = (type ? (dir ? C_HFB : C_HFF) : C_RK) + hh * 128;
        const int colV0 = (type ? C_HI : C_RV) + hh * 128 + vsl * 64;
        const int own = 2 * lane, par = (2 * lane + 64) & 127;
        const size_t ocol = (size_t)type * 768 + hh * 128 + vsl * 64;
#define MX_LOAD(ch) do { \
            _Pragma("unroll") for (int i2 = 0; i2 < 2; ++i2) { const int pos = wave * 8 + i2 * 4 + (lane >> 4); const int tau = (ch) * 64 + pos; const int t = dir ? (SEQ - 1 - tau) : tau; \
                const bf16_t* row = proj + (size_t)(b * SEQ + t) * INC + (lane & 15) * 8; \
                __builtin_amdgcn_global_load_lds((const unsigned*)(row + colA), (LAS unsigned*)(lds + MX_RQ + (wave * 8 + i2 * 4) * 256), 16, 0, 0); \
                __builtin_amdgcn_global_load_lds((const unsigned*)(row + colB), (LAS unsigned*)(lds + MX_RK + (wave * 8 + i2 * 4) * 256), 16, 0, 0); } \
            { const int pos = wave * 8 + (lane >> 3); const int tau = (ch) * 64 + pos; const int t = dir ? (SEQ - 1 - tau) : tau; \
              const bf16_t* row = proj + (size_t)(b * SEQ + t) * INC + colV0 + (lane & 7) * 8; \
              __builtin_amdgcn_global_load_lds((const unsigned*)row, (LAS unsigned*)(lds + MX_RV + (wave * 8) * 128), 16, 0, 0); } } while (0)
        f32x4 Sacc[4];
#pragma unroll
        for (int vt = 0; vt < 4; ++vt) Sacc[vt] = (f32x4){0.f, 0.f, 0.f, 0.f};
        for (int i = tid; i < 64 * 272 / 4; i += 512) ((LAS unsigned*)(lds + MX_ST))[i] = 0u;
        float cd0 = 1.f, sd0 = 0.f, cd1 = 1.f, sd1 = 0.f;
        if (type == 0) {
            if (tid < 64) { const float fi = (float)tid; *(LAS f32x4*)(lds + MX_DEC + 512 + tid * 16) = (f32x4){ex2((fi - 31.f) * lg2), ex2((31.f - fi) * lg2), ex2((fi + 1.f) * lg2), ex2((63.f - fi) * lg2)}; }
            const float r0 = invf0 * 0.15915494309189535f, r1 = invf1 * 0.15915494309189535f, sg = dir ? -1.f : 1.f;
            cd0 = __builtin_amdgcn_cosf(r0); sd0 = sg * __builtin_amdgcn_sinf(r0); cd1 = __builtin_amdgcn_cosf(r1); sd1 = sg * __builtin_amdgcn_sinf(r1);
        }
        __syncthreads();
        MX_LOAD(0);
        asm volatile("s_waitcnt vmcnt(0)" ::: "memory");
        __syncthreads();
        for (int ch = 0; ch < 32; ++ch) {
            float q0[8], q1[8], k0[8], k1[8], c0[8], c1[8];
            float run0 = 0.f, run1 = 0.f;
            u32x4 vpk = (u32x4){0u, 0u, 0u, 0u};
#pragma unroll
            for (int j = 0; j < 8; ++j) { q0[j] = q1[j] = k0[j] = k1[j] = c0[j] = c1[j] = 0.f; }
            if (MODE != 3 && MODE != 4) {
            if (type == 0) {
                const int tau0 = ch * 64 + wave * 8; const int t0 = dir ? (SEQ - 1 - tau0) : tau0;
                float rev0 = (float)t0 * invf0 * 0.15915494309189535f, rev1 = (float)t0 * invf1 * 0.15915494309189535f;
                rev0 -= rintf(rev0); rev1 -= rintf(rev1);
                float sn0 = __builtin_amdgcn_sinf(rev0), cs0 = __builtin_amdgcn_cosf(rev0), sn1 = __builtin_amdgcn_sinf(rev1), cs1 = __builtin_amdgcn_cosf(rev1);
#pragma unroll
                for (int j = 0; j < 8; ++j) {
                    const int pos_ = wave * 8 + j;
                    const unsigned ra_ = *(const LAS unsigned*)(lds + MX_RQ + pos_ * 256 + own * 2), rb_ = *(const LAS unsigned*)(lds + MX_RK + pos_ * 256 + own * 2);
                    const unsigned rc_ = *(const LAS unsigned*)(lds + MX_RQ + pos_ * 256 + par * 2), rd_ = *(const LAS unsigned*)(lds + MX_RK + pos_ * 256 + par * 2);
                    const float a_lo = bf2f(ra_ & 0xffffu), a_hi = bf2f(ra_ >> 16), b_lo = bf2f(rb_ & 0xffffu), b_hi = bf2f(rb_ >> 16);
                    const float pa_lo = bf2f(rc_ & 0xffffu), pa_hi = bf2f(rc_ >> 16), pb_lo = bf2f(rd_ & 0xffffu), pb_hi = bf2f(rd_ >> 16);
                    const float ss0 = sgn * sn0, ss1 = sgn * sn1;
                    q0[j] = a_lo * cs0 + pa_lo * ss0; q1[j] = a_hi * cs1 + pa_hi * ss1;
                    k0[j] = (b_lo * cs0 + pb_lo * ss0) * 0.08838834764831845f; k1[j] = (b_hi * cs1 + pb_hi * ss1) * 0.08838834764831845f;
                    const float nc0 = cs0 * cd0 - sn0 * sd0, ns0 = sn0 * cd0 + cs0 * sd0, nc1 = cs1 * cd1 - sn1 * sd1, ns1 = sn1 * cd1 + cs1 * sd1;
                    cs0 = nc0; sn0 = ns0; cs1 = nc1; sn1 = ns1;
                    c0[j] = 0.f; c1[j] = 0.f;
                }
            } else {
#pragma unroll
                for (int j = 0; j < 8; ++j) {
                    const int pos_ = wave * 8 + j;
                    const unsigned ra_ = *(const LAS unsigned*)(lds + MX_RQ + pos_ * 256 + own * 2), rb_ = *(const LAS unsigned*)(lds + MX_RK + pos_ * 256 + own * 2);
                    const float a_lo = bf2f(ra_ & 0xffffu), a_hi = bf2f(ra_ >> 16), b_lo = bf2f(rb_ & 0xffffu), b_hi = bf2f(rb_ >> 16);
                    q0[j] = a_lo; q1[j] = a_hi;
                    float f0 = lb0 + (1.0f - lb0) * __builtin_amdgcn_rcpf(1.0f + ex2(-b_lo * 1.4426950408889634f));
                    float f1 = lb1 + (1.0f - lb1) * __builtin_amdgcn_rcpf(1.0f + ex2(-b_hi * 1.4426950408889634f));
                    f0 = fmaxf(f0, 1e-6f); f1 = fmaxf(f1, 1e-6f);
                    k0[j] = 1.0f - f0; k1[j] = 1.0f - f1;
                    run0 += __builtin_amdgcn_logf(f0); run1 += __builtin_amdgcn_logf(f1); c0[j] = run0; c1[j] = run1;
                }
            }
            { unsigned rv[8];
#pragma unroll
              for (int j = 0; j < 8; ++j) rv[j] = *(const LAS unsigned short*)(lds + MX_RV + (wave * 8 + j) * 128 + lane * 2);
              vpk[0] = rv[0] | (rv[1] << 16); vpk[1] = rv[2] | (rv[3] << 16); vpk[2] = rv[4] | (rv[5] << 16); vpk[3] = rv[6] | (rv[7] << 16); }
            }
            { typedef float f32x2_ __attribute__((ext_vector_type(2))); *(LAS f32x2_*)(lds + MX_TOT + (wave * 128 + 2 * lane) * 4) = (f32x2_){run0, run1}; }
            LDS_BARRIER();
            if (ch + 1 < 32) MX_LOAD(ch + 1);
            float kt0[8], kt1[8];
            float tt0, tt1;
#pragma unroll
            for (int j = 0; j < 8; ++j) { kt0[j] = kt1[j] = 0.f; }
            tt0 = tt1 = 0.f;
            if (MODE != 3 && MODE != 4) {
            if (type == 0) {
                tt0 = tt1 = 64.f * lg2;
#pragma unroll
                for (int j = 0; j < 8; ++j) {
                    const int pos = wave * 8 + j;
                    const f32x4 e = *(const LAS f32x4*)(lds + MX_DEC + 512 + pos * 16);
                    *(LAS unsigned*)(lds + MX_QI + pos * 272 + lane * 4) = pack2(q0[j] * e[0], q1[j] * e[0]);
                    *(LAS unsigned*)(lds + MX_KI + pos * 272 + lane * 4) = pack2(k0[j] * e[1], k1[j] * e[1]);
                    kt0[j] = k0[j] * e[3]; kt1[j] = k1[j] * e[3];
                }
            } else {
                float off0 = 0.f, off1 = 0.f, m0 = 0.f, m1 = 0.f; tt0 = 0.f; tt1 = 0.f;
#pragma unroll
                for (int g = 0; g < 8; ++g) {
                    typedef float f32x2_ __attribute__((ext_vector_type(2)));
                    const f32x2_ tv = *(const LAS f32x2_*)(lds + MX_TOT + (g * 128 + 2 * lane) * 4);
                    if (g < wave) { off0 += tv[0]; off1 += tv[1]; }
                    if (g < 4) { m0 += tv[0]; m1 += tv[1]; }
                    tt0 += tv[0]; tt1 += tv[1];
                }
                const float etm0 = ex2(tt0 - m0), etm1 = ex2(tt1 - m1);
#pragma unroll
                for (int j = 0; j < 8; ++j) {
                    const float cu0 = c0[j] + off0, cu1 = c1[j] + off1;
                    const float e10 = ex2(clampe(cu0 - m0)), e11 = ex2(clampe(cu1 - m1));
                    const float e20 = __builtin_amdgcn_rcpf(e10), e21 = __builtin_amdgcn_rcpf(e11);
                    const int pos = wave * 8 + j;
                    *(LAS unsigned*)(lds + MX_QI + pos * 272 + lane * 4) = pack2(q0[j] * e10, q1[j] * e11);
                    *(LAS unsigned*)(lds + MX_KI + pos * 272 + lane * 4) = pack2(k0[j] * e20, k1[j] * e21);
                    kt0[j] = k0[j] * (e20 * etm0); kt1[j] = k1[j] * (e21 * etm1);
                }
            }
            }
            { u32x4 w0, w1;
              w0[0] = pack2(kt0[0], kt0[1]); w0[1] = pack2(kt0[2], kt0[3]); w0[2] = pack2(kt0[4], kt0[5]); w0[3] = pack2(kt0[6], kt0[7]);
              w1[0] = pack2(kt1[0], kt1[1]); w1[1] = pack2(kt1[2], kt1[3]); w1[2] = pack2(kt1[4], kt1[5]); w1[3] = pack2(kt1[6], kt1[7]);
              *(LAS u32x4*)(lds + MX_KTT + (2 * lane) * 144 + wave * 16) = w0;
              *(LAS u32x4*)(lds + MX_KTT + (2 * lane + 1) * 144 + wave * 16) = w1;
              *(LAS u32x4*)(lds + MX_VT + lane * 144 + wave * 16) = vpk; }
            if (MODE != 3 && MODE != 4) {
                f32x4 em;
                if (type == 0) { const float e_ = ex2(32.f * lg2); em = (f32x4){e_, e_, e_, e_}; }
                else {
                    f32x4 ms = (f32x4){0.f, 0.f, 0.f, 0.f};
#pragma unroll
                    for (int g = 0; g < 4; ++g) ms += *(const LAS f32x4*)(lds + MX_TOT + (g * 128 + 16 * wave + 4 * fq) * 4);
                    em = (f32x4){ex2(ms[0]), ex2(ms[1]), ex2(ms[2]), ex2(ms[3])};
                }
#pragma unroll
                for (int vt = 0; vt < 4; ++vt) { u32x2 o; o[0] = pack2(Sacc[vt][0] * em[0], Sacc[vt][1] * em[1]); o[1] = pack2(Sacc[vt][2] * em[2], Sacc[vt][3] * em[3]);
                    *(LAS u32x2*)(lds + MX_ST + (16 * vt + fr) * 272 + (16 * wave + 4 * fq) * 2) = o; }
            }
            if (wave == 0) { typedef float f32x2_ __attribute__((ext_vector_type(2))); *(LAS f32x2_*)(lds + MX_DEC + lane * 8) = (f32x2_){ex2(tt0), ex2(tt1)}; }
            LDS_BARRIER();
            if (MODE != 2 && MODE != 4) {
                const int it = wave >> 1, st0 = 2 * (wave & 1);
                bf16x8 ka[2][4], qb[4];
#pragma unroll
                for (int kq = 0; kq < 4; ++kq) {
                    qb[kq] = *(const LAS bf16x8*)(lds + MX_QI + (16 * it + fr) * 272 + (32 * kq + 8 * fq) * 2);
                    ka[0][kq] = *(const LAS bf16x8*)(lds + MX_KI + (16 * st0 + fr) * 272 + (32 * kq + 8 * fq) * 2);
                    ka[1][kq] = *(const LAS bf16x8*)(lds + MX_KI + (16 * st0 + 16 + fr) * 272 + (32 * kq + 8 * fq) * 2);
                }
                asm volatile("s_waitcnt lgkmcnt(0)" ::: "memory");
                f32x4 acc0 = (f32x4){0.f, 0.f, 0.f, 0.f}, acc1 = acc0;
#pragma unroll
                for (int kq = 0; kq < 4; ++kq) {
                    acc0 = __builtin_amdgcn_mfma_f32_16x16x32_bf16(ka[0][kq], qb[kq], acc0, 0, 0, 0);
                    acc1 = __builtin_amdgcn_mfma_f32_16x16x32_bf16(ka[1][kq], qb[kq], acc1, 0, 0, 0);
                }
                const int i = 16 * it + fr;
                { const int s0 = 16 * st0 + 4 * fq;
                  const float v0 = (s0 + 0 <= i) ? acc0[0] : 0.f, v1 = (s0 + 1 <= i) ? acc0[1] : 0.f, v2 = (s0 + 2 <= i) ? acc0[2] : 0.f, v3 = (s0 + 3 <= i) ? acc0[3] : 0.f;
                  u32x2 o; o[0] = pack2(v0, v1); o[1] = pack2(v2, v3);
                  *(LAS u32x2*)(lds + MX_P + i * 144 + s0 * 2) = o; }
                { const int s0 = 16 * st0 + 16 + 4 * fq;
                  const float v0 = (s0 + 0 <= i) ? acc1[0] : 0.f, v1 = (s0 + 1 <= i) ? acc1[1] : 0.f, v2 = (s0 + 2 <= i) ? acc1[2] : 0.f, v3 = (s0 + 3 <= i) ? acc1[3] : 0.f;
                  u32x2 o; o[0] = pack2(v0, v1); o[1] = pack2(v2, v3);
                  *(LAS u32x2*)(lds + MX_P + i * 144 + s0 * 2) = o; }
            }
            LDS_BARRIER();
            if (MODE != 2 && MODE != 4) {
                const int vt = wave >> 1, it0 = 2 * (wave & 1);
                bf16x8 va[2], sa[4], pb[2][2], qsb[2][4], kta[2], vb[4][2];
#pragma unroll
                for (int kq = 0; kq < 2; ++kq) {
                    va[kq] = *(const LAS bf16x8*)(lds + MX_VT + (16 * vt + fr) * 144 + (32 * kq + 8 * fq) * 2);
                    pb[0][kq] = *(const LAS bf16x8*)(lds + MX_P + (16 * it0 + fr) * 144 + (32 * kq + 8 * fq) * 2);
                    pb[1][kq] = *(const LAS bf16x8*)(lds + MX_P + (16 * it0 + 16 + fr) * 144 + (32 * kq + 8 * fq) * 2);
                    kta[kq] = *(const LAS bf16x8*)(lds + MX_KTT + (16 * wave + fr) * 144 + (32 * kq + 8 * fq) * 2);
                }
#pragma unroll
                for (int kq = 0; kq < 4; ++kq) {
                    sa[kq] = *(const LAS bf16x8*)(lds + MX_ST + (16 * vt + fr) * 272 + (32 * kq + 8 * fq) * 2);
                    qsb[0][kq] = *(const LAS bf16x8*)(lds + MX_QI + (16 * it0 + fr) * 272 + (32 * kq + 8 * fq) * 2);
                    qsb[1][kq] = *(const LAS bf16x8*)(lds + MX_QI + (16 * it0 + 16 + fr) * 272 + (32 * kq + 8 * fq) * 2);
                }
#pragma unroll
                for (int v4 = 0; v4 < 4; ++v4)
#pragma unroll
                    for (int kq = 0; kq < 2; ++kq) vb[v4][kq] = *(const LAS bf16x8*)(lds + MX_VT + (16 * v4 + fr) * 144 + (32 * kq + 8 * fq) * 2);
                const f32x4 dc = *(const LAS f32x4*)(lds + MX_DEC + (16 * wave + 4 * fq) * 4);
                asm volatile("s_waitcnt lgkmcnt(0)" ::: "memory");
                f32x4 acc0 = (f32x4){0.f, 0.f, 0.f, 0.f}, acc1 = acc0;
#pragma unroll
                for (int kq = 0; kq < 2; ++kq) {
                    acc0 = __builtin_amdgcn_mfma_f32_16x16x32_bf16(va[kq], pb[0][kq], acc0, 0, 0, 0);
                    acc1 = __builtin_amdgcn_mfma_f32_16x16x32_bf16(va[kq], pb[1][kq], acc1, 0, 0, 0);
                }
#pragma unroll
                for (int kq = 0; kq < 4; ++kq) {
                    acc0 = __builtin_amdgcn_mfma_f32_16x16x32_bf16(sa[kq], qsb[0][kq], acc0, 0, 0, 0);
                    acc1 = __builtin_amdgcn_mfma_f32_16x16x32_bf16(sa[kq], qsb[1][kq], acc1, 0, 0, 0);
                }
#pragma unroll
                for (int v4 = 0; v4 < 4; ++v4) {
                    f32x4 a = Sacc[v4]; a[0] *= dc[0]; a[1] *= dc[1]; a[2] *= dc[2]; a[3] *= dc[3];
                    a = __builtin_amdgcn_mfma_f32_16x16x32_bf16(kta[0], vb[v4][0], a, 0, 0, 0);
                    a = __builtin_amdgcn_mfma_f32_16x16x32_bf16(kta[1], vb[v4][1], a, 0, 0, 0);
                    Sacc[v4] = a;
                }
                asm volatile("s_waitcnt vmcnt(0)" ::: "memory");
                { const int tau = ch * 64 + 16 * it0 + fr; const int t = dir ? (SEQ - 1 - tau) : tau;
                  u32x2 o; o[0] = pack2(acc0[0], acc0[1]); o[1] = pack2(acc0[2], acc0[3]);
                  *(u32x2*)((bf16_t*)obuf + ((size_t)dir * T + (size_t)(b * SEQ + t)) * 1536 + ocol + 16 * vt + 4 * fq) = o; }
                { const int tau = ch * 64 + 16 * it0 + 16 + fr; const int t = dir ? (SEQ - 1 - tau) : tau;
                  u32x2 o; o[0] = pack2(acc1[0], acc1[1]); o[1] = pack2(acc1[2], acc1[3]);
                  *(u32x2*)((bf16_t*)obuf + ((size_t)dir * T + (size_t)(b * SEQ + t)) * 1536 + ocol + 16 * vt + 4 * fq) = o; }
            }
        }
        __syncthreads();
#undef MX_LOAD
    }
}

#ifdef MIXER_CHECK
__device__ __forceinline__ void phase_mixer_check(const Params& p, const float* __restrict__ oa, const float* __restrict__ ob, float* chk) {
    int tid_ = threadIdx.x; asm volatile("" : "+v"(tid_)); const int wave = __builtin_amdgcn_readfirstlane(tid_ >> 6), lane = tid_ & 63;
    for (int r = blockIdx.x * 8 + wave; r < 2 * T; r += gridDim.x * 8) {
        const int dir = r / T;
#pragma unroll
        for (int ty = 0; ty < 2; ++ty) {
            float sd = 0.f, sq = 0.f;
#pragma unroll
            for (int i = 0; i < 3; ++i) { const float4 a = *(const float4*)(oa + (size_t)r * 1536 + ty * 768 + i * 256 + lane * 4), bq = *(const float4*)(ob + (size_t)r * 1536 + ty * 768 + i * 256 + lane * 4);
                sd += (a.x - bq.x) * (a.x - bq.x) + (a.y - bq.y) * (a.y - bq.y) + (a.z - bq.z) * (a.z - bq.z) + (a.w - bq.w) * (a.w - bq.w);
                sq += a.x * a.x + a.y * a.y + a.z * a.z + a.w * a.w; }
            sd = wave_sum(sd); sq = wave_sum(sq);
            if (lane == 0) { atomicAdd(&chk[(ty * 2 + dir) * 2 + 0], sd); atomicAdd(&chk[(ty * 2 + dir) * 2 + 1], sq); }
        }
    }
}
#endif

__device__ __forceinline__ float4 ld_bf4(const bf16_t* p) { const u32x2 r = *(const u32x2*)p; return make_float4(bf2f(r[0] & 0xffffu), bf2f(r[0] >> 16), bf2f(r[1] & 0xffffu), bf2f(r[1] >> 16)); }
__device__ __forceinline__ float grp16_sum(float v) {
#pragma unroll
    for (int o = 8; o > 0; o >>= 1) v += __shfl_xor(v, o, 64);
    return v;
}
__device__ __forceinline__ void phase_finalize(const Params& p, int l) {
    int tid_ = threadIdx.x; asm volatile("" : "+v"(tid_)); const int wave = __builtin_amdgcn_readfirstlane(tid_ >> 6), lane = tid_ & 63;
    const bf16_t* proj = (const bf16_t*)(p.ws + WS_PROJ);
    const bf16_t* obuf = (const bf16_t*)(p.ws + WS_OBUF);
    bf16_t* mixed = (bf16_t*)(p.ws + WS_MIXED);
    const float* cw = p.conv_w + (size_t)l * 3 * CW;
    const float* beta = p.mix_beta + (size_t)l * D;
    for (int n = blockIdx.x * 8 + wave; n < T; n += gridDim.x * 8) {
        const int t = n % SEQ;
        const bf16_t* row = proj + (size_t)n * INC;
#pragma unroll
        for (int i = 0; i < 4; ++i) {
            const int c = COL8(i);
            float4 r[2];
            if (i == 0) {
                float4 cc[2], ch[2], cb[2], um[2], up[2];
                ld_bf8(row + C_CC + c, cc[0], cc[1]); ld_bf8(row + C_CH + c, ch[0], ch[1]); ld_bf8(row + C_CB + c, cb[0], cb[1]);
                um[0] = um[1] = up[0] = up[1] = make_float4(0.f, 0.f, 0.f, 0.f);
                if (t > 0) { float4 a[2], b2[2]; ld_bf8(row - INC + C_CC + c, a[0], a[1]); ld_bf8(row - INC + C_CH + c, b2[0], b2[1]);
#pragma unroll
                    for (int q = 0; q < 2; ++q) um[q] = make_float4(a[q].x * b2[q].x, a[q].y * b2[q].y, a[q].z * b2[q].z, a[q].w * b2[q].w); }
                if (t < SEQ - 1) { float4 a[2], b2[2]; ld_bf8(row + INC + C_CC + c, a[0], a[1]); ld_bf8(row + INC + C_CH + c, b2[0], b2[1]);
#pragma unroll
                    for (int q = 0; q < 2; ++q) up[q] = make_float4(a[q].x * b2[q].x, a[q].y * b2[q].y, a[q].z * b2[q].z, a[q].w * b2[q].w); }
#pragma unroll
                for (int q = 0; q < 2; ++q) {
                    const float4 w0 = *(const float4*)(cw + c + 4 * q), w1 = *(const float4*)(cw + CW + c + 4 * q), w2 = *(const float4*)(cw + 2 * CW + c + 4 * q);
                    r[q].x = cb[q].x * (um[q].x * w0.x + cc[q].x * ch[q].x * w1.x + up[q].x * w2.x);
                    r[q].y = cb[q].y * (um[q].y * w0.y + cc[q].y * ch[q].y * w1.y + up[q].y * w2.y);
                    r[q].z = cb[q].z * (um[q].z * w0.z + cc[q].z * ch[q].z * w1.z + up[q].z * w2.z);
                    r[q].w = cb[q].w * (um[q].w * w0.w + cc[q].w * ch[q].w * w1.w + up[q].w * w2.w);
                }
            } else {
                const int oc = c - 512;
                const bool isret = oc < 768;
                float4 of[2], ob[2], gt[2];
                ld_bf8(obuf + (size_t)n * 1536 + oc, of[0], of[1]); ld_bf8(obuf + ((size_t)T + n) * 1536 + oc, ob[0], ob[1]);
                ld_bf8(row + (isret ? C_RG + oc : C_HG + (oc - 768)), gt[0], gt[1]);
                float4 o[2];
#pragma unroll
                for (int q = 0; q < 2; ++q) o[q] = make_float4(of[q].x + ob[q].x, of[q].y + ob[q].y, of[q].z + ob[q].z, of[q].w + ob[q].w);
                const float sm = grp16_sum(((o[0].x + o[0].y) + (o[0].z + o[0].w)) + ((o[1].x + o[1].y) + (o[1].z + o[1].w)));
                const float mu = isret ? sm * (1.0f / 128.0f) : 0.f;
#pragma unroll
                for (int q = 0; q < 2; ++q) { o[q].x -= mu; o[q].y -= mu; o[q].z -= mu; o[q].w -= mu; }
                const float var = grp16_sum(((o[0].x * o[0].x + o[0].y * o[0].y) + (o[0].z * o[0].z + o[0].w * o[0].w)) + ((o[1].x * o[1].x + o[1].y * o[1].y) + (o[1].z * o[1].z + o[1].w * o[1].w))) * (1.0f / 128.0f);
                const float rs = rsqrtf(var + 1e-6f);
#pragma unroll
                for (int q = 0; q < 2; ++q) r[q] = make_float4(o[q].x * rs * siluf_(gt[q].x), o[q].y * rs * siluf_(gt[q].y), o[q].z * rs * siluf_(gt[q].z), o[q].w * rs * siluf_(gt[q].w));
            }
            const float4 bt0 = *(const float4*)(beta + c), bt1 = *(const float4*)(beta + c + 4);
            r[0] = make_float4(r[0].x * bt0.x, r[0].y * bt0.y, r[0].z * bt0.z, r[0].w * bt0.w);
            r[1] = make_float4(r[1].x * bt1.x, r[1].y * bt1.y, r[1].z * bt1.z, r[1].w * bt1.w);
            if (OUT8(l)) { const float4 a4 = make_float4(r[0].x * 4.f, r[0].y * 4.f, r[0].z * 4.f, r[0].w * 4.f), b4 = make_float4(r[1].x * 4.f, r[1].y * 4.f, r[1].z * 4.f, r[1].w * 4.f);
                           st_fp8x8((unsigned char*)mixed + (size_t)n * D + c, a4, b4); }
            else st_bf8(mixed + (size_t)n * D + c, r[0], r[1]);
        }
    }
}

#define RGRP 4
#if RGRP == 4
#define LN1_SB() __builtin_amdgcn_sched_barrier(0)
#else
#define LN1_SB()
#endif
__device__ __forceinline__ void phase_ln1_router(const Params& p, int l, LAS unsigned char* lds) {
    int tid = threadIdx.x; asm volatile("" : "+v"(tid)); const int wave = __builtin_amdgcn_readfirstlane(tid >> 6), lane = tid & 63;
    LAS float* wrt = (LAS float*)lds;
    for (int i = tid; i < D * NE / 4; i += 512) {
        const float4 w = *(const float4*)(p.w_router + (size_t)i * 4);
        const int d = i >> 2, e4 = (i & 3) * 4;
        const int dp = (((d >> 9) * 2 + ((d >> 2) & 1)) << 8) + (((d >> 3) & 63) << 2) + (d & 3);
        wrt[(e4 + 0) * D + dp] = w.x; wrt[(e4 + 1) * D + dp] = w.y; wrt[(e4 + 2) * D + dp] = w.z; wrt[(e4 + 3) * D + dp] = w.w;
    }
    LAS int* lcnt = (LAS int*)(lds + LDS_MISC + 256);
    if (tid < 16) lcnt[tid] = 0;
    __syncthreads();
    const float* mod = (const float*)(p.ws + WS_MOD);
    const float* y = (const float*)(p.ws + WS_Y);
    float* xres = (float*)(p.ws + WS_XRES);
    int* route = (int*)(p.ws + WS_ROUTE);
    for (int n0 = (blockIdx.x * 8 + wave) * RGRP; n0 < T; n0 += gridDim.x * 8 * RGRP) {
        float4 h[RGRP][8];
        {
            const int b = n0 / SEQ;
            const float* mb = mod + ((size_t)l * 4 + b) * (6 * D);
#pragma unroll
            for (int i = 0; i < 4; ++i) {
                float4 xv[RGRP][2], yv[RGRP][2];
#pragma unroll
                for (int r = 0; r < RGRP; ++r) { ld_bf8((const bf16_t*)xres + (size_t)(n0 + r) * D + COL8(i), xv[r][0], xv[r][1]); ld_bf8((const bf16_t*)y + (size_t)(n0 + r) * D + COL8(i), yv[r][0], yv[r][1]); }
#pragma unroll
                for (int q = 0; q < 2; ++q) {
                    const float4 g = *(const float4*)(mb + 2 * D + COLK(2 * i + q));
#pragma unroll
                    for (int r = 0; r < RGRP; ++r)
                        h[r][2 * i + q] = make_float4(ALPHA * xv[r][q].x + (1.f + g.x) * yv[r][q].x, ALPHA * xv[r][q].y + (1.f + g.y) * yv[r][q].y, ALPHA * xv[r][q].z + (1.f + g.z) * yv[r][q].z, ALPHA * xv[r][q].w + (1.f + g.w) * yv[r][q].w);
                }
                LN1_SB();
            }
            float mean[RGRP], rstd[RGRP];
#pragma unroll
            for (int r = 0; r < RGRP; ++r) {
                float s0 = 0.f;
#pragma unroll
                for (int i = 0; i < 8; ++i) s0 += (h[r][i].x + h[r][i].y) + (h[r][i].z + h[r][i].w);
                mean[r] = s0;
            }
#pragma unroll
            for (int o = 32; o > 0; o >>= 1)
#pragma unroll
                for (int r = 0; r < RGRP; ++r) mean[r] += __shfl_xor(mean[r], o, 64);
#pragma unroll
            for (int r = 0; r < RGRP; ++r) {
                mean[r] *= (1.0f / D);
                float q0 = 0.f;
#pragma unroll
                for (int i = 0; i < 8; ++i) { const float a = h[r][i].x - mean[r], bb = h[r][i].y - mean[r], c = h[r][i].z - mean[r], d = h[r][i].w - mean[r]; q0 += (a * a + bb * bb) + (c * c + d * d); }
                rstd[r] = q0;
            }
#pragma unroll
            for (int o = 32; o > 0; o >>= 1)
#pragma unroll
                for (int r = 0; r < RGRP; ++r) rstd[r] += __shfl_xor(rstd[r], o, 64);
#pragma unroll
            for (int r = 0; r < RGRP; ++r) rstd[r] = rsqrtf(rstd[r] * (1.0f / D) + 1e-5f);
            const float* lg_ = p.ln_g + (size_t)(l * 2 + 0) * D; const float* lb_ = p.ln_b + (size_t)(l * 2 + 0) * D;
            LN1_SB();
#pragma unroll
            for (int i = 0; i < 8; ++i) {
                const float4 gv = *(const float4*)(lg_ + COLK(i)), bv = *(const float4*)(lb_ + COLK(i));
#pragma unroll
                for (int r = 0; r < RGRP; ++r) {
                    float4& v = h[r][i];
                    v.x = (v.x - mean[r]) * rstd[r] * gv.x + bv.x; v.y = (v.y - mean[r]) * rstd[r] * gv.y + bv.y;
                    v.z = (v.z - mean[r]) * rstd[r] * gv.z + bv.z; v.w = (v.w - mean[r]) * rstd[r] * gv.w + bv.w;
                }
                if (i & 1) LN1_SB();
            }
#pragma unroll
            for (int r = 0; r < RGRP; ++r)
#pragma unroll
                for (int i = 0; i < 4; ++i) st_bf8((bf16_t*)xres + (size_t)(n0 + r) * D + COL8(i), h[r][2 * i], h[r][2 * i + 1]);
            LN1_SB();
#pragma unroll
            for (int i = 0; i < 8; ++i) {
                const float4 sh = *(const float4*)(mb + 3 * D + COLK(i)), sc = *(const float4*)(mb + 4 * D + COLK(i));
#pragma unroll
                for (int r = 0; r < RGRP; ++r) {
                    float4& v = h[r][i];
                    v.x = v.x * (1.f + sc.x) + sh.x; v.y = v.y * (1.f + sc.y) + sh.y; v.z = v.z * (1.f + sc.z) + sh.z; v.w = v.w * (1.f + sc.w) + sh.w;
                }
                if (i & 1) LN1_SB();
            }
#pragma unroll
            for (int r = 0; r < RGRP; ++r) {
#if MOE_FP8
                unsigned char* hb = p.ws + WS_HB + (size_t)(n0 + r) * D;
#pragma unroll
                for (int i = 0; i < 4; ++i) st_fp8x8(hb + COL8(i), h[r][2 * i], h[r][2 * i + 1]);
#else
                bf16_t* hb = (bf16_t*)(p.ws + WS_HB) + (size_t)(n0 + r) * D;
#pragma unroll
                for (int i = 0; i < 4; ++i) st_bf8(hb + COL8(i), h[r][2 * i], h[r][2 * i + 1]);
#endif
            }
        }
        float lgk0 = 0.f, lgk1 = 0.f, lgk2 = 0.f, lgk3 = 0.f;
        const bool b5 = (lane & 32) != 0, b4 = (lane & 16) != 0, b3 = (lane & 8) != 0, b2 = (lane & 4) != 0;
#pragma unroll 1
        for (int eg = 0; eg < 4; ++eg) {
            float s[RGRP][4];
#pragma unroll
            for (int q = 0; q < 4; ++q) {
                f32x2_t ac[RGRP];
#pragma unroll
                for (int r = 0; r < RGRP; ++r) ac[r] = (f32x2_t){0.f, 0.f};
#pragma unroll
                for (int i = 0; i < 8; ++i) {
                    const f32x4 w = *(const LAS f32x4*)(wrt + (eg * 4 + q) * D + i * 256 + lane * 4);
                    const f32x2_t w01 = __builtin_shufflevector(w, w, 0, 1), w23 = __builtin_shufflevector(w, w, 2, 3);
#pragma unroll
                    for (int r = 0; r < RGRP; ++r) {
                        ac[r] = __builtin_elementwise_fma((f32x2_t){h[r][i].x, h[r][i].y}, w01, ac[r]);
                        ac[r] = __builtin_elementwise_fma((f32x2_t){h[r][i].z, h[r][i].w}, w23, ac[r]);
                    }
                }
#pragma unroll
                for (int r = 0; r < RGRP; ++r) s[r][q] = ac[r][0] + ac[r][1];
                LN1_SB();
            }
            float u[RGRP];
#pragma unroll
            for (int r = 0; r < RGRP; ++r) {
                const float tA = (b5 ? s[r][2] : s[r][0]) + __shfl_xor(b5 ? s[r][0] : s[r][2], 32, 64);
                const float tB = (b5 ? s[r][3] : s[r][1]) + __shfl_xor(b5 ? s[r][1] : s[r][3], 32, 64);
                u[r] = (b4 ? tB : tA) + __shfl_xor(b4 ? tA : tB, 16, 64);
            }
#if RGRP == 4
            const float pA = (b3 ? u[2] : u[0]) + __shfl_xor(b3 ? u[0] : u[2], 8, 64);
            const float pB = (b3 ? u[3] : u[1]) + __shfl_xor(b3 ? u[1] : u[3], 8, 64);
            float z = (b2 ? pB : pA) + __shfl_xor(b2 ? pA : pB, 4, 64);
#else
            float z = (b3 ? u[1] : u[0]) + __shfl_xor(b3 ? u[0] : u[1], 8, 64);
            z += __shfl_xor(z, 4, 64);
#endif
            z += __shfl_xor(z, 2, 64); z += __shfl_xor(z, 1, 64);
            lgk0 = (eg == 0) ? z : lgk0; lgk1 = (eg == 1) ? z : lgk1; lgk2 = (eg == 2) ? z : lgk2; lgk3 = (eg == 3) ? z : lgk3;
        }
#pragma unroll 1
        for (int r = 0; r < RGRP; ++r) {
            const int n = n0 + r;
            const int rl = (RGRP == 4) ? (r >> 1) * 8 + (r & 1) * 4 : r * 8;
            float lg[16];
#pragma unroll
            for (int q = 0; q < 4; ++q) {
                const int src = ((q >> 1) * 32) + ((q & 1) * 16) + rl;
                lg[0 + q] = __int_as_float(__builtin_amdgcn_readlane(__float_as_int(lgk0), src));
                lg[4 + q] = __int_as_float(__builtin_amdgcn_readlane(__float_as_int(lgk1), src));
                lg[8 + q] = __int_as_float(__builtin_amdgcn_readlane(__float_as_int(lgk2), src));
                lg[12 + q] = __int_as_float(__builtin_amdgcn_readlane(__float_as_int(lgk3), src));
            }
            float mx = lg[0];
#pragma unroll
            for (int e = 1; e < 16; ++e) mx = fmaxf(mx, lg[e]);
            float sc[16], sum = 0.f;
#pragma unroll
            for (int e = 0; e < 16; ++e) { sc[e] = expf(lg[e] - mx); sum += sc[e]; }
            const float inv = 1.0f / sum;
            float sel[16];
#pragma unroll
            for (int e = 0; e < 16; ++e) { sc[e] *= inv; sel[e] = sc[e] + p.router_bias[e]; }
            float best_gs = -3.0e38f; int bi0 = 0, bi1 = 1; float bw0 = 0.f, bw1 = 0.f;
#pragma unroll
            for (int g = 0; g < 4; ++g) {
                int i0 = 0; float m0 = sel[4 * g];
#pragma unroll
                for (int j = 1; j < 4; ++j) if (sel[4 * g + j] > m0) { m0 = sel[4 * g + j]; i0 = j; }
                int i1 = -1; float m1 = -3.0e38f;
#pragma unroll
                for (int j = 0; j < 4; ++j) if (j != i0 && sel[4 * g + j] > m1) { m1 = sel[4 * g + j]; i1 = j; }
                float w0 = 0.f, w1 = 0.f;
#pragma unroll
                for (int j = 0; j < 4; ++j) { w0 = (j == i0) ? sc[4 * g + j] : w0; w1 = (j == i1) ? sc[4 * g + j] : w1; }
                const float gs = m0 + m1;
                if (gs > best_gs) { best_gs = gs; bi0 = 4 * g + i0; bi1 = 4 * g + i1; bw0 = w0; bw1 = w1; }
            }
            if (lane == 0) {
                const float ws_ = 1.0f / (bw0 + bw1);
                const int p0 = __hip_atomic_fetch_add(&lcnt[bi0], 1, __ATOMIC_RELAXED, __HIP_MEMORY_SCOPE_WORKGROUP), p1 = __hip_atomic_fetch_add(&lcnt[bi1], 1, __ATOMIC_RELAXED, __HIP_MEMORY_SCOPE_WORKGROUP);
                int* rr = route + (size_t)n * 8;
                rr[0] = bi0; rr[1] = bi1; rr[2] = (int)p0; rr[3] = (int)p1; rr[4] = __float_as_int(bw0 * ws_); rr[5] = __float_as_int(bw1 * ws_);
            }
        }
    }
    __syncthreads();
    if (tid < 16) ((int*)(p.ws + WS_WGCNT))[((size_t)l * 1024 + blockIdx.x) * 16 + tid] = lcnt[tid];
}

__device__ __forceinline__ void build_moe_tab(const Params& p, int l, LAS int* tab) {
    if (threadIdx.x == 0) {
        const unsigned* cnt = (const unsigned*)(p.ws + WS_CNT) + l * 16;
        int acc = 0;
        for (int e = 0; e < 16; ++e) { tab[e] = acc; acc += (int)((cnt[e] + 255u) >> 8); }
        tab[16] = acc;
    }
    __syncthreads();
}

__device__ __forceinline__ void phase_permute(const Params& p, int l, LAS int* tab) {
    int tid_ = threadIdx.x; asm volatile("" : "+v"(tid_)); const int wave = __builtin_amdgcn_readfirstlane(tid_ >> 6), lane = tid_ & 63;
    LAS int* base = tab + 32; LAS int* total = tab + 48;
    if (tid_ < 16) { base[tid_] = 0; total[tid_] = 0; }
    __syncthreads();
    {
        const int* wgc = (const int*)(p.ws + WS_WGCNT) + (size_t)l * 1024 * 16;
        const int e = tid_ & 15; int bs = 0, tt = 0;
        for (int w = tid_ >> 4; w < (int)gridDim.x; w += 32) { const int v = wgc[w * 16 + e]; tt += v; bs += (w < (int)blockIdx.x) ? v : 0; }
        __hip_atomic_fetch_add(&base[e], bs, __ATOMIC_RELAXED, __HIP_MEMORY_SCOPE_WORKGROUP);
        __hip_atomic_fetch_add(&total[e], tt, __ATOMIC_RELAXED, __HIP_MEMORY_SCOPE_WORKGROUP);
    }
    __syncthreads();
    if (tid_ == 0) { int acc = 0; for (int e = 0; e < 16; ++e) { tab[e] = acc; acc += (total[e] + 255) >> 8; } tab[16] = acc; }
    if (blockIdx.x == 0 && tid_ < 16) ((unsigned*)(p.ws + WS_CNT))[l * 16 + tid_] = (unsigned)total[tid_];
    __syncthreads();
#if MOE_FP8
    for (int i = blockIdx.x * 512 + tid_; i < XE_ROWS * 8; i += gridDim.x * 512) *(u32x4*)(p.ws + WS_HID + (size_t)(i >> 3) * DEP + DE + (i & 7) * 16) = (u32x4){0u, 0u, 0u, 0u};
#endif
    int* route = (int*)(p.ws + WS_ROUTE);
    const bf16_t* hb = (const bf16_t*)(p.ws + WS_HB);
    bf16_t* xe = (bf16_t*)(p.ws + WS_XE);
    for (int m = (blockIdx.x * 8 + wave) * RGRP; m < T; m += gridDim.x * 8 * RGRP)
#pragma unroll 1
    for (int n = m; n < m + RGRP; ++n) {
        int* r = route + (size_t)n * 8;
        const int e0 = r[0], e1 = r[1], p0 = r[2], p1 = r[3];
        const int row0 = tab[e0] * 256 + base[e0] + p0, row1 = tab[e1] * 256 + base[e1] + p1;
        constexpr int RB = MOE_FP8 ? D : 2 * D;
        const u32x4* src = (const u32x4*)((const unsigned char*)hb + (size_t)n * RB);
        u32x4* d0 = (u32x4*)((unsigned char*)xe + (size_t)row0 * RB); u32x4* d1 = (u32x4*)((unsigned char*)xe + (size_t)row1 * RB);
#pragma unroll
        for (int i = 0; i < RB / 1024; ++i) { const u32x4 v = src[i * 64 + lane]; d0[i * 64 + lane] = v; d1[i * 64 + lane] = v; }
        if (lane == 0) { r[6] = row0; r[7] = row1; }
    }
}

#define LN2_RG 2
#define LN2_SB() __builtin_amdgcn_sched_barrier(0)
__device__ __forceinline__ void phase_ln2(const Params& p, int l) {
    int tid_ = threadIdx.x; asm volatile("" : "+v"(tid_)); const int wave = __builtin_amdgcn_readfirstlane(tid_ >> 6), lane = tid_ & 63;
    const float* mod = (const float*)(p.ws + WS_MOD);
    const float* ye = (const float*)(p.ws + WS_YE);
    float* xres = (float*)(p.ws + WS_XRES);
    const int* route = (const int*)(p.ws + WS_ROUTE);
    const int lane_ = lane;
    for (int n0 = (blockIdx.x * 8 + wave) * LN2_RG; n0 < T; n0 += gridDim.x * 8 * LN2_RG) {
        int lane = lane_; asm volatile("" : "+v"(lane));
        const int b = n0 / SEQ;
        const float* mb = mod + ((size_t)l * 4 + b) * (6 * D);
        float w0[LN2_RG], w1[LN2_RG]; const bf16_t* y0[LN2_RG]; const bf16_t* y1[LN2_RG];
#pragma unroll
        for (int r = 0; r < LN2_RG; ++r) {
            const int* rr = route + (size_t)(n0 + r) * 8;
            w0[r] = __int_as_float(__builtin_amdgcn_readfirstlane(rr[4])); w1[r] = __int_as_float(__builtin_amdgcn_readfirstlane(rr[5]));
            y0[r] = (const bf16_t*)ye + (size_t)__builtin_amdgcn_readfirstlane(rr[6]) * D; y1[r] = (const bf16_t*)ye + (size_t)__builtin_amdgcn_readfirstlane(rr[7]) * D;
        }
        float4 v[LN2_RG][8];
#pragma unroll
        for (int i = 0; i < 4; ++i) {
            float4 g[2];
#pragma unroll
            for (int q = 0; q < 2; ++q) g[q] = *(const float4*)(mb + 5 * D + COLK(2 * i + q));
#pragma unroll
            for (int rp = 0; rp < LN2_RG; rp += 2) {
                float4 xv[2][2], a[2][2], c[2][2];
#pragma unroll
                for (int r = 0; r < 2; ++r) { ld_bf8((const bf16_t*)xres + (size_t)(n0 + rp + r) * D + COL8(i), xv[r][0], xv[r][1]); ld_bf8(y0[rp + r] + COL8(i), a[r][0], a[r][1]); ld_bf8(y1[rp + r] + COL8(i), c[r][0], c[r][1]); }
#pragma unroll
                for (int q = 0; q < 2; ++q)
#pragma unroll
                    for (int r = 0; r < 2; ++r)
                        v[rp + r][2 * i + q] = make_float4(ALPHA * xv[r][q].x + (1.f + g[q].x) * (w0[rp + r] * a[r][q].x + w1[rp + r] * c[r][q].x), ALPHA * xv[r][q].y + (1.f + g[q].y) * (w0[rp + r] * a[r][q].y + w1[rp + r] * c[r][q].y),
                                                           ALPHA * xv[r][q].z + (1.f + g[q].z) * (w0[rp + r] * a[r][q].z + w1[rp + r] * c[r][q].z), ALPHA * xv[r][q].w + (1.f + g[q].w) * (w0[rp + r] * a[r][q].w + w1[rp + r] * c[r][q].w));
                LN2_SB();
            }
        }
        float mean[LN2_RG], rstd[LN2_RG];
#pragma unroll
        for (int r = 0; r < LN2_RG; ++r) {
            float s0 = 0.f;
#pragma unroll
            for (int i = 0; i < 8; ++i) s0 += (v[r][i].x + v[r][i].y) + (v[r][i].z + v[r][i].w);
            mean[r] = s0;
        }
#pragma unroll
        for (int o = 32; o > 0; o >>= 1)
#pragma unroll
            for (int r = 0; r < LN2_RG; ++r) mean[r] += __shfl_xor(mean[r], o, 64);
#pragma unroll
        for (int r = 0; r < LN2_RG; ++r) {
            mean[r] *= (1.0f / D);
            float q0 = 0.f;
#pragma unroll
            for (int i = 0; i < 8; ++i) { const float aa = v[r][i].x - mean[r], bb = v[r][i].y - mean[r], cc = v[r][i].z - mean[r], dd = v[r][i].w - mean[r]; q0 += (aa * aa + bb * bb) + (cc * cc + dd * dd); }
            rstd[r] = q0;
        }
#pragma unroll
        for (int o = 32; o > 0; o >>= 1)
#pragma unroll
            for (int r = 0; r < LN2_RG; ++r) rstd[r] += __shfl_xor(rstd[r], o, 64);
#pragma unroll
        for (int r = 0; r < LN2_RG; ++r) rstd[r] = rsqrtf(rstd[r] * (1.0f / D) + 1e-5f);
        const float* lg_ = p.ln_g + (size_t)(l * 2 + 1) * D; const float* lb_ = p.ln_b + (size_t)(l * 2 + 1) * D;
        LN2_SB();
#pragma unroll
        for (int i = 0; i < 8; ++i) {
            const float4 gv = *(const float4*)(lg_ + COLK(i)), bv = *(const float4*)(lb_ + COLK(i));
#pragma unroll
            for (int r = 0; r < LN2_RG; ++r) {
                float4& x = v[r][i];
                x.x = (x.x - mean[r]) * rstd[r] * gv.x + bv.x; x.y = (x.y - mean[r]) * rstd[r] * gv.y + bv.y;
                x.z = (x.z - mean[r]) * rstd[r] * gv.z + bv.z; x.w = (x.w - mean[r]) * rstd[r] * gv.w + bv.w;
            }
            if (i & 1) LN2_SB();
        }
        if (l + 1 < DEPTH) {
#pragma unroll
            for (int r = 0; r < LN2_RG; ++r)
#pragma unroll
                for (int i = 0; i < 4; ++i) st_bf8((bf16_t*)xres + (size_t)(n0 + r) * D + COL8(i), v[r][2 * i], v[r][2 * i + 1]);
            const float* mn = mod + ((size_t)(l + 1) * 4 + b) * (6 * D);
            LN2_SB();
#pragma unroll
            for (int i = 0; i < 4; ++i) {
                float4 sh[2], sc[2];
#pragma unroll
                for (int q = 0; q < 2; ++q) { sh[q] = *(const float4*)(mn + COLK(2 * i + q)); sc[q] = *(const float4*)(mn + D + COLK(2 * i + q)); }
#pragma unroll
                for (int r = 0; r < LN2_RG; ++r) {
                    float4 h[2];
#pragma unroll
                    for (int q = 0; q < 2; ++q) { const float4 x = v[r][2 * i + q]; h[q] = make_float4(x.x * (1.f + sc[q].x) + sh[q].x, x.y * (1.f + sc[q].y) + sh[q].y, x.z * (1.f + sc[q].z) + sh[q].z, x.w * (1.f + sc[q].w) + sh[q].w); }
                    if (INP8(l + 1)) st_fp8x8(p.ws + WS_HA + (size_t)(n0 + r) * D + COL8(i), h[0], h[1]);
                    else st_bf8((bf16_t*)(p.ws + WS_HA) + (size_t)(n0 + r) * D + COL8(i), h[0], h[1]);
                }
                LN2_SB();
            }
        } else {
#pragma unroll
            for (int r = 0; r < LN2_RG; ++r)
#pragma unroll
                for (int i = 0; i < 8; ++i) *(float4*)(p.out + (size_t)(n0 + r) * D + COLK(i)) = v[r][i];
        }
    }
}

typedef const __attribute__((address_space(4))) unsigned char* KargPtr;
__device__ __forceinline__ Params load_params(KargPtr q) { asm volatile("" : "+s"(q)); Params lp; __builtin_memcpy(&lp, (const __attribute__((address_space(4))) unsigned long long*)q, sizeof(Params)); return lp; }

__global__ __launch_bounds__(512, 2) void mega(Params p_in) {
    extern __shared__ __attribute__((aligned(16))) unsigned char smem[];
    LAS unsigned char* lds = (LAS unsigned char*)smem;
    LAS int* tab = (LAS int*)(lds + LDS_MISC + 64);
    KargPtr kp = (KargPtr)__builtin_amdgcn_kernarg_segment_ptr();
    if (threadIdx.x == 0) { *(LAS u32x4*)(lds + LDS_MISC) = (u32x4){0u, 0u, 0u, 0u}; *(LAS u32x4*)(lds + LDS_MISC + 768) = (u32x4){0u, 0u, 0u, 0u}; *(LAS u32x4*)(lds + LDS_MISC + 784) = (u32x4){0u, 0u, 0u, 0u}; }
    __syncthreads();
    const int fused = p_in.fused, ph_lo = p_in.ph_lo, ph_hi = p_in.ph_hi, l_hi = p_in.l_hi;
    XcdBarrier bar;
    if (fused) bar = xcd_barrier_post((unsigned*)(p_in.ws + WS_BAR), (volatile LAS unsigned*)(lds + LDS_MISC));
    else { bar.bar = (unsigned*)(p_in.ws + WS_BAR); bar.x = 0; bar.st = (volatile LAS unsigned*)(lds + LDS_MISC); }
#ifdef ONLY_PH
#define PH(i) ((i) == ONLY_PH && ph_lo <= (i) && (i) < ph_hi)
#else
#define PH(i) (ph_lo <= (i) && (i) < ph_hi)
#endif
#ifdef PROBE_PH
#define SYNC_PLAIN() do { if (fused) xcd_barrier(bar); } while (0)
#define PSTART(i) do { if ((i) == PROBE_PH && blockIdx.x == 0 && threadIdx.x == 0) { *(LAS unsigned long long*)(lds + LDS_MISC + 768) = __builtin_amdgcn_s_memrealtime(); } } while (0)
#define PSTOP(i) do { if ((i) == PROBE_PH && blockIdx.x == 0 && threadIdx.x == 0) { *(LAS unsigned long long*)(lds + LDS_MISC + 776) += __builtin_amdgcn_s_memrealtime() - *(LAS unsigned long long*)(lds + LDS_MISC + 768); } } while (0)
#else
#define PSTART(i) do { } while (0)
#define PSTOP(i) do { } while (0)
#endif
#if defined(PROBE_PH) && defined(PROBE_SUB)
#define QSTART(i, k) do { if ((i) == PROBE_PH && (k) == PROBE_SUB && blockIdx.x == PROBE_WG && threadIdx.x == 0) { *(LAS unsigned long long*)(lds + LDS_MISC + 784) = __builtin_amdgcn_s_memrealtime(); } } while (0)
#define QSTOP(i, k) do { if ((i) == PROBE_PH && (k) == PROBE_SUB && blockIdx.x == PROBE_WG && threadIdx.x == 0) { *(LAS unsigned long long*)(lds + LDS_MISC + 792) += __builtin_amdgcn_s_memrealtime() - *(LAS unsigned long long*)(lds + LDS_MISC + 784); } } while (0)
#else
#define QSTART(i, k) do { } while (0)
#define QSTOP(i, k) do { } while (0)
#endif
#define SYNC() do { if (fused) xcd_barrier(bar); } while (0)
#ifndef DUP_MASK
#define DUP_MASK 0
#endif
#define REP(i) _Pragma("unroll 1") for (int rep_ = 0; rep_ < 1 + ((DUP_MASK >> (i)) & 1); ++rep_)
    const int G = gridDim.x, c = blockIdx.x;
    if (PH(0)) REP(0) { PSTART(0); const Params p = load_params(kp); phase_prologue(p, lds); SYNC(); PSTOP(0); }
    if (PH(1)) REP(1) { PSTART(1); const Params p = load_params(kp); phase_ln0(p); SYNC(); PSTOP(1); }
    for (int l = p_in.l_lo; l < l_hi; ++l) {
        const bool svc = (l == 0) && (G >= 256);
        if (PH(2)) REP(2) { PSTART(2);
            const Params p = load_params(kp);
            pg8::Gemm g{(const bf16_t*)(p.ws + WS_HA), (const bf16_t*)(p.ws + WS_WIN) + (size_t)l * INC * D, D};
            pg8::EpiBf16 E{(bf16_t*)(p.ws + WS_PROJ), INC};
            if (svc) {
                if (c < 240) {
                    pg8::DenseOrder<32, 30> S; S.init(INP8(0) ? D : 2 * D, 240, c);
                    if (INP8(0)) pg8::gemm_phase<pg8::EpiBf16, pg8::DenseOrder<32, 30>, true>(lds, g, S, E, 121, 127);
                    else pg8::gemm_phase(lds, g, S, E);
                } else ada_chunks(p, lds, 128 + (c - 240), 256, 16);
                tail_pull(p, lds, l * 4 + 0);
            } else {
                pg8::DenseOrder<32, 32> S; S.init(INP8(l) ? D : 2 * D, G, c);
                if (INP8(l)) pg8::gemm_phase<pg8::EpiBf16, pg8::DenseOrder<32, 32>, true>(lds, g, S, E, 121, 127);
                else pg8::gemm_phase(lds, g, S, E);
            }
            SYNC(); PSTOP(2);
        }
#ifdef MIXER_CHECK
        if (PH(3)) REP(3) { PSTART(3); const Params p = load_params(kp); phase_mixer_valu(p, l, lds); SYNC(); PSTOP(3); }
        if (PH(3)) REP(3) { PSTART(3); const Params p = load_params(kp); phase_mixer_mfma<0>(p, l, lds, (float*)(p.ws + WS_XE)); SYNC(); PSTOP(3); }
        if (PH(3)) REP(3) { PSTART(3); const Params p = load_params(kp); phase_mixer_check(p, (const float*)(p.ws + WS_OBUF), (const float*)(p.ws + WS_XE), (float*)(p.ws + WS_CNT + 1024) + l * 8); SYNC(); PSTOP(3); }
#else
        if (PH(3)) REP(3) { PSTART(3);
            const Params p = load_params(kp);
            const int n_extra = svc ? 96 : 32, pn0 = svc ? 30 : 32;
            for (int uu = (G >= 224 ? c - 192 : c); uu >= 0 && uu < n_extra; uu += (G >= 224 ? 64 : G)) {
                const int RBI = INP8(l) ? D : 2 * D;
                pg8::OneUnit S; S.u0.aB = (size_t)(uu & 31) * 256 * RBI; S.u0.bB = (size_t)(pn0 + (uu >> 5)) * 256 * RBI; S.u0.row0 = (uu & 31) * 256; S.u0.col0 = (pn0 + (uu >> 5)) * 256;
                pg8::EpiBf16 E{(bf16_t*)(p.ws + WS_PROJ), INC};
                pg8::Gemm g{(const bf16_t*)(p.ws + WS_HA), (const bf16_t*)(p.ws + WS_WIN) + (size_t)l * INC * D, D};
                if (INP8(l)) pg8::gemm_phase<pg8::EpiBf16, pg8::OneUnit, true>(lds, g, S, E, 121, 127);
                else pg8::gemm_phase(lds, g, S, E);
            }
            phase_mixer_mfma<0>(p, l, lds, (float*)(p.ws + WS_OBUF));
            tail_pull(p, lds, l * 4 + 1);
            SYNC(); PSTOP(3);
#ifdef MIXER_PROBE
            phase_mixer_mfma<MIXER_PROBE>(p, l, lds, (float*)(p.ws + WS_XE));
            SYNC(); PSTOP(3);
#endif
        }
#endif
        if (PH(4)) REP(4) { PSTART(4); const Params p = load_params(kp); phase_finalize(p, l); SYNC(); PSTOP(4); }
        if (PH(5)) REP(5) { PSTART(5);
            const Params p = load_params(kp);
            pg8::DenseOrder<32, 8> S; S.init(OUT8(l) ? D : 2 * D, G, c);
            pg8::Gemm g{(const bf16_t*)(p.ws + WS_MIXED), (const bf16_t*)(p.ws + WS_WOUT) + (size_t)l * D * D, D};
            pg8::EpiBf16 E{(bf16_t*)(p.ws + WS_Y), D};
            if (OUT8(l)) pg8::gemm_phase<pg8::EpiBf16, pg8::DenseOrder<32, 8>, true>(lds, g, S, E, 121, 125);
            else pg8::gemm_phase(lds, g, S, E);
            SYNC(); PSTOP(5);
        }
        if (PH(6)) REP(6) { PSTART(6); const Params p = load_params(kp); phase_ln1_router(p, l, lds); SYNC(); PSTOP(6); }
        if (PH(7)) REP(7) { PSTART(7); const Params p = load_params(kp); phase_permute(p, l, tab); cvt_pull(p, lds, l * CV_PER_L + CV_A1, nullptr, 0u); SYNC(); PSTOP(7); }
        if (PH(8)) REP(8) { PSTART(8);
            const Params p = load_params(kp);
            build_moe_tab(p, l, tab);
#if MOE_FP8
            pg8::MoeOrder S; S.tab = tab; S.NTn = 11; S.G = G; S.c = c; S.tstep = (size_t)256 * D; S.bexp = (size_t)2 * DE * D;
            pg8::Gemm g{(const bf16_t*)(p.ws + WS_XE), (const bf16_t*)(p.ws + WS_WGU + (size_t)l * NE * 2 * DE * D), D};
            pg8::EpiHidden8 E{p.ws + WS_HID};
            QSTART(8, 1); pg8::gemm_phase<pg8::EpiHidden8, pg8::MoeOrder, true>(lds, g, S, E, 121, 127); QSTOP(8, 1);
#else
            pg8::MoeOrder S; S.tab = tab; S.NTn = 11; S.G = G; S.c = c; S.tstep = (size_t)256 * D * 2; S.bexp = (size_t)2 * DE * D * 2;
            pg8::Gemm g{(const bf16_t*)(p.ws + WS_XE), (const bf16_t*)(p.ws + WS_WGU) + (size_t)l * NE * 2 * DE * D, D};
            pg8::EpiHidden E{(bf16_t*)(p.ws + WS_HID)};
            pg8::gemm_phase(lds, g, S, E);
#endif
            QSTART(8, 2); tail_pull(p, lds, l * 4 + 2); QSTOP(8, 2);
            QSTART(8, 3); cvt_pull(p, lds, (l + 1) * CV_PER_L, nullptr, 0u); QSTOP(8, 3);
            SYNC(); PSTOP(8);
        }
        if (PH(9)) REP(9) { PSTART(9);
            const Params p = load_params(kp);
            build_moe_tab(p, l, tab);
#if MOE_FP8
            pg8::MoeOrder S; S.tab = tab; S.NTn = 8; S.G = G; S.c = c; S.tstep = (size_t)256 * DEP; S.bexp = (size_t)D * DEP;
            pg8::Gemm g{(const bf16_t*)(p.ws + WS_HID), (const bf16_t*)(p.ws + WS_WD + (size_t)l * NE * D * DEP), DEP};
            pg8::EpiBf16 E{(bf16_t*)(p.ws + WS_YE), D};
            QSTART(9, 1); pg8::gemm_phase<pg8::EpiBf16, pg8::MoeOrder, true>(lds, g, S, E, 121, 124); QSTOP(9, 1);
#else
            pg8::MoeOrder S; S.tab = tab; S.NTn = 8; S.G = G; S.c = c; S.tstep = (size_t)256 * DE * 2; S.bexp = (size_t)D * DE * 2;
            pg8::Gemm g{(const bf16_t*)(p.ws + WS_HID), (const bf16_t*)(p.ws + WS_WD) + (size_t)l * NE * D * DE, DE};
            pg8::EpiBf16 E{(bf16_t*)(p.ws + WS_YE), D};
            pg8::gemm_phase(lds, g, S, E);
#endif
            QSTART(9, 2); tail_pull(p, lds, l * 4 + 3); QSTOP(9, 2);
            QSTART(9, 3); if (l + 1 < DEPTH) cvt_pull(p, lds, (l + 1) * CV_PER_L + CV_A0, nullptr, 0u); QSTOP(9, 3);
            SYNC(); PSTOP(9);
        }
        if (PH(10)) REP(10) { PSTART(10); const Params p = load_params(kp); phase_ln2(p, l); SYNC(); PSTOP(10); }
    }
#ifdef PROBE_PH
    if (blockIdx.x == 0 && threadIdx.x == 0) {
#ifdef PROBE_SUB
        const unsigned long long t = 0ull, t0 = __builtin_amdgcn_s_memrealtime();
#else
        const unsigned long long t = *(LAS unsigned long long*)(lds + LDS_MISC + 776) * 4ull, t0 = __builtin_amdgcn_s_memrealtime();
#endif
        while (__builtin_amdgcn_s_memrealtime() - t0 < t) __builtin_amdgcn_s_sleep(8);
    }
#ifdef PROBE_SUB
    if (blockIdx.x == PROBE_WG && threadIdx.x == 0) {
        const unsigned long long t = *(LAS unsigned long long*)(lds + LDS_MISC + 792) * 4ull, t0 = __builtin_amdgcn_s_memrealtime();
        while (__builtin_amdgcn_s_memrealtime() - t0 < t) __builtin_amdgcn_s_sleep(8);
    }
#endif
#endif
}

#ifndef MK_FUSED
#define MK_FUSED 1
#endif
extern "C" void kernel_launch(void* const* d_in, const int* in_sizes, int n_in, void* d_out, int out_size, void* d_ws, size_t ws_size, hipStream_t stream) {
    static int grid = 0;
    if (grid == 0) {
        if (n_in != 18 || ws_size < WS_END) { fprintf(stderr, "kernel_launch: unexpected n_in %d or ws_size %zu (< %zu)\n", n_in, ws_size, (size_t)WS_END); grid = -1; return; }
        int dev = 0, cus = 0, per_cu = 0;
        hipGetDevice(&dev);
        hipDeviceGetAttribute(&cus, hipDeviceAttributeMultiprocessorCount, dev);
        if (hipFuncSetAttribute((const void*)mega, hipFuncAttributeMaxDynamicSharedMemorySize, LDS_BYTES) != hipSuccess) { fprintf(stderr, "kernel_launch: hipFuncSetAttribute failed\n"); grid = -1; return; }
        hipOccupancyMaxActiveBlocksPerMultiprocessor(&per_cu, (const void*)mega, 512, LDS_BYTES);
        if (per_cu < 1) fprintf(stderr, "kernel_launch: occupancy query says %d\n", per_cu);
        grid = cus > 0 ? cus : 256;
    }
    if (grid < 0) return;
    hipMemsetAsync(d_ws, 0, WS_ZERO_BYTES, stream);
    Params p{};
    p.x = (const float*)d_in[0]; p.c = (const float*)d_in[1]; p.emb_g = (const float*)d_in[2]; p.emb_b = (const float*)d_in[3];
    p.w_ada = (const float*)d_in[4]; p.b_ada = (const float*)d_in[5]; p.w_in = (const float*)d_in[6]; p.conv_w = (const float*)d_in[7];
    p.mix_beta = (const float*)d_in[8]; p.w_out = (const float*)d_in[9]; p.lb_logits = (const float*)d_in[10]; p.ln_g = (const float*)d_in[11];
    p.ln_b = (const float*)d_in[12]; p.w_router = (const float*)d_in[13]; p.router_bias = (const float*)d_in[14]; p.w_gate = (const float*)d_in[15];
    p.w_up = (const float*)d_in[16]; p.w_down = (const float*)d_in[17];
    p.out = (float*)d_out; p.ws = (unsigned char*)d_ws; p.pad = 0;
#if MK_FUSED
    p.ph_lo = 0; p.ph_hi = 11; p.l_lo = 0; p.l_hi = DEPTH; p.fused = 1;
    hipLaunchKernelGGL(mega, dim3(grid), dim3(512), LDS_BYTES, stream, p);
#else
    p.fused = 0;
    for (int ph = 0; ph < 2; ++ph) { p.ph_lo = ph; p.ph_hi = ph + 1; p.l_lo = 0; p.l_hi = 0; hipLaunchKernelGGL(mega, dim3(grid), dim3(512), LDS_BYTES, stream, p); }
    for (int l = 0; l < DEPTH; ++l)
        for (int ph = 2; ph < 11; ++ph) { p.ph_lo = ph; p.ph_hi = ph + 1; p.l_lo = l; p.l_hi = l + 1; hipLaunchKernelGGL(mega, dim3(grid), dim3(512), LDS_BYTES, stream, p); }
#endif
}
```

```cpp
#include <hip/hip_runtime.h>
#include <stdint.h>
#include <stdio.h>

#define LAS __attribute__((address_space(3)))
typedef unsigned short bf16_t;
typedef short bf16x8 __attribute__((ext_vector_type(8)));
typedef float f32x4 __attribute__((ext_vector_type(4)));
typedef unsigned u32x4 __attribute__((ext_vector_type(4)));
typedef unsigned u32x2 __attribute__((ext_vector_type(2)));

constexpr int D = 2048, NB = 4, SEQ = 2048, T = NB * SEQ, DEPTH = 2;
constexpr int CW = 512, RW = 768, HWD = 768, INC = 8448;
constexpr int NE = 16, DE = 1408;
constexpr int C_CB = 0, C_CC = 512, C_CH = 1024, C_RQ = 1536, C_RK = 2304, C_RV = 3072, C_RG = 3840, C_HQ = 4608, C_HFF = 5376, C_HFB = 6144, C_HI = 6912, C_HG = 7680;
constexpr int XE_ROWS = 20480;
#ifndef MOE_FP8
#define MOE_FP8 1
#endif
#ifndef INP_FP8_FROM
#define INP_FP8_FROM 1
#endif
#define INP8(l) ((l) >= INP_FP8_FROM)
#ifndef OUT_FP8_FROM
#define OUT_FP8_FROM 1
#endif
#define OUT8(l) ((l) >= OUT_FP8_FROM)
constexpr int DEP = 1536;
constexpr float W8_SCALE = 64.f, H8_SCALE = 8.f;
constexpr float ALPHA = 1.4142135623730951f;

constexpr size_t WS_BAR = 0;
constexpr size_t WS_CNT = 16384;
constexpr size_t WS_CVTQ = 20480;
constexpr size_t WS_ZERO_BYTES = 32768;
constexpr size_t WS_MOD = 32768;
constexpr size_t WS_ROUTE = WS_MOD + 393216;
constexpr size_t WS_WGCNT = WS_ROUTE + 262144;
constexpr size_t WS_WRT = WS_WGCNT + 131072;
constexpr size_t WS_WIN = 1048576;
constexpr size_t SZ_WIN = (size_t)DEPTH * INC * D * 2;
constexpr size_t WS_WOUT = WS_WIN + SZ_WIN;
constexpr size_t SZ_WOUT = (size_t)DEPTH * D * D * 2;
constexpr size_t WS_WGU = WS_WOUT + SZ_WOUT;
constexpr size_t SZ_WGU = (size_t)DEPTH * NE * 2 * DE * D * 2;
constexpr size_t WS_WD = WS_WGU + SZ_WGU;
constexpr size_t SZ_WD = (size_t)DEPTH * NE * D * DE * 2;
constexpr size_t WS_XRES = WS_WD + SZ_WD;
constexpr size_t SZ_XRES = (size_t)T * D * 4;
constexpr size_t WS_HA = WS_XRES + SZ_XRES;
constexpr size_t SZ_H = (size_t)T * D * 2;
constexpr size_t WS_HB = WS_HA + SZ_H;
constexpr size_t WS_PROJ = WS_HB + SZ_H;
constexpr size_t SZ_PROJ = (size_t)T * INC * 2;
constexpr size_t WS_OBUF = WS_PROJ + SZ_PROJ;
constexpr size_t SZ_OBUF = (size_t)2 * T * 1536 * 4;
constexpr size_t WS_YE = WS_PROJ;
constexpr size_t SZ_YE = (size_t)XE_ROWS * D * 4;
static_assert(SZ_YE <= SZ_PROJ + SZ_OBUF, "ye alias");
constexpr size_t WS_MIXED = WS_OBUF + SZ_OBUF;
constexpr size_t WS_Y = WS_MIXED + SZ_H;
constexpr size_t SZ_Y = (size_t)T * D * 4;
constexpr size_t WS_XE = WS_Y + SZ_Y;
constexpr size_t SZ_XE = (size_t)XE_ROWS * D * 2;
constexpr size_t WS_HID = WS_XE + SZ_XE;
constexpr size_t SZ_HID = (size_t)XE_ROWS * DE * 2;
constexpr size_t WS_END = WS_HID + SZ_HID;

constexpr int LDS_BYTES = 156672;
constexpr int LDS_MISC = 153600;

struct Params {
    const float *x, *c, *emb_g, *emb_b, *w_ada, *b_ada, *w_in, *conv_w, *mix_beta, *w_out, *lb_logits, *ln_g, *ln_b, *w_router, *router_bias, *w_gate, *w_up, *w_down;
    float* out;
    unsigned char* ws;
    int ph_lo, ph_hi, l_lo, l_hi, fused, pad;
};

__device__ __forceinline__ float bf2f(unsigned b) { return __uint_as_float(b << 16); }
__device__ __forceinline__ unsigned f2bf(float f) { unsigned u = __float_as_uint(f); u += 0x7FFFu + ((u >> 16) & 1u); return u >> 16; }
typedef __bf16 bf16x2_t __attribute__((ext_vector_type(2)));
typedef float f32x2_t __attribute__((ext_vector_type(2)));
__device__ __forceinline__ unsigned pack2a(float lo, float hi) { unsigned r; asm("v_cvt_pk_bf16_f32 %0, %1, %2" : "=v"(r) : "v"(lo), "v"(hi)); return r; }
__device__ __forceinline__ unsigned pack2(float lo, float hi) { const bf16x2_t r = __builtin_convertvector((f32x2_t){lo, hi}, bf16x2_t); return __builtin_bit_cast(unsigned, r); }
__device__ __forceinline__ float wave_sum(float v) {
#pragma unroll
    for (int o = 32; o > 0; o >>= 1) v += __shfl_xor(v, o, 64);
    return v;
}
__device__ __forceinline__ float half_sum(float v) {
#pragma unroll
    for (int o = 16; o > 0; o >>= 1) v += __shfl_xor(v, o, 64);
    return v;
}
#define LDS_BARRIER() do { asm volatile("s_waitcnt lgkmcnt(0)" ::: "memory"); __builtin_amdgcn_s_barrier(); asm volatile("" ::: "memory"); } while (0)
__device__ __forceinline__ float sigmoidf_(float z) { return 1.0f / (1.0f + __expf(-z)); }
__device__ __forceinline__ float siluf_(float z) { return z / (1.0f + __expf(-z)); }

#define XB_TMO      128
#define XB_XCNT(j)  (256  + 64 * (j))
#define XB_XSUB(j)  (1280 + 64 * (j))
#define XB_XGEN(j)  (2304 + 64 * (j))
#define XB_TOP      3328
#define XB_TOPGEN   3392
#define XCD_BAR_WORDS 3456
#define XB_SPIN_CAP (1u << 22)
__device__ __forceinline__ unsigned xb_ld(unsigned* p)              { return __hip_atomic_load(p, __ATOMIC_RELAXED, __HIP_MEMORY_SCOPE_AGENT); }
__device__ __forceinline__ unsigned xb_add(unsigned* p, unsigned v) { return __hip_atomic_fetch_add(p, v, __ATOMIC_RELAXED, __HIP_MEMORY_SCOPE_AGENT); }
__device__ __forceinline__ unsigned xb_xcc_id() { return (unsigned)__builtin_amdgcn_s_getreg((3 << 11) | 20) & 0xFu; }
#define XB_SPIN(cond, bar) do { unsigned _sp = 0; while (cond) { __builtin_amdgcn_s_sleep(1); \
    if ((++_sp & 255u) == 0u) { if (xb_ld(&(bar)[XB_TMO])) break; if (_sp > XB_SPIN_CAP) { atomicAdd(&(bar)[XB_TMO], 1u); break; } } } } while (0)
struct XcdBarrier { unsigned* bar; unsigned x; volatile LAS unsigned* st; };
__device__ __forceinline__ XcdBarrier xcd_barrier_post(unsigned* bar, volatile LAS unsigned* st) {
    XcdBarrier b; b.bar = bar; b.x = xb_xcc_id(); b.st = st;
    if (threadIdx.x == 0) (void)xb_add(&bar[XB_XCNT(b.x)], 1u);
    return b;
}
__device__ __forceinline__ void xcd_barrier_complete(unsigned* bar, unsigned x, unsigned& nloc, unsigned& nx) {
    const unsigned G = gridDim.x * gridDim.y * gridDim.z;
    unsigned sum, cnt, mine, sp = 0u;
    for (;;) {
        sum = 0u; cnt = 0u; mine = 0u;
#pragma unroll
        for (unsigned j = 0; j < 16; ++j) { const unsigned c = xb_ld(&bar[XB_XCNT(j)]); sum += c; cnt += (c > 0u) ? 1u : 0u; mine = (j == x) ? c : mine; }
        if (sum == G) break;
        __builtin_amdgcn_s_sleep(1);
        if ((++sp & 255u) == 0u) { if (xb_ld(&bar[XB_TMO])) break; if (sp > XB_SPIN_CAP) { atomicAdd(&bar[XB_TMO], 1u); break; } }
    }
    nloc = mine > 0u ? mine : 1u; nx = cnt > 0u ? cnt : 1u;
}
__device__ __forceinline__ void xcd_barrier(const XcdBarrier& b) {
    asm volatile("s_waitcnt vmcnt(0)" ::: "memory");
    __syncthreads();
    if (threadIdx.x == 0) {
        unsigned* bar = b.bar;
        __builtin_amdgcn_s_waitcnt(0);
        unsigned nloc = b.st[0], nx = b.st[1];
        if (nloc == 0u) { xcd_barrier_complete(bar, b.x, nloc, nx); b.st[0] = nloc; b.st[1] = nx; }
        const unsigned old = xb_add(&bar[XB_XSUB(b.x)], 1u);
        const unsigned gen = old / nloc;
        if (old + 1u == (gen + 1u) * nloc) {
            __builtin_amdgcn_fence(__ATOMIC_RELEASE, "agent");
            asm volatile("s_waitcnt vmcnt(0)" ::: "memory");
            const unsigned og = xb_add(&bar[XB_TOP], 1u);
            const unsigned tg = og / nx;
            if (og + 1u == (tg + 1u) * nx) xb_add(&bar[XB_TOPGEN], 1u);
            else XB_SPIN(xb_ld(&bar[XB_TOPGEN]) == tg, bar);
            __builtin_amdgcn_fence(__ATOMIC_ACQUIRE, "agent");
            xb_add(&bar[XB_XGEN(b.x)], 1u);
            asm volatile("s_waitcnt vmcnt(0)" ::: "memory");
        } else {
            XB_SPIN(xb_ld(&bar[XB_XGEN(b.x)]) == gen, bar);
            __builtin_amdgcn_fence(__ATOMIC_ACQUIRE, "agent");
            asm volatile("s_waitcnt vmcnt(0)" ::: "memory");
        }
    }
    __syncthreads();
}

namespace pg8 {
constexpr int BM = 256, BK = 64, HALF = 128, HTB = HALF * BK * 2, STAGE_BYTES = 8 * HTB, NXCD = 8, WGM = 8;
__host__ __device__ __forceinline__ int lds_byte(int r, int c) { const int st = (r >> 4) * 2 + (c >> 5), rr = r & 15, cc = c & 31, ob = rr * 64 + cc * 2; return st * 1024 + (ob ^ (((ob >> 9) & 1) << 5)); }
__host__ __device__ __forceinline__ void stage_rc(int b, int& R, int& C) { const int st = b / 1024, sb = b % 1024, swz = sb ^ (((sb >> 9) & 1) << 5); R = (st >> 1) * 16 + swz / 64; C = (st & 1) * 32 + (swz % 64) / 2; }
__host__ __device__ __forceinline__ int perm32(int rho) { const int n = rho >> 4, i = rho & 15; return 8 * (i >> 2) + 4 * n + (i & 3); }

struct Unit { size_t aB, bB; int row0, col0; };
struct Gemm { const bf16_t* A; const bf16_t* Bt; int K; };

template <int NM, int NN>
struct DenseOrder {
    int G, c; size_t tstep;
    __device__ void init(int rowbytes, int G_, int c_) { G = G_; c = c_; tstep = (size_t)BM * rowbytes; }
    __device__ bool next(int i, Unit& u) const {
        constexpr int nwg = NM * NN, q = nwg / NXCD, r = nwg % NXCD, nig = WGM * NN;
        static_assert(NM % WGM == 0, "row tiles come in groups of 8");
        const int L = __builtin_amdgcn_readfirstlane(i * G + c); if (L >= nwg) return false;
        const int xcd = L % NXCD, off = L / NXCD;
        const int wgid = (xcd < r ? xcd * (q + 1) : r * (q + 1) + (xcd - r) * q) + off;
        const int gid = wgid / nig, fm = gid * WGM, rem = wgid % nig;
        const int pm = fm + (rem % WGM), pn = rem / WGM;
        u.aB = (size_t)pm * tstep; u.bB = (size_t)pn * tstep; u.row0 = pm * BM; u.col0 = pn * BM; return true;
    }
};
struct OneUnit {
    Unit u0;
    __device__ bool next(int i, Unit& u) const { if (i > 0) return false; u = u0; return true; }
};
struct MoeOrder {
    const LAS int* tab; int NTn, G, c; size_t tstep, bexp;
    __device__ bool next(int i, Unit& u) const {
        const int MT = tab[16], U = MT * NTn, nx = G >> 3;
        int f;
        if ((G & 7) == 0) { const int per = (U + 7) >> 3, x = c & 7, j = c >> 3, loc = i * nx + j; f = x * per + loc; if (loc >= per || f >= U) return false; }
        else { f = i * G + c; if (f >= U) return false; }
        int e = 0;
#pragma unroll
        for (int j = 1; j < 16; ++j) e += (f >= tab[j] * NTn) ? 1 : 0;
        const int t0 = tab[e], te = tab[e + 1] - t0, r = f - t0 * NTn;
        const int nt = r / te, mt = t0 + (r - nt * te);
        u.aB = (size_t)mt * tstep; u.bB = (size_t)e * bexp + (size_t)nt * tstep; u.row0 = mt * BM; u.col0 = nt * BM; return true;
    }
};

__device__ __forceinline__ size_t rfl64(size_t v) { const unsigned lo = (unsigned)__builtin_amdgcn_readfirstlane((int)(unsigned)v), hi = (unsigned)__builtin_amdgcn_readfirstlane((int)(unsigned)(v >> 32)); return ((size_t)hi << 32) | lo; }
__device__ __forceinline__ void uniformize(Unit& u) { u.aB = rfl64(u.aB); u.bB = rfl64(u.bB); u.row0 = __builtin_amdgcn_readfirstlane(u.row0); u.col0 = __builtin_amdgcn_readfirstlane(u.col0); }
__device__ __forceinline__ unsigned cvt_pk_bf16(float lo, float hi) { unsigned r; asm volatile("v_cvt_pk_bf16_f32 %0, %1, %2" : "=v"(r) : "v"(lo), "v"(hi)); return r; }

struct EpiF32 {
    static constexpr bool PERM = false;
    float* C; int ldc;
    __device__ __forceinline__ void operator()(const f32x4 (&acc)[2][2][4][2], const Unit& u, int wr, int wc, int fr, int fq) const {
        const int row0 = u.row0 + wr * 64 + fr, col0 = u.col0 + wc * 32 + 4 * fq;
#pragma unroll
        for (int ai = 0; ai < 2; ++ai)
#pragma unroll
            for (int m = 0; m < 4; ++m) { float* rowp = C + (size_t)(row0 + ai * HALF + m * 16) * ldc + col0;
#pragma unroll
                for (int bj = 0; bj < 2; ++bj)
#pragma unroll
                    for (int n = 0; n < 2; ++n) *(f32x4*)(rowp + bj * HALF + n * 16) = acc[ai][bj][m][n]; }
    }
};
struct EpiBf16 {
    static constexpr bool PERM = true;
    bf16_t* O; int ldc;
    __device__ __forceinline__ void operator()(const f32x4 (&acc)[2][2][4][2], const Unit& u, int wr, int wc, int fr, int fq) const {
        const int row0 = u.row0 + wr * 64 + fr, col0 = u.col0 + wc * 32 + 8 * fq;
#pragma unroll
        for (int ai = 0; ai < 2; ++ai)
#pragma unroll
            for (int m = 0; m < 4; ++m) { bf16_t* rowp = O + (size_t)(row0 + ai * HALF + m * 16) * ldc + col0;
#pragma unroll
                for (int bj = 0; bj < 2; ++bj) { const f32x4 v0 = acc[ai][bj][m][0], v1 = acc[ai][bj][m][1];
                    u32x4 o; o[0] = cvt_pk_bf16(v0[0], v0[1]); o[1] = cvt_pk_bf16(v0[2], v0[3]); o[2] = cvt_pk_bf16(v1[0], v1[1]); o[3] = cvt_pk_bf16(v1[2], v1[3]);
                    *(u32x4*)(rowp + bj * HALF) = o; } }
    }
};
struct EpiHidden {
    static constexpr bool PERM = true;
    bf16_t* O;
    __device__ __forceinline__ void operator()(const f32x4 (&acc)[2][2][4][2], const Unit& u, int wr, int wc, int fr, int fq) const {
        const int row0 = u.row0 + wr * 64 + fr, col0 = (u.col0 >> 1) + wc * 32 + 8 * fq;
#pragma unroll
        for (int ai = 0; ai < 2; ++ai)
#pragma unroll
            for (int m = 0; m < 4; ++m) { bf16_t* rowp = O + (size_t)(row0 + ai * HALF + m * 16) * DE + col0;
                float h[8];
#pragma unroll
                for (int n = 0; n < 2; ++n)
#pragma unroll
                    for (int j = 0; j < 4; ++j) { const float g = acc[ai][0][m][n][j], up = acc[ai][1][m][n][j]; h[n * 4 + j] = g * __builtin_amdgcn_rcpf(1.0f + __expf(-g)) * up; }
                u32x4 o; o[0] = cvt_pk_bf16(h[0], h[1]); o[1] = cvt_pk_bf16(h[2], h[3]); o[2] = cvt_pk_bf16(h[4], h[5]); o[3] = cvt_pk_bf16(h[6], h[7]);
                *(u32x4*)rowp = o; }
    }
};

typedef int v8i32 __attribute__((ext_vector_type(8)));
typedef int v4i32 __attribute__((ext_vector_type(4)));
struct EpiHidden8 {
    static constexpr bool PERM = true;
    unsigned char* O;
    __device__ __forceinline__ void operator()(const f32x4 (&acc)[2][2][4][2], const Unit& u, int wr, int wc, int fr, int fq) const {
        const int row0 = u.row0 + wr * 64 + fr, col0 = (u.col0 >> 1) + wc * 32 + 8 * fq;
#pragma unroll
        for (int ai = 0; ai < 2; ++ai)
#pragma unroll
            for (int m = 0; m < 4; ++m) { unsigned char* rowp = O + (size_t)(row0 + ai * HALF + m * 16) * DEP + col0;
                float h[8];
#pragma unroll
                for (int n = 0; n < 2; ++n)
#pragma unroll
                    for (int j = 0; j < 4; ++j) { const float g = acc[ai][0][m][n][j], up = acc[ai][1][m][n][j]; h[n * 4 + j] = g * __builtin_amdgcn_rcpf(1.0f + __expf(-g)) * up * H8_SCALE; }
                int o0 = __builtin_amdgcn_cvt_pk_fp8_f32(h[0], h[1], 0, false); o0 = __builtin_amdgcn_cvt_pk_fp8_f32(h[2], h[3], o0, true);
                int o1 = __builtin_amdgcn_cvt_pk_fp8_f32(h[4], h[5], 0, false); o1 = __builtin_amdgcn_cvt_pk_fp8_f32(h[6], h[7], o1, true);
                u32x2 o; o[0] = (unsigned)o0; o[1] = (unsigned)o1;
                *(u32x2*)rowp = o; }
    }
};
template <class Epi, class Sched, bool FP8 = false>
__device__ __forceinline__ void gemm_phase(LAS unsigned char* lds, const Gemm g, const Sched& S, const Epi& E, int sclW = 127, int sclA = 127) {
    int tid = threadIdx.x; asm volatile("" : "+v"(tid)); const int wid = __builtin_amdgcn_readfirstlane(tid >> 6), lane = tid & 63, wr = wid >> 2, wc = wid & 3, fr = lane & 15, fq = lane >> 4;
    const int K = g.K, rowb = FP8 ? K : 2 * K, nt = rowb / 128;
    int sclWv = sclW, sclAv = sclA; asm volatile("" : "+v"(sclWv), "+v"(sclAv));
    unsigned voffA[2], voffB[2];
#pragma unroll
    for (int i = 0; i < 2; ++i) { int R, C; stage_rc(tid * 16 + i * 8192, R, C); const int Rb = Epi::PERM ? ((R & ~31) + perm32(R & 31)) : R;
        voffA[i] = (unsigned)(R * rowb + 2 * C); voffB[i] = (unsigned)(Rb * rowb + 2 * C); }
    const size_t kstep = 128;
    const size_t hstep = (size_t)HALF * rowb;
    const unsigned ldsw = (unsigned)wid * 1024u;
    const int aoff = lds_byte(wr * 64 + fr, fq * 8), boff = lds_byte(wc * 32 + fr, fq * 8);
    constexpr int P2 = 1024;
#define PG8_SA(b, h) (((b) * 2 + (h)) * HTB)
#define PG8_SB(b, h) ((4 + (b) * 2 + (h)) * HTB)
#define PG8_STAGE(bufoff, gbase, voff) do { _Pragma("unroll") for (int _i = 0; _i < 2; ++_i) \
        __builtin_amdgcn_global_load_lds((const unsigned*)((const char*)(gbase) + (voff)[_i]), (LAS unsigned*)(lds + (bufoff) + ldsw + _i * 8192), 16, 0, 0); } while (0)
#define PG8_LDA(dst, b, h) do { _Pragma("unroll") for (int m = 0; m < 4; ++m) { \
        const v4i32 _l = *(const LAS v4i32*)(lds + PG8_SA(b, h) + aoff + m * 2048), _h = *(const LAS v4i32*)(lds + PG8_SA(b, h) + aoff + P2 + m * 2048); \
        dst[m] = __builtin_shufflevector(_l, _h, 0, 1, 2, 3, 4, 5, 6, 7); } } while (0)
#define PG8_LDB(dst, b, h) do { _Pragma("unroll") for (int n = 0; n < 2; ++n) { \
        const v4i32 _l = *(const LAS v4i32*)(lds + PG8_SB(b, h) + boff + n * 2048), _h = *(const LAS v4i32*)(lds + PG8_SB(b, h) + boff + P2 + n * 2048); \
        dst[n] = __builtin_shufflevector(_l, _h, 0, 1, 2, 3, 4, 5, 6, 7); } } while (0)
#define PG8_MMA(ai, bj, At, Bt) do { __builtin_amdgcn_s_setprio(1); _Pragma("unroll") for (int m = 0; m < 4; ++m) _Pragma("unroll") for (int n = 0; n < 2; ++n) { \
        if constexpr (FP8) { \
            asm volatile("v_mfma_scale_f32_16x16x128_f8f6f4 %0, %1, %2, %0, %3, %4 op_sel_hi:[0,0,0]" : "+v"(acc[ai][bj][m][n]) : "v"(Bt[n]), "v"(At[m]), "v"(sclWv), "v"(sclAv)); \
        } else { \
            acc[ai][bj][m][n] = __builtin_amdgcn_mfma_f32_16x16x32_bf16(__builtin_bit_cast(bf16x8, __builtin_shufflevector(Bt[n], Bt[n], 0, 1, 2, 3)), __builtin_bit_cast(bf16x8, __builtin_shufflevector(At[m], At[m], 0, 1, 2, 3)), acc[ai][bj][m][n], 0, 0, 0); \
            acc[ai][bj][m][n] = __builtin_amdgcn_mfma_f32_16x16x32_bf16(__builtin_bit_cast(bf16x8, __builtin_shufflevector(Bt[n], Bt[n], 4, 5, 6, 7)), __builtin_bit_cast(bf16x8, __builtin_shufflevector(At[m], At[m], 4, 5, 6, 7)), acc[ai][bj][m][n], 0, 0, 0); } } \
        __builtin_amdgcn_s_setprio(0); } while (0)
#define PG8_WAIT_V(n) asm volatile("s_waitcnt vmcnt(" #n ")" ::: "memory")
#define PG8_WAIT_L(n) asm volatile("s_waitcnt lgkmcnt(" #n ")" ::: "memory")
#define PG8_BAR __builtin_amdgcn_s_barrier()
#define PG8_SCHED __builtin_amdgcn_sched_barrier(0)
    Unit cur, nxt; int ui = 0;
    if (!S.next(0, cur)) return;
    uniformize(cur);
    f32x4 acc[2][2][4][2];
#pragma unroll
    for (int a = 0; a < 2; ++a)
#pragma unroll
        for (int b = 0; b < 2; ++b)
#pragma unroll
            for (int m = 0; m < 4; ++m)
#pragma unroll
                for (int n = 0; n < 2; ++n) acc[a][b][m][n] = (f32x4){0.f, 0.f, 0.f, 0.f};
    v8i32 At[4], B0[2], B1[2];
    const char* cA = (const char*)g.A + cur.aB; const char* cB = (const char*)g.Bt + cur.bB;
    PG8_STAGE(PG8_SB(0, 0), cB, voffB); PG8_STAGE(PG8_SA(0, 0), cA, voffA); PG8_STAGE(PG8_SB(0, 1), cB + hstep, voffB); PG8_STAGE(PG8_SA(0, 1), cA + hstep, voffA);
    if (wr == 1) PG8_BAR;
    PG8_WAIT_V(4); PG8_BAR;
    PG8_STAGE(PG8_SB(1, 0), cB + kstep, voffB); PG8_STAGE(PG8_SA(1, 0), cA + kstep, voffA); PG8_STAGE(PG8_SB(1, 1), cB + hstep + kstep, voffB);
    PG8_WAIT_V(6); PG8_BAR;
    for (;;) {
        const bool has_next = S.next(ui + 1, nxt);
        uniformize(nxt);
        const char* nA = has_next ? (const char*)g.A + nxt.aB : cA; const char* nB = has_next ? (const char*)g.Bt + nxt.bB : cB;
        for (int t = 0; t < nt; t += 2) {
            const bool last = (t == nt - 2);
            const char* a1 = cA + (size_t)(t + 1) * kstep;
            const char* a2 = last ? nA : cA + (size_t)(t + 2) * kstep; const char* b2 = last ? nB : cB + (size_t)(t + 2) * kstep;
            const char* a3 = a2 + kstep; const char* b3 = b2 + kstep;
            PG8_LDB(B0, 0, 0); PG8_SCHED; PG8_LDA(At, 0, 0); PG8_STAGE(PG8_SA(1, 1), a1 + hstep, voffA);
            PG8_WAIT_L(8); PG8_BAR; PG8_WAIT_L(0); PG8_MMA(0, 0, At, B0); PG8_BAR; PG8_SCHED;
            PG8_LDB(B1, 0, 1); PG8_STAGE(PG8_SB(0, 0), b2, voffB);
            PG8_BAR; PG8_WAIT_L(0); PG8_MMA(0, 1, At, B1); PG8_BAR;
            PG8_LDA(At, 0, 1); PG8_STAGE(PG8_SA(0, 0), a2, voffA);
            PG8_BAR; PG8_WAIT_L(0); PG8_MMA(1, 0, At, B0); PG8_BAR; PG8_SCHED;
            PG8_STAGE(PG8_SB(0, 1), b2 + hstep, voffB);
            PG8_WAIT_V(6); PG8_BAR; PG8_MMA(1, 1, At, B1); PG8_BAR;
            PG8_LDB(B0, 1, 0); PG8_SCHED; PG8_LDA(At, 1, 0); PG8_STAGE(PG8_SA(0, 1), a2 + hstep, voffA);
            PG8_WAIT_L(8); PG8_BAR; PG8_WAIT_L(0); PG8_MMA(0, 0, At, B0); PG8_BAR; PG8_SCHED;
            PG8_LDB(B1, 1, 1); PG8_STAGE(PG8_SB(1, 0), b3, voffB);
            PG8_BAR; PG8_WAIT_L(0); PG8_MMA(0, 1, At, B1); PG8_BAR;
            PG8_LDA(At, 1, 1); PG8_STAGE(PG8_SA(1, 0), a3, voffA);
            PG8_BAR; PG8_WAIT_L(0); PG8_MMA(1, 0, At, B0); PG8_BAR; PG8_SCHED;
            PG8_STAGE(PG8_SB(1, 1), b3 + hstep, voffB);
            PG8_WAIT_V(6); PG8_BAR; PG8_MMA(1, 1, At, B1); PG8_BAR;
        }
        if constexpr (FP8) asm volatile("s_nop 15\n\ts_nop 15" ::: "memory");
        E(acc, cur, wr, wc, fr, fq);
        if (!has_next) break;
#pragma unroll
        for (int a = 0; a < 2; ++a)
#pragma unroll
            for (int b = 0; b < 2; ++b)
#pragma unroll
                for (int m = 0; m < 4; ++m)
#pragma unroll
                    for (int n = 0; n < 2; ++n) acc[a][b][m][n] = (f32x4){0.f, 0.f, 0.f, 0.f};
        cur = nxt; cA = nA; cB = nB; ++ui;
    }
    PG8_WAIT_V(0);
    if (wr == 0) PG8_BAR;
    PG8_BAR;
#undef PG8_SA
#undef PG8_SB
#undef PG8_STAGE
#undef PG8_LDA
#undef PG8_LDB
#undef PG8_MMA
#undef PG8_WAIT_V
#undef PG8_WAIT_L
#undef PG8_BAR
#undef PG8_SCHED
}
}

constexpr int S_IN = 16 * 66, S_OUT = 16 * 16, S_GU = 16 * 11, S_DN = 11 * 16;
constexpr int CV_PER_L = S_IN + S_OUT + NE * 2 * S_GU + NE * S_DN;
constexpr int CV_A0 = S_IN + S_OUT;
constexpr int CV_A1 = CV_A0 + NE * 2 * S_GU;
constexpr int CV_TOTAL = DEPTH * CV_PER_L;
constexpr int CV_LAST = 1 << 30;
struct StripDesc { const float* src; bf16_t* dst; int lds_, ldd, k0, n0, drow0, fp8; };
__device__ __forceinline__ StripDesc strip_desc(const Params& p, int si) {
    unsigned char* ws = p.ws; StripDesc d;
    const int l = si / CV_PER_L; int r = si - l * CV_PER_L;
    if (r < S_IN) {
        const int kt = r / 66, ntl = r % 66;
        d.src = p.w_in + (size_t)l * D * INC; d.lds_ = INC; d.fp8 = INP8(l) ? 1 : 0; d.dst = (bf16_t*)(ws + WS_WIN) + (size_t)l * INC * D; d.ldd = D; d.k0 = kt * 128; d.n0 = ntl * 128; d.drow0 = ntl * 128;
    } else if (r < CV_A0) {
        r -= S_IN; const int kt = r / 16, ntl = r % 16;
        d.src = p.w_out + (size_t)l * D * D; d.lds_ = D; d.dst = (bf16_t*)(ws + WS_WOUT) + (size_t)l * D * D; d.ldd = D; d.k0 = kt * 128; d.n0 = ntl * 128; d.drow0 = ntl * 128; d.fp8 = OUT8(l) ? 1 : 0;
    } else if (r < CV_A1) {
        r -= CV_A0; const int mat = r / S_GU, q = r % S_GU, kt = q / 11, ntl = q % 11;
        const int which = mat & 1, le = l * NE + (mat >> 1);
        d.src = (which ? p.w_up : p.w_gate) + (size_t)le * D * DE; d.lds_ = DE; d.fp8 = MOE_FP8; d.dst = MOE_FP8 ? (bf16_t*)(ws + WS_WGU + (size_t)le * (2 * DE) * D) : (bf16_t*)(ws + WS_WGU) + (size_t)le * (2 * DE) * D; d.ldd = D; d.k0 = kt * 128; d.n0 = ntl * 128; d.drow0 = ntl * 256 + which * 128;
    } else {
        r -= CV_A1; const int le = l * NE + r / S_DN, q = r % S_DN, kt = q / 16, ntl = q % 16;
        d.src = p.w_down + (size_t)le * DE * D; d.lds_ = D; d.fp8 = MOE_FP8; d.dst = MOE_FP8 ? (bf16_t*)(ws + WS_WD + (size_t)le * D * DEP) : (bf16_t*)(ws + WS_WD) + (size_t)le * D * DE; d.ldd = MOE_FP8 ? DEP : DE; d.k0 = kt * 128; d.n0 = ntl * 128; d.drow0 = ntl * 128;
    }
    return d;
}
__device__ __forceinline__ void cvt_store_strip(const StripDesc& d, const float4 (&a)[2][2], const float4 (&b)[2][2], LAS unsigned char* tb, int tid, bool readout) {
    const int kp = tid >> 4, n4 = (tid & 15) * 4;
    if (!readout) {
        if (!d.fp8) {
#pragma unroll
            for (int ki = 0; ki < 2; ++ki)
#pragma unroll
                for (int ni = 0; ni < 2; ++ni) {
                    LAS unsigned* t = (LAS unsigned*)tb + (ki * 2 + ni) * 2112;
                    t[(n4 + 0) * 33 + kp] = pack2a(a[ki][ni].x, b[ki][ni].x);
                    t[(n4 + 1) * 33 + kp] = pack2a(a[ki][ni].y, b[ki][ni].y);
                    t[(n4 + 2) * 33 + kp] = pack2a(a[ki][ni].z, b[ki][ni].z);
                    t[(n4 + 3) * 33 + kp] = pack2a(a[ki][ni].w, b[ki][ni].w);
                }
        } else {
#pragma unroll
            for (int ki = 0; ki < 2; ++ki)
#pragma unroll
                for (int ni = 0; ni < 2; ++ni) {
                    LAS unsigned char* t = tb + (ki * 2 + ni) * 4352;
                    *(LAS unsigned short*)(t + (n4 + 0) * 68 + 2 * kp) = (unsigned short)__builtin_amdgcn_cvt_pk_fp8_f32(a[ki][ni].x * W8_SCALE, b[ki][ni].x * W8_SCALE, 0, false);
                    *(LAS unsigned short*)(t + (n4 + 1) * 68 + 2 * kp) = (unsigned short)__builtin_amdgcn_cvt_pk_fp8_f32(a[ki][ni].y * W8_SCALE, b[ki][ni].y * W8_SCALE, 0, false);
                    *(LAS unsigned short*)(t + (n4 + 2) * 68 + 2 * kp) = (unsigned short)__builtin_amdgcn_cvt_pk_fp8_f32(a[ki][ni].z * W8_SCALE, b[ki][ni].z * W8_SCALE, 0, false);
                    *(LAS unsigned short*)(t + (n4 + 3) * 68 + 2 * kp) = (unsigned short)__builtin_amdgcn_cvt_pk_fp8_f32(a[ki][ni].w * W8_SCALE, b[ki][ni].w * W8_SCALE, 0, false);
                }
        }
    } else {
        if (!d.fp8) {
            const int n = tid >> 3, kc = (tid & 7) * 4;
#pragma unroll
            for (int ki = 0; ki < 2; ++ki)
#pragma unroll
                for (int ni = 0; ni < 2; ++ni) {
                    const LAS unsigned* t = (const LAS unsigned*)tb + (ki * 2 + ni) * 2112;
                    u32x4 o; o[0] = t[n * 33 + kc]; o[1] = t[n * 33 + kc + 1]; o[2] = t[n * 33 + kc + 2]; o[3] = t[n * 33 + kc + 3];
                    *(u32x4*)(d.dst + (size_t)(d.drow0 + ni * 64 + n) * d.ldd + d.k0 + ki * 64 + kc * 2) = o;
                }
        } else {
            const int n = tid >> 3, kc8 = (tid & 7) * 8;
            unsigned char* dst8 = (unsigned char*)d.dst;
#pragma unroll
            for (int ki = 0; ki < 2; ++ki)
#pragma unroll
                for (int ni = 0; ni < 2; ++ni) {
                    const LAS unsigned char* t = tb + (ki * 2 + ni) * 4352;
                    u32x2 o; o[0] = *(const LAS unsigned*)(t + n * 68 + kc8); o[1] = *(const LAS unsigned*)(t + n * 68 + kc8 + 4);
                    *(u32x2*)(dst8 + (size_t)(d.drow0 + ni * 64 + n) * d.ldd + d.k0 + ki * 64 + kc8) = o;
                }
        }
    }
}
__device__ __forceinline__ void cvt_pull(const Params& p, LAS unsigned char* lds, int limit, unsigned* done_ctr, unsigned need_done) {
    int tid = threadIdx.x; asm volatile("" : "+v"(tid));
    LAS int* slot = (LAS int*)(lds + LDS_MISC + 512);
    unsigned* head = (unsigned*)(p.ws + WS_CVTQ);
    if (tid == 0) {
        int sv = -1;
        const bool stop = done_ctr ? (xb_ld(done_ctr) >= need_done) : (xb_ld(head) >= (unsigned)limit);
        if (!stop) { const unsigned c = xb_add(head, 2u); sv = c < (unsigned)CV_TOTAL ? (int)c : -1; }
        slot[0] = sv;
    }
    __syncthreads();
    const int kp = tid >> 4, n4 = (tid & 15) * 4;
    for (;;) {
        const int sraw = slot[0];
        if (sraw < 0) break;
        const int si = sraw & (CV_LAST - 1); const bool lastone = (sraw & CV_LAST) != 0;
        const StripDesc d0 = strip_desc(p, si), d1 = strip_desc(p, si + 1);
        float4 a0[2][2], b0[2][2], a1[2][2], b1[2][2];
#pragma unroll
        for (int ki = 0; ki < 2; ++ki)
#pragma unroll
            for (int ni = 0; ni < 2; ++ni) {
                a0[ki][ni] = *(const float4*)(d0.src + (size_t)(d0.k0 + ki * 64 + 2 * kp) * d0.lds_ + d0.n0 + ni * 64 + n4);
                b0[ki][ni] = *(const float4*)(d0.src + (size_t)(d0.k0 + ki * 64 + 2 * kp + 1) * d0.lds_ + d0.n0 + ni * 64 + n4);
            }
#pragma unroll
        for (int ki = 0; ki < 2; ++ki)
#pragma unroll
            for (int ni = 0; ni < 2; ++ni) {
                a1[ki][ni] = *(const float4*)(d1.src + (size_t)(d1.k0 + ki * 64 + 2 * kp) * d1.lds_ + d1.n0 + ni * 64 + n4);
                b1[ki][ni] = *(const float4*)(d1.src + (size_t)(d1.k0 + ki * 64 + 2 * kp + 1) * d1.lds_ + d1.n0 + ni * 64 + n4);
            }
        unsigned c = 0u, dn = 0u;
        if (tid == 0 && !lastone) { c = xb_add(head, 2u); if (done_ctr) dn = xb_ld(done_ctr); }
        cvt_store_strip(d0, a0, b0, lds, tid, false);
        cvt_store_strip(d1, a1, b1, lds + 33792, tid, false);
        LDS_BARRIER();
        cvt_store_strip(d0, a0, b0, lds, tid, true);
        cvt_store_strip(d1, a1, b1, lds + 33792, tid, true);
        if (tid == 0) {
            int sv = -1;
            if (!lastone && c < (unsigned)CV_TOTAL) { const bool fin = done_ctr ? (dn >= need_done) : (c >= (unsigned)limit); sv = (int)c | (fin ? CV_LAST : 0); }
            slot[0] = sv;
        }
        LDS_BARRIER();
    }
    __syncthreads();
}
__device__ __forceinline__ void tail_pull(const Params& p, LAS unsigned char* lds, int ctr_idx) {
    unsigned* ctr = (unsigned*)(p.ws + WS_CVTQ) + 64 * (1 + ctr_idx);
    __syncthreads();
    if (threadIdx.x == 0) (void)xb_add(ctr, 1u);
    cvt_pull(p, lds, 0, ctr, gridDim.x);
}

__device__ __forceinline__ void ada_chunks(const Params& p, LAS unsigned char* lds, int ch0, int ch_end, int step) {
    int tid = threadIdx.x; asm volatile("" : "+v"(tid));
    unsigned char* ws = p.ws;
    LAS float* cond = (LAS float*)lds;
    LAS float* red = (LAS float*)(lds + 32768);
    if (ch0 >= ch_end) return;
    for (int i = tid; i < 4 * D; i += 512) { const float v = p.c[i]; cond[i] = siluf_(v); }
    __syncthreads();
    for (int ch = ch0; ch < ch_end; ch += step) {
        const int l = ch >> 7, j0 = (ch & 127) * 96;
        const float* w = p.w_ada + (size_t)l * D * (6 * D);
        const int kg = tid / 24, cl = tid % 24;
        float acc[4][4];
#pragma unroll
        for (int b = 0; b < 4; ++b)
#pragma unroll
            for (int j = 0; j < 4; ++j) acc[b][j] = 0.f;
        if (kg < 21) {
            for (int it0 = 0; it0 < 98; it0 += 14) {
                float4 wv[14];
#pragma unroll
                for (int q = 0; q < 14; ++q) { const int k = kg + 21 * (it0 + q); wv[q] = (k < D) ? *(const float4*)(w + (size_t)k * (6 * D) + j0 + cl * 4) : make_float4(0.f, 0.f, 0.f, 0.f); }
#pragma unroll
                for (int q = 0; q < 14; ++q) { const int k = kg + 21 * (it0 + q); const int kc = k < D ? k : 0;
#pragma unroll
                    for (int b = 0; b < 4; ++b) { const float cv = cond[b * D + kc]; acc[b][0] += cv * wv[q].x; acc[b][1] += cv * wv[q].y; acc[b][2] += cv * wv[q].z; acc[b][3] += cv * wv[q].w; } }
            }
#pragma unroll
            for (int b = 0; b < 4; ++b)
#pragma unroll
                for (int j = 0; j < 4; ++j) red[(kg * 4 + b) * 96 + cl * 4 + j] = acc[b][j];
        }
        __syncthreads();
        if (tid < 384) {
            const int b = tid / 96, col = tid % 96; float s = 0.f;
            for (int g = 0; g < 21; ++g) s += red[(g * 4 + b) * 96 + col];
            float* mod = (float*)(ws + WS_MOD);
            mod[((size_t)l * 4 + b) * (6 * D) + j0 + col] = s + p.b_ada[(size_t)l * 6 * D + j0 + col];
        }
        __syncthreads();
    }
}
__device__ __forceinline__ void phase_prologue(const Params& p, LAS unsigned char* lds) {
    const bool svc = (gridDim.x >= 256);
    {
        float* wrt = (float*)(p.ws + WS_WRT);
        for (int i = blockIdx.x * 512 + threadIdx.x; i < D * NE / 4; i += gridDim.x * 512) {
            const float4 w = *(const float4*)(p.w_router + (size_t)i * 4);
            const int d = i >> 2, e4 = (i & 3) * 4;
            const int dp = (((d >> 9) * 2 + ((d >> 2) & 1)) << 8) + (((d >> 3) & 63) << 2) + (d & 3);
            wrt[(e4 + 0) * D + dp] = w.x; wrt[(e4 + 1) * D + dp] = w.y; wrt[(e4 + 2) * D + dp] = w.z; wrt[(e4 + 3) * D + dp] = w.w;
        }
    }
    ada_chunks(p, lds, blockIdx.x, svc ? 128 : 256, gridDim.x);
    cvt_pull(p, lds, CV_A0, nullptr, 0u);
}

#define COLK(k) ((unsigned)((((k) >> 1) << 9) + lane * 8 + (((k) & 1) << 2)))
#define COL8(i) ((unsigned)(((i) << 9) + lane * 8))
__device__ __forceinline__ void ld_bf8(const bf16_t* p, float4& a, float4& b) {
    const u32x4 r = *(const u32x4*)p;
    a = make_float4(bf2f(r[0] & 0xffffu), bf2f(r[0] >> 16), bf2f(r[1] & 0xffffu), bf2f(r[1] >> 16));
    b = make_float4(bf2f(r[2] & 0xffffu), bf2f(r[2] >> 16), bf2f(r[3] & 0xffffu), bf2f(r[3] >> 16));
}
__device__ __forceinline__ void st_bf8(bf16_t* p, const float4& a, const float4& b) {
    u32x4 o; o[0] = pack2a(a.x, a.y); o[1] = pack2a(a.z, a.w); o[2] = pack2a(b.x, b.y); o[3] = pack2a(b.z, b.w);
    *(u32x4*)p = o;
}
__device__ __forceinline__ void st_fp8x8(unsigned char* p, const float4& a, const float4& b) {
    int o0 = __builtin_amdgcn_cvt_pk_fp8_f32(a.x, a.y, 0, false); o0 = __builtin_amdgcn_cvt_pk_fp8_f32(a.z, a.w, o0, true);
    int o1 = __builtin_amdgcn_cvt_pk_fp8_f32(b.x, b.y, 0, false); o1 = __builtin_amdgcn_cvt_pk_fp8_f32(b.z, b.w, o1, true);
    u32x2 o; o[0] = (unsigned)o0; o[1] = (unsigned)o1;
    *(u32x2*)p = o;
}
__device__ __forceinline__ void ln_rows(float4 (&v)[8], const float* __restrict__ g, const float* __restrict__ b, int lane) {
    float s = 0.f;
#pragma unroll
    for (int i = 0; i < 8; ++i) s += (v[i].x + v[i].y) + (v[i].z + v[i].w);
    const float mean = wave_sum(s) * (1.0f / D);
    float q = 0.f;
#pragma unroll
    for (int i = 0; i < 8; ++i) { const float a = v[i].x - mean, bb = v[i].y - mean, c = v[i].z - mean, d = v[i].w - mean; q += (a * a + bb * bb) + (c * c + d * d); }
    const float rstd = rsqrtf(wave_sum(q) * (1.0f / D) + 1e-5f);
#pragma unroll
    for (int i = 0; i < 8; ++i) {
        const float4 gv = *(const float4*)(g + COLK(i)), bv = *(const float4*)(b + COLK(i));
        v[i].x = (v[i].x - mean) * rstd * gv.x + bv.x; v[i].y = (v[i].y - mean) * rstd * gv.y + bv.y;
        v[i].z = (v[i].z - mean) * rstd * gv.z + bv.z; v[i].w = (v[i].w - mean) * rstd * gv.w + bv.w;
    }
}
__device__ __forceinline__ void modulate_store(const float4 (&v)[8], const float* __restrict__ shift, const float* __restrict__ scale, bf16_t* __restrict__ dst, int lane, bool fp8) {
#pragma unroll
    for (int i = 0; i < 4; ++i) {
        float4 h[2];
#pragma unroll
        for (int q = 0; q < 2; ++q) {
            const float4 sh = *(const float4*)(shift + COLK(2 * i + q)), sc = *(const float4*)(scale + COLK(2 * i + q));
            const float4 x = v[2 * i + q];
            h[q] = make_float4(x.x * (1.f + sc.x) + sh.x, x.y * (1.f + sc.y) + sh.y, x.z * (1.f + sc.z) + sh.z, x.w * (1.f + sc.w) + sh.w);
        }
        if (fp8) st_fp8x8((unsigned char*)dst + COL8(i), h[0], h[1]);
        else st_bf8(dst + COL8(i), h[0], h[1]);
    }
}

__device__ __forceinline__ void phase_ln0(const Params& p) {
    int tid_ = threadIdx.x; asm volatile("" : "+v"(tid_)); const int wave = __builtin_amdgcn_readfirstlane(tid_ >> 6), lane = tid_ & 63;
    const float* mod = (const float*)(p.ws + WS_MOD);
    for (int n = blockIdx.x * 8 + wave; n < T; n += gridDim.x * 8) {
        const int b = n / SEQ;
        float4 v[8];
#pragma unroll
        for (int i = 0; i < 8; ++i) v[i] = *(const float4*)(p.x + (size_t)n * D + COLK(i));
        ln_rows(v, p.emb_g, p.emb_b, lane);
        bf16_t* xr = (bf16_t*)(p.ws + WS_XRES) + (size_t)n * D;
#pragma unroll
        for (int i = 0; i < 4; ++i) st_bf8(xr + COL8(i), v[2 * i], v[2 * i + 1]);
        const float* mb = mod + ((size_t)0 * 4 + b) * (6 * D);
        modulate_store(v, mb, mb + D, INP8(0) ? (bf16_t*)(p.ws + WS_HA + (size_t)n * D) : (bf16_t*)(p.ws + WS_HA) + (size_t)n * D, lane, INP8(0));
    }
}

__device__ __forceinline__ void phase_mixer_valu(const Params& p, int l, LAS unsigned char* lds) {
    LAS float* qs = (LAS float*)lds; LAS float* ks = qs + 4096; LAS float* fs = ks + 4096; LAS float* vs = fs + 4096; LAS float* po = vs + 1024;
    int tid = threadIdx.x; asm volatile("" : "+v"(tid)); const int wave = tid >> 6, lane = tid & 63, kk = tid >> 5, vv = tid & 31;
    const bf16_t* proj = (const bf16_t*)(p.ws + WS_PROJ);
    float* obuf = (float*)(p.ws + WS_OBUF);
    for (int u = blockIdx.x; u < 384; u += gridDim.x) {
        const int vsl = u & 3, dir = (u >> 2) & 1, hh = (u >> 3) % 6, b = ((u >> 3) / 6) % 4, type = (u >> 3) / 24;
        float S[8];
#pragma unroll
        for (int j = 0; j < 8; ++j) S[j] = 0.f;
        const float gamma = 1.0f - exp2f(-(dir ? 5.5f : 5.0f) - (float)hh);
        for (int blk = 0; blk < 64; ++blk) {
            const int rb = dir ? 63 - blk : blk, t0 = rb * 32;
            if (type == 0) {
#pragma unroll
                for (int j = 0; j < 4; ++j) {
                    const int idx = tid + 512 * j, tt = idx >> 6, dp = idx & 63;
                    const bf16_t* row = proj + (size_t)(b * SEQ + t0 + tt) * INC;
                    const float q1 = bf2f(row[C_RQ + hh * 128 + dp]), q2 = bf2f(row[C_RQ + hh * 128 + 64 + dp]);
                    const float k1 = bf2f(row[C_RK + hh * 128 + dp]), k2 = bf2f(row[C_RK + hh * 128 + 64 + dp]);
                    const float inv_freq = exp2f(-(float)dp * (13.287712379549449f / 64.0f));
                    const float ang = (float)(t0 + tt) * inv_freq;
                    float rev = ang * 0.15915494309189535f; rev -= rintf(rev);
                    const float sn = __builtin_amdgcn_sinf(rev), cs = __builtin_amdgcn_cosf(rev);
                    qs[tt * 128 + dp] = q1 * cs - q2 * sn; qs[tt * 128 + 64 + dp] = q1 * sn + q2 * cs;
                    ks[tt * 128 + dp] = (k1 * cs - k2 * sn) * 0.08838834764831845f; ks[tt * 128 + 64 + dp] = (k1 * sn + k2 * cs) * 0.08838834764831845f;
                    fs[tt * 128 + dp] = gamma; fs[tt * 128 + 64 + dp] = gamma;
                }
            } else {
#pragma unroll
                for (int j = 0; j < 8; ++j) {
                    const int idx = tid + 512 * j, tt = idx >> 7, d = idx & 127;
                    const bf16_t* row = proj + (size_t)(b * SEQ + t0 + tt) * INC;
                    const float q = bf2f(row[C_HQ + hh * 128 + d]);
                    const float z = bf2f(row[(dir ? C_HFB : C_HFF) + hh * 128 + d]);
                    float lb = 0.f;
                    if (l > 0) { const float a0 = p.lb_logits[(0 * 2 + dir) * HWD + hh * 128 + d], a1 = p.lb_logits[(1 * 2 + dir) * HWD + hh * 128 + d]; lb = 1.0f / (1.0f + expf(a0 - a1)); }
                    float f = lb + (1.0f - lb) * (1.0f / (1.0f + expf(-z)));
                    f = fmaxf(f, 1e-6f);
                    qs[tt * 128 + d] = q; ks[tt * 128 + d] = 1.0f - f; fs[tt * 128 + d] = f;
                }
            }
#pragma unroll
            for (int j = 0; j < 2; ++j) {
                const int idx = tid + 512 * j, tt = idx >> 5, c = idx & 31;
                const bf16_t* row = proj + (size_t)(b * SEQ + t0 + tt) * INC;
                vs[tt * 32 + c] = bf2f(row[(type ? C_HI : C_RV) + hh * 128 + vsl * 32 + c]);
            }
            __syncthreads();
            for (int s = 0; s < 32; ++s) {
                const int ss = dir ? 31 - s : s;
                const f32x4 qa = *(const LAS f32x4*)(qs + ss * 128 + kk * 8), qb = *(const LAS f32x4*)(qs + ss * 128 + kk * 8 + 4);
                const f32x4 ka = *(const LAS f32x4*)(ks + ss * 128 + kk * 8), kb = *(const LAS f32x4*)(ks + ss * 128 + kk * 8 + 4);
                const f32x4 fa = *(const LAS f32x4*)(fs + ss * 128 + kk * 8), fb = *(const LAS f32x4*)(fs + ss * 128 + kk * 8 + 4);
                const float vval = vs[ss * 32 + vv];
                float acc = 0.f;
#pragma unroll
                for (int j = 0; j < 4; ++j) { S[j] = fa[j] * S[j] + ka[j] * vval; acc += S[j] * qa[j]; }
#pragma unroll
                for (int j = 0; j < 4; ++j) { S[4 + j] = fb[j] * S[4 + j] + kb[j] * vval; acc += S[4 + j] * qb[j]; }
                acc += __shfl_xor(acc, 32, 64);
                if (lane < 32) po[(ss * 8 + wave) * 32 + vv] = acc;
            }
            __syncthreads();
#pragma unroll
            for (int j = 0; j < 2; ++j) {
                const int idx = tid + 512 * j, tt = idx >> 5, c = idx & 31;
                float s = 0.f;
#pragma unroll
                for (int w = 0; w < 8; ++w) s += po[(tt * 8 + w) * 32 + c];
                obuf[((size_t)dir * T + (size_t)(b * SEQ + t0 + tt)) * 1536 + type * 768 + hh * 128 + vsl * 32 + c] = s;
            }
        }
        __syncthreads();
    }
}

constexpr int MX_QI = 0, MX_KI = 17408, MX_QS = 34816, MX_KTT = 52224, MX_VT = 70656, MX_P = 79872, MX_ST = 89088, MX_TOT = 106496, MX_DEC = 110592, MX_RQ = 112128, MX_RK = 128512, MX_RV = 144896;
__device__ __forceinline__ float ex2(float x) { return __builtin_amdgcn_exp2f(x); }
__device__ __forceinline__ float clampe(float x) { return fminf(fmaxf(x, -120.f), 120.f); }
template <int MODE>
__device__ __forceinline__ void phase_mixer_mfma(const Params& p, int l, LAS unsigned char* lds, float* __restrict__ obuf) {
    int tid = threadIdx.x; asm volatile("" : "+v"(tid));
    const int wave = __builtin_amdgcn_readfirstlane(tid >> 6), lane = tid & 63, fr = lane & 15, fq = lane >> 4;
    const bf16_t* proj = (const bf16_t*)(p.ws + WS_PROJ);
    for (int u = blockIdx.x; u < 192; u += gridDim.x) {
        const int vsl = u & 1, dir = (u >> 1) & 1, hh = (u >> 2) % 6, b = ((u >> 2) / 6) % 4, type = (u >> 2) / 24;
        float lg2 = 0.f, invf0 = 0.f, invf1 = 0.f, sgn = 1.f, lb0 = 0.f, lb1 = 0.f;
        if (type == 0) {
            const float gamma = 1.0f - exp2f(-(dir ? 5.5f : 5.0f) - (float)hh);
            lg2 = log2f(gamma);
            const int dm0 = (2 * lane) & 63;
            invf0 = exp2f(-(float)dm0 * (13.287712379549449f / 64.0f)); invf1 = exp2f(-(float)(dm0 + 1) * (13.287712379549449f / 64.0f));
            sgn = lane < 32 ? -1.f : 1.f;
        } else if (l > 0) {
            const float* lbl = p.lb_logits + dir * HWD + hh * 128 + 2 * lane;
            lb0 = 1.0f / (1.0f + expf(lbl[0] - lbl[2 * HWD])); lb1 = 1.0f / (1.0f + expf(lbl[1] - lbl[2 * HWD + 1]));
        }
        const int colA = (type ? C_HQ : C_RQ) + hh * 128, colB = (type ? (dir ? C_HFB : C_HFF) : C_RK) + hh * 128;
        const int colV0 = (type ? C_HI : C_RV) + hh * 128 + vsl * 64;
        const int own = 2 * lane, par = (2 * lane + 64) & 127;
        const size_t ocol = (size_t)type * 768 + hh * 128 + vsl * 64;
#define MX_LOAD(ch) do { \
            _Pragma("unroll") for (int i2 = 0; i2 < 2; ++i2) { const int pos = wave * 8 + i2 * 4 + (lane >> 4); const int tau = (ch) * 64 + pos; const int t = dir ? (SEQ - 1 - tau) : tau; \
                const bf16_t* row = proj + (size_t)(b * SEQ + t) * INC + (lane & 15) * 8; \
                __builtin_amdgcn_global_load_lds((const unsigned*)(row + colA), (LAS unsigned*)(lds + MX_RQ + (wave * 8 + i2 * 4) * 256), 16, 0, 0); \
                __builtin_amdgcn_global_load_lds((const unsigned*)(row + colB), (LAS unsigned*)(lds + MX_RK + (wave * 8 + i2 * 4) * 256), 16, 0, 0); } \
            { const int pos = wave * 8 + (lane >> 3); const int tau = (ch) * 64 + pos; const int t = dir ? (SEQ - 1 - tau) : tau; \
              const bf16_t* row = proj + (size_t)(b * SEQ + t) * INC + colV0 + (lane & 7) * 8; \
              __builtin_amdgcn_global_load_lds((const unsigned*)row, (LAS unsigned*)(lds + MX_RV + (wave * 8) * 128), 16, 0, 0); } } while (0)
        f32x4 Sacc[4];
#pragma unroll
        for (int vt = 0; vt < 4; ++vt) Sacc[vt] = (f32x4){0.f, 0.f, 0.f, 0.f};
        for (int i = tid; i < 64 * 272 / 4; i += 512) ((LAS unsigned*)(lds + MX_ST))[i] = 0u;
        float cd0 = 1.f, sd0 = 0.f, cd1 = 1.f, sd1 = 0.f;
        if (type == 0) {
            if (tid < 64) { const float fi = (float)tid; *(LAS f32x4*)(lds + MX_DEC + 512 + tid * 16) = (f32x4){ex2((fi - 31.f) * lg2), ex2((31.f - fi) * lg2), ex2((fi + 1.f) * lg2), ex2((63.f - fi) * lg2)}; }
            const float r0 = invf0 * 0.15915494309189535f, r1 = invf1 * 0.15915494309189535f, sg = dir ? -1.f : 1.f;
            cd0 = __builtin_amdgcn_cosf(r0); sd0 = sg * __builtin_amdgcn_sinf(r0); cd1 = __builtin_amdgcn_cosf(r1); sd1 = sg * __builtin_amdgcn_sinf(r1);
        }
        __syncthreads();
        MX_LOAD(0);
        asm volatile("s_waitcnt vmcnt(0)" ::: "memory");
        __syncthreads();
        for (int ch = 0; ch < 32; ++ch) {
            float q0[8], q1[8], k0[8], k1[8], c0[8], c1[8];
            float run0 = 0.f, run1 = 0.f;
            u32x4 vpk = (u32x4){0u, 0u, 0u, 0u};
#pragma unroll
            for (int j = 0; j < 8; ++j) { q0[j] = q1[j] = k0[j] = k1[j] = c0[j] = c1[j] = 0.f; }
            if (MODE != 3 && MODE != 4) {
            if (type == 0) {
                const int tau0 = ch * 64 + wave * 8; const int t0 = dir ? (SEQ - 1 - tau0) : tau0;
                float rev0 = (float)t0 * invf0 * 0.15915494309189535f, rev1 = (float)t0 * invf1 * 0.15915494309189535f;
                rev0 -= rintf(rev0); rev1 -= rintf(rev1);
                float sn0 = __builtin_amdgcn_sinf(rev0), cs0 = __builtin_amdgcn_cosf(rev0), sn1 = __builtin_amdgcn_sinf(rev1), cs1 = __builtin_amdgcn_cosf(rev1);
#pragma unroll
                for (int j = 0; j < 8; ++j) {
                    const int pos_ = wave * 8 + j;
                    const unsigned ra_ = *(const LAS unsigned*)(lds + MX_RQ + pos_ * 256 + own * 2), rb_ = *(const LAS unsigned*)(lds + MX_RK + pos_ * 256 + own * 2);
                    const unsigned rc_ = *(const LAS unsigned*)(lds + MX_RQ + pos_ * 256 + par * 2), rd_ = *(const LAS unsigned*)(lds + MX_RK + pos_ * 256 + par * 2);
                    const float a_lo = bf2f(ra_ & 0xffffu), a_hi = bf2f(ra_ >> 16), b_lo = bf2f(rb_ & 0xffffu), b_hi = bf2f(rb_ >> 16);
                    const float pa_lo = bf2f(rc_ & 0xffffu), pa_hi = bf2f(rc_ >> 16), pb_lo = bf2f(rd_ & 0xffffu), pb_hi = bf2f(rd_ >> 16);
                    const float ss0 = sgn * sn0, ss1 = sgn * sn1;
                    q0[j] = a_lo * cs0 + pa_lo * ss0; q1[j] = a_hi * cs1 + pa_hi * ss1;
                    k0[j] = (b_lo * cs0 + pb_lo * ss0) * 0.08838834764831845f; k1[j] = (b_hi * cs1 + pb_hi * ss1) * 0.08838834764831845f;
                    const float nc0 = cs0 * cd0 - sn0 * sd0, ns0 = sn0 * cd0 + cs0 * sd0, nc1 = cs1 * cd1 - sn1 * sd1, ns1 = sn1 * cd1 + cs1 * sd1;
                    cs0 = nc0; sn0 = ns0; cs1 = nc1; sn1 = ns1;
                    c0[j] = 0.f; c1[j] = 0.f;
                }
            } else {
#pragma unroll
                for (int j = 0; j < 8; ++j) {
                    const int pos_ = wave * 8 + j;
                    const unsigned ra_ = *(const LAS unsigned*)(lds + MX_RQ + pos_ * 256 + own * 2), rb_ = *(const LAS unsigned*)(lds + MX_RK + pos_ * 256 + own * 2);
                    const float a_lo = bf2f(ra_ & 0xffffu), a_hi = bf2f(ra_ >> 16), b_lo = bf2f(rb_ & 0xffffu), b_hi = bf2f(rb_ >> 16);
                    q0[j] = a_lo; q1[j] = a_hi;
                    float f0 = lb0 + (1.0f - lb0) * __builtin_amdgcn_rcpf(1.0f + ex2(-b_lo * 1.4426950408889634f));
                    float f1 = lb1 + (1.0f - lb1) * __builtin_amdgcn_rcpf(1.0f + ex2(-b_hi * 1.4426950408889634f));
                    f0 = fmaxf(f0, 1e-6f); f1 = fmaxf(f1, 1e-6f);
                    k0[j] = 1.0f - f0; k1[j] = 1.0f - f1;
                    run0 += __builtin_amdgcn_logf(f0); run1 += __builtin_amdgcn_logf(f1); c0[j] = run0; c1[j] = run1;
                }
            }
            { unsigned rv[8];
#pragma unroll
              for (int j = 0; j < 8; ++j) rv[j] = *(const LAS unsigned short*)(lds + MX_RV + (wave * 8 + j) * 128 + lane * 2);
              vpk[0] = rv[0] | (rv[1] << 16); vpk[1] = rv[2] | (rv[3] << 16); vpk[2] = rv[4] | (rv[5] << 16); vpk[3] = rv[6] | (rv[7] << 16); }
            }
            { typedef float f32x2_ __attribute__((ext_vector_type(2))); *(LAS f32x2_*)(lds + MX_TOT + (wave * 128 + 2 * lane) * 4) = (f32x2_){run0, run1}; }
            LDS_BARRIER();
            if (ch + 1 < 32) MX_LOAD(ch + 1);
            float kt0[8], kt1[8];
            float tt0, tt1;
#pragma unroll
            for (int j = 0; j < 8; ++j) { kt0[j] = kt1[j] = 0.f; }
            tt0 = tt1 = 0.f;
            if (MODE != 3 && MODE != 4) {
            if (type == 0) {
                tt0 = tt1 = 64.f * lg2;
#pragma unroll
                for (int j = 0; j < 8; ++j) {
                    const int pos = wave * 8 + j;
                    const f32x4 e = *(const LAS f32x4*)(lds + MX_DEC + 512 + pos * 16);
                    *(LAS unsigned*)(lds + MX_QI + pos * 272 + lane * 4) = pack2(q0[j] * e[0], q1[j] * e[0]);
                    *(LAS unsigned*)(lds + MX_KI + pos * 272 + lane * 4) = pack2(k0[j] * e[1], k1[j] * e[1]);
                    kt0[j] = k0[j] * e[3]; kt1[j] = k1[j] * e[3];
                }
            } else {
                float off0 = 0.f, off1 = 0.f, m0 = 0.f, m1 = 0.f; tt0 = 0.f; tt1 = 0.f;
#pragma unroll
                for (int g = 0; g < 8; ++g) {
                    typedef float f32x2_ __attribute__((ext_vector_type(2)));
                    const f32x2_ tv = *(const LAS f32x2_*)(lds + MX_TOT + (g * 128 + 2 * lane) * 4);
                    if (g < wave) { off0 += tv[0]; off1 += tv[1]; }
                    if (g < 4) { m0 += tv[0]; m1 += tv[1]; }
                    tt0 += tv[0]; tt1 += tv[1];
                }
                const float etm0 = ex2(tt0 - m0), etm1 = ex2(tt1 - m1);
#pragma unroll
                for (int j = 0; j < 8; ++j) {
                    const float cu0 = c0[j] + off0, cu1 = c1[j] + off1;
                    const float e10 = ex2(clampe(cu0 - m0)), e11 = ex2(clampe(cu1 - m1));
                    const float e20 = __builtin_amdgcn_rcpf(e10), e21 = __builtin_amdgcn_rcpf(e11);
                    const int pos = wave * 8 + j;
                    *(LAS unsigned*)(lds + MX_QI + pos * 272 + lane * 4) = pack2(q0[j] * e10, q1[j] * e11);
                    *(LAS unsigned*)(lds + MX_KI + pos * 272 + lane * 4) = pack2(k0[j] * e20, k1[j] * e21);
                    kt0[j] = k0[j] * (e20 * etm0); kt1[j] = k1[j] * (e21 * etm1);
                }
            }
            }
            { u32x4 w0, w1;
              w0[0] = pack2(kt0[0], kt0[1]); w0[1] = pack2(kt0[2], kt0[3]); w0[2] = pack2(kt0[4], kt0[5]); w0[3] = pack2(kt0[6], kt0[7]);
              w1[0] = pack2(kt1[0], kt1[1]); w1[1] = pack2(kt1[2], kt1[3]); w1[2] = pack2(kt1[4], kt1[5]); w1[3] = pack2(kt1[6], kt1[7]);
              *(LAS u32x4*)(lds + MX_KTT + (2 * lane) * 144 + wave * 16) = w0;
              *(LAS u32x4*)(lds + MX_KTT + (2 * lane + 1) * 144 + wave * 16) = w1;
              *(LAS u32x4*)(lds + MX_VT + lane * 144 + wave * 16) = vpk; }
            if (MODE != 3 && MODE != 4) {
                f32x4 em;
                if (type == 0) { const float e_ = ex2(32.f * lg2); em = (f32x4){e_, e_, e_, e_}; }
                else {
                    f32x4 ms = (f32x4){0.f, 0.f, 0.f, 0.f};
#pragma unroll
                    for (int g = 0; g < 4; ++g) ms += *(const LAS f32x4*)(lds + MX_TOT + (g * 128 + 16 * wave + 4 * fq) * 4);
                    em = (f32x4){ex2(ms[0]), ex2(ms[1]), ex2(ms[2]), ex2(ms[3])};
                }
#pragma unroll
                for (int vt = 0; vt < 4; ++vt) { u32x2 o; o[0] = pack2(Sacc[vt][0] * em[0], Sacc[vt][1] * em[1]); o[1] = pack2(Sacc[vt][2] * em[2], Sacc[vt][3] * em[3]);
                    *(LAS u32x2*)(lds + MX_ST + (16 * vt + fr) * 272 + (16 * wave + 4 * fq) * 2) = o; }
            }
            if (wave == 0) { typedef float f32x2_ __attribute__((ext_vector_type(2))); *(LAS f32x2_*)(lds + MX_DEC + lane * 8) = (f32x2_){ex2(tt0), ex2(tt1)}; }
            LDS_BARRIER();
            if (MODE != 2 && MODE != 4) {
                const int it = wave >> 1, st0 = 2 * (wave & 1);
                bf16x8 ka[2][4], qb[4];
#pragma unroll
                for (int kq = 0; kq < 4; ++kq) {
                    qb[kq] = *(const LAS bf16x8*)(lds + MX_QI + (16 * it + fr) * 272 + (32 * kq + 8 * fq) * 2);
                    ka[0][kq] = *(const LAS bf16x8*)(lds + MX_KI + (16 * st0 + fr) * 272 + (32 * kq + 8 * fq) * 2);
                    ka[1][kq] = *(const LAS bf16x8*)(lds + MX_KI + (16 * st0 + 16 + fr) * 272 + (32 * kq + 8 * fq) * 2);
                }
                asm volatile("s_waitcnt lgkmcnt(0)" ::: "memory");
                f32x4 acc0 = (f32x4){0.f, 0.f, 0.f, 0.f}, acc1 = acc0;
#pragma unroll
                for (int kq = 0; kq < 4; ++kq) {
                    acc0 = __builtin_amdgcn_mfma_f32_16x16x32_bf16(ka[0][kq], qb[kq], acc0, 0, 0, 0);
                    acc1 = __builtin_amdgcn_mfma_f32_16x16x32_bf16(ka[1][kq], qb[kq], acc1, 0, 0, 0);
                }
                const int i = 16 * it + fr;
                { const int s0 = 16 * st0 + 4 * fq;
                  const float v0 = (s0 + 0 <= i) ? acc0[0] : 0.f, v1 = (s0 + 1 <= i) ? acc0[1] : 0.f, v2 = (s0 + 2 <= i) ? acc0[2] : 0.f, v3 = (s0 + 3 <= i) ? acc0[3] : 0.f;
                  u32x2 o; o[0] = pack2(v0, v1); o[1] = pack2(v2, v3);
                  *(LAS u32x2*)(lds + MX_P + i * 144 + s0 * 2) = o; }
                { const int s0 = 16 * st0 + 16 + 4 * fq;
                  const float v0 = (s0 + 0 <= i) ? acc1[0] : 0.f, v1 = (s0 + 1 <= i) ? acc1[1] : 0.f, v2 = (s0 + 2 <= i) ? acc1[2] : 0.f, v3 = (s0 + 3 <= i) ? acc1[3] : 0.f;
                  u32x2 o; o[0] = pack2(v0, v1); o[1] = pack2(v2, v3);
                  *(LAS u32x2*)(lds + MX_P + i * 144 + s0 * 2) = o; }
            }
            LDS_BARRIER();
            if (MODE != 2 && MODE != 4) {
                const int vt = wave >> 1, it0 = 2 * (wave & 1);
                bf16x8 va[2], sa[4], pb[2][2], qsb[2][4], kta[2], vb[4][2];
#pragma unroll
                for (int kq = 0; kq < 2; ++kq) {
                    va[kq] = *(const LAS bf16x8*)(lds + MX_VT + (16 * vt + fr) * 144 + (32 * kq + 8 * fq) * 2);
                    pb[0][kq] = *(const LAS bf16x8*)(lds + MX_P + (16 * it0 + fr) * 144 + (32 * kq + 8 * fq) * 2);
                    pb[1][kq] = *(const LAS bf16x8*)(lds + MX_P + (16 * it0 + 16 + fr) * 144 + (32 * kq + 8 * fq) * 2);
                    kta[kq] = *(const LAS bf16x8*)(lds + MX_KTT + (16 * wave + fr) * 144 + (32 * kq + 8 * fq) * 2);
                }
#pragma unroll
                for (int kq = 0; kq < 4; ++kq) {
                    sa[kq] = *(const LAS bf16x8*)(lds + MX_ST + (16 * vt + fr) * 272 + (32 * kq + 8 * fq) * 2);
                    qsb[0][kq] = *(const LAS bf16x8*)(lds + MX_QI + (16 * it0 + fr) * 272 + (32 * kq + 8 * fq) * 2);
                    qsb[1][kq] = *(const LAS bf16x8*)(lds + MX_QI + (16 * it0 + 16 + fr) * 272 + (32 * kq + 8 * fq) * 2);
                }
#pragma unroll
                for (int v4 = 0; v4 < 4; ++v4)
#pragma unroll
                    for (int kq = 0; kq < 2; ++kq) vb[v4][kq] = *(const LAS bf16x8*)(lds + MX_VT + (16 * v4 + fr) * 144 + (32 * kq + 8 * fq) * 2);
                const f32x4 dc = *(const LAS f32x4*)(lds + MX_DEC + (16 * wave + 4 * fq) * 4);
                asm volatile("s_waitcnt lgkmcnt(0)" ::: "memory");
                f32x4 acc0 = (f32x4){0.f, 0.f, 0.f, 0.f}, acc1 = acc0;
#pragma unroll
                for (int kq = 0; kq < 2; ++kq) {
                    acc0 = __builtin_amdgcn_mfma_f32_16x16x32_bf16(va[kq], pb[0][kq], acc0, 0, 0, 0);
                    acc1 = __builtin_amdgcn_mfma_f32_16x16x32_bf16(va[kq], pb[1][kq], acc1, 0, 0, 0);
                }
#pragma unroll
                for (int kq = 0; kq < 4; ++kq) {
                    acc0 = __builtin_amdgcn_mfma_f32_16x16x32_bf16(sa[kq], qsb[0][kq], acc0, 0, 0, 0);
                    acc1 = __builtin_amdgcn_mfma_f32_16x16x32_bf16(sa[kq], qsb[1][kq], acc1, 0, 0, 0);
                }
#pragma unroll
                for (int v4 = 0; v4 < 4; ++v4) {
                    f32x4 a = Sacc[v4]; a[0] *= dc[0]; a[1] *= dc[1]; a[2] *= dc[2]; a[3] *= dc[3];
                    a = __builtin_amdgcn_mfma_f32_16x16x32_bf16(kta[0], vb[v4][0], a, 0, 0, 0);
                    a = __builtin_amdgcn_mfma_f32_16x16x32_bf16(kta[1], vb[v4][1], a, 0, 0, 0);
                    Sacc[v4] = a;
                }
                asm volatile("s_waitcnt vmcnt(0)" ::: "memory");
                { const int tau = ch * 64 + 16 * it0 + fr; const int t = dir ? (SEQ - 1 - tau) : tau;
                  u32x2 o; o[0] = pack2(acc0[0], acc0[1]); o[1] = pack2(acc0[2], acc0[3]);
                  *(u32x2*)((bf16_t*)obuf + ((size_t)dir * T + (size_t)(b * SEQ + t)) * 1536 + ocol + 16 * vt + 4 * fq) = o; }
                { const int tau = ch * 64 + 16 * it0 + 16 + fr; const int t = dir ? (SEQ - 1 - tau) : tau;
                  u32x2 o; o[0] = pack2(acc1[0], acc1[1]); o[1] = pack2(acc1[2], acc1[3]);
                  *(u32x2*)((bf16_t*)obuf + ((size_t)dir * T + (size_t)(b * SEQ + t)) * 1536 + ocol + 16 * vt + 4 * fq) = o; }
            }
        }
        __syncthreads();
#undef MX_LOAD
    }
}

#ifdef MIXER_CHECK
__device__ __forceinline__ void phase_mixer_check(const Params& p, const float* __restrict__ oa, const float* __restrict__ ob, float* chk) {
    int tid_ = threadIdx.x; asm volatile("" : "+v"(tid_)); const int wave = __builtin_amdgcn_readfirstlane(tid_ >> 6), lane = tid_ & 63;
    for (int r = blockIdx.x * 8 + wave; r < 2 * T; r += gridDim.x * 8) {
        const int dir = r / T;
#pragma unroll
        for (int ty = 0; ty < 2; ++ty) {
            float sd = 0.f, sq = 0.f;
#pragma unroll
            for (int i = 0; i < 3; ++i) { const float4 a = *(const float4*)(oa + (size_t)r * 1536 + ty * 768 + i * 256 + lane * 4), bq = *(const float4*)(ob + (size_t)r * 1536 + ty * 768 + i * 256 + lane * 4);
                sd += (a.x - bq.x) * (a.x - bq.x) + (a.y - bq.y) * (a.y - bq.y) + (a.z - bq.z) * (a.z - bq.z) + (a.w - bq.w) * (a.w - bq.w);
                sq += a.x * a.x + a.y * a.y + a.z * a.z + a.w * a.w; }
            sd = wave_sum(sd); sq = wave_sum(sq);
            if (lane == 0) { atomicAdd(&chk[(ty * 2 + dir) * 2 + 0], sd); atomicAdd(&chk[(ty * 2 + dir) * 2 + 1], sq); }
        }
    }
}
#endif

__device__ __forceinline__ float4 ld_bf4(const bf16_t* p) { const u32x2 r = *(const u32x2*)p; return make_float4(bf2f(r[0] & 0xffffu), bf2f(r[0] >> 16), bf2f(r[1] & 0xffffu), bf2f(r[1] >> 16)); }
__device__ __forceinline__ float grp16_sum(float v) {
#pragma unroll
    for (int o = 8; o > 0; o >>= 1) v += __shfl_xor(v, o, 64);
    return v;
}
__device__ __forceinline__ void phase_finalize(const Params& p, int l) {
    int tid_ = threadIdx.x; asm volatile("" : "+v"(tid_)); const int wave = __builtin_amdgcn_readfirstlane(tid_ >> 6), lane = tid_ & 63;
    const bf16_t* proj = (const bf16_t*)(p.ws + WS_PROJ);
    const bf16_t* obuf = (const bf16_t*)(p.ws + WS_OBUF);
    bf16_t* mixed = (bf16_t*)(p.ws + WS_MIXED);
    const float* cw = p.conv_w + (size_t)l * 3 * CW;
    const float* beta = p.mix_beta + (size_t)l * D;
    for (int n = blockIdx.x * 8 + wave; n < T; n += gridDim.x * 8) {
        const int t = n % SEQ;
        const bf16_t* row = proj + (size_t)n * INC;
#pragma unroll
        for (int i = 0; i < 4; ++i) {
            const int c = COL8(i);
            float4 r[2];
            if (i == 0) {
                float4 cc[2], ch[2], cb[2], um[2], up[2];
                ld_bf8(row + C_CC + c, cc[0], cc[1]); ld_bf8(row + C_CH + c, ch[0], ch[1]); ld_bf8(row + C_CB + c, cb[0], cb[1]);
                um[0] = um[1] = up[0] = up[1] = make_float4(0.f, 0.f, 0.f, 0.f);
                if (t > 0) { float4 a[2], b2[2]; ld_bf8(row - INC + C_CC + c, a[0], a[1]); ld_bf8(row - INC + C_CH + c, b2[0], b2[1]);
#pragma unroll
                    for (int q = 0; q < 2; ++q) um[q] = make_float4(a[q].x * b2[q].x, a[q].y * b2[q].y, a[q].z * b2[q].z, a[q].w * b2[q].w); }
                if (t < SEQ - 1) { float4 a[2], b2[2]; ld_bf8(row + INC + C_CC + c, a[0], a[1]); ld_bf8(row + INC + C_CH + c, b2[0], b2[1]);
#pragma unroll
                    for (int q = 0; q < 2; ++q) up[q] = make_float4(a[q].x * b2[q].x, a[q].y * b2[q].y, a[q].z * b2[q].z, a[q].w * b2[q].w); }
#pragma unroll
                for (int q = 0; q < 2; ++q) {
                    const float4 w0 = *(const float4*)(cw + c + 4 * q), w1 = *(const float4*)(cw + CW + c + 4 * q), w2 = *(const float4*)(cw + 2 * CW + c + 4 * q);
                    r[q].x = cb[q].x * (um[q].x * w0.x + cc[q].x * ch[q].x * w1.x + up[q].x * w2.x);
                    r[q].y = cb[q].y * (um[q].y * w0.y + cc[q].y * ch[q].y * w1.y + up[q].y * w2.y);
                    r[q].z = cb[q].z * (um[q].z * w0.z + cc[q].z * ch[q].z * w1.z + up[q].z * w2.z);
                    r[q].w = cb[q].w * (um[q].w * w0.w + cc[q].w * ch[q].w * w1.w + up[q].w * w2.w);
                }
            } else {
                const int oc = c - 512;
                const bool isret = oc < 768;
                float4 of[2], ob[2], gt[2];
                ld_bf8(obuf + (size_t)n * 1536 + oc, of[0], of[1]); ld_bf8(obuf + ((size_t)T + n) * 1536 + oc, ob[0], ob[1]);
                ld_bf8(row + (isret ? C_RG + oc : C_HG + (oc - 768)), gt[0], gt[1]);
                float4 o[2];
#pragma unroll
                for (int q = 0; q < 2; ++q) o[q] = make_float4(of[q].x + ob[q].x, of[q].y + ob[q].y, of[q].z + ob[q].z, of[q].w + ob[q].w);
                const float sm = grp16_sum(((o[0].x + o[0].y) + (o[0].z + o[0].w)) + ((o[1].x + o[1].y) + (o[1].z + o[1].w)));
                const float mu = isret ? sm * (1.0f / 128.0f) : 0.f;
#pragma unroll
                for (int q = 0; q < 2; ++q) { o[q].x -= mu; o[q].y -= mu; o[q].z -= mu; o[q].w -= mu; }
                const float var = grp16_sum(((o[0].x * o[0].x + o[0].y * o[0].y) + (o[0].z * o[0].z + o[0].w * o[0].w)) + ((o[1].x * o[1].x + o[1].y * o[1].y) + (o[1].z * o[1].z + o[1].w * o[1].w))) * (1.0f / 128.0f);
                const float rs = rsqrtf(var + 1e-6f);
#pragma unroll
                for (int q = 0; q < 2; ++q) r[q] = make_float4(o[q].x * rs * siluf_(gt[q].x), o[q].y * rs * siluf_(gt[q].y), o[q].z * rs * siluf_(gt[q].z), o[q].w * rs * siluf_(gt[q].w));
            }
            const float4 bt0 = *(const float4*)(beta + c), bt1 = *(const float4*)(beta + c + 4);
            r[0] = make_float4(r[0].x * bt0.x, r[0].y * bt0.y, r[0].z * bt0.z, r[0].w * bt0.w);
            r[1] = make_float4(r[1].x * bt1.x, r[1].y * bt1.y, r[1].z * bt1.z, r[1].w * bt1.w);
            if (OUT8(l)) { const float4 a4 = make_float4(r[0].x * 4.f, r[0].y * 4.f, r[0].z * 4.f, r[0].w * 4.f), b4 = make_float4(r[1].x * 4.f, r[1].y * 4.f, r[1].z * 4.f, r[1].w * 4.f);
                           st_fp8x8((unsigned char*)mixed + (size_t)n * D + c, a4, b4); }
            else st_bf8(mixed + (size_t)n * D + c, r[0], r[1]);
        }
    }
}

#define RGRP 4
#if RGRP == 4
#define LN1_SB() __builtin_amdgcn_sched_barrier(0)
#else
#define LN1_SB()
#endif
__device__ __forceinline__ void phase_ln1_router(const Params& p, int l, LAS unsigned char* lds) {
    int tid = threadIdx.x; asm volatile("" : "+v"(tid)); const int wave = __builtin_amdgcn_readfirstlane(tid >> 6), lane = tid & 63;
    LAS float* wrt = (LAS float*)lds;
    {
        const unsigned char* wg = p.ws + WS_WRT;
#pragma unroll
        for (int j = 0; j < 16; ++j) {
            const int ch = wave * 16 + j;
            __builtin_amdgcn_global_load_lds((const unsigned*)(wg + (size_t)ch * 1024 + lane * 16), (LAS unsigned*)(lds + ch * 1024), 16, 0, 0);
        }
    }
    LAS int* lcnt = (LAS int*)(lds + LDS_MISC + 256);
    if (tid < 16) lcnt[tid] = 0;
    asm volatile("s_waitcnt vmcnt(0)" ::: "memory");
    __syncthreads();
    const float* mod = (const float*)(p.ws + WS_MOD);
    const float* y = (const float*)(p.ws + WS_Y);
    float* xres = (float*)(p.ws + WS_XRES);
    int* route = (int*)(p.ws + WS_ROUTE);
    for (int n0 = (blockIdx.x * 8 + wave) * RGRP; n0 < T; n0 += gridDim.x * 8 * RGRP) {
        float4 h[RGRP][8];
        {
            const int b = n0 / SEQ;
            const float* mb = mod + ((size_t)l * 4 + b) * (6 * D);
#pragma unroll
            for (int i = 0; i < 4; ++i) {
                float4 xv[RGRP][2], yv[RGRP][2];
#pragma unroll
                for (int r = 0; r < RGRP; ++r) { ld_bf8((const bf16_t*)xres + (size_t)(n0 + r) * D + COL8(i), xv[r][0], xv[r][1]); ld_bf8((const bf16_t*)y + (size_t)(n0 + r) * D + COL8(i), yv[r][0], yv[r][1]); }
#pragma unroll
                for (int q = 0; q < 2; ++q) {
                    const float4 g = *(const float4*)(mb + 2 * D + COLK(2 * i + q));
#pragma unroll
                    for (int r = 0; r < RGRP; ++r)
                        h[r][2 * i + q] = make_float4(ALPHA * xv[r][q].x + (1.f + g.x) * yv[r][q].x, ALPHA * xv[r][q].y + (1.f + g.y) * yv[r][q].y, ALPHA * xv[r][q].z + (1.f + g.z) * yv[r][q].z, ALPHA * xv[r][q].w + (1.f + g.w) * yv[r][q].w);
                }
                LN1_SB();
            }
            float mean[RGRP], rstd[RGRP];
#pragma unroll
            for (int r = 0; r < RGRP; ++r) {
                float s0 = 0.f;
#pragma unroll
                for (int i = 0; i < 8; ++i) s0 += (h[r][i].x + h[r][i].y) + (h[r][i].z + h[r][i].w);
                mean[r] = s0;
            }
#pragma unroll
            for (int o = 32; o > 0; o >>= 1)
#pragma unroll
                for (int r = 0; r < RGRP; ++r) mean[r] += __shfl_xor(mean[r], o, 64);
#pragma unroll
            for (int r = 0; r < RGRP; ++r) {
                mean[r] *= (1.0f / D);
                float q0 = 0.f;
#pragma unroll
                for (int i = 0; i < 8; ++i) { const float a = h[r][i].x - mean[r], bb = h[r][i].y - mean[r], c = h[r][i].z - mean[r], d = h[r][i].w - mean[r]; q0 += (a * a + bb * bb) + (c * c + d * d); }
                rstd[r] = q0;
            }
#pragma unroll
            for (int o = 32; o > 0; o >>= 1)
#pragma unroll
                for (int r = 0; r < RGRP; ++r) rstd[r] += __shfl_xor(rstd[r], o, 64);
#pragma unroll
            for (int r = 0; r < RGRP; ++r) rstd[r] = rsqrtf(rstd[r] * (1.0f / D) + 1e-5f);
            const float* lg_ = p.ln_g + (size_t)(l * 2 + 0) * D; const float* lb_ = p.ln_b + (size_t)(l * 2 + 0) * D;
            LN1_SB();
#pragma unroll
            for (int i = 0; i < 8; ++i) {
                const float4 gv = *(const float4*)(lg_ + COLK(i)), bv = *(const float4*)(lb_ + COLK(i));
#pragma unroll
                for (int r = 0; r < RGRP; ++r) {
                    float4& v = h[r][i];
                    v.x = (v.x - mean[r]) * rstd[r] * gv.x + bv.x; v.y = (v.y - mean[r]) * rstd[r] * gv.y + bv.y;
                    v.z = (v.z - mean[r]) * rstd[r] * gv.z + bv.z; v.w = (v.w - mean[r]) * rstd[r] * gv.w + bv.w;
                }
                if (i & 1) LN1_SB();
            }
#pragma unroll
            for (int r = 0; r < RGRP; ++r)
#pragma unroll
                for (int i = 0; i < 4; ++i) st_bf8((bf16_t*)xres + (size_t)(n0 + r) * D + COL8(i), h[r][2 * i], h[r][2 * i + 1]);
            LN1_SB();
#pragma unroll
            for (int i = 0; i < 8; ++i) {
                const float4 sh = *(const float4*)(mb + 3 * D + COLK(i)), sc = *(const float4*)(mb + 4 * D + COLK(i));
#pragma unroll
                for (int r = 0; r < RGRP; ++r) {
                    float4& v = h[r][i];
                    v.x = v.x * (1.f + sc.x) + sh.x; v.y = v.y * (1.f + sc.y) + sh.y; v.z = v.z * (1.f + sc.z) + sh.z; v.w = v.w * (1.f + sc.w) + sh.w;
                }
                if (i & 1) LN1_SB();
            }
#pragma unroll
            for (int r = 0; r < RGRP; ++r) {
#if MOE_FP8
                unsigned char* hb = p.ws + WS_HB + (size_t)(n0 + r) * D;
#pragma unroll
                for (int i = 0; i < 4; ++i) st_fp8x8(hb + COL8(i), h[r][2 * i], h[r][2 * i + 1]);
#else
                bf16_t* hb = (bf16_t*)(p.ws + WS_HB) + (size_t)(n0 + r) * D;
#pragma unroll
                for (int i = 0; i < 4; ++i) st_bf8(hb + COL8(i), h[r][2 * i], h[r][2 * i + 1]);
#endif
            }
        }
        float lgk0 = 0.f, lgk1 = 0.f, lgk2 = 0.f, lgk3 = 0.f;
        const bool b5 = (lane & 32) != 0, b4 = (lane & 16) != 0, b3 = (lane & 8) != 0, b2 = (lane & 4) != 0;
#pragma unroll 1
        for (int eg = 0; eg < 4; ++eg) {
            float s[RGRP][4];
#pragma unroll
            for (int q = 0; q < 4; ++q) {
                f32x2_t ac[RGRP];
#pragma unroll
                for (int r = 0; r < RGRP; ++r) ac[r] = (f32x2_t){0.f, 0.f};
#pragma unroll
                for (int i = 0; i < 8; ++i) {
                    const f32x4 w = *(const LAS f32x4*)(wrt + (eg * 4 + q) * D + i * 256 + lane * 4);
                    const f32x2_t w01 = __builtin_shufflevector(w, w, 0, 1), w23 = __builtin_shufflevector(w, w, 2, 3);
#pragma unroll
                    for (int r = 0; r < RGRP; ++r) {
                        ac[r] = __builtin_elementwise_fma((f32x2_t){h[r][i].x, h[r][i].y}, w01, ac[r]);
                        ac[r] = __builtin_elementwise_fma((f32x2_t){h[r][i].z, h[r][i].w}, w23, ac[r]);
                    }
                }
#pragma unroll
                for (int r = 0; r < RGRP; ++r) s[r][q] = ac[r][0] + ac[r][1];
                LN1_SB();
            }
            float u[RGRP];
#pragma unroll
            for (int r = 0; r < RGRP; ++r) {
                const float tA = (b5 ? s[r][2] : s[r][0]) + __shfl_xor(b5 ? s[r][0] : s[r][2], 32, 64);
                const float tB = (b5 ? s[r][3] : s[r][1]) + __shfl_xor(b5 ? s[r][1] : s[r][3], 32, 64);
                u[r] = (b4 ? tB : tA) + __shfl_xor(b4 ? tA : tB, 16, 64);
            }
#if RGRP == 4
            const float pA = (b3 ? u[2] : u[0]) + __shfl_xor(b3 ? u[0] : u[2], 8, 64);
            const float pB = (b3 ? u[3] : u[1]) + __shfl_xor(b3 ? u[1] : u[3], 8, 64);
            float z = (b2 ? pB : pA) + __shfl_xor(b2 ? pA : pB, 4, 64);
#else
            float z = (b3 ? u[1] : u[0]) + __shfl_xor(b3 ? u[0] : u[1], 8, 64);
            z += __shfl_xor(z, 4, 64);
#endif
            z += __shfl_xor(z, 2, 64); z += __shfl_xor(z, 1, 64);
            lgk0 = (eg == 0) ? z : lgk0; lgk1 = (eg == 1) ? z : lgk1; lgk2 = (eg == 2) ? z : lgk2; lgk3 = (eg == 3) ? z : lgk3;
        }
#pragma unroll 1
        for (int r = 0; r < RGRP; ++r) {
            const int n = n0 + r;
            const int rl = (RGRP == 4) ? (r >> 1) * 8 + (r & 1) * 4 : r * 8;
            float lg[16];
#pragma unroll
            for (int q = 0; q < 4; ++q) {
                const int src = ((q >> 1) * 32) + ((q & 1) * 16) + rl;
                lg[0 + q] = __int_as_float(__builtin_amdgcn_readlane(__float_as_int(lgk0), src));
                lg[4 + q] = __int_as_float(__builtin_amdgcn_readlane(__float_as_int(lgk1), src));
                lg[8 + q] = __int_as_float(__builtin_amdgcn_readlane(__float_as_int(lgk2), src));
                lg[12 + q] = __int_as_float(__builtin_amdgcn_readlane(__float_as_int(lgk3), src));
            }
            float mx = lg[0];
#pragma unroll
            for (int e = 1; e < 16; ++e) mx = fmaxf(mx, lg[e]);
            float sc[16], sum = 0.f;
#pragma unroll
            for (int e = 0; e < 16; ++e) { sc[e] = expf(lg[e] - mx); sum += sc[e]; }
            const float inv = 1.0f / sum;
            float sel[16];
#pragma unroll
            for (int e = 0; e < 16; ++e) { sc[e] *= inv; sel[e] = sc[e] + p.router_bias[e]; }
            float best_gs = -3.0e38f; int bi0 = 0, bi1 = 1; float bw0 = 0.f, bw1 = 0.f;
#pragma unroll
            for (int g = 0; g < 4; ++g) {
                int i0 = 0; float m0 = sel[4 * g];
#pragma unroll
                for (int j = 1; j < 4; ++j) if (sel[4 * g + j] > m0) { m0 = sel[4 * g + j]; i0 = j; }
                int i1 = -1; float m1 = -3.0e38f;
#pragma unroll
                for (int j = 0; j < 4; ++j) if (j != i0 && sel[4 * g + j] > m1) { m1 = sel[4 * g + j]; i1 = j; }
                float w0 = 0.f, w1 = 0.f;
#pragma unroll
                for (int j = 0; j < 4; ++j) { w0 = (j == i0) ? sc[4 * g + j] : w0; w1 = (j == i1) ? sc[4 * g + j] : w1; }
                const float gs = m0 + m1;
                if (gs > best_gs) { best_gs = gs; bi0 = 4 * g + i0; bi1 = 4 * g + i1; bw0 = w0; bw1 = w1; }
            }
            if (lane == 0) {
                const float ws_ = 1.0f / (bw0 + bw1);
                const int p0 = __hip_atomic_fetch_add(&lcnt[bi0], 1, __ATOMIC_RELAXED, __HIP_MEMORY_SCOPE_WORKGROUP), p1 = __hip_atomic_fetch_add(&lcnt[bi1], 1, __ATOMIC_RELAXED, __HIP_MEMORY_SCOPE_WORKGROUP);
                int* rr = route + (size_t)n * 8;
                rr[0] = bi0; rr[1] = bi1; rr[2] = (int)p0; rr[3] = (int)p1; rr[4] = __float_as_int(bw0 * ws_); rr[5] = __float_as_int(bw1 * ws_);
            }
        }
    }
    __syncthreads();
    if (tid < 16) ((int*)(p.ws + WS_WGCNT))[((size_t)l * 1024 + blockIdx.x) * 16 + tid] = lcnt[tid];
}

__device__ __forceinline__ void build_moe_tab(const Params& p, int l, LAS int* tab) {
    if (threadIdx.x == 0) {
        const unsigned* cnt = (const unsigned*)(p.ws + WS_CNT) + l * 16;
        int acc = 0;
        for (int e = 0; e < 16; ++e) { tab[e] = acc; acc += (int)((cnt[e] + 255u) >> 8); }
        tab[16] = acc;
    }
    __syncthreads();
}

__device__ __forceinline__ void phase_permute(const Params& p, int l, LAS int* tab) {
    int tid_ = threadIdx.x; asm volatile("" : "+v"(tid_)); const int wave = __builtin_amdgcn_readfirstlane(tid_ >> 6), lane = tid_ & 63;
    LAS int* base = tab + 32; LAS int* total = tab + 48;
    if (tid_ < 16) { base[tid_] = 0; total[tid_] = 0; }
    __syncthreads();
    {
        const int* wgc = (const int*)(p.ws + WS_WGCNT) + (size_t)l * 1024 * 16;
        const int e = tid_ & 15; int bs = 0, tt = 0;
        for (int w = tid_ >> 4; w < (int)gridDim.x; w += 32) { const int v = wgc[w * 16 + e]; tt += v; bs += (w < (int)blockIdx.x) ? v : 0; }
        __hip_atomic_fetch_add(&base[e], bs, __ATOMIC_RELAXED, __HIP_MEMORY_SCOPE_WORKGROUP);
        __hip_atomic_fetch_add(&total[e], tt, __ATOMIC_RELAXED, __HIP_MEMORY_SCOPE_WORKGROUP);
    }
    __syncthreads();
    if (tid_ == 0) { int acc = 0; for (int e = 0; e < 16; ++e) { tab[e] = acc; acc += (total[e] + 255) >> 8; } tab[16] = acc; }
    if (blockIdx.x == 0 && tid_ < 16) ((unsigned*)(p.ws + WS_CNT))[l * 16 + tid_] = (unsigned)total[tid_];
    __syncthreads();
#if MOE_FP8
    for (int i = blockIdx.x * 512 + tid_; i < XE_ROWS * 8; i += gridDim.x * 512) *(u32x4*)(p.ws + WS_HID + (size_t)(i >> 3) * DEP + DE + (i & 7) * 16) = (u32x4){0u, 0u, 0u, 0u};
#endif
    int* route = (int*)(p.ws + WS_ROUTE);
    const bf16_t* hb = (const bf16_t*)(p.ws + WS_HB);
    bf16_t* xe = (bf16_t*)(p.ws + WS_XE);
    for (int m = (blockIdx.x * 8 + wave) * RGRP; m < T; m += gridDim.x * 8 * RGRP)
#pragma unroll 1
    for (int n = m; n < m + RGRP; ++n) {
        int* r = route + (size_t)n * 8;
        const int e0 = r[0], e1 = r[1], p0 = r[2], p1 = r[3];
        const int row0 = tab[e0] * 256 + base[e0] + p0, row1 = tab[e1] * 256 + base[e1] + p1;
        constexpr int RB = MOE_FP8 ? D : 2 * D;
        const u32x4* src = (const u32x4*)((const unsigned char*)hb + (size_t)n * RB);
        u32x4* d0 = (u32x4*)((unsigned char*)xe + (size_t)row0 * RB); u32x4* d1 = (u32x4*)((unsigned char*)xe + (size_t)row1 * RB);
#pragma unroll
        for (int i = 0; i < RB / 1024; ++i) { const u32x4 v = src[i * 64 + lane]; d0[i * 64 + lane] = v; d1[i * 64 + lane] = v; }
        if (lane == 0) { r[6] = row0; r[7] = row1; }
    }
}

#define LN2_RG 2
#define LN2_SB() __builtin_amdgcn_sched_barrier(0)
__device__ __forceinline__ void phase_ln2(const Params& p, int l) {
    int tid_ = threadIdx.x; asm volatile("" : "+v"(tid_)); const int wave = __builtin_amdgcn_readfirstlane(tid_ >> 6), lane = tid_ & 63;
    const float* mod = (const float*)(p.ws + WS_MOD);
    const float* ye = (const float*)(p.ws + WS_YE);
    float* xres = (float*)(p.ws + WS_XRES);
    const int* route = (const int*)(p.ws + WS_ROUTE);
    const int lane_ = lane;
    for (int n0 = (blockIdx.x * 8 + wave) * LN2_RG; n0 < T; n0 += gridDim.x * 8 * LN2_RG) {
        int lane = lane_; asm volatile("" : "+v"(lane));
        const int b = n0 / SEQ;
        const float* mb = mod + ((size_t)l * 4 + b) * (6 * D);
        float w0[LN2_RG], w1[LN2_RG]; const bf16_t* y0[LN2_RG]; const bf16_t* y1[LN2_RG];
#pragma unroll
        for (int r = 0; r < LN2_RG; ++r) {
            const int* rr = route + (size_t)(n0 + r) * 8;
            w0[r] = __int_as_float(__builtin_amdgcn_readfirstlane(rr[4])); w1[r] = __int_as_float(__builtin_amdgcn_readfirstlane(rr[5]));
            y0[r] = (const bf16_t*)ye + (size_t)__builtin_amdgcn_readfirstlane(rr[6]) * D; y1[r] = (const bf16_t*)ye + (size_t)__builtin_amdgcn_readfirstlane(rr[7]) * D;
        }
        float4 v[LN2_RG][8];
#pragma unroll
        for (int i = 0; i < 4; ++i) {
            float4 g[2];
#pragma unroll
            for (int q = 0; q < 2; ++q) g[q] = *(const float4*)(mb + 5 * D + COLK(2 * i + q));
#pragma unroll
            for (int rp = 0; rp < LN2_RG; rp += 2) {
                float4 xv[2][2], a[2][2], c[2][2];
#pragma unroll
                for (int r = 0; r < 2; ++r) { ld_bf8((const bf16_t*)xres + (size_t)(n0 + rp + r) * D + COL8(i), xv[r][0], xv[r][1]); ld_bf8(y0[rp + r] + COL8(i), a[r][0], a[r][1]); ld_bf8(y1[rp + r] + COL8(i), c[r][0], c[r][1]); }
#pragma unroll
                for (int q = 0; q < 2; ++q)
#pragma unroll
                    for (int r = 0; r < 2; ++r)
                        v[rp + r][2 * i + q] = make_float4(ALPHA * xv[r][q].x + (1.f + g[q].x) * (w0[rp + r] * a[r][q].x + w1[rp + r] * c[r][q].x), ALPHA * xv[r][q].y + (1.f + g[q].y) * (w0[rp + r] * a[r][q].y + w1[rp + r] * c[r][q].y),
                                                           ALPHA * xv[r][q].z + (1.f + g[q].z) * (w0[rp + r] * a[r][q].z + w1[rp + r] * c[r][q].z), ALPHA * xv[r][q].w + (1.f + g[q].w) * (w0[rp + r] * a[r][q].w + w1[rp + r] * c[r][q].w));
                LN2_SB();
            }
        }
        float mean[LN2_RG], rstd[LN2_RG];
#pragma unroll
        for (int r = 0; r < LN2_RG; ++r) {
            float s0 = 0.f;
#pragma unroll
            for (int i = 0; i < 8; ++i) s0 += (v[r][i].x + v[r][i].y) + (v[r][i].z + v[r][i].w);
            mean[r] = s0;
        }
#pragma unroll
        for (int o = 32; o > 0; o >>= 1)
#pragma unroll
            for (int r = 0; r < LN2_RG; ++r) mean[r] += __shfl_xor(mean[r], o, 64);
#pragma unroll
        for (int r = 0; r < LN2_RG; ++r) {
            mean[r] *= (1.0f / D);
            float q0 = 0.f;
#pragma unroll
            for (int i = 0; i < 8; ++i) { const float aa = v[r][i].x - mean[r], bb = v[r][i].y - mean[r], cc = v[r][i].z - mean[r], dd = v[r][i].w - mean[r]; q0 += (aa * aa + bb * bb) + (cc * cc + dd * dd); }
            rstd[r] = q0;
        }
#pragma unroll
        for (int o = 32; o > 0; o >>= 1)
#pragma unroll
            for (int r = 0; r < LN2_RG; ++r) rstd[r] += __shfl_xor(rstd[r], o, 64);
#pragma unroll
        for (int r = 0; r < LN2_RG; ++r) rstd[r] = rsqrtf(rstd[r] * (1.0f / D) + 1e-5f);
        const float* lg_ = p.ln_g + (size_t)(l * 2 + 1) * D; const float* lb_ = p.ln_b + (size_t)(l * 2 + 1) * D;
        LN2_SB();
#pragma unroll
        for (int i = 0; i < 8; ++i) {
            const float4 gv = *(const float4*)(lg_ + COLK(i)), bv = *(const float4*)(lb_ + COLK(i));
#pragma unroll
            for (int r = 0; r < LN2_RG; ++r) {
                float4& x = v[r][i];
                x.x = (x.x - mean[r]) * rstd[r] * gv.x + bv.x; x.y = (x.y - mean[r]) * rstd[r] * gv.y + bv.y;
                x.z = (x.z - mean[r]) * rstd[r] * gv.z + bv.z; x.w = (x.w - mean[r]) * rstd[r] * gv.w + bv.w;
            }
            if (i & 1) LN2_SB();
        }
        if (l + 1 < DEPTH) {
#pragma unroll
            for (int r = 0; r < LN2_RG; ++r)
#pragma unroll
                for (int i = 0; i < 4; ++i) st_bf8((bf16_t*)xres + (size_t)(n0 + r) * D + COL8(i), v[r][2 * i], v[r][2 * i + 1]);
            const float* mn = mod + ((size_t)(l + 1) * 4 + b) * (6 * D);
            LN2_SB();
#pragma unroll
            for (int i = 0; i < 4; ++i) {
                float4 sh[2], sc[2];
#pragma unroll
                for (int q = 0; q < 2; ++q) { sh[q] = *(const float4*)(mn + COLK(2 * i + q)); sc[q] = *(const float4*)(mn + D + COLK(2 * i + q)); }
#pragma unroll
                for (int r = 0; r < LN2_RG; ++r) {
                    float4 h[2];
#pragma unroll
                    for (int q = 0; q < 2; ++q) { const float4 x = v[r][2 * i + q]; h[q] = make_float4(x.x * (1.f + sc[q].x) + sh[q].x, x.y * (1.f + sc[q].y) + sh[q].y, x.z * (1.f + sc[q].z) + sh[q].z, x.w * (1.f + sc[q].w) + sh[q].w); }
                    if (INP8(l + 1)) st_fp8x8(p.ws + WS_HA + (size_t)(n0 + r) * D + COL8(i), h[0], h[1]);
                    else st_bf8((bf16_t*)(p.ws + WS_HA) + (size_t)(n0 + r) * D + COL8(i), h[0], h[1]);
                }
                LN2_SB();
            }
        } else {
#pragma unroll
            for (int r = 0; r < LN2_RG; ++r)
#pragma unroll
                for (int i = 0; i < 8; ++i) *(float4*)(p.out + (size_t)(n0 + r) * D + COLK(i)) = v[r][i];
        }
    }
}

typedef const __attribute__((address_space(4))) unsigned char* KargPtr;
__device__ __forceinline__ Params load_params(KargPtr q) { asm volatile("" : "+s"(q)); Params lp; __builtin_memcpy(&lp, (const __attribute__((address_space(4))) unsigned long long*)q, sizeof(Params)); return lp; }

__global__ __launch_bounds__(512, 2) void mega(Params p_in) {
    extern __shared__ __attribute__((aligned(16))) unsigned char smem[];
    LAS unsigned char* lds = (LAS unsigned char*)smem;
    LAS int* tab = (LAS int*)(lds + LDS_MISC + 64);
    KargPtr kp = (KargPtr)__builtin_amdgcn_kernarg_segment_ptr();
    if (threadIdx.x == 0) { *(LAS u32x4*)(lds + LDS_MISC) = (u32x4){0u, 0u, 0u, 0u}; *(LAS u32x4*)(lds + LDS_MISC + 768) = (u32x4){0u, 0u, 0u, 0u}; *(LAS u32x4*)(lds + LDS_MISC + 784) = (u32x4){0u, 0u, 0u, 0u}; }
    __syncthreads();
    const int fused = p_in.fused, ph_lo = p_in.ph_lo, ph_hi = p_in.ph_hi, l_hi = p_in.l_hi;
    XcdBarrier bar;
    if (fused) bar = xcd_barrier_post((unsigned*)(p_in.ws + WS_BAR), (volatile LAS unsigned*)(lds + LDS_MISC));
    else { bar.bar = (unsigned*)(p_in.ws + WS_BAR); bar.x = 0; bar.st = (volatile LAS unsigned*)(lds + LDS_MISC); }
#ifdef ONLY_PH
#define PH(i) ((i) == ONLY_PH && ph_lo <= (i) && (i) < ph_hi)
#else
#define PH(i) (ph_lo <= (i) && (i) < ph_hi)
#endif
#ifdef PROBE_PH
#define SYNC_PLAIN() do { if (fused) xcd_barrier(bar); } while (0)
#define PSTART(i) do { if ((i) == PROBE_PH && blockIdx.x == 0 && threadIdx.x == 0) { *(LAS unsigned long long*)(lds + LDS_MISC + 768) = __builtin_amdgcn_s_memrealtime(); } } while (0)
#define PSTOP(i) do { if ((i) == PROBE_PH && blockIdx.x == 0 && threadIdx.x == 0) { *(LAS unsigned long long*)(lds + LDS_MISC + 776) += __builtin_amdgcn_s_memrealtime() - *(LAS unsigned long long*)(lds + LDS_MISC + 768); } } while (0)
#else
#define PSTART(i) do { } while (0)
#define PSTOP(i) do { } while (0)
#endif
#if defined(PROBE_PH) && defined(PROBE_SUB)
#define QSTART(i, k) do { if ((i) == PROBE_PH && (k) == PROBE_SUB && blockIdx.x == PROBE_WG && threadIdx.x == 0) { *(LAS unsigned long long*)(lds + LDS_MISC + 784) = __builtin_amdgcn_s_memrealtime(); } } while (0)
#define QSTOP(i, k) do { if ((i) == PROBE_PH && (k) == PROBE_SUB && blockIdx.x == PROBE_WG && threadIdx.x == 0) { *(LAS unsigned long long*)(lds + LDS_MISC + 792) += __builtin_amdgcn_s_memrealtime() - *(LAS unsigned long long*)(lds + LDS_MISC + 784); } } while (0)
#else
#define QSTART(i, k) do { } while (0)
#define QSTOP(i, k) do { } while (0)
#endif
#define SYNC() do { if (fused) xcd_barrier(bar); } while (0)
#ifndef DUP_MASK
#define DUP_MASK 0
#endif
#define REP(i) _Pragma("unroll 1") for (int rep_ = 0; rep_ < 1 + ((DUP_MASK >> (i)) & 1); ++rep_)
    const int G = gridDim.x, c = blockIdx.x;
    if (PH(0)) REP(0) { PSTART(0); const Params p = load_params(kp); phase_prologue(p, lds); SYNC(); PSTOP(0); }
    if (PH(1)) REP(1) { PSTART(1); const Params p = load_params(kp); phase_ln0(p); SYNC(); PSTOP(1); }
    for (int l = p_in.l_lo; l < l_hi; ++l) {
        const bool svc = (l == 0) && (G >= 256);
        if (PH(2)) REP(2) { PSTART(2);
            const Params p = load_params(kp);
            pg8::Gemm g{(const bf16_t*)(p.ws + WS_HA), (const bf16_t*)(p.ws + WS_WIN) + (size_t)l * INC * D, D};
            pg8::EpiBf16 E{(bf16_t*)(p.ws + WS_PROJ), INC};
            if (svc) {
                if (c < 240) {
                    pg8::DenseOrder<32, 30> S; S.init(INP8(0) ? D : 2 * D, 240, c);
                    if (INP8(0)) pg8::gemm_phase<pg8::EpiBf16, pg8::DenseOrder<32, 30>, true>(lds, g, S, E, 121, 127);
                    else pg8::gemm_phase(lds, g, S, E);
                } else ada_chunks(p, lds, 128 + (c - 240), 256, 16);
                tail_pull(p, lds, l * 4 + 0);
            } else {
                pg8::DenseOrder<32, 32> S; S.init(INP8(l) ? D : 2 * D, G, c);
                if (INP8(l)) pg8::gemm_phase<pg8::EpiBf16, pg8::DenseOrder<32, 32>, true>(lds, g, S, E, 121, 127);
                else pg8::gemm_phase(lds, g, S, E);
            }
            SYNC(); PSTOP(2);
        }
#ifdef MIXER_CHECK
        if (PH(3)) REP(3) { PSTART(3); const Params p = load_params(kp); phase_mixer_valu(p, l, lds); SYNC(); PSTOP(3); }
        if (PH(3)) REP(3) { PSTART(3); const Params p = load_params(kp); phase_mixer_mfma<0>(p, l, lds, (float*)(p.ws + WS_XE)); SYNC(); PSTOP(3); }
        if (PH(3)) REP(3) { PSTART(3); const Params p = load_params(kp); phase_mixer_check(p, (const float*)(p.ws + WS_OBUF), (const float*)(p.ws + WS_XE), (float*)(p.ws + WS_CNT + 1024) + l * 8); SYNC(); PSTOP(3); }
#else
        if (PH(3)) REP(3) { PSTART(3);
            const Params p = load_params(kp);
            const int n_extra = svc ? 96 : 32, pn0 = svc ? 30 : 32;
            for (int uu = (G >= 224 ? c - 192 : c); uu >= 0 && uu < n_extra; uu += (G >= 224 ? 64 : G)) {
                const int RBI = INP8(l) ? D : 2 * D;
                pg8::OneUnit S; S.u0.aB = (size_t)(uu & 31) * 256 * RBI; S.u0.bB = (size_t)(pn0 + (uu >> 5)) * 256 * RBI; S.u0.row0 = (uu & 31) * 256; S.u0.col0 = (pn0 + (uu >> 5)) * 256;
                pg8::EpiBf16 E{(bf16_t*)(p.ws + WS_PROJ), INC};
                pg8::Gemm g{(const bf16_t*)(p.ws + WS_HA), (const bf16_t*)(p.ws + WS_WIN) + (size_t)l * INC * D, D};
                if (INP8(l)) pg8::gemm_phase<pg8::EpiBf16, pg8::OneUnit, true>(lds, g, S, E, 121, 127);
                else pg8::gemm_phase(lds, g, S, E);
            }
            phase_mixer_mfma<0>(p, l, lds, (float*)(p.ws + WS_OBUF));
            tail_pull(p, lds, l * 4 + 1);
            SYNC(); PSTOP(3);
#ifdef MIXER_PROBE
            phase_mixer_mfma<MIXER_PROBE>(p, l, lds, (float*)(p.ws + WS_XE));
            SYNC(); PSTOP(3);
#endif
        }
#endif
        if (PH(4)) REP(4) { PSTART(4); const Params p = load_params(kp); phase_finalize(p, l); SYNC(); PSTOP(4); }
        if (PH(5)) REP(5) { PSTART(5);
            const Params p = load_params(kp);
            pg8::DenseOrder<32, 8> S; S.init(OUT8(l) ? D : 2 * D, G, c);
            pg8::Gemm g{(const bf16_t*)(p.ws + WS_MIXED), (const bf16_t*)(p.ws + WS_WOUT) + (size_t)l * D * D, D};
            pg8::EpiBf16 E{(bf16_t*)(p.ws + WS_Y), D};
            if (OUT8(l)) pg8::gemm_phase<pg8::EpiBf16, pg8::DenseOrder<32, 8>, true>(lds, g, S, E, 121, 125);
            else pg8::gemm_phase(lds, g, S, E);
            SYNC(); PSTOP(5);
        }
        if (PH(6)) REP(6) { PSTART(6); const Params p = load_params(kp); phase_ln1_router(p, l, lds); SYNC(); PSTOP(6); }
        if (PH(7)) REP(7) { PSTART(7); const Params p = load_params(kp); phase_permute(p, l, tab); cvt_pull(p, lds, l * CV_PER_L + CV_A1, nullptr, 0u); SYNC(); PSTOP(7); }
        if (PH(8)) REP(8) { PSTART(8);
            const Params p = load_params(kp);
            build_moe_tab(p, l, tab);
#if MOE_FP8
            pg8::MoeOrder S; S.tab = tab; S.NTn = 11; S.G = G; S.c = c; S.tstep = (size_t)256 * D; S.bexp = (size_t)2 * DE * D;
            pg8::Gemm g{(const bf16_t*)(p.ws + WS_XE), (const bf16_t*)(p.ws + WS_WGU + (size_t)l * NE * 2 * DE * D), D};
            pg8::EpiHidden8 E{p.ws + WS_HID};
            QSTART(8, 1); pg8::gemm_phase<pg8::EpiHidden8, pg8::MoeOrder, true>(lds, g, S, E, 121, 127); QSTOP(8, 1);
#else
            pg8::MoeOrder S; S.tab = tab; S.NTn = 11; S.G = G; S.c = c; S.tstep = (size_t)256 * D * 2; S.bexp = (size_t)2 * DE * D * 2;
            pg8::Gemm g{(const bf16_t*)(p.ws + WS_XE), (const bf16_t*)(p.ws + WS_WGU) + (size_t)l * NE * 2 * DE * D, D};
            pg8::EpiHidden E{(bf16_t*)(p.ws + WS_HID)};
            pg8::gemm_phase(lds, g, S, E);
#endif
            QSTART(8, 2); tail_pull(p, lds, l * 4 + 2); QSTOP(8, 2);
            QSTART(8, 3); cvt_pull(p, lds, (l + 1) * CV_PER_L, nullptr, 0u); QSTOP(8, 3);
            SYNC(); PSTOP(8);
        }
        if (PH(9)) REP(9) { PSTART(9);
            const Params p = load_params(kp);
            build_moe_tab(p, l, tab);
#if MOE_FP8
            pg8::MoeOrder S; S.tab = tab; S.NTn = 8; S.G = G; S.c = c; S.tstep = (size_t)256 * DEP; S.bexp = (size_t)D * DEP;
            pg8::Gemm g{(const bf16_t*)(p.ws + WS_HID), (const bf16_t*)(p.ws + WS_WD + (size_t)l * NE * D * DEP), DEP};
            pg8::EpiBf16 E{(bf16_t*)(p.ws + WS_YE), D};
            QSTART(9, 1); pg8::gemm_phase<pg8::EpiBf16, pg8::MoeOrder, true>(lds, g, S, E, 121, 124); QSTOP(9, 1);
#else
            pg8::MoeOrder S; S.tab = tab; S.NTn = 8; S.G = G; S.c = c; S.tstep = (size_t)256 * DE * 2; S.bexp = (size_t)D * DE * 2;
            pg8::Gemm g{(const bf16_t*)(p.ws + WS_HID), (const bf16_t*)(p.ws + WS_WD) + (size_t)l * NE * D * DE, DE};
            pg8::EpiBf16 E{(bf16_t*)(p.ws + WS_YE), D};
            pg8::gemm_phase(lds, g, S, E);
#endif
            QSTART(9, 2); tail_pull(p, lds, l * 4 + 3); QSTOP(9, 2);
            QSTART(9, 3); if (l + 1 < DEPTH) cvt_pull(p, lds, (l + 1) * CV_PER_L + CV_A0, nullptr, 0u); QSTOP(9, 3);
            SYNC(); PSTOP(9);
        }
        if (PH(10)) REP(10) { PSTART(10); const Params p = load_params(kp); phase_ln2(p, l); SYNC(); PSTOP(10); }
    }
#ifdef PROBE_PH
    if (blockIdx.x == 0 && threadIdx.x == 0) {
#ifdef PROBE_SUB
        const unsigned long long t = 0ull, t0 = __builtin_amdgcn_s_memrealtime();
#else
        const unsigned long long t = *(LAS unsigned long long*)(lds + LDS_MISC + 776) * 4ull, t0 = __builtin_amdgcn_s_memrealtime();
#endif
        while (__builtin_amdgcn_s_memrealtime() - t0 < t) __builtin_amdgcn_s_sleep(8);
    }
#ifdef PROBE_SUB
    if (blockIdx.x == PROBE_WG && threadIdx.x == 0) {
        const unsigned long long t = *(LAS unsigned long long*)(lds + LDS_MISC + 792) * 4ull, t0 = __builtin_amdgcn_s_memrealtime();
        while (__builtin_amdgcn_s_memrealtime() - t0 < t) __builtin_amdgcn_s_sleep(8);
    }
#endif
#endif
}

#ifndef MK_FUSED
#define MK_FUSED 1
#endif
extern "C" void kernel_launch(void* const* d_in, const int* in_sizes, int n_in, void* d_out, int out_size, void* d_ws, size_t ws_size, hipStream_t stream) {
    static int grid = 0;
    if (grid == 0) {
        if (n_in != 18 || ws_size < WS_END) { fprintf(stderr, "kernel_launch: unexpected n_in %d or ws_size %zu (< %zu)\n", n_in, ws_size, (size_t)WS_END); grid = -1; return; }
        int dev = 0, cus = 0, per_cu = 0;
        hipGetDevice(&dev);
        hipDeviceGetAttribute(&cus, hipDeviceAttributeMultiprocessorCount, dev);
        if (hipFuncSetAttribute((const void*)mega, hipFuncAttributeMaxDynamicSharedMemorySize, LDS_BYTES) != hipSuccess) { fprintf(stderr, "kernel_launch: hipFuncSetAttribute failed\n"); grid = -1; return; }
        hipOccupancyMaxActiveBlocksPerMultiprocessor(&per_cu, (const void*)mega, 512, LDS_BYTES);
        if (per_cu < 1) fprintf(stderr, "kernel_launch: occupancy query says %d\n", per_cu);
        grid = cus > 0 ? cus : 256;
    }
    if (grid < 0) return;
    hipMemsetAsync(d_ws, 0, WS_ZERO_BYTES, stream);
    Params p{};
    p.x = (const float*)d_in[0]; p.c = (const float*)d_in[1]; p.emb_g = (const float*)d_in[2]; p.emb_b = (const float*)d_in[3];
    p.w_ada = (const float*)d_in[4]; p.b_ada = (const float*)d_in[5]; p.w_in = (const float*)d_in[6]; p.conv_w = (const float*)d_in[7];
    p.mix_beta = (const float*)d_in[8]; p.w_out = (const float*)d_in[9]; p.lb_logits = (const float*)d_in[10]; p.ln_g = (const float*)d_in[11];
    p.ln_b = (const float*)d_in[12]; p.w_router = (const float*)d_in[13]; p.router_bias = (const float*)d_in[14]; p.w_gate = (const float*)d_in[15];
    p.w_up = (const float*)d_in[16]; p.w_down = (const float*)d_in[17];
    p.out = (float*)d_out; p.ws = (unsigned char*)d_ws; p.pad = 0;
#if MK_FUSED
    p.ph_lo = 0; p.ph_hi = 11; p.l_lo = 0; p.l_hi = DEPTH; p.fused = 1;
    hipLaunchKernelGGL(mega, dim3(grid), dim3(512), LDS_BYTES, stream, p);
#else
    p.fused = 0;
    for (int ph = 0; ph < 2; ++ph) { p.ph_lo = ph; p.ph_hi = ph + 1; p.l_lo = 0; p.l_hi = 0; hipLaunchKernelGGL(mega, dim3(grid), dim3(512), LDS_BYTES, stream, p); }
    for (int l = 0; l < DEPTH; ++l)
        for (int ph = 2; ph < 11; ++ph) { p.ph_lo = ph; p.ph_hi = ph + 1; p.l_lo = l; p.l_hi = l + 1; hipLaunchKernelGGL(mega, dim3(grid), dim3(512), LDS_BYTES, stream, p); }
#endif
}
```

```cpp
#include <hip/hip_runtime.h>
#include <stdint.h>
#include <stdio.h>

#define LAS __attribute__((address_space(3)))
typedef unsigned short bf16_t;
typedef short bf16x8 __attribute__((ext_vector_type(8)));
typedef float f32x4 __attribute__((ext_vector_type(4)));
typedef unsigned u32x4 __attribute__((ext_vector_type(4)));
typedef unsigned u32x2 __attribute__((ext_vector_type(2)));

constexpr int D = 2048, NB = 4, SEQ = 2048, T = NB * SEQ, DEPTH = 2;
constexpr int CW = 512, RW = 768, HWD = 768, INC = 8448;
constexpr int NE = 16, DE = 1408;
constexpr int C_CB = 0, C_CC = 512, C_CH = 1024, C_RQ = 1536, C_RK = 2304, C_RV = 3072, C_RG = 3840, C_HQ = 4608, C_HFF = 5376, C_HFB = 6144, C_HI = 6912, C_HG = 7680;
constexpr int XE_ROWS = 20480;
#ifndef MOE_FP8
#define MOE_FP8 1
#endif
#ifndef INP_FP8_FROM
#define INP_FP8_FROM 1
#endif
#define INP8(l) ((l) >= INP_FP8_FROM)
#ifndef OUT_FP8_FROM
#define OUT_FP8_FROM 1
#endif
#define OUT8(l) ((l) >= OUT_FP8_FROM)
constexpr int DEP = 1536;
constexpr float W8_SCALE = 64.f, H8_SCALE = 8.f;
constexpr float ALPHA = 1.4142135623730951f;

constexpr size_t WS_BAR = 0;
constexpr size_t WS_CNT = 16384;
constexpr size_t WS_CVTQ = 20480;
constexpr size_t WS_ZERO_BYTES = 32768;
constexpr size_t WS_MOD = 32768;
constexpr size_t WS_ROUTE = WS_MOD + 393216;
constexpr size_t WS_WGCNT = WS_ROUTE + 262144;
constexpr size_t WS_WRT = WS_WGCNT + 131072;
constexpr size_t WS_WIN = 1048576;
constexpr size_t SZ_WIN = (size_t)DEPTH * INC * D * 2;
constexpr size_t WS_WOUT = WS_WIN + SZ_WIN;
constexpr size_t SZ_WOUT = (size_t)DEPTH * D * D * 2;
constexpr size_t WS_WGU = WS_WOUT + SZ_WOUT;
constexpr size_t SZ_WGU = (size_t)DEPTH * NE * 2 * DE * D * 2;
constexpr size_t WS_WD = WS_WGU + SZ_WGU;
constexpr size_t SZ_WD = (size_t)DEPTH * NE * D * DE * 2;
constexpr size_t WS_XRES = WS_WD + SZ_WD;
constexpr size_t SZ_XRES = (size_t)T * D * 4;
constexpr size_t WS_HA = WS_XRES + SZ_XRES;
constexpr size_t SZ_H = (size_t)T * D * 2;
constexpr size_t WS_HB = WS_HA + SZ_H;
constexpr size_t WS_PROJ = WS_HB + SZ_H;
constexpr size_t SZ_PROJ = (size_t)T * INC * 2;
constexpr size_t WS_OBUF = WS_PROJ + SZ_PROJ;
constexpr size_t SZ_OBUF = (size_t)2 * T * 1536 * 4;
constexpr size_t WS_YE = WS_PROJ;
constexpr size_t SZ_YE = (size_t)XE_ROWS * D * 4;
static_assert(SZ_YE <= SZ_PROJ + SZ_OBUF, "ye alias");
constexpr size_t WS_MIXED = WS_OBUF + SZ_OBUF;
constexpr size_t WS_Y = WS_MIXED + SZ_H;
constexpr size_t SZ_Y = (size_t)T * D * 4;
constexpr size_t WS_XE = WS_Y + SZ_Y;
constexpr size_t SZ_XE = (size_t)XE_ROWS * D * 2;
constexpr size_t WS_HID = WS_XE + SZ_XE;
constexpr size_t SZ_HID = (size_t)XE_ROWS * DE * 2;
constexpr size_t WS_END = WS_HID + SZ_HID;

constexpr int LDS_BYTES = 156672;
constexpr int LDS_MISC = 153600;

struct Params {
    const float *x, *c, *emb_g, *emb_b, *w_ada, *b_ada, *w_in, *conv_w, *mix_beta, *w_out, *lb_logits, *ln_g, *ln_b, *w_router, *router_bias, *w_gate, *w_up, *w_down;
    float* out;
    unsigned char* ws;
    int ph_lo, ph_hi, l_lo, l_hi, fused, pad;
};

__device__ __forceinline__ float bf2f(unsigned b) { return __uint_as_float(b << 16); }
__device__ __forceinline__ unsigned f2bf(float f) { unsigned u = __float_as_uint(f); u += 0x7FFFu + ((u >> 16) & 1u); return u >> 16; }
typedef __bf16 bf16x2_t __attribute__((ext_vector_type(2)));
typedef float f32x2_t __attribute__((ext_vector_type(2)));
__device__ __forceinline__ unsigned pack2a(float lo, float hi) { unsigned r; asm("v_cvt_pk_bf16_f32 %0, %1, %2" : "=v"(r) : "v"(lo), "v"(hi)); return r; }
__device__ __forceinline__ unsigned pack2(float lo, float hi) { const bf16x2_t r = __builtin_convertvector((f32x2_t){lo, hi}, bf16x2_t); return __builtin_bit_cast(unsigned, r); }
__device__ __forceinline__ float wave_sum(float v) {
#pragma unroll
    for (int o = 32; o > 0; o >>= 1) v += __shfl_xor(v, o, 64);
    return v;
}
__device__ __forceinline__ float half_sum(float v) {
#pragma unroll
    for (int o = 16; o > 0; o >>= 1) v += __shfl_xor(v, o, 64);
    return v;
}
#define LDS_BARRIER() do { asm volatile("s_waitcnt lgkmcnt(0)" ::: "memory"); __builtin_amdgcn_s_barrier(); asm volatile("" ::: "memory"); } while (0)
__device__ __forceinline__ float sigmoidf_(float z) { return 1.0f / (1.0f + __expf(-z)); }
__device__ __forceinline__ float siluf_(float z) { return z / (1.0f + __expf(-z)); }

#define XB_TMO      128
#define XB_XCNT(j)  (256  + 64 * (j))
#define XB_XSUB(j)  (1280 + 64 * (j))
#define XB_XGEN(j)  (2304 + 64 * (j))
#define XB_TOP      3328
#define XB_TOPGEN   3392
#define XCD_BAR_WORDS 3456
#define XB_SPIN_CAP (1u << 22)
__device__ __forceinline__ unsigned xb_ld(unsigned* p)              { return __hip_atomic_load(p, __ATOMIC_RELAXED, __HIP_MEMORY_SCOPE_AGENT); }
__device__ __forceinline__ unsigned xb_add(unsigned* p, unsigned v) { return __hip_atomic_fetch_add(p, v, __ATOMIC_RELAXED, __HIP_MEMORY_SCOPE_AGENT); }
__device__ __forceinline__ unsigned xb_xcc_id() { return (unsigned)__builtin_amdgcn_s_getreg((3 << 11) | 20) & 0xFu; }
#define XB_SPIN(cond, bar) do { unsigned _sp = 0; while (cond) { __builtin_amdgcn_s_sleep(1); \
    if ((++_sp & 255u) == 0u) { if (xb_ld(&(bar)[XB_TMO])) break; if (_sp > XB_SPIN_CAP) { atomicAdd(&(bar)[XB_TMO], 1u); break; } } } } while (0)
struct XcdBarrier { unsigned* bar; unsigned x; volatile LAS unsigned* st; };
__device__ __forceinline__ XcdBarrier xcd_barrier_post(unsigned* bar, volatile LAS unsigned* st) {
    XcdBarrier b; b.bar = bar; b.x = xb_xcc_id(); b.st = st;
    if (threadIdx.x == 0) (void)xb_add(&bar[XB_XCNT(b.x)], 1u);
    return b;
}
__device__ __forceinline__ void xcd_barrier_complete(unsigned* bar, unsigned x, unsigned& nloc, unsigned& nx) {
    const unsigned G = gridDim.x * gridDim.y * gridDim.z;
    unsigned sum, cnt, mine, sp = 0u;
    for (;;) {
        sum = 0u; cnt = 0u; mine = 0u;
#pragma unroll
        for (unsigned j = 0; j < 16; ++j) { const unsigned c = xb_ld(&bar[XB_XCNT(j)]); sum += c; cnt += (c > 0u) ? 1u : 0u; mine = (j == x) ? c : mine; }
        if (sum == G) break;
        __builtin_amdgcn_s_sleep(1);
        if ((++sp & 255u) == 0u) { if (xb_ld(&bar[XB_TMO])) break; if (sp > XB_SPIN_CAP) { atomicAdd(&bar[XB_TMO], 1u); break; } }
    }
    nloc = mine > 0u ? mine : 1u; nx = cnt > 0u ? cnt : 1u;
}
__device__ __forceinline__ void xcd_barrier(const XcdBarrier& b) {
    asm volatile("s_waitcnt vmcnt(0)" ::: "memory");
    __syncthreads();
    if (threadIdx.x == 0) {
        unsigned* bar = b.bar;
        __builtin_amdgcn_s_waitcnt(0);
        unsigned nloc = b.st[0], nx = b.st[1];
        if (nloc == 0u) { xcd_barrier_complete(bar, b.x, nloc, nx); b.st[0] = nloc; b.st[1] = nx; }
        const unsigned old = xb_add(&bar[XB_XSUB(b.x)], 1u);
        const unsigned gen = old / nloc;
        if (old + 1u == (gen + 1u) * nloc) {
            __builtin_amdgcn_fence(__ATOMIC_RELEASE, "agent");
            asm volatile("s_waitcnt vmcnt(0)" ::: "memory");
            const unsigned og = xb_add(&bar[XB_TOP], 1u);
            const unsigned tg = og / nx;
            if (og + 1u == (tg + 1u) * nx) xb_add(&bar[XB_TOPGEN], 1u);
            else XB_SPIN(xb_ld(&bar[XB_TOPGEN]) == tg, bar);
            __builtin_amdgcn_fence(__ATOMIC_ACQUIRE, "agent");
            xb_add(&bar[XB_XGEN(b.x)], 1u);
            asm volatile("s_waitcnt vmcnt(0)" ::: "memory");
        } else {
            XB_SPIN(xb_ld(&bar[XB_XGEN(b.x)]) == gen, bar);
            __builtin_amdgcn_fence(__ATOMIC_ACQUIRE, "agent");
            asm volatile("s_waitcnt vmcnt(0)" ::: "memory");
        }
    }
    __syncthreads();
}

namespace pg8 {
constexpr int BM = 256, BK = 64, HALF = 128, HTB = HALF * BK * 2, STAGE_BYTES = 8 * HTB, NXCD = 8, WGM = 8;
__host__ __device__ __forceinline__ int lds_byte(int r, int c) { const int st = (r >> 4) * 2 + (c >> 5), rr = r & 15, cc = c & 31, ob = rr * 64 + cc * 2; return st * 1024 + (ob ^ (((ob >> 9) & 1) << 5)); }
__host__ __device__ __forceinline__ void stage_rc(int b, int& R, int& C) { const int st = b / 1024, sb = b % 1024, swz = sb ^ (((sb >> 9) & 1) << 5); R = (st >> 1) * 16 + swz / 64; C = (st & 1) * 32 + (swz % 64) / 2; }
__host__ __device__ __forceinline__ int perm32(int rho) { const int n = rho >> 4, i = rho & 15; return 8 * (i >> 2) + 4 * n + (i & 3); }

struct Unit { size_t aB, bB; int row0, col0; };
struct Gemm { const bf16_t* A; const bf16_t* Bt; int K; };

template <int NM, int NN>
struct DenseOrder {
    int G, c; size_t tstep;
    __device__ void init(int rowbytes, int G_, int c_) { G = G_; c = c_; tstep = (size_t)BM * rowbytes; }
    __device__ bool next(int i, Unit& u) const {
        constexpr int nwg = NM * NN, q = nwg / NXCD, r = nwg % NXCD, nig = WGM * NN;
        static_assert(NM % WGM == 0, "row tiles come in groups of 8");
        const int L = __builtin_amdgcn_readfirstlane(i * G + c); if (L >= nwg) return false;
        const int xcd = L % NXCD, off = L / NXCD;
        const int wgid = (xcd < r ? xcd * (q + 1) : r * (q + 1) + (xcd - r) * q) + off;
        const int gid = wgid / nig, fm = gid * WGM, rem = wgid % nig;
        const int pm = fm + (rem % WGM), pn = rem / WGM;
        u.aB = (size_t)pm * tstep; u.bB = (size_t)pn * tstep; u.row0 = pm * BM; u.col0 = pn * BM; return true;
    }
};
struct OneUnit {
    Unit u0;
    __device__ bool next(int i, Unit& u) const { if (i > 0) return false; u = u0; return true; }
};
struct MoeOrder {
    const LAS int* tab; int NTn, G, c; size_t tstep, bexp;
    __device__ bool next(int i, Unit& u) const {
        const int MT = tab[16], U = MT * NTn, nx = G >> 3;
        int f;
        if ((G & 7) == 0) { const int per = (U + 7) >> 3, x = c & 7, j = c >> 3, loc = i * nx + j; f = x * per + loc; if (loc >= per || f >= U) return false; }
        else { f = i * G + c; if (f >= U) return false; }
        int e = 0;
#pragma unroll
        for (int j = 1; j < 16; ++j) e += (f >= tab[j] * NTn) ? 1 : 0;
        const int t0 = tab[e], te = tab[e + 1] - t0, r = f - t0 * NTn;
        const int nt = r / te, mt = t0 + (r - nt * te);
        u.aB = (size_t)mt * tstep; u.bB = (size_t)e * bexp + (size_t)nt * tstep; u.row0 = mt * BM; u.col0 = nt * BM; return true;
    }
};

__device__ __forceinline__ size_t rfl64(size_t v) { const unsigned lo = (unsigned)__builtin_amdgcn_readfirstlane((int)(unsigned)v), hi = (unsigned)__builtin_amdgcn_readfirstlane((int)(unsigned)(v >> 32)); return ((size_t)hi << 32) | lo; }
__device__ __forceinline__ void uniformize(Unit& u) { u.aB = rfl64(u.aB); u.bB = rfl64(u.bB); u.row0 = __builtin_amdgcn_readfirstlane(u.row0); u.col0 = __builtin_amdgcn_readfirstlane(u.col0); }
__device__ __forceinline__ unsigned cvt_pk_bf16(float lo, float hi) { unsigned r; asm volatile("v_cvt_pk_bf16_f32 %0, %1, %2" : "=v"(r) : "v"(lo), "v"(hi)); return r; }

struct EpiF32 {
    static constexpr bool PERM = false;
    float* C; int ldc;
    __device__ __forceinline__ void operator()(const f32x4 (&acc)[2][2][4][2], const Unit& u, int wr, int wc, int fr, int fq) const {
        const int row0 = u.row0 + wr * 64 + fr, col0 = u.col0 + wc * 32 + 4 * fq;
#pragma unroll
        for (int ai = 0; ai < 2; ++ai)
#pragma unroll
            for (int m = 0; m < 4; ++m) { float* rowp = C + (size_t)(row0 + ai * HALF + m * 16) * ldc + col0;
#pragma unroll
                for (int bj = 0; bj < 2; ++bj)
#pragma unroll
                    for (int n = 0; n < 2; ++n) *(f32x4*)(rowp + bj * HALF + n * 16) = acc[ai][bj][m][n]; }
    }
};
struct EpiBf16 {
    static constexpr bool PERM = true;
    bf16_t* O; int ldc;
    __device__ __forceinline__ void operator()(const f32x4 (&acc)[2][2][4][2], const Unit& u, int wr, int wc, int fr, int fq) const {
        const int row0 = u.row0 + wr * 64 + fr, col0 = u.col0 + wc * 32 + 8 * fq;
#pragma unroll
        for (int ai = 0; ai < 2; ++ai)
#pragma unroll
            for (int m = 0; m < 4; ++m) { bf16_t* rowp = O + (size_t)(row0 + ai * HALF + m * 16) * ldc + col0;
#pragma unroll
                for (int bj = 0; bj < 2; ++bj) { const f32x4 v0 = acc[ai][bj][m][0], v1 = acc[ai][bj][m][1];
                    u32x4 o; o[0] = cvt_pk_bf16(v0[0], v0[1]); o[1] = cvt_pk_bf16(v0[2], v0[3]); o[2] = cvt_pk_bf16(v1[0], v1[1]); o[3] = cvt_pk_bf16(v1[2], v1[3]);
                    *(u32x4*)(rowp + bj * HALF) = o; } }
    }
};
struct EpiHidden {
    static constexpr bool PERM = true;
    bf16_t* O;
    __device__ __forceinline__ void operator()(const f32x4 (&acc)[2][2][4][2], const Unit& u, int wr, int wc, int fr, int fq) const {
        const int row0 = u.row0 + wr * 64 + fr, col0 = (u.col0 >> 1) + wc * 32 + 8 * fq;
#pragma unroll
        for (int ai = 0; ai < 2; ++ai)
#pragma unroll
            for (int m = 0; m < 4; ++m) { bf16_t* rowp = O + (size_t)(row0 + ai * HALF + m * 16) * DE + col0;
                float h[8];
#pragma unroll
                for (int n = 0; n < 2; ++n)
#pragma unroll
                    for (int j = 0; j < 4; ++j) { const float g = acc[ai][0][m][n][j], up = acc[ai][1][m][n][j]; h[n * 4 + j] = g * __builtin_amdgcn_rcpf(1.0f + __expf(-g)) * up; }
                u32x4 o; o[0] = cvt_pk_bf16(h[0], h[1]); o[1] = cvt_pk_bf16(h[2], h[3]); o[2] = cvt_pk_bf16(h[4], h[5]); o[3] = cvt_pk_bf16(h[6], h[7]);
                *(u32x4*)rowp = o; }
    }
};

typedef int v8i32 __attribute__((ext_vector_type(8)));
typedef int v4i32 __attribute__((ext_vector_type(4)));
struct EpiHidden8 {
    static constexpr bool PERM = true;
    unsigned char* O;
    __device__ __forceinline__ void operator()(const f32x4 (&acc)[2][2][4][2], const Unit& u, int wr, int wc, int fr, int fq) const {
        const int row0 = u.row0 + wr * 64 + fr, col0 = (u.col0 >> 1) + wc * 32 + 8 * fq;
#pragma unroll
        for (int ai = 0; ai < 2; ++ai)
#pragma unroll
            for (int m = 0; m < 4; ++m) { unsigned char* rowp = O + (size_t)(row0 + ai * HALF + m * 16) * DEP + col0;
                float h[8];
#pragma unroll
                for (int n = 0; n < 2; ++n)
#pragma unroll
                    for (int j = 0; j < 4; ++j) { const float g = acc[ai][0][m][n][j], up = acc[ai][1][m][n][j]; h[n * 4 + j] = g * __builtin_amdgcn_rcpf(1.0f + __expf(-g)) * up * H8_SCALE; }
                int o0 = __builtin_amdgcn_cvt_pk_fp8_f32(h[0], h[1], 0, false); o0 = __builtin_amdgcn_cvt_pk_fp8_f32(h[2], h[3], o0, true);
                int o1 = __builtin_amdgcn_cvt_pk_fp8_f32(h[4], h[5], 0, false); o1 = __builtin_amdgcn_cvt_pk_fp8_f32(h[6], h[7], o1, true);
                u32x2 o; o[0] = (unsigned)o0; o[1] = (unsigned)o1;
                *(u32x2*)rowp = o; }
    }
};
template <class Epi, class Sched, bool FP8 = false>
__device__ __forceinline__ void gemm_phase(LAS unsigned char* lds, const Gemm g, const Sched& S, const Epi& E, int sclW = 127, int sclA = 127) {
    int tid = threadIdx.x; asm volatile("" : "+v"(tid)); const int wid = __builtin_amdgcn_readfirstlane(tid >> 6), lane = tid & 63, wr = wid >> 2, wc = wid & 3, fr = lane & 15, fq = lane >> 4;
    const int K = g.K, rowb = FP8 ? K : 2 * K, nt = rowb / 128;
    int sclWv = sclW, sclAv = sclA; asm volatile("" : "+v"(sclWv), "+v"(sclAv));
    unsigned voffA[2], voffB[2];
#pragma unroll
    for (int i = 0; i < 2; ++i) { int R, C; stage_rc(tid * 16 + i * 8192, R, C); const int Rb = Epi::PERM ? ((R & ~31) + perm32(R & 31)) : R;
        voffA[i] = (unsigned)(R * rowb + 2 * C); voffB[i] = (unsigned)(Rb * rowb + 2 * C); }
    const size_t kstep = 128;
    const size_t hstep = (size_t)HALF * rowb;
    const unsigned ldsw = (unsigned)wid * 1024u;
    const int aoff = lds_byte(wr * 64 + fr, fq * 8), boff = lds_byte(wc * 32 + fr, fq * 8);
    constexpr int P2 = 1024;
#define PG8_SA(b, h) (((b) * 2 + (h)) * HTB)
#define PG8_SB(b, h) ((4 + (b) * 2 + (h)) * HTB)
#define PG8_STAGE(bufoff, gbase, voff) do { _Pragma("unroll") for (int _i = 0; _i < 2; ++_i) \
        __builtin_amdgcn_global_load_lds((const unsigned*)((const char*)(gbase) + (voff)[_i]), (LAS unsigned*)(lds + (bufoff) + ldsw + _i * 8192), 16, 0, 0); } while (0)
#define PG8_LDA(dst, b, h) do { _Pragma("unroll") for (int m = 0; m < 4; ++m) { \
        const v4i32 _l = *(const LAS v4i32*)(lds + PG8_SA(b, h) + aoff + m * 2048), _h = *(const LAS v4i32*)(lds + PG8_SA(b, h) + aoff + P2 + m * 2048); \
        dst[m] = __builtin_shufflevector(_l, _h, 0, 1, 2, 3, 4, 5, 6, 7); } } while (0)
#define PG8_LDB(dst, b, h) do { _Pragma("unroll") for (int n = 0; n < 2; ++n) { \
        const v4i32 _l = *(const LAS v4i32*)(lds + PG8_SB(b, h) + boff + n * 2048), _h = *(const LAS v4i32*)(lds + PG8_SB(b, h) + boff + P2 + n * 2048); \
        dst[n] = __builtin_shufflevector(_l, _h, 0, 1, 2, 3, 4, 5, 6, 7); } } while (0)
#define PG8_MMA(ai, bj, At, Bt) do { __builtin_amdgcn_s_setprio(1); _Pragma("unroll") for (int m = 0; m < 4; ++m) _Pragma("unroll") for (int n = 0; n < 2; ++n) { \
        if constexpr (FP8) { \
            asm volatile("v_mfma_scale_f32_16x16x128_f8f6f4 %0, %1, %2, %0, %3, %4 op_sel_hi:[0,0,0]" : "+v"(acc[ai][bj][m][n]) : "v"(Bt[n]), "v"(At[m]), "v"(sclWv), "v"(sclAv)); \
        } else { \
            acc[ai][bj][m][n] = __builtin_amdgcn_mfma_f32_16x16x32_bf16(__builtin_bit_cast(bf16x8, __builtin_shufflevector(Bt[n], Bt[n], 0, 1, 2, 3)), __builtin_bit_cast(bf16x8, __builtin_shufflevector(At[m], At[m], 0, 1, 2, 3)), acc[ai][bj][m][n], 0, 0, 0); \
            acc[ai][bj][m][n] = __builtin_amdgcn_mfma_f32_16x16x32_bf16(__builtin_bit_cast(bf16x8, __builtin_shufflevector(Bt[n], Bt[n], 4, 5, 6, 7)), __builtin_bit_cast(bf16x8, __builtin_shufflevector(At[m], At[m], 4, 5, 6, 7)), acc[ai][bj][m][n], 0, 0, 0); } } \
        __builtin_amdgcn_s_setprio(0); } while (0)
#define PG8_WAIT_V(n) asm volatile("s_waitcnt vmcnt(" #n ")" ::: "memory")
#define PG8_WAIT_L(n) asm volatile("s_waitcnt lgkmcnt(" #n ")" ::: "memory")
#define PG8_BAR __builtin_amdgcn_s_barrier()
#define PG8_SCHED __builtin_amdgcn_sched_barrier(0)
    Unit cur, nxt; int ui = 0;
    if (!S.next(0, cur)) return;
    uniformize(cur);
    f32x4 acc[2][2][4][2];
#pragma unroll
    for (int a = 0; a < 2; ++a)
#pragma unroll
        for (int b = 0; b < 2; ++b)
#pragma unroll
            for (int m = 0; m < 4; ++m)
#pragma unroll
                for (int n = 0; n < 2; ++n) acc[a][b][m][n] = (f32x4){0.f, 0.f, 0.f, 0.f};
    v8i32 At[4], B0[2], B1[2];
    const char* cA = (const char*)g.A + cur.aB; const char* cB = (const char*)g.Bt + cur.bB;
    PG8_STAGE(PG8_SB(0, 0), cB, voffB); PG8_STAGE(PG8_SA(0, 0), cA, voffA); PG8_STAGE(PG8_SB(0, 1), cB + hstep, voffB); PG8_STAGE(PG8_SA(0, 1), cA + hstep, voffA);
    if (wr == 1) PG8_BAR;
    PG8_WAIT_V(4); PG8_BAR;
    PG8_STAGE(PG8_SB(1, 0), cB + kstep, voffB); PG8_STAGE(PG8_SA(1, 0), cA + kstep, voffA); PG8_STAGE(PG8_SB(1, 1), cB + hstep + kstep, voffB);
    PG8_WAIT_V(6); PG8_BAR;
    for (;;) {
        const bool has_next = S.next(ui + 1, nxt);
        uniformize(nxt);
        const char* nA = has_next ? (const char*)g.A + nxt.aB : cA; const char* nB = has_next ? (const char*)g.Bt + nxt.bB : cB;
        for (int t = 0; t < nt; t += 2) {
            const bool last = (t == nt - 2);
            const char* a1 = cA + (size_t)(t + 1) * kstep;
            const char* a2 = last ? nA : cA + (size_t)(t + 2) * kstep; const char* b2 = last ? nB : cB + (size_t)(t + 2) * kstep;
            const char* a3 = a2 + kstep; const char* b3 = b2 + kstep;
            PG8_LDB(B0, 0, 0); PG8_SCHED; PG8_LDA(At, 0, 0); PG8_STAGE(PG8_SA(1, 1), a1 + hstep, voffA);
            PG8_WAIT_L(8); PG8_BAR; PG8_WAIT_L(0); PG8_MMA(0, 0, At, B0); PG8_BAR; PG8_SCHED;
            PG8_LDB(B1, 0, 1); PG8_STAGE(PG8_SB(0, 0), b2, voffB);
            PG8_BAR; PG8_WAIT_L(0); PG8_MMA(0, 1, At, B1); PG8_BAR;
            PG8_LDA(At, 0, 1); PG8_STAGE(PG8_SA(0, 0), a2, voffA);
            PG8_BAR; PG8_WAIT_L(0); PG8_MMA(1, 0, At, B0); PG8_BAR; PG8_SCHED;
            PG8_STAGE(PG8_SB(0, 1), b2 + hstep, voffB);
            PG8_WAIT_V(6); PG8_BAR; PG8_MMA(1, 1, At, B1); PG8_BAR;
            PG8_LDB(B0, 1, 0); PG8_SCHED; PG8_LDA(At, 1, 0); PG8_STAGE(PG8_SA(0, 1), a2 + hstep, voffA);
            PG8_WAIT_L(8); PG8_BAR; PG8_WAIT_L(0); PG8_MMA(0, 0, At, B0); PG8_BAR; PG8_SCHED;
            PG8_LDB(B1, 1, 1); PG8_STAGE(PG8_SB(1, 0), b3, voffB);
            PG8_BAR; PG8_WAIT_L(0); PG8_MMA(0, 1, At, B1); PG8_BAR;
            PG8_LDA(At, 1, 1); PG8_STAGE(PG8_SA(1, 0), a3, voffA);
            PG8_BAR; PG8_WAIT_L(0); PG8_MMA(1, 0, At, B0); PG8_BAR; PG8_SCHED;
            PG8_STAGE(PG8_SB(1, 1), b3 + hstep, voffB);
            PG8_WAIT_V(6); PG8_BAR; PG8_MMA(1, 1, At, B1); PG8_BAR;
        }
        if constexpr (FP8) asm volatile("s_nop 15\n\ts_nop 15" ::: "memory");
        E(acc, cur, wr, wc, fr, fq);
        if (!has_next) break;
#pragma unroll
        for (int a = 0; a < 2; ++a)
#pragma unroll
            for (int b = 0; b < 2; ++b)
#pragma unroll
                for (int m = 0; m < 4; ++m)
#pragma unroll
                    for (int n = 0; n < 2; ++n) acc[a][b][m][n] = (f32x4){0.f, 0.f, 0.f, 0.f};
        cur = nxt; cA = nA; cB = nB; ++ui;
    }
    PG8_WAIT_V(0);
    if (wr == 0) PG8_BAR;
    PG8_BAR;
#undef PG8_SA
#undef PG8_SB
#undef PG8_STAGE
#undef PG8_LDA
#undef PG8_LDB
#undef PG8_MMA
#undef PG8_WAIT_V
#undef PG8_WAIT_L
#undef PG8_BAR
#undef PG8_SCHED
}
}

constexpr int S_IN = 16 * 66, S_OUT = 16 * 16, S_GU = 16 * 11, S_DN = 11 * 16;
constexpr int CV_PER_L = S_IN + S_OUT + NE * 2 * S_GU + NE * S_DN;
constexpr int CV_A0 = S_IN + S_OUT;
constexpr int CV_A1 = CV_A0 + NE * 2 * S_GU;
constexpr int CV_TOTAL = DEPTH * CV_PER_L;
constexpr int CV_LAST = 1 << 30;
struct StripDesc { const float* src; bf16_t* dst; int lds_, ldd, k0, n0, drow0, fp8; };
__device__ __forceinline__ StripDesc strip_desc(const Params& p, int si) {
    unsigned char* ws = p.ws; StripDesc d;
    const int l = si / CV_PER_L; int r = si - l * CV_PER_L;
    if (r < S_IN) {
        const int kt = r / 66, ntl = r % 66;
        d.src = p.w_in + (size_t)l * D * INC; d.lds_ = INC; d.fp8 = INP8(l) ? 1 : 0; d.dst = (bf16_t*)(ws + WS_WIN) + (size_t)l * INC * D; d.ldd = D; d.k0 = kt * 128; d.n0 = ntl * 128; d.drow0 = ntl * 128;
    } else if (r < CV_A0) {
        r -= S_IN; const int kt = r / 16, ntl = r % 16;
        d.src = p.w_out + (size_t)l * D * D; d.lds_ = D; d.dst = (bf16_t*)(ws + WS_WOUT) + (size_t)l * D * D; d.ldd = D; d.k0 = kt * 128; d.n0 = ntl * 128; d.drow0 = ntl * 128; d.fp8 = OUT8(l) ? 1 : 0;
    } else if (r < CV_A1) {
        r -= CV_A0; const int mat = r / S_GU, q = r % S_GU, kt = q / 11, ntl = q % 11;
        const int which = mat & 1, le = l * NE + (mat >> 1);
        d.src = (which ? p.w_up : p.w_gate) + (size_t)le * D * DE; d.lds_ = DE; d.fp8 = MOE_FP8; d.dst = MOE_FP8 ? (bf16_t*)(ws + WS_WGU + (size_t)le * (2 * DE) * D) : (bf16_t*)(ws + WS_WGU) + (size_t)le * (2 * DE) * D; d.ldd = D; d.k0 = kt * 128; d.n0 = ntl * 128; d.drow0 = ntl * 256 + which * 128;
    } else {
        r -= CV_A1; const int le = l * NE + r / S_DN, q = r % S_DN, kt = q / 16, ntl = q % 16;
        d.src = p.w_down + (size_t)le * DE * D; d.lds_ = D; d.fp8 = MOE_FP8; d.dst = MOE_FP8 ? (bf16_t*)(ws + WS_WD + (size_t)le * D * DEP) : (bf16_t*)(ws + WS_WD) + (size_t)le * D * DE; d.ldd = MOE_FP8 ? DEP : DE; d.k0 = kt * 128; d.n0 = ntl * 128; d.drow0 = ntl * 128;
    }
    return d;
}
__device__ __forceinline__ void cvt_store_strip(const StripDesc& d, const float4 (&a)[2][2], const float4 (&b)[2][2], LAS unsigned char* tb, int tid, bool readout) {
    const int kp = tid >> 4, n4 = (tid & 15) * 4;
    if (!readout) {
        if (!d.fp8) {
#pragma unroll
            for (int ki = 0; ki < 2; ++ki)
#pragma unroll
                for (int ni = 0; ni < 2; ++ni) {
                    LAS unsigned* t = (LAS unsigned*)tb + (ki * 2 + ni) * 2112;
                    t[(n4 + 0) * 33 + kp] = pack2a(a[ki][ni].x, b[ki][ni].x);
                    t[(n4 + 1) * 33 + kp] = pack2a(a[ki][ni].y, b[ki][ni].y);
                    t[(n4 + 2) * 33 + kp] = pack2a(a[ki][ni].z, b[ki][ni].z);
                    t[(n4 + 3) * 33 + kp] = pack2a(a[ki][ni].w, b[ki][ni].w);
                }
        } else {
#pragma unroll
            for (int ki = 0; ki < 2; ++ki)
#pragma unroll
                for (int ni = 0; ni < 2; ++ni) {
                    LAS unsigned char* t = tb + (ki * 2 + ni) * 4352;
                    *(LAS unsigned short*)(t + (n4 + 0) * 68 + 2 * kp) = (unsigned short)__builtin_amdgcn_cvt_pk_fp8_f32(a[ki][ni].x * W8_SCALE, b[ki][ni].x * W8_SCALE, 0, false);
                    *(LAS unsigned short*)(t + (n4 + 1) * 68 + 2 * kp) = (unsigned short)__builtin_amdgcn_cvt_pk_fp8_f32(a[ki][ni].y * W8_SCALE, b[ki][ni].y * W8_SCALE, 0, false);
                    *(LAS unsigned short*)(t + (n4 + 2) * 68 + 2 * kp) = (unsigned short)__builtin_amdgcn_cvt_pk_fp8_f32(a[ki][ni].z * W8_SCALE, b[ki][ni].z * W8_SCALE, 0, false);
                    *(LAS unsigned short*)(t + (n4 + 3) * 68 + 2 * kp) = (unsigned short)__builtin_amdgcn_cvt_pk_fp8_f32(a[ki][ni].w * W8_SCALE, b[ki][ni].w * W8_SCALE, 0, false);
                }
        }
    } else {
        if (!d.fp8) {
            const int n = tid >> 3, kc = (tid & 7) * 4;
#pragma unroll
            for (int ki = 0; ki < 2; ++ki)
#pragma unroll
                for (int ni = 0; ni < 2; ++ni) {
                    const LAS unsigned* t = (const LAS unsigned*)tb + (ki * 2 + ni) * 2112;
                    u32x4 o; o[0] = t[n * 33 + kc]; o[1] = t[n * 33 + kc + 1]; o[2] = t[n * 33 + kc + 2]; o[3] = t[n * 33 + kc + 3];
                    *(u32x4*)(d.dst + (size_t)(d.drow0 + ni * 64 + n) * d.ldd + d.k0 + ki * 64 + kc * 2) = o;
                }
        } else {
            const int n = tid >> 3, kc8 = (tid & 7) * 8;
            unsigned char* dst8 = (unsigned char*)d.dst;
#pragma unroll
            for (int ki = 0; ki < 2; ++ki)
#pragma unroll
                for (int ni = 0; ni < 2; ++ni) {
                    const LAS unsigned char* t = tb + (ki * 2 + ni) * 4352;
                    u32x2 o; o[0] = *(const LAS unsigned*)(t + n * 68 + kc8); o[1] = *(const LAS unsigned*)(t + n * 68 + kc8 + 4);
                    *(u32x2*)(dst8 + (size_t)(d.drow0 + ni * 64 + n) * d.ldd + d.k0 + ki * 64 + kc8) = o;
                }
        }
    }
}
__device__ __forceinline__ void cvt_pull(const Params& p, LAS unsigned char* lds, int limit, unsigned* done_ctr, unsigned need_done) {
    int tid = threadIdx.x; asm volatile("" : "+v"(tid));
    LAS int* slot = (LAS int*)(lds + LDS_MISC + 512);
    unsigned* head = (unsigned*)(p.ws + WS_CVTQ);
    if (tid == 0) {
        int sv = -1;
        const bool stop = done_ctr ? (xb_ld(done_ctr) >= need_done) : (xb_ld(head) >= (unsigned)limit);
        if (!stop) { const unsigned c = xb_add(head, 2u); sv = c < (unsigned)CV_TOTAL ? (int)c : -1; }
        slot[0] = sv;
    }
    __syncthreads();
    const int kp = tid >> 4, n4 = (tid & 15) * 4;
    for (;;) {
        const int sraw = slot[0];
        if (sraw < 0) break;
        const int si = sraw & (CV_LAST - 1); const bool lastone = (sraw & CV_LAST) != 0;
        const StripDesc d0 = strip_desc(p, si), d1 = strip_desc(p, si + 1);
        float4 a0[2][2], b0[2][2], a1[2][2], b1[2][2];
#pragma unroll
        for (int ki = 0; ki < 2; ++ki)
#pragma unroll
            for (int ni = 0; ni < 2; ++ni) {
                a0[ki][ni] = *(const float4*)(d0.src + (size_t)(d0.k0 + ki * 64 + 2 * kp) * d0.lds_ + d0.n0 + ni * 64 + n4);
                b0[ki][ni] = *(const float4*)(d0.src + (size_t)(d0.k0 + ki * 64 + 2 * kp + 1) * d0.lds_ + d0.n0 + ni * 64 + n4);
            }
#pragma unroll
        for (int ki = 0; ki < 2; ++ki)
#pragma unroll
            for (int ni = 0; ni < 2; ++ni) {
                a1[ki][ni] = *(const float4*)(d1.src + (size_t)(d1.k0 + ki * 64 + 2 * kp) * d1.lds_ + d1.n0 + ni * 64 + n4);
                b1[ki][ni] = *(const float4*)(d1.src + (size_t)(d1.k0 + ki * 64 + 2 * kp + 1) * d1.lds_ + d1.n0 + ni * 64 + n4);
            }
        unsigned c = 0u, dn = 0u;
        if (tid == 0 && !lastone) { c = xb_add(head, 2u); if (done_ctr) dn = xb_ld(done_ctr); }
        cvt_store_strip(d0, a0, b0, lds, tid, false);
        cvt_store_strip(d1, a1, b1, lds + 33792, tid, false);
        LDS_BARRIER();
        cvt_store_strip(d0, a0, b0, lds, tid, true);
        cvt_store_strip(d1, a1, b1, lds + 33792, tid, true);
        if (tid == 0) {
            int sv = -1;
            if (!lastone && c < (unsigned)CV_TOTAL) { const bool fin = done_ctr ? (dn >= need_done) : (c >= (unsigned)limit); sv = (int)c | (fin ? CV_LAST : 0); }
            slot[0] = sv;
        }
        LDS_BARRIER();
    }
    __syncthreads();
}
__device__ __forceinline__ void tail_pull(const Params& p, LAS unsigned char* lds, int ctr_idx) {
    unsigned* ctr = (unsigned*)(p.ws + WS_CVTQ) + 64 * (1 + ctr_idx);
    __syncthreads();
    if (threadIdx.x == 0) (void)xb_add(ctr, 1u);
    cvt_pull(p, lds, 0, ctr, gridDim.x);
}

__device__ __forceinline__ void ada_chunks(const Params& p, LAS unsigned char* lds, int ch0, int ch_end, int step) {
    int tid = threadIdx.x; asm volatile("" : "+v"(tid));
    unsigned char* ws = p.ws;
    LAS float* cond = (LAS float*)lds;
    LAS float* red = (LAS float*)(lds + 32768);
    if (ch0 >= ch_end) return;
    for (int i = tid; i < 4 * D; i += 512) { const float v = p.c[i]; cond[i] = siluf_(v); }
    __syncthreads();
    for (int ch = ch0; ch < ch_end; ch += step) {
        const int l = ch >> 7, j0 = (ch & 127) * 96;
        const float* w = p.w_ada + (size_t)l * D * (6 * D);
        const int kg = tid / 24, cl = tid % 24;
        float acc[4][4];
#pragma unroll
        for (int b = 0; b < 4; ++b)
#pragma unroll
            for (int j = 0; j < 4; ++j) acc[b][j] = 0.f;
        if (kg < 21) {
            for (int it0 = 0; it0 < 98; it0 += 14) {
                float4 wv[14];
#pragma unroll
                for (int q = 0; q < 14; ++q) { const int k = kg + 21 * (it0 + q); wv[q] = (k < D) ? *(const float4*)(w + (size_t)k * (6 * D) + j0 + cl * 4) : make_float4(0.f, 0.f, 0.f, 0.f); }
#pragma unroll
                for (int q = 0; q < 14; ++q) { const int k = kg + 21 * (it0 + q); const int kc = k < D ? k : 0;
#pragma unroll
                    for (int b = 0; b < 4; ++b) { const float cv = cond[b * D + kc]; acc[b][0] += cv * wv[q].x; acc[b][1] += cv * wv[q].y; acc[b][2] += cv * wv[q].z; acc[b][3] += cv * wv[q].w; } }
            }
#pragma unroll
            for (int b = 0; b < 4; ++b)
#pragma unroll
                for (int j = 0; j < 4; ++j) red[(kg * 4 + b) * 96 + cl * 4 + j] = acc[b][j];
        }
        __syncthreads();
        if (tid < 384) {
            const int b = tid / 96, col = tid % 96; float s = 0.f;
            for (int g = 0; g < 21; ++g) s += red[(g * 4 + b) * 96 + col];
            float* mod = (float*)(ws + WS_MOD);
            mod[((size_t)l * 4 + b) * (6 * D) + j0 + col] = s + p.b_ada[(size_t)l * 6 * D + j0 + col];
        }
        __syncthreads();
    }
}
__device__ __forceinline__ void phase_prologue(const Params& p, LAS unsigned char* lds) {
    const bool svc = (gridDim.x >= 256);
    {
        float* wrt = (float*)(p.ws + WS_WRT);
        for (int i = blockIdx.x * 512 + threadIdx.x; i < D * NE / 4; i += gridDim.x * 512) {
            const float4 w = *(const float4*)(p.w_router + (size_t)i * 4);
            const int d = i >> 2, e4 = (i & 3) * 4;
            const int dp = (((d >> 9) * 2 + ((d >> 2) & 1)) << 8) + (((d >> 3) & 63) << 2) + (d & 3);
            wrt[(e4 + 0) * D + dp] = w.x; wrt[(e4 + 1) * D + dp] = w.y; wrt[(e4 + 2) * D + dp] = w.z; wrt[(e4 + 3) * D + dp] = w.w;
        }
    }
    ada_chunks(p, lds, blockIdx.x, svc ? 128 : 256, gridDim.x);
    cvt_pull(p, lds, CV_A0, nullptr, 0u);
}

#define COLK(k) ((unsigned)((((k) >> 1) << 9) + lane * 8 + (((k) & 1) << 2)))
#define COL8(i) ((unsigned)(((i) << 9) + lane * 8))
__device__ __forceinline__ void ld_bf8(const bf16_t* p, float4& a, float4& b) {
    const u32x4 r = *(const u32x4*)p;
    a = make_float4(bf2f(r[0] & 0xffffu), bf2f(r[0] >> 16), bf2f(r[1] & 0xffffu), bf2f(r[1] >> 16));
    b = make_float4(bf2f(r[2] & 0xffffu), bf2f(r[2] >> 16), bf2f(r[3] & 0xffffu), bf2f(r[3] >> 16));
}
__device__ __forceinline__ void st_bf8(bf16_t* p, const float4& a, const float4& b) {
    u32x4 o; o[0] = pack2a(a.x, a.y); o[1] = pack2a(a.z, a.w); o[2] = pack2a(b.x, b.y); o[3] = pack2a(b.z, b.w);
    *(u32x4*)p = o;
}
__device__ __forceinline__ void st_fp8x8(unsigned char* p, const float4& a, const float4& b) {
    int o0 = __builtin_amdgcn_cvt_pk_fp8_f32(a.x, a.y, 0, false); o0 = __builtin_amdgcn_cvt_pk_fp8_f32(a.z, a.w, o0, true);
    int o1 = __builtin_amdgcn_cvt_pk_fp8_f32(b.x, b.y, 0, false); o1 = __builtin_amdgcn_cvt_pk_fp8_f32(b.z, b.w, o1, true);
    u32x2 o; o[0] = (unsigned)o0; o[1] = (unsigned)o1;
    *(u32x2*)p = o;
}
__device__ __forceinline__ void ln_rows(float4 (&v)[8], const float* __restrict__ g, const float* __restrict__ b, int lane) {
    float s = 0.f;
#pragma unroll
    for (int i = 0; i < 8; ++i) s += (v[i].x + v[i].y) + (v[i].z + v[i].w);
    const float mean = wave_sum(s) * (1.0f / D);
    float q = 0.f;
#pragma unroll
    for (int i = 0; i < 8; ++i) { const float a = v[i].x - mean, bb = v[i].y - mean, c = v[i].z - mean, d = v[i].w - mean; q += (a * a + bb * bb) + (c * c + d * d); }
    const float rstd = rsqrtf(wave_sum(q) * (1.0f / D) + 1e-5f);
#pragma unroll
    for (int i = 0; i < 8; ++i) {
        const float4 gv = *(const float4*)(g + COLK(i)), bv = *(const float4*)(b + COLK(i));
        v[i].x = (v[i].x - mean) * rstd * gv.x + bv.x; v[i].y = (v[i].y - mean) * rstd * gv.y + bv.y;
        v[i].z = (v[i].z - mean) * rstd * gv.z + bv.z; v[i].w = (v[i].w - mean) * rstd * gv.w + bv.w;
    }
}
__device__ __forceinline__ void modulate_store(const float4 (&v)[8], const float* __restrict__ shift, const float* __restrict__ scale, bf16_t* __restrict__ dst, int lane, bool fp8) {
#pragma unroll
    for (int i = 0; i < 4; ++i) {
        float4 h[2];
#pragma unroll
        for (int q = 0; q < 2; ++q) {
            const float4 sh = *(const float4*)(shift + COLK(2 * i + q)), sc = *(const float4*)(scale + COLK(2 * i + q));
            const float4 x = v[2 * i + q];
            h[q] = make_float4(x.x * (1.f + sc.x) + sh.x, x.y * (1.f + sc.y) + sh.y, x.z * (1.f + sc.z) + sh.z, x.w * (1.f + sc.w) + sh.w);
        }
        if (fp8) st_fp8x8((unsigned char*)dst + COL8(i), h[0], h[1]);
        else st_bf8(dst + COL8(i), h[0], h[1]);
    }
}

__device__ __forceinline__ void phase_ln0(const Params& p) {
    int tid_ = threadIdx.x; asm volatile("" : "+v"(tid_)); const int wave = __builtin_amdgcn_readfirstlane(tid_ >> 6), lane = tid_ & 63;
    const float* mod = (const float*)(p.ws + WS_MOD);
    for (int n = blockIdx.x * 8 + wave; n < T; n += gridDim.x * 8) {
        const int b = n / SEQ;
        float4 v[8];
#pragma unroll
        for (int i = 0; i < 8; ++i) v[i] = *(const float4*)(p.x + (size_t)n * D + COLK(i));
        ln_rows(v, p.emb_g, p.emb_b, lane);
        bf16_t* xr = (bf16_t*)(p.ws + WS_XRES) + (size_t)n * D;
#pragma unroll
        for (int i = 0; i < 4; ++i) st_bf8(xr + COL8(i), v[2 * i], v[2 * i + 1]);
        const float* mb = mod + ((size_t)0 * 4 + b) * (6 * D);
        modulate_store(v, mb, mb + D, INP8(0) ? (bf16_t*)(p.ws + WS_HA + (size_t)n * D) : (bf16_t*)(p.ws + WS_HA) + (size_t)n * D, lane, INP8(0));
    }
}

__device__ __forceinline__ void phase_mixer_valu(const Params& p, int l, LAS unsigned char* lds) {
    LAS float* qs = (LAS float*)lds; LAS float* ks = qs + 4096; LAS float* fs = ks + 4096; LAS float* vs = fs + 4096; LAS float* po = vs + 1024;
    int tid = threadIdx.x; asm volatile("" : "+v"(tid)); const int wave = tid >> 6, lane = tid & 63, kk = tid >> 5, vv = tid & 31;
    const bf16_t* proj = (const bf16_t*)(p.ws + WS_PROJ);
    float* obuf = (float*)(p.ws + WS_OBUF);
    for (int u = blockIdx.x; u < 384; u += gridDim.x) {
        const int vsl = u & 3, dir = (u >> 2) & 1, hh = (u >> 3) % 6, b = ((u >> 3) / 6) % 4, type = (u >> 3) / 24;
        float S[8];
#pragma unroll
        for (int j = 0; j < 8; ++j) S[j] = 0.f;
        const float gamma = 1.0f - exp2f(-(dir ? 5.5f : 5.0f) - (float)hh);
        for (int blk = 0; blk < 64; ++blk) {
            const int rb = dir ? 63 - blk : blk, t0 = rb * 32;
            if (type == 0) {
#pragma unroll
                for (int j = 0; j < 4; ++j) {
                    const int idx = tid + 512 * j, tt = idx >> 6, dp = idx & 63;
                    const bf16_t* row = proj + (size_t)(b * SEQ + t0 + tt) * INC;
                    const float q1 = bf2f(row[C_RQ + hh * 128 + dp]), q2 = bf2f(row[C_RQ + hh * 128 + 64 + dp]);
                    const float k1 = bf2f(row[C_RK + hh * 128 + dp]), k2 = bf2f(row[C_RK + hh * 128 + 64 + dp]);
                    const float inv_freq = exp2f(-(float)dp * (13.287712379549449f / 64.0f));
                    const float ang = (float)(t0 + tt) * inv_freq;
                    float rev = ang * 0.15915494309189535f; rev -= rintf(rev);
                    const float sn = __builtin_amdgcn_sinf(rev), cs = __builtin_amdgcn_cosf(rev);
                    qs[tt * 128 + dp] = q1 * cs - q2 * sn; qs[tt * 128 + 64 + dp] = q1 * sn + q2 * cs;
                    ks[tt * 128 + dp] = (k1 * cs - k2 * sn) * 0.08838834764831845f; ks[tt * 128 + 64 + dp] = (k1 * sn + k2 * cs) * 0.08838834764831845f;
                    fs[tt * 128 + dp] = gamma; fs[tt * 128 + 64 + dp] = gamma;
                }
            } else {
#pragma unroll
                for (int j = 0; j < 8; ++j) {
                    const int idx = tid + 512 * j, tt = idx >> 7, d = idx & 127;
                    const bf16_t* row = proj + (size_t)(b * SEQ + t0 + tt) * INC;
                    const float q = bf2f(row[C_HQ + hh * 128 + d]);
                    const float z = bf2f(row[(dir ? C_HFB : C_HFF) + hh * 128 + d]);
                    float lb = 0.f;
                    if (l > 0) { const float a0 = p.lb_logits[(0 * 2 + dir) * HWD + hh * 128 + d], a1 = p.lb_logits[(1 * 2 + dir) * HWD + hh * 128 + d]; lb = 1.0f / (1.0f + expf(a0 - a1)); }
                    float f = lb + (1.0f - lb) * (1.0f / (1.0f + expf(-z)));
                    f = fmaxf(f, 1e-6f);
                    qs[tt * 128 + d] = q; ks[tt * 128 + d] = 1.0f - f; fs[tt * 128 + d] = f;
                }
            }
#pragma unroll
            for (int j = 0; j < 2; ++j) {
                const int idx = tid + 512 * j, tt = idx >> 5, c = idx & 31;
                const bf16_t* row = proj + (size_t)(b * SEQ + t0 + tt) * INC;
                vs[tt * 32 + c] = bf2f(row[(type ? C_HI : C_RV) + hh * 128 + vsl * 32 + c]);
            }
            __syncthreads();
            for (int s = 0; s < 32; ++s) {
                const int ss = dir ? 31 - s : s;
                const f32x4 qa = *(const LAS f32x4*)(qs + ss * 128 + kk * 8), qb = *(const LAS f32x4*)(qs + ss * 128 + kk * 8 + 4);
                const f32x4 ka = *(const LAS f32x4*)(ks + ss * 128 + kk * 8), kb = *(const LAS f32x4*)(ks + ss * 128 + kk * 8 + 4);
                const f32x4 fa = *(const LAS f32x4*)(fs + ss * 128 + kk * 8), fb = *(const LAS f32x4*)(fs + ss * 128 + kk * 8 + 4);
                const float vval = vs[ss * 32 + vv];
                float acc = 0.f;
#pragma unroll
                for (int j = 0; j < 4; ++j) { S[j] = fa[j] * S[j] + ka[j] * vval; acc += S[j] * qa[j]; }
#pragma unroll
                for (int j = 0; j < 4; ++j) { S[4 + j] = fb[j] * S[4 + j] + kb[j] * vval; acc += S[4 + j] * qb[j]; }
                acc += __shfl_xor(acc, 32, 64);
                if (lane < 32) po[(ss * 8 + wave) * 32 + vv] = acc;
            }
            __syncthreads();
#pragma unroll
            for (int j = 0; j < 2; ++j) {
                const int idx = tid + 512 * j, tt = idx >> 5, c = idx & 31;
                float s = 0.f;
#pragma unroll
                for (int w = 0; w < 8; ++w) s += po[(tt * 8 + w) * 32 + c];
                obuf[((size_t)dir * T + (size_t)(b * SEQ + t0 + tt)) * 1536 + type * 768 + hh * 128 + vsl * 32 + c] = s;
            }
        }
        __syncthreads();
    }
}

constexpr int MX_QI = 0, MX_KI = 17408, MX_QS = 34816, MX_KTT = 52224, MX_VT = 70656, MX_P = 79872, MX_ST = 89088, MX_TOT = 106496, MX_DEC = 110592, MX_RQ = 112128, MX_RK = 128512, MX_RV = 144896;
__device__ __forceinline__ float ex2(float x) { return __builtin_amdgcn_exp2f(x); }
__device__ __forceinline__ float clampe(float x) { return fminf(fmaxf(x, -120.f), 120.f); }
template <int MODE>
__device__ __forceinline__ void phase_mixer_mfma(const Params& p, int l, LAS unsigned char* lds, float* __restrict__ obuf) {
    int tid = threadIdx.x; asm volatile("" : "+v"(tid));
    const int wave = __builtin_amdgcn_readfirstlane(tid >> 6), lane = tid & 63, fr = lane & 15, fq = lane >> 4;
    const bf16_t* proj = (const bf16_t*)(p.ws + WS_PROJ);
    for (int u = blockIdx.x; u < 192; u += gridDim.x) {
        const int vsl = u & 1, dir = (u >> 1) & 1, hh = (u >> 2) % 6, b = ((u >> 2) / 6) % 4, type = (u >> 2) / 24;
        float lg2 = 0.f, invf0 = 0.f, invf1 = 0.f, sgn = 1.f, lb0 = 0.f, lb1 = 0.f;
        if (type == 0) {
            const float gamma = 1.0f - exp2f(-(dir ? 5.5f : 5.0f) - (float)hh);
            lg2 = log2f(gamma);
            const int dm0 = (2 * lane) & 63;
            invf0 = exp2f(-(float)dm0 * (13.287712379549449f / 64.0f)); invf1 = exp2f(-(float)(dm0 + 1) * (13.287712379549449f / 64.0f));
            sgn = lane < 32 ? -1.f : 1.f;
        } else if (l > 0) {
            const float* lbl = p.lb_logits + dir * HWD + hh * 128 + 2 * lane;
            lb0 = 1.0f / (1.0f + expf(lbl[0] - lbl[2 * HWD])); lb1 = 1.0f / (1.0f + expf(lbl[1] - lbl[2 * HWD + 1]));
        }
        const int colA = (type ? C_HQ : C_RQ) + hh * 128, colB = (type ? (dir ? C_HFB : C_HFF) : C_RK) + hh * 128;
        const int colV0 = (type ? C_HI : C_RV) + hh * 128 + vsl * 64;
        const int own = 2 * lane, par = (2 * lane + 64) & 127;
        const size_t ocol = (size_t)type * 768 + hh * 128 + vsl * 64;
#define MX_LOAD(ch) do { \
            _Pragma("unroll") for (int i2 = 0; i2 < 2; ++i2) { const int pos = wave * 8 + i2 * 4 + (lane >> 4); const int tau = (ch) * 64 + pos; const int t = dir ? (SEQ - 1 - tau) : tau; \
                const bf16_t* row = proj + (size_t)(b * SEQ + t) * INC + (lane & 15) * 8; \
                __builtin_amdgcn_global_load_lds((const unsigned*)(row + colA), (LAS unsigned*)(lds + MX_RQ + (wave * 8 + i2 * 4) * 256), 16, 0, 0); \
                __builtin_amdgcn_global_load_lds((const unsigned*)(row + colB), (LAS unsigned*)(lds + MX_RK + (wave * 8 + i2 * 4) * 256), 16, 0, 0); } \
            { const int pos = wave * 8 + (lane >> 3); const int tau = (ch) * 64 + pos; const int t = dir ? (SEQ - 1 - tau) : tau; \
              const bf16_t* row = proj + (size_t)(b * SEQ + t) * INC + colV0 + (lane & 7) * 8; \
              __builtin_amdgcn_global_load_lds((const unsigned*)row, (LAS unsigned*)(lds + MX_RV + (wave * 8) * 128), 16, 0, 0); } } while (0)
        f32x4 Sacc[4];
#pragma unroll
        for (int vt = 0; vt < 4; ++vt) Sacc[vt] = (f32x4){0.f, 0.f, 0.f, 0.f};
        for (int i = tid; i < 64 * 272 / 4; i += 512) ((LAS unsigned*)(lds + MX_ST))[i] = 0u;
        float cd0 = 1.f, sd0 = 0.f, cd1 = 1.f, sd1 = 0.f;
        if (type == 0) {
            if (tid < 64) { const float fi = (float)tid; *(LAS f32x4*)(lds + MX_DEC + 512 + tid * 16) = (f32x4){ex2((fi - 31.f) * lg2), ex2((31.f - fi) * lg2), ex2((fi + 1.f) * lg2), ex2((63.f - fi) * lg2)}; }
            const float r0 = invf0 * 0.15915494309189535f, r1 = invf1 * 0.15915494309189535f, sg = dir ? -1.f : 1.f;
            cd0 = __builtin_amdgcn_cosf(r0); sd0 = sg * __builtin_amdgcn_sinf(r0); cd1 = __builtin_amdgcn_cosf(r1); sd1 = sg * __builtin_amdgcn_sinf(r1);
        }
        __syncthreads();
        MX_LOAD(0);
        asm volatile("s_waitcnt vmcnt(0)" ::: "memory");
        __syncthreads();
        for (int ch = 0; ch < 32; ++ch) {
            float q0[8], q1[8], k0[8], k1[8], c0[8], c1[8];
            float run0 = 0.f, run1 = 0.f;
            u32x4 vpk = (u32x4){0u, 0u, 0u, 0u};
#pragma unroll
            for (int j = 0; j < 8; ++j) { q0[j] = q1[j] = k0[j] = k1[j] = c0[j] = c1[j] = 0.f; }
            if (MODE != 3 && MODE != 4) {
            if (type == 0) {
                const int tau0 = ch * 64 + wave * 8; const int t0 = dir ? (SEQ - 1 - tau0) : tau0;
                float rev0 = (float)t0 * invf0 * 0.15915494309189535f, rev1 = (float)t0 * invf1 * 0.15915494309189535f;
                rev0 -= rintf(rev0); rev1 -= rintf(rev1);
                float sn0 = __builtin_amdgcn_sinf(rev0), cs0 = __builtin_amdgcn_cosf(rev0), sn1 = __builtin_amdgcn_sinf(rev1), cs1 = __builtin_amdgcn_cosf(rev1);
#pragma unroll
                for (int j = 0; j < 8; ++j) {
                    const int pos_ = wave * 8 + j;
                    const unsigned ra_ = *(const LAS unsigned*)(lds + MX_RQ + pos_ * 256 + own * 2), rb_ = *(const LAS unsigned*)(lds + MX_RK + pos_ * 256 + own * 2);
                    const unsigned rc_ = *(const LAS unsigned*)(lds + MX_RQ + pos_ * 256 + par * 2), rd_ = *(const LAS unsigned*)(lds + MX_RK + pos_ * 256 + par * 2);
                    const float a_lo = bf2f(ra_ & 0xffffu), a_hi = bf2f(ra_ >> 16), b_lo = bf2f(rb_ & 0xffffu), b_hi = bf2f(rb_ >> 16);
                    const float pa_lo = bf2f(rc_ & 0xffffu), pa_hi = bf2f(rc_ >> 16), pb_lo = bf2f(rd_ & 0xffffu), pb_hi = bf2f(rd_ >> 16);
                    const float ss0 = sgn * sn0, ss1 = sgn * sn1;
                    q0[j] = a_lo * cs0 + pa_lo * ss0; q1[j] = a_hi * cs1 + pa_hi * ss1;
                    k0[j] = (b_lo * cs0 + pb_lo * ss0) * 0.08838834764831845f; k1[j] = (b_hi * cs1 + pb_hi * ss1) * 0.08838834764831845f;
                    const float nc0 = cs0 * cd0 - sn0 * sd0, ns0 = sn0 * cd0 + cs0 * sd0, nc1 = cs1 * cd1 - sn1 * sd1, ns1 = sn1 * cd1 + cs1 * sd1;
                    cs0 = nc0; sn0 = ns0; cs1 = nc1; sn1 = ns1;
                    c0[j] = 0.f; c1[j] = 0.f;
                }
            } else {
#pragma unroll
                for (int j = 0; j < 8; ++j) {
                    const int pos_ = wave * 8 + j;
                    const unsigned ra_ = *(const LAS unsigned*)(lds + MX_RQ + pos_ * 256 + own * 2), rb_ = *(const LAS unsigned*)(lds + MX_RK + pos_ * 256 + own * 2);
                    const float a_lo = bf2f(ra_ & 0xffffu), a_hi = bf2f(ra_ >> 16), b_lo = bf2f(rb_ & 0xffffu), b_hi = bf2f(rb_ >> 16);
                    q0[j] = a_lo; q1[j] = a_hi;
                    float f0 = lb0 + (1.0f - lb0) * __builtin_amdgcn_rcpf(1.0f + ex2(-b_lo * 1.4426950408889634f));
                    float f1 = lb1 + (1.0f - lb1) * __builtin_amdgcn_rcpf(1.0f + ex2(-b_hi * 1.4426950408889634f));
                    f0 = fmaxf(f0, 1e-6f); f1 = fmaxf(f1, 1e-6f);
                    k0[j] = 1.0f - f0; k1[j] = 1.0f - f1;
                    run0 += __builtin_amdgcn_logf(f0); run1 += __builtin_amdgcn_logf(f1); c0[j] = run0; c1[j] = run1;
                }
            }
            { unsigned rv[8];
#pragma unroll
              for (int j = 0; j < 8; ++j) rv[j] = *(const LAS unsigned short*)(lds + MX_RV + (wave * 8 + j) * 128 + lane * 2);
              vpk[0] = rv[0] | (rv[1] << 16); vpk[1] = rv[2] | (rv[3] << 16); vpk[2] = rv[4] | (rv[5] << 16); vpk[3] = rv[6] | (rv[7] << 16); }
            }
            { typedef float f32x2_ __attribute__((ext_vector_type(2))); *(LAS f32x2_*)(lds + MX_TOT + (wave * 128 + 2 * lane) * 4) = (f32x2_){run0, run1}; }
            LDS_BARRIER();
            if (ch + 1 < 32) MX_LOAD(ch + 1);
            float kt0[8], kt1[8];
            float tt0, tt1;
#pragma unroll
            for (int j = 0; j < 8; ++j) { kt0[j] = kt1[j] = 0.f; }
            tt0 = tt1 = 0.f;
            if (MODE != 3 && MODE != 4) {
            if (type == 0) {
                tt0 = tt1 = 64.f * lg2;
#pragma unroll
                for (int j = 0; j < 8; ++j) {
                    const int pos = wave * 8 + j;
                    const f32x4 e = *(const LAS f32x4*)(lds + MX_DEC + 512 + pos * 16);
                    *(LAS unsigned*)(lds + MX_QI + pos * 272 + lane * 4) = pack2(q0[j] * e[0], q1[j] * e[0]);
                    *(LAS unsigned*)(lds + MX_KI + pos * 272 + lane * 4) = pack2(k0[j] * e[1], k1[j] * e[1]);
                    kt0[j] = k0[j] * e[3]; kt1[j] = k1[j] * e[3];
                }
            } else {
                float off0 = 0.f, off1 = 0.f, m0 = 0.f, m1 = 0.f; tt0 = 0.f; tt1 = 0.f;
#pragma unroll
                for (int g = 0; g < 8; ++g) {
                    typedef float f32x2_ __attribute__((ext_vector_type(2)));
                    const f32x2_ tv = *(const LAS f32x2_*)(lds + MX_TOT + (g * 128 + 2 * lane) * 4);
                    if (g < wave) { off0 += tv[0]; off1 += tv[1]; }
                    if (g < 4) { m0 += tv[0]; m1 += tv[1]; }
                    tt0 += tv[0]; tt1 += tv[1];
                }
                const float etm0 = ex2(tt0 - m0), etm1 = ex2(tt1 - m1);
#pragma unroll
                for (int j = 0; j < 8; ++j) {
                    const float cu0 = c0[j] + off0, cu1 = c1[j] + off1;
                    const float e10 = ex2(clampe(cu0 - m0)), e11 = ex2(clampe(cu1 - m1));
                    const float e20 = __builtin_amdgcn_rcpf(e10), e21 = __builtin_amdgcn_rcpf(e11);
                    const int pos = wave * 8 + j;
                    *(LAS unsigned*)(lds + MX_QI + pos * 272 + lane * 4) = pack2(q0[j] * e10, q1[j] * e11);
                    *(LAS unsigned*)(lds + MX_KI + pos * 272 + lane * 4) = pack2(k0[j] * e20, k1[j] * e21);
                    kt0[j] = k0[j] * (e20 * etm0); kt1[j] = k1[j] * (e21 * etm1);
                }
            }
            }
            { u32x4 w0, w1;
              w0[0] = pack2(kt0[0], kt0[1]); w0[1] = pack2(kt0[2], kt0[3]); w0[2] = pack2(kt0[4], kt0[5]); w0[3] = pack2(kt0[6], kt0[7]);
              w1[0] = pack2(kt1[0], kt1[1]); w1[1] = pack2(kt1[2], kt1[3]); w1[2] = pack2(kt1[4], kt1[5]); w1[3] = pack2(kt1[6], kt1[7]);
              *(LAS u32x4*)(lds + MX_KTT + (2 * lane) * 144 + wave * 16) = w0;
              *(LAS u32x4*)(lds + MX_KTT + (2 * lane + 1) * 144 + wave * 16) = w1;
              *(LAS u32x4*)(lds + MX_VT + lane * 144 + wave * 16) = vpk; }
            if (MODE != 3 && MODE != 4) {
                f32x4 em;
                if (type == 0) { const float e_ = ex2(32.f * lg2); em = (f32x4){e_, e_, e_, e_}; }
                else {
                    f32x4 ms = (f32x4){0.f, 0.f, 0.f, 0.f};
#pragma unroll
                    for (int g = 0; g < 4; ++g) ms += *(const LAS f32x4*)(lds + MX_TOT + (g * 128 + 16 * wave + 4 * fq) * 4);
                    em = (f32x4){ex2(ms[0]), ex2(ms[1]), ex2(ms[2]), ex2(ms[3])};
                }
#pragma unroll
                for (int vt = 0; vt < 4; ++vt) { u32x2 o; o[0] = pack2(Sacc[vt][0] * em[0], Sacc[vt][1] * em[1]); o[1] = pack2(Sacc[vt][2] * em[2], Sacc[vt][3] * em[3]);
                    *(LAS u32x2*)(lds + MX_ST + (16 * vt + fr) * 272 + (16 * wave + 4 * fq) * 2) = o; }
            }
            if (wave == 0) { typedef float f32x2_ __attribute__((ext_vector_type(2))); *(LAS f32x2_*)(lds + MX_DEC + lane * 8) = (f32x2_){ex2(tt0), ex2(tt1)}; }
            LDS_BARRIER();
            if (MODE != 2 && MODE != 4) {
                const int it = wave >> 1, st0 = 2 * (wave & 1);
                bf16x8 ka[2][4], qb[4];
#pragma unroll
                for (int kq = 0; kq < 4; ++kq) {
                    qb[kq] = *(const LAS bf16x8*)(lds + MX_QI + (16 * it + fr) * 272 + (32 * kq + 8 * fq) * 2);
                    ka[0][kq] = *(const LAS bf16x8*)(lds + MX_KI + (16 * st0 + fr) * 272 + (32 * kq + 8 * fq) * 2);
                    ka[1][kq] = *(const LAS bf16x8*)(lds + MX_KI + (16 * st0 + 16 + fr) * 272 + (32 * kq + 8 * fq) * 2);
                }
                asm volatile("s_waitcnt lgkmcnt(0)" ::: "memory");
                f32x4 acc0 = (f32x4){0.f, 0.f, 0.f, 0.f}, acc1 = acc0;
#pragma unroll
                for (int kq = 0; kq < 4; ++kq) {
                    acc0 = __builtin_amdgcn_mfma_f32_16x16x32_bf16(ka[0][kq], qb[kq], acc0, 0, 0, 0);
                    acc1 = __builtin_amdgcn_mfma_f32_16x16x32_bf16(ka[1][kq], qb[kq], acc1, 0, 0, 0);
                }
                const int i = 16 * it + fr;
                { const int s0 = 16 * st0 + 4 * fq;
                  const float v0 = (s0 + 0 <= i) ? acc0[0] : 0.f, v1 = (s0 + 1 <= i) ? acc0[1] : 0.f, v2 = (s0 + 2 <= i) ? acc0[2] : 0.f, v3 = (s0 + 3 <= i) ? acc0[3] : 0.f;
                  u32x2 o; o[0] = pack2(v0, v1); o[1] = pack2(v2, v3);
                  *(LAS u32x2*)(lds + MX_P + i * 144 + s0 * 2) = o; }
                { const int s0 = 16 * st0 + 16 + 4 * fq;
                  const float v0 = (s0 + 0 <= i) ? acc1[0] : 0.f, v1 = (s0 + 1 <= i) ? acc1[1] : 0.f, v2 = (s0 + 2 <= i) ? acc1[2] : 0.f, v3 = (s0 + 3 <= i) ? acc1[3] : 0.f;
                  u32x2 o; o[0] = pack2(v0, v1); o[1] = pack2(v2, v3);
                  *(LAS u32x2*)(lds + MX_P + i * 144 + s0 * 2) = o; }
            }
            LDS_BARRIER();
            if (MODE != 2 && MODE != 4) {
                const int vt = wave >> 1, it0 = 2 * (wave & 1);
                bf16x8 va[2], sa[4], pb[2][2], qsb[2][4], kta[2], vb[4][2];
#pragma unroll
                for (int kq = 0; kq < 2; ++kq) {
                    va[kq] = *(const LAS bf16x8*)(lds + MX_VT + (16 * vt + fr) * 144 + (32 * kq + 8 * fq) * 2);
                    pb[0][kq] = *(const LAS bf16x8*)(lds + MX_P + (16 * it0 + fr) * 144 + (32 * kq + 8 * fq) * 2);
                    pb[1][kq] = *(const LAS bf16x8*)(lds + MX_P + (16 * it0 + 16 + fr) * 144 + (32 * kq + 8 * fq) * 2);
                    kta[kq] = *(const LAS bf16x8*)(lds + MX_KTT + (16 * wave + fr) * 144 + (32 * kq + 8 * fq) * 2);
                }
#pragma unroll
                for (int kq = 0; kq < 4; ++kq) {
                    sa[kq] = *(const LAS bf16x8*)(lds + MX_ST + (16 * vt + fr) * 272 + (32 * kq + 8 * fq) * 2);
                    qsb[0][kq] = *(const LAS bf16x8*)(lds + MX_QI + (16 * it0 + fr) * 272 + (32 * kq + 8 * fq) * 2);
                    qsb[1][kq] = *(const LAS bf16x8*)(lds + MX_QI + (16 * it0 + 16 + fr) * 272 + (32 * kq + 8 * fq) * 2);
                }
#pragma unroll
                for (int v4 = 0; v4 < 4; ++v4)
#pragma unroll
                    for (int kq = 0; kq < 2; ++kq) vb[v4][kq] = *(const LAS bf16x8*)(lds + MX_VT + (16 * v4 + fr) * 144 + (32 * kq + 8 * fq) * 2);
                const f32x4 dc = *(const LAS f32x4*)(lds + MX_DEC + (16 * wave + 4 * fq) * 4);
                asm volatile("s_waitcnt lgkmcnt(0)" ::: "memory");
                f32x4 acc0 = (f32x4){0.f, 0.f, 0.f, 0.f}, acc1 = acc0;
#pragma unroll
                for (int kq = 0; kq < 2; ++kq) {
                    acc0 = __builtin_amdgcn_mfma_f32_16x16x32_bf16(va[kq], pb[0][kq], acc0, 0, 0, 0);
                    acc1 = __builtin_amdgcn_mfma_f32_16x16x32_bf16(va[kq], pb[1][kq], acc1, 0, 0, 0);
                }
#pragma unroll
                for (int kq = 0; kq < 4; ++kq) {
                    acc0 = __builtin_amdgcn_mfma_f32_16x16x32_bf16(sa[kq], qsb[0][kq], acc0, 0, 0, 0);
                    acc1 = __builtin_amdgcn_mfma_f32_16x16x32_bf16(sa[kq], qsb[1][kq], acc1, 0, 0, 0);
                }
#pragma unroll
                for (int v4 = 0; v4 < 4; ++v4) {
                    f32x4 a = Sacc[v4]; a[0] *= dc[0]; a[1] *= dc[1]; a[2] *= dc[2]; a[3] *= dc[3];
                    a = __builtin_amdgcn_mfma_f32_16x16x32_bf16(kta[0], vb[v4][0], a, 0, 0, 0);
                    a = __builtin_amdgcn_mfma_f32_16x16x32_bf16(kta[1], vb[v4][1], a, 0, 0, 0);
                    Sacc[v4] = a;
                }
                asm volatile("s_waitcnt vmcnt(0)" ::: "memory");
                { const int tau = ch * 64 + 16 * it0 + fr; const int t = dir ? (SEQ - 1 - tau) : tau;
                  u32x2 o; o[0] = pack2(acc0[0], acc0[1]); o[1] = pack2(acc0[2], acc0[3]);
                  *(u32x2*)((bf16_t*)obuf + ((size_t)dir * T + (size_t)(b * SEQ + t)) * 1536 + ocol + 16 * vt + 4 * fq) = o; }
                { const int tau = ch * 64 + 16 * it0 + 16 + fr; const int t = dir ? (SEQ - 1 - tau) : tau;
                  u32x2 o; o[0] = pack2(acc1[0], acc1[1]); o[1] = pack2(acc1[2], acc1[3]);
                  *(u32x2*)((bf16_t*)obuf + ((size_t)dir * T + (size_t)(b * SEQ + t)) * 1536 + ocol + 16 * vt + 4 * fq) = o; }
            }
        }
        __syncthreads();
#undef MX_LOAD
    }
}

#ifdef MIXER_CHECK
__device__ __forceinline__ void phase_mixer_check(const Params& p, const float* __restrict__ oa, const float* __restrict__ ob, float* chk) {
    int tid_ = threadIdx.x; asm volatile("" : "+v"(tid_)); const int wave = __builtin_amdgcn_readfirstlane(tid_ >> 6), lane = tid_ & 63;
    for (int r = blockIdx.x * 8 + wave; r < 2 * T; r += gridDim.x * 8) {
        const int dir = r / T;
#pragma unroll
        for (int ty = 0; ty < 2; ++ty) {
            float sd = 0.f, sq = 0.f;
#pragma unroll
            for (int i = 0; i < 3; ++i) { const float4 a = *(const float4*)(oa + (size_t)r * 1536 + ty * 768 + i * 256 + lane * 4), bq = *(const float4*)(ob + (size_t)r * 1536 + ty * 768 + i * 256 + lane * 4);
                sd += (a.x - bq.x) * (a.x - bq.x) + (a.y - bq.y) * (a.y - bq.y) + (a.z - bq.z) * (a.z - bq.z) + (a.w - bq.w) * (a.w - bq.w);
                sq += a.x * a.x + a.y * a.y + a.z * a.z + a.w * a.w; }
            sd = wave_sum(sd); sq = wave_sum(sq);
            if (lane == 0) { atomicAdd(&chk[(ty * 2 + dir) * 2 + 0], sd); atomicAdd(&chk[(ty * 2 + dir) * 2 + 1], sq); }
        }
    }
}
#endif

__device__ __forceinline__ float4 ld_bf4(const bf16_t* p) { const u32x2 r = *(const u32x2*)p; return make_float4(bf2f(r[0] & 0xffffu), bf2f(r[0] >> 16), bf2f(r[1] & 0xffffu), bf2f(r[1] >> 16)); }
__device__ __forceinline__ float grp16_sum(float v) {
#pragma unroll
    for (int o = 8; o > 0; o >>= 1) v += __shfl_xor(v, o, 64);
    return v;
}
__device__ __forceinline__ void phase_finalize(const Params& p, int l) {
    int tid_ = threadIdx.x; asm volatile("" : "+v"(tid_)); const int wave = __builtin_amdgcn_readfirstlane(tid_ >> 6), lane = tid_ & 63;
    const bf16_t* proj = (const bf16_t*)(p.ws + WS_PROJ);
    const bf16_t* obuf = (const bf16_t*)(p.ws + WS_OBUF);
    bf16_t* mixed = (bf16_t*)(p.ws + WS_MIXED);
    const float* cw = p.conv_w + (size_t)l * 3 * CW;
    const float* beta = p.mix_beta + (size_t)l * D;
    for (int n = blockIdx.x * 8 + wave; n < T; n += gridDim.x * 8) {
        const int t = n % SEQ;
        const bf16_t* row = proj + (size_t)n * INC;
#pragma unroll
        for (int i = 0; i < 4; ++i) {
            const int c = COL8(i);
            float4 r[2];
            if (i == 0) {
                float4 cc[2], ch[2], cb[2], um[2], up[2];
                ld_bf8(row + C_CC + c, cc[0], cc[1]); ld_bf8(row + C_CH + c, ch[0], ch[1]); ld_bf8(row + C_CB + c, cb[0], cb[1]);
                um[0] = um[1] = up[0] = up[1] = make_float4(0.f, 0.f, 0.f, 0.f);
                if (t > 0) { float4 a[2], b2[2]; ld_bf8(row - INC + C_CC + c, a[0], a[1]); ld_bf8(row - INC + C_CH + c, b2[0], b2[1]);
#pragma unroll
                    for (int q = 0; q < 2; ++q) um[q] = make_float4(a[q].x * b2[q].x, a[q].y * b2[q].y, a[q].z * b2[q].z, a[q].w * b2[q].w); }
                if (t < SEQ - 1) { float4 a[2], b2[2]; ld_bf8(row + INC + C_CC + c, a[0], a[1]); ld_bf8(row + INC + C_CH + c, b2[0], b2[1]);
#pragma unroll
                    for (int q = 0; q < 2; ++q) up[q] = make_float4(a[q].x * b2[q].x, a[q].y * b2[q].y, a[q].z * b2[q].z, a[q].w * b2[q].w); }
#pragma unroll
                for (int q = 0; q < 2; ++q) {
                    const float4 w0 = *(const float4*)(cw + c + 4 * q), w1 = *(const float4*)(cw + CW + c + 4 * q), w2 = *(const float4*)(cw + 2 * CW + c + 4 * q);
                    r[q].x = cb[q].x * (um[q].x * w0.x + cc[q].x * ch[q].x * w1.x + up[q].x * w2.x);
                    r[q].y = cb[q].y * (um[q].y * w0.y + cc[q].y * ch[q].y * w1.y + up[q].y * w2.y);
                    r[q].z = cb[q].z * (um[q].z * w0.z + cc[q].z * ch[q].z * w1.z + up[q].z * w2.z);
                    r[q].w = cb[q].w * (um[q].w * w0.w + cc[q].w * ch[q].w * w1.w + up[q].w * w2.w);
                }
            } else {
                const int oc = c - 512;
                const bool isret = oc < 768;
                float4 of[2], ob[2], gt[2];
                ld_bf8(obuf + (size_t)n * 1536 + oc, of[0], of[1]); ld_bf8(obuf + ((size_t)T + n) * 1536 + oc, ob[0], ob[1]);
                ld_bf8(row + (isret ? C_RG + oc : C_HG + (oc - 768)), gt[0], gt[1]);
                float4 o[2];
#pragma unroll
                for (int q = 0; q < 2; ++q) o[q] = make_float4(of[q].x + ob[q].x, of[q].y + ob[q].y, of[q].z + ob[q].z, of[q].w + ob[q].w);
                const float sm = grp16_sum(((o[0].x + o[0].y) + (o[0].z + o[0].w)) + ((o[1].x + o[1].y) + (o[1].z + o[1].w)));
                const float mu = isret ? sm * (1.0f / 128.0f) : 0.f;
#pragma unroll
                for (int q = 0; q < 2; ++q) { o[q].x -= mu; o[q].y -= mu; o[q].z -= mu; o[q].w -= mu; }
                const float var = grp16_sum(((o[0].x * o[0].x + o[0].y * o[0].y) + (o[0].z * o[0].z + o[0].w * o[0].w)) + ((o[1].x * o[1].x + o[1].y * o[1].y) + (o[1].z * o[1].z + o[1].w * o[1].w))) * (1.0f / 128.0f);
                const float rs = rsqrtf(var + 1e-6f);
#pragma unroll
                for (int q = 0; q < 2; ++q) r[q] = make_float4(o[q].x * rs * siluf_(gt[q].x), o[q].y * rs * siluf_(gt[q].y), o[q].z * rs * siluf_(gt[q].z), o[q].w * rs * siluf_(gt[q].w));
            }
            const float4 bt0 = *(const float4*)(beta + c), bt1 = *(const float4*)(beta + c + 4);
            r[0] = make_float4(r[0].x * bt0.x, r[0].y * bt0.y, r[0].z * bt0.z, r[0].w * bt0.w);
            r[1] = make_float4(r[1].x * bt1.x, r[1].y * bt1.y, r[1].z * bt1.z, r[1].w * bt1.w);
            if (OUT8(l)) { const float4 a4 = make_float4(r[0].x * 4.f, r[0].y * 4.f, r[0].z * 4.f, r[0].w * 4.f), b4 = make_float4(r[1].x * 4.f, r[1].y * 4.f, r[1].z * 4.f, r[1].w * 4.f);
                           st_fp8x8((unsigned char*)mixed + (size_t)n * D + c, a4, b4); }
            else st_bf8(mixed + (size_t)n * D + c, r[0], r[1]);
        }
    }
}

#define RGRP 4
#if RGRP == 4
#define LN1_SB() __builtin_amdgcn_sched_barrier(0)
#else
#define LN1_SB()
#endif
__device__ __forceinline__ void phase_ln1_router(const Params& p, int l, LAS unsigned char* lds) {
    int tid = threadIdx.x; asm volatile("" : "+v"(tid)); const int wave = __builtin_amdgcn_readfirstlane(tid >> 6), lane = tid & 63;
    LAS float* wrt = (LAS float*)lds;
    {
        const unsigned char* wg = p.ws + WS_WRT;
#pragma unroll
        for (int j = 0; j < 16; ++j) {
            const int ch = wave * 16 + j;
            __builtin_amdgcn_global_load_lds((const unsigned*)(wg + (size_t)ch * 1024 + lane * 16), (LAS unsigned*)(lds + ch * 1024), 16, 0, 0);
        }
    }
    LAS int* lcnt = (LAS int*)(lds + LDS_MISC + 256);
    if (tid < 16) lcnt[tid] = 0;
    asm volatile("s_waitcnt vmcnt(0)" ::: "memory");
    __syncthreads();
    const float* mod = (const float*)(p.ws + WS_MOD);
    const float* y = (const float*)(p.ws + WS_Y);
    float* xres = (float*)(p.ws + WS_XRES);
    int* route = (int*)(p.ws + WS_ROUTE);
    for (int n0 = (blockIdx.x * 8 + wave) * RGRP; n0 < T; n0 += gridDim.x * 8 * RGRP) {
        float4 h[RGRP][8];
        {
            const int b = n0 / SEQ;
            const float* mb = mod + ((size_t)l * 4 + b) * (6 * D);
#pragma unroll
            for (int i = 0; i < 4; ++i) {
                float4 xv[RGRP][2], yv[RGRP][2];
#pragma unroll
                for (int r = 0; r < RGRP; ++r) { ld_bf8((const bf16_t*)xres + (size_t)(n0 + r) * D + COL8(i), xv[r][0], xv[r][1]); ld_bf8((const bf16_t*)y + (size_t)(n0 + r) * D + COL8(i), yv[r][0], yv[r][1]); }
#pragma unroll
                for (int q = 0; q < 2; ++q) {
                    const float4 g = *(const float4*)(mb + 2 * D + COLK(2 * i + q));
#pragma unroll
                    for (int r = 0; r < RGRP; ++r)
                        h[r][2 * i + q] = make_float4(ALPHA * xv[r][q].x + (1.f + g.x) * yv[r][q].x, ALPHA * xv[r][q].y + (1.f + g.y) * yv[r][q].y, ALPHA * xv[r][q].z + (1.f + g.z) * yv[r][q].z, ALPHA * xv[r][q].w + (1.f + g.w) * yv[r][q].w);
                }
                LN1_SB();
            }
            float mean[RGRP], rstd[RGRP];
#pragma unroll
            for (int r = 0; r < RGRP; ++r) {
                float s0 = 0.f;
#pragma unroll
                for (int i = 0; i < 8; ++i) s0 += (h[r][i].x + h[r][i].y) + (h[r][i].z + h[r][i].w);
                mean[r] = s0;
            }
#pragma unroll
            for (int o = 32; o > 0; o >>= 1)
#pragma unroll
                for (int r = 0; r < RGRP; ++r) mean[r] += __shfl_xor(mean[r], o, 64);
#pragma unroll
            for (int r = 0; r < RGRP; ++r) {
                mean[r] *= (1.0f / D);
                float q0 = 0.f;
#pragma unroll
                for (int i = 0; i < 8; ++i) { const float a = h[r][i].x - mean[r], bb = h[r][i].y - mean[r], c = h[r][i].z - mean[r], d = h[r][i].w - mean[r]; q0 += (a * a + bb * bb) + (c * c + d * d); }
                rstd[r] = q0;
            }
#pragma unroll
            for (int o = 32; o > 0; o >>= 1)
#pragma unroll
                for (int r = 0; r < RGRP; ++r) rstd[r] += __shfl_xor(rstd[r], o, 64);
#pragma unroll
            for (int r = 0; r < RGRP; ++r) rstd[r] = rsqrtf(rstd[r] * (1.0f / D) + 1e-5f);
            const float* lg_ = p.ln_g + (size_t)(l * 2 + 0) * D; const float* lb_ = p.ln_b + (size_t)(l * 2 + 0) * D;
            LN1_SB();
#pragma unroll
            for (int i = 0; i < 8; ++i) {
                const float4 gv = *(const float4*)(lg_ + COLK(i)), bv = *(const float4*)(lb_ + COLK(i));
#pragma unroll
                for (int r = 0; r < RGRP; ++r) {
                    float4& v = h[r][i];
                    v.x = (v.x - mean[r]) * rstd[r] * gv.x + bv.x; v.y = (v.y - mean[r]) * rstd[r] * gv.y + bv.y;
                    v.z = (v.z - mean[r]) * rstd[r] * gv.z + bv.z; v.w = (v.w - mean[r]) * rstd[r] * gv.w + bv.w;
                }
                if (i & 1) LN1_SB();
            }
#pragma unroll
            for (int r = 0; r < RGRP; ++r)
#pragma unroll
                for (int i = 0; i < 4; ++i) st_bf8((bf16_t*)xres + (size_t)(n0 + r) * D + COL8(i), h[r][2 * i], h[r][2 * i + 1]);
            LN1_SB();
#pragma unroll
            for (int i = 0; i < 8; ++i) {
                const float4 sh = *(const float4*)(mb + 3 * D + COLK(i)), sc = *(const float4*)(mb + 4 * D + COLK(i));
#pragma unroll
                for (int r = 0; r < RGRP; ++r) {
                    float4& v = h[r][i];
                    v.x = v.x * (1.f + sc.x) + sh.x; v.y = v.y * (1.f + sc.y) + sh.y; v.z = v.z * (1.f + sc.z) + sh.z; v.w = v.w * (1.f + sc.w) + sh.w;
                }
                if (i & 1) LN1_SB();
            }
#pragma unroll
            for (int r = 0; r < RGRP; ++r) {
#if MOE_FP8
                unsigned char* hb = p.ws + WS_HB + (size_t)(n0 + r) * D;
#pragma unroll
                for (int i = 0; i < 4; ++i) st_fp8x8(hb + COL8(i), h[r][2 * i], h[r][2 * i + 1]);
#else
                bf16_t* hb = (bf16_t*)(p.ws + WS_HB) + (size_t)(n0 + r) * D;
#pragma unroll
                for (int i = 0; i < 4; ++i) st_bf8(hb + COL8(i), h[r][2 * i], h[r][2 * i + 1]);
#endif
            }
        }
        float lgk0 = 0.f, lgk1 = 0.f, lgk2 = 0.f, lgk3 = 0.f;
        const bool b5 = (lane & 32) != 0, b4 = (lane & 16) != 0, b3 = (lane & 8) != 0, b2 = (lane & 4) != 0;
#pragma unroll 1
        for (int eg = 0; eg < 4; ++eg) {
            float s[RGRP][4];
#pragma unroll
            for (int q = 0; q < 4; ++q) {
                f32x2_t ac[RGRP];
#pragma unroll
                for (int r = 0; r < RGRP; ++r) ac[r] = (f32x2_t){0.f, 0.f};
#pragma unroll
                for (int i = 0; i < 8; ++i) {
                    const f32x4 w = *(const LAS f32x4*)(wrt + (eg * 4 + q) * D + i * 256 + lane * 4);
                    const f32x2_t w01 = __builtin_shufflevector(w, w, 0, 1), w23 = __builtin_shufflevector(w, w, 2, 3);
#pragma unroll
                    for (int r = 0; r < RGRP; ++r) {
                        ac[r] = __builtin_elementwise_fma((f32x2_t){h[r][i].x, h[r][i].y}, w01, ac[r]);
                        ac[r] = __builtin_elementwise_fma((f32x2_t){h[r][i].z, h[r][i].w}, w23, ac[r]);
                    }
                }
#pragma unroll
                for (int r = 0; r < RGRP; ++r) s[r][q] = ac[r][0] + ac[r][1];
                LN1_SB();
            }
            float u[RGRP];
#pragma unroll
            for (int r = 0; r < RGRP; ++r) {
                const float tA = (b5 ? s[r][2] : s[r][0]) + __shfl_xor(b5 ? s[r][0] : s[r][2], 32, 64);
                const float tB = (b5 ? s[r][3] : s[r][1]) + __shfl_xor(b5 ? s[r][1] : s[r][3], 32, 64);
                u[r] = (b4 ? tB : tA) + __shfl_xor(b4 ? tA : tB, 16, 64);
            }
#if RGRP == 4
            const float pA = (b3 ? u[2] : u[0]) + __shfl_xor(b3 ? u[0] : u[2], 8, 64);
            const float pB = (b3 ? u[3] : u[1]) + __shfl_xor(b3 ? u[1] : u[3], 8, 64);
            float z = (b2 ? pB : pA) + __shfl_xor(b2 ? pA : pB, 4, 64);
#else
            float z = (b3 ? u[1] : u[0]) + __shfl_xor(b3 ? u[0] : u[1], 8, 64);
            z += __shfl_xor(z, 4, 64);
#endif
            z += __shfl_xor(z, 2, 64); z += __shfl_xor(z, 1, 64);
            lgk0 = (eg == 0) ? z : lgk0; lgk1 = (eg == 1) ? z : lgk1; lgk2 = (eg == 2) ? z : lgk2; lgk3 = (eg == 3) ? z : lgk3;
        }
#if RGRP == 4
        {
            const int rr_ = lane >> 4, ee = lane & 15, qq = ee & 3, gg = ee >> 2;
            const int src = ((qq >> 1) * 32) + ((qq & 1) * 16) + (rr_ >> 1) * 8 + (rr_ & 1) * 4;
            const float c0 = __shfl(lgk0, src, 64), c1 = __shfl(lgk1, src, 64), c2 = __shfl(lgk2, src, 64), c3 = __shfl(lgk3, src, 64);
            const float lgt = gg == 0 ? c0 : gg == 1 ? c1 : gg == 2 ? c2 : c3;
            float mx = lgt;
#pragma unroll
            for (int o = 8; o > 0; o >>= 1) mx = fmaxf(mx, __shfl_xor(mx, o, 64));
            const float ex = expf(lgt - mx);
            float sum = ex;
#pragma unroll
            for (int o = 8; o > 0; o >>= 1) sum += __shfl_xor(sum, o, 64);
            const float sc = ex * (1.0f / sum);
            const float sel = sc + p.router_bias[ee];
            int rank = 0;
#pragma unroll
            for (int j = 1; j < 4; ++j) { const float o = __shfl_xor(sel, j, 64); rank += (o > sel || (o == sel && (ee ^ j) < ee)) ? 1 : 0; }
            const float top2 = rank < 2 ? sel : 0.f;
            float gs = top2 + __shfl_xor(top2, 1, 64); gs += __shfl_xor(gs, 2, 64);
            int grank = 0;
#pragma unroll
            for (int j = 1; j < 4; ++j) { const float o = __shfl_xor(gs, 4 * j, 64); grank += (o > gs || (o == gs && (gg ^ j) < gg)) ? 1 : 0; }
            const unsigned long long m0 = __ballot(grank == 0 && rank == 0), m1 = __ballot(grank == 0 && rank == 1);
            const int myr = lane & 3;
            const int bi0 = __builtin_ctz(((unsigned)(m0 >> (16 * myr)) & 0xffffu) | 0x10000u), bi1 = __builtin_ctz(((unsigned)(m1 >> (16 * myr)) & 0xffffu) | 0x10000u);
            const float bw0 = __shfl(sc, myr * 16 + (bi0 & 15), 64), bw1 = __shfl(sc, myr * 16 + (bi1 & 15), 64);
            if (lane < 4) {
                const int n = n0 + lane;
                const float ws_ = 1.0f / (bw0 + bw1);
                const int p0 = __hip_atomic_fetch_add(&lcnt[bi0], 1, __ATOMIC_RELAXED, __HIP_MEMORY_SCOPE_WORKGROUP), p1 = __hip_atomic_fetch_add(&lcnt[bi1], 1, __ATOMIC_RELAXED, __HIP_MEMORY_SCOPE_WORKGROUP);
                int* rr = route + (size_t)n * 8;
                rr[0] = bi0; rr[1] = bi1; rr[2] = (int)p0; rr[3] = (int)p1; rr[4] = __float_as_int(bw0 * ws_); rr[5] = __float_as_int(bw1 * ws_);
            }
        }
#else
#pragma unroll 1
        for (int r = 0; r < RGRP; ++r) {
            const int n = n0 + r;
            const int rl = (RGRP == 4) ? (r >> 1) * 8 + (r & 1) * 4 : r * 8;
            float lg[16];
#pragma unroll
            for (int q = 0; q < 4; ++q) {
                const int src = ((q >> 1) * 32) + ((q & 1) * 16) + rl;
                lg[0 + q] = __int_as_float(__builtin_amdgcn_readlane(__float_as_int(lgk0), src));
                lg[4 + q] = __int_as_float(__builtin_amdgcn_readlane(__float_as_int(lgk1), src));
                lg[8 + q] = __int_as_float(__builtin_amdgcn_readlane(__float_as_int(lgk2), src));
                lg[12 + q] = __int_as_float(__builtin_amdgcn_readlane(__float_as_int(lgk3), src));
            }
            float mx = lg[0];
#pragma unroll
            for (int e = 1; e < 16; ++e) mx = fmaxf(mx, lg[e]);
            float sc[16], sum = 0.f;
#pragma unroll
            for (int e = 0; e < 16; ++e) { sc[e] = expf(lg[e] - mx); sum += sc[e]; }
            const float inv = 1.0f / sum;
            float sel[16];
#pragma unroll
            for (int e = 0; e < 16; ++e) { sc[e] *= inv; sel[e] = sc[e] + p.router_bias[e]; }
            float best_gs = -3.0e38f; int bi0 = 0, bi1 = 1; float bw0 = 0.f, bw1 = 0.f;
#pragma unroll
            for (int g = 0; g < 4; ++g) {
                int i0 = 0; float m0 = sel[4 * g];
#pragma unroll
                for (int j = 1; j < 4; ++j) if (sel[4 * g + j] > m0) { m0 = sel[4 * g + j]; i0 = j; }
                int i1 = -1; float m1 = -3.0e38f;
#pragma unroll
                for (int j = 0; j < 4; ++j) if (j != i0 && sel[4 * g + j] > m1) { m1 = sel[4 * g + j]; i1 = j; }
                float w0 = 0.f, w1 = 0.f;
#pragma unroll
                for (int j = 0; j < 4; ++j) { w0 = (j == i0) ? sc[4 * g + j] : w0; w1 = (j == i1) ? sc[4 * g + j] : w1; }
                const float gs = m0 + m1;
                if (gs > best_gs) { best_gs = gs; bi0 = 4 * g + i0; bi1 = 4 * g + i1; bw0 = w0; bw1 = w1; }
            }
            if (lane == 0) {
                const float ws_ = 1.0f / (bw0 + bw1);
                const int p0 = __hip_atomic_fetch_add(&lcnt[bi0], 1, __ATOMIC_RELAXED, __HIP_MEMORY_SCOPE_WORKGROUP), p1 = __hip_atomic_fetch_add(&lcnt[bi1], 1, __ATOMIC_RELAXED, __HIP_MEMORY_SCOPE_WORKGROUP);
                int* rr = route + (size_t)n * 8;
                rr[0] = bi0; rr[1] = bi1; rr[2] = (int)p0; rr[3] = (int)p1; rr[4] = __float_as_int(bw0 * ws_); rr[5] = __float_as_int(bw1 * ws_);
            }
        }
#endif
    }
    __syncthreads();
    if (tid < 16) ((int*)(p.ws + WS_WGCNT))[((size_t)l * 1024 + blockIdx.x) * 16 + tid] = lcnt[tid];
}

__device__ __forceinline__ void build_moe_tab(const Params& p, int l, LAS int* tab) {
    if (threadIdx.x == 0) {
        const unsigned* cnt = (const unsigned*)(p.ws + WS_CNT) + l * 16;
        int acc = 0;
        for (int e = 0; e < 16; ++e) { tab[e] = acc; acc += (int)((cnt[e] + 255u) >> 8); }
        tab[16] = acc;
    }
    __syncthreads();
}

__device__ __forceinline__ void phase_permute(const Params& p, int l, LAS int* tab) {
    int tid_ = threadIdx.x; asm volatile("" : "+v"(tid_)); const int wave = __builtin_amdgcn_readfirstlane(tid_ >> 6), lane = tid_ & 63;
    LAS int* base = tab + 32; LAS int* total = tab + 48;
    if (tid_ < 16) { base[tid_] = 0; total[tid_] = 0; }
    __syncthreads();
    {
        const int* wgc = (const int*)(p.ws + WS_WGCNT) + (size_t)l * 1024 * 16;
        const int e = tid_ & 15; int bs = 0, tt = 0;
        for (int w = tid_ >> 4; w < (int)gridDim.x; w += 32) { const int v = wgc[w * 16 + e]; tt += v; bs += (w < (int)blockIdx.x) ? v : 0; }
        __hip_atomic_fetch_add(&base[e], bs, __ATOMIC_RELAXED, __HIP_MEMORY_SCOPE_WORKGROUP);
        __hip_atomic_fetch_add(&total[e], tt, __ATOMIC_RELAXED, __HIP_MEMORY_SCOPE_WORKGROUP);
    }
    __syncthreads();
    if (tid_ == 0) { int acc = 0; for (int e = 0; e < 16; ++e) { tab[e] = acc; acc += (total[e] + 255) >> 8; } tab[16] = acc; }
    if (blockIdx.x == 0 && tid_ < 16) ((unsigned*)(p.ws + WS_CNT))[l * 16 + tid_] = (unsigned)total[tid_];
    __syncthreads();
#if MOE_FP8
    for (int i = blockIdx.x * 512 + tid_; i < XE_ROWS * 8; i += gridDim.x * 512) *(u32x4*)(p.ws + WS_HID + (size_t)(i >> 3) * DEP + DE + (i & 7) * 16) = (u32x4){0u, 0u, 0u, 0u};
#endif
    int* route = (int*)(p.ws + WS_ROUTE);
    const bf16_t* hb = (const bf16_t*)(p.ws + WS_HB);
    bf16_t* xe = (bf16_t*)(p.ws + WS_XE);
    for (int m = (blockIdx.x * 8 + wave) * RGRP; m < T; m += gridDim.x * 8 * RGRP)
#pragma unroll 1
    for (int n = m; n < m + RGRP; ++n) {
        int* r = route + (size_t)n * 8;
        const int e0 = r[0], e1 = r[1], p0 = r[2], p1 = r[3];
        const int row0 = tab[e0] * 256 + base[e0] + p0, row1 = tab[e1] * 256 + base[e1] + p1;
        constexpr int RB = MOE_FP8 ? D : 2 * D;
        const u32x4* src = (const u32x4*)((const unsigned char*)hb + (size_t)n * RB);
        u32x4* d0 = (u32x4*)((unsigned char*)xe + (size_t)row0 * RB); u32x4* d1 = (u32x4*)((unsigned char*)xe + (size_t)row1 * RB);
#pragma unroll
        for (int i = 0; i < RB / 1024; ++i) { const u32x4 v = src[i * 64 + lane]; d0[i * 64 + lane] = v; d1[i * 64 + lane] = v; }
        if (lane == 0) { r[6] = row0; r[7] = row1; }
    }
}

#define LN2_RG 2
#define LN2_SB() __builtin_amdgcn_sched_barrier(0)
__device__ __forceinline__ void phase_ln2(const Params& p, int l) {
    int tid_ = threadIdx.x; asm volatile("" : "+v"(tid_)); const int wave = __builtin_amdgcn_readfirstlane(tid_ >> 6), lane = tid_ & 63;
    const float* mod = (const float*)(p.ws + WS_MOD);
    const float* ye = (const float*)(p.ws + WS_YE);
    float* xres = (float*)(p.ws + WS_XRES);
    const int* route = (const int*)(p.ws + WS_ROUTE);
    const int lane_ = lane;
    for (int n0 = (blockIdx.x * 8 + wave) * LN2_RG; n0 < T; n0 += gridDim.x * 8 * LN2_RG) {
        int lane = lane_; asm volatile("" : "+v"(lane));
        const int b = n0 / SEQ;
        const float* mb = mod + ((size_t)l * 4 + b) * (6 * D);
        float w0[LN2_RG], w1[LN2_RG]; const bf16_t* y0[LN2_RG]; const bf16_t* y1[LN2_RG];
#pragma unroll
        for (int r = 0; r < LN2_RG; ++r) {
            const int* rr = route + (size_t)(n0 + r) * 8;
            w0[r] = __int_as_float(__builtin_amdgcn_readfirstlane(rr[4])); w1[r] = __int_as_float(__builtin_amdgcn_readfirstlane(rr[5]));
            y0[r] = (const bf16_t*)ye + (size_t)__builtin_amdgcn_readfirstlane(rr[6]) * D; y1[r] = (const bf16_t*)ye + (size_t)__builtin_amdgcn_readfirstlane(rr[7]) * D;
        }
        float4 v[LN2_RG][8];
#pragma unroll
        for (int i = 0; i < 4; ++i) {
            float4 g[2];
#pragma unroll
            for (int q = 0; q < 2; ++q) g[q] = *(const float4*)(mb + 5 * D + COLK(2 * i + q));
#pragma unroll
            for (int rp = 0; rp < LN2_RG; rp += 2) {
                float4 xv[2][2], a[2][2], c[2][2];
#pragma unroll
                for (int r = 0; r < 2; ++r) { ld_bf8((const bf16_t*)xres + (size_t)(n0 + rp + r) * D + COL8(i), xv[r][0], xv[r][1]); ld_bf8(y0[rp + r] + COL8(i), a[r][0], a[r][1]); ld_bf8(y1[rp + r] + COL8(i), c[r][0], c[r][1]); }
#pragma unroll
                for (int q = 0; q < 2; ++q)
#pragma unroll
                    for (int r = 0; r < 2; ++r)
                        v[rp + r][2 * i + q] = make_float4(ALPHA * xv[r][q].x + (1.f + g[q].x) * (w0[rp + r] * a[r][q].x + w1[rp + r] * c[r][q].x), ALPHA * xv[r][q].y + (1.f + g[q].y) * (w0[rp + r] * a[r][q].y + w1[rp + r] * c[r][q].y),
                                                           ALPHA * xv[r][q].z + (1.f + g[q].z) * (w0[rp + r] * a[r][q].z + w1[rp + r] * c[r][q].z), ALPHA * xv[r][q].w + (1.f + g[q].w) * (w0[rp + r] * a[r][q].w + w1[rp + r] * c[r][q].w));
                LN2_SB();
            }
        }
        float mean[LN2_RG], rstd[LN2_RG];
#pragma unroll
        for (int r = 0; r < LN2_RG; ++r) {
            float s0 = 0.f;
#pragma unroll
            for (int i = 0; i < 8; ++i) s0 += (v[r][i].x + v[r][i].y) + (v[r][i].z + v[r][i].w);
            mean[r] = s0;
        }
#pragma unroll
        for (int o = 32; o > 0; o >>= 1)
#pragma unroll
            for (int r = 0; r < LN2_RG; ++r) mean[r] += __shfl_xor(mean[r], o, 64);
#pragma unroll
        for (int r = 0; r < LN2_RG; ++r) {
            mean[r] *= (1.0f / D);
            float q0 = 0.f;
#pragma unroll
            for (int i = 0; i < 8; ++i) { const float aa = v[r][i].x - mean[r], bb = v[r][i].y - mean[r], cc = v[r][i].z - mean[r], dd = v[r][i].w - mean[r]; q0 += (aa * aa + bb * bb) + (cc * cc + dd * dd); }
            rstd[r] = q0;
        }
#pragma unroll
        for (int o = 32; o > 0; o >>= 1)
#pragma unroll
            for (int r = 0; r < LN2_RG; ++r) rstd[r] += __shfl_xor(rstd[r], o, 64);
#pragma unroll
        for (int r = 0; r < LN2_RG; ++r) rstd[r] = rsqrtf(rstd[r] * (1.0f / D) + 1e-5f);
        const float* lg_ = p.ln_g + (size_t)(l * 2 + 1) * D; const float* lb_ = p.ln_b + (size_t)(l * 2 + 1) * D;
        LN2_SB();
#pragma unroll
        for (int i = 0; i < 8; ++i) {
            const float4 gv = *(const float4*)(lg_ + COLK(i)), bv = *(const float4*)(lb_ + COLK(i));
#pragma unroll
            for (int r = 0; r < LN2_RG; ++r) {
                float4& x = v[r][i];
                x.x = (x.x - mean[r]) * rstd[r] * gv.x + bv.x; x.y = (x.y - mean[r]) * rstd[r] * gv.y + bv.y;
                x.z = (x.z - mean[r]) * rstd[r] * gv.z + bv.z; x.w = (x.w - mean[r]) * rstd[r] * gv.w + bv.w;
            }
            if (i & 1) LN2_SB();
        }
        if (l + 1 < DEPTH) {
#pragma unroll
            for (int r = 0; r < LN2_RG; ++r)
#pragma unroll
                for (int i = 0; i < 4; ++i) st_bf8((bf16_t*)xres + (size_t)(n0 + r) * D + COL8(i), v[r][2 * i], v[r][2 * i + 1]);
            const float* mn = mod + ((size_t)(l + 1) * 4 + b) * (6 * D);
            LN2_SB();
#pragma unroll
            for (int i = 0; i < 4; ++i) {
                float4 sh[2], sc[2];
#pragma unroll
                for (int q = 0; q < 2; ++q) { sh[q] = *(const float4*)(mn + COLK(2 * i + q)); sc[q] = *(const float4*)(mn + D + COLK(2 * i + q)); }
#pragma unroll
                for (int r = 0; r < LN2_RG; ++r) {
                    float4 h[2];
#pragma unroll
                    for (int q = 0; q < 2; ++q) { const float4 x = v[r][2 * i + q]; h[q] = make_float4(x.x * (1.f + sc[q].x) + sh[q].x, x.y * (1.f + sc[q].y) + sh[q].y, x.z * (1.f + sc[q].z) + sh[q].z, x.w * (1.f + sc[q].w) + sh[q].w); }
                    if (INP8(l + 1)) st_fp8x8(p.ws + WS_HA + (size_t)(n0 + r) * D + COL8(i), h[0], h[1]);
                    else st_bf8((bf16_t*)(p.ws + WS_HA) + (size_t)(n0 + r) * D + COL8(i), h[0], h[1]);
                }
                LN2_SB();
            }
        } else {
#pragma unroll
            for (int r = 0; r < LN2_RG; ++r)
#pragma unroll
                for (int i = 0; i < 8; ++i) *(float4*)(p.out + (size_t)(n0 + r) * D + COLK(i)) = v[r][i];
        }
    }
}

typedef const __attribute__((address_space(4))) unsigned char* KargPtr;
__device__ __forceinline__ Params load_params(KargPtr q) { asm volatile("" : "+s"(q)); Params lp; __builtin_memcpy(&lp, (const __attribute__((address_space(4))) unsigned long long*)q, sizeof(Params)); return lp; }

__global__ __launch_bounds__(512, 2) void mega(Params p_in) {
    extern __shared__ __attribute__((aligned(16))) unsigned char smem[];
    LAS unsigned char* lds = (LAS unsigned char*)smem;
    LAS int* tab = (LAS int*)(lds + LDS_MISC + 64);
    KargPtr kp = (KargPtr)__builtin_amdgcn_kernarg_segment_ptr();
    if (threadIdx.x == 0) { *(LAS u32x4*)(lds + LDS_MISC) = (u32x4){0u, 0u, 0u, 0u}; *(LAS u32x4*)(lds + LDS_MISC + 768) = (u32x4){0u, 0u, 0u, 0u}; *(LAS u32x4*)(lds + LDS_MISC + 784) = (u32x4){0u, 0u, 0u, 0u}; }
    __syncthreads();
    const int fused = p_in.fused, ph_lo = p_in.ph_lo, ph_hi = p_in.ph_hi, l_hi = p_in.l_hi;
    XcdBarrier bar;
    if (fused) bar = xcd_barrier_post((unsigned*)(p_in.ws + WS_BAR), (volatile LAS unsigned*)(lds + LDS_MISC));
    else { bar.bar = (unsigned*)(p_in.ws + WS_BAR); bar.x = 0; bar.st = (volatile LAS unsigned*)(lds + LDS_MISC); }
#ifdef ONLY_PH
#define PH(i) ((i) == ONLY_PH && ph_lo <= (i) && (i) < ph_hi)
#else
#define PH(i) (ph_lo <= (i) && (i) < ph_hi)
#endif
#ifdef PROBE_PH
#define SYNC_PLAIN() do { if (fused) xcd_barrier(bar); } while (0)
#define PSTART(i) do { if ((i) == PROBE_PH && blockIdx.x == 0 && threadIdx.x == 0) { *(LAS unsigned long long*)(lds + LDS_MISC + 768) = __builtin_amdgcn_s_memrealtime(); } } while (0)
#define PSTOP(i) do { if ((i) == PROBE_PH && blockIdx.x == 0 && threadIdx.x == 0) { *(LAS unsigned long long*)(lds + LDS_MISC + 776) += __builtin_amdgcn_s_memrealtime() - *(LAS unsigned long long*)(lds + LDS_MISC + 768); } } while (0)
#else
#define PSTART(i) do { } while (0)
#define PSTOP(i) do { } while (0)
#endif
#if defined(PROBE_PH) && defined(PROBE_SUB)
#define QSTART(i, k) do { if ((i) == PROBE_PH && (k) == PROBE_SUB && blockIdx.x == PROBE_WG && threadIdx.x == 0) { *(LAS unsigned long long*)(lds + LDS_MISC + 784) = __builtin_amdgcn_s_memrealtime(); } } while (0)
#define QSTOP(i, k) do { if ((i) == PROBE_PH && (k) == PROBE_SUB && blockIdx.x == PROBE_WG && threadIdx.x == 0) { *(LAS unsigned long long*)(lds + LDS_MISC + 792) += __builtin_amdgcn_s_memrealtime() - *(LAS unsigned long long*)(lds + LDS_MISC + 784); } } while (0)
#else
#define QSTART(i, k) do { } while (0)
#define QSTOP(i, k) do { } while (0)
#endif
#define SYNC() do { if (fused) xcd_barrier(bar); } while (0)
#ifndef DUP_MASK
#define DUP_MASK 0
#endif
#define REP(i) _Pragma("unroll 1") for (int rep_ = 0; rep_ < 1 + ((DUP_MASK >> (i)) & 1); ++rep_)
    const int G = gridDim.x, c = blockIdx.x;
    if (PH(0)) REP(0) { PSTART(0); const Params p = load_params(kp); phase_prologue(p, lds); SYNC(); PSTOP(0); }
    if (PH(1)) REP(1) { PSTART(1); const Params p = load_params(kp); phase_ln0(p); SYNC(); PSTOP(1); }
    for (int l = p_in.l_lo; l < l_hi; ++l) {
        const bool svc = (l == 0) && (G >= 256);
        if (PH(2)) REP(2) { PSTART(2);
            const Params p = load_params(kp);
            pg8::Gemm g{(const bf16_t*)(p.ws + WS_HA), (const bf16_t*)(p.ws + WS_WIN) + (size_t)l * INC * D, D};
            pg8::EpiBf16 E{(bf16_t*)(p.ws + WS_PROJ), INC};
            if (svc) {
                if (c < 240) {
                    pg8::DenseOrder<32, 30> S; S.init(INP8(0) ? D : 2 * D, 240, c);
                    if (INP8(0)) pg8::gemm_phase<pg8::EpiBf16, pg8::DenseOrder<32, 30>, true>(lds, g, S, E, 121, 127);
                    else pg8::gemm_phase(lds, g, S, E);
                } else ada_chunks(p, lds, 128 + (c - 240), 256, 16);
                tail_pull(p, lds, l * 4 + 0);
            } else {
                pg8::DenseOrder<32, 32> S; S.init(INP8(l) ? D : 2 * D, G, c);
                if (INP8(l)) pg8::gemm_phase<pg8::EpiBf16, pg8::DenseOrder<32, 32>, true>(lds, g, S, E, 121, 127);
                else pg8::gemm_phase(lds, g, S, E);
            }
            SYNC(); PSTOP(2);
        }
#ifdef MIXER_CHECK
        if (PH(3)) REP(3) { PSTART(3); const Params p = load_params(kp); phase_mixer_valu(p, l, lds); SYNC(); PSTOP(3); }
        if (PH(3)) REP(3) { PSTART(3); const Params p = load_params(kp); phase_mixer_mfma<0>(p, l, lds, (float*)(p.ws + WS_XE)); SYNC(); PSTOP(3); }
        if (PH(3)) REP(3) { PSTART(3); const Params p = load_params(kp); phase_mixer_check(p, (const float*)(p.ws + WS_OBUF), (const float*)(p.ws + WS_XE), (float*)(p.ws + WS_CNT + 1024) + l * 8); SYNC(); PSTOP(3); }
#else
        if (PH(3)) REP(3) { PSTART(3);
            const Params p = load_params(kp);
            const int n_extra = svc ? 96 : 32, pn0 = svc ? 30 : 32;
            for (int uu = (G >= 224 ? c - 192 : c); uu >= 0 && uu < n_extra; uu += (G >= 224 ? 64 : G)) {
                const int RBI = INP8(l) ? D : 2 * D;
                pg8::OneUnit S; S.u0.aB = (size_t)(uu & 31) * 256 * RBI; S.u0.bB = (size_t)(pn0 + (uu >> 5)) * 256 * RBI; S.u0.row0 = (uu & 31) * 256; S.u0.col0 = (pn0 + (uu >> 5)) * 256;
                pg8::EpiBf16 E{(bf16_t*)(p.ws + WS_PROJ), INC};
                pg8::Gemm g{(const bf16_t*)(p.ws + WS_HA), (const bf16_t*)(p.ws + WS_WIN) + (size_t)l * INC * D, D};
                if (INP8(l)) pg8::gemm_phase<pg8::EpiBf16, pg8::OneUnit, true>(lds, g, S, E, 121, 127);
                else pg8::gemm_phase(lds, g, S, E);
            }
            phase_mixer_mfma<0>(p, l, lds, (float*)(p.ws + WS_OBUF));
            tail_pull(p, lds, l * 4 + 1);
            SYNC(); PSTOP(3);
#ifdef MIXER_PROBE
            phase_mixer_mfma<MIXER_PROBE>(p, l, lds, (float*)(p.ws + WS_XE));
            SYNC(); PSTOP(3);
#endif
        }
#endif
        if (PH(4)) REP(4) { PSTART(4); const Params p = load_params(kp); phase_finalize(p, l); SYNC(); PSTOP(4); }
        if (PH(5)) REP(5) { PSTART(5);
            const Params p = load_params(kp);
            pg8::DenseOrder<32, 8> S; S.init(OUT8(l) ? D : 2 * D, G, c);
            pg8::Gemm g{(const bf16_t*)(p.ws + WS_MIXED), (const bf16_t*)(p.ws + WS_WOUT) + (size_t)l * D * D, D};
            pg8::EpiBf16 E{(bf16_t*)(p.ws + WS_Y), D};
            if (OUT8(l)) pg8::gemm_phase<pg8::EpiBf16, pg8::DenseOrder<32, 8>, true>(lds, g, S, E, 121, 125);
            else pg8::gemm_phase(lds, g, S, E);
            SYNC(); PSTOP(5);
        }
        if (PH(6)) REP(6) { PSTART(6); const Params p = load_params(kp); phase_ln1_router(p, l, lds); SYNC(); PSTOP(6); }
        if (PH(7)) REP(7) { PSTART(7); const Params p = load_params(kp); phase_permute(p, l, tab); cvt_pull(p, lds, l * CV_PER_L + CV_A1, nullptr, 0u); SYNC(); PSTOP(7); }
        if (PH(8)) REP(8) { PSTART(8);
            const Params p = load_params(kp);
            build_moe_tab(p, l, tab);
#if MOE_FP8
            pg8::MoeOrder S; S.tab = tab; S.NTn = 11; S.G = G; S.c = c; S.tstep = (size_t)256 * D; S.bexp = (size_t)2 * DE * D;
            pg8::Gemm g{(const bf16_t*)(p.ws + WS_XE), (const bf16_t*)(p.ws + WS_WGU + (size_t)l * NE * 2 * DE * D), D};
            pg8::EpiHidden8 E{p.ws + WS_HID};
            QSTART(8, 1); pg8::gemm_phase<pg8::EpiHidden8, pg8::MoeOrder, true>(lds, g, S, E, 121, 127); QSTOP(8, 1);
#else
            pg8::MoeOrder S; S.tab = tab; S.NTn = 11; S.G = G; S.c = c; S.tstep = (size_t)256 * D * 2; S.bexp = (size_t)2 * DE * D * 2;
            pg8::Gemm g{(const bf16_t*)(p.ws + WS_XE), (const bf16_t*)(p.ws + WS_WGU) + (size_t)l * NE * 2 * DE * D, D};
            pg8::EpiHidden E{(bf16_t*)(p.ws + WS_HID)};
            pg8::gemm_phase(lds, g, S, E);
#endif
            QSTART(8, 2); tail_pull(p, lds, l * 4 + 2); QSTOP(8, 2);
            QSTART(8, 3); cvt_pull(p, lds, (l + 1) * CV_PER_L, nullptr, 0u); QSTOP(8, 3);
            SYNC(); PSTOP(8);
        }
        if (PH(9)) REP(9) { PSTART(9);
            const Params p = load_params(kp);
            build_moe_tab(p, l, tab);
#if MOE_FP8
            pg8::MoeOrder S; S.tab = tab; S.NTn = 8; S.G = G; S.c = c; S.tstep = (size_t)256 * DEP; S.bexp = (size_t)D * DEP;
            pg8::Gemm g{(const bf16_t*)(p.ws + WS_HID), (const bf16_t*)(p.ws + WS_WD + (size_t)l * NE * D * DEP), DEP};
            pg8::EpiBf16 E{(bf16_t*)(p.ws + WS_YE), D};
            QSTART(9, 1); pg8::gemm_phase<pg8::EpiBf16, pg8::MoeOrder, true>(lds, g, S, E, 121, 124); QSTOP(9, 1);
#else
            pg8::MoeOrder S; S.tab = tab; S.NTn = 8; S.G = G; S.c = c; S.tstep = (size_t)256 * DE * 2; S.bexp = (size_t)D * DE * 2;
            pg8::Gemm g{(const bf16_t*)(p.ws + WS_HID), (const bf16_t*)(p.ws + WS_WD) + (size_t)l * NE * D * DE, DE};
            pg8::EpiBf16 E{(bf16_t*)(p.ws + WS_YE), D};
            pg8::gemm_phase(lds, g, S, E);
#endif
            QSTART(9, 2); tail_pull(p, lds, l * 4 + 3); QSTOP(9, 2);
            QSTART(9, 3); if (l + 1 < DEPTH) cvt_pull(p, lds, (l + 1) * CV_PER_L + CV_A0, nullptr, 0u); QSTOP(9, 3);
            SYNC(); PSTOP(9);
        }
        if (PH(10)) REP(10) { PSTART(10); const Params p = load_params(kp); phase_ln2(p, l); SYNC(); PSTOP(10); }
    }
#ifdef PROBE_PH
    if (blockIdx.x == 0 && threadIdx.x == 0) {
#ifdef PROBE_SUB
        const unsigned long long t = 0ull, t0 = __builtin_amdgcn_s_memrealtime();
#else
        const unsigned long long t = *(LAS unsigned long long*)(lds + LDS_MISC + 776) * 4ull, t0 = __builtin_amdgcn_s_memrealtime();
#endif
        while (__builtin_amdgcn_s_memrealtime() - t0 < t) __builtin_amdgcn_s_sleep(8);
    }
#ifdef PROBE_SUB
    if (blockIdx.x == PROBE_WG && threadIdx.x == 0) {
        const unsigned long long t = *(LAS unsigned long long*)(lds + LDS_MISC + 792) * 4ull, t0 = __builtin_amdgcn_s_memrealtime();
        while (__builtin_amdgcn_s_memrealtime() - t0 < t) __builtin_amdgcn_s_sleep(8);
    }
#endif
#endif
}

#ifndef MK_FUSED
#define MK_FUSED 1
#endif
extern "C" void kernel_launch(void* const* d_in, const int* in_sizes, int n_in, void* d_out, int out_size, void* d_ws, size_t ws_size, hipStream_t stream) {
    static int grid = 0;
    if (grid == 0) {
        if (n_in != 18 || ws_size < WS_END) { fprintf(stderr, "kernel_launch: unexpected n_in %d or ws_size %zu (< %zu)\n", n_in, ws_size, (size_t)WS_END); grid = -1; return; }
        int dev = 0, cus = 0, per_cu = 0;
        hipGetDevice(&dev);
        hipDeviceGetAttribute(&cus, hipDeviceAttributeMultiprocessorCount, dev);
        if (hipFuncSetAttribute((const void*)mega, hipFuncAttributeMaxDynamicSharedMemorySize, LDS_BYTES) != hipSuccess) { fprintf(stderr, "kernel_launch: hipFuncSetAttribute failed\n"); grid = -1; return; }
        hipOccupancyMaxActiveBlocksPerMultiprocessor(&per_cu, (const void*)mega, 512, LDS_BYTES);
        if (per_cu < 1) fprintf(stderr, "kernel_launch: occupancy query says %d\n", per_cu);
        grid = cus > 0 ? cus : 256;
    }
    if (grid < 0) return;
    hipMemsetAsync(d_ws, 0, WS_ZERO_BYTES, stream);
    Params p{};
    p.x = (const float*)d_in[0]; p.c = (const float*)d_in[1]; p.emb_g = (const float*)d_in[2]; p.emb_b = (const float*)d_in[3];
    p.w_ada = (const float*)d_in[4]; p.b_ada = (const float*)d_in[5]; p.w_in = (const float*)d_in[6]; p.conv_w = (const float*)d_in[7];
    p.mix_beta = (const float*)d_in[8]; p.w_out = (const float*)d_in[9]; p.lb_logits = (const float*)d_in[10]; p.ln_g = (const float*)d_in[11];
    p.ln_b = (const float*)d_in[12]; p.w_router = (const float*)d_in[13]; p.router_bias = (const float*)d_in[14]; p.w_gate = (const float*)d_in[15];
    p.w_up = (const float*)d_in[16]; p.w_down = (const float*)d_in[17];
    p.out = (float*)d_out; p.ws = (unsigned char*)d_ws; p.pad = 0;
#if MK_FUSED
    p.ph_lo = 0; p.ph_hi = 11; p.l_lo = 0; p.l_hi = DEPTH; p.fused = 1;
    hipLaunchKernelGGL(mega, dim3(grid), dim3(512), LDS_BYTES, stream, p);
#else
    p.fused = 0;
    for (int ph = 0; ph < 2; ++ph) { p.ph_lo = ph; p.ph_hi = ph + 1; p.l_lo = 0; p.l_hi = 0; hipLaunchKernelGGL(mega, dim3(grid), dim3(512), LDS_BYTES, stream, p); }
    for (int l = 0; l < DEPTH; ++l)
        for (int ph = 2; ph < 11; ++ph) { p.ph_lo = ph; p.ph_hi = ph + 1; p.l_lo = l; p.l_hi = l + 1; hipLaunchKernelGGL(mega, dim3(grid), dim3(512), LDS_BYTES, stream, p); }
#endif
}
```

```cpp
#include <hip/hip_runtime.h>
#include <stdint.h>
#include <stdio.h>

#define LAS __attribute__((address_space(3)))
typedef unsigned short bf16_t;
typedef short bf16x8 __attribute__((ext_vector_type(8)));
typedef float f32x4 __attribute__((ext_vector_type(4)));
typedef unsigned u32x4 __attribute__((ext_vector_type(4)));
typedef unsigned u32x2 __attribute__((ext_vector_type(2)));

constexpr int D = 2048, NB = 4, SEQ = 2048, T = NB * SEQ, DEPTH = 2;
constexpr int CW = 512, RW = 768, HWD = 768, INC = 8448;
constexpr int NE = 16, DE = 1408;
constexpr int C_CB = 0, C_CC = 512, C_CH = 1024, C_RQ = 1536, C_RK = 2304, C_RV = 3072, C_RG = 3840, C_HQ = 4608, C_HFF = 5376, C_HFB = 6144, C_HI = 6912, C_HG = 7680;
constexpr int XE_ROWS = 20480;
#ifndef MOE_FP8
#define MOE_FP8 1
#endif
#ifndef MK_FUSED
#define MK_FUSED 1
#endif
#ifndef INP_FP8_FROM
#define INP_FP8_FROM 1
#endif
#define INP8(l) ((l) >= INP_FP8_FROM)
#ifndef OUT_FP8_FROM
#define OUT_FP8_FROM 0
#endif
#define OUT8(l) ((l) >= OUT_FP8_FROM)
constexpr int DEP = 1536;
constexpr float W8_SCALE = 64.f, H8_SCALE = 8.f;
constexpr float ALPHA = 1.4142135623730951f;

constexpr size_t WS_BAR = 0;
constexpr size_t WS_CNT = 16384;
constexpr size_t WS_CVTQ = 20480;
constexpr size_t WS_ZERO_BYTES = 32768;
constexpr size_t WS_MOD = 32768;
constexpr size_t WS_ROUTE = WS_MOD + 393216;
constexpr size_t WS_WGCNT = WS_ROUTE + 262144;
constexpr size_t WS_WRT = WS_WGCNT + 131072;
constexpr size_t WS_WIN = 1048576;
constexpr size_t SZ_WIN = (size_t)DEPTH * INC * D * 2;
constexpr size_t WS_WOUT = WS_WIN + SZ_WIN;
constexpr size_t SZ_WOUT = (size_t)DEPTH * D * D * 2;
constexpr size_t WS_WGU = WS_WOUT + SZ_WOUT;
constexpr size_t SZ_WGU = (size_t)DEPTH * NE * 2 * DE * D * 2;
constexpr size_t WS_WD = WS_WGU + SZ_WGU;
constexpr size_t SZ_WD = (size_t)DEPTH * NE * D * DE * 2;
constexpr size_t WS_XRES = WS_WD + SZ_WD;
constexpr size_t SZ_XRES = (size_t)T * D * 4;
constexpr size_t WS_HA = WS_XRES + SZ_XRES;
constexpr size_t SZ_H = (size_t)T * D * 2;
constexpr size_t WS_HB = WS_HA + SZ_H;
constexpr size_t WS_PROJ = WS_HB + SZ_H;
constexpr size_t SZ_PROJ = (size_t)T * INC * 2;
constexpr size_t WS_OBUF = WS_PROJ + SZ_PROJ;
constexpr size_t SZ_OBUF = (size_t)2 * T * 1536 * 4;
constexpr size_t WS_YE = WS_PROJ;
constexpr size_t SZ_YE = (size_t)XE_ROWS * D * 4;
static_assert(SZ_YE <= SZ_PROJ + SZ_OBUF, "ye alias");
constexpr size_t WS_MIXED = WS_OBUF + SZ_OBUF;
constexpr size_t WS_Y = WS_MIXED + SZ_H;
constexpr size_t SZ_Y = (size_t)T * D * 4;
constexpr size_t WS_XE = WS_Y + SZ_Y;
constexpr size_t SZ_XE = (size_t)XE_ROWS * D * 2;
constexpr size_t WS_HID = WS_XE + SZ_XE;
constexpr size_t SZ_HID = (size_t)XE_ROWS * DE * 2;
constexpr size_t WS_END = WS_HID + SZ_HID;

constexpr int LDS_BYTES = 156672;
constexpr int LDS_MISC = 153600;

struct Params {
    const float *x, *c, *emb_g, *emb_b, *w_ada, *b_ada, *w_in, *conv_w, *mix_beta, *w_out, *lb_logits, *ln_g, *ln_b, *w_router, *router_bias, *w_gate, *w_up, *w_down;
    float* out;
    unsigned char* ws;
    int ph_lo, ph_hi, l_lo, l_hi, fused, pad;
};

__device__ __forceinline__ float bf2f(unsigned b) { return __uint_as_float(b << 16); }
__device__ __forceinline__ unsigned f2bf(float f) { unsigned u = __float_as_uint(f); u += 0x7FFFu + ((u >> 16) & 1u); return u >> 16; }
typedef __bf16 bf16x2_t __attribute__((ext_vector_type(2)));
typedef float f32x2_t __attribute__((ext_vector_type(2)));
__device__ __forceinline__ unsigned pack2a(float lo, float hi) { unsigned r; asm("v_cvt_pk_bf16_f32 %0, %1, %2" : "=v"(r) : "v"(lo), "v"(hi)); return r; }
__device__ __forceinline__ unsigned pack2(float lo, float hi) { const bf16x2_t r = __builtin_convertvector((f32x2_t){lo, hi}, bf16x2_t); return __builtin_bit_cast(unsigned, r); }
__device__ __forceinline__ float wave_sum(float v) {
#pragma unroll
    for (int o = 32; o > 0; o >>= 1) v += __shfl_xor(v, o, 64);
    return v;
}
__device__ __forceinline__ float half_sum(float v) {
#pragma unroll
    for (int o = 16; o > 0; o >>= 1) v += __shfl_xor(v, o, 64);
    return v;
}
#define LDS_BARRIER() do { asm volatile("s_waitcnt lgkmcnt(0)" ::: "memory"); __builtin_amdgcn_s_barrier(); asm volatile("" ::: "memory"); } while (0)
__device__ __forceinline__ float sigmoidf_(float z) { return 1.0f / (1.0f + __expf(-z)); }
__device__ __forceinline__ float siluf_(float z) { return z / (1.0f + __expf(-z)); }

#define XB_TMO      128
#define XB_XCNT(j)  (256  + 64 * (j))
#define XB_XSUB(j)  (1280 + 64 * (j))
#define XB_XGEN(j)  (2304 + 64 * (j))
#define XB_TOP      3328
#define XB_TOPGEN   3392
#define XCD_BAR_WORDS 3456
#define XB_SPIN_CAP (1u << 22)
__device__ __forceinline__ unsigned xb_ld(unsigned* p)              { return __hip_atomic_load(p, __ATOMIC_RELAXED, __HIP_MEMORY_SCOPE_AGENT); }
__device__ __forceinline__ unsigned xb_add(unsigned* p, unsigned v) { return __hip_atomic_fetch_add(p, v, __ATOMIC_RELAXED, __HIP_MEMORY_SCOPE_AGENT); }
__device__ __forceinline__ unsigned xb_xcc_id() { return (unsigned)__builtin_amdgcn_s_getreg((3 << 11) | 20) & 0xFu; }
#define XB_SPIN(cond, bar) do { unsigned _sp = 0; while (cond) { __builtin_amdgcn_s_sleep(1); \
    if ((++_sp & 255u) == 0u) { if (xb_ld(&(bar)[XB_TMO])) break; if (_sp > XB_SPIN_CAP) { atomicAdd(&(bar)[XB_TMO], 1u); break; } } } } while (0)
struct XcdBarrier { unsigned* bar; unsigned x; volatile LAS unsigned* st; };
__device__ __forceinline__ XcdBarrier xcd_barrier_post(unsigned* bar, volatile LAS unsigned* st) {
    XcdBarrier b; b.bar = bar; b.x = xb_xcc_id(); b.st = st;
    if (threadIdx.x == 0) (void)xb_add(&bar[XB_XCNT(b.x)], 1u);
    return b;
}
__device__ __forceinline__ void xcd_barrier_complete(unsigned* bar, unsigned x, unsigned& nloc, unsigned& nx) {
    const unsigned G = gridDim.x * gridDim.y * gridDim.z;
    unsigned sum, cnt, mine, sp = 0u;
    for (;;) {
        sum = 0u; cnt = 0u; mine = 0u;
#pragma unroll
        for (unsigned j = 0; j < 16; ++j) { const unsigned c = xb_ld(&bar[XB_XCNT(j)]); sum += c; cnt += (c > 0u) ? 1u : 0u; mine = (j == x) ? c : mine; }
        if (sum == G) break;
        __builtin_amdgcn_s_sleep(1);
        if ((++sp & 255u) == 0u) { if (xb_ld(&bar[XB_TMO])) break; if (sp > XB_SPIN_CAP) { atomicAdd(&bar[XB_TMO], 1u); break; } }
    }
    nloc = mine > 0u ? mine : 1u; nx = cnt > 0u ? cnt : 1u;
}
template <bool WRT_DMA = false>
__device__ __forceinline__ void xcd_barrier(const XcdBarrier& b, const unsigned char* wrt_g = nullptr, LAS unsigned char* lds = nullptr) {
    asm volatile("s_waitcnt vmcnt(0)" ::: "memory");
    __syncthreads();
    if constexpr (WRT_DMA) {
        int t_ = threadIdx.x; asm volatile("" : "+v"(t_));
        const int wv = __builtin_amdgcn_readfirstlane(t_ >> 6), ln = t_ & 63;
        if (wv > 0)
            for (int ch = wv - 1; ch < 128; ch += 7)
                __builtin_amdgcn_global_load_lds((const unsigned*)(wrt_g + (size_t)ch * 1024 + ln * 16), (LAS unsigned*)(lds + ch * 1024), 16, 0, 0);
    }
    if (threadIdx.x == 0) {
        unsigned* bar = b.bar;
        __builtin_amdgcn_s_waitcnt(0);
        unsigned nloc = b.st[0], nx = b.st[1];
        if (nloc == 0u) { xcd_barrier_complete(bar, b.x, nloc, nx); b.st[0] = nloc; b.st[1] = nx; }
        const unsigned old = xb_add(&bar[XB_XSUB(b.x)], 1u);
        const unsigned gen = old / nloc;
        if (old + 1u == (gen + 1u) * nloc) {
            __builtin_amdgcn_fence(__ATOMIC_RELEASE, "agent");
            asm volatile("s_waitcnt vmcnt(0)" ::: "memory");
            const unsigned og = xb_add(&bar[XB_TOP], 1u);
            const unsigned tg = og / nx;
            if (og + 1u == (tg + 1u) * nx) xb_add(&bar[XB_TOPGEN], 1u);
            else XB_SPIN(xb_ld(&bar[XB_TOPGEN]) == tg, bar);
            __builtin_amdgcn_fence(__ATOMIC_ACQUIRE, "agent");
            xb_add(&bar[XB_XGEN(b.x)], 1u);
            asm volatile("s_waitcnt vmcnt(0)" ::: "memory");
        } else {
            XB_SPIN(xb_ld(&bar[XB_XGEN(b.x)]) == gen, bar);
            __builtin_amdgcn_fence(__ATOMIC_ACQUIRE, "agent");
            asm volatile("s_waitcnt vmcnt(0)" ::: "memory");
        }
    }
    __syncthreads();
}

namespace pg8 {
constexpr int PG8_TOKBUF = LDS_MISC + 1024;
constexpr int BM = 256, BK = 64, HALF = 128, HTB = HALF * BK * 2, STAGE_BYTES = 8 * HTB, NXCD = 8, WGM = 8;
__host__ __device__ __forceinline__ int lds_byte(int r, int c) { const int st = (r >> 4) * 2 + (c >> 5), rr = r & 15, cc = c & 31, ob = rr * 64 + cc * 2; return st * 1024 + (ob ^ (((ob >> 9) & 1) << 5)); }
__host__ __device__ __forceinline__ void stage_rc(int b, int& R, int& C) { const int st = b / 1024, sb = b % 1024, swz = sb ^ (((sb >> 9) & 1) << 5); R = (st >> 1) * 16 + swz / 64; C = (st & 1) * 32 + (swz % 64) / 2; }
__host__ __device__ __forceinline__ int perm32(int rho) { const int n = rho >> 4, i = rho & 15; return 8 * (i >> 2) + 4 * n + (i & 3); }

struct Unit { size_t aB, bB; int row0, col0; };
struct Gemm { const bf16_t* A; const bf16_t* Bt; int K; const int* tok = nullptr; };

template <int NM, int NN>
struct DenseOrder {
    int G, c; size_t tstep;
    __device__ void init(int rowbytes, int G_, int c_) { G = G_; c = c_; tstep = (size_t)BM * rowbytes; }
    __device__ bool next(int i, Unit& u) const {
        constexpr int nwg = NM * NN, q = nwg / NXCD, r = nwg % NXCD, nig = WGM * NN;
        static_assert(NM % WGM == 0, "row tiles come in groups of 8");
        const int L = __builtin_amdgcn_readfirstlane(i * G + c); if (L >= nwg) return false;
        const int xcd = L % NXCD, off = L / NXCD;
        const int wgid = (xcd < r ? xcd * (q + 1) : r * (q + 1) + (xcd - r) * q) + off;
        const int gid = wgid / nig, fm = gid * WGM, rem = wgid % nig;
        const int pm = fm + (rem % WGM), pn = rem / WGM;
        u.aB = (size_t)pm * tstep; u.bB = (size_t)pn * tstep; u.row0 = pm * BM; u.col0 = pn * BM; return true;
    }
};
struct OneUnit {
    Unit u0;
    __device__ bool next(int i, Unit& u) const { if (i > 0) return false; u = u0; return true; }
};
struct MoeOrder {
    const LAS int* tab; int NTn, G, c; size_t tstep, bexp;
    __device__ bool next(int i, Unit& u) const {
        const int MT = tab[16], U = MT * NTn, nx = G >> 3;
        int f;
        if ((G & 7) == 0) { const int per = (U + 7) >> 3, x = c & 7, j = c >> 3, loc = i * nx + j; f = x * per + loc; if (loc >= per || f >= U) return false; }
        else { f = i * G + c; if (f >= U) return false; }
        int e = 0;
#pragma unroll
        for (int j = 1; j < 16; ++j) e += (f >= tab[j] * NTn) ? 1 : 0;
        const int t0 = tab[e], te = tab[e + 1] - t0, r = f - t0 * NTn;
        const int nt = r / te, mt = t0 + (r - nt * te);
        u.aB = (size_t)mt * tstep; u.bB = (size_t)e * bexp + (size_t)nt * tstep; u.row0 = mt * BM; u.col0 = nt * BM; return true;
    }
};

__device__ __forceinline__ size_t rfl64(size_t v) { const unsigned lo = (unsigned)__builtin_amdgcn_readfirstlane((int)(unsigned)v), hi = (unsigned)__builtin_amdgcn_readfirstlane((int)(unsigned)(v >> 32)); return ((size_t)hi << 32) | lo; }
__device__ __forceinline__ void uniformize(Unit& u) { u.aB = rfl64(u.aB); u.bB = rfl64(u.bB); u.row0 = __builtin_amdgcn_readfirstlane(u.row0); u.col0 = __builtin_amdgcn_readfirstlane(u.col0); }
__device__ __forceinline__ unsigned cvt_pk_bf16(float lo, float hi) { unsigned r; asm volatile("v_cvt_pk_bf16_f32 %0, %1, %2" : "=v"(r) : "v"(lo), "v"(hi)); return r; }

struct EpiF32 {
    static constexpr bool PERM = false;
    float* C; int ldc;
    __device__ __forceinline__ void operator()(const f32x4 (&acc)[2][2][4][2], const Unit& u, int wr, int wc, int fr, int fq) const {
        const int row0 = u.row0 + wr * 64 + fr, col0 = u.col0 + wc * 32 + 4 * fq;
#pragma unroll
        for (int ai = 0; ai < 2; ++ai)
#pragma unroll
            for (int m = 0; m < 4; ++m) { float* rowp = C + (size_t)(row0 + ai * HALF + m * 16) * ldc + col0;
#pragma unroll
                for (int bj = 0; bj < 2; ++bj)
#pragma unroll
                    for (int n = 0; n < 2; ++n) *(f32x4*)(rowp + bj * HALF + n * 16) = acc[ai][bj][m][n]; }
    }
};
struct EpiBf16 {
    static constexpr bool PERM = true;
    bf16_t* O; int ldc;
    __device__ __forceinline__ void operator()(const f32x4 (&acc)[2][2][4][2], const Unit& u, int wr, int wc, int fr, int fq) const {
        const int row0 = u.row0 + wr * 64 + fr, col0 = u.col0 + wc * 32 + 8 * fq;
#pragma unroll
        for (int ai = 0; ai < 2; ++ai)
#pragma unroll
            for (int m = 0; m < 4; ++m) { bf16_t* rowp = O + (size_t)(row0 + ai * HALF + m * 16) * ldc + col0;
#pragma unroll
                for (int bj = 0; bj < 2; ++bj) { const f32x4 v0 = acc[ai][bj][m][0], v1 = acc[ai][bj][m][1];
                    u32x4 o; o[0] = cvt_pk_bf16(v0[0], v0[1]); o[1] = cvt_pk_bf16(v0[2], v0[3]); o[2] = cvt_pk_bf16(v1[0], v1[1]); o[3] = cvt_pk_bf16(v1[2], v1[3]);
                    *(u32x4*)(rowp + bj * HALF) = o; } }
    }
};
struct EpiHidden {
    static constexpr bool PERM = true;
    bf16_t* O;
    __device__ __forceinline__ void operator()(const f32x4 (&acc)[2][2][4][2], const Unit& u, int wr, int wc, int fr, int fq) const {
        const int row0 = u.row0 + wr * 64 + fr, col0 = (u.col0 >> 1) + wc * 32 + 8 * fq;
#pragma unroll
        for (int ai = 0; ai < 2; ++ai)
#pragma unroll
            for (int m = 0; m < 4; ++m) { bf16_t* rowp = O + (size_t)(row0 + ai * HALF + m * 16) * DE + col0;
                float h[8];
#pragma unroll
                for (int n = 0; n < 2; ++n)
#pragma unroll
                    for (int j = 0; j < 4; ++j) { const float g = acc[ai][0][m][n][j], up = acc[ai][1][m][n][j]; h[n * 4 + j] = g * __builtin_amdgcn_rcpf(1.0f + __expf(-g)) * up; }
                u32x4 o; o[0] = cvt_pk_bf16(h[0], h[1]); o[1] = cvt_pk_bf16(h[2], h[3]); o[2] = cvt_pk_bf16(h[4], h[5]); o[3] = cvt_pk_bf16(h[6], h[7]);
                *(u32x4*)rowp = o; }
    }
};

typedef int v8i32 __attribute__((ext_vector_type(8)));
typedef int v4i32 __attribute__((ext_vector_type(4)));
struct EpiHidden8 {
    static constexpr bool PERM = true;
    unsigned char* O;
    __device__ __forceinline__ void operator()(const f32x4 (&acc)[2][2][4][2], const Unit& u, int wr, int wc, int fr, int fq) const {
        const int row0 = u.row0 + wr * 64 + fr, col0 = (u.col0 >> 1) + wc * 32 + 8 * fq;
#pragma unroll
        for (int ai = 0; ai < 2; ++ai)
#pragma unroll
            for (int m = 0; m < 4; ++m) { unsigned char* rowp = O + (size_t)(row0 + ai * HALF + m * 16) * DEP + col0;
                float h[8];
#pragma unroll
                for (int n = 0; n < 2; ++n)
#pragma unroll
                    for (int j = 0; j < 4; ++j) { const float g = acc[ai][0][m][n][j], up = acc[ai][1][m][n][j]; h[n * 4 + j] = g * __builtin_amdgcn_rcpf(1.0f + __expf(-g)) * up * H8_SCALE; }
                int o0 = __builtin_amdgcn_cvt_pk_fp8_f32(h[0], h[1], 0, false); o0 = __builtin_amdgcn_cvt_pk_fp8_f32(h[2], h[3], o0, true);
                int o1 = __builtin_amdgcn_cvt_pk_fp8_f32(h[4], h[5], 0, false); o1 = __builtin_amdgcn_cvt_pk_fp8_f32(h[6], h[7], o1, true);
                u32x2 o; o[0] = (unsigned)o0; o[1] = (unsigned)o1;
                *(u32x2*)rowp = o; }
    }
};
template <class Epi, class Sched, bool FP8 = false, bool GATHER = false>
__device__ __forceinline__ void gemm_phase(LAS unsigned char* lds, const Gemm g, const Sched& S, const Epi& E, int sclW = 127, int sclA = 127) {
    int tid = threadIdx.x; asm volatile("" : "+v"(tid)); const int wid = __builtin_amdgcn_readfirstlane(tid >> 6), lane = tid & 63, wr = wid >> 2, wc = wid & 3, fr = lane & 15, fq = lane >> 4;
    const int K = g.K, rowb = FP8 ? K : 2 * K, nt = rowb / 128;
    int sclWv = sclW, sclAv = sclA; asm volatile("" : "+v"(sclWv), "+v"(sclAv));
    unsigned voffA[2], voffB[2];
#pragma unroll
    for (int i = 0; i < 2; ++i) { int R, C; stage_rc(tid * 16 + i * 8192, R, C); const int Rb = Epi::PERM ? ((R & ~31) + perm32(R & 31)) : R;
        voffA[i] = (unsigned)(R * rowb + 2 * C); voffB[i] = (unsigned)(Rb * rowb + 2 * C); }
    const size_t kstep = 128;
    const size_t hstep = (size_t)HALF * rowb;
    const unsigned ldsw = (unsigned)wid * 1024u;
    const int aoff = lds_byte(wr * 64 + fr, fq * 8), boff = lds_byte(wc * 32 + fr, fq * 8);
    constexpr int P2 = 1024;
#define PG8_SA(b, h) (((b) * 2 + (h)) * HTB)
#define PG8_SB(b, h) ((4 + (b) * 2 + (h)) * HTB)
#define PG8_STAGE(bufoff, gbase, voff) do { _Pragma("unroll") for (int _i = 0; _i < 2; ++_i) \
        __builtin_amdgcn_global_load_lds((const unsigned*)((const char*)(gbase) + (voff)[_i]), (LAS unsigned*)(lds + (bufoff) + ldsw + _i * 8192), 16, 0, 0); } while (0)
#define PG8_LDA(dst, b, h) do { _Pragma("unroll") for (int m = 0; m < 4; ++m) { \
        const v4i32 _l = *(const LAS v4i32*)(lds + PG8_SA(b, h) + aoff + m * 2048), _h = *(const LAS v4i32*)(lds + PG8_SA(b, h) + aoff + P2 + m * 2048); \
        dst[m] = __builtin_shufflevector(_l, _h, 0, 1, 2, 3, 4, 5, 6, 7); } } while (0)
#define PG8_LDB(dst, b, h) do { _Pragma("unroll") for (int n = 0; n < 2; ++n) { \
        const v4i32 _l = *(const LAS v4i32*)(lds + PG8_SB(b, h) + boff + n * 2048), _h = *(const LAS v4i32*)(lds + PG8_SB(b, h) + boff + P2 + n * 2048); \
        dst[n] = __builtin_shufflevector(_l, _h, 0, 1, 2, 3, 4, 5, 6, 7); } } while (0)
#define PG8_MMA(ai, bj, At, Bt) do { __builtin_amdgcn_s_setprio(1); _Pragma("unroll") for (int m = 0; m < 4; ++m) _Pragma("unroll") for (int n = 0; n < 2; ++n) { \
        if constexpr (FP8) { \
            asm volatile("v_mfma_scale_f32_16x16x128_f8f6f4 %0, %1, %2, %0, %3, %4 op_sel_hi:[0,0,0]" : "+v"(acc[ai][bj][m][n]) : "v"(Bt[n]), "v"(At[m]), "v"(sclWv), "v"(sclAv)); \
        } else { \
            acc[ai][bj][m][n] = __builtin_amdgcn_mfma_f32_16x16x32_bf16(__builtin_bit_cast(bf16x8, __builtin_shufflevector(Bt[n], Bt[n], 0, 1, 2, 3)), __builtin_bit_cast(bf16x8, __builtin_shufflevector(At[m], At[m], 0, 1, 2, 3)), acc[ai][bj][m][n], 0, 0, 0); \
            acc[ai][bj][m][n] = __builtin_amdgcn_mfma_f32_16x16x32_bf16(__builtin_bit_cast(bf16x8, __builtin_shufflevector(Bt[n], Bt[n], 4, 5, 6, 7)), __builtin_bit_cast(bf16x8, __builtin_shufflevector(At[m], At[m], 4, 5, 6, 7)), acc[ai][bj][m][n], 0, 0, 0); } } \
        __builtin_amdgcn_s_setprio(0); } while (0)
#define PG8_WAIT_V(n) asm volatile("s_waitcnt vmcnt(" #n ")" ::: "memory")
#define PG8_WAIT_L(n) asm volatile("s_waitcnt lgkmcnt(" #n ")" ::: "memory")
#define PG8_BAR __builtin_amdgcn_s_barrier()
#define PG8_SCHED __builtin_amdgcn_sched_barrier(0)
    Unit cur, nxt; int ui = 0;
    if (!S.next(0, cur)) return;
    uniformize(cur);
    f32x4 acc[2][2][4][2];
#pragma unroll
    for (int a = 0; a < 2; ++a)
#pragma unroll
        for (int b = 0; b < 2; ++b)
#pragma unroll
            for (int m = 0; m < 4; ++m)
#pragma unroll
                for (int n = 0; n < 2; ++n) acc[a][b][m][n] = (f32x4){0.f, 0.f, 0.f, 0.f};
    v8i32 At[4], B0[2], B1[2];
    const char* cA = (const char*)g.A + cur.aB; const char* cB = (const char*)g.Bt + cur.bB;
    unsigned voffG[2][2]; int tokN[2][2];
#define PG8_TOKLD(dst, u_) do { _Pragma("unroll") for (int _h = 0; _h < 2; ++_h) _Pragma("unroll") for (int _i = 0; _i < 2; ++_i) { \
        const unsigned _R = voffA[_i] / (unsigned)rowb; dst[_h][_i] = g.tok[(u_).row0 + _h * HALF + (int)_R]; } } while (0)
#define PG8_TOKOFF(src) do { _Pragma("unroll") for (int _h = 0; _h < 2; ++_h) _Pragma("unroll") for (int _i = 0; _i < 2; ++_i) { \
        const unsigned _R = voffA[_i] / (unsigned)rowb, _c = voffA[_i] - _R * (unsigned)rowb; voffG[_h][_i] = (unsigned)src[_h][_i] * (unsigned)rowb + _c; } } while (0)
#define PG8_STAGE_A(bufoff, base, h) do { if constexpr (GATHER) PG8_STAGE(bufoff, base, voffG[h]); else PG8_STAGE(bufoff, (base) + (h) * hstep, voffA); } while (0)
    if constexpr (GATHER) { PG8_TOKLD(tokN, cur); PG8_TOKOFF(tokN); cA = (const char*)g.A; }
    PG8_STAGE(PG8_SB(0, 0), cB, voffB); PG8_STAGE_A(PG8_SA(0, 0), cA, 0); PG8_STAGE(PG8_SB(0, 1), cB + hstep, voffB); PG8_STAGE_A(PG8_SA(0, 1), cA, 1);
    if (wr == 1) PG8_BAR;
    PG8_WAIT_V(4); PG8_BAR;
    PG8_STAGE(PG8_SB(1, 0), cB + kstep, voffB); PG8_STAGE_A(PG8_SA(1, 0), cA + kstep, 0); PG8_STAGE(PG8_SB(1, 1), cB + hstep + kstep, voffB);
    PG8_WAIT_V(6); PG8_BAR;
    for (;;) {
        const bool has_next = S.next(ui + 1, nxt);
        uniformize(nxt);
        const char* nA = GATHER ? cA : (has_next ? (const char*)g.A + nxt.aB : cA); const char* nB = has_next ? (const char*)g.Bt + nxt.bB : cB;
        if constexpr (GATHER) { if (has_next && wid < 4)
            __builtin_amdgcn_global_load_lds((const unsigned*)(g.tok + nxt.row0 + wid * 64 + lane), (LAS unsigned*)(lds + PG8_TOKBUF + wid * 256), 4, 0, 0); }
        for (int t = 0; t < nt; t += 2) {
            const bool last = (t == nt - 2);
            const char* a1 = cA + (size_t)(t + 1) * kstep;
            const char* a2 = last ? nA : cA + (size_t)(t + 2) * kstep; const char* b2 = last ? nB : cB + (size_t)(t + 2) * kstep;
            const char* a3 = a2 + kstep; const char* b3 = b2 + kstep;
            PG8_LDB(B0, 0, 0); PG8_SCHED; PG8_LDA(At, 0, 0); PG8_STAGE_A(PG8_SA(1, 1), a1, 1);
            if constexpr (GATHER) { if (last && has_next) {
#pragma unroll
                for (int _h = 0; _h < 2; ++_h)
#pragma unroll
                    for (int _i = 0; _i < 2; ++_i) tokN[_h][_i] = *(const LAS int*)(lds + PG8_TOKBUF + (_h * HALF + (int)(voffA[_i] / (unsigned)rowb)) * 4);
                PG8_TOKOFF(tokN); } }
            PG8_WAIT_L(8); PG8_BAR; PG8_WAIT_L(0); PG8_MMA(0, 0, At, B0); PG8_BAR; PG8_SCHED;
            PG8_LDB(B1, 0, 1); PG8_STAGE(PG8_SB(0, 0), b2, voffB);
            PG8_BAR; PG8_WAIT_L(0); PG8_MMA(0, 1, At, B1); PG8_BAR;
            PG8_LDA(At, 0, 1); PG8_STAGE_A(PG8_SA(0, 0), a2, 0);
            PG8_BAR; PG8_WAIT_L(0); PG8_MMA(1, 0, At, B0); PG8_BAR; PG8_SCHED;
            PG8_STAGE(PG8_SB(0, 1), b2 + hstep, voffB);
            PG8_WAIT_V(6); PG8_BAR; PG8_MMA(1, 1, At, B1); PG8_BAR;
            PG8_LDB(B0, 1, 0); PG8_SCHED; PG8_LDA(At, 1, 0); PG8_STAGE_A(PG8_SA(0, 1), a2, 1);
            PG8_WAIT_L(8); PG8_BAR; PG8_WAIT_L(0); PG8_MMA(0, 0, At, B0); PG8_BAR; PG8_SCHED;
            PG8_LDB(B1, 1, 1); PG8_STAGE(PG8_SB(1, 0), b3, voffB);
            PG8_BAR; PG8_WAIT_L(0); PG8_MMA(0, 1, At, B1); PG8_BAR;
            PG8_LDA(At, 1, 1); PG8_STAGE_A(PG8_SA(1, 0), a3, 0);
            PG8_BAR; PG8_WAIT_L(0); PG8_MMA(1, 0, At, B0); PG8_BAR; PG8_SCHED;
            PG8_STAGE(PG8_SB(1, 1), b3 + hstep, voffB);
            PG8_WAIT_V(6); PG8_BAR; PG8_MMA(1, 1, At, B1); PG8_BAR;
        }
        if constexpr (FP8) asm volatile("s_nop 15\n\ts_nop 15" ::: "memory");
        E(acc, cur, wr, wc, fr, fq);
        if (!has_next) break;
#pragma unroll
        for (int a = 0; a < 2; ++a)
#pragma unroll
            for (int b = 0; b < 2; ++b)
#pragma unroll
                for (int m = 0; m < 4; ++m)
#pragma unroll
                    for (int n = 0; n < 2; ++n) acc[a][b][m][n] = (f32x4){0.f, 0.f, 0.f, 0.f};
        cur = nxt; cA = nA; cB = nB; ++ui;
    }
    PG8_WAIT_V(0);
    if (wr == 0) PG8_BAR;
    PG8_BAR;
#undef PG8_SA
#undef PG8_SB
#undef PG8_STAGE
#undef PG8_STAGE_A
#undef PG8_TOKOFF
#undef PG8_TOKLD
#undef PG8_LDA
#undef PG8_LDB
#undef PG8_MMA
#undef PG8_WAIT_V
#undef PG8_WAIT_L
#undef PG8_BAR
#undef PG8_SCHED
}
}

constexpr int S_IN = 16 * 66, S_OUT = 16 * 16, S_GU = 16 * 11, S_DN = 11 * 16;
constexpr int CV_PER_L = S_IN + S_OUT + NE * 2 * S_GU + NE * S_DN;
constexpr int CV_A0 = S_IN + S_OUT;
constexpr int CV_A1 = CV_A0 + NE * 2 * S_GU;
constexpr int CV_TOTAL = DEPTH * CV_PER_L;
constexpr int CV_LAST = 1 << 30;
struct StripDesc { const float* src; bf16_t* dst; int lds_, ldd, k0, n0, drow0, fp8; };
__device__ __forceinline__ StripDesc strip_desc(const Params& p, int si) {
    unsigned char* ws = p.ws; StripDesc d;
    const int l = si / CV_PER_L; int r = si - l * CV_PER_L;
    if (r < S_IN) {
        const int qq = r >> 1, kt = qq % 16, ntl = 2 * (qq / 16) + (r & 1);
        d.src = p.w_in + (size_t)l * D * INC; d.lds_ = INC; d.fp8 = INP8(l) ? 1 : 0; d.dst = (bf16_t*)(ws + WS_WIN) + (size_t)l * INC * D; d.ldd = D; d.k0 = kt * 128; d.n0 = ntl * 128; d.drow0 = ntl * 128;
    } else if (r < CV_A0) {
        r -= S_IN; const int qq = r >> 1, kt = qq % 16, ntl = 2 * (qq / 16) + (r & 1);
        d.src = p.w_out + (size_t)l * D * D; d.lds_ = D; d.dst = (bf16_t*)(ws + WS_WOUT) + (size_t)l * D * D; d.ldd = D; d.k0 = kt * 128; d.n0 = ntl * 128; d.drow0 = ntl * 128; d.fp8 = OUT8(l) ? 1 : 0;
    } else if (r < CV_A1) {
        r -= CV_A0; const int mat = r / S_GU, q = r % S_GU;
        const int qq = q >> 1, kt = q < 160 ? qq % 16 : q - 160, ntl = q < 160 ? 2 * (qq / 16) + (q & 1) : 10;
        const int which = mat & 1, le = l * NE + (mat >> 1);
        d.src = (which ? p.w_up : p.w_gate) + (size_t)le * D * DE; d.lds_ = DE; d.fp8 = MOE_FP8; d.dst = MOE_FP8 ? (bf16_t*)(ws + WS_WGU + (size_t)le * (2 * DE) * D) : (bf16_t*)(ws + WS_WGU) + (size_t)le * (2 * DE) * D; d.ldd = D; d.k0 = kt * 128; d.n0 = ntl * 128; d.drow0 = ntl * 256 + which * 128;
    } else {
        r -= CV_A1; const int le = l * NE + r / S_DN, q = r % S_DN, qq = q >> 1, kt = qq % 11, ntl = 2 * (qq / 11) + (q & 1);
        d.src = p.w_down + (size_t)le * DE * D; d.lds_ = D; d.fp8 = MOE_FP8; d.dst = MOE_FP8 ? (bf16_t*)(ws + WS_WD + (size_t)le * D * DEP) : (bf16_t*)(ws + WS_WD) + (size_t)le * D * DE; d.ldd = MOE_FP8 ? DEP : DE; d.k0 = kt * 128; d.n0 = ntl * 128; d.drow0 = ntl * 128;
    }
    return d;
}
__device__ __forceinline__ void cvt_store_strip(const StripDesc& d, const float4 (&a)[2][2], const float4 (&b)[2][2], LAS unsigned char* tb, int tid, bool readout) {
    const int kp = tid >> 4, n4 = (tid & 15) * 4;
    if (!readout) {
        if (!d.fp8) {
#pragma unroll
            for (int ki = 0; ki < 2; ++ki)
#pragma unroll
                for (int ni = 0; ni < 2; ++ni) {
                    LAS unsigned* t = (LAS unsigned*)tb + (ki * 2 + ni) * 2112;
                    t[(n4 + 0) * 33 + kp] = pack2a(a[ki][ni].x, b[ki][ni].x);
                    t[(n4 + 1) * 33 + kp] = pack2a(a[ki][ni].y, b[ki][ni].y);
                    t[(n4 + 2) * 33 + kp] = pack2a(a[ki][ni].z, b[ki][ni].z);
                    t[(n4 + 3) * 33 + kp] = pack2a(a[ki][ni].w, b[ki][ni].w);
                }
        } else {
#pragma unroll
            for (int ki = 0; ki < 2; ++ki)
#pragma unroll
                for (int ni = 0; ni < 2; ++ni) {
                    LAS unsigned char* t = tb + (ki * 2 + ni) * 4352;
                    *(LAS unsigned short*)(t + (n4 + 0) * 68 + 2 * kp) = (unsigned short)__builtin_amdgcn_cvt_pk_fp8_f32(a[ki][ni].x * W8_SCALE, b[ki][ni].x * W8_SCALE, 0, false);
                    *(LAS unsigned short*)(t + (n4 + 1) * 68 + 2 * kp) = (unsigned short)__builtin_amdgcn_cvt_pk_fp8_f32(a[ki][ni].y * W8_SCALE, b[ki][ni].y * W8_SCALE, 0, false);
                    *(LAS unsigned short*)(t + (n4 + 2) * 68 + 2 * kp) = (unsigned short)__builtin_amdgcn_cvt_pk_fp8_f32(a[ki][ni].z * W8_SCALE, b[ki][ni].z * W8_SCALE, 0, false);
                    *(LAS unsigned short*)(t + (n4 + 3) * 68 + 2 * kp) = (unsigned short)__builtin_amdgcn_cvt_pk_fp8_f32(a[ki][ni].w * W8_SCALE, b[ki][ni].w * W8_SCALE, 0, false);
                }
        }
    } else {
        if (!d.fp8) {
            const int n = tid >> 3, kc = (tid & 7) * 4;
#pragma unroll
            for (int ki = 0; ki < 2; ++ki)
#pragma unroll
                for (int ni = 0; ni < 2; ++ni) {
                    const LAS unsigned* t = (const LAS unsigned*)tb + (ki * 2 + ni) * 2112;
                    u32x4 o; o[0] = t[n * 33 + kc]; o[1] = t[n * 33 + kc + 1]; o[2] = t[n * 33 + kc + 2]; o[3] = t[n * 33 + kc + 3];
                    *(u32x4*)(d.dst + (size_t)(d.drow0 + ni * 64 + n) * d.ldd + d.k0 + ki * 64 + kc * 2) = o;
                }
        } else {
            const int n = tid >> 3, kc8 = (tid & 7) * 8;
            unsigned char* dst8 = (unsigned char*)d.dst;
#pragma unroll
            for (int ki = 0; ki < 2; ++ki)
#pragma unroll
                for (int ni = 0; ni < 2; ++ni) {
                    const LAS unsigned char* t = tb + (ki * 2 + ni) * 4352;
                    u32x2 o; o[0] = *(const LAS unsigned*)(t + n * 68 + kc8); o[1] = *(const LAS unsigned*)(t + n * 68 + kc8 + 4);
                    *(u32x2*)(dst8 + (size_t)(d.drow0 + ni * 64 + n) * d.ldd + d.k0 + ki * 64 + kc8) = o;
                }
        }
    }
}
__device__ __forceinline__ void cvt_pull(const Params& p, LAS unsigned char* lds, int limit, unsigned* done_ctr, unsigned need_done) {
    int tid = threadIdx.x; asm volatile("" : "+v"(tid));
    LAS int* slot = (LAS int*)(lds + LDS_MISC + 512);
    unsigned* head = (unsigned*)(p.ws + WS_CVTQ);
    if (tid == 0) {
        int sv = -1;
        const bool stop = done_ctr ? (xb_ld(done_ctr) >= need_done) : (xb_ld(head) >= (unsigned)limit);
        if (!stop) { const unsigned c = xb_add(head, 2u); sv = c < (unsigned)CV_TOTAL ? (int)c : -1; }
        slot[0] = sv;
    }
    __syncthreads();
    const int kp = tid >> 4, n4 = (tid & 15) * 4;
    for (;;) {
        const int sraw = slot[0];
        if (sraw < 0) break;
        const int si = sraw & (CV_LAST - 1); const bool lastone = (sraw & CV_LAST) != 0;
        const StripDesc d0 = strip_desc(p, si), d1 = strip_desc(p, si + 1);
        float4 a0[2][2], b0[2][2], a1[2][2], b1[2][2];
#pragma unroll
        for (int ki = 0; ki < 2; ++ki)
#pragma unroll
            for (int ni = 0; ni < 2; ++ni) {
                { const f32x4 t_ = __builtin_nontemporal_load((const f32x4*)(d0.src + (size_t)(d0.k0 + ki * 64 + 2 * kp) * d0.lds_ + d0.n0 + ni * 64 + n4)); a0[ki][ni] = make_float4(t_[0], t_[1], t_[2], t_[3]); }
                { const f32x4 t_ = __builtin_nontemporal_load((const f32x4*)(d0.src + (size_t)(d0.k0 + ki * 64 + 2 * kp + 1) * d0.lds_ + d0.n0 + ni * 64 + n4)); b0[ki][ni] = make_float4(t_[0], t_[1], t_[2], t_[3]); }
            }
#pragma unroll
        for (int ki = 0; ki < 2; ++ki)
#pragma unroll
            for (int ni = 0; ni < 2; ++ni) {
                { const f32x4 t_ = __builtin_nontemporal_load((const f32x4*)(d1.src + (size_t)(d1.k0 + ki * 64 + 2 * kp) * d1.lds_ + d1.n0 + ni * 64 + n4)); a1[ki][ni] = make_float4(t_[0], t_[1], t_[2], t_[3]); }
                { const f32x4 t_ = __builtin_nontemporal_load((const f32x4*)(d1.src + (size_t)(d1.k0 + ki * 64 + 2 * kp + 1) * d1.lds_ + d1.n0 + ni * 64 + n4)); b1[ki][ni] = make_float4(t_[0], t_[1], t_[2], t_[3]); }
            }
        unsigned c = 0u, dn = 0u;
        if (tid == 0 && !lastone) { c = xb_add(head, 2u); if (done_ctr) dn = xb_ld(done_ctr); }
        cvt_store_strip(d0, a0, b0, lds, tid, false);
        cvt_store_strip(d1, a1, b1, lds + 33792, tid, false);
        LDS_BARRIER();
        cvt_store_strip(d0, a0, b0, lds, tid, true);
        cvt_store_strip(d1, a1, b1, lds + 33792, tid, true);
        if (tid == 0) {
            int sv = -1;
            if (!lastone && c < (unsigned)CV_TOTAL) { const bool fin = done_ctr ? (dn >= need_done) : (c >= (unsigned)limit); sv = (int)c | (fin ? CV_LAST : 0); }
            slot[0] = sv;
        }
        LDS_BARRIER();
    }
    __syncthreads();
}
__device__ __forceinline__ void tail_pull(const Params& p, LAS unsigned char* lds, int ctr_idx) {
    unsigned* ctr = (unsigned*)(p.ws + WS_CVTQ) + 64 * (1 + ctr_idx);
    __syncthreads();
    if (threadIdx.x == 0) (void)xb_add(ctr, 1u);
    cvt_pull(p, lds, 0, ctr, gridDim.x);
}

__device__ __forceinline__ void ada_chunks(const Params& p, LAS unsigned char* lds, int ch0, int ch_end, int step) {
    int tid = threadIdx.x; asm volatile("" : "+v"(tid));
    unsigned char* ws = p.ws;
    LAS float* cond = (LAS float*)lds;
    LAS float* red = (LAS float*)(lds + 32768);
    if (ch0 >= ch_end) return;
    for (int i = tid; i < 4 * D; i += 512) { const float v = p.c[i]; cond[i] = siluf_(v); }
    __syncthreads();
    for (int ch = ch0; ch < ch_end; ch += step) {
        const int l = ch >> 7, j0 = (ch & 127) * 96;
        const float* w = p.w_ada + (size_t)l * D * (6 * D);
        const int kg = tid / 24, cl = tid % 24;
        float acc[4][4];
#pragma unroll
        for (int b = 0; b < 4; ++b)
#pragma unroll
            for (int j = 0; j < 4; ++j) acc[b][j] = 0.f;
        if (kg < 21) {
            for (int it0 = 0; it0 < 98; it0 += 14) {
                float4 wv[14];
#pragma unroll
                for (int q = 0; q < 14; ++q) { const int k = kg + 21 * (it0 + q); if (k < D) { const f32x4 t_ = __builtin_nontemporal_load((const f32x4*)(w + (size_t)k * (6 * D) + j0 + cl * 4)); wv[q] = make_float4(t_[0], t_[1], t_[2], t_[3]); } else wv[q] = make_float4(0.f, 0.f, 0.f, 0.f); }
#pragma unroll
                for (int q = 0; q < 14; ++q) { const int k = kg + 21 * (it0 + q); const int kc = k < D ? k : 0;
#pragma unroll
                    for (int b = 0; b < 4; ++b) { const float cv = cond[b * D + kc]; acc[b][0] += cv * wv[q].x; acc[b][1] += cv * wv[q].y; acc[b][2] += cv * wv[q].z; acc[b][3] += cv * wv[q].w; } }
            }
#pragma unroll
            for (int b = 0; b < 4; ++b)
#pragma unroll
                for (int j = 0; j < 4; ++j) red[(kg * 4 + b) * 96 + cl * 4 + j] = acc[b][j];
        }
        __syncthreads();
        if (tid < 384) {
            const int b = tid / 96, col = tid % 96; float s = 0.f;
            for (int g = 0; g < 21; ++g) s += red[(g * 4 + b) * 96 + col];
            float* mod = (float*)(ws + WS_MOD);
            mod[((size_t)l * 4 + b) * (6 * D) + j0 + col] = s + p.b_ada[(size_t)l * 6 * D + j0 + col];
        }
        __syncthreads();
    }
}
__device__ __forceinline__ void phase_prologue(const Params& p, LAS unsigned char* lds) {
    const bool svc = (gridDim.x >= 256);
    {
        float* wrt = (float*)(p.ws + WS_WRT);
        for (int i = blockIdx.x * 512 + threadIdx.x; i < D * NE / 4; i += gridDim.x * 512) {
            const float4 w = *(const float4*)(p.w_router + (size_t)i * 4);
            const int d = i >> 2, e4 = (i & 3) * 4;
            const int dp = (((d >> 9) * 2 + ((d >> 2) & 1)) << 8) + (((d >> 3) & 63) << 2) + (d & 3);
            wrt[(e4 + 0) * D + dp] = w.x; wrt[(e4 + 1) * D + dp] = w.y; wrt[(e4 + 2) * D + dp] = w.z; wrt[(e4 + 3) * D + dp] = w.w;
        }
    }
    ada_chunks(p, lds, blockIdx.x, svc ? 128 : 256, gridDim.x);
    cvt_pull(p, lds, CV_A0, nullptr, 0u);
}

#define COLK(k) ((unsigned)((((k) >> 1) << 9) + lane * 8 + (((k) & 1) << 2)))
#define COL8(i) ((unsigned)(((i) << 9) + lane * 8))
__device__ __forceinline__ void ld_bf8(const bf16_t* p, float4& a, float4& b) {
    const u32x4 r = *(const u32x4*)p;
    a = make_float4(bf2f(r[0] & 0xffffu), bf2f(r[0] >> 16), bf2f(r[1] & 0xffffu), bf2f(r[1] >> 16));
    b = make_float4(bf2f(r[2] & 0xffffu), bf2f(r[2] >> 16), bf2f(r[3] & 0xffffu), bf2f(r[3] >> 16));
}
__device__ __forceinline__ void st_bf8(bf16_t* p, const float4& a, const float4& b) {
    u32x4 o; o[0] = pack2a(a.x, a.y); o[1] = pack2a(a.z, a.w); o[2] = pack2a(b.x, b.y); o[3] = pack2a(b.z, b.w);
    *(u32x4*)p = o;
}
__device__ __forceinline__ void st_fp8x8(unsigned char* p, const float4& a, const float4& b) {
    int o0 = __builtin_amdgcn_cvt_pk_fp8_f32(a.x, a.y, 0, false); o0 = __builtin_amdgcn_cvt_pk_fp8_f32(a.z, a.w, o0, true);
    int o1 = __builtin_amdgcn_cvt_pk_fp8_f32(b.x, b.y, 0, false); o1 = __builtin_amdgcn_cvt_pk_fp8_f32(b.z, b.w, o1, true);
    u32x2 o; o[0] = (unsigned)o0; o[1] = (unsigned)o1;
    *(u32x2*)p = o;
}
__device__ __forceinline__ void ln_rows(float4 (&v)[8], const float* __restrict__ g, const float* __restrict__ b, int lane) {
    float s = 0.f;
#pragma unroll
    for (int i = 0; i < 8; ++i) s += (v[i].x + v[i].y) + (v[i].z + v[i].w);
    const float mean = wave_sum(s) * (1.0f / D);
    float q = 0.f;
#pragma unroll
    for (int i = 0; i < 8; ++i) { const float a = v[i].x - mean, bb = v[i].y - mean, c = v[i].z - mean, d = v[i].w - mean; q += (a * a + bb * bb) + (c * c + d * d); }
    const float rstd = rsqrtf(wave_sum(q) * (1.0f / D) + 1e-5f);
#pragma unroll
    for (int i = 0; i < 8; ++i) {
        const float4 gv = *(const float4*)(g + COLK(i)), bv = *(const float4*)(b + COLK(i));
        v[i].x = (v[i].x - mean) * rstd * gv.x + bv.x; v[i].y = (v[i].y - mean) * rstd * gv.y + bv.y;
        v[i].z = (v[i].z - mean) * rstd * gv.z + bv.z; v[i].w = (v[i].w - mean) * rstd * gv.w + bv.w;
    }
}
__device__ __forceinline__ void modulate_store(const float4 (&v)[8], const float* __restrict__ shift, const float* __restrict__ scale, bf16_t* __restrict__ dst, int lane, bool fp8) {
#pragma unroll
    for (int i = 0; i < 4; ++i) {
        float4 h[2];
#pragma unroll
        for (int q = 0; q < 2; ++q) {
            const float4 sh = *(const float4*)(shift + COLK(2 * i + q)), sc = *(const float4*)(scale + COLK(2 * i + q));
            const float4 x = v[2 * i + q];
            h[q] = make_float4(x.x * (1.f + sc.x) + sh.x, x.y * (1.f + sc.y) + sh.y, x.z * (1.f + sc.z) + sh.z, x.w * (1.f + sc.w) + sh.w);
        }
        if (fp8) st_fp8x8((unsigned char*)dst + COL8(i), h[0], h[1]);
        else st_bf8(dst + COL8(i), h[0], h[1]);
    }
}

__device__ __forceinline__ void phase_ln0(const Params& p) {
    int tid_ = threadIdx.x; asm volatile("" : "+v"(tid_)); const int wave = __builtin_amdgcn_readfirstlane(tid_ >> 6), lane = tid_ & 63;
    const float* mod = (const float*)(p.ws + WS_MOD);
    for (int n = blockIdx.x * 8 + wave; n < T; n += gridDim.x * 8) {
        const int b = n / SEQ;
        float4 v[8];
#pragma unroll
        for (int i = 0; i < 8; ++i) v[i] = *(const float4*)(p.x + (size_t)n * D + COLK(i));
        ln_rows(v, p.emb_g, p.emb_b, lane);
        bf16_t* xr = (bf16_t*)(p.ws + WS_XRES) + (size_t)n * D;
#pragma unroll
        for (int i = 0; i < 4; ++i) st_bf8(xr + COL8(i), v[2 * i], v[2 * i + 1]);
        const float* mb = mod + ((size_t)0 * 4 + b) * (6 * D);
        modulate_store(v, mb, mb + D, INP8(0) ? (bf16_t*)(p.ws + WS_HA + (size_t)n * D) : (bf16_t*)(p.ws + WS_HA) + (size_t)n * D, lane, INP8(0));
    }
}

__device__ __forceinline__ void phase_mixer_valu(const Params& p, int l, LAS unsigned char* lds) {
    LAS float* qs = (LAS float*)lds; LAS float* ks = qs + 4096; LAS float* fs = ks + 4096; LAS float* vs = fs + 4096; LAS float* po = vs + 1024;
    int tid = threadIdx.x; asm volatile("" : "+v"(tid)); const int wave = tid >> 6, lane = tid & 63, kk = tid >> 5, vv = tid & 31;
    const bf16_t* proj = (const bf16_t*)(p.ws + WS_PROJ);
    float* obuf = (float*)(p.ws + WS_OBUF);
    for (int u = blockIdx.x; u < 384; u += gridDim.x) {
        const int vsl = u & 3, dir = (u >> 2) & 1, hh = (u >> 3) % 6, b = ((u >> 3) / 6) % 4, type = (u >> 3) / 24;
        float S[8];
#pragma unroll
        for (int j = 0; j < 8; ++j) S[j] = 0.f;
        const float gamma = 1.0f - exp2f(-(dir ? 5.5f : 5.0f) - (float)hh);
        for (int blk = 0; blk < 64; ++blk) {
            const int rb = dir ? 63 - blk : blk, t0 = rb * 32;
            if (type == 0) {
#pragma unroll
                for (int j = 0; j < 4; ++j) {
                    const int idx = tid + 512 * j, tt = idx >> 6, dp = idx & 63;
                    const bf16_t* row = proj + (size_t)(b * SEQ + t0 + tt) * INC;
                    const float q1 = bf2f(row[C_RQ + hh * 128 + dp]), q2 = bf2f(row[C_RQ + hh * 128 + 64 + dp]);
                    const float k1 = bf2f(row[C_RK + hh * 128 + dp]), k2 = bf2f(row[C_RK + hh * 128 + 64 + dp]);
                    const float inv_freq = exp2f(-(float)dp * (13.287712379549449f / 64.0f));
                    const float ang = (float)(t0 + tt) * inv_freq;
                    float rev = ang * 0.15915494309189535f; rev -= rintf(rev);
                    const float sn = __builtin_amdgcn_sinf(rev), cs = __builtin_amdgcn_cosf(rev);
                    qs[tt * 128 + dp] = q1 * cs - q2 * sn; qs[tt * 128 + 64 + dp] = q1 * sn + q2 * cs;
                    ks[tt * 128 + dp] = (k1 * cs - k2 * sn) * 0.08838834764831845f; ks[tt * 128 + 64 + dp] = (k1 * sn + k2 * cs) * 0.08838834764831845f;
                    fs[tt * 128 + dp] = gamma; fs[tt * 128 + 64 + dp] = gamma;
                }
            } else {
#pragma unroll
                for (int j = 0; j < 8; ++j) {
                    const int idx = tid + 512 * j, tt = idx >> 7, d = idx & 127;
                    const bf16_t* row = proj + (size_t)(b * SEQ + t0 + tt) * INC;
                    const float q = bf2f(row[C_HQ + hh * 128 + d]);
                    const float z = bf2f(row[(dir ? C_HFB : C_HFF) + hh * 128 + d]);
                    float lb = 0.f;
                    if (l > 0) { const float a0 = p.lb_logits[(0 * 2 + dir) * HWD + hh * 128 + d], a1 = p.lb_logits[(1 * 2 + dir) * HWD + hh * 128 + d]; lb = 1.0f / (1.0f + expf(a0 - a1)); }
                    float f = lb + (1.0f - lb) * (1.0f / (1.0f + expf(-z)));
                    f = fmaxf(f, 1e-6f);
                    qs[tt * 128 + d] = q; ks[tt * 128 + d] = 1.0f - f; fs[tt * 128 + d] = f;
                }
            }
#pragma unroll
            for (int j = 0; j < 2; ++j) {
                const int idx = tid + 512 * j, tt = idx >> 5, c = idx & 31;
                const bf16_t* row = proj + (size_t)(b * SEQ + t0 + tt) * INC;
                vs[tt * 32 + c] = bf2f(row[(type ? C_HI : C_RV) + hh * 128 + vsl * 32 + c]);
            }
            __syncthreads();
            for (int s = 0; s < 32; ++s) {
                const int ss = dir ? 31 - s : s;
                const f32x4 qa = *(const LAS f32x4*)(qs + ss * 128 + kk * 8), qb = *(const LAS f32x4*)(qs + ss * 128 + kk * 8 + 4);
                const f32x4 ka = *(const LAS f32x4*)(ks + ss * 128 + kk * 8), kb = *(const LAS f32x4*)(ks + ss * 128 + kk * 8 + 4);
                const f32x4 fa = *(const LAS f32x4*)(fs + ss * 128 + kk * 8), fb = *(const LAS f32x4*)(fs + ss * 128 + kk * 8 + 4);
                const float vval = vs[ss * 32 + vv];
                float acc = 0.f;
#pragma unroll
                for (int j = 0; j < 4; ++j) { S[j] = fa[j] * S[j] + ka[j] * vval; acc += S[j] * qa[j]; }
#pragma unroll
                for (int j = 0; j < 4; ++j) { S[4 + j] = fb[j] * S[4 + j] + kb[j] * vval; acc += S[4 + j] * qb[j]; }
                acc += __shfl_xor(acc, 32, 64);
                if (lane < 32) po[(ss * 8 + wave) * 32 + vv] = acc;
            }
            __syncthreads();
#pragma unroll
            for (int j = 0; j < 2; ++j) {
                const int idx = tid + 512 * j, tt = idx >> 5, c = idx & 31;
                float s = 0.f;
#pragma unroll
                for (int w = 0; w < 8; ++w) s += po[(tt * 8 + w) * 32 + c];
                obuf[((size_t)dir * T + (size_t)(b * SEQ + t0 + tt)) * 1536 + type * 768 + hh * 128 + vsl * 32 + c] = s;
            }
        }
        __syncthreads();
    }
}

constexpr int MX_QI = 0, MX_KI = 17408, MX_QS = 34816, MX_KTT = 52224, MX_VT = 70656, MX_P = 79872, MX_ST = 89088, MX_TOT = 106496, MX_DEC = 110592, MX_RQ = 112128, MX_RK = 128512, MX_RV = 144896;
__device__ __forceinline__ float ex2(float x) { return __builtin_amdgcn_exp2f(x); }
__device__ __forceinline__ float clampe(float x) { return fminf(fmaxf(x, -120.f), 120.f); }
template <int MODE>
__device__ __forceinline__ void phase_mixer_mfma(const Params& p, int l, LAS unsigned char* lds, float* __restrict__ obuf) {
    int tid = threadIdx.x; asm volatile("" : "+v"(tid));
    const int wave = __builtin_amdgcn_readfirstlane(tid >> 6), lane = tid & 63, fr = lane & 15, fq = lane >> 4;
    const bf16_t* proj = (const bf16_t*)(p.ws + WS_PROJ);
    const bool xmap = gridDim.x >= 192;
    for (int uu = blockIdx.x; uu < 192; uu += gridDim.x) {
        const int u = xmap ? (uu & 7) * 24 + (uu >> 3) : uu;
        const int vsl = u & 1, dir = (u >> 1) & 1, hh = (u >> 2) % 6, b = ((u >> 2) / 6) % 4, type = (u >> 2) / 24;
        float lg2 = 0.f, invf0 = 0.f, invf1 = 0.f, sgn = 1.f, lb0 = 0.f, lb1 = 0.f;
        if (type == 0) {
            const float gamma = 1.0f - exp2f(-(dir ? 5.5f : 5.0f) - (float)hh);
            lg2 = log2f(gamma);
            const int dm0 = (2 * lane) & 63;
            invf0 = exp2f(-(float)dm0 * (13.287712379549449f / 64.0f)); invf1 = exp2f(-(float)(dm0 + 1) * (13.287712379549449f / 64.0f));
            sgn = lane < 32 ? -1.f : 1.f;
        } else if (l > 0) {
            const float* lbl = p.lb_logits + dir * HWD + hh * 128 + 2 * lane;
            lb0 = 1.0f / (1.0f + expf(lbl[0] - lbl[2 * HWD])); lb1 = 1.0f / (1.0f + expf(lbl[1] - lbl[2 * HWD + 1]));
        }
        const int colA = (type ? C_HQ : C_RQ) + hh * 128, colB = (type ? (dir ? C_HFB : C_HFF) : C_RK) + hh * 128;
        const int colV0 = (type ? C_HI : C_RV) + hh * 128 + vsl * 64;
        const int own = 2 * lane, par = (2 * lane + 64) & 127;
        const size_t ocol = (size_t)type * 768 + hh * 128 + vsl * 64;
#define MX_LOAD(ch) do { \
            _Pragma("unroll") for (int i2 = 0; i2 < 2; ++i2) { const int pos = wave * 8 + i2 * 4 + (lane >> 4); const int tau = (ch) * 64 + pos; const int t = dir ? (SEQ - 1 - tau) : tau; \
                const bf16_t* row = proj + (size_t)(b * SEQ + t) * INC + (lane & 15) * 8; \
                __builtin_amdgcn_global_load_lds((const unsigned*)(row + colA), (LAS unsigned*)(lds + MX_RQ + (wave * 8 + i2 * 4) * 256), 16, 0, 0); \
                __builtin_amdgcn_global_load_lds((const unsigned*)(row + colB), (LAS unsigned*)(lds + MX_RK + (wave * 8 + i2 * 4) * 256), 16, 0, 0); } \
            { const int pos = wave * 8 + (lane >> 3); const int tau = (ch) * 64 + pos; const int t = dir ? (SEQ - 1 - tau) : tau; \
              const bf16_t* row = proj + (size_t)(b * SEQ + t) * INC + colV0 + (lane & 7) * 8; \
              __builtin_amdgcn_global_load_lds((const unsigned*)row, (LAS unsigned*)(lds + MX_RV + (wave * 8) * 128), 16, 0, 0); } } while (0)
        f32x4 Sacc[4];
#pragma unroll
        for (int vt = 0; vt < 4; ++vt) Sacc[vt] = (f32x4){0.f, 0.f, 0.f, 0.f};
        for (int i = tid; i < 64 * 272 / 4; i += 512) ((LAS unsigned*)(lds + MX_ST))[i] = 0u;
        float cd0 = 1.f, sd0 = 0.f, cd1 = 1.f, sd1 = 0.f;
        if (type == 0) {
            if (tid < 64) { const float fi = (float)tid; *(LAS f32x4*)(lds + MX_DEC + 512 + tid * 16) = (f32x4){ex2((fi - 31.f) * lg2), ex2((31.f - fi) * lg2), ex2((fi + 1.f) * lg2), ex2((63.f - fi) * lg2)}; }
            const float r0 = invf0 * 0.15915494309189535f, r1 = invf1 * 0.15915494309189535f, sg = dir ? -1.f : 1.f;
            cd0 = __builtin_amdgcn_cosf(r0); sd0 = sg * __builtin_amdgcn_sinf(r0); cd1 = __builtin_amdgcn_cosf(r1); sd1 = sg * __builtin_amdgcn_sinf(r1);
        }
        __syncthreads();
        MX_LOAD(0);
        asm volatile("s_waitcnt vmcnt(0)" ::: "memory");
        __syncthreads();
        for (int ch = 0; ch < 32; ++ch) {
            float q0[8], q1[8], k0[8], k1[8], c0[8], c1[8];
            float run0 = 0.f, run1 = 0.f;
            u32x4 vpk = (u32x4){0u, 0u, 0u, 0u};
#pragma unroll
            for (int j = 0; j < 8; ++j) { q0[j] = q1[j] = k0[j] = k1[j] = c0[j] = c1[j] = 0.f; }
            if (MODE != 3 && MODE != 4) {
            if (type == 0) {
                const int tau0 = ch * 64 + wave * 8; const int t0 = dir ? (SEQ - 1 - tau0) : tau0;
                float rev0 = (float)t0 * invf0 * 0.15915494309189535f, rev1 = (float)t0 * invf1 * 0.15915494309189535f;
                rev0 -= rintf(rev0); rev1 -= rintf(rev1);
                float sn0 = __builtin_amdgcn_sinf(rev0), cs0 = __builtin_amdgcn_cosf(rev0), sn1 = __builtin_amdgcn_sinf(rev1), cs1 = __builtin_amdgcn_cosf(rev1);
#pragma unroll
                for (int j = 0; j < 8; ++j) {
                    const int pos_ = wave * 8 + j;
                    const unsigned ra_ = *(const LAS unsigned*)(lds + MX_RQ + pos_ * 256 + own * 2), rb_ = *(const LAS unsigned*)(lds + MX_RK + pos_ * 256 + own * 2);
                    const unsigned rc_ = *(const LAS unsigned*)(lds + MX_RQ + pos_ * 256 + par * 2), rd_ = *(const LAS unsigned*)(lds + MX_RK + pos_ * 256 + par * 2);
                    const float a_lo = bf2f(ra_ & 0xffffu), a_hi = bf2f(ra_ >> 16), b_lo = bf2f(rb_ & 0xffffu), b_hi = bf2f(rb_ >> 16);
                    const float pa_lo = bf2f(rc_ & 0xffffu), pa_hi = bf2f(rc_ >> 16), pb_lo = bf2f(rd_ & 0xffffu), pb_hi = bf2f(rd_ >> 16);
                    const float ss0 = sgn * sn0, ss1 = sgn * sn1;
                    q0[j] = a_lo * cs0 + pa_lo * ss0; q1[j] = a_hi * cs1 + pa_hi * ss1;
                    k0[j] = (b_lo * cs0 + pb_lo * ss0) * 0.08838834764831845f; k1[j] = (b_hi * cs1 + pb_hi * ss1) * 0.08838834764831845f;
                    const float nc0 = cs0 * cd0 - sn0 * sd0, ns0 = sn0 * cd0 + cs0 * sd0, nc1 = cs1 * cd1 - sn1 * sd1, ns1 = sn1 * cd1 + cs1 * sd1;
                    cs0 = nc0; sn0 = ns0; cs1 = nc1; sn1 = ns1;
                    c0[j] = 0.f; c1[j] = 0.f;
                }
            } else {
#pragma unroll
                for (int j = 0; j < 8; ++j) {
                    const int pos_ = wave * 8 + j;
                    const unsigned ra_ = *(const LAS unsigned*)(lds + MX_RQ + pos_ * 256 + own * 2), rb_ = *(const LAS unsigned*)(lds + MX_RK + pos_ * 256 + own * 2);
                    const float a_lo = bf2f(ra_ & 0xffffu), a_hi = bf2f(ra_ >> 16), b_lo = bf2f(rb_ & 0xffffu), b_hi = bf2f(rb_ >> 16);
                    q0[j] = a_lo; q1[j] = a_hi;
                    float f0 = lb0 + (1.0f - lb0) * __builtin_amdgcn_rcpf(1.0f + ex2(-b_lo * 1.4426950408889634f));
                    float f1 = lb1 + (1.0f - lb1) * __builtin_amdgcn_rcpf(1.0f + ex2(-b_hi * 1.4426950408889634f));
                    f0 = fmaxf(f0, 1e-6f); f1 = fmaxf(f1, 1e-6f);
                    k0[j] = 1.0f - f0; k1[j] = 1.0f - f1;
                    run0 += __builtin_amdgcn_logf(f0); run1 += __builtin_amdgcn_logf(f1); c0[j] = run0; c1[j] = run1;
                }
            }
            { unsigned rv[8];
#pragma unroll
              for (int j = 0; j < 8; ++j) rv[j] = *(const LAS unsigned short*)(lds + MX_RV + (wave * 8 + j) * 128 + lane * 2);
              vpk[0] = rv[0] | (rv[1] << 16); vpk[1] = rv[2] | (rv[3] << 16); vpk[2] = rv[4] | (rv[5] << 16); vpk[3] = rv[6] | (rv[7] << 16); }
            }
            { typedef float f32x2_ __attribute__((ext_vector_type(2))); *(LAS f32x2_*)(lds + MX_TOT + (wave * 128 + 2 * lane) * 4) = (f32x2_){run0, run1}; }
            LDS_BARRIER();
            if (ch + 1 < 32) MX_LOAD(ch + 1);
            float kt0[8], kt1[8];
            float tt0, tt1;
#pragma unroll
            for (int j = 0; j < 8; ++j) { kt0[j] = kt1[j] = 0.f; }
            tt0 = tt1 = 0.f;
            if (MODE != 3 && MODE != 4) {
            if (type == 0) {
                tt0 = tt1 = 64.f * lg2;
#pragma unroll
                for (int j = 0; j < 8; ++j) {
                    const int pos = wave * 8 + j;
                    const f32x4 e = *(const LAS f32x4*)(lds + MX_DEC + 512 + pos * 16);
                    *(LAS unsigned*)(lds + MX_QI + pos * 272 + lane * 4) = pack2(q0[j] * e[0], q1[j] * e[0]);
                    *(LAS unsigned*)(lds + MX_KI + pos * 272 + lane * 4) = pack2(k0[j] * e[1], k1[j] * e[1]);
                    kt0[j] = k0[j] * e[3]; kt1[j] = k1[j] * e[3];
                }
            } else {
                float off0 = 0.f, off1 = 0.f, m0 = 0.f, m1 = 0.f; tt0 = 0.f; tt1 = 0.f;
#pragma unroll
                for (int g = 0; g < 8; ++g) {
                    typedef float f32x2_ __attribute__((ext_vector_type(2)));
                    const f32x2_ tv = *(const LAS f32x2_*)(lds + MX_TOT + (g * 128 + 2 * lane) * 4);
                    if (g < wave) { off0 += tv[0]; off1 += tv[1]; }
                    if (g < 4) { m0 += tv[0]; m1 += tv[1]; }
                    tt0 += tv[0]; tt1 += tv[1];
                }
                const float etm0 = ex2(tt0 - m0), etm1 = ex2(tt1 - m1);
#pragma unroll
                for (int j = 0; j < 8; ++j) {
                    const float cu0 = c0[j] + off0, cu1 = c1[j] + off1;
                    const float e10 = ex2(clampe(cu0 - m0)), e11 = ex2(clampe(cu1 - m1));
                    const float e20 = __builtin_amdgcn_rcpf(e10), e21 = __builtin_amdgcn_rcpf(e11);
                    const int pos = wave * 8 + j;
                    *(LAS unsigned*)(lds + MX_QI + pos * 272 + lane * 4) = pack2(q0[j] * e10, q1[j] * e11);
                    *(LAS unsigned*)(lds + MX_KI + pos * 272 + lane * 4) = pack2(k0[j] * e20, k1[j] * e21);
                    kt0[j] = k0[j] * (e20 * etm0); kt1[j] = k1[j] * (e21 * etm1);
                }
            }
            }
            { u32x4 w0, w1;
              w0[0] = pack2(kt0[0], kt0[1]); w0[1] = pack2(kt0[2], kt0[3]); w0[2] = pack2(kt0[4], kt0[5]); w0[3] = pack2(kt0[6], kt0[7]);
              w1[0] = pack2(kt1[0], kt1[1]); w1[1] = pack2(kt1[2], kt1[3]); w1[2] = pack2(kt1[4], kt1[5]); w1[3] = pack2(kt1[6], kt1[7]);
              *(LAS u32x4*)(lds + MX_KTT + (2 * lane) * 144 + wave * 16) = w0;
              *(LAS u32x4*)(lds + MX_KTT + (2 * lane + 1) * 144 + wave * 16) = w1;
              *(LAS u32x4*)(lds + MX_VT + lane * 144 + wave * 16) = vpk; }
            if (MODE != 3 && MODE != 4) {
                f32x4 em;
                if (type == 0) { const float e_ = ex2(32.f * lg2); em = (f32x4){e_, e_, e_, e_}; }
                else {
                    f32x4 ms = (f32x4){0.f, 0.f, 0.f, 0.f};
#pragma unroll
                    for (int g = 0; g < 4; ++g) ms += *(const LAS f32x4*)(lds + MX_TOT + (g * 128 + 16 * wave + 4 * fq) * 4);
                    em = (f32x4){ex2(ms[0]), ex2(ms[1]), ex2(ms[2]), ex2(ms[3])};
                }
#pragma unroll
                for (int vt = 0; vt < 4; ++vt) { u32x2 o; o[0] = pack2(Sacc[vt][0] * em[0], Sacc[vt][1] * em[1]); o[1] = pack2(Sacc[vt][2] * em[2], Sacc[vt][3] * em[3]);
                    *(LAS u32x2*)(lds + MX_ST + (16 * vt + fr) * 272 + (16 * wave + 4 * fq) * 2) = o; }
            }
            if (wave == 0) { typedef float f32x2_ __attribute__((ext_vector_type(2))); *(LAS f32x2_*)(lds + MX_DEC + lane * 8) = (f32x2_){ex2(tt0), ex2(tt1)}; }
            LDS_BARRIER();
            if (MODE != 2 && MODE != 4) {
                const int it = wave >> 1, st0 = 2 * (wave & 1);
                bf16x8 ka[2][4], qb[4];
#pragma unroll
                for (int kq = 0; kq < 4; ++kq) {
                    qb[kq] = *(const LAS bf16x8*)(lds + MX_QI + (16 * it + fr) * 272 + (32 * kq + 8 * fq) * 2);
                    ka[0][kq] = *(const LAS bf16x8*)(lds + MX_KI + (16 * st0 + fr) * 272 + (32 * kq + 8 * fq) * 2);
                    ka[1][kq] = *(const LAS bf16x8*)(lds + MX_KI + (16 * st0 + 16 + fr) * 272 + (32 * kq + 8 * fq) * 2);
                }
                asm volatile("s_waitcnt lgkmcnt(0)" ::: "memory");
                f32x4 acc0 = (f32x4){0.f, 0.f, 0.f, 0.f}, acc1 = acc0;
#pragma unroll
                for (int kq = 0; kq < 4; ++kq) {
                    acc0 = __builtin_amdgcn_mfma_f32_16x16x32_bf16(ka[0][kq], qb[kq], acc0, 0, 0, 0);
                    acc1 = __builtin_amdgcn_mfma_f32_16x16x32_bf16(ka[1][kq], qb[kq], acc1, 0, 0, 0);
                }
                const int i = 16 * it + fr;
                { const int s0 = 16 * st0 + 4 * fq;
                  const float v0 = (s0 + 0 <= i) ? acc0[0] : 0.f, v1 = (s0 + 1 <= i) ? acc0[1] : 0.f, v2 = (s0 + 2 <= i) ? acc0[2] : 0.f, v3 = (s0 + 3 <= i) ? acc0[3] : 0.f;
                  u32x2 o; o[0] = pack2(v0, v1); o[1] = pack2(v2, v3);
                  *(LAS u32x2*)(lds + MX_P + i * 144 + s0 * 2) = o; }
                { const int s0 = 16 * st0 + 16 + 4 * fq;
                  const float v0 = (s0 + 0 <= i) ? acc1[0] : 0.f, v1 = (s0 + 1 <= i) ? acc1[1] : 0.f, v2 = (s0 + 2 <= i) ? acc1[2] : 0.f, v3 = (s0 + 3 <= i) ? acc1[3] : 0.f;
                  u32x2 o; o[0] = pack2(v0, v1); o[1] = pack2(v2, v3);
                  *(LAS u32x2*)(lds + MX_P + i * 144 + s0 * 2) = o; }
            }
            LDS_BARRIER();
            if (MODE != 2 && MODE != 4) {
                const int vt = wave >> 1, it0 = 2 * (wave & 1);
                bf16x8 va[2], sa[4], pb[2][2], qsb[2][4], kta[2], vb[4][2];
#pragma unroll
                for (int kq = 0; kq < 2; ++kq) {
                    va[kq] = *(const LAS bf16x8*)(lds + MX_VT + (16 * vt + fr) * 144 + (32 * kq + 8 * fq) * 2);
                    pb[0][kq] = *(const LAS bf16x8*)(lds + MX_P + (16 * it0 + fr) * 144 + (32 * kq + 8 * fq) * 2);
                    pb[1][kq] = *(const LAS bf16x8*)(lds + MX_P + (16 * it0 + 16 + fr) * 144 + (32 * kq + 8 * fq) * 2);
                    kta[kq] = *(const LAS bf16x8*)(lds + MX_KTT + (16 * wave + fr) * 144 + (32 * kq + 8 * fq) * 2);
                }
#pragma unroll
                for (int kq = 0; kq < 4; ++kq) {
                    sa[kq] = *(const LAS bf16x8*)(lds + MX_ST + (16 * vt + fr) * 272 + (32 * kq + 8 * fq) * 2);
                    qsb[0][kq] = *(const LAS bf16x8*)(lds + MX_QI + (16 * it0 + fr) * 272 + (32 * kq + 8 * fq) * 2);
                    qsb[1][kq] = *(const LAS bf16x8*)(lds + MX_QI + (16 * it0 + 16 + fr) * 272 + (32 * kq + 8 * fq) * 2);
                }
#pragma unroll
                for (int v4 = 0; v4 < 4; ++v4)
#pragma unroll
                    for (int kq = 0; kq < 2; ++kq) vb[v4][kq] = *(const LAS bf16x8*)(lds + MX_VT + (16 * v4 + fr) * 144 + (32 * kq + 8 * fq) * 2);
                const f32x4 dc = *(const LAS f32x4*)(lds + MX_DEC + (16 * wave + 4 * fq) * 4);
                asm volatile("s_waitcnt lgkmcnt(0)" ::: "memory");
                f32x4 acc0 = (f32x4){0.f, 0.f, 0.f, 0.f}, acc1 = acc0;
#pragma unroll
                for (int kq = 0; kq < 2; ++kq) {
                    acc0 = __builtin_amdgcn_mfma_f32_16x16x32_bf16(va[kq], pb[0][kq], acc0, 0, 0, 0);
                    acc1 = __builtin_amdgcn_mfma_f32_16x16x32_bf16(va[kq], pb[1][kq], acc1, 0, 0, 0);
                }
#pragma unroll
                for (int kq = 0; kq < 4; ++kq) {
                    acc0 = __builtin_amdgcn_mfma_f32_16x16x32_bf16(sa[kq], qsb[0][kq], acc0, 0, 0, 0);
                    acc1 = __builtin_amdgcn_mfma_f32_16x16x32_bf16(sa[kq], qsb[1][kq], acc1, 0, 0, 0);
                }
#pragma unroll
                for (int v4 = 0; v4 < 4; ++v4) {
                    f32x4 a = Sacc[v4]; a[0] *= dc[0]; a[1] *= dc[1]; a[2] *= dc[2]; a[3] *= dc[3];
                    a = __builtin_amdgcn_mfma_f32_16x16x32_bf16(kta[0], vb[v4][0], a, 0, 0, 0);
                    a = __builtin_amdgcn_mfma_f32_16x16x32_bf16(kta[1], vb[v4][1], a, 0, 0, 0);
                    Sacc[v4] = a;
                }
                asm volatile("s_waitcnt vmcnt(0)" ::: "memory");
                { const int tau = ch * 64 + 16 * it0 + fr; const int t = dir ? (SEQ - 1 - tau) : tau;
                  u32x2 o; o[0] = pack2(acc0[0], acc0[1]); o[1] = pack2(acc0[2], acc0[3]);
                  *(u32x2*)((bf16_t*)obuf + ((size_t)dir * T + (size_t)(b * SEQ + t)) * 1536 + ocol + 16 * vt + 4 * fq) = o; }
                { const int tau = ch * 64 + 16 * it0 + 16 + fr; const int t = dir ? (SEQ - 1 - tau) : tau;
                  u32x2 o; o[0] = pack2(acc1[0], acc1[1]); o[1] = pack2(acc1[2], acc1[3]);
                  *(u32x2*)((bf16_t*)obuf + ((size_t)dir * T + (size_t)(b * SEQ + t)) * 1536 + ocol + 16 * vt + 4 * fq) = o; }
            }
        }
        __syncthreads();
#undef MX_LOAD
    }
}

#ifdef MIXER_CHECK
__device__ __forceinline__ void phase_mixer_check(const Params& p, const float* __restrict__ oa, const float* __restrict__ ob, float* chk) {
    int tid_ = threadIdx.x; asm volatile("" : "+v"(tid_)); const int wave = __builtin_amdgcn_readfirstlane(tid_ >> 6), lane = tid_ & 63;
    for (int r = blockIdx.x * 8 + wave; r < 2 * T; r += gridDim.x * 8) {
        const int dir = r / T;
#pragma unroll
        for (int ty = 0; ty < 2; ++ty) {
            float sd = 0.f, sq = 0.f;
#pragma unroll
            for (int i = 0; i < 3; ++i) { const float4 a = *(const float4*)(oa + (size_t)r * 1536 + ty * 768 + i * 256 + lane * 4), bq = *(const float4*)(ob + (size_t)r * 1536 + ty * 768 + i * 256 + lane * 4);
                sd += (a.x - bq.x) * (a.x - bq.x) + (a.y - bq.y) * (a.y - bq.y) + (a.z - bq.z) * (a.z - bq.z) + (a.w - bq.w) * (a.w - bq.w);
                sq += a.x * a.x + a.y * a.y + a.z * a.z + a.w * a.w; }
            sd = wave_sum(sd); sq = wave_sum(sq);
            if (lane == 0) { atomicAdd(&chk[(ty * 2 + dir) * 2 + 0], sd); atomicAdd(&chk[(ty * 2 + dir) * 2 + 1], sq); }
        }
    }
}
#endif

__device__ __forceinline__ float4 ld_bf4(const bf16_t* p) { const u32x2 r = *(const u32x2*)p; return make_float4(bf2f(r[0] & 0xffffu), bf2f(r[0] >> 16), bf2f(r[1] & 0xffffu), bf2f(r[1] >> 16)); }
__device__ __forceinline__ float grp16_sum(float v) {
#pragma unroll
    for (int o = 8; o > 0; o >>= 1) v += __shfl_xor(v, o, 64);
    return v;
}
__device__ __forceinline__ void phase_finalize(const Params& p, int l) {
    int tid_ = threadIdx.x; asm volatile("" : "+v"(tid_)); const int wave = __builtin_amdgcn_readfirstlane(tid_ >> 6), lane = tid_ & 63;
    const bf16_t* proj = (const bf16_t*)(p.ws + WS_PROJ);
    const bf16_t* obuf = (const bf16_t*)(p.ws + WS_OBUF);
    bf16_t* mixed = (bf16_t*)(p.ws + WS_MIXED);
    const float* cw = p.conv_w + (size_t)l * 3 * CW;
    const float* beta = p.mix_beta + (size_t)l * D;
    for (int n = blockIdx.x * 8 + wave; n < T; n += gridDim.x * 8) {
        const int t = n % SEQ;
        const bf16_t* row = proj + (size_t)n * INC;
#pragma unroll
        for (int i = 0; i < 4; ++i) {
            const int c = COL8(i);
            float4 r[2];
            if (i == 0) {
                float4 cc[2], ch[2], cb[2], um[2], up[2];
                ld_bf8(row + C_CC + c, cc[0], cc[1]); ld_bf8(row + C_CH + c, ch[0], ch[1]); ld_bf8(row + C_CB + c, cb[0], cb[1]);
                um[0] = um[1] = up[0] = up[1] = make_float4(0.f, 0.f, 0.f, 0.f);
                if (t > 0) { float4 a[2], b2[2]; ld_bf8(row - INC + C_CC + c, a[0], a[1]); ld_bf8(row - INC + C_CH + c, b2[0], b2[1]);
#pragma unroll
                    for (int q = 0; q < 2; ++q) um[q] = make_float4(a[q].x * b2[q].x, a[q].y * b2[q].y, a[q].z * b2[q].z, a[q].w * b2[q].w); }
                if (t < SEQ - 1) { float4 a[2], b2[2]; ld_bf8(row + INC + C_CC + c, a[0], a[1]); ld_bf8(row + INC + C_CH + c, b2[0], b2[1]);
#pragma unroll
                    for (int q = 0; q < 2; ++q) up[q] = make_float4(a[q].x * b2[q].x, a[q].y * b2[q].y, a[q].z * b2[q].z, a[q].w * b2[q].w); }
#pragma unroll
                for (int q = 0; q < 2; ++q) {
                    const float4 w0 = *(const float4*)(cw + c + 4 * q), w1 = *(const float4*)(cw + CW + c + 4 * q), w2 = *(const float4*)(cw + 2 * CW + c + 4 * q);
                    r[q].x = cb[q].x * (um[q].x * w0.x + cc[q].x * ch[q].x * w1.x + up[q].x * w2.x);
                    r[q].y = cb[q].y * (um[q].y * w0.y + cc[q].y * ch[q].y * w1.y + up[q].y * w2.y);
                    r[q].z = cb[q].z * (um[q].z * w0.z + cc[q].z * ch[q].z * w1.z + up[q].z * w2.z);
                    r[q].w = cb[q].w * (um[q].w * w0.w + cc[q].w * ch[q].w * w1.w + up[q].w * w2.w);
                }
            } else {
                const int oc = c - 512;
                const bool isret = oc < 768;
                float4 of[2], ob[2], gt[2];
                ld_bf8(obuf + (size_t)n * 1536 + oc, of[0], of[1]); ld_bf8(obuf + ((size_t)T + n) * 1536 + oc, ob[0], ob[1]);
                ld_bf8(row + (isret ? C_RG + oc : C_HG + (oc - 768)), gt[0], gt[1]);
                float4 o[2];
#pragma unroll
                for (int q = 0; q < 2; ++q) o[q] = make_float4(of[q].x + ob[q].x, of[q].y + ob[q].y, of[q].z + ob[q].z, of[q].w + ob[q].w);
                const float sm = grp16_sum(((o[0].x + o[0].y) + (o[0].z + o[0].w)) + ((o[1].x + o[1].y) + (o[1].z + o[1].w)));
                const float mu = isret ? sm * (1.0f / 128.0f) : 0.f;
#pragma unroll
                for (int q = 0; q < 2; ++q) { o[q].x -= mu; o[q].y -= mu; o[q].z -= mu; o[q].w -= mu; }
                const float var = grp16_sum(((o[0].x * o[0].x + o[0].y * o[0].y) + (o[0].z * o[0].z + o[0].w * o[0].w)) + ((o[1].x * o[1].x + o[1].y * o[1].y) + (o[1].z * o[1].z + o[1].w * o[1].w))) * (1.0f / 128.0f);
                const float rs = rsqrtf(var + 1e-6f);
#pragma unroll
                for (int q = 0; q < 2; ++q) r[q] = make_float4(o[q].x * rs * siluf_(gt[q].x), o[q].y * rs * siluf_(gt[q].y), o[q].z * rs * siluf_(gt[q].z), o[q].w * rs * siluf_(gt[q].w));
            }
            const float4 bt0 = *(const float4*)(beta + c), bt1 = *(const float4*)(beta + c + 4);
            r[0] = make_float4(r[0].x * bt0.x, r[0].y * bt0.y, r[0].z * bt0.z, r[0].w * bt0.w);
            r[1] = make_float4(r[1].x * bt1.x, r[1].y * bt1.y, r[1].z * bt1.z, r[1].w * bt1.w);
            if (OUT8(l)) { const float4 a4 = make_float4(r[0].x * 4.f, r[0].y * 4.f, r[0].z * 4.f, r[0].w * 4.f), b4 = make_float4(r[1].x * 4.f, r[1].y * 4.f, r[1].z * 4.f, r[1].w * 4.f);
                           st_fp8x8((unsigned char*)mixed + (size_t)n * D + c, a4, b4); }
            else st_bf8(mixed + (size_t)n * D + c, r[0], r[1]);
        }
    }
}

#define RGRP 4
#if RGRP == 4
#define LN1_SB() __builtin_amdgcn_sched_barrier(0)
#else
#define LN1_SB()
#endif
__device__ __forceinline__ void phase_ln1_router(const Params& p, int l, LAS unsigned char* lds, bool prefetched) {
    int tid = threadIdx.x; asm volatile("" : "+v"(tid)); const int wave = __builtin_amdgcn_readfirstlane(tid >> 6), lane = tid & 63;
    LAS float* wrt = (LAS float*)lds;
#if MK_FUSED
    (void)prefetched;
#else
    {
        const unsigned char* wg = p.ws + WS_WRT;
#pragma unroll
        for (int j = 0; j < 16; ++j) {
            const int ch = wave * 16 + j;
            __builtin_amdgcn_global_load_lds((const unsigned*)(wg + (size_t)ch * 1024 + lane * 16), (LAS unsigned*)(lds + ch * 1024), 16, 0, 0);
        }
    }
#endif
    LAS int* lcnt = (LAS int*)(lds + LDS_MISC + 256);
    if (tid < 16) lcnt[tid] = 0;
    asm volatile("s_waitcnt vmcnt(0)" ::: "memory");
    __syncthreads();
    const float* mod = (const float*)(p.ws + WS_MOD);
    const float* y = (const float*)(p.ws + WS_Y);
    float* xres = (float*)(p.ws + WS_XRES);
    int* route = (int*)(p.ws + WS_ROUTE);
    for (int n0 = (blockIdx.x * 8 + wave) * RGRP; n0 < T; n0 += gridDim.x * 8 * RGRP) {
        float4 h[RGRP][8];
        {
            const int b = n0 / SEQ;
            const float* mb = mod + ((size_t)l * 4 + b) * (6 * D);
#pragma unroll
            for (int i = 0; i < 4; ++i) {
                float4 xv[RGRP][2], yv[RGRP][2];
#pragma unroll
                for (int r = 0; r < RGRP; ++r) { ld_bf8((const bf16_t*)xres + (size_t)(n0 + r) * D + COL8(i), xv[r][0], xv[r][1]); ld_bf8((const bf16_t*)y + (size_t)(n0 + r) * D + COL8(i), yv[r][0], yv[r][1]); }
#pragma unroll
                for (int q = 0; q < 2; ++q) {
                    const float4 g = *(const float4*)(mb + 2 * D + COLK(2 * i + q));
#pragma unroll
                    for (int r = 0; r < RGRP; ++r)
                        h[r][2 * i + q] = make_float4(ALPHA * xv[r][q].x + (1.f + g.x) * yv[r][q].x, ALPHA * xv[r][q].y + (1.f + g.y) * yv[r][q].y, ALPHA * xv[r][q].z + (1.f + g.z) * yv[r][q].z, ALPHA * xv[r][q].w + (1.f + g.w) * yv[r][q].w);
                }
                LN1_SB();
            }
            float mean[RGRP], rstd[RGRP];
#pragma unroll
            for (int r = 0; r < RGRP; ++r) {
                float s0 = 0.f;
#pragma unroll
                for (int i = 0; i < 8; ++i) s0 += (h[r][i].x + h[r][i].y) + (h[r][i].z + h[r][i].w);
                mean[r] = s0;
            }
#pragma unroll
            for (int o = 32; o > 0; o >>= 1)
#pragma unroll
                for (int r = 0; r < RGRP; ++r) mean[r] += __shfl_xor(mean[r], o, 64);
#pragma unroll
            for (int r = 0; r < RGRP; ++r) {
                mean[r] *= (1.0f / D);
                float q0 = 0.f;
#pragma unroll
                for (int i = 0; i < 8; ++i) { const float a = h[r][i].x - mean[r], bb = h[r][i].y - mean[r], c = h[r][i].z - mean[r], d = h[r][i].w - mean[r]; q0 += (a * a + bb * bb) + (c * c + d * d); }
                rstd[r] = q0;
            }
#pragma unroll
            for (int o = 32; o > 0; o >>= 1)
#pragma unroll
                for (int r = 0; r < RGRP; ++r) rstd[r] += __shfl_xor(rstd[r], o, 64);
#pragma unroll
            for (int r = 0; r < RGRP; ++r) rstd[r] = rsqrtf(rstd[r] * (1.0f / D) + 1e-5f);
            const float* lg_ = p.ln_g + (size_t)(l * 2 + 0) * D; const float* lb_ = p.ln_b + (size_t)(l * 2 + 0) * D;
            LN1_SB();
#pragma unroll
            for (int i = 0; i < 8; ++i) {
                const float4 gv = *(const float4*)(lg_ + COLK(i)), bv = *(const float4*)(lb_ + COLK(i));
#pragma unroll
                for (int r = 0; r < RGRP; ++r) {
                    float4& v = h[r][i];
                    v.x = (v.x - mean[r]) * rstd[r] * gv.x + bv.x; v.y = (v.y - mean[r]) * rstd[r] * gv.y + bv.y;
                    v.z = (v.z - mean[r]) * rstd[r] * gv.z + bv.z; v.w = (v.w - mean[r]) * rstd[r] * gv.w + bv.w;
                }
                if (i & 1) LN1_SB();
            }
#pragma unroll
            for (int r = 0; r < RGRP; ++r)
#pragma unroll
                for (int i = 0; i < 4; ++i) st_bf8((bf16_t*)xres + (size_t)(n0 + r) * D + COL8(i), h[r][2 * i], h[r][2 * i + 1]);
            LN1_SB();
#pragma unroll
            for (int i = 0; i < 8; ++i) {
                const float4 sh = *(const float4*)(mb + 3 * D + COLK(i)), sc = *(const float4*)(mb + 4 * D + COLK(i));
#pragma unroll
                for (int r = 0; r < RGRP; ++r) {
                    float4& v = h[r][i];
                    v.x = v.x * (1.f + sc.x) + sh.x; v.y = v.y * (1.f + sc.y) + sh.y; v.z = v.z * (1.f + sc.z) + sh.z; v.w = v.w * (1.f + sc.w) + sh.w;
                }
                if (i & 1) LN1_SB();
            }
#pragma unroll
            for (int r = 0; r < RGRP; ++r) {
#if MOE_FP8
                unsigned char* hb = p.ws + WS_HB + (size_t)(n0 + r) * D;
#pragma unroll
                for (int i = 0; i < 4; ++i) st_fp8x8(hb + COL8(i), h[r][2 * i], h[r][2 * i + 1]);
#else
                bf16_t* hb = (bf16_t*)(p.ws + WS_HB) + (size_t)(n0 + r) * D;
#pragma unroll
                for (int i = 0; i < 4; ++i) st_bf8(hb + COL8(i), h[r][2 * i], h[r][2 * i + 1]);
#endif
            }
        }
        float lgk0 = 0.f, lgk1 = 0.f, lgk2 = 0.f, lgk3 = 0.f;
        const bool b5 = (lane & 32) != 0, b4 = (lane & 16) != 0, b3 = (lane & 8) != 0, b2 = (lane & 4) != 0;
#pragma unroll 1
        for (int eg = 0; eg < 4; ++eg) {
            float s[RGRP][4];
#pragma unroll
            for (int q = 0; q < 4; ++q) {
                f32x2_t ac[RGRP];
#pragma unroll
                for (int r = 0; r < RGRP; ++r) ac[r] = (f32x2_t){0.f, 0.f};
#pragma unroll
                for (int i = 0; i < 8; ++i) {
                    const f32x4 w = *(const LAS f32x4*)(wrt + (eg * 4 + q) * D + i * 256 + lane * 4);
                    const f32x2_t w01 = __builtin_shufflevector(w, w, 0, 1), w23 = __builtin_shufflevector(w, w, 2, 3);
#pragma unroll
                    for (int r = 0; r < RGRP; ++r) {
                        ac[r] = __builtin_elementwise_fma((f32x2_t){h[r][i].x, h[r][i].y}, w01, ac[r]);
                        ac[r] = __builtin_elementwise_fma((f32x2_t){h[r][i].z, h[r][i].w}, w23, ac[r]);
                    }
                }
#pragma unroll
                for (int r = 0; r < RGRP; ++r) s[r][q] = ac[r][0] + ac[r][1];
                LN1_SB();
            }
            float u[RGRP];
#pragma unroll
            for (int r = 0; r < RGRP; ++r) {
                const float tA = (b5 ? s[r][2] : s[r][0]) + __shfl_xor(b5 ? s[r][0] : s[r][2], 32, 64);
                const float tB = (b5 ? s[r][3] : s[r][1]) + __shfl_xor(b5 ? s[r][1] : s[r][3], 32, 64);
                u[r] = (b4 ? tB : tA) + __shfl_xor(b4 ? tA : tB, 16, 64);
            }
#if RGRP == 4
            const float pA = (b3 ? u[2] : u[0]) + __shfl_xor(b3 ? u[0] : u[2], 8, 64);
            const float pB = (b3 ? u[3] : u[1]) + __shfl_xor(b3 ? u[1] : u[3], 8, 64);
            float z = (b2 ? pB : pA) + __shfl_xor(b2 ? pA : pB, 4, 64);
#else
            float z = (b3 ? u[1] : u[0]) + __shfl_xor(b3 ? u[0] : u[1], 8, 64);
            z += __shfl_xor(z, 4, 64);
#endif
            z += __shfl_xor(z, 2, 64); z += __shfl_xor(z, 1, 64);
            lgk0 = (eg == 0) ? z : lgk0; lgk1 = (eg == 1) ? z : lgk1; lgk2 = (eg == 2) ? z : lgk2; lgk3 = (eg == 3) ? z : lgk3;
        }
#if RGRP == 4
        {
            const int rr_ = lane >> 4, ee = lane & 15, qq = ee & 3, gg = ee >> 2;
            const int src = ((qq >> 1) * 32) + ((qq & 1) * 16) + (rr_ >> 1) * 8 + (rr_ & 1) * 4;
            const float c0 = __shfl(lgk0, src, 64), c1 = __shfl(lgk1, src, 64), c2 = __shfl(lgk2, src, 64), c3 = __shfl(lgk3, src, 64);
            const float lgt = gg == 0 ? c0 : gg == 1 ? c1 : gg == 2 ? c2 : c3;
            float mx = lgt;
#pragma unroll
            for (int o = 8; o > 0; o >>= 1) mx = fmaxf(mx, __shfl_xor(mx, o, 64));
            const float ex = expf(lgt - mx);
            float sum = ex;
#pragma unroll
            for (int o = 8; o > 0; o >>= 1) sum += __shfl_xor(sum, o, 64);
            const float sc = ex * (1.0f / sum);
            const float sel = sc + p.router_bias[ee];
            int rank = 0;
#pragma unroll
            for (int j = 1; j < 4; ++j) { const float o = __shfl_xor(sel, j, 64); rank += (o > sel || (o == sel && (ee ^ j) < ee)) ? 1 : 0; }
            const float top2 = rank < 2 ? sel : 0.f;
            float gs = top2 + __shfl_xor(top2, 1, 64); gs += __shfl_xor(gs, 2, 64);
            int grank = 0;
#pragma unroll
            for (int j = 1; j < 4; ++j) { const float o = __shfl_xor(gs, 4 * j, 64); grank += (o > gs || (o == gs && (gg ^ j) < gg)) ? 1 : 0; }
            const unsigned long long m0 = __ballot(grank == 0 && rank == 0), m1 = __ballot(grank == 0 && rank == 1);
            const int myr = lane & 3;
            const int bi0 = __builtin_ctz(((unsigned)(m0 >> (16 * myr)) & 0xffffu) | 0x10000u), bi1 = __builtin_ctz(((unsigned)(m1 >> (16 * myr)) & 0xffffu) | 0x10000u);
            const float bw0 = __shfl(sc, myr * 16 + (bi0 & 15), 64), bw1 = __shfl(sc, myr * 16 + (bi1 & 15), 64);
            if (lane < 4) {
                const int n = n0 + lane;
                const float ws_ = 1.0f / (bw0 + bw1);
                const int p0 = __hip_atomic_fetch_add(&lcnt[bi0], 1, __ATOMIC_RELAXED, __HIP_MEMORY_SCOPE_WORKGROUP), p1 = __hip_atomic_fetch_add(&lcnt[bi1], 1, __ATOMIC_RELAXED, __HIP_MEMORY_SCOPE_WORKGROUP);
                int* rr = route + (size_t)n * 8;
                rr[0] = bi0; rr[1] = bi1; rr[2] = (int)p0; rr[3] = (int)p1; rr[4] = __float_as_int(bw0 * ws_); rr[5] = __float_as_int(bw1 * ws_);
            }
        }
#else
#pragma unroll 1
        for (int r = 0; r < RGRP; ++r) {
            const int n = n0 + r;
            const int rl = (RGRP == 4) ? (r >> 1) * 8 + (r & 1) * 4 : r * 8;
            float lg[16];
#pragma unroll
            for (int q = 0; q < 4; ++q) {
                const int src = ((q >> 1) * 32) + ((q & 1) * 16) + rl;
                lg[0 + q] = __int_as_float(__builtin_amdgcn_readlane(__float_as_int(lgk0), src));
                lg[4 + q] = __int_as_float(__builtin_amdgcn_readlane(__float_as_int(lgk1), src));
                lg[8 + q] = __int_as_float(__builtin_amdgcn_readlane(__float_as_int(lgk2), src));
                lg[12 + q] = __int_as_float(__builtin_amdgcn_readlane(__float_as_int(lgk3), src));
            }
            float mx = lg[0];
#pragma unroll
            for (int e = 1; e < 16; ++e) mx = fmaxf(mx, lg[e]);
            float sc[16], sum = 0.f;
#pragma unroll
            for (int e = 0; e < 16; ++e) { sc[e] = expf(lg[e] - mx); sum += sc[e]; }
            const float inv = 1.0f / sum;
            float sel[16];
#pragma unroll
            for (int e = 0; e < 16; ++e) { sc[e] *= inv; sel[e] = sc[e] + p.router_bias[e]; }
            float best_gs = -3.0e38f; int bi0 = 0, bi1 = 1; float bw0 = 0.f, bw1 = 0.f;
#pragma unroll
            for (int g = 0; g < 4; ++g) {
                int i0 = 0; float m0 = sel[4 * g];
#pragma unroll
                for (int j = 1; j < 4; ++j) if (sel[4 * g + j] > m0) { m0 = sel[4 * g + j]; i0 = j; }
                int i1 = -1; float m1 = -3.0e38f;
#pragma unroll
                for (int j = 0; j < 4; ++j) if (j != i0 && sel[4 * g + j] > m1) { m1 = sel[4 * g + j]; i1 = j; }
                float w0 = 0.f, w1 = 0.f;
#pragma unroll
                for (int j = 0; j < 4; ++j) { w0 = (j == i0) ? sc[4 * g + j] : w0; w1 = (j == i1) ? sc[4 * g + j] : w1; }
                const float gs = m0 + m1;
                if (gs > best_gs) { best_gs = gs; bi0 = 4 * g + i0; bi1 = 4 * g + i1; bw0 = w0; bw1 = w1; }
            }
            if (lane == 0) {
                const float ws_ = 1.0f / (bw0 + bw1);
                const int p0 = __hip_atomic_fetch_add(&lcnt[bi0], 1, __ATOMIC_RELAXED, __HIP_MEMORY_SCOPE_WORKGROUP), p1 = __hip_atomic_fetch_add(&lcnt[bi1], 1, __ATOMIC_RELAXED, __HIP_MEMORY_SCOPE_WORKGROUP);
                int* rr = route + (size_t)n * 8;
                rr[0] = bi0; rr[1] = bi1; rr[2] = (int)p0; rr[3] = (int)p1; rr[4] = __float_as_int(bw0 * ws_); rr[5] = __float_as_int(bw1 * ws_);
            }
        }
#endif
    }
    __syncthreads();
    if (tid < 16) ((int*)(p.ws + WS_WGCNT))[((size_t)l * 1024 + blockIdx.x) * 16 + tid] = lcnt[tid];
}

__device__ __forceinline__ void build_moe_tab(const Params& p, int l, LAS int* tab) {
    if (threadIdx.x == 0) {
        const unsigned* cnt = (const unsigned*)(p.ws + WS_CNT) + l * 16;
        int acc = 0;
        for (int e = 0; e < 16; ++e) { tab[e] = acc; acc += (int)((cnt[e] + 255u) >> 8); }
        tab[16] = acc;
    }
    __syncthreads();
}

__device__ __forceinline__ void phase_permute(const Params& p, int l, LAS int* tab) {
    int tid_ = threadIdx.x; asm volatile("" : "+v"(tid_)); const int wave = __builtin_amdgcn_readfirstlane(tid_ >> 6), lane = tid_ & 63;
    LAS int* base = tab + 32; LAS int* total = tab + 48;
    if (tid_ < 16) { base[tid_] = 0; total[tid_] = 0; }
    __syncthreads();
    {
        const int* wgc = (const int*)(p.ws + WS_WGCNT) + (size_t)l * 1024 * 16;
        const int e = tid_ & 15; int bs = 0, tt = 0;
        for (int w = tid_ >> 4; w < (int)gridDim.x; w += 32) { const int v = wgc[w * 16 + e]; tt += v; bs += (w < (int)blockIdx.x) ? v : 0; }
        __hip_atomic_fetch_add(&base[e], bs, __ATOMIC_RELAXED, __HIP_MEMORY_SCOPE_WORKGROUP);
        __hip_atomic_fetch_add(&total[e], tt, __ATOMIC_RELAXED, __HIP_MEMORY_SCOPE_WORKGROUP);
    }
    __syncthreads();
    if (tid_ == 0) { int acc = 0; for (int e = 0; e < 16; ++e) { tab[e] = acc; acc += (total[e] + 255) >> 8; } tab[16] = acc; }
    if (blockIdx.x == 0 && tid_ < 16) ((unsigned*)(p.ws + WS_CNT))[l * 16 + tid_] = (unsigned)total[tid_];
    __syncthreads();
#if MOE_FP8
    for (int i = blockIdx.x * 512 + tid_; i < XE_ROWS * 8; i += gridDim.x * 512) *(u32x4*)(p.ws + WS_HID + (size_t)(i >> 3) * DEP + DE + (i & 7) * 16) = (u32x4){0u, 0u, 0u, 0u};
#endif
    int* route = (int*)(p.ws + WS_ROUTE);
#if MOE_FP8
    int* tok = (int*)(p.ws + WS_XE);
    {
        const int gt = blockIdx.x * 512 + tid_;
#pragma unroll 1
        for (int e = 0; e < 16; ++e) { const int s0 = tab[e] * 256, e1 = tab[e + 1] * 256; for (int i = s0 + total[e] + gt; i < e1; i += gridDim.x * 512) tok[i] = 0; }
    }
    for (int idx = tid_; ; idx += 512) {
        const int k = idx / (8 * RGRP), rem = idx - k * (8 * RGRP);
        const int n = (blockIdx.x * 8 + rem / RGRP) * RGRP + (rem % RGRP) + k * (int)gridDim.x * 8 * RGRP;
        if (n >= T) break;
        int* r = route + (size_t)n * 8;
        const int e0 = r[0], e1 = r[1], p0 = r[2], p1 = r[3];
        const int row0 = tab[e0] * 256 + base[e0] + p0, row1 = tab[e1] * 256 + base[e1] + p1;
        tok[row0] = n; tok[row1] = n; r[6] = row0; r[7] = row1;
    }
    (void)wave; (void)lane;
}
#else
    const bf16_t* hb = (const bf16_t*)(p.ws + WS_HB);
    bf16_t* xe = (bf16_t*)(p.ws + WS_XE);
    for (int m = (blockIdx.x * 8 + wave) * RGRP; m < T; m += gridDim.x * 8 * RGRP)
#pragma unroll 1
    for (int n = m; n < m + RGRP; ++n) {
        int* r = route + (size_t)n * 8;
        const int e0 = r[0], e1 = r[1], p0 = r[2], p1 = r[3];
        const int row0 = tab[e0] * 256 + base[e0] + p0, row1 = tab[e1] * 256 + base[e1] + p1;
        constexpr int RB = MOE_FP8 ? D : 2 * D;
        const u32x4* src = (const u32x4*)((const unsigned char*)hb + (size_t)n * RB);
        u32x4* d0 = (u32x4*)((unsigned char*)xe + (size_t)row0 * RB); u32x4* d1 = (u32x4*)((unsigned char*)xe + (size_t)row1 * RB);
#pragma unroll
        for (int i = 0; i < RB / 1024; ++i) { const u32x4 v = src[i * 64 + lane]; d0[i * 64 + lane] = v; d1[i * 64 + lane] = v; }
        if (lane == 0) { r[6] = row0; r[7] = row1; }
    }
}
#endif

#define LN2_RG 2
#define LN2_SB() __builtin_amdgcn_sched_barrier(0)
__device__ __forceinline__ void phase_ln2(const Params& p, int l) {
    int tid_ = threadIdx.x; asm volatile("" : "+v"(tid_)); const int wave = __builtin_amdgcn_readfirstlane(tid_ >> 6), lane = tid_ & 63;
    const float* mod = (const float*)(p.ws + WS_MOD);
    const float* ye = (const float*)(p.ws + WS_YE);
    float* xres = (float*)(p.ws + WS_XRES);
    const int* route = (const int*)(p.ws + WS_ROUTE);
    const int lane_ = lane;
    for (int n0 = (blockIdx.x * 8 + wave) * LN2_RG; n0 < T; n0 += gridDim.x * 8 * LN2_RG) {
        int lane = lane_; asm volatile("" : "+v"(lane));
        const int b = n0 / SEQ;
        const float* mb = mod + ((size_t)l * 4 + b) * (6 * D);
        float w0[LN2_RG], w1[LN2_RG]; const bf16_t* y0[LN2_RG]; const bf16_t* y1[LN2_RG];
#pragma unroll
        for (int r = 0; r < LN2_RG; ++r) {
            const int* rr = route + (size_t)(n0 + r) * 8;
            w0[r] = __int_as_float(__builtin_amdgcn_readfirstlane(rr[4])); w1[r] = __int_as_float(__builtin_amdgcn_readfirstlane(rr[5]));
            y0[r] = (const bf16_t*)ye + (size_t)__builtin_amdgcn_readfirstlane(rr[6]) * D; y1[r] = (const bf16_t*)ye + (size_t)__builtin_amdgcn_readfirstlane(rr[7]) * D;
        }
        float4 v[LN2_RG][8];
#pragma unroll
        for (int i = 0; i < 4; ++i) {
            float4 g[2];
#pragma unroll
            for (int q = 0; q < 2; ++q) g[q] = *(const float4*)(mb + 5 * D + COLK(2 * i + q));
#pragma unroll
            for (int rp = 0; rp < LN2_RG; rp += 2) {
                float4 xv[2][2], a[2][2], c[2][2];
#pragma unroll
                for (int r = 0; r < 2; ++r) { ld_bf8((const bf16_t*)xres + (size_t)(n0 + rp + r) * D + COL8(i), xv[r][0], xv[r][1]); ld_bf8(y0[rp + r] + COL8(i), a[r][0], a[r][1]); ld_bf8(y1[rp + r] + COL8(i), c[r][0], c[r][1]); }
#pragma unroll
                for (int q = 0; q < 2; ++q)
#pragma unroll
                    for (int r = 0; r < 2; ++r)
                        v[rp + r][2 * i + q] = make_float4(ALPHA * xv[r][q].x + (1.f + g[q].x) * (w0[rp + r] * a[r][q].x + w1[rp + r] * c[r][q].x), ALPHA * xv[r][q].y + (1.f + g[q].y) * (w0[rp + r] * a[r][q].y + w1[rp + r] * c[r][q].y),
                                                           ALPHA * xv[r][q].z + (1.f + g[q].z) * (w0[rp + r] * a[r][q].z + w1[rp + r] * c[r][q].z), ALPHA * xv[r][q].w + (1.f + g[q].w) * (w0[rp + r] * a[r][q].w + w1[rp + r] * c[r][q].w));
                LN2_SB();
            }
        }
        float mean[LN2_RG], rstd[LN2_RG];
#pragma unroll
        for (int r = 0; r < LN2_RG; ++r) {
            float s0 = 0.f;
#pragma unroll
            for (int i = 0; i < 8; ++i) s0 += (v[r][i].x + v[r][i].y) + (v[r][i].z + v[r][i].w);
            mean[r] = s0;
        }
#pragma unroll
        for (int o = 32; o > 0; o >>= 1)
#pragma unroll
            for (int r = 0; r < LN2_RG; ++r) mean[r] += __shfl_xor(mean[r], o, 64);
#pragma unroll
        for (int r = 0; r < LN2_RG; ++r) {
            mean[r] *= (1.0f / D);
            float q0 = 0.f;
#pragma unroll
            for (int i = 0; i < 8; ++i) { const float aa = v[r][i].x - mean[r], bb = v[r][i].y - mean[r], cc = v[r][i].z - mean[r], dd = v[r][i].w - mean[r]; q0 += (aa * aa + bb * bb) + (cc * cc + dd * dd); }
            rstd[r] = q0;
        }
#pragma unroll
        for (int o = 32; o > 0; o >>= 1)
#pragma unroll
            for (int r = 0; r < LN2_RG; ++r) rstd[r] += __shfl_xor(rstd[r], o, 64);
#pragma unroll
        for (int r = 0; r < LN2_RG; ++r) rstd[r] = rsqrtf(rstd[r] * (1.0f / D) + 1e-5f);
        const float* lg_ = p.ln_g + (size_t)(l * 2 + 1) * D; const float* lb_ = p.ln_b + (size_t)(l * 2 + 1) * D;
        LN2_SB();
#pragma unroll
        for (int i = 0; i < 8; ++i) {
            const float4 gv = *(const float4*)(lg_ + COLK(i)), bv = *(const float4*)(lb_ + COLK(i));
#pragma unroll
            for (int r = 0; r < LN2_RG; ++r) {
                float4& x = v[r][i];
                x.x = (x.x - mean[r]) * rstd[r] * gv.x + bv.x; x.y = (x.y - mean[r]) * rstd[r] * gv.y + bv.y;
                x.z = (x.z - mean[r]) * rstd[r] * gv.z + bv.z; x.w = (x.w - mean[r]) * rstd[r] * gv.w + bv.w;
            }
            if (i & 1) LN2_SB();
        }
        if (l + 1 < DEPTH) {
#pragma unroll
            for (int r = 0; r < LN2_RG; ++r)
#pragma unroll
                for (int i = 0; i < 4; ++i) st_bf8((bf16_t*)xres + (size_t)(n0 + r) * D + COL8(i), v[r][2 * i], v[r][2 * i + 1]);
            const float* mn = mod + ((size_t)(l + 1) * 4 + b) * (6 * D);
            LN2_SB();
#pragma unroll
            for (int i = 0; i < 4; ++i) {
                float4 sh[2], sc[2];
#pragma unroll
                for (int q = 0; q < 2; ++q) { sh[q] = *(const float4*)(mn + COLK(2 * i + q)); sc[q] = *(const float4*)(mn + D + COLK(2 * i + q)); }
#pragma unroll
                for (int r = 0; r < LN2_RG; ++r) {
                    float4 h[2];
#pragma unroll
                    for (int q = 0; q < 2; ++q) { const float4 x = v[r][2 * i + q]; h[q] = make_float4(x.x * (1.f + sc[q].x) + sh[q].x, x.y * (1.f + sc[q].y) + sh[q].y, x.z * (1.f + sc[q].z) + sh[q].z, x.w * (1.f + sc[q].w) + sh[q].w); }
                    if (INP8(l + 1)) st_fp8x8(p.ws + WS_HA + (size_t)(n0 + r) * D + COL8(i), h[0], h[1]);
                    else st_bf8((bf16_t*)(p.ws + WS_HA) + (size_t)(n0 + r) * D + COL8(i), h[0], h[1]);
                }
                LN2_SB();
            }
        } else {
#pragma unroll
            for (int r = 0; r < LN2_RG; ++r)
#pragma unroll
                for (int i = 0; i < 8; ++i) *(float4*)(p.out + (size_t)(n0 + r) * D + COLK(i)) = v[r][i];
        }
    }
}

typedef const __attribute__((address_space(4))) unsigned char* KargPtr;
__device__ __forceinline__ Params load_params(KargPtr q) { asm volatile("" : "+s"(q)); Params lp; __builtin_memcpy(&lp, (const __attribute__((address_space(4))) unsigned long long*)q, sizeof(Params)); return lp; }

__global__ __launch_bounds__(512, 2) void mega(Params p_in) {
    extern __shared__ __attribute__((aligned(16))) unsigned char smem[];
    LAS unsigned char* lds = (LAS unsigned char*)smem;
    LAS int* tab = (LAS int*)(lds + LDS_MISC + 64);
    KargPtr kp = (KargPtr)__builtin_amdgcn_kernarg_segment_ptr();
    if (threadIdx.x == 0) { *(LAS u32x4*)(lds + LDS_MISC) = (u32x4){0u, 0u, 0u, 0u}; *(LAS u32x4*)(lds + LDS_MISC + 768) = (u32x4){0u, 0u, 0u, 0u}; *(LAS u32x4*)(lds + LDS_MISC + 784) = (u32x4){0u, 0u, 0u, 0u}; }
    __syncthreads();
    const int fused = p_in.fused, ph_lo = p_in.ph_lo, ph_hi = p_in.ph_hi, l_hi = p_in.l_hi;
    XcdBarrier bar;
    if (fused) bar = xcd_barrier_post((unsigned*)(p_in.ws + WS_BAR), (volatile LAS unsigned*)(lds + LDS_MISC));
    else { bar.bar = (unsigned*)(p_in.ws + WS_BAR); bar.x = 0; bar.st = (volatile LAS unsigned*)(lds + LDS_MISC); }
#ifdef ONLY_PH
#define PH(i) ((i) == ONLY_PH && ph_lo <= (i) && (i) < ph_hi)
#else
#define PH(i) (ph_lo <= (i) && (i) < ph_hi)
#endif
#ifdef PROBE_PH
#define SYNC_PLAIN() do { if (fused) xcd_barrier(bar); } while (0)
#define PSTART(i) do { if ((i) == PROBE_PH && blockIdx.x == 0 && threadIdx.x == 0) { *(LAS unsigned long long*)(lds + LDS_MISC + 768) = __builtin_amdgcn_s_memrealtime(); } } while (0)
#define PSTOP(i) do { if ((i) == PROBE_PH && blockIdx.x == 0 && threadIdx.x == 0) { *(LAS unsigned long long*)(lds + LDS_MISC + 776) += __builtin_amdgcn_s_memrealtime() - *(LAS unsigned long long*)(lds + LDS_MISC + 768); } } while (0)
#else
#define PSTART(i) do { } while (0)
#define PSTOP(i) do { } while (0)
#endif
#if defined(PROBE_PH) && defined(PROBE_SUB)
#define QSTART(i, k) do { if ((i) == PROBE_PH && (k) == PROBE_SUB && blockIdx.x == PROBE_WG && threadIdx.x == 0) { *(LAS unsigned long long*)(lds + LDS_MISC + 784) = __builtin_amdgcn_s_memrealtime(); } } while (0)
#define QSTOP(i, k) do { if ((i) == PROBE_PH && (k) == PROBE_SUB && blockIdx.x == PROBE_WG && threadIdx.x == 0) { *(LAS unsigned long long*)(lds + LDS_MISC + 792) += __builtin_amdgcn_s_memrealtime() - *(LAS unsigned long long*)(lds + LDS_MISC + 784); } } while (0)
#else
#define QSTART(i, k) do { } while (0)
#define QSTOP(i, k) do { } while (0)
#endif
#define SYNC() do { if (fused) xcd_barrier(bar); } while (0)
#ifndef DUP_MASK
#define DUP_MASK 0
#endif
#define REP(i) _Pragma("unroll 1") for (int rep_ = 0; rep_ < 1 + ((DUP_MASK >> (i)) & 1); ++rep_)
    const int G = gridDim.x, c = blockIdx.x;
    if (PH(0)) REP(0) { PSTART(0); const Params p = load_params(kp); phase_prologue(p, lds); SYNC(); PSTOP(0); }
    if (PH(1)) REP(1) { PSTART(1); const Params p = load_params(kp); phase_ln0(p); SYNC(); PSTOP(1); }
    for (int l = p_in.l_lo; l < l_hi; ++l) {
        const bool svc = (l == 0) && (G >= 256);
        if (PH(2)) REP(2) { PSTART(2);
            const Params p = load_params(kp);
            pg8::Gemm g{(const bf16_t*)(p.ws + WS_HA), (const bf16_t*)(p.ws + WS_WIN) + (size_t)l * INC * D, D};
            pg8::EpiBf16 E{(bf16_t*)(p.ws + WS_PROJ), INC};
            if (svc) {
                if (c < 240) {
                    pg8::DenseOrder<32, 30> S; S.init(INP8(0) ? D : 2 * D, 240, c);
                    if (INP8(0)) pg8::gemm_phase<pg8::EpiBf16, pg8::DenseOrder<32, 30>, true>(lds, g, S, E, 121, 127);
                    else pg8::gemm_phase(lds, g, S, E);
                } else ada_chunks(p, lds, 128 + (c - 240), 256, 16);
                tail_pull(p, lds, l * 4 + 0);
            } else {
                pg8::DenseOrder<32, 32> S; S.init(INP8(l) ? D : 2 * D, G, c);
                if (INP8(l)) pg8::gemm_phase<pg8::EpiBf16, pg8::DenseOrder<32, 32>, true>(lds, g, S, E, 121, 127);
                else pg8::gemm_phase(lds, g, S, E);
            }
            SYNC(); PSTOP(2);
        }
#ifdef MIXER_CHECK
        if (PH(3)) REP(3) { PSTART(3); const Params p = load_params(kp); phase_mixer_valu(p, l, lds); SYNC(); PSTOP(3); }
        if (PH(3)) REP(3) { PSTART(3); const Params p = load_params(kp); phase_mixer_mfma<0>(p, l, lds, (float*)(p.ws + WS_XE)); SYNC(); PSTOP(3); }
        if (PH(3)) REP(3) { PSTART(3); const Params p = load_params(kp); phase_mixer_check(p, (const float*)(p.ws + WS_OBUF), (const float*)(p.ws + WS_XE), (float*)(p.ws + WS_CNT + 1024) + l * 8); SYNC(); PSTOP(3); }
#else
        if (PH(3)) REP(3) { PSTART(3);
            const Params p = load_params(kp);
            const int n_extra = svc ? 96 : 32, pn0 = svc ? 30 : 32;
            for (int uu = (G >= 224 ? c - 192 : c); uu >= 0 && uu < n_extra; uu += (G >= 224 ? 64 : G)) {
                const int RBI = INP8(l) ? D : 2 * D;
                pg8::OneUnit S; S.u0.aB = (size_t)(uu & 31) * 256 * RBI; S.u0.bB = (size_t)(pn0 + (uu >> 5)) * 256 * RBI; S.u0.row0 = (uu & 31) * 256; S.u0.col0 = (pn0 + (uu >> 5)) * 256;
                pg8::EpiBf16 E{(bf16_t*)(p.ws + WS_PROJ), INC};
                pg8::Gemm g{(const bf16_t*)(p.ws + WS_HA), (const bf16_t*)(p.ws + WS_WIN) + (size_t)l * INC * D, D};
                if (INP8(l)) pg8::gemm_phase<pg8::EpiBf16, pg8::OneUnit, true>(lds, g, S, E, 121, 127);
                else pg8::gemm_phase(lds, g, S, E);
            }
            phase_mixer_mfma<0>(p, l, lds, (float*)(p.ws + WS_OBUF));
            tail_pull(p, lds, l * 4 + 1);
            SYNC(); PSTOP(3);
#ifdef MIXER_PROBE
            phase_mixer_mfma<MIXER_PROBE>(p, l, lds, (float*)(p.ws + WS_XE));
            SYNC(); PSTOP(3);
#endif
        }
#endif
        if (PH(4)) REP(4) { PSTART(4); const Params p = load_params(kp); phase_finalize(p, l); SYNC(); PSTOP(4); }
        if (PH(5)) REP(5) { PSTART(5);
            const Params p = load_params(kp);
            pg8::DenseOrder<32, 8> S; S.init(OUT8(l) ? D : 2 * D, G, c);
            pg8::Gemm g{(const bf16_t*)(p.ws + WS_MIXED), (const bf16_t*)(p.ws + WS_WOUT) + (size_t)l * D * D, D};
            pg8::EpiBf16 E{(bf16_t*)(p.ws + WS_Y), D};
            if (OUT8(l)) pg8::gemm_phase<pg8::EpiBf16, pg8::DenseOrder<32, 8>, true>(lds, g, S, E, 121, 125);
            else pg8::gemm_phase(lds, g, S, E);
            if (fused) xcd_barrier<true>(bar, p.ws + WS_WRT, lds);
            PSTOP(5);
        }
        if (PH(6)) REP(6) { PSTART(6); const Params p = load_params(kp); phase_ln1_router(p, l, lds, fused && PH(5)); SYNC(); PSTOP(6); }
        if (PH(7)) REP(7) { PSTART(7); const Params p = load_params(kp); phase_permute(p, l, tab); cvt_pull(p, lds, l * CV_PER_L + CV_A1, nullptr, 0u); SYNC(); PSTOP(7); }
        if (PH(8)) REP(8) { PSTART(8);
            const Params p = load_params(kp);
            build_moe_tab(p, l, tab);
#if MOE_FP8
            pg8::MoeOrder S; S.tab = tab; S.NTn = 11; S.G = G; S.c = c; S.tstep = (size_t)256 * D; S.bexp = (size_t)2 * DE * D;
            pg8::Gemm g{(const bf16_t*)(p.ws + WS_HB), (const bf16_t*)(p.ws + WS_WGU + (size_t)l * NE * 2 * DE * D), D, (const int*)(p.ws + WS_XE)};
            pg8::EpiHidden8 E{p.ws + WS_HID};
            QSTART(8, 1); pg8::gemm_phase<pg8::EpiHidden8, pg8::MoeOrder, true, true>(lds, g, S, E, 121, 127); QSTOP(8, 1);
#else
            pg8::MoeOrder S; S.tab = tab; S.NTn = 11; S.G = G; S.c = c; S.tstep = (size_t)256 * D * 2; S.bexp = (size_t)2 * DE * D * 2;
            pg8::Gemm g{(const bf16_t*)(p.ws + WS_XE), (const bf16_t*)(p.ws + WS_WGU) + (size_t)l * NE * 2 * DE * D, D};
            pg8::EpiHidden E{(bf16_t*)(p.ws + WS_HID)};
            pg8::gemm_phase(lds, g, S, E);
#endif
            QSTART(8, 2); tail_pull(p, lds, l * 4 + 2); QSTOP(8, 2);
            QSTART(8, 3); cvt_pull(p, lds, (l + 1) * CV_PER_L, nullptr, 0u); QSTOP(8, 3);
            SYNC(); PSTOP(8);
        }
        if (PH(9)) REP(9) { PSTART(9);
            const Params p = load_params(kp);
            build_moe_tab(p, l, tab);
#if MOE_FP8
            pg8::MoeOrder S; S.tab = tab; S.NTn = 8; S.G = G; S.c = c; S.tstep = (size_t)256 * DEP; S.bexp = (size_t)D * DEP;
            pg8::Gemm g{(const bf16_t*)(p.ws + WS_HID), (const bf16_t*)(p.ws + WS_WD + (size_t)l * NE * D * DEP), DEP};
            pg8::EpiBf16 E{(bf16_t*)(p.ws + WS_YE), D};
            QSTART(9, 1); pg8::gemm_phase<pg8::EpiBf16, pg8::MoeOrder, true>(lds, g, S, E, 121, 124); QSTOP(9, 1);
#else
            pg8::MoeOrder S; S.tab = tab; S.NTn = 8; S.G = G; S.c = c; S.tstep = (size_t)256 * DE * 2; S.bexp = (size_t)D * DE * 2;
            pg8::Gemm g{(const bf16_t*)(p.ws + WS_HID), (const bf16_t*)(p.ws + WS_WD) + (size_t)l * NE * D * DE, DE};
            pg8::EpiBf16 E{(bf16_t*)(p.ws + WS_YE), D};
            pg8::gemm_phase(lds, g, S, E);
#endif
            QSTART(9, 2); tail_pull(p, lds, l * 4 + 3); QSTOP(9, 2);
            QSTART(9, 3); if (l + 1 < DEPTH) cvt_pull(p, lds, (l + 1) * CV_PER_L + CV_A0, nullptr, 0u); QSTOP(9, 3);
            SYNC(); PSTOP(9);
        }
        if (PH(10)) REP(10) { PSTART(10); const Params p = load_params(kp); phase_ln2(p, l); SYNC(); PSTOP(10); }
    }
#ifdef PROBE_PH
    if (blockIdx.x == 0 && threadIdx.x == 0) {
#ifdef PROBE_SUB
        const unsigned long long t = 0ull, t0 = __builtin_amdgcn_s_memrealtime();
#else
        const unsigned long long t = *(LAS unsigned long long*)(lds + LDS_MISC + 776) * 4ull, t0 = __builtin_amdgcn_s_memrealtime();
#endif
        while (__builtin_amdgcn_s_memrealtime() - t0 < t) __builtin_amdgcn_s_sleep(8);
    }
#ifdef PROBE_SUB
    if (blockIdx.x == PROBE_WG && threadIdx.x == 0) {
        const unsigned long long t = *(LAS unsigned long long*)(lds + LDS_MISC + 792) * 4ull, t0 = __builtin_amdgcn_s_memrealtime();
        while (__builtin_amdgcn_s_memrealtime() - t0 < t) __builtin_amdgcn_s_sleep(8);
    }
#endif
#endif
}

#ifndef MK_FUSED_LATE_
#define MK_FUSED_LATE_ 1
#endif
extern "C" void kernel_launch(void* const* d_in, const int* in_sizes, int n_in, void* d_out, int out_size, void* d_ws, size_t ws_size, hipStream_t stream) {
    static int grid = 0;
    if (grid == 0) {
        if (n_in != 18 || ws_size < WS_END) { fprintf(stderr, "kernel_launch: unexpected n_in %d or ws_size %zu (< %zu)\n", n_in, ws_size, (size_t)WS_END); grid = -1; return; }
        int dev = 0, cus = 0, per_cu = 0;
        hipGetDevice(&dev);
        hipDeviceGetAttribute(&cus, hipDeviceAttributeMultiprocessorCount, dev);
        if (hipFuncSetAttribute((const void*)mega, hipFuncAttributeMaxDynamicSharedMemorySize, LDS_BYTES) != hipSuccess) { fprintf(stderr, "kernel_launch: hipFuncSetAttribute failed\n"); grid = -1; return; }
        hipOccupancyMaxActiveBlocksPerMultiprocessor(&per_cu, (const void*)mega, 512, LDS_BYTES);
        if (per_cu < 1) fprintf(stderr, "kernel_launch: occupancy query says %d\n", per_cu);
        grid = cus > 0 ? cus : 256;
    }
    if (grid < 0) return;
    hipMemsetAsync(d_ws, 0, WS_ZERO_BYTES, stream);
    Params p{};
    p.x = (const float*)d_in[0]; p.c = (const float*)d_in[1]; p.emb_g = (const float*)d_in[2]; p.emb_b = (const float*)d_in[3];
    p.w_ada = (const float*)d_in[4]; p.b_ada = (const float*)d_in[5]; p.w_in = (const float*)d_in[6]; p.conv_w = (const float*)d_in[7];
    p.mix_beta = (const float*)d_in[8]; p.w_out = (const float*)d_in[9]; p.lb_logits = (const float*)d_in[10]; p.ln_g = (const float*)d_in[11];
    p.ln_b = (const float*)d_in[12]; p.w_router = (const float*)d_in[13]; p.router_bias = (const float*)d_in[14]; p.w_gate = (const float*)d_in[15];
    p.w_up = (const float*)d_in[16]; p.w_down = (const float*)d_in[17];
    p.out = (float*)d_out; p.ws = (unsigned char*)d_ws; p.pad = 0;
#if MK_FUSED
    p.ph_lo = 0; p.ph_hi = 11; p.l_lo = 0; p.l_hi = DEPTH; p.fused = 1;
    hipLaunchKernelGGL(mega, dim3(grid), dim3(512), LDS_BYTES, stream, p);
#else
    p.fused = 0;
    for (int ph = 0; ph < 2; ++ph) { p.ph_lo = ph; p.ph_hi = ph + 1; p.l_lo = 0; p.l_hi = 0; hipLaunchKernelGGL(mega, dim3(grid), dim3(512), LDS_BYTES, stream, p); }
    for (int l = 0; l < DEPTH; ++l)
        for (int ph = 2; ph < 11; ++ph) { p.ph_lo = ph; p.ph_hi = ph + 1; p.l_lo = l; p.l_hi = l + 1; hipLaunchKernelGGL(mega, dim3(grid), dim3(512), LDS_BYTES, stream, p); }
#endif
}
```
